# Optimizing an MI355X kernel written in HIP

```python
import math
import jax
import jax.numpy as jnp
from jax import lax
import numpy as np

D_MODEL = 1024
BATCH = 2
SEQ = 8192
DEPTH = 4

GDN_HEADS = 4
GDN_DK = 128
GDN_DV = 128
CONV_WIDTH = 4
GDN_CHUNK = 64
ATT_HEADS = 4
ATT_DH = 128
IDX_HEADS = 4
IDX_DH = 64
TOPK_MAX = 256
Q_BLOCK = 128
GLA_HEADS = 4
GLA_DK = D_MODEL // 2 // GLA_HEADS
GLA_DV = D_MODEL // GLA_HEADS
GLA_RANK = 16
GLA_TAU = 16.0
GLA_CHUNK = 64
N_GROUPS = 4
EXPERTS_PER_GROUP = 8
N_EXPERTS = N_GROUPS * EXPERTS_PER_GROUP
TOP_K_EXPERTS = 2
D_EXPERT = 512
MOE_BLOCK = 128
ROPE_THETA = 10000.0
EPS = 1e-6

GDN_QK = GDN_HEADS * GDN_DK
GDN_V = GDN_HEADS * GDN_DV
ATT_W = ATT_HEADS * ATT_DH
EVEN_SPLITS = [GDN_QK, GDN_QK, GDN_V, GDN_V, GDN_HEADS, GDN_HEADS,
               ATT_W, ATT_W, ATT_W, IDX_HEADS * IDX_DH, IDX_DH, IDX_HEADS]
EVEN_IN = int(sum(EVEN_SPLITS))
EVEN_MIX = GDN_V + ATT_W
ODD_SPLITS = [GLA_HEADS * GLA_DK, GLA_HEADS * GLA_DK, GLA_HEADS * GLA_DV,
              GLA_HEADS * GLA_DV, GLA_RANK]
ODD_IN = int(sum(ODD_SPLITS))
ODD_MIX = GLA_HEADS * GLA_DV

kernel_name = "hybrid_gdn_dsa_gla_hmoe_trunk"

F32 = jnp.float32


def split_cols(t, sizes):
    idx = np.cumsum(sizes)[:-1].tolist()
    return jnp.split(t, idx, axis=-1)


def rms_norm(t, g):
    tf = t.astype(F32)
    y = tf * lax.rsqrt(jnp.mean(tf * tf, axis=-1, keepdims=True) + EPS)
    return (y * g.astype(F32)).astype(t.dtype)


def l2_normalize(t):
    tf = t.astype(F32)
    return (tf * lax.rsqrt(jnp.sum(tf * tf, axis=-1, keepdims=True) + EPS)).astype(t.dtype)


def modulate(hn, shift, scale):
    return hn * (1 + scale[:, None, :]) + shift[:, None, :]


def rope_tables(positions, dim):
    inv = 1.0 / (ROPE_THETA ** (jnp.arange(0, dim, 2, dtype=F32) / dim))
    ang = positions.astype(F32)[..., None] * inv
    return jnp.cos(ang), jnp.sin(ang)


def apply_rope(t, cos, sin):
    t1, t2 = jnp.split(t.astype(F32), 2, axis=-1)
    c = cos[:, :, None, :]
    s = sin[:, :, None, :]
    return jnp.concatenate([t1 * c - t2 * s, t2 * c + t1 * s], axis=-1).astype(t.dtype)


def causal_depthwise_conv(t, w):
    width = w.shape[0]
    return lax.conv_general_dilated(
        t, w[:, None, :].astype(t.dtype), window_strides=(1,),
        padding=((width - 1, 0),), dimension_numbers=('NWC', 'WIO', 'NWC'),
        feature_group_count=t.shape[-1])


def to_chunks(t, chunk):
    b, s, h = t.shape[:3]
    t = t.reshape((b, s // chunk, chunk, h) + t.shape[3:])
    return t.transpose((1, 0, 3, 2) + tuple(range(4, t.ndim)))


def from_chunks(t):
    n, b, h, c = t.shape[:4]
    t = t.transpose((1, 0, 3, 2) + tuple(range(4, t.ndim)))
    return t.reshape((b, n * c, h) + t.shape[4:])


def gated_delta_rule(q, k, v, g, beta):
    dtype = v.dtype
    b_, _, h, dk = q.shape
    dv = v.shape[-1]
    c = GDN_CHUNK
    q = to_chunks(q.astype(F32) * dk ** -0.5, c)
    k = to_chunks(k.astype(F32), c)
    v = to_chunks(v.astype(F32), c)
    g = to_chunks(g.astype(F32), c)
    beta = to_chunks(beta.astype(F32), c)
    gc = jnp.cumsum(g, axis=-1)
    incl = jnp.tril(jnp.ones((c, c), bool))
    strict = jnp.tril(jnp.ones((c, c), bool), -1)
    decay = jnp.exp(jnp.where(incl, gc[..., :, None] - gc[..., None, :], -jnp.inf))
    kb = k * beta[..., None]
    lmat = jnp.where(strict, jnp.einsum('nbhid,nbhjd->nbhij', kb, k) * decay, 0.0)
    eye = jnp.eye(c, dtype=F32)
    tmat = lax.linalg.triangular_solve(eye + lmat, jnp.broadcast_to(eye, lmat.shape),
                                       left_side=True, lower=True, unit_diagonal=True)
    w = tmat @ (kb * jnp.exp(gc)[..., None])
    u = tmat @ (v * beta[..., None])
    aqk = jnp.einsum('nbhid,nbhjd->nbhij', q, k) * decay
    qg = q * jnp.exp(gc)[..., None]
    glast = gc[..., -1:]
    kd = k * jnp.exp(glast - gc)[..., None]

    def step(state, xs):
        qg_i, aqk_i, w_i, u_i, kd_i, gl_i = xs
        v_new = u_i - w_i @ state
        o = qg_i @ state + aqk_i @ v_new
        state = state * jnp.exp(gl_i)[..., None] + jnp.swapaxes(kd_i, -1, -2) @ v_new
        return state, o

    s0 = jnp.zeros((b_, h, dk, dv), F32)
    _, o = lax.scan(step, s0, (qg, aqk, w, u, kd, glast))
    return from_chunks(o).astype(dtype)


def gla_chunked(q, k, v, log_a):
    dtype = v.dtype
    b_, _, h, dk = q.shape
    dv = v.shape[-1]
    c = GLA_CHUNK
    q = to_chunks(q.astype(F32) * dk ** -0.5, c)
    k = to_chunks(k.astype(F32), c)
    v = to_chunks(v.astype(F32), c)
    bcum = jnp.cumsum(to_chunks(log_a.astype(F32), c), axis=-2)
    incl = jnp.tril(jnp.ones((c, c), bool))

    def step(state, xs):
        q_i, k_i, v_i, b_i = xs
        bl = b_i[..., -1:, :]
        o_inter = (q_i * jnp.exp(b_i)) @ state
        diff = jnp.where(incl[..., None], b_i[..., :, None, :] - b_i[..., None, :, :], -jnp.inf)
        att = jnp.einsum('bhid,bhjd,bhijd->bhij', q_i, k_i, jnp.exp(diff))
        o = o_inter + att @ v_i
        state = (state * jnp.swapaxes(jnp.exp(bl), -1, -2)
                 + jnp.swapaxes(k_i * jnp.exp(bl - b_i), -1, -2) @ v_i)
        return state, o

    s0 = jnp.zeros((b_, h, dk, dv), F32)
    _, o = lax.scan(step, s0, (q, k, v, bcum))
    return from_chunks(o).astype(dtype)


def dsa_sparse_attention(q, k, v, q_idx, k_idx, w_idx):
    b_, s_, h, dh = q.shape
    topk = min(TOPK_MAX, s_ // 4)
    nblk = s_ // Q_BLOCK
    key_pos = jnp.arange(s_)
    k_idx32 = k_idx.astype(F32)

    def blockify(t):
        return jnp.swapaxes(t.reshape((b_, nblk, Q_BLOCK) + t.shape[2:]), 0, 1)

    def one_block(args):
        q_b, qi_b, wi_b, start = args
        q_pos = start + jnp.arange(Q_BLOCK)
        dots = jnp.einsum('bqhd,bsd->bqhs', qi_b.astype(F32), k_idx32)
        score = jnp.einsum('bqh,bqhs->bqs', wi_b.astype(F32), jax.nn.relu(dots))
        causal = key_pos[None, :] <= q_pos[:, None]
        score = jnp.where(causal[None], score, -jnp.inf)
        _, sel = lax.top_k(score, topk)
        k_sel = jax.vmap(lambda kk, ii: kk[ii])(k, sel)
        v_sel = jax.vmap(lambda vv, ii: vv[ii])(v, sel)
        logits = jnp.einsum('bqhd,bqkhd->bqhk', q_b, k_sel).astype(F32) * dh ** -0.5
        valid = sel <= q_pos[None, :, None]
        logits = jnp.where(valid[:, :, None, :], logits, -jnp.inf)
        p = jax.nn.softmax(logits, axis=-1).astype(v.dtype)
        return jnp.einsum('bqhk,bqkhd->bqhd', p, v_sel)

    starts = jnp.arange(nblk) * Q_BLOCK
    out = lax.map(one_block, (blockify(q), blockify(q_idx), blockify(w_idx), starts))
    return jnp.swapaxes(out, 0, 1).reshape(b_, s_, h, dh)


def even_mixer(h, cos_a, sin_a, cos_i, sin_i, w_in, conv_w, a_log, dt_bias, out_norm, w_out):
    b_, s_, _ = h.shape
    heads = lambda t, n: t.reshape(b_, s_, n, -1)
    proj = h @ w_in
    qa, ka, va, za, ba, aa, qb, kb, vb, qi, ki, wi = split_cols(proj, EVEN_SPLITS)
    qkv = jax.nn.silu(causal_depthwise_conv(jnp.concatenate([qa, ka, va], axis=-1), conv_w))
    qa, ka, va = split_cols(qkv, [GDN_QK, GDN_QK, GDN_V])
    qa = l2_normalize(heads(qa, GDN_HEADS))
    ka = l2_normalize(heads(ka, GDN_HEADS))
    va = heads(va, GDN_HEADS)
    beta = jax.nn.sigmoid(ba.astype(F32))
    g = -jnp.exp(a_log.astype(F32)) * jax.nn.softplus(aa.astype(F32) + dt_bias.astype(F32))
    oa = gated_delta_rule(qa, ka, va, g, beta)
    oa = rms_norm(oa, out_norm) * jax.nn.silu(heads(za, GDN_HEADS))
    qb = apply_rope(heads(qb, ATT_HEADS), cos_a, sin_a)
    kb = apply_rope(heads(kb, ATT_HEADS), cos_a, sin_a)
    vb = heads(vb, ATT_HEADS)
    qi = apply_rope(heads(qi, IDX_HEADS), cos_i, sin_i)
    ki = apply_rope(ki[:, :, None, :], cos_i, sin_i)[:, :, 0, :]
    wi = wi * (IDX_HEADS * IDX_DH) ** -0.5
    ob = dsa_sparse_attention(qb, kb, vb, qi, ki, wi)
    o = jnp.concatenate([oa.reshape(b_, s_, -1), ob.reshape(b_, s_, -1)], axis=-1)
    return o @ w_out


def gla_mixer(h, w_in, w_gate2, b_gate2, out_norm, w_out):
    b_, s_, _ = h.shape
    heads = lambda t: t.reshape(b_, s_, GLA_HEADS, -1)
    proj = h @ w_in
    q, k, v, r, glr = split_cols(proj, ODD_SPLITS)
    log_a = jax.nn.log_sigmoid((glr @ w_gate2 + b_gate2).astype(F32)) / GLA_TAU
    o = gla_chunked(heads(q), heads(k), heads(v), heads(log_a))
    o = rms_norm(o, out_norm) * jax.nn.silu(heads(r))
    return o.reshape(b_, s_, -1) @ w_out


def hier_moe(h, wg, bg, we, be, w1, w3, w2):
    b_, s_, d = h.shape
    t = b_ * s_
    xt = h.reshape(t, d)
    tok_ids = jnp.arange(t)
    g_logits = (xt @ wg + bg).astype(F32)
    g_prob = jax.nn.softmax(g_logits, axis=-1)
    g_sel = jnp.argmax(g_logits, axis=-1)
    g_gate = g_prob[tok_ids, g_sel]
    e_logits = (jnp.einsum('td,gde->tge', xt, we) + be).astype(F32)
    e_logits = e_logits[tok_ids, g_sel]
    top_l, top_i = lax.top_k(e_logits, TOP_K_EXPERTS)
    gates = g_gate[:, None] * jax.nn.softmax(top_l, axis=-1)
    eid = (g_sel[:, None] * EXPERTS_PER_GROUP + top_i).reshape(-1).astype(jnp.int32)
    wts = gates.reshape(-1)
    tok = jnp.repeat(tok_ids.astype(jnp.int32), TOP_K_EXPERTS)
    m = t * TOP_K_EXPERTS
    counts = jnp.bincount(eid, length=N_EXPERTS)
    padded = ((counts + MOE_BLOCK - 1) // MOE_BLOCK) * MOE_BLOCK
    pad_end = jnp.cumsum(padded)
    pad_start = pad_end - padded
    raw_start = jnp.cumsum(counts) - counts
    order = jnp.argsort(eid)
    se = eid[order]
    dest = pad_start[se] + (jnp.arange(m) - raw_start[se])
    p_rows = (-(-m // MOE_BLOCK) + N_EXPERTS) * MOE_BLOCK
    buf_tok = jnp.zeros((p_rows,), jnp.int32).at[dest].set(tok[order])
    buf_w = jnp.zeros((p_rows,), F32).at[dest].set(wts[order])
    nblk = p_rows // MOE_BLOCK
    blk_exp = jnp.clip(jnp.searchsorted(pad_end, jnp.arange(nblk) * MOE_BLOCK, side='right'),
                       0, N_EXPERTS - 1)
    xb = xt[buf_tok].reshape(nblk, MOE_BLOCK, d)

    def expert_block(args):
        xi, e = args
        hid = jax.nn.silu(xi @ w1[e]) * (xi @ w3[e])
        return hid @ w2[e]

    yb = lax.map(expert_block, (xb, blk_exp)).reshape(p_rows, d)
    y = jnp.zeros((t, d), h.dtype).at[buf_tok].add(yb * buf_w[:, None].astype(yb.dtype))
    return y.reshape(b_, s_, d)


def setup_inputs(seed: int = 0) -> dict:
    key = jax.random.key(seed)
    d = D_MODEL
    n_even = (DEPTH + 1) // 2
    n_odd = DEPTH // 2

    def nrm(i, shape, scale):
        return jax.random.normal(jax.random.fold_in(key, i), shape, F32) * scale

    def gain(i, shape):
        return 1.0 + nrm(i, shape, 0.02)

    return {
        "x": nrm(0, (BATCH, SEQ, d), 1.0),
        "c": nrm(1, (BATCH, d), 1.0),
        "positions": jnp.broadcast_to(jnp.arange(SEQ, dtype=jnp.int32), (BATCH, SEQ)),
        "ada_w": nrm(2, (DEPTH, d, 6 * d), 0.5 * d ** -0.5),
        "ada_b": nrm(3, (DEPTH, 6 * d), 0.02),
        "norm_mix": gain(4, (DEPTH, d)),
        "norm_ffn": gain(5, (DEPTH, d)),
        "even_w_in": nrm(6, (n_even, d, EVEN_IN), d ** -0.5),
        "gdn_conv_w": nrm(7, (n_even, CONV_WIDTH, 2 * GDN_QK + GDN_V), CONV_WIDTH ** -0.5),
        "gdn_a_log": jnp.log(jax.random.uniform(jax.random.fold_in(key, 8), (n_even, GDN_HEADS), F32, 1.0, 16.0)),
        "gdn_dt_bias": nrm(9, (n_even, GDN_HEADS), 0.1),
        "gdn_out_norm": gain(10, (n_even, GDN_DV)),
        "even_w_out": nrm(11, (n_even, EVEN_MIX, d), EVEN_MIX ** -0.5),
        "gla_w_in": nrm(12, (n_odd, d, ODD_IN), d ** -0.5),
        "gla_w_gate2": nrm(13, (n_odd, GLA_RANK, GLA_HEADS * GLA_DK), GLA_RANK ** -0.5),
        "gla_b_gate2": nrm(14, (n_odd, GLA_HEADS * GLA_DK), 0.1),
        "gla_out_norm": gain(15, (n_odd, GLA_DV)),
        "gla_w_out": nrm(16, (n_odd, ODD_MIX, d), ODD_MIX ** -0.5),
        "router_group_w": nrm(17, (DEPTH, d, N_GROUPS), d ** -0.5),
        "router_group_b": nrm(18, (DEPTH, N_GROUPS), 0.01),
        "router_exp_w": nrm(19, (DEPTH, N_GROUPS, d, EXPERTS_PER_GROUP), d ** -0.5),
        "router_exp_b": nrm(20, (DEPTH, N_GROUPS, EXPERTS_PER_GROUP), 0.01),
        "exp_w1": nrm(21, (DEPTH, N_EXPERTS, d, D_EXPERT), d ** -0.5),
        "exp_w3": nrm(22, (DEPTH, N_EXPERTS, d, D_EXPERT), d ** -0.5),
        "exp_w2": nrm(23, (DEPTH, N_EXPERTS, D_EXPERT, d), D_EXPERT ** -0.5),
        "final_norm": gain(24, (d,)),
    }


def reference(x, c, positions, ada_w, ada_b, norm_mix, norm_ffn,
              even_w_in, gdn_conv_w, gdn_a_log, gdn_dt_bias, gdn_out_norm, even_w_out,
              gla_w_in, gla_w_gate2, gla_b_gate2, gla_out_norm, gla_w_out,
              router_group_w, router_group_b, router_exp_w, router_exp_b,
              exp_w1, exp_w3, exp_w2, final_norm):
    cos_a, sin_a = rope_tables(positions, ATT_DH)
    cos_i, sin_i = rope_tables(positions, IDX_DH)
    cond = jax.nn.silu(c)
    for layer in range(DEPTH):
        mod = cond @ ada_w[layer] + ada_b[layer]
        sh_m, sc_m, gt_m, sh_f, sc_f, gt_f = jnp.split(mod, 6, axis=-1)
        h = modulate(rms_norm(x, norm_mix[layer]), sh_m, sc_m)
        i = layer // 2
        if layer % 2 == 0:
            mix = even_mixer(h, cos_a, sin_a, cos_i, sin_i, even_w_in[i], gdn_conv_w[i],
                             gdn_a_log[i], gdn_dt_bias[i], gdn_out_norm[i], even_w_out[i])
        else:
            mix = gla_mixer(h, gla_w_in[i], gla_w_gate2[i], gla_b_gate2[i],
                            gla_out_norm[i], gla_w_out[i])
        x = x + gt_m[:, None, :] * mix
        h = modulate(rms_norm(x, norm_ffn[layer]), sh_f, sc_f)
        x = x + gt_f[:, None, :] * hier_moe(h, router_group_w[layer], router_group_b[layer],
                                           router_exp_w[layer], router_exp_b[layer],
                                           exp_w1[layer], exp_w3[layer], exp_w2[layer])
    return rms_norm(x, final_norm)
```

```cpp
#include <hip/hip_runtime.h>
#include <stdint.h>
#include <math.h>
#include <stdio.h>

#ifndef MK_MULTI
#define MK_MULTI 1
#endif

namespace {

constexpr int NT = 16384, ND = 1024, LDP = 3920;
constexpr float EPS = 1e-6f;
constexpr int NTHREADS = 512;
constexpr size_t LDS_BYTES = 147456;
constexpr float SCALE128 = 0.08838834764831845f;
constexpr int LISTCAP = 32768;

constexpr size_t OFF_BAR  = 0;
constexpr size_t OFF_CNT  = 16384;
constexpr size_t ZERO_BYTES = 32768;
constexpr size_t OFF_MOD  = 32768;
constexpr size_t OFF_COSA = OFF_MOD + 4 * 2 * 6144 * 4;
constexpr size_t OFF_SINA = OFF_COSA + (size_t)NT * 64 * 4;
constexpr size_t OFF_COSI = OFF_SINA + (size_t)NT * 64 * 4;
constexpr size_t OFF_SINI = OFF_COSI + (size_t)NT * 32 * 4;
constexpr size_t OFF_H    = OFF_SINI + (size_t)NT * 32 * 4;
constexpr size_t OFF_P    = OFF_H + (size_t)NT * 1024 * 4;
constexpr size_t OFF_HID  = OFF_P;
constexpr size_t OFF_YB   = OFF_HID + (size_t)36864 * 512 * 4;
constexpr size_t OFF_O    = OFF_P + (size_t)NT * LDP * 4;
constexpr size_t OFF_ASG  = OFF_O + (size_t)NT * 1024 * 4;
constexpr size_t OFF_GATE = OFF_ASG + (size_t)NT * 4 * 4;
constexpr size_t OFF_LIST = OFF_GATE + (size_t)NT * 2 * 4;
constexpr size_t OFF_R    = OFF_LIST + (size_t)32 * LISTCAP * 4;
constexpr size_t OFF_QN   = OFF_R;
constexpr size_t OFF_KN   = OFF_QN + (size_t)NT * 512 * 4;
constexpr size_t OFF_VC   = OFF_KN + (size_t)NT * 512 * 4;
constexpr size_t OFF_BETA = OFF_VC + (size_t)NT * 512 * 4;
constexpr size_t OFF_G    = OFF_BETA + (size_t)NT * 4 * 4;
constexpr size_t OFF_W    = OFF_G + (size_t)NT * 4 * 4;
constexpr size_t OFF_U    = OFF_W + (size_t)1024 * 8192 * 4;
constexpr size_t OFF_QG   = OFF_U + (size_t)1024 * 8192 * 4;
constexpr size_t OFF_KD   = OFF_QG + (size_t)1024 * 8192 * 4;
constexpr size_t OFF_AQK  = OFF_KD + (size_t)1024 * 8192 * 4;
constexpr size_t OFF_GL   = OFF_AQK + (size_t)1024 * 4096 * 4;
constexpr size_t OFF_QB   = OFF_GL + 4096;
constexpr size_t OFF_KB   = OFF_QB + (size_t)NT * 512 * 4;
constexpr size_t OFF_QI   = OFF_KB + (size_t)NT * 512 * 4;
constexpr size_t OFF_KI   = OFF_QI + (size_t)NT * 256 * 4;
constexpr size_t OFF_WI   = OFF_KI + (size_t)NT * 64 * 4;
constexpr size_t OFF_SEL  = OFF_WI + (size_t)NT * 4 * 4;
constexpr size_t OFF_EVEN_END = OFF_SEL + (size_t)NT * 256 * 4;
constexpr size_t OFF_LA   = OFF_R;
constexpr size_t OFF_ATT  = OFF_LA + (size_t)NT * 512 * 4;
constexpr size_t OFF_QE   = OFF_ATT + (size_t)1024 * 4096 * 4;
constexpr size_t OFF_GKD  = OFF_QE + (size_t)1024 * 8192 * 4;
constexpr size_t OFF_EBL  = OFF_GKD + (size_t)1024 * 8192 * 4;
constexpr size_t WS_NEEDED = OFF_EVEN_END;

struct Params {
    const float* x; const float* c; const int* pos; const float* ada_w; const float* ada_b;
    const float* norm_mix; const float* norm_ffn; const float* even_w_in; const float* conv_w;
    const float* a_log; const float* dt_bias; const float* gdn_out_norm; const float* even_w_out;
    const float* gla_w_in; const float* gla_w_gate2; const float* gla_b_gate2; const float* gla_out_norm; const float* gla_w_out;
    const float* rg_w; const float* rg_b; const float* re_w; const float* re_b;
    const float* w1; const float* w3; const float* w2; const float* final_norm;
    float* X;
    unsigned char* ws;
    double rA, rI;
};

#define XB_TMO      128
#define XB_XCNT(j)  (256  + 64 * (j))
#define XB_XSUB(j)  (1280 + 64 * (j))
#define XB_XGEN(j)  (2304 + 64 * (j))
#define XB_TOP      3328
#define XB_TOPGEN   3392
#define XCD_BAR_WORDS 3456
#define XB_SPIN_CAP (1u << 18)
#define LAS __attribute__((address_space(3)))

__device__ __forceinline__ unsigned xb_ld(unsigned* p)              { return __hip_atomic_load(p, __ATOMIC_RELAXED, __HIP_MEMORY_SCOPE_AGENT); }
__device__ __forceinline__ unsigned xb_add(unsigned* p, unsigned v) { return __hip_atomic_fetch_add(p, v, __ATOMIC_RELAXED, __HIP_MEMORY_SCOPE_AGENT); }
__device__ __forceinline__ unsigned xb_xcc_id() { return (unsigned)__builtin_amdgcn_s_getreg((3 << 11) | 20) & 0xFu; }
#define XB_SPIN(cond, bar) do { unsigned _sp = 0; while (cond) { __builtin_amdgcn_s_sleep(1); \
    if ((++_sp & 255u) == 0u) { if (xb_ld(&(bar)[XB_TMO])) break; if (_sp > XB_SPIN_CAP) { atomicAdd(&(bar)[XB_TMO], 1u); break; } } } } while (0)

struct XcdBarrier { unsigned* bar; unsigned x; volatile LAS unsigned* st; };

__device__ __forceinline__ XcdBarrier xcd_barrier_post(unsigned* bar, volatile LAS unsigned* st) {
    XcdBarrier b; b.bar = bar; b.x = xb_xcc_id(); b.st = st;
    if (threadIdx.x == 0) (void)xb_add(&bar[XB_XCNT(b.x)], 1u);
    return b;
}
__device__ __forceinline__ void xcd_barrier_complete(unsigned* bar, unsigned x, unsigned& nloc, unsigned& nx) {
    const unsigned G = gridDim.x * gridDim.y * gridDim.z;
    unsigned sum, cnt, mine, sp = 0u;
    for (;;) {
        sum = 0u; cnt = 0u; mine = 0u;
#pragma unroll
        for (unsigned j = 0; j < 16; ++j) { const unsigned c = xb_ld(&bar[XB_XCNT(j)]); sum += c; cnt += (c > 0u) ? 1u : 0u; mine = (j == x) ? c : mine; }
        if (sum == G) break;
        __builtin_amdgcn_s_sleep(1);
        if ((++sp & 255u) == 0u) { if (xb_ld(&bar[XB_TMO])) break; if (sp > XB_SPIN_CAP) { atomicAdd(&bar[XB_TMO], 1u); break; } }
    }
    nloc = mine > 0u ? mine : 1u; nx = cnt > 0u ? cnt : 1u;
}
__device__ __forceinline__ void xcd_barrier(const XcdBarrier& b) {
    asm volatile("s_waitcnt vmcnt(0)" ::: "memory");
    __syncthreads();
    if (threadIdx.x == 0) {
        unsigned* bar = b.bar;
        __builtin_amdgcn_s_waitcnt(0);
        unsigned nloc = b.st[0], nx = b.st[1];
        if (nloc == 0u) { xcd_barrier_complete(bar, b.x, nloc, nx); b.st[0] = nloc; b.st[1] = nx; }
        const unsigned old = xb_add(&bar[XB_XSUB(b.x)], 1u);
        const unsigned gen = old / nloc;
        if (old + 1u == (gen + 1u) * nloc) {
            __builtin_amdgcn_fence(__ATOMIC_RELEASE, "agent");
            asm volatile("s_waitcnt vmcnt(0)" ::: "memory");
            const unsigned og = xb_add(&bar[XB_TOP], 1u);
            const unsigned tg = og / nx;
            if (og + 1u == (tg + 1u) * nx) xb_add(&bar[XB_TOPGEN], 1u);
            else XB_SPIN(xb_ld(&bar[XB_TOPGEN]) == tg, bar);
            __builtin_amdgcn_fence(__ATOMIC_ACQUIRE, "agent");
            xb_add(&bar[XB_XGEN(b.x)], 1u);
            asm volatile("s_waitcnt vmcnt(0)" ::: "memory");
        } else {
            XB_SPIN(xb_ld(&bar[XB_XGEN(b.x)]) == gen, bar);
            __builtin_amdgcn_fence(__ATOMIC_ACQUIRE, "agent");
            asm volatile("s_waitcnt vmcnt(0)" ::: "memory");
        }
    }
    __syncthreads();
}

__device__ __forceinline__ float wave_sum(float v) {
#pragma unroll
    for (int o = 32; o > 0; o >>= 1) v += __shfl_xor(v, o);
    return v;
}
__device__ __forceinline__ int wave_sum_i(int v) {
#pragma unroll
    for (int o = 32; o > 0; o >>= 1) v += __shfl_xor(v, o);
    return v;
}
__device__ __forceinline__ float wave_max(float v) {
#pragma unroll
    for (int o = 32; o > 0; o >>= 1) v = fmaxf(v, __shfl_xor(v, o));
    return v;
}
__device__ __forceinline__ float sigmoidf_(float x) { return 1.f / (1.f + expf(-x)); }
__device__ __forceinline__ float siluf_(float x) { return x / (1.f + expf(-x)); }
__device__ __forceinline__ float softplusf_(float x) { return fmaxf(x, 0.f) + log1pf(expf(-fabsf(x))); }
__device__ __forceinline__ unsigned ordkey(float f) { const unsigned u = __float_as_uint(f); return (u & 0x80000000u) ? ~u : (u | 0x80000000u); }

__device__ __forceinline__ void sincos_d(double a, double& s, double& c) {
    const double kq = rint(a * 0.63661977236758134308);
    double r = fma(-kq, 1.57079632673412561417e+00, a);
    r = fma(-kq, 6.07710050650619224932e-11, r);
    const int q = (int)((long long)kq & 3);
    const double r2 = r * r;
    const double sp = r * (1.0 + r2 * (-1.0 / 6 + r2 * (1.0 / 120 + r2 * (-1.0 / 5040 + r2 * (1.0 / 362880 + r2 * (-1.0 / 39916800 + r2 * (1.0 / 6227020800.0)))))));
    const double cp = 1.0 + r2 * (-0.5 + r2 * (1.0 / 24 + r2 * (-1.0 / 720 + r2 * (1.0 / 40320 + r2 * (-1.0 / 3628800 + r2 * (1.0 / 479001600.0 + r2 * (-1.0 / 87178291200.0)))))));
    if (q == 0) { s = sp; c = cp; } else if (q == 1) { s = cp; c = -sp; } else if (q == 2) { s = -sp; c = -cp; } else { s = -cp; c = sp; }
}
__device__ __forceinline__ double ipow_d(double b, int e) { double v = 1.0; while (e) { if (e & 1) v *= b; b *= b; e >>= 1; } return v; }

struct GemmArgs { const float* A; int lda; const int* rows; int m0; int mvalid; const float* B; int ldb; int n0; int N; int K; };

template <class Epi>
__device__ __forceinline__ void gemm128(const GemmArgs& g, float* smem, Epi epi) {
    float* As = smem;
    float* Bs = smem + 16 * 132;
    const int tid = threadIdx.x, ty = tid >> 4, tx = tid & 15;
    const int arow = tid >> 2, kq = (tid & 3) * 4;
    const int bk = tid >> 5, bn = (tid & 31) * 4;
    long asrc = -1;
    if (arow < g.mvalid) { const int r = g.rows ? g.rows[arow] : (g.m0 + arow); if (r >= 0) asrc = (long)r * g.lda; }
    const bool bval = (g.n0 + bn) < g.N;
    float acc[4][8];
#pragma unroll
    for (int i = 0; i < 4; ++i)
#pragma unroll
        for (int j = 0; j < 8; ++j) acc[i][j] = 0.f;
    for (int k0 = 0; k0 < g.K; k0 += 16) {
        float4 av = make_float4(0.f, 0.f, 0.f, 0.f), bv = make_float4(0.f, 0.f, 0.f, 0.f);
        if (asrc >= 0) av = *(const float4*)(g.A + asrc + k0 + kq);
        if (bval) bv = *(const float4*)(g.B + (size_t)(k0 + bk) * g.ldb + g.n0 + bn);
        __syncthreads();
        As[(kq + 0) * 132 + arow] = av.x; As[(kq + 1) * 132 + arow] = av.y; As[(kq + 2) * 132 + arow] = av.z; As[(kq + 3) * 132 + arow] = av.w;
        *(float4*)&Bs[bk * 132 + bn] = bv;
        __syncthreads();
#pragma unroll
        for (int kk = 0; kk < 16; ++kk) {
            const float4 a = *(const float4*)&As[kk * 132 + ty * 4];
            const float4 b0 = *(const float4*)&Bs[kk * 132 + tx * 8];
            const float4 b1 = *(const float4*)&Bs[kk * 132 + tx * 8 + 4];
            const float aa[4] = {a.x, a.y, a.z, a.w};
            const float bb[8] = {b0.x, b0.y, b0.z, b0.w, b1.x, b1.y, b1.z, b1.w};
#pragma unroll
            for (int i = 0; i < 4; ++i)
#pragma unroll
                for (int j = 0; j < 8; ++j) acc[i][j] += aa[i] * bb[j];
        }
    }
#pragma unroll
    for (int i = 0; i < 4; ++i) {
        const int r = ty * 4 + i;
        if (r < g.mvalid) {
#pragma unroll
            for (int j = 0; j < 8; ++j) { const int n = g.n0 + tx * 8 + j; if (n < g.N) epi(r, n, acc[i][j]); }
        }
    }
}

enum { PH_PROLOGUE = 0, PH_NORM_MIX, PH_GEMM_IN_EVEN, PH_EVEN_TOK, PH_GDN_CHUNK, PH_GDN_SCAN, PH_DSA_TOPK, PH_DSA_ATTN, PH_GDN_OUT,
       PH_GEMM_OUT, PH_NORM_FFN, PH_MOE1, PH_MOE2, PH_GEMM_IN_ODD, PH_GLA_TOK, PH_GLA_CHUNK, PH_GLA_SCAN, PH_GLA_OUT, PH_FINAL };

__device__ void ph_prologue(const Params& p, float* smem) {
    const int tid = threadIdx.x, nthr = gridDim.x * NTHREADS, gid = blockIdx.x * NTHREADS + tid;
    { const float4* src = (const float4*)p.x; float4* dst = (float4*)p.X;
      for (size_t i = gid; i < (size_t)NT * ND / 4; i += nthr) dst[i] = src[i]; }
    for (int i = tid; i < 2 * ND; i += NTHREADS) smem[i] = siluf_(p.c[i]);
    __syncthreads();
    float* MOD = (float*)(p.ws + OFF_MOD);
    for (int o = gid; o < 4 * 6144; o += nthr) {
        const int l = o / 6144, n = o % 6144;
        const float* w = p.ada_w + (size_t)l * ND * 6144 + n;
        float a0 = 0.f, a1 = 0.f;
        for (int k = 0; k < ND; ++k) { const float wv = w[(size_t)k * 6144]; a0 += smem[k] * wv; a1 += smem[ND + k] * wv; }
        const float bb = p.ada_b[l * 6144 + n];
        MOD[(l * 2 + 0) * 6144 + n] = a0 + bb; MOD[(l * 2 + 1) * 6144 + n] = a1 + bb;
    }
    float* COSA = (float*)(p.ws + OFF_COSA); float* SINA = (float*)(p.ws + OFF_SINA);
    float* COSI = (float*)(p.ws + OFF_COSI); float* SINI = (float*)(p.ws + OFF_SINI);
    for (size_t i = gid; i < (size_t)NT * 64; i += nthr) {
        const int t = (int)(i >> 6), j = (int)(i & 63);
        double s, c; sincos_d((double)p.pos[t] * ipow_d(p.rA, j), s, c);
        COSA[i] = (float)c; SINA[i] = (float)s;
    }
    for (size_t i = gid; i < (size_t)NT * 32; i += nthr) {
        const int t = (int)(i >> 5), j = (int)(i & 31);
        double s, c; sincos_d((double)p.pos[t] * ipow_d(p.rI, j), s, c);
        COSI[i] = (float)c; SINI[i] = (float)s;
    }
}

__device__ void ph_rows(const Params& p, int layer, int mode, float* smem) {
    const int tid = threadIdx.x, lane = tid & 63, wv = tid >> 6;
    int* pad = (int*)smem;
    const int moe_layer = (mode == 1) ? 3 : layer - 1;
    if (moe_layer >= 0) {
        if (tid == 0) { const int* cnt = (const int*)(p.ws + OFF_CNT) + moe_layer * 32; int a = 0; for (int e = 0; e < 32; ++e) { pad[e] = a; a += ((cnt[e] + 127) / 128) * 128; } }
        __syncthreads();
    }
    const float* MOD = (const float*)(p.ws + OFF_MOD);
    float* H = (float*)(p.ws + OFF_H);
    const float* YB = (const float*)(p.ws + OFF_YB);
    const int* ASG = (const int*)(p.ws + OFF_ASG);
    const float* GATE = (const float*)(p.ws + OFF_GATE);
    for (int row = blockIdx.x * 8 + wv; row < NT; row += gridDim.x * 8) {
        const int b = row >> 13;
        float* xr = p.X + (size_t)row * ND;
        float xv[16];
#pragma unroll
        for (int j = 0; j < 4; ++j) { const float4 v = *(const float4*)(xr + j * 256 + lane * 4); xv[4 * j] = v.x; xv[4 * j + 1] = v.y; xv[4 * j + 2] = v.z; xv[4 * j + 3] = v.w; }
        if (moe_layer >= 0) {
            const float* gt = MOD + (size_t)(moe_layer * 2 + b) * 6144 + 5 * 1024;
            const int e0 = ASG[row * 4 + 0], r0 = ASG[row * 4 + 1], e1 = ASG[row * 4 + 2], r1 = ASG[row * 4 + 3];
            const float g0 = GATE[row * 2], g1 = GATE[row * 2 + 1];
            const float* y0 = YB + (size_t)(pad[e0] + r0) * ND;
            const float* y1 = YB + (size_t)(pad[e1] + r1) * ND;
#pragma unroll
            for (int j = 0; j < 4; ++j) {
                const int col = j * 256 + lane * 4;
                const float4 a = *(const float4*)(y0 + col), bq = *(const float4*)(y1 + col), g = *(const float4*)(gt + col);
                xv[4 * j] += g.x * (g0 * a.x + g1 * bq.x); xv[4 * j + 1] += g.y * (g0 * a.y + g1 * bq.y);
                xv[4 * j + 2] += g.z * (g0 * a.z + g1 * bq.z); xv[4 * j + 3] += g.w * (g0 * a.w + g1 * bq.w);
                if (mode == 0) *(float4*)(xr + col) = make_float4(xv[4 * j], xv[4 * j + 1], xv[4 * j + 2], xv[4 * j + 3]);
            }
        }
        float ss = 0.f;
#pragma unroll
        for (int j = 0; j < 16; ++j) ss += xv[j] * xv[j];
        ss = wave_sum(ss);
        const float rstd = rsqrtf(ss * (1.f / 1024.f) + EPS);
        if (mode == 0) {
            const float* nw = p.norm_mix + layer * 1024;
            const float* sh = MOD + (size_t)(layer * 2 + b) * 6144;
            const float* sc = sh + 1024;
#pragma unroll
            for (int j = 0; j < 4; ++j) {
                const int col = j * 256 + lane * 4;
                const float4 w = *(const float4*)(nw + col), s4 = *(const float4*)(sc + col), h4 = *(const float4*)(sh + col);
                float4 o;
                o.x = xv[4 * j] * rstd * w.x * (1.f + s4.x) + h4.x; o.y = xv[4 * j + 1] * rstd * w.y * (1.f + s4.y) + h4.y;
                o.z = xv[4 * j + 2] * rstd * w.z * (1.f + s4.z) + h4.z; o.w = xv[4 * j + 3] * rstd * w.w * (1.f + s4.w) + h4.w;
                *(float4*)(H + (size_t)row * ND + col) = o;
            }
        } else {
#pragma unroll
            for (int j = 0; j < 4; ++j) {
                const int col = j * 256 + lane * 4;
                const float4 w = *(const float4*)(p.final_norm + col);
                *(float4*)(xr + col) = make_float4(xv[4 * j] * rstd * w.x, xv[4 * j + 1] * rstd * w.y, xv[4 * j + 2] * rstd * w.z, xv[4 * j + 3] * rstd * w.w);
            }
        }
    }
}

__device__ void ph_gemm_in(const Params& p, int layer, bool even, float* smem) {
    const int N = even ? 3916 : 3088;
    const float* Wt = even ? p.even_w_in + (size_t)(layer >> 1) * ND * 3916 : p.gla_w_in + (size_t)(layer >> 1) * ND * 3088;
    const int ntn = (N + 127) / 128, ntiles = 128 * ntn;
    float* P = (float*)(p.ws + OFF_P);
    for (int tile = blockIdx.x; tile < ntiles; tile += gridDim.x) {
        const int mt = tile % 128, nt = tile / 128;
        GemmArgs g; g.A = (const float*)(p.ws + OFF_H); g.lda = ND; g.rows = nullptr; g.m0 = mt * 128; g.mvalid = 128; g.B = Wt; g.ldb = N; g.n0 = nt * 128; g.N = N; g.K = ND;
        float* Pt = P + (size_t)mt * 128 * LDP;
        gemm128(g, smem, [=](int r, int n, float v) { Pt[(size_t)r * LDP + n] = v; });
    }
}

__device__ void ph_even_tok(const Params& p, int layer, float* smem) {
    const int tid = threadIdx.x, lane = tid & 63, wv = tid >> 6, li = layer >> 1;
    const float* P = (const float*)(p.ws + OFF_P);
    const float* cw = p.conv_w + (size_t)li * 4 * 1536;
    float* QN = (float*)(p.ws + OFF_QN); float* KN = (float*)(p.ws + OFF_KN); float* VC = (float*)(p.ws + OFF_VC);
    float* BETA = (float*)(p.ws + OFF_BETA); float* G = (float*)(p.ws + OFF_G);
    float* QB = (float*)(p.ws + OFF_QB); float* KB = (float*)(p.ws + OFF_KB); float* QI = (float*)(p.ws + OFF_QI); float* KI = (float*)(p.ws + OFF_KI); float* WI = (float*)(p.ws + OFF_WI);
    const float* COSA = (const float*)(p.ws + OFF_COSA); const float* SINA = (const float*)(p.ws + OFF_SINA);
    const float* COSI = (const float*)(p.ws + OFF_COSI); const float* SINI = (const float*)(p.ws + OFF_SINI);
    for (int t = blockIdx.x * 8 + wv; t < NT; t += gridDim.x * 8) {
        const int s = t & 8191;
        const float* Pt = P + (size_t)t * LDP;
        auto convs = [&](int c) -> float {
            float a = 0.f;
#pragma unroll
            for (int j = 0; j < 4; ++j) { if (s - 3 + j >= 0) a += cw[j * 1536 + c] * P[(size_t)(t - 3 + j) * LDP + c]; }
            return siluf_(a);
        };
#pragma unroll 1
        for (int h = 0; h < 4; ++h) {
            const float q0 = convs(h * 128 + lane), q1 = convs(h * 128 + 64 + lane);
            float ss = wave_sum(q0 * q0 + q1 * q1);
            float r = rsqrtf(ss + EPS);
            QN[(size_t)t * 512 + h * 128 + lane] = q0 * r; QN[(size_t)t * 512 + h * 128 + 64 + lane] = q1 * r;
            const float k0 = convs(512 + h * 128 + lane), k1 = convs(512 + h * 128 + 64 + lane);
            ss = wave_sum(k0 * k0 + k1 * k1);
            r = rsqrtf(ss + EPS);
            KN[(size_t)t * 512 + h * 128 + lane] = k0 * r; KN[(size_t)t * 512 + h * 128 + 64 + lane] = k1 * r;
            VC[(size_t)t * 512 + h * 128 + lane] = convs(1024 + h * 128 + lane);
            VC[(size_t)t * 512 + h * 128 + 64 + lane] = convs(1024 + h * 128 + 64 + lane);
        }
        if (lane < 4) {
            const float ba = Pt[2048 + lane], aa = Pt[2052 + lane];
            BETA[t * 4 + lane] = sigmoidf_(ba);
            G[t * 4 + lane] = -expf(p.a_log[li * 4 + lane]) * softplusf_(aa + p.dt_bias[li * 4 + lane]);
            WI[t * 4 + lane] = Pt[3912 + lane] * 0.0625f;
        }
        { const float c = COSA[(size_t)t * 64 + lane], sn = SINA[(size_t)t * 64 + lane];
#pragma unroll
          for (int h = 0; h < 4; ++h) {
              float t1 = Pt[2056 + h * 128 + lane], t2 = Pt[2056 + h * 128 + 64 + lane];
              QB[(size_t)t * 512 + h * 128 + lane] = t1 * c - t2 * sn; QB[(size_t)t * 512 + h * 128 + 64 + lane] = t2 * c + t1 * sn;
              t1 = Pt[2568 + h * 128 + lane]; t2 = Pt[2568 + h * 128 + 64 + lane];
              KB[(size_t)t * 512 + h * 128 + lane] = t1 * c - t2 * sn; KB[(size_t)t * 512 + h * 128 + 64 + lane] = t2 * c + t1 * sn;
          } }
#pragma unroll
        for (int r = 0; r < 2; ++r) {
            const int item = lane + 64 * r, hh = item >> 5, ii = item & 31;
            const float c = COSI[(size_t)t * 32 + ii], sn = SINI[(size_t)t * 32 + ii];
            const float t1 = Pt[3592 + hh * 64 + ii], t2 = Pt[3592 + hh * 64 + 32 + ii];
            QI[(size_t)t * 256 + hh * 64 + ii] = t1 * c - t2 * sn; QI[(size_t)t * 256 + hh * 64 + 32 + ii] = t2 * c + t1 * sn;
        }
        if (lane < 32) {
            const float c = COSI[(size_t)t * 32 + lane], sn = SINI[(size_t)t * 32 + lane];
            const float t1 = Pt[3848 + lane], t2 = Pt[3848 + 32 + lane];
            KI[(size_t)t * 64 + lane] = t1 * c - t2 * sn; KI[(size_t)t * 64 + 32 + lane] = t2 * c + t1 * sn;
        }
    }
}

__device__ void ph_gdn_chunk(const Params& p, float* smem) {
    const int tid = threadIdx.x;
    float* sK = smem; float* sX = sK + 64 * 129; float* sL = sX + 64 * 129; float* sT = sL + 64 * 65; float* sG = sT + 64 * 65; float* sB = sG + 64; float* sE = sB + 64;
    const float* QN = (const float*)(p.ws + OFF_QN); const float* KN = (const float*)(p.ws + OFF_KN); const float* VC = (const float*)(p.ws + OFF_VC);
    const float* BETA = (const float*)(p.ws + OFF_BETA); const float* G = (const float*)(p.ws + OFF_G);
    float* W = (float*)(p.ws + OFF_W); float* U = (float*)(p.ws + OFF_U); float* QG = (float*)(p.ws + OFF_QG); float* KD = (float*)(p.ws + OFF_KD);
    float* AQK = (float*)(p.ws + OFF_AQK); float* GL = (float*)(p.ws + OFF_GL);
    for (int ci = blockIdx.x; ci < 1024; ci += gridDim.x) {
        const int b = ci >> 9, h = (ci >> 7) & 3, n = ci & 127;
        const int t0 = b * 8192 + n * 64;
        __syncthreads();
        for (int e = tid; e < 8192; e += NTHREADS) { const int i = e >> 7, d = e & 127; sK[i * 129 + d] = KN[(size_t)(t0 + i) * 512 + h * 128 + d]; sX[i * 129 + d] = QN[(size_t)(t0 + i) * 512 + h * 128 + d]; }
        if (tid < 64) { sG[tid] = G[(t0 + tid) * 4 + h]; sB[tid] = BETA[(t0 + tid) * 4 + h]; }
        __syncthreads();
        if (tid == 0) { float a = 0.f; for (int i = 0; i < 64; ++i) { a += sG[i]; sG[i] = a; } }
        __syncthreads();
        const float gl = sG[63];
        if (tid < 64) sE[tid] = sB[tid] * expf(sG[tid]);
        for (int e = tid; e < 4096; e += NTHREADS) {
            const int i = e >> 6, j = e & 63; float dkk = 0.f, dqk = 0.f;
            if (j <= i) { for (int d = 0; d < 128; ++d) { const float kj = sK[j * 129 + d]; dkk += sK[i * 129 + d] * kj; dqk += sX[i * 129 + d] * kj; } }
            const float dec = (j <= i) ? expf(sG[i] - sG[j]) : 0.f;
            sL[i * 65 + j] = (j < i) ? sB[i] * dkk * dec : 0.f;
            AQK[(size_t)ci * 4096 + e] = (j <= i) ? dqk * SCALE128 * dec : 0.f;
        }
        for (int e = tid; e < 8192; e += NTHREADS) {
            const int i = e >> 7, d = e & 127;
            QG[(size_t)ci * 8192 + e] = sX[i * 129 + d] * SCALE128 * expf(sG[i]);
            KD[(size_t)ci * 8192 + e] = sK[i * 129 + d] * expf(gl - sG[i]);
        }
        if (tid == 0) GL[ci] = gl;
        __syncthreads();
        if (tid < 64) { const int c = tid; for (int i = 0; i < 64; ++i) { float a = (i == c) ? 1.f : 0.f; for (int j = 0; j < i; ++j) a -= sL[i * 65 + j] * sT[j * 65 + c]; sT[i * 65 + c] = a; } }
        __syncthreads();
        for (int e = tid; e < 8192; e += NTHREADS) {
            const int i = e >> 7, d = e & 127; float a = 0.f;
            for (int j = 0; j < 64; ++j) a += sT[i * 65 + j] * (sK[j * 129 + d] * sE[j]);
            W[(size_t)ci * 8192 + e] = a;
        }
        __syncthreads();
        for (int e = tid; e < 8192; e += NTHREADS) { const int i = e >> 7, d = e & 127; sX[i * 129 + d] = VC[(size_t)(t0 + i) * 512 + h * 128 + d]; }
        __syncthreads();
        for (int e = tid; e < 8192; e += NTHREADS) {
            const int i = e >> 7, d = e & 127; float a = 0.f;
            for (int j = 0; j < 64; ++j) a += sT[i * 65 + j] * (sX[j * 129 + d] * sB[j]);
            U[(size_t)ci * 8192 + e] = a;
        }
    }
}

__device__ void ph_gdn_scan(const Params& p, float* smem) {
    const int tid = threadIdx.x;
    float* sS = smem; float* sW = sS + 128 * 17; float* sV = sW + 64 * 129; float* sA = sV + 64 * 17;
    const float* W = (const float*)(p.ws + OFF_W); const float* U = (const float*)(p.ws + OFF_U); const float* QG = (const float*)(p.ws + OFF_QG); const float* KD = (const float*)(p.ws + OFF_KD);
    const float* AQK = (const float*)(p.ws + OFF_AQK); const float* GL = (const float*)(p.ws + OFF_GL);
    float* O = (float*)(p.ws + OFF_O);
    for (int it = blockIdx.x; it < 64; it += gridDim.x) {
        const int bh = it >> 3, sl = it & 7, b = bh >> 2, h = bh & 3;
        __syncthreads();
        for (int e = tid; e < 128 * 16; e += NTHREADS) sS[(e >> 4) * 17 + (e & 15)] = 0.f;
        for (int n = 0; n < 128; ++n) {
            const int ci = bh * 128 + n, t0 = b * 8192 + n * 64;
            __syncthreads();
            for (int e = tid; e < 8192; e += NTHREADS) sW[(e >> 7) * 129 + (e & 127)] = W[(size_t)ci * 8192 + e];
            for (int e = tid; e < 4096; e += NTHREADS) sA[(e >> 6) * 65 + (e & 63)] = AQK[(size_t)ci * 4096 + e];
            __syncthreads();
            for (int o = tid; o < 1024; o += NTHREADS) {
                const int i = o >> 4, c = o & 15; float a = U[(size_t)ci * 8192 + i * 128 + sl * 16 + c];
                for (int d = 0; d < 128; ++d) a -= sW[i * 129 + d] * sS[d * 17 + c];
                sV[i * 17 + c] = a;
            }
            __syncthreads();
            for (int e = tid; e < 8192; e += NTHREADS) sW[(e >> 7) * 129 + (e & 127)] = QG[(size_t)ci * 8192 + e];
            __syncthreads();
            for (int o = tid; o < 1024; o += NTHREADS) {
                const int i = o >> 4, c = o & 15; float a = 0.f;
                for (int d = 0; d < 128; ++d) a += sW[i * 129 + d] * sS[d * 17 + c];
                for (int j = 0; j < 64; ++j) a += sA[i * 65 + j] * sV[j * 17 + c];
                O[(size_t)(t0 + i) * 1024 + h * 128 + sl * 16 + c] = a;
            }
            __syncthreads();
            for (int e = tid; e < 8192; e += NTHREADS) sW[(e >> 7) * 129 + (e & 127)] = KD[(size_t)ci * 8192 + e];
            __syncthreads();
            const float eg = expf(GL[ci]);
            for (int o = tid; o < 2048; o += NTHREADS) {
                const int d = o >> 4, c = o & 15; float a = sS[d * 17 + c] * eg;
                for (int j = 0; j < 64; ++j) a += sW[j * 129 + d] * sV[j * 17 + c];
                sS[d * 17 + c] = a;
            }
        }
    }
}

__device__ __forceinline__ void block_sum4(int (&v)[4], int* buf) {
    const int lane = threadIdx.x & 63, wv = threadIdx.x >> 6;
#pragma unroll
    for (int q = 0; q < 4; ++q) v[q] = wave_sum_i(v[q]);
    if (lane == 0) {
#pragma unroll
        for (int q = 0; q < 4; ++q) buf[wv * 4 + q] = v[q];
    }
    __syncthreads();
#pragma unroll
    for (int q = 0; q < 4; ++q) { int a = 0; for (int w = 0; w < 8; ++w) a += buf[w * 4 + q]; v[q] = a; }
}

__device__ void ph_dsa_topk(const Params& p, float* smem) {
    const int tid = threadIdx.x, lane = tid & 63, wv = tid >> 6;
    unsigned* sk = (unsigned*)smem; float* sQ = (float*)(sk + 4 * 8192); float* sWi = sQ + 1024; int* sRed = (int*)(sWi + 16); int* sScan = sRed + 64;
    const float* QI = (const float*)(p.ws + OFF_QI); const float* KI = (const float*)(p.ws + OFF_KI); const float* WI = (const float*)(p.ws + OFF_WI);
    int* SEL = (int*)(p.ws + OFF_SEL);
    for (int it = blockIdx.x; it < 4096; it += gridDim.x) {
        const int k = it >> 8, j = (it & 255) >> 1, b = it & 1;
        const int grp = (k & 1) ? 2047 - ((k >> 1) * 128 + j) : (k >> 1) * 128 + j;
        const int s0 = grp * 4, t0 = b * 8192 + s0, nkeys = s0 + 4;
        __syncthreads();
        for (int e = tid; e < 1024; e += NTHREADS) sQ[e] = QI[(size_t)t0 * 256 + e];
        if (tid < 16) sWi[tid] = WI[t0 * 4 + tid];
        __syncthreads();
        for (int s = tid; s < nkeys; s += NTHREADS) {
            float kr[64];
            const float4* kp = (const float4*)(KI + (size_t)(b * 8192 + s) * 64);
#pragma unroll
            for (int i = 0; i < 16; ++i) { const float4 v = kp[i]; kr[4 * i] = v.x; kr[4 * i + 1] = v.y; kr[4 * i + 2] = v.z; kr[4 * i + 3] = v.w; }
#pragma unroll 1
            for (int q = 0; q < 4; ++q) {
                float sc = 0.f;
#pragma unroll 1
                for (int h = 0; h < 4; ++h) {
                    float d = 0.f;
#pragma unroll
                    for (int dd = 0; dd < 64; ++dd) d += sQ[q * 256 + h * 64 + dd] * kr[dd];
                    sc += sWi[q * 4 + h] * fmaxf(d, 0.f);
                }
                sk[q * 8192 + s] = (s <= s0 + q) ? ordkey(sc) : 0u;
            }
        }
        __syncthreads();
        int keff[4]; unsigned U[4]; int par = 0;
#pragma unroll
        for (int q = 0; q < 4; ++q) { keff[q] = (s0 + q + 1 < 256) ? (s0 + q + 1) : 256; U[q] = 0u; }
        const int niter = (nkeys + NTHREADS - 1) / NTHREADS;
        for (int bit = 31; bit >= 0; --bit) {
            unsigned cand[4]; int cnt[4];
#pragma unroll
            for (int q = 0; q < 4; ++q) { cand[q] = U[q] | (1u << bit); cnt[q] = 0; }
            for (int i = 0; i < niter; ++i) { const int e = tid + NTHREADS * i; if (e < nkeys) {
#pragma unroll
                for (int q = 0; q < 4; ++q) cnt[q] += (sk[q * 8192 + e] >= cand[q]) ? 1 : 0; } }
            block_sum4(cnt, sRed + 32 * (par ^= 1));
#pragma unroll
            for (int q = 0; q < 4; ++q) if (cnt[q] >= keff[q]) U[q] = cand[q];
        }
        int cgt[4], ceq[4];
#pragma unroll
        for (int q = 0; q < 4; ++q) { cgt[q] = 0; ceq[q] = 0; }
        for (int i = 0; i < niter; ++i) { const int e = tid + NTHREADS * i; if (e < nkeys) {
#pragma unroll
            for (int q = 0; q < 4; ++q) { const unsigned kk = sk[q * 8192 + e]; cgt[q] += (kk > U[q]) ? 1 : 0; ceq[q] += (kk == U[q]) ? 1 : 0; } } }
        block_sum4(cgt, sRed + 32 * (par ^= 1));
        block_sum4(ceq, sRed + 32 * (par ^= 1));
        int need[4]; int J[4]; bool overflow = false;
#pragma unroll
        for (int q = 0; q < 4; ++q) { need[q] = keff[q] - cgt[q]; J[q] = 8191; overflow = overflow || (ceq[q] > need[q]); }
        if (overflow) {
#pragma unroll
            for (int q = 0; q < 4; ++q) J[q] = 0;
            for (int bit = 12; bit >= 0; --bit) {
                int cj[4]; int cnt[4];
#pragma unroll
                for (int q = 0; q < 4; ++q) { cj[q] = J[q] | (1 << bit); cnt[q] = 0; }
                for (int i = 0; i < niter; ++i) { const int e = tid + NTHREADS * i; if (e < nkeys) {
#pragma unroll
                    for (int q = 0; q < 4; ++q) cnt[q] += (sk[q * 8192 + e] == U[q] && e < cj[q]) ? 1 : 0; } }
                block_sum4(cnt, sRed + 32 * (par ^= 1));
#pragma unroll
                for (int q = 0; q < 4; ++q) if (cnt[q] <= need[q] - 1) J[q] = cj[q];
            }
        }
        int c4[4];
#pragma unroll
        for (int q = 0; q < 4; ++q) c4[q] = 0;
        for (int i = 0; i < 16; ++i) { const int e = 16 * tid + i; if (e < nkeys) {
#pragma unroll
            for (int q = 0; q < 4; ++q) { const unsigned kk = sk[q * 8192 + e]; c4[q] += (kk > U[q] || (kk == U[q] && e <= J[q])) ? 1 : 0; } } }
        int off[4];
#pragma unroll
        for (int q = 0; q < 4; ++q) {
            int v = c4[q];
#pragma unroll
            for (int o = 1; o < 64; o <<= 1) { const int n = __shfl_up(v, o); if (lane >= o) v += n; }
            off[q] = v - c4[q];
            if (lane == 63) sScan[wv * 4 + q] = v;
        }
        __syncthreads();
#pragma unroll
        for (int q = 0; q < 4; ++q) { int base = 0; for (int w = 0; w < wv; ++w) base += sScan[w * 4 + q]; off[q] += base; }
        for (int i = 0; i < 16; ++i) { const int e = 16 * tid + i; if (e < nkeys) {
#pragma unroll
            for (int q = 0; q < 4; ++q) { const unsigned kk = sk[q * 8192 + e];
                if (kk > U[q] || (kk == U[q] && e <= J[q])) { if (off[q] < 256) SEL[(size_t)(t0 + q) * 256 + off[q]] = e; off[q]++; } } } }
    }
}

__device__ void ph_dsa_attn(const Params& p, float* smem) {
    const int tid = threadIdx.x, lane = tid & 63, wv = tid >> 6;
    float* lg = smem + wv * 256;
    const float* QB = (const float*)(p.ws + OFF_QB); const float* KB = (const float*)(p.ws + OFF_KB); const float* P = (const float*)(p.ws + OFF_P);
    const int* SEL = (const int*)(p.ws + OFF_SEL);
    float* O = (float*)(p.ws + OFF_O);
    const int r = lane >> 4, cl = lane & 15;
    for (int it = blockIdx.x * 8 + wv; it < NT * 4; it += gridDim.x * 8) {
        const int t = it >> 2, h = it & 3, b = t >> 13, s = t & 8191;
        const int nsel = (s + 1 < 256) ? (s + 1) : 256;
        float qv[8];
        { const float4 a = *(const float4*)(QB + (size_t)t * 512 + h * 128 + cl * 8), c = *(const float4*)(QB + (size_t)t * 512 + h * 128 + cl * 8 + 4);
          qv[0] = a.x; qv[1] = a.y; qv[2] = a.z; qv[3] = a.w; qv[4] = c.x; qv[5] = c.y; qv[6] = c.z; qv[7] = c.w; }
        for (int kk = 0; kk < nsel; kk += 4) {
            const int ki = kk + r; float part = 0.f;
            if (ki < nsel) {
                const int idx = SEL[(size_t)t * 256 + ki];
                const float* kr = KB + (size_t)(b * 8192 + idx) * 512 + h * 128 + cl * 8;
                const float4 a = *(const float4*)kr, c = *(const float4*)(kr + 4);
                part = qv[0] * a.x + qv[1] * a.y + qv[2] * a.z + qv[3] * a.w + qv[4] * c.x + qv[5] * c.y + qv[6] * c.z + qv[7] * c.w;
            }
            part += __shfl_xor(part, 1); part += __shfl_xor(part, 2); part += __shfl_xor(part, 4); part += __shfl_xor(part, 8);
            if (cl == 0 && ki < nsel) lg[ki] = part * SCALE128;
        }
        __builtin_amdgcn_fence(__ATOMIC_ACQ_REL, "wavefront");
        float m = -INFINITY;
        for (int e = lane; e < nsel; e += 64) m = fmaxf(m, lg[e]);
        m = wave_max(m);
        float sum = 0.f;
        for (int e = lane; e < nsel; e += 64) sum += expf(lg[e] - m);
        sum = wave_sum(sum);
        const float inv = 1.f / sum;
        for (int e = lane; e < nsel; e += 64) lg[e] = expf(lg[e] - m) * inv;
        __builtin_amdgcn_fence(__ATOMIC_ACQ_REL, "wavefront");
        float acc[8];
#pragma unroll
        for (int j = 0; j < 8; ++j) acc[j] = 0.f;
        for (int kk = 0; kk < nsel; kk += 4) {
            const int ki = kk + r;
            if (ki < nsel) {
                const int idx = SEL[(size_t)t * 256 + ki];
                const float pk = lg[ki];
                const float* vr = P + (size_t)(b * 8192 + idx) * LDP + 3080 + h * 128 + cl * 8;
                const float4 a = *(const float4*)vr, c = *(const float4*)(vr + 4);
                acc[0] += pk * a.x; acc[1] += pk * a.y; acc[2] += pk * a.z; acc[3] += pk * a.w; acc[4] += pk * c.x; acc[5] += pk * c.y; acc[6] += pk * c.z; acc[7] += pk * c.w;
            }
        }
#pragma unroll
        for (int j = 0; j < 8; ++j) { acc[j] += __shfl_xor(acc[j], 16); acc[j] += __shfl_xor(acc[j], 32); }
        if (lane < 16) {
            float* op = O + (size_t)t * 1024 + 512 + h * 128 + cl * 8;
            *(float4*)op = make_float4(acc[0], acc[1], acc[2], acc[3]); *(float4*)(op + 4) = make_float4(acc[4], acc[5], acc[6], acc[7]);
        }
        __builtin_amdgcn_fence(__ATOMIC_ACQ_REL, "wavefront");
    }
}

__device__ void ph_gdn_out(const Params& p, int layer) {
    const int tid = threadIdx.x, lane = tid & 63, wv = tid >> 6;
    float* O = (float*)(p.ws + OFF_O); const float* P = (const float*)(p.ws + OFF_P);
    const float* onw = p.gdn_out_norm + (layer >> 1) * 128;
    for (int t = blockIdx.x * 8 + wv; t < NT; t += gridDim.x * 8) {
#pragma unroll
        for (int h = 0; h < 4; ++h) {
            float* op = O + (size_t)t * 1024 + h * 128;
            const float o0 = op[lane], o1 = op[64 + lane];
            const float ss = wave_sum(o0 * o0 + o1 * o1);
            const float r = rsqrtf(ss * (1.f / 128.f) + EPS);
            const float z0 = P[(size_t)t * LDP + 1536 + h * 128 + lane], z1 = P[(size_t)t * LDP + 1536 + h * 128 + 64 + lane];
            op[lane] = o0 * r * onw[lane] * siluf_(z0); op[64 + lane] = o1 * r * onw[64 + lane] * siluf_(z1);
        }
    }
}

__device__ void ph_gemm_out(const Params& p, int layer, float* smem) {
    const bool even = (layer & 1) == 0;
    const float* Wt = (even ? p.even_w_out : p.gla_w_out) + (size_t)(layer >> 1) * ND * ND;
    const float* MOD = (const float*)(p.ws + OFF_MOD);
    for (int tile = blockIdx.x; tile < 128 * 8; tile += gridDim.x) {
        const int mt = tile % 128, nt = tile / 128;
        GemmArgs g; g.A = (const float*)(p.ws + OFF_O); g.lda = ND; g.rows = nullptr; g.m0 = mt * 128; g.mvalid = 128; g.B = Wt; g.ldb = ND; g.n0 = nt * 128; g.N = ND; g.K = ND;
        const int b = (mt * 128) >> 13;
        const float* gt = MOD + (size_t)(layer * 2 + b) * 6144 + 2048;
        float* Xt = p.X + (size_t)mt * 128 * ND;
        gemm128(g, smem, [=](int r, int n, float v) { Xt[(size_t)r * ND + n] += gt[n] * v; });
    }
}

__device__ void ph_norm_ffn(const Params& p, int layer) {
    const int tid = threadIdx.x, lane = tid & 63, wv = tid >> 6;
    const float* MOD = (const float*)(p.ws + OFF_MOD);
    float* H = (float*)(p.ws + OFF_H);
    int* CNT = (int*)(p.ws + OFF_CNT) + layer * 32;
    int* ASG = (int*)(p.ws + OFF_ASG); float* GATE = (float*)(p.ws + OFF_GATE); int* LIST = (int*)(p.ws + OFF_LIST);
    const float* nw = p.norm_ffn + layer * 1024;
    const float* wg = p.rg_w + (size_t)layer * 1024 * 4;
    for (int row = blockIdx.x * 8 + wv; row < NT; row += gridDim.x * 8) {
        const int b = row >> 13;
        const float* xr = p.X + (size_t)row * ND;
        const float* sh = MOD + (size_t)(layer * 2 + b) * 6144 + 3072;
        const float* sc = sh + 1024;
        float hv[16]; float ss = 0.f;
#pragma unroll
        for (int j = 0; j < 4; ++j) { const float4 v = *(const float4*)(xr + j * 256 + lane * 4); hv[4 * j] = v.x; hv[4 * j + 1] = v.y; hv[4 * j + 2] = v.z; hv[4 * j + 3] = v.w; }
#pragma unroll
        for (int j = 0; j < 16; ++j) ss += hv[j] * hv[j];
        ss = wave_sum(ss);
        const float rstd = rsqrtf(ss * (1.f / 1024.f) + EPS);
#pragma unroll
        for (int j = 0; j < 4; ++j) {
            const int col = j * 256 + lane * 4;
            const float4 w = *(const float4*)(nw + col), s4 = *(const float4*)(sc + col), h4 = *(const float4*)(sh + col);
            hv[4 * j] = hv[4 * j] * rstd * w.x * (1.f + s4.x) + h4.x; hv[4 * j + 1] = hv[4 * j + 1] * rstd * w.y * (1.f + s4.y) + h4.y;
            hv[4 * j + 2] = hv[4 * j + 2] * rstd * w.z * (1.f + s4.z) + h4.z; hv[4 * j + 3] = hv[4 * j + 3] * rstd * w.w * (1.f + s4.w) + h4.w;
            *(float4*)(H + (size_t)row * ND + col) = make_float4(hv[4 * j], hv[4 * j + 1], hv[4 * j + 2], hv[4 * j + 3]);
        }
        float gl[4] = {0.f, 0.f, 0.f, 0.f};
#pragma unroll
        for (int j = 0; j < 4; ++j)
#pragma unroll
            for (int e = 0; e < 4; ++e) { const int col = j * 256 + lane * 4 + e; const float4 w = *(const float4*)(wg + (size_t)col * 4); const float hh = hv[4 * j + e];
                gl[0] += hh * w.x; gl[1] += hh * w.y; gl[2] += hh * w.z; gl[3] += hh * w.w; }
#pragma unroll
        for (int g = 0; g < 4; ++g) gl[g] = wave_sum(gl[g]) + p.rg_b[layer * 4 + g];
        int gs = 0; float gm = gl[0];
#pragma unroll
        for (int g = 1; g < 4; ++g) if (gl[g] > gm) { gm = gl[g]; gs = g; }
        float gsum = 0.f;
#pragma unroll
        for (int g = 0; g < 4; ++g) gsum += expf(gl[g] - gm);
        const float ggate = 1.f / gsum;
        const float* we = p.re_w + ((size_t)(layer * 4 + gs) * 1024) * 8;
        float el[8] = {0.f, 0.f, 0.f, 0.f, 0.f, 0.f, 0.f, 0.f};
#pragma unroll
        for (int j = 0; j < 4; ++j)
#pragma unroll
            for (int e = 0; e < 4; ++e) { const int col = j * 256 + lane * 4 + e; const float4 w0 = *(const float4*)(we + (size_t)col * 8), w1 = *(const float4*)(we + (size_t)col * 8 + 4); const float hh = hv[4 * j + e];
                el[0] += hh * w0.x; el[1] += hh * w0.y; el[2] += hh * w0.z; el[3] += hh * w0.w; el[4] += hh * w1.x; el[5] += hh * w1.y; el[6] += hh * w1.z; el[7] += hh * w1.w; }
#pragma unroll
        for (int e = 0; e < 8; ++e) el[e] = wave_sum(el[e]) + p.re_b[(layer * 4 + gs) * 8 + e];
        int i1 = 0; float l1 = el[0];
#pragma unroll
        for (int e = 1; e < 8; ++e) if (el[e] > l1) { l1 = el[e]; i1 = e; }
        int i2 = -1; float l2 = -INFINITY;
#pragma unroll
        for (int e = 0; e < 8; ++e) if (e != i1 && el[e] > l2) { l2 = el[e]; i2 = e; }
        const float ex = expf(l2 - l1);
        const float p1 = 1.f / (1.f + ex), p2 = ex / (1.f + ex);
        if (lane == 0) {
            const int e1 = gs * 8 + i1, e2 = gs * 8 + i2;
            const int r1 = atomicAdd(&CNT[e1], 1), r2 = atomicAdd(&CNT[e2], 1);
            LIST[(size_t)e1 * LISTCAP + r1] = row; LIST[(size_t)e2 * LISTCAP + r2] = row;
            ASG[row * 4 + 0] = e1; ASG[row * 4 + 1] = r1; ASG[row * 4 + 2] = e2; ASG[row * 4 + 3] = r2;
            GATE[row * 2] = ggate * p1; GATE[row * 2 + 1] = ggate * p2;
        }
    }
}

__device__ void ph_moe(const Params& p, int layer, int which, float* smem) {
    const int tid = threadIdx.x;
    int* sPad = (int*)smem; int* sTs = sPad + 33;
    const int* CNT = (const int*)(p.ws + OFF_CNT) + layer * 32;
    __syncthreads();
    if (tid == 0) { int a = 0, ts = 0; for (int e = 0; e < 32; ++e) { sPad[e] = a; sTs[e] = ts; const int nm = (CNT[e] + 127) / 128; a += nm * 128; ts += nm; } sTs[32] = ts; sPad[32] = a; }
    __syncthreads();
    float* gs = smem + 128;
    const int ntn = (which == 0) ? 4 : 8;
    const int total = sTs[32] * ntn;
    float* HID = (float*)(p.ws + OFF_HID); float* YB = (float*)(p.ws + OFF_YB);
    const int* LIST = (const int*)(p.ws + OFF_LIST);
    for (int tile = blockIdx.x; tile < total; tile += gridDim.x) {
        const int mt = tile / ntn, nt = tile % ntn;
        int e = 0;
        for (int q = 1; q < 32; ++q) if (sTs[q] <= mt) e = q;
        const int mi = mt - sTs[e];
        const int cnt = CNT[e];
        const int mvalid = (cnt - mi * 128 < 128) ? (cnt - mi * 128) : 128;
        const int rowbase = sPad[e] + mi * 128;
        if (which == 0) {
            GemmArgs g; g.A = (const float*)(p.ws + OFF_H); g.lda = ND; g.rows = LIST + (size_t)e * LISTCAP + mi * 128; g.m0 = 0; g.mvalid = mvalid;
            g.B = p.w1 + ((size_t)(layer * 32 + e)) * 1024 * 512; g.ldb = 512; g.n0 = nt * 128; g.N = 512; g.K = 1024;
            float* Ht = HID + (size_t)rowbase * 512;
            gemm128(g, gs, [=](int r, int n, float v) { Ht[(size_t)r * 512 + n] = v; });
            g.B = p.w3 + ((size_t)(layer * 32 + e)) * 1024 * 512;
            gemm128(g, gs, [=](int r, int n, float v) { const float a = Ht[(size_t)r * 512 + n]; Ht[(size_t)r * 512 + n] = siluf_(a) * v; });
        } else {
            GemmArgs g; g.A = HID + (size_t)rowbase * 512; g.lda = 512; g.rows = nullptr; g.m0 = 0; g.mvalid = mvalid;
            g.B = p.w2 + ((size_t)(layer * 32 + e)) * 512 * 1024; g.ldb = 1024; g.n0 = nt * 128; g.N = 1024; g.K = 512;
            float* Yt = YB + (size_t)rowbase * 1024;
            gemm128(g, gs, [=](int r, int n, float v) { Yt[(size_t)r * 1024 + n] = v; });
        }
    }
}

__device__ void ph_gla_tok(const Params& p, int layer) {
    const int tid = threadIdx.x, lane = tid & 63, wv = tid >> 6, li = layer >> 1;
    const float* P = (const float*)(p.ws + OFF_P);
    float* LA = (float*)(p.ws + OFF_LA);
    const float* w2 = p.gla_w_gate2 + (size_t)li * 16 * 512; const float* b2 = p.gla_b_gate2 + li * 512;
    for (int t = blockIdx.x * 8 + wv; t < NT; t += gridDim.x * 8) {
        float glr[16];
#pragma unroll
        for (int r = 0; r < 16; ++r) glr[r] = P[(size_t)t * LDP + 3072 + r];
#pragma unroll 1
        for (int i = 0; i < 8; ++i) {
            const int c = lane + 64 * i; float z = b2[c];
#pragma unroll
            for (int r = 0; r < 16; ++r) z += glr[r] * w2[r * 512 + c];
            LA[(size_t)t * 512 + c] = -softplusf_(-z) * (1.f / 16.f);
        }
    }
}

__device__ void ph_gla_chunk(const Params& p, float* smem) {
    const int tid = threadIdx.x;
    float* sQ = smem; float* sK = sQ + 64 * 129; float* sBc = sK + 64 * 129;
    const float* P = (const float*)(p.ws + OFF_P); const float* LA = (const float*)(p.ws + OFF_LA);
    float* ATT = (float*)(p.ws + OFF_ATT); float* QE = (float*)(p.ws + OFF_QE); float* KD = (float*)(p.ws + OFF_GKD); float* EBL = (float*)(p.ws + OFF_EBL);
    for (int ci = blockIdx.x; ci < 1024; ci += gridDim.x) {
        const int b = ci >> 9, h = (ci >> 7) & 3, n = ci & 127;
        const int t0 = b * 8192 + n * 64;
        __syncthreads();
        for (int e = tid; e < 8192; e += NTHREADS) {
            const int i = e >> 7, d = e & 127;
            sQ[i * 129 + d] = P[(size_t)(t0 + i) * LDP + h * 128 + d]; sK[i * 129 + d] = P[(size_t)(t0 + i) * LDP + 512 + h * 128 + d];
            sBc[i * 129 + d] = LA[(size_t)(t0 + i) * 512 + h * 128 + d];
        }
        __syncthreads();
        if (tid < 128) { float a = 0.f; for (int i = 0; i < 64; ++i) { a += sBc[i * 129 + tid]; sBc[i * 129 + tid] = a; } }
        __syncthreads();
        for (int e = tid; e < 4096; e += NTHREADS) {
            const int i = e >> 6, j = e & 63; float a = 0.f;
            if (j <= i) { for (int d = 0; d < 128; ++d) a += sQ[i * 129 + d] * sK[j * 129 + d] * expf(sBc[i * 129 + d] - sBc[j * 129 + d]); }
            ATT[(size_t)ci * 4096 + e] = a * SCALE128;
        }
        for (int e = tid; e < 8192; e += NTHREADS) {
            const int i = e >> 7, d = e & 127;
            QE[(size_t)ci * 8192 + e] = sQ[i * 129 + d] * SCALE128 * expf(sBc[i * 129 + d]);
            KD[(size_t)ci * 8192 + e] = sK[i * 129 + d] * expf(sBc[63 * 129 + d] - sBc[i * 129 + d]);
        }
        if (tid < 128) EBL[ci * 128 + tid] = expf(sBc[63 * 129 + tid]);
    }
}

__device__ void ph_gla_scan(const Params& p, float* smem) {
    const int tid = threadIdx.x;
    float* sS = smem; float* sW = sS + 128 * 17; float* sV = sW + 64 * 129; float* sA = sV + 64 * 17; float* sE = sA + 64 * 65;
    const float* P = (const float*)(p.ws + OFF_P);
    const float* ATT = (const float*)(p.ws + OFF_ATT); const float* QE = (const float*)(p.ws + OFF_QE); const float* KD = (const float*)(p.ws + OFF_GKD); const float* EBL = (const float*)(p.ws + OFF_EBL);
    float* O = (float*)(p.ws + OFF_O);
    for (int it = blockIdx.x; it < 128; it += gridDim.x) {
        const int bh = it >> 4, sl = it & 15, b = bh >> 2, h = bh & 3;
        __syncthreads();
        for (int e = tid; e < 128 * 16; e += NTHREADS) sS[(e >> 4) * 17 + (e & 15)] = 0.f;
        for (int n = 0; n < 128; ++n) {
            const int ci = bh * 128 + n, t0 = b * 8192 + n * 64;
            __syncthreads();
            for (int e = tid; e < 8192; e += NTHREADS) sW[(e >> 7) * 129 + (e & 127)] = QE[(size_t)ci * 8192 + e];
            for (int e = tid; e < 4096; e += NTHREADS) sA[(e >> 6) * 65 + (e & 63)] = ATT[(size_t)ci * 4096 + e];
            for (int e = tid; e < 1024; e += NTHREADS) sV[(e >> 4) * 17 + (e & 15)] = P[(size_t)(t0 + (e >> 4)) * LDP + 1024 + h * 256 + sl * 16 + (e & 15)];
            if (tid < 128) sE[tid] = EBL[ci * 128 + tid];
            __syncthreads();
            for (int o = tid; o < 1024; o += NTHREADS) {
                const int i = o >> 4, c = o & 15; float a = 0.f;
                for (int d = 0; d < 128; ++d) a += sW[i * 129 + d] * sS[d * 17 + c];
                for (int j = 0; j < 64; ++j) a += sA[i * 65 + j] * sV[j * 17 + c];
                O[(size_t)(t0 + i) * 1024 + h * 256 + sl * 16 + c] = a;
            }
            __syncthreads();
            for (int e = tid; e < 8192; e += NTHREADS) sW[(e >> 7) * 129 + (e & 127)] = KD[(size_t)ci * 8192 + e];
            __syncthreads();
            for (int o = tid; o < 2048; o += NTHREADS) {
                const int d = o >> 4, c = o & 15; float a = sS[d * 17 + c] * sE[d];
                for (int j = 0; j < 64; ++j) a += sW[j * 129 + d] * sV[j * 17 + c];
                sS[d * 17 + c] = a;
            }
        }
    }
}

__device__ void ph_gla_out(const Params& p, int layer) {
    const int tid = threadIdx.x, lane = tid & 63, wv = tid >> 6;
    float* O = (float*)(p.ws + OFF_O); const float* P = (const float*)(p.ws + OFF_P);
    const float* onw = p.gla_out_norm + (layer >> 1) * 256;
    for (int t = blockIdx.x * 8 + wv; t < NT; t += gridDim.x * 8) {
#pragma unroll
        for (int h = 0; h < 4; ++h) {
            float* op = O + (size_t)t * 1024 + h * 256;
            const float4 o = *(const float4*)(op + lane * 4);
            const float ss = wave_sum(o.x * o.x + o.y * o.y + o.z * o.z + o.w * o.w);
            const float r = rsqrtf(ss * (1.f / 256.f) + EPS);
            const float4 z = *(const float4*)(P + (size_t)t * LDP + 2048 + h * 256 + lane * 4);
            const float4 w = *(const float4*)(onw + lane * 4);
            *(float4*)(op + lane * 4) = make_float4(o.x * r * w.x * siluf_(z.x), o.y * r * w.y * siluf_(z.y), o.z * r * w.z * siluf_(z.z), o.w * r * w.w * siluf_(z.w));
        }
    }
}

template <int PH>
__device__ __forceinline__ void run_phase(const Params& p, int layer, float* smem) {
    if (PH == PH_PROLOGUE) ph_prologue(p, smem);
    else if (PH == PH_NORM_MIX) ph_rows(p, layer, 0, smem);
    else if (PH == PH_GEMM_IN_EVEN) ph_gemm_in(p, layer, true, smem);
    else if (PH == PH_EVEN_TOK) ph_even_tok(p, layer, smem);
    else if (PH == PH_GDN_CHUNK) ph_gdn_chunk(p, smem);
    else if (PH == PH_GDN_SCAN) ph_gdn_scan(p, smem);
    else if (PH == PH_DSA_TOPK) ph_dsa_topk(p, smem);
    else if (PH == PH_DSA_ATTN) ph_dsa_attn(p, smem);
    else if (PH == PH_GDN_OUT) ph_gdn_out(p, layer);
    else if (PH == PH_GEMM_OUT) ph_gemm_out(p, layer, smem);
    else if (PH == PH_NORM_FFN) ph_norm_ffn(p, layer);
    else if (PH == PH_MOE1) ph_moe(p, layer, 0, smem);
    else if (PH == PH_MOE2) ph_moe(p, layer, 1, smem);
    else if (PH == PH_GEMM_IN_ODD) ph_gemm_in(p, layer, false, smem);
    else if (PH == PH_GLA_TOK) ph_gla_tok(p, layer);
    else if (PH == PH_GLA_CHUNK) ph_gla_chunk(p, smem);
    else if (PH == PH_GLA_SCAN) ph_gla_scan(p, smem);
    else if (PH == PH_GLA_OUT) ph_gla_out(p, layer);
    else if (PH == PH_FINAL) ph_rows(p, 0, 1, smem);
}

#if MK_MULTI
template <int PH>
__global__ void __launch_bounds__(NTHREADS, 2) k_phase(Params p, int layer) {
    extern __shared__ __attribute__((aligned(16))) unsigned char smem_raw[];
    run_phase<PH>(p, layer, (float*)smem_raw);
}
#else
__global__ void __launch_bounds__(NTHREADS, 2) k_mega(Params p) {
    extern __shared__ __attribute__((aligned(16))) unsigned char smem_raw[];
    float* smem = (float*)smem_raw;
    volatile LAS unsigned* xbw = (volatile LAS unsigned*)(LAS unsigned char*)(smem_raw + LDS_BYTES - 16);
    if (threadIdx.x == 0) { xbw[0] = 0u; xbw[1] = 0u; xbw[2] = 0u; xbw[3] = 0u; }
    __syncthreads();
    XcdBarrier bar = xcd_barrier_post((unsigned*)(p.ws + OFF_BAR), xbw);
#define BAR() xcd_barrier(bar)
    run_phase<PH_PROLOGUE>(p, 0, smem); BAR();
    for (int lp = 0; lp < 2; ++lp) {
        const int le = 2 * lp, lo = 2 * lp + 1;
        run_phase<PH_NORM_MIX>(p, le, smem); BAR();
        run_phase<PH_GEMM_IN_EVEN>(p, le, smem); BAR();
        run_phase<PH_EVEN_TOK>(p, le, smem); BAR();
        run_phase<PH_GDN_CHUNK>(p, le, smem); BAR();
        run_phase<PH_GDN_SCAN>(p, le, smem); BAR();
        run_phase<PH_DSA_TOPK>(p, le, smem); BAR();
        run_phase<PH_DSA_ATTN>(p, le, smem); BAR();
        run_phase<PH_GDN_OUT>(p, le, smem); BAR();
        run_phase<PH_GEMM_OUT>(p, le, smem); BAR();
        run_phase<PH_NORM_FFN>(p, le, smem); BAR();
        run_phase<PH_MOE1>(p, le, smem); BAR();
        run_phase<PH_MOE2>(p, le, smem); BAR();
        run_phase<PH_NORM_MIX>(p, lo, smem); BAR();
        run_phase<PH_GEMM_IN_ODD>(p, lo, smem); BAR();
        run_phase<PH_GLA_TOK>(p, lo, smem); BAR();
        run_phase<PH_GLA_CHUNK>(p, lo, smem); BAR();
        run_phase<PH_GLA_SCAN>(p, lo, smem); BAR();
        run_phase<PH_GLA_OUT>(p, lo, smem); BAR();
        run_phase<PH_GEMM_OUT>(p, lo, smem); BAR();
        run_phase<PH_NORM_FFN>(p, lo, smem); BAR();
        run_phase<PH_MOE1>(p, lo, smem); BAR();
        run_phase<PH_MOE2>(p, lo, smem); BAR();
    }
    run_phase<PH_FINAL>(p, 0, smem);
}
#endif

}

#if MK_MULTI
template <int PH>
static void launch_phase(const Params& p, int layer, hipStream_t stream) {
    static bool attr_set = false;
    if (!attr_set) { hipFuncSetAttribute((const void*)k_phase<PH>, hipFuncAttributeMaxDynamicSharedMemorySize, (int)LDS_BYTES); attr_set = true; }
    hipLaunchKernelGGL((k_phase<PH>), dim3(256), dim3(NTHREADS), LDS_BYTES, stream, p, layer);
}
#endif

extern "C" void kernel_launch(void* const* d_in, const int* in_sizes, int n_in, void* d_out, int out_size, void* d_ws, size_t ws_size, hipStream_t stream) {
    (void)in_sizes; (void)n_in; (void)out_size;
    if (ws_size < WS_NEEDED) { fprintf(stderr, "workspace too small: %zu < %zu\n", ws_size, (size_t)WS_NEEDED); return; }
    Params p{};
    p.x = (const float*)d_in[0]; p.c = (const float*)d_in[1]; p.pos = (const int*)d_in[2]; p.ada_w = (const float*)d_in[3]; p.ada_b = (const float*)d_in[4];
    p.norm_mix = (const float*)d_in[5]; p.norm_ffn = (const float*)d_in[6]; p.even_w_in = (const float*)d_in[7]; p.conv_w = (const float*)d_in[8];
    p.a_log = (const float*)d_in[9]; p.dt_bias = (const float*)d_in[10]; p.gdn_out_norm = (const float*)d_in[11]; p.even_w_out = (const float*)d_in[12];
    p.gla_w_in = (const float*)d_in[13]; p.gla_w_gate2 = (const float*)d_in[14]; p.gla_b_gate2 = (const float*)d_in[15]; p.gla_out_norm = (const float*)d_in[16]; p.gla_w_out = (const float*)d_in[17];
    p.rg_w = (const float*)d_in[18]; p.rg_b = (const float*)d_in[19]; p.re_w = (const float*)d_in[20]; p.re_b = (const float*)d_in[21];
    p.w1 = (const float*)d_in[22]; p.w3 = (const float*)d_in[23]; p.w2 = (const float*)d_in[24]; p.final_norm = (const float*)d_in[25];
    p.X = (float*)d_out; p.ws = (unsigned char*)d_ws;
    p.rA = pow(10000.0, -2.0 / 128.0); p.rI = pow(10000.0, -2.0 / 64.0);
    hipMemsetAsync(d_ws, 0, ZERO_BYTES, stream);
#if MK_MULTI
    launch_phase<PH_PROLOGUE>(p, 0, stream);
    for (int lp = 0; lp < 2; ++lp) {
        const int le = 2 * lp, lo = 2 * lp + 1;
        launch_phase<PH_NORM_MIX>(p, le, stream);
        launch_phase<PH_GEMM_IN_EVEN>(p, le, stream);
        launch_phase<PH_EVEN_TOK>(p, le, stream);
        launch_phase<PH_GDN_CHUNK>(p, le, stream);
        launch_phase<PH_GDN_SCAN>(p, le, stream);
        launch_phase<PH_DSA_TOPK>(p, le, stream);
        launch_phase<PH_DSA_ATTN>(p, le, stream);
        launch_phase<PH_GDN_OUT>(p, le, stream);
        launch_phase<PH_GEMM_OUT>(p, le, stream);
        launch_phase<PH_NORM_FFN>(p, le, stream);
        launch_phase<PH_MOE1>(p, le, stream);
        launch_phase<PH_MOE2>(p, le, stream);
        launch_phase<PH_NORM_MIX>(p, lo, stream);
        launch_phase<PH_GEMM_IN_ODD>(p, lo, stream);
        launch_phase<PH_GLA_TOK>(p, lo, stream);
        launch_phase<PH_GLA_CHUNK>(p, lo, stream);
        launch_phase<PH_GLA_SCAN>(p, lo, stream);
        launch_phase<PH_GLA_OUT>(p, lo, stream);
        launch_phase<PH_GEMM_OUT>(p, lo, stream);
        launch_phase<PH_NORM_FFN>(p, lo, stream);
        launch_phase<PH_MOE1>(p, lo, stream);
        launch_phase<PH_MOE2>(p, lo, stream);
    }
    launch_phase<PH_FINAL>(p, 0, stream);
#else
    static int grid = 0;
    if (!grid) {
        int dev = 0, cus = 0, per_cu = 0;
        hipGetDevice(&dev);
        hipDeviceGetAttribute(&cus, hipDeviceAttributeMultiprocessorCount, dev);
        hipFuncSetAttribute((const void*)k_mega, hipFuncAttributeMaxDynamicSharedMemorySize, (int)LDS_BYTES);
        hipOccupancyMaxActiveBlocksPerMultiprocessor(&per_cu, k_mega, NTHREADS, LDS_BYTES);
        if (cus <= 0) cus = 256;
        grid = cus * (per_cu < 1 ? 1 : 1);
    }
    hipLaunchKernelGGL(k_mega, dim3(grid), dim3(NTHREADS), LDS_BYTES, stream, p);
#endif
}
```

```cpp
#include <hip/hip_runtime.h>
#include <stdint.h>
#include <math.h>
#include <stdio.h>

#ifndef MK_MULTI
#define MK_MULTI 0
#endif

namespace {

constexpr int NT = 16384, ND = 1024, LDP = 3920;
constexpr float EPS = 1e-6f;
constexpr int NTHREADS = 512;
constexpr size_t LDS_BYTES = 147456;
constexpr float SCALE128 = 0.08838834764831845f;
constexpr int LISTCAP = 32768;

constexpr size_t OFF_BAR  = 0;
constexpr size_t OFF_CNT  = 16384;
constexpr size_t ZERO_BYTES = 32768;
constexpr size_t OFF_MOD  = 32768;
constexpr size_t OFF_COSA = OFF_MOD + 4 * 2 * 6144 * 4;
constexpr size_t OFF_SINA = OFF_COSA + (size_t)NT * 64 * 4;
constexpr size_t OFF_COSI = OFF_SINA + (size_t)NT * 64 * 4;
constexpr size_t OFF_SINI = OFF_COSI + (size_t)NT * 32 * 4;
constexpr size_t OFF_H    = OFF_SINI + (size_t)NT * 32 * 4;
constexpr size_t OFF_P    = OFF_H + (size_t)NT * 1024 * 4;
constexpr size_t OFF_HID  = OFF_P;
constexpr size_t OFF_YB   = OFF_HID + (size_t)36864 * 512 * 4;
constexpr size_t OFF_O    = OFF_P + (size_t)NT * LDP * 4;
constexpr size_t OFF_ASG  = OFF_O + (size_t)NT * 1024 * 4;
constexpr size_t OFF_GATE = OFF_ASG + (size_t)NT * 4 * 4;
constexpr size_t OFF_LIST = OFF_GATE + (size_t)NT * 2 * 4;
constexpr size_t OFF_R    = OFF_LIST + (size_t)32 * LISTCAP * 4;
constexpr size_t OFF_QN   = OFF_R;
constexpr size_t OFF_KN   = OFF_QN + (size_t)NT * 512 * 4;
constexpr size_t OFF_VC   = OFF_KN + (size_t)NT * 512 * 4;
constexpr size_t OFF_BETA = OFF_VC + (size_t)NT * 512 * 4;
constexpr size_t OFF_G    = OFF_BETA + (size_t)NT * 4 * 4;
constexpr size_t OFF_W    = OFF_G + (size_t)NT * 4 * 4;
constexpr size_t OFF_U    = OFF_W + (size_t)1024 * 8192 * 4;
constexpr size_t OFF_QG   = OFF_U + (size_t)1024 * 8192 * 4;
constexpr size_t OFF_KD   = OFF_QG + (size_t)1024 * 8192 * 4;
constexpr size_t OFF_AQK  = OFF_KD + (size_t)1024 * 8192 * 4;
constexpr size_t OFF_GL   = OFF_AQK + (size_t)1024 * 4096 * 4;
constexpr size_t OFF_QB   = OFF_GL + 4096;
constexpr size_t OFF_KB   = OFF_QB + (size_t)NT * 512 * 4;
constexpr size_t OFF_QI   = OFF_KB + (size_t)NT * 512 * 4;
constexpr size_t OFF_KI   = OFF_QI + (size_t)NT * 256 * 4;
constexpr size_t OFF_WI   = OFF_KI + (size_t)NT * 64 * 4;
constexpr size_t OFF_SEL  = OFF_WI + (size_t)NT * 4 * 4;
constexpr size_t OFF_EVEN_END = OFF_SEL + (size_t)NT * 256 * 4;
constexpr size_t OFF_LA   = OFF_R;
constexpr size_t OFF_ATT  = OFF_LA + (size_t)NT * 512 * 4;
constexpr size_t OFF_QE   = OFF_ATT + (size_t)1024 * 4096 * 4;
constexpr size_t OFF_GKD  = OFF_QE + (size_t)1024 * 8192 * 4;
constexpr size_t OFF_EBL  = OFF_GKD + (size_t)1024 * 8192 * 4;
constexpr size_t WS_NEEDED = OFF_EVEN_END;

struct Params {
    const float* x; const float* c; const int* pos; const float* ada_w; const float* ada_b;
    const float* norm_mix; const float* norm_ffn; const float* even_w_in; const float* conv_w;
    const float* a_log; const float* dt_bias; const float* gdn_out_norm; const float* even_w_out;
    const float* gla_w_in; const float* gla_w_gate2; const float* gla_b_gate2; const float* gla_out_norm; const float* gla_w_out;
    const float* rg_w; const float* rg_b; const float* re_w; const float* re_b;
    const float* w1; const float* w3; const float* w2; const float* final_norm;
    float* X;
    unsigned char* ws;
    double rA, rI;
};

#define XB_TMO      128
#define XB_XCNT(j)  (256  + 64 * (j))
#define XB_XSUB(j)  (1280 + 64 * (j))
#define XB_XGEN(j)  (2304 + 64 * (j))
#define XB_TOP      3328
#define XB_TOPGEN   3392
#define XCD_BAR_WORDS 3456
#define XB_SPIN_CAP (1u << 18)
#define LAS __attribute__((address_space(3)))

__device__ __forceinline__ unsigned xb_ld(unsigned* p)              { return __hip_atomic_load(p, __ATOMIC_RELAXED, __HIP_MEMORY_SCOPE_AGENT); }
__device__ __forceinline__ unsigned xb_add(unsigned* p, unsigned v) { return __hip_atomic_fetch_add(p, v, __ATOMIC_RELAXED, __HIP_MEMORY_SCOPE_AGENT); }
__device__ __forceinline__ unsigned xb_xcc_id() { return (unsigned)__builtin_amdgcn_s_getreg((3 << 11) | 20) & 0xFu; }
#define XB_SPIN(cond, bar) do { unsigned _sp = 0; while (cond) { __builtin_amdgcn_s_sleep(1); \
    if ((++_sp & 255u) == 0u) { if (xb_ld(&(bar)[XB_TMO])) break; if (_sp > XB_SPIN_CAP) { atomicAdd(&(bar)[XB_TMO], 1u); break; } } } } while (0)

struct XcdBarrier { unsigned* bar; unsigned x; volatile LAS unsigned* st; };

__device__ __forceinline__ XcdBarrier xcd_barrier_post(unsigned* bar, volatile LAS unsigned* st) {
    XcdBarrier b; b.bar = bar; b.x = xb_xcc_id(); b.st = st;
    if (threadIdx.x == 0) (void)xb_add(&bar[XB_XCNT(b.x)], 1u);
    return b;
}
__device__ __forceinline__ void xcd_barrier_complete(unsigned* bar, unsigned x, unsigned& nloc, unsigned& nx) {
    const unsigned G = gridDim.x * gridDim.y * gridDim.z;
    unsigned sum, cnt, mine, sp = 0u;
    for (;;) {
        sum = 0u; cnt = 0u; mine = 0u;
#pragma unroll
        for (unsigned j = 0; j < 16; ++j) { const unsigned c = xb_ld(&bar[XB_XCNT(j)]); sum += c; cnt += (c > 0u) ? 1u : 0u; mine = (j == x) ? c : mine; }
        if (sum == G) break;
        __builtin_amdgcn_s_sleep(1);
        if ((++sp & 255u) == 0u) { if (xb_ld(&bar[XB_TMO])) break; if (sp > XB_SPIN_CAP) { atomicAdd(&bar[XB_TMO], 1u); break; } }
    }
    nloc = mine > 0u ? mine : 1u; nx = cnt > 0u ? cnt : 1u;
}
__device__ __forceinline__ void xcd_barrier(const XcdBarrier& b) {
    asm volatile("s_waitcnt vmcnt(0)" ::: "memory");
    __syncthreads();
    if (threadIdx.x == 0) {
        unsigned* bar = b.bar;
        __builtin_amdgcn_s_waitcnt(0);
        unsigned nloc = b.st[0], nx = b.st[1];
        if (nloc == 0u) { xcd_barrier_complete(bar, b.x, nloc, nx); b.st[0] = nloc; b.st[1] = nx; }
        const unsigned old = xb_add(&bar[XB_XSUB(b.x)], 1u);
        const unsigned gen = old / nloc;
        if (old + 1u == (gen + 1u) * nloc) {
            __builtin_amdgcn_fence(__ATOMIC_RELEASE, "agent");
            asm volatile("s_waitcnt vmcnt(0)" ::: "memory");
            const unsigned og = xb_add(&bar[XB_TOP], 1u);
            const unsigned tg = og / nx;
            if (og + 1u == (tg + 1u) * nx) xb_add(&bar[XB_TOPGEN], 1u);
            else XB_SPIN(xb_ld(&bar[XB_TOPGEN]) == tg, bar);
            __builtin_amdgcn_fence(__ATOMIC_ACQUIRE, "agent");
            xb_add(&bar[XB_XGEN(b.x)], 1u);
            asm volatile("s_waitcnt vmcnt(0)" ::: "memory");
        } else {
            XB_SPIN(xb_ld(&bar[XB_XGEN(b.x)]) == gen, bar);
            __builtin_amdgcn_fence(__ATOMIC_ACQUIRE, "agent");
            asm volatile("s_waitcnt vmcnt(0)" ::: "memory");
        }
    }
    __syncthreads();
}

__device__ __forceinline__ float wave_sum(float v) {
#pragma unroll
    for (int o = 32; o > 0; o >>= 1) v += __shfl_xor(v, o);
    return v;
}
__device__ __forceinline__ int wave_sum_i(int v) {
#pragma unroll
    for (int o = 32; o > 0; o >>= 1) v += __shfl_xor(v, o);
    return v;
}
__device__ __forceinline__ float wave_max(float v) {
#pragma unroll
    for (int o = 32; o > 0; o >>= 1) v = fmaxf(v, __shfl_xor(v, o));
    return v;
}
__device__ __forceinline__ float sigmoidf_(float x) { return 1.f / (1.f + expf(-x)); }
__device__ __forceinline__ float siluf_(float x) { return x / (1.f + expf(-x)); }
__device__ __forceinline__ float softplusf_(float x) { return fmaxf(x, 0.f) + log1pf(expf(-fabsf(x))); }
__device__ __forceinline__ unsigned ordkey(float f) { const unsigned u = __float_as_uint(f); return (u & 0x80000000u) ? ~u : (u | 0x80000000u); }

__device__ __forceinline__ void sincos_d(double a, double& s, double& c) {
    const double kq = rint(a * 0.63661977236758134308);
    double r = fma(-kq, 1.57079632673412561417e+00, a);
    r = fma(-kq, 6.07710050650619224932e-11, r);
    const int q = (int)((long long)kq & 3);
    const double r2 = r * r;
    const double sp = r * (1.0 + r2 * (-1.0 / 6 + r2 * (1.0 / 120 + r2 * (-1.0 / 5040 + r2 * (1.0 / 362880 + r2 * (-1.0 / 39916800 + r2 * (1.0 / 6227020800.0)))))));
    const double cp = 1.0 + r2 * (-0.5 + r2 * (1.0 / 24 + r2 * (-1.0 / 720 + r2 * (1.0 / 40320 + r2 * (-1.0 / 3628800 + r2 * (1.0 / 479001600.0 + r2 * (-1.0 / 87178291200.0)))))));
    if (q == 0) { s = sp; c = cp; } else if (q == 1) { s = cp; c = -sp; } else if (q == 2) { s = -sp; c = -cp; } else { s = -cp; c = sp; }
}
__device__ __forceinline__ double ipow_d(double b, int e) { double v = 1.0; while (e) { if (e & 1) v *= b; b *= b; e >>= 1; } return v; }

struct GemmArgs { const float* A; int lda; const int* rows; int m0; int mvalid; const float* B; int ldb; int n0; int N; int K; };

template <class Epi>
__device__ __forceinline__ void gemm128(const GemmArgs& g, float* smem, Epi epi) {
    float* As = smem;
    float* Bs = smem + 16 * 132;
    int tid_ = threadIdx.x; asm volatile("" : "+v"(tid_)); const int tid = tid_, ty = tid >> 4, tx = tid & 15;
    const int arow = tid >> 2, kq = (tid & 3) * 4;
    const int bk = tid >> 5, bn = (tid & 31) * 4;
    long asrc = -1;
    if (arow < g.mvalid) { const int r = g.rows ? g.rows[arow] : (g.m0 + arow); if (r >= 0) asrc = (long)r * g.lda; }
    const bool bval = (g.n0 + bn) < g.N;
    float acc[4][8];
#pragma unroll
    for (int i = 0; i < 4; ++i)
#pragma unroll
        for (int j = 0; j < 8; ++j) acc[i][j] = 0.f;
    for (int k0 = 0; k0 < g.K; k0 += 16) {
        float4 av = make_float4(0.f, 0.f, 0.f, 0.f), bv = make_float4(0.f, 0.f, 0.f, 0.f);
        if (asrc >= 0) av = *(const float4*)(g.A + asrc + k0 + kq);
        if (bval) bv = *(const float4*)(g.B + (size_t)(k0 + bk) * g.ldb + g.n0 + bn);
        __syncthreads();
        As[(kq + 0) * 132 + arow] = av.x; As[(kq + 1) * 132 + arow] = av.y; As[(kq + 2) * 132 + arow] = av.z; As[(kq + 3) * 132 + arow] = av.w;
        *(float4*)&Bs[bk * 132 + bn] = bv;
        __syncthreads();
#pragma unroll
        for (int kk = 0; kk < 16; ++kk) {
            const float4 a = *(const float4*)&As[kk * 132 + ty * 4];
            const float4 b0 = *(const float4*)&Bs[kk * 132 + tx * 8];
            const float4 b1 = *(const float4*)&Bs[kk * 132 + tx * 8 + 4];
            const float aa[4] = {a.x, a.y, a.z, a.w};
            const float bb[8] = {b0.x, b0.y, b0.z, b0.w, b1.x, b1.y, b1.z, b1.w};
#pragma unroll
            for (int i = 0; i < 4; ++i)
#pragma unroll
                for (int j = 0; j < 8; ++j) acc[i][j] += aa[i] * bb[j];
        }
    }
#pragma unroll
    for (int i = 0; i < 4; ++i) {
        const int r = ty * 4 + i;
        if (r < g.mvalid) {
#pragma unroll
            for (int j = 0; j < 8; ++j) { const int n = g.n0 + tx * 8 + j; if (n < g.N) epi(r, n, acc[i][j]); }
        }
    }
}

extern __shared__ __attribute__((aligned(16))) unsigned char g_smem[];
#define PHASE_FN __device__ __forceinline__
enum { PH_PROLOGUE = 0, PH_NORM_MIX, PH_GEMM_IN_EVEN, PH_EVEN_TOK, PH_GDN_CHUNK, PH_GDN_SCAN, PH_DSA_TOPK, PH_DSA_ATTN, PH_GDN_OUT,
       PH_GEMM_OUT, PH_NORM_FFN, PH_MOE1, PH_MOE2, PH_GEMM_IN_ODD, PH_GLA_TOK, PH_GLA_CHUNK, PH_GLA_SCAN, PH_GLA_OUT, PH_FINAL };

PHASE_FN void ph_prologue(const Params& p, float* smem) {
    smem = (float*)g_smem;
    int tid_ = threadIdx.x; asm volatile("" : "+v"(tid_)); const int tid = tid_, nthr = gridDim.x * NTHREADS, gid = blockIdx.x * NTHREADS + tid;
    { const float4* src = (const float4*)p.x; float4* dst = (float4*)p.X;
      for (size_t i = gid; i < (size_t)NT * ND / 4; i += nthr) dst[i] = src[i]; }
    for (int i = tid; i < 2 * ND; i += NTHREADS) smem[i] = siluf_(p.c[i]);
    __syncthreads();
    float* MOD = (float*)(p.ws + OFF_MOD);
    for (int o = gid; o < 4 * 6144; o += nthr) {
        const int l = o / 6144, n = o % 6144;
        const float* w = p.ada_w + (size_t)l * ND * 6144 + n;
        float a0 = 0.f, a1 = 0.f;
        for (int k = 0; k < ND; ++k) { const float wv = w[(size_t)k * 6144]; a0 += smem[k] * wv; a1 += smem[ND + k] * wv; }
        const float bb = p.ada_b[l * 6144 + n];
        MOD[(l * 2 + 0) * 6144 + n] = a0 + bb; MOD[(l * 2 + 1) * 6144 + n] = a1 + bb;
    }
    float* COSA = (float*)(p.ws + OFF_COSA); float* SINA = (float*)(p.ws + OFF_SINA);
    float* COSI = (float*)(p.ws + OFF_COSI); float* SINI = (float*)(p.ws + OFF_SINI);
    for (size_t i = gid; i < (size_t)NT * 64; i += nthr) {
        const int t = (int)(i >> 6), j = (int)(i & 63);
        double s, c; sincos_d((double)p.pos[t] * ipow_d(p.rA, j), s, c);
        COSA[i] = (float)c; SINA[i] = (float)s;
    }
    for (size_t i = gid; i < (size_t)NT * 32; i += nthr) {
        const int t = (int)(i >> 5), j = (int)(i & 31);
        double s, c; sincos_d((double)p.pos[t] * ipow_d(p.rI, j), s, c);
        COSI[i] = (float)c; SINI[i] = (float)s;
    }
}

PHASE_FN void ph_rows(const Params& p, int layer, int mode, float* smem) {
    smem = (float*)g_smem;
    int tid_ = threadIdx.x; asm volatile("" : "+v"(tid_)); const int tid = tid_, lane = tid & 63, wv = tid >> 6;
    int* pad = (int*)smem;
    const int moe_layer = (mode == 1) ? 3 : layer - 1;
    if (moe_layer >= 0) {
        if (tid == 0) { const int* cnt = (const int*)(p.ws + OFF_CNT) + moe_layer * 32; int a = 0; for (int e = 0; e < 32; ++e) { pad[e] = a; a += ((cnt[e] + 127) / 128) * 128; } }
        __syncthreads();
    }
    const float* MOD = (const float*)(p.ws + OFF_MOD);
    float* H = (float*)(p.ws + OFF_H);
    const float* YB = (const float*)(p.ws + OFF_YB);
    const int* ASG = (const int*)(p.ws + OFF_ASG);
    const float* GATE = (const float*)(p.ws + OFF_GATE);
    for (int row = blockIdx.x * 8 + wv; row < NT; row += gridDim.x * 8) {
        const int b = row >> 13;
        float* xr = p.X + (size_t)row * ND;
        float xv[16];
#pragma unroll
        for (int j = 0; j < 4; ++j) { const float4 v = *(const float4*)(xr + j * 256 + lane * 4); xv[4 * j] = v.x; xv[4 * j + 1] = v.y; xv[4 * j + 2] = v.z; xv[4 * j + 3] = v.w; }
        if (moe_layer >= 0) {
            const float* gt = MOD + (size_t)(moe_layer * 2 + b) * 6144 + 5 * 1024;
            const int e0 = ASG[row * 4 + 0], r0 = ASG[row * 4 + 1], e1 = ASG[row * 4 + 2], r1 = ASG[row * 4 + 3];
            const float g0 = GATE[row * 2], g1 = GATE[row * 2 + 1];
            const float* y0 = YB + (size_t)(pad[e0] + r0) * ND;
            const float* y1 = YB + (size_t)(pad[e1] + r1) * ND;
#pragma unroll
            for (int j = 0; j < 4; ++j) {
                const int col = j * 256 + lane * 4;
                const float4 a = *(const float4*)(y0 + col), bq = *(const float4*)(y1 + col), g = *(const float4*)(gt + col);
                xv[4 * j] += g.x * (g0 * a.x + g1 * bq.x); xv[4 * j + 1] += g.y * (g0 * a.y + g1 * bq.y);
                xv[4 * j + 2] += g.z * (g0 * a.z + g1 * bq.z); xv[4 * j + 3] += g.w * (g0 * a.w + g1 * bq.w);
                if (mode == 0) *(float4*)(xr + col) = make_float4(xv[4 * j], xv[4 * j + 1], xv[4 * j + 2], xv[4 * j + 3]);
            }
        }
        float ss = 0.f;
#pragma unroll
        for (int j = 0; j < 16; ++j) ss += xv[j] * xv[j];
        ss = wave_sum(ss);
        const float rstd = rsqrtf(ss * (1.f / 1024.f) + EPS);
        if (mode == 0) {
            const float* nw = p.norm_mix + layer * 1024;
            const float* sh = MOD + (size_t)(layer * 2 + b) * 6144;
            const float* sc = sh + 1024;
#pragma unroll
            for (int j = 0; j < 4; ++j) {
                const int col = j * 256 + lane * 4;
                const float4 w = *(const float4*)(nw + col), s4 = *(const float4*)(sc + col), h4 = *(const float4*)(sh + col);
                float4 o;
                o.x = xv[4 * j] * rstd * w.x * (1.f + s4.x) + h4.x; o.y = xv[4 * j + 1] * rstd * w.y * (1.f + s4.y) + h4.y;
                o.z = xv[4 * j + 2] * rstd * w.z * (1.f + s4.z) + h4.z; o.w = xv[4 * j + 3] * rstd * w.w * (1.f + s4.w) + h4.w;
                *(float4*)(H + (size_t)row * ND + col) = o;
            }
        } else {
#pragma unroll
            for (int j = 0; j < 4; ++j) {
                const int col = j * 256 + lane * 4;
                const float4 w = *(const float4*)(p.final_norm + col);
                *(float4*)(xr + col) = make_float4(xv[4 * j] * rstd * w.x, xv[4 * j + 1] * rstd * w.y, xv[4 * j + 2] * rstd * w.z, xv[4 * j + 3] * rstd * w.w);
            }
        }
    }
}

PHASE_FN void ph_gemm_in(const Params& p, int layer, bool even, float* smem) {
    smem = (float*)g_smem;
    const int N = even ? 3916 : 3088;
    const float* Wt = even ? p.even_w_in + (size_t)(layer >> 1) * ND * 3916 : p.gla_w_in + (size_t)(layer >> 1) * ND * 3088;
    const int ntn = (N + 127) / 128, ntiles = 128 * ntn;
    float* P = (float*)(p.ws + OFF_P);
    for (int tile = blockIdx.x; tile < ntiles; tile += gridDim.x) {
        const int mt = tile % 128, nt = tile / 128;
        GemmArgs g; g.A = (const float*)(p.ws + OFF_H); g.lda = ND; g.rows = nullptr; g.m0 = mt * 128; g.mvalid = 128; g.B = Wt; g.ldb = N; g.n0 = nt * 128; g.N = N; g.K = ND;
        float* Pt = P + (size_t)mt * 128 * LDP;
        gemm128(g, smem, [=](int r, int n, float v) { Pt[(size_t)r * LDP + n] = v; });
    }
}

PHASE_FN void ph_even_tok(const Params& p, int layer, float* smem) {
    smem = (float*)g_smem;
    int tid_ = threadIdx.x; asm volatile("" : "+v"(tid_)); const int tid = tid_, lane = tid & 63, wv = tid >> 6, li = layer >> 1;
    const float* P = (const float*)(p.ws + OFF_P);
    const float* cw = p.conv_w + (size_t)li * 4 * 1536;
    float* QN = (float*)(p.ws + OFF_QN); float* KN = (float*)(p.ws + OFF_KN); float* VC = (float*)(p.ws + OFF_VC);
    float* BETA = (float*)(p.ws + OFF_BETA); float* G = (float*)(p.ws + OFF_G);
    float* QB = (float*)(p.ws + OFF_QB); float* KB = (float*)(p.ws + OFF_KB); float* QI = (float*)(p.ws + OFF_QI); float* KI = (float*)(p.ws + OFF_KI); float* WI = (float*)(p.ws + OFF_WI);
    const float* COSA = (const float*)(p.ws + OFF_COSA); const float* SINA = (const float*)(p.ws + OFF_SINA);
    const float* COSI = (const float*)(p.ws + OFF_COSI); const float* SINI = (const float*)(p.ws + OFF_SINI);
    for (int t = blockIdx.x * 8 + wv; t < NT; t += gridDim.x * 8) {
        const int s = t & 8191;
        const float* Pt = P + (size_t)t * LDP;
        auto convs = [&](int c) -> float {
            float a = 0.f;
#pragma unroll
            for (int j = 0; j < 4; ++j) { if (s - 3 + j >= 0) a += cw[j * 1536 + c] * P[(size_t)(t - 3 + j) * LDP + c]; }
            return siluf_(a);
        };
#pragma unroll 1
        for (int h = 0; h < 4; ++h) {
            const float q0 = convs(h * 128 + lane), q1 = convs(h * 128 + 64 + lane);
            float ss = wave_sum(q0 * q0 + q1 * q1);
            float r = rsqrtf(ss + EPS);
            QN[(size_t)t * 512 + h * 128 + lane] = q0 * r; QN[(size_t)t * 512 + h * 128 + 64 + lane] = q1 * r;
            const float k0 = convs(512 + h * 128 + lane), k1 = convs(512 + h * 128 + 64 + lane);
            ss = wave_sum(k0 * k0 + k1 * k1);
            r = rsqrtf(ss + EPS);
            KN[(size_t)t * 512 + h * 128 + lane] = k0 * r; KN[(size_t)t * 512 + h * 128 + 64 + lane] = k1 * r;
            VC[(size_t)t * 512 + h * 128 + lane] = convs(1024 + h * 128 + lane);
            VC[(size_t)t * 512 + h * 128 + 64 + lane] = convs(1024 + h * 128 + 64 + lane);
        }
        if (lane < 4) {
            const float ba = Pt[2048 + lane], aa = Pt[2052 + lane];
            BETA[t * 4 + lane] = sigmoidf_(ba);
            G[t * 4 + lane] = -expf(p.a_log[li * 4 + lane]) * softplusf_(aa + p.dt_bias[li * 4 + lane]);
            WI[t * 4 + lane] = Pt[3912 + lane] * 0.0625f;
        }
        { const float c = COSA[(size_t)t * 64 + lane], sn = SINA[(size_t)t * 64 + lane];
#pragma unroll
          for (int h = 0; h < 4; ++h) {
              float t1 = Pt[2056 + h * 128 + lane], t2 = Pt[2056 + h * 128 + 64 + lane];
              QB[(size_t)t * 512 + h * 128 + lane] = t1 * c - t2 * sn; QB[(size_t)t * 512 + h * 128 + 64 + lane] = t2 * c + t1 * sn;
              t1 = Pt[2568 + h * 128 + lane]; t2 = Pt[2568 + h * 128 + 64 + lane];
              KB[(size_t)t * 512 + h * 128 + lane] = t1 * c - t2 * sn; KB[(size_t)t * 512 + h * 128 + 64 + lane] = t2 * c + t1 * sn;
          } }
#pragma unroll
        for (int r = 0; r < 2; ++r) {
            const int item = lane + 64 * r, hh = item >> 5, ii = item & 31;
            const float c = COSI[(size_t)t * 32 + ii], sn = SINI[(size_t)t * 32 + ii];
            const float t1 = Pt[3592 + hh * 64 + ii], t2 = Pt[3592 + hh * 64 + 32 + ii];
            QI[(size_t)t * 256 + hh * 64 + ii] = t1 * c - t2 * sn; QI[(size_t)t * 256 + hh * 64 + 32 + ii] = t2 * c + t1 * sn;
        }
        if (lane < 32) {
            const float c = COSI[(size_t)t * 32 + lane], sn = SINI[(size_t)t * 32 + lane];
            const float t1 = Pt[3848 + lane], t2 = Pt[3848 + 32 + lane];
            KI[(size_t)t * 64 + lane] = t1 * c - t2 * sn; KI[(size_t)t * 64 + 32 + lane] = t2 * c + t1 * sn;
        }
    }
}

PHASE_FN void ph_gdn_chunk(const Params& p, float* smem) {
    smem = (float*)g_smem;
    int tid_ = threadIdx.x; asm volatile("" : "+v"(tid_)); const int tid = tid_;
    float* sK = smem; float* sX = sK + 64 * 129; float* sL = sX + 64 * 129; float* sT = sL + 64 * 65; float* sG = sT + 64 * 65; float* sB = sG + 64; float* sE = sB + 64;
    const float* QN = (const float*)(p.ws + OFF_QN); const float* KN = (const float*)(p.ws + OFF_KN); const float* VC = (const float*)(p.ws + OFF_VC);
    const float* BETA = (const float*)(p.ws + OFF_BETA); const float* G = (const float*)(p.ws + OFF_G);
    float* W = (float*)(p.ws + OFF_W); float* U = (float*)(p.ws + OFF_U); float* QG = (float*)(p.ws + OFF_QG); float* KD = (float*)(p.ws + OFF_KD);
    float* AQK = (float*)(p.ws + OFF_AQK); float* GL = (float*)(p.ws + OFF_GL);
    for (int ci = blockIdx.x; ci < 1024; ci += gridDim.x) {
        const int b = ci >> 9, h = (ci >> 7) & 3, n = ci & 127;
        const int t0 = b * 8192 + n * 64;
        __syncthreads();
        for (int e = tid; e < 8192; e += NTHREADS) { const int i = e >> 7, d = e & 127; sK[i * 129 + d] = KN[(size_t)(t0 + i) * 512 + h * 128 + d]; sX[i * 129 + d] = QN[(size_t)(t0 + i) * 512 + h * 128 + d]; }
        if (tid < 64) { sG[tid] = G[(t0 + tid) * 4 + h]; sB[tid] = BETA[(t0 + tid) * 4 + h]; }
        __syncthreads();
        if (tid == 0) { float a = 0.f; for (int i = 0; i < 64; ++i) { a += sG[i]; sG[i] = a; } }
        __syncthreads();
        const float gl = sG[63];
        if (tid < 64) sE[tid] = sB[tid] * expf(sG[tid]);
        for (int e = tid; e < 4096; e += NTHREADS) {
            const int i = e >> 6, j = e & 63; float dkk = 0.f, dqk = 0.f;
            if (j <= i) { for (int d = 0; d < 128; ++d) { const float kj = sK[j * 129 + d]; dkk += sK[i * 129 + d] * kj; dqk += sX[i * 129 + d] * kj; } }
            const float dec = (j <= i) ? expf(sG[i] - sG[j]) : 0.f;
            sL[i * 65 + j] = (j < i) ? sB[i] * dkk * dec : 0.f;
            AQK[(size_t)ci * 4096 + e] = (j <= i) ? dqk * SCALE128 * dec : 0.f;
        }
        for (int e = tid; e < 8192; e += NTHREADS) {
            const int i = e >> 7, d = e & 127;
            QG[(size_t)ci * 8192 + e] = sX[i * 129 + d] * SCALE128 * expf(sG[i]);
            KD[(size_t)ci * 8192 + e] = sK[i * 129 + d] * expf(gl - sG[i]);
        }
        if (tid == 0) GL[ci] = gl;
        __syncthreads();
        if (tid < 64) { const int c = tid; for (int i = 0; i < 64; ++i) { float a = (i == c) ? 1.f : 0.f; for (int j = 0; j < i; ++j) a -= sL[i * 65 + j] * sT[j * 65 + c]; sT[i * 65 + c] = a; } }
        __syncthreads();
        for (int e = tid; e < 8192; e += NTHREADS) {
            const int i = e >> 7, d = e & 127; float a = 0.f;
            for (int j = 0; j < 64; ++j) a += sT[i * 65 + j] * (sK[j * 129 + d] * sE[j]);
            W[(size_t)ci * 8192 + e] = a;
        }
        __syncthreads();
        for (int e = tid; e < 8192; e += NTHREADS) { const int i = e >> 7, d = e & 127; sX[i * 129 + d] = VC[(size_t)(t0 + i) * 512 + h * 128 + d]; }
        __syncthreads();
        for (int e = tid; e < 8192; e += NTHREADS) {
            const int i = e >> 7, d = e & 127; float a = 0.f;
            for (int j = 0; j < 64; ++j) a += sT[i * 65 + j] * (sX[j * 129 + d] * sB[j]);
            U[(size_t)ci * 8192 + e] = a;
        }
    }
}

PHASE_FN void ph_gdn_scan(const Params& p, float* smem) {
    smem = (float*)g_smem;
    int tid_ = threadIdx.x; asm volatile("" : "+v"(tid_)); const int tid = tid_;
    float* sS = smem; float* sW = sS + 128 * 17; float* sV = sW + 64 * 129; float* sA = sV + 64 * 17;
    const float* W = (const float*)(p.ws + OFF_W); const float* U = (const float*)(p.ws + OFF_U); const float* QG = (const float*)(p.ws + OFF_QG); const float* KD = (const float*)(p.ws + OFF_KD);
    const float* AQK = (const float*)(p.ws + OFF_AQK); const float* GL = (const float*)(p.ws + OFF_GL);
    float* O = (float*)(p.ws + OFF_O);
    for (int it = blockIdx.x; it < 64; it += gridDim.x) {
        const int bh = it >> 3, sl = it & 7, b = bh >> 2, h = bh & 3;
        __syncthreads();
        for (int e = tid; e < 128 * 16; e += NTHREADS) sS[(e >> 4) * 17 + (e & 15)] = 0.f;
        for (int n = 0; n < 128; ++n) {
            const int ci = bh * 128 + n, t0 = b * 8192 + n * 64;
            __syncthreads();
            for (int e = tid; e < 8192; e += NTHREADS) sW[(e >> 7) * 129 + (e & 127)] = W[(size_t)ci * 8192 + e];
            for (int e = tid; e < 4096; e += NTHREADS) sA[(e >> 6) * 65 + (e & 63)] = AQK[(size_t)ci * 4096 + e];
            __syncthreads();
            for (int o = tid; o < 1024; o += NTHREADS) {
                const int i = o >> 4, c = o & 15; float a = U[(size_t)ci * 8192 + i * 128 + sl * 16 + c];
                for (int d = 0; d < 128; ++d) a -= sW[i * 129 + d] * sS[d * 17 + c];
                sV[i * 17 + c] = a;
            }
            __syncthreads();
            for (int e = tid; e < 8192; e += NTHREADS) sW[(e >> 7) * 129 + (e & 127)] = QG[(size_t)ci * 8192 + e];
            __syncthreads();
            for (int o = tid; o < 1024; o += NTHREADS) {
                const int i = o >> 4, c = o & 15; float a = 0.f;
                for (int d = 0; d < 128; ++d) a += sW[i * 129 + d] * sS[d * 17 + c];
                for (int j = 0; j < 64; ++j) a += sA[i * 65 + j] * sV[j * 17 + c];
                O[(size_t)(t0 + i) * 1024 + h * 128 + sl * 16 + c] = a;
            }
            __syncthreads();
            for (int e = tid; e < 8192; e += NTHREADS) sW[(e >> 7) * 129 + (e & 127)] = KD[(size_t)ci * 8192 + e];
            __syncthreads();
            const float eg = expf(GL[ci]);
            for (int o = tid; o < 2048; o += NTHREADS) {
                const int d = o >> 4, c = o & 15; float a = sS[d * 17 + c] * eg;
                for (int j = 0; j < 64; ++j) a += sW[j * 129 + d] * sV[j * 17 + c];
                sS[d * 17 + c] = a;
            }
        }
    }
}

__device__ __forceinline__ void block_sum4(int (&v)[4], int* buf) {
    const int lane = threadIdx.x & 63, wv = threadIdx.x >> 6;
#pragma unroll
    for (int q = 0; q < 4; ++q) v[q] = wave_sum_i(v[q]);
    if (lane == 0) {
#pragma unroll
        for (int q = 0; q < 4; ++q) buf[wv * 4 + q] = v[q];
    }
    __syncthreads();
#pragma unroll
    for (int q = 0; q < 4; ++q) { int a = 0; for (int w = 0; w < 8; ++w) a += buf[w * 4 + q]; v[q] = a; }
}

PHASE_FN void ph_dsa_topk(const Params& p, float* smem) {
    smem = (float*)g_smem;
    int tid_ = threadIdx.x; asm volatile("" : "+v"(tid_)); const int tid = tid_, lane = tid & 63, wv = tid >> 6;
    unsigned* sk = (unsigned*)smem; float* sQ = (float*)(sk + 4 * 8192); float* sWi = sQ + 1024; int* sRed = (int*)(sWi + 16); int* sScan = sRed + 64;
    const float* QI = (const float*)(p.ws + OFF_QI); const float* KI = (const float*)(p.ws + OFF_KI); const float* WI = (const float*)(p.ws + OFF_WI);
    int* SEL = (int*)(p.ws + OFF_SEL);
    for (int it = blockIdx.x; it < 4096; it += gridDim.x) {
        const int k = it >> 8, j = (it & 255) >> 1, b = it & 1;
        const int grp = (k & 1) ? 2047 - ((k >> 1) * 128 + j) : (k >> 1) * 128 + j;
        const int s0 = grp * 4, t0 = b * 8192 + s0, nkeys = s0 + 4;
        __syncthreads();
        for (int e = tid; e < 1024; e += NTHREADS) sQ[e] = QI[(size_t)t0 * 256 + e];
        if (tid < 16) sWi[tid] = WI[t0 * 4 + tid];
        __syncthreads();
        for (int s = tid; s < nkeys; s += NTHREADS) {
            float kr[64];
            const float4* kp = (const float4*)(KI + (size_t)(b * 8192 + s) * 64);
#pragma unroll
            for (int i = 0; i < 16; ++i) { const float4 v = kp[i]; kr[4 * i] = v.x; kr[4 * i + 1] = v.y; kr[4 * i + 2] = v.z; kr[4 * i + 3] = v.w; }
#pragma unroll 1
            for (int q = 0; q < 4; ++q) {
                float sc = 0.f;
#pragma unroll 1
                for (int h = 0; h < 4; ++h) {
                    float d = 0.f;
#pragma unroll
                    for (int dd = 0; dd < 64; ++dd) d += sQ[q * 256 + h * 64 + dd] * kr[dd];
                    sc += sWi[q * 4 + h] * fmaxf(d, 0.f);
                }
                sk[q * 8192 + s] = (s <= s0 + q) ? ordkey(sc) : 0u;
            }
        }
        __syncthreads();
        int keff[4]; unsigned U[4]; int par = 0;
#pragma unroll
        for (int q = 0; q < 4; ++q) { keff[q] = (s0 + q + 1 < 256) ? (s0 + q + 1) : 256; U[q] = 0u; }
        const int niter = (nkeys + NTHREADS - 1) / NTHREADS;
        for (int bit = 31; bit >= 0; --bit) {
            unsigned cand[4]; int cnt[4];
#pragma unroll
            for (int q = 0; q < 4; ++q) { cand[q] = U[q] | (1u << bit); cnt[q] = 0; }
            for (int i = 0; i < niter; ++i) { const int e = tid + NTHREADS * i; if (e < nkeys) {
#pragma unroll
                for (int q = 0; q < 4; ++q) cnt[q] += (sk[q * 8192 + e] >= cand[q]) ? 1 : 0; } }
            block_sum4(cnt, sRed + 32 * (par ^= 1));
#pragma unroll
            for (int q = 0; q < 4; ++q) if (cnt[q] >= keff[q]) U[q] = cand[q];
        }
        int cgt[4], ceq[4];
#pragma unroll
        for (int q = 0; q < 4; ++q) { cgt[q] = 0; ceq[q] = 0; }
        for (int i = 0; i < niter; ++i) { const int e = tid + NTHREADS * i; if (e < nkeys) {
#pragma unroll
            for (int q = 0; q < 4; ++q) { const unsigned kk = sk[q * 8192 + e]; cgt[q] += (kk > U[q]) ? 1 : 0; ceq[q] += (kk == U[q]) ? 1 : 0; } } }
        block_sum4(cgt, sRed + 32 * (par ^= 1));
        block_sum4(ceq, sRed + 32 * (par ^= 1));
        int need[4]; int J[4]; bool overflow = false;
#pragma unroll
        for (int q = 0; q < 4; ++q) { need[q] = keff[q] - cgt[q]; J[q] = 8191; overflow = overflow || (ceq[q] > need[q]); }
        if (overflow) {
#pragma unroll
            for (int q = 0; q < 4; ++q) J[q] = 0;
            for (int bit = 12; bit >= 0; --bit) {
                int cj[4]; int cnt[4];
#pragma unroll
                for (int q = 0; q < 4; ++q) { cj[q] = J[q] | (1 << bit); cnt[q] = 0; }
                for (int i = 0; i < niter; ++i) { const int e = tid + NTHREADS * i; if (e < nkeys) {
#pragma unroll
                    for (int q = 0; q < 4; ++q) cnt[q] += (sk[q * 8192 + e] == U[q] && e < cj[q]) ? 1 : 0; } }
                block_sum4(cnt, sRed + 32 * (par ^= 1));
#pragma unroll
                for (int q = 0; q < 4; ++q) if (cnt[q] <= need[q] - 1) J[q] = cj[q];
            }
        }
        int c4[4];
#pragma unroll
        for (int q = 0; q < 4; ++q) c4[q] = 0;
        for (int i = 0; i < 16; ++i) { const int e = 16 * tid + i; if (e < nkeys) {
#pragma unroll
            for (int q = 0; q < 4; ++q) { const unsigned kk = sk[q * 8192 + e]; c4[q] += (kk > U[q] || (kk == U[q] && e <= J[q])) ? 1 : 0; } } }
        int off[4];
#pragma unroll
        for (int q = 0; q < 4; ++q) {
            int v = c4[q];
#pragma unroll
            for (int o = 1; o < 64; o <<= 1) { const int n = __shfl_up(v, o); if (lane >= o) v += n; }
            off[q] = v - c4[q];
            if (lane == 63) sScan[wv * 4 + q] = v;
        }
        __syncthreads();
#pragma unroll
        for (int q = 0; q < 4; ++q) { int base = 0; for (int w = 0; w < wv; ++w) base += sScan[w * 4 + q]; off[q] += base; }
        for (int i = 0; i < 16; ++i) { const int e = 16 * tid + i; if (e < nkeys) {
#pragma unroll
            for (int q = 0; q < 4; ++q) { const unsigned kk = sk[q * 8192 + e];
                if (kk > U[q] || (kk == U[q] && e <= J[q])) { if (off[q] < 256) SEL[(size_t)(t0 + q) * 256 + off[q]] = e; off[q]++; } } } }
    }
}

PHASE_FN void ph_dsa_attn(const Params& p, float* smem) {
    smem = (float*)g_smem;
    int tid_ = threadIdx.x; asm volatile("" : "+v"(tid_)); const int tid = tid_, lane = tid & 63, wv = tid >> 6;
    float* lg = smem + wv * 256;
    const float* QB = (const float*)(p.ws + OFF_QB); const float* KB = (const float*)(p.ws + OFF_KB); const float* P = (const float*)(p.ws + OFF_P);
    const int* SEL = (const int*)(p.ws + OFF_SEL);
    float* O = (float*)(p.ws + OFF_O);
    const int r = lane >> 4, cl = lane & 15;
    for (int it = blockIdx.x * 8 + wv; it < NT * 4; it += gridDim.x * 8) {
        const int t = it >> 2, h = it & 3, b = t >> 13, s = t & 8191;
        const int nsel = (s + 1 < 256) ? (s + 1) : 256;
        float qv[8];
        { const float4 a = *(const float4*)(QB + (size_t)t * 512 + h * 128 + cl * 8), c = *(const float4*)(QB + (size_t)t * 512 + h * 128 + cl * 8 + 4);
          qv[0] = a.x; qv[1] = a.y; qv[2] = a.z; qv[3] = a.w; qv[4] = c.x; qv[5] = c.y; qv[6] = c.z; qv[7] = c.w; }
        for (int kk = 0; kk < nsel; kk += 4) {
            const int ki = kk + r; float part = 0.f;
            if (ki < nsel) {
                const int idx = SEL[(size_t)t * 256 + ki];
                const float* kr = KB + (size_t)(b * 8192 + idx) * 512 + h * 128 + cl * 8;
                const float4 a = *(const float4*)kr, c = *(const float4*)(kr + 4);
                part = qv[0] * a.x + qv[1] * a.y + qv[2] * a.z + qv[3] * a.w + qv[4] * c.x + qv[5] * c.y + qv[6] * c.z + qv[7] * c.w;
            }
            part += __shfl_xor(part, 1); part += __shfl_xor(part, 2); part += __shfl_xor(part, 4); part += __shfl_xor(part, 8);
            if (cl == 0 && ki < nsel) lg[ki] = part * SCALE128;
        }
        __builtin_amdgcn_fence(__ATOMIC_ACQ_REL, "wavefront");
        float m = -INFINITY;
        for (int e = lane; e < nsel; e += 64) m = fmaxf(m, lg[e]);
        m = wave_max(m);
        float sum = 0.f;
        for (int e = lane; e < nsel; e += 64) sum += expf(lg[e] - m);
        sum = wave_sum(sum);
        const float inv = 1.f / sum;
        for (int e = lane; e < nsel; e += 64) lg[e] = expf(lg[e] - m) * inv;
        __builtin_amdgcn_fence(__ATOMIC_ACQ_REL, "wavefront");
        float acc[8];
#pragma unroll
        for (int j = 0; j < 8; ++j) acc[j] = 0.f;
        for (int kk = 0; kk < nsel; kk += 4) {
            const int ki = kk + r;
            if (ki < nsel) {
                const int idx = SEL[(size_t)t * 256 + ki];
                const float pk = lg[ki];
                const float* vr = P + (size_t)(b * 8192 + idx) * LDP + 3080 + h * 128 + cl * 8;
                const float4 a = *(const float4*)vr, c = *(const float4*)(vr + 4);
                acc[0] += pk * a.x; acc[1] += pk * a.y; acc[2] += pk * a.z; acc[3] += pk * a.w; acc[4] += pk * c.x; acc[5] += pk * c.y; acc[6] += pk * c.z; acc[7] += pk * c.w;
            }
        }
#pragma unroll
        for (int j = 0; j < 8; ++j) { acc[j] += __shfl_xor(acc[j], 16); acc[j] += __shfl_xor(acc[j], 32); }
        if (lane < 16) {
            float* op = O + (size_t)t * 1024 + 512 + h * 128 + cl * 8;
            *(float4*)op = make_float4(acc[0], acc[1], acc[2], acc[3]); *(float4*)(op + 4) = make_float4(acc[4], acc[5], acc[6], acc[7]);
        }
        __builtin_amdgcn_fence(__ATOMIC_ACQ_REL, "wavefront");
    }
}

PHASE_FN void ph_gdn_out(const Params& p, int layer) {
    int tid_ = threadIdx.x; asm volatile("" : "+v"(tid_)); const int tid = tid_, lane = tid & 63, wv = tid >> 6;
    float* O = (float*)(p.ws + OFF_O); const float* P = (const float*)(p.ws + OFF_P);
    const float* onw = p.gdn_out_norm + (layer >> 1) * 128;
    for (int t = blockIdx.x * 8 + wv; t < NT; t += gridDim.x * 8) {
#pragma unroll
        for (int h = 0; h < 4; ++h) {
            float* op = O + (size_t)t * 1024 + h * 128;
            const float o0 = op[lane], o1 = op[64 + lane];
            const float ss = wave_sum(o0 * o0 + o1 * o1);
            const float r = rsqrtf(ss * (1.f / 128.f) + EPS);
            const float z0 = P[(size_t)t * LDP + 1536 + h * 128 + lane], z1 = P[(size_t)t * LDP + 1536 + h * 128 + 64 + lane];
            op[lane] = o0 * r * onw[lane] * siluf_(z0); op[64 + lane] = o1 * r * onw[64 + lane] * siluf_(z1);
        }
    }
}

PHASE_FN void ph_gemm_out(const Params& p, int layer, float* smem) {
    smem = (float*)g_smem;
    const bool even = (layer & 1) == 0;
    const float* Wt = (even ? p.even_w_out : p.gla_w_out) + (size_t)(layer >> 1) * ND * ND;
    const float* MOD = (const float*)(p.ws + OFF_MOD);
    for (int tile = blockIdx.x; tile < 128 * 8; tile += gridDim.x) {
        const int mt = tile % 128, nt = tile / 128;
        GemmArgs g; g.A = (const float*)(p.ws + OFF_O); g.lda = ND; g.rows = nullptr; g.m0 = mt * 128; g.mvalid = 128; g.B = Wt; g.ldb = ND; g.n0 = nt * 128; g.N = ND; g.K = ND;
        const int b = (mt * 128) >> 13;
        const float* gt = MOD + (size_t)(layer * 2 + b) * 6144 + 2048;
        float* Xt = p.X + (size_t)mt * 128 * ND;
        gemm128(g, smem, [=](int r, int n, float v) { Xt[(size_t)r * ND + n] += gt[n] * v; });
    }
}

PHASE_FN void ph_norm_ffn(const Params& p, int layer) {
    int tid_ = threadIdx.x; asm volatile("" : "+v"(tid_)); const int tid = tid_, lane = tid & 63, wv = tid >> 6;
    const float* MOD = (const float*)(p.ws + OFF_MOD);
    float* H = (float*)(p.ws + OFF_H);
    int* CNT = (int*)(p.ws + OFF_CNT) + layer * 32;
    int* ASG = (int*)(p.ws + OFF_ASG); float* GATE = (float*)(p.ws + OFF_GATE); int* LIST = (int*)(p.ws + OFF_LIST);
    const float* nw = p.norm_ffn + layer * 1024;
    const float* wg = p.rg_w + (size_t)layer * 1024 * 4;
    for (int row = blockIdx.x * 8 + wv; row < NT; row += gridDim.x * 8) {
        const int b = row >> 13;
        const float* xr = p.X + (size_t)row * ND;
        const float* sh = MOD + (size_t)(layer * 2 + b) * 6144 + 3072;
        const float* sc = sh + 1024;
        float hv[16]; float ss = 0.f;
#pragma unroll
        for (int j = 0; j < 4; ++j) { const float4 v = *(const float4*)(xr + j * 256 + lane * 4); hv[4 * j] = v.x; hv[4 * j + 1] = v.y; hv[4 * j + 2] = v.z; hv[4 * j + 3] = v.w; }
#pragma unroll
        for (int j = 0; j < 16; ++j) ss += hv[j] * hv[j];
        ss = wave_sum(ss);
        const float rstd = rsqrtf(ss * (1.f / 1024.f) + EPS);
#pragma unroll
        for (int j = 0; j < 4; ++j) {
            const int col = j * 256 + lane * 4;
            const float4 w = *(const float4*)(nw + col), s4 = *(const float4*)(sc + col), h4 = *(const float4*)(sh + col);
            hv[4 * j] = hv[4 * j] * rstd * w.x * (1.f + s4.x) + h4.x; hv[4 * j + 1] = hv[4 * j + 1] * rstd * w.y * (1.f + s4.y) + h4.y;
            hv[4 * j + 2] = hv[4 * j + 2] * rstd * w.z * (1.f + s4.z) + h4.z; hv[4 * j + 3] = hv[4 * j + 3] * rstd * w.w * (1.f + s4.w) + h4.w;
            *(float4*)(H + (size_t)row * ND + col) = make_float4(hv[4 * j], hv[4 * j + 1], hv[4 * j + 2], hv[4 * j + 3]);
        }
        float gl[4] = {0.f, 0.f, 0.f, 0.f};
#pragma unroll
        for (int j = 0; j < 4; ++j)
#pragma unroll
            for (int e = 0; e < 4; ++e) { const int col = j * 256 + lane * 4 + e; const float4 w = *(const float4*)(wg + (size_t)col * 4); const float hh = hv[4 * j + e];
                gl[0] += hh * w.x; gl[1] += hh * w.y; gl[2] += hh * w.z; gl[3] += hh * w.w; }
#pragma unroll
        for (int g = 0; g < 4; ++g) gl[g] = wave_sum(gl[g]) + p.rg_b[layer * 4 + g];
        int gs = 0; float gm = gl[0];
#pragma unroll
        for (int g = 1; g < 4; ++g) if (gl[g] > gm) { gm = gl[g]; gs = g; }
        float gsum = 0.f;
#pragma unroll
        for (int g = 0; g < 4; ++g) gsum += expf(gl[g] - gm);
        const float ggate = 1.f / gsum;
        const float* we = p.re_w + ((size_t)(layer * 4 + gs) * 1024) * 8;
        float el[8] = {0.f, 0.f, 0.f, 0.f, 0.f, 0.f, 0.f, 0.f};
#pragma unroll
        for (int j = 0; j < 4; ++j)
#pragma unroll
            for (int e = 0; e < 4; ++e) { const int col = j * 256 + lane * 4 + e; const float4 w0 = *(const float4*)(we + (size_t)col * 8), w1 = *(const float4*)(we + (size_t)col * 8 + 4); const float hh = hv[4 * j + e];
                el[0] += hh * w0.x; el[1] += hh * w0.y; el[2] += hh * w0.z; el[3] += hh * w0.w; el[4] += hh * w1.x; el[5] += hh * w1.y; el[6] += hh * w1.z; el[7] += hh * w1.w; }
#pragma unroll
        for (int e = 0; e < 8; ++e) el[e] = wave_sum(el[e]) + p.re_b[(layer * 4 + gs) * 8 + e];
        int i1 = 0; float l1 = el[0];
#pragma unroll
        for (int e = 1; e < 8; ++e) if (el[e] > l1) { l1 = el[e]; i1 = e; }
        int i2 = -1; float l2 = -INFINITY;
#pragma unroll
        for (int e = 0; e < 8; ++e) if (e != i1 && el[e] > l2) { l2 = el[e]; i2 = e; }
        const float ex = expf(l2 - l1);
        const float p1 = 1.f / (1.f + ex), p2 = ex / (1.f + ex);
        if (lane == 0) {
            const int e1 = gs * 8 + i1, e2 = gs * 8 + i2;
            const int r1 = atomicAdd(&CNT[e1], 1), r2 = atomicAdd(&CNT[e2], 1);
            LIST[(size_t)e1 * LISTCAP + r1] = row; LIST[(size_t)e2 * LISTCAP + r2] = row;
            ASG[row * 4 + 0] = e1; ASG[row * 4 + 1] = r1; ASG[row * 4 + 2] = e2; ASG[row * 4 + 3] = r2;
            GATE[row * 2] = ggate * p1; GATE[row * 2 + 1] = ggate * p2;
        }
    }
}

PHASE_FN void ph_moe(const Params& p, int layer, int which, float* smem) {
    smem = (float*)g_smem;
    int tid_ = threadIdx.x; asm volatile("" : "+v"(tid_)); const int tid = tid_;
    int* sPad = (int*)smem; int* sTs = sPad + 33;
    const int* CNT = (const int*)(p.ws + OFF_CNT) + layer * 32;
    __syncthreads();
    if (tid == 0) { int a = 0, ts = 0; for (int e = 0; e < 32; ++e) { sPad[e] = a; sTs[e] = ts; const int nm = (CNT[e] + 127) / 128; a += nm * 128; ts += nm; } sTs[32] = ts; sPad[32] = a; }
    __syncthreads();
    float* gs = smem + 128;
    const int ntn = (which == 0) ? 4 : 8;
    const int total = sTs[32] * ntn;
    float* HID = (float*)(p.ws + OFF_HID); float* YB = (float*)(p.ws + OFF_YB);
    const int* LIST = (const int*)(p.ws + OFF_LIST);
    for (int tile = blockIdx.x; tile < total; tile += gridDim.x) {
        const int mt = tile / ntn, nt = tile % ntn;
        int e = 0;
        for (int q = 1; q < 32; ++q) if (sTs[q] <= mt) e = q;
        const int mi = mt - sTs[e];
        const int cnt = CNT[e];
        const int mvalid = (cnt - mi * 128 < 128) ? (cnt - mi * 128) : 128;
        const int rowbase = sPad[e] + mi * 128;
        if (which == 0) {
            GemmArgs g; g.A = (const float*)(p.ws + OFF_H); g.lda = ND; g.rows = LIST + (size_t)e * LISTCAP + mi * 128; g.m0 = 0; g.mvalid = mvalid;
            g.B = p.w1 + ((size_t)(layer * 32 + e)) * 1024 * 512; g.ldb = 512; g.n0 = nt * 128; g.N = 512; g.K = 1024;
            float* Ht = HID + (size_t)rowbase * 512;
            gemm128(g, gs, [=](int r, int n, float v) { Ht[(size_t)r * 512 + n] = v; });
            g.B = p.w3 + ((size_t)(layer * 32 + e)) * 1024 * 512;
            gemm128(g, gs, [=](int r, int n, float v) { const float a = Ht[(size_t)r * 512 + n]; Ht[(size_t)r * 512 + n] = siluf_(a) * v; });
        } else {
            GemmArgs g; g.A = HID + (size_t)rowbase * 512; g.lda = 512; g.rows = nullptr; g.m0 = 0; g.mvalid = mvalid;
            g.B = p.w2 + ((size_t)(layer * 32 + e)) * 512 * 1024; g.ldb = 1024; g.n0 = nt * 128; g.N = 1024; g.K = 512;
            float* Yt = YB + (size_t)rowbase * 1024;
            gemm128(g, gs, [=](int r, int n, float v) { Yt[(size_t)r * 1024 + n] = v; });
        }
    }
}

PHASE_FN void ph_gla_tok(const Params& p, int layer) {
    int tid_ = threadIdx.x; asm volatile("" : "+v"(tid_)); const int tid = tid_, lane = tid & 63, wv = tid >> 6, li = layer >> 1;
    const float* P = (const float*)(p.ws + OFF_P);
    float* LA = (float*)(p.ws + OFF_LA);
    const float* w2 = p.gla_w_gate2 + (size_t)li * 16 * 512; const float* b2 = p.gla_b_gate2 + li * 512;
    for (int t = blockIdx.x * 8 + wv; t < NT; t += gridDim.x * 8) {
        float glr[16];
#pragma unroll
        for (int r = 0; r < 16; ++r) glr[r] = P[(size_t)t * LDP + 3072 + r];
#pragma unroll 1
        for (int i = 0; i < 8; ++i) {
            const int c = lane + 64 * i; float z = b2[c];
#pragma unroll
            for (int r = 0; r < 16; ++r) z += glr[r] * w2[r * 512 + c];
            LA[(size_t)t * 512 + c] = -softplusf_(-z) * (1.f / 16.f);
        }
    }
}

PHASE_FN void ph_gla_chunk(const Params& p, float* smem) {
    smem = (float*)g_smem;
    int tid_ = threadIdx.x; asm volatile("" : "+v"(tid_)); const int tid = tid_;
    float* sQ = smem; float* sK = sQ + 64 * 129; float* sBc = sK + 64 * 129;
    const float* P = (const float*)(p.ws + OFF_P); const float* LA = (const float*)(p.ws + OFF_LA);
    float* ATT = (float*)(p.ws + OFF_ATT); float* QE = (float*)(p.ws + OFF_QE); float* KD = (float*)(p.ws + OFF_GKD); float* EBL = (float*)(p.ws + OFF_EBL);
    for (int ci = blockIdx.x; ci < 1024; ci += gridDim.x) {
        const int b = ci >> 9, h = (ci >> 7) & 3, n = ci & 127;
        const int t0 = b * 8192 + n * 64;
        __syncthreads();
        for (int e = tid; e < 8192; e += NTHREADS) {
            const int i = e >> 7, d = e & 127;
            sQ[i * 129 + d] = P[(size_t)(t0 + i) * LDP + h * 128 + d]; sK[i * 129 + d] = P[(size_t)(t0 + i) * LDP + 512 + h * 128 + d];
            sBc[i * 129 + d] = LA[(size_t)(t0 + i) * 512 + h * 128 + d];
        }
        __syncthreads();
        if (tid < 128) { float a = 0.f; for (int i = 0; i < 64; ++i) { a += sBc[i * 129 + tid]; sBc[i * 129 + tid] = a; } }
        __syncthreads();
        for (int e = tid; e < 4096; e += NTHREADS) {
            const int i = e >> 6, j = e & 63; float a = 0.f;
            if (j <= i) { for (int d = 0; d < 128; ++d) a += sQ[i * 129 + d] * sK[j * 129 + d] * expf(sBc[i * 129 + d] - sBc[j * 129 + d]); }
            ATT[(size_t)ci * 4096 + e] = a * SCALE128;
        }
        for (int e = tid; e < 8192; e += NTHREADS) {
            const int i = e >> 7, d = e & 127;
            QE[(size_t)ci * 8192 + e] = sQ[i * 129 + d] * SCALE128 * expf(sBc[i * 129 + d]);
            KD[(size_t)ci * 8192 + e] = sK[i * 129 + d] * expf(sBc[63 * 129 + d] - sBc[i * 129 + d]);
        }
        if (tid < 128) EBL[ci * 128 + tid] = expf(sBc[63 * 129 + tid]);
    }
}

PHASE_FN void ph_gla_scan(const Params& p, float* smem) {
    smem = (float*)g_smem;
    int tid_ = threadIdx.x; asm volatile("" : "+v"(tid_)); const int tid = tid_;
    float* sS = smem; float* sW = sS + 128 * 17; float* sV = sW + 64 * 129; float* sA = sV + 64 * 17; float* sE = sA + 64 * 65;
    const float* P = (const float*)(p.ws + OFF_P);
    const float* ATT = (const float*)(p.ws + OFF_ATT); const float* QE = (const float*)(p.ws + OFF_QE); const float* KD = (const float*)(p.ws + OFF_GKD); const float* EBL = (const float*)(p.ws + OFF_EBL);
    float* O = (float*)(p.ws + OFF_O);
    for (int it = blockIdx.x; it < 128; it += gridDim.x) {
        const int bh = it >> 4, sl = it & 15, b = bh >> 2, h = bh & 3;
        __syncthreads();
        for (int e = tid; e < 128 * 16; e += NTHREADS) sS[(e >> 4) * 17 + (e & 15)] = 0.f;
        for (int n = 0; n < 128; ++n) {
            const int ci = bh * 128 + n, t0 = b * 8192 + n * 64;
            __syncthreads();
            for (int e = tid; e < 8192; e += NTHREADS) sW[(e >> 7) * 129 + (e & 127)] = QE[(size_t)ci * 8192 + e];
            for (int e = tid; e < 4096; e += NTHREADS) sA[(e >> 6) * 65 + (e & 63)] = ATT[(size_t)ci * 4096 + e];
            for (int e = tid; e < 1024; e += NTHREADS) sV[(e >> 4) * 17 + (e & 15)] = P[(size_t)(t0 + (e >> 4)) * LDP + 1024 + h * 256 + sl * 16 + (e & 15)];
            if (tid < 128) sE[tid] = EBL[ci * 128 + tid];
            __syncthreads();
            for (int o = tid; o < 1024; o += NTHREADS) {
                const int i = o >> 4, c = o & 15; float a = 0.f;
                for (int d = 0; d < 128; ++d) a += sW[i * 129 + d] * sS[d * 17 + c];
                for (int j = 0; j < 64; ++j) a += sA[i * 65 + j] * sV[j * 17 + c];
                O[(size_t)(t0 + i) * 1024 + h * 256 + sl * 16 + c] = a;
            }
            __syncthreads();
            for (int e = tid; e < 8192; e += NTHREADS) sW[(e >> 7) * 129 + (e & 127)] = KD[(size_t)ci * 8192 + e];
            __syncthreads();
            for (int o = tid; o < 2048; o += NTHREADS) {
                const int d = o >> 4, c = o & 15; float a = sS[d * 17 + c] * sE[d];
                for (int j = 0; j < 64; ++j) a += sW[j * 129 + d] * sV[j * 17 + c];
                sS[d * 17 + c] = a;
            }
        }
    }
}

PHASE_FN void ph_gla_out(const Params& p, int layer) {
    int tid_ = threadIdx.x; asm volatile("" : "+v"(tid_)); const int tid = tid_, lane = tid & 63, wv = tid >> 6;
    float* O = (float*)(p.ws + OFF_O); const float* P = (const float*)(p.ws + OFF_P);
    const float* onw = p.gla_out_norm + (layer >> 1) * 256;
    for (int t = blockIdx.x * 8 + wv; t < NT; t += gridDim.x * 8) {
#pragma unroll
        for (int h = 0; h < 4; ++h) {
            float* op = O + (size_t)t * 1024 + h * 256;
            const float4 o = *(const float4*)(op + lane * 4);
            const float ss = wave_sum(o.x * o.x + o.y * o.y + o.z * o.z + o.w * o.w);
            const float r = rsqrtf(ss * (1.f / 256.f) + EPS);
            const float4 z = *(const float4*)(P + (size_t)t * LDP + 2048 + h * 256 + lane * 4);
            const float4 w = *(const float4*)(onw + lane * 4);
            *(float4*)(op + lane * 4) = make_float4(o.x * r * w.x * siluf_(z.x), o.y * r * w.y * siluf_(z.y), o.z * r * w.z * siluf_(z.z), o.w * r * w.w * siluf_(z.w));
        }
    }
}

template <int PH>
__device__ __forceinline__ void run_phase(const Params& p, int layer, float* smem) {
    if (PH == PH_PROLOGUE) ph_prologue(p, smem);
    else if (PH == PH_NORM_MIX) ph_rows(p, layer, 0, smem);
    else if (PH == PH_GEMM_IN_EVEN) ph_gemm_in(p, layer, true, smem);
    else if (PH == PH_EVEN_TOK) ph_even_tok(p, layer, smem);
    else if (PH == PH_GDN_CHUNK) ph_gdn_chunk(p, smem);
    else if (PH == PH_GDN_SCAN) ph_gdn_scan(p, smem);
    else if (PH == PH_DSA_TOPK) ph_dsa_topk(p, smem);
    else if (PH == PH_DSA_ATTN) ph_dsa_attn(p, smem);
    else if (PH == PH_GDN_OUT) ph_gdn_out(p, layer);
    else if (PH == PH_GEMM_OUT) ph_gemm_out(p, layer, smem);
    else if (PH == PH_NORM_FFN) ph_norm_ffn(p, layer);
    else if (PH == PH_MOE1) ph_moe(p, layer, 0, smem);
    else if (PH == PH_MOE2) ph_moe(p, layer, 1, smem);
    else if (PH == PH_GEMM_IN_ODD) ph_gemm_in(p, layer, false, smem);
    else if (PH == PH_GLA_TOK) ph_gla_tok(p, layer);
    else if (PH == PH_GLA_CHUNK) ph_gla_chunk(p, smem);
    else if (PH == PH_GLA_SCAN) ph_gla_scan(p, smem);
    else if (PH == PH_GLA_OUT) ph_gla_out(p, layer);
    else if (PH == PH_FINAL) ph_rows(p, 0, 1, smem);
}

#if MK_MULTI
template <int PH>
__global__ void __launch_bounds__(NTHREADS, 2) k_phase(Params p, int layer) {
    run_phase<PH>(p, layer, (float*)g_smem);
}
#else
__global__ void __launch_bounds__(NTHREADS, 2) k_mega(Params p) {
    float* smem = (float*)g_smem;
    volatile LAS unsigned* xbw = (volatile LAS unsigned*)(LAS unsigned char*)(g_smem + LDS_BYTES - 16);
    if (threadIdx.x == 0) { xbw[0] = 0u; xbw[1] = 0u; xbw[2] = 0u; xbw[3] = 0u; }
    __syncthreads();
    XcdBarrier bar = xcd_barrier_post((unsigned*)(p.ws + OFF_BAR), xbw);
#define BAR() xcd_barrier(bar)
    run_phase<PH_PROLOGUE>(p, 0, smem); BAR();
    for (int lp = 0; lp < 2; ++lp) {
        const int le = 2 * lp, lo = 2 * lp + 1;
        run_phase<PH_NORM_MIX>(p, le, smem); BAR();
        run_phase<PH_GEMM_IN_EVEN>(p, le, smem); BAR();
        run_phase<PH_EVEN_TOK>(p, le, smem); BAR();
        run_phase<PH_GDN_CHUNK>(p, le, smem); BAR();
        run_phase<PH_GDN_SCAN>(p, le, smem); BAR();
        run_phase<PH_DSA_TOPK>(p, le, smem); BAR();
        run_phase<PH_DSA_ATTN>(p, le, smem); BAR();
        run_phase<PH_GDN_OUT>(p, le, smem); BAR();
        run_phase<PH_GEMM_OUT>(p, le, smem); BAR();
        run_phase<PH_NORM_FFN>(p, le, smem); BAR();
        run_phase<PH_MOE1>(p, le, smem); BAR();
        run_phase<PH_MOE2>(p, le, smem); BAR();
        run_phase<PH_NORM_MIX>(p, lo, smem); BAR();
        run_phase<PH_GEMM_IN_ODD>(p, lo, smem); BAR();
        run_phase<PH_GLA_TOK>(p, lo, smem); BAR();
        run_phase<PH_GLA_CHUNK>(p, lo, smem); BAR();
        run_phase<PH_GLA_SCAN>(p, lo, smem); BAR();
        run_phase<PH_GLA_OUT>(p, lo, smem); BAR();
        run_phase<PH_GEMM_OUT>(p, lo, smem); BAR();
        run_phase<PH_NORM_FFN>(p, lo, smem); BAR();
        run_phase<PH_MOE1>(p, lo, smem); BAR();
        run_phase<PH_MOE2>(p, lo, smem); BAR();
    }
    run_phase<PH_FINAL>(p, 0, smem);
}
#endif

}

#if MK_MULTI
template <int PH>
static void launch_phase(const Params& p, int layer, hipStream_t stream) {
    static bool attr_set = false;
    if (!attr_set) { hipFuncSetAttribute((const void*)k_phase<PH>, hipFuncAttributeMaxDynamicSharedMemorySize, (int)LDS_BYTES); attr_set = true; }
    hipLaunchKernelGGL((k_phase<PH>), dim3(256), dim3(NTHREADS), LDS_BYTES, stream, p, layer);
}
#endif

extern "C" void kernel_launch(void* const* d_in, const int* in_sizes, int n_in, void* d_out, int out_size, void* d_ws, size_t ws_size, hipStream_t stream) {
    (void)in_sizes; (void)n_in; (void)out_size;
    if (ws_size < WS_NEEDED) { fprintf(stderr, "workspace too small: %zu < %zu\n", ws_size, (size_t)WS_NEEDED); return; }
    Params p{};
    p.x = (const float*)d_in[0]; p.c = (const float*)d_in[1]; p.pos = (const int*)d_in[2]; p.ada_w = (const float*)d_in[3]; p.ada_b = (const float*)d_in[4];
    p.norm_mix = (const float*)d_in[5]; p.norm_ffn = (const float*)d_in[6]; p.even_w_in = (const float*)d_in[7]; p.conv_w = (const float*)d_in[8];
    p.a_log = (const float*)d_in[9]; p.dt_bias = (const float*)d_in[10]; p.gdn_out_norm = (const float*)d_in[11]; p.even_w_out = (const float*)d_in[12];
    p.gla_w_in = (const float*)d_in[13]; p.gla_w_gate2 = (const float*)d_in[14]; p.gla_b_gate2 = (const float*)d_in[15]; p.gla_out_norm = (const float*)d_in[16]; p.gla_w_out = (const float*)d_in[17];
    p.rg_w = (const float*)d_in[18]; p.rg_b = (const float*)d_in[19]; p.re_w = (const float*)d_in[20]; p.re_b = (const float*)d_in[21];
    p.w1 = (const float*)d_in[22]; p.w3 = (const float*)d_in[23]; p.w2 = (const float*)d_in[24]; p.final_norm = (const float*)d_in[25];
    p.X = (float*)d_out; p.ws = (unsigned char*)d_ws;
    p.rA = pow(10000.0, -2.0 / 128.0); p.rI = pow(10000.0, -2.0 / 64.0);
    hipMemsetAsync(d_ws, 0, ZERO_BYTES, stream);
#if MK_MULTI
    launch_phase<PH_PROLOGUE>(p, 0, stream);
    for (int lp = 0; lp < 2; ++lp) {
        const int le = 2 * lp, lo = 2 * lp + 1;
        launch_phase<PH_NORM_MIX>(p, le, stream);
        launch_phase<PH_GEMM_IN_EVEN>(p, le, stream);
        launch_phase<PH_EVEN_TOK>(p, le, stream);
        launch_phase<PH_GDN_CHUNK>(p, le, stream);
        launch_phase<PH_GDN_SCAN>(p, le, stream);
        launch_phase<PH_DSA_TOPK>(p, le, stream);
        launch_phase<PH_DSA_ATTN>(p, le, stream);
        launch_phase<PH_GDN_OUT>(p, le, stream);
        launch_phase<PH_GEMM_OUT>(p, le, stream);
        launch_phase<PH_NORM_FFN>(p, le, stream);
        launch_phase<PH_MOE1>(p, le, stream);
        launch_phase<PH_MOE2>(p, le, stream);
        launch_phase<PH_NORM_MIX>(p, lo, stream);
        launch_phase<PH_GEMM_IN_ODD>(p, lo, stream);
        launch_phase<PH_GLA_TOK>(p, lo, stream);
        launch_phase<PH_GLA_CHUNK>(p, lo, stream);
        launch_phase<PH_GLA_SCAN>(p, lo, stream);
        launch_phase<PH_GLA_OUT>(p, lo, stream);
        launch_phase<PH_GEMM_OUT>(p, lo, stream);
        launch_phase<PH_NORM_FFN>(p, lo, stream);
        launch_phase<PH_MOE1>(p, lo, stream);
        launch_phase<PH_MOE2>(p, lo, stream);
    }
    launch_phase<PH_FINAL>(p, 0, stream);
#else
    static int grid = 0;
    if (!grid) {
        int dev = 0, cus = 0, per_cu = 0;
        hipGetDevice(&dev);
        hipDeviceGetAttribute(&cus, hipDeviceAttributeMultiprocessorCount, dev);
        hipFuncSetAttribute((const void*)k_mega, hipFuncAttributeMaxDynamicSharedMemorySize, (int)LDS_BYTES);
        hipOccupancyMaxActiveBlocksPerMultiprocessor(&per_cu, k_mega, NTHREADS, LDS_BYTES);
        if (cus <= 0) cus = 256;
        grid = cus * (per_cu < 1 ? 1 : 1);
    }
    hipLaunchKernelGGL(k_mega, dim3(grid), dim3(NTHREADS), LDS_BYTES, stream, p);
#endif
}
```

```cpp
#include <hip/hip_runtime.h>
#include <stdint.h>
#include <math.h>
#include <stdio.h>

#define EXTRA_BARS 0
#ifndef DUP_MASK
#define DUP_MASK 0
#endif
#ifndef MK_MULTI
#define MK_MULTI 0
#endif

namespace {

constexpr int NT = 16384, ND = 1024, LDP = 3920;
constexpr float EPS = 1e-6f;
constexpr int NTHREADS = 512;
constexpr size_t LDS_BYTES = 147456;
constexpr float SCALE128 = 0.08838834764831845f;
constexpr int LISTCAP = 32768;
constexpr int CSTR = 16;

constexpr size_t OFF_BAR  = 0;
constexpr size_t OFF_CNT  = 16384;
constexpr size_t ZERO_BYTES = 32768;
constexpr size_t OFF_MOD  = 32768;
constexpr size_t OFF_COSA = OFF_MOD + 4 * 2 * 6144 * 4;
constexpr size_t OFF_SINA = OFF_COSA + (size_t)NT * 64 * 4;
constexpr size_t OFF_COSI = OFF_SINA + (size_t)NT * 64 * 4;
constexpr size_t OFF_SINI = OFF_COSI + (size_t)NT * 32 * 4;
constexpr size_t OFF_H    = OFF_SINI + (size_t)NT * 32 * 4;
constexpr size_t OFF_P    = OFF_H + (size_t)NT * 1024 * 4;
constexpr size_t OFF_HID  = OFF_P;
constexpr size_t OFF_YB   = OFF_HID + (size_t)36864 * 512 * 4;
constexpr size_t OFF_O    = OFF_P + (size_t)NT * LDP * 4;
constexpr size_t OFF_ASG  = OFF_O + (size_t)NT * 1024 * 4;
constexpr size_t OFF_GATE = OFF_ASG + (size_t)NT * 4 * 4;
constexpr size_t OFF_LIST = OFF_GATE + (size_t)NT * 2 * 4;
constexpr size_t OFF_R    = OFF_LIST + (size_t)32 * LISTCAP * 4;
constexpr size_t OFF_QN   = OFF_R;
constexpr size_t OFF_KN   = OFF_QN + (size_t)NT * 512 * 4;
constexpr size_t OFF_VC   = OFF_KN + (size_t)NT * 512 * 4;
constexpr size_t OFF_BETA = OFF_VC + (size_t)NT * 512 * 4;
constexpr size_t OFF_G    = OFF_BETA + (size_t)NT * 4 * 4;
constexpr size_t OFF_W    = OFF_G + (size_t)NT * 4 * 4;
constexpr size_t OFF_U    = OFF_W + (size_t)1024 * 8192 * 4;
constexpr size_t OFF_QG   = OFF_U + (size_t)1024 * 8192 * 4;
constexpr size_t OFF_KD   = OFF_QG + (size_t)1024 * 8192 * 4;
constexpr size_t OFF_AQK  = OFF_KD + (size_t)1024 * 8192 * 4;
constexpr size_t OFF_GL   = OFF_AQK + (size_t)1024 * 4096 * 4;
constexpr size_t OFF_QB   = OFF_GL + 4096;
constexpr size_t OFF_KB   = OFF_QB + (size_t)NT * 512 * 4;
constexpr size_t OFF_QI   = OFF_KB + (size_t)NT * 512 * 4;
constexpr size_t OFF_KI   = OFF_QI + (size_t)NT * 256 * 4;
constexpr size_t OFF_WI   = OFF_KI + (size_t)NT * 64 * 4;
constexpr size_t OFF_SEL  = OFF_WI + (size_t)NT * 4 * 4;
constexpr size_t OFF_EVEN_END = OFF_SEL + (size_t)NT * 256 * 4;
constexpr size_t OFF_QBB  = OFF_QB;
constexpr size_t OFF_KBB  = OFF_QBB + (size_t)NT * 512 * 2;
constexpr size_t OFF_VT   = OFF_KBB + (size_t)NT * 512 * 2;
constexpr size_t OFF_QIB  = OFF_VT + (size_t)NT * 512 * 2;
constexpr size_t OFF_KIB  = OFF_QIB + (size_t)NT * 256 * 2;
constexpr size_t OFF_M16  = OFF_KIB + (size_t)NT * 64 * 2;
static_assert(OFF_M16 + (size_t)NT * 512 * 2 <= OFF_WI, "dsa v2 buffers overflow");
constexpr size_t OFF_LA   = OFF_R;
constexpr size_t OFF_ATT  = OFF_LA + (size_t)NT * 512 * 4;
constexpr size_t OFF_QE   = OFF_ATT + (size_t)1024 * 4096 * 4;
constexpr size_t OFF_GKD  = OFF_QE + (size_t)1024 * 8192 * 4;
constexpr size_t OFF_EBL  = OFF_GKD + (size_t)1024 * 8192 * 4;
constexpr size_t OFF_WINE = OFF_EVEN_END;
constexpr size_t OFF_WINO = OFF_WINE + (size_t)2 * 3968 * 1024 * 2;
constexpr size_t OFF_WOUT = OFF_WINO + (size_t)2 * 3200 * 1024 * 2;
constexpr size_t OFF_W13  = OFF_WOUT + (size_t)4 * 1024 * 1024 * 2;
constexpr size_t OFF_W2T  = OFF_W13 + (size_t)32 * 1024 * 1024 * 2;
constexpr size_t WS_NEEDED = OFF_W2T + (size_t)32 * 1024 * 512 * 2;

struct Params {
    const float* x; const float* c; const int* pos; const float* ada_w; const float* ada_b;
    const float* norm_mix; const float* norm_ffn; const float* even_w_in; const float* conv_w;
    const float* a_log; const float* dt_bias; const float* gdn_out_norm; const float* even_w_out;
    const float* gla_w_in; const float* gla_w_gate2; const float* gla_b_gate2; const float* gla_out_norm; const float* gla_w_out;
    const float* rg_w; const float* rg_b; const float* re_w; const float* re_b;
    const float* w1; const float* w3; const float* w2; const float* final_norm;
    float* X;
    unsigned char* ws;
    double rA, rI;
};

#define XB_TMO      128
#define XB_XCNT(j)  (256  + 64 * (j))
#define XB_XSUB(j)  (1280 + 64 * (j))
#define XB_XGEN(j)  (2304 + 64 * (j))
#define XB_TOP      3328
#define XB_TOPGEN   3392
#define XCD_BAR_WORDS 3456
#define XB_SPIN_CAP (1u << 18)
#define LAS __attribute__((address_space(3)))

__device__ __forceinline__ unsigned xb_ld(unsigned* p)              { return __hip_atomic_load(p, __ATOMIC_RELAXED, __HIP_MEMORY_SCOPE_AGENT); }
__device__ __forceinline__ unsigned xb_add(unsigned* p, unsigned v) { return __hip_atomic_fetch_add(p, v, __ATOMIC_RELAXED, __HIP_MEMORY_SCOPE_AGENT); }
__device__ __forceinline__ unsigned xb_xcc_id() { return (unsigned)__builtin_amdgcn_s_getreg((3 << 11) | 20) & 0xFu; }
#define XB_SPIN(cond, bar) do { unsigned _sp = 0; while (cond) { __builtin_amdgcn_s_sleep(1); \
    if ((++_sp & 255u) == 0u) { if (xb_ld(&(bar)[XB_TMO])) break; if (_sp > XB_SPIN_CAP) { atomicAdd(&(bar)[XB_TMO], 1u); break; } } } } while (0)

struct XcdBarrier { unsigned* bar; unsigned x; volatile LAS unsigned* st; };

__device__ __forceinline__ XcdBarrier xcd_barrier_post(unsigned* bar, volatile LAS unsigned* st) {
    XcdBarrier b; b.bar = bar; b.x = xb_xcc_id(); b.st = st;
    if (threadIdx.x == 0) (void)xb_add(&bar[XB_XCNT(b.x)], 1u);
    return b;
}
__device__ __forceinline__ void xcd_barrier_complete(unsigned* bar, unsigned x, unsigned& nloc, unsigned& nx) {
    const unsigned G = gridDim.x * gridDim.y * gridDim.z;
    unsigned sum, cnt, mine, sp = 0u;
    for (;;) {
        sum = 0u; cnt = 0u; mine = 0u;
#pragma unroll
        for (unsigned j = 0; j < 16; ++j) { const unsigned c = xb_ld(&bar[XB_XCNT(j)]); sum += c; cnt += (c > 0u) ? 1u : 0u; mine = (j == x) ? c : mine; }
        if (sum == G) break;
        __builtin_amdgcn_s_sleep(1);
        if ((++sp & 255u) == 0u) { if (xb_ld(&bar[XB_TMO])) break; if (sp > XB_SPIN_CAP) { atomicAdd(&bar[XB_TMO], 1u); break; } }
    }
    nloc = mine > 0u ? mine : 1u; nx = cnt > 0u ? cnt : 1u;
}
__device__ __forceinline__ void xcd_barrier(const XcdBarrier& b) {
    asm volatile("s_waitcnt vmcnt(0)" ::: "memory");
    __syncthreads();
    if (threadIdx.x == 0) {
        unsigned* bar = b.bar;
        __builtin_amdgcn_s_waitcnt(0);
        unsigned nloc = b.st[0], nx = b.st[1];
        if (nloc == 0u) { xcd_barrier_complete(bar, b.x, nloc, nx); b.st[0] = nloc; b.st[1] = nx; }
        const unsigned old = xb_add(&bar[XB_XSUB(b.x)], 1u);
        const unsigned gen = old / nloc;
        if (old + 1u == (gen + 1u) * nloc) {
            __builtin_amdgcn_fence(__ATOMIC_RELEASE, "agent");
            asm volatile("s_waitcnt vmcnt(0)" ::: "memory");
            const unsigned og = xb_add(&bar[XB_TOP], 1u);
            const unsigned tg = og / nx;
            if (og + 1u == (tg + 1u) * nx) xb_add(&bar[XB_TOPGEN], 1u);
            else XB_SPIN(xb_ld(&bar[XB_TOPGEN]) == tg, bar);
            __builtin_amdgcn_fence(__ATOMIC_ACQUIRE, "agent");
            xb_add(&bar[XB_XGEN(b.x)], 1u);
            asm volatile("s_waitcnt vmcnt(0)" ::: "memory");
        } else {
            XB_SPIN(xb_ld(&bar[XB_XGEN(b.x)]) == gen, bar);
            __builtin_amdgcn_fence(__ATOMIC_ACQUIRE, "agent");
            asm volatile("s_waitcnt vmcnt(0)" ::: "memory");
        }
    }
    __syncthreads();
}

__device__ __forceinline__ float wave_sum(float v) {
#pragma unroll
    for (int o = 32; o > 0; o >>= 1) v += __shfl_xor(v, o);
    return v;
}
__device__ __forceinline__ int wave_sum_i(int v) {
#pragma unroll
    for (int o = 32; o > 0; o >>= 1) v += __shfl_xor(v, o);
    return v;
}
__device__ __forceinline__ float wave_max(float v) {
#pragma unroll
    for (int o = 32; o > 0; o >>= 1) v = fmaxf(v, __shfl_xor(v, o));
    return v;
}
__device__ __forceinline__ float sigmoidf_(float x) { return 1.f / (1.f + expf(-x)); }
__device__ __forceinline__ float siluf_(float x) { return x / (1.f + expf(-x)); }
__device__ __forceinline__ float softplusf_(float x) { return fmaxf(x, 0.f) + log1pf(expf(-fabsf(x))); }
__device__ __forceinline__ unsigned ordkey(float f) { const unsigned u = __float_as_uint(f); return (u & 0x80000000u) ? ~u : (u | 0x80000000u); }

__device__ __forceinline__ void sincos_d(double a, double& s, double& c) {
    const double kq = rint(a * 0.63661977236758134308);
    double r = fma(-kq, 1.57079632673412561417e+00, a);
    r = fma(-kq, 6.07710050650619224932e-11, r);
    const int q = (int)((long long)kq & 3);
    const double r2 = r * r;
    const double sp = r * (1.0 + r2 * (-1.0 / 6 + r2 * (1.0 / 120 + r2 * (-1.0 / 5040 + r2 * (1.0 / 362880 + r2 * (-1.0 / 39916800 + r2 * (1.0 / 6227020800.0)))))));
    const double cp = 1.0 + r2 * (-0.5 + r2 * (1.0 / 24 + r2 * (-1.0 / 720 + r2 * (1.0 / 40320 + r2 * (-1.0 / 3628800 + r2 * (1.0 / 479001600.0 + r2 * (-1.0 / 87178291200.0)))))));
    if (q == 0) { s = sp; c = cp; } else if (q == 1) { s = cp; c = -sp; } else if (q == 2) { s = -sp; c = -cp; } else { s = -cp; c = sp; }
}
__device__ __forceinline__ double ipow_d(double b, int e) { double v = 1.0; while (e) { if (e & 1) v *= b; b *= b; e >>= 1; } return v; }

struct GemmArgs { const float* A; int lda; const int* rows; int m0; int mvalid; const float* B; int ldb; int n0; int N; int K; };

template <class Epi>
__device__ __forceinline__ void gemm128(const GemmArgs& g, float* smem, Epi epi) {
    float* As = smem;
    float* Bs = smem + 16 * 132;
    int tid_ = threadIdx.x; asm volatile("" : "+v"(tid_)); const int tid = tid_, ty = tid >> 4, tx = tid & 15;
    const int arow = tid >> 2, kq = (tid & 3) * 4;
    const int bk = tid >> 5, bn = (tid & 31) * 4;
    long asrc = -1;
    if (arow < g.mvalid) { const int r = g.rows ? g.rows[arow] : (g.m0 + arow); if (r >= 0) asrc = (long)r * g.lda; }
    const bool bval = (g.n0 + bn) < g.N;
    float acc[4][8];
#pragma unroll
    for (int i = 0; i < 4; ++i)
#pragma unroll
        for (int j = 0; j < 8; ++j) acc[i][j] = 0.f;
    for (int k0 = 0; k0 < g.K; k0 += 16) {
        float4 av = make_float4(0.f, 0.f, 0.f, 0.f), bv = make_float4(0.f, 0.f, 0.f, 0.f);
        if (asrc >= 0) av = *(const float4*)(g.A + asrc + k0 + kq);
        if (bval) bv = *(const float4*)(g.B + (size_t)(k0 + bk) * g.ldb + g.n0 + bn);
        __syncthreads();
        As[(kq + 0) * 132 + arow] = av.x; As[(kq + 1) * 132 + arow] = av.y; As[(kq + 2) * 132 + arow] = av.z; As[(kq + 3) * 132 + arow] = av.w;
        *(float4*)&Bs[bk * 132 + bn] = bv;
        __syncthreads();
#pragma unroll
        for (int kk = 0; kk < 16; ++kk) {
            const float4 a = *(const float4*)&As[kk * 132 + ty * 4];
            const float4 b0 = *(const float4*)&Bs[kk * 132 + tx * 8];
            const float4 b1 = *(const float4*)&Bs[kk * 132 + tx * 8 + 4];
            const float aa[4] = {a.x, a.y, a.z, a.w};
            const float bb[8] = {b0.x, b0.y, b0.z, b0.w, b1.x, b1.y, b1.z, b1.w};
#pragma unroll
            for (int i = 0; i < 4; ++i)
#pragma unroll
                for (int j = 0; j < 8; ++j) acc[i][j] += aa[i] * bb[j];
        }
    }
#pragma unroll
    for (int i = 0; i < 4; ++i) {
        const int r = ty * 4 + i;
        if (r < g.mvalid) {
#pragma unroll
            for (int j = 0; j < 8; ++j) { const int n = g.n0 + tx * 8 + j; if (n < g.N) epi(r, n, acc[i][j]); }
        }
    }
}


typedef short bf16x8 __attribute__((ext_vector_type(8)));
typedef float f32x4 __attribute__((ext_vector_type(4)));
typedef unsigned short bf16_t;
__device__ __forceinline__ unsigned cvt_pk_bf16(float lo, float hi) { unsigned r; asm volatile("v_cvt_pk_bf16_f32 %0, %1, %2" : "=v"(r) : "v"(lo), "v"(hi)); return r; }
__device__ __forceinline__ bf16_t f2bf(float f) { return (bf16_t)(cvt_pk_bf16(f, 0.f) & 0xffffu); }
__device__ __forceinline__ float bf16_to_f32(bf16_t v) { return __uint_as_float(((unsigned)v) << 16); }
__device__ __forceinline__ uint4 pack8(const float4 a, const float4 b) { uint4 r; r.x = cvt_pk_bf16(a.x, a.y); r.y = cvt_pk_bf16(a.z, a.w); r.z = cvt_pk_bf16(b.x, b.y); r.w = cvt_pk_bf16(b.z, b.w); return r; }
__device__ __forceinline__ int lds_off(int r, int c) { return r * 128 + ((c ^ (r & 7)) << 4); }

template <class ALoad, class BLoad, class Epi>
__device__ __forceinline__ void gemm_tile_bf16(const int K, unsigned char* lds, ALoad aload, BLoad bload, Epi epi) {
    int tid_ = threadIdx.x; asm volatile("" : "+v"(tid_)); const int tid = tid_, lane = tid & 63, wid = tid >> 6, wm = wid >> 1, wn = wid & 1;
    f32x4 acc[4][4];
#pragma unroll
    for (int mi = 0; mi < 4; ++mi)
#pragma unroll
        for (int ni = 0; ni < 4; ++ni) acc[mi][ni] = (f32x4){0.f, 0.f, 0.f, 0.f};
    uint4 ra[4], rb[2];
    const int nk = K >> 6;
#pragma unroll
    for (int i = 0; i < 4; ++i) { const int q = tid + 512 * i; ra[i] = aload(i, q >> 3, (q & 7) * 8); }
#pragma unroll
    for (int i = 0; i < 2; ++i) { const int q = tid + 512 * i; rb[i] = bload(i, q >> 3, (q & 7) * 8); }
    __syncthreads();
#pragma unroll
    for (int i = 0; i < 4; ++i) { const int q = tid + 512 * i; *(uint4*)(lds + lds_off(q >> 3, q & 7)) = ra[i]; }
#pragma unroll
    for (int i = 0; i < 2; ++i) { const int q = tid + 512 * i; *(uint4*)(lds + 32768 + lds_off(q >> 3, q & 7)) = rb[i]; }
    __syncthreads();
    for (int kt = 0; kt < nk; ++kt) {
        if (kt + 1 < nk) {
#pragma unroll
            for (int i = 0; i < 4; ++i) { const int q = tid + 512 * i; ra[i] = aload(i, q >> 3, (kt + 1) * 64 + (q & 7) * 8); }
#pragma unroll
            for (int i = 0; i < 2; ++i) { const int q = tid + 512 * i; rb[i] = bload(i, q >> 3, (kt + 1) * 64 + (q & 7) * 8); }
        }
        const unsigned char* At = lds + (kt & 1) * 49152;
        const unsigned char* Bt = At + 32768;
#pragma unroll
        for (int ks = 0; ks < 2; ++ks) {
            bf16x8 af[4], bfr[4];
            const int c = ks * 4 + (lane >> 4);
#pragma unroll
            for (int mi = 0; mi < 4; ++mi) af[mi] = *(const bf16x8*)(At + lds_off(wm * 64 + mi * 16 + (lane & 15), c));
#pragma unroll
            for (int ni = 0; ni < 4; ++ni) bfr[ni] = *(const bf16x8*)(Bt + lds_off(wn * 64 + ni * 16 + (lane & 15), c));
#pragma unroll
            for (int mi = 0; mi < 4; ++mi)
#pragma unroll
                for (int ni = 0; ni < 4; ++ni) acc[mi][ni] = __builtin_amdgcn_mfma_f32_16x16x32_bf16(bfr[ni], af[mi], acc[mi][ni], 0, 0, 0);
        }
        if (kt + 1 < nk) {
            unsigned char* An = lds + ((kt + 1) & 1) * 49152;
#pragma unroll
            for (int i = 0; i < 4; ++i) { const int q = tid + 512 * i; *(uint4*)(An + lds_off(q >> 3, q & 7)) = ra[i]; }
#pragma unroll
            for (int i = 0; i < 2; ++i) { const int q = tid + 512 * i; *(uint4*)(An + 32768 + lds_off(q >> 3, q & 7)) = rb[i]; }
        }
        __syncthreads();
    }
    epi(acc, wm, wn, lane);
}

__device__ __forceinline__ void convert_tile(const float* src0, const float* src1, int mode, int K, int N, int ld, bf16_t* dst, int rt, int kt, float* smem) {
    int tid_ = threadIdx.x; asm volatile("" : "+v"(tid_)); const int tid = tid_;
    __syncthreads();
    { const int k = tid >> 3, R0 = rt * 64 + (tid & 7) * 8;
      const float* sp; int col;
      if (mode == 0) { sp = src0; col = R0; } else { sp = (R0 & 32) ? src1 : src0; col = (R0 >> 6) * 32 + (R0 & 31); }
      float4 a = make_float4(0.f, 0.f, 0.f, 0.f), b = a;
      const float* rp = sp + (size_t)(kt * 64 + k) * ld + col;
      if (col < N) a = *(const float4*)rp;
      if (col + 4 < N) b = *(const float4*)(rp + 4);
      float* d = smem + k * 65 + (tid & 7) * 8;
      d[0] = a.x; d[1] = a.y; d[2] = a.z; d[3] = a.w; d[4] = b.x; d[5] = b.y; d[6] = b.z; d[7] = b.w; }
    __syncthreads();
    { const int R = tid >> 3, kc = (tid & 7) * 8;
      float v[8];
#pragma unroll
      for (int j = 0; j < 8; ++j) v[j] = smem[(kc + j) * 65 + R];
      uint4 o; o.x = cvt_pk_bf16(v[0], v[1]); o.y = cvt_pk_bf16(v[2], v[3]); o.z = cvt_pk_bf16(v[4], v[5]); o.w = cvt_pk_bf16(v[6], v[7]);
      *(uint4*)(dst + (size_t)(rt * 64 + R) * K + kt * 64 + kc) = o; }
}

extern __shared__ __attribute__((aligned(16))) unsigned char g_smem[];
#define PHASE_FN __device__ __forceinline__
enum { PH_PROLOGUE = 0, PH_NORM_MIX, PH_GEMM_IN_EVEN, PH_EVEN_TOK, PH_GDN_CHUNK, PH_GDN_SCAN, PH_DSA_TOPK, PH_DSA_ATTN, PH_GDN_OUT,
       PH_GEMM_OUT, PH_NORM_FFN, PH_MOE1, PH_MOE2, PH_GEMM_IN_ODD, PH_GLA_TOK, PH_GLA_CHUNK, PH_GLA_SCAN, PH_GLA_OUT, PH_FINAL };

PHASE_FN void ph_prologue(const Params& p, float* smem) {
    smem = (float*)g_smem;
    int tid_ = threadIdx.x; asm volatile("" : "+v"(tid_)); const int tid = tid_, nthr = gridDim.x * NTHREADS, gid = blockIdx.x * NTHREADS + tid;
    { const float4* src = (const float4*)p.x; float4* dst = (float4*)p.X;
      for (size_t i = gid; i < (size_t)NT * ND / 4; i += nthr) dst[i] = src[i]; }
    for (int i = tid; i < 2 * ND; i += NTHREADS) smem[i] = siluf_(p.c[i]);
    __syncthreads();
    float* MOD = (float*)(p.ws + OFF_MOD);
    { float* red = smem + 2048;
      const int lane = tid & 63, wv = tid >> 6;
      for (int item = blockIdx.x; item < 4 * 96; item += gridDim.x) {
          const int l = item / 96, n = (item % 96) * 64 + lane;
          const float* w = p.ada_w + (size_t)l * ND * 6144 + n;
          float a0 = 0.f, a1 = 0.f;
#pragma unroll 8
          for (int k = wv * 128; k < wv * 128 + 128; ++k) { const float wv_ = w[(size_t)k * 6144]; a0 += smem[k] * wv_; a1 += smem[ND + k] * wv_; }
          __syncthreads();
          red[(wv * 64 + lane) * 2] = a0; red[(wv * 64 + lane) * 2 + 1] = a1;
          __syncthreads();
          if (tid < 128) { const int c = tid >> 1, bb = tid & 1; float a = 0.f; for (int w8 = 0; w8 < 8; ++w8) a += red[(w8 * 64 + c) * 2 + bb];
              MOD[(l * 2 + bb) * 6144 + (item % 96) * 64 + c] = a + p.ada_b[l * 6144 + (item % 96) * 64 + c]; }
      }
      __syncthreads(); }
    float* COSA = (float*)(p.ws + OFF_COSA); float* SINA = (float*)(p.ws + OFF_SINA);
    float* COSI = (float*)(p.ws + OFF_COSI); float* SINI = (float*)(p.ws + OFF_SINI);
    for (size_t i = gid; i < (size_t)NT * 64; i += nthr) {
        const int t = (int)(i >> 6), j = (int)(i & 63);
        double s, c; sincos_d((double)p.pos[t] * ipow_d(p.rA, j), s, c);
        COSA[i] = (float)c; SINA[i] = (float)s;
    }
    for (size_t i = gid; i < (size_t)NT * 32; i += nthr) {
        const int t = (int)(i >> 5), j = (int)(i & 31);
        double s, c; sincos_d((double)p.pos[t] * ipow_d(p.rI, j), s, c);
        COSI[i] = (float)c; SINI[i] = (float)s;
    }
}

PHASE_FN void ph_rows(const Params& p, int layer, int mode, float* smem) {
    smem = (float*)g_smem;
    int tid_ = threadIdx.x; asm volatile("" : "+v"(tid_)); const int tid = tid_, lane = tid & 63, wv = tid >> 6;
    int* pad = (int*)smem;
    const int moe_layer = (mode == 1) ? 3 : layer - 1;
    if (moe_layer >= 0) {
        if (tid == 0) { const int* cnt = (const int*)(p.ws + OFF_CNT) + moe_layer * 32 * CSTR; int a = 0; for (int e = 0; e < 32; ++e) { pad[e] = a; a += ((cnt[e * CSTR] + 127) / 128) * 128; } }
        __syncthreads();
    }
    const float* MOD = (const float*)(p.ws + OFF_MOD);
    float* H = (float*)(p.ws + OFF_H);
    const float* YB = (const float*)(p.ws + OFF_YB);
    const int* ASG = (const int*)(p.ws + OFF_ASG);
    const float* GATE = (const float*)(p.ws + OFF_GATE);
    for (int row = blockIdx.x * 8 + wv; row < NT; row += gridDim.x * 8) {
        const int b = row >> 13;
        float* xr = p.X + (size_t)row * ND;
        float xv[16];
#pragma unroll
        for (int j = 0; j < 4; ++j) { const float4 v = *(const float4*)(xr + j * 256 + lane * 4); xv[4 * j] = v.x; xv[4 * j + 1] = v.y; xv[4 * j + 2] = v.z; xv[4 * j + 3] = v.w; }
        if (moe_layer >= 0) {
            const float* gt = MOD + (size_t)(moe_layer * 2 + b) * 6144 + 5 * 1024;
            const int e0 = ASG[row * 4 + 0], r0 = ASG[row * 4 + 1], e1 = ASG[row * 4 + 2], r1 = ASG[row * 4 + 3];
            const float g0 = GATE[row * 2], g1 = GATE[row * 2 + 1];
            const float* y0 = YB + (size_t)(pad[e0] + r0) * ND;
            const float* y1 = YB + (size_t)(pad[e1] + r1) * ND;
#pragma unroll
            for (int j = 0; j < 4; ++j) {
                const int col = j * 256 + lane * 4;
                const float4 a = *(const float4*)(y0 + col), bq = *(const float4*)(y1 + col), g = *(const float4*)(gt + col);
                xv[4 * j] += g.x * (g0 * a.x + g1 * bq.x); xv[4 * j + 1] += g.y * (g0 * a.y + g1 * bq.y);
                xv[4 * j + 2] += g.z * (g0 * a.z + g1 * bq.z); xv[4 * j + 3] += g.w * (g0 * a.w + g1 * bq.w);
                if (mode == 0) *(float4*)(xr + col) = make_float4(xv[4 * j], xv[4 * j + 1], xv[4 * j + 2], xv[4 * j + 3]);
            }
        }
        float ss = 0.f;
#pragma unroll
        for (int j = 0; j < 16; ++j) ss += xv[j] * xv[j];
        ss = wave_sum(ss);
        const float rstd = rsqrtf(ss * (1.f / 1024.f) + EPS);
        if (mode == 0) {
            const float* nw = p.norm_mix + layer * 1024;
            const float* sh = MOD + (size_t)(layer * 2 + b) * 6144;
            const float* sc = sh + 1024;
#pragma unroll
            for (int j = 0; j < 4; ++j) {
                const int col = j * 256 + lane * 4;
                const float4 w = *(const float4*)(nw + col), s4 = *(const float4*)(sc + col), h4 = *(const float4*)(sh + col);
                float4 o;
                o.x = xv[4 * j] * rstd * w.x * (1.f + s4.x) + h4.x; o.y = xv[4 * j + 1] * rstd * w.y * (1.f + s4.y) + h4.y;
                o.z = xv[4 * j + 2] * rstd * w.z * (1.f + s4.z) + h4.z; o.w = xv[4 * j + 3] * rstd * w.w * (1.f + s4.w) + h4.w;
                *(float4*)(H + (size_t)row * ND + col) = o;
            }
        } else {
#pragma unroll
            for (int j = 0; j < 4; ++j) {
                const int col = j * 256 + lane * 4;
                const float4 w = *(const float4*)(p.final_norm + col);
                *(float4*)(xr + col) = make_float4(xv[4 * j] * rstd * w.x, xv[4 * j + 1] * rstd * w.y, xv[4 * j + 2] * rstd * w.z, xv[4 * j + 3] * rstd * w.w);
            }
        }
    }
}

PHASE_FN void ph_gemm_in(const Params& p, int layer, bool even, float* smem) {
    smem = (float*)g_smem;
    const int N = even ? 3916 : 3088, ntn = even ? 31 : 25;
    const bf16_t* Wt = even ? (const bf16_t*)(p.ws + OFF_WINE) + (size_t)(layer >> 1) * 3968 * 1024 : (const bf16_t*)(p.ws + OFF_WINO) + (size_t)(layer >> 1) * 3200 * 1024;
    const float* H = (const float*)(p.ws + OFF_H);
    float* P = (float*)(p.ws + OFF_P);
    for (int tile = blockIdx.x; tile < 64 * ntn; tile += gridDim.x) {
        const int mt = tile % 64, nt = tile / 64;
        const float* Ab = H + (size_t)mt * 256 * 1024;
        const bf16_t* Bb = Wt + (size_t)nt * 128 * 1024;
        float* Pt = P + (size_t)mt * 256 * LDP + nt * 128;
        const int nrem = N - nt * 128;
        gemm_tile_bf16(1024, (unsigned char*)smem,
            [=](int i, int r, int k) -> uint4 { const float* sp = Ab + (size_t)r * 1024 + k; return pack8(*(const float4*)sp, *(const float4*)(sp + 4)); },
            [=](int i, int r, int k) -> uint4 { return *(const uint4*)(Bb + (size_t)r * 1024 + k); },
            [=](const f32x4 (&acc)[4][4], int wm, int wn, int lane) {
#pragma unroll
                for (int mi = 0; mi < 4; ++mi)
#pragma unroll
                    for (int ni = 0; ni < 4; ++ni) {
                        const int m = wm * 64 + mi * 16 + (lane & 15), n = wn * 64 + ni * 16 + 4 * (lane >> 4);
                        if (n < nrem) *(f32x4*)(Pt + (size_t)m * LDP + n) = acc[mi][ni];
                    }
            });
    }
}

PHASE_FN void ph_even_tok(const Params& p, int layer, float* smem) {
    smem = (float*)g_smem;
    int tid_ = threadIdx.x; asm volatile("" : "+v"(tid_)); const int tid = tid_, lane = tid & 63, wv = tid >> 6, li = layer >> 1;
    const float* P = (const float*)(p.ws + OFF_P);
    const float* cw = p.conv_w + (size_t)li * 4 * 1536;
    float* QN = (float*)(p.ws + OFF_QN); float* KN = (float*)(p.ws + OFF_KN); float* VC = (float*)(p.ws + OFF_VC);
    float* BETA = (float*)(p.ws + OFF_BETA); float* G = (float*)(p.ws + OFF_G);
    bf16_t* QB = (bf16_t*)(p.ws + OFF_QBB); bf16_t* KB = (bf16_t*)(p.ws + OFF_KBB); bf16_t* QI = (bf16_t*)(p.ws + OFF_QIB); bf16_t* KI = (bf16_t*)(p.ws + OFF_KIB); float* WI = (float*)(p.ws + OFF_WI);
    const float* COSA = (const float*)(p.ws + OFF_COSA); const float* SINA = (const float*)(p.ws + OFF_SINA);
    const float* COSI = (const float*)(p.ws + OFF_COSI); const float* SINI = (const float*)(p.ws + OFF_SINI);
    for (int t = blockIdx.x * 8 + wv; t < NT; t += gridDim.x * 8) {
        const int s = t & 8191;
        const float* Pt = P + (size_t)t * LDP;
        auto convs = [&](int c) -> float {
            float a = 0.f;
#pragma unroll
            for (int j = 0; j < 4; ++j) { if (s - 3 + j >= 0) a += cw[j * 1536 + c] * P[(size_t)(t - 3 + j) * LDP + c]; }
            return siluf_(a);
        };
#pragma unroll 1
        for (int h = 0; h < 4; ++h) {
            const float q0 = convs(h * 128 + lane), q1 = convs(h * 128 + 64 + lane);
            float ss = wave_sum(q0 * q0 + q1 * q1);
            float r = rsqrtf(ss + EPS);
            QN[(size_t)t * 512 + h * 128 + lane] = q0 * r; QN[(size_t)t * 512 + h * 128 + 64 + lane] = q1 * r;
            const float k0 = convs(512 + h * 128 + lane), k1 = convs(512 + h * 128 + 64 + lane);
            ss = wave_sum(k0 * k0 + k1 * k1);
            r = rsqrtf(ss + EPS);
            KN[(size_t)t * 512 + h * 128 + lane] = k0 * r; KN[(size_t)t * 512 + h * 128 + 64 + lane] = k1 * r;
            VC[(size_t)t * 512 + h * 128 + lane] = convs(1024 + h * 128 + lane);
            VC[(size_t)t * 512 + h * 128 + 64 + lane] = convs(1024 + h * 128 + 64 + lane);
        }
        if (lane < 4) {
            const float ba = Pt[2048 + lane], aa = Pt[2052 + lane];
            BETA[t * 4 + lane] = sigmoidf_(ba);
            G[t * 4 + lane] = -expf(p.a_log[li * 4 + lane]) * softplusf_(aa + p.dt_bias[li * 4 + lane]);
            WI[t * 4 + lane] = Pt[3912 + lane] * 0.0625f;
        }
        { const float c = COSA[(size_t)t * 64 + lane], sn = SINA[(size_t)t * 64 + lane];
#pragma unroll
          for (int h = 0; h < 4; ++h) {
              float t1 = Pt[2056 + h * 128 + lane], t2 = Pt[2056 + h * 128 + 64 + lane];
              QB[(size_t)t * 512 + h * 128 + lane] = f2bf(t1 * c - t2 * sn); QB[(size_t)t * 512 + h * 128 + 64 + lane] = f2bf(t2 * c + t1 * sn);
              t1 = Pt[2568 + h * 128 + lane]; t2 = Pt[2568 + h * 128 + 64 + lane];
              KB[(size_t)t * 512 + h * 128 + lane] = f2bf(t1 * c - t2 * sn); KB[(size_t)t * 512 + h * 128 + 64 + lane] = f2bf(t2 * c + t1 * sn);
          } }
#pragma unroll
        for (int r = 0; r < 2; ++r) {
            const int item = lane + 64 * r, hh = item >> 5, ii = item & 31;
            const float c = COSI[(size_t)t * 32 + ii], sn = SINI[(size_t)t * 32 + ii];
            const float t1 = Pt[3592 + hh * 64 + ii], t2 = Pt[3592 + hh * 64 + 32 + ii];
            QI[(size_t)t * 256 + hh * 64 + ii] = f2bf(t1 * c - t2 * sn); QI[(size_t)t * 256 + hh * 64 + 32 + ii] = f2bf(t2 * c + t1 * sn);
        }
        if (lane < 32) {
            const float c = COSI[(size_t)t * 32 + lane], sn = SINI[(size_t)t * 32 + lane];
            const float t1 = Pt[3848 + lane], t2 = Pt[3848 + 32 + lane];
            KI[(size_t)t * 64 + lane] = f2bf(t1 * c - t2 * sn); KI[(size_t)t * 64 + 32 + lane] = f2bf(t2 * c + t1 * sn);
        }
    }
    { bf16_t* VT = (bf16_t*)(p.ws + OFF_VT);
      bf16_t* sv = (bf16_t*)g_smem;
      for (int item = blockIdx.x; item < 2 * 128 * 4; item += gridDim.x) {
          const int h = item & 3, tt = item >> 2, b = tt >> 7, s0 = (tt & 127) * 64;
          __syncthreads();
          for (int e = tid; e < 64 * 128; e += NTHREADS) { const int i = e >> 7, d = e & 127; sv[d * 72 + i] = f2bf(P[(size_t)(b * 8192 + s0 + i) * LDP + 3080 + h * 128 + d]); }
          __syncthreads();
          for (int e = tid; e < 128 * 8; e += NTHREADS) { const int d = e >> 3, c = e & 7;
              *(uint4*)(VT + ((size_t)((b * 4 + h) * 128 + d)) * 8192 + s0 + c * 8) = *(const uint4*)(sv + d * 72 + c * 8); }
      } }
}

PHASE_FN void ph_gdn_chunk(const Params& p, float* smem) {
    smem = (float*)g_smem;
    int tid_ = threadIdx.x; asm volatile("" : "+v"(tid_)); const int tid = tid_;
    float* sK = smem; float* sX = sK + 64 * 129; float* sL = sX + 64 * 129; float* sT = sL + 64 * 65; float* sG = sT + 64 * 65; float* sB = sG + 64; float* sE = sB + 64;
    const float* QN = (const float*)(p.ws + OFF_QN); const float* KN = (const float*)(p.ws + OFF_KN); const float* VC = (const float*)(p.ws + OFF_VC);
    const float* BETA = (const float*)(p.ws + OFF_BETA); const float* G = (const float*)(p.ws + OFF_G);
    float* W = (float*)(p.ws + OFF_W); float* U = (float*)(p.ws + OFF_U); float* QG = (float*)(p.ws + OFF_QG); float* KD = (float*)(p.ws + OFF_KD);
    float* AQK = (float*)(p.ws + OFF_AQK); float* GL = (float*)(p.ws + OFF_GL);
    for (int ci = blockIdx.x; ci < 1024; ci += gridDim.x) {
        const int b = ci >> 9, h = (ci >> 7) & 3, n = ci & 127;
        const int t0 = b * 8192 + n * 64;
        __syncthreads();
        for (int e = tid; e < 8192; e += NTHREADS) { const int i = e >> 7, d = e & 127; sK[i * 129 + d] = KN[(size_t)(t0 + i) * 512 + h * 128 + d]; sX[i * 129 + d] = QN[(size_t)(t0 + i) * 512 + h * 128 + d]; }
        if (tid < 64) { sG[tid] = G[(t0 + tid) * 4 + h]; sB[tid] = BETA[(t0 + tid) * 4 + h]; }
        __syncthreads();
        if (tid == 0) { float a = 0.f; for (int i = 0; i < 64; ++i) { a += sG[i]; sG[i] = a; } }
        __syncthreads();
        const float gl = sG[63];
        if (tid < 64) sE[tid] = sB[tid] * expf(sG[tid]);
        for (int e = tid; e < 4096; e += NTHREADS) {
            const int i = e >> 6, j = e & 63; float dkk = 0.f, dqk = 0.f;
            if (j <= i) { for (int d = 0; d < 128; ++d) { const float kj = sK[j * 129 + d]; dkk += sK[i * 129 + d] * kj; dqk += sX[i * 129 + d] * kj; } }
            const float dec = (j <= i) ? expf(sG[i] - sG[j]) : 0.f;
            sL[i * 65 + j] = (j < i) ? sB[i] * dkk * dec : 0.f;
            AQK[(size_t)ci * 4096 + e] = (j <= i) ? dqk * SCALE128 * dec : 0.f;
        }
        for (int e = tid; e < 8192; e += NTHREADS) {
            const int i = e >> 7, d = e & 127;
            QG[(size_t)ci * 8192 + e] = sX[i * 129 + d] * SCALE128 * expf(sG[i]);
            KD[(size_t)ci * 8192 + e] = sK[i * 129 + d] * expf(gl - sG[i]);
        }
        if (tid == 0) GL[ci] = gl;
        __syncthreads();
        if (tid < 64) { const int c = tid; for (int i = 0; i < 64; ++i) { float a = (i == c) ? 1.f : 0.f; for (int j = 0; j < i; ++j) a -= sL[i * 65 + j] * sT[j * 65 + c]; sT[i * 65 + c] = a; } }
        __syncthreads();
        for (int e = tid; e < 8192; e += NTHREADS) {
            const int i = e >> 7, d = e & 127; float a = 0.f;
            for (int j = 0; j < 64; ++j) a += sT[i * 65 + j] * (sK[j * 129 + d] * sE[j]);
            W[(size_t)ci * 8192 + e] = a;
        }
        __syncthreads();
        for (int e = tid; e < 8192; e += NTHREADS) { const int i = e >> 7, d = e & 127; sX[i * 129 + d] = VC[(size_t)(t0 + i) * 512 + h * 128 + d]; }
        __syncthreads();
        for (int e = tid; e < 8192; e += NTHREADS) {
            const int i = e >> 7, d = e & 127; float a = 0.f;
            for (int j = 0; j < 64; ++j) a += sT[i * 65 + j] * (sX[j * 129 + d] * sB[j]);
            U[(size_t)ci * 8192 + e] = a;
        }
    }
}

PHASE_FN void ph_gdn_scan(const Params& p, float* smem) {
    smem = (float*)g_smem;
    int tid_ = threadIdx.x; asm volatile("" : "+v"(tid_)); const int tid = tid_;
    float* sS = smem; float* sW = sS + 128 * 17; float* sV = sW + 64 * 129; float* sA = sV + 64 * 17;
    const float* W = (const float*)(p.ws + OFF_W); const float* U = (const float*)(p.ws + OFF_U); const float* QG = (const float*)(p.ws + OFF_QG); const float* KD = (const float*)(p.ws + OFF_KD);
    const float* AQK = (const float*)(p.ws + OFF_AQK); const float* GL = (const float*)(p.ws + OFF_GL);
    float* O = (float*)(p.ws + OFF_O);
    for (int it = blockIdx.x; it < 64; it += gridDim.x) {
        const int bh = it >> 3, sl = it & 7, b = bh >> 2, h = bh & 3;
        __syncthreads();
        for (int e = tid; e < 128 * 16; e += NTHREADS) sS[(e >> 4) * 17 + (e & 15)] = 0.f;
        for (int n = 0; n < 128; ++n) {
            const int ci = bh * 128 + n, t0 = b * 8192 + n * 64;
            __syncthreads();
            for (int e = tid; e < 8192; e += NTHREADS) sW[(e >> 7) * 129 + (e & 127)] = W[(size_t)ci * 8192 + e];
            for (int e = tid; e < 4096; e += NTHREADS) sA[(e >> 6) * 65 + (e & 63)] = AQK[(size_t)ci * 4096 + e];
            __syncthreads();
            for (int o = tid; o < 1024; o += NTHREADS) {
                const int i = o >> 4, c = o & 15; float a = U[(size_t)ci * 8192 + i * 128 + sl * 16 + c];
                for (int d = 0; d < 128; ++d) a -= sW[i * 129 + d] * sS[d * 17 + c];
                sV[i * 17 + c] = a;
            }
            __syncthreads();
            for (int e = tid; e < 8192; e += NTHREADS) sW[(e >> 7) * 129 + (e & 127)] = QG[(size_t)ci * 8192 + e];
            __syncthreads();
            for (int o = tid; o < 1024; o += NTHREADS) {
                const int i = o >> 4, c = o & 15; float a = 0.f;
                for (int d = 0; d < 128; ++d) a += sW[i * 129 + d] * sS[d * 17 + c];
                for (int j = 0; j < 64; ++j) a += sA[i * 65 + j] * sV[j * 17 + c];
                O[(size_t)(t0 + i) * 1024 + h * 128 + sl * 16 + c] = a;
            }
            __syncthreads();
            for (int e = tid; e < 8192; e += NTHREADS) sW[(e >> 7) * 129 + (e & 127)] = KD[(size_t)ci * 8192 + e];
            __syncthreads();
            const float eg = expf(GL[ci]);
            for (int o = tid; o < 2048; o += NTHREADS) {
                const int d = o >> 4, c = o & 15; float a = sS[d * 17 + c] * eg;
                for (int j = 0; j < 64; ++j) a += sW[j * 129 + d] * sV[j * 17 + c];
                sS[d * 17 + c] = a;
            }
        }
    }
}

__device__ __forceinline__ void block_sum4(int (&v)[4], int* buf) {
    const int lane = threadIdx.x & 63, wv = threadIdx.x >> 6;
#pragma unroll
    for (int q = 0; q < 4; ++q) v[q] = wave_sum_i(v[q]);
    if (lane == 0) {
#pragma unroll
        for (int q = 0; q < 4; ++q) buf[wv * 4 + q] = v[q];
    }
    __syncthreads();
#pragma unroll
    for (int q = 0; q < 4; ++q) { int a = 0; for (int w = 0; w < 8; ++w) a += buf[w * 4 + q]; v[q] = a; }
}

PHASE_FN void ph_dsa_topk(const Params& p, float* smem) {
    int tid_ = threadIdx.x; asm volatile("" : "+v"(tid_)); const int tid = tid_, lane = tid & 63, wv = __builtin_amdgcn_readfirstlane(tid >> 6), q4 = lane >> 4, c16 = lane & 15;
    int* sRed = (int*)g_smem;
    const bf16_t* QIb = (const bf16_t*)(p.ws + OFF_QIB); const bf16_t* KIb = (const bf16_t*)(p.ws + OFF_KIB); const float* WI = (const float*)(p.ws + OFF_WI);
    unsigned short* M16 = (unsigned short*)(p.ws + OFF_M16);
    for (int it = blockIdx.x; it < 4096; it += gridDim.x) {
        const int k = it >> 8, j = (it & 255) >> 1, b = it & 1;
        const int grp = (k & 1) ? 2047 - ((k >> 1) * 128 + j) : (k >> 1) * 128 + j;
        const int s0 = grp * 4, t0 = b * 8192 + s0;
        const int ntiles = (s0 >> 4) + 1;
        const int nreg = (ntiles > wv) ? ((ntiles - wv + 7) >> 3) : 0;
        const bf16x8 a0 = *(const bf16x8*)(QIb + (size_t)(t0 + (c16 >> 2)) * 256 + (c16 & 3) * 64 + 8 * q4);
        const bf16x8 a1 = *(const bf16x8*)(QIb + (size_t)(t0 + (c16 >> 2)) * 256 + (c16 & 3) * 64 + 32 + 8 * q4);
        const float4 wq = *(const float4*)(WI + (size_t)(t0 + q4) * 4);
        const int myq = s0 + q4;
        int c16s = c16; asm volatile("" : "+v"(c16s));
        unsigned keys[64];
#pragma unroll
        for (int i = 0; i < 64; ++i) keys[i] = 0u;
#pragma unroll
        for (int blk = 0; blk < 4; ++blk) if (nreg > blk * 16) {
#pragma unroll
            for (int ii = 0; ii < 16; ++ii) { const int i = blk * 16 + ii, tile = wv + 8 * i;
                if (tile < ntiles) {
                    const bf16_t* kp = KIb + (size_t)(b * 8192 + tile * 16 + c16s) * 64 + 8 * q4;
                    const bf16x8 k0 = *(const bf16x8*)kp, k1 = *(const bf16x8*)(kp + 32);
                    f32x4 acc = (f32x4){0.f, 0.f, 0.f, 0.f};
                    acc = __builtin_amdgcn_mfma_f32_16x16x32_bf16(a0, k0, acc, 0, 0, 0);
                    acc = __builtin_amdgcn_mfma_f32_16x16x32_bf16(a1, k1, acc, 0, 0, 0);
                    float sc = 0.f;
                    sc += wq.x * fmaxf(acc[0], 0.f); sc += wq.y * fmaxf(acc[1], 0.f); sc += wq.z * fmaxf(acc[2], 0.f); sc += wq.w * fmaxf(acc[3], 0.f);
                    keys[i] = (tile * 16 + c16s <= myq) ? ordkey(sc) : 0u;
                }
                if ((ii & 3) == 3) asm volatile("" ::: "memory"); }
        }
        const int keff = (myq + 1 < 256) ? (myq + 1) : 256;
        int par = 0;
        auto qsum = [&](int c) -> int {
            c += __shfl_xor(c, 1); c += __shfl_xor(c, 2); c += __shfl_xor(c, 4); c += __shfl_xor(c, 8);
            par ^= 1;
            if (c16 == 0) sRed[par * 32 + wv * 4 + q4] = c;
            __syncthreads();
            int a = 0;
#pragma unroll
            for (int w = 0; w < 8; ++w) a += sRed[par * 32 + w * 4 + q4];
            return a;
        };
        unsigned U = 0u;
        for (int bit = 31; bit >= 0; --bit) {
            const unsigned cand = U | (1u << bit);
            int c = 0;
#pragma unroll
            for (int blk = 0; blk < 4; ++blk) if (nreg > blk * 16) {
#pragma unroll
                for (int ii = 0; ii < 16; ++ii) c += (keys[blk * 16 + ii] >= cand) ? 1 : 0;
            }
            if (qsum(c) >= keff) U = cand;
        }
        int cg = 0, ce = 0;
#pragma unroll
        for (int i = 0; i < 64; ++i) { cg += (keys[i] > U) ? 1 : 0; ce += (keys[i] == U) ? 1 : 0; }
        cg = qsum(cg); ce = qsum(ce);
        const int need = keff - cg;
        int J = 8191;
        par ^= 1;
        if (c16 == 0) sRed[par * 32 + wv * 4 + q4] = (ce > need) ? 1 : 0;
        __syncthreads();
        int anyov = 0;
#pragma unroll
        for (int w = 0; w < 32; ++w) anyov |= sRed[par * 32 + w];
        if (anyov) {
            J = 0;
            int c16j = c16; asm volatile("" : "+v"(c16j));
            for (int bit = 12; bit >= 0; --bit) {
                const int cj = J | (1 << bit);
                int c = 0;
#pragma unroll
                for (int i = 0; i < 64; ++i) c += (keys[i] == U && ((wv + 8 * i) * 16 + c16j) < cj) ? 1 : 0;
                if (qsum(c) <= need - 1) J = cj;
            }
        }
        int c16e = c16; asm volatile("" : "+v"(c16e));
#pragma unroll
        for (int i = 0; i < 64; ++i) {
            const int tile = wv + 8 * i;
            const bool sel = keys[i] > U || (keys[i] == U && (tile * 16 + c16e) <= J);
            const unsigned long long bal = __ballot(sel);
            if (c16 == 0) M16[(size_t)(t0 + q4) * 512 + tile] = (unsigned short)((bal >> (16 * q4)) & 0xffffull);
        }
    }
}

PHASE_FN void ph_dsa_attn(const Params& p, float* smem) {
    int tid_ = threadIdx.x; asm volatile("" : "+v"(tid_)); const int tid = tid_, lane = tid & 63, wv = tid >> 6, q4 = lane >> 4, c16 = lane & 15;
    unsigned char* lds = g_smem;
    const bf16_t* QBb = (const bf16_t*)(p.ws + OFF_QBB); const bf16_t* KBb = (const bf16_t*)(p.ws + OFF_KBB); const bf16_t* VT = (const bf16_t*)(p.ws + OFF_VT);
    const unsigned short* M16 = (const unsigned short*)(p.ws + OFF_M16);
    float* O = (float*)(p.ws + OFF_O);
    const float SC = SCALE128 * 1.4426950408889634f;
    for (int it = blockIdx.x; it < 256; it += gridDim.x) {
        const int bh = it & 7, jp = it >> 3, b = bh >> 2, h = bh & 3;
        for (int half = 0; half < 2; ++half) {
            const int jq = half ? jp : 63 - jp;
            const int qs = jq * 128, nkt = 2 * jq + 2;
            const int tq = b * 8192 + qs + wv * 16 + c16;
            bf16x8 qf[4];
#pragma unroll
            for (int a = 0; a < 4; ++a) qf[a] = *(const bf16x8*)(QBb + (size_t)tq * 512 + h * 128 + 8 * q4 + 32 * a);
            float m = -1e30f, lsum = 0.f;
            f32x4 oacc[8];
#pragma unroll
            for (int t = 0; t < 8; ++t) oacc[t] = (f32x4){0.f, 0.f, 0.f, 0.f};
            uint4 rk0, rk1, rv0, rv1;
            const int q0 = tid, q1 = tid + 512;
            const bf16_t* kg0 = KBb + (size_t)(b * 8192 + (q0 >> 4)) * 512 + h * 128 + (q0 & 15) * 8;
            const bf16_t* kg1 = KBb + (size_t)(b * 8192 + (q1 >> 4)) * 512 + h * 128 + (q1 & 15) * 8;
            const bf16_t* vg0 = VT + ((size_t)((b * 4 + h) * 128 + (q0 >> 3))) * 8192 + (q0 & 7) * 8;
            const bf16_t* vg1 = VT + ((size_t)((b * 4 + h) * 128 + (q1 >> 3))) * 8192 + (q1 & 7) * 8;
            const int lk0 = (q0 >> 4) * 256 + ((((q0 & 15)) ^ ((q0 >> 4) & 15)) << 4), lk1 = (q1 >> 4) * 256 + ((((q1 & 15)) ^ ((q1 >> 4) & 15)) << 4);
            const int lv0 = 16384 + (q0 >> 3) * 128 + ((((q0 & 7)) ^ ((q0 >> 3) & 7)) << 4), lv1 = 16384 + (q1 >> 3) * 128 + ((((q1 & 7)) ^ ((q1 >> 3) & 7)) << 4);
#define ATT_GLOAD(kt_) do { rk0 = *(const uint4*)(kg0 + (size_t)(kt_) * 64 * 512); rk1 = *(const uint4*)(kg1 + (size_t)(kt_) * 64 * 512); \
                            rv0 = *(const uint4*)(vg0 + (kt_) * 64); rv1 = *(const uint4*)(vg1 + (kt_) * 64); } while (0)
#define ATT_LSTORE(st_) do { unsigned char* base_ = lds + (st_) * 32768; *(uint4*)(base_ + lk0) = rk0; *(uint4*)(base_ + lk1) = rk1; *(uint4*)(base_ + lv0) = rv0; *(uint4*)(base_ + lv1) = rv1; } while (0)
            __syncthreads();
            ATT_GLOAD(0); ATT_LSTORE(0);
            __syncthreads();
            for (int kt = 0; kt < nkt; ++kt) {
                if (kt + 1 < nkt) ATT_GLOAD(kt + 1);
                const unsigned long long mbits = *(const unsigned long long*)(M16 + (size_t)tq * 512 + 4 * kt);
                const unsigned char* Kt = lds + (kt & 1) * 32768;
                const unsigned char* Vt = Kt + 16384;
                f32x4 sacc[4];
#pragma unroll
                for (int ti = 0; ti < 4; ++ti) { sacc[ti] = (f32x4){0.f, 0.f, 0.f, 0.f};
                    const int row = 16 * ti + c16;
#pragma unroll
                    for (int a = 0; a < 4; ++a) { const bf16x8 kf = *(const bf16x8*)(Kt + row * 256 + ((((q4 + 4 * a)) ^ (row & 15)) << 4));
                        sacc[ti] = __builtin_amdgcn_mfma_f32_16x16x32_bf16(kf, qf[a], sacc[ti], 0, 0, 0); } }
                float mx = m;
#pragma unroll
                for (int ti = 0; ti < 4; ++ti)
#pragma unroll
                    for (int r = 0; r < 4; ++r) { const bool valid = (mbits >> (16 * ti + 4 * q4 + r)) & 1ull; const float v = sacc[ti][r] * SC; sacc[ti][r] = v; mx = fmaxf(mx, valid ? v : -1e30f); }
                mx = fmaxf(mx, __shfl_xor(mx, 16)); mx = fmaxf(mx, __shfl_xor(mx, 32));
                const float alpha = __builtin_amdgcn_exp2f(m - mx); m = mx;
                float ps = 0.f;
#pragma unroll
                for (int ti = 0; ti < 4; ++ti)
#pragma unroll
                    for (int r = 0; r < 4; ++r) { const bool valid = (mbits >> (16 * ti + 4 * q4 + r)) & 1ull; const float pv = valid ? __builtin_amdgcn_exp2f(sacc[ti][r] - mx) : 0.f; sacc[ti][r] = pv; ps += pv; }
                lsum = lsum * alpha + ps;
#pragma unroll
                for (int t = 0; t < 8; ++t) oacc[t] = oacc[t] * alpha;
                bf16x8 pb[2];
#pragma unroll
                for (int a = 0; a < 2; ++a) {
                    union { uint4 u; bf16x8 v; } cv;
                    cv.u.x = cvt_pk_bf16(sacc[2 * a][0], sacc[2 * a][1]); cv.u.y = cvt_pk_bf16(sacc[2 * a][2], sacc[2 * a][3]);
                    cv.u.z = cvt_pk_bf16(sacc[2 * a + 1][0], sacc[2 * a + 1][1]); cv.u.w = cvt_pk_bf16(sacc[2 * a + 1][2], sacc[2 * a + 1][3]);
                    pb[a] = cv.v; }
#pragma unroll
                for (int t = 0; t < 8; ++t) { const int row = 16 * t + c16;
#pragma unroll
                    for (int a = 0; a < 2; ++a) {
                        union { uint2 h2[2]; bf16x8 v; } vf;
                        vf.h2[0] = *(const uint2*)(Vt + row * 128 + ((((4 * a + (q4 >> 1))) ^ (row & 7)) << 4) + 8 * (q4 & 1));
                        vf.h2[1] = *(const uint2*)(Vt + row * 128 + ((((4 * a + 2 + (q4 >> 1))) ^ (row & 7)) << 4) + 8 * (q4 & 1));
                        oacc[t] = __builtin_amdgcn_mfma_f32_16x16x32_bf16(vf.v, pb[a], oacc[t], 0, 0, 0); } }
                if (kt + 1 < nkt) ATT_LSTORE((kt + 1) & 1);
                __syncthreads();
            }
            lsum += __shfl_xor(lsum, 16); lsum += __shfl_xor(lsum, 32);
            const float inv = 1.f / lsum;
#pragma unroll
            for (int t = 0; t < 8; ++t) *(f32x4*)(O + (size_t)tq * 1024 + 512 + h * 128 + 16 * t + 4 * q4) = oacc[t] * inv;
        }
    }
}

PHASE_FN void ph_gdn_out(const Params& p, int layer) {
    int tid_ = threadIdx.x; asm volatile("" : "+v"(tid_)); const int tid = tid_, lane = tid & 63, wv = tid >> 6;
    float* O = (float*)(p.ws + OFF_O); const float* P = (const float*)(p.ws + OFF_P);
    const float* onw = p.gdn_out_norm + (layer >> 1) * 128;
    for (int t = blockIdx.x * 8 + wv; t < NT; t += gridDim.x * 8) {
#pragma unroll
        for (int h = 0; h < 4; ++h) {
            float* op = O + (size_t)t * 1024 + h * 128;
            const float o0 = op[lane], o1 = op[64 + lane];
            const float ss = wave_sum(o0 * o0 + o1 * o1);
            const float r = rsqrtf(ss * (1.f / 128.f) + EPS);
            const float z0 = P[(size_t)t * LDP + 1536 + h * 128 + lane], z1 = P[(size_t)t * LDP + 1536 + h * 128 + 64 + lane];
            op[lane] = o0 * r * onw[lane] * siluf_(z0); op[64 + lane] = o1 * r * onw[64 + lane] * siluf_(z1);
        }
    }
}

PHASE_FN void ph_gemm_out(const Params& p, int layer, float* smem) {
    smem = (float*)g_smem;
    const bf16_t* Wt = (const bf16_t*)(p.ws + OFF_WOUT) + (size_t)layer * 1024 * 1024;
    const float* MOD = (const float*)(p.ws + OFF_MOD);
    const float* O = (const float*)(p.ws + OFF_O);
    for (int tile = blockIdx.x; tile < 64 * 8; tile += gridDim.x) {
        const int mt = tile % 64, nt = tile / 64;
        const float* Ab = O + (size_t)mt * 256 * 1024;
        const bf16_t* Bb = Wt + (size_t)nt * 128 * 1024;
        const int b = (mt * 256) >> 13;
        const float* gt = MOD + (size_t)(layer * 2 + b) * 6144 + 2048 + nt * 128;
        float* Xt = p.X + (size_t)mt * 256 * ND + nt * 128;
        gemm_tile_bf16(1024, (unsigned char*)smem,
            [=](int i, int r, int k) -> uint4 { const float* sp = Ab + (size_t)r * 1024 + k; return pack8(*(const float4*)sp, *(const float4*)(sp + 4)); },
            [=](int i, int r, int k) -> uint4 { return *(const uint4*)(Bb + (size_t)r * 1024 + k); },
            [=](const f32x4 (&acc)[4][4], int wm, int wn, int lane) {
#pragma unroll
                for (int mi = 0; mi < 4; ++mi)
#pragma unroll
                    for (int ni = 0; ni < 4; ++ni) {
                        const int m = wm * 64 + mi * 16 + (lane & 15), n = wn * 64 + ni * 16 + 4 * (lane >> 4);
                        const f32x4 g = *(const f32x4*)(gt + n);
                        f32x4* xp = (f32x4*)(Xt + (size_t)m * ND + n);
                        *xp = *xp + g * acc[mi][ni];
                    }
            });
    }
}

PHASE_FN void ph_norm_ffn(const Params& p, int layer) {
    int tid_ = threadIdx.x; asm volatile("" : "+v"(tid_)); const int tid = tid_, lane = tid & 63, wv = tid >> 6;
    const float* MOD = (const float*)(p.ws + OFF_MOD);
    float* H = (float*)(p.ws + OFF_H);
    int* CNT = (int*)(p.ws + OFF_CNT) + layer * 32 * CSTR;
    int* sCnt = (int*)g_smem; int* sBase = sCnt + 32; int* sE = sBase + 32; int* sR = sE + 256;
    const int nrb = (NT + (int)gridDim.x - 1) / (int)gridDim.x, row_lo = blockIdx.x * nrb, row_hi = (row_lo + nrb < NT) ? row_lo + nrb : NT;
    __syncthreads();
    if (tid < 32) sCnt[tid] = 0;
    __syncthreads();
    int* ASG = (int*)(p.ws + OFF_ASG); float* GATE = (float*)(p.ws + OFF_GATE); int* LIST = (int*)(p.ws + OFF_LIST);
    const float* nw = p.norm_ffn + layer * 1024;
    const float* wg = p.rg_w + (size_t)layer * 1024 * 4;
    for (int row = row_lo + wv; row < row_hi; row += 8) {
        const int b = row >> 13;
        const float* xr = p.X + (size_t)row * ND;
        const float* sh = MOD + (size_t)(layer * 2 + b) * 6144 + 3072;
        const float* sc = sh + 1024;
        float hv[16]; float ss = 0.f;
#pragma unroll
        for (int j = 0; j < 4; ++j) { const float4 v = *(const float4*)(xr + j * 256 + lane * 4); hv[4 * j] = v.x; hv[4 * j + 1] = v.y; hv[4 * j + 2] = v.z; hv[4 * j + 3] = v.w; }
#pragma unroll
        for (int j = 0; j < 16; ++j) ss += hv[j] * hv[j];
        ss = wave_sum(ss);
        const float rstd = rsqrtf(ss * (1.f / 1024.f) + EPS);
#pragma unroll
        for (int j = 0; j < 4; ++j) {
            const int col = j * 256 + lane * 4;
            const float4 w = *(const float4*)(nw + col), s4 = *(const float4*)(sc + col), h4 = *(const float4*)(sh + col);
            hv[4 * j] = hv[4 * j] * rstd * w.x * (1.f + s4.x) + h4.x; hv[4 * j + 1] = hv[4 * j + 1] * rstd * w.y * (1.f + s4.y) + h4.y;
            hv[4 * j + 2] = hv[4 * j + 2] * rstd * w.z * (1.f + s4.z) + h4.z; hv[4 * j + 3] = hv[4 * j + 3] * rstd * w.w * (1.f + s4.w) + h4.w;
            *(float4*)(H + (size_t)row * ND + col) = make_float4(hv[4 * j], hv[4 * j + 1], hv[4 * j + 2], hv[4 * j + 3]);
        }
        float gl[4] = {0.f, 0.f, 0.f, 0.f};
#pragma unroll
        for (int j = 0; j < 4; ++j)
#pragma unroll
            for (int e = 0; e < 4; ++e) { const int col = j * 256 + lane * 4 + e; const float4 w = *(const float4*)(wg + (size_t)col * 4); const float hh = hv[4 * j + e];
                gl[0] += hh * w.x; gl[1] += hh * w.y; gl[2] += hh * w.z; gl[3] += hh * w.w; }
#pragma unroll
        for (int g = 0; g < 4; ++g) gl[g] = wave_sum(gl[g]) + p.rg_b[layer * 4 + g];
        int gs = 0; float gm = gl[0];
#pragma unroll
        for (int g = 1; g < 4; ++g) if (gl[g] > gm) { gm = gl[g]; gs = g; }
        float gsum = 0.f;
#pragma unroll
        for (int g = 0; g < 4; ++g) gsum += expf(gl[g] - gm);
        const float ggate = 1.f / gsum;
        const float* we = p.re_w + ((size_t)(layer * 4 + gs) * 1024) * 8;
        float el[8] = {0.f, 0.f, 0.f, 0.f, 0.f, 0.f, 0.f, 0.f};
#pragma unroll
        for (int j = 0; j < 4; ++j)
#pragma unroll
            for (int e = 0; e < 4; ++e) { const int col = j * 256 + lane * 4 + e; const float4 w0 = *(const float4*)(we + (size_t)col * 8), w1 = *(const float4*)(we + (size_t)col * 8 + 4); const float hh = hv[4 * j + e];
                el[0] += hh * w0.x; el[1] += hh * w0.y; el[2] += hh * w0.z; el[3] += hh * w0.w; el[4] += hh * w1.x; el[5] += hh * w1.y; el[6] += hh * w1.z; el[7] += hh * w1.w; }
#pragma unroll
        for (int e = 0; e < 8; ++e) el[e] = wave_sum(el[e]) + p.re_b[(layer * 4 + gs) * 8 + e];
        int i1 = 0; float l1 = el[0];
#pragma unroll
        for (int e = 1; e < 8; ++e) if (el[e] > l1) { l1 = el[e]; i1 = e; }
        int i2 = -1; float l2 = -INFINITY;
#pragma unroll
        for (int e = 0; e < 8; ++e) if (e != i1 && el[e] > l2) { l2 = el[e]; i2 = e; }
        const float ex = expf(l2 - l1);
        const float p1 = 1.f / (1.f + ex), p2 = ex / (1.f + ex);
        if (lane == 0) {
            const int e1 = gs * 8 + i1, e2 = gs * 8 + i2, lr = row - row_lo;
            sE[lr * 2] = e1; sE[lr * 2 + 1] = e2;
            sR[lr * 2] = atomicAdd(&sCnt[e1], 1); sR[lr * 2 + 1] = atomicAdd(&sCnt[e2], 1);
            GATE[row * 2] = ggate * p1; GATE[row * 2 + 1] = ggate * p2;
        }
    }
    __syncthreads();
    if (tid < 32) sBase[tid] = (sCnt[tid] > 0) ? atomicAdd(&CNT[tid * CSTR], sCnt[tid]) : 0;
    __syncthreads();
    for (int a = tid; a < (row_hi - row_lo) * 2; a += NTHREADS) {
        const int row = row_lo + (a >> 1), e = sE[a], r = sBase[e] + sR[a];
        LIST[(size_t)e * LISTCAP + r] = row;
        ASG[row * 4 + (a & 1) * 2] = e; ASG[row * 4 + (a & 1) * 2 + 1] = r;
    }
}

PHASE_FN void ph_moe(const Params& p, int layer, int which, float* smem) {
    smem = (float*)g_smem;
    int tid_ = threadIdx.x; asm volatile("" : "+v"(tid_)); const int tid = tid_;
    int* sPad = (int*)(g_smem + 98304); int* sTs = sPad + 33;
    const int* CNT = (const int*)(p.ws + OFF_CNT) + layer * 32 * CSTR;
    __syncthreads();
    if (tid == 0) { int a = 0, ts = 0; for (int e = 0; e < 32; ++e) { sPad[e] = a; sTs[e] = ts; a += ((CNT[e * CSTR] + 127) / 128) * 128; ts += (CNT[e * CSTR] + 255) / 256; } sTs[32] = ts; sPad[32] = a; }
    __syncthreads();
    const int total = sTs[32] * 8;
    float* HID = (float*)(p.ws + OFF_HID); float* YB = (float*)(p.ws + OFF_YB);
    const float* H = (const float*)(p.ws + OFF_H);
    const int* LIST = (const int*)(p.ws + OFF_LIST);
    for (int tile = blockIdx.x; tile < total; tile += gridDim.x) {
        const int mt = tile >> 3, nt = tile & 7;
        int e = 0;
        for (int q = 1; q < 32; ++q) if (sTs[q] <= mt) e = q;
        const int mi0 = mt - sTs[e];
        const int cnt = CNT[e * CSTR];
        const int mvalid = (cnt - mi0 * 256 < 256) ? (cnt - mi0 * 256) : 256;
        const int rowbase = sPad[e] + mi0 * 256;
        if (which == 0) {
            long ro[4];
#pragma unroll
            for (int i = 0; i < 4; ++i) { const int r = (tid + 512 * i) >> 3; ro[i] = (r < mvalid) ? (long)LIST[(size_t)e * LISTCAP + mi0 * 256 + r] * 1024 : -1; }
            const long ro0 = ro[0], ro1 = ro[1], ro2 = ro[2], ro3 = ro[3];
            const bf16_t* Bb = (const bf16_t*)(p.ws + OFF_W13) + (size_t)e * 1024 * 1024 + (size_t)nt * 128 * 1024;
            float* Ht = HID + (size_t)rowbase * 512 + nt * 64;
            gemm_tile_bf16(1024, (unsigned char*)smem,
                [=](int i, int r, int k) -> uint4 { const long o = (i == 0) ? ro0 : (i == 1) ? ro1 : (i == 2) ? ro2 : ro3; if (o < 0) return make_uint4(0u, 0u, 0u, 0u);
                    const float* sp = H + o + k; return pack8(*(const float4*)sp, *(const float4*)(sp + 4)); },
                [=](int i, int r, int k) -> uint4 { return *(const uint4*)(Bb + (size_t)r * 1024 + k); },
                [=](const f32x4 (&acc)[4][4], int wm, int wn, int lane) {
#pragma unroll
                    for (int mi = 0; mi < 4; ++mi)
#pragma unroll
                        for (int ni = 0; ni < 2; ++ni) {
                            const int m = wm * 64 + mi * 16 + (lane & 15), n = wn * 32 + ni * 16 + 4 * (lane >> 4);
                            const f32x4 a1 = acc[mi][ni], a3 = acc[mi][ni + 2];
                            f32x4 hv; hv[0] = siluf_(a1[0]) * a3[0]; hv[1] = siluf_(a1[1]) * a3[1]; hv[2] = siluf_(a1[2]) * a3[2]; hv[3] = siluf_(a1[3]) * a3[3];
                            if (m < mvalid) *(f32x4*)(Ht + (size_t)m * 512 + n) = hv;
                        }
                });
        } else {
            const float* Ab = HID + (size_t)rowbase * 512;
            const bf16_t* Bb = (const bf16_t*)(p.ws + OFF_W2T) + (size_t)e * 1024 * 512 + (size_t)nt * 128 * 512;
            float* Yt = YB + (size_t)rowbase * 1024 + nt * 128;
            gemm_tile_bf16(512, (unsigned char*)smem,
                [=](int i, int r, int k) -> uint4 { if (r >= mvalid) return make_uint4(0u, 0u, 0u, 0u); const float* sp = Ab + (size_t)r * 512 + k; return pack8(*(const float4*)sp, *(const float4*)(sp + 4)); },
                [=](int i, int r, int k) -> uint4 { return *(const uint4*)(Bb + (size_t)r * 512 + k); },
                [=](const f32x4 (&acc)[4][4], int wm, int wn, int lane) {
#pragma unroll
                    for (int mi = 0; mi < 4; ++mi)
#pragma unroll
                        for (int ni = 0; ni < 4; ++ni) {
                            const int m = wm * 64 + mi * 16 + (lane & 15), n = wn * 64 + ni * 16 + 4 * (lane >> 4);
                            if (m < mvalid) *(f32x4*)(Yt + (size_t)m * 1024 + n) = acc[mi][ni];
                        }
                });
        }
    }
}

PHASE_FN void ph_conv_dense(const Params& p, float* smem) {
    smem = (float*)g_smem;
    for (int t = blockIdx.x; t < 1984 + 1600 + 1024; t += gridDim.x) {
        if (t < 1984) { const int l = t / 992, u = t % 992;
            convert_tile(p.even_w_in + (size_t)l * 1024 * 3916, nullptr, 0, 1024, 3916, 3916, (bf16_t*)(p.ws + OFF_WINE) + (size_t)l * 3968 * 1024, u >> 4, u & 15, smem); }
        else if (t < 3584) { const int v = t - 1984, l = v / 800, u = v % 800;
            convert_tile(p.gla_w_in + (size_t)l * 1024 * 3088, nullptr, 0, 1024, 3088, 3088, (bf16_t*)(p.ws + OFF_WINO) + (size_t)l * 3200 * 1024, u >> 4, u & 15, smem); }
        else { const int v = t - 3584, l = v >> 8, u = v & 255;
            convert_tile(((l & 1) ? p.gla_w_out : p.even_w_out) + (size_t)(l >> 1) * 1024 * 1024, nullptr, 0, 1024, 1024, 1024, (bf16_t*)(p.ws + OFF_WOUT) + (size_t)l * 1024 * 1024, u >> 4, u & 15, smem); }
    }
}

PHASE_FN void ph_conv_exp(const Params& p, int layer, float* smem) {
    smem = (float*)g_smem;
    for (int t = blockIdx.x; t < 8192 + 4096; t += gridDim.x) {
        if (t < 8192) { const int e = t >> 8, u = t & 255;
            convert_tile(p.w1 + (size_t)(layer * 32 + e) * 1024 * 512, p.w3 + (size_t)(layer * 32 + e) * 1024 * 512, 1, 1024, 512, 512, (bf16_t*)(p.ws + OFF_W13) + (size_t)e * 1024 * 1024, u >> 4, u & 15, smem); }
        else { const int v = t - 8192, e = v >> 7, u = v & 127;
            convert_tile(p.w2 + (size_t)(layer * 32 + e) * 512 * 1024, nullptr, 0, 512, 1024, 1024, (bf16_t*)(p.ws + OFF_W2T) + (size_t)e * 1024 * 512, u >> 3, u & 7, smem); }
    }
}

PHASE_FN void ph_gla_tok(const Params& p, int layer) {
    int tid_ = threadIdx.x; asm volatile("" : "+v"(tid_)); const int tid = tid_, lane = tid & 63, wv = tid >> 6, li = layer >> 1;
    const float* P = (const float*)(p.ws + OFF_P);
    float* LA = (float*)(p.ws + OFF_LA);
    const float* w2 = p.gla_w_gate2 + (size_t)li * 16 * 512; const float* b2 = p.gla_b_gate2 + li * 512;
    for (int t = blockIdx.x * 8 + wv; t < NT; t += gridDim.x * 8) {
        float glr[16];
#pragma unroll
        for (int r = 0; r < 16; ++r) glr[r] = P[(size_t)t * LDP + 3072 + r];
#pragma unroll 1
        for (int i = 0; i < 8; ++i) {
            const int c = lane + 64 * i; float z = b2[c];
#pragma unroll
            for (int r = 0; r < 16; ++r) z += glr[r] * w2[r * 512 + c];
            LA[(size_t)t * 512 + c] = -softplusf_(-z) * (1.f / 16.f);
        }
    }
}

PHASE_FN void ph_gla_chunk(const Params& p, float* smem) {
    smem = (float*)g_smem;
    int tid_ = threadIdx.x; asm volatile("" : "+v"(tid_)); const int tid = tid_;
    float* sQ = smem; float* sK = sQ + 64 * 129; float* sBc = sK + 64 * 129;
    const float* P = (const float*)(p.ws + OFF_P); const float* LA = (const float*)(p.ws + OFF_LA);
    float* ATT = (float*)(p.ws + OFF_ATT); float* QE = (float*)(p.ws + OFF_QE); float* KD = (float*)(p.ws + OFF_GKD); float* EBL = (float*)(p.ws + OFF_EBL);
    for (int ci = blockIdx.x; ci < 1024; ci += gridDim.x) {
        const int b = ci >> 9, h = (ci >> 7) & 3, n = ci & 127;
        const int t0 = b * 8192 + n * 64;
        __syncthreads();
        for (int e = tid; e < 8192; e += NTHREADS) {
            const int i = e >> 7, d = e & 127;
            sQ[i * 129 + d] = P[(size_t)(t0 + i) * LDP + h * 128 + d]; sK[i * 129 + d] = P[(size_t)(t0 + i) * LDP + 512 + h * 128 + d];
            sBc[i * 129 + d] = LA[(size_t)(t0 + i) * 512 + h * 128 + d];
        }
        __syncthreads();
        if (tid < 128) { float a = 0.f; for (int i = 0; i < 64; ++i) { a += sBc[i * 129 + tid]; sBc[i * 129 + tid] = a; } }
        __syncthreads();
        for (int e = tid; e < 4096; e += NTHREADS) {
            const int i = e >> 6, j = e & 63; float a = 0.f;
            if (j <= i) { for (int d = 0; d < 128; ++d) a += sQ[i * 129 + d] * sK[j * 129 + d] * expf(sBc[i * 129 + d] - sBc[j * 129 + d]); }
            ATT[(size_t)ci * 4096 + e] = a * SCALE128;
        }
        for (int e = tid; e < 8192; e += NTHREADS) {
            const int i = e >> 7, d = e & 127;
            QE[(size_t)ci * 8192 + e] = sQ[i * 129 + d] * SCALE128 * expf(sBc[i * 129 + d]);
            KD[(size_t)ci * 8192 + e] = sK[i * 129 + d] * expf(sBc[63 * 129 + d] - sBc[i * 129 + d]);
        }
        if (tid < 128) EBL[ci * 128 + tid] = expf(sBc[63 * 129 + tid]);
    }
}

PHASE_FN void ph_gla_scan(const Params& p, float* smem) {
    smem = (float*)g_smem;
    int tid_ = threadIdx.x; asm volatile("" : "+v"(tid_)); const int tid = tid_;
    float* sS = smem; float* sW = sS + 128 * 17; float* sV = sW + 64 * 129; float* sA = sV + 64 * 17; float* sE = sA + 64 * 65;
    const float* P = (const float*)(p.ws + OFF_P);
    const float* ATT = (const float*)(p.ws + OFF_ATT); const float* QE = (const float*)(p.ws + OFF_QE); const float* KD = (const float*)(p.ws + OFF_GKD); const float* EBL = (const float*)(p.ws + OFF_EBL);
    float* O = (float*)(p.ws + OFF_O);
    for (int it = blockIdx.x; it < 128; it += gridDim.x) {
        const int bh = it >> 4, sl = it & 15, b = bh >> 2, h = bh & 3;
        __syncthreads();
        for (int e = tid; e < 128 * 16; e += NTHREADS) sS[(e >> 4) * 17 + (e & 15)] = 0.f;
        for (int n = 0; n < 128; ++n) {
            const int ci = bh * 128 + n, t0 = b * 8192 + n * 64;
            __syncthreads();
            for (int e = tid; e < 8192; e += NTHREADS) sW[(e >> 7) * 129 + (e & 127)] = QE[(size_t)ci * 8192 + e];
            for (int e = tid; e < 4096; e += NTHREADS) sA[(e >> 6) * 65 + (e & 63)] = ATT[(size_t)ci * 4096 + e];
            for (int e = tid; e < 1024; e += NTHREADS) sV[(e >> 4) * 17 + (e & 15)] = P[(size_t)(t0 + (e >> 4)) * LDP + 1024 + h * 256 + sl * 16 + (e & 15)];
            if (tid < 128) sE[tid] = EBL[ci * 128 + tid];
            __syncthreads();
            for (int o = tid; o < 1024; o += NTHREADS) {
                const int i = o >> 4, c = o & 15; float a = 0.f;
                for (int d = 0; d < 128; ++d) a += sW[i * 129 + d] * sS[d * 17 + c];
                for (int j = 0; j < 64; ++j) a += sA[i * 65 + j] * sV[j * 17 + c];
                O[(size_t)(t0 + i) * 1024 + h * 256 + sl * 16 + c] = a;
            }
            __syncthreads();
            for (int e = tid; e < 8192; e += NTHREADS) sW[(e >> 7) * 129 + (e & 127)] = KD[(size_t)ci * 8192 + e];
            __syncthreads();
            for (int o = tid; o < 2048; o += NTHREADS) {
                const int d = o >> 4, c = o & 15; float a = sS[d * 17 + c] * sE[d];
                for (int j = 0; j < 64; ++j) a += sW[j * 129 + d] * sV[j * 17 + c];
                sS[d * 17 + c] = a;
            }
        }
    }
}

PHASE_FN void ph_gla_out(const Params& p, int layer) {
    int tid_ = threadIdx.x; asm volatile("" : "+v"(tid_)); const int tid = tid_, lane = tid & 63, wv = tid >> 6;
    float* O = (float*)(p.ws + OFF_O); const float* P = (const float*)(p.ws + OFF_P);
    const float* onw = p.gla_out_norm + (layer >> 1) * 256;
    for (int t = blockIdx.x * 8 + wv; t < NT; t += gridDim.x * 8) {
#pragma unroll
        for (int h = 0; h < 4; ++h) {
            float* op = O + (size_t)t * 1024 + h * 256;
            const float4 o = *(const float4*)(op + lane * 4);
            const float ss = wave_sum(o.x * o.x + o.y * o.y + o.z * o.z + o.w * o.w);
            const float r = rsqrtf(ss * (1.f / 256.f) + EPS);
            const float4 z = *(const float4*)(P + (size_t)t * LDP + 2048 + h * 256 + lane * 4);
            const float4 w = *(const float4*)(onw + lane * 4);
            *(float4*)(op + lane * 4) = make_float4(o.x * r * w.x * siluf_(z.x), o.y * r * w.y * siluf_(z.y), o.z * r * w.z * siluf_(z.z), o.w * r * w.w * siluf_(z.w));
        }
    }
}

template <int PH>
__device__ __forceinline__ void run_phase(const Params& p, int layer, float* smem) {
    if (PH == PH_PROLOGUE) { ph_prologue(p, smem); ph_conv_dense(p, smem); }
    else if (PH == PH_NORM_MIX) ph_rows(p, layer, 0, smem);
    else if (PH == PH_GEMM_IN_EVEN) ph_gemm_in(p, layer, true, smem);
    else if (PH == PH_EVEN_TOK) ph_even_tok(p, layer, smem);
    else if (PH == PH_GDN_CHUNK) ph_gdn_chunk(p, smem);
    else if (PH == PH_GDN_SCAN) ph_gdn_scan(p, smem);
    else if (PH == PH_DSA_TOPK) ph_dsa_topk(p, smem);
    else if (PH == PH_DSA_ATTN) ph_dsa_attn(p, smem);
    else if (PH == PH_GDN_OUT) ph_gdn_out(p, layer);
    else if (PH == PH_GEMM_OUT) ph_gemm_out(p, layer, smem);
    else if (PH == PH_NORM_FFN) { ph_norm_ffn(p, layer); ph_conv_exp(p, layer, smem); }
    else if (PH == PH_MOE1) ph_moe(p, layer, 0, smem);
    else if (PH == PH_MOE2) ph_moe(p, layer, 1, smem);
    else if (PH == PH_GEMM_IN_ODD) ph_gemm_in(p, layer, false, smem);
    else if (PH == PH_GLA_TOK) ph_gla_tok(p, layer);
    else if (PH == PH_GLA_CHUNK) ph_gla_chunk(p, smem);
    else if (PH == PH_GLA_SCAN) ph_gla_scan(p, smem);
    else if (PH == PH_GLA_OUT) ph_gla_out(p, layer);
    else if (PH == PH_FINAL) ph_rows(p, 0, 1, smem);
}

#if MK_MULTI
template <int PH>
__global__ void __launch_bounds__(NTHREADS, 2) k_phase(Params p, int layer) {
    run_phase<PH>(p, layer, (float*)g_smem);
}
#else
__global__ void __launch_bounds__(NTHREADS, 2) k_mega(Params p) {
    float* smem = (float*)g_smem;
    volatile LAS unsigned* xbw = (volatile LAS unsigned*)(LAS unsigned char*)(g_smem + LDS_BYTES - 16);
    if (threadIdx.x == 0) { xbw[0] = 0u; xbw[1] = 0u; xbw[2] = 0u; xbw[3] = 0u; }
    __syncthreads();
    XcdBarrier bar = xcd_barrier_post((unsigned*)(p.ws + OFF_BAR), xbw);
#define BAR() xcd_barrier(bar)
    run_phase<PH_PROLOGUE>(p, 0, smem); BAR(); if (DUP_MASK & 4096) { run_phase<PH_PROLOGUE>(p, 0, smem); BAR(); }
    for (int lp = 0; lp < 2; ++lp) {
        const int le = 2 * lp, lo = 2 * lp + 1;
        run_phase<PH_NORM_MIX>(p, le, smem); BAR();
        run_phase<PH_GEMM_IN_EVEN>(p, le, smem); BAR(); if (DUP_MASK & 1) { run_phase<PH_GEMM_IN_EVEN>(p, le, smem); BAR(); }
        run_phase<PH_EVEN_TOK>(p, le, smem); BAR(); if (DUP_MASK & 2) { run_phase<PH_EVEN_TOK>(p, le, smem); BAR(); }
        run_phase<PH_GDN_CHUNK>(p, le, smem); BAR(); if (DUP_MASK & 4) { run_phase<PH_GDN_CHUNK>(p, le, smem); BAR(); }
        run_phase<PH_GDN_SCAN>(p, le, smem); BAR(); if (DUP_MASK & 8) { run_phase<PH_GDN_SCAN>(p, le, smem); BAR(); }
        run_phase<PH_DSA_TOPK>(p, le, smem); BAR(); if (DUP_MASK & 16) { run_phase<PH_DSA_TOPK>(p, le, smem); BAR(); }
        run_phase<PH_DSA_ATTN>(p, le, smem); BAR(); if (DUP_MASK & 32) { run_phase<PH_DSA_ATTN>(p, le, smem); BAR(); }
        run_phase<PH_GDN_OUT>(p, le, smem); BAR();
        run_phase<PH_GEMM_OUT>(p, le, smem); BAR();
        run_phase<PH_NORM_FFN>(p, le, smem); BAR();
        run_phase<PH_MOE1>(p, le, smem); BAR(); if (DUP_MASK & 64) { run_phase<PH_MOE1>(p, le, smem); BAR(); }
        run_phase<PH_MOE2>(p, le, smem); BAR(); if (DUP_MASK & 128) { run_phase<PH_MOE2>(p, le, smem); BAR(); }
        run_phase<PH_NORM_MIX>(p, lo, smem); BAR();
        run_phase<PH_GEMM_IN_ODD>(p, lo, smem); BAR(); if (DUP_MASK & 256) { run_phase<PH_GEMM_IN_ODD>(p, lo, smem); BAR(); }
        run_phase<PH_GLA_TOK>(p, lo, smem); BAR(); if (DUP_MASK & 512) { run_phase<PH_GLA_TOK>(p, lo, smem); BAR(); }
        run_phase<PH_GLA_CHUNK>(p, lo, smem); BAR(); if (DUP_MASK & 1024) { run_phase<PH_GLA_CHUNK>(p, lo, smem); BAR(); }
        run_phase<PH_GLA_SCAN>(p, lo, smem); BAR(); if (DUP_MASK & 2048) { run_phase<PH_GLA_SCAN>(p, lo, smem); BAR(); }
        run_phase<PH_GLA_OUT>(p, lo, smem); BAR();
        run_phase<PH_GEMM_OUT>(p, lo, smem); BAR();
        run_phase<PH_NORM_FFN>(p, lo, smem); BAR();
        run_phase<PH_MOE1>(p, lo, smem); BAR(); if (DUP_MASK & 64) { run_phase<PH_MOE1>(p, lo, smem); BAR(); }
        run_phase<PH_MOE2>(p, lo, smem); BAR(); if (DUP_MASK & 128) { run_phase<PH_MOE2>(p, lo, smem); BAR(); }
    }
    for (int xb = 0; xb < EXTRA_BARS; ++xb) BAR();
    run_phase<PH_FINAL>(p, 0, smem);
}
#endif

}

#if MK_MULTI
template <int PH>
static void launch_phase(const Params& p, int layer, hipStream_t stream) {
    static bool attr_set = false;
    if (!attr_set) { hipFuncSetAttribute((const void*)k_phase<PH>, hipFuncAttributeMaxDynamicSharedMemorySize, (int)LDS_BYTES); attr_set = true; }
    hipLaunchKernelGGL((k_phase<PH>), dim3(256), dim3(NTHREADS), LDS_BYTES, stream, p, layer);
}
#endif

extern "C" void kernel_launch(void* const* d_in, const int* in_sizes, int n_in, void* d_out, int out_size, void* d_ws, size_t ws_size, hipStream_t stream) {
    (void)in_sizes; (void)n_in; (void)out_size;
    if (ws_size < WS_NEEDED) { fprintf(stderr, "workspace too small: %zu < %zu\n", ws_size, (size_t)WS_NEEDED); return; }
    Params p{};
    p.x = (const float*)d_in[0]; p.c = (const float*)d_in[1]; p.pos = (const int*)d_in[2]; p.ada_w = (const float*)d_in[3]; p.ada_b = (const float*)d_in[4];
    p.norm_mix = (const float*)d_in[5]; p.norm_ffn = (const float*)d_in[6]; p.even_w_in = (const float*)d_in[7]; p.conv_w = (const float*)d_in[8];
    p.a_log = (const float*)d_in[9]; p.dt_bias = (const float*)d_in[10]; p.gdn_out_norm = (const float*)d_in[11]; p.even_w_out = (const float*)d_in[12];
    p.gla_w_in = (const float*)d_in[13]; p.gla_w_gate2 = (const float*)d_in[14]; p.gla_b_gate2 = (const float*)d_in[15]; p.gla_out_norm = (const float*)d_in[16]; p.gla_w_out = (const float*)d_in[17];
    p.rg_w = (const float*)d_in[18]; p.rg_b = (const float*)d_in[19]; p.re_w = (const float*)d_in[20]; p.re_b = (const float*)d_in[21];
    p.w1 = (const float*)d_in[22]; p.w3 = (const float*)d_in[23]; p.w2 = (const float*)d_in[24]; p.final_norm = (const float*)d_in[25];
    p.X = (float*)d_out; p.ws = (unsigned char*)d_ws;
    p.rA = pow(10000.0, -2.0 / 128.0); p.rI = pow(10000.0, -2.0 / 64.0);
    hipMemsetAsync(d_ws, 0, ZERO_BYTES, stream);
#if MK_MULTI
    launch_phase<PH_PROLOGUE>(p, 0, stream);
    for (int lp = 0; lp < 2; ++lp) {
        const int le = 2 * lp, lo = 2 * lp + 1;
        launch_phase<PH_NORM_MIX>(p, le, stream);
        launch_phase<PH_GEMM_IN_EVEN>(p, le, stream);
        launch_phase<PH_EVEN_TOK>(p, le, stream);
        launch_phase<PH_GDN_CHUNK>(p, le, stream);
        launch_phase<PH_GDN_SCAN>(p, le, stream);
        launch_phase<PH_DSA_TOPK>(p, le, stream);
        launch_phase<PH_DSA_ATTN>(p, le, stream);
        launch_phase<PH_GDN_OUT>(p, le, stream);
        launch_phase<PH_GEMM_OUT>(p, le, stream);
        launch_phase<PH_NORM_FFN>(p, le, stream);
        launch_phase<PH_MOE1>(p, le, stream);
        launch_phase<PH_MOE2>(p, le, stream);
        launch_phase<PH_NORM_MIX>(p, lo, stream);
        launch_phase<PH_GEMM_IN_ODD>(p, lo, stream);
        launch_phase<PH_GLA_TOK>(p, lo, stream);
        launch_phase<PH_GLA_CHUNK>(p, lo, stream);
        launch_phase<PH_GLA_SCAN>(p, lo, stream);
        launch_phase<PH_GLA_OUT>(p, lo, stream);
        launch_phase<PH_GEMM_OUT>(p, lo, stream);
        launch_phase<PH_NORM_FFN>(p, lo, stream);
        launch_phase<PH_MOE1>(p, lo, stream);
        launch_phase<PH_MOE2>(p, lo, stream);
    }
    launch_phase<PH_FINAL>(p, 0, stream);
#else
    static int grid = 0;
    if (!grid) {
        int dev = 0, cus = 0, per_cu = 0;
        hipGetDevice(&dev);
        hipDeviceGetAttribute(&cus, hipDeviceAttributeMultiprocessorCount, dev);
        hipFuncSetAttribute((const void*)k_mega, hipFuncAttributeMaxDynamicSharedMemorySize, (int)LDS_BYTES);
        hipOccupancyMaxActiveBlocksPerMultiprocessor(&per_cu, k_mega, NTHREADS, LDS_BYTES);
        if (cus <= 0) cus = 256;
        grid = cus * (per_cu < 1 ? 1 : 1);
    }
    hipLaunchKernelGGL(k_mega, dim3(grid), dim3(NTHREADS), LDS_BYTES, stream, p);
#endif
}
```

```cpp
#include <hip/hip_runtime.h>
#include <stdint.h>
#include <math.h>
#include <stdio.h>

#define EXTRA_BARS 0
#define PROBE_NOP 0
#define PROBE_CONST 0
#define PROBE_NOR 0
#define SCAN_DIRECT 0
#ifndef DUP_MASK
#define DUP_MASK 0
#endif
#ifndef MK_MULTI
#define MK_MULTI 0
#endif

namespace {

constexpr int NT = 16384, ND = 1024, LDP = 3920;
constexpr float EPS = 1e-6f;
constexpr int NTHREADS = 512;
constexpr size_t LDS_BYTES = 147456;
constexpr float SCALE128 = 0.08838834764831845f;
constexpr int LISTCAP = 32768;
constexpr int CSTR = 16;

constexpr size_t OFF_BAR  = 0;
constexpr size_t OFF_CNT  = 16384;
constexpr size_t ZERO_BYTES = 32768;
constexpr size_t OFF_MOD  = 32768;
constexpr size_t OFF_COSA = OFF_MOD + 4 * 2 * 6144 * 4;
constexpr size_t OFF_SINA = OFF_COSA + (size_t)NT * 64 * 4;
constexpr size_t OFF_COSI = OFF_SINA + (size_t)NT * 64 * 4;
constexpr size_t OFF_SINI = OFF_COSI + (size_t)NT * 32 * 4;
constexpr size_t OFF_H    = OFF_SINI + (size_t)NT * 32 * 4;
constexpr size_t OFF_P    = OFF_H + (size_t)NT * 1024 * 4;
constexpr size_t OFF_HID  = OFF_P;
constexpr size_t OFF_YB   = OFF_HID + (size_t)36864 * 512 * 4;
constexpr size_t OFF_O    = OFF_P + (size_t)NT * LDP * 4;
constexpr size_t OFF_ASG  = OFF_O + (size_t)NT * 1024 * 4;
constexpr size_t OFF_GATE = OFF_ASG + (size_t)NT * 4 * 4;
constexpr size_t OFF_LIST = OFF_GATE + (size_t)NT * 2 * 4;
constexpr size_t OFF_R    = OFF_LIST + (size_t)32 * LISTCAP * 4;
constexpr size_t OFF_QN   = OFF_R;
constexpr size_t OFF_KN   = OFF_QN + (size_t)NT * 512 * 4;
constexpr size_t OFF_VC   = OFF_KN + (size_t)NT * 512 * 4;
constexpr size_t OFF_BETA = OFF_VC + (size_t)NT * 512 * 4;
constexpr size_t OFF_G    = OFF_BETA + (size_t)NT * 4 * 4;
constexpr size_t OFF_W    = OFF_G + (size_t)NT * 4 * 4;
constexpr size_t OFF_U    = OFF_W + (size_t)1024 * 8192 * 4;
constexpr size_t OFF_QG   = OFF_U + (size_t)1024 * 8192 * 4;
constexpr size_t OFF_KD   = OFF_QG + (size_t)1024 * 8192 * 4;
constexpr size_t OFF_AQK  = OFF_KD + (size_t)1024 * 8192 * 4;
constexpr size_t OFF_GL   = OFF_AQK + (size_t)1024 * 4096 * 4;
constexpr size_t OFF_QB   = OFF_GL + 4096;
constexpr size_t OFF_KB   = OFF_QB + (size_t)NT * 512 * 4;
constexpr size_t OFF_QI   = OFF_KB + (size_t)NT * 512 * 4;
constexpr size_t OFF_KI   = OFF_QI + (size_t)NT * 256 * 4;
constexpr size_t OFF_WI   = OFF_KI + (size_t)NT * 64 * 4;
constexpr size_t OFF_SEL  = OFF_WI + (size_t)NT * 4 * 4;
constexpr size_t OFF_EVEN_END = OFF_SEL + (size_t)NT * 256 * 4;
constexpr size_t OFF_PFR  = OFF_W;
constexpr size_t OFF_RFR  = OFF_PFR + (size_t)1024 * 32768;
constexpr size_t OFF_QFR  = OFF_RFR + (size_t)1024 * 16384;
constexpr size_t OFF_OFR  = OFF_QFR + (size_t)1024 * 32768;
static_assert(OFF_OFR + (size_t)1024 * 16384 <= OFF_GL, "gdn v2 buffers overflow");
constexpr size_t OFF_QBB  = OFF_QB;
constexpr size_t OFF_KBB  = OFF_QBB + (size_t)NT * 512 * 2;
constexpr size_t OFF_VT   = OFF_KBB + (size_t)NT * 512 * 2;
constexpr size_t OFF_QIB  = OFF_VT + (size_t)NT * 512 * 2;
constexpr size_t OFF_KIB  = OFF_QIB + (size_t)NT * 256 * 2;
constexpr size_t OFF_M16  = OFF_KIB + (size_t)NT * 64 * 2;
static_assert(OFF_M16 + (size_t)NT * 512 * 2 <= OFF_WI, "dsa v2 buffers overflow");
constexpr size_t OFF_LA   = OFF_R;
constexpr size_t OFF_ATT  = OFF_LA + (size_t)NT * 512 * 4;
constexpr size_t OFF_QE   = OFF_ATT + (size_t)1024 * 4096 * 4;
constexpr size_t OFF_GKD  = OFF_QE + (size_t)1024 * 8192 * 4;
constexpr size_t OFF_EBL  = OFF_GKD + (size_t)1024 * 8192 * 4;
constexpr size_t OFF_WINE = OFF_EVEN_END;
constexpr size_t OFF_WINO = OFF_WINE + (size_t)2 * 3968 * 1024 * 2;
constexpr size_t OFF_WOUT = OFF_WINO + (size_t)2 * 3200 * 1024 * 2;
constexpr size_t OFF_W13  = OFF_WOUT + (size_t)4 * 1024 * 1024 * 2;
constexpr size_t OFF_W2T  = OFF_W13 + (size_t)32 * 1024 * 1024 * 2;
constexpr size_t WS_NEEDED = OFF_W2T + (size_t)32 * 1024 * 512 * 2;

struct Params {
    const float* x; const float* c; const int* pos; const float* ada_w; const float* ada_b;
    const float* norm_mix; const float* norm_ffn; const float* even_w_in; const float* conv_w;
    const float* a_log; const float* dt_bias; const float* gdn_out_norm; const float* even_w_out;
    const float* gla_w_in; const float* gla_w_gate2; const float* gla_b_gate2; const float* gla_out_norm; const float* gla_w_out;
    const float* rg_w; const float* rg_b; const float* re_w; const float* re_b;
    const float* w1; const float* w3; const float* w2; const float* final_norm;
    float* X;
    unsigned char* ws;
    double rA, rI;
};

#define XB_TMO      128
#define XB_XCNT(j)  (256  + 64 * (j))
#define XB_XSUB(j)  (1280 + 64 * (j))
#define XB_XGEN(j)  (2304 + 64 * (j))
#define XB_TOP      3328
#define XB_TOPGEN   3392
#define XCD_BAR_WORDS 3456
#define XB_SPIN_CAP (1u << 18)
#define LAS __attribute__((address_space(3)))

__device__ __forceinline__ unsigned xb_ld(unsigned* p)              { return __hip_atomic_load(p, __ATOMIC_RELAXED, __HIP_MEMORY_SCOPE_AGENT); }
__device__ __forceinline__ unsigned xb_add(unsigned* p, unsigned v) { return __hip_atomic_fetch_add(p, v, __ATOMIC_RELAXED, __HIP_MEMORY_SCOPE_AGENT); }
__device__ __forceinline__ unsigned xb_xcc_id() { return (unsigned)__builtin_amdgcn_s_getreg((3 << 11) | 20) & 0xFu; }
#define XB_SPIN(cond, bar) do { unsigned _sp = 0; while (cond) { __builtin_amdgcn_s_sleep(1); \
    if ((++_sp & 255u) == 0u) { if (xb_ld(&(bar)[XB_TMO])) break; if (_sp > XB_SPIN_CAP) { atomicAdd(&(bar)[XB_TMO], 1u); break; } } } } while (0)

struct XcdBarrier { unsigned* bar; unsigned x; volatile LAS unsigned* st; };

__device__ __forceinline__ XcdBarrier xcd_barrier_post(unsigned* bar, volatile LAS unsigned* st) {
    XcdBarrier b; b.bar = bar; b.x = xb_xcc_id(); b.st = st;
    if (threadIdx.x == 0) (void)xb_add(&bar[XB_XCNT(b.x)], 1u);
    return b;
}
__device__ __forceinline__ void xcd_barrier_complete(unsigned* bar, unsigned x, unsigned& nloc, unsigned& nx) {
    const unsigned G = gridDim.x * gridDim.y * gridDim.z;
    unsigned sum, cnt, mine, sp = 0u;
    for (;;) {
        sum = 0u; cnt = 0u; mine = 0u;
#pragma unroll
        for (unsigned j = 0; j < 16; ++j) { const unsigned c = xb_ld(&bar[XB_XCNT(j)]); sum += c; cnt += (c > 0u) ? 1u : 0u; mine = (j == x) ? c : mine; }
        if (sum == G) break;
        __builtin_amdgcn_s_sleep(1);
        if ((++sp & 255u) == 0u) { if (xb_ld(&bar[XB_TMO])) break; if (sp > XB_SPIN_CAP) { atomicAdd(&bar[XB_TMO], 1u); break; } }
    }
    nloc = mine > 0u ? mine : 1u; nx = cnt > 0u ? cnt : 1u;
}
__device__ __forceinline__ void xcd_barrier(const XcdBarrier& b) {
    asm volatile("s_waitcnt vmcnt(0)" ::: "memory");
    __syncthreads();
    if (threadIdx.x == 0) {
        unsigned* bar = b.bar;
        __builtin_amdgcn_s_waitcnt(0);
        unsigned nloc = b.st[0], nx = b.st[1];
        if (nloc == 0u) { xcd_barrier_complete(bar, b.x, nloc, nx); b.st[0] = nloc; b.st[1] = nx; }
        const unsigned old = xb_add(&bar[XB_XSUB(b.x)], 1u);
        const unsigned gen = old / nloc;
        if (old + 1u == (gen + 1u) * nloc) {
            __builtin_amdgcn_fence(__ATOMIC_RELEASE, "agent");
            asm volatile("s_waitcnt vmcnt(0)" ::: "memory");
            const unsigned og = xb_add(&bar[XB_TOP], 1u);
            const unsigned tg = og / nx;
            if (og + 1u == (tg + 1u) * nx) xb_add(&bar[XB_TOPGEN], 1u);
            else XB_SPIN(xb_ld(&bar[XB_TOPGEN]) == tg, bar);
            __builtin_amdgcn_fence(__ATOMIC_ACQUIRE, "agent");
            xb_add(&bar[XB_XGEN(b.x)], 1u);
            asm volatile("s_waitcnt vmcnt(0)" ::: "memory");
        } else {
            XB_SPIN(xb_ld(&bar[XB_XGEN(b.x)]) == gen, bar);
            __builtin_amdgcn_fence(__ATOMIC_ACQUIRE, "agent");
            asm volatile("s_waitcnt vmcnt(0)" ::: "memory");
        }
    }
    __syncthreads();
}

__device__ __forceinline__ float wave_sum(float v) {
#pragma unroll
    for (int o = 32; o > 0; o >>= 1) v += __shfl_xor(v, o);
    return v;
}
__device__ __forceinline__ int wave_sum_i(int v) {
#pragma unroll
    for (int o = 32; o > 0; o >>= 1) v += __shfl_xor(v, o);
    return v;
}
__device__ __forceinline__ float wave_max(float v) {
#pragma unroll
    for (int o = 32; o > 0; o >>= 1) v = fmaxf(v, __shfl_xor(v, o));
    return v;
}
__device__ __forceinline__ float sigmoidf_(float x) { return 1.f / (1.f + expf(-x)); }
__device__ __forceinline__ float siluf_(float x) { return x / (1.f + expf(-x)); }
__device__ __forceinline__ float softplusf_(float x) { return fmaxf(x, 0.f) + log1pf(expf(-fabsf(x))); }
__device__ __forceinline__ unsigned ordkey(float f) { const unsigned u = __float_as_uint(f); return (u & 0x80000000u) ? ~u : (u | 0x80000000u); }

__device__ __forceinline__ void sincos_d(double a, double& s, double& c) {
    const double kq = rint(a * 0.63661977236758134308);
    double r = fma(-kq, 1.57079632673412561417e+00, a);
    r = fma(-kq, 6.07710050650619224932e-11, r);
    const int q = (int)((long long)kq & 3);
    const double r2 = r * r;
    const double sp = r * (1.0 + r2 * (-1.0 / 6 + r2 * (1.0 / 120 + r2 * (-1.0 / 5040 + r2 * (1.0 / 362880 + r2 * (-1.0 / 39916800 + r2 * (1.0 / 6227020800.0)))))));
    const double cp = 1.0 + r2 * (-0.5 + r2 * (1.0 / 24 + r2 * (-1.0 / 720 + r2 * (1.0 / 40320 + r2 * (-1.0 / 3628800 + r2 * (1.0 / 479001600.0 + r2 * (-1.0 / 87178291200.0)))))));
    if (q == 0) { s = sp; c = cp; } else if (q == 1) { s = cp; c = -sp; } else if (q == 2) { s = -sp; c = -cp; } else { s = -cp; c = sp; }
}
__device__ __forceinline__ double ipow_d(double b, int e) { double v = 1.0; while (e) { if (e & 1) v *= b; b *= b; e >>= 1; } return v; }

struct GemmArgs { const float* A; int lda; const int* rows; int m0; int mvalid; const float* B; int ldb; int n0; int N; int K; };

template <class Epi>
__device__ __forceinline__ void gemm128(const GemmArgs& g, float* smem, Epi epi) {
    float* As = smem;
    float* Bs = smem + 16 * 132;
    int tid_ = threadIdx.x; asm volatile("" : "+v"(tid_)); const int tid = tid_, ty = tid >> 4, tx = tid & 15;
    const int arow = tid >> 2, kq = (tid & 3) * 4;
    const int bk = tid >> 5, bn = (tid & 31) * 4;
    long asrc = -1;
    if (arow < g.mvalid) { const int r = g.rows ? g.rows[arow] : (g.m0 + arow); if (r >= 0) asrc = (long)r * g.lda; }
    const bool bval = (g.n0 + bn) < g.N;
    float acc[4][8];
#pragma unroll
    for (int i = 0; i < 4; ++i)
#pragma unroll
        for (int j = 0; j < 8; ++j) acc[i][j] = 0.f;
    for (int k0 = 0; k0 < g.K; k0 += 16) {
        float4 av = make_float4(0.f, 0.f, 0.f, 0.f), bv = make_float4(0.f, 0.f, 0.f, 0.f);
        if (asrc >= 0) av = *(const float4*)(g.A + asrc + k0 + kq);
        if (bval) bv = *(const float4*)(g.B + (size_t)(k0 + bk) * g.ldb + g.n0 + bn);
        __syncthreads();
        As[(kq + 0) * 132 + arow] = av.x; As[(kq + 1) * 132 + arow] = av.y; As[(kq + 2) * 132 + arow] = av.z; As[(kq + 3) * 132 + arow] = av.w;
        *(float4*)&Bs[bk * 132 + bn] = bv;
        __syncthreads();
#pragma unroll
        for (int kk = 0; kk < 16; ++kk) {
            const float4 a = *(const float4*)&As[kk * 132 + ty * 4];
            const float4 b0 = *(const float4*)&Bs[kk * 132 + tx * 8];
            const float4 b1 = *(const float4*)&Bs[kk * 132 + tx * 8 + 4];
            const float aa[4] = {a.x, a.y, a.z, a.w};
            const float bb[8] = {b0.x, b0.y, b0.z, b0.w, b1.x, b1.y, b1.z, b1.w};
#pragma unroll
            for (int i = 0; i < 4; ++i)
#pragma unroll
                for (int j = 0; j < 8; ++j) acc[i][j] += aa[i] * bb[j];
        }
    }
#pragma unroll
    for (int i = 0; i < 4; ++i) {
        const int r = ty * 4 + i;
        if (r < g.mvalid) {
#pragma unroll
            for (int j = 0; j < 8; ++j) { const int n = g.n0 + tx * 8 + j; if (n < g.N) epi(r, n, acc[i][j]); }
        }
    }
}


typedef short bf16x8 __attribute__((ext_vector_type(8)));
typedef float f32x4 __attribute__((ext_vector_type(4)));
typedef unsigned short bf16_t;
typedef __bf16 bf16x2_t __attribute__((ext_vector_type(2)));
typedef float f32x2_t __attribute__((ext_vector_type(2)));
__device__ __forceinline__ unsigned cvt_pk_bf16(float lo, float hi) { const f32x2_t v = {lo, hi}; const bf16x2_t r = __builtin_convertvector(v, bf16x2_t); return __builtin_bit_cast(unsigned, r); }
__device__ __forceinline__ bf16_t f2bf(float f) { return (bf16_t)(cvt_pk_bf16(f, 0.f) & 0xffffu); }
__device__ __forceinline__ float bf16_to_f32(bf16_t v) { return __uint_as_float(((unsigned)v) << 16); }
__device__ __forceinline__ uint4 pack8(const float4 a, const float4 b) { uint4 r; r.x = cvt_pk_bf16(a.x, a.y); r.y = cvt_pk_bf16(a.z, a.w); r.z = cvt_pk_bf16(b.x, b.y); r.w = cvt_pk_bf16(b.z, b.w); return r; }
__device__ __forceinline__ int lds_off(int r, int c) { return r * 128 + ((c ^ (r & 7)) << 4); }

template <class ALoad, class BLoad, class Epi>
__device__ __forceinline__ void gemm_tile_bf16(const int K, unsigned char* lds, ALoad aload, BLoad bload, Epi epi) {
    int tid_ = threadIdx.x; asm volatile("" : "+v"(tid_)); const int tid = tid_, lane = tid & 63, wid = tid >> 6, wm = wid >> 1, wn = wid & 1;
    f32x4 acc[4][4];
#pragma unroll
    for (int mi = 0; mi < 4; ++mi)
#pragma unroll
        for (int ni = 0; ni < 4; ++ni) acc[mi][ni] = (f32x4){0.f, 0.f, 0.f, 0.f};
    uint4 ra[4], rb[2];
    const int nk = K >> 6;
#pragma unroll
    for (int i = 0; i < 4; ++i) { const int q = tid + 512 * i; ra[i] = aload(i, q >> 3, (q & 7) * 8); }
#pragma unroll
    for (int i = 0; i < 2; ++i) { const int q = tid + 512 * i; rb[i] = bload(i, q >> 3, (q & 7) * 8); }
    __syncthreads();
#pragma unroll
    for (int i = 0; i < 4; ++i) { const int q = tid + 512 * i; *(uint4*)(lds + lds_off(q >> 3, q & 7)) = ra[i]; }
#pragma unroll
    for (int i = 0; i < 2; ++i) { const int q = tid + 512 * i; *(uint4*)(lds + 32768 + lds_off(q >> 3, q & 7)) = rb[i]; }
    __syncthreads();
    for (int kt = 0; kt < nk; ++kt) {
        if (kt + 1 < nk) {
#pragma unroll
            for (int i = 0; i < 4; ++i) { const int q = tid + 512 * i; ra[i] = aload(i, q >> 3, (kt + 1) * 64 + (q & 7) * 8); }
#pragma unroll
            for (int i = 0; i < 2; ++i) { const int q = tid + 512 * i; rb[i] = bload(i, q >> 3, (kt + 1) * 64 + (q & 7) * 8); }
        }
        const unsigned char* At = lds + (kt & 1) * 49152;
        const unsigned char* Bt = At + 32768;
#pragma unroll
        for (int ks = 0; ks < 2; ++ks) {
            bf16x8 af[4], bfr[4];
            const int c = ks * 4 + (lane >> 4);
#pragma unroll
            for (int mi = 0; mi < 4; ++mi) af[mi] = *(const bf16x8*)(At + lds_off(wm * 64 + mi * 16 + (lane & 15), c));
#pragma unroll
            for (int ni = 0; ni < 4; ++ni) bfr[ni] = *(const bf16x8*)(Bt + lds_off(wn * 64 + ni * 16 + (lane & 15), c));
#pragma unroll
            for (int mi = 0; mi < 4; ++mi)
#pragma unroll
                for (int ni = 0; ni < 4; ++ni) acc[mi][ni] = __builtin_amdgcn_mfma_f32_16x16x32_bf16(bfr[ni], af[mi], acc[mi][ni], 0, 0, 0);
        }
        if (kt + 1 < nk) {
            unsigned char* An = lds + ((kt + 1) & 1) * 49152;
#pragma unroll
            for (int i = 0; i < 4; ++i) { const int q = tid + 512 * i; *(uint4*)(An + lds_off(q >> 3, q & 7)) = ra[i]; }
#pragma unroll
            for (int i = 0; i < 2; ++i) { const int q = tid + 512 * i; *(uint4*)(An + 32768 + lds_off(q >> 3, q & 7)) = rb[i]; }
        }
        __syncthreads();
    }
    epi(acc, wm, wn, lane);
}

__device__ __forceinline__ void convert_tile(const float* src0, const float* src1, int mode, int K, int N, int ld, bf16_t* dst, int rt, int kt, float* smem) {
    int tid_ = threadIdx.x; asm volatile("" : "+v"(tid_)); const int tid = tid_;
    __syncthreads();
    { const int k = tid >> 3, R0 = rt * 64 + (tid & 7) * 8;
      const float* sp; int col;
      if (mode == 0) { sp = src0; col = R0; } else { sp = (R0 & 32) ? src1 : src0; col = (R0 >> 6) * 32 + (R0 & 31); }
      float4 a = make_float4(0.f, 0.f, 0.f, 0.f), b = a;
      const float* rp = sp + (size_t)(kt * 64 + k) * ld + col;
      if (col < N) a = *(const float4*)rp;
      if (col + 4 < N) b = *(const float4*)(rp + 4);
      float* d = smem + k * 65 + (tid & 7) * 8;
      d[0] = a.x; d[1] = a.y; d[2] = a.z; d[3] = a.w; d[4] = b.x; d[5] = b.y; d[6] = b.z; d[7] = b.w; }
    __syncthreads();
    { const int R = tid >> 3, kc = (tid & 7) * 8;
      float v[8];
#pragma unroll
      for (int j = 0; j < 8; ++j) v[j] = smem[(kc + j) * 65 + R];
      uint4 o; o.x = cvt_pk_bf16(v[0], v[1]); o.y = cvt_pk_bf16(v[2], v[3]); o.z = cvt_pk_bf16(v[4], v[5]); o.w = cvt_pk_bf16(v[6], v[7]);
      *(uint4*)(dst + (size_t)(rt * 64 + R) * K + kt * 64 + kc) = o; }
}

extern __shared__ __attribute__((aligned(16))) unsigned char g_smem[];
#define PHASE_FN __device__ __forceinline__
enum { PH_PROLOGUE = 0, PH_NORM_MIX, PH_GEMM_IN_EVEN, PH_EVEN_TOK, PH_GDN_CHUNK, PH_GDN_SCAN, PH_DSA_TOPK, PH_DSA_ATTN, PH_GDN_OUT,
       PH_GEMM_OUT, PH_NORM_FFN, PH_MOE1, PH_MOE2, PH_GEMM_IN_ODD, PH_GLA_TOK, PH_GLA_CHUNK, PH_GLA_SCAN, PH_GLA_OUT, PH_FINAL };

PHASE_FN void ph_prologue(const Params& p, float* smem) {
    smem = (float*)g_smem;
    int tid_ = threadIdx.x; asm volatile("" : "+v"(tid_)); const int tid = tid_, nthr = gridDim.x * NTHREADS, gid = blockIdx.x * NTHREADS + tid;
    { const float4* src = (const float4*)p.x; float4* dst = (float4*)p.X;
      for (size_t i = gid; i < (size_t)NT * ND / 4; i += nthr) dst[i] = src[i]; }
    for (int i = tid; i < 2 * ND; i += NTHREADS) smem[i] = siluf_(p.c[i]);
    __syncthreads();
    float* MOD = (float*)(p.ws + OFF_MOD);
    { float* red = smem + 2048;
      const int lane = tid & 63, wv = tid >> 6;
      for (int item = blockIdx.x; item < 4 * 96; item += gridDim.x) {
          const int l = item / 96, n = (item % 96) * 64 + lane;
          const float* w = p.ada_w + (size_t)l * ND * 6144 + n;
          float a0 = 0.f, a1 = 0.f;
#pragma unroll 8
          for (int k = wv * 128; k < wv * 128 + 128; ++k) { const float wv_ = w[(size_t)k * 6144]; a0 += smem[k] * wv_; a1 += smem[ND + k] * wv_; }
          __syncthreads();
          red[(wv * 64 + lane) * 2] = a0; red[(wv * 64 + lane) * 2 + 1] = a1;
          __syncthreads();
          if (tid < 128) { const int c = tid >> 1, bb = tid & 1; float a = 0.f; for (int w8 = 0; w8 < 8; ++w8) a += red[(w8 * 64 + c) * 2 + bb];
              MOD[(l * 2 + bb) * 6144 + (item % 96) * 64 + c] = a + p.ada_b[l * 6144 + (item % 96) * 64 + c]; }
      }
      __syncthreads(); }
    float* COSA = (float*)(p.ws + OFF_COSA); float* SINA = (float*)(p.ws + OFF_SINA);
    float* COSI = (float*)(p.ws + OFF_COSI); float* SINI = (float*)(p.ws + OFF_SINI);
    for (size_t i = gid; i < (size_t)NT * 64; i += nthr) {
        const int t = (int)(i >> 6), j = (int)(i & 63);
        double s, c; sincos_d((double)p.pos[t] * ipow_d(p.rA, j), s, c);
        COSA[i] = (float)c; SINA[i] = (float)s;
    }
    for (size_t i = gid; i < (size_t)NT * 32; i += nthr) {
        const int t = (int)(i >> 5), j = (int)(i & 31);
        double s, c; sincos_d((double)p.pos[t] * ipow_d(p.rI, j), s, c);
        COSI[i] = (float)c; SINI[i] = (float)s;
    }
}

PHASE_FN void ph_rows(const Params& p, int layer, int mode, float* smem) {
    smem = (float*)g_smem;
    int tid_ = threadIdx.x; asm volatile("" : "+v"(tid_)); const int tid = tid_, lane = tid & 63, wv = tid >> 6;
    int* pad = (int*)smem;
    const int moe_layer = (mode == 1) ? 3 : layer - 1;
    if (moe_layer >= 0) {
        if (tid == 0) { const int* cnt = (const int*)(p.ws + OFF_CNT) + moe_layer * 32 * CSTR; int a = 0; for (int e = 0; e < 32; ++e) { pad[e] = a; a += ((cnt[e * CSTR] + 127) / 128) * 128; } }
        __syncthreads();
    }
    const float* MOD = (const float*)(p.ws + OFF_MOD);
    float* H = (float*)(p.ws + OFF_H);
    const float* YB = (const float*)(p.ws + OFF_YB);
    const int* ASG = (const int*)(p.ws + OFF_ASG);
    const float* GATE = (const float*)(p.ws + OFF_GATE);
    for (int row = blockIdx.x * 8 + wv; row < NT; row += gridDim.x * 8) {
        const int b = row >> 13;
        float* xr = p.X + (size_t)row * ND;
        float xv[16];
#pragma unroll
        for (int j = 0; j < 4; ++j) { const float4 v = *(const float4*)(xr + j * 256 + lane * 4); xv[4 * j] = v.x; xv[4 * j + 1] = v.y; xv[4 * j + 2] = v.z; xv[4 * j + 3] = v.w; }
        if (moe_layer >= 0) {
            const float* gt = MOD + (size_t)(moe_layer * 2 + b) * 6144 + 5 * 1024;
            const int e0 = ASG[row * 4 + 0], r0 = ASG[row * 4 + 1], e1 = ASG[row * 4 + 2], r1 = ASG[row * 4 + 3];
            const float g0 = GATE[row * 2], g1 = GATE[row * 2 + 1];
            const float* y0 = YB + (size_t)(pad[e0] + r0) * ND;
            const float* y1 = YB + (size_t)(pad[e1] + r1) * ND;
#pragma unroll
            for (int j = 0; j < 4; ++j) {
                const int col = j * 256 + lane * 4;
                const float4 a = *(const float4*)(y0 + col), bq = *(const float4*)(y1 + col), g = *(const float4*)(gt + col);
                xv[4 * j] += g.x * (g0 * a.x + g1 * bq.x); xv[4 * j + 1] += g.y * (g0 * a.y + g1 * bq.y);
                xv[4 * j + 2] += g.z * (g0 * a.z + g1 * bq.z); xv[4 * j + 3] += g.w * (g0 * a.w + g1 * bq.w);
                if (mode == 0) *(float4*)(xr + col) = make_float4(xv[4 * j], xv[4 * j + 1], xv[4 * j + 2], xv[4 * j + 3]);
            }
        }
        float ss = 0.f;
#pragma unroll
        for (int j = 0; j < 16; ++j) ss += xv[j] * xv[j];
        ss = wave_sum(ss);
        const float rstd = rsqrtf(ss * (1.f / 1024.f) + EPS);
        if (mode == 0) {
            const float* nw = p.norm_mix + layer * 1024;
            const float* sh = MOD + (size_t)(layer * 2 + b) * 6144;
            const float* sc = sh + 1024;
#pragma unroll
            for (int j = 0; j < 4; ++j) {
                const int col = j * 256 + lane * 4;
                const float4 w = *(const float4*)(nw + col), s4 = *(const float4*)(sc + col), h4 = *(const float4*)(sh + col);
                float4 o;
                o.x = xv[4 * j] * rstd * w.x * (1.f + s4.x) + h4.x; o.y = xv[4 * j + 1] * rstd * w.y * (1.f + s4.y) + h4.y;
                o.z = xv[4 * j + 2] * rstd * w.z * (1.f + s4.z) + h4.z; o.w = xv[4 * j + 3] * rstd * w.w * (1.f + s4.w) + h4.w;
                *(float4*)(H + (size_t)row * ND + col) = o;
            }
        } else {
#pragma unroll
            for (int j = 0; j < 4; ++j) {
                const int col = j * 256 + lane * 4;
                const float4 w = *(const float4*)(p.final_norm + col);
                *(float4*)(xr + col) = make_float4(xv[4 * j] * rstd * w.x, xv[4 * j + 1] * rstd * w.y, xv[4 * j + 2] * rstd * w.z, xv[4 * j + 3] * rstd * w.w);
            }
        }
    }
}

PHASE_FN void ph_gemm_in(const Params& p, int layer, bool even, float* smem) {
    smem = (float*)g_smem;
    const int N = even ? 3916 : 3088, ntn = even ? 31 : 25;
    const bf16_t* Wt = even ? (const bf16_t*)(p.ws + OFF_WINE) + (size_t)(layer >> 1) * 3968 * 1024 : (const bf16_t*)(p.ws + OFF_WINO) + (size_t)(layer >> 1) * 3200 * 1024;
    const float* H = (const float*)(p.ws + OFF_H);
    float* P = (float*)(p.ws + OFF_P);
    for (int tile = blockIdx.x; tile < 64 * ntn; tile += gridDim.x) {
        const int mt = tile % 64, nt = tile / 64;
        const float* Ab = H + (size_t)mt * 256 * 1024;
        const bf16_t* Bb = Wt + (size_t)nt * 128 * 1024;
        float* Pt = P + (size_t)mt * 256 * LDP + nt * 128;
        const int nrem = N - nt * 128;
        gemm_tile_bf16(1024, (unsigned char*)smem,
            [=](int i, int r, int k) -> uint4 { const float* sp = Ab + (size_t)r * 1024 + k; return pack8(*(const float4*)sp, *(const float4*)(sp + 4)); },
            [=](int i, int r, int k) -> uint4 { return *(const uint4*)(Bb + (size_t)r * 1024 + k); },
            [=](const f32x4 (&acc)[4][4], int wm, int wn, int lane) {
#pragma unroll
                for (int mi = 0; mi < 4; ++mi)
#pragma unroll
                    for (int ni = 0; ni < 4; ++ni) {
                        const int m = wm * 64 + mi * 16 + (lane & 15), n = wn * 64 + ni * 16 + 4 * (lane >> 4);
                        if (n < nrem) *(f32x4*)(Pt + (size_t)m * LDP + n) = acc[mi][ni];
                    }
            });
    }
}

PHASE_FN void ph_even_tok(const Params& p, int layer, float* smem) {
    smem = (float*)g_smem;
    int tid_ = threadIdx.x; asm volatile("" : "+v"(tid_)); const int tid = tid_, lane = tid & 63, wv = tid >> 6, li = layer >> 1;
    const float* P = (const float*)(p.ws + OFF_P);
    const float* cw = p.conv_w + (size_t)li * 4 * 1536;
    float* QN = (float*)(p.ws + OFF_QN); float* KN = (float*)(p.ws + OFF_KN); float* VC = (float*)(p.ws + OFF_VC);
    float* BETA = (float*)(p.ws + OFF_BETA); float* G = (float*)(p.ws + OFF_G);
    bf16_t* QB = (bf16_t*)(p.ws + OFF_QBB); bf16_t* KB = (bf16_t*)(p.ws + OFF_KBB); bf16_t* QI = (bf16_t*)(p.ws + OFF_QIB); bf16_t* KI = (bf16_t*)(p.ws + OFF_KIB); float* WI = (float*)(p.ws + OFF_WI);
    const float* COSA = (const float*)(p.ws + OFF_COSA); const float* SINA = (const float*)(p.ws + OFF_SINA);
    const float* COSI = (const float*)(p.ws + OFF_COSI); const float* SINI = (const float*)(p.ws + OFF_SINI);
    for (int t = blockIdx.x * 8 + wv; t < NT; t += gridDim.x * 8) {
        const int s = t & 8191;
        const float* Pt = P + (size_t)t * LDP;
        auto convs = [&](int c) -> float {
            float a = 0.f;
#pragma unroll
            for (int j = 0; j < 4; ++j) { if (s - 3 + j >= 0) a += cw[j * 1536 + c] * P[(size_t)(t - 3 + j) * LDP + c]; }
            return siluf_(a);
        };
#pragma unroll 1
        for (int h = 0; h < 4; ++h) {
            const float q0 = convs(h * 128 + lane), q1 = convs(h * 128 + 64 + lane);
            float ss = wave_sum(q0 * q0 + q1 * q1);
            float r = rsqrtf(ss + EPS);
            QN[(size_t)t * 512 + h * 128 + lane] = q0 * r; QN[(size_t)t * 512 + h * 128 + 64 + lane] = q1 * r;
            const float k0 = convs(512 + h * 128 + lane), k1 = convs(512 + h * 128 + 64 + lane);
            ss = wave_sum(k0 * k0 + k1 * k1);
            r = rsqrtf(ss + EPS);
            KN[(size_t)t * 512 + h * 128 + lane] = k0 * r; KN[(size_t)t * 512 + h * 128 + 64 + lane] = k1 * r;
            VC[(size_t)t * 512 + h * 128 + lane] = convs(1024 + h * 128 + lane);
            VC[(size_t)t * 512 + h * 128 + 64 + lane] = convs(1024 + h * 128 + 64 + lane);
        }
        if (lane < 4) {
            const float ba = Pt[2048 + lane], aa = Pt[2052 + lane];
            BETA[t * 4 + lane] = sigmoidf_(ba);
            G[t * 4 + lane] = -expf(p.a_log[li * 4 + lane]) * softplusf_(aa + p.dt_bias[li * 4 + lane]);
            WI[t * 4 + lane] = Pt[3912 + lane] * 0.0625f;
        }
        { const float c = COSA[(size_t)t * 64 + lane], sn = SINA[(size_t)t * 64 + lane];
#pragma unroll
          for (int h = 0; h < 4; ++h) {
              float t1 = Pt[2056 + h * 128 + lane], t2 = Pt[2056 + h * 128 + 64 + lane];
              QB[(size_t)t * 512 + h * 128 + lane] = f2bf(t1 * c - t2 * sn); QB[(size_t)t * 512 + h * 128 + 64 + lane] = f2bf(t2 * c + t1 * sn);
              t1 = Pt[2568 + h * 128 + lane]; t2 = Pt[2568 + h * 128 + 64 + lane];
              KB[(size_t)t * 512 + h * 128 + lane] = f2bf(t1 * c - t2 * sn); KB[(size_t)t * 512 + h * 128 + 64 + lane] = f2bf(t2 * c + t1 * sn);
          } }
#pragma unroll
        for (int r = 0; r < 2; ++r) {
            const int item = lane + 64 * r, hh = item >> 5, ii = item & 31;
            const float c = COSI[(size_t)t * 32 + ii], sn = SINI[(size_t)t * 32 + ii];
            const float t1 = Pt[3592 + hh * 64 + ii], t2 = Pt[3592 + hh * 64 + 32 + ii];
            QI[(size_t)t * 256 + hh * 64 + ii] = f2bf(t1 * c - t2 * sn); QI[(size_t)t * 256 + hh * 64 + 32 + ii] = f2bf(t2 * c + t1 * sn);
        }
        if (lane < 32) {
            const float c = COSI[(size_t)t * 32 + lane], sn = SINI[(size_t)t * 32 + lane];
            const float t1 = Pt[3848 + lane], t2 = Pt[3848 + 32 + lane];
            KI[(size_t)t * 64 + lane] = f2bf(t1 * c - t2 * sn); KI[(size_t)t * 64 + 32 + lane] = f2bf(t2 * c + t1 * sn);
        }
    }
    { bf16_t* VT = (bf16_t*)(p.ws + OFF_VT);
      bf16_t* sv = (bf16_t*)g_smem;
      for (int item = blockIdx.x; item < 2 * 128 * 4; item += gridDim.x) {
          const int h = item & 3, tt = item >> 2, b = tt >> 7, s0 = (tt & 127) * 64;
          __syncthreads();
          for (int e = tid; e < 64 * 128; e += NTHREADS) { const int i = e >> 7, d = e & 127; sv[d * 72 + i] = f2bf(P[(size_t)(b * 8192 + s0 + i) * LDP + 3080 + h * 128 + d]); }
          __syncthreads();
          for (int e = tid; e < 128 * 8; e += NTHREADS) { const int d = e >> 3, c = e & 7;
              *(uint4*)(VT + ((size_t)((b * 4 + h) * 128 + d)) * 8192 + s0 + c * 8) = *(const uint4*)(sv + d * 72 + c * 8); }
      } }
}

__device__ __forceinline__ f32x4 mma_lds(const unsigned char* A, int sa, int a0, const unsigned char* B, int sb, int b0, int K, f32x4 acc, int c16, int q4) {
    const unsigned char* ap = A + (a0 + c16) * sa + q4 * 16;
    const unsigned char* bp = B + (b0 + c16) * sb + q4 * 16;
    for (int kk = 0; kk < K; kk += 32) { acc = __builtin_amdgcn_mfma_f32_16x16x32_bf16(*(const bf16x8*)(ap + kk * 2), *(const bf16x8*)(bp + kk * 2), acc, 0, 0, 0); }
    return acc;
}
__device__ __forceinline__ uint2 pack4(const f32x4 v) { uint2 r; r.x = cvt_pk_bf16(v[0], v[1]); r.y = cvt_pk_bf16(v[2], v[3]); return r; }
__device__ __forceinline__ uint2 pack4s(f32x4 v) { for (int r = 0; r < 4; ++r) if (!(fabsf(v[r]) < 1e4f)) v[r] = 0.f; return pack4(v); }
__device__ __forceinline__ f32x4 unpack4(const uint2 u) { f32x4 r; r[0] = __uint_as_float(u.x << 16); r[1] = __uint_as_float(u.x & 0xffff0000u); r[2] = __uint_as_float(u.y << 16); r[3] = __uint_as_float(u.y & 0xffff0000u); return r; }

PHASE_FN void ph_gdn_chunk(const Params& p, float* smem) {
    int tid_ = threadIdx.x; asm volatile("" : "+v"(tid_)); const int tid = tid_, lane = tid & 63, wv = __builtin_amdgcn_readfirstlane(tid >> 6), q4 = lane >> 4, c16 = lane & 15;
    unsigned char* lds = g_smem;
    constexpr int SN = 272, ST = 144;
    unsigned char* bKN = lds;
    unsigned char* bQN = lds + 18432;
    unsigned char* bKBG = lds + 35840;
    unsigned char* bVB = lds + 54272;
    unsigned char* bKD = lds + 72704;
    unsigned char* bUT = lds + 91136;
    float* sL = (float*)(lds + 109568);
    unsigned char* bAQK = lds + 126208;
    unsigned char* bTB = lds + 135424;
    float* sG = (float*)(lds + 144640); float* sB = sG + 64; float* sEg = sB + 64;
    const float* QN = (const float*)(p.ws + OFF_QN); const float* KN = (const float*)(p.ws + OFF_KN); const float* VC = (const float*)(p.ws + OFF_VC);
    const float* BETA = (const float*)(p.ws + OFF_BETA); const float* G = (const float*)(p.ws + OFF_G);
    uint4* PFR = (uint4*)(p.ws + OFF_PFR); uint4* RFR = (uint4*)(p.ws + OFF_RFR); uint2* QFR = (uint2*)(p.ws + OFF_QFR); uint2* OFR = (uint2*)(p.ws + OFF_OFR);
    float* GL = (float*)(p.ws + OFF_GL);
    for (int ci = blockIdx.x; ci < 1024; ci += gridDim.x) {
        const int b = ci >> 9, h = (ci >> 7) & 3, n = ci & 127;
        const int t0 = b * 8192 + n * 64;
        __syncthreads();
        if (tid < 64) { float g = G[(t0 + tid) * 4 + h];
#pragma unroll
            for (int o = 1; o < 64; o <<= 1) { const float nb = __shfl_up(g, o); if (lane >= o) g += nb; }
            sG[tid] = g; sB[tid] = BETA[(t0 + tid) * 4 + h]; sEg[tid] = expf(g); }
        for (int e = tid; e < 64 * 36; e += NTHREADS) ((unsigned*)bAQK)[e] = 0u;
        __syncthreads();
        const float gl = sG[63];
        for (int e = tid; e < 8192; e += NTHREADS) {
            const int i = e >> 7, d = e & 127;
            const float kf = KN[(size_t)(t0 + i) * 512 + h * 128 + d], qf = QN[(size_t)(t0 + i) * 512 + h * 128 + d], vf = VC[(size_t)(t0 + i) * 512 + h * 128 + d];
            const float be = sB[i];
            *(bf16_t*)(bKN + i * SN + d * 2) = f2bf(kf);
            *(bf16_t*)(bQN + i * SN + d * 2) = f2bf(qf);
            *(bf16_t*)(bKBG + d * ST + i * 2) = f2bf(kf * be * sEg[i]);
            *(bf16_t*)(bVB + d * ST + i * 2) = f2bf(vf * be);
            *(bf16_t*)(bKD + d * ST + i * 2) = f2bf(kf * expf(gl - sG[i]));
        }
        __syncthreads();
        for (int u = wv; u < 20; u += 8) {
            const int kind = (u >= 10) ? 1 : 0, idx = u - kind * 10;
            const int ti = (idx >= 6) ? 3 : (idx >= 3) ? 2 : (idx >= 1) ? 1 : 0, tj = idx - ((ti * (ti + 1)) >> 1);
            f32x4 acc = (f32x4){0.f, 0.f, 0.f, 0.f};
            acc = mma_lds(kind ? bQN : bKN, SN, 16 * ti, bKN, SN, 16 * tj, 128, acc, c16, q4);
            const int j = 16 * tj + c16;
#pragma unroll
            for (int r = 0; r < 4; ++r) { const int i = 16 * ti + 4 * q4 + r;
                const float dec = (j <= i) ? expf(sG[i] - sG[j]) : 0.f;
                if (kind == 0) sL[i * 65 + j] = (j < i) ? sB[i] * acc[r] * dec : 0.f;
                else *(bf16_t*)(bAQK + i * ST + j * 2) = f2bf(acc[r] * SCALE128 * dec); }
        }
        __syncthreads();
        if (wv == 0) {
            float t[64];
            int zz = 0; asm volatile("" : "+v"(zz)); const float* sLo = sL + zz;
#pragma unroll
            for (int i = 0; i < 64; ++i) { float a = (i == lane) ? 1.f : 0.f;
#pragma unroll
                for (int j = 0; j < i; ++j) a -= sLo[i * 65 + j] * t[j];
                t[i] = a; asm volatile("" ::: "memory"); }
#pragma unroll
            for (int i = 0; i < 64; ++i) *(bf16_t*)(bTB + i * ST + lane * 2) = f2bf(t[i]);
        }
        __syncthreads();
        for (int x = 0; x < 8; ++x) {
            const int u = wv * 8 + x, kind = u >> 5, ti = (u >> 3) & 3, td = u & 7;
            f32x4 acc = (f32x4){0.f, 0.f, 0.f, 0.f};
            acc = mma_lds(bTB, ST, 16 * ti, kind ? bVB : bKBG, ST, 16 * td, 64, acc, c16, q4);
            *(uint2*)((kind ? bUT : bKN) + (16 * td + c16) * ST + (16 * ti + 4 * q4) * 2) = pack4(acc);
        }
        __syncthreads();
        unsigned char* bWT = bKN;
        const float eg = expf(gl);
        for (int x = 0; x < 4; ++x) {
            const int u = wv * 4 + x, ti = u >> 2, a = u & 3;
            uint4 fr;
#pragma unroll
            for (int hf = 0; hf < 2; ++hf) { const int tk = 2 * a + hf;
                f32x4 acc = (f32x4){0.f, 0.f, 0.f, 0.f};
                acc = mma_lds(bWT, ST, 16 * tk, bKD, ST, 16 * ti, 64, acc, c16, q4);
                f32x4 v;
#pragma unroll
                for (int r = 0; r < 4; ++r) v[r] = ((16 * tk + 4 * q4 + r) == (16 * ti + c16) ? eg : 0.f) - acc[r];
                const uint2 pk = pack4(v);
                if (hf == 0) { fr.x = pk.x; fr.y = pk.y; } else { fr.z = pk.x; fr.w = pk.y; } }
            PFR[((size_t)(ci * 8 + ti) * 4 + a) * 64 + lane] = fr;
        }
        for (int x = 0; x < 2; ++x) {
            const int u = wv * 2 + x, ti = u >> 2, a = u & 3;
            uint4 fr;
            const int i = 16 * ti + c16;
            const float qs = SCALE128 * sEg[i];
#pragma unroll
            for (int hf = 0; hf < 2; ++hf) { const int tk = 2 * a + hf;
                f32x4 acc = (f32x4){0.f, 0.f, 0.f, 0.f};
                acc = mma_lds(bWT, ST, 16 * tk, bAQK, ST, 16 * ti, 64, acc, c16, q4);
                const f32x4 qv = unpack4(*(const uint2*)(bQN + i * SN + (16 * tk + 4 * q4) * 2));
                const uint2 pk = pack4(qv * qs - acc);
                if (hf == 0) { fr.x = pk.x; fr.y = pk.y; } else { fr.z = pk.x; fr.w = pk.y; } }
            RFR[((size_t)(ci * 4 + ti) * 4 + a) * 64 + lane] = fr;
        }
        for (int x = 0; x < 8; ++x) {
            const int u = wv * 8 + x, tdv = u >> 3, tdk = u & 7;
            f32x4 acc = (f32x4){0.f, 0.f, 0.f, 0.f};
            acc = mma_lds(bKD, ST, 16 * tdk, bUT, ST, 16 * tdv, 64, acc, c16, q4);
            QFR[((size_t)(ci * 8 + tdv) * 8 + tdk) * 64 + lane] = pack4(acc);
        }
        for (int x = 0; x < 4; ++x) {
            const int u = wv * 4 + x, tdv = u >> 2, ti = u & 3;
            f32x4 acc = (f32x4){0.f, 0.f, 0.f, 0.f};
            if (PROBE_CONST == 2) acc = mma_lds(bTB, ST, 16 * ti, bTB, ST, 16 * (tdv & 3), 64, acc, c16, q4); else if (PROBE_CONST == 3) acc = mma_lds(bAQK, ST, 16 * ti, bAQK, ST, 16 * (tdv & 3), 64, acc, c16, q4); else if (PROBE_CONST == 4) acc = mma_lds(bUT, ST, 16 * ti, bUT, ST, 16 * tdv, 64, acc, c16, q4); else if (PROBE_CONST == 5) acc = mma_lds(bVB, ST, 16 * ti, bVB, ST, 16 * tdv, 64, acc, c16, q4); else if (PROBE_CONST == 6) { acc = mma_lds(bTB, ST, 16 * ti, bVB, ST, 16 * tdv, 64, acc, c16, q4); for (int r = 0; r < 4; ++r) acc[r] = (fabsf(acc[r]) < 100.f) ? 1.f : __builtin_nanf(""); } else if (PROBE_CONST == 7) { acc = unpack4(*(const uint2*)(bUT + (16 * tdv + c16) * ST + (16 * ti + 4 * q4) * 2)); for (int r = 0; r < 4; ++r) acc[r] = (fabsf(acc[r]) < 100.f) ? 1.f : __builtin_nanf(""); } else acc = mma_lds(bAQK, ST, 16 * ti, bUT, ST, 16 * tdv, 64, acc, c16, q4);
            OFR[((size_t)(ci * 8 + tdv) * 4 + ti) * 64 + lane] = (PROBE_CONST == 1) ? pack4((f32x4){0.5f, 0.5f, 0.5f, 0.5f}) : (PROBE_CONST >= 2) ? pack4s((f32x4){0.5f, 0.5f, 0.5f, 0.5f} + acc * 0.f) : pack4(acc);
        }
        if (tid == 0) GL[ci] = gl;
    }
}

__device__ __forceinline__ void gs_load(uint4 (&d)[12], const unsigned char* pp, const unsigned char* rr, const unsigned char* qq, const unsigned char* oo, const int lt) {
#pragma unroll
    for (int i = 0; i < 6; ++i) { int c = lt + 384 * i; c = c < 2048 ? c : 2047; d[i] = *(const uint4*)(pp + c * 16); }
#pragma unroll
    for (int i = 0; i < 3; ++i) { int c = lt + 384 * i; c = c < 1024 ? c : 1023; d[6 + i] = *(const uint4*)(rr + c * 16); }
#pragma unroll
    for (int i = 0; i < 2; ++i) { int c = lt + 384 * i; c = c < 512 ? c : 511; d[9 + i] = *(const uint4*)(qq + c * 16); }
    { const int c = lt < 256 ? lt : 255; d[11] = *(const uint4*)(oo + c * 16); }
}
__device__ __forceinline__ void gs_store(const uint4 (&d)[12], unsigned char* sb, const int lt) {
#pragma unroll
    for (int i = 0; i < 6; ++i) { const int c = lt + 384 * i; if (c < 2048) *(uint4*)(sb + c * 16) = d[i]; }
#pragma unroll
    for (int i = 0; i < 3; ++i) { const int c = lt + 384 * i; if (c < 1024) *(uint4*)(sb + 32768 + c * 16) = d[6 + i]; }
#pragma unroll
    for (int i = 0; i < 2; ++i) { const int c = lt + 384 * i; if (c < 512) *(uint4*)(sb + 49152 + c * 16) = d[9 + i]; }
    if (lt < 256) *(uint4*)(sb + 57344 + lt * 16) = d[11];
}

#define SCAN_BODY                 bf16x8 Sb[4]; \
_Pragma("unroll") \
                for (int a = 0; a < 4; ++a) { union { uint4 u; bf16x8 v; } cv; const uint2 lo = pack4(S[2 * a]), hi = pack4(S[2 * a + 1]); cv.u.x = lo.x; cv.u.y = lo.y; cv.u.z = hi.x; cv.u.w = hi.y; Sb[a] = cv.v; } \
                const int t0 = b * 8192 + n * 64; \
                {   f32x4 oa[4]; \
_Pragma("unroll") \
                    for (int ti = 0; ti < 4; ++ti) oa[ti] = unpack4(*(const uint2*)(Of + ti * 512)); \
_Pragma("unroll") \
                    for (int a = 0; a < 4; ++a) \
_Pragma("unroll") \
                        for (int ti = 0; ti < 4; ++ti) { if (PROBE_NOR == 0) oa[ti] = __builtin_amdgcn_mfma_f32_16x16x32_bf16(*(const bf16x8*)(Rf + (ti * 4 + a) * 1024), Sb[a], oa[ti], 0, 0, 0); } \
_Pragma("unroll") \
                    for (int ti = 0; ti < 4; ++ti) { \
                        float* op = O + (size_t)(t0 + 16 * ti + 4 * q4) * 1024 + h * 128 + 16 * tdv + c16; \
                        op[0] = oa[ti][0]; op[1024] = oa[ti][1]; op[2048] = oa[ti][2]; op[3072] = oa[ti][3]; } \
                } \
                asm volatile("" ::: "memory"); \
_Pragma("unroll") \
                for (int g = 0; g < 2; ++g) { \
                    f32x4 sa[4]; \
_Pragma("unroll") \
                    for (int t = 0; t < 4; ++t) sa[t] = unpack4(*(const uint2*)(Qf + (g * 4 + t) * 512)); \
_Pragma("unroll") \
                    for (int a = 0; a < 4; ++a) \
_Pragma("unroll") \
                        for (int t = 0; t < 4; ++t) { if (PROBE_NOP == 0) sa[t] = __builtin_amdgcn_mfma_f32_16x16x32_bf16(*(const bf16x8*)(Pf + ((g * 4 + t) * 4 + a) * 1024), Sb[a], sa[t], 0, 0, 0); } \
_Pragma("unroll") \
                    for (int t = 0; t < 4; ++t) S[g * 4 + t] = sa[t]; \
                    asm volatile("" ::: "memory"); \
                }
PHASE_FN void ph_gdn_scan(const Params& p, float* smem) {
    int tid_ = threadIdx.x; asm volatile("" : "+v"(tid_)); const int tid = tid_, lane = tid & 63, wv = __builtin_amdgcn_readfirstlane(tid >> 6), q4 = lane >> 4, c16 = lane & 15;
    unsigned char* lds = g_smem;
    constexpr int STG = 61440;
    const unsigned char* PFR = p.ws + OFF_PFR; const unsigned char* RFR = p.ws + OFF_RFR; const unsigned char* QFR = p.ws + OFF_QFR; const unsigned char* OFR = p.ws + OFF_OFR;
    float* O = (float*)(p.ws + OFF_O);
    for (int it = blockIdx.x; it < 32; it += gridDim.x) {
        const int bh = it >> 2, pair = it & 3, b = bh >> 2, h = bh & 3;
        __syncthreads();
        if (SCAN_DIRECT) { if (wv < 2) {
            const int tdv = pair * 2 + wv;
            f32x4 S[8];
#pragma unroll
            for (int t = 0; t < 8; ++t) S[t] = (f32x4){0.f, 0.f, 0.f, 0.f};
            for (int n = 0; n < 128; ++n) {
                const int ci = bh * 128 + n;
                const unsigned char* Pf = PFR + (size_t)ci * 32768 + lane * 16, *Rf = RFR + (size_t)ci * 16384 + lane * 16;
                const unsigned char* Qf = QFR + (size_t)ci * 32768 + tdv * 4096 + lane * 8, *Of = OFR + (size_t)ci * 16384 + tdv * 2048 + lane * 8;
                SCAN_BODY
            } }
        } else if (wv >= 2) {
            const int lt = tid - 128;
            const unsigned char* Pb = PFR + (size_t)bh * 128 * 32768;
            const unsigned char* Rb = RFR + (size_t)bh * 128 * 16384;
            const unsigned char* Qb = QFR + (size_t)bh * 128 * 32768 + pair * 8192;
            const unsigned char* Ob = OFR + (size_t)bh * 128 * 16384 + pair * 4096;
            uint4 ra0, ra1, ra2, ra3, ra4, ra5, ra6, ra7, ra8, ra9, ra10, ra11, rb0, rb1, rb2, rb3, rb4, rb5, rb6, rb7, rb8, rb9, rb10, rb11;
#define LDC(base_, c_, mx_) (*(const uint4*)((base_) + (size_t)(((c_) < (mx_)) ? (c_) : (mx_)) * 16))
#define GS_LOAD(X, n_) do { const unsigned char* pp_ = Pb + (size_t)(n_) * 32768; const unsigned char* rr_ = Rb + (size_t)(n_) * 16384; \
                const unsigned char* qq_ = Qb + (size_t)(n_) * 32768; const unsigned char* oo_ = Ob + (size_t)(n_) * 16384; \
                X##0 = LDC(pp_, lt, 2047); X##1 = LDC(pp_, lt + 384, 2047); X##2 = LDC(pp_, lt + 768, 2047); X##3 = LDC(pp_, lt + 1152, 2047); X##4 = LDC(pp_, lt + 1536, 2047); X##5 = LDC(pp_, lt + 1920, 2047); \
                X##6 = LDC(rr_, lt, 1023); X##7 = LDC(rr_, lt + 384, 1023); X##8 = LDC(rr_, lt + 768, 1023); \
                X##9 = LDC(qq_, lt, 511); X##10 = LDC(qq_, lt + 384, 511); X##11 = LDC(oo_, lt, 255); } while (0)
#define STC(off_, c_, lim_, v_) do { if ((c_) < (lim_)) *(uint4*)(sb_ + (off_) + (c_) * 16) = v_; } while (0)
#define GS_STORE(X, st_) do { unsigned char* sb_ = lds + (st_) * STG; \
                STC(0, lt, 2048, X##0); STC(0, lt + 384, 2048, X##1); STC(0, lt + 768, 2048, X##2); STC(0, lt + 1152, 2048, X##3); STC(0, lt + 1536, 2048, X##4); STC(0, lt + 1920, 2048, X##5); \
                STC(32768, lt, 1024, X##6); STC(32768, lt + 384, 1024, X##7); STC(32768, lt + 768, 1024, X##8); \
                STC(49152, lt, 512, X##9); STC(49152, lt + 384, 512, X##10); STC(57344, lt, 256, X##11); } while (0)
            GS_LOAD(ra, 0); GS_STORE(ra, 0);
            GS_LOAD(rb, 1); GS_LOAD(ra, 2);
            __syncthreads();
            for (int n = 0; n < 128; n += 2) {
                GS_STORE(rb, 1);
                GS_LOAD(rb, (n + 3 < 128) ? n + 3 : 127);
                __syncthreads();
                if (n + 2 < 128) GS_STORE(ra, 0);
                GS_LOAD(ra, (n + 4 < 128) ? n + 4 : 127);
                __syncthreads();
            }
        } else {
            const int tdv = pair * 2 + wv;
            f32x4 S[8];
#pragma unroll
            for (int t = 0; t < 8; ++t) S[t] = (f32x4){0.f, 0.f, 0.f, 0.f};
            __syncthreads();
            for (int n = 0; n < 128; ++n) {
                const unsigned char* base = lds + (n & 1) * STG;
                const unsigned char* Pf = base + lane * 16, *Rf = base + 32768 + lane * 16;
                const unsigned char* Qf = base + 49152 + wv * 4096 + lane * 8, *Of = base + 57344 + wv * 2048 + lane * 8;
                SCAN_BODY
                __syncthreads();
            }
        }
    }
}

__device__ __forceinline__ void block_sum4(int (&v)[4], int* buf) {
    const int lane = threadIdx.x & 63, wv = threadIdx.x >> 6;
#pragma unroll
    for (int q = 0; q < 4; ++q) v[q] = wave_sum_i(v[q]);
    if (lane == 0) {
#pragma unroll
        for (int q = 0; q < 4; ++q) buf[wv * 4 + q] = v[q];
    }
    __syncthreads();
#pragma unroll
    for (int q = 0; q < 4; ++q) { int a = 0; for (int w = 0; w < 8; ++w) a += buf[w * 4 + q]; v[q] = a; }
}

PHASE_FN void ph_dsa_topk(const Params& p, float* smem) {
    int tid_ = threadIdx.x; asm volatile("" : "+v"(tid_)); const int tid = tid_, lane = tid & 63, wv = __builtin_amdgcn_readfirstlane(tid >> 6), q4 = lane >> 4, c16 = lane & 15;
    int* sRed = (int*)g_smem;
    const bf16_t* QIb = (const bf16_t*)(p.ws + OFF_QIB); const bf16_t* KIb = (const bf16_t*)(p.ws + OFF_KIB); const float* WI = (const float*)(p.ws + OFF_WI);
    unsigned short* M16 = (unsigned short*)(p.ws + OFF_M16);
    for (int it = blockIdx.x; it < 4096; it += gridDim.x) {
        const int k = it >> 8, j = (it & 255) >> 1, b = it & 1;
        const int grp = (k & 1) ? 2047 - ((k >> 1) * 128 + j) : (k >> 1) * 128 + j;
        const int s0 = grp * 4, t0 = b * 8192 + s0;
        const int ntiles = (s0 >> 4) + 1;
        const int nreg = (ntiles > wv) ? ((ntiles - wv + 7) >> 3) : 0;
        const bf16x8 a0 = *(const bf16x8*)(QIb + (size_t)(t0 + (c16 >> 2)) * 256 + (c16 & 3) * 64 + 8 * q4);
        const bf16x8 a1 = *(const bf16x8*)(QIb + (size_t)(t0 + (c16 >> 2)) * 256 + (c16 & 3) * 64 + 32 + 8 * q4);
        const float4 wq = *(const float4*)(WI + (size_t)(t0 + q4) * 4);
        const int myq = s0 + q4;
        int c16s = c16; asm volatile("" : "+v"(c16s));
        unsigned keys[64];
#pragma unroll
        for (int i = 0; i < 64; ++i) keys[i] = 0u;
#pragma unroll
        for (int blk = 0; blk < 4; ++blk) if (nreg > blk * 16) {
#pragma unroll
            for (int ii = 0; ii < 16; ++ii) { const int i = blk * 16 + ii, tile = wv + 8 * i;
                if (tile < ntiles) {
                    const bf16_t* kp = KIb + (size_t)(b * 8192 + tile * 16 + c16s) * 64 + 8 * q4;
                    const bf16x8 k0 = *(const bf16x8*)kp, k1 = *(const bf16x8*)(kp + 32);
                    f32x4 acc = (f32x4){0.f, 0.f, 0.f, 0.f};
                    acc = __builtin_amdgcn_mfma_f32_16x16x32_bf16(a0, k0, acc, 0, 0, 0);
                    acc = __builtin_amdgcn_mfma_f32_16x16x32_bf16(a1, k1, acc, 0, 0, 0);
                    float sc = 0.f;
                    sc += wq.x * fmaxf(acc[0], 0.f); sc += wq.y * fmaxf(acc[1], 0.f); sc += wq.z * fmaxf(acc[2], 0.f); sc += wq.w * fmaxf(acc[3], 0.f);
                    keys[i] = (tile * 16 + c16s <= myq) ? ordkey(sc) : 0u;
                }
                if ((ii & 3) == 3) asm volatile("" ::: "memory"); }
        }
        const int keff = (myq + 1 < 256) ? (myq + 1) : 256;
        int par = 0;
        auto qsum = [&](int c) -> int {
            c += __shfl_xor(c, 1); c += __shfl_xor(c, 2); c += __shfl_xor(c, 4); c += __shfl_xor(c, 8);
            par ^= 1;
            if (c16 == 0) sRed[par * 32 + wv * 4 + q4] = c;
            __syncthreads();
            int a = 0;
#pragma unroll
            for (int w = 0; w < 8; ++w) a += sRed[par * 32 + w * 4 + q4];
            return a;
        };
        unsigned U = 0u;
        for (int bit = 31; bit >= 0; --bit) {
            const unsigned cand = U | (1u << bit);
            int c = 0;
#pragma unroll
            for (int blk = 0; blk < 4; ++blk) if (nreg > blk * 16) {
#pragma unroll
                for (int ii = 0; ii < 16; ++ii) c += (keys[blk * 16 + ii] >= cand) ? 1 : 0;
            }
            if (qsum(c) >= keff) U = cand;
        }
        int cg = 0, ce = 0;
#pragma unroll
        for (int i = 0; i < 64; ++i) { cg += (keys[i] > U) ? 1 : 0; ce += (keys[i] == U) ? 1 : 0; }
        cg = qsum(cg); ce = qsum(ce);
        const int need = keff - cg;
        int J = 8191;
        par ^= 1;
        if (c16 == 0) sRed[par * 32 + wv * 4 + q4] = (ce > need) ? 1 : 0;
        __syncthreads();
        int anyov = 0;
#pragma unroll
        for (int w = 0; w < 32; ++w) anyov |= sRed[par * 32 + w];
        if (anyov) {
            J = 0;
            int c16j = c16; asm volatile("" : "+v"(c16j));
            for (int bit = 12; bit >= 0; --bit) {
                const int cj = J | (1 << bit);
                int c = 0;
#pragma unroll
                for (int i = 0; i < 64; ++i) c += (keys[i] == U && ((wv + 8 * i) * 16 + c16j) < cj) ? 1 : 0;
                if (qsum(c) <= need - 1) J = cj;
            }
        }
        int c16e = c16; asm volatile("" : "+v"(c16e));
#pragma unroll
        for (int i = 0; i < 64; ++i) {
            const int tile = wv + 8 * i;
            const bool sel = keys[i] > U || (keys[i] == U && (tile * 16 + c16e) <= J);
            const unsigned long long bal = __ballot(sel);
            if (c16 == 0) M16[(size_t)(t0 + q4) * 512 + tile] = (unsigned short)((bal >> (16 * q4)) & 0xffffull);
        }
    }
}

PHASE_FN void ph_dsa_attn(const Params& p, float* smem) {
    int tid_ = threadIdx.x; asm volatile("" : "+v"(tid_)); const int tid = tid_, lane = tid & 63, wv = tid >> 6, q4 = lane >> 4, c16 = lane & 15;
    unsigned char* lds = g_smem;
    const bf16_t* QBb = (const bf16_t*)(p.ws + OFF_QBB); const bf16_t* KBb = (const bf16_t*)(p.ws + OFF_KBB); const bf16_t* VT = (const bf16_t*)(p.ws + OFF_VT);
    const unsigned short* M16 = (const unsigned short*)(p.ws + OFF_M16);
    float* O = (float*)(p.ws + OFF_O);
    const float SC = SCALE128 * 1.4426950408889634f;
    for (int it = blockIdx.x; it < 256; it += gridDim.x) {
        const int bh = it & 7, jp = it >> 3, b = bh >> 2, h = bh & 3;
        for (int half = 0; half < 2; ++half) {
            const int jq = half ? jp : 63 - jp;
            const int qs = jq * 128, nkt = 2 * jq + 2;
            const int tq = b * 8192 + qs + wv * 16 + c16;
            bf16x8 qf[4];
#pragma unroll
            for (int a = 0; a < 4; ++a) qf[a] = *(const bf16x8*)(QBb + (size_t)tq * 512 + h * 128 + 8 * q4 + 32 * a);
            float m = -1e30f, lsum = 0.f;
            f32x4 oacc[8];
#pragma unroll
            for (int t = 0; t < 8; ++t) oacc[t] = (f32x4){0.f, 0.f, 0.f, 0.f};
            uint4 rk0, rk1, rv0, rv1;
            const int q0 = tid, q1 = tid + 512;
            const bf16_t* kg0 = KBb + (size_t)(b * 8192 + (q0 >> 4)) * 512 + h * 128 + (q0 & 15) * 8;
            const bf16_t* kg1 = KBb + (size_t)(b * 8192 + (q1 >> 4)) * 512 + h * 128 + (q1 & 15) * 8;
            const bf16_t* vg0 = VT + ((size_t)((b * 4 + h) * 128 + (q0 >> 3))) * 8192 + (q0 & 7) * 8;
            const bf16_t* vg1 = VT + ((size_t)((b * 4 + h) * 128 + (q1 >> 3))) * 8192 + (q1 & 7) * 8;
            const int lk0 = (q0 >> 4) * 256 + ((((q0 & 15)) ^ ((q0 >> 4) & 15)) << 4), lk1 = (q1 >> 4) * 256 + ((((q1 & 15)) ^ ((q1 >> 4) & 15)) << 4);
            const int lv0 = 16384 + (q0 >> 3) * 128 + ((((q0 & 7)) ^ ((q0 >> 3) & 7)) << 4), lv1 = 16384 + (q1 >> 3) * 128 + ((((q1 & 7)) ^ ((q1 >> 3) & 7)) << 4);
#define ATT_GLOAD(kt_) do { rk0 = *(const uint4*)(kg0 + (size_t)(kt_) * 64 * 512); rk1 = *(const uint4*)(kg1 + (size_t)(kt_) * 64 * 512); \
                            rv0 = *(const uint4*)(vg0 + (kt_) * 64); rv1 = *(const uint4*)(vg1 + (kt_) * 64); } while (0)
#define ATT_LSTORE(st_) do { unsigned char* base_ = lds + (st_) * 32768; *(uint4*)(base_ + lk0) = rk0; *(uint4*)(base_ + lk1) = rk1; *(uint4*)(base_ + lv0) = rv0; *(uint4*)(base_ + lv1) = rv1; } while (0)
            __syncthreads();
            ATT_GLOAD(0); ATT_LSTORE(0);
            __syncthreads();
            for (int kt = 0; kt < nkt; ++kt) {
                if (kt + 1 < nkt) ATT_GLOAD(kt + 1);
                const unsigned long long mbits = *(const unsigned long long*)(M16 + (size_t)tq * 512 + 4 * kt);
                const unsigned char* Kt = lds + (kt & 1) * 32768;
                const unsigned char* Vt = Kt + 16384;
                f32x4 sacc[4];
#pragma unroll
                for (int ti = 0; ti < 4; ++ti) { sacc[ti] = (f32x4){0.f, 0.f, 0.f, 0.f};
                    const int row = 16 * ti + c16;
#pragma unroll
                    for (int a = 0; a < 4; ++a) { const bf16x8 kf = *(const bf16x8*)(Kt + row * 256 + ((((q4 + 4 * a)) ^ (row & 15)) << 4));
                        sacc[ti] = __builtin_amdgcn_mfma_f32_16x16x32_bf16(kf, qf[a], sacc[ti], 0, 0, 0); } }
                float mx = m;
#pragma unroll
                for (int ti = 0; ti < 4; ++ti)
#pragma unroll
                    for (int r = 0; r < 4; ++r) { const bool valid = (mbits >> (16 * ti + 4 * q4 + r)) & 1ull; const float v = sacc[ti][r] * SC; sacc[ti][r] = v; mx = fmaxf(mx, valid ? v : -1e30f); }
                mx = fmaxf(mx, __shfl_xor(mx, 16)); mx = fmaxf(mx, __shfl_xor(mx, 32));
                const float alpha = __builtin_amdgcn_exp2f(m - mx); m = mx;
                float ps = 0.f;
#pragma unroll
                for (int ti = 0; ti < 4; ++ti)
#pragma unroll
                    for (int r = 0; r < 4; ++r) { const bool valid = (mbits >> (16 * ti + 4 * q4 + r)) & 1ull; const float pv = valid ? __builtin_amdgcn_exp2f(sacc[ti][r] - mx) : 0.f; sacc[ti][r] = pv; ps += pv; }
                lsum = lsum * alpha + ps;
#pragma unroll
                for (int t = 0; t < 8; ++t) oacc[t] = oacc[t] * alpha;
                bf16x8 pb[2];
#pragma unroll
                for (int a = 0; a < 2; ++a) {
                    union { uint4 u; bf16x8 v; } cv;
                    cv.u.x = cvt_pk_bf16(sacc[2 * a][0], sacc[2 * a][1]); cv.u.y = cvt_pk_bf16(sacc[2 * a][2], sacc[2 * a][3]);
                    cv.u.z = cvt_pk_bf16(sacc[2 * a + 1][0], sacc[2 * a + 1][1]); cv.u.w = cvt_pk_bf16(sacc[2 * a + 1][2], sacc[2 * a + 1][3]);
                    pb[a] = cv.v; }
#pragma unroll
                for (int t = 0; t < 8; ++t) { const int row = 16 * t + c16;
#pragma unroll
                    for (int a = 0; a < 2; ++a) {
                        union { uint2 h2[2]; bf16x8 v; } vf;
                        vf.h2[0] = *(const uint2*)(Vt + row * 128 + ((((4 * a + (q4 >> 1))) ^ (row & 7)) << 4) + 8 * (q4 & 1));
                        vf.h2[1] = *(const uint2*)(Vt + row * 128 + ((((4 * a + 2 + (q4 >> 1))) ^ (row & 7)) << 4) + 8 * (q4 & 1));
                        oacc[t] = __builtin_amdgcn_mfma_f32_16x16x32_bf16(vf.v, pb[a], oacc[t], 0, 0, 0); } }
                if (kt + 1 < nkt) ATT_LSTORE((kt + 1) & 1);
                __syncthreads();
            }
            lsum += __shfl_xor(lsum, 16); lsum += __shfl_xor(lsum, 32);
            const float inv = 1.f / lsum;
#pragma unroll
            for (int t = 0; t < 8; ++t) *(f32x4*)(O + (size_t)tq * 1024 + 512 + h * 128 + 16 * t + 4 * q4) = oacc[t] * inv;
        }
    }
}

PHASE_FN void ph_gdn_out(const Params& p, int layer) {
    int tid_ = threadIdx.x; asm volatile("" : "+v"(tid_)); const int tid = tid_, lane = tid & 63, wv = tid >> 6;
    float* O = (float*)(p.ws + OFF_O); const float* P = (const float*)(p.ws + OFF_P);
    const float* onw = p.gdn_out_norm + (layer >> 1) * 128;
    for (int t = blockIdx.x * 8 + wv; t < NT; t += gridDim.x * 8) {
#pragma unroll
        for (int h = 0; h < 4; ++h) {
            float* op = O + (size_t)t * 1024 + h * 128;
            const float o0 = op[lane], o1 = op[64 + lane];
            const float ss = wave_sum(o0 * o0 + o1 * o1);
            const float r = rsqrtf(ss * (1.f / 128.f) + EPS);
            const float z0 = P[(size_t)t * LDP + 1536 + h * 128 + lane], z1 = P[(size_t)t * LDP + 1536 + h * 128 + 64 + lane];
            op[lane] = o0 * r * onw[lane] * siluf_(z0); op[64 + lane] = o1 * r * onw[64 + lane] * siluf_(z1);
        }
    }
}

PHASE_FN void ph_gemm_out(const Params& p, int layer, float* smem) {
    smem = (float*)g_smem;
    const bf16_t* Wt = (const bf16_t*)(p.ws + OFF_WOUT) + (size_t)layer * 1024 * 1024;
    const float* MOD = (const float*)(p.ws + OFF_MOD);
    const float* O = (const float*)(p.ws + OFF_O);
    for (int tile = blockIdx.x; tile < 64 * 8; tile += gridDim.x) {
        const int mt = tile % 64, nt = tile / 64;
        const float* Ab = O + (size_t)mt * 256 * 1024;
        const bf16_t* Bb = Wt + (size_t)nt * 128 * 1024;
        const int b = (mt * 256) >> 13;
        const float* gt = MOD + (size_t)(layer * 2 + b) * 6144 + 2048 + nt * 128;
        float* Xt = p.X + (size_t)mt * 256 * ND + nt * 128;
        gemm_tile_bf16(1024, (unsigned char*)smem,
            [=](int i, int r, int k) -> uint4 { const float* sp = Ab + (size_t)r * 1024 + k; return pack8(*(const float4*)sp, *(const float4*)(sp + 4)); },
            [=](int i, int r, int k) -> uint4 { return *(const uint4*)(Bb + (size_t)r * 1024 + k); },
            [=](const f32x4 (&acc)[4][4], int wm, int wn, int lane) {
#pragma unroll
                for (int mi = 0; mi < 4; ++mi)
#pragma unroll
                    for (int ni = 0; ni < 4; ++ni) {
                        const int m = wm * 64 + mi * 16 + (lane & 15), n = wn * 64 + ni * 16 + 4 * (lane >> 4);
                        const f32x4 g = *(const f32x4*)(gt + n);
                        f32x4* xp = (f32x4*)(Xt + (size_t)m * ND + n);
                        *xp = *xp + g * acc[mi][ni];
                    }
            });
    }
}

PHASE_FN void ph_norm_ffn(const Params& p, int layer) {
    int tid_ = threadIdx.x; asm volatile("" : "+v"(tid_)); const int tid = tid_, lane = tid & 63, wv = tid >> 6;
    const float* MOD = (const float*)(p.ws + OFF_MOD);
    float* H = (float*)(p.ws + OFF_H);
    int* CNT = (int*)(p.ws + OFF_CNT) + layer * 32 * CSTR;
    int* sCnt = (int*)g_smem; int* sBase = sCnt + 32; int* sE = sBase + 32; int* sR = sE + 256;
    const int nrb = (NT + (int)gridDim.x - 1) / (int)gridDim.x, row_lo = blockIdx.x * nrb, row_hi = (row_lo + nrb < NT) ? row_lo + nrb : NT;
    __syncthreads();
    if (tid < 32) sCnt[tid] = 0;
    __syncthreads();
    int* ASG = (int*)(p.ws + OFF_ASG); float* GATE = (float*)(p.ws + OFF_GATE); int* LIST = (int*)(p.ws + OFF_LIST);
    const float* nw = p.norm_ffn + layer * 1024;
    const float* wg = p.rg_w + (size_t)layer * 1024 * 4;
    for (int row = row_lo + wv; row < row_hi; row += 8) {
        const int b = row >> 13;
        const float* xr = p.X + (size_t)row * ND;
        const float* sh = MOD + (size_t)(layer * 2 + b) * 6144 + 3072;
        const float* sc = sh + 1024;
        float hv[16]; float ss = 0.f;
#pragma unroll
        for (int j = 0; j < 4; ++j) { const float4 v = *(const float4*)(xr + j * 256 + lane * 4); hv[4 * j] = v.x; hv[4 * j + 1] = v.y; hv[4 * j + 2] = v.z; hv[4 * j + 3] = v.w; }
#pragma unroll
        for (int j = 0; j < 16; ++j) ss += hv[j] * hv[j];
        ss = wave_sum(ss);
        const float rstd = rsqrtf(ss * (1.f / 1024.f) + EPS);
#pragma unroll
        for (int j = 0; j < 4; ++j) {
            const int col = j * 256 + lane * 4;
            const float4 w = *(const float4*)(nw + col), s4 = *(const float4*)(sc + col), h4 = *(const float4*)(sh + col);
            hv[4 * j] = hv[4 * j] * rstd * w.x * (1.f + s4.x) + h4.x; hv[4 * j + 1] = hv[4 * j + 1] * rstd * w.y * (1.f + s4.y) + h4.y;
            hv[4 * j + 2] = hv[4 * j + 2] * rstd * w.z * (1.f + s4.z) + h4.z; hv[4 * j + 3] = hv[4 * j + 3] * rstd * w.w * (1.f + s4.w) + h4.w;
            *(float4*)(H + (size_t)row * ND + col) = make_float4(hv[4 * j], hv[4 * j + 1], hv[4 * j + 2], hv[4 * j + 3]);
        }
        float gl[4] = {0.f, 0.f, 0.f, 0.f};
#pragma unroll
        for (int j = 0; j < 4; ++j)
#pragma unroll
            for (int e = 0; e < 4; ++e) { const int col = j * 256 + lane * 4 + e; const float4 w = *(const float4*)(wg + (size_t)col * 4); const float hh = hv[4 * j + e];
                gl[0] += hh * w.x; gl[1] += hh * w.y; gl[2] += hh * w.z; gl[3] += hh * w.w; }
#pragma unroll
        for (int g = 0; g < 4; ++g) gl[g] = wave_sum(gl[g]) + p.rg_b[layer * 4 + g];
        int gs = 0; float gm = gl[0];
#pragma unroll
        for (int g = 1; g < 4; ++g) if (gl[g] > gm) { gm = gl[g]; gs = g; }
        float gsum = 0.f;
#pragma unroll
        for (int g = 0; g < 4; ++g) gsum += expf(gl[g] - gm);
        const float ggate = 1.f / gsum;
        const float* we = p.re_w + ((size_t)(layer * 4 + gs) * 1024) * 8;
        float el[8] = {0.f, 0.f, 0.f, 0.f, 0.f, 0.f, 0.f, 0.f};
#pragma unroll
        for (int j = 0; j < 4; ++j)
#pragma unroll
            for (int e = 0; e < 4; ++e) { const int col = j * 256 + lane * 4 + e; const float4 w0 = *(const float4*)(we + (size_t)col * 8), w1 = *(const float4*)(we + (size_t)col * 8 + 4); const float hh = hv[4 * j + e];
                el[0] += hh * w0.x; el[1] += hh * w0.y; el[2] += hh * w0.z; el[3] += hh * w0.w; el[4] += hh * w1.x; el[5] += hh * w1.y; el[6] += hh * w1.z; el[7] += hh * w1.w; }
#pragma unroll
        for (int e = 0; e < 8; ++e) el[e] = wave_sum(el[e]) + p.re_b[(layer * 4 + gs) * 8 + e];
        int i1 = 0; float l1 = el[0];
#pragma unroll
        for (int e = 1; e < 8; ++e) if (el[e] > l1) { l1 = el[e]; i1 = e; }
        int i2 = -1; float l2 = -INFINITY;
#pragma unroll
        for (int e = 0; e < 8; ++e) if (e != i1 && el[e] > l2) { l2 = el[e]; i2 = e; }
        const float ex = expf(l2 - l1);
        const float p1 = 1.f / (1.f + ex), p2 = ex / (1.f + ex);
        if (lane == 0) {
            const int e1 = gs * 8 + i1, e2 = gs * 8 + i2, lr = row - row_lo;
            sE[lr * 2] = e1; sE[lr * 2 + 1] = e2;
            sR[lr * 2] = atomicAdd(&sCnt[e1], 1); sR[lr * 2 + 1] = atomicAdd(&sCnt[e2], 1);
            GATE[row * 2] = ggate * p1; GATE[row * 2 + 1] = ggate * p2;
        }
    }
    __syncthreads();
    if (tid < 32) sBase[tid] = (sCnt[tid] > 0) ? atomicAdd(&CNT[tid * CSTR], sCnt[tid]) : 0;
    __syncthreads();
    for (int a = tid; a < (row_hi - row_lo) * 2; a += NTHREADS) {
        const int row = row_lo + (a >> 1), e = sE[a], r = sBase[e] + sR[a];
        LIST[(size_t)e * LISTCAP + r] = row;
        ASG[row * 4 + (a & 1) * 2] = e; ASG[row * 4 + (a & 1) * 2 + 1] = r;
    }
}

PHASE_FN void ph_moe(const Params& p, int layer, int which, float* smem) {
    smem = (float*)g_smem;
    int tid_ = threadIdx.x; asm volatile("" : "+v"(tid_)); const int tid = tid_;
    int* sPad = (int*)(g_smem + 98304); int* sTs = sPad + 33;
    const int* CNT = (const int*)(p.ws + OFF_CNT) + layer * 32 * CSTR;
    __syncthreads();
    if (tid == 0) { int a = 0, ts = 0; for (int e = 0; e < 32; ++e) { sPad[e] = a; sTs[e] = ts; a += ((CNT[e * CSTR] + 127) / 128) * 128; ts += (CNT[e * CSTR] + 255) / 256; } sTs[32] = ts; sPad[32] = a; }
    __syncthreads();
    const int total = sTs[32] * 8;
    float* HID = (float*)(p.ws + OFF_HID); float* YB = (float*)(p.ws + OFF_YB);
    const float* H = (const float*)(p.ws + OFF_H);
    const int* LIST = (const int*)(p.ws + OFF_LIST);
    for (int tile = blockIdx.x; tile < total; tile += gridDim.x) {
        const int mt = tile >> 3, nt = tile & 7;
        int e = 0;
        for (int q = 1; q < 32; ++q) if (sTs[q] <= mt) e = q;
        const int mi0 = mt - sTs[e];
        const int cnt = CNT[e * CSTR];
        const int mvalid = (cnt - mi0 * 256 < 256) ? (cnt - mi0 * 256) : 256;
        const int rowbase = sPad[e] + mi0 * 256;
        if (which == 0) {
            long ro[4];
#pragma unroll
            for (int i = 0; i < 4; ++i) { const int r = (tid + 512 * i) >> 3; ro[i] = (r < mvalid) ? (long)LIST[(size_t)e * LISTCAP + mi0 * 256 + r] * 1024 : -1; }
            const long ro0 = ro[0], ro1 = ro[1], ro2 = ro[2], ro3 = ro[3];
            const bf16_t* Bb = (const bf16_t*)(p.ws + OFF_W13) + (size_t)e * 1024 * 1024 + (size_t)nt * 128 * 1024;
            float* Ht = HID + (size_t)rowbase * 512 + nt * 64;
            gemm_tile_bf16(1024, (unsigned char*)smem,
                [=](int i, int r, int k) -> uint4 { const long o = (i == 0) ? ro0 : (i == 1) ? ro1 : (i == 2) ? ro2 : ro3; if (o < 0) return make_uint4(0u, 0u, 0u, 0u);
                    const float* sp = H + o + k; return pack8(*(const float4*)sp, *(const float4*)(sp + 4)); },
                [=](int i, int r, int k) -> uint4 { return *(const uint4*)(Bb + (size_t)r * 1024 + k); },
                [=](const f32x4 (&acc)[4][4], int wm, int wn, int lane) {
#pragma unroll
                    for (int mi = 0; mi < 4; ++mi)
#pragma unroll
                        for (int ni = 0; ni < 2; ++ni) {
                            const int m = wm * 64 + mi * 16 + (lane & 15), n = wn * 32 + ni * 16 + 4 * (lane >> 4);
                            const f32x4 a1 = acc[mi][ni], a3 = acc[mi][ni + 2];
                            f32x4 hv; hv[0] = siluf_(a1[0]) * a3[0]; hv[1] = siluf_(a1[1]) * a3[1]; hv[2] = siluf_(a1[2]) * a3[2]; hv[3] = siluf_(a1[3]) * a3[3];
                            if (m < mvalid) *(f32x4*)(Ht + (size_t)m * 512 + n) = hv;
                        }
                });
        } else {
            const float* Ab = HID + (size_t)rowbase * 512;
            const bf16_t* Bb = (const bf16_t*)(p.ws + OFF_W2T) + (size_t)e * 1024 * 512 + (size_t)nt * 128 * 512;
            float* Yt = YB + (size_t)rowbase * 1024 + nt * 128;
            gemm_tile_bf16(512, (unsigned char*)smem,
                [=](int i, int r, int k) -> uint4 { if (r >= mvalid) return make_uint4(0u, 0u, 0u, 0u); const float* sp = Ab + (size_t)r * 512 + k; return pack8(*(const float4*)sp, *(const float4*)(sp + 4)); },
                [=](int i, int r, int k) -> uint4 { return *(const uint4*)(Bb + (size_t)r * 512 + k); },
                [=](const f32x4 (&acc)[4][4], int wm, int wn, int lane) {
#pragma unroll
                    for (int mi = 0; mi < 4; ++mi)
#pragma unroll
                        for (int ni = 0; ni < 4; ++ni) {
                            const int m = wm * 64 + mi * 16 + (lane & 15), n = wn * 64 + ni * 16 + 4 * (lane >> 4);
                            if (m < mvalid) *(f32x4*)(Yt + (size_t)m * 1024 + n) = acc[mi][ni];
                        }
                });
        }
    }
}

PHASE_FN void ph_conv_dense(const Params& p, float* smem) {
    smem = (float*)g_smem;
    for (int t = blockIdx.x; t < 1984 + 1600 + 1024; t += gridDim.x) {
        if (t < 1984) { const int l = t / 992, u = t % 992;
            convert_tile(p.even_w_in + (size_t)l * 1024 * 3916, nullptr, 0, 1024, 3916, 3916, (bf16_t*)(p.ws + OFF_WINE) + (size_t)l * 3968 * 1024, u >> 4, u & 15, smem); }
        else if (t < 3584) { const int v = t - 1984, l = v / 800, u = v % 800;
            convert_tile(p.gla_w_in + (size_t)l * 1024 * 3088, nullptr, 0, 1024, 3088, 3088, (bf16_t*)(p.ws + OFF_WINO) + (size_t)l * 3200 * 1024, u >> 4, u & 15, smem); }
        else { const int v = t - 3584, l = v >> 8, u = v & 255;
            convert_tile(((l & 1) ? p.gla_w_out : p.even_w_out) + (size_t)(l >> 1) * 1024 * 1024, nullptr, 0, 1024, 1024, 1024, (bf16_t*)(p.ws + OFF_WOUT) + (size_t)l * 1024 * 1024, u >> 4, u & 15, smem); }
    }
}

PHASE_FN void ph_conv_exp(const Params& p, int layer, float* smem) {
    smem = (float*)g_smem;
    for (int t = blockIdx.x; t < 8192 + 4096; t += gridDim.x) {
        if (t < 8192) { const int e = t >> 8, u = t & 255;
            convert_tile(p.w1 + (size_t)(layer * 32 + e) * 1024 * 512, p.w3 + (size_t)(layer * 32 + e) * 1024 * 512, 1, 1024, 512, 512, (bf16_t*)(p.ws + OFF_W13) + (size_t)e * 1024 * 1024, u >> 4, u & 15, smem); }
        else { const int v = t - 8192, e = v >> 7, u = v & 127;
            convert_tile(p.w2 + (size_t)(layer * 32 + e) * 512 * 1024, nullptr, 0, 512, 1024, 1024, (bf16_t*)(p.ws + OFF_W2T) + (size_t)e * 1024 * 512, u >> 3, u & 7, smem); }
    }
}

PHASE_FN void ph_gla_tok(const Params& p, int layer) {
    int tid_ = threadIdx.x; asm volatile("" : "+v"(tid_)); const int tid = tid_, lane = tid & 63, wv = tid >> 6, li = layer >> 1;
    const float* P = (const float*)(p.ws + OFF_P);
    float* LA = (float*)(p.ws + OFF_LA);
    const float* w2 = p.gla_w_gate2 + (size_t)li * 16 * 512; const float* b2 = p.gla_b_gate2 + li * 512;
    for (int t = blockIdx.x * 8 + wv; t < NT; t += gridDim.x * 8) {
        float glr[16];
#pragma unroll
        for (int r = 0; r < 16; ++r) glr[r] = P[(size_t)t * LDP + 3072 + r];
#pragma unroll 1
        for (int i = 0; i < 8; ++i) {
            const int c = lane + 64 * i; float z = b2[c];
#pragma unroll
            for (int r = 0; r < 16; ++r) z += glr[r] * w2[r * 512 + c];
            LA[(size_t)t * 512 + c] = -softplusf_(-z) * (1.f / 16.f);
        }
    }
}

PHASE_FN void ph_gla_chunk(const Params& p, float* smem) {
    smem = (float*)g_smem;
    int tid_ = threadIdx.x; asm volatile("" : "+v"(tid_)); const int tid = tid_;
    float* sQ = smem; float* sK = sQ + 64 * 129; float* sBc = sK + 64 * 129;
    const float* P = (const float*)(p.ws + OFF_P); const float* LA = (const float*)(p.ws + OFF_LA);
    float* ATT = (float*)(p.ws + OFF_ATT); float* QE = (float*)(p.ws + OFF_QE); float* KD = (float*)(p.ws + OFF_GKD); float* EBL = (float*)(p.ws + OFF_EBL);
    for (int ci = blockIdx.x; ci < 1024; ci += gridDim.x) {
        const int b = ci >> 9, h = (ci >> 7) & 3, n = ci & 127;
        const int t0 = b * 8192 + n * 64;
        __syncthreads();
        for (int e = tid; e < 8192; e += NTHREADS) {
            const int i = e >> 7, d = e & 127;
            sQ[i * 129 + d] = P[(size_t)(t0 + i) * LDP + h * 128 + d]; sK[i * 129 + d] = P[(size_t)(t0 + i) * LDP + 512 + h * 128 + d];
            sBc[i * 129 + d] = LA[(size_t)(t0 + i) * 512 + h * 128 + d];
        }
        __syncthreads();
        if (tid < 128) { float a = 0.f; for (int i = 0; i < 64; ++i) { a += sBc[i * 129 + tid]; sBc[i * 129 + tid] = a; } }
        __syncthreads();
        for (int e = tid; e < 4096; e += NTHREADS) {
            const int i = e >> 6, j = e & 63; float a = 0.f;
            if (j <= i) { for (int d = 0; d < 128; ++d) a += sQ[i * 129 + d] * sK[j * 129 + d] * expf(sBc[i * 129 + d] - sBc[j * 129 + d]); }
            ATT[(size_t)ci * 4096 + e] = a * SCALE128;
        }
        for (int e = tid; e < 8192; e += NTHREADS) {
            const int i = e >> 7, d = e & 127;
            QE[(size_t)ci * 8192 + e] = sQ[i * 129 + d] * SCALE128 * expf(sBc[i * 129 + d]);
            KD[(size_t)ci * 8192 + e] = sK[i * 129 + d] * expf(sBc[63 * 129 + d] - sBc[i * 129 + d]);
        }
        if (tid < 128) EBL[ci * 128 + tid] = expf(sBc[63 * 129 + tid]);
    }
}

PHASE_FN void ph_gla_scan(const Params& p, float* smem) {
    smem = (float*)g_smem;
    int tid_ = threadIdx.x; asm volatile("" : "+v"(tid_)); const int tid = tid_;
    float* sS = smem; float* sW = sS + 128 * 17; float* sV = sW + 64 * 129; float* sA = sV + 64 * 17; float* sE = sA + 64 * 65;
    const float* P = (const float*)(p.ws + OFF_P);
    const float* ATT = (const float*)(p.ws + OFF_ATT); const float* QE = (const float*)(p.ws + OFF_QE); const float* KD = (const float*)(p.ws + OFF_GKD); const float* EBL = (const float*)(p.ws + OFF_EBL);
    float* O = (float*)(p.ws + OFF_O);
    for (int it = blockIdx.x; it < 128; it += gridDim.x) {
        const int bh = it >> 4, sl = it & 15, b = bh >> 2, h = bh & 3;
        __syncthreads();
        for (int e = tid; e < 128 * 16; e += NTHREADS) sS[(e >> 4) * 17 + (e & 15)] = 0.f;
        for (int n = 0; n < 128; ++n) {
            const int ci = bh * 128 + n, t0 = b * 8192 + n * 64;
            __syncthreads();
            for (int e = tid; e < 8192; e += NTHREADS) sW[(e >> 7) * 129 + (e & 127)] = QE[(size_t)ci * 8192 + e];
            for (int e = tid; e < 4096; e += NTHREADS) sA[(e >> 6) * 65 + (e & 63)] = ATT[(size_t)ci * 4096 + e];
            for (int e = tid; e < 1024; e += NTHREADS) sV[(e >> 4) * 17 + (e & 15)] = P[(size_t)(t0 + (e >> 4)) * LDP + 1024 + h * 256 + sl * 16 + (e & 15)];
            if (tid < 128) sE[tid] = EBL[ci * 128 + tid];
            __syncthreads();
            for (int o = tid; o < 1024; o += NTHREADS) {
                const int i = o >> 4, c = o & 15; float a = 0.f;
                for (int d = 0; d < 128; ++d) a += sW[i * 129 + d] * sS[d * 17 + c];
                for (int j = 0; j < 64; ++j) a += sA[i * 65 + j] * sV[j * 17 + c];
                O[(size_t)(t0 + i) * 1024 + h * 256 + sl * 16 + c] = a;
            }
            __syncthreads();
            for (int e = tid; e < 8192; e += NTHREADS) sW[(e >> 7) * 129 + (e & 127)] = KD[(size_t)ci * 8192 + e];
            __syncthreads();
            for (int o = tid; o < 2048; o += NTHREADS) {
                const int d = o >> 4, c = o & 15; float a = sS[d * 17 + c] * sE[d];
                for (int j = 0; j < 64; ++j) a += sW[j * 129 + d] * sV[j * 17 + c];
                sS[d * 17 + c] = a;
            }
        }
    }
}

PHASE_FN void ph_gla_out(const Params& p, int layer) {
    int tid_ = threadIdx.x; asm volatile("" : "+v"(tid_)); const int tid = tid_, lane = tid & 63, wv = tid >> 6;
    float* O = (float*)(p.ws + OFF_O); const float* P = (const float*)(p.ws + OFF_P);
    const float* onw = p.gla_out_norm + (layer >> 1) * 256;
    for (int t = blockIdx.x * 8 + wv; t < NT; t += gridDim.x * 8) {
#pragma unroll
        for (int h = 0; h < 4; ++h) {
            float* op = O + (size_t)t * 1024 + h * 256;
            const float4 o = *(const float4*)(op + lane * 4);
            const float ss = wave_sum(o.x * o.x + o.y * o.y + o.z * o.z + o.w * o.w);
            const float r = rsqrtf(ss * (1.f / 256.f) + EPS);
            const float4 z = *(const float4*)(P + (size_t)t * LDP + 2048 + h * 256 + lane * 4);
            const float4 w = *(const float4*)(onw + lane * 4);
            *(float4*)(op + lane * 4) = make_float4(o.x * r * w.x * siluf_(z.x), o.y * r * w.y * siluf_(z.y), o.z * r * w.z * siluf_(z.z), o.w * r * w.w * siluf_(z.w));
        }
    }
}

template <int PH>
__device__ __forceinline__ void run_phase(const Params& p, int layer, float* smem) {
    if (PH == PH_PROLOGUE) { ph_prologue(p, smem); ph_conv_dense(p, smem); }
    else if (PH == PH_NORM_MIX) ph_rows(p, layer, 0, smem);
    else if (PH == PH_GEMM_IN_EVEN) ph_gemm_in(p, layer, true, smem);
    else if (PH == PH_EVEN_TOK) ph_even_tok(p, layer, smem);
    else if (PH == PH_GDN_CHUNK) ph_gdn_chunk(p, smem);
    else if (PH == PH_GDN_SCAN) ph_gdn_scan(p, smem);
    else if (PH == PH_DSA_TOPK) ph_dsa_topk(p, smem);
    else if (PH == PH_DSA_ATTN) ph_dsa_attn(p, smem);
    else if (PH == PH_GDN_OUT) ph_gdn_out(p, layer);
    else if (PH == PH_GEMM_OUT) ph_gemm_out(p, layer, smem);
    else if (PH == PH_NORM_FFN) { ph_norm_ffn(p, layer); ph_conv_exp(p, layer, smem); }
    else if (PH == PH_MOE1) ph_moe(p, layer, 0, smem);
    else if (PH == PH_MOE2) ph_moe(p, layer, 1, smem);
    else if (PH == PH_GEMM_IN_ODD) ph_gemm_in(p, layer, false, smem);
    else if (PH == PH_GLA_TOK) ph_gla_tok(p, layer);
    else if (PH == PH_GLA_CHUNK) ph_gla_chunk(p, smem);
    else if (PH == PH_GLA_SCAN) ph_gla_scan(p, smem);
    else if (PH == PH_GLA_OUT) ph_gla_out(p, layer);
    else if (PH == PH_FINAL) ph_rows(p, 0, 1, smem);
}

#if MK_MULTI
template <int PH>
__global__ void __launch_bounds__(NTHREADS, 2) k_phase(Params p, int layer) {
    run_phase<PH>(p, layer, (float*)g_smem);
}
#else
__global__ void __launch_bounds__(NTHREADS, 2) k_mega(Params p) {
    float* smem = (float*)g_smem;
    volatile LAS unsigned* xbw = (volatile LAS unsigned*)(LAS unsigned char*)(g_smem + LDS_BYTES - 16);
    if (threadIdx.x == 0) { xbw[0] = 0u; xbw[1] = 0u; xbw[2] = 0u; xbw[3] = 0u; }
    __syncthreads();
    XcdBarrier bar = xcd_barrier_post((unsigned*)(p.ws + OFF_BAR), xbw);
#define BAR() xcd_barrier(bar)
    run_phase<PH_PROLOGUE>(p, 0, smem); BAR(); if (DUP_MASK & 4096) { run_phase<PH_PROLOGUE>(p, 0, smem); BAR(); }
    for (int lp = 0; lp < 2; ++lp) {
        const int le = 2 * lp, lo = 2 * lp + 1;
        run_phase<PH_NORM_MIX>(p, le, smem); BAR();
        run_phase<PH_GEMM_IN_EVEN>(p, le, smem); BAR(); if (DUP_MASK & 1) { run_phase<PH_GEMM_IN_EVEN>(p, le, smem); BAR(); }
        run_phase<PH_EVEN_TOK>(p, le, smem); BAR(); if (DUP_MASK & 2) { run_phase<PH_EVEN_TOK>(p, le, smem); BAR(); }
        run_phase<PH_GDN_CHUNK>(p, le, smem); BAR(); if (DUP_MASK & 4) { run_phase<PH_GDN_CHUNK>(p, le, smem); BAR(); }
        run_phase<PH_GDN_SCAN>(p, le, smem); BAR(); if (DUP_MASK & 8) { run_phase<PH_GDN_SCAN>(p, le, smem); BAR(); }
        run_phase<PH_DSA_TOPK>(p, le, smem); BAR(); if (DUP_MASK & 16) { run_phase<PH_DSA_TOPK>(p, le, smem); BAR(); }
        run_phase<PH_DSA_ATTN>(p, le, smem); BAR(); if (DUP_MASK & 32) { run_phase<PH_DSA_ATTN>(p, le, smem); BAR(); }
        run_phase<PH_GDN_OUT>(p, le, smem); BAR();
        run_phase<PH_GEMM_OUT>(p, le, smem); BAR();
        run_phase<PH_NORM_FFN>(p, le, smem); BAR();
        run_phase<PH_MOE1>(p, le, smem); BAR(); if (DUP_MASK & 64) { run_phase<PH_MOE1>(p, le, smem); BAR(); }
        run_phase<PH_MOE2>(p, le, smem); BAR(); if (DUP_MASK & 128) { run_phase<PH_MOE2>(p, le, smem); BAR(); }
        run_phase<PH_NORM_MIX>(p, lo, smem); BAR();
        run_phase<PH_GEMM_IN_ODD>(p, lo, smem); BAR(); if (DUP_MASK & 256) { run_phase<PH_GEMM_IN_ODD>(p, lo, smem); BAR(); }
        run_phase<PH_GLA_TOK>(p, lo, smem); BAR(); if (DUP_MASK & 512) { run_phase<PH_GLA_TOK>(p, lo, smem); BAR(); }
        run_phase<PH_GLA_CHUNK>(p, lo, smem); BAR(); if (DUP_MASK & 1024) { run_phase<PH_GLA_CHUNK>(p, lo, smem); BAR(); }
        run_phase<PH_GLA_SCAN>(p, lo, smem); BAR(); if (DUP_MASK & 2048) { run_phase<PH_GLA_SCAN>(p, lo, smem); BAR(); }
        run_phase<PH_GLA_OUT>(p, lo, smem); BAR();
        run_phase<PH_GEMM_OUT>(p, lo, smem); BAR();
        run_phase<PH_NORM_FFN>(p, lo, smem); BAR();
        run_phase<PH_MOE1>(p, lo, smem); BAR(); if (DUP_MASK & 64) { run_phase<PH_MOE1>(p, lo, smem); BAR(); }
        run_phase<PH_MOE2>(p, lo, smem); BAR(); if (DUP_MASK & 128) { run_phase<PH_MOE2>(p, lo, smem); BAR(); }
    }
    for (int xb = 0; xb < EXTRA_BARS; ++xb) BAR();
    run_phase<PH_FINAL>(p, 0, smem);
}
#endif

}

#if MK_MULTI
template <int PH>
static void launch_phase(const Params& p, int layer, hipStream_t stream) {
    static bool attr_set = false;
    if (!attr_set) { hipFuncSetAttribute((const void*)k_phase<PH>, hipFuncAttributeMaxDynamicSharedMemorySize, (int)LDS_BYTES); attr_set = true; }
    hipLaunchKernelGGL((k_phase<PH>), dim3(256), dim3(NTHREADS), LDS_BYTES, stream, p, layer);
}
#endif

extern "C" void kernel_launch(void* const* d_in, const int* in_sizes, int n_in, void* d_out, int out_size, void* d_ws, size_t ws_size, hipStream_t stream) {
    (void)in_sizes; (void)n_in; (void)out_size;
    if (ws_size < WS_NEEDED) { fprintf(stderr, "workspace too small: %zu < %zu\n", ws_size, (size_t)WS_NEEDED); return; }
    Params p{};
    p.x = (const float*)d_in[0]; p.c = (const float*)d_in[1]; p.pos = (const int*)d_in[2]; p.ada_w = (const float*)d_in[3]; p.ada_b = (const float*)d_in[4];
    p.norm_mix = (const float*)d_in[5]; p.norm_ffn = (const float*)d_in[6]; p.even_w_in = (const float*)d_in[7]; p.conv_w = (const float*)d_in[8];
    p.a_log = (const float*)d_in[9]; p.dt_bias = (const float*)d_in[10]; p.gdn_out_norm = (const float*)d_in[11]; p.even_w_out = (const float*)d_in[12];
    p.gla_w_in = (const float*)d_in[13]; p.gla_w_gate2 = (const float*)d_in[14]; p.gla_b_gate2 = (const float*)d_in[15]; p.gla_out_norm = (const float*)d_in[16]; p.gla_w_out = (const float*)d_in[17];
    p.rg_w = (const float*)d_in[18]; p.rg_b = (const float*)d_in[19]; p.re_w = (const float*)d_in[20]; p.re_b = (const float*)d_in[21];
    p.w1 = (const float*)d_in[22]; p.w3 = (const float*)d_in[23]; p.w2 = (const float*)d_in[24]; p.final_norm = (const float*)d_in[25];
    p.X = (float*)d_out; p.ws = (unsigned char*)d_ws;
    p.rA = pow(10000.0, -2.0 / 128.0); p.rI = pow(10000.0, -2.0 / 64.0);
    hipMemsetAsync(d_ws, 0, ZERO_BYTES, stream);
#if MK_MULTI
    launch_phase<PH_PROLOGUE>(p, 0, stream);
    for (int lp = 0; lp < 2; ++lp) {
        const int le = 2 * lp, lo = 2 * lp + 1;
        launch_phase<PH_NORM_MIX>(p, le, stream);
        launch_phase<PH_GEMM_IN_EVEN>(p, le, stream);
        launch_phase<PH_EVEN_TOK>(p, le, stream);
        launch_phase<PH_GDN_CHUNK>(p, le, stream);
        launch_phase<PH_GDN_SCAN>(p, le, stream);
        launch_phase<PH_DSA_TOPK>(p, le, stream);
        launch_phase<PH_DSA_ATTN>(p, le, stream);
        launch_phase<PH_GDN_OUT>(p, le, stream);
        launch_phase<PH_GEMM_OUT>(p, le, stream);
        launch_phase<PH_NORM_FFN>(p, le, stream);
        launch_phase<PH_MOE1>(p, le, stream);
        launch_phase<PH_MOE2>(p, le, stream);
        launch_phase<PH_NORM_MIX>(p, lo, stream);
        launch_phase<PH_GEMM_IN_ODD>(p, lo, stream);
        launch_phase<PH_GLA_TOK>(p, lo, stream);
        launch_phase<PH_GLA_CHUNK>(p, lo, stream);
        launch_phase<PH_GLA_SCAN>(p, lo, stream);
        launch_phase<PH_GLA_OUT>(p, lo, stream);
        launch_phase<PH_GEMM_OUT>(p, lo, stream);
        launch_phase<PH_NORM_FFN>(p, lo, stream);
        launch_phase<PH_MOE1>(p, lo, stream);
        launch_phase<PH_MOE2>(p, lo, stream);
    }
    launch_phase<PH_FINAL>(p, 0, stream);
#else
    static int grid = 0;
    if (!grid) {
        int dev = 0, cus = 0, per_cu = 0;
        hipGetDevice(&dev);
        hipDeviceGetAttribute(&cus, hipDeviceAttributeMultiprocessorCount, dev);
        hipFuncSetAttribute((const void*)k_mega, hipFuncAttributeMaxDynamicSharedMemorySize, (int)LDS_BYTES);
        hipOccupancyMaxActiveBlocksPerMultiprocessor(&per_cu, k_mega, NTHREADS, LDS_BYTES);
        if (cus <= 0) cus = 256;
        grid = cus * (per_cu < 1 ? 1 : 1);
    }
    hipLaunchKernelGGL(k_mega, dim3(grid), dim3(NTHREADS), LDS_BYTES, stream, p);
#endif
}
```

```cpp
#include <hip/hip_runtime.h>
#include <stdint.h>
#include <math.h>
#include <stdio.h>

#define EXTRA_BARS 0
#define PROBE_NOP 0
#define PROBE_CONST 0
#define PROBE_NOR 0
#define SCAN_DIRECT 0
#ifndef DUP_MASK
#define DUP_MASK 0
#endif
#ifndef MK_MULTI
#define MK_MULTI 0
#endif

namespace {

constexpr int NT = 16384, ND = 1024, LDP = 3920;
constexpr float EPS = 1e-6f;
constexpr int NTHREADS = 512;
constexpr size_t LDS_BYTES = 147456;
constexpr float SCALE128 = 0.08838834764831845f;
constexpr int LISTCAP = 32768;
constexpr int CSTR = 16;

constexpr size_t OFF_BAR  = 0;
constexpr size_t OFF_CNT  = 16384;
constexpr size_t ZERO_BYTES = 32768;
constexpr size_t OFF_MOD  = 32768;
constexpr size_t OFF_COSA = OFF_MOD + 4 * 2 * 6144 * 4;
constexpr size_t OFF_SINA = OFF_COSA + (size_t)NT * 64 * 4;
constexpr size_t OFF_COSI = OFF_SINA + (size_t)NT * 64 * 4;
constexpr size_t OFF_SINI = OFF_COSI + (size_t)NT * 32 * 4;
constexpr size_t OFF_H    = OFF_SINI + (size_t)NT * 32 * 4;
constexpr size_t OFF_P    = OFF_H + (size_t)NT * 1024 * 4;
constexpr size_t OFF_HID  = OFF_P;
constexpr size_t OFF_YB   = OFF_HID + (size_t)36864 * 512 * 4;
constexpr size_t OFF_O    = OFF_P + (size_t)NT * LDP * 4;
constexpr size_t OFF_ASG  = OFF_O + (size_t)NT * 1024 * 4;
constexpr size_t OFF_GATE = OFF_ASG + (size_t)NT * 4 * 4;
constexpr size_t OFF_LIST = OFF_GATE + (size_t)NT * 2 * 4;
constexpr size_t OFF_R    = OFF_LIST + (size_t)32 * LISTCAP * 4;
constexpr size_t OFF_QN   = OFF_R;
constexpr size_t OFF_KN   = OFF_QN + (size_t)NT * 512 * 4;
constexpr size_t OFF_VC   = OFF_KN + (size_t)NT * 512 * 4;
constexpr size_t OFF_BETA = OFF_VC + (size_t)NT * 512 * 4;
constexpr size_t OFF_G    = OFF_BETA + (size_t)NT * 4 * 4;
constexpr size_t OFF_W    = OFF_G + (size_t)NT * 4 * 4;
constexpr size_t OFF_U    = OFF_W + (size_t)1024 * 8192 * 4;
constexpr size_t OFF_QG   = OFF_U + (size_t)1024 * 8192 * 4;
constexpr size_t OFF_KD   = OFF_QG + (size_t)1024 * 8192 * 4;
constexpr size_t OFF_AQK  = OFF_KD + (size_t)1024 * 8192 * 4;
constexpr size_t OFF_GL   = OFF_AQK + (size_t)1024 * 4096 * 4;
constexpr size_t OFF_QB   = OFF_GL + 4096;
constexpr size_t OFF_KB   = OFF_QB + (size_t)NT * 512 * 4;
constexpr size_t OFF_QI   = OFF_KB + (size_t)NT * 512 * 4;
constexpr size_t OFF_KI   = OFF_QI + (size_t)NT * 256 * 4;
constexpr size_t OFF_WI   = OFF_KI + (size_t)NT * 64 * 4;
constexpr size_t OFF_SEL  = OFF_WI + (size_t)NT * 4 * 4;
constexpr size_t OFF_EVEN_END = OFF_SEL + (size_t)NT * 256 * 4;
constexpr size_t OFF_PFR  = OFF_W;
constexpr size_t OFF_RFR  = OFF_PFR + (size_t)1024 * 32768;
constexpr size_t OFF_QFR  = OFF_RFR + (size_t)1024 * 16384;
constexpr size_t OFF_OFR  = OFF_QFR + (size_t)1024 * 32768;
static_assert(OFF_OFR + (size_t)1024 * 16384 <= OFF_GL, "gdn v2 buffers overflow");
constexpr size_t OFF_QBB  = OFF_QB;
constexpr size_t OFF_KBB  = OFF_QBB + (size_t)NT * 512 * 2;
constexpr size_t OFF_VT   = OFF_KBB + (size_t)NT * 512 * 2;
constexpr size_t OFF_QIB  = OFF_VT + (size_t)NT * 512 * 2;
constexpr size_t OFF_KIB  = OFF_QIB + (size_t)NT * 256 * 2;
constexpr size_t OFF_M16  = OFF_KIB + (size_t)NT * 64 * 2;
static_assert(OFF_M16 + (size_t)NT * 512 * 2 <= OFF_WI, "dsa v2 buffers overflow");
constexpr size_t OFF_LA   = OFF_R;
constexpr size_t OFF_ATT  = OFF_LA + (size_t)NT * 512 * 4;
constexpr size_t OFF_QE   = OFF_ATT + (size_t)1024 * 4096 * 4;
constexpr size_t OFF_GKD  = OFF_QE + (size_t)1024 * 8192 * 4;
constexpr size_t OFF_EBL  = OFF_GKD + (size_t)1024 * 8192 * 4;
constexpr size_t OFF_GQE  = OFF_LA + (size_t)NT * 512 * 4;
constexpr size_t OFF_GOI  = OFF_GQE + (size_t)1024 * 16384;
constexpr size_t OFF_GH   = OFF_GOI + (size_t)1024 * 32768;
constexpr size_t OFF_GEBL = OFF_GH + (size_t)1024 * 65536;
static_assert(OFF_GEBL + (size_t)1024 * 512 <= OFF_EVEN_END, "gla v2 buffers overflow");
constexpr size_t OFF_WINE = OFF_EVEN_END;
constexpr size_t OFF_WINO = OFF_WINE + (size_t)2 * 3968 * 1024 * 2;
constexpr size_t OFF_WOUT = OFF_WINO + (size_t)2 * 3200 * 1024 * 2;
constexpr size_t OFF_W13  = OFF_WOUT + (size_t)4 * 1024 * 1024 * 2;
constexpr size_t OFF_W2T  = OFF_W13 + (size_t)32 * 1024 * 1024 * 2;
constexpr size_t WS_NEEDED = OFF_W2T + (size_t)32 * 1024 * 512 * 2;

struct Params {
    const float* x; const float* c; const int* pos; const float* ada_w; const float* ada_b;
    const float* norm_mix; const float* norm_ffn; const float* even_w_in; const float* conv_w;
    const float* a_log; const float* dt_bias; const float* gdn_out_norm; const float* even_w_out;
    const float* gla_w_in; const float* gla_w_gate2; const float* gla_b_gate2; const float* gla_out_norm; const float* gla_w_out;
    const float* rg_w; const float* rg_b; const float* re_w; const float* re_b;
    const float* w1; const float* w3; const float* w2; const float* final_norm;
    float* X;
    unsigned char* ws;
    double rA, rI;
};

#define XB_TMO      128
#define XB_XCNT(j)  (256  + 64 * (j))
#define XB_XSUB(j)  (1280 + 64 * (j))
#define XB_XGEN(j)  (2304 + 64 * (j))
#define XB_TOP      3328
#define XB_TOPGEN   3392
#define XCD_BAR_WORDS 3456
#define XB_SPIN_CAP (1u << 18)
#define LAS __attribute__((address_space(3)))

__device__ __forceinline__ unsigned xb_ld(unsigned* p)              { return __hip_atomic_load(p, __ATOMIC_RELAXED, __HIP_MEMORY_SCOPE_AGENT); }
__device__ __forceinline__ unsigned xb_add(unsigned* p, unsigned v) { return __hip_atomic_fetch_add(p, v, __ATOMIC_RELAXED, __HIP_MEMORY_SCOPE_AGENT); }
__device__ __forceinline__ unsigned xb_xcc_id() { return (unsigned)__builtin_amdgcn_s_getreg((3 << 11) | 20) & 0xFu; }
#define XB_SPIN(cond, bar) do { unsigned _sp = 0; while (cond) { __builtin_amdgcn_s_sleep(1); \
    if ((++_sp & 255u) == 0u) { if (xb_ld(&(bar)[XB_TMO])) break; if (_sp > XB_SPIN_CAP) { atomicAdd(&(bar)[XB_TMO], 1u); break; } } } } while (0)

struct XcdBarrier { unsigned* bar; unsigned x; volatile LAS unsigned* st; };

__device__ __forceinline__ XcdBarrier xcd_barrier_post(unsigned* bar, volatile LAS unsigned* st) {
    XcdBarrier b; b.bar = bar; b.x = xb_xcc_id(); b.st = st;
    if (threadIdx.x == 0) (void)xb_add(&bar[XB_XCNT(b.x)], 1u);
    return b;
}
__device__ __forceinline__ void xcd_barrier_complete(unsigned* bar, unsigned x, unsigned& nloc, unsigned& nx) {
    const unsigned G = gridDim.x * gridDim.y * gridDim.z;
    unsigned sum, cnt, mine, sp = 0u;
    for (;;) {
        sum = 0u; cnt = 0u; mine = 0u;
#pragma unroll
        for (unsigned j = 0; j < 16; ++j) { const unsigned c = xb_ld(&bar[XB_XCNT(j)]); sum += c; cnt += (c > 0u) ? 1u : 0u; mine = (j == x) ? c : mine; }
        if (sum == G) break;
        __builtin_amdgcn_s_sleep(1);
        if ((++sp & 255u) == 0u) { if (xb_ld(&bar[XB_TMO])) break; if (sp > XB_SPIN_CAP) { atomicAdd(&bar[XB_TMO], 1u); break; } }
    }
    nloc = mine > 0u ? mine : 1u; nx = cnt > 0u ? cnt : 1u;
}
__device__ __forceinline__ void xcd_barrier(const XcdBarrier& b) {
    asm volatile("s_waitcnt vmcnt(0)" ::: "memory");
    __syncthreads();
    if (threadIdx.x == 0) {
        unsigned* bar = b.bar;
        __builtin_amdgcn_s_waitcnt(0);
        unsigned nloc = b.st[0], nx = b.st[1];
        if (nloc == 0u) { xcd_barrier_complete(bar, b.x, nloc, nx); b.st[0] = nloc; b.st[1] = nx; }
        const unsigned old = xb_add(&bar[XB_XSUB(b.x)], 1u);
        const unsigned gen = old / nloc;
        if (old + 1u == (gen + 1u) * nloc) {
            __builtin_amdgcn_fence(__ATOMIC_RELEASE, "agent");
            asm volatile("s_waitcnt vmcnt(0)" ::: "memory");
            const unsigned og = xb_add(&bar[XB_TOP], 1u);
            const unsigned tg = og / nx;
            if (og + 1u == (tg + 1u) * nx) xb_add(&bar[XB_TOPGEN], 1u);
            else XB_SPIN(xb_ld(&bar[XB_TOPGEN]) == tg, bar);
            __builtin_amdgcn_fence(__ATOMIC_ACQUIRE, "agent");
            xb_add(&bar[XB_XGEN(b.x)], 1u);
            asm volatile("s_waitcnt vmcnt(0)" ::: "memory");
        } else {
            XB_SPIN(xb_ld(&bar[XB_XGEN(b.x)]) == gen, bar);
            __builtin_amdgcn_fence(__ATOMIC_ACQUIRE, "agent");
            asm volatile("s_waitcnt vmcnt(0)" ::: "memory");
        }
    }
    __syncthreads();
}

__device__ __forceinline__ float wave_sum(float v) {
#pragma unroll
    for (int o = 32; o > 0; o >>= 1) v += __shfl_xor(v, o);
    return v;
}
__device__ __forceinline__ int wave_sum_i(int v) {
#pragma unroll
    for (int o = 32; o > 0; o >>= 1) v += __shfl_xor(v, o);
    return v;
}
__device__ __forceinline__ float wave_max(float v) {
#pragma unroll
    for (int o = 32; o > 0; o >>= 1) v = fmaxf(v, __shfl_xor(v, o));
    return v;
}
__device__ __forceinline__ float sigmoidf_(float x) { return 1.f / (1.f + expf(-x)); }
__device__ __forceinline__ float siluf_(float x) { return x / (1.f + expf(-x)); }
__device__ __forceinline__ float softplusf_(float x) { return fmaxf(x, 0.f) + log1pf(expf(-fabsf(x))); }
__device__ __forceinline__ unsigned ordkey(float f) { const unsigned u = __float_as_uint(f); return (u & 0x80000000u) ? ~u : (u | 0x80000000u); }

__device__ __forceinline__ void sincos_d(double a, double& s, double& c) {
    const double kq = rint(a * 0.63661977236758134308);
    double r = fma(-kq, 1.57079632673412561417e+00, a);
    r = fma(-kq, 6.07710050650619224932e-11, r);
    const int q = (int)((long long)kq & 3);
    const double r2 = r * r;
    const double sp = r * (1.0 + r2 * (-1.0 / 6 + r2 * (1.0 / 120 + r2 * (-1.0 / 5040 + r2 * (1.0 / 362880 + r2 * (-1.0 / 39916800 + r2 * (1.0 / 6227020800.0)))))));
    const double cp = 1.0 + r2 * (-0.5 + r2 * (1.0 / 24 + r2 * (-1.0 / 720 + r2 * (1.0 / 40320 + r2 * (-1.0 / 3628800 + r2 * (1.0 / 479001600.0 + r2 * (-1.0 / 87178291200.0)))))));
    if (q == 0) { s = sp; c = cp; } else if (q == 1) { s = cp; c = -sp; } else if (q == 2) { s = -sp; c = -cp; } else { s = -cp; c = sp; }
}
__device__ __forceinline__ double ipow_d(double b, int e) { double v = 1.0; while (e) { if (e & 1) v *= b; b *= b; e >>= 1; } return v; }

struct GemmArgs { const float* A; int lda; const int* rows; int m0; int mvalid; const float* B; int ldb; int n0; int N; int K; };

template <class Epi>
__device__ __forceinline__ void gemm128(const GemmArgs& g, float* smem, Epi epi) {
    float* As = smem;
    float* Bs = smem + 16 * 132;
    int tid_ = threadIdx.x; asm volatile("" : "+v"(tid_)); const int tid = tid_, ty = tid >> 4, tx = tid & 15;
    const int arow = tid >> 2, kq = (tid & 3) * 4;
    const int bk = tid >> 5, bn = (tid & 31) * 4;
    long asrc = -1;
    if (arow < g.mvalid) { const int r = g.rows ? g.rows[arow] : (g.m0 + arow); if (r >= 0) asrc = (long)r * g.lda; }
    const bool bval = (g.n0 + bn) < g.N;
    float acc[4][8];
#pragma unroll
    for (int i = 0; i < 4; ++i)
#pragma unroll
        for (int j = 0; j < 8; ++j) acc[i][j] = 0.f;
    for (int k0 = 0; k0 < g.K; k0 += 16) {
        float4 av = make_float4(0.f, 0.f, 0.f, 0.f), bv = make_float4(0.f, 0.f, 0.f, 0.f);
        if (asrc >= 0) av = *(const float4*)(g.A + asrc + k0 + kq);
        if (bval) bv = *(const float4*)(g.B + (size_t)(k0 + bk) * g.ldb + g.n0 + bn);
        __syncthreads();
        As[(kq + 0) * 132 + arow] = av.x; As[(kq + 1) * 132 + arow] = av.y; As[(kq + 2) * 132 + arow] = av.z; As[(kq + 3) * 132 + arow] = av.w;
        *(float4*)&Bs[bk * 132 + bn] = bv;
        __syncthreads();
#pragma unroll
        for (int kk = 0; kk < 16; ++kk) {
            const float4 a = *(const float4*)&As[kk * 132 + ty * 4];
            const float4 b0 = *(const float4*)&Bs[kk * 132 + tx * 8];
            const float4 b1 = *(const float4*)&Bs[kk * 132 + tx * 8 + 4];
            const float aa[4] = {a.x, a.y, a.z, a.w};
            const float bb[8] = {b0.x, b0.y, b0.z, b0.w, b1.x, b1.y, b1.z, b1.w};
#pragma unroll
            for (int i = 0; i < 4; ++i)
#pragma unroll
                for (int j = 0; j < 8; ++j) acc[i][j] += aa[i] * bb[j];
        }
    }
#pragma unroll
    for (int i = 0; i < 4; ++i) {
        const int r = ty * 4 + i;
        if (r < g.mvalid) {
#pragma unroll
            for (int j = 0; j < 8; ++j) { const int n = g.n0 + tx * 8 + j; if (n < g.N) epi(r, n, acc[i][j]); }
        }
    }
}


typedef short bf16x8 __attribute__((ext_vector_type(8)));
typedef float f32x4 __attribute__((ext_vector_type(4)));
typedef unsigned short bf16_t;
typedef __bf16 bf16x2_t __attribute__((ext_vector_type(2)));
typedef float f32x2_t __attribute__((ext_vector_type(2)));
__device__ __forceinline__ unsigned cvt_pk_bf16(float lo, float hi) { const f32x2_t v = {lo, hi}; const bf16x2_t r = __builtin_convertvector(v, bf16x2_t); return __builtin_bit_cast(unsigned, r); }
__device__ __forceinline__ bf16_t f2bf(float f) { return (bf16_t)(cvt_pk_bf16(f, 0.f) & 0xffffu); }
__device__ __forceinline__ float bf16_to_f32(bf16_t v) { return __uint_as_float(((unsigned)v) << 16); }
__device__ __forceinline__ uint4 pack8(const float4 a, const float4 b) { uint4 r; r.x = cvt_pk_bf16(a.x, a.y); r.y = cvt_pk_bf16(a.z, a.w); r.z = cvt_pk_bf16(b.x, b.y); r.w = cvt_pk_bf16(b.z, b.w); return r; }
__device__ __forceinline__ int lds_off(int r, int c) { return r * 128 + ((c ^ (r & 7)) << 4); }

template <class ALoad, class BLoad, class Epi>
__device__ __forceinline__ void gemm_tile_bf16(const int K, unsigned char* lds, ALoad aload, BLoad bload, Epi epi) {
    int tid_ = threadIdx.x; asm volatile("" : "+v"(tid_)); const int tid = tid_, lane = tid & 63, wid = tid >> 6, wm = wid >> 1, wn = wid & 1;
    f32x4 acc[4][4];
#pragma unroll
    for (int mi = 0; mi < 4; ++mi)
#pragma unroll
        for (int ni = 0; ni < 4; ++ni) acc[mi][ni] = (f32x4){0.f, 0.f, 0.f, 0.f};
    uint4 ra[4], rb[2];
    const int nk = K >> 6;
#pragma unroll
    for (int i = 0; i < 4; ++i) { const int q = tid + 512 * i; ra[i] = aload(i, q >> 3, (q & 7) * 8); }
#pragma unroll
    for (int i = 0; i < 2; ++i) { const int q = tid + 512 * i; rb[i] = bload(i, q >> 3, (q & 7) * 8); }
    __syncthreads();
#pragma unroll
    for (int i = 0; i < 4; ++i) { const int q = tid + 512 * i; *(uint4*)(lds + lds_off(q >> 3, q & 7)) = ra[i]; }
#pragma unroll
    for (int i = 0; i < 2; ++i) { const int q = tid + 512 * i; *(uint4*)(lds + 32768 + lds_off(q >> 3, q & 7)) = rb[i]; }
    __syncthreads();
    for (int kt = 0; kt < nk; ++kt) {
        if (kt + 1 < nk) {
#pragma unroll
            for (int i = 0; i < 4; ++i) { const int q = tid + 512 * i; ra[i] = aload(i, q >> 3, (kt + 1) * 64 + (q & 7) * 8); }
#pragma unroll
            for (int i = 0; i < 2; ++i) { const int q = tid + 512 * i; rb[i] = bload(i, q >> 3, (kt + 1) * 64 + (q & 7) * 8); }
        }
        const unsigned char* At = lds + (kt & 1) * 49152;
        const unsigned char* Bt = At + 32768;
#pragma unroll
        for (int ks = 0; ks < 2; ++ks) {
            bf16x8 af[4], bfr[4];
            const int c = ks * 4 + (lane >> 4);
#pragma unroll
            for (int mi = 0; mi < 4; ++mi) af[mi] = *(const bf16x8*)(At + lds_off(wm * 64 + mi * 16 + (lane & 15), c));
#pragma unroll
            for (int ni = 0; ni < 4; ++ni) bfr[ni] = *(const bf16x8*)(Bt + lds_off(wn * 64 + ni * 16 + (lane & 15), c));
#pragma unroll
            for (int mi = 0; mi < 4; ++mi)
#pragma unroll
                for (int ni = 0; ni < 4; ++ni) acc[mi][ni] = __builtin_amdgcn_mfma_f32_16x16x32_bf16(bfr[ni], af[mi], acc[mi][ni], 0, 0, 0);
        }
        if (kt + 1 < nk) {
            unsigned char* An = lds + ((kt + 1) & 1) * 49152;
#pragma unroll
            for (int i = 0; i < 4; ++i) { const int q = tid + 512 * i; *(uint4*)(An + lds_off(q >> 3, q & 7)) = ra[i]; }
#pragma unroll
            for (int i = 0; i < 2; ++i) { const int q = tid + 512 * i; *(uint4*)(An + 32768 + lds_off(q >> 3, q & 7)) = rb[i]; }
        }
        __syncthreads();
    }
    epi(acc, wm, wn, lane);
}

__device__ __forceinline__ void convert_tile(const float* src0, const float* src1, int mode, int K, int N, int ld, bf16_t* dst, int rt, int kt, float* smem) {
    int tid_ = threadIdx.x; asm volatile("" : "+v"(tid_)); const int tid = tid_;
    __syncthreads();
    { const int k = tid >> 3, R0 = rt * 64 + (tid & 7) * 8;
      const float* sp; int col;
      if (mode == 0) { sp = src0; col = R0; } else { sp = (R0 & 32) ? src1 : src0; col = (R0 >> 6) * 32 + (R0 & 31); }
      float4 a = make_float4(0.f, 0.f, 0.f, 0.f), b = a;
      const float* rp = sp + (size_t)(kt * 64 + k) * ld + col;
      if (col < N) a = *(const float4*)rp;
      if (col + 4 < N) b = *(const float4*)(rp + 4);
      float* d = smem + k * 65 + (tid & 7) * 8;
      d[0] = a.x; d[1] = a.y; d[2] = a.z; d[3] = a.w; d[4] = b.x; d[5] = b.y; d[6] = b.z; d[7] = b.w; }
    __syncthreads();
    { const int R = tid >> 3, kc = (tid & 7) * 8;
      float v[8];
#pragma unroll
      for (int j = 0; j < 8; ++j) v[j] = smem[(kc + j) * 65 + R];
      uint4 o; o.x = cvt_pk_bf16(v[0], v[1]); o.y = cvt_pk_bf16(v[2], v[3]); o.z = cvt_pk_bf16(v[4], v[5]); o.w = cvt_pk_bf16(v[6], v[7]);
      *(uint4*)(dst + (size_t)(rt * 64 + R) * K + kt * 64 + kc) = o; }
}

extern __shared__ __attribute__((aligned(16))) unsigned char g_smem[];
#define PHASE_FN __device__ __forceinline__
enum { PH_PROLOGUE = 0, PH_NORM_MIX, PH_GEMM_IN_EVEN, PH_EVEN_TOK, PH_GDN_CHUNK, PH_GDN_SCAN, PH_DSA_TOPK, PH_DSA_ATTN, PH_GDN_OUT,
       PH_GEMM_OUT, PH_NORM_FFN, PH_MOE1, PH_MOE2, PH_GEMM_IN_ODD, PH_GLA_TOK, PH_GLA_CHUNK, PH_GLA_SCAN, PH_GLA_OUT, PH_FINAL };

PHASE_FN void ph_prologue(const Params& p, float* smem) {
    smem = (float*)g_smem;
    int tid_ = threadIdx.x; asm volatile("" : "+v"(tid_)); const int tid = tid_, nthr = gridDim.x * NTHREADS, gid = blockIdx.x * NTHREADS + tid;
    { const float4* src = (const float4*)p.x; float4* dst = (float4*)p.X;
      for (size_t i = gid; i < (size_t)NT * ND / 4; i += nthr) dst[i] = src[i]; }
    for (int i = tid; i < 2 * ND; i += NTHREADS) smem[i] = siluf_(p.c[i]);
    __syncthreads();
    float* MOD = (float*)(p.ws + OFF_MOD);
    { float* red = smem + 2048;
      const int lane = tid & 63, wv = tid >> 6;
      for (int item = blockIdx.x; item < 4 * 96; item += gridDim.x) {
          const int l = item / 96, n = (item % 96) * 64 + lane;
          const float* w = p.ada_w + (size_t)l * ND * 6144 + n;
          float a0 = 0.f, a1 = 0.f;
#pragma unroll 8
          for (int k = wv * 128; k < wv * 128 + 128; ++k) { const float wv_ = w[(size_t)k * 6144]; a0 += smem[k] * wv_; a1 += smem[ND + k] * wv_; }
          __syncthreads();
          red[(wv * 64 + lane) * 2] = a0; red[(wv * 64 + lane) * 2 + 1] = a1;
          __syncthreads();
          if (tid < 128) { const int c = tid >> 1, bb = tid & 1; float a = 0.f; for (int w8 = 0; w8 < 8; ++w8) a += red[(w8 * 64 + c) * 2 + bb];
              MOD[(l * 2 + bb) * 6144 + (item % 96) * 64 + c] = a + p.ada_b[l * 6144 + (item % 96) * 64 + c]; }
      }
      __syncthreads(); }
    float* COSA = (float*)(p.ws + OFF_COSA); float* SINA = (float*)(p.ws + OFF_SINA);
    float* COSI = (float*)(p.ws + OFF_COSI); float* SINI = (float*)(p.ws + OFF_SINI);
    for (size_t i = gid; i < (size_t)NT * 64; i += nthr) {
        const int t = (int)(i >> 6), j = (int)(i & 63);
        double s, c; sincos_d((double)p.pos[t] * ipow_d(p.rA, j), s, c);
        COSA[i] = (float)c; SINA[i] = (float)s;
    }
    for (size_t i = gid; i < (size_t)NT * 32; i += nthr) {
        const int t = (int)(i >> 5), j = (int)(i & 31);
        double s, c; sincos_d((double)p.pos[t] * ipow_d(p.rI, j), s, c);
        COSI[i] = (float)c; SINI[i] = (float)s;
    }
}

PHASE_FN void ph_rows(const Params& p, int layer, int mode, float* smem) {
    smem = (float*)g_smem;
    int tid_ = threadIdx.x; asm volatile("" : "+v"(tid_)); const int tid = tid_, lane = tid & 63, wv = tid >> 6;
    int* pad = (int*)smem;
    const int moe_layer = (mode == 1) ? 3 : layer - 1;
    if (moe_layer >= 0) {
        if (tid == 0) { const int* cnt = (const int*)(p.ws + OFF_CNT) + moe_layer * 32 * CSTR; int a = 0; for (int e = 0; e < 32; ++e) { pad[e] = a; a += ((cnt[e * CSTR] + 127) / 128) * 128; } }
        __syncthreads();
    }
    const float* MOD = (const float*)(p.ws + OFF_MOD);
    float* H = (float*)(p.ws + OFF_H);
    const float* YB = (const float*)(p.ws + OFF_YB);
    const int* ASG = (const int*)(p.ws + OFF_ASG);
    const float* GATE = (const float*)(p.ws + OFF_GATE);
    for (int row = blockIdx.x * 8 + wv; row < NT; row += gridDim.x * 8) {
        const int b = row >> 13;
        float* xr = p.X + (size_t)row * ND;
        float xv[16];
#pragma unroll
        for (int j = 0; j < 4; ++j) { const float4 v = *(const float4*)(xr + j * 256 + lane * 4); xv[4 * j] = v.x; xv[4 * j + 1] = v.y; xv[4 * j + 2] = v.z; xv[4 * j + 3] = v.w; }
        if (moe_layer >= 0) {
            const float* gt = MOD + (size_t)(moe_layer * 2 + b) * 6144 + 5 * 1024;
            const int e0 = ASG[row * 4 + 0], r0 = ASG[row * 4 + 1], e1 = ASG[row * 4 + 2], r1 = ASG[row * 4 + 3];
            const float g0 = GATE[row * 2], g1 = GATE[row * 2 + 1];
            const float* y0 = YB + (size_t)(pad[e0] + r0) * ND;
            const float* y1 = YB + (size_t)(pad[e1] + r1) * ND;
#pragma unroll
            for (int j = 0; j < 4; ++j) {
                const int col = j * 256 + lane * 4;
                const float4 a = *(const float4*)(y0 + col), bq = *(const float4*)(y1 + col), g = *(const float4*)(gt + col);
                xv[4 * j] += g.x * (g0 * a.x + g1 * bq.x); xv[4 * j + 1] += g.y * (g0 * a.y + g1 * bq.y);
                xv[4 * j + 2] += g.z * (g0 * a.z + g1 * bq.z); xv[4 * j + 3] += g.w * (g0 * a.w + g1 * bq.w);
                if (mode == 0) *(float4*)(xr + col) = make_float4(xv[4 * j], xv[4 * j + 1], xv[4 * j + 2], xv[4 * j + 3]);
            }
        }
        float ss = 0.f;
#pragma unroll
        for (int j = 0; j < 16; ++j) ss += xv[j] * xv[j];
        ss = wave_sum(ss);
        const float rstd = rsqrtf(ss * (1.f / 1024.f) + EPS);
        if (mode == 0) {
            const float* nw = p.norm_mix + layer * 1024;
            const float* sh = MOD + (size_t)(layer * 2 + b) * 6144;
            const float* sc = sh + 1024;
#pragma unroll
            for (int j = 0; j < 4; ++j) {
                const int col = j * 256 + lane * 4;
                const float4 w = *(const float4*)(nw + col), s4 = *(const float4*)(sc + col), h4 = *(const float4*)(sh + col);
                float4 o;
                o.x = xv[4 * j] * rstd * w.x * (1.f + s4.x) + h4.x; o.y = xv[4 * j + 1] * rstd * w.y * (1.f + s4.y) + h4.y;
                o.z = xv[4 * j + 2] * rstd * w.z * (1.f + s4.z) + h4.z; o.w = xv[4 * j + 3] * rstd * w.w * (1.f + s4.w) + h4.w;
                *(float4*)(H + (size_t)row * ND + col) = o;
            }
        } else {
#pragma unroll
            for (int j = 0; j < 4; ++j) {
                const int col = j * 256 + lane * 4;
                const float4 w = *(const float4*)(p.final_norm + col);
                *(float4*)(xr + col) = make_float4(xv[4 * j] * rstd * w.x, xv[4 * j + 1] * rstd * w.y, xv[4 * j + 2] * rstd * w.z, xv[4 * j + 3] * rstd * w.w);
            }
        }
    }
}

PHASE_FN void ph_gemm_in(const Params& p, int layer, bool even, float* smem) {
    smem = (float*)g_smem;
    const int N = even ? 3916 : 3088, ntn = even ? 31 : 25;
    const bf16_t* Wt = even ? (const bf16_t*)(p.ws + OFF_WINE) + (size_t)(layer >> 1) * 3968 * 1024 : (const bf16_t*)(p.ws + OFF_WINO) + (size_t)(layer >> 1) * 3200 * 1024;
    const float* H = (const float*)(p.ws + OFF_H);
    float* P = (float*)(p.ws + OFF_P);
    for (int tile = blockIdx.x; tile < 64 * ntn; tile += gridDim.x) {
        const int mt = tile % 64, nt = tile / 64;
        const float* Ab = H + (size_t)mt * 256 * 1024;
        const bf16_t* Bb = Wt + (size_t)nt * 128 * 1024;
        float* Pt = P + (size_t)mt * 256 * LDP + nt * 128;
        const int nrem = N - nt * 128;
        gemm_tile_bf16(1024, (unsigned char*)smem,
            [=](int i, int r, int k) -> uint4 { const float* sp = Ab + (size_t)r * 1024 + k; return pack8(*(const float4*)sp, *(const float4*)(sp + 4)); },
            [=](int i, int r, int k) -> uint4 { return *(const uint4*)(Bb + (size_t)r * 1024 + k); },
            [=](const f32x4 (&acc)[4][4], int wm, int wn, int lane) {
#pragma unroll
                for (int mi = 0; mi < 4; ++mi)
#pragma unroll
                    for (int ni = 0; ni < 4; ++ni) {
                        const int m = wm * 64 + mi * 16 + (lane & 15), n = wn * 64 + ni * 16 + 4 * (lane >> 4);
                        if (n < nrem) *(f32x4*)(Pt + (size_t)m * LDP + n) = acc[mi][ni];
                    }
            });
    }
}

PHASE_FN void ph_even_tok(const Params& p, int layer, float* smem) {
    smem = (float*)g_smem;
    int tid_ = threadIdx.x; asm volatile("" : "+v"(tid_)); const int tid = tid_, lane = tid & 63, wv = tid >> 6, li = layer >> 1;
    const float* P = (const float*)(p.ws + OFF_P);
    const float* cw = p.conv_w + (size_t)li * 4 * 1536;
    float* QN = (float*)(p.ws + OFF_QN); float* KN = (float*)(p.ws + OFF_KN); float* VC = (float*)(p.ws + OFF_VC);
    float* BETA = (float*)(p.ws + OFF_BETA); float* G = (float*)(p.ws + OFF_G);
    bf16_t* QB = (bf16_t*)(p.ws + OFF_QBB); bf16_t* KB = (bf16_t*)(p.ws + OFF_KBB); bf16_t* QI = (bf16_t*)(p.ws + OFF_QIB); bf16_t* KI = (bf16_t*)(p.ws + OFF_KIB); float* WI = (float*)(p.ws + OFF_WI);
    const float* COSA = (const float*)(p.ws + OFF_COSA); const float* SINA = (const float*)(p.ws + OFF_SINA);
    const float* COSI = (const float*)(p.ws + OFF_COSI); const float* SINI = (const float*)(p.ws + OFF_SINI);
    for (int t = blockIdx.x * 8 + wv; t < NT; t += gridDim.x * 8) {
        const int s = t & 8191;
        const float* Pt = P + (size_t)t * LDP;
        auto convs = [&](int c) -> float {
            float a = 0.f;
#pragma unroll
            for (int j = 0; j < 4; ++j) { if (s - 3 + j >= 0) a += cw[j * 1536 + c] * P[(size_t)(t - 3 + j) * LDP + c]; }
            return siluf_(a);
        };
#pragma unroll 1
        for (int h = 0; h < 4; ++h) {
            const float q0 = convs(h * 128 + lane), q1 = convs(h * 128 + 64 + lane);
            float ss = wave_sum(q0 * q0 + q1 * q1);
            float r = rsqrtf(ss + EPS);
            QN[(size_t)t * 512 + h * 128 + lane] = q0 * r; QN[(size_t)t * 512 + h * 128 + 64 + lane] = q1 * r;
            const float k0 = convs(512 + h * 128 + lane), k1 = convs(512 + h * 128 + 64 + lane);
            ss = wave_sum(k0 * k0 + k1 * k1);
            r = rsqrtf(ss + EPS);
            KN[(size_t)t * 512 + h * 128 + lane] = k0 * r; KN[(size_t)t * 512 + h * 128 + 64 + lane] = k1 * r;
            VC[(size_t)t * 512 + h * 128 + lane] = convs(1024 + h * 128 + lane);
            VC[(size_t)t * 512 + h * 128 + 64 + lane] = convs(1024 + h * 128 + 64 + lane);
        }
        if (lane < 4) {
            const float ba = Pt[2048 + lane], aa = Pt[2052 + lane];
            BETA[t * 4 + lane] = sigmoidf_(ba);
            G[t * 4 + lane] = -expf(p.a_log[li * 4 + lane]) * softplusf_(aa + p.dt_bias[li * 4 + lane]);
            WI[t * 4 + lane] = Pt[3912 + lane] * 0.0625f;
        }
        { const float c = COSA[(size_t)t * 64 + lane], sn = SINA[(size_t)t * 64 + lane];
#pragma unroll
          for (int h = 0; h < 4; ++h) {
              float t1 = Pt[2056 + h * 128 + lane], t2 = Pt[2056 + h * 128 + 64 + lane];
              QB[(size_t)t * 512 + h * 128 + lane] = f2bf(t1 * c - t2 * sn); QB[(size_t)t * 512 + h * 128 + 64 + lane] = f2bf(t2 * c + t1 * sn);
              t1 = Pt[2568 + h * 128 + lane]; t2 = Pt[2568 + h * 128 + 64 + lane];
              KB[(size_t)t * 512 + h * 128 + lane] = f2bf(t1 * c - t2 * sn); KB[(size_t)t * 512 + h * 128 + 64 + lane] = f2bf(t2 * c + t1 * sn);
          } }
#pragma unroll
        for (int r = 0; r < 2; ++r) {
            const int item = lane + 64 * r, hh = item >> 5, ii = item & 31;
            const float c = COSI[(size_t)t * 32 + ii], sn = SINI[(size_t)t * 32 + ii];
            const float t1 = Pt[3592 + hh * 64 + ii], t2 = Pt[3592 + hh * 64 + 32 + ii];
            QI[(size_t)t * 256 + hh * 64 + ii] = f2bf(t1 * c - t2 * sn); QI[(size_t)t * 256 + hh * 64 + 32 + ii] = f2bf(t2 * c + t1 * sn);
        }
        if (lane < 32) {
            const float c = COSI[(size_t)t * 32 + lane], sn = SINI[(size_t)t * 32 + lane];
            const float t1 = Pt[3848 + lane], t2 = Pt[3848 + 32 + lane];
            KI[(size_t)t * 64 + lane] = f2bf(t1 * c - t2 * sn); KI[(size_t)t * 64 + 32 + lane] = f2bf(t2 * c + t1 * sn);
        }
    }
    { bf16_t* VT = (bf16_t*)(p.ws + OFF_VT);
      bf16_t* sv = (bf16_t*)g_smem;
      for (int item = blockIdx.x; item < 2 * 128 * 4; item += gridDim.x) {
          const int h = item & 3, tt = item >> 2, b = tt >> 7, s0 = (tt & 127) * 64;
          __syncthreads();
          for (int e = tid; e < 64 * 128; e += NTHREADS) { const int i = e >> 7, d = e & 127; sv[d * 72 + i] = f2bf(P[(size_t)(b * 8192 + s0 + i) * LDP + 3080 + h * 128 + d]); }
          __syncthreads();
          for (int e = tid; e < 128 * 8; e += NTHREADS) { const int d = e >> 3, c = e & 7;
              *(uint4*)(VT + ((size_t)((b * 4 + h) * 128 + d)) * 8192 + s0 + c * 8) = *(const uint4*)(sv + d * 72 + c * 8); }
      } }
}

__device__ __forceinline__ f32x4 mma_lds(const unsigned char* A, int sa, int a0, const unsigned char* B, int sb, int b0, int K, f32x4 acc, int c16, int q4) {
    const unsigned char* ap = A + (a0 + c16) * sa + q4 * 16;
    const unsigned char* bp = B + (b0 + c16) * sb + q4 * 16;
    for (int kk = 0; kk < K; kk += 32) { acc = __builtin_amdgcn_mfma_f32_16x16x32_bf16(*(const bf16x8*)(ap + kk * 2), *(const bf16x8*)(bp + kk * 2), acc, 0, 0, 0); }
    return acc;
}
__device__ __forceinline__ uint2 pack4(const f32x4 v) { uint2 r; r.x = cvt_pk_bf16(v[0], v[1]); r.y = cvt_pk_bf16(v[2], v[3]); return r; }
__device__ __forceinline__ uint2 pack4s(f32x4 v) { for (int r = 0; r < 4; ++r) if (!(fabsf(v[r]) < 1e4f)) v[r] = 0.f; return pack4(v); }
__device__ __forceinline__ f32x4 unpack4(const uint2 u) { f32x4 r; r[0] = __uint_as_float(u.x << 16); r[1] = __uint_as_float(u.x & 0xffff0000u); r[2] = __uint_as_float(u.y << 16); r[3] = __uint_as_float(u.y & 0xffff0000u); return r; }

PHASE_FN void ph_gdn_chunk(const Params& p, float* smem) {
    int tid_ = threadIdx.x; asm volatile("" : "+v"(tid_)); const int tid = tid_, lane = tid & 63, wv = __builtin_amdgcn_readfirstlane(tid >> 6), q4 = lane >> 4, c16 = lane & 15;
    unsigned char* lds = g_smem;
    constexpr int SN = 272, ST = 144;
    unsigned char* bKN = lds;
    unsigned char* bQN = lds + 18432;
    unsigned char* bKBG = lds + 35840;
    unsigned char* bVB = lds + 54272;
    unsigned char* bKD = lds + 72704;
    unsigned char* bUT = lds + 91136;
    float* sL = (float*)(lds + 109568);
    unsigned char* bAQK = lds + 126208;
    unsigned char* bTB = lds + 135424;
    float* sG = (float*)(lds + 144640); float* sB = sG + 64; float* sEg = sB + 64;
    const float* QN = (const float*)(p.ws + OFF_QN); const float* KN = (const float*)(p.ws + OFF_KN); const float* VC = (const float*)(p.ws + OFF_VC);
    const float* BETA = (const float*)(p.ws + OFF_BETA); const float* G = (const float*)(p.ws + OFF_G);
    uint4* PFR = (uint4*)(p.ws + OFF_PFR); uint4* RFR = (uint4*)(p.ws + OFF_RFR); uint2* QFR = (uint2*)(p.ws + OFF_QFR); uint2* OFR = (uint2*)(p.ws + OFF_OFR);
    float* GL = (float*)(p.ws + OFF_GL);
    for (int ci = blockIdx.x; ci < 1024; ci += gridDim.x) {
        const int b = ci >> 9, h = (ci >> 7) & 3, n = ci & 127;
        const int t0 = b * 8192 + n * 64;
        __syncthreads();
        if (tid < 64) { float g = G[(t0 + tid) * 4 + h];
#pragma unroll
            for (int o = 1; o < 64; o <<= 1) { const float nb = __shfl_up(g, o); if (lane >= o) g += nb; }
            sG[tid] = g; sB[tid] = BETA[(t0 + tid) * 4 + h]; sEg[tid] = expf(g); }
        for (int e = tid; e < 64 * 36; e += NTHREADS) ((unsigned*)bAQK)[e] = 0u;
        __syncthreads();
        const float gl = sG[63];
        for (int e = tid; e < 8192; e += NTHREADS) {
            const int i = e >> 7, d = e & 127;
            const float kf = KN[(size_t)(t0 + i) * 512 + h * 128 + d], qf = QN[(size_t)(t0 + i) * 512 + h * 128 + d], vf = VC[(size_t)(t0 + i) * 512 + h * 128 + d];
            const float be = sB[i];
            *(bf16_t*)(bKN + i * SN + d * 2) = f2bf(kf);
            *(bf16_t*)(bQN + i * SN + d * 2) = f2bf(qf);
            *(bf16_t*)(bKBG + d * ST + i * 2) = f2bf(kf * be * sEg[i]);
            *(bf16_t*)(bVB + d * ST + i * 2) = f2bf(vf * be);
            *(bf16_t*)(bKD + d * ST + i * 2) = f2bf(kf * expf(gl - sG[i]));
        }
        __syncthreads();
        for (int u = wv; u < 20; u += 8) {
            const int kind = (u >= 10) ? 1 : 0, idx = u - kind * 10;
            const int ti = (idx >= 6) ? 3 : (idx >= 3) ? 2 : (idx >= 1) ? 1 : 0, tj = idx - ((ti * (ti + 1)) >> 1);
            f32x4 acc = (f32x4){0.f, 0.f, 0.f, 0.f};
            acc = mma_lds(kind ? bQN : bKN, SN, 16 * ti, bKN, SN, 16 * tj, 128, acc, c16, q4);
            const int j = 16 * tj + c16;
#pragma unroll
            for (int r = 0; r < 4; ++r) { const int i = 16 * ti + 4 * q4 + r;
                const float dec = (j <= i) ? expf(sG[i] - sG[j]) : 0.f;
                if (kind == 0) sL[i * 65 + j] = (j < i) ? sB[i] * acc[r] * dec : 0.f;
                else *(bf16_t*)(bAQK + i * ST + j * 2) = f2bf(acc[r] * SCALE128 * dec); }
        }
        __syncthreads();
        if (wv == 0) {
            float t[64];
            int zz = 0; asm volatile("" : "+v"(zz)); const float* sLo = sL + zz;
#pragma unroll
            for (int i = 0; i < 64; ++i) { float a = (i == lane) ? 1.f : 0.f;
#pragma unroll
                for (int j = 0; j < i; ++j) a -= sLo[i * 65 + j] * t[j];
                t[i] = a; asm volatile("" ::: "memory"); }
#pragma unroll
            for (int i = 0; i < 64; ++i) *(bf16_t*)(bTB + i * ST + lane * 2) = f2bf(t[i]);
        }
        __syncthreads();
        for (int x = 0; x < 8; ++x) {
            const int u = wv * 8 + x, kind = u >> 5, ti = (u >> 3) & 3, td = u & 7;
            f32x4 acc = (f32x4){0.f, 0.f, 0.f, 0.f};
            acc = mma_lds(bTB, ST, 16 * ti, kind ? bVB : bKBG, ST, 16 * td, 64, acc, c16, q4);
            *(uint2*)((kind ? bUT : bKN) + (16 * td + c16) * ST + (16 * ti + 4 * q4) * 2) = pack4(acc);
        }
        __syncthreads();
        unsigned char* bWT = bKN;
        const float eg = expf(gl);
        for (int x = 0; x < 4; ++x) {
            const int u = wv * 4 + x, ti = u >> 2, a = u & 3;
            uint4 fr;
#pragma unroll
            for (int hf = 0; hf < 2; ++hf) { const int tk = 2 * a + hf;
                f32x4 acc = (f32x4){0.f, 0.f, 0.f, 0.f};
                acc = mma_lds(bWT, ST, 16 * tk, bKD, ST, 16 * ti, 64, acc, c16, q4);
                f32x4 v;
#pragma unroll
                for (int r = 0; r < 4; ++r) v[r] = ((16 * tk + 4 * q4 + r) == (16 * ti + c16) ? eg : 0.f) - acc[r];
                const uint2 pk = pack4(v);
                if (hf == 0) { fr.x = pk.x; fr.y = pk.y; } else { fr.z = pk.x; fr.w = pk.y; } }
            PFR[((size_t)(ci * 8 + ti) * 4 + a) * 64 + lane] = fr;
        }
        for (int x = 0; x < 2; ++x) {
            const int u = wv * 2 + x, ti = u >> 2, a = u & 3;
            uint4 fr;
            const int i = 16 * ti + c16;
            const float qs = SCALE128 * sEg[i];
#pragma unroll
            for (int hf = 0; hf < 2; ++hf) { const int tk = 2 * a + hf;
                f32x4 acc = (f32x4){0.f, 0.f, 0.f, 0.f};
                acc = mma_lds(bWT, ST, 16 * tk, bAQK, ST, 16 * ti, 64, acc, c16, q4);
                const f32x4 qv = unpack4(*(const uint2*)(bQN + i * SN + (16 * tk + 4 * q4) * 2));
                const uint2 pk = pack4(qv * qs - acc);
                if (hf == 0) { fr.x = pk.x; fr.y = pk.y; } else { fr.z = pk.x; fr.w = pk.y; } }
            RFR[((size_t)(ci * 4 + ti) * 4 + a) * 64 + lane] = fr;
        }
        for (int x = 0; x < 8; ++x) {
            const int u = wv * 8 + x, tdv = u >> 3, tdk = u & 7;
            f32x4 acc = (f32x4){0.f, 0.f, 0.f, 0.f};
            acc = mma_lds(bKD, ST, 16 * tdk, bUT, ST, 16 * tdv, 64, acc, c16, q4);
            QFR[((size_t)(ci * 8 + tdv) * 8 + tdk) * 64 + lane] = pack4(acc);
        }
        for (int x = 0; x < 4; ++x) {
            const int u = wv * 4 + x, tdv = u >> 2, ti = u & 3;
            f32x4 acc = (f32x4){0.f, 0.f, 0.f, 0.f};
            if (PROBE_CONST == 2) acc = mma_lds(bTB, ST, 16 * ti, bTB, ST, 16 * (tdv & 3), 64, acc, c16, q4); else if (PROBE_CONST == 3) acc = mma_lds(bAQK, ST, 16 * ti, bAQK, ST, 16 * (tdv & 3), 64, acc, c16, q4); else if (PROBE_CONST == 4) acc = mma_lds(bUT, ST, 16 * ti, bUT, ST, 16 * tdv, 64, acc, c16, q4); else if (PROBE_CONST == 5) acc = mma_lds(bVB, ST, 16 * ti, bVB, ST, 16 * tdv, 64, acc, c16, q4); else if (PROBE_CONST == 6) { acc = mma_lds(bTB, ST, 16 * ti, bVB, ST, 16 * tdv, 64, acc, c16, q4); for (int r = 0; r < 4; ++r) acc[r] = (fabsf(acc[r]) < 100.f) ? 1.f : __builtin_nanf(""); } else if (PROBE_CONST == 7) { acc = unpack4(*(const uint2*)(bUT + (16 * tdv + c16) * ST + (16 * ti + 4 * q4) * 2)); for (int r = 0; r < 4; ++r) acc[r] = (fabsf(acc[r]) < 100.f) ? 1.f : __builtin_nanf(""); } else acc = mma_lds(bAQK, ST, 16 * ti, bUT, ST, 16 * tdv, 64, acc, c16, q4);
            OFR[((size_t)(ci * 8 + tdv) * 4 + ti) * 64 + lane] = (PROBE_CONST == 1) ? pack4((f32x4){0.5f, 0.5f, 0.5f, 0.5f}) : (PROBE_CONST >= 2) ? pack4s((f32x4){0.5f, 0.5f, 0.5f, 0.5f} + acc * 0.f) : pack4(acc);
        }
        if (tid == 0) GL[ci] = gl;
    }
}

__device__ __forceinline__ void gs_load(uint4 (&d)[12], const unsigned char* pp, const unsigned char* rr, const unsigned char* qq, const unsigned char* oo, const int lt) {
#pragma unroll
    for (int i = 0; i < 6; ++i) { int c = lt + 384 * i; c = c < 2048 ? c : 2047; d[i] = *(const uint4*)(pp + c * 16); }
#pragma unroll
    for (int i = 0; i < 3; ++i) { int c = lt + 384 * i; c = c < 1024 ? c : 1023; d[6 + i] = *(const uint4*)(rr + c * 16); }
#pragma unroll
    for (int i = 0; i < 2; ++i) { int c = lt + 384 * i; c = c < 512 ? c : 511; d[9 + i] = *(const uint4*)(qq + c * 16); }
    { const int c = lt < 256 ? lt : 255; d[11] = *(const uint4*)(oo + c * 16); }
}
__device__ __forceinline__ void gs_store(const uint4 (&d)[12], unsigned char* sb, const int lt) {
#pragma unroll
    for (int i = 0; i < 6; ++i) { const int c = lt + 384 * i; if (c < 2048) *(uint4*)(sb + c * 16) = d[i]; }
#pragma unroll
    for (int i = 0; i < 3; ++i) { const int c = lt + 384 * i; if (c < 1024) *(uint4*)(sb + 32768 + c * 16) = d[6 + i]; }
#pragma unroll
    for (int i = 0; i < 2; ++i) { const int c = lt + 384 * i; if (c < 512) *(uint4*)(sb + 49152 + c * 16) = d[9 + i]; }
    if (lt < 256) *(uint4*)(sb + 57344 + lt * 16) = d[11];
}

#define SCAN_BODY                 bf16x8 Sb[4]; \
_Pragma("unroll") \
                for (int a = 0; a < 4; ++a) { union { uint4 u; bf16x8 v; } cv; const uint2 lo = pack4(S[2 * a]), hi = pack4(S[2 * a + 1]); cv.u.x = lo.x; cv.u.y = lo.y; cv.u.z = hi.x; cv.u.w = hi.y; Sb[a] = cv.v; } \
                const int t0 = b * 8192 + n * 64; \
                {   f32x4 oa[4]; \
_Pragma("unroll") \
                    for (int ti = 0; ti < 4; ++ti) oa[ti] = unpack4(*(const uint2*)(Of + ti * 512)); \
_Pragma("unroll") \
                    for (int a = 0; a < 4; ++a) \
_Pragma("unroll") \
                        for (int ti = 0; ti < 4; ++ti) { if (PROBE_NOR == 0) oa[ti] = __builtin_amdgcn_mfma_f32_16x16x32_bf16(*(const bf16x8*)(Rf + (ti * 4 + a) * 1024), Sb[a], oa[ti], 0, 0, 0); } \
_Pragma("unroll") \
                    for (int ti = 0; ti < 4; ++ti) { \
                        float* op = O + (size_t)(t0 + 16 * ti + 4 * q4) * 1024 + h * 128 + 16 * tdv + c16; \
                        op[0] = oa[ti][0]; op[1024] = oa[ti][1]; op[2048] = oa[ti][2]; op[3072] = oa[ti][3]; } \
                } \
                asm volatile("" ::: "memory"); \
_Pragma("unroll") \
                for (int g = 0; g < 2; ++g) { \
                    f32x4 sa[4]; \
_Pragma("unroll") \
                    for (int t = 0; t < 4; ++t) sa[t] = unpack4(*(const uint2*)(Qf + (g * 4 + t) * 512)); \
_Pragma("unroll") \
                    for (int a = 0; a < 4; ++a) \
_Pragma("unroll") \
                        for (int t = 0; t < 4; ++t) { if (PROBE_NOP == 0) sa[t] = __builtin_amdgcn_mfma_f32_16x16x32_bf16(*(const bf16x8*)(Pf + ((g * 4 + t) * 4 + a) * 1024), Sb[a], sa[t], 0, 0, 0); } \
_Pragma("unroll") \
                    for (int t = 0; t < 4; ++t) S[g * 4 + t] = sa[t]; \
                    asm volatile("" ::: "memory"); \
                }
PHASE_FN void ph_gdn_scan(const Params& p, float* smem) {
    int tid_ = threadIdx.x; asm volatile("" : "+v"(tid_)); const int tid = tid_, lane = tid & 63, wv = __builtin_amdgcn_readfirstlane(tid >> 6), q4 = lane >> 4, c16 = lane & 15;
    unsigned char* lds = g_smem;
    constexpr int STG = 61440;
    const unsigned char* PFR = p.ws + OFF_PFR; const unsigned char* RFR = p.ws + OFF_RFR; const unsigned char* QFR = p.ws + OFF_QFR; const unsigned char* OFR = p.ws + OFF_OFR;
    float* O = (float*)(p.ws + OFF_O);
    for (int it = blockIdx.x; it < 32; it += gridDim.x) {
        const int bh = it >> 2, pair = it & 3, b = bh >> 2, h = bh & 3;
        __syncthreads();
        if (SCAN_DIRECT) { if (wv < 2) {
            const int tdv = pair * 2 + wv;
            f32x4 S[8];
#pragma unroll
            for (int t = 0; t < 8; ++t) S[t] = (f32x4){0.f, 0.f, 0.f, 0.f};
            for (int n = 0; n < 128; ++n) {
                const int ci = bh * 128 + n;
                const unsigned char* Pf = PFR + (size_t)ci * 32768 + lane * 16, *Rf = RFR + (size_t)ci * 16384 + lane * 16;
                const unsigned char* Qf = QFR + (size_t)ci * 32768 + tdv * 4096 + lane * 8, *Of = OFR + (size_t)ci * 16384 + tdv * 2048 + lane * 8;
                SCAN_BODY
            } }
        } else if (wv >= 2) {
            const int lt = tid - 128;
            const unsigned char* Pb = PFR + (size_t)bh * 128 * 32768;
            const unsigned char* Rb = RFR + (size_t)bh * 128 * 16384;
            const unsigned char* Qb = QFR + (size_t)bh * 128 * 32768 + pair * 8192;
            const unsigned char* Ob = OFR + (size_t)bh * 128 * 16384 + pair * 4096;
            uint4 ra0, ra1, ra2, ra3, ra4, ra5, ra6, ra7, ra8, ra9, ra10, ra11, rb0, rb1, rb2, rb3, rb4, rb5, rb6, rb7, rb8, rb9, rb10, rb11;
#define LDC(base_, c_, mx_) (*(const uint4*)((base_) + (size_t)(((c_) < (mx_)) ? (c_) : (mx_)) * 16))
#define GS_LOAD(X, n_) do { const unsigned char* pp_ = Pb + (size_t)(n_) * 32768; const unsigned char* rr_ = Rb + (size_t)(n_) * 16384; \
                const unsigned char* qq_ = Qb + (size_t)(n_) * 32768; const unsigned char* oo_ = Ob + (size_t)(n_) * 16384; \
                X##0 = LDC(pp_, lt, 2047); X##1 = LDC(pp_, lt + 384, 2047); X##2 = LDC(pp_, lt + 768, 2047); X##3 = LDC(pp_, lt + 1152, 2047); X##4 = LDC(pp_, lt + 1536, 2047); X##5 = LDC(pp_, lt + 1920, 2047); \
                X##6 = LDC(rr_, lt, 1023); X##7 = LDC(rr_, lt + 384, 1023); X##8 = LDC(rr_, lt + 768, 1023); \
                X##9 = LDC(qq_, lt, 511); X##10 = LDC(qq_, lt + 384, 511); X##11 = LDC(oo_, lt, 255); } while (0)
#define STC(off_, c_, lim_, v_) do { if ((c_) < (lim_)) *(uint4*)(sb_ + (off_) + (c_) * 16) = v_; } while (0)
#define GS_STORE(X, st_) do { unsigned char* sb_ = lds + (st_) * STG; \
                STC(0, lt, 2048, X##0); STC(0, lt + 384, 2048, X##1); STC(0, lt + 768, 2048, X##2); STC(0, lt + 1152, 2048, X##3); STC(0, lt + 1536, 2048, X##4); STC(0, lt + 1920, 2048, X##5); \
                STC(32768, lt, 1024, X##6); STC(32768, lt + 384, 1024, X##7); STC(32768, lt + 768, 1024, X##8); \
                STC(49152, lt, 512, X##9); STC(49152, lt + 384, 512, X##10); STC(57344, lt, 256, X##11); } while (0)
            GS_LOAD(ra, 0); GS_STORE(ra, 0);
            GS_LOAD(rb, 1); GS_LOAD(ra, 2);
            __syncthreads();
            for (int n = 0; n < 128; n += 2) {
                GS_STORE(rb, 1);
                GS_LOAD(rb, (n + 3 < 128) ? n + 3 : 127);
                __syncthreads();
                if (n + 2 < 128) GS_STORE(ra, 0);
                GS_LOAD(ra, (n + 4 < 128) ? n + 4 : 127);
                __syncthreads();
            }
        } else {
            const int tdv = pair * 2 + wv;
            f32x4 S[8];
#pragma unroll
            for (int t = 0; t < 8; ++t) S[t] = (f32x4){0.f, 0.f, 0.f, 0.f};
            __syncthreads();
            for (int n = 0; n < 128; ++n) {
                const unsigned char* base = lds + (n & 1) * STG;
                const unsigned char* Pf = base + lane * 16, *Rf = base + 32768 + lane * 16;
                const unsigned char* Qf = base + 49152 + wv * 4096 + lane * 8, *Of = base + 57344 + wv * 2048 + lane * 8;
                SCAN_BODY
                __syncthreads();
            }
        }
    }
}

__device__ __forceinline__ void block_sum4(int (&v)[4], int* buf) {
    const int lane = threadIdx.x & 63, wv = threadIdx.x >> 6;
#pragma unroll
    for (int q = 0; q < 4; ++q) v[q] = wave_sum_i(v[q]);
    if (lane == 0) {
#pragma unroll
        for (int q = 0; q < 4; ++q) buf[wv * 4 + q] = v[q];
    }
    __syncthreads();
#pragma unroll
    for (int q = 0; q < 4; ++q) { int a = 0; for (int w = 0; w < 8; ++w) a += buf[w * 4 + q]; v[q] = a; }
}

PHASE_FN void ph_dsa_topk(const Params& p, float* smem) {
    int tid_ = threadIdx.x; asm volatile("" : "+v"(tid_)); const int tid = tid_, lane = tid & 63, wv = __builtin_amdgcn_readfirstlane(tid >> 6), q4 = lane >> 4, c16 = lane & 15;
    int* sRed = (int*)g_smem;
    const bf16_t* QIb = (const bf16_t*)(p.ws + OFF_QIB); const bf16_t* KIb = (const bf16_t*)(p.ws + OFF_KIB); const float* WI = (const float*)(p.ws + OFF_WI);
    unsigned short* M16 = (unsigned short*)(p.ws + OFF_M16);
    for (int it = blockIdx.x; it < 4096; it += gridDim.x) {
        const int k = it >> 8, j = (it & 255) >> 1, b = it & 1;
        const int grp = (k & 1) ? 2047 - ((k >> 1) * 128 + j) : (k >> 1) * 128 + j;
        const int s0 = grp * 4, t0 = b * 8192 + s0;
        const int ntiles = (s0 >> 4) + 1;
        const int nreg = (ntiles > wv) ? ((ntiles - wv + 7) >> 3) : 0;
        const bf16x8 a0 = *(const bf16x8*)(QIb + (size_t)(t0 + (c16 >> 2)) * 256 + (c16 & 3) * 64 + 8 * q4);
        const bf16x8 a1 = *(const bf16x8*)(QIb + (size_t)(t0 + (c16 >> 2)) * 256 + (c16 & 3) * 64 + 32 + 8 * q4);
        const float4 wq = *(const float4*)(WI + (size_t)(t0 + q4) * 4);
        const int myq = s0 + q4;
        int c16s = c16; asm volatile("" : "+v"(c16s));
        unsigned keys[64];
#pragma unroll
        for (int i = 0; i < 64; ++i) keys[i] = 0u;
#pragma unroll
        for (int blk = 0; blk < 4; ++blk) if (nreg > blk * 16) {
#pragma unroll
            for (int ii = 0; ii < 16; ++ii) { const int i = blk * 16 + ii, tile = wv + 8 * i;
                if (tile < ntiles) {
                    const bf16_t* kp = KIb + (size_t)(b * 8192 + tile * 16 + c16s) * 64 + 8 * q4;
                    const bf16x8 k0 = *(const bf16x8*)kp, k1 = *(const bf16x8*)(kp + 32);
                    f32x4 acc = (f32x4){0.f, 0.f, 0.f, 0.f};
                    acc = __builtin_amdgcn_mfma_f32_16x16x32_bf16(a0, k0, acc, 0, 0, 0);
                    acc = __builtin_amdgcn_mfma_f32_16x16x32_bf16(a1, k1, acc, 0, 0, 0);
                    float sc = 0.f;
                    sc += wq.x * fmaxf(acc[0], 0.f); sc += wq.y * fmaxf(acc[1], 0.f); sc += wq.z * fmaxf(acc[2], 0.f); sc += wq.w * fmaxf(acc[3], 0.f);
                    keys[i] = (tile * 16 + c16s <= myq) ? ordkey(sc) : 0u;
                }
                if ((ii & 3) == 3) asm volatile("" ::: "memory"); }
        }
        const int keff = (myq + 1 < 256) ? (myq + 1) : 256;
        int par = 0;
        auto qsum = [&](int c) -> int {
            c += __shfl_xor(c, 1); c += __shfl_xor(c, 2); c += __shfl_xor(c, 4); c += __shfl_xor(c, 8);
            par ^= 1;
            if (c16 == 0) sRed[par * 32 + wv * 4 + q4] = c;
            __syncthreads();
            int a = 0;
#pragma unroll
            for (int w = 0; w < 8; ++w) a += sRed[par * 32 + w * 4 + q4];
            return a;
        };
        unsigned U = 0u;
        for (int bit = 31; bit >= 0; --bit) {
            const unsigned cand = U | (1u << bit);
            int c = 0;
#pragma unroll
            for (int blk = 0; blk < 4; ++blk) if (nreg > blk * 16) {
#pragma unroll
                for (int ii = 0; ii < 16; ++ii) c += (keys[blk * 16 + ii] >= cand) ? 1 : 0;
            }
            if (qsum(c) >= keff) U = cand;
        }
        int cg = 0, ce = 0;
#pragma unroll
        for (int i = 0; i < 64; ++i) { cg += (keys[i] > U) ? 1 : 0; ce += (keys[i] == U) ? 1 : 0; }
        cg = qsum(cg); ce = qsum(ce);
        const int need = keff - cg;
        int J = 8191;
        par ^= 1;
        if (c16 == 0) sRed[par * 32 + wv * 4 + q4] = (ce > need) ? 1 : 0;
        __syncthreads();
        int anyov = 0;
#pragma unroll
        for (int w = 0; w < 32; ++w) anyov |= sRed[par * 32 + w];
        if (anyov) {
            J = 0;
            int c16j = c16; asm volatile("" : "+v"(c16j));
            for (int bit = 12; bit >= 0; --bit) {
                const int cj = J | (1 << bit);
                int c = 0;
#pragma unroll
                for (int i = 0; i < 64; ++i) c += (keys[i] == U && ((wv + 8 * i) * 16 + c16j) < cj) ? 1 : 0;
                if (qsum(c) <= need - 1) J = cj;
            }
        }
        int c16e = c16; asm volatile("" : "+v"(c16e));
#pragma unroll
        for (int i = 0; i < 64; ++i) {
            const int tile = wv + 8 * i;
            const bool sel = keys[i] > U || (keys[i] == U && (tile * 16 + c16e) <= J);
            const unsigned long long bal = __ballot(sel);
            if (c16 == 0) M16[(size_t)(t0 + q4) * 512 + tile] = (unsigned short)((bal >> (16 * q4)) & 0xffffull);
        }
    }
}

PHASE_FN void ph_dsa_attn(const Params& p, float* smem) {
    int tid_ = threadIdx.x; asm volatile("" : "+v"(tid_)); const int tid = tid_, lane = tid & 63, wv = tid >> 6, q4 = lane >> 4, c16 = lane & 15;
    unsigned char* lds = g_smem;
    const bf16_t* QBb = (const bf16_t*)(p.ws + OFF_QBB); const bf16_t* KBb = (const bf16_t*)(p.ws + OFF_KBB); const bf16_t* VT = (const bf16_t*)(p.ws + OFF_VT);
    const unsigned short* M16 = (const unsigned short*)(p.ws + OFF_M16);
    float* O = (float*)(p.ws + OFF_O);
    const float SC = SCALE128 * 1.4426950408889634f;
    for (int it = blockIdx.x; it < 256; it += gridDim.x) {
        const int bh = it & 7, jp = it >> 3, b = bh >> 2, h = bh & 3;
        for (int half = 0; half < 2; ++half) {
            const int jq = half ? jp : 63 - jp;
            const int qs = jq * 128, nkt = 2 * jq + 2;
            const int tq = b * 8192 + qs + wv * 16 + c16;
            bf16x8 qf[4];
#pragma unroll
            for (int a = 0; a < 4; ++a) qf[a] = *(const bf16x8*)(QBb + (size_t)tq * 512 + h * 128 + 8 * q4 + 32 * a);
            float m = -1e30f, lsum = 0.f;
            f32x4 oacc[8];
#pragma unroll
            for (int t = 0; t < 8; ++t) oacc[t] = (f32x4){0.f, 0.f, 0.f, 0.f};
            uint4 rk0, rk1, rv0, rv1;
            const int q0 = tid, q1 = tid + 512;
            const bf16_t* kg0 = KBb + (size_t)(b * 8192 + (q0 >> 4)) * 512 + h * 128 + (q0 & 15) * 8;
            const bf16_t* kg1 = KBb + (size_t)(b * 8192 + (q1 >> 4)) * 512 + h * 128 + (q1 & 15) * 8;
            const bf16_t* vg0 = VT + ((size_t)((b * 4 + h) * 128 + (q0 >> 3))) * 8192 + (q0 & 7) * 8;
            const bf16_t* vg1 = VT + ((size_t)((b * 4 + h) * 128 + (q1 >> 3))) * 8192 + (q1 & 7) * 8;
            const int lk0 = (q0 >> 4) * 256 + ((((q0 & 15)) ^ ((q0 >> 4) & 15)) << 4), lk1 = (q1 >> 4) * 256 + ((((q1 & 15)) ^ ((q1 >> 4) & 15)) << 4);
            const int lv0 = 16384 + (q0 >> 3) * 128 + ((((q0 & 7)) ^ ((q0 >> 3) & 7)) << 4), lv1 = 16384 + (q1 >> 3) * 128 + ((((q1 & 7)) ^ ((q1 >> 3) & 7)) << 4);
#define ATT_GLOAD(kt_) do { rk0 = *(const uint4*)(kg0 + (size_t)(kt_) * 64 * 512); rk1 = *(const uint4*)(kg1 + (size_t)(kt_) * 64 * 512); \
                            rv0 = *(const uint4*)(vg0 + (kt_) * 64); rv1 = *(const uint4*)(vg1 + (kt_) * 64); } while (0)
#define ATT_LSTORE(st_) do { unsigned char* base_ = lds + (st_) * 32768; *(uint4*)(base_ + lk0) = rk0; *(uint4*)(base_ + lk1) = rk1; *(uint4*)(base_ + lv0) = rv0; *(uint4*)(base_ + lv1) = rv1; } while (0)
            __syncthreads();
            ATT_GLOAD(0); ATT_LSTORE(0);
            __syncthreads();
            for (int kt = 0; kt < nkt; ++kt) {
                if (kt + 1 < nkt) ATT_GLOAD(kt + 1);
                const unsigned long long mbits = *(const unsigned long long*)(M16 + (size_t)tq * 512 + 4 * kt);
                const unsigned char* Kt = lds + (kt & 1) * 32768;
                const unsigned char* Vt = Kt + 16384;
                f32x4 sacc[4];
#pragma unroll
                for (int ti = 0; ti < 4; ++ti) { sacc[ti] = (f32x4){0.f, 0.f, 0.f, 0.f};
                    const int row = 16 * ti + c16;
#pragma unroll
                    for (int a = 0; a < 4; ++a) { const bf16x8 kf = *(const bf16x8*)(Kt + row * 256 + ((((q4 + 4 * a)) ^ (row & 15)) << 4));
                        sacc[ti] = __builtin_amdgcn_mfma_f32_16x16x32_bf16(kf, qf[a], sacc[ti], 0, 0, 0); } }
                float mx = m;
#pragma unroll
                for (int ti = 0; ti < 4; ++ti)
#pragma unroll
                    for (int r = 0; r < 4; ++r) { const bool valid = (mbits >> (16 * ti + 4 * q4 + r)) & 1ull; const float v = sacc[ti][r] * SC; sacc[ti][r] = v; mx = fmaxf(mx, valid ? v : -1e30f); }
                mx = fmaxf(mx, __shfl_xor(mx, 16)); mx = fmaxf(mx, __shfl_xor(mx, 32));
                const float alpha = __builtin_amdgcn_exp2f(m - mx); m = mx;
                float ps = 0.f;
#pragma unroll
                for (int ti = 0; ti < 4; ++ti)
#pragma unroll
                    for (int r = 0; r < 4; ++r) { const bool valid = (mbits >> (16 * ti + 4 * q4 + r)) & 1ull; const float pv = valid ? __builtin_amdgcn_exp2f(sacc[ti][r] - mx) : 0.f; sacc[ti][r] = pv; ps += pv; }
                lsum = lsum * alpha + ps;
#pragma unroll
                for (int t = 0; t < 8; ++t) oacc[t] = oacc[t] * alpha;
                bf16x8 pb[2];
#pragma unroll
                for (int a = 0; a < 2; ++a) {
                    union { uint4 u; bf16x8 v; } cv;
                    cv.u.x = cvt_pk_bf16(sacc[2 * a][0], sacc[2 * a][1]); cv.u.y = cvt_pk_bf16(sacc[2 * a][2], sacc[2 * a][3]);
                    cv.u.z = cvt_pk_bf16(sacc[2 * a + 1][0], sacc[2 * a + 1][1]); cv.u.w = cvt_pk_bf16(sacc[2 * a + 1][2], sacc[2 * a + 1][3]);
                    pb[a] = cv.v; }
#pragma unroll
                for (int t = 0; t < 8; ++t) { const int row = 16 * t + c16;
#pragma unroll
                    for (int a = 0; a < 2; ++a) {
                        union { uint2 h2[2]; bf16x8 v; } vf;
                        vf.h2[0] = *(const uint2*)(Vt + row * 128 + ((((4 * a + (q4 >> 1))) ^ (row & 7)) << 4) + 8 * (q4 & 1));
                        vf.h2[1] = *(const uint2*)(Vt + row * 128 + ((((4 * a + 2 + (q4 >> 1))) ^ (row & 7)) << 4) + 8 * (q4 & 1));
                        oacc[t] = __builtin_amdgcn_mfma_f32_16x16x32_bf16(vf.v, pb[a], oacc[t], 0, 0, 0); } }
                if (kt + 1 < nkt) ATT_LSTORE((kt + 1) & 1);
                __syncthreads();
            }
            lsum += __shfl_xor(lsum, 16); lsum += __shfl_xor(lsum, 32);
            const float inv = 1.f / lsum;
#pragma unroll
            for (int t = 0; t < 8; ++t) *(f32x4*)(O + (size_t)tq * 1024 + 512 + h * 128 + 16 * t + 4 * q4) = oacc[t] * inv;
        }
    }
}

PHASE_FN void ph_gdn_out(const Params& p, int layer) {
    int tid_ = threadIdx.x; asm volatile("" : "+v"(tid_)); const int tid = tid_, lane = tid & 63, wv = tid >> 6;
    float* O = (float*)(p.ws + OFF_O); const float* P = (const float*)(p.ws + OFF_P);
    const float* onw = p.gdn_out_norm + (layer >> 1) * 128;
    for (int t = blockIdx.x * 8 + wv; t < NT; t += gridDim.x * 8) {
#pragma unroll
        for (int h = 0; h < 4; ++h) {
            float* op = O + (size_t)t * 1024 + h * 128;
            const float o0 = op[lane], o1 = op[64 + lane];
            const float ss = wave_sum(o0 * o0 + o1 * o1);
            const float r = rsqrtf(ss * (1.f / 128.f) + EPS);
            const float z0 = P[(size_t)t * LDP + 1536 + h * 128 + lane], z1 = P[(size_t)t * LDP + 1536 + h * 128 + 64 + lane];
            op[lane] = o0 * r * onw[lane] * siluf_(z0); op[64 + lane] = o1 * r * onw[64 + lane] * siluf_(z1);
        }
    }
}

PHASE_FN void ph_gemm_out(const Params& p, int layer, float* smem) {
    smem = (float*)g_smem;
    const bf16_t* Wt = (const bf16_t*)(p.ws + OFF_WOUT) + (size_t)layer * 1024 * 1024;
    const float* MOD = (const float*)(p.ws + OFF_MOD);
    const float* O = (const float*)(p.ws + OFF_O);
    for (int tile = blockIdx.x; tile < 64 * 8; tile += gridDim.x) {
        const int mt = tile % 64, nt = tile / 64;
        const float* Ab = O + (size_t)mt * 256 * 1024;
        const bf16_t* Bb = Wt + (size_t)nt * 128 * 1024;
        const int b = (mt * 256) >> 13;
        const float* gt = MOD + (size_t)(layer * 2 + b) * 6144 + 2048 + nt * 128;
        float* Xt = p.X + (size_t)mt * 256 * ND + nt * 128;
        gemm_tile_bf16(1024, (unsigned char*)smem,
            [=](int i, int r, int k) -> uint4 { const float* sp = Ab + (size_t)r * 1024 + k; return pack8(*(const float4*)sp, *(const float4*)(sp + 4)); },
            [=](int i, int r, int k) -> uint4 { return *(const uint4*)(Bb + (size_t)r * 1024 + k); },
            [=](const f32x4 (&acc)[4][4], int wm, int wn, int lane) {
#pragma unroll
                for (int mi = 0; mi < 4; ++mi)
#pragma unroll
                    for (int ni = 0; ni < 4; ++ni) {
                        const int m = wm * 64 + mi * 16 + (lane & 15), n = wn * 64 + ni * 16 + 4 * (lane >> 4);
                        const f32x4 g = *(const f32x4*)(gt + n);
                        f32x4* xp = (f32x4*)(Xt + (size_t)m * ND + n);
                        *xp = *xp + g * acc[mi][ni];
                    }
            });
    }
}

PHASE_FN void ph_norm_ffn(const Params& p, int layer) {
    int tid_ = threadIdx.x; asm volatile("" : "+v"(tid_)); const int tid = tid_, lane = tid & 63, wv = tid >> 6;
    const float* MOD = (const float*)(p.ws + OFF_MOD);
    float* H = (float*)(p.ws + OFF_H);
    int* CNT = (int*)(p.ws + OFF_CNT) + layer * 32 * CSTR;
    int* sCnt = (int*)g_smem; int* sBase = sCnt + 32; int* sE = sBase + 32; int* sR = sE + 256;
    const int nrb = (NT + (int)gridDim.x - 1) / (int)gridDim.x, row_lo = blockIdx.x * nrb, row_hi = (row_lo + nrb < NT) ? row_lo + nrb : NT;
    __syncthreads();
    if (tid < 32) sCnt[tid] = 0;
    __syncthreads();
    int* ASG = (int*)(p.ws + OFF_ASG); float* GATE = (float*)(p.ws + OFF_GATE); int* LIST = (int*)(p.ws + OFF_LIST);
    const float* nw = p.norm_ffn + layer * 1024;
    const float* wg = p.rg_w + (size_t)layer * 1024 * 4;
    for (int row = row_lo + wv; row < row_hi; row += 8) {
        const int b = row >> 13;
        const float* xr = p.X + (size_t)row * ND;
        const float* sh = MOD + (size_t)(layer * 2 + b) * 6144 + 3072;
        const float* sc = sh + 1024;
        float hv[16]; float ss = 0.f;
#pragma unroll
        for (int j = 0; j < 4; ++j) { const float4 v = *(const float4*)(xr + j * 256 + lane * 4); hv[4 * j] = v.x; hv[4 * j + 1] = v.y; hv[4 * j + 2] = v.z; hv[4 * j + 3] = v.w; }
#pragma unroll
        for (int j = 0; j < 16; ++j) ss += hv[j] * hv[j];
        ss = wave_sum(ss);
        const float rstd = rsqrtf(ss * (1.f / 1024.f) + EPS);
#pragma unroll
        for (int j = 0; j < 4; ++j) {
            const int col = j * 256 + lane * 4;
            const float4 w = *(const float4*)(nw + col), s4 = *(const float4*)(sc + col), h4 = *(const float4*)(sh + col);
            hv[4 * j] = hv[4 * j] * rstd * w.x * (1.f + s4.x) + h4.x; hv[4 * j + 1] = hv[4 * j + 1] * rstd * w.y * (1.f + s4.y) + h4.y;
            hv[4 * j + 2] = hv[4 * j + 2] * rstd * w.z * (1.f + s4.z) + h4.z; hv[4 * j + 3] = hv[4 * j + 3] * rstd * w.w * (1.f + s4.w) + h4.w;
            *(float4*)(H + (size_t)row * ND + col) = make_float4(hv[4 * j], hv[4 * j + 1], hv[4 * j + 2], hv[4 * j + 3]);
        }
        float gl[4] = {0.f, 0.f, 0.f, 0.f};
#pragma unroll
        for (int j = 0; j < 4; ++j)
#pragma unroll
            for (int e = 0; e < 4; ++e) { const int col = j * 256 + lane * 4 + e; const float4 w = *(const float4*)(wg + (size_t)col * 4); const float hh = hv[4 * j + e];
                gl[0] += hh * w.x; gl[1] += hh * w.y; gl[2] += hh * w.z; gl[3] += hh * w.w; }
#pragma unroll
        for (int g = 0; g < 4; ++g) gl[g] = wave_sum(gl[g]) + p.rg_b[layer * 4 + g];
        int gs = 0; float gm = gl[0];
#pragma unroll
        for (int g = 1; g < 4; ++g) if (gl[g] > gm) { gm = gl[g]; gs = g; }
        float gsum = 0.f;
#pragma unroll
        for (int g = 0; g < 4; ++g) gsum += expf(gl[g] - gm);
        const float ggate = 1.f / gsum;
        const float* we = p.re_w + ((size_t)(layer * 4 + gs) * 1024) * 8;
        float el[8] = {0.f, 0.f, 0.f, 0.f, 0.f, 0.f, 0.f, 0.f};
#pragma unroll
        for (int j = 0; j < 4; ++j)
#pragma unroll
            for (int e = 0; e < 4; ++e) { const int col = j * 256 + lane * 4 + e; const float4 w0 = *(const float4*)(we + (size_t)col * 8), w1 = *(const float4*)(we + (size_t)col * 8 + 4); const float hh = hv[4 * j + e];
                el[0] += hh * w0.x; el[1] += hh * w0.y; el[2] += hh * w0.z; el[3] += hh * w0.w; el[4] += hh * w1.x; el[5] += hh * w1.y; el[6] += hh * w1.z; el[7] += hh * w1.w; }
#pragma unroll
        for (int e = 0; e < 8; ++e) el[e] = wave_sum(el[e]) + p.re_b[(layer * 4 + gs) * 8 + e];
        int i1 = 0; float l1 = el[0];
#pragma unroll
        for (int e = 1; e < 8; ++e) if (el[e] > l1) { l1 = el[e]; i1 = e; }
        int i2 = -1; float l2 = -INFINITY;
#pragma unroll
        for (int e = 0; e < 8; ++e) if (e != i1 && el[e] > l2) { l2 = el[e]; i2 = e; }
        const float ex = expf(l2 - l1);
        const float p1 = 1.f / (1.f + ex), p2 = ex / (1.f + ex);
        if (lane == 0) {
            const int e1 = gs * 8 + i1, e2 = gs * 8 + i2, lr = row - row_lo;
            sE[lr * 2] = e1; sE[lr * 2 + 1] = e2;
            sR[lr * 2] = atomicAdd(&sCnt[e1], 1); sR[lr * 2 + 1] = atomicAdd(&sCnt[e2], 1);
            GATE[row * 2] = ggate * p1; GATE[row * 2 + 1] = ggate * p2;
        }
    }
    __syncthreads();
    if (tid < 32) sBase[tid] = (sCnt[tid] > 0) ? atomicAdd(&CNT[tid * CSTR], sCnt[tid]) : 0;
    __syncthreads();
    for (int a = tid; a < (row_hi - row_lo) * 2; a += NTHREADS) {
        const int row = row_lo + (a >> 1), e = sE[a], r = sBase[e] + sR[a];
        LIST[(size_t)e * LISTCAP + r] = row;
        ASG[row * 4 + (a & 1) * 2] = e; ASG[row * 4 + (a & 1) * 2 + 1] = r;
    }
}

PHASE_FN void ph_moe(const Params& p, int layer, int which, float* smem) {
    smem = (float*)g_smem;
    int tid_ = threadIdx.x; asm volatile("" : "+v"(tid_)); const int tid = tid_;
    int* sPad = (int*)(g_smem + 98304); int* sTs = sPad + 33;
    const int* CNT = (const int*)(p.ws + OFF_CNT) + layer * 32 * CSTR;
    __syncthreads();
    if (tid == 0) { int a = 0, ts = 0; for (int e = 0; e < 32; ++e) { sPad[e] = a; sTs[e] = ts; a += ((CNT[e * CSTR] + 127) / 128) * 128; ts += (CNT[e * CSTR] + 255) / 256; } sTs[32] = ts; sPad[32] = a; }
    __syncthreads();
    const int total = sTs[32] * 8;
    float* HID = (float*)(p.ws + OFF_HID); float* YB = (float*)(p.ws + OFF_YB);
    const float* H = (const float*)(p.ws + OFF_H);
    const int* LIST = (const int*)(p.ws + OFF_LIST);
    for (int tile = blockIdx.x; tile < total; tile += gridDim.x) {
        const int mt = tile >> 3, nt = tile & 7;
        int e = 0;
        for (int q = 1; q < 32; ++q) if (sTs[q] <= mt) e = q;
        const int mi0 = mt - sTs[e];
        const int cnt = CNT[e * CSTR];
        const int mvalid = (cnt - mi0 * 256 < 256) ? (cnt - mi0 * 256) : 256;
        const int rowbase = sPad[e] + mi0 * 256;
        if (which == 0) {
            long ro[4];
#pragma unroll
            for (int i = 0; i < 4; ++i) { const int r = (tid + 512 * i) >> 3; ro[i] = (r < mvalid) ? (long)LIST[(size_t)e * LISTCAP + mi0 * 256 + r] * 1024 : -1; }
            const long ro0 = ro[0], ro1 = ro[1], ro2 = ro[2], ro3 = ro[3];
            const bf16_t* Bb = (const bf16_t*)(p.ws + OFF_W13) + (size_t)e * 1024 * 1024 + (size_t)nt * 128 * 1024;
            float* Ht = HID + (size_t)rowbase * 512 + nt * 64;
            gemm_tile_bf16(1024, (unsigned char*)smem,
                [=](int i, int r, int k) -> uint4 { const long o = (i == 0) ? ro0 : (i == 1) ? ro1 : (i == 2) ? ro2 : ro3; if (o < 0) return make_uint4(0u, 0u, 0u, 0u);
                    const float* sp = H + o + k; return pack8(*(const float4*)sp, *(const float4*)(sp + 4)); },
                [=](int i, int r, int k) -> uint4 { return *(const uint4*)(Bb + (size_t)r * 1024 + k); },
                [=](const f32x4 (&acc)[4][4], int wm, int wn, int lane) {
#pragma unroll
                    for (int mi = 0; mi < 4; ++mi)
#pragma unroll
                        for (int ni = 0; ni < 2; ++ni) {
                            const int m = wm * 64 + mi * 16 + (lane & 15), n = wn * 32 + ni * 16 + 4 * (lane >> 4);
                            const f32x4 a1 = acc[mi][ni], a3 = acc[mi][ni + 2];
                            f32x4 hv; hv[0] = siluf_(a1[0]) * a3[0]; hv[1] = siluf_(a1[1]) * a3[1]; hv[2] = siluf_(a1[2]) * a3[2]; hv[3] = siluf_(a1[3]) * a3[3];
                            if (m < mvalid) *(f32x4*)(Ht + (size_t)m * 512 + n) = hv;
                        }
                });
        } else {
            const float* Ab = HID + (size_t)rowbase * 512;
            const bf16_t* Bb = (const bf16_t*)(p.ws + OFF_W2T) + (size_t)e * 1024 * 512 + (size_t)nt * 128 * 512;
            float* Yt = YB + (size_t)rowbase * 1024 + nt * 128;
            gemm_tile_bf16(512, (unsigned char*)smem,
                [=](int i, int r, int k) -> uint4 { if (r >= mvalid) return make_uint4(0u, 0u, 0u, 0u); const float* sp = Ab + (size_t)r * 512 + k; return pack8(*(const float4*)sp, *(const float4*)(sp + 4)); },
                [=](int i, int r, int k) -> uint4 { return *(const uint4*)(Bb + (size_t)r * 512 + k); },
                [=](const f32x4 (&acc)[4][4], int wm, int wn, int lane) {
#pragma unroll
                    for (int mi = 0; mi < 4; ++mi)
#pragma unroll
                        for (int ni = 0; ni < 4; ++ni) {
                            const int m = wm * 64 + mi * 16 + (lane & 15), n = wn * 64 + ni * 16 + 4 * (lane >> 4);
                            if (m < mvalid) *(f32x4*)(Yt + (size_t)m * 1024 + n) = acc[mi][ni];
                        }
                });
        }
    }
}

PHASE_FN void ph_conv_dense(const Params& p, float* smem) {
    smem = (float*)g_smem;
    for (int t = blockIdx.x; t < 1984 + 1600 + 1024; t += gridDim.x) {
        if (t < 1984) { const int l = t / 992, u = t % 992;
            convert_tile(p.even_w_in + (size_t)l * 1024 * 3916, nullptr, 0, 1024, 3916, 3916, (bf16_t*)(p.ws + OFF_WINE) + (size_t)l * 3968 * 1024, u >> 4, u & 15, smem); }
        else if (t < 3584) { const int v = t - 1984, l = v / 800, u = v % 800;
            convert_tile(p.gla_w_in + (size_t)l * 1024 * 3088, nullptr, 0, 1024, 3088, 3088, (bf16_t*)(p.ws + OFF_WINO) + (size_t)l * 3200 * 1024, u >> 4, u & 15, smem); }
        else { const int v = t - 3584, l = v >> 8, u = v & 255;
            convert_tile(((l & 1) ? p.gla_w_out : p.even_w_out) + (size_t)(l >> 1) * 1024 * 1024, nullptr, 0, 1024, 1024, 1024, (bf16_t*)(p.ws + OFF_WOUT) + (size_t)l * 1024 * 1024, u >> 4, u & 15, smem); }
    }
}

PHASE_FN void ph_conv_exp(const Params& p, int layer, float* smem) {
    smem = (float*)g_smem;
    for (int t = blockIdx.x; t < 8192 + 4096; t += gridDim.x) {
        if (t < 8192) { const int e = t >> 8, u = t & 255;
            convert_tile(p.w1 + (size_t)(layer * 32 + e) * 1024 * 512, p.w3 + (size_t)(layer * 32 + e) * 1024 * 512, 1, 1024, 512, 512, (bf16_t*)(p.ws + OFF_W13) + (size_t)e * 1024 * 1024, u >> 4, u & 15, smem); }
        else { const int v = t - 8192, e = v >> 7, u = v & 127;
            convert_tile(p.w2 + (size_t)(layer * 32 + e) * 512 * 1024, nullptr, 0, 512, 1024, 1024, (bf16_t*)(p.ws + OFF_W2T) + (size_t)e * 1024 * 512, u >> 3, u & 7, smem); }
    }
}

PHASE_FN void ph_gla_tok(const Params& p, int layer) {
    int tid_ = threadIdx.x; asm volatile("" : "+v"(tid_)); const int tid = tid_, lane = tid & 63, wv = tid >> 6, li = layer >> 1;
    const float* P = (const float*)(p.ws + OFF_P);
    float* LA = (float*)(p.ws + OFF_LA);
    const float* w2 = p.gla_w_gate2 + (size_t)li * 16 * 512; const float* b2 = p.gla_b_gate2 + li * 512;
    for (int t = blockIdx.x * 8 + wv; t < NT; t += gridDim.x * 8) {
        float glr[16];
#pragma unroll
        for (int r = 0; r < 16; ++r) glr[r] = P[(size_t)t * LDP + 3072 + r];
#pragma unroll 1
        for (int i = 0; i < 8; ++i) {
            const int c = lane + 64 * i; float z = b2[c];
#pragma unroll
            for (int r = 0; r < 16; ++r) z += glr[r] * w2[r * 512 + c];
            LA[(size_t)t * 512 + c] = -softplusf_(-z) * (1.f / 16.f);
        }
    }
}

PHASE_FN void ph_gla_chunk(const Params& p, float* smem) {
    int tid_ = threadIdx.x; asm volatile("" : "+v"(tid_)); const int tid = tid_, lane = tid & 63, wv = __builtin_amdgcn_readfirstlane(tid >> 6), q4 = lane >> 4, c16 = lane & 15;
    unsigned char* lds = g_smem;
    constexpr int SN = 272, ST = 144;
    float* sBc = (float*)lds;
    unsigned char* bQE = lds + 33024;
    unsigned char* bKE = lds + 50432;
    unsigned char* bKD = lds + 67840;
    unsigned char* bVT = lds + 86272;
    unsigned char* bATT = lds + 123136;
    const float* P = (const float*)(p.ws + OFF_P); const float* LA = (const float*)(p.ws + OFF_LA);
    uint4* QEF = (uint4*)(p.ws + OFF_GQE); uint2* OIF = (uint2*)(p.ws + OFF_GOI); uint2* HF = (uint2*)(p.ws + OFF_GH); float* EBL = (float*)(p.ws + OFF_GEBL);
    for (int ci = blockIdx.x; ci < 1024; ci += gridDim.x) {
        const int b = ci >> 9, h = (ci >> 7) & 3, n = ci & 127;
        const int t0 = b * 8192 + n * 64;
        __syncthreads();
        for (int e = tid; e < 8192; e += NTHREADS) { const int i = e >> 7, d = e & 127; sBc[i * 129 + d] = LA[(size_t)(t0 + i) * 512 + h * 128 + d]; }
        for (int e = tid; e < 64 * 36; e += NTHREADS) ((unsigned*)bATT)[e] = 0u;
        __syncthreads();
        if (tid < 128) { float a = 0.f; for (int i = 0; i < 64; ++i) { a += sBc[i * 129 + tid]; sBc[i * 129 + tid] = a; } }
        __syncthreads();
        for (int e = tid; e < 8192; e += NTHREADS) {
            const int i = e >> 7, d = e & 127;
            const float bb = sBc[i * 129 + d], bl = sBc[63 * 129 + d];
            const float qf = P[(size_t)(t0 + i) * LDP + h * 128 + d], kf = P[(size_t)(t0 + i) * LDP + 512 + h * 128 + d];
            *(bf16_t*)(bQE + i * SN + d * 2) = f2bf(qf * SCALE128 * expf(bb));
            *(bf16_t*)(bKE + i * SN + d * 2) = f2bf(kf * expf(-bb));
            *(bf16_t*)(bKD + d * ST + i * 2) = f2bf(kf * expf(bl - bb));
        }
        for (int e = tid; e < 16384; e += NTHREADS) { const int i = e >> 8, dv = e & 255; *(bf16_t*)(bVT + dv * ST + i * 2) = f2bf(P[(size_t)(t0 + i) * LDP + 1024 + h * 256 + dv]); }
        if (tid < 128) EBL[ci * 128 + tid] = expf(sBc[63 * 129 + tid]);
        __syncthreads();
        for (int u = wv; u < 10; u += 8) {
            const int ti = (u >= 6) ? 3 : (u >= 3) ? 2 : (u >= 1) ? 1 : 0, tj = u - ((ti * (ti + 1)) >> 1);
            f32x4 acc = (f32x4){0.f, 0.f, 0.f, 0.f};
            acc = mma_lds(bQE, SN, 16 * ti, bKE, SN, 16 * tj, 128, acc, c16, q4);
            const int j = 16 * tj + c16;
#pragma unroll
            for (int r = 0; r < 4; ++r) { const int i = 16 * ti + 4 * q4 + r; *(bf16_t*)(bATT + i * ST + j * 2) = f2bf((j <= i) ? acc[r] : 0.f); }
        }
        for (int x = 0; x < 2; ++x) {
            const int u = wv * 2 + x, ti = u >> 2, a = u & 3;
            const unsigned char* rp = bQE + (16 * ti + c16) * SN;
            const uint2 lo = *(const uint2*)(rp + (32 * a + 4 * q4) * 2), hi = *(const uint2*)(rp + (32 * a + 16 + 4 * q4) * 2);
            QEF[((size_t)(ci * 4 + ti) * 4 + a) * 64 + lane] = make_uint4(lo.x, lo.y, hi.x, hi.y);
        }
        __syncthreads();
        for (int x = 0; x < 8; ++x) {
            const int u = wv * 8 + x, tdv = u >> 2, ti = u & 3;
            f32x4 acc = (f32x4){0.f, 0.f, 0.f, 0.f};
            acc = mma_lds(bATT, ST, 16 * ti, bVT, ST, 16 * tdv, 64, acc, c16, q4);
            OIF[((size_t)(ci * 16 + tdv) * 4 + ti) * 64 + lane] = pack4(acc);
        }
        for (int x = 0; x < 16; ++x) {
            const int u = wv * 16 + x, tdv = u >> 3, tdk = u & 7;
            f32x4 acc = (f32x4){0.f, 0.f, 0.f, 0.f};
            acc = mma_lds(bKD, ST, 16 * tdk, bVT, ST, 16 * tdv, 64, acc, c16, q4);
            HF[((size_t)(ci * 16 + tdv) * 8 + tdk) * 64 + lane] = pack4(acc);
        }
    }
}

PHASE_FN void ph_gla_scan(const Params& p, float* smem) {
    int tid_ = threadIdx.x; asm volatile("" : "+v"(tid_)); const int tid = tid_, lane = tid & 63, wv = __builtin_amdgcn_readfirstlane(tid >> 6), q4 = lane >> 4, c16 = lane & 15;
    unsigned char* lds = g_smem;
    constexpr int STG = 29184;
    const unsigned char* QEF = p.ws + OFF_GQE; const unsigned char* HF = p.ws + OFF_GH; const unsigned char* OIF = p.ws + OFF_GOI; const unsigned char* EBL = p.ws + OFF_GEBL;
    float* O = (float*)(p.ws + OFF_O);
    for (int it = blockIdx.x; it < 64; it += gridDim.x) {
        const int bh = it >> 3, pair = it & 7, b = bh >> 2, h = bh & 3;
        __syncthreads();
        if (wv >= 2) {
            const int lt = tid - 128;
            const unsigned char* Qb = QEF + (size_t)bh * 128 * 16384;
            const unsigned char* Hb = HF + (size_t)bh * 128 * 65536 + pair * 8192;
            const unsigned char* Ob = OIF + (size_t)bh * 128 * 32768 + pair * 4096;
            const unsigned char* Lb = EBL + (size_t)bh * 128 * 512;
            uint4 ra0, ra1, ra2, ra3, ra4, ra5, ra6, rb0, rb1, rb2, rb3, rb4, rb5, rb6;
#define GL_LOAD(X, n_) do { const unsigned char* q_ = Qb + (size_t)(n_) * 16384; const unsigned char* h_ = Hb + (size_t)(n_) * 65536; \
                const unsigned char* o_ = Ob + (size_t)(n_) * 32768; const unsigned char* l_ = Lb + (size_t)(n_) * 512; \
                X##0 = LDC(q_, lt, 1023); X##1 = LDC(q_, lt + 384, 1023); X##2 = LDC(q_, lt + 768, 1023); \
                X##3 = LDC(h_, lt, 511); X##4 = LDC(h_, lt + 384, 511); X##5 = LDC(o_, lt, 255); X##6 = LDC(l_, lt, 31); } while (0)
#define GL_STORE(X, st_) do { unsigned char* sb_ = lds + (st_) * STG; \
                STC(0, lt, 1024, X##0); STC(0, lt + 384, 1024, X##1); STC(0, lt + 768, 1024, X##2); \
                STC(16384, lt, 512, X##3); STC(16384, lt + 384, 512, X##4); STC(24576, lt, 256, X##5); STC(28672, lt, 32, X##6); } while (0)
            GL_LOAD(ra, 0); GL_STORE(ra, 0);
            GL_LOAD(rb, 1); GL_LOAD(ra, 2);
            __syncthreads();
            for (int n = 0; n < 128; n += 2) {
                GL_STORE(rb, 1);
                GL_LOAD(rb, (n + 3 < 128) ? n + 3 : 127);
                __syncthreads();
                if (n + 2 < 128) GL_STORE(ra, 0);
                GL_LOAD(ra, (n + 4 < 128) ? n + 4 : 127);
                __syncthreads();
            }
        } else {
            const int tdv = pair * 2 + wv;
            f32x4 S[8];
#pragma unroll
            for (int t = 0; t < 8; ++t) S[t] = (f32x4){0.f, 0.f, 0.f, 0.f};
            __syncthreads();
            for (int n = 0; n < 128; ++n) {
                const unsigned char* base = lds + (n & 1) * STG;
                const unsigned char* Qf = base + lane * 16, *Hf = base + 16384 + wv * 4096 + lane * 8, *Of = base + 24576 + wv * 2048 + lane * 8, *Lf = base + 28672 + q4 * 16;
                bf16x8 Sb[4];
#pragma unroll
                for (int a = 0; a < 4; ++a) { union { uint4 u; bf16x8 v; } cv; const uint2 lo = pack4(S[2 * a]), hi = pack4(S[2 * a + 1]); cv.u.x = lo.x; cv.u.y = lo.y; cv.u.z = hi.x; cv.u.w = hi.y; Sb[a] = cv.v; }
                const int t0 = b * 8192 + n * 64;
                f32x4 oa[4];
#pragma unroll
                for (int ti = 0; ti < 4; ++ti) oa[ti] = unpack4(*(const uint2*)(Of + ti * 512));
#pragma unroll
                for (int a = 0; a < 4; ++a)
#pragma unroll
                    for (int ti = 0; ti < 4; ++ti) oa[ti] = __builtin_amdgcn_mfma_f32_16x16x32_bf16(*(const bf16x8*)(Qf + (ti * 4 + a) * 1024), Sb[a], oa[ti], 0, 0, 0);
#pragma unroll
                for (int ti = 0; ti < 4; ++ti) {
                    float* op = O + (size_t)(t0 + 16 * ti + 4 * q4) * 1024 + h * 256 + 16 * tdv + c16;
                    op[0] = oa[ti][0]; op[1024] = oa[ti][1]; op[2048] = oa[ti][2]; op[3072] = oa[ti][3]; }
#pragma unroll
                for (int t = 0; t < 8; ++t) { const f32x4 lam = *(const f32x4*)(Lf + t * 64); S[t] = S[t] * lam + unpack4(*(const uint2*)(Hf + t * 512)); }
                __syncthreads();
            }
        }
    }
}

PHASE_FN void ph_gla_out(const Params& p, int layer) {
    int tid_ = threadIdx.x; asm volatile("" : "+v"(tid_)); const int tid = tid_, lane = tid & 63, wv = tid >> 6;
    float* O = (float*)(p.ws + OFF_O); const float* P = (const float*)(p.ws + OFF_P);
    const float* onw = p.gla_out_norm + (layer >> 1) * 256;
    for (int t = blockIdx.x * 8 + wv; t < NT; t += gridDim.x * 8) {
#pragma unroll
        for (int h = 0; h < 4; ++h) {
            float* op = O + (size_t)t * 1024 + h * 256;
            const float4 o = *(const float4*)(op + lane * 4);
            const float ss = wave_sum(o.x * o.x + o.y * o.y + o.z * o.z + o.w * o.w);
            const float r = rsqrtf(ss * (1.f / 256.f) + EPS);
            const float4 z = *(const float4*)(P + (size_t)t * LDP + 2048 + h * 256 + lane * 4);
            const float4 w = *(const float4*)(onw + lane * 4);
            *(float4*)(op + lane * 4) = make_float4(o.x * r * w.x * siluf_(z.x), o.y * r * w.y * siluf_(z.y), o.z * r * w.z * siluf_(z.z), o.w * r * w.w * siluf_(z.w));
        }
    }
}

template <int PH>
__device__ __forceinline__ void run_phase(const Params& p, int layer, float* smem) {
    if (PH == PH_PROLOGUE) { ph_prologue(p, smem); ph_conv_dense(p, smem); }
    else if (PH == PH_NORM_MIX) ph_rows(p, layer, 0, smem);
    else if (PH == PH_GEMM_IN_EVEN) ph_gemm_in(p, layer, true, smem);
    else if (PH == PH_EVEN_TOK) ph_even_tok(p, layer, smem);
    else if (PH == PH_GDN_CHUNK) ph_gdn_chunk(p, smem);
    else if (PH == PH_GDN_SCAN) ph_gdn_scan(p, smem);
    else if (PH == PH_DSA_TOPK) ph_dsa_topk(p, smem);
    else if (PH == PH_DSA_ATTN) ph_dsa_attn(p, smem);
    else if (PH == PH_GDN_OUT) ph_gdn_out(p, layer);
    else if (PH == PH_GEMM_OUT) ph_gemm_out(p, layer, smem);
    else if (PH == PH_NORM_FFN) { ph_norm_ffn(p, layer); ph_conv_exp(p, layer, smem); }
    else if (PH == PH_MOE1) ph_moe(p, layer, 0, smem);
    else if (PH == PH_MOE2) ph_moe(p, layer, 1, smem);
    else if (PH == PH_GEMM_IN_ODD) ph_gemm_in(p, layer, false, smem);
    else if (PH == PH_GLA_TOK) ph_gla_tok(p, layer);
    else if (PH == PH_GLA_CHUNK) ph_gla_chunk(p, smem);
    else if (PH == PH_GLA_SCAN) ph_gla_scan(p, smem);
    else if (PH == PH_GLA_OUT) ph_gla_out(p, layer);
    else if (PH == PH_FINAL) ph_rows(p, 0, 1, smem);
}

#if MK_MULTI
template <int PH>
__global__ void __launch_bounds__(NTHREADS, 2) k_phase(Params p, int layer) {
    run_phase<PH>(p, layer, (float*)g_smem);
}
#else
__global__ void __launch_bounds__(NTHREADS, 2) k_mega(Params p) {
    float* smem = (float*)g_smem;
    volatile LAS unsigned* xbw = (volatile LAS unsigned*)(LAS unsigned char*)(g_smem + LDS_BYTES - 16);
    if (threadIdx.x == 0) { xbw[0] = 0u; xbw[1] = 0u; xbw[2] = 0u; xbw[3] = 0u; }
    __syncthreads();
    XcdBarrier bar = xcd_barrier_post((unsigned*)(p.ws + OFF_BAR), xbw);
#define BAR() xcd_barrier(bar)
    run_phase<PH_PROLOGUE>(p, 0, smem); BAR(); if (DUP_MASK & 4096) { run_phase<PH_PROLOGUE>(p, 0, smem); BAR(); }
    for (int lp = 0; lp < 2; ++lp) {
        const int le = 2 * lp, lo = 2 * lp + 1;
        run_phase<PH_NORM_MIX>(p, le, smem); BAR();
        run_phase<PH_GEMM_IN_EVEN>(p, le, smem); BAR(); if (DUP_MASK & 1) { run_phase<PH_GEMM_IN_EVEN>(p, le, smem); BAR(); }
        run_phase<PH_EVEN_TOK>(p, le, smem); BAR(); if (DUP_MASK & 2) { run_phase<PH_EVEN_TOK>(p, le, smem); BAR(); }
        run_phase<PH_GDN_CHUNK>(p, le, smem); BAR(); if (DUP_MASK & 4) { run_phase<PH_GDN_CHUNK>(p, le, smem); BAR(); }
        run_phase<PH_GDN_SCAN>(p, le, smem); BAR(); if (DUP_MASK & 8) { run_phase<PH_GDN_SCAN>(p, le, smem); BAR(); }
        run_phase<PH_DSA_TOPK>(p, le, smem); BAR(); if (DUP_MASK & 16) { run_phase<PH_DSA_TOPK>(p, le, smem); BAR(); }
        run_phase<PH_DSA_ATTN>(p, le, smem); BAR(); if (DUP_MASK & 32) { run_phase<PH_DSA_ATTN>(p, le, smem); BAR(); }
        run_phase<PH_GDN_OUT>(p, le, smem); BAR();
        run_phase<PH_GEMM_OUT>(p, le, smem); BAR();
        run_phase<PH_NORM_FFN>(p, le, smem); BAR();
        run_phase<PH_MOE1>(p, le, smem); BAR(); if (DUP_MASK & 64) { run_phase<PH_MOE1>(p, le, smem); BAR(); }
        run_phase<PH_MOE2>(p, le, smem); BAR(); if (DUP_MASK & 128) { run_phase<PH_MOE2>(p, le, smem); BAR(); }
        run_phase<PH_NORM_MIX>(p, lo, smem); BAR();
        run_phase<PH_GEMM_IN_ODD>(p, lo, smem); BAR(); if (DUP_MASK & 256) { run_phase<PH_GEMM_IN_ODD>(p, lo, smem); BAR(); }
        run_phase<PH_GLA_TOK>(p, lo, smem); BAR(); if (DUP_MASK & 512) { run_phase<PH_GLA_TOK>(p, lo, smem); BAR(); }
        run_phase<PH_GLA_CHUNK>(p, lo, smem); BAR(); if (DUP_MASK & 1024) { run_phase<PH_GLA_CHUNK>(p, lo, smem); BAR(); }
        run_phase<PH_GLA_SCAN>(p, lo, smem); BAR(); if (DUP_MASK & 2048) { run_phase<PH_GLA_SCAN>(p, lo, smem); BAR(); }
        run_phase<PH_GLA_OUT>(p, lo, smem); BAR();
        run_phase<PH_GEMM_OUT>(p, lo, smem); BAR();
        run_phase<PH_NORM_FFN>(p, lo, smem); BAR();
        run_phase<PH_MOE1>(p, lo, smem); BAR(); if (DUP_MASK & 64) { run_phase<PH_MOE1>(p, lo, smem); BAR(); }
        run_phase<PH_MOE2>(p, lo, smem); BAR(); if (DUP_MASK & 128) { run_phase<PH_MOE2>(p, lo, smem); BAR(); }
    }
    for (int xb = 0; xb < EXTRA_BARS; ++xb) BAR();
    run_phase<PH_FINAL>(p, 0, smem);
}
#endif

}

#if MK_MULTI
template <int PH>
static void launch_phase(const Params& p, int layer, hipStream_t stream) {
    static bool attr_set = false;
    if (!attr_set) { hipFuncSetAttribute((const void*)k_phase<PH>, hipFuncAttributeMaxDynamicSharedMemorySize, (int)LDS_BYTES); attr_set = true; }
    hipLaunchKernelGGL((k_phase<PH>), dim3(256), dim3(NTHREADS), LDS_BYTES, stream, p, layer);
}
#endif

extern "C" void kernel_launch(void* const* d_in, const int* in_sizes, int n_in, void* d_out, int out_size, void* d_ws, size_t ws_size, hipStream_t stream) {
    (void)in_sizes; (void)n_in; (void)out_size;
    if (ws_size < WS_NEEDED) { fprintf(stderr, "workspace too small: %zu < %zu\n", ws_size, (size_t)WS_NEEDED); return; }
    Params p{};
    p.x = (const float*)d_in[0]; p.c = (const float*)d_in[1]; p.pos = (const int*)d_in[2]; p.ada_w = (const float*)d_in[3]; p.ada_b = (const float*)d_in[4];
    p.norm_mix = (const float*)d_in[5]; p.norm_ffn = (const float*)d_in[6]; p.even_w_in = (const float*)d_in[7]; p.conv_w = (const float*)d_in[8];
    p.a_log = (const float*)d_in[9]; p.dt_bias = (const float*)d_in[10]; p.gdn_out_norm = (const float*)d_in[11]; p.even_w_out = (const float*)d_in[12];
    p.gla_w_in = (const float*)d_in[13]; p.gla_w_gate2 = (const float*)d_in[14]; p.gla_b_gate2 = (const float*)d_in[15]; p.gla_out_norm = (const float*)d_in[16]; p.gla_w_out = (const float*)d_in[17];
    p.rg_w = (const float*)d_in[18]; p.rg_b = (const float*)d_in[19]; p.re_w = (const float*)d_in[20]; p.re_b = (const float*)d_in[21];
    p.w1 = (const float*)d_in[22]; p.w3 = (const float*)d_in[23]; p.w2 = (const float*)d_in[24]; p.final_norm = (const float*)d_in[25];
    p.X = (float*)d_out; p.ws = (unsigned char*)d_ws;
    p.rA = pow(10000.0, -2.0 / 128.0); p.rI = pow(10000.0, -2.0 / 64.0);
    hipMemsetAsync(d_ws, 0, ZERO_BYTES, stream);
#if MK_MULTI
    launch_phase<PH_PROLOGUE>(p, 0, stream);
    for (int lp = 0; lp < 2; ++lp) {
        const int le = 2 * lp, lo = 2 * lp + 1;
        launch_phase<PH_NORM_MIX>(p, le, stream);
        launch_phase<PH_GEMM_IN_EVEN>(p, le, stream);
        launch_phase<PH_EVEN_TOK>(p, le, stream);
        launch_phase<PH_GDN_CHUNK>(p, le, stream);
        launch_phase<PH_GDN_SCAN>(p, le, stream);
        launch_phase<PH_DSA_TOPK>(p, le, stream);
        launch_phase<PH_DSA_ATTN>(p, le, stream);
        launch_phase<PH_GDN_OUT>(p, le, stream);
        launch_phase<PH_GEMM_OUT>(p, le, stream);
        launch_phase<PH_NORM_FFN>(p, le, stream);
        launch_phase<PH_MOE1>(p, le, stream);
        launch_phase<PH_MOE2>(p, le, stream);
        launch_phase<PH_NORM_MIX>(p, lo, stream);
        launch_phase<PH_GEMM_IN_ODD>(p, lo, stream);
        launch_phase<PH_GLA_TOK>(p, lo, stream);
        launch_phase<PH_GLA_CHUNK>(p, lo, stream);
        launch_phase<PH_GLA_SCAN>(p, lo, stream);
        launch_phase<PH_GLA_OUT>(p, lo, stream);
        launch_phase<PH_GEMM_OUT>(p, lo, stream);
        launch_phase<PH_NORM_FFN>(p, lo, stream);
        launch_phase<PH_MOE1>(p, lo, stream);
        launch_phase<PH_MOE2>(p, lo, stream);
    }
    launch_phase<PH_FINAL>(p, 0, stream);
#else
    static int grid = 0;
    if (!grid) {
        int dev = 0, cus = 0, per_cu = 0;
        hipGetDevice(&dev);
        hipDeviceGetAttribute(&cus, hipDeviceAttributeMultiprocessorCount, dev);
        hipFuncSetAttribute((const void*)k_mega, hipFuncAttributeMaxDynamicSharedMemorySize, (int)LDS_BYTES);
        hipOccupancyMaxActiveBlocksPerMultiprocessor(&per_cu, k_mega, NTHREADS, LDS_BYTES);
        if (cus <= 0) cus = 256;
        grid = cus * (per_cu < 1 ? 1 : 1);
    }
    hipLaunchKernelGGL(k_mega, dim3(grid), dim3(NTHREADS), LDS_BYTES, stream, p);
#endif
}
```

```cpp
#include <hip/hip_runtime.h>
#include <stdint.h>
#include <math.h>
#include <stdio.h>

#define EXTRA_BARS 0
#ifndef DUP_MASK
#define DUP_MASK 0
#endif
#ifndef MK_MULTI
#define MK_MULTI 0
#endif

namespace {

constexpr int NT = 16384, ND = 1024, LDP = 3920, LDPB = 3968;
constexpr float EPS = 1e-6f;
constexpr int NTHREADS = 512;
constexpr size_t LDS_BYTES = 147456;
constexpr float SCALE128 = 0.08838834764831845f;
constexpr int LISTCAP = 32768;
constexpr int CSTR = 16;

constexpr size_t OFF_BAR  = 0;
constexpr size_t OFF_CNT  = 16384;
constexpr size_t ZERO_BYTES = 32768;
constexpr size_t OFF_MOD  = 32768;
constexpr size_t OFF_COSA = OFF_MOD + 4 * 2 * 6144 * 4;
constexpr size_t OFF_SINA = OFF_COSA + (size_t)NT * 64 * 4;
constexpr size_t OFF_COSI = OFF_SINA + (size_t)NT * 64 * 4;
constexpr size_t OFF_SINI = OFF_COSI + (size_t)NT * 32 * 4;
constexpr size_t OFF_H    = OFF_SINI + (size_t)NT * 32 * 4;
constexpr size_t OFF_P    = OFF_H + (size_t)NT * 1024 * 4;
constexpr size_t OFF_HID  = OFF_P;
constexpr size_t OFF_YB   = OFF_HID + (size_t)36864 * 512 * 4;
constexpr size_t OFF_O    = OFF_P + (size_t)NT * LDP * 4;
constexpr size_t OFF_ASG  = OFF_O + (size_t)NT * 1024 * 4;
constexpr size_t OFF_GATE = OFF_ASG + (size_t)NT * 4 * 4;
constexpr size_t OFF_LIST = OFF_GATE + (size_t)NT * 2 * 4;
constexpr size_t OFF_R    = OFF_LIST + (size_t)32 * LISTCAP * 4;
constexpr size_t OFF_QN   = OFF_R;
constexpr size_t OFF_KN   = OFF_QN + (size_t)NT * 512 * 4;
constexpr size_t OFF_VC   = OFF_KN + (size_t)NT * 512 * 4;
constexpr size_t OFF_BETA = OFF_VC + (size_t)NT * 512 * 4;
constexpr size_t OFF_G    = OFF_BETA + (size_t)NT * 4 * 4;
constexpr size_t OFF_W    = OFF_G + (size_t)NT * 4 * 4;
constexpr size_t OFF_U    = OFF_W + (size_t)1024 * 8192 * 4;
constexpr size_t OFF_QG   = OFF_U + (size_t)1024 * 8192 * 4;
constexpr size_t OFF_KD   = OFF_QG + (size_t)1024 * 8192 * 4;
constexpr size_t OFF_AQK  = OFF_KD + (size_t)1024 * 8192 * 4;
constexpr size_t OFF_GL   = OFF_AQK + (size_t)1024 * 4096 * 4;
constexpr size_t OFF_QB   = OFF_GL + 4096;
constexpr size_t OFF_KB   = OFF_QB + (size_t)NT * 512 * 4;
constexpr size_t OFF_QI   = OFF_KB + (size_t)NT * 512 * 4;
constexpr size_t OFF_KI   = OFF_QI + (size_t)NT * 256 * 4;
constexpr size_t OFF_WI   = OFF_KI + (size_t)NT * 64 * 4;
constexpr size_t OFF_SEL  = OFF_WI + (size_t)NT * 4 * 4;
constexpr size_t OFF_EVEN_END = OFF_SEL + (size_t)NT * 256 * 4;
constexpr size_t OFF_PFR  = OFF_W;
constexpr size_t OFF_RFR  = OFF_PFR + (size_t)1024 * 32768;
constexpr size_t OFF_QFR  = OFF_RFR + (size_t)1024 * 16384;
constexpr size_t OFF_OFR  = OFF_QFR + (size_t)1024 * 32768;
static_assert(OFF_OFR + (size_t)1024 * 16384 <= OFF_GL, "gdn v2 buffers overflow");
constexpr size_t OFF_QBB  = OFF_QB;
constexpr size_t OFF_KBB  = OFF_QBB + (size_t)NT * 512 * 2;
constexpr size_t OFF_VT   = OFF_KBB + (size_t)NT * 512 * 2;
constexpr size_t OFF_QIB  = OFF_VT + (size_t)NT * 512 * 2;
constexpr size_t OFF_KIB  = OFF_QIB + (size_t)NT * 256 * 2;
constexpr size_t OFF_M16  = OFF_KIB + (size_t)NT * 64 * 2;
static_assert(OFF_M16 + (size_t)NT * 512 * 2 <= OFF_WI, "dsa v2 buffers overflow");
constexpr size_t OFF_LA   = OFF_R;
constexpr size_t OFF_ATT  = OFF_LA + (size_t)NT * 512 * 4;
constexpr size_t OFF_QE   = OFF_ATT + (size_t)1024 * 4096 * 4;
constexpr size_t OFF_GKD  = OFF_QE + (size_t)1024 * 8192 * 4;
constexpr size_t OFF_EBL  = OFF_GKD + (size_t)1024 * 8192 * 4;
constexpr size_t OFF_GQE  = OFF_LA + (size_t)NT * 512 * 4;
constexpr size_t OFF_GOI  = OFF_GQE + (size_t)1024 * 16384;
constexpr size_t OFF_GH   = OFF_GOI + (size_t)1024 * 32768;
constexpr size_t OFF_GEBL = OFF_GH + (size_t)1024 * 65536;
static_assert(OFF_GEBL + (size_t)1024 * 512 <= OFF_EVEN_END, "gla v2 buffers overflow");
constexpr size_t OFF_WINE = OFF_EVEN_END;
constexpr size_t OFF_WINO = OFF_WINE + (size_t)2 * 3968 * 1024 * 2;
constexpr size_t OFF_WOUT = OFF_WINO + (size_t)2 * 3200 * 1024 * 2;
constexpr size_t OFF_W13  = OFF_WOUT + (size_t)4 * 1024 * 1024 * 2;
constexpr size_t OFF_W2T  = OFF_W13 + (size_t)32 * 1024 * 1024 * 2;
constexpr size_t OFF_OB   = OFF_W2T + (size_t)32 * 1024 * 512 * 2;
constexpr size_t OFF_AUX  = OFF_OB + (size_t)NT * 1024 * 2;
constexpr size_t WS_NEEDED = OFF_AUX + (size_t)NT * 16 * 4;

struct Params {
    const float* x; const float* c; const int* pos; const float* ada_w; const float* ada_b;
    const float* norm_mix; const float* norm_ffn; const float* even_w_in; const float* conv_w;
    const float* a_log; const float* dt_bias; const float* gdn_out_norm; const float* even_w_out;
    const float* gla_w_in; const float* gla_w_gate2; const float* gla_b_gate2; const float* gla_out_norm; const float* gla_w_out;
    const float* rg_w; const float* rg_b; const float* re_w; const float* re_b;
    const float* w1; const float* w3; const float* w2; const float* final_norm;
    float* X;
    unsigned char* ws;
    double rA, rI;
};

#define XB_TMO      128
#define XB_XCNT(j)  (256  + 64 * (j))
#define XB_XSUB(j)  (1280 + 64 * (j))
#define XB_XGEN(j)  (2304 + 64 * (j))
#define XB_TOP      3328
#define XB_TOPGEN   3392
#define XCD_BAR_WORDS 3456
#define XB_SPIN_CAP (1u << 18)
#define LAS __attribute__((address_space(3)))

__device__ __forceinline__ unsigned xb_ld(unsigned* p)              { return __hip_atomic_load(p, __ATOMIC_RELAXED, __HIP_MEMORY_SCOPE_AGENT); }
__device__ __forceinline__ unsigned xb_add(unsigned* p, unsigned v) { return __hip_atomic_fetch_add(p, v, __ATOMIC_RELAXED, __HIP_MEMORY_SCOPE_AGENT); }
__device__ __forceinline__ unsigned xb_xcc_id() { return (unsigned)__builtin_amdgcn_s_getreg((3 << 11) | 20) & 0xFu; }
#define XB_SPIN(cond, bar) do { unsigned _sp = 0; while (cond) { __builtin_amdgcn_s_sleep(1); \
    if ((++_sp & 255u) == 0u) { if (xb_ld(&(bar)[XB_TMO])) break; if (_sp > XB_SPIN_CAP) { atomicAdd(&(bar)[XB_TMO], 1u); break; } } } } while (0)

struct XcdBarrier { unsigned* bar; unsigned x; volatile LAS unsigned* st; };

__device__ __forceinline__ XcdBarrier xcd_barrier_post(unsigned* bar, volatile LAS unsigned* st) {
    XcdBarrier b; b.bar = bar; b.x = xb_xcc_id(); b.st = st;
    if (threadIdx.x == 0) (void)xb_add(&bar[XB_XCNT(b.x)], 1u);
    return b;
}
__device__ __forceinline__ void xcd_barrier_complete(unsigned* bar, unsigned x, unsigned& nloc, unsigned& nx) {
    const unsigned G = gridDim.x * gridDim.y * gridDim.z;
    unsigned sum, cnt, mine, sp = 0u;
    for (;;) {
        sum = 0u; cnt = 0u; mine = 0u;
#pragma unroll
        for (unsigned j = 0; j < 16; ++j) { const unsigned c = xb_ld(&bar[XB_XCNT(j)]); sum += c; cnt += (c > 0u) ? 1u : 0u; mine = (j == x) ? c : mine; }
        if (sum == G) break;
        __builtin_amdgcn_s_sleep(1);
        if ((++sp & 255u) == 0u) { if (xb_ld(&bar[XB_TMO])) break; if (sp > XB_SPIN_CAP) { atomicAdd(&bar[XB_TMO], 1u); break; } }
    }
    nloc = mine > 0u ? mine : 1u; nx = cnt > 0u ? cnt : 1u;
}
__device__ __forceinline__ void xcd_barrier(const XcdBarrier& b) {
    asm volatile("s_waitcnt vmcnt(0)" ::: "memory");
    __syncthreads();
    if (threadIdx.x == 0) {
        unsigned* bar = b.bar;
        __builtin_amdgcn_s_waitcnt(0);
        unsigned nloc = b.st[0], nx = b.st[1];
        if (nloc == 0u) { xcd_barrier_complete(bar, b.x, nloc, nx); b.st[0] = nloc; b.st[1] = nx; }
        const unsigned old = xb_add(&bar[XB_XSUB(b.x)], 1u);
        const unsigned gen = old / nloc;
        if (old + 1u == (gen + 1u) * nloc) {
            __builtin_amdgcn_fence(__ATOMIC_RELEASE, "agent");
            asm volatile("s_waitcnt vmcnt(0)" ::: "memory");
            const unsigned og = xb_add(&bar[XB_TOP], 1u);
            const unsigned tg = og / nx;
            if (og + 1u == (tg + 1u) * nx) xb_add(&bar[XB_TOPGEN], 1u);
            else XB_SPIN(xb_ld(&bar[XB_TOPGEN]) == tg, bar);
            __builtin_amdgcn_fence(__ATOMIC_ACQUIRE, "agent");
            xb_add(&bar[XB_XGEN(b.x)], 1u);
            asm volatile("s_waitcnt vmcnt(0)" ::: "memory");
        } else {
            XB_SPIN(xb_ld(&bar[XB_XGEN(b.x)]) == gen, bar);
            __builtin_amdgcn_fence(__ATOMIC_ACQUIRE, "agent");
            asm volatile("s_waitcnt vmcnt(0)" ::: "memory");
        }
    }
    __syncthreads();
}

__device__ __forceinline__ float wave_sum(float v) {
#pragma unroll
    for (int o = 32; o > 0; o >>= 1) v += __shfl_xor(v, o);
    return v;
}
__device__ __forceinline__ int wave_sum_i(int v) {
#pragma unroll
    for (int o = 32; o > 0; o >>= 1) v += __shfl_xor(v, o);
    return v;
}
__device__ __forceinline__ float wave_max(float v) {
#pragma unroll
    for (int o = 32; o > 0; o >>= 1) v = fmaxf(v, __shfl_xor(v, o));
    return v;
}
__device__ __forceinline__ float sigmoidf_(float x) { return 1.f / (1.f + expf(-x)); }
__device__ __forceinline__ float siluf_(float x) { return x / (1.f + expf(-x)); }
__device__ __forceinline__ float softplusf_(float x) { return fmaxf(x, 0.f) + log1pf(expf(-fabsf(x))); }
__device__ __forceinline__ unsigned ordkey(float f) { const unsigned u = __float_as_uint(f); return (u & 0x80000000u) ? ~u : (u | 0x80000000u); }

__device__ __forceinline__ void sincos_d(double a, double& s, double& c) {
    const double kq = rint(a * 0.63661977236758134308);
    double r = fma(-kq, 1.57079632673412561417e+00, a);
    r = fma(-kq, 6.07710050650619224932e-11, r);
    const int q = (int)((long long)kq & 3);
    const double r2 = r * r;
    const double sp = r * (1.0 + r2 * (-1.0 / 6 + r2 * (1.0 / 120 + r2 * (-1.0 / 5040 + r2 * (1.0 / 362880 + r2 * (-1.0 / 39916800 + r2 * (1.0 / 6227020800.0)))))));
    const double cp = 1.0 + r2 * (-0.5 + r2 * (1.0 / 24 + r2 * (-1.0 / 720 + r2 * (1.0 / 40320 + r2 * (-1.0 / 3628800 + r2 * (1.0 / 479001600.0 + r2 * (-1.0 / 87178291200.0)))))));
    if (q == 0) { s = sp; c = cp; } else if (q == 1) { s = cp; c = -sp; } else if (q == 2) { s = -sp; c = -cp; } else { s = -cp; c = sp; }
}
__device__ __forceinline__ double ipow_d(double b, int e) { double v = 1.0; while (e) { if (e & 1) v *= b; b *= b; e >>= 1; } return v; }

struct GemmArgs { const float* A; int lda; const int* rows; int m0; int mvalid; const float* B; int ldb; int n0; int N; int K; };

template <class Epi>
__device__ __forceinline__ void gemm128(const GemmArgs& g, float* smem, Epi epi) {
    float* As = smem;
    float* Bs = smem + 16 * 132;
    int tid_ = threadIdx.x; asm volatile("" : "+v"(tid_)); const int tid = tid_, ty = tid >> 4, tx = tid & 15;
    const int arow = tid >> 2, kq = (tid & 3) * 4;
    const int bk = tid >> 5, bn = (tid & 31) * 4;
    long asrc = -1;
    if (arow < g.mvalid) { const int r = g.rows ? g.rows[arow] : (g.m0 + arow); if (r >= 0) asrc = (long)r * g.lda; }
    const bool bval = (g.n0 + bn) < g.N;
    float acc[4][8];
#pragma unroll
    for (int i = 0; i < 4; ++i)
#pragma unroll
        for (int j = 0; j < 8; ++j) acc[i][j] = 0.f;
    for (int k0 = 0; k0 < g.K; k0 += 16) {
        float4 av = make_float4(0.f, 0.f, 0.f, 0.f), bv = make_float4(0.f, 0.f, 0.f, 0.f);
        if (asrc >= 0) av = *(const float4*)(g.A + asrc + k0 + kq);
        if (bval) bv = *(const float4*)(g.B + (size_t)(k0 + bk) * g.ldb + g.n0 + bn);
        __syncthreads();
        As[(kq + 0) * 132 + arow] = av.x; As[(kq + 1) * 132 + arow] = av.y; As[(kq + 2) * 132 + arow] = av.z; As[(kq + 3) * 132 + arow] = av.w;
        *(float4*)&Bs[bk * 132 + bn] = bv;
        __syncthreads();
#pragma unroll
        for (int kk = 0; kk < 16; ++kk) {
            const float4 a = *(const float4*)&As[kk * 132 + ty * 4];
            const float4 b0 = *(const float4*)&Bs[kk * 132 + tx * 8];
            const float4 b1 = *(const float4*)&Bs[kk * 132 + tx * 8 + 4];
            const float aa[4] = {a.x, a.y, a.z, a.w};
            const float bb[8] = {b0.x, b0.y, b0.z, b0.w, b1.x, b1.y, b1.z, b1.w};
#pragma unroll
            for (int i = 0; i < 4; ++i)
#pragma unroll
                for (int j = 0; j < 8; ++j) acc[i][j] += aa[i] * bb[j];
        }
    }
#pragma unroll
    for (int i = 0; i < 4; ++i) {
        const int r = ty * 4 + i;
        if (r < g.mvalid) {
#pragma unroll
            for (int j = 0; j < 8; ++j) { const int n = g.n0 + tx * 8 + j; if (n < g.N) epi(r, n, acc[i][j]); }
        }
    }
}


typedef short bf16x8 __attribute__((ext_vector_type(8)));
typedef float f32x4 __attribute__((ext_vector_type(4)));
typedef unsigned short bf16_t;
typedef __bf16 bf16x2_t __attribute__((ext_vector_type(2)));
typedef float f32x2_t __attribute__((ext_vector_type(2)));
__device__ __forceinline__ unsigned cvt_pk_bf16(float lo, float hi) { const f32x2_t v = {lo, hi}; const bf16x2_t r = __builtin_convertvector(v, bf16x2_t); return __builtin_bit_cast(unsigned, r); }
__device__ __forceinline__ bf16_t f2bf(float f) { return (bf16_t)(cvt_pk_bf16(f, 0.f) & 0xffffu); }
__device__ __forceinline__ float bf16_to_f32(bf16_t v) { return __uint_as_float(((unsigned)v) << 16); }
__device__ __forceinline__ uint2 pack4(const f32x4 v) { uint2 r; r.x = cvt_pk_bf16(v[0], v[1]); r.y = cvt_pk_bf16(v[2], v[3]); return r; }
__device__ __forceinline__ f32x4 unpack4(const uint2 u) { f32x4 r; r[0] = __uint_as_float(u.x << 16); r[1] = __uint_as_float(u.x & 0xffff0000u); r[2] = __uint_as_float(u.y << 16); r[3] = __uint_as_float(u.y & 0xffff0000u); return r; }
#define PBF(Pb_, t_, c_) bf16_to_f32((Pb_)[(size_t)(t_) * LDPB + (c_)])
__device__ __forceinline__ uint4 pack8(const float4 a, const float4 b) { uint4 r; r.x = cvt_pk_bf16(a.x, a.y); r.y = cvt_pk_bf16(a.z, a.w); r.z = cvt_pk_bf16(b.x, b.y); r.w = cvt_pk_bf16(b.z, b.w); return r; }
__device__ __forceinline__ int lds_off(int r, int c) { return r * 128 + ((c ^ (r & 7)) << 4); }

template <class ALoad, class BLoad, class Epi>
__device__ __forceinline__ void gemm_tile_bf16(const int K, unsigned char* lds, ALoad aload, BLoad bload, Epi epi) {
    int tid_ = threadIdx.x; asm volatile("" : "+v"(tid_)); const int tid = tid_, lane = tid & 63, wid = tid >> 6, wm = wid >> 1, wn = wid & 1;
    f32x4 acc[4][4];
#pragma unroll
    for (int mi = 0; mi < 4; ++mi)
#pragma unroll
        for (int ni = 0; ni < 4; ++ni) acc[mi][ni] = (f32x4){0.f, 0.f, 0.f, 0.f};
    uint4 ra[4], rb[2];
    const int nk = K >> 6;
#pragma unroll
    for (int i = 0; i < 4; ++i) { const int q = tid + 512 * i; ra[i] = aload(i, q >> 3, (q & 7) * 8); }
#pragma unroll
    for (int i = 0; i < 2; ++i) { const int q = tid + 512 * i; rb[i] = bload(i, q >> 3, (q & 7) * 8); }
    __syncthreads();
#pragma unroll
    for (int i = 0; i < 4; ++i) { const int q = tid + 512 * i; *(uint4*)(lds + lds_off(q >> 3, q & 7)) = ra[i]; }
#pragma unroll
    for (int i = 0; i < 2; ++i) { const int q = tid + 512 * i; *(uint4*)(lds + 32768 + lds_off(q >> 3, q & 7)) = rb[i]; }
    __syncthreads();
    for (int kt = 0; kt < nk; ++kt) {
        if (kt + 1 < nk) {
#pragma unroll
            for (int i = 0; i < 4; ++i) { const int q = tid + 512 * i; ra[i] = aload(i, q >> 3, (kt + 1) * 64 + (q & 7) * 8); }
#pragma unroll
            for (int i = 0; i < 2; ++i) { const int q = tid + 512 * i; rb[i] = bload(i, q >> 3, (kt + 1) * 64 + (q & 7) * 8); }
        }
        const unsigned char* At = lds + (kt & 1) * 49152;
        const unsigned char* Bt = At + 32768;
#pragma unroll
        for (int ks = 0; ks < 2; ++ks) {
            bf16x8 af[4], bfr[4];
            const int c = ks * 4 + (lane >> 4);
#pragma unroll
            for (int mi = 0; mi < 4; ++mi) af[mi] = *(const bf16x8*)(At + lds_off(wm * 64 + mi * 16 + (lane & 15), c));
#pragma unroll
            for (int ni = 0; ni < 4; ++ni) bfr[ni] = *(const bf16x8*)(Bt + lds_off(wn * 64 + ni * 16 + (lane & 15), c));
#pragma unroll
            for (int mi = 0; mi < 4; ++mi)
#pragma unroll
                for (int ni = 0; ni < 4; ++ni) acc[mi][ni] = __builtin_amdgcn_mfma_f32_16x16x32_bf16(bfr[ni], af[mi], acc[mi][ni], 0, 0, 0);
        }
        if (kt + 1 < nk) {
            unsigned char* An = lds + ((kt + 1) & 1) * 49152;
#pragma unroll
            for (int i = 0; i < 4; ++i) { const int q = tid + 512 * i; *(uint4*)(An + lds_off(q >> 3, q & 7)) = ra[i]; }
#pragma unroll
            for (int i = 0; i < 2; ++i) { const int q = tid + 512 * i; *(uint4*)(An + 32768 + lds_off(q >> 3, q & 7)) = rb[i]; }
        }
        __syncthreads();
    }
    epi(acc, wm, wn, lane);
}

__device__ __forceinline__ void convert_tile(const float* src0, const float* src1, int mode, int K, int N, int ld, bf16_t* dst, int rt, int kt, float* smem) {
    int tid_ = threadIdx.x; asm volatile("" : "+v"(tid_)); const int tid = tid_;
    __syncthreads();
    { const int k = tid >> 3, R0 = rt * 64 + (tid & 7) * 8;
      const float* sp; int col;
      if (mode == 0) { sp = src0; col = R0; } else { sp = (R0 & 32) ? src1 : src0; col = (R0 >> 6) * 32 + (R0 & 31); }
      float4 a = make_float4(0.f, 0.f, 0.f, 0.f), b = a;
      const float* rp = sp + (size_t)(kt * 64 + k) * ld + col;
      if (col < N) a = *(const float4*)rp;
      if (col + 4 < N) b = *(const float4*)(rp + 4);
      float* d = smem + k * 65 + (tid & 7) * 8;
      d[0] = a.x; d[1] = a.y; d[2] = a.z; d[3] = a.w; d[4] = b.x; d[5] = b.y; d[6] = b.z; d[7] = b.w; }
    __syncthreads();
    { const int R = tid >> 3, kc = (tid & 7) * 8;
      float v[8];
#pragma unroll
      for (int j = 0; j < 8; ++j) v[j] = smem[(kc + j) * 65 + R];
      uint4 o; o.x = cvt_pk_bf16(v[0], v[1]); o.y = cvt_pk_bf16(v[2], v[3]); o.z = cvt_pk_bf16(v[4], v[5]); o.w = cvt_pk_bf16(v[6], v[7]);
      *(uint4*)(dst + (size_t)(rt * 64 + R) * K + kt * 64 + kc) = o; }
}

extern __shared__ __attribute__((aligned(16))) unsigned char g_smem[];
#define PHASE_FN __device__ __forceinline__
enum { PH_PROLOGUE = 0, PH_NORM_MIX, PH_GEMM_IN_EVEN, PH_EVEN_TOK, PH_GDN_CHUNK, PH_GDN_SCAN, PH_DSA_TOPK, PH_DSA_ATTN, PH_GDN_OUT,
       PH_GEMM_OUT, PH_NORM_FFN, PH_MOE1, PH_MOE2, PH_GEMM_IN_ODD, PH_GLA_TOK, PH_GLA_CHUNK, PH_GLA_SCAN, PH_GLA_OUT, PH_FINAL };

PHASE_FN void ph_prologue(const Params& p, float* smem) {
    smem = (float*)g_smem;
    int tid_ = threadIdx.x; asm volatile("" : "+v"(tid_)); const int tid = tid_, nthr = gridDim.x * NTHREADS, gid = blockIdx.x * NTHREADS + tid;
    { const float4* src = (const float4*)p.x; float4* dst = (float4*)p.X;
      for (size_t i = gid; i < (size_t)NT * ND / 4; i += nthr) dst[i] = src[i]; }
    for (int i = tid; i < 2 * ND; i += NTHREADS) smem[i] = siluf_(p.c[i]);
    __syncthreads();
    float* MOD = (float*)(p.ws + OFF_MOD);
    { float* red = smem + 2048;
      const int lane = tid & 63, wv = tid >> 6;
      for (int item = blockIdx.x; item < 4 * 96; item += gridDim.x) {
          const int l = item / 96, n = (item % 96) * 64 + lane;
          const float* w = p.ada_w + (size_t)l * ND * 6144 + n;
          float a0 = 0.f, a1 = 0.f;
#pragma unroll 8
          for (int k = wv * 128; k < wv * 128 + 128; ++k) { const float wv_ = w[(size_t)k * 6144]; a0 += smem[k] * wv_; a1 += smem[ND + k] * wv_; }
          __syncthreads();
          red[(wv * 64 + lane) * 2] = a0; red[(wv * 64 + lane) * 2 + 1] = a1;
          __syncthreads();
          if (tid < 128) { const int c = tid >> 1, bb = tid & 1; float a = 0.f; for (int w8 = 0; w8 < 8; ++w8) a += red[(w8 * 64 + c) * 2 + bb];
              MOD[(l * 2 + bb) * 6144 + (item % 96) * 64 + c] = a + p.ada_b[l * 6144 + (item % 96) * 64 + c]; }
      }
      __syncthreads(); }
    float* COSA = (float*)(p.ws + OFF_COSA); float* SINA = (float*)(p.ws + OFF_SINA);
    float* COSI = (float*)(p.ws + OFF_COSI); float* SINI = (float*)(p.ws + OFF_SINI);
    for (size_t i = gid; i < (size_t)NT * 64; i += nthr) {
        const int t = (int)(i >> 6), j = (int)(i & 63);
        double s, c; sincos_d((double)p.pos[t] * ipow_d(p.rA, j), s, c);
        COSA[i] = (float)c; SINA[i] = (float)s;
    }
    for (size_t i = gid; i < (size_t)NT * 32; i += nthr) {
        const int t = (int)(i >> 5), j = (int)(i & 31);
        double s, c; sincos_d((double)p.pos[t] * ipow_d(p.rI, j), s, c);
        COSI[i] = (float)c; SINI[i] = (float)s;
    }
}

PHASE_FN void ph_rows(const Params& p, int layer, int mode, float* smem) {
    smem = (float*)g_smem;
    int tid_ = threadIdx.x; asm volatile("" : "+v"(tid_)); const int tid = tid_, lane = tid & 63, wv = tid >> 6;
    int* pad = (int*)smem;
    const int moe_layer = (mode == 1) ? 3 : layer - 1;
    if (moe_layer >= 0) {
        if (tid == 0) { const int* cnt = (const int*)(p.ws + OFF_CNT) + moe_layer * 32 * CSTR; int a = 0; for (int e = 0; e < 32; ++e) { pad[e] = a; a += ((cnt[e * CSTR] + 127) / 128) * 128; } }
        __syncthreads();
    }
    const float* MOD = (const float*)(p.ws + OFF_MOD);
    bf16_t* H = (bf16_t*)(p.ws + OFF_H);
    const float* YB = (const float*)(p.ws + OFF_YB);
    const int* ASG = (const int*)(p.ws + OFF_ASG);
    const float* GATE = (const float*)(p.ws + OFF_GATE);
    for (int row = blockIdx.x * 8 + wv; row < NT; row += gridDim.x * 8) {
        const int b = row >> 13;
        float* xr = p.X + (size_t)row * ND;
        float xv[16];
#pragma unroll
        for (int j = 0; j < 4; ++j) { const float4 v = *(const float4*)(xr + j * 256 + lane * 4); xv[4 * j] = v.x; xv[4 * j + 1] = v.y; xv[4 * j + 2] = v.z; xv[4 * j + 3] = v.w; }
        if (moe_layer >= 0) {
            const float* gt = MOD + (size_t)(moe_layer * 2 + b) * 6144 + 5 * 1024;
            const int e0 = ASG[row * 4 + 0], r0 = ASG[row * 4 + 1], e1 = ASG[row * 4 + 2], r1 = ASG[row * 4 + 3];
            const float g0 = GATE[row * 2], g1 = GATE[row * 2 + 1];
            const float* y0 = YB + (size_t)(pad[e0] + r0) * ND;
            const float* y1 = YB + (size_t)(pad[e1] + r1) * ND;
#pragma unroll
            for (int j = 0; j < 4; ++j) {
                const int col = j * 256 + lane * 4;
                const float4 a = *(const float4*)(y0 + col), bq = *(const float4*)(y1 + col), g = *(const float4*)(gt + col);
                xv[4 * j] += g.x * (g0 * a.x + g1 * bq.x); xv[4 * j + 1] += g.y * (g0 * a.y + g1 * bq.y);
                xv[4 * j + 2] += g.z * (g0 * a.z + g1 * bq.z); xv[4 * j + 3] += g.w * (g0 * a.w + g1 * bq.w);
                if (mode == 0) *(float4*)(xr + col) = make_float4(xv[4 * j], xv[4 * j + 1], xv[4 * j + 2], xv[4 * j + 3]);
            }
        }
        float ss = 0.f;
#pragma unroll
        for (int j = 0; j < 16; ++j) ss += xv[j] * xv[j];
        ss = wave_sum(ss);
        const float rstd = rsqrtf(ss * (1.f / 1024.f) + EPS);
        if (mode == 0) {
            const float* nw = p.norm_mix + layer * 1024;
            const float* sh = MOD + (size_t)(layer * 2 + b) * 6144;
            const float* sc = sh + 1024;
#pragma unroll
            for (int j = 0; j < 4; ++j) {
                const int col = j * 256 + lane * 4;
                const float4 w = *(const float4*)(nw + col), s4 = *(const float4*)(sc + col), h4 = *(const float4*)(sh + col);
                float4 o;
                o.x = xv[4 * j] * rstd * w.x * (1.f + s4.x) + h4.x; o.y = xv[4 * j + 1] * rstd * w.y * (1.f + s4.y) + h4.y;
                o.z = xv[4 * j + 2] * rstd * w.z * (1.f + s4.z) + h4.z; o.w = xv[4 * j + 3] * rstd * w.w * (1.f + s4.w) + h4.w;
                { f32x4 ov; ov[0] = o.x; ov[1] = o.y; ov[2] = o.z; ov[3] = o.w; *(uint2*)(H + (size_t)row * ND + col) = pack4(ov); }
            }
        } else {
#pragma unroll
            for (int j = 0; j < 4; ++j) {
                const int col = j * 256 + lane * 4;
                const float4 w = *(const float4*)(p.final_norm + col);
                *(float4*)(xr + col) = make_float4(xv[4 * j] * rstd * w.x, xv[4 * j + 1] * rstd * w.y, xv[4 * j + 2] * rstd * w.z, xv[4 * j + 3] * rstd * w.w);
            }
        }
    }
}

PHASE_FN void ph_gemm_in(const Params& p, int layer, bool even, float* smem) {
    smem = (float*)g_smem;
    const int N = even ? 3916 : 3088, ntn = even ? 31 : 25;
    const bf16_t* Wt = even ? (const bf16_t*)(p.ws + OFF_WINE) + (size_t)(layer >> 1) * 3968 * 1024 : (const bf16_t*)(p.ws + OFF_WINO) + (size_t)(layer >> 1) * 3200 * 1024;
    const bf16_t* H = (const bf16_t*)(p.ws + OFF_H);
    bf16_t* P = (bf16_t*)(p.ws + OFF_P);
    float* AUX = (float*)(p.ws + OFF_AUX);
    for (int tile = blockIdx.x; tile < 64 * ntn; tile += gridDim.x) {
        const int mt = tile % 64, nt = tile / 64;
        const bf16_t* Ab = H + (size_t)mt * 256 * 1024;
        const bf16_t* Bb = Wt + (size_t)nt * 128 * 1024;
        bf16_t* Pt = P + (size_t)mt * 256 * LDPB + nt * 128;
        float* At = AUX + (size_t)mt * 256 * 16;
        const int ncol0 = nt * 128;
        const int nrem = N - nt * 128;
        gemm_tile_bf16(1024, (unsigned char*)smem,
            [=](int i, int r, int k) -> uint4 { return *(const uint4*)(Ab + (size_t)r * 1024 + k); },
            [=](int i, int r, int k) -> uint4 { return *(const uint4*)(Bb + (size_t)r * 1024 + k); },
            [=](const f32x4 (&acc)[4][4], int wm, int wn, int lane) {
#pragma unroll
                for (int mi = 0; mi < 4; ++mi)
#pragma unroll
                    for (int ni = 0; ni < 4; ++ni) {
                        const int m = wm * 64 + mi * 16 + (lane & 15), n = wn * 64 + ni * 16 + 4 * (lane >> 4);
                        if (n < nrem) {
                            *(uint2*)(Pt + (size_t)m * LDPB + n) = pack4(acc[mi][ni]);
                            const int gc = ncol0 + n;
                            int ax = -1;
                            if (even) { if (gc == 2048) ax = 0; else if (gc == 2052) ax = 4; else if (gc == 3912) ax = 8; }
                            else { if (gc >= 3072 && gc < 3088) ax = gc - 3072; }
                            if (ax >= 0) *(f32x4*)(At + (size_t)m * 16 + ax) = acc[mi][ni];
                        }
                    }
            });
    }
}

PHASE_FN void ph_even_tok(const Params& p, int layer, float* smem) {
    smem = (float*)g_smem;
    int tid_ = threadIdx.x; asm volatile("" : "+v"(tid_)); const int tid = tid_, lane = tid & 63, wv = tid >> 6, li = layer >> 1;
    const bf16_t* P = (const bf16_t*)(p.ws + OFF_P); const float* AUX = (const float*)(p.ws + OFF_AUX);
    const float* cw = p.conv_w + (size_t)li * 4 * 1536;
    float* QN = (float*)(p.ws + OFF_QN); float* KN = (float*)(p.ws + OFF_KN); float* VC = (float*)(p.ws + OFF_VC);
    float* BETA = (float*)(p.ws + OFF_BETA); float* G = (float*)(p.ws + OFF_G);
    bf16_t* QB = (bf16_t*)(p.ws + OFF_QBB); bf16_t* KB = (bf16_t*)(p.ws + OFF_KBB); bf16_t* QI = (bf16_t*)(p.ws + OFF_QIB); bf16_t* KI = (bf16_t*)(p.ws + OFF_KIB); float* WI = (float*)(p.ws + OFF_WI);
    const float* COSA = (const float*)(p.ws + OFF_COSA); const float* SINA = (const float*)(p.ws + OFF_SINA);
    const float* COSI = (const float*)(p.ws + OFF_COSI); const float* SINI = (const float*)(p.ws + OFF_SINI);
    for (int t = blockIdx.x * 8 + wv; t < NT; t += gridDim.x * 8) {
        const int s = t & 8191;
        const bf16_t* Pt = P + (size_t)t * LDPB;
        auto convs = [&](int c) -> float {
            float a = 0.f;
#pragma unroll
            for (int j = 0; j < 4; ++j) { if (s - 3 + j >= 0) a += cw[j * 1536 + c] * bf16_to_f32(P[(size_t)(t - 3 + j) * LDPB + c]); }
            return siluf_(a);
        };
#pragma unroll 1
        for (int h = 0; h < 4; ++h) {
            const float q0 = convs(h * 128 + lane), q1 = convs(h * 128 + 64 + lane);
            float ss = wave_sum(q0 * q0 + q1 * q1);
            float r = rsqrtf(ss + EPS);
            QN[(size_t)t * 512 + h * 128 + lane] = q0 * r; QN[(size_t)t * 512 + h * 128 + 64 + lane] = q1 * r;
            const float k0 = convs(512 + h * 128 + lane), k1 = convs(512 + h * 128 + 64 + lane);
            ss = wave_sum(k0 * k0 + k1 * k1);
            r = rsqrtf(ss + EPS);
            KN[(size_t)t * 512 + h * 128 + lane] = k0 * r; KN[(size_t)t * 512 + h * 128 + 64 + lane] = k1 * r;
            VC[(size_t)t * 512 + h * 128 + lane] = convs(1024 + h * 128 + lane);
            VC[(size_t)t * 512 + h * 128 + 64 + lane] = convs(1024 + h * 128 + 64 + lane);
        }
        if (lane < 4) {
            const float ba = AUX[(size_t)t * 16 + lane], aa = AUX[(size_t)t * 16 + 4 + lane];
            BETA[t * 4 + lane] = sigmoidf_(ba);
            G[t * 4 + lane] = -expf(p.a_log[li * 4 + lane]) * softplusf_(aa + p.dt_bias[li * 4 + lane]);
            WI[t * 4 + lane] = AUX[(size_t)t * 16 + 8 + lane] * 0.0625f;
        }
        { const float c = COSA[(size_t)t * 64 + lane], sn = SINA[(size_t)t * 64 + lane];
#pragma unroll
          for (int h = 0; h < 4; ++h) {
              float t1 = bf16_to_f32(Pt[2056 + h * 128 + lane]), t2 = bf16_to_f32(Pt[2056 + h * 128 + 64 + lane]);
              QB[(size_t)t * 512 + h * 128 + lane] = f2bf(t1 * c - t2 * sn); QB[(size_t)t * 512 + h * 128 + 64 + lane] = f2bf(t2 * c + t1 * sn);
              t1 = bf16_to_f32(Pt[2568 + h * 128 + lane]); t2 = bf16_to_f32(Pt[2568 + h * 128 + 64 + lane]);
              KB[(size_t)t * 512 + h * 128 + lane] = f2bf(t1 * c - t2 * sn); KB[(size_t)t * 512 + h * 128 + 64 + lane] = f2bf(t2 * c + t1 * sn);
          } }
#pragma unroll
        for (int r = 0; r < 2; ++r) {
            const int item = lane + 64 * r, hh = item >> 5, ii = item & 31;
            const float c = COSI[(size_t)t * 32 + ii], sn = SINI[(size_t)t * 32 + ii];
            const float t1 = bf16_to_f32(Pt[3592 + hh * 64 + ii]), t2 = bf16_to_f32(Pt[3592 + hh * 64 + 32 + ii]);
            QI[(size_t)t * 256 + hh * 64 + ii] = f2bf(t1 * c - t2 * sn); QI[(size_t)t * 256 + hh * 64 + 32 + ii] = f2bf(t2 * c + t1 * sn);
        }
        if (lane < 32) {
            const float c = COSI[(size_t)t * 32 + lane], sn = SINI[(size_t)t * 32 + lane];
            const float t1 = bf16_to_f32(Pt[3848 + lane]), t2 = bf16_to_f32(Pt[3848 + 32 + lane]);
            KI[(size_t)t * 64 + lane] = f2bf(t1 * c - t2 * sn); KI[(size_t)t * 64 + 32 + lane] = f2bf(t2 * c + t1 * sn);
        }
    }
    { bf16_t* VT = (bf16_t*)(p.ws + OFF_VT);
      bf16_t* sv = (bf16_t*)g_smem;
      for (int item = blockIdx.x; item < 2 * 128 * 4; item += gridDim.x) {
          const int h = item & 3, tt = item >> 2, b = tt >> 7, s0 = (tt & 127) * 64;
          __syncthreads();
          for (int e = tid; e < 64 * 128; e += NTHREADS) { const int i = e >> 7, d = e & 127; sv[d * 72 + i] = P[(size_t)(b * 8192 + s0 + i) * LDPB + 3080 + h * 128 + d]; }
          __syncthreads();
          for (int e = tid; e < 128 * 8; e += NTHREADS) { const int d = e >> 3, c = e & 7;
              *(uint4*)(VT + ((size_t)((b * 4 + h) * 128 + d)) * 8192 + s0 + c * 8) = *(const uint4*)(sv + d * 72 + c * 8); }
      } }
}

__device__ __forceinline__ f32x4 mma_lds(const unsigned char* A, int sa, int a0, const unsigned char* B, int sb, int b0, int K, f32x4 acc, int c16, int q4) {
    const unsigned char* ap = A + (a0 + c16) * sa + q4 * 16;
    const unsigned char* bp = B + (b0 + c16) * sb + q4 * 16;
    for (int kk = 0; kk < K; kk += 32) { acc = __builtin_amdgcn_mfma_f32_16x16x32_bf16(*(const bf16x8*)(ap + kk * 2), *(const bf16x8*)(bp + kk * 2), acc, 0, 0, 0); }
    return acc;
}

PHASE_FN void ph_gdn_chunk(const Params& p, float* smem) {
    int tid_ = threadIdx.x; asm volatile("" : "+v"(tid_)); const int tid = tid_, lane = tid & 63, wv = __builtin_amdgcn_readfirstlane(tid >> 6), q4 = lane >> 4, c16 = lane & 15;
    unsigned char* lds = g_smem;
    constexpr int SN = 272, ST = 144;
    unsigned char* bKN = lds;
    unsigned char* bQN = lds + 18432;
    unsigned char* bKBG = lds + 35840;
    unsigned char* bVB = lds + 54272;
    unsigned char* bKD = lds + 72704;
    unsigned char* bUT = lds + 91136;
    float* sL = (float*)(lds + 109568);
    unsigned char* bAQK = lds + 126208;
    unsigned char* bTB = lds + 135424;
    float* sG = (float*)(lds + 144640); float* sB = sG + 64; float* sEg = sB + 64;
    const float* QN = (const float*)(p.ws + OFF_QN); const float* KN = (const float*)(p.ws + OFF_KN); const float* VC = (const float*)(p.ws + OFF_VC);
    const float* BETA = (const float*)(p.ws + OFF_BETA); const float* G = (const float*)(p.ws + OFF_G);
    uint4* PFR = (uint4*)(p.ws + OFF_PFR); uint4* RFR = (uint4*)(p.ws + OFF_RFR); uint2* QFR = (uint2*)(p.ws + OFF_QFR); uint2* OFR = (uint2*)(p.ws + OFF_OFR);
    float* GL = (float*)(p.ws + OFF_GL);
    for (int ci = blockIdx.x; ci < 1024; ci += gridDim.x) {
        const int b = ci >> 9, h = (ci >> 7) & 3, n = ci & 127;
        const int t0 = b * 8192 + n * 64;
        __syncthreads();
        if (tid < 64) { float g = G[(t0 + tid) * 4 + h];
#pragma unroll
            for (int o = 1; o < 64; o <<= 1) { const float nb = __shfl_up(g, o); if (lane >= o) g += nb; }
            sG[tid] = g; sB[tid] = BETA[(t0 + tid) * 4 + h]; sEg[tid] = expf(g); }
        for (int e = tid; e < 64 * 36; e += NTHREADS) ((unsigned*)bAQK)[e] = 0u;
        __syncthreads();
        const float gl = sG[63];
        for (int e = tid; e < 8192; e += NTHREADS) {
            const int i = e >> 7, d = e & 127;
            const float kf = KN[(size_t)(t0 + i) * 512 + h * 128 + d], qf = QN[(size_t)(t0 + i) * 512 + h * 128 + d], vf = VC[(size_t)(t0 + i) * 512 + h * 128 + d];
            const float be = sB[i];
            *(bf16_t*)(bKN + i * SN + d * 2) = f2bf(kf);
            *(bf16_t*)(bQN + i * SN + d * 2) = f2bf(qf);
            *(bf16_t*)(bKBG + d * ST + i * 2) = f2bf(kf * be * sEg[i]);
            *(bf16_t*)(bVB + d * ST + i * 2) = f2bf(vf * be);
            *(bf16_t*)(bKD + d * ST + i * 2) = f2bf(kf * expf(gl - sG[i]));
        }
        __syncthreads();
        for (int u = wv; u < 20; u += 8) {
            const int kind = (u >= 10) ? 1 : 0, idx = u - kind * 10;
            const int ti = (idx >= 6) ? 3 : (idx >= 3) ? 2 : (idx >= 1) ? 1 : 0, tj = idx - ((ti * (ti + 1)) >> 1);
            f32x4 acc = (f32x4){0.f, 0.f, 0.f, 0.f};
            acc = mma_lds(kind ? bQN : bKN, SN, 16 * ti, bKN, SN, 16 * tj, 128, acc, c16, q4);
            const int j = 16 * tj + c16;
#pragma unroll
            for (int r = 0; r < 4; ++r) { const int i = 16 * ti + 4 * q4 + r;
                const float dec = (j <= i) ? expf(sG[i] - sG[j]) : 0.f;
                if (kind == 0) sL[i * 65 + j] = (j < i) ? sB[i] * acc[r] * dec : 0.f;
                else *(bf16_t*)(bAQK + i * ST + j * 2) = f2bf(acc[r] * SCALE128 * dec); }
        }
        __syncthreads();
        if (wv == 0) {
            float t[64];
            int zz = 0; asm volatile("" : "+v"(zz)); const float* sLo = sL + zz;
#pragma unroll
            for (int i = 0; i < 64; ++i) { float a = (i == lane) ? 1.f : 0.f;
#pragma unroll
                for (int j = 0; j < i; ++j) a -= sLo[i * 65 + j] * t[j];
                t[i] = a; asm volatile("" ::: "memory"); }
#pragma unroll
            for (int i = 0; i < 64; ++i) *(bf16_t*)(bTB + i * ST + lane * 2) = f2bf(t[i]);
        }
        __syncthreads();
        for (int x = 0; x < 8; ++x) {
            const int u = wv * 8 + x, kind = u >> 5, ti = (u >> 3) & 3, td = u & 7;
            f32x4 acc = (f32x4){0.f, 0.f, 0.f, 0.f};
            acc = mma_lds(bTB, ST, 16 * ti, kind ? bVB : bKBG, ST, 16 * td, 64, acc, c16, q4);
            *(uint2*)((kind ? bUT : bKN) + (16 * td + c16) * ST + (16 * ti + 4 * q4) * 2) = pack4(acc);
        }
        __syncthreads();
        unsigned char* bWT = bKN;
        const float eg = expf(gl);
        for (int x = 0; x < 4; ++x) {
            const int u = wv * 4 + x, ti = u >> 2, a = u & 3;
            uint4 fr;
#pragma unroll
            for (int hf = 0; hf < 2; ++hf) { const int tk = 2 * a + hf;
                f32x4 acc = (f32x4){0.f, 0.f, 0.f, 0.f};
                acc = mma_lds(bWT, ST, 16 * tk, bKD, ST, 16 * ti, 64, acc, c16, q4);
                f32x4 v;
#pragma unroll
                for (int r = 0; r < 4; ++r) v[r] = ((16 * tk + 4 * q4 + r) == (16 * ti + c16) ? eg : 0.f) - acc[r];
                const uint2 pk = pack4(v);
                if (hf == 0) { fr.x = pk.x; fr.y = pk.y; } else { fr.z = pk.x; fr.w = pk.y; } }
            PFR[((size_t)(ci * 8 + ti) * 4 + a) * 64 + lane] = fr;
        }
        for (int x = 0; x < 2; ++x) {
            const int u = wv * 2 + x, ti = u >> 2, a = u & 3;
            uint4 fr;
            const int i = 16 * ti + c16;
            const float qs = SCALE128 * sEg[i];
#pragma unroll
            for (int hf = 0; hf < 2; ++hf) { const int tk = 2 * a + hf;
                f32x4 acc = (f32x4){0.f, 0.f, 0.f, 0.f};
                acc = mma_lds(bWT, ST, 16 * tk, bAQK, ST, 16 * ti, 64, acc, c16, q4);
                const f32x4 qv = unpack4(*(const uint2*)(bQN + i * SN + (16 * tk + 4 * q4) * 2));
                const uint2 pk = pack4(qv * qs - acc);
                if (hf == 0) { fr.x = pk.x; fr.y = pk.y; } else { fr.z = pk.x; fr.w = pk.y; } }
            RFR[((size_t)(ci * 4 + ti) * 4 + a) * 64 + lane] = fr;
        }
        for (int x = 0; x < 8; ++x) {
            const int u = wv * 8 + x, tdv = u >> 3, tdk = u & 7;
            f32x4 acc = (f32x4){0.f, 0.f, 0.f, 0.f};
            acc = mma_lds(bKD, ST, 16 * tdk, bUT, ST, 16 * tdv, 64, acc, c16, q4);
            QFR[((size_t)(ci * 8 + tdv) * 8 + tdk) * 64 + lane] = pack4(acc);
        }
        for (int x = 0; x < 4; ++x) {
            const int u = wv * 4 + x, tdv = u >> 2, ti = u & 3;
            f32x4 acc = (f32x4){0.f, 0.f, 0.f, 0.f};
            acc = mma_lds(bAQK, ST, 16 * ti, bUT, ST, 16 * tdv, 64, acc, c16, q4);
            OFR[((size_t)(ci * 8 + tdv) * 4 + ti) * 64 + lane] = pack4(acc);
        }
        if (tid == 0) GL[ci] = gl;
    }
}

__device__ __forceinline__ void gs_load(uint4 (&d)[12], const unsigned char* pp, const unsigned char* rr, const unsigned char* qq, const unsigned char* oo, const int lt) {
#pragma unroll
    for (int i = 0; i < 6; ++i) { int c = lt + 384 * i; c = c < 2048 ? c : 2047; d[i] = *(const uint4*)(pp + c * 16); }
#pragma unroll
    for (int i = 0; i < 3; ++i) { int c = lt + 384 * i; c = c < 1024 ? c : 1023; d[6 + i] = *(const uint4*)(rr + c * 16); }
#pragma unroll
    for (int i = 0; i < 2; ++i) { int c = lt + 384 * i; c = c < 512 ? c : 511; d[9 + i] = *(const uint4*)(qq + c * 16); }
    { const int c = lt < 256 ? lt : 255; d[11] = *(const uint4*)(oo + c * 16); }
}
__device__ __forceinline__ void gs_store(const uint4 (&d)[12], unsigned char* sb, const int lt) {
#pragma unroll
    for (int i = 0; i < 6; ++i) { const int c = lt + 384 * i; if (c < 2048) *(uint4*)(sb + c * 16) = d[i]; }
#pragma unroll
    for (int i = 0; i < 3; ++i) { const int c = lt + 384 * i; if (c < 1024) *(uint4*)(sb + 32768 + c * 16) = d[6 + i]; }
#pragma unroll
    for (int i = 0; i < 2; ++i) { const int c = lt + 384 * i; if (c < 512) *(uint4*)(sb + 49152 + c * 16) = d[9 + i]; }
    if (lt < 256) *(uint4*)(sb + 57344 + lt * 16) = d[11];
}

#define SCAN_BODY                 bf16x8 Sb[4]; \
_Pragma("unroll") \
                for (int a = 0; a < 4; ++a) { union { uint4 u; bf16x8 v; } cv; const uint2 lo = pack4(S[2 * a]), hi = pack4(S[2 * a + 1]); cv.u.x = lo.x; cv.u.y = lo.y; cv.u.z = hi.x; cv.u.w = hi.y; Sb[a] = cv.v; } \
                const int t0 = b * 8192 + n * 64; \
                {   f32x4 oa[4]; \
_Pragma("unroll") \
                    for (int ti = 0; ti < 4; ++ti) oa[ti] = unpack4(*(const uint2*)(Of + ti * 512)); \
_Pragma("unroll") \
                    for (int a = 0; a < 4; ++a) \
_Pragma("unroll") \
                        for (int ti = 0; ti < 4; ++ti) oa[ti] = __builtin_amdgcn_mfma_f32_16x16x32_bf16(*(const bf16x8*)(Rf + (ti * 4 + a) * 1024), Sb[a], oa[ti], 0, 0, 0); \
_Pragma("unroll") \
                    for (int ti = 0; ti < 4; ++ti) { \
                        float* op = O + (size_t)(t0 + 16 * ti + 4 * q4) * 1024 + h * 128 + 16 * tdv + c16; \
                        op[0] = oa[ti][0]; op[1024] = oa[ti][1]; op[2048] = oa[ti][2]; op[3072] = oa[ti][3]; } \
                } \
                asm volatile("" ::: "memory"); \
_Pragma("unroll") \
                for (int g = 0; g < 2; ++g) { \
                    f32x4 sa[4]; \
_Pragma("unroll") \
                    for (int t = 0; t < 4; ++t) sa[t] = unpack4(*(const uint2*)(Qf + (g * 4 + t) * 512)); \
_Pragma("unroll") \
                    for (int a = 0; a < 4; ++a) \
_Pragma("unroll") \
                        for (int t = 0; t < 4; ++t) sa[t] = __builtin_amdgcn_mfma_f32_16x16x32_bf16(*(const bf16x8*)(Pf + ((g * 4 + t) * 4 + a) * 1024), Sb[a], sa[t], 0, 0, 0); \
_Pragma("unroll") \
                    for (int t = 0; t < 4; ++t) S[g * 4 + t] = sa[t]; \
                    asm volatile("" ::: "memory"); \
                }
PHASE_FN void ph_gdn_scan(const Params& p, float* smem) {
    int tid_ = threadIdx.x; asm volatile("" : "+v"(tid_)); const int tid = tid_, lane = tid & 63, wv = __builtin_amdgcn_readfirstlane(tid >> 6), q4 = lane >> 4, c16 = lane & 15;
    unsigned char* lds = g_smem;
    constexpr int STG = 61440;
    const unsigned char* PFR = p.ws + OFF_PFR; const unsigned char* RFR = p.ws + OFF_RFR; const unsigned char* QFR = p.ws + OFF_QFR; const unsigned char* OFR = p.ws + OFF_OFR;
    float* O = (float*)(p.ws + OFF_O);
    for (int it = blockIdx.x; it < 32; it += gridDim.x) {
        const int bh = it >> 2, pair = it & 3, b = bh >> 2, h = bh & 3;
        __syncthreads();
        if (wv >= 2) {
            const int lt = tid - 128;
            const unsigned char* Pb = PFR + (size_t)bh * 128 * 32768;
            const unsigned char* Rb = RFR + (size_t)bh * 128 * 16384;
            const unsigned char* Qb = QFR + (size_t)bh * 128 * 32768 + pair * 8192;
            const unsigned char* Ob = OFR + (size_t)bh * 128 * 16384 + pair * 4096;
            uint4 ra0, ra1, ra2, ra3, ra4, ra5, ra6, ra7, ra8, ra9, ra10, ra11, rb0, rb1, rb2, rb3, rb4, rb5, rb6, rb7, rb8, rb9, rb10, rb11;
#define LDC(base_, c_, mx_) (*(const uint4*)((base_) + (size_t)(((c_) < (mx_)) ? (c_) : (mx_)) * 16))
#define GS_LOAD(X, n_) do { const unsigned char* pp_ = Pb + (size_t)(n_) * 32768; const unsigned char* rr_ = Rb + (size_t)(n_) * 16384; \
                const unsigned char* qq_ = Qb + (size_t)(n_) * 32768; const unsigned char* oo_ = Ob + (size_t)(n_) * 16384; \
                X##0 = LDC(pp_, lt, 2047); X##1 = LDC(pp_, lt + 384, 2047); X##2 = LDC(pp_, lt + 768, 2047); X##3 = LDC(pp_, lt + 1152, 2047); X##4 = LDC(pp_, lt + 1536, 2047); X##5 = LDC(pp_, lt + 1920, 2047); \
                X##6 = LDC(rr_, lt, 1023); X##7 = LDC(rr_, lt + 384, 1023); X##8 = LDC(rr_, lt + 768, 1023); \
                X##9 = LDC(qq_, lt, 511); X##10 = LDC(qq_, lt + 384, 511); X##11 = LDC(oo_, lt, 255); } while (0)
#define STC(off_, c_, lim_, v_) do { if ((c_) < (lim_)) *(uint4*)(sb_ + (off_) + (c_) * 16) = v_; } while (0)
#define GS_STORE(X, st_) do { unsigned char* sb_ = lds + (st_) * STG; \
                STC(0, lt, 2048, X##0); STC(0, lt + 384, 2048, X##1); STC(0, lt + 768, 2048, X##2); STC(0, lt + 1152, 2048, X##3); STC(0, lt + 1536, 2048, X##4); STC(0, lt + 1920, 2048, X##5); \
                STC(32768, lt, 1024, X##6); STC(32768, lt + 384, 1024, X##7); STC(32768, lt + 768, 1024, X##8); \
                STC(49152, lt, 512, X##9); STC(49152, lt + 384, 512, X##10); STC(57344, lt, 256, X##11); } while (0)
            GS_LOAD(ra, 0); GS_STORE(ra, 0);
            GS_LOAD(rb, 1); GS_LOAD(ra, 2);
            __syncthreads();
            for (int n = 0; n < 128; n += 2) {
                GS_STORE(rb, 1);
                GS_LOAD(rb, (n + 3 < 128) ? n + 3 : 127);
                __syncthreads();
                if (n + 2 < 128) GS_STORE(ra, 0);
                GS_LOAD(ra, (n + 4 < 128) ? n + 4 : 127);
                __syncthreads();
            }
        } else {
            const int tdv = pair * 2 + wv;
            f32x4 S[8];
#pragma unroll
            for (int t = 0; t < 8; ++t) S[t] = (f32x4){0.f, 0.f, 0.f, 0.f};
            __syncthreads();
            for (int n = 0; n < 128; ++n) {
                const unsigned char* base = lds + (n & 1) * STG;
                const unsigned char* Pf = base + lane * 16, *Rf = base + 32768 + lane * 16;
                const unsigned char* Qf = base + 49152 + wv * 4096 + lane * 8, *Of = base + 57344 + wv * 2048 + lane * 8;
                SCAN_BODY
                __syncthreads();
            }
        }
    }
}

__device__ __forceinline__ void block_sum4(int (&v)[4], int* buf) {
    const int lane = threadIdx.x & 63, wv = threadIdx.x >> 6;
#pragma unroll
    for (int q = 0; q < 4; ++q) v[q] = wave_sum_i(v[q]);
    if (lane == 0) {
#pragma unroll
        for (int q = 0; q < 4; ++q) buf[wv * 4 + q] = v[q];
    }
    __syncthreads();
#pragma unroll
    for (int q = 0; q < 4; ++q) { int a = 0; for (int w = 0; w < 8; ++w) a += buf[w * 4 + q]; v[q] = a; }
}

PHASE_FN void ph_dsa_topk(const Params& p, float* smem) {
    int tid_ = threadIdx.x; asm volatile("" : "+v"(tid_)); const int tid = tid_, lane = tid & 63, wv = __builtin_amdgcn_readfirstlane(tid >> 6), q4 = lane >> 4, c16 = lane & 15;
    int* sRed = (int*)g_smem;
    const bf16_t* QIb = (const bf16_t*)(p.ws + OFF_QIB); const bf16_t* KIb = (const bf16_t*)(p.ws + OFF_KIB); const float* WI = (const float*)(p.ws + OFF_WI);
    unsigned short* M16 = (unsigned short*)(p.ws + OFF_M16);
    for (int it = blockIdx.x; it < 4096; it += gridDim.x) {
        const int k = it >> 8, j = (it & 255) >> 1, b = it & 1;
        const int grp = (k & 1) ? 2047 - ((k >> 1) * 128 + j) : (k >> 1) * 128 + j;
        const int s0 = grp * 4, t0 = b * 8192 + s0;
        const int ntiles = (s0 >> 4) + 1;
        const int nreg = (ntiles > wv) ? ((ntiles - wv + 7) >> 3) : 0;
        const bf16x8 a0 = *(const bf16x8*)(QIb + (size_t)(t0 + (c16 >> 2)) * 256 + (c16 & 3) * 64 + 8 * q4);
        const bf16x8 a1 = *(const bf16x8*)(QIb + (size_t)(t0 + (c16 >> 2)) * 256 + (c16 & 3) * 64 + 32 + 8 * q4);
        const float4 wq = *(const float4*)(WI + (size_t)(t0 + q4) * 4);
        const int myq = s0 + q4;
        int c16s = c16; asm volatile("" : "+v"(c16s));
        unsigned keys[64];
#pragma unroll
        for (int i = 0; i < 64; ++i) keys[i] = 0u;
#pragma unroll
        for (int blk = 0; blk < 4; ++blk) if (nreg > blk * 16) {
#pragma unroll
            for (int ii = 0; ii < 16; ++ii) { const int i = blk * 16 + ii, tile = wv + 8 * i;
                if (tile < ntiles) {
                    const bf16_t* kp = KIb + (size_t)(b * 8192 + tile * 16 + c16s) * 64 + 8 * q4;
                    const bf16x8 k0 = *(const bf16x8*)kp, k1 = *(const bf16x8*)(kp + 32);
                    f32x4 acc = (f32x4){0.f, 0.f, 0.f, 0.f};
                    acc = __builtin_amdgcn_mfma_f32_16x16x32_bf16(a0, k0, acc, 0, 0, 0);
                    acc = __builtin_amdgcn_mfma_f32_16x16x32_bf16(a1, k1, acc, 0, 0, 0);
                    float sc = 0.f;
                    sc += wq.x * fmaxf(acc[0], 0.f); sc += wq.y * fmaxf(acc[1], 0.f); sc += wq.z * fmaxf(acc[2], 0.f); sc += wq.w * fmaxf(acc[3], 0.f);
                    keys[i] = (tile * 16 + c16s <= myq) ? ordkey(sc) : 0u;
                }
                if ((ii & 3) == 3) asm volatile("" ::: "memory"); }
        }
        const int keff = (myq + 1 < 256) ? (myq + 1) : 256;
        int par = 0;
        auto qsum = [&](int c) -> int {
            c += __shfl_xor(c, 1); c += __shfl_xor(c, 2); c += __shfl_xor(c, 4); c += __shfl_xor(c, 8);
            par ^= 1;
            if (c16 == 0) sRed[par * 32 + wv * 4 + q4] = c;
            __syncthreads();
            int a = 0;
#pragma unroll
            for (int w = 0; w < 8; ++w) a += sRed[par * 32 + w * 4 + q4];
            return a;
        };
        unsigned U = 0u;
        for (int bit = 31; bit >= 0; --bit) {
            const unsigned cand = U | (1u << bit);
            int c = 0;
#pragma unroll
            for (int blk = 0; blk < 4; ++blk) if (nreg > blk * 16) {
#pragma unroll
                for (int ii = 0; ii < 16; ++ii) c += (keys[blk * 16 + ii] >= cand) ? 1 : 0;
            }
            if (qsum(c) >= keff) U = cand;
        }
        int cg = 0, ce = 0;
#pragma unroll
        for (int i = 0; i < 64; ++i) { cg += (keys[i] > U) ? 1 : 0; ce += (keys[i] == U) ? 1 : 0; }
        cg = qsum(cg); ce = qsum(ce);
        const int need = keff - cg;
        int J = 8191;
        par ^= 1;
        if (c16 == 0) sRed[par * 32 + wv * 4 + q4] = (ce > need) ? 1 : 0;
        __syncthreads();
        int anyov = 0;
#pragma unroll
        for (int w = 0; w < 32; ++w) anyov |= sRed[par * 32 + w];
        if (anyov) {
            J = 0;
            int c16j = c16; asm volatile("" : "+v"(c16j));
            for (int bit = 12; bit >= 0; --bit) {
                const int cj = J | (1 << bit);
                int c = 0;
#pragma unroll
                for (int i = 0; i < 64; ++i) c += (keys[i] == U && ((wv + 8 * i) * 16 + c16j) < cj) ? 1 : 0;
                if (qsum(c) <= need - 1) J = cj;
            }
        }
        int c16e = c16; asm volatile("" : "+v"(c16e));
#pragma unroll
        for (int i = 0; i < 64; ++i) {
            const int tile = wv + 8 * i;
            const bool sel = keys[i] > U || (keys[i] == U && (tile * 16 + c16e) <= J);
            const unsigned long long bal = __ballot(sel);
            if (c16 == 0) M16[(size_t)(t0 + q4) * 512 + tile] = (unsigned short)((bal >> (16 * q4)) & 0xffffull);
        }
    }
}

PHASE_FN void ph_dsa_attn(const Params& p, float* smem) {
    int tid_ = threadIdx.x; asm volatile("" : "+v"(tid_)); const int tid = tid_, lane = tid & 63, wv = tid >> 6, q4 = lane >> 4, c16 = lane & 15;
    unsigned char* lds = g_smem;
    const bf16_t* QBb = (const bf16_t*)(p.ws + OFF_QBB); const bf16_t* KBb = (const bf16_t*)(p.ws + OFF_KBB); const bf16_t* VT = (const bf16_t*)(p.ws + OFF_VT);
    const unsigned short* M16 = (const unsigned short*)(p.ws + OFF_M16);
    bf16_t* OB = (bf16_t*)(p.ws + OFF_OB);
    const float SC = SCALE128 * 1.4426950408889634f;
    for (int it = blockIdx.x; it < 256; it += gridDim.x) {
        const int bh = it & 7, jp = it >> 3, b = bh >> 2, h = bh & 3;
        for (int half = 0; half < 2; ++half) {
            const int jq = half ? jp : 63 - jp;
            const int qs = jq * 128, nkt = 2 * jq + 2;
            const int tq = b * 8192 + qs + wv * 16 + c16;
            bf16x8 qf[4];
#pragma unroll
            for (int a = 0; a < 4; ++a) qf[a] = *(const bf16x8*)(QBb + (size_t)tq * 512 + h * 128 + 8 * q4 + 32 * a);
            float m = -1e30f, lsum = 0.f;
            f32x4 oacc[8];
#pragma unroll
            for (int t = 0; t < 8; ++t) oacc[t] = (f32x4){0.f, 0.f, 0.f, 0.f};
            uint4 rk0, rk1, rv0, rv1;
            const int q0 = tid, q1 = tid + 512;
            const bf16_t* kg0 = KBb + (size_t)(b * 8192 + (q0 >> 4)) * 512 + h * 128 + (q0 & 15) * 8;
            const bf16_t* kg1 = KBb + (size_t)(b * 8192 + (q1 >> 4)) * 512 + h * 128 + (q1 & 15) * 8;
            const bf16_t* vg0 = VT + ((size_t)((b * 4 + h) * 128 + (q0 >> 3))) * 8192 + (q0 & 7) * 8;
            const bf16_t* vg1 = VT + ((size_t)((b * 4 + h) * 128 + (q1 >> 3))) * 8192 + (q1 & 7) * 8;
            const int lk0 = (q0 >> 4) * 256 + ((((q0 & 15)) ^ ((q0 >> 4) & 15)) << 4), lk1 = (q1 >> 4) * 256 + ((((q1 & 15)) ^ ((q1 >> 4) & 15)) << 4);
            const int lv0 = 16384 + (q0 >> 3) * 128 + ((((q0 & 7)) ^ ((q0 >> 3) & 7)) << 4), lv1 = 16384 + (q1 >> 3) * 128 + ((((q1 & 7)) ^ ((q1 >> 3) & 7)) << 4);
#define ATT_GLOAD(kt_) do { rk0 = *(const uint4*)(kg0 + (size_t)(kt_) * 64 * 512); rk1 = *(const uint4*)(kg1 + (size_t)(kt_) * 64 * 512); \
                            rv0 = *(const uint4*)(vg0 + (kt_) * 64); rv1 = *(const uint4*)(vg1 + (kt_) * 64); } while (0)
#define ATT_LSTORE(st_) do { unsigned char* base_ = lds + (st_) * 32768; *(uint4*)(base_ + lk0) = rk0; *(uint4*)(base_ + lk1) = rk1; *(uint4*)(base_ + lv0) = rv0; *(uint4*)(base_ + lv1) = rv1; } while (0)
            __syncthreads();
            ATT_GLOAD(0); ATT_LSTORE(0);
            __syncthreads();
            for (int kt = 0; kt < nkt; ++kt) {
                if (kt + 1 < nkt) ATT_GLOAD(kt + 1);
                const unsigned long long mbits = *(const unsigned long long*)(M16 + (size_t)tq * 512 + 4 * kt);
                const unsigned char* Kt = lds + (kt & 1) * 32768;
                const unsigned char* Vt = Kt + 16384;
                f32x4 sacc[4];
#pragma unroll
                for (int ti = 0; ti < 4; ++ti) { sacc[ti] = (f32x4){0.f, 0.f, 0.f, 0.f};
                    const int row = 16 * ti + c16;
#pragma unroll
                    for (int a = 0; a < 4; ++a) { const bf16x8 kf = *(const bf16x8*)(Kt + row * 256 + ((((q4 + 4 * a)) ^ (row & 15)) << 4));
                        sacc[ti] = __builtin_amdgcn_mfma_f32_16x16x32_bf16(kf, qf[a], sacc[ti], 0, 0, 0); } }
                float mx = m;
#pragma unroll
                for (int ti = 0; ti < 4; ++ti)
#pragma unroll
                    for (int r = 0; r < 4; ++r) { const bool valid = (mbits >> (16 * ti + 4 * q4 + r)) & 1ull; const float v = sacc[ti][r] * SC; sacc[ti][r] = v; mx = fmaxf(mx, valid ? v : -1e30f); }
                mx = fmaxf(mx, __shfl_xor(mx, 16)); mx = fmaxf(mx, __shfl_xor(mx, 32));
                const float alpha = __builtin_amdgcn_exp2f(m - mx); m = mx;
                float ps = 0.f;
#pragma unroll
                for (int ti = 0; ti < 4; ++ti)
#pragma unroll
                    for (int r = 0; r < 4; ++r) { const bool valid = (mbits >> (16 * ti + 4 * q4 + r)) & 1ull; const float pv = valid ? __builtin_amdgcn_exp2f(sacc[ti][r] - mx) : 0.f; sacc[ti][r] = pv; ps += pv; }
                lsum = lsum * alpha + ps;
#pragma unroll
                for (int t = 0; t < 8; ++t) oacc[t] = oacc[t] * alpha;
                bf16x8 pb[2];
#pragma unroll
                for (int a = 0; a < 2; ++a) {
                    union { uint4 u; bf16x8 v; } cv;
                    cv.u.x = cvt_pk_bf16(sacc[2 * a][0], sacc[2 * a][1]); cv.u.y = cvt_pk_bf16(sacc[2 * a][2], sacc[2 * a][3]);
                    cv.u.z = cvt_pk_bf16(sacc[2 * a + 1][0], sacc[2 * a + 1][1]); cv.u.w = cvt_pk_bf16(sacc[2 * a + 1][2], sacc[2 * a + 1][3]);
                    pb[a] = cv.v; }
#pragma unroll
                for (int t = 0; t < 8; ++t) { const int row = 16 * t + c16;
#pragma unroll
                    for (int a = 0; a < 2; ++a) {
                        union { uint2 h2[2]; bf16x8 v; } vf;
                        vf.h2[0] = *(const uint2*)(Vt + row * 128 + ((((4 * a + (q4 >> 1))) ^ (row & 7)) << 4) + 8 * (q4 & 1));
                        vf.h2[1] = *(const uint2*)(Vt + row * 128 + ((((4 * a + 2 + (q4 >> 1))) ^ (row & 7)) << 4) + 8 * (q4 & 1));
                        oacc[t] = __builtin_amdgcn_mfma_f32_16x16x32_bf16(vf.v, pb[a], oacc[t], 0, 0, 0); } }
                if (kt + 1 < nkt) ATT_LSTORE((kt + 1) & 1);
                __syncthreads();
            }
            lsum += __shfl_xor(lsum, 16); lsum += __shfl_xor(lsum, 32);
            const float inv = 1.f / lsum;
#pragma unroll
            for (int t = 0; t < 8; ++t) *(uint2*)(OB + (size_t)tq * 1024 + 512 + h * 128 + 16 * t + 4 * q4) = pack4(oacc[t] * inv);
        }
    }
}

PHASE_FN void ph_gdn_out(const Params& p, int layer) {
    int tid_ = threadIdx.x; asm volatile("" : "+v"(tid_)); const int tid = tid_, lane = tid & 63, wv = tid >> 6;
    const float* O = (const float*)(p.ws + OFF_O); const bf16_t* P = (const bf16_t*)(p.ws + OFF_P); bf16_t* OB = (bf16_t*)(p.ws + OFF_OB);
    const float* onw = p.gdn_out_norm + (layer >> 1) * 128;
    for (int t = blockIdx.x * 8 + wv; t < NT; t += gridDim.x * 8) {
#pragma unroll
        for (int h = 0; h < 4; ++h) {
            const float* op = O + (size_t)t * 1024 + h * 128; bf16_t* ob = OB + (size_t)t * 1024 + h * 128;
            const float o0 = op[lane], o1 = op[64 + lane];
            const float ss = wave_sum(o0 * o0 + o1 * o1);
            const float r = rsqrtf(ss * (1.f / 128.f) + EPS);
            const float z0 = PBF(P, t, 1536 + h * 128 + lane), z1 = PBF(P, t, 1536 + h * 128 + 64 + lane);
            ob[lane] = f2bf(o0 * r * onw[lane] * siluf_(z0)); ob[64 + lane] = f2bf(o1 * r * onw[64 + lane] * siluf_(z1));
        }
    }
}

PHASE_FN void ph_gemm_out(const Params& p, int layer, float* smem) {
    smem = (float*)g_smem;
    const bf16_t* Wt = (const bf16_t*)(p.ws + OFF_WOUT) + (size_t)layer * 1024 * 1024;
    const float* MOD = (const float*)(p.ws + OFF_MOD);
    const bf16_t* O = (const bf16_t*)(p.ws + OFF_OB);
    for (int tile = blockIdx.x; tile < 64 * 8; tile += gridDim.x) {
        const int mt = tile % 64, nt = tile / 64;
        const bf16_t* Ab = O + (size_t)mt * 256 * 1024;
        const bf16_t* Bb = Wt + (size_t)nt * 128 * 1024;
        const int b = (mt * 256) >> 13;
        const float* gt = MOD + (size_t)(layer * 2 + b) * 6144 + 2048 + nt * 128;
        float* Xt = p.X + (size_t)mt * 256 * ND + nt * 128;
        gemm_tile_bf16(1024, (unsigned char*)smem,
            [=](int i, int r, int k) -> uint4 { return *(const uint4*)(Ab + (size_t)r * 1024 + k); },
            [=](int i, int r, int k) -> uint4 { return *(const uint4*)(Bb + (size_t)r * 1024 + k); },
            [=](const f32x4 (&acc)[4][4], int wm, int wn, int lane) {
#pragma unroll
                for (int mi = 0; mi < 4; ++mi)
#pragma unroll
                    for (int ni = 0; ni < 4; ++ni) {
                        const int m = wm * 64 + mi * 16 + (lane & 15), n = wn * 64 + ni * 16 + 4 * (lane >> 4);
                        const f32x4 g = *(const f32x4*)(gt + n);
                        f32x4* xp = (f32x4*)(Xt + (size_t)m * ND + n);
                        *xp = *xp + g * acc[mi][ni];
                    }
            });
    }
}

PHASE_FN void ph_norm_ffn(const Params& p, int layer) {
    int tid_ = threadIdx.x; asm volatile("" : "+v"(tid_)); const int tid = tid_, lane = tid & 63, wv = tid >> 6;
    const float* MOD = (const float*)(p.ws + OFF_MOD);
    bf16_t* H = (bf16_t*)(p.ws + OFF_H);
    int* CNT = (int*)(p.ws + OFF_CNT) + layer * 32 * CSTR;
    int* sCnt = (int*)g_smem; int* sBase = sCnt + 32; int* sE = sBase + 32; int* sR = sE + 256;
    const int nrb = (NT + (int)gridDim.x - 1) / (int)gridDim.x, row_lo = blockIdx.x * nrb, row_hi = (row_lo + nrb < NT) ? row_lo + nrb : NT;
    __syncthreads();
    if (tid < 32) sCnt[tid] = 0;
    __syncthreads();
    int* ASG = (int*)(p.ws + OFF_ASG); float* GATE = (float*)(p.ws + OFF_GATE); int* LIST = (int*)(p.ws + OFF_LIST);
    const float* nw = p.norm_ffn + layer * 1024;
    const float* wg = p.rg_w + (size_t)layer * 1024 * 4;
    for (int row = row_lo + wv; row < row_hi; row += 8) {
        const int b = row >> 13;
        const float* xr = p.X + (size_t)row * ND;
        const float* sh = MOD + (size_t)(layer * 2 + b) * 6144 + 3072;
        const float* sc = sh + 1024;
        float hv[16]; float ss = 0.f;
#pragma unroll
        for (int j = 0; j < 4; ++j) { const float4 v = *(const float4*)(xr + j * 256 + lane * 4); hv[4 * j] = v.x; hv[4 * j + 1] = v.y; hv[4 * j + 2] = v.z; hv[4 * j + 3] = v.w; }
#pragma unroll
        for (int j = 0; j < 16; ++j) ss += hv[j] * hv[j];
        ss = wave_sum(ss);
        const float rstd = rsqrtf(ss * (1.f / 1024.f) + EPS);
#pragma unroll
        for (int j = 0; j < 4; ++j) {
            const int col = j * 256 + lane * 4;
            const float4 w = *(const float4*)(nw + col), s4 = *(const float4*)(sc + col), h4 = *(const float4*)(sh + col);
            hv[4 * j] = hv[4 * j] * rstd * w.x * (1.f + s4.x) + h4.x; hv[4 * j + 1] = hv[4 * j + 1] * rstd * w.y * (1.f + s4.y) + h4.y;
            hv[4 * j + 2] = hv[4 * j + 2] * rstd * w.z * (1.f + s4.z) + h4.z; hv[4 * j + 3] = hv[4 * j + 3] * rstd * w.w * (1.f + s4.w) + h4.w;
            { f32x4 ov; ov[0] = hv[4 * j]; ov[1] = hv[4 * j + 1]; ov[2] = hv[4 * j + 2]; ov[3] = hv[4 * j + 3]; *(uint2*)(H + (size_t)row * ND + col) = pack4(ov); }
        }
        float gl[4] = {0.f, 0.f, 0.f, 0.f};
#pragma unroll
        for (int j = 0; j < 4; ++j)
#pragma unroll
            for (int e = 0; e < 4; ++e) { const int col = j * 256 + lane * 4 + e; const float4 w = *(const float4*)(wg + (size_t)col * 4); const float hh = hv[4 * j + e];
                gl[0] += hh * w.x; gl[1] += hh * w.y; gl[2] += hh * w.z; gl[3] += hh * w.w; }
#pragma unroll
        for (int g = 0; g < 4; ++g) gl[g] = wave_sum(gl[g]) + p.rg_b[layer * 4 + g];
        int gs = 0; float gm = gl[0];
#pragma unroll
        for (int g = 1; g < 4; ++g) if (gl[g] > gm) { gm = gl[g]; gs = g; }
        float gsum = 0.f;
#pragma unroll
        for (int g = 0; g < 4; ++g) gsum += expf(gl[g] - gm);
        const float ggate = 1.f / gsum;
        const float* we = p.re_w + ((size_t)(layer * 4 + gs) * 1024) * 8;
        float el[8] = {0.f, 0.f, 0.f, 0.f, 0.f, 0.f, 0.f, 0.f};
#pragma unroll
        for (int j = 0; j < 4; ++j)
#pragma unroll
            for (int e = 0; e < 4; ++e) { const int col = j * 256 + lane * 4 + e; const float4 w0 = *(const float4*)(we + (size_t)col * 8), w1 = *(const float4*)(we + (size_t)col * 8 + 4); const float hh = hv[4 * j + e];
                el[0] += hh * w0.x; el[1] += hh * w0.y; el[2] += hh * w0.z; el[3] += hh * w0.w; el[4] += hh * w1.x; el[5] += hh * w1.y; el[6] += hh * w1.z; el[7] += hh * w1.w; }
#pragma unroll
        for (int e = 0; e < 8; ++e) el[e] = wave_sum(el[e]) + p.re_b[(layer * 4 + gs) * 8 + e];
        int i1 = 0; float l1 = el[0];
#pragma unroll
        for (int e = 1; e < 8; ++e) if (el[e] > l1) { l1 = el[e]; i1 = e; }
        int i2 = -1; float l2 = -INFINITY;
#pragma unroll
        for (int e = 0; e < 8; ++e) if (e != i1 && el[e] > l2) { l2 = el[e]; i2 = e; }
        const float ex = expf(l2 - l1);
        const float p1 = 1.f / (1.f + ex), p2 = ex / (1.f + ex);
        if (lane == 0) {
            const int e1 = gs * 8 + i1, e2 = gs * 8 + i2, lr = row - row_lo;
            sE[lr * 2] = e1; sE[lr * 2 + 1] = e2;
            sR[lr * 2] = atomicAdd(&sCnt[e1], 1); sR[lr * 2 + 1] = atomicAdd(&sCnt[e2], 1);
            GATE[row * 2] = ggate * p1; GATE[row * 2 + 1] = ggate * p2;
        }
    }
    __syncthreads();
    if (tid < 32) sBase[tid] = (sCnt[tid] > 0) ? atomicAdd(&CNT[tid * CSTR], sCnt[tid]) : 0;
    __syncthreads();
    for (int a = tid; a < (row_hi - row_lo) * 2; a += NTHREADS) {
        const int row = row_lo + (a >> 1), e = sE[a], r = sBase[e] + sR[a];
        LIST[(size_t)e * LISTCAP + r] = row;
        ASG[row * 4 + (a & 1) * 2] = e; ASG[row * 4 + (a & 1) * 2 + 1] = r;
    }
}

PHASE_FN void ph_moe(const Params& p, int layer, int which, float* smem) {
    smem = (float*)g_smem;
    int tid_ = threadIdx.x; asm volatile("" : "+v"(tid_)); const int tid = tid_;
    int* sPad = (int*)(g_smem + 98304); int* sTs = sPad + 33;
    const int* CNT = (const int*)(p.ws + OFF_CNT) + layer * 32 * CSTR;
    __syncthreads();
    if (tid == 0) { int a = 0, ts = 0; for (int e = 0; e < 32; ++e) { sPad[e] = a; sTs[e] = ts; a += ((CNT[e * CSTR] + 127) / 128) * 128; ts += (CNT[e * CSTR] + 255) / 256; } sTs[32] = ts; sPad[32] = a; }
    __syncthreads();
    const int total = sTs[32] * 8;
    bf16_t* HID = (bf16_t*)(p.ws + OFF_HID); float* YB = (float*)(p.ws + OFF_YB);
    const bf16_t* H = (const bf16_t*)(p.ws + OFF_H);
    const int* LIST = (const int*)(p.ws + OFF_LIST);
    for (int tile = blockIdx.x; tile < total; tile += gridDim.x) {
        const int mt = tile >> 3, nt = tile & 7;
        int e = 0;
        for (int q = 1; q < 32; ++q) if (sTs[q] <= mt) e = q;
        const int mi0 = mt - sTs[e];
        const int cnt = CNT[e * CSTR];
        const int mvalid = (cnt - mi0 * 256 < 256) ? (cnt - mi0 * 256) : 256;
        const int rowbase = sPad[e] + mi0 * 256;
        if (which == 0) {
            long ro[4];
#pragma unroll
            for (int i = 0; i < 4; ++i) { const int r = (tid + 512 * i) >> 3; ro[i] = (r < mvalid) ? (long)LIST[(size_t)e * LISTCAP + mi0 * 256 + r] * 1024 : -1; }
            const long ro0 = ro[0], ro1 = ro[1], ro2 = ro[2], ro3 = ro[3];
            const bf16_t* Bb = (const bf16_t*)(p.ws + OFF_W13) + (size_t)e * 1024 * 1024 + (size_t)nt * 128 * 1024;
            bf16_t* Ht = HID + (size_t)rowbase * 512 + nt * 64;
            gemm_tile_bf16(1024, (unsigned char*)smem,
                [=](int i, int r, int k) -> uint4 { const long o = (i == 0) ? ro0 : (i == 1) ? ro1 : (i == 2) ? ro2 : ro3; if (o < 0) return make_uint4(0u, 0u, 0u, 0u);
                    return *(const uint4*)(H + o + k); },
                [=](int i, int r, int k) -> uint4 { return *(const uint4*)(Bb + (size_t)r * 1024 + k); },
                [=](const f32x4 (&acc)[4][4], int wm, int wn, int lane) {
#pragma unroll
                    for (int mi = 0; mi < 4; ++mi)
#pragma unroll
                        for (int ni = 0; ni < 2; ++ni) {
                            const int m = wm * 64 + mi * 16 + (lane & 15), n = wn * 32 + ni * 16 + 4 * (lane >> 4);
                            const f32x4 a1 = acc[mi][ni], a3 = acc[mi][ni + 2];
                            f32x4 hv; hv[0] = siluf_(a1[0]) * a3[0]; hv[1] = siluf_(a1[1]) * a3[1]; hv[2] = siluf_(a1[2]) * a3[2]; hv[3] = siluf_(a1[3]) * a3[3];
                            if (m < mvalid) *(uint2*)(Ht + (size_t)m * 512 + n) = pack4(hv);
                        }
                });
        } else {
            const bf16_t* Ab = HID + (size_t)rowbase * 512;
            const bf16_t* Bb = (const bf16_t*)(p.ws + OFF_W2T) + (size_t)e * 1024 * 512 + (size_t)nt * 128 * 512;
            float* Yt = YB + (size_t)rowbase * 1024 + nt * 128;
            gemm_tile_bf16(512, (unsigned char*)smem,
                [=](int i, int r, int k) -> uint4 { if (r >= mvalid) return make_uint4(0u, 0u, 0u, 0u); return *(const uint4*)(Ab + (size_t)r * 512 + k); },
                [=](int i, int r, int k) -> uint4 { return *(const uint4*)(Bb + (size_t)r * 512 + k); },
                [=](const f32x4 (&acc)[4][4], int wm, int wn, int lane) {
#pragma unroll
                    for (int mi = 0; mi < 4; ++mi)
#pragma unroll
                        for (int ni = 0; ni < 4; ++ni) {
                            const int m = wm * 64 + mi * 16 + (lane & 15), n = wn * 64 + ni * 16 + 4 * (lane >> 4);
                            if (m < mvalid) *(f32x4*)(Yt + (size_t)m * 1024 + n) = acc[mi][ni];
                        }
                });
        }
    }
}

PHASE_FN void ph_conv_dense(const Params& p, float* smem) {
    smem = (float*)g_smem;
    for (int t = blockIdx.x; t < 1984 + 1600 + 1024; t += gridDim.x) {
        if (t < 1984) { const int l = t / 992, u = t % 992;
            convert_tile(p.even_w_in + (size_t)l * 1024 * 3916, nullptr, 0, 1024, 3916, 3916, (bf16_t*)(p.ws + OFF_WINE) + (size_t)l * 3968 * 1024, u >> 4, u & 15, smem); }
        else if (t < 3584) { const int v = t - 1984, l = v / 800, u = v % 800;
            convert_tile(p.gla_w_in + (size_t)l * 1024 * 3088, nullptr, 0, 1024, 3088, 3088, (bf16_t*)(p.ws + OFF_WINO) + (size_t)l * 3200 * 1024, u >> 4, u & 15, smem); }
        else { const int v = t - 3584, l = v >> 8, u = v & 255;
            convert_tile(((l & 1) ? p.gla_w_out : p.even_w_out) + (size_t)(l >> 1) * 1024 * 1024, nullptr, 0, 1024, 1024, 1024, (bf16_t*)(p.ws + OFF_WOUT) + (size_t)l * 1024 * 1024, u >> 4, u & 15, smem); }
    }
}

PHASE_FN void ph_conv_exp(const Params& p, int layer, float* smem) {
    smem = (float*)g_smem;
    for (int t = blockIdx.x; t < 8192 + 4096; t += gridDim.x) {
        if (t < 8192) { const int e = t >> 8, u = t & 255;
            convert_tile(p.w1 + (size_t)(layer * 32 + e) * 1024 * 512, p.w3 + (size_t)(layer * 32 + e) * 1024 * 512, 1, 1024, 512, 512, (bf16_t*)(p.ws + OFF_W13) + (size_t)e * 1024 * 1024, u >> 4, u & 15, smem); }
        else { const int v = t - 8192, e = v >> 7, u = v & 127;
            convert_tile(p.w2 + (size_t)(layer * 32 + e) * 512 * 1024, nullptr, 0, 512, 1024, 1024, (bf16_t*)(p.ws + OFF_W2T) + (size_t)e * 1024 * 512, u >> 3, u & 7, smem); }
    }
}

PHASE_FN void ph_gla_tok(const Params& p, int layer) {
    int tid_ = threadIdx.x; asm volatile("" : "+v"(tid_)); const int tid = tid_, lane = tid & 63, wv = tid >> 6, li = layer >> 1;
    const float* AUX = (const float*)(p.ws + OFF_AUX);
    float* LA = (float*)(p.ws + OFF_LA);
    const float* w2 = p.gla_w_gate2 + (size_t)li * 16 * 512; const float* b2 = p.gla_b_gate2 + li * 512;
    for (int t = blockIdx.x * 8 + wv; t < NT; t += gridDim.x * 8) {
        float glr[16];
#pragma unroll
        for (int r = 0; r < 16; ++r) glr[r] = AUX[(size_t)t * 16 + r];
#pragma unroll 1
        for (int i = 0; i < 8; ++i) {
            const int c = lane + 64 * i; float z = b2[c];
#pragma unroll
            for (int r = 0; r < 16; ++r) z += glr[r] * w2[r * 512 + c];
            LA[(size_t)t * 512 + c] = -softplusf_(-z) * (1.f / 16.f);
        }
    }
}

PHASE_FN void ph_gla_chunk(const Params& p, float* smem) {
    int tid_ = threadIdx.x; asm volatile("" : "+v"(tid_)); const int tid = tid_, lane = tid & 63, wv = __builtin_amdgcn_readfirstlane(tid >> 6), q4 = lane >> 4, c16 = lane & 15;
    unsigned char* lds = g_smem;
    constexpr int SN = 272, ST = 144;
    float* sBc = (float*)lds;
    unsigned char* bQE = lds + 33024;
    unsigned char* bKE = lds + 50432;
    unsigned char* bKD = lds + 67840;
    unsigned char* bVT = lds + 86272;
    unsigned char* bATT = lds + 123136;
    const bf16_t* P = (const bf16_t*)(p.ws + OFF_P); const float* LA = (const float*)(p.ws + OFF_LA);
    uint4* QEF = (uint4*)(p.ws + OFF_GQE); uint2* OIF = (uint2*)(p.ws + OFF_GOI); uint2* HF = (uint2*)(p.ws + OFF_GH); float* EBL = (float*)(p.ws + OFF_GEBL);
    for (int ci = blockIdx.x; ci < 1024; ci += gridDim.x) {
        const int b = ci >> 9, h = (ci >> 7) & 3, n = ci & 127;
        const int t0 = b * 8192 + n * 64;
        __syncthreads();
        for (int e = tid; e < 8192; e += NTHREADS) { const int i = e >> 7, d = e & 127; sBc[i * 129 + d] = LA[(size_t)(t0 + i) * 512 + h * 128 + d]; }
        for (int e = tid; e < 64 * 36; e += NTHREADS) ((unsigned*)bATT)[e] = 0u;
        __syncthreads();
        if (tid < 128) { float a = 0.f; for (int i = 0; i < 64; ++i) { a += sBc[i * 129 + tid]; sBc[i * 129 + tid] = a; } }
        __syncthreads();
        for (int e = tid; e < 8192; e += NTHREADS) {
            const int i = e >> 7, d = e & 127;
            const float bb = sBc[i * 129 + d], bl = sBc[63 * 129 + d];
            const float qf = PBF(P, t0 + i, h * 128 + d), kf = PBF(P, t0 + i, 512 + h * 128 + d);
            *(bf16_t*)(bQE + i * SN + d * 2) = f2bf(qf * SCALE128 * expf(bb));
            *(bf16_t*)(bKE + i * SN + d * 2) = f2bf(kf * expf(-bb));
            *(bf16_t*)(bKD + d * ST + i * 2) = f2bf(kf * expf(bl - bb));
        }
        for (int e = tid; e < 16384; e += NTHREADS) { const int i = e >> 8, dv = e & 255; *(bf16_t*)(bVT + dv * ST + i * 2) = P[(size_t)(t0 + i) * LDPB + 1024 + h * 256 + dv]; }
        if (tid < 128) EBL[ci * 128 + tid] = expf(sBc[63 * 129 + tid]);
        __syncthreads();
        for (int u = wv; u < 10; u += 8) {
            const int ti = (u >= 6) ? 3 : (u >= 3) ? 2 : (u >= 1) ? 1 : 0, tj = u - ((ti * (ti + 1)) >> 1);
            f32x4 acc = (f32x4){0.f, 0.f, 0.f, 0.f};
            acc = mma_lds(bQE, SN, 16 * ti, bKE, SN, 16 * tj, 128, acc, c16, q4);
            const int j = 16 * tj + c16;
#pragma unroll
            for (int r = 0; r < 4; ++r) { const int i = 16 * ti + 4 * q4 + r; *(bf16_t*)(bATT + i * ST + j * 2) = f2bf((j <= i) ? acc[r] : 0.f); }
        }
        for (int x = 0; x < 2; ++x) {
            const int u = wv * 2 + x, ti = u >> 2, a = u & 3;
            const unsigned char* rp = bQE + (16 * ti + c16) * SN;
            const uint2 lo = *(const uint2*)(rp + (32 * a + 4 * q4) * 2), hi = *(const uint2*)(rp + (32 * a + 16 + 4 * q4) * 2);
            QEF[((size_t)(ci * 4 + ti) * 4 + a) * 64 + lane] = make_uint4(lo.x, lo.y, hi.x, hi.y);
        }
        __syncthreads();
        for (int x = 0; x < 8; ++x) {
            const int u = wv * 8 + x, tdv = u >> 2, ti = u & 3;
            f32x4 acc = (f32x4){0.f, 0.f, 0.f, 0.f};
            acc = mma_lds(bATT, ST, 16 * ti, bVT, ST, 16 * tdv, 64, acc, c16, q4);
            OIF[((size_t)(ci * 16 + tdv) * 4 + ti) * 64 + lane] = pack4(acc);
        }
        for (int x = 0; x < 16; ++x) {
            const int u = wv * 16 + x, tdv = u >> 3, tdk = u & 7;
            f32x4 acc = (f32x4){0.f, 0.f, 0.f, 0.f};
            acc = mma_lds(bKD, ST, 16 * tdk, bVT, ST, 16 * tdv, 64, acc, c16, q4);
            HF[((size_t)(ci * 16 + tdv) * 8 + tdk) * 64 + lane] = pack4(acc);
        }
    }
}

PHASE_FN void ph_gla_scan(const Params& p, float* smem) {
    int tid_ = threadIdx.x; asm volatile("" : "+v"(tid_)); const int tid = tid_, lane = tid & 63, wv = __builtin_amdgcn_readfirstlane(tid >> 6), q4 = lane >> 4, c16 = lane & 15;
    unsigned char* lds = g_smem;
    constexpr int STG = 29184;
    const unsigned char* QEF = p.ws + OFF_GQE; const unsigned char* HF = p.ws + OFF_GH; const unsigned char* OIF = p.ws + OFF_GOI; const unsigned char* EBL = p.ws + OFF_GEBL;
    float* O = (float*)(p.ws + OFF_O);
    for (int it = blockIdx.x; it < 64; it += gridDim.x) {
        const int bh = it >> 3, pair = it & 7, b = bh >> 2, h = bh & 3;
        __syncthreads();
        if (wv >= 2) {
            const int lt = tid - 128;
            const unsigned char* Qb = QEF + (size_t)bh * 128 * 16384;
            const unsigned char* Hb = HF + (size_t)bh * 128 * 65536 + pair * 8192;
            const unsigned char* Ob = OIF + (size_t)bh * 128 * 32768 + pair * 4096;
            const unsigned char* Lb = EBL + (size_t)bh * 128 * 512;
            uint4 ra0, ra1, ra2, ra3, ra4, ra5, ra6, rb0, rb1, rb2, rb3, rb4, rb5, rb6;
#define GL_LOAD(X, n_) do { const unsigned char* q_ = Qb + (size_t)(n_) * 16384; const unsigned char* h_ = Hb + (size_t)(n_) * 65536; \
                const unsigned char* o_ = Ob + (size_t)(n_) * 32768; const unsigned char* l_ = Lb + (size_t)(n_) * 512; \
                X##0 = LDC(q_, lt, 1023); X##1 = LDC(q_, lt + 384, 1023); X##2 = LDC(q_, lt + 768, 1023); \
                X##3 = LDC(h_, lt, 511); X##4 = LDC(h_, lt + 384, 511); X##5 = LDC(o_, lt, 255); X##6 = LDC(l_, lt, 31); } while (0)
#define GL_STORE(X, st_) do { unsigned char* sb_ = lds + (st_) * STG; \
                STC(0, lt, 1024, X##0); STC(0, lt + 384, 1024, X##1); STC(0, lt + 768, 1024, X##2); \
                STC(16384, lt, 512, X##3); STC(16384, lt + 384, 512, X##4); STC(24576, lt, 256, X##5); STC(28672, lt, 32, X##6); } while (0)
            GL_LOAD(ra, 0); GL_STORE(ra, 0);
            GL_LOAD(rb, 1); GL_LOAD(ra, 2);
            __syncthreads();
            for (int n = 0; n < 128; n += 2) {
                GL_STORE(rb, 1);
                GL_LOAD(rb, (n + 3 < 128) ? n + 3 : 127);
                __syncthreads();
                if (n + 2 < 128) GL_STORE(ra, 0);
                GL_LOAD(ra, (n + 4 < 128) ? n + 4 : 127);
                __syncthreads();
            }
        } else {
            const int tdv = pair * 2 + wv;
            f32x4 S[8];
#pragma unroll
            for (int t = 0; t < 8; ++t) S[t] = (f32x4){0.f, 0.f, 0.f, 0.f};
            __syncthreads();
            for (int n = 0; n < 128; ++n) {
                const unsigned char* base = lds + (n & 1) * STG;
                const unsigned char* Qf = base + lane * 16, *Hf = base + 16384 + wv * 4096 + lane * 8, *Of = base + 24576 + wv * 2048 + lane * 8, *Lf = base + 28672 + q4 * 16;
                bf16x8 Sb[4];
#pragma unroll
                for (int a = 0; a < 4; ++a) { union { uint4 u; bf16x8 v; } cv; const uint2 lo = pack4(S[2 * a]), hi = pack4(S[2 * a + 1]); cv.u.x = lo.x; cv.u.y = lo.y; cv.u.z = hi.x; cv.u.w = hi.y; Sb[a] = cv.v; }
                const int t0 = b * 8192 + n * 64;
                f32x4 oa[4];
#pragma unroll
                for (int ti = 0; ti < 4; ++ti) oa[ti] = unpack4(*(const uint2*)(Of + ti * 512));
#pragma unroll
                for (int a = 0; a < 4; ++a)
#pragma unroll
                    for (int ti = 0; ti < 4; ++ti) oa[ti] = __builtin_amdgcn_mfma_f32_16x16x32_bf16(*(const bf16x8*)(Qf + (ti * 4 + a) * 1024), Sb[a], oa[ti], 0, 0, 0);
#pragma unroll
                for (int ti = 0; ti < 4; ++ti) {
                    float* op = O + (size_t)(t0 + 16 * ti + 4 * q4) * 1024 + h * 256 + 16 * tdv + c16;
                    op[0] = oa[ti][0]; op[1024] = oa[ti][1]; op[2048] = oa[ti][2]; op[3072] = oa[ti][3]; }
#pragma unroll
                for (int t = 0; t < 8; ++t) { const f32x4 lam = *(const f32x4*)(Lf + t * 64); S[t] = S[t] * lam + unpack4(*(const uint2*)(Hf + t * 512)); }
                __syncthreads();
            }
        }
    }
}

PHASE_FN void ph_gla_out(const Params& p, int layer) {
    int tid_ = threadIdx.x; asm volatile("" : "+v"(tid_)); const int tid = tid_, lane = tid & 63, wv = tid >> 6;
    const float* O = (const float*)(p.ws + OFF_O); const bf16_t* P = (const bf16_t*)(p.ws + OFF_P); bf16_t* OB = (bf16_t*)(p.ws + OFF_OB);
    const float* onw = p.gla_out_norm + (layer >> 1) * 256;
    for (int t = blockIdx.x * 8 + wv; t < NT; t += gridDim.x * 8) {
#pragma unroll
        for (int h = 0; h < 4; ++h) {
            const float* op = O + (size_t)t * 1024 + h * 256;
            const float4 o = *(const float4*)(op + lane * 4);
            const float ss = wave_sum(o.x * o.x + o.y * o.y + o.z * o.z + o.w * o.w);
            const float r = rsqrtf(ss * (1.f / 256.f) + EPS);
            const f32x4 z = unpack4(*(const uint2*)(P + (size_t)t * LDPB + 2048 + h * 256 + lane * 4));
            const float4 w = *(const float4*)(onw + lane * 4);
            f32x4 ov; ov[0] = o.x * r * w.x * siluf_(z[0]); ov[1] = o.y * r * w.y * siluf_(z[1]); ov[2] = o.z * r * w.z * siluf_(z[2]); ov[3] = o.w * r * w.w * siluf_(z[3]);
            *(uint2*)(OB + (size_t)t * 1024 + h * 256 + lane * 4) = pack4(ov);
        }
    }
}

template <int PH>
__device__ __forceinline__ void run_phase(const Params& p, int layer, float* smem) {
    if (PH == PH_PROLOGUE) { ph_prologue(p, smem); ph_conv_dense(p, smem); }
    else if (PH == PH_NORM_MIX) ph_rows(p, layer, 0, smem);
    else if (PH == PH_GEMM_IN_EVEN) ph_gemm_in(p, layer, true, smem);
    else if (PH == PH_EVEN_TOK) ph_even_tok(p, layer, smem);
    else if (PH == PH_GDN_CHUNK) ph_gdn_chunk(p, smem);
    else if (PH == PH_GDN_SCAN) ph_gdn_scan(p, smem);
    else if (PH == PH_DSA_TOPK) ph_dsa_topk(p, smem);
    else if (PH == PH_DSA_ATTN) ph_dsa_attn(p, smem);
    else if (PH == PH_GDN_OUT) ph_gdn_out(p, layer);
    else if (PH == PH_GEMM_OUT) ph_gemm_out(p, layer, smem);
    else if (PH == PH_NORM_FFN) { ph_norm_ffn(p, layer); ph_conv_exp(p, layer, smem); }
    else if (PH == PH_MOE1) ph_moe(p, layer, 0, smem);
    else if (PH == PH_MOE2) ph_moe(p, layer, 1, smem);
    else if (PH == PH_GEMM_IN_ODD) ph_gemm_in(p, layer, false, smem);
    else if (PH == PH_GLA_TOK) ph_gla_tok(p, layer);
    else if (PH == PH_GLA_CHUNK) ph_gla_chunk(p, smem);
    else if (PH == PH_GLA_SCAN) ph_gla_scan(p, smem);
    else if (PH == PH_GLA_OUT) ph_gla_out(p, layer);
    else if (PH == PH_FINAL) ph_rows(p, 0, 1, smem);
}

#if MK_MULTI
template <int PH>
__global__ void __launch_bounds__(NTHREADS, 2) k_phase(Params p, int layer) {
    run_phase<PH>(p, layer, (float*)g_smem);
}
#else
__global__ void __launch_bounds__(NTHREADS, 2) k_mega(Params p) {
    float* smem = (float*)g_smem;
    volatile LAS unsigned* xbw = (volatile LAS unsigned*)(LAS unsigned char*)(g_smem + LDS_BYTES - 16);
    if (threadIdx.x == 0) { xbw[0] = 0u; xbw[1] = 0u; xbw[2] = 0u; xbw[3] = 0u; }
    __syncthreads();
    XcdBarrier bar = xcd_barrier_post((unsigned*)(p.ws + OFF_BAR), xbw);
#define BAR() xcd_barrier(bar)
    run_phase<PH_PROLOGUE>(p, 0, smem); BAR(); if (DUP_MASK & 4096) { run_phase<PH_PROLOGUE>(p, 0, smem); BAR(); }
    for (int lp = 0; lp < 2; ++lp) {
        const int le = 2 * lp, lo = 2 * lp + 1;
        run_phase<PH_NORM_MIX>(p, le, smem); BAR();
        run_phase<PH_GEMM_IN_EVEN>(p, le, smem); BAR(); if (DUP_MASK & 1) { run_phase<PH_GEMM_IN_EVEN>(p, le, smem); BAR(); }
        run_phase<PH_EVEN_TOK>(p, le, smem); BAR(); if (DUP_MASK & 2) { run_phase<PH_EVEN_TOK>(p, le, smem); BAR(); }
        run_phase<PH_GDN_CHUNK>(p, le, smem); BAR(); if (DUP_MASK & 4) { run_phase<PH_GDN_CHUNK>(p, le, smem); BAR(); }
        run_phase<PH_GDN_SCAN>(p, le, smem); BAR(); if (DUP_MASK & 8) { run_phase<PH_GDN_SCAN>(p, le, smem); BAR(); }
        run_phase<PH_DSA_TOPK>(p, le, smem); BAR(); if (DUP_MASK & 16) { run_phase<PH_DSA_TOPK>(p, le, smem); BAR(); }
        run_phase<PH_DSA_ATTN>(p, le, smem); BAR(); if (DUP_MASK & 32) { run_phase<PH_DSA_ATTN>(p, le, smem); BAR(); }
        run_phase<PH_GDN_OUT>(p, le, smem); BAR();
        run_phase<PH_GEMM_OUT>(p, le, smem); BAR();
        run_phase<PH_NORM_FFN>(p, le, smem); BAR();
        run_phase<PH_MOE1>(p, le, smem); BAR(); if (DUP_MASK & 64) { run_phase<PH_MOE1>(p, le, smem); BAR(); }
        run_phase<PH_MOE2>(p, le, smem); BAR(); if (DUP_MASK & 128) { run_phase<PH_MOE2>(p, le, smem); BAR(); }
        run_phase<PH_NORM_MIX>(p, lo, smem); BAR();
        run_phase<PH_GEMM_IN_ODD>(p, lo, smem); BAR(); if (DUP_MASK & 256) { run_phase<PH_GEMM_IN_ODD>(p, lo, smem); BAR(); }
        run_phase<PH_GLA_TOK>(p, lo, smem); BAR(); if (DUP_MASK & 512) { run_phase<PH_GLA_TOK>(p, lo, smem); BAR(); }
        run_phase<PH_GLA_CHUNK>(p, lo, smem); BAR(); if (DUP_MASK & 1024) { run_phase<PH_GLA_CHUNK>(p, lo, smem); BAR(); }
        run_phase<PH_GLA_SCAN>(p, lo, smem); BAR(); if (DUP_MASK & 2048) { run_phase<PH_GLA_SCAN>(p, lo, smem); BAR(); }
        run_phase<PH_GLA_OUT>(p, lo, smem); BAR();
        run_phase<PH_GEMM_OUT>(p, lo, smem); BAR();
        run_phase<PH_NORM_FFN>(p, lo, smem); BAR();
        run_phase<PH_MOE1>(p, lo, smem); BAR(); if (DUP_MASK & 64) { run_phase<PH_MOE1>(p, lo, smem); BAR(); }
        run_phase<PH_MOE2>(p, lo, smem); BAR(); if (DUP_MASK & 128) { run_phase<PH_MOE2>(p, lo, smem); BAR(); }
    }
    for (int xb = 0; xb < EXTRA_BARS; ++xb) BAR();
    run_phase<PH_FINAL>(p, 0, smem);
}
#endif

}

#if MK_MULTI
template <int PH>
static void launch_phase(const Params& p, int layer, hipStream_t stream) {
    static bool attr_set = false;
    if (!attr_set) { hipFuncSetAttribute((const void*)k_phase<PH>, hipFuncAttributeMaxDynamicSharedMemorySize, (int)LDS_BYTES); attr_set = true; }
    hipLaunchKernelGGL((k_phase<PH>), dim3(256), dim3(NTHREADS), LDS_BYTES, stream, p, layer);
}
#endif

extern "C" void kernel_launch(void* const* d_in, const int* in_sizes, int n_in, void* d_out, int out_size, void* d_ws, size_t ws_size, hipStream_t stream) {
    (void)in_sizes; (void)n_in; (void)out_size;
    if (ws_size < WS_NEEDED) { fprintf(stderr, "workspace too small: %zu < %zu\n", ws_size, (size_t)WS_NEEDED); return; }
    Params p{};
    p.x = (const float*)d_in[0]; p.c = (const float*)d_in[1]; p.pos = (const int*)d_in[2]; p.ada_w = (const float*)d_in[3]; p.ada_b = (const float*)d_in[4];
    p.norm_mix = (const float*)d_in[5]; p.norm_ffn = (const float*)d_in[6]; p.even_w_in = (const float*)d_in[7]; p.conv_w = (const float*)d_in[8];
    p.a_log = (const float*)d_in[9]; p.dt_bias = (const float*)d_in[10]; p.gdn_out_norm = (const float*)d_in[11]; p.even_w_out = (const float*)d_in[12];
    p.gla_w_in = (const float*)d_in[13]; p.gla_w_gate2 = (const float*)d_in[14]; p.gla_b_gate2 = (const float*)d_in[15]; p.gla_out_norm = (const float*)d_in[16]; p.gla_w_out = (const float*)d_in[17];
    p.rg_w = (const float*)d_in[18]; p.rg_b = (const float*)d_in[19]; p.re_w = (const float*)d_in[20]; p.re_b = (const float*)d_in[21];
    p.w1 = (const float*)d_in[22]; p.w3 = (const float*)d_in[23]; p.w2 = (const float*)d_in[24]; p.final_norm = (const float*)d_in[25];
    p.X = (float*)d_out; p.ws = (unsigned char*)d_ws;
    p.rA = pow(10000.0, -2.0 / 128.0); p.rI = pow(10000.0, -2.0 / 64.0);
    hipMemsetAsync(d_ws, 0, ZERO_BYTES, stream);
#if MK_MULTI
    launch_phase<PH_PROLOGUE>(p, 0, stream);
    for (int lp = 0; lp < 2; ++lp) {
        const int le = 2 * lp, lo = 2 * lp + 1;
        launch_phase<PH_NORM_MIX>(p, le, stream);
        launch_phase<PH_GEMM_IN_EVEN>(p, le, stream);
        launch_phase<PH_EVEN_TOK>(p, le, stream);
        launch_phase<PH_GDN_CHUNK>(p, le, stream);
        launch_phase<PH_GDN_SCAN>(p, le, stream);
        launch_phase<PH_DSA_TOPK>(p, le, stream);
        launch_phase<PH_DSA_ATTN>(p, le, stream);
        launch_phase<PH_GDN_OUT>(p, le, stream);
        launch_phase<PH_GEMM_OUT>(p, le, stream);
        launch_phase<PH_NORM_FFN>(p, le, stream);
        launch_phase<PH_MOE1>(p, le, stream);
        launch_phase<PH_MOE2>(p, le, stream);
        launch_phase<PH_NORM_MIX>(p, lo, stream);
        launch_phase<PH_GEMM_IN_ODD>(p, lo, stream);
        launch_phase<PH_GLA_TOK>(p, lo, stream);
        launch_phase<PH_GLA_CHUNK>(p, lo, stream);
        launch_phase<PH_GLA_SCAN>(p, lo, stream);
        launch_phase<PH_GLA_OUT>(p, lo, stream);
        launch_phase<PH_GEMM_OUT>(p, lo, stream);
        launch_phase<PH_NORM_FFN>(p, lo, stream);
        launch_phase<PH_MOE1>(p, lo, stream);
        launch_phase<PH_MOE2>(p, lo, stream);
    }
    launch_phase<PH_FINAL>(p, 0, stream);
#else
    static int grid = 0;
    if (!grid) {
        int dev = 0, cus = 0, per_cu = 0;
        hipGetDevice(&dev);
        hipDeviceGetAttribute(&cus, hipDeviceAttributeMultiprocessorCount, dev);
        hipFuncSetAttribute((const void*)k_mega, hipFuncAttributeMaxDynamicSharedMemorySize, (int)LDS_BYTES);
        hipOccupancyMaxActiveBlocksPerMultiprocessor(&per_cu, k_mega, NTHREADS, LDS_BYTES);
        if (cus <= 0) cus = 256;
        grid = cus * (per_cu < 1 ? 1 : 1);
    }
    hipLaunchKernelGGL(k_mega, dim3(grid), dim3(NTHREADS), LDS_BYTES, stream, p);
#endif
}
```

```cpp
#include <hip/hip_runtime.h>
#include <stdint.h>
#include <math.h>
#include <stdio.h>

#define EXTRA_BARS 0
#define TOPK_SEARCH_REP 1
#ifndef DUP_MASK
#define DUP_MASK 0
#endif
#ifndef MK_MULTI
#define MK_MULTI 0
#endif

namespace {

constexpr int NT = 16384, ND = 1024, LDP = 3920, LDPB = 3968;
constexpr float EPS = 1e-6f;
constexpr int NTHREADS = 512;
constexpr size_t LDS_BYTES = 147456;
constexpr float SCALE128 = 0.08838834764831845f;
constexpr int LISTCAP = 32768;
constexpr int CSTR = 16;

constexpr size_t OFF_BAR  = 0;
constexpr size_t OFF_CNT  = 16384;
constexpr size_t ZERO_BYTES = 32768;
constexpr size_t OFF_MOD  = 32768;
constexpr size_t OFF_COSA = OFF_MOD + 4 * 2 * 6144 * 4;
constexpr size_t OFF_SINA = OFF_COSA + (size_t)NT * 64 * 4;
constexpr size_t OFF_COSI = OFF_SINA + (size_t)NT * 64 * 4;
constexpr size_t OFF_SINI = OFF_COSI + (size_t)NT * 32 * 4;
constexpr size_t OFF_H    = OFF_SINI + (size_t)NT * 32 * 4;
constexpr size_t OFF_P    = OFF_H + (size_t)NT * 1024 * 4;
constexpr size_t OFF_HID  = OFF_P;
constexpr size_t OFF_YB   = OFF_HID + (size_t)36864 * 512 * 4;
constexpr size_t OFF_O    = OFF_P + (size_t)NT * LDP * 4;
constexpr size_t OFF_ASG  = OFF_O + (size_t)NT * 1024 * 4;
constexpr size_t OFF_GATE = OFF_ASG + (size_t)NT * 4 * 4;
constexpr size_t OFF_LIST = OFF_GATE + (size_t)NT * 2 * 4;
constexpr size_t OFF_R    = OFF_LIST + (size_t)32 * LISTCAP * 4;
constexpr size_t OFF_QN   = OFF_R;
constexpr size_t OFF_KN   = OFF_QN + (size_t)NT * 512 * 4;
constexpr size_t OFF_VC   = OFF_KN + (size_t)NT * 512 * 4;
constexpr size_t OFF_BETA = OFF_VC + (size_t)NT * 512 * 4;
constexpr size_t OFF_G    = OFF_BETA + (size_t)NT * 4 * 4;
constexpr size_t OFF_W    = OFF_G + (size_t)NT * 4 * 4;
constexpr size_t OFF_U    = OFF_W + (size_t)1024 * 8192 * 4;
constexpr size_t OFF_QG   = OFF_U + (size_t)1024 * 8192 * 4;
constexpr size_t OFF_KD   = OFF_QG + (size_t)1024 * 8192 * 4;
constexpr size_t OFF_AQK  = OFF_KD + (size_t)1024 * 8192 * 4;
constexpr size_t OFF_GL   = OFF_AQK + (size_t)1024 * 4096 * 4;
constexpr size_t OFF_QB   = OFF_GL + 4096;
constexpr size_t OFF_KB   = OFF_QB + (size_t)NT * 512 * 4;
constexpr size_t OFF_QI   = OFF_KB + (size_t)NT * 512 * 4;
constexpr size_t OFF_KI   = OFF_QI + (size_t)NT * 256 * 4;
constexpr size_t OFF_WI   = OFF_KI + (size_t)NT * 64 * 4;
constexpr size_t OFF_SEL  = OFF_WI + (size_t)NT * 4 * 4;
constexpr size_t OFF_EVEN_END = OFF_SEL + (size_t)NT * 256 * 4;
constexpr size_t OFF_PFR  = OFF_W;
constexpr size_t OFF_RFR  = OFF_PFR + (size_t)1024 * 32768;
constexpr size_t OFF_QFR  = OFF_RFR + (size_t)1024 * 16384;
constexpr size_t OFF_OFR  = OFF_QFR + (size_t)1024 * 32768;
static_assert(OFF_OFR + (size_t)1024 * 16384 <= OFF_GL, "gdn v2 buffers overflow");
constexpr size_t OFF_QBB  = OFF_QB;
constexpr size_t OFF_KBB  = OFF_QBB + (size_t)NT * 512 * 2;
constexpr size_t OFF_VT   = OFF_KBB + (size_t)NT * 512 * 2;
constexpr size_t OFF_QIB  = OFF_VT + (size_t)NT * 512 * 2;
constexpr size_t OFF_KIB  = OFF_QIB + (size_t)NT * 256 * 2;
constexpr size_t OFF_M16  = OFF_KIB + (size_t)NT * 64 * 2;
static_assert(OFF_M16 + (size_t)NT * 512 * 2 <= OFF_WI, "dsa v2 buffers overflow");
constexpr size_t OFF_LA   = OFF_R;
constexpr size_t OFF_ATT  = OFF_LA + (size_t)NT * 512 * 4;
constexpr size_t OFF_QE   = OFF_ATT + (size_t)1024 * 4096 * 4;
constexpr size_t OFF_GKD  = OFF_QE + (size_t)1024 * 8192 * 4;
constexpr size_t OFF_EBL  = OFF_GKD + (size_t)1024 * 8192 * 4;
constexpr size_t OFF_GQE  = OFF_LA + (size_t)NT * 512 * 4;
constexpr size_t OFF_GOI  = OFF_GQE + (size_t)1024 * 16384;
constexpr size_t OFF_GH   = OFF_GOI + (size_t)1024 * 32768;
constexpr size_t OFF_GEBL = OFF_GH + (size_t)1024 * 65536;
static_assert(OFF_GEBL + (size_t)1024 * 512 <= OFF_EVEN_END, "gla v2 buffers overflow");
constexpr size_t OFF_WINE = OFF_EVEN_END;
constexpr size_t OFF_WINO = OFF_WINE + (size_t)2 * 3968 * 1024 * 2;
constexpr size_t OFF_WOUT = OFF_WINO + (size_t)2 * 3200 * 1024 * 2;
constexpr size_t OFF_W13  = OFF_WOUT + (size_t)4 * 1024 * 1024 * 2;
constexpr size_t OFF_W2T  = OFF_W13 + (size_t)32 * 1024 * 1024 * 2;
constexpr size_t OFF_OB   = OFF_W2T + (size_t)32 * 1024 * 512 * 2;
constexpr size_t OFF_AUX  = OFF_OB + (size_t)NT * 1024 * 2;
constexpr size_t WS_NEEDED = OFF_AUX + (size_t)NT * 16 * 4;

struct Params {
    const float* x; const float* c; const int* pos; const float* ada_w; const float* ada_b;
    const float* norm_mix; const float* norm_ffn; const float* even_w_in; const float* conv_w;
    const float* a_log; const float* dt_bias; const float* gdn_out_norm; const float* even_w_out;
    const float* gla_w_in; const float* gla_w_gate2; const float* gla_b_gate2; const float* gla_out_norm; const float* gla_w_out;
    const float* rg_w; const float* rg_b; const float* re_w; const float* re_b;
    const float* w1; const float* w3; const float* w2; const float* final_norm;
    float* X;
    unsigned char* ws;
    double rA, rI;
};

#define XB_TMO      128
#define XB_XCNT(j)  (256  + 64 * (j))
#define XB_XSUB(j)  (1280 + 64 * (j))
#define XB_XGEN(j)  (2304 + 64 * (j))
#define XB_TOP      3328
#define XB_TOPGEN   3392
#define XCD_BAR_WORDS 3456
#define XB_SPIN_CAP (1u << 18)
#define LAS __attribute__((address_space(3)))

__device__ __forceinline__ unsigned xb_ld(unsigned* p)              { return __hip_atomic_load(p, __ATOMIC_RELAXED, __HIP_MEMORY_SCOPE_AGENT); }
__device__ __forceinline__ unsigned xb_add(unsigned* p, unsigned v) { return __hip_atomic_fetch_add(p, v, __ATOMIC_RELAXED, __HIP_MEMORY_SCOPE_AGENT); }
__device__ __forceinline__ unsigned xb_xcc_id() { return (unsigned)__builtin_amdgcn_s_getreg((3 << 11) | 20) & 0xFu; }
#define XB_SPIN(cond, bar) do { unsigned _sp = 0; while (cond) { __builtin_amdgcn_s_sleep(1); \
    if ((++_sp & 255u) == 0u) { if (xb_ld(&(bar)[XB_TMO])) break; if (_sp > XB_SPIN_CAP) { atomicAdd(&(bar)[XB_TMO], 1u); break; } } } } while (0)

struct XcdBarrier { unsigned* bar; unsigned x; volatile LAS unsigned* st; };

__device__ __forceinline__ XcdBarrier xcd_barrier_post(unsigned* bar, volatile LAS unsigned* st) {
    XcdBarrier b; b.bar = bar; b.x = xb_xcc_id(); b.st = st;
    if (threadIdx.x == 0) (void)xb_add(&bar[XB_XCNT(b.x)], 1u);
    return b;
}
__device__ __forceinline__ void xcd_barrier_complete(unsigned* bar, unsigned x, unsigned& nloc, unsigned& nx) {
    const unsigned G = gridDim.x * gridDim.y * gridDim.z;
    unsigned sum, cnt, mine, sp = 0u;
    for (;;) {
        sum = 0u; cnt = 0u; mine = 0u;
#pragma unroll
        for (unsigned j = 0; j < 16; ++j) { const unsigned c = xb_ld(&bar[XB_XCNT(j)]); sum += c; cnt += (c > 0u) ? 1u : 0u; mine = (j == x) ? c : mine; }
        if (sum == G) break;
        __builtin_amdgcn_s_sleep(1);
        if ((++sp & 255u) == 0u) { if (xb_ld(&bar[XB_TMO])) break; if (sp > XB_SPIN_CAP) { atomicAdd(&bar[XB_TMO], 1u); break; } }
    }
    nloc = mine > 0u ? mine : 1u; nx = cnt > 0u ? cnt : 1u;
}
__device__ __forceinline__ void xcd_barrier(const XcdBarrier& b) {
    asm volatile("s_waitcnt vmcnt(0)" ::: "memory");
    __syncthreads();
    if (threadIdx.x == 0) {
        unsigned* bar = b.bar;
        __builtin_amdgcn_s_waitcnt(0);
        unsigned nloc = b.st[0], nx = b.st[1];
        if (nloc == 0u) { xcd_barrier_complete(bar, b.x, nloc, nx); b.st[0] = nloc; b.st[1] = nx; }
        const unsigned old = xb_add(&bar[XB_XSUB(b.x)], 1u);
        const unsigned gen = old / nloc;
        if (old + 1u == (gen + 1u) * nloc) {
            __builtin_amdgcn_fence(__ATOMIC_RELEASE, "agent");
            asm volatile("s_waitcnt vmcnt(0)" ::: "memory");
            const unsigned og = xb_add(&bar[XB_TOP], 1u);
            const unsigned tg = og / nx;
            if (og + 1u == (tg + 1u) * nx) xb_add(&bar[XB_TOPGEN], 1u);
            else XB_SPIN(xb_ld(&bar[XB_TOPGEN]) == tg, bar);
            __builtin_amdgcn_fence(__ATOMIC_ACQUIRE, "agent");
            xb_add(&bar[XB_XGEN(b.x)], 1u);
            asm volatile("s_waitcnt vmcnt(0)" ::: "memory");
        } else {
            XB_SPIN(xb_ld(&bar[XB_XGEN(b.x)]) == gen, bar);
            __builtin_amdgcn_fence(__ATOMIC_ACQUIRE, "agent");
            asm volatile("s_waitcnt vmcnt(0)" ::: "memory");
        }
    }
    __syncthreads();
}

__device__ __forceinline__ float wave_sum(float v) {
#pragma unroll
    for (int o = 32; o > 0; o >>= 1) v += __shfl_xor(v, o);
    return v;
}
__device__ __forceinline__ int wave_sum_i(int v) {
#pragma unroll
    for (int o = 32; o > 0; o >>= 1) v += __shfl_xor(v, o);
    return v;
}
__device__ __forceinline__ float wave_max(float v) {
#pragma unroll
    for (int o = 32; o > 0; o >>= 1) v = fmaxf(v, __shfl_xor(v, o));
    return v;
}
__device__ __forceinline__ float sigmoidf_(float x) { return 1.f / (1.f + expf(-x)); }
__device__ __forceinline__ float siluf_(float x) { return x / (1.f + expf(-x)); }
__device__ __forceinline__ float softplusf_(float x) { return fmaxf(x, 0.f) + log1pf(expf(-fabsf(x))); }
__device__ __forceinline__ unsigned ordkey(float f) { const unsigned u = __float_as_uint(f); return (u & 0x80000000u) ? ~u : (u | 0x80000000u); }

__device__ __forceinline__ void sincos_d(double a, double& s, double& c) {
    const double kq = rint(a * 0.63661977236758134308);
    double r = fma(-kq, 1.57079632673412561417e+00, a);
    r = fma(-kq, 6.07710050650619224932e-11, r);
    const int q = (int)((long long)kq & 3);
    const double r2 = r * r;
    const double sp = r * (1.0 + r2 * (-1.0 / 6 + r2 * (1.0 / 120 + r2 * (-1.0 / 5040 + r2 * (1.0 / 362880 + r2 * (-1.0 / 39916800 + r2 * (1.0 / 6227020800.0)))))));
    const double cp = 1.0 + r2 * (-0.5 + r2 * (1.0 / 24 + r2 * (-1.0 / 720 + r2 * (1.0 / 40320 + r2 * (-1.0 / 3628800 + r2 * (1.0 / 479001600.0 + r2 * (-1.0 / 87178291200.0)))))));
    if (q == 0) { s = sp; c = cp; } else if (q == 1) { s = cp; c = -sp; } else if (q == 2) { s = -sp; c = -cp; } else { s = -cp; c = sp; }
}
__device__ __forceinline__ double ipow_d(double b, int e) { double v = 1.0; while (e) { if (e & 1) v *= b; b *= b; e >>= 1; } return v; }

struct GemmArgs { const float* A; int lda; const int* rows; int m0; int mvalid; const float* B; int ldb; int n0; int N; int K; };

template <class Epi>
__device__ __forceinline__ void gemm128(const GemmArgs& g, float* smem, Epi epi) {
    float* As = smem;
    float* Bs = smem + 16 * 132;
    int tid_ = threadIdx.x; asm volatile("" : "+v"(tid_)); const int tid = tid_, ty = tid >> 4, tx = tid & 15;
    const int arow = tid >> 2, kq = (tid & 3) * 4;
    const int bk = tid >> 5, bn = (tid & 31) * 4;
    long asrc = -1;
    if (arow < g.mvalid) { const int r = g.rows ? g.rows[arow] : (g.m0 + arow); if (r >= 0) asrc = (long)r * g.lda; }
    const bool bval = (g.n0 + bn) < g.N;
    float acc[4][8];
#pragma unroll
    for (int i = 0; i < 4; ++i)
#pragma unroll
        for (int j = 0; j < 8; ++j) acc[i][j] = 0.f;
    for (int k0 = 0; k0 < g.K; k0 += 16) {
        float4 av = make_float4(0.f, 0.f, 0.f, 0.f), bv = make_float4(0.f, 0.f, 0.f, 0.f);
        if (asrc >= 0) av = *(const float4*)(g.A + asrc + k0 + kq);
        if (bval) bv = *(const float4*)(g.B + (size_t)(k0 + bk) * g.ldb + g.n0 + bn);
        __syncthreads();
        As[(kq + 0) * 132 + arow] = av.x; As[(kq + 1) * 132 + arow] = av.y; As[(kq + 2) * 132 + arow] = av.z; As[(kq + 3) * 132 + arow] = av.w;
        *(float4*)&Bs[bk * 132 + bn] = bv;
        __syncthreads();
#pragma unroll
        for (int kk = 0; kk < 16; ++kk) {
            const float4 a = *(const float4*)&As[kk * 132 + ty * 4];
            const float4 b0 = *(const float4*)&Bs[kk * 132 + tx * 8];
            const float4 b1 = *(const float4*)&Bs[kk * 132 + tx * 8 + 4];
            const float aa[4] = {a.x, a.y, a.z, a.w};
            const float bb[8] = {b0.x, b0.y, b0.z, b0.w, b1.x, b1.y, b1.z, b1.w};
#pragma unroll
            for (int i = 0; i < 4; ++i)
#pragma unroll
                for (int j = 0; j < 8; ++j) acc[i][j] += aa[i] * bb[j];
        }
    }
#pragma unroll
    for (int i = 0; i < 4; ++i) {
        const int r = ty * 4 + i;
        if (r < g.mvalid) {
#pragma unroll
            for (int j = 0; j < 8; ++j) { const int n = g.n0 + tx * 8 + j; if (n < g.N) epi(r, n, acc[i][j]); }
        }
    }
}


typedef short bf16x8 __attribute__((ext_vector_type(8)));
typedef float f32x4 __attribute__((ext_vector_type(4)));
typedef unsigned short bf16_t;
typedef __bf16 bf16x2_t __attribute__((ext_vector_type(2)));
typedef float f32x2_t __attribute__((ext_vector_type(2)));
__device__ __forceinline__ unsigned cvt_pk_bf16(float lo, float hi) { const f32x2_t v = {lo, hi}; const bf16x2_t r = __builtin_convertvector(v, bf16x2_t); return __builtin_bit_cast(unsigned, r); }
__device__ __forceinline__ bf16_t f2bf(float f) { return (bf16_t)(cvt_pk_bf16(f, 0.f) & 0xffffu); }
__device__ __forceinline__ float bf16_to_f32(bf16_t v) { return __uint_as_float(((unsigned)v) << 16); }
__device__ __forceinline__ uint2 pack4(const f32x4 v) { uint2 r; r.x = cvt_pk_bf16(v[0], v[1]); r.y = cvt_pk_bf16(v[2], v[3]); return r; }
__device__ __forceinline__ f32x4 unpack4(const uint2 u) { f32x4 r; r[0] = __uint_as_float(u.x << 16); r[1] = __uint_as_float(u.x & 0xffff0000u); r[2] = __uint_as_float(u.y << 16); r[3] = __uint_as_float(u.y & 0xffff0000u); return r; }
#define PBF(Pb_, t_, c_) bf16_to_f32((Pb_)[(size_t)(t_) * LDPB + (c_)])
__device__ __forceinline__ uint4 pack8(const float4 a, const float4 b) { uint4 r; r.x = cvt_pk_bf16(a.x, a.y); r.y = cvt_pk_bf16(a.z, a.w); r.z = cvt_pk_bf16(b.x, b.y); r.w = cvt_pk_bf16(b.z, b.w); return r; }
__device__ __forceinline__ int lds_off(int r, int c) { return r * 128 + ((c ^ (r & 7)) << 4); }

template <class ALoad, class BLoad, class Epi>
__device__ __forceinline__ void gemm_tile_bf16(const int K, unsigned char* lds, ALoad aload, BLoad bload, Epi epi) {
    int tid_ = threadIdx.x; asm volatile("" : "+v"(tid_)); const int tid = tid_, lane = tid & 63, wid = tid >> 6, wm = wid >> 1, wn = wid & 1;
    f32x4 acc[4][4];
#pragma unroll
    for (int mi = 0; mi < 4; ++mi)
#pragma unroll
        for (int ni = 0; ni < 4; ++ni) acc[mi][ni] = (f32x4){0.f, 0.f, 0.f, 0.f};
    uint4 ra[4], rb[2];
    const int nk = K >> 6;
#pragma unroll
    for (int i = 0; i < 4; ++i) { const int q = tid + 512 * i; ra[i] = aload(i, q >> 3, (q & 7) * 8); }
#pragma unroll
    for (int i = 0; i < 2; ++i) { const int q = tid + 512 * i; rb[i] = bload(i, q >> 3, (q & 7) * 8); }
    __syncthreads();
#pragma unroll
    for (int i = 0; i < 4; ++i) { const int q = tid + 512 * i; *(uint4*)(lds + lds_off(q >> 3, q & 7)) = ra[i]; }
#pragma unroll
    for (int i = 0; i < 2; ++i) { const int q = tid + 512 * i; *(uint4*)(lds + 32768 + lds_off(q >> 3, q & 7)) = rb[i]; }
    __syncthreads();
    for (int kt = 0; kt < nk; ++kt) {
        if (kt + 1 < nk) {
#pragma unroll
            for (int i = 0; i < 4; ++i) { const int q = tid + 512 * i; ra[i] = aload(i, q >> 3, (kt + 1) * 64 + (q & 7) * 8); }
#pragma unroll
            for (int i = 0; i < 2; ++i) { const int q = tid + 512 * i; rb[i] = bload(i, q >> 3, (kt + 1) * 64 + (q & 7) * 8); }
        }
        const unsigned char* At = lds + (kt & 1) * 49152;
        const unsigned char* Bt = At + 32768;
#pragma unroll
        for (int ks = 0; ks < 2; ++ks) {
            bf16x8 af[4], bfr[4];
            const int c = ks * 4 + (lane >> 4);
#pragma unroll
            for (int mi = 0; mi < 4; ++mi) af[mi] = *(const bf16x8*)(At + lds_off(wm * 64 + mi * 16 + (lane & 15), c));
#pragma unroll
            for (int ni = 0; ni < 4; ++ni) bfr[ni] = *(const bf16x8*)(Bt + lds_off(wn * 64 + ni * 16 + (lane & 15), c));
#pragma unroll
            for (int mi = 0; mi < 4; ++mi)
#pragma unroll
                for (int ni = 0; ni < 4; ++ni) acc[mi][ni] = __builtin_amdgcn_mfma_f32_16x16x32_bf16(bfr[ni], af[mi], acc[mi][ni], 0, 0, 0);
        }
        if (kt + 1 < nk) {
            unsigned char* An = lds + ((kt + 1) & 1) * 49152;
#pragma unroll
            for (int i = 0; i < 4; ++i) { const int q = tid + 512 * i; *(uint4*)(An + lds_off(q >> 3, q & 7)) = ra[i]; }
#pragma unroll
            for (int i = 0; i < 2; ++i) { const int q = tid + 512 * i; *(uint4*)(An + 32768 + lds_off(q >> 3, q & 7)) = rb[i]; }
        }
        __syncthreads();
    }
    epi(acc, wm, wn, lane);
}

__device__ __forceinline__ void convert_tile(const float* src0, const float* src1, int mode, int K, int N, int ld, bf16_t* dst, int rt, int kt, float* smem) {
    int tid_ = threadIdx.x; asm volatile("" : "+v"(tid_)); const int tid = tid_;
    __syncthreads();
    { const int k = tid >> 3, R0 = rt * 64 + (tid & 7) * 8;
      const float* sp; int col;
      if (mode == 0) { sp = src0; col = R0; } else { sp = (R0 & 32) ? src1 : src0; col = (R0 >> 6) * 32 + (R0 & 31); }
      float4 a = make_float4(0.f, 0.f, 0.f, 0.f), b = a;
      const float* rp = sp + (size_t)(kt * 64 + k) * ld + col;
      if (col < N) a = *(const float4*)rp;
      if (col + 4 < N) b = *(const float4*)(rp + 4);
      float* d = smem + k * 65 + (tid & 7) * 8;
      d[0] = a.x; d[1] = a.y; d[2] = a.z; d[3] = a.w; d[4] = b.x; d[5] = b.y; d[6] = b.z; d[7] = b.w; }
    __syncthreads();
    { const int R = tid >> 3, kc = (tid & 7) * 8;
      float v[8];
#pragma unroll
      for (int j = 0; j < 8; ++j) v[j] = smem[(kc + j) * 65 + R];
      uint4 o; o.x = cvt_pk_bf16(v[0], v[1]); o.y = cvt_pk_bf16(v[2], v[3]); o.z = cvt_pk_bf16(v[4], v[5]); o.w = cvt_pk_bf16(v[6], v[7]);
      *(uint4*)(dst + (size_t)(rt * 64 + R) * K + kt * 64 + kc) = o; }
}

extern __shared__ __attribute__((aligned(16))) unsigned char g_smem[];
#define PHASE_FN __device__ __forceinline__
enum { PH_PROLOGUE = 0, PH_NORM_MIX, PH_GEMM_IN_EVEN, PH_EVEN_TOK, PH_GDN_CHUNK, PH_GDN_SCAN, PH_DSA_TOPK, PH_DSA_ATTN, PH_GDN_OUT,
       PH_GEMM_OUT, PH_NORM_FFN, PH_MOE1, PH_MOE2, PH_GEMM_IN_ODD, PH_GLA_TOK, PH_GLA_CHUNK, PH_GLA_SCAN, PH_GLA_OUT, PH_FINAL };

PHASE_FN void ph_prologue(const Params& p, float* smem) {
    unsigned char* ws_ = p.ws; asm volatile("" : "+s"(ws_));
    { int ldz_ = 0; asm volatile("" : "+s"(ldz_)); smem = (float*)(g_smem + ldz_); }
    int tid_ = threadIdx.x; asm volatile("" : "+v"(tid_)); const int tid = tid_, nthr = gridDim.x * NTHREADS, gid = blockIdx.x * NTHREADS + tid;
    { const float4* src = (const float4*)p.x; float4* dst = (float4*)p.X;
      for (size_t i = gid; i < (size_t)NT * ND / 4; i += nthr) dst[i] = src[i]; }
    for (int i = tid; i < 2 * ND; i += NTHREADS) smem[i] = siluf_(p.c[i]);
    __syncthreads();
    float* MOD = (float*)(ws_ + OFF_MOD);
    { float* red = smem + 2048;
      const int lane = tid & 63, wv = tid >> 6;
      for (int item = blockIdx.x; item < 4 * 96; item += gridDim.x) {
          const int l = item / 96, n = (item % 96) * 64 + lane;
          const float* w = p.ada_w + (size_t)l * ND * 6144 + n;
          float a0 = 0.f, a1 = 0.f;
#pragma unroll 8
          for (int k = wv * 128; k < wv * 128 + 128; ++k) { const float wv_ = w[(size_t)k * 6144]; a0 += smem[k] * wv_; a1 += smem[ND + k] * wv_; }
          __syncthreads();
          red[(wv * 64 + lane) * 2] = a0; red[(wv * 64 + lane) * 2 + 1] = a1;
          __syncthreads();
          if (tid < 128) { const int c = tid >> 1, bb = tid & 1; float a = 0.f; for (int w8 = 0; w8 < 8; ++w8) a += red[(w8 * 64 + c) * 2 + bb];
              MOD[(l * 2 + bb) * 6144 + (item % 96) * 64 + c] = a + p.ada_b[l * 6144 + (item % 96) * 64 + c]; }
      }
      __syncthreads(); }
    float* COSA = (float*)(ws_ + OFF_COSA); float* SINA = (float*)(ws_ + OFF_SINA);
    float* COSI = (float*)(ws_ + OFF_COSI); float* SINI = (float*)(ws_ + OFF_SINI);
    for (size_t i = gid; i < (size_t)NT * 64; i += nthr) {
        const int t = (int)(i >> 6), j = (int)(i & 63);
        double s, c; sincos_d((double)p.pos[t] * ipow_d(p.rA, j), s, c);
        COSA[i] = (float)c; SINA[i] = (float)s;
    }
    for (size_t i = gid; i < (size_t)NT * 32; i += nthr) {
        const int t = (int)(i >> 5), j = (int)(i & 31);
        double s, c; sincos_d((double)p.pos[t] * ipow_d(p.rI, j), s, c);
        COSI[i] = (float)c; SINI[i] = (float)s;
    }
}

PHASE_FN void ph_rows(const Params& p, int layer, int mode, float* smem) {
    unsigned char* ws_ = p.ws; asm volatile("" : "+s"(ws_));
    { int ldz_ = 0; asm volatile("" : "+s"(ldz_)); smem = (float*)(g_smem + ldz_); }
    int tid_ = threadIdx.x; asm volatile("" : "+v"(tid_)); const int tid = tid_, lane = tid & 63, wv = tid >> 6;
    int* pad = (int*)smem;
    const int moe_layer = (mode == 1) ? 3 : layer - 1;
    if (moe_layer >= 0) {
        if (tid == 0) { const int* cnt = (const int*)(ws_ + OFF_CNT) + moe_layer * 32 * CSTR; int a = 0; for (int e = 0; e < 32; ++e) { pad[e] = a; a += ((cnt[e * CSTR] + 127) / 128) * 128; } }
        __syncthreads();
    }
    const float* MOD = (const float*)(ws_ + OFF_MOD);
    bf16_t* H = (bf16_t*)(ws_ + OFF_H);
    const float* YB = (const float*)(ws_ + OFF_YB);
    const int* ASG = (const int*)(ws_ + OFF_ASG);
    const float* GATE = (const float*)(ws_ + OFF_GATE);
    for (int row = blockIdx.x * 8 + wv; row < NT; row += gridDim.x * 8) {
        const int b = row >> 13;
        float* xr = p.X + (size_t)row * ND;
        float xv[16];
#pragma unroll
        for (int j = 0; j < 4; ++j) { const float4 v = *(const float4*)(xr + j * 256 + lane * 4); xv[4 * j] = v.x; xv[4 * j + 1] = v.y; xv[4 * j + 2] = v.z; xv[4 * j + 3] = v.w; }
        if (moe_layer >= 0) {
            const float* gt = MOD + (size_t)(moe_layer * 2 + b) * 6144 + 5 * 1024;
            const int e0 = ASG[row * 4 + 0], r0 = ASG[row * 4 + 1], e1 = ASG[row * 4 + 2], r1 = ASG[row * 4 + 3];
            const float g0 = GATE[row * 2], g1 = GATE[row * 2 + 1];
            const float* y0 = YB + (size_t)(pad[e0] + r0) * ND;
            const float* y1 = YB + (size_t)(pad[e1] + r1) * ND;
#pragma unroll
            for (int j = 0; j < 4; ++j) {
                const int col = j * 256 + lane * 4;
                const float4 a = *(const float4*)(y0 + col), bq = *(const float4*)(y1 + col), g = *(const float4*)(gt + col);
                xv[4 * j] += g.x * (g0 * a.x + g1 * bq.x); xv[4 * j + 1] += g.y * (g0 * a.y + g1 * bq.y);
                xv[4 * j + 2] += g.z * (g0 * a.z + g1 * bq.z); xv[4 * j + 3] += g.w * (g0 * a.w + g1 * bq.w);
                if (mode == 0) *(float4*)(xr + col) = make_float4(xv[4 * j], xv[4 * j + 1], xv[4 * j + 2], xv[4 * j + 3]);
            }
        }
        float ss = 0.f;
#pragma unroll
        for (int j = 0; j < 16; ++j) ss += xv[j] * xv[j];
        ss = wave_sum(ss);
        const float rstd = rsqrtf(ss * (1.f / 1024.f) + EPS);
        if (mode == 0) {
            const float* nw = p.norm_mix + layer * 1024;
            const float* sh = MOD + (size_t)(layer * 2 + b) * 6144;
            const float* sc = sh + 1024;
#pragma unroll
            for (int j = 0; j < 4; ++j) {
                const int col = j * 256 + lane * 4;
                const float4 w = *(const float4*)(nw + col), s4 = *(const float4*)(sc + col), h4 = *(const float4*)(sh + col);
                float4 o;
                o.x = xv[4 * j] * rstd * w.x * (1.f + s4.x) + h4.x; o.y = xv[4 * j + 1] * rstd * w.y * (1.f + s4.y) + h4.y;
                o.z = xv[4 * j + 2] * rstd * w.z * (1.f + s4.z) + h4.z; o.w = xv[4 * j + 3] * rstd * w.w * (1.f + s4.w) + h4.w;
                { f32x4 ov; ov[0] = o.x; ov[1] = o.y; ov[2] = o.z; ov[3] = o.w; *(uint2*)(H + (size_t)row * ND + col) = pack4(ov); }
            }
        } else {
#pragma unroll
            for (int j = 0; j < 4; ++j) {
                const int col = j * 256 + lane * 4;
                const float4 w = *(const float4*)(p.final_norm + col);
                *(float4*)(xr + col) = make_float4(xv[4 * j] * rstd * w.x, xv[4 * j + 1] * rstd * w.y, xv[4 * j + 2] * rstd * w.z, xv[4 * j + 3] * rstd * w.w);
            }
        }
    }
}

PHASE_FN void ph_gemm_in(const Params& p, int layer, bool even, float* smem) {
    unsigned char* ws_ = p.ws; asm volatile("" : "+s"(ws_));
    { int ldz_ = 0; asm volatile("" : "+s"(ldz_)); smem = (float*)(g_smem + ldz_); }
    const int N = even ? 3916 : 3088, ntn = even ? 31 : 25;
    const bf16_t* Wt = even ? (const bf16_t*)(ws_ + OFF_WINE) + (size_t)(layer >> 1) * 3968 * 1024 : (const bf16_t*)(ws_ + OFF_WINO) + (size_t)(layer >> 1) * 3200 * 1024;
    const bf16_t* H = (const bf16_t*)(ws_ + OFF_H);
    bf16_t* P = (bf16_t*)(ws_ + OFF_P);
    float* AUX = (float*)(ws_ + OFF_AUX);
    for (int tile = blockIdx.x; tile < 64 * ntn; tile += gridDim.x) {
        const int mt = tile % 64, nt = tile / 64;
        const bf16_t* Ab = H + (size_t)mt * 256 * 1024;
        const bf16_t* Bb = Wt + (size_t)nt * 128 * 1024;
        bf16_t* Pt = P + (size_t)mt * 256 * LDPB + nt * 128;
        float* At = AUX + (size_t)mt * 256 * 16;
        const int ncol0 = nt * 128;
        const int nrem = N - nt * 128;
        gemm_tile_bf16(1024, (unsigned char*)smem,
            [=](int i, int r, int k) -> uint4 { return *(const uint4*)(Ab + (size_t)r * 1024 + k); },
            [=](int i, int r, int k) -> uint4 { return *(const uint4*)(Bb + (size_t)r * 1024 + k); },
            [=](const f32x4 (&acc)[4][4], int wm, int wn, int lane) {
#pragma unroll
                for (int mi = 0; mi < 4; ++mi)
#pragma unroll
                    for (int ni = 0; ni < 4; ++ni) {
                        const int m = wm * 64 + mi * 16 + (lane & 15), n = wn * 64 + ni * 16 + 4 * (lane >> 4);
                        if (n < nrem) {
                            *(uint2*)(Pt + (size_t)m * LDPB + n) = pack4(acc[mi][ni]);
                            const int gc = ncol0 + n;
                            int ax = -1;
                            if (even) { if (gc == 2048) ax = 0; else if (gc == 2052) ax = 4; else if (gc == 3912) ax = 8; }
                            else { if (gc >= 3072 && gc < 3088) ax = gc - 3072; }
                            if (ax >= 0) *(f32x4*)(At + (size_t)m * 16 + ax) = acc[mi][ni];
                        }
                    }
            });
    }
}

PHASE_FN void ph_even_tok(const Params& p, int layer, float* smem) {
    unsigned char* ws_ = p.ws; asm volatile("" : "+s"(ws_));
    { int ldz_ = 0; asm volatile("" : "+s"(ldz_)); smem = (float*)(g_smem + ldz_); }
    int tid_ = threadIdx.x; asm volatile("" : "+v"(tid_)); const int tid = tid_, lane = tid & 63, wv = tid >> 6, li = layer >> 1;
    const bf16_t* P = (const bf16_t*)(ws_ + OFF_P); const float* AUX = (const float*)(ws_ + OFF_AUX);
    bf16_t* QB = (bf16_t*)(ws_ + OFF_QBB); bf16_t* KB = (bf16_t*)(ws_ + OFF_KBB); bf16_t* QI = (bf16_t*)(ws_ + OFF_QIB); bf16_t* KI = (bf16_t*)(ws_ + OFF_KIB); float* WI = (float*)(ws_ + OFF_WI);
    const float* COSA = (const float*)(ws_ + OFF_COSA); const float* SINA = (const float*)(ws_ + OFF_SINA);
    const float* COSI = (const float*)(ws_ + OFF_COSI); const float* SINI = (const float*)(ws_ + OFF_SINI);
    for (int t = blockIdx.x * 8 + wv; t < NT; t += gridDim.x * 8) {
        const bf16_t* Pt = P + (size_t)t * LDPB;
        if (lane < 4) {
            WI[t * 4 + lane] = AUX[(size_t)t * 16 + 8 + lane] * 0.0625f;
        }
        { const float c = COSA[(size_t)t * 64 + lane], sn = SINA[(size_t)t * 64 + lane];
#pragma unroll
          for (int h = 0; h < 4; ++h) {
              float t1 = bf16_to_f32(Pt[2056 + h * 128 + lane]), t2 = bf16_to_f32(Pt[2056 + h * 128 + 64 + lane]);
              QB[(size_t)t * 512 + h * 128 + lane] = f2bf(t1 * c - t2 * sn); QB[(size_t)t * 512 + h * 128 + 64 + lane] = f2bf(t2 * c + t1 * sn);
              t1 = bf16_to_f32(Pt[2568 + h * 128 + lane]); t2 = bf16_to_f32(Pt[2568 + h * 128 + 64 + lane]);
              KB[(size_t)t * 512 + h * 128 + lane] = f2bf(t1 * c - t2 * sn); KB[(size_t)t * 512 + h * 128 + 64 + lane] = f2bf(t2 * c + t1 * sn);
          } }
#pragma unroll
        for (int r = 0; r < 2; ++r) {
            const int item = lane + 64 * r, hh = item >> 5, ii = item & 31;
            const float c = COSI[(size_t)t * 32 + ii], sn = SINI[(size_t)t * 32 + ii];
            const float t1 = bf16_to_f32(Pt[3592 + hh * 64 + ii]), t2 = bf16_to_f32(Pt[3592 + hh * 64 + 32 + ii]);
            QI[(size_t)t * 256 + hh * 64 + ii] = f2bf(t1 * c - t2 * sn); QI[(size_t)t * 256 + hh * 64 + 32 + ii] = f2bf(t2 * c + t1 * sn);
        }
        if (lane < 32) {
            const float c = COSI[(size_t)t * 32 + lane], sn = SINI[(size_t)t * 32 + lane];
            const float t1 = bf16_to_f32(Pt[3848 + lane]), t2 = bf16_to_f32(Pt[3848 + 32 + lane]);
            KI[(size_t)t * 64 + lane] = f2bf(t1 * c - t2 * sn); KI[(size_t)t * 64 + 32 + lane] = f2bf(t2 * c + t1 * sn);
        }
    }
    { bf16_t* VT = (bf16_t*)(ws_ + OFF_VT);
      bf16_t* sv = (bf16_t*)g_smem;
      for (int item = blockIdx.x; item < 2 * 128 * 4; item += gridDim.x) {
          const int h = item & 3, tt = item >> 2, b = tt >> 7, s0 = (tt & 127) * 64;
          __syncthreads();
          for (int e = tid; e < 64 * 128; e += NTHREADS) { const int i = e >> 7, d = e & 127; sv[d * 72 + i] = P[(size_t)(b * 8192 + s0 + i) * LDPB + 3080 + h * 128 + d]; }
          __syncthreads();
          for (int e = tid; e < 128 * 8; e += NTHREADS) { const int d = e >> 3, c = e & 7;
              *(uint4*)(VT + ((size_t)((b * 4 + h) * 128 + d)) * 8192 + s0 + c * 8) = *(const uint4*)(sv + d * 72 + c * 8); }
      } }
}

__device__ __forceinline__ f32x4 mma_lds(const unsigned char* A, int sa, int a0, const unsigned char* B, int sb, int b0, int K, f32x4 acc, int c16, int q4) {
    const unsigned char* ap = A + (a0 + c16) * sa + q4 * 16;
    const unsigned char* bp = B + (b0 + c16) * sb + q4 * 16;
    for (int kk = 0; kk < K; kk += 32) { acc = __builtin_amdgcn_mfma_f32_16x16x32_bf16(*(const bf16x8*)(ap + kk * 2), *(const bf16x8*)(bp + kk * 2), acc, 0, 0, 0); }
    return acc;
}

PHASE_FN void ph_gdn_chunk(const Params& p, int layer, float* smem) {
    unsigned char* ws_ = p.ws; asm volatile("" : "+s"(ws_));
    int tid_ = threadIdx.x; asm volatile("" : "+v"(tid_)); const int tid = tid_, lane = tid & 63, wv = __builtin_amdgcn_readfirstlane(tid >> 6), q4 = lane >> 4, c16 = lane & 15;
    int ldz_ = 0; asm volatile("" : "+s"(ldz_)); unsigned char* lds = g_smem + ldz_;
    constexpr int SN = 272, ST = 144;
    unsigned char* bKN = lds;
    unsigned char* bQN = lds + 18432;
    unsigned char* bKBG = lds + 35840;
    unsigned char* bVB = lds + 54272;
    unsigned char* bKD = lds + 72704;
    unsigned char* bUT = lds + 91136;
    float* sL = (float*)(lds + 109568);
    unsigned char* bAQK = lds + 126208;
    unsigned char* bTB = lds + 135424;
    float* sG = (float*)(lds + 144640); float* sB = sG + 64; float* sEg = sB + 64;
    const int li = layer >> 1;
    const bf16_t* P = (const bf16_t*)(ws_ + OFF_P); const float* AUX = (const float*)(ws_ + OFF_AUX);
    const float* cw = p.conv_w + (size_t)li * 4 * 1536;
    uint4* PFR = (uint4*)(ws_ + OFF_PFR); uint4* RFR = (uint4*)(ws_ + OFF_RFR); uint2* QFR = (uint2*)(ws_ + OFF_QFR); uint2* OFR = (uint2*)(ws_ + OFF_OFR);
    float* GL = (float*)(ws_ + OFF_GL);
    for (int ci = blockIdx.x; ci < 1024; ci += gridDim.x) {
        const int b = ci >> 9, h = (ci >> 7) & 3, n = ci & 127;
        const int t0 = b * 8192 + n * 64;
        __syncthreads();
        if (tid < 64) { float g = -expf(p.a_log[li * 4 + h]) * softplusf_(AUX[(size_t)(t0 + tid) * 16 + 4 + h] + p.dt_bias[li * 4 + h]);
#pragma unroll
            for (int o = 1; o < 64; o <<= 1) { const float nb = __shfl_up(g, o); if (lane >= o) g += nb; }
            sG[tid] = g; sB[tid] = sigmoidf_(AUX[(size_t)(t0 + tid) * 16 + h]); sEg[tid] = expf(g); }
        for (int e = tid; e < 64 * 36; e += NTHREADS) ((unsigned*)bAQK)[e] = 0u;
        __syncthreads();
        const float gl = sG[63];
        {
            const int d0 = 2 * lane, cb = h * 128 + d0, s00 = n * 64;
            float wq[4][2], wk[4][2], wvv[4][2];
#pragma unroll
            for (int jj = 0; jj < 4; ++jj) { wq[jj][0] = cw[jj * 1536 + cb]; wq[jj][1] = cw[jj * 1536 + cb + 1]; wk[jj][0] = cw[jj * 1536 + 512 + cb]; wk[jj][1] = cw[jj * 1536 + 512 + cb + 1];
                                            wvv[jj][0] = cw[jj * 1536 + 1024 + cb]; wvv[jj][1] = cw[jj * 1536 + 1024 + cb + 1]; }
#pragma unroll 2
            for (int r = 0; r < 8; ++r) {
                const int i = wv + 8 * r;
                float aq0 = 0.f, aq1 = 0.f, ak0 = 0.f, ak1 = 0.f, av0 = 0.f, av1 = 0.f;
#pragma unroll
                for (int jj = 0; jj < 4; ++jj) {
                    if (s00 + i - 3 + jj >= 0) {
                        const bf16_t* rp = P + (size_t)(t0 + i - 3 + jj) * LDPB + cb;
                        const unsigned uq = *(const unsigned*)rp, uk = *(const unsigned*)(rp + 512), uv = *(const unsigned*)(rp + 1024);
                        aq0 += wq[jj][0] * __uint_as_float(uq << 16); aq1 += wq[jj][1] * __uint_as_float(uq & 0xffff0000u);
                        ak0 += wk[jj][0] * __uint_as_float(uk << 16); ak1 += wk[jj][1] * __uint_as_float(uk & 0xffff0000u);
                        av0 += wvv[jj][0] * __uint_as_float(uv << 16); av1 += wvv[jj][1] * __uint_as_float(uv & 0xffff0000u);
                    }
                }
                aq0 = siluf_(aq0); aq1 = siluf_(aq1); ak0 = siluf_(ak0); ak1 = siluf_(ak1); av0 = siluf_(av0); av1 = siluf_(av1);
                const float rq = rsqrtf(wave_sum(aq0 * aq0 + aq1 * aq1) + EPS), rk = rsqrtf(wave_sum(ak0 * ak0 + ak1 * ak1) + EPS);
                aq0 *= rq; aq1 *= rq; ak0 *= rk; ak1 *= rk;
                const float be = sB[i], eg_i = sEg[i], ekd = expf(gl - sG[i]);
                *(unsigned*)(bKN + i * SN + d0 * 2) = cvt_pk_bf16(ak0, ak1);
                *(unsigned*)(bQN + i * SN + d0 * 2) = cvt_pk_bf16(aq0, aq1);
                *(bf16_t*)(bKBG + d0 * ST + i * 2) = f2bf(ak0 * be * eg_i); *(bf16_t*)(bKBG + (d0 + 1) * ST + i * 2) = f2bf(ak1 * be * eg_i);
                *(bf16_t*)(bVB + d0 * ST + i * 2) = f2bf(av0 * be); *(bf16_t*)(bVB + (d0 + 1) * ST + i * 2) = f2bf(av1 * be);
                *(bf16_t*)(bKD + d0 * ST + i * 2) = f2bf(ak0 * ekd); *(bf16_t*)(bKD + (d0 + 1) * ST + i * 2) = f2bf(ak1 * ekd);
            }
        }
        __syncthreads();
        for (int u = wv; u < 20; u += 8) {
            const int kind = (u >= 10) ? 1 : 0, idx = u - kind * 10;
            const int ti = (idx >= 6) ? 3 : (idx >= 3) ? 2 : (idx >= 1) ? 1 : 0, tj = idx - ((ti * (ti + 1)) >> 1);
            f32x4 acc = (f32x4){0.f, 0.f, 0.f, 0.f};
            acc = mma_lds(kind ? bQN : bKN, SN, 16 * ti, bKN, SN, 16 * tj, 128, acc, c16, q4);
            const int j = 16 * tj + c16;
#pragma unroll
            for (int r = 0; r < 4; ++r) { const int i = 16 * ti + 4 * q4 + r;
                const float dec = (j <= i) ? expf(sG[i] - sG[j]) : 0.f;
                if (kind == 0) sL[i * 65 + j] = (j < i) ? sB[i] * acc[r] * dec : 0.f;
                else *(bf16_t*)(bAQK + i * ST + j * 2) = f2bf(acc[r] * SCALE128 * dec); }
        }
        __syncthreads();
        if (wv == 0) {
            float t[64];
            int zz = 0; asm volatile("" : "+v"(zz)); const float* sLo = sL + zz;
#pragma unroll
            for (int i = 0; i < 64; ++i) { float a = (i == lane) ? 1.f : 0.f;
#pragma unroll
                for (int j = 0; j < i; ++j) a -= sLo[i * 65 + j] * t[j];
                t[i] = a; asm volatile("" ::: "memory"); }
#pragma unroll
            for (int i = 0; i < 64; ++i) *(bf16_t*)(bTB + i * ST + lane * 2) = f2bf(t[i]);
        }
        __syncthreads();
        for (int x = 0; x < 8; ++x) {
            const int u = wv * 8 + x, kind = u >> 5, ti = (u >> 3) & 3, td = u & 7;
            f32x4 acc = (f32x4){0.f, 0.f, 0.f, 0.f};
            acc = mma_lds(bTB, ST, 16 * ti, kind ? bVB : bKBG, ST, 16 * td, 64, acc, c16, q4);
            *(uint2*)((kind ? bUT : bKN) + (16 * td + c16) * ST + (16 * ti + 4 * q4) * 2) = pack4(acc);
        }
        __syncthreads();
        unsigned char* bWT = bKN;
        const float eg = expf(gl);
        for (int x = 0; x < 4; ++x) {
            const int u = wv * 4 + x, ti = u >> 2, a = u & 3;
            uint4 fr;
#pragma unroll
            for (int hf = 0; hf < 2; ++hf) { const int tk = 2 * a + hf;
                f32x4 acc = (f32x4){0.f, 0.f, 0.f, 0.f};
                acc = mma_lds(bWT, ST, 16 * tk, bKD, ST, 16 * ti, 64, acc, c16, q4);
                f32x4 v;
#pragma unroll
                for (int r = 0; r < 4; ++r) v[r] = ((16 * tk + 4 * q4 + r) == (16 * ti + c16) ? eg : 0.f) - acc[r];
                const uint2 pk = pack4(v);
                if (hf == 0) { fr.x = pk.x; fr.y = pk.y; } else { fr.z = pk.x; fr.w = pk.y; } }
            PFR[((size_t)(ci * 8 + ti) * 4 + a) * 64 + lane] = fr;
        }
        for (int x = 0; x < 2; ++x) {
            const int u = wv * 2 + x, ti = u >> 2, a = u & 3;
            uint4 fr;
            const int i = 16 * ti + c16;
            const float qs = SCALE128 * sEg[i];
#pragma unroll
            for (int hf = 0; hf < 2; ++hf) { const int tk = 2 * a + hf;
                f32x4 acc = (f32x4){0.f, 0.f, 0.f, 0.f};
                acc = mma_lds(bWT, ST, 16 * tk, bAQK, ST, 16 * ti, 64, acc, c16, q4);
                const f32x4 qv = unpack4(*(const uint2*)(bQN + i * SN + (16 * tk + 4 * q4) * 2));
                const uint2 pk = pack4(qv * qs - acc);
                if (hf == 0) { fr.x = pk.x; fr.y = pk.y; } else { fr.z = pk.x; fr.w = pk.y; } }
            RFR[((size_t)(ci * 4 + ti) * 4 + a) * 64 + lane] = fr;
        }
        for (int x = 0; x < 8; ++x) {
            const int u = wv * 8 + x, tdv = u >> 3, tdk = u & 7;
            f32x4 acc = (f32x4){0.f, 0.f, 0.f, 0.f};
            acc = mma_lds(bKD, ST, 16 * tdk, bUT, ST, 16 * tdv, 64, acc, c16, q4);
            QFR[((size_t)(ci * 8 + tdv) * 8 + tdk) * 64 + lane] = pack4(acc);
        }
        for (int x = 0; x < 4; ++x) {
            const int u = wv * 4 + x, tdv = u >> 2, ti = u & 3;
            f32x4 acc = (f32x4){0.f, 0.f, 0.f, 0.f};
            acc = mma_lds(bAQK, ST, 16 * ti, bUT, ST, 16 * tdv, 64, acc, c16, q4);
            OFR[((size_t)(ci * 8 + tdv) * 4 + ti) * 64 + lane] = pack4(acc);
        }
        if (tid == 0) GL[ci] = gl;
    }
}

__device__ __forceinline__ void gs_load(uint4 (&d)[12], const unsigned char* pp, const unsigned char* rr, const unsigned char* qq, const unsigned char* oo, const int lt) {
#pragma unroll
    for (int i = 0; i < 6; ++i) { int c = lt + 384 * i; c = c < 2048 ? c : 2047; d[i] = *(const uint4*)(pp + c * 16); }
#pragma unroll
    for (int i = 0; i < 3; ++i) { int c = lt + 384 * i; c = c < 1024 ? c : 1023; d[6 + i] = *(const uint4*)(rr + c * 16); }
#pragma unroll
    for (int i = 0; i < 2; ++i) { int c = lt + 384 * i; c = c < 512 ? c : 511; d[9 + i] = *(const uint4*)(qq + c * 16); }
    { const int c = lt < 256 ? lt : 255; d[11] = *(const uint4*)(oo + c * 16); }
}
__device__ __forceinline__ void gs_store(const uint4 (&d)[12], unsigned char* sb, const int lt) {
#pragma unroll
    for (int i = 0; i < 6; ++i) { const int c = lt + 384 * i; if (c < 2048) *(uint4*)(sb + c * 16) = d[i]; }
#pragma unroll
    for (int i = 0; i < 3; ++i) { const int c = lt + 384 * i; if (c < 1024) *(uint4*)(sb + 32768 + c * 16) = d[6 + i]; }
#pragma unroll
    for (int i = 0; i < 2; ++i) { const int c = lt + 384 * i; if (c < 512) *(uint4*)(sb + 49152 + c * 16) = d[9 + i]; }
    if (lt < 256) *(uint4*)(sb + 57344 + lt * 16) = d[11];
}

#define SCAN_BODY                 bf16x8 Sb[4]; \
_Pragma("unroll") \
                for (int a = 0; a < 4; ++a) { union { uint4 u; bf16x8 v; } cv; const uint2 lo = pack4(S[2 * a]), hi = pack4(S[2 * a + 1]); cv.u.x = lo.x; cv.u.y = lo.y; cv.u.z = hi.x; cv.u.w = hi.y; Sb[a] = cv.v; } \
                const int t0 = b * 8192 + n * 64; \
                {   f32x4 oa[4]; \
_Pragma("unroll") \
                    for (int ti = 0; ti < 4; ++ti) oa[ti] = unpack4(*(const uint2*)(Of + ti * 512)); \
_Pragma("unroll") \
                    for (int a = 0; a < 4; ++a) \
_Pragma("unroll") \
                        for (int ti = 0; ti < 4; ++ti) oa[ti] = __builtin_amdgcn_mfma_f32_16x16x32_bf16(*(const bf16x8*)(Rf + (ti * 4 + a) * 1024), Sb[a], oa[ti], 0, 0, 0); \
_Pragma("unroll") \
                    for (int ti = 0; ti < 4; ++ti) { \
                        float* op = O + (size_t)(t0 + 16 * ti + 4 * q4) * 1024 + h * 128 + 16 * tdv + c16; \
                        op[0] = oa[ti][0]; op[1024] = oa[ti][1]; op[2048] = oa[ti][2]; op[3072] = oa[ti][3]; } \
                } \
                asm volatile("" ::: "memory"); \
_Pragma("unroll") \
                for (int g = 0; g < 2; ++g) { \
                    f32x4 sa[4]; \
_Pragma("unroll") \
                    for (int t = 0; t < 4; ++t) sa[t] = unpack4(*(const uint2*)(Qf + (g * 4 + t) * 512)); \
_Pragma("unroll") \
                    for (int a = 0; a < 4; ++a) \
_Pragma("unroll") \
                        for (int t = 0; t < 4; ++t) sa[t] = __builtin_amdgcn_mfma_f32_16x16x32_bf16(*(const bf16x8*)(Pf + ((g * 4 + t) * 4 + a) * 1024), Sb[a], sa[t], 0, 0, 0); \
_Pragma("unroll") \
                    for (int t = 0; t < 4; ++t) S[g * 4 + t] = sa[t]; \
                    asm volatile("" ::: "memory"); \
                }
PHASE_FN void ph_gdn_scan(const Params& p, float* smem) {
    unsigned char* ws_ = p.ws; asm volatile("" : "+s"(ws_));
    int tid_ = threadIdx.x; asm volatile("" : "+v"(tid_)); const int tid = tid_, lane = tid & 63, wv = __builtin_amdgcn_readfirstlane(tid >> 6), q4 = lane >> 4, c16 = lane & 15;
    int ldz_ = 0; asm volatile("" : "+s"(ldz_)); unsigned char* lds = g_smem + ldz_;
    constexpr int STG = 61440;
    const unsigned char* PFR = ws_ + OFF_PFR; const unsigned char* RFR = ws_ + OFF_RFR; const unsigned char* QFR = ws_ + OFF_QFR; const unsigned char* OFR = ws_ + OFF_OFR;
    float* O = (float*)(ws_ + OFF_O);
    for (int it = blockIdx.x; it < 32; it += gridDim.x) {
        const int bh = it >> 2, pair = it & 3, b = bh >> 2, h = bh & 3;
        __syncthreads();
        if (wv >= 2) {
            const int lt = tid - 128;
            const unsigned char* Pb = PFR + (size_t)bh * 128 * 32768;
            const unsigned char* Rb = RFR + (size_t)bh * 128 * 16384;
            const unsigned char* Qb = QFR + (size_t)bh * 128 * 32768 + pair * 8192;
            const unsigned char* Ob = OFR + (size_t)bh * 128 * 16384 + pair * 4096;
            uint4 ra0, ra1, ra2, ra3, ra4, ra5, ra6, ra7, ra8, ra9, ra10, ra11, rb0, rb1, rb2, rb3, rb4, rb5, rb6, rb7, rb8, rb9, rb10, rb11;
#define LDC(base_, c_, mx_) (*(const uint4*)((base_) + (size_t)(((c_) < (mx_)) ? (c_) : (mx_)) * 16))
#define GS_LOAD(X, n_) do { const unsigned char* pp_ = Pb + (size_t)(n_) * 32768; const unsigned char* rr_ = Rb + (size_t)(n_) * 16384; \
                const unsigned char* qq_ = Qb + (size_t)(n_) * 32768; const unsigned char* oo_ = Ob + (size_t)(n_) * 16384; \
                X##0 = LDC(pp_, lt, 2047); X##1 = LDC(pp_, lt + 384, 2047); X##2 = LDC(pp_, lt + 768, 2047); X##3 = LDC(pp_, lt + 1152, 2047); X##4 = LDC(pp_, lt + 1536, 2047); X##5 = LDC(pp_, lt + 1920, 2047); \
                X##6 = LDC(rr_, lt, 1023); X##7 = LDC(rr_, lt + 384, 1023); X##8 = LDC(rr_, lt + 768, 1023); \
                X##9 = LDC(qq_, lt, 511); X##10 = LDC(qq_, lt + 384, 511); X##11 = LDC(oo_, lt, 255); } while (0)
#define STC(off_, c_, lim_, v_) do { if ((c_) < (lim_)) *(uint4*)(sb_ + (off_) + (c_) * 16) = v_; } while (0)
#define GS_STORE(X, st_) do { unsigned char* sb_ = lds + (st_) * STG; \
                STC(0, lt, 2048, X##0); STC(0, lt + 384, 2048, X##1); STC(0, lt + 768, 2048, X##2); STC(0, lt + 1152, 2048, X##3); STC(0, lt + 1536, 2048, X##4); STC(0, lt + 1920, 2048, X##5); \
                STC(32768, lt, 1024, X##6); STC(32768, lt + 384, 1024, X##7); STC(32768, lt + 768, 1024, X##8); \
                STC(49152, lt, 512, X##9); STC(49152, lt + 384, 512, X##10); STC(57344, lt, 256, X##11); } while (0)
            GS_LOAD(ra, 0); GS_STORE(ra, 0);
            GS_LOAD(rb, 1); GS_LOAD(ra, 2);
            __syncthreads();
            for (int n = 0; n < 128; n += 2) {
                GS_STORE(rb, 1);
                GS_LOAD(rb, (n + 3 < 128) ? n + 3 : 127);
                __syncthreads();
                if (n + 2 < 128) GS_STORE(ra, 0);
                GS_LOAD(ra, (n + 4 < 128) ? n + 4 : 127);
                __syncthreads();
            }
        } else {
            const int tdv = pair * 2 + wv;
            f32x4 S[8];
#pragma unroll
            for (int t = 0; t < 8; ++t) S[t] = (f32x4){0.f, 0.f, 0.f, 0.f};
            __syncthreads();
            for (int n = 0; n < 128; ++n) {
                const unsigned char* base = lds + (n & 1) * STG;
                const unsigned char* Pf = base + lane * 16, *Rf = base + 32768 + lane * 16;
                const unsigned char* Qf = base + 49152 + wv * 4096 + lane * 8, *Of = base + 57344 + wv * 2048 + lane * 8;
                SCAN_BODY
                __syncthreads();
            }
        }
    }
}

__device__ __forceinline__ void block_sum4(int (&v)[4], int* buf) {
    const int lane = threadIdx.x & 63, wv = threadIdx.x >> 6;
#pragma unroll
    for (int q = 0; q < 4; ++q) v[q] = wave_sum_i(v[q]);
    if (lane == 0) {
#pragma unroll
        for (int q = 0; q < 4; ++q) buf[wv * 4 + q] = v[q];
    }
    __syncthreads();
#pragma unroll
    for (int q = 0; q < 4; ++q) { int a = 0; for (int w = 0; w < 8; ++w) a += buf[w * 4 + q]; v[q] = a; }
}

PHASE_FN void ph_dsa_topk(const Params& p, float* smem) {
    unsigned char* ws_ = p.ws; asm volatile("" : "+s"(ws_));
    int tid_ = threadIdx.x; asm volatile("" : "+v"(tid_)); const int tid = tid_, lane = tid & 63, wv = __builtin_amdgcn_readfirstlane(tid >> 6), q4 = lane >> 4, c16 = lane & 15;
    int* sRed = (int*)g_smem;
    const bf16_t* QIb = (const bf16_t*)(ws_ + OFF_QIB); const bf16_t* KIb = (const bf16_t*)(ws_ + OFF_KIB); const float* WI = (const float*)(ws_ + OFF_WI);
    unsigned short* M16 = (unsigned short*)(ws_ + OFF_M16);
    for (int it = blockIdx.x; it < 2048; it += gridDim.x) {
        const int k = it >> 8, j = (it & 255) >> 1, b = it & 1;
        const int gp = (k & 1) ? 1023 - ((k >> 1) * 128 + j) : (k >> 1) * 128 + j;
        const int s0 = gp * 8, t0 = b * 8192 + s0;
        const int ntiles = (s0 >> 4) + 1;
        const int nreg = (ntiles > wv) ? ((ntiles - wv + 7) >> 3) : 0;
        const bf16_t* qp = QIb + (size_t)(t0 + (c16 >> 2)) * 256 + (c16 & 3) * 64 + 8 * q4;
        const bf16x8 a0A = *(const bf16x8*)qp, a1A = *(const bf16x8*)(qp + 32), a0B = *(const bf16x8*)(qp + 4 * 256), a1B = *(const bf16x8*)(qp + 4 * 256 + 32);
        const float4 wqA = *(const float4*)(WI + (size_t)(t0 + q4) * 4), wqB = *(const float4*)(WI + (size_t)(t0 + 4 + q4) * 4);
        const int myqA = s0 + q4, myqB = s0 + 4 + q4;
        int c16s = c16; asm volatile("" : "+v"(c16s));
        int wvs = wv; asm volatile("" : "+s"(wvs));
        unsigned kA[64], kB[64];
#pragma unroll
        for (int i = 0; i < 64; ++i) { kA[i] = 0u; kB[i] = 0u; }
#pragma unroll
        for (int blk = 0; blk < 4; ++blk) if (nreg > blk * 16) {
#pragma unroll
            for (int ii = 0; ii < 16; ++ii) { const int i = blk * 16 + ii, tile = wvs + 8 * i;
                if (tile < ntiles) {
                    const bf16_t* kp = KIb + (size_t)(b * 8192 + tile * 16 + c16s) * 64 + 8 * q4;
                    const bf16x8 k0 = *(const bf16x8*)kp, k1 = *(const bf16x8*)(kp + 32);
                    f32x4 accA = (f32x4){0.f, 0.f, 0.f, 0.f}, accB = accA;
                    accA = __builtin_amdgcn_mfma_f32_16x16x32_bf16(a0A, k0, accA, 0, 0, 0);
                    accB = __builtin_amdgcn_mfma_f32_16x16x32_bf16(a0B, k0, accB, 0, 0, 0);
                    accA = __builtin_amdgcn_mfma_f32_16x16x32_bf16(a1A, k1, accA, 0, 0, 0);
                    accB = __builtin_amdgcn_mfma_f32_16x16x32_bf16(a1B, k1, accB, 0, 0, 0);
                    float sa = 0.f, sb = 0.f;
                    sa += wqA.x * fmaxf(accA[0], 0.f); sa += wqA.y * fmaxf(accA[1], 0.f); sa += wqA.z * fmaxf(accA[2], 0.f); sa += wqA.w * fmaxf(accA[3], 0.f);
                    sb += wqB.x * fmaxf(accB[0], 0.f); sb += wqB.y * fmaxf(accB[1], 0.f); sb += wqB.z * fmaxf(accB[2], 0.f); sb += wqB.w * fmaxf(accB[3], 0.f);
                    const int kidx = tile * 16 + c16s;
                    kA[i] = (kidx <= myqA) ? ordkey(sa) : 0u;
                    kB[i] = (kidx <= myqB) ? ordkey(sb) : 0u;
                }
                if ((ii & 3) == 3) asm volatile("" ::: "memory"); }
        }
        const int keffA = (myqA + 1 < 256) ? (myqA + 1) : 256, keffB = (myqB + 1 < 256) ? (myqB + 1) : 256;
        int par = 0;
        auto qsum = [&](int c) -> int {
            c += __shfl_xor(c, 1); c += __shfl_xor(c, 2); c += __shfl_xor(c, 4); c += __shfl_xor(c, 8);
            par ^= 1;
            if (c16 == 0) sRed[par * 32 + wv * 4 + q4] = c;
            __syncthreads();
            int a = 0;
#pragma unroll
            for (int w = 0; w < 8; ++w) a += sRed[par * 32 + w * 4 + q4];
            return a;
        };
        unsigned UA = 0u, UB = 0u;
        for (int rep_ = 0; rep_ < TOPK_SEARCH_REP; ++rep_) { UA = 0u; UB = 0u;
        for (int bit = 31; bit >= 0; --bit) {
            const unsigned candA = UA | (1u << bit), candB = UB | (1u << bit);
            int c = 0;
#pragma unroll
            for (int blk = 0; blk < 4; ++blk) if (nreg > blk * 16) {
#pragma unroll
                for (int ii = 0; ii < 16; ++ii) { c += (kA[blk * 16 + ii] >= candA) ? 1 : 0; c += (kB[blk * 16 + ii] >= candB) ? 65536 : 0; }
            }
            const int tot = qsum(c);
            if ((tot & 0xffff) >= keffA) UA = candA;
            if ((tot >> 16) >= keffB) UB = candB;
        } }
        int cg = 0, ce = 0;
#pragma unroll
        for (int i = 0; i < 64; ++i) { cg += (kA[i] > UA) ? 1 : 0; ce += (kA[i] == UA) ? 1 : 0; cg += (kB[i] > UB) ? 65536 : 0; ce += (kB[i] == UB) ? 65536 : 0; }
        cg = qsum(cg); ce = qsum(ce);
        const int needA = keffA - (cg & 0xffff), needB = keffB - (cg >> 16);
        int JA = 8191, JB = 8191;
        par ^= 1;
        if (c16 == 0) sRed[par * 32 + wv * 4 + q4] = (((ce & 0xffff) > needA) || ((ce >> 16) > needB)) ? 1 : 0;
        __syncthreads();
        int anyov = 0;
#pragma unroll
        for (int w = 0; w < 32; ++w) anyov |= sRed[par * 32 + w];
        if (anyov) {
            JA = 0; JB = 0;
            int c16j = c16; asm volatile("" : "+v"(c16j));
            int wvj = wv; asm volatile("" : "+s"(wvj));
            for (int bit = 12; bit >= 0; --bit) {
                const int cjA = JA | (1 << bit), cjB = JB | (1 << bit);
                int c = 0;
#pragma unroll
                for (int i = 0; i < 64; ++i) { const int kidx = (wvj + 8 * i) * 16 + c16j; c += (kA[i] == UA && kidx < cjA) ? 1 : 0; c += (kB[i] == UB && kidx < cjB) ? 65536 : 0; }
                const int tot = qsum(c);
                if ((tot & 0xffff) <= needA - 1) JA = cjA;
                if ((tot >> 16) <= needB - 1) JB = cjB;
            }
        }
        unsigned short* sM = (unsigned short*)(g_smem + 1024);
        ((uint4*)sM)[tid] = make_uint4(0u, 0u, 0u, 0u);
        __syncthreads();
        int c16e = c16; asm volatile("" : "+v"(c16e));
        int wve = wv; asm volatile("" : "+s"(wve));
#pragma unroll
        for (int blk = 0; blk < 4; ++blk) if (nreg > blk * 16) {
#pragma unroll
            for (int ii = 0; ii < 16; ++ii) { const int i = blk * 16 + ii;
                const int tile = wve + 8 * i, kidx = tile * 16 + c16e;
                const bool selA = kA[i] > UA || (kA[i] == UA && kidx <= JA);
                const bool selB = kB[i] > UB || (kB[i] == UB && kidx <= JB);
                const unsigned long long balA = __ballot(selA), balB = __ballot(selB);
                if (c16 == 0) { sM[q4 * 512 + tile] = (unsigned short)((balA >> (16 * q4)) & 0xffffull);
                                sM[(4 + q4) * 512 + tile] = (unsigned short)((balB >> (16 * q4)) & 0xffffull); }
            }
        }
        __syncthreads();
        *(uint4*)(M16 + (size_t)(t0 + (tid >> 6)) * 512 + (tid & 63) * 8) = ((const uint4*)sM)[tid];
    }
}

PHASE_FN void ph_dsa_attn(const Params& p, float* smem) {
    unsigned char* ws_ = p.ws; asm volatile("" : "+s"(ws_));
    int tid_ = threadIdx.x; asm volatile("" : "+v"(tid_)); const int tid = tid_, lane = tid & 63, wv = tid >> 6, q4 = lane >> 4, c16 = lane & 15;
    int ldz_ = 0; asm volatile("" : "+s"(ldz_)); unsigned char* lds = g_smem + ldz_;
    const bf16_t* QBb = (const bf16_t*)(ws_ + OFF_QBB); const bf16_t* KBb = (const bf16_t*)(ws_ + OFF_KBB); const bf16_t* VT = (const bf16_t*)(ws_ + OFF_VT);
    const unsigned short* M16 = (const unsigned short*)(ws_ + OFF_M16);
    bf16_t* OB = (bf16_t*)(ws_ + OFF_OB);
    const float SC = SCALE128 * 1.4426950408889634f;
    for (int it = blockIdx.x; it < 256; it += gridDim.x) {
        const int bh = it & 7, jp = it >> 3, b = bh >> 2, h = bh & 3;
        for (int half = 0; half < 2; ++half) {
            const int jq = half ? jp : 63 - jp;
            const int qs = jq * 128, nkt = 2 * jq + 2;
            const int tq = b * 8192 + qs + wv * 16 + c16;
            bf16x8 qf[4];
#pragma unroll
            for (int a = 0; a < 4; ++a) qf[a] = *(const bf16x8*)(QBb + (size_t)tq * 512 + h * 128 + 8 * q4 + 32 * a);
            float m = -1e30f, lsum = 0.f;
            f32x4 oacc[8];
#pragma unroll
            for (int t = 0; t < 8; ++t) oacc[t] = (f32x4){0.f, 0.f, 0.f, 0.f};
            uint4 rk0, rk1, rv0, rv1;
            const int q0 = tid, q1 = tid + 512;
            const bf16_t* kg0 = KBb + (size_t)(b * 8192 + (q0 >> 4)) * 512 + h * 128 + (q0 & 15) * 8;
            const bf16_t* kg1 = KBb + (size_t)(b * 8192 + (q1 >> 4)) * 512 + h * 128 + (q1 & 15) * 8;
            const bf16_t* vg0 = VT + ((size_t)((b * 4 + h) * 128 + (q0 >> 3))) * 8192 + (q0 & 7) * 8;
            const bf16_t* vg1 = VT + ((size_t)((b * 4 + h) * 128 + (q1 >> 3))) * 8192 + (q1 & 7) * 8;
            const int lk0 = (q0 >> 4) * 256 + ((((q0 & 15)) ^ ((q0 >> 4) & 15)) << 4), lk1 = (q1 >> 4) * 256 + ((((q1 & 15)) ^ ((q1 >> 4) & 15)) << 4);
            const int lv0 = 16384 + (q0 >> 3) * 128 + ((((q0 & 7)) ^ ((q0 >> 3) & 7)) << 4), lv1 = 16384 + (q1 >> 3) * 128 + ((((q1 & 7)) ^ ((q1 >> 3) & 7)) << 4);
#define ATT_GLOAD(kt_) do { rk0 = *(const uint4*)(kg0 + (size_t)(kt_) * 64 * 512); rk1 = *(const uint4*)(kg1 + (size_t)(kt_) * 64 * 512); \
                            rv0 = *(const uint4*)(vg0 + (kt_) * 64); rv1 = *(const uint4*)(vg1 + (kt_) * 64); } while (0)
#define ATT_LSTORE(st_) do { unsigned char* base_ = lds + (st_) * 32768; *(uint4*)(base_ + lk0) = rk0; *(uint4*)(base_ + lk1) = rk1; *(uint4*)(base_ + lv0) = rv0; *(uint4*)(base_ + lv1) = rv1; } while (0)
            __syncthreads();
            ATT_GLOAD(0); ATT_LSTORE(0);
            __syncthreads();
            for (int kt = 0; kt < nkt; ++kt) {
                if (kt + 1 < nkt) ATT_GLOAD(kt + 1);
                const unsigned long long mbits = *(const unsigned long long*)(M16 + (size_t)tq * 512 + 4 * kt);
                const unsigned char* Kt = lds + (kt & 1) * 32768;
                const unsigned char* Vt = Kt + 16384;
                f32x4 sacc[4];
#pragma unroll
                for (int ti = 0; ti < 4; ++ti) { sacc[ti] = (f32x4){0.f, 0.f, 0.f, 0.f};
                    const int row = 16 * ti + c16;
#pragma unroll
                    for (int a = 0; a < 4; ++a) { const bf16x8 kf = *(const bf16x8*)(Kt + row * 256 + ((((q4 + 4 * a)) ^ (row & 15)) << 4));
                        sacc[ti] = __builtin_amdgcn_mfma_f32_16x16x32_bf16(kf, qf[a], sacc[ti], 0, 0, 0); } }
                float mx = m;
#pragma unroll
                for (int ti = 0; ti < 4; ++ti)
#pragma unroll
                    for (int r = 0; r < 4; ++r) { const bool valid = (mbits >> (16 * ti + 4 * q4 + r)) & 1ull; const float v = sacc[ti][r] * SC; sacc[ti][r] = v; mx = fmaxf(mx, valid ? v : -1e30f); }
                mx = fmaxf(mx, __shfl_xor(mx, 16)); mx = fmaxf(mx, __shfl_xor(mx, 32));
                const float alpha = __builtin_amdgcn_exp2f(m - mx); m = mx;
                float ps = 0.f;
#pragma unroll
                for (int ti = 0; ti < 4; ++ti)
#pragma unroll
                    for (int r = 0; r < 4; ++r) { const bool valid = (mbits >> (16 * ti + 4 * q4 + r)) & 1ull; const float pv = valid ? __builtin_amdgcn_exp2f(sacc[ti][r] - mx) : 0.f; sacc[ti][r] = pv; ps += pv; }
                lsum = lsum * alpha + ps;
#pragma unroll
                for (int t = 0; t < 8; ++t) oacc[t] = oacc[t] * alpha;
                bf16x8 pb[2];
#pragma unroll
                for (int a = 0; a < 2; ++a) {
                    union { uint4 u; bf16x8 v; } cv;
                    cv.u.x = cvt_pk_bf16(sacc[2 * a][0], sacc[2 * a][1]); cv.u.y = cvt_pk_bf16(sacc[2 * a][2], sacc[2 * a][3]);
                    cv.u.z = cvt_pk_bf16(sacc[2 * a + 1][0], sacc[2 * a + 1][1]); cv.u.w = cvt_pk_bf16(sacc[2 * a + 1][2], sacc[2 * a + 1][3]);
                    pb[a] = cv.v; }
#pragma unroll
                for (int t = 0; t < 8; ++t) { const int row = 16 * t + c16;
#pragma unroll
                    for (int a = 0; a < 2; ++a) {
                        union { uint2 h2[2]; bf16x8 v; } vf;
                        vf.h2[0] = *(const uint2*)(Vt + row * 128 + ((((4 * a + (q4 >> 1))) ^ (row & 7)) << 4) + 8 * (q4 & 1));
                        vf.h2[1] = *(const uint2*)(Vt + row * 128 + ((((4 * a + 2 + (q4 >> 1))) ^ (row & 7)) << 4) + 8 * (q4 & 1));
                        oacc[t] = __builtin_amdgcn_mfma_f32_16x16x32_bf16(vf.v, pb[a], oacc[t], 0, 0, 0); } }
                if (kt + 1 < nkt) ATT_LSTORE((kt + 1) & 1);
                __syncthreads();
            }
            lsum += __shfl_xor(lsum, 16); lsum += __shfl_xor(lsum, 32);
            const float inv = 1.f / lsum;
#pragma unroll
            for (int t = 0; t < 8; ++t) *(uint2*)(OB + (size_t)tq * 1024 + 512 + h * 128 + 16 * t + 4 * q4) = pack4(oacc[t] * inv);
        }
    }
}

PHASE_FN void ph_gdn_out(const Params& p, int layer) {
    unsigned char* ws_ = p.ws; asm volatile("" : "+s"(ws_));
    int tid_ = threadIdx.x; asm volatile("" : "+v"(tid_)); const int tid = tid_, lane = tid & 63, wv = tid >> 6;
    const float* O = (const float*)(ws_ + OFF_O); const bf16_t* P = (const bf16_t*)(ws_ + OFF_P); bf16_t* OB = (bf16_t*)(ws_ + OFF_OB);
    const float* onw = p.gdn_out_norm + (layer >> 1) * 128;
    for (int t = blockIdx.x * 8 + wv; t < NT; t += gridDim.x * 8) {
#pragma unroll
        for (int h = 0; h < 4; ++h) {
            const float* op = O + (size_t)t * 1024 + h * 128; bf16_t* ob = OB + (size_t)t * 1024 + h * 128;
            const float o0 = op[lane], o1 = op[64 + lane];
            const float ss = wave_sum(o0 * o0 + o1 * o1);
            const float r = rsqrtf(ss * (1.f / 128.f) + EPS);
            const float z0 = PBF(P, t, 1536 + h * 128 + lane), z1 = PBF(P, t, 1536 + h * 128 + 64 + lane);
            ob[lane] = f2bf(o0 * r * onw[lane] * siluf_(z0)); ob[64 + lane] = f2bf(o1 * r * onw[64 + lane] * siluf_(z1));
        }
    }
}

PHASE_FN void ph_gemm_out(const Params& p, int layer, float* smem) {
    unsigned char* ws_ = p.ws; asm volatile("" : "+s"(ws_));
    { int ldz_ = 0; asm volatile("" : "+s"(ldz_)); smem = (float*)(g_smem + ldz_); }
    const bf16_t* Wt = (const bf16_t*)(ws_ + OFF_WOUT) + (size_t)layer * 1024 * 1024;
    const float* MOD = (const float*)(ws_ + OFF_MOD);
    const bf16_t* O = (const bf16_t*)(ws_ + OFF_OB);
    for (int tile = blockIdx.x; tile < 64 * 8; tile += gridDim.x) {
        const int mt = tile % 64, nt = tile / 64;
        const bf16_t* Ab = O + (size_t)mt * 256 * 1024;
        const bf16_t* Bb = Wt + (size_t)nt * 128 * 1024;
        const int b = (mt * 256) >> 13;
        const float* gt = MOD + (size_t)(layer * 2 + b) * 6144 + 2048 + nt * 128;
        float* Xt = p.X + (size_t)mt * 256 * ND + nt * 128;
        gemm_tile_bf16(1024, (unsigned char*)smem,
            [=](int i, int r, int k) -> uint4 { return *(const uint4*)(Ab + (size_t)r * 1024 + k); },
            [=](int i, int r, int k) -> uint4 { return *(const uint4*)(Bb + (size_t)r * 1024 + k); },
            [=](const f32x4 (&acc)[4][4], int wm, int wn, int lane) {
#pragma unroll
                for (int mi = 0; mi < 4; ++mi)
#pragma unroll
                    for (int ni = 0; ni < 4; ++ni) {
                        const int m = wm * 64 + mi * 16 + (lane & 15), n = wn * 64 + ni * 16 + 4 * (lane >> 4);
                        const f32x4 g = *(const f32x4*)(gt + n);
                        f32x4* xp = (f32x4*)(Xt + (size_t)m * ND + n);
                        *xp = *xp + g * acc[mi][ni];
                    }
            });
    }
}

PHASE_FN void ph_norm_ffn(const Params& p, int layer) {
    unsigned char* ws_ = p.ws; asm volatile("" : "+s"(ws_));
    int tid_ = threadIdx.x; asm volatile("" : "+v"(tid_)); const int tid = tid_, lane = tid & 63, wv = tid >> 6;
    const float* MOD = (const float*)(ws_ + OFF_MOD);
    bf16_t* H = (bf16_t*)(ws_ + OFF_H);
    int* CNT = (int*)(ws_ + OFF_CNT) + layer * 32 * CSTR;
    int* sCnt = (int*)g_smem; int* sBase = sCnt + 32; int* sE = sBase + 32; int* sR = sE + 256;
    const int nrb = (NT + (int)gridDim.x - 1) / (int)gridDim.x, row_lo = blockIdx.x * nrb, row_hi = (row_lo + nrb < NT) ? row_lo + nrb : NT;
    __syncthreads();
    if (tid < 32) sCnt[tid] = 0;
    __syncthreads();
    int* ASG = (int*)(ws_ + OFF_ASG); float* GATE = (float*)(ws_ + OFF_GATE); int* LIST = (int*)(ws_ + OFF_LIST);
    const float* nw = p.norm_ffn + layer * 1024;
    const float* wg = p.rg_w + (size_t)layer * 1024 * 4;
    for (int row = row_lo + wv; row < row_hi; row += 8) {
        const int b = row >> 13;
        const float* xr = p.X + (size_t)row * ND;
        const float* sh = MOD + (size_t)(layer * 2 + b) * 6144 + 3072;
        const float* sc = sh + 1024;
        float hv[16]; float ss = 0.f;
#pragma unroll
        for (int j = 0; j < 4; ++j) { const float4 v = *(const float4*)(xr + j * 256 + lane * 4); hv[4 * j] = v.x; hv[4 * j + 1] = v.y; hv[4 * j + 2] = v.z; hv[4 * j + 3] = v.w; }
#pragma unroll
        for (int j = 0; j < 16; ++j) ss += hv[j] * hv[j];
        ss = wave_sum(ss);
        const float rstd = rsqrtf(ss * (1.f / 1024.f) + EPS);
#pragma unroll
        for (int j = 0; j < 4; ++j) {
            const int col = j * 256 + lane * 4;
            const float4 w = *(const float4*)(nw + col), s4 = *(const float4*)(sc + col), h4 = *(const float4*)(sh + col);
            hv[4 * j] = hv[4 * j] * rstd * w.x * (1.f + s4.x) + h4.x; hv[4 * j + 1] = hv[4 * j + 1] * rstd * w.y * (1.f + s4.y) + h4.y;
            hv[4 * j + 2] = hv[4 * j + 2] * rstd * w.z * (1.f + s4.z) + h4.z; hv[4 * j + 3] = hv[4 * j + 3] * rstd * w.w * (1.f + s4.w) + h4.w;
            { f32x4 ov; ov[0] = hv[4 * j]; ov[1] = hv[4 * j + 1]; ov[2] = hv[4 * j + 2]; ov[3] = hv[4 * j + 3]; *(uint2*)(H + (size_t)row * ND + col) = pack4(ov); }
        }
        float gl[4] = {0.f, 0.f, 0.f, 0.f};
#pragma unroll
        for (int j = 0; j < 4; ++j)
#pragma unroll
            for (int e = 0; e < 4; ++e) { const int col = j * 256 + lane * 4 + e; const float4 w = *(const float4*)(wg + (size_t)col * 4); const float hh = hv[4 * j + e];
                gl[0] += hh * w.x; gl[1] += hh * w.y; gl[2] += hh * w.z; gl[3] += hh * w.w; }
#pragma unroll
        for (int g = 0; g < 4; ++g) gl[g] = wave_sum(gl[g]) + p.rg_b[layer * 4 + g];
        int gs = 0; float gm = gl[0];
#pragma unroll
        for (int g = 1; g < 4; ++g) if (gl[g] > gm) { gm = gl[g]; gs = g; }
        float gsum = 0.f;
#pragma unroll
        for (int g = 0; g < 4; ++g) gsum += expf(gl[g] - gm);
        const float ggate = 1.f / gsum;
        const float* we = p.re_w + ((size_t)(layer * 4 + gs) * 1024) * 8;
        float el[8] = {0.f, 0.f, 0.f, 0.f, 0.f, 0.f, 0.f, 0.f};
#pragma unroll
        for (int j = 0; j < 4; ++j)
#pragma unroll
            for (int e = 0; e < 4; ++e) { const int col = j * 256 + lane * 4 + e; const float4 w0 = *(const float4*)(we + (size_t)col * 8), w1 = *(const float4*)(we + (size_t)col * 8 + 4); const float hh = hv[4 * j + e];
                el[0] += hh * w0.x; el[1] += hh * w0.y; el[2] += hh * w0.z; el[3] += hh * w0.w; el[4] += hh * w1.x; el[5] += hh * w1.y; el[6] += hh * w1.z; el[7] += hh * w1.w; }
#pragma unroll
        for (int e = 0; e < 8; ++e) el[e] = wave_sum(el[e]) + p.re_b[(layer * 4 + gs) * 8 + e];
        int i1 = 0; float l1 = el[0];
#pragma unroll
        for (int e = 1; e < 8; ++e) if (el[e] > l1) { l1 = el[e]; i1 = e; }
        int i2 = -1; float l2 = -INFINITY;
#pragma unroll
        for (int e = 0; e < 8; ++e) if (e != i1 && el[e] > l2) { l2 = el[e]; i2 = e; }
        const float ex = expf(l2 - l1);
        const float p1 = 1.f / (1.f + ex), p2 = ex / (1.f + ex);
        if (lane == 0) {
            const int e1 = gs * 8 + i1, e2 = gs * 8 + i2, lr = row - row_lo;
            sE[lr * 2] = e1; sE[lr * 2 + 1] = e2;
            sR[lr * 2] = atomicAdd(&sCnt[e1], 1); sR[lr * 2 + 1] = atomicAdd(&sCnt[e2], 1);
            GATE[row * 2] = ggate * p1; GATE[row * 2 + 1] = ggate * p2;
        }
    }
    __syncthreads();
    if (tid < 32) sBase[tid] = (sCnt[tid] > 0) ? atomicAdd(&CNT[tid * CSTR], sCnt[tid]) : 0;
    __syncthreads();
    for (int a = tid; a < (row_hi - row_lo) * 2; a += NTHREADS) {
        const int row = row_lo + (a >> 1), e = sE[a], r = sBase[e] + sR[a];
        LIST[(size_t)e * LISTCAP + r] = row;
        ASG[row * 4 + (a & 1) * 2] = e; ASG[row * 4 + (a & 1) * 2 + 1] = r;
    }
}

PHASE_FN void ph_moe(const Params& p, int layer, int which, float* smem) {
    unsigned char* ws_ = p.ws; asm volatile("" : "+s"(ws_));
    { int ldz_ = 0; asm volatile("" : "+s"(ldz_)); smem = (float*)(g_smem + ldz_); }
    int tid_ = threadIdx.x; asm volatile("" : "+v"(tid_)); const int tid = tid_;
    int* sPad = (int*)((unsigned char*)smem + 98304); int* sTs = sPad + 33;
    const int* CNT = (const int*)(ws_ + OFF_CNT) + layer * 32 * CSTR;
    __syncthreads();
    if (tid == 0) { int a = 0, ts = 0; for (int e = 0; e < 32; ++e) { sPad[e] = a; sTs[e] = ts; a += ((CNT[e * CSTR] + 127) / 128) * 128; ts += (CNT[e * CSTR] + 255) / 256; } sTs[32] = ts; sPad[32] = a; }
    __syncthreads();
    const int total = sTs[32] * 8;
    bf16_t* HID = (bf16_t*)(ws_ + OFF_HID); float* YB = (float*)(ws_ + OFF_YB);
    const bf16_t* H = (const bf16_t*)(ws_ + OFF_H);
    const int* LIST = (const int*)(ws_ + OFF_LIST);
    for (int tile = blockIdx.x; tile < total; tile += gridDim.x) {
        const int mt = tile >> 3, nt = tile & 7;
        int e = 0;
        for (int q = 1; q < 32; ++q) if (sTs[q] <= mt) e = q;
        const int mi0 = mt - sTs[e];
        const int cnt = CNT[e * CSTR];
        const int mvalid = (cnt - mi0 * 256 < 256) ? (cnt - mi0 * 256) : 256;
        const int rowbase = sPad[e] + mi0 * 256;
        if (which == 0) {
            long ro[4];
#pragma unroll
            for (int i = 0; i < 4; ++i) { const int r = (tid + 512 * i) >> 3; ro[i] = (r < mvalid) ? (long)LIST[(size_t)e * LISTCAP + mi0 * 256 + r] * 1024 : -1; }
            const long ro0 = ro[0], ro1 = ro[1], ro2 = ro[2], ro3 = ro[3];
            const bf16_t* Bb = (const bf16_t*)(ws_ + OFF_W13) + (size_t)e * 1024 * 1024 + (size_t)nt * 128 * 1024;
            bf16_t* Ht = HID + (size_t)rowbase * 512 + nt * 64;
            gemm_tile_bf16(1024, (unsigned char*)smem,
                [=](int i, int r, int k) -> uint4 { const long o = (i == 0) ? ro0 : (i == 1) ? ro1 : (i == 2) ? ro2 : ro3; if (o < 0) return make_uint4(0u, 0u, 0u, 0u);
                    return *(const uint4*)(H + o + k); },
                [=](int i, int r, int k) -> uint4 { return *(const uint4*)(Bb + (size_t)r * 1024 + k); },
                [=](const f32x4 (&acc)[4][4], int wm, int wn, int lane) {
#pragma unroll
                    for (int mi = 0; mi < 4; ++mi)
#pragma unroll
                        for (int ni = 0; ni < 2; ++ni) {
                            const int m = wm * 64 + mi * 16 + (lane & 15), n = wn * 32 + ni * 16 + 4 * (lane >> 4);
                            const f32x4 a1 = acc[mi][ni], a3 = acc[mi][ni + 2];
                            f32x4 hv; hv[0] = siluf_(a1[0]) * a3[0]; hv[1] = siluf_(a1[1]) * a3[1]; hv[2] = siluf_(a1[2]) * a3[2]; hv[3] = siluf_(a1[3]) * a3[3];
                            if (m < mvalid) *(uint2*)(Ht + (size_t)m * 512 + n) = pack4(hv);
                        }
                });
        } else {
            const bf16_t* Ab = HID + (size_t)rowbase * 512;
            const bf16_t* Bb = (const bf16_t*)(ws_ + OFF_W2T) + (size_t)e * 1024 * 512 + (size_t)nt * 128 * 512;
            float* Yt = YB + (size_t)rowbase * 1024 + nt * 128;
            gemm_tile_bf16(512, (unsigned char*)smem,
                [=](int i, int r, int k) -> uint4 { if (r >= mvalid) return make_uint4(0u, 0u, 0u, 0u); return *(const uint4*)(Ab + (size_t)r * 512 + k); },
                [=](int i, int r, int k) -> uint4 { return *(const uint4*)(Bb + (size_t)r * 512 + k); },
                [=](const f32x4 (&acc)[4][4], int wm, int wn, int lane) {
#pragma unroll
                    for (int mi = 0; mi < 4; ++mi)
#pragma unroll
                        for (int ni = 0; ni < 4; ++ni) {
                            const int m = wm * 64 + mi * 16 + (lane & 15), n = wn * 64 + ni * 16 + 4 * (lane >> 4);
                            if (m < mvalid) *(f32x4*)(Yt + (size_t)m * 1024 + n) = acc[mi][ni];
                        }
                });
        }
    }
}

PHASE_FN void ph_conv_dense(const Params& p, float* smem) {
    unsigned char* ws_ = p.ws; asm volatile("" : "+s"(ws_));
    { int ldz_ = 0; asm volatile("" : "+s"(ldz_)); smem = (float*)(g_smem + ldz_); }
    for (int t = blockIdx.x; t < 1984 + 1600 + 1024; t += gridDim.x) {
        if (t < 1984) { const int l = t / 992, u = t % 992;
            convert_tile(p.even_w_in + (size_t)l * 1024 * 3916, nullptr, 0, 1024, 3916, 3916, (bf16_t*)(ws_ + OFF_WINE) + (size_t)l * 3968 * 1024, u >> 4, u & 15, smem); }
        else if (t < 3584) { const int v = t - 1984, l = v / 800, u = v % 800;
            convert_tile(p.gla_w_in + (size_t)l * 1024 * 3088, nullptr, 0, 1024, 3088, 3088, (bf16_t*)(ws_ + OFF_WINO) + (size_t)l * 3200 * 1024, u >> 4, u & 15, smem); }
        else { const int v = t - 3584, l = v >> 8, u = v & 255;
            convert_tile(((l & 1) ? p.gla_w_out : p.even_w_out) + (size_t)(l >> 1) * 1024 * 1024, nullptr, 0, 1024, 1024, 1024, (bf16_t*)(ws_ + OFF_WOUT) + (size_t)l * 1024 * 1024, u >> 4, u & 15, smem); }
    }
}

PHASE_FN void ph_conv_exp(const Params& p, int layer, float* smem, int first_blk) {
    unsigned char* ws_ = p.ws; asm volatile("" : "+s"(ws_));
    { int ldz_ = 0; asm volatile("" : "+s"(ldz_)); smem = (float*)(g_smem + ldz_); }
    if ((int)blockIdx.x < first_blk) return;
    for (int t = blockIdx.x - first_blk; t < 8192 + 4096; t += gridDim.x - first_blk) {
        if (t < 8192) { const int e = t >> 8, u = t & 255;
            convert_tile(p.w1 + (size_t)(layer * 32 + e) * 1024 * 512, p.w3 + (size_t)(layer * 32 + e) * 1024 * 512, 1, 1024, 512, 512, (bf16_t*)(ws_ + OFF_W13) + (size_t)e * 1024 * 1024, u >> 4, u & 15, smem); }
        else { const int v = t - 8192, e = v >> 7, u = v & 127;
            convert_tile(p.w2 + (size_t)(layer * 32 + e) * 512 * 1024, nullptr, 0, 512, 1024, 1024, (bf16_t*)(ws_ + OFF_W2T) + (size_t)e * 1024 * 512, u >> 3, u & 7, smem); }
    }
}

PHASE_FN void ph_gla_tok(const Params& p, int layer) {
    unsigned char* ws_ = p.ws; asm volatile("" : "+s"(ws_));
    int tid_ = threadIdx.x; asm volatile("" : "+v"(tid_)); const int tid = tid_, lane = tid & 63, wv = tid >> 6, li = layer >> 1;
    const float* AUX = (const float*)(ws_ + OFF_AUX);
    float* LA = (float*)(ws_ + OFF_LA);
    const float* w2 = p.gla_w_gate2 + (size_t)li * 16 * 512; const float* b2 = p.gla_b_gate2 + li * 512;
    for (int t = blockIdx.x * 8 + wv; t < NT; t += gridDim.x * 8) {
        float glr[16];
#pragma unroll
        for (int r = 0; r < 16; ++r) glr[r] = AUX[(size_t)t * 16 + r];
#pragma unroll 1
        for (int i = 0; i < 8; ++i) {
            const int c = lane + 64 * i; float z = b2[c];
#pragma unroll
            for (int r = 0; r < 16; ++r) z += glr[r] * w2[r * 512 + c];
            LA[(size_t)t * 512 + c] = -softplusf_(-z) * (1.f / 16.f);
        }
    }
}

PHASE_FN void ph_gla_chunk(const Params& p, int layer, float* smem) {
    unsigned char* ws_ = p.ws; asm volatile("" : "+s"(ws_));
    int tid_ = threadIdx.x; asm volatile("" : "+v"(tid_)); const int tid = tid_, lane = tid & 63, wv = __builtin_amdgcn_readfirstlane(tid >> 6), q4 = lane >> 4, c16 = lane & 15;
    int ldz_ = 0; asm volatile("" : "+s"(ldz_)); unsigned char* lds = g_smem + ldz_;
    constexpr int SN = 272, ST = 144;
    float* sBc = (float*)lds;
    unsigned char* bQE = lds + 33024;
    unsigned char* bKE = lds + 50432;
    unsigned char* bKD = lds + 67840;
    unsigned char* bVT = lds + 86272;
    unsigned char* bATT = lds + 123136;
    const bf16_t* P = (const bf16_t*)(ws_ + OFF_P); const float* AUX = (const float*)(ws_ + OFF_AUX);
    const float* w2 = p.gla_w_gate2 + (size_t)(layer >> 1) * 16 * 512; const float* b2 = p.gla_b_gate2 + (layer >> 1) * 512;
    float* sGlr = (float*)(lds + 132352);
    uint4* QEF = (uint4*)(ws_ + OFF_GQE); uint2* OIF = (uint2*)(ws_ + OFF_GOI); uint2* HF = (uint2*)(ws_ + OFF_GH); float* EBL = (float*)(ws_ + OFF_GEBL);
    for (int ci = blockIdx.x; ci < 1024; ci += gridDim.x) {
        const int b = ci >> 9, h = (ci >> 7) & 3, n = ci & 127;
        const int t0 = b * 8192 + n * 64;
        __syncthreads();
        for (int e = tid; e < 1024; e += NTHREADS) sGlr[e] = AUX[(size_t)(t0 + (e >> 4)) * 16 + (e & 15)];
        __syncthreads();
        {
            const int d = tid & 127, c = h * 128 + d;
            float wg[16];
#pragma unroll
            for (int r = 0; r < 16; ++r) wg[r] = w2[r * 512 + c];
            const float bz = b2[c];
            for (int i = tid >> 7; i < 64; i += 4) {
                float z = bz;
#pragma unroll
                for (int r = 0; r < 16; ++r) z += sGlr[i * 16 + r] * wg[r];
                sBc[i * 129 + d] = -softplusf_(-z) * (1.f / 16.f);
            }
        }
        for (int e = tid; e < 64 * 36; e += NTHREADS) ((unsigned*)bATT)[e] = 0u;
        __syncthreads();
        if (tid < 128) { float a = 0.f; for (int i = 0; i < 64; ++i) { a += sBc[i * 129 + tid]; sBc[i * 129 + tid] = a; } }
        __syncthreads();
        for (int e = tid; e < 8192; e += NTHREADS) {
            const int i = e >> 7, d = e & 127;
            const float bb = sBc[i * 129 + d], bl = sBc[63 * 129 + d];
            const float qf = PBF(P, t0 + i, h * 128 + d), kf = PBF(P, t0 + i, 512 + h * 128 + d);
            *(bf16_t*)(bQE + i * SN + d * 2) = f2bf(qf * SCALE128 * expf(bb));
            *(bf16_t*)(bKE + i * SN + d * 2) = f2bf(kf * expf(-bb));
            *(bf16_t*)(bKD + d * ST + i * 2) = f2bf(kf * expf(bl - bb));
        }
        for (int e = tid; e < 16384; e += NTHREADS) { const int i = e >> 8, dv = e & 255; *(bf16_t*)(bVT + dv * ST + i * 2) = P[(size_t)(t0 + i) * LDPB + 1024 + h * 256 + dv]; }
        if (tid < 128) EBL[ci * 128 + tid] = expf(sBc[63 * 129 + tid]);
        __syncthreads();
        for (int u = wv; u < 10; u += 8) {
            const int ti = (u >= 6) ? 3 : (u >= 3) ? 2 : (u >= 1) ? 1 : 0, tj = u - ((ti * (ti + 1)) >> 1);
            f32x4 acc = (f32x4){0.f, 0.f, 0.f, 0.f};
            acc = mma_lds(bQE, SN, 16 * ti, bKE, SN, 16 * tj, 128, acc, c16, q4);
            const int j = 16 * tj + c16;
#pragma unroll
            for (int r = 0; r < 4; ++r) { const int i = 16 * ti + 4 * q4 + r; *(bf16_t*)(bATT + i * ST + j * 2) = f2bf((j <= i) ? acc[r] : 0.f); }
        }
        for (int x = 0; x < 2; ++x) {
            const int u = wv * 2 + x, ti = u >> 2, a = u & 3;
            const unsigned char* rp = bQE + (16 * ti + c16) * SN;
            const uint2 lo = *(const uint2*)(rp + (32 * a + 4 * q4) * 2), hi = *(const uint2*)(rp + (32 * a + 16 + 4 * q4) * 2);
            QEF[((size_t)(ci * 4 + ti) * 4 + a) * 64 + lane] = make_uint4(lo.x, lo.y, hi.x, hi.y);
        }
        __syncthreads();
        for (int x = 0; x < 8; ++x) {
            const int u = wv * 8 + x, tdv = u >> 2, ti = u & 3;
            f32x4 acc = (f32x4){0.f, 0.f, 0.f, 0.f};
            acc = mma_lds(bATT, ST, 16 * ti, bVT, ST, 16 * tdv, 64, acc, c16, q4);
            OIF[((size_t)(ci * 16 + tdv) * 4 + ti) * 64 + lane] = pack4(acc);
        }
        for (int x = 0; x < 16; ++x) {
            const int u = wv * 16 + x, tdv = u >> 3, tdk = u & 7;
            f32x4 acc = (f32x4){0.f, 0.f, 0.f, 0.f};
            acc = mma_lds(bKD, ST, 16 * tdk, bVT, ST, 16 * tdv, 64, acc, c16, q4);
            HF[((size_t)(ci * 16 + tdv) * 8 + tdk) * 64 + lane] = pack4(acc);
        }
    }
}

PHASE_FN void ph_gla_scan(const Params& p, float* smem) {
    unsigned char* ws_ = p.ws; asm volatile("" : "+s"(ws_));
    int tid_ = threadIdx.x; asm volatile("" : "+v"(tid_)); const int tid = tid_, lane = tid & 63, wv = __builtin_amdgcn_readfirstlane(tid >> 6), q4 = lane >> 4, c16 = lane & 15;
    int ldz_ = 0; asm volatile("" : "+s"(ldz_)); unsigned char* lds = g_smem + ldz_;
    constexpr int STG = 29184;
    const unsigned char* QEF = ws_ + OFF_GQE; const unsigned char* HF = ws_ + OFF_GH; const unsigned char* OIF = ws_ + OFF_GOI; const unsigned char* EBL = ws_ + OFF_GEBL;
    float* O = (float*)(ws_ + OFF_O);
    for (int it = blockIdx.x; it < 64; it += gridDim.x) {
        const int bh = it >> 3, pair = it & 7, b = bh >> 2, h = bh & 3;
        __syncthreads();
        if (wv >= 2) {
            const int lt = tid - 128;
            const unsigned char* Qb = QEF + (size_t)bh * 128 * 16384;
            const unsigned char* Hb = HF + (size_t)bh * 128 * 65536 + pair * 8192;
            const unsigned char* Ob = OIF + (size_t)bh * 128 * 32768 + pair * 4096;
            const unsigned char* Lb = EBL + (size_t)bh * 128 * 512;
            uint4 ra0, ra1, ra2, ra3, ra4, ra5, ra6, rb0, rb1, rb2, rb3, rb4, rb5, rb6;
#define GL_LOAD(X, n_) do { const unsigned char* q_ = Qb + (size_t)(n_) * 16384; const unsigned char* h_ = Hb + (size_t)(n_) * 65536; \
                const unsigned char* o_ = Ob + (size_t)(n_) * 32768; const unsigned char* l_ = Lb + (size_t)(n_) * 512; \
                X##0 = LDC(q_, lt, 1023); X##1 = LDC(q_, lt + 384, 1023); X##2 = LDC(q_, lt + 768, 1023); \
                X##3 = LDC(h_, lt, 511); X##4 = LDC(h_, lt + 384, 511); X##5 = LDC(o_, lt, 255); X##6 = LDC(l_, lt, 31); } while (0)
#define GL_STORE(X, st_) do { unsigned char* sb_ = lds + (st_) * STG; \
                STC(0, lt, 1024, X##0); STC(0, lt + 384, 1024, X##1); STC(0, lt + 768, 1024, X##2); \
                STC(16384, lt, 512, X##3); STC(16384, lt + 384, 512, X##4); STC(24576, lt, 256, X##5); STC(28672, lt, 32, X##6); } while (0)
            GL_LOAD(ra, 0); GL_STORE(ra, 0);
            GL_LOAD(rb, 1); GL_LOAD(ra, 2);
            __syncthreads();
            for (int n = 0; n < 128; n += 2) {
                GL_STORE(rb, 1);
                GL_LOAD(rb, (n + 3 < 128) ? n + 3 : 127);
                __syncthreads();
                if (n + 2 < 128) GL_STORE(ra, 0);
                GL_LOAD(ra, (n + 4 < 128) ? n + 4 : 127);
                __syncthreads();
            }
        } else {
            const int tdv = pair * 2 + wv;
            f32x4 S[8];
#pragma unroll
            for (int t = 0; t < 8; ++t) S[t] = (f32x4){0.f, 0.f, 0.f, 0.f};
            __syncthreads();
            for (int n = 0; n < 128; ++n) {
                const unsigned char* base = lds + (n & 1) * STG;
                const unsigned char* Qf = base + lane * 16, *Hf = base + 16384 + wv * 4096 + lane * 8, *Of = base + 24576 + wv * 2048 + lane * 8, *Lf = base + 28672 + q4 * 16;
                bf16x8 Sb[4];
#pragma unroll
                for (int a = 0; a < 4; ++a) { union { uint4 u; bf16x8 v; } cv; const uint2 lo = pack4(S[2 * a]), hi = pack4(S[2 * a + 1]); cv.u.x = lo.x; cv.u.y = lo.y; cv.u.z = hi.x; cv.u.w = hi.y; Sb[a] = cv.v; }
                const int t0 = b * 8192 + n * 64;
                f32x4 oa[4];
#pragma unroll
                for (int ti = 0; ti < 4; ++ti) oa[ti] = unpack4(*(const uint2*)(Of + ti * 512));
#pragma unroll
                for (int a = 0; a < 4; ++a)
#pragma unroll
                    for (int ti = 0; ti < 4; ++ti) oa[ti] = __builtin_amdgcn_mfma_f32_16x16x32_bf16(*(const bf16x8*)(Qf + (ti * 4 + a) * 1024), Sb[a], oa[ti], 0, 0, 0);
#pragma unroll
                for (int ti = 0; ti < 4; ++ti) {
                    float* op = O + (size_t)(t0 + 16 * ti + 4 * q4) * 1024 + h * 256 + 16 * tdv + c16;
                    op[0] = oa[ti][0]; op[1024] = oa[ti][1]; op[2048] = oa[ti][2]; op[3072] = oa[ti][3]; }
#pragma unroll
                for (int t = 0; t < 8; ++t) { const f32x4 lam = *(const f32x4*)(Lf + t * 64); S[t] = S[t] * lam + unpack4(*(const uint2*)(Hf + t * 512)); }
                __syncthreads();
            }
        }
    }
}

PHASE_FN void ph_gla_out(const Params& p, int layer) {
    unsigned char* ws_ = p.ws; asm volatile("" : "+s"(ws_));
    int tid_ = threadIdx.x; asm volatile("" : "+v"(tid_)); const int tid = tid_, lane = tid & 63, wv = tid >> 6;
    const float* O = (const float*)(ws_ + OFF_O); const bf16_t* P = (const bf16_t*)(ws_ + OFF_P); bf16_t* OB = (bf16_t*)(ws_ + OFF_OB);
    const float* onw = p.gla_out_norm + (layer >> 1) * 256;
    for (int t = blockIdx.x * 8 + wv; t < NT; t += gridDim.x * 8) {
#pragma unroll
        for (int h = 0; h < 4; ++h) {
            const float* op = O + (size_t)t * 1024 + h * 256;
            const float4 o = *(const float4*)(op + lane * 4);
            const float ss = wave_sum(o.x * o.x + o.y * o.y + o.z * o.z + o.w * o.w);
            const float r = rsqrtf(ss * (1.f / 256.f) + EPS);
            const f32x4 z = unpack4(*(const uint2*)(P + (size_t)t * LDPB + 2048 + h * 256 + lane * 4));
            const float4 w = *(const float4*)(onw + lane * 4);
            f32x4 ov; ov[0] = o.x * r * w.x * siluf_(z[0]); ov[1] = o.y * r * w.y * siluf_(z[1]); ov[2] = o.z * r * w.z * siluf_(z[2]); ov[3] = o.w * r * w.w * siluf_(z[3]);
            *(uint2*)(OB + (size_t)t * 1024 + h * 256 + lane * 4) = pack4(ov);
        }
    }
}

template <int PH>
__device__ __forceinline__ void run_phase(const Params& p, int layer, float* smem) {
    if (PH == PH_PROLOGUE) { ph_prologue(p, smem); ph_conv_dense(p, smem); }
    else if (PH == PH_NORM_MIX) ph_rows(p, layer, 0, smem);
    else if (PH == PH_GEMM_IN_EVEN) ph_gemm_in(p, layer, true, smem);
    else if (PH == PH_EVEN_TOK) ph_even_tok(p, layer, smem);
    else if (PH == PH_GDN_CHUNK) ph_gdn_chunk(p, layer, smem);
    else if (PH == PH_GDN_SCAN) { ph_gdn_scan(p, smem); ph_conv_exp(p, layer, smem, 32); }
    else if (PH == PH_DSA_TOPK) ph_dsa_topk(p, smem);
    else if (PH == PH_DSA_ATTN) ph_dsa_attn(p, smem);
    else if (PH == PH_GDN_OUT) ph_gdn_out(p, layer);
    else if (PH == PH_GEMM_OUT) ph_gemm_out(p, layer, smem);
    else if (PH == PH_NORM_FFN) ph_norm_ffn(p, layer);
    else if (PH == PH_MOE1) ph_moe(p, layer, 0, smem);
    else if (PH == PH_MOE2) ph_moe(p, layer, 1, smem);
    else if (PH == PH_GEMM_IN_ODD) ph_gemm_in(p, layer, false, smem);
    else if (PH == PH_GLA_TOK) ph_gla_tok(p, layer);
    else if (PH == PH_GLA_CHUNK) ph_gla_chunk(p, layer, smem);
    else if (PH == PH_GLA_SCAN) { ph_gla_scan(p, smem); ph_conv_exp(p, layer, smem, 64); }
    else if (PH == PH_GLA_OUT) ph_gla_out(p, layer);
    else if (PH == PH_FINAL) ph_rows(p, 0, 1, smem);
}

#if MK_MULTI
template <int PH>
__global__ void __launch_bounds__(NTHREADS, 2) k_phase(Params p, int layer) {
    run_phase<PH>(p, layer, (float*)g_smem);
}
#else
__global__ void __launch_bounds__(NTHREADS, 2) k_mega(Params p) {
    float* smem = (float*)g_smem;
    volatile LAS unsigned* xbw = (volatile LAS unsigned*)(LAS unsigned char*)(g_smem + LDS_BYTES - 16);
    if (threadIdx.x == 0) { xbw[0] = 0u; xbw[1] = 0u; xbw[2] = 0u; xbw[3] = 0u; }
    __syncthreads();
    XcdBarrier bar = xcd_barrier_post((unsigned*)(p.ws + OFF_BAR), xbw);
#define BAR() xcd_barrier(bar)
    run_phase<PH_PROLOGUE>(p, 0, smem); BAR(); if (DUP_MASK & 4096) { run_phase<PH_PROLOGUE>(p, 0, smem); BAR(); }
    for (int lp = 0; lp < 2; ++lp) {
        const int le = 2 * lp, lo = 2 * lp + 1;
        run_phase<PH_NORM_MIX>(p, le, smem); BAR();
        run_phase<PH_GEMM_IN_EVEN>(p, le, smem); BAR(); if (DUP_MASK & 1) { run_phase<PH_GEMM_IN_EVEN>(p, le, smem); BAR(); }
        run_phase<PH_EVEN_TOK>(p, le, smem); BAR(); if (DUP_MASK & 2) { run_phase<PH_EVEN_TOK>(p, le, smem); BAR(); }
        run_phase<PH_GDN_CHUNK>(p, le, smem); BAR(); if (DUP_MASK & 4) { run_phase<PH_GDN_CHUNK>(p, le, smem); BAR(); }
        run_phase<PH_GDN_SCAN>(p, le, smem); BAR(); if (DUP_MASK & 8) { run_phase<PH_GDN_SCAN>(p, le, smem); BAR(); }
        run_phase<PH_DSA_TOPK>(p, le, smem); BAR(); if (DUP_MASK & 16) { run_phase<PH_DSA_TOPK>(p, le, smem); BAR(); }
        run_phase<PH_DSA_ATTN>(p, le, smem); BAR(); if (DUP_MASK & 32) { run_phase<PH_DSA_ATTN>(p, le, smem); BAR(); }
        run_phase<PH_GDN_OUT>(p, le, smem); BAR();
        run_phase<PH_GEMM_OUT>(p, le, smem); BAR();
        run_phase<PH_NORM_FFN>(p, le, smem); BAR();
        run_phase<PH_MOE1>(p, le, smem); BAR(); if (DUP_MASK & 64) { run_phase<PH_MOE1>(p, le, smem); BAR(); }
        run_phase<PH_MOE2>(p, le, smem); BAR(); if (DUP_MASK & 128) { run_phase<PH_MOE2>(p, le, smem); BAR(); }
        run_phase<PH_NORM_MIX>(p, lo, smem); BAR();
        run_phase<PH_GEMM_IN_ODD>(p, lo, smem); BAR(); if (DUP_MASK & 256) { run_phase<PH_GEMM_IN_ODD>(p, lo, smem); BAR(); }
        run_phase<PH_GLA_CHUNK>(p, lo, smem); BAR(); if (DUP_MASK & 1024) { run_phase<PH_GLA_CHUNK>(p, lo, smem); BAR(); }
        run_phase<PH_GLA_SCAN>(p, lo, smem); BAR(); if (DUP_MASK & 2048) { run_phase<PH_GLA_SCAN>(p, lo, smem); BAR(); }
        run_phase<PH_GLA_OUT>(p, lo, smem); BAR();
        run_phase<PH_GEMM_OUT>(p, lo, smem); BAR();
        run_phase<PH_NORM_FFN>(p, lo, smem); BAR();
        run_phase<PH_MOE1>(p, lo, smem); BAR(); if (DUP_MASK & 64) { run_phase<PH_MOE1>(p, lo, smem); BAR(); }
        run_phase<PH_MOE2>(p, lo, smem); BAR(); if (DUP_MASK & 128) { run_phase<PH_MOE2>(p, lo, smem); BAR(); }
    }
    for (int xb = 0; xb < EXTRA_BARS; ++xb) BAR();
    run_phase<PH_FINAL>(p, 0, smem);
}
#endif

}

#if MK_MULTI
template <int PH>
static void launch_phase(const Params& p, int layer, hipStream_t stream) {
    static bool attr_set = false;
    if (!attr_set) { hipFuncSetAttribute((const void*)k_phase<PH>, hipFuncAttributeMaxDynamicSharedMemorySize, (int)LDS_BYTES); attr_set = true; }
    hipLaunchKernelGGL((k_phase<PH>), dim3(256), dim3(NTHREADS), LDS_BYTES, stream, p, layer);
}
#endif

extern "C" void kernel_launch(void* const* d_in, const int* in_sizes, int n_in, void* d_out, int out_size, void* d_ws, size_t ws_size, hipStream_t stream) {
    (void)in_sizes; (void)n_in; (void)out_size;
    if (ws_size < WS_NEEDED) { fprintf(stderr, "workspace too small: %zu < %zu\n", ws_size, (size_t)WS_NEEDED); return; }
    Params p{};
    p.x = (const float*)d_in[0]; p.c = (const float*)d_in[1]; p.pos = (const int*)d_in[2]; p.ada_w = (const float*)d_in[3]; p.ada_b = (const float*)d_in[4];
    p.norm_mix = (const float*)d_in[5]; p.norm_ffn = (const float*)d_in[6]; p.even_w_in = (const float*)d_in[7]; p.conv_w = (const float*)d_in[8];
    p.a_log = (const float*)d_in[9]; p.dt_bias = (const float*)d_in[10]; p.gdn_out_norm = (const float*)d_in[11]; p.even_w_out = (const float*)d_in[12];
    p.gla_w_in = (const float*)d_in[13]; p.gla_w_gate2 = (const float*)d_in[14]; p.gla_b_gate2 = (const float*)d_in[15]; p.gla_out_norm = (const float*)d_in[16]; p.gla_w_out = (const float*)d_in[17];
    p.rg_w = (const float*)d_in[18]; p.rg_b = (const float*)d_in[19]; p.re_w = (const float*)d_in[20]; p.re_b = (const float*)d_in[21];
    p.w1 = (const float*)d_in[22]; p.w3 = (const float*)d_in[23]; p.w2 = (const float*)d_in[24]; p.final_norm = (const float*)d_in[25];
    p.X = (float*)d_out; p.ws = (unsigned char*)d_ws;
    p.rA = pow(10000.0, -2.0 / 128.0); p.rI = pow(10000.0, -2.0 / 64.0);
    hipMemsetAsync(d_ws, 0, ZERO_BYTES, stream);
#if MK_MULTI
    launch_phase<PH_PROLOGUE>(p, 0, stream);
    for (int lp = 0; lp < 2; ++lp) {
        const int le = 2 * lp, lo = 2 * lp + 1;
        launch_phase<PH_NORM_MIX>(p, le, stream);
        launch_phase<PH_GEMM_IN_EVEN>(p, le, stream);
        launch_phase<PH_EVEN_TOK>(p, le, stream);
        launch_phase<PH_GDN_CHUNK>(p, le, stream);
        launch_phase<PH_GDN_SCAN>(p, le, stream);
        launch_phase<PH_DSA_TOPK>(p, le, stream);
        launch_phase<PH_DSA_ATTN>(p, le, stream);
        launch_phase<PH_GDN_OUT>(p, le, stream);
        launch_phase<PH_GEMM_OUT>(p, le, stream);
        launch_phase<PH_NORM_FFN>(p, le, stream);
        launch_phase<PH_MOE1>(p, le, stream);
        launch_phase<PH_MOE2>(p, le, stream);
        launch_phase<PH_NORM_MIX>(p, lo, stream);
        launch_phase<PH_GEMM_IN_ODD>(p, lo, stream);
        launch_phase<PH_GLA_CHUNK>(p, lo, stream);
        launch_phase<PH_GLA_SCAN>(p, lo, stream);
        launch_phase<PH_GLA_OUT>(p, lo, stream);
        launch_phase<PH_GEMM_OUT>(p, lo, stream);
        launch_phase<PH_NORM_FFN>(p, lo, stream);
        launch_phase<PH_MOE1>(p, lo, stream);
        launch_phase<PH_MOE2>(p, lo, stream);
    }
    launch_phase<PH_FINAL>(p, 0, stream);
#else
    static int grid = 0;
    if (!grid) {
        int dev = 0, cus = 0, per_cu = 0;
        hipGetDevice(&dev);
        hipDeviceGetAttribute(&cus, hipDeviceAttributeMultiprocessorCount, dev);
        hipFuncSetAttribute((const void*)k_mega, hipFuncAttributeMaxDynamicSharedMemorySize, (int)LDS_BYTES);
        hipOccupancyMaxActiveBlocksPerMultiprocessor(&per_cu, k_mega, NTHREADS, LDS_BYTES);
        if (cus <= 0) cus = 256;
        grid = cus * (per_cu < 1 ? 1 : 1);
    }
    hipLaunchKernelGGL(k_mega, dim3(grid), dim3(NTHREADS), LDS_BYTES, stream, p);
#endif
}
```

```cpp
#include <hip/hip_runtime.h>
#include <stdint.h>
#include <math.h>
#include <stdio.h>

#define EXTRA_BARS 0
#define TOPK_SEARCH_REP 1
#ifndef DUP_MASK
#define DUP_MASK 0
#endif
#ifndef MK_MULTI
#define MK_MULTI 0
#endif

namespace {

constexpr int NT = 16384, ND = 1024, LDP = 3920, LDPB = 3968;
constexpr float EPS = 1e-6f;
constexpr int NTHREADS = 512;
constexpr size_t LDS_BYTES = 147456;
constexpr float SCALE128 = 0.08838834764831845f;
constexpr int LISTCAP = 32768;
constexpr int CSTR = 16;

constexpr size_t OFF_BAR  = 0;
constexpr size_t OFF_CNT  = 16384;
constexpr size_t ZERO_BYTES = 32768;
constexpr size_t OFF_QCTR = 28672;
constexpr size_t OFF_MOD  = 32768;
constexpr size_t OFF_COSA = OFF_MOD + 4 * 2 * 6144 * 4;
constexpr size_t OFF_SINA = OFF_COSA + (size_t)NT * 64 * 4;
constexpr size_t OFF_COSI = OFF_SINA + (size_t)NT * 64 * 4;
constexpr size_t OFF_SINI = OFF_COSI + (size_t)NT * 32 * 4;
constexpr size_t OFF_H    = OFF_SINI + (size_t)NT * 32 * 4;
constexpr size_t OFF_P    = OFF_H + (size_t)NT * 1024 * 4;
constexpr size_t OFF_HID  = OFF_P;
constexpr size_t OFF_YB   = OFF_HID + (size_t)36864 * 512 * 4;
constexpr size_t OFF_O    = OFF_P + (size_t)NT * LDP * 4;
constexpr size_t OFF_ASG  = OFF_O + (size_t)NT * 1024 * 4;
constexpr size_t OFF_GATE = OFF_ASG + (size_t)NT * 4 * 4;
constexpr size_t OFF_LIST = OFF_GATE + (size_t)NT * 2 * 4;
constexpr size_t OFF_R    = OFF_LIST + (size_t)32 * LISTCAP * 4;
constexpr size_t OFF_QN   = OFF_R;
constexpr size_t OFF_KN   = OFF_QN + (size_t)NT * 512 * 4;
constexpr size_t OFF_VC   = OFF_KN + (size_t)NT * 512 * 4;
constexpr size_t OFF_BETA = OFF_VC + (size_t)NT * 512 * 4;
constexpr size_t OFF_G    = OFF_BETA + (size_t)NT * 4 * 4;
constexpr size_t OFF_W    = OFF_G + (size_t)NT * 4 * 4;
constexpr size_t OFF_U    = OFF_W + (size_t)1024 * 8192 * 4;
constexpr size_t OFF_QG   = OFF_U + (size_t)1024 * 8192 * 4;
constexpr size_t OFF_KD   = OFF_QG + (size_t)1024 * 8192 * 4;
constexpr size_t OFF_AQK  = OFF_KD + (size_t)1024 * 8192 * 4;
constexpr size_t OFF_GL   = OFF_AQK + (size_t)1024 * 4096 * 4;
constexpr size_t OFF_QB   = OFF_GL + 4096;
constexpr size_t OFF_KB   = OFF_QB + (size_t)NT * 512 * 4;
constexpr size_t OFF_QI   = OFF_KB + (size_t)NT * 512 * 4;
constexpr size_t OFF_KI   = OFF_QI + (size_t)NT * 256 * 4;
constexpr size_t OFF_WI   = OFF_KI + (size_t)NT * 64 * 4;
constexpr size_t OFF_SEL  = OFF_WI + (size_t)NT * 4 * 4;
constexpr size_t OFF_EVEN_END = OFF_SEL + (size_t)NT * 256 * 4;
constexpr size_t OFF_PFR  = OFF_W;
constexpr size_t OFF_RFR  = OFF_PFR + (size_t)1024 * 32768;
constexpr size_t OFF_QFR  = OFF_RFR + (size_t)1024 * 16384;
constexpr size_t OFF_OFR  = OFF_QFR + (size_t)1024 * 32768;
static_assert(OFF_OFR + (size_t)1024 * 16384 <= OFF_GL, "gdn v2 buffers overflow");
constexpr size_t OFF_QBB  = OFF_QB;
constexpr size_t OFF_KBB  = OFF_QBB + (size_t)NT * 512 * 2;
constexpr size_t OFF_VT   = OFF_KBB + (size_t)NT * 512 * 2;
constexpr size_t OFF_QIB  = OFF_VT + (size_t)NT * 512 * 2;
constexpr size_t OFF_KIB  = OFF_QIB + (size_t)NT * 256 * 2;
constexpr size_t OFF_M16  = OFF_KIB + (size_t)NT * 64 * 2;
static_assert(OFF_M16 + (size_t)NT * 512 * 2 <= OFF_WI, "dsa v2 buffers overflow");
constexpr size_t OFF_LA   = OFF_R;
constexpr size_t OFF_ATT  = OFF_LA + (size_t)NT * 512 * 4;
constexpr size_t OFF_QE   = OFF_ATT + (size_t)1024 * 4096 * 4;
constexpr size_t OFF_GKD  = OFF_QE + (size_t)1024 * 8192 * 4;
constexpr size_t OFF_EBL  = OFF_GKD + (size_t)1024 * 8192 * 4;
constexpr size_t OFF_GQE  = OFF_LA + (size_t)NT * 512 * 4;
constexpr size_t OFF_GOI  = OFF_GQE + (size_t)1024 * 16384;
constexpr size_t OFF_GH   = OFF_GOI + (size_t)1024 * 32768;
constexpr size_t OFF_GEBL = OFF_GH + (size_t)1024 * 65536;
static_assert(OFF_GEBL + (size_t)1024 * 512 <= OFF_EVEN_END, "gla v2 buffers overflow");
constexpr size_t OFF_WINE = OFF_EVEN_END;
constexpr size_t OFF_WINO = OFF_WINE + (size_t)2 * 3968 * 1024 * 2;
constexpr size_t OFF_WOUT = OFF_WINO + (size_t)2 * 3200 * 1024 * 2;
constexpr size_t OFF_W13  = OFF_WOUT + (size_t)4 * 1024 * 1024 * 2;
constexpr size_t OFF_W2T  = OFF_W13 + (size_t)32 * 1024 * 1024 * 2;
constexpr size_t OFF_OB   = OFF_W2T + (size_t)32 * 1024 * 512 * 2;
constexpr size_t OFF_AUX  = OFF_OB + (size_t)NT * 1024 * 2;
constexpr size_t WS_NEEDED = OFF_AUX + (size_t)NT * 16 * 4;

struct Params {
    const float* x; const float* c; const int* pos; const float* ada_w; const float* ada_b;
    const float* norm_mix; const float* norm_ffn; const float* even_w_in; const float* conv_w;
    const float* a_log; const float* dt_bias; const float* gdn_out_norm; const float* even_w_out;
    const float* gla_w_in; const float* gla_w_gate2; const float* gla_b_gate2; const float* gla_out_norm; const float* gla_w_out;
    const float* rg_w; const float* rg_b; const float* re_w; const float* re_b;
    const float* w1; const float* w3; const float* w2; const float* final_norm;
    float* X;
    unsigned char* ws;
    double rA, rI;
};

#define XB_TMO      128
#define XB_XCNT(j)  (256  + 64 * (j))
#define XB_XSUB(j)  (1280 + 64 * (j))
#define XB_XGEN(j)  (2304 + 64 * (j))
#define XB_TOP      3328
#define XB_TOPGEN   3392
#define XCD_BAR_WORDS 3456
#define XB_SPIN_CAP (1u << 18)
#define LAS __attribute__((address_space(3)))

__device__ __forceinline__ unsigned xb_ld(unsigned* p)              { return __hip_atomic_load(p, __ATOMIC_RELAXED, __HIP_MEMORY_SCOPE_AGENT); }
__device__ __forceinline__ unsigned xb_add(unsigned* p, unsigned v) { return __hip_atomic_fetch_add(p, v, __ATOMIC_RELAXED, __HIP_MEMORY_SCOPE_AGENT); }
__device__ __forceinline__ unsigned xb_xcc_id() { return (unsigned)__builtin_amdgcn_s_getreg((3 << 11) | 20) & 0xFu; }
#define XB_SPIN(cond, bar) do { unsigned _sp = 0; while (cond) { __builtin_amdgcn_s_sleep(1); \
    if ((++_sp & 255u) == 0u) { if (xb_ld(&(bar)[XB_TMO])) break; if (_sp > XB_SPIN_CAP) { atomicAdd(&(bar)[XB_TMO], 1u); break; } } } } while (0)

struct XcdBarrier { unsigned* bar; unsigned x; volatile LAS unsigned* st; };

__device__ __forceinline__ XcdBarrier xcd_barrier_post(unsigned* bar, volatile LAS unsigned* st) {
    XcdBarrier b; b.bar = bar; b.x = xb_xcc_id(); b.st = st;
    if (threadIdx.x == 0) (void)xb_add(&bar[XB_XCNT(b.x)], 1u);
    return b;
}
__device__ __forceinline__ void xcd_barrier_complete(unsigned* bar, unsigned x, unsigned& nloc, unsigned& nx) {
    const unsigned G = gridDim.x * gridDim.y * gridDim.z;
    unsigned sum, cnt, mine, sp = 0u;
    for (;;) {
        sum = 0u; cnt = 0u; mine = 0u;
#pragma unroll
        for (unsigned j = 0; j < 16; ++j) { const unsigned c = xb_ld(&bar[XB_XCNT(j)]); sum += c; cnt += (c > 0u) ? 1u : 0u; mine = (j == x) ? c : mine; }
        if (sum == G) break;
        __builtin_amdgcn_s_sleep(1);
        if ((++sp & 255u) == 0u) { if (xb_ld(&bar[XB_TMO])) break; if (sp > XB_SPIN_CAP) { atomicAdd(&bar[XB_TMO], 1u); break; } }
    }
    nloc = mine > 0u ? mine : 1u; nx = cnt > 0u ? cnt : 1u;
}
__device__ __forceinline__ void xcd_barrier(const XcdBarrier& b) {
    asm volatile("s_waitcnt vmcnt(0)" ::: "memory");
    __syncthreads();
    if (threadIdx.x == 0) {
        unsigned* bar = b.bar;
        __builtin_amdgcn_s_waitcnt(0);
        unsigned nloc = b.st[0], nx = b.st[1];
        if (nloc == 0u) { xcd_barrier_complete(bar, b.x, nloc, nx); b.st[0] = nloc; b.st[1] = nx; }
        const unsigned old = xb_add(&bar[XB_XSUB(b.x)], 1u);
        const unsigned gen = old / nloc;
        if (old + 1u == (gen + 1u) * nloc) {
            __builtin_amdgcn_fence(__ATOMIC_RELEASE, "agent");
            asm volatile("s_waitcnt vmcnt(0)" ::: "memory");
            const unsigned og = xb_add(&bar[XB_TOP], 1u);
            const unsigned tg = og / nx;
            if (og + 1u == (tg + 1u) * nx) xb_add(&bar[XB_TOPGEN], 1u);
            else XB_SPIN(xb_ld(&bar[XB_TOPGEN]) == tg, bar);
            __builtin_amdgcn_fence(__ATOMIC_ACQUIRE, "agent");
            xb_add(&bar[XB_XGEN(b.x)], 1u);
            asm volatile("s_waitcnt vmcnt(0)" ::: "memory");
        } else {
            XB_SPIN(xb_ld(&bar[XB_XGEN(b.x)]) == gen, bar);
            __builtin_amdgcn_fence(__ATOMIC_ACQUIRE, "agent");
            asm volatile("s_waitcnt vmcnt(0)" ::: "memory");
        }
    }
    __syncthreads();
}

__device__ __forceinline__ float wave_sum(float v) {
#pragma unroll
    for (int o = 32; o > 0; o >>= 1) v += __shfl_xor(v, o);
    return v;
}
__device__ __forceinline__ int wave_sum_i(int v) {
#pragma unroll
    for (int o = 32; o > 0; o >>= 1) v += __shfl_xor(v, o);
    return v;
}
__device__ __forceinline__ float wave_max(float v) {
#pragma unroll
    for (int o = 32; o > 0; o >>= 1) v = fmaxf(v, __shfl_xor(v, o));
    return v;
}
__device__ __forceinline__ float sigmoidf_(float x) { return 1.f / (1.f + expf(-x)); }
__device__ __forceinline__ float siluf_(float x) { return x / (1.f + expf(-x)); }
__device__ __forceinline__ float softplusf_(float x) { return fmaxf(x, 0.f) + log1pf(expf(-fabsf(x))); }
__device__ __forceinline__ unsigned ordkey(float f) { const unsigned u = __float_as_uint(f); return (u & 0x80000000u) ? ~u : (u | 0x80000000u); }

__device__ __forceinline__ void sincos_d(double a, double& s, double& c) {
    const double kq = rint(a * 0.63661977236758134308);
    double r = fma(-kq, 1.57079632673412561417e+00, a);
    r = fma(-kq, 6.07710050650619224932e-11, r);
    const int q = (int)((long long)kq & 3);
    const double r2 = r * r;
    const double sp = r * (1.0 + r2 * (-1.0 / 6 + r2 * (1.0 / 120 + r2 * (-1.0 / 5040 + r2 * (1.0 / 362880 + r2 * (-1.0 / 39916800 + r2 * (1.0 / 6227020800.0)))))));
    const double cp = 1.0 + r2 * (-0.5 + r2 * (1.0 / 24 + r2 * (-1.0 / 720 + r2 * (1.0 / 40320 + r2 * (-1.0 / 3628800 + r2 * (1.0 / 479001600.0 + r2 * (-1.0 / 87178291200.0)))))));
    if (q == 0) { s = sp; c = cp; } else if (q == 1) { s = cp; c = -sp; } else if (q == 2) { s = -sp; c = -cp; } else { s = -cp; c = sp; }
}
__device__ __forceinline__ double ipow_d(double b, int e) { double v = 1.0; while (e) { if (e & 1) v *= b; b *= b; e >>= 1; } return v; }

struct GemmArgs { const float* A; int lda; const int* rows; int m0; int mvalid; const float* B; int ldb; int n0; int N; int K; };

template <class Epi>
__device__ __forceinline__ void gemm128(const GemmArgs& g, float* smem, Epi epi) {
    float* As = smem;
    float* Bs = smem + 16 * 132;
    int tid_ = threadIdx.x; asm volatile("" : "+v"(tid_)); const int tid = tid_, ty = tid >> 4, tx = tid & 15;
    const int arow = tid >> 2, kq = (tid & 3) * 4;
    const int bk = tid >> 5, bn = (tid & 31) * 4;
    long asrc = -1;
    if (arow < g.mvalid) { const int r = g.rows ? g.rows[arow] : (g.m0 + arow); if (r >= 0) asrc = (long)r * g.lda; }
    const bool bval = (g.n0 + bn) < g.N;
    float acc[4][8];
#pragma unroll
    for (int i = 0; i < 4; ++i)
#pragma unroll
        for (int j = 0; j < 8; ++j) acc[i][j] = 0.f;
    for (int k0 = 0; k0 < g.K; k0 += 16) {
        float4 av = make_float4(0.f, 0.f, 0.f, 0.f), bv = make_float4(0.f, 0.f, 0.f, 0.f);
        if (asrc >= 0) av = *(const float4*)(g.A + asrc + k0 + kq);
        if (bval) bv = *(const float4*)(g.B + (size_t)(k0 + bk) * g.ldb + g.n0 + bn);
        __syncthreads();
        As[(kq + 0) * 132 + arow] = av.x; As[(kq + 1) * 132 + arow] = av.y; As[(kq + 2) * 132 + arow] = av.z; As[(kq + 3) * 132 + arow] = av.w;
        *(float4*)&Bs[bk * 132 + bn] = bv;
        __syncthreads();
#pragma unroll
        for (int kk = 0; kk < 16; ++kk) {
            const float4 a = *(const float4*)&As[kk * 132 + ty * 4];
            const float4 b0 = *(const float4*)&Bs[kk * 132 + tx * 8];
            const float4 b1 = *(const float4*)&Bs[kk * 132 + tx * 8 + 4];
            const float aa[4] = {a.x, a.y, a.z, a.w};
            const float bb[8] = {b0.x, b0.y, b0.z, b0.w, b1.x, b1.y, b1.z, b1.w};
#pragma unroll
            for (int i = 0; i < 4; ++i)
#pragma unroll
                for (int j = 0; j < 8; ++j) acc[i][j] += aa[i] * bb[j];
        }
    }
#pragma unroll
    for (int i = 0; i < 4; ++i) {
        const int r = ty * 4 + i;
        if (r < g.mvalid) {
#pragma unroll
            for (int j = 0; j < 8; ++j) { const int n = g.n0 + tx * 8 + j; if (n < g.N) epi(r, n, acc[i][j]); }
        }
    }
}


typedef short bf16x8 __attribute__((ext_vector_type(8)));
typedef float f32x4 __attribute__((ext_vector_type(4)));
typedef unsigned short bf16_t;
typedef __bf16 bf16x2_t __attribute__((ext_vector_type(2)));
typedef float f32x2_t __attribute__((ext_vector_type(2)));
__device__ __forceinline__ unsigned cvt_pk_bf16(float lo, float hi) { const f32x2_t v = {lo, hi}; const bf16x2_t r = __builtin_convertvector(v, bf16x2_t); return __builtin_bit_cast(unsigned, r); }
__device__ __forceinline__ bf16_t f2bf(float f) { return (bf16_t)(cvt_pk_bf16(f, 0.f) & 0xffffu); }
__device__ __forceinline__ float bf16_to_f32(bf16_t v) { return __uint_as_float(((unsigned)v) << 16); }
__device__ __forceinline__ uint2 pack4(const f32x4 v) { uint2 r; r.x = cvt_pk_bf16(v[0], v[1]); r.y = cvt_pk_bf16(v[2], v[3]); return r; }
__device__ __forceinline__ f32x4 unpack4(const uint2 u) { f32x4 r; r[0] = __uint_as_float(u.x << 16); r[1] = __uint_as_float(u.x & 0xffff0000u); r[2] = __uint_as_float(u.y << 16); r[3] = __uint_as_float(u.y & 0xffff0000u); return r; }
#define PBF(Pb_, t_, c_) bf16_to_f32((Pb_)[(size_t)(t_) * LDPB + (c_)])
__device__ __forceinline__ uint4 pack8(const float4 a, const float4 b) { uint4 r; r.x = cvt_pk_bf16(a.x, a.y); r.y = cvt_pk_bf16(a.z, a.w); r.z = cvt_pk_bf16(b.x, b.y); r.w = cvt_pk_bf16(b.z, b.w); return r; }
__device__ __forceinline__ int lds_off(int r, int c) { return r * 128 + ((c ^ (r & 7)) << 4); }

template <class ALoad, class BLoad, class Epi>
__device__ __forceinline__ void gemm_tile_bf16(const int K, unsigned char* lds, ALoad aload, BLoad bload, Epi epi) {
    int tid_ = threadIdx.x; asm volatile("" : "+v"(tid_)); const int tid = tid_, lane = tid & 63, wid = tid >> 6, wm = wid >> 1, wn = wid & 1;
    f32x4 acc[4][4];
#pragma unroll
    for (int mi = 0; mi < 4; ++mi)
#pragma unroll
        for (int ni = 0; ni < 4; ++ni) acc[mi][ni] = (f32x4){0.f, 0.f, 0.f, 0.f};
    uint4 ra[4], rb[2];
    const int nk = K >> 6;
#pragma unroll
    for (int i = 0; i < 4; ++i) { const int q = tid + 512 * i; ra[i] = aload(i, q >> 3, (q & 7) * 8); }
#pragma unroll
    for (int i = 0; i < 2; ++i) { const int q = tid + 512 * i; rb[i] = bload(i, q >> 3, (q & 7) * 8); }
    __syncthreads();
#pragma unroll
    for (int i = 0; i < 4; ++i) { const int q = tid + 512 * i; *(uint4*)(lds + lds_off(q >> 3, q & 7)) = ra[i]; }
#pragma unroll
    for (int i = 0; i < 2; ++i) { const int q = tid + 512 * i; *(uint4*)(lds + 32768 + lds_off(q >> 3, q & 7)) = rb[i]; }
    __syncthreads();
    for (int kt = 0; kt < nk; ++kt) {
        if (kt + 1 < nk) {
#pragma unroll
            for (int i = 0; i < 4; ++i) { const int q = tid + 512 * i; ra[i] = aload(i, q >> 3, (kt + 1) * 64 + (q & 7) * 8); }
#pragma unroll
            for (int i = 0; i < 2; ++i) { const int q = tid + 512 * i; rb[i] = bload(i, q >> 3, (kt + 1) * 64 + (q & 7) * 8); }
        }
        const unsigned char* At = lds + (kt & 1) * 49152;
        const unsigned char* Bt = At + 32768;
#pragma unroll
        for (int ks = 0; ks < 2; ++ks) {
            bf16x8 af[4], bfr[4];
            const int c = ks * 4 + (lane >> 4);
#pragma unroll
            for (int mi = 0; mi < 4; ++mi) af[mi] = *(const bf16x8*)(At + lds_off(wm * 64 + mi * 16 + (lane & 15), c));
#pragma unroll
            for (int ni = 0; ni < 4; ++ni) bfr[ni] = *(const bf16x8*)(Bt + lds_off(wn * 64 + ni * 16 + (lane & 15), c));
#pragma unroll
            for (int mi = 0; mi < 4; ++mi)
#pragma unroll
                for (int ni = 0; ni < 4; ++ni) acc[mi][ni] = __builtin_amdgcn_mfma_f32_16x16x32_bf16(bfr[ni], af[mi], acc[mi][ni], 0, 0, 0);
        }
        if (kt + 1 < nk) {
            unsigned char* An = lds + ((kt + 1) & 1) * 49152;
#pragma unroll
            for (int i = 0; i < 4; ++i) { const int q = tid + 512 * i; *(uint4*)(An + lds_off(q >> 3, q & 7)) = ra[i]; }
#pragma unroll
            for (int i = 0; i < 2; ++i) { const int q = tid + 512 * i; *(uint4*)(An + 32768 + lds_off(q >> 3, q & 7)) = rb[i]; }
        }
        __syncthreads();
    }
    epi(acc, wm, wn, lane);
}

__device__ __forceinline__ void convert_tile(const float* src0, const float* src1, int mode, int K, int N, int ld, bf16_t* dst, int rt, int kt, float* smem) {
    int tid_ = threadIdx.x; asm volatile("" : "+v"(tid_)); const int tid = tid_;
    __syncthreads();
    { const int k = tid >> 3, R0 = rt * 64 + (tid & 7) * 8;
      const float* sp; int col;
      if (mode == 0) { sp = src0; col = R0; } else { sp = (R0 & 32) ? src1 : src0; col = (R0 >> 6) * 32 + (R0 & 31); }
      float4 a = make_float4(0.f, 0.f, 0.f, 0.f), b = a;
      const float* rp = sp + (size_t)(kt * 64 + k) * ld + col;
      if (col < N) a = *(const float4*)rp;
      if (col + 4 < N) b = *(const float4*)(rp + 4);
      float* d = smem + k * 65 + (tid & 7) * 8;
      d[0] = a.x; d[1] = a.y; d[2] = a.z; d[3] = a.w; d[4] = b.x; d[5] = b.y; d[6] = b.z; d[7] = b.w; }
    __syncthreads();
    { const int R = tid >> 3, kc = (tid & 7) * 8;
      float v[8];
#pragma unroll
      for (int j = 0; j < 8; ++j) v[j] = smem[(kc + j) * 65 + R];
      uint4 o; o.x = cvt_pk_bf16(v[0], v[1]); o.y = cvt_pk_bf16(v[2], v[3]); o.z = cvt_pk_bf16(v[4], v[5]); o.w = cvt_pk_bf16(v[6], v[7]);
      *(uint4*)(dst + (size_t)(rt * 64 + R) * K + kt * 64 + kc) = o; }
}

#define CT_LOAD(S0, S1, MODE, NN, LD, RT, KT, A, B) do { const int k_ = tid >> 3, R0_ = (RT) * 64 + (tid & 7) * 8; const float* sp_; int col_; \
        if ((MODE) == 0) { sp_ = (S0); col_ = R0_; } else { sp_ = (R0_ & 32) ? (S1) : (S0); col_ = (R0_ >> 6) * 32 + (R0_ & 31); } \
        A = make_float4(0.f, 0.f, 0.f, 0.f); B = A; const float* rp_ = sp_ + (size_t)((KT) * 64 + k_) * (LD) + col_; \
        if (col_ < (NN)) A = *(const float4*)rp_; if (col_ + 4 < (NN)) B = *(const float4*)(rp_ + 4); } while (0)
#define CT_WRITE(BUF, A, B) do { float* d_ = smem + (BUF) * 4160 + (tid >> 3) * 65 + (tid & 7) * 8; \
        d_[0] = A.x; d_[1] = A.y; d_[2] = A.z; d_[3] = A.w; d_[4] = B.x; d_[5] = B.y; d_[6] = B.z; d_[7] = B.w; } while (0)
#define CT_STORE(DST, KK, RT, KT, BUF) do { const int R_ = tid >> 3, kc_ = (tid & 7) * 8; const float* sb_ = smem + (BUF) * 4160; \
        uint4 o_; o_.x = cvt_pk_bf16(sb_[(kc_ + 0) * 65 + R_], sb_[(kc_ + 1) * 65 + R_]); o_.y = cvt_pk_bf16(sb_[(kc_ + 2) * 65 + R_], sb_[(kc_ + 3) * 65 + R_]); \
        o_.z = cvt_pk_bf16(sb_[(kc_ + 4) * 65 + R_], sb_[(kc_ + 5) * 65 + R_]); o_.w = cvt_pk_bf16(sb_[(kc_ + 6) * 65 + R_], sb_[(kc_ + 7) * 65 + R_]); \
        *(uint4*)((DST) + (size_t)((RT) * 64 + R_) * (KK) + (KT) * 64 + kc_) = o_; } while (0)
#define CT_DECL(I) const float* s0_##I; const float* s1_##I; bf16_t* d_##I; int md_##I, K_##I, N_##I, ld_##I, rt_##I, kt_##I
#define CT_ARGS(I) s0_##I, s1_##I, d_##I, md_##I, K_##I, N_##I, ld_##I, rt_##I, kt_##I
template <class Dec>
__device__ __forceinline__ void convert_tiles4(const Dec& dec, int t, int nj, float* smem) {
    int tid_ = threadIdx.x; asm volatile("" : "+v"(tid_)); const int tid = tid_;
    CT_DECL(0); CT_DECL(1); CT_DECL(2); CT_DECL(3);
    dec(t, CT_ARGS(0)); dec(t + 1, CT_ARGS(1)); dec(t + 2, CT_ARGS(2)); dec(t + 3, CT_ARGS(3));
    float4 a0, b0, a1, b1, a2, b2, a3, b3;
    a1 = b1 = a2 = b2 = a3 = b3 = make_float4(0.f, 0.f, 0.f, 0.f);
    CT_LOAD(s0_0, s1_0, md_0, N_0, ld_0, rt_0, kt_0, a0, b0);
    if (nj > 1) CT_LOAD(s0_1, s1_1, md_1, N_1, ld_1, rt_1, kt_1, a1, b1);
    if (nj > 2) CT_LOAD(s0_2, s1_2, md_2, N_2, ld_2, rt_2, kt_2, a2, b2);
    if (nj > 3) CT_LOAD(s0_3, s1_3, md_3, N_3, ld_3, rt_3, kt_3, a3, b3);
    __syncthreads();
    CT_WRITE(0, a0, b0); CT_WRITE(1, a1, b1); CT_WRITE(2, a2, b2); CT_WRITE(3, a3, b3);
    __syncthreads();
    CT_STORE(d_0, K_0, rt_0, kt_0, 0);
    if (nj > 1) CT_STORE(d_1, K_1, rt_1, kt_1, 1);
    if (nj > 2) CT_STORE(d_2, K_2, rt_2, kt_2, 2);
    if (nj > 3) CT_STORE(d_3, K_3, rt_3, kt_3, 3);
}

extern __shared__ __attribute__((aligned(16))) unsigned char g_smem[];
#define PHASE_FN __device__ __forceinline__
enum { PH_PROLOGUE = 0, PH_NORM_MIX, PH_GEMM_IN_EVEN, PH_EVEN_TOK, PH_GDN_CHUNK, PH_GDN_SCAN, PH_DSA_TOPK, PH_DSA_ATTN, PH_GDN_OUT,
       PH_GEMM_OUT, PH_NORM_FFN, PH_MOE1, PH_MOE2, PH_GEMM_IN_ODD, PH_GLA_TOK, PH_GLA_CHUNK, PH_GLA_SCAN, PH_GLA_OUT, PH_FINAL };

PHASE_FN void ph_prologue(const Params& p, float* smem) {
    unsigned char* ws_ = p.ws; asm volatile("" : "+s"(ws_));
    { int ldz_ = 0; asm volatile("" : "+s"(ldz_)); smem = (float*)(g_smem + ldz_); }
    int tid_ = threadIdx.x; asm volatile("" : "+v"(tid_)); const int tid = tid_, nthr = gridDim.x * NTHREADS, gid = blockIdx.x * NTHREADS + tid;
    for (int i = tid; i < 2 * ND; i += NTHREADS) smem[i] = siluf_(p.c[i]);
    __syncthreads();
    float* MOD = (float*)(ws_ + OFF_MOD);
    { float* red = smem + 2048;
      const int lane = tid & 63, wv = tid >> 6;
      for (int item = blockIdx.x; item < 4 * 96; item += gridDim.x) {
          const int l = item / 96, n = (item % 96) * 64 + lane;
          const float* w = p.ada_w + (size_t)l * ND * 6144 + n;
          float a0 = 0.f, a1 = 0.f;
#pragma unroll 8
          for (int k = wv * 128; k < wv * 128 + 128; ++k) { const float wv_ = w[(size_t)k * 6144]; a0 += smem[k] * wv_; a1 += smem[ND + k] * wv_; }
          __syncthreads();
          red[(wv * 64 + lane) * 2] = a0; red[(wv * 64 + lane) * 2 + 1] = a1;
          __syncthreads();
          if (tid < 128) { const int c = tid >> 1, bb = tid & 1; float a = 0.f; for (int w8 = 0; w8 < 8; ++w8) a += red[(w8 * 64 + c) * 2 + bb];
              MOD[(l * 2 + bb) * 6144 + (item % 96) * 64 + c] = a + p.ada_b[l * 6144 + (item % 96) * 64 + c]; }
      }
      __syncthreads(); }
    float* COSA = (float*)(ws_ + OFF_COSA); float* SINA = (float*)(ws_ + OFF_SINA);
    float* COSI = (float*)(ws_ + OFF_COSI); float* SINI = (float*)(ws_ + OFF_SINI);
    for (size_t i = gid; i < (size_t)NT * 64; i += nthr) {
        const int t = (int)(i >> 6), j = (int)(i & 63);
        double s, c; sincos_d((double)p.pos[t] * ipow_d(p.rA, j), s, c);
        COSA[i] = (float)c; SINA[i] = (float)s;
    }
    for (size_t i = gid; i < (size_t)NT * 32; i += nthr) {
        const int t = (int)(i >> 5), j = (int)(i & 31);
        double s, c; sincos_d((double)p.pos[t] * ipow_d(p.rI, j), s, c);
        COSI[i] = (float)c; SINI[i] = (float)s;
    }
}

PHASE_FN void ph_rows(const Params& p, int layer, int mode, float* smem) {
    unsigned char* ws_ = p.ws; asm volatile("" : "+s"(ws_));
    { int ldz_ = 0; asm volatile("" : "+s"(ldz_)); smem = (float*)(g_smem + ldz_); }
    int tid_ = threadIdx.x; asm volatile("" : "+v"(tid_)); const int tid = tid_, lane = tid & 63, wv = tid >> 6;
    int* pad = (int*)smem;
    const int moe_layer = (mode == 1) ? 3 : layer - 1;
    if (moe_layer >= 0) {
        if (tid == 0) { const int* cnt = (const int*)(ws_ + OFF_CNT) + moe_layer * 32 * CSTR; int a = 0; for (int e = 0; e < 32; ++e) { pad[e] = a; a += ((cnt[e * CSTR] + 127) / 128) * 128; } }
        __syncthreads();
    }
    const float* MOD = (const float*)(ws_ + OFF_MOD);
    bf16_t* H = (bf16_t*)(ws_ + OFF_H);
    const float* YB = (const float*)(ws_ + OFF_YB);
    const int* ASG = (const int*)(ws_ + OFF_ASG);
    const float* GATE = (const float*)(ws_ + OFF_GATE);
    for (int row = blockIdx.x * 8 + wv; row < NT; row += gridDim.x * 8) {
        const int b = row >> 13;
        float* xr = p.X + (size_t)row * ND;
        const float* xin = (mode == 0 && layer == 0) ? (p.x + (size_t)row * ND) : xr;
        float xv[16];
#pragma unroll
        for (int j = 0; j < 4; ++j) { const float4 v = *(const float4*)(xin + j * 256 + lane * 4); xv[4 * j] = v.x; xv[4 * j + 1] = v.y; xv[4 * j + 2] = v.z; xv[4 * j + 3] = v.w; }
        if (moe_layer >= 0) {
            const float* gt = MOD + (size_t)(moe_layer * 2 + b) * 6144 + 5 * 1024;
            const int e0 = ASG[row * 4 + 0], r0 = ASG[row * 4 + 1], e1 = ASG[row * 4 + 2], r1 = ASG[row * 4 + 3];
            const float g0 = GATE[row * 2], g1 = GATE[row * 2 + 1];
            const float* y0 = YB + (size_t)(pad[e0] + r0) * ND;
            const float* y1 = YB + (size_t)(pad[e1] + r1) * ND;
#pragma unroll
            for (int j = 0; j < 4; ++j) {
                const int col = j * 256 + lane * 4;
                const float4 a = *(const float4*)(y0 + col), bq = *(const float4*)(y1 + col), g = *(const float4*)(gt + col);
                xv[4 * j] += g.x * (g0 * a.x + g1 * bq.x); xv[4 * j + 1] += g.y * (g0 * a.y + g1 * bq.y);
                xv[4 * j + 2] += g.z * (g0 * a.z + g1 * bq.z); xv[4 * j + 3] += g.w * (g0 * a.w + g1 * bq.w);
                if (mode == 0) *(float4*)(xr + col) = make_float4(xv[4 * j], xv[4 * j + 1], xv[4 * j + 2], xv[4 * j + 3]);
            }
        }
        float ss = 0.f;
#pragma unroll
        for (int j = 0; j < 16; ++j) ss += xv[j] * xv[j];
        ss = wave_sum(ss);
        const float rstd = rsqrtf(ss * (1.f / 1024.f) + EPS);
        if (mode == 0) {
            const float* nw = p.norm_mix + layer * 1024;
            const float* sh = MOD + (size_t)(layer * 2 + b) * 6144;
            const float* sc = sh + 1024;
#pragma unroll
            for (int j = 0; j < 4; ++j) {
                const int col = j * 256 + lane * 4;
                const float4 w = *(const float4*)(nw + col), s4 = *(const float4*)(sc + col), h4 = *(const float4*)(sh + col);
                float4 o;
                o.x = xv[4 * j] * rstd * w.x * (1.f + s4.x) + h4.x; o.y = xv[4 * j + 1] * rstd * w.y * (1.f + s4.y) + h4.y;
                o.z = xv[4 * j + 2] * rstd * w.z * (1.f + s4.z) + h4.z; o.w = xv[4 * j + 3] * rstd * w.w * (1.f + s4.w) + h4.w;
                { f32x4 ov; ov[0] = o.x; ov[1] = o.y; ov[2] = o.z; ov[3] = o.w; *(uint2*)(H + (size_t)row * ND + col) = pack4(ov); }
            }
        } else {
#pragma unroll
            for (int j = 0; j < 4; ++j) {
                const int col = j * 256 + lane * 4;
                const float4 w = *(const float4*)(p.final_norm + col);
                *(float4*)(xr + col) = make_float4(xv[4 * j] * rstd * w.x, xv[4 * j + 1] * rstd * w.y, xv[4 * j + 2] * rstd * w.z, xv[4 * j + 3] * rstd * w.w);
            }
        }
    }
}

PHASE_FN void ph_gemm_in(const Params& p, int layer, bool even, float* smem) {
    unsigned char* ws_ = p.ws; asm volatile("" : "+s"(ws_));
    { int ldz_ = 0; asm volatile("" : "+s"(ldz_)); smem = (float*)(g_smem + ldz_); }
    const int N = even ? 3916 : 3088, ntn = even ? 31 : 25;
    const bf16_t* Wt = even ? (const bf16_t*)(ws_ + OFF_WINE) + (size_t)(layer >> 1) * 3968 * 1024 : (const bf16_t*)(ws_ + OFF_WINO) + (size_t)(layer >> 1) * 3200 * 1024;
    const bf16_t* H = (const bf16_t*)(ws_ + OFF_H);
    bf16_t* P = (bf16_t*)(ws_ + OFF_P);
    float* AUX = (float*)(ws_ + OFF_AUX);
    for (int tile = blockIdx.x; tile < 64 * ntn; tile += gridDim.x) {
        const int mt = tile % 64, nt = tile / 64;
        const bf16_t* Ab = H + (size_t)mt * 256 * 1024;
        const bf16_t* Bb = Wt + (size_t)nt * 128 * 1024;
        bf16_t* Pt = P + (size_t)mt * 256 * LDPB + nt * 128;
        float* At = AUX + (size_t)mt * 256 * 16;
        const int ncol0 = nt * 128;
        const int nrem = N - nt * 128;
        gemm_tile_bf16(1024, (unsigned char*)smem,
            [=](int i, int r, int k) -> uint4 { return *(const uint4*)(Ab + (size_t)r * 1024 + k); },
            [=](int i, int r, int k) -> uint4 { return *(const uint4*)(Bb + (size_t)r * 1024 + k); },
            [=](const f32x4 (&acc)[4][4], int wm, int wn, int lane) {
#pragma unroll
                for (int mi = 0; mi < 4; ++mi)
#pragma unroll
                    for (int ni = 0; ni < 4; ++ni) {
                        const int m = wm * 64 + mi * 16 + (lane & 15), n = wn * 64 + ni * 16 + 4 * (lane >> 4);
                        if (n < nrem) {
                            *(uint2*)(Pt + (size_t)m * LDPB + n) = pack4(acc[mi][ni]);
                            const int gc = ncol0 + n;
                            int ax = -1;
                            if (even) { if (gc == 2048) ax = 0; else if (gc == 2052) ax = 4; else if (gc == 3912) ax = 8; }
                            else { if (gc >= 3072 && gc < 3088) ax = gc - 3072; }
                            if (ax >= 0) *(f32x4*)(At + (size_t)m * 16 + ax) = acc[mi][ni];
                        }
                    }
            });
    }
}

PHASE_FN void ph_even_tok(const Params& p, int layer, float* smem) {
    unsigned char* ws_ = p.ws; asm volatile("" : "+s"(ws_));
    { int ldz_ = 0; asm volatile("" : "+s"(ldz_)); smem = (float*)(g_smem + ldz_); }
    int tid_ = threadIdx.x; asm volatile("" : "+v"(tid_)); const int tid = tid_, lane = tid & 63, wv = tid >> 6, li = layer >> 1;
    const bf16_t* P = (const bf16_t*)(ws_ + OFF_P); const float* AUX = (const float*)(ws_ + OFF_AUX);
    bf16_t* QB = (bf16_t*)(ws_ + OFF_QBB); bf16_t* KB = (bf16_t*)(ws_ + OFF_KBB); bf16_t* QI = (bf16_t*)(ws_ + OFF_QIB); bf16_t* KI = (bf16_t*)(ws_ + OFF_KIB); float* WI = (float*)(ws_ + OFF_WI);
    const float* COSA = (const float*)(ws_ + OFF_COSA); const float* SINA = (const float*)(ws_ + OFF_SINA);
    const float* COSI = (const float*)(ws_ + OFF_COSI); const float* SINI = (const float*)(ws_ + OFF_SINI);
    for (int t = blockIdx.x * 8 + wv; t < NT; t += gridDim.x * 8) {
        const bf16_t* Pt = P + (size_t)t * LDPB;
        if (lane < 4) {
            WI[t * 4 + lane] = AUX[(size_t)t * 16 + 8 + lane] * 0.0625f;
        }
        { const float c = COSA[(size_t)t * 64 + lane], sn = SINA[(size_t)t * 64 + lane];
#pragma unroll
          for (int h = 0; h < 4; ++h) {
              float t1 = bf16_to_f32(Pt[2056 + h * 128 + lane]), t2 = bf16_to_f32(Pt[2056 + h * 128 + 64 + lane]);
              QB[(size_t)t * 512 + h * 128 + lane] = f2bf(t1 * c - t2 * sn); QB[(size_t)t * 512 + h * 128 + 64 + lane] = f2bf(t2 * c + t1 * sn);
              t1 = bf16_to_f32(Pt[2568 + h * 128 + lane]); t2 = bf16_to_f32(Pt[2568 + h * 128 + 64 + lane]);
              KB[(size_t)t * 512 + h * 128 + lane] = f2bf(t1 * c - t2 * sn); KB[(size_t)t * 512 + h * 128 + 64 + lane] = f2bf(t2 * c + t1 * sn);
          } }
#pragma unroll
        for (int r = 0; r < 2; ++r) {
            const int item = lane + 64 * r, hh = item >> 5, ii = item & 31;
            const float c = COSI[(size_t)t * 32 + ii], sn = SINI[(size_t)t * 32 + ii];
            const float t1 = bf16_to_f32(Pt[3592 + hh * 64 + ii]), t2 = bf16_to_f32(Pt[3592 + hh * 64 + 32 + ii]);
            QI[(size_t)t * 256 + hh * 64 + ii] = f2bf(t1 * c - t2 * sn); QI[(size_t)t * 256 + hh * 64 + 32 + ii] = f2bf(t2 * c + t1 * sn);
        }
        if (lane < 32) {
            const float c = COSI[(size_t)t * 32 + lane], sn = SINI[(size_t)t * 32 + lane];
            const float t1 = bf16_to_f32(Pt[3848 + lane]), t2 = bf16_to_f32(Pt[3848 + 32 + lane]);
            KI[(size_t)t * 64 + lane] = f2bf(t1 * c - t2 * sn); KI[(size_t)t * 64 + 32 + lane] = f2bf(t2 * c + t1 * sn);
        }
    }
    { bf16_t* VT = (bf16_t*)(ws_ + OFF_VT);
      bf16_t* sv = (bf16_t*)g_smem;
      for (int item = blockIdx.x; item < 2 * 128 * 4; item += gridDim.x) {
          const int h = item & 3, tt = item >> 2, b = tt >> 7, s0 = (tt & 127) * 64;
          __syncthreads();
          for (int e = tid; e < 64 * 128; e += NTHREADS) { const int i = e >> 7, d = e & 127; sv[d * 72 + i] = P[(size_t)(b * 8192 + s0 + i) * LDPB + 3080 + h * 128 + d]; }
          __syncthreads();
          for (int e = tid; e < 128 * 8; e += NTHREADS) { const int d = e >> 3, c = e & 7;
              *(uint4*)(VT + ((size_t)((b * 4 + h) * 128 + d)) * 8192 + s0 + c * 8) = *(const uint4*)(sv + d * 72 + c * 8); }
      } }
}

__device__ __forceinline__ f32x4 mma_lds(const unsigned char* A, int sa, int a0, const unsigned char* B, int sb, int b0, int K, f32x4 acc, int c16, int q4) {
    const unsigned char* ap = A + (a0 + c16) * sa + q4 * 16;
    const unsigned char* bp = B + (b0 + c16) * sb + q4 * 16;
    for (int kk = 0; kk < K; kk += 32) { acc = __builtin_amdgcn_mfma_f32_16x16x32_bf16(*(const bf16x8*)(ap + kk * 2), *(const bf16x8*)(bp + kk * 2), acc, 0, 0, 0); }
    return acc;
}

PHASE_FN void ph_gdn_chunk(const Params& p, int layer, float* smem) {
    unsigned char* ws_ = p.ws; asm volatile("" : "+s"(ws_));
    int tid_ = threadIdx.x; asm volatile("" : "+v"(tid_)); const int tid = tid_, lane = tid & 63, wv = __builtin_amdgcn_readfirstlane(tid >> 6), q4 = lane >> 4, c16 = lane & 15;
    int ldz_ = 0; asm volatile("" : "+s"(ldz_)); unsigned char* lds = g_smem + ldz_;
    constexpr int SN = 272, ST = 144;
    unsigned char* bKN = lds;
    unsigned char* bQN = lds + 18432;
    unsigned char* bKBG = lds + 35840;
    unsigned char* bVB = lds + 54272;
    unsigned char* bKD = lds + 72704;
    unsigned char* bUT = lds + 91136;
    float* sL = (float*)(lds + 109568);
    unsigned char* bAQK = lds + 126208;
    unsigned char* bTB = lds + 135424;
    float* sG = (float*)(lds + 144640); float* sB = sG + 64; float* sEg = sB + 64;
    const int li = layer >> 1;
    const bf16_t* P = (const bf16_t*)(ws_ + OFF_P); const float* AUX = (const float*)(ws_ + OFF_AUX);
    const float* cw = p.conv_w + (size_t)li * 4 * 1536;
    uint4* PFR = (uint4*)(ws_ + OFF_PFR); uint4* RFR = (uint4*)(ws_ + OFF_RFR); uint2* QFR = (uint2*)(ws_ + OFF_QFR); uint2* OFR = (uint2*)(ws_ + OFF_OFR);
    float* GL = (float*)(ws_ + OFF_GL);
    for (int ci = blockIdx.x; ci < 1024; ci += gridDim.x) {
        const int b = ci >> 9, h = (ci >> 7) & 3, n = ci & 127;
        const int t0 = b * 8192 + n * 64;
        __syncthreads();
        if (tid < 64) { float g = -expf(p.a_log[li * 4 + h]) * softplusf_(AUX[(size_t)(t0 + tid) * 16 + 4 + h] + p.dt_bias[li * 4 + h]);
#pragma unroll
            for (int o = 1; o < 64; o <<= 1) { const float nb = __shfl_up(g, o); if (lane >= o) g += nb; }
            sG[tid] = g; sB[tid] = sigmoidf_(AUX[(size_t)(t0 + tid) * 16 + h]); sEg[tid] = expf(g); }
        for (int e = tid; e < 64 * 36; e += NTHREADS) ((unsigned*)bAQK)[e] = 0u;
        __syncthreads();
        const float gl = sG[63];
        {
            const int d0 = 2 * lane, cb = h * 128 + d0, s00 = n * 64;
            float wq[4][2], wk[4][2], wvv[4][2];
#pragma unroll
            for (int jj = 0; jj < 4; ++jj) { wq[jj][0] = cw[jj * 1536 + cb]; wq[jj][1] = cw[jj * 1536 + cb + 1]; wk[jj][0] = cw[jj * 1536 + 512 + cb]; wk[jj][1] = cw[jj * 1536 + 512 + cb + 1];
                                            wvv[jj][0] = cw[jj * 1536 + 1024 + cb]; wvv[jj][1] = cw[jj * 1536 + 1024 + cb + 1]; }
#pragma unroll 2
            for (int r = 0; r < 8; ++r) {
                const int i = wv + 8 * r;
                float aq0 = 0.f, aq1 = 0.f, ak0 = 0.f, ak1 = 0.f, av0 = 0.f, av1 = 0.f;
#pragma unroll
                for (int jj = 0; jj < 4; ++jj) {
                    if (s00 + i - 3 + jj >= 0) {
                        const bf16_t* rp = P + (size_t)(t0 + i - 3 + jj) * LDPB + cb;
                        const unsigned uq = *(const unsigned*)rp, uk = *(const unsigned*)(rp + 512), uv = *(const unsigned*)(rp + 1024);
                        aq0 += wq[jj][0] * __uint_as_float(uq << 16); aq1 += wq[jj][1] * __uint_as_float(uq & 0xffff0000u);
                        ak0 += wk[jj][0] * __uint_as_float(uk << 16); ak1 += wk[jj][1] * __uint_as_float(uk & 0xffff0000u);
                        av0 += wvv[jj][0] * __uint_as_float(uv << 16); av1 += wvv[jj][1] * __uint_as_float(uv & 0xffff0000u);
                    }
                }
                aq0 = siluf_(aq0); aq1 = siluf_(aq1); ak0 = siluf_(ak0); ak1 = siluf_(ak1); av0 = siluf_(av0); av1 = siluf_(av1);
                const float rq = rsqrtf(wave_sum(aq0 * aq0 + aq1 * aq1) + EPS), rk = rsqrtf(wave_sum(ak0 * ak0 + ak1 * ak1) + EPS);
                aq0 *= rq; aq1 *= rq; ak0 *= rk; ak1 *= rk;
                const float be = sB[i], eg_i = sEg[i], ekd = expf(gl - sG[i]);
                *(unsigned*)(bKN + i * SN + d0 * 2) = cvt_pk_bf16(ak0, ak1);
                *(unsigned*)(bQN + i * SN + d0 * 2) = cvt_pk_bf16(aq0, aq1);
                *(bf16_t*)(bKBG + d0 * ST + i * 2) = f2bf(ak0 * be * eg_i); *(bf16_t*)(bKBG + (d0 + 1) * ST + i * 2) = f2bf(ak1 * be * eg_i);
                *(bf16_t*)(bVB + d0 * ST + i * 2) = f2bf(av0 * be); *(bf16_t*)(bVB + (d0 + 1) * ST + i * 2) = f2bf(av1 * be);
                *(bf16_t*)(bKD + d0 * ST + i * 2) = f2bf(ak0 * ekd); *(bf16_t*)(bKD + (d0 + 1) * ST + i * 2) = f2bf(ak1 * ekd);
            }
        }
        __syncthreads();
        for (int u = wv; u < 20; u += 8) {
            const int kind = (u >= 10) ? 1 : 0, idx = u - kind * 10;
            const int ti = (idx >= 6) ? 3 : (idx >= 3) ? 2 : (idx >= 1) ? 1 : 0, tj = idx - ((ti * (ti + 1)) >> 1);
            f32x4 acc = (f32x4){0.f, 0.f, 0.f, 0.f};
            acc = mma_lds(kind ? bQN : bKN, SN, 16 * ti, bKN, SN, 16 * tj, 128, acc, c16, q4);
            const int j = 16 * tj + c16;
#pragma unroll
            for (int r = 0; r < 4; ++r) { const int i = 16 * ti + 4 * q4 + r;
                const float dec = (j <= i) ? expf(sG[i] - sG[j]) : 0.f;
                if (kind == 0) sL[i * 65 + j] = (j < i) ? sB[i] * acc[r] * dec : 0.f;
                else *(bf16_t*)(bAQK + i * ST + j * 2) = f2bf(acc[r] * SCALE128 * dec); }
        }
        __syncthreads();
        if (wv == 0) {
            float t[64];
            int zz = 0; asm volatile("" : "+v"(zz)); const float* sLo = sL + zz;
#pragma unroll
            for (int i = 0; i < 64; ++i) { float a = (i == lane) ? 1.f : 0.f;
#pragma unroll
                for (int j = 0; j < i; ++j) a -= sLo[i * 65 + j] * t[j];
                t[i] = a; asm volatile("" ::: "memory"); }
#pragma unroll
            for (int i = 0; i < 64; ++i) *(bf16_t*)(bTB + i * ST + lane * 2) = f2bf(t[i]);
        }
        __syncthreads();
        for (int x = 0; x < 8; ++x) {
            const int u = wv * 8 + x, kind = u >> 5, ti = (u >> 3) & 3, td = u & 7;
            f32x4 acc = (f32x4){0.f, 0.f, 0.f, 0.f};
            acc = mma_lds(bTB, ST, 16 * ti, kind ? bVB : bKBG, ST, 16 * td, 64, acc, c16, q4);
            *(uint2*)((kind ? bUT : bKN) + (16 * td + c16) * ST + (16 * ti + 4 * q4) * 2) = pack4(acc);
        }
        __syncthreads();
        unsigned char* bWT = bKN;
        const float eg = expf(gl);
        for (int x = 0; x < 4; ++x) {
            const int u = wv * 4 + x, ti = u >> 2, a = u & 3;
            uint4 fr;
#pragma unroll
            for (int hf = 0; hf < 2; ++hf) { const int tk = 2 * a + hf;
                f32x4 acc = (f32x4){0.f, 0.f, 0.f, 0.f};
                acc = mma_lds(bWT, ST, 16 * tk, bKD, ST, 16 * ti, 64, acc, c16, q4);
                f32x4 v;
#pragma unroll
                for (int r = 0; r < 4; ++r) v[r] = ((16 * tk + 4 * q4 + r) == (16 * ti + c16) ? eg : 0.f) - acc[r];
                const uint2 pk = pack4(v);
                if (hf == 0) { fr.x = pk.x; fr.y = pk.y; } else { fr.z = pk.x; fr.w = pk.y; } }
            PFR[((size_t)(ci * 8 + ti) * 4 + a) * 64 + lane] = fr;
        }
        for (int x = 0; x < 2; ++x) {
            const int u = wv * 2 + x, ti = u >> 2, a = u & 3;
            uint4 fr;
            const int i = 16 * ti + c16;
            const float qs = SCALE128 * sEg[i];
#pragma unroll
            for (int hf = 0; hf < 2; ++hf) { const int tk = 2 * a + hf;
                f32x4 acc = (f32x4){0.f, 0.f, 0.f, 0.f};
                acc = mma_lds(bWT, ST, 16 * tk, bAQK, ST, 16 * ti, 64, acc, c16, q4);
                const f32x4 qv = unpack4(*(const uint2*)(bQN + i * SN + (16 * tk + 4 * q4) * 2));
                const uint2 pk = pack4(qv * qs - acc);
                if (hf == 0) { fr.x = pk.x; fr.y = pk.y; } else { fr.z = pk.x; fr.w = pk.y; } }
            RFR[((size_t)(ci * 4 + ti) * 4 + a) * 64 + lane] = fr;
        }
        for (int x = 0; x < 8; ++x) {
            const int u = wv * 8 + x, tdv = u >> 3, tdk = u & 7;
            f32x4 acc = (f32x4){0.f, 0.f, 0.f, 0.f};
            acc = mma_lds(bKD, ST, 16 * tdk, bUT, ST, 16 * tdv, 64, acc, c16, q4);
            QFR[((size_t)(ci * 8 + tdv) * 8 + tdk) * 64 + lane] = pack4(acc);
        }
        for (int x = 0; x < 4; ++x) {
            const int u = wv * 4 + x, tdv = u >> 2, ti = u & 3;
            f32x4 acc = (f32x4){0.f, 0.f, 0.f, 0.f};
            acc = mma_lds(bAQK, ST, 16 * ti, bUT, ST, 16 * tdv, 64, acc, c16, q4);
            OFR[((size_t)(ci * 8 + tdv) * 4 + ti) * 64 + lane] = pack4(acc);
        }
        if (tid == 0) GL[ci] = gl;
    }
}

__device__ __forceinline__ void gs_load(uint4 (&d)[12], const unsigned char* pp, const unsigned char* rr, const unsigned char* qq, const unsigned char* oo, const int lt) {
#pragma unroll
    for (int i = 0; i < 6; ++i) { int c = lt + 384 * i; c = c < 2048 ? c : 2047; d[i] = *(const uint4*)(pp + c * 16); }
#pragma unroll
    for (int i = 0; i < 3; ++i) { int c = lt + 384 * i; c = c < 1024 ? c : 1023; d[6 + i] = *(const uint4*)(rr + c * 16); }
#pragma unroll
    for (int i = 0; i < 2; ++i) { int c = lt + 384 * i; c = c < 512 ? c : 511; d[9 + i] = *(const uint4*)(qq + c * 16); }
    { const int c = lt < 256 ? lt : 255; d[11] = *(const uint4*)(oo + c * 16); }
}
__device__ __forceinline__ void gs_store(const uint4 (&d)[12], unsigned char* sb, const int lt) {
#pragma unroll
    for (int i = 0; i < 6; ++i) { const int c = lt + 384 * i; if (c < 2048) *(uint4*)(sb + c * 16) = d[i]; }
#pragma unroll
    for (int i = 0; i < 3; ++i) { const int c = lt + 384 * i; if (c < 1024) *(uint4*)(sb + 32768 + c * 16) = d[6 + i]; }
#pragma unroll
    for (int i = 0; i < 2; ++i) { const int c = lt + 384 * i; if (c < 512) *(uint4*)(sb + 49152 + c * 16) = d[9 + i]; }
    if (lt < 256) *(uint4*)(sb + 57344 + lt * 16) = d[11];
}

#define SCAN_BODY                 bf16x8 Sb[4]; \
_Pragma("unroll") \
                for (int a = 0; a < 4; ++a) { union { uint4 u; bf16x8 v; } cv; const uint2 lo = pack4(S[2 * a]), hi = pack4(S[2 * a + 1]); cv.u.x = lo.x; cv.u.y = lo.y; cv.u.z = hi.x; cv.u.w = hi.y; Sb[a] = cv.v; } \
                const int t0 = b * 8192 + n * 64; \
                {   f32x4 oa[4]; \
_Pragma("unroll") \
                    for (int ti = 0; ti < 4; ++ti) oa[ti] = unpack4(*(const uint2*)(Of + ti * 512)); \
_Pragma("unroll") \
                    for (int a = 0; a < 4; ++a) \
_Pragma("unroll") \
                        for (int ti = 0; ti < 4; ++ti) oa[ti] = __builtin_amdgcn_mfma_f32_16x16x32_bf16(*(const bf16x8*)(Rf + (ti * 4 + a) * 1024), Sb[a], oa[ti], 0, 0, 0); \
_Pragma("unroll") \
                    for (int ti = 0; ti < 4; ++ti) { \
                        float* op = O + (size_t)(t0 + 16 * ti + 4 * q4) * 1024 + h * 128 + 16 * tdv + c16; \
                        op[0] = oa[ti][0]; op[1024] = oa[ti][1]; op[2048] = oa[ti][2]; op[3072] = oa[ti][3]; } \
                } \
                asm volatile("" ::: "memory"); \
_Pragma("unroll") \
                for (int g = 0; g < 2; ++g) { \
                    f32x4 sa[4]; \
_Pragma("unroll") \
                    for (int t = 0; t < 4; ++t) sa[t] = unpack4(*(const uint2*)(Qf + (g * 4 + t) * 512)); \
_Pragma("unroll") \
                    for (int a = 0; a < 4; ++a) \
_Pragma("unroll") \
                        for (int t = 0; t < 4; ++t) sa[t] = __builtin_amdgcn_mfma_f32_16x16x32_bf16(*(const bf16x8*)(Pf + ((g * 4 + t) * 4 + a) * 1024), Sb[a], sa[t], 0, 0, 0); \
_Pragma("unroll") \
                    for (int t = 0; t < 4; ++t) S[g * 4 + t] = sa[t]; \
                    asm volatile("" ::: "memory"); \
                }
PHASE_FN void ph_gdn_scan(const Params& p, float* smem) {
    unsigned char* ws_ = p.ws; asm volatile("" : "+s"(ws_));
    int tid_ = threadIdx.x; asm volatile("" : "+v"(tid_)); const int tid = tid_, lane = tid & 63, wv = __builtin_amdgcn_readfirstlane(tid >> 6), q4 = lane >> 4, c16 = lane & 15;
    int ldz_ = 0; asm volatile("" : "+s"(ldz_)); unsigned char* lds = g_smem + ldz_;
    constexpr int STG = 61440;
    const unsigned char* PFR = ws_ + OFF_PFR; const unsigned char* RFR = ws_ + OFF_RFR; const unsigned char* QFR = ws_ + OFF_QFR; const unsigned char* OFR = ws_ + OFF_OFR;
    float* O = (float*)(ws_ + OFF_O);
    for (int it = blockIdx.x; it < 32; it += gridDim.x) {
        const int bh = it >> 2, pair = it & 3, b = bh >> 2, h = bh & 3;
        __syncthreads();
        if (wv >= 2) {
            const int lt = tid - 128;
            const unsigned char* Pb = PFR + (size_t)bh * 128 * 32768;
            const unsigned char* Rb = RFR + (size_t)bh * 128 * 16384;
            const unsigned char* Qb = QFR + (size_t)bh * 128 * 32768 + pair * 8192;
            const unsigned char* Ob = OFR + (size_t)bh * 128 * 16384 + pair * 4096;
            uint4 ra0, ra1, ra2, ra3, ra4, ra5, ra6, ra7, ra8, ra9, ra10, ra11, rb0, rb1, rb2, rb3, rb4, rb5, rb6, rb7, rb8, rb9, rb10, rb11;
            uint4 rc0, rc1, rc2, rc3, rc4, rc5, rc6, rc7, rc8, rc9, rc10, rc11;
#define LDC(base_, c_, mx_) (*(const uint4*)((base_) + (size_t)(((c_) < (mx_)) ? (c_) : (mx_)) * 16))
#define GS_LOAD(X, n_) do { const unsigned char* pp_ = Pb + (size_t)(n_) * 32768; const unsigned char* rr_ = Rb + (size_t)(n_) * 16384; \
                const unsigned char* qq_ = Qb + (size_t)(n_) * 32768; const unsigned char* oo_ = Ob + (size_t)(n_) * 16384; \
                X##0 = LDC(pp_, lt, 2047); X##1 = LDC(pp_, lt + 384, 2047); X##2 = LDC(pp_, lt + 768, 2047); X##3 = LDC(pp_, lt + 1152, 2047); X##4 = LDC(pp_, lt + 1536, 2047); X##5 = LDC(pp_, lt + 1920, 2047); \
                X##6 = LDC(rr_, lt, 1023); X##7 = LDC(rr_, lt + 384, 1023); X##8 = LDC(rr_, lt + 768, 1023); \
                X##9 = LDC(qq_, lt, 511); X##10 = LDC(qq_, lt + 384, 511); X##11 = LDC(oo_, lt, 255); } while (0)
#define STC(off_, c_, lim_, v_) do { if ((c_) < (lim_)) *(uint4*)(sb_ + (off_) + (c_) * 16) = v_; } while (0)
#define GS_STORE(X, st_) do { unsigned char* sb_ = lds + (st_) * STG; \
                STC(0, lt, 2048, X##0); STC(0, lt + 384, 2048, X##1); STC(0, lt + 768, 2048, X##2); STC(0, lt + 1152, 2048, X##3); STC(0, lt + 1536, 2048, X##4); STC(0, lt + 1920, 2048, X##5); \
                STC(32768, lt, 1024, X##6); STC(32768, lt + 384, 1024, X##7); STC(32768, lt + 768, 1024, X##8); \
                STC(49152, lt, 512, X##9); STC(49152, lt + 384, 512, X##10); STC(57344, lt, 256, X##11); } while (0)
            GS_LOAD(ra, 0); GS_STORE(ra, 0);
            GS_LOAD(rb, 1); GS_LOAD(rc, 2); GS_LOAD(ra, 3);
            __syncthreads();
#define CLAMPN(x_) (((x_) < 128) ? (x_) : 127)
            for (int n = 0; n < 128; n += 3) {
                if (n + 1 < 128) GS_STORE(rb, (n + 1) & 1);
                GS_LOAD(rb, CLAMPN(n + 4)); __syncthreads();
                if (n + 1 < 128) { if (n + 2 < 128) GS_STORE(rc, (n + 2) & 1);
                    GS_LOAD(rc, CLAMPN(n + 5)); __syncthreads(); }
                if (n + 2 < 128) { if (n + 3 < 128) GS_STORE(ra, (n + 3) & 1);
                    GS_LOAD(ra, CLAMPN(n + 6)); __syncthreads(); }
            }
        } else {
            const int tdv = pair * 2 + wv;
            f32x4 S[8];
#pragma unroll
            for (int t = 0; t < 8; ++t) S[t] = (f32x4){0.f, 0.f, 0.f, 0.f};
            __syncthreads();
            for (int n = 0; n < 128; ++n) {
                const unsigned char* base = lds + (n & 1) * STG;
                const unsigned char* Pf = base + lane * 16, *Rf = base + 32768 + lane * 16;
                const unsigned char* Qf = base + 49152 + wv * 4096 + lane * 8, *Of = base + 57344 + wv * 2048 + lane * 8;
                SCAN_BODY
                __syncthreads();
            }
        }
    }
}

__device__ __forceinline__ void block_sum4(int (&v)[4], int* buf) {
    const int lane = threadIdx.x & 63, wv = threadIdx.x >> 6;
#pragma unroll
    for (int q = 0; q < 4; ++q) v[q] = wave_sum_i(v[q]);
    if (lane == 0) {
#pragma unroll
        for (int q = 0; q < 4; ++q) buf[wv * 4 + q] = v[q];
    }
    __syncthreads();
#pragma unroll
    for (int q = 0; q < 4; ++q) { int a = 0; for (int w = 0; w < 8; ++w) a += buf[w * 4 + q]; v[q] = a; }
}

PHASE_FN void ph_dsa_topk(const Params& p, int layer, float* smem) {
    unsigned char* ws_ = p.ws; asm volatile("" : "+s"(ws_));
    int tid_ = threadIdx.x; asm volatile("" : "+v"(tid_)); const int tid = tid_, lane = tid & 63, wv = __builtin_amdgcn_readfirstlane(tid >> 6), q4 = lane >> 4, c16 = lane & 15;
    int* sRed = (int*)g_smem;
    const bf16_t* QIb = (const bf16_t*)(ws_ + OFF_QIB); const bf16_t* KIb = (const bf16_t*)(ws_ + OFF_KIB); const float* WI = (const float*)(ws_ + OFF_WI);
    unsigned short* M16 = (unsigned short*)(ws_ + OFF_M16);
    int* qhead = (int*)(ws_ + OFF_QCTR) + layer * 16;
    int* sIt = (int*)(g_smem + 512);
    for (;;) {
        __syncthreads();
        if (tid == 0) *sIt = atomicAdd(qhead, 1);
        __syncthreads();
        const int it = *sIt;
        if (it >= 2048) break;
        const int b = it & 1, gp = 1023 - (it >> 1);
        const int s0 = gp * 8, t0 = b * 8192 + s0;
        const int ntiles = (s0 >> 4) + 1;
        const int nreg = (ntiles > wv) ? ((ntiles - wv + 7) >> 3) : 0;
        const bf16_t* qp = QIb + (size_t)(t0 + (c16 >> 2)) * 256 + (c16 & 3) * 64 + 8 * q4;
        const bf16x8 a0A = *(const bf16x8*)qp, a1A = *(const bf16x8*)(qp + 32), a0B = *(const bf16x8*)(qp + 4 * 256), a1B = *(const bf16x8*)(qp + 4 * 256 + 32);
        const float4 wqA = *(const float4*)(WI + (size_t)(t0 + q4) * 4), wqB = *(const float4*)(WI + (size_t)(t0 + 4 + q4) * 4);
        const int myqA = s0 + q4, myqB = s0 + 4 + q4;
        int c16s = c16; asm volatile("" : "+v"(c16s));
        int wvs = wv; asm volatile("" : "+s"(wvs));
        unsigned kA[64], kB[64];
#pragma unroll
        for (int i = 0; i < 64; ++i) { kA[i] = 0u; kB[i] = 0u; }
#pragma unroll
        for (int blk = 0; blk < 4; ++blk) if (nreg > blk * 16) {
#pragma unroll
            for (int ii = 0; ii < 16; ++ii) { const int i = blk * 16 + ii, tile = wvs + 8 * i;
                if (tile < ntiles) {
                    const bf16_t* kp = KIb + (size_t)(b * 8192 + tile * 16 + c16s) * 64 + 8 * q4;
                    const bf16x8 k0 = *(const bf16x8*)kp, k1 = *(const bf16x8*)(kp + 32);
                    f32x4 accA = (f32x4){0.f, 0.f, 0.f, 0.f}, accB = accA;
                    accA = __builtin_amdgcn_mfma_f32_16x16x32_bf16(a0A, k0, accA, 0, 0, 0);
                    accB = __builtin_amdgcn_mfma_f32_16x16x32_bf16(a0B, k0, accB, 0, 0, 0);
                    accA = __builtin_amdgcn_mfma_f32_16x16x32_bf16(a1A, k1, accA, 0, 0, 0);
                    accB = __builtin_amdgcn_mfma_f32_16x16x32_bf16(a1B, k1, accB, 0, 0, 0);
                    float sa = 0.f, sb = 0.f;
                    sa += wqA.x * fmaxf(accA[0], 0.f); sa += wqA.y * fmaxf(accA[1], 0.f); sa += wqA.z * fmaxf(accA[2], 0.f); sa += wqA.w * fmaxf(accA[3], 0.f);
                    sb += wqB.x * fmaxf(accB[0], 0.f); sb += wqB.y * fmaxf(accB[1], 0.f); sb += wqB.z * fmaxf(accB[2], 0.f); sb += wqB.w * fmaxf(accB[3], 0.f);
                    const int kidx = tile * 16 + c16s;
                    kA[i] = (kidx <= myqA) ? ordkey(sa) : 0u;
                    kB[i] = (kidx <= myqB) ? ordkey(sb) : 0u;
                }
                if ((ii & 3) == 3) asm volatile("" ::: "memory"); }
        }
        const int keffA = (myqA + 1 < 256) ? (myqA + 1) : 256, keffB = (myqB + 1 < 256) ? (myqB + 1) : 256;
        int par = 0;
        auto qsum = [&](int c) -> int {
            c += __shfl_xor(c, 1); c += __shfl_xor(c, 2); c += __shfl_xor(c, 4); c += __shfl_xor(c, 8);
            par ^= 1;
            if (c16 == 0) sRed[par * 32 + wv * 4 + q4] = c;
            __syncthreads();
            int a = 0;
#pragma unroll
            for (int w = 0; w < 8; ++w) a += sRed[par * 32 + w * 4 + q4];
            return a;
        };
        unsigned UA = 0u, UB = 0u;
        for (int rep_ = 0; rep_ < TOPK_SEARCH_REP; ++rep_) { UA = 0u; UB = 0u;
        for (int bit = 31; bit >= 0; --bit) {
            const unsigned candA = UA | (1u << bit), candB = UB | (1u << bit);
            int ca = 0, cb = 0;
#pragma unroll
            for (int blk = 0; blk < 4; ++blk) if (nreg > blk * 16) {
#pragma unroll
                for (int ii = 0; ii < 16; ++ii) { ca += (kA[blk * 16 + ii] >= candA) ? 1 : 0; cb += (kB[blk * 16 + ii] >= candB) ? 1 : 0; }
            }
            const int tot = qsum(ca | (cb << 16));
            if ((tot & 0xffff) >= keffA) UA = candA;
            if ((tot >> 16) >= keffB) UB = candB;
        } }
        int cg = 0, ce = 0;
#pragma unroll
        for (int i = 0; i < 64; ++i) { cg += (kA[i] > UA) ? 1 : 0; ce += (kA[i] == UA) ? 1 : 0; cg += (kB[i] > UB) ? 65536 : 0; ce += (kB[i] == UB) ? 65536 : 0; }
        cg = qsum(cg); ce = qsum(ce);
        const int needA = keffA - (cg & 0xffff), needB = keffB - (cg >> 16);
        int JA = 8191, JB = 8191;
        par ^= 1;
        if (c16 == 0) sRed[par * 32 + wv * 4 + q4] = (((ce & 0xffff) > needA) || ((ce >> 16) > needB)) ? 1 : 0;
        __syncthreads();
        int anyov = 0;
#pragma unroll
        for (int w = 0; w < 32; ++w) anyov |= sRed[par * 32 + w];
        if (anyov) {
            JA = 0; JB = 0;
            int c16j = c16; asm volatile("" : "+v"(c16j));
            int wvj = wv; asm volatile("" : "+s"(wvj));
            for (int bit = 12; bit >= 0; --bit) {
                const int cjA = JA | (1 << bit), cjB = JB | (1 << bit);
                int c = 0;
#pragma unroll
                for (int i = 0; i < 64; ++i) { const int kidx = (wvj + 8 * i) * 16 + c16j; c += (kA[i] == UA && kidx < cjA) ? 1 : 0; c += (kB[i] == UB && kidx < cjB) ? 65536 : 0; }
                const int tot = qsum(c);
                if ((tot & 0xffff) <= needA - 1) JA = cjA;
                if ((tot >> 16) <= needB - 1) JB = cjB;
            }
        }
        unsigned short* sM = (unsigned short*)(g_smem + 1024);
        ((uint4*)sM)[tid] = make_uint4(0u, 0u, 0u, 0u);
        __syncthreads();
        int c16e = c16; asm volatile("" : "+v"(c16e));
        int wve = wv; asm volatile("" : "+s"(wve));
#pragma unroll
        for (int blk = 0; blk < 4; ++blk) if (nreg > blk * 16) {
#pragma unroll
            for (int ii = 0; ii < 16; ++ii) { const int i = blk * 16 + ii;
                const int tile = wve + 8 * i, kidx = tile * 16 + c16e;
                const bool selA = kA[i] > UA || (kA[i] == UA && kidx <= JA);
                const bool selB = kB[i] > UB || (kB[i] == UB && kidx <= JB);
                const unsigned long long balA = __ballot(selA), balB = __ballot(selB);
                if (c16 == 0) { sM[q4 * 512 + tile] = (unsigned short)((balA >> (16 * q4)) & 0xffffull);
                                sM[(4 + q4) * 512 + tile] = (unsigned short)((balB >> (16 * q4)) & 0xffffull); }
            }
        }
        __syncthreads();
        *(uint4*)(M16 + (size_t)(t0 + (tid >> 6)) * 512 + (tid & 63) * 8) = ((const uint4*)sM)[tid];
    }
}

PHASE_FN void ph_dsa_attn(const Params& p, float* smem) {
    unsigned char* ws_ = p.ws; asm volatile("" : "+s"(ws_));
    int tid_ = threadIdx.x; asm volatile("" : "+v"(tid_)); const int tid = tid_, lane = tid & 63, wv = tid >> 6, q4 = lane >> 4, c16 = lane & 15;
    int ldz_ = 0; asm volatile("" : "+s"(ldz_)); unsigned char* lds = g_smem + ldz_;
    const bf16_t* QBb = (const bf16_t*)(ws_ + OFF_QBB); const bf16_t* KBb = (const bf16_t*)(ws_ + OFF_KBB); const bf16_t* VT = (const bf16_t*)(ws_ + OFF_VT);
    const unsigned short* M16 = (const unsigned short*)(ws_ + OFF_M16);
    bf16_t* OB = (bf16_t*)(ws_ + OFF_OB);
    const float SC = SCALE128 * 1.4426950408889634f;
    for (int it = blockIdx.x; it < 256; it += gridDim.x) {
        const int bh = it & 7, jp = it >> 3, b = bh >> 2, h = bh & 3;
        for (int half = 0; half < 2; ++half) {
            const int jq = half ? jp : 63 - jp;
            const int qs = jq * 128, nkt = 2 * jq + 2;
            const int tq = b * 8192 + qs + wv * 16 + c16;
            bf16x8 qf[4];
#pragma unroll
            for (int a = 0; a < 4; ++a) qf[a] = *(const bf16x8*)(QBb + (size_t)tq * 512 + h * 128 + 8 * q4 + 32 * a);
            float m = -1e30f, lsum = 0.f;
            f32x4 oacc[8];
#pragma unroll
            for (int t = 0; t < 8; ++t) oacc[t] = (f32x4){0.f, 0.f, 0.f, 0.f};
            uint4 rk0, rk1, rv0, rv1;
            const int q0 = tid, q1 = tid + 512;
            const bf16_t* kg0 = KBb + (size_t)(b * 8192 + (q0 >> 4)) * 512 + h * 128 + (q0 & 15) * 8;
            const bf16_t* kg1 = KBb + (size_t)(b * 8192 + (q1 >> 4)) * 512 + h * 128 + (q1 & 15) * 8;
            const bf16_t* vg0 = VT + ((size_t)((b * 4 + h) * 128 + (q0 >> 3))) * 8192 + (q0 & 7) * 8;
            const bf16_t* vg1 = VT + ((size_t)((b * 4 + h) * 128 + (q1 >> 3))) * 8192 + (q1 & 7) * 8;
            const int lk0 = (q0 >> 4) * 256 + ((((q0 & 15)) ^ ((q0 >> 4) & 15)) << 4), lk1 = (q1 >> 4) * 256 + ((((q1 & 15)) ^ ((q1 >> 4) & 15)) << 4);
            const int lv0 = 16384 + (q0 >> 3) * 128 + ((((q0 & 7)) ^ ((q0 >> 3) & 7)) << 4), lv1 = 16384 + (q1 >> 3) * 128 + ((((q1 & 7)) ^ ((q1 >> 3) & 7)) << 4);
#define ATT_GLOAD(kt_) do { rk0 = *(const uint4*)(kg0 + (size_t)(kt_) * 64 * 512); rk1 = *(const uint4*)(kg1 + (size_t)(kt_) * 64 * 512); \
                            rv0 = *(const uint4*)(vg0 + (kt_) * 64); rv1 = *(const uint4*)(vg1 + (kt_) * 64); } while (0)
#define ATT_LSTORE(st_) do { unsigned char* base_ = lds + (st_) * 32768; *(uint4*)(base_ + lk0) = rk0; *(uint4*)(base_ + lk1) = rk1; *(uint4*)(base_ + lv0) = rv0; *(uint4*)(base_ + lv1) = rv1; } while (0)
            __syncthreads();
            ATT_GLOAD(0); ATT_LSTORE(0);
            __syncthreads();
            for (int kt = 0; kt < nkt; ++kt) {
                if (kt + 1 < nkt) ATT_GLOAD(kt + 1);
                const unsigned long long mbits = *(const unsigned long long*)(M16 + (size_t)tq * 512 + 4 * kt);
                const unsigned char* Kt = lds + (kt & 1) * 32768;
                const unsigned char* Vt = Kt + 16384;
                f32x4 sacc[4];
#pragma unroll
                for (int ti = 0; ti < 4; ++ti) { sacc[ti] = (f32x4){0.f, 0.f, 0.f, 0.f};
                    const int row = 16 * ti + c16;
#pragma unroll
                    for (int a = 0; a < 4; ++a) { const bf16x8 kf = *(const bf16x8*)(Kt + row * 256 + ((((q4 + 4 * a)) ^ (row & 15)) << 4));
                        sacc[ti] = __builtin_amdgcn_mfma_f32_16x16x32_bf16(kf, qf[a], sacc[ti], 0, 0, 0); } }
                float mx = m;
#pragma unroll
                for (int ti = 0; ti < 4; ++ti)
#pragma unroll
                    for (int r = 0; r < 4; ++r) { const bool valid = (mbits >> (16 * ti + 4 * q4 + r)) & 1ull; const float v = sacc[ti][r] * SC; sacc[ti][r] = v; mx = fmaxf(mx, valid ? v : -1e30f); }
                mx = fmaxf(mx, __shfl_xor(mx, 16)); mx = fmaxf(mx, __shfl_xor(mx, 32));
                const float alpha = __builtin_amdgcn_exp2f(m - mx); m = mx;
                float ps = 0.f;
#pragma unroll
                for (int ti = 0; ti < 4; ++ti)
#pragma unroll
                    for (int r = 0; r < 4; ++r) { const bool valid = (mbits >> (16 * ti + 4 * q4 + r)) & 1ull; const float pv = valid ? __builtin_amdgcn_exp2f(sacc[ti][r] - mx) : 0.f; sacc[ti][r] = pv; ps += pv; }
                lsum = lsum * alpha + ps;
#pragma unroll
                for (int t = 0; t < 8; ++t) oacc[t] = oacc[t] * alpha;
                bf16x8 pb[2];
#pragma unroll
                for (int a = 0; a < 2; ++a) {
                    union { uint4 u; bf16x8 v; } cv;
                    cv.u.x = cvt_pk_bf16(sacc[2 * a][0], sacc[2 * a][1]); cv.u.y = cvt_pk_bf16(sacc[2 * a][2], sacc[2 * a][3]);
                    cv.u.z = cvt_pk_bf16(sacc[2 * a + 1][0], sacc[2 * a + 1][1]); cv.u.w = cvt_pk_bf16(sacc[2 * a + 1][2], sacc[2 * a + 1][3]);
                    pb[a] = cv.v; }
#pragma unroll
                for (int t = 0; t < 8; ++t) { const int row = 16 * t + c16;
#pragma unroll
                    for (int a = 0; a < 2; ++a) {
                        union { uint2 h2[2]; bf16x8 v; } vf;
                        vf.h2[0] = *(const uint2*)(Vt + row * 128 + ((((4 * a + (q4 >> 1))) ^ (row & 7)) << 4) + 8 * (q4 & 1));
                        vf.h2[1] = *(const uint2*)(Vt + row * 128 + ((((4 * a + 2 + (q4 >> 1))) ^ (row & 7)) << 4) + 8 * (q4 & 1));
                        oacc[t] = __builtin_amdgcn_mfma_f32_16x16x32_bf16(vf.v, pb[a], oacc[t], 0, 0, 0); } }
                if (kt + 1 < nkt) ATT_LSTORE((kt + 1) & 1);
                __syncthreads();
            }
            lsum += __shfl_xor(lsum, 16); lsum += __shfl_xor(lsum, 32);
            const float inv = 1.f / lsum;
#pragma unroll
            for (int t = 0; t < 8; ++t) *(uint2*)(OB + (size_t)tq * 1024 + 512 + h * 128 + 16 * t + 4 * q4) = pack4(oacc[t] * inv);
        }
    }
}

PHASE_FN void ph_gdn_out(const Params& p, int layer) {
    unsigned char* ws_ = p.ws; asm volatile("" : "+s"(ws_));
    int tid_ = threadIdx.x; asm volatile("" : "+v"(tid_)); const int tid = tid_, lane = tid & 63, wv = tid >> 6;
    const float* O = (const float*)(ws_ + OFF_O); const bf16_t* P = (const bf16_t*)(ws_ + OFF_P); bf16_t* OB = (bf16_t*)(ws_ + OFF_OB);
    const float* onw = p.gdn_out_norm + (layer >> 1) * 128;
    for (int t = blockIdx.x * 8 + wv; t < NT; t += gridDim.x * 8) {
#pragma unroll
        for (int h = 0; h < 4; ++h) {
            const float* op = O + (size_t)t * 1024 + h * 128; bf16_t* ob = OB + (size_t)t * 1024 + h * 128;
            const float o0 = op[lane], o1 = op[64 + lane];
            const float ss = wave_sum(o0 * o0 + o1 * o1);
            const float r = rsqrtf(ss * (1.f / 128.f) + EPS);
            const float z0 = PBF(P, t, 1536 + h * 128 + lane), z1 = PBF(P, t, 1536 + h * 128 + 64 + lane);
            ob[lane] = f2bf(o0 * r * onw[lane] * siluf_(z0)); ob[64 + lane] = f2bf(o1 * r * onw[64 + lane] * siluf_(z1));
        }
    }
}

PHASE_FN void ph_gemm_out(const Params& p, int layer, float* smem) {
    unsigned char* ws_ = p.ws; asm volatile("" : "+s"(ws_));
    { int ldz_ = 0; asm volatile("" : "+s"(ldz_)); smem = (float*)(g_smem + ldz_); }
    const bf16_t* Wt = (const bf16_t*)(ws_ + OFF_WOUT) + (size_t)layer * 1024 * 1024;
    const float* MOD = (const float*)(ws_ + OFF_MOD);
    const bf16_t* O = (const bf16_t*)(ws_ + OFF_OB);
    for (int tile = blockIdx.x; tile < 64 * 8; tile += gridDim.x) {
        const int mt = tile % 64, nt = tile / 64;
        const bf16_t* Ab = O + (size_t)mt * 256 * 1024;
        const bf16_t* Bb = Wt + (size_t)nt * 128 * 1024;
        const int b = (mt * 256) >> 13;
        const float* gt = MOD + (size_t)(layer * 2 + b) * 6144 + 2048 + nt * 128;
        float* Xt = p.X + (size_t)mt * 256 * ND + nt * 128;
        const float* Xr = ((layer == 0) ? p.x : (const float*)p.X) + (size_t)mt * 256 * ND + nt * 128;
        gemm_tile_bf16(1024, (unsigned char*)smem,
            [=](int i, int r, int k) -> uint4 { return *(const uint4*)(Ab + (size_t)r * 1024 + k); },
            [=](int i, int r, int k) -> uint4 { return *(const uint4*)(Bb + (size_t)r * 1024 + k); },
            [=](const f32x4 (&acc)[4][4], int wm, int wn, int lane) {
#pragma unroll
                for (int mi = 0; mi < 4; ++mi)
#pragma unroll
                    for (int ni = 0; ni < 4; ++ni) {
                        const int m = wm * 64 + mi * 16 + (lane & 15), n = wn * 64 + ni * 16 + 4 * (lane >> 4);
                        const f32x4 g = *(const f32x4*)(gt + n);
                        *(f32x4*)(Xt + (size_t)m * ND + n) = *(const f32x4*)(Xr + (size_t)m * ND + n) + g * acc[mi][ni];
                    }
            });
    }
}

PHASE_FN void ph_norm_ffn(const Params& p, int layer) {
    unsigned char* ws_ = p.ws; asm volatile("" : "+s"(ws_));
    int tid_ = threadIdx.x; asm volatile("" : "+v"(tid_)); const int tid = tid_, lane = tid & 63, wv = tid >> 6;
    const float* MOD = (const float*)(ws_ + OFF_MOD);
    bf16_t* H = (bf16_t*)(ws_ + OFF_H);
    int* CNT = (int*)(ws_ + OFF_CNT) + layer * 32 * CSTR;
    int* sCnt = (int*)g_smem; int* sBase = sCnt + 32; int* sE = sBase + 32; int* sR = sE + 256;
    const int nrb = (NT + (int)gridDim.x - 1) / (int)gridDim.x, row_lo = blockIdx.x * nrb, row_hi = (row_lo + nrb < NT) ? row_lo + nrb : NT;
    __syncthreads();
    if (tid < 32) sCnt[tid] = 0;
    __syncthreads();
    int* ASG = (int*)(ws_ + OFF_ASG); float* GATE = (float*)(ws_ + OFF_GATE); int* LIST = (int*)(ws_ + OFF_LIST);
    const float* nw = p.norm_ffn + layer * 1024;
    const float* wg = p.rg_w + (size_t)layer * 1024 * 4;
    for (int row = row_lo + wv; row < row_hi; row += 8) {
        const int b = row >> 13;
        const float* xr = p.X + (size_t)row * ND;
        const float* sh = MOD + (size_t)(layer * 2 + b) * 6144 + 3072;
        const float* sc = sh + 1024;
        float hv[16]; float ss = 0.f;
#pragma unroll
        for (int j = 0; j < 4; ++j) { const float4 v = *(const float4*)(xr + j * 256 + lane * 4); hv[4 * j] = v.x; hv[4 * j + 1] = v.y; hv[4 * j + 2] = v.z; hv[4 * j + 3] = v.w; }
#pragma unroll
        for (int j = 0; j < 16; ++j) ss += hv[j] * hv[j];
        ss = wave_sum(ss);
        const float rstd = rsqrtf(ss * (1.f / 1024.f) + EPS);
#pragma unroll
        for (int j = 0; j < 4; ++j) {
            const int col = j * 256 + lane * 4;
            const float4 w = *(const float4*)(nw + col), s4 = *(const float4*)(sc + col), h4 = *(const float4*)(sh + col);
            hv[4 * j] = hv[4 * j] * rstd * w.x * (1.f + s4.x) + h4.x; hv[4 * j + 1] = hv[4 * j + 1] * rstd * w.y * (1.f + s4.y) + h4.y;
            hv[4 * j + 2] = hv[4 * j + 2] * rstd * w.z * (1.f + s4.z) + h4.z; hv[4 * j + 3] = hv[4 * j + 3] * rstd * w.w * (1.f + s4.w) + h4.w;
            { f32x4 ov; ov[0] = hv[4 * j]; ov[1] = hv[4 * j + 1]; ov[2] = hv[4 * j + 2]; ov[3] = hv[4 * j + 3]; *(uint2*)(H + (size_t)row * ND + col) = pack4(ov); }
        }
        float gl[4] = {0.f, 0.f, 0.f, 0.f};
#pragma unroll
        for (int j = 0; j < 4; ++j)
#pragma unroll
            for (int e = 0; e < 4; ++e) { const int col = j * 256 + lane * 4 + e; const float4 w = *(const float4*)(wg + (size_t)col * 4); const float hh = hv[4 * j + e];
                gl[0] += hh * w.x; gl[1] += hh * w.y; gl[2] += hh * w.z; gl[3] += hh * w.w; }
#pragma unroll
        for (int g = 0; g < 4; ++g) gl[g] = wave_sum(gl[g]) + p.rg_b[layer * 4 + g];
        int gs = 0; float gm = gl[0];
#pragma unroll
        for (int g = 1; g < 4; ++g) if (gl[g] > gm) { gm = gl[g]; gs = g; }
        float gsum = 0.f;
#pragma unroll
        for (int g = 0; g < 4; ++g) gsum += expf(gl[g] - gm);
        const float ggate = 1.f / gsum;
        const float* we = p.re_w + ((size_t)(layer * 4 + gs) * 1024) * 8;
        float el[8] = {0.f, 0.f, 0.f, 0.f, 0.f, 0.f, 0.f, 0.f};
#pragma unroll
        for (int j = 0; j < 4; ++j)
#pragma unroll
            for (int e = 0; e < 4; ++e) { const int col = j * 256 + lane * 4 + e; const float4 w0 = *(const float4*)(we + (size_t)col * 8), w1 = *(const float4*)(we + (size_t)col * 8 + 4); const float hh = hv[4 * j + e];
                el[0] += hh * w0.x; el[1] += hh * w0.y; el[2] += hh * w0.z; el[3] += hh * w0.w; el[4] += hh * w1.x; el[5] += hh * w1.y; el[6] += hh * w1.z; el[7] += hh * w1.w; }
#pragma unroll
        for (int e = 0; e < 8; ++e) el[e] = wave_sum(el[e]) + p.re_b[(layer * 4 + gs) * 8 + e];
        int i1 = 0; float l1 = el[0];
#pragma unroll
        for (int e = 1; e < 8; ++e) if (el[e] > l1) { l1 = el[e]; i1 = e; }
        int i2 = -1; float l2 = -INFINITY;
#pragma unroll
        for (int e = 0; e < 8; ++e) if (e != i1 && el[e] > l2) { l2 = el[e]; i2 = e; }
        const float ex = expf(l2 - l1);
        const float p1 = 1.f / (1.f + ex), p2 = ex / (1.f + ex);
        if (lane == 0) {
            const int e1 = gs * 8 + i1, e2 = gs * 8 + i2, lr = row - row_lo;
            sE[lr * 2] = e1; sE[lr * 2 + 1] = e2;
            sR[lr * 2] = atomicAdd(&sCnt[e1], 1); sR[lr * 2 + 1] = atomicAdd(&sCnt[e2], 1);
            GATE[row * 2] = ggate * p1; GATE[row * 2 + 1] = ggate * p2;
        }
    }
    __syncthreads();
    if (tid < 32) sBase[tid] = (sCnt[tid] > 0) ? atomicAdd(&CNT[tid * CSTR], sCnt[tid]) : 0;
    __syncthreads();
    for (int a = tid; a < (row_hi - row_lo) * 2; a += NTHREADS) {
        const int row = row_lo + (a >> 1), e = sE[a], r = sBase[e] + sR[a];
        LIST[(size_t)e * LISTCAP + r] = row;
        ASG[row * 4 + (a & 1) * 2] = e; ASG[row * 4 + (a & 1) * 2 + 1] = r;
    }
}

PHASE_FN void ph_moe(const Params& p, int layer, int which, float* smem) {
    unsigned char* ws_ = p.ws; asm volatile("" : "+s"(ws_));
    { int ldz_ = 0; asm volatile("" : "+s"(ldz_)); smem = (float*)(g_smem + ldz_); }
    int tid_ = threadIdx.x; asm volatile("" : "+v"(tid_)); const int tid = tid_;
    int* sPad = (int*)((unsigned char*)smem + 98304); int* sTs = sPad + 33;
    const int* CNT = (const int*)(ws_ + OFF_CNT) + layer * 32 * CSTR;
    __syncthreads();
    if (tid == 0) { int a = 0, ts = 0; for (int e = 0; e < 32; ++e) { sPad[e] = a; sTs[e] = ts; a += ((CNT[e * CSTR] + 127) / 128) * 128; ts += (CNT[e * CSTR] + 255) / 256; } sTs[32] = ts; sPad[32] = a; }
    __syncthreads();
    const int total = sTs[32] * 8;
    bf16_t* HID = (bf16_t*)(ws_ + OFF_HID); float* YB = (float*)(ws_ + OFF_YB);
    const bf16_t* H = (const bf16_t*)(ws_ + OFF_H);
    const int* LIST = (const int*)(ws_ + OFF_LIST);
    for (int tile = blockIdx.x; tile < total; tile += gridDim.x) {
        const int mt = tile >> 3, nt = tile & 7;
        int e = 0;
        for (int q = 1; q < 32; ++q) if (sTs[q] <= mt) e = q;
        const int mi0 = mt - sTs[e];
        const int cnt = CNT[e * CSTR];
        const int mvalid = (cnt - mi0 * 256 < 256) ? (cnt - mi0 * 256) : 256;
        const int rowbase = sPad[e] + mi0 * 256;
        if (which == 0) {
            long ro[4];
#pragma unroll
            for (int i = 0; i < 4; ++i) { const int r = (tid + 512 * i) >> 3; ro[i] = (r < mvalid) ? (long)LIST[(size_t)e * LISTCAP + mi0 * 256 + r] * 1024 : -1; }
            const long ro0 = ro[0], ro1 = ro[1], ro2 = ro[2], ro3 = ro[3];
            const bf16_t* Bb = (const bf16_t*)(ws_ + OFF_W13) + (size_t)e * 1024 * 1024 + (size_t)nt * 128 * 1024;
            bf16_t* Ht = HID + (size_t)rowbase * 512 + nt * 64;
            gemm_tile_bf16(1024, (unsigned char*)smem,
                [=](int i, int r, int k) -> uint4 { const long o = (i == 0) ? ro0 : (i == 1) ? ro1 : (i == 2) ? ro2 : ro3; if (o < 0) return make_uint4(0u, 0u, 0u, 0u);
                    return *(const uint4*)(H + o + k); },
                [=](int i, int r, int k) -> uint4 { return *(const uint4*)(Bb + (size_t)r * 1024 + k); },
                [=](const f32x4 (&acc)[4][4], int wm, int wn, int lane) {
#pragma unroll
                    for (int mi = 0; mi < 4; ++mi)
#pragma unroll
                        for (int ni = 0; ni < 2; ++ni) {
                            const int m = wm * 64 + mi * 16 + (lane & 15), n = wn * 32 + ni * 16 + 4 * (lane >> 4);
                            const f32x4 a1 = acc[mi][ni], a3 = acc[mi][ni + 2];
                            f32x4 hv; hv[0] = siluf_(a1[0]) * a3[0]; hv[1] = siluf_(a1[1]) * a3[1]; hv[2] = siluf_(a1[2]) * a3[2]; hv[3] = siluf_(a1[3]) * a3[3];
                            if (m < mvalid) *(uint2*)(Ht + (size_t)m * 512 + n) = pack4(hv);
                        }
                });
        } else {
            const bf16_t* Ab = HID + (size_t)rowbase * 512;
            const bf16_t* Bb = (const bf16_t*)(ws_ + OFF_W2T) + (size_t)e * 1024 * 512 + (size_t)nt * 128 * 512;
            float* Yt = YB + (size_t)rowbase * 1024 + nt * 128;
            gemm_tile_bf16(512, (unsigned char*)smem,
                [=](int i, int r, int k) -> uint4 { if (r >= mvalid) return make_uint4(0u, 0u, 0u, 0u); return *(const uint4*)(Ab + (size_t)r * 512 + k); },
                [=](int i, int r, int k) -> uint4 { return *(const uint4*)(Bb + (size_t)r * 512 + k); },
                [=](const f32x4 (&acc)[4][4], int wm, int wn, int lane) {
#pragma unroll
                    for (int mi = 0; mi < 4; ++mi)
#pragma unroll
                        for (int ni = 0; ni < 4; ++ni) {
                            const int m = wm * 64 + mi * 16 + (lane & 15), n = wn * 64 + ni * 16 + 4 * (lane >> 4);
                            if (m < mvalid) *(f32x4*)(Yt + (size_t)m * 1024 + n) = acc[mi][ni];
                        }
                });
        }
    }
}

PHASE_FN void ph_conv_dense(const Params& p, float* smem) {
    unsigned char* ws_ = p.ws; asm volatile("" : "+s"(ws_));
    { int ldz_ = 0; asm volatile("" : "+s"(ldz_)); smem = (float*)(g_smem + ldz_); }
    auto dec = [&](int t, const float*& s0, const float*& s1, bf16_t*& dst, int& mode, int& K, int& N, int& ld, int& rt, int& kt) {
        s1 = nullptr; mode = 0; K = 1024;
        if (t >= 4608) t = 4607;
        if (t < 1984) { const int l = t / 992, u = t % 992; s0 = p.even_w_in + (size_t)l * 1024 * 3916; N = 3916; ld = 3916; dst = (bf16_t*)(ws_ + OFF_WINE) + (size_t)l * 3968 * 1024; rt = u >> 4; kt = u & 15; }
        else if (t < 3584) { const int v = t - 1984, l = v / 800, u = v % 800; s0 = p.gla_w_in + (size_t)l * 1024 * 3088; N = 3088; ld = 3088; dst = (bf16_t*)(ws_ + OFF_WINO) + (size_t)l * 3200 * 1024; rt = u >> 4; kt = u & 15; }
        else { const int v = t - 3584, l = v >> 8, u = v & 255; s0 = ((l & 1) ? p.gla_w_out : p.even_w_out) + (size_t)(l >> 1) * 1024 * 1024; N = 1024; ld = 1024; dst = (bf16_t*)(ws_ + OFF_WOUT) + (size_t)l * 1024 * 1024; rt = u >> 4; kt = u & 15; }
    };
    for (int t = blockIdx.x * 4; t < 4608; t += gridDim.x * 4) convert_tiles4(dec, t, (4608 - t < 4) ? (4608 - t) : 4, smem);
}

PHASE_FN void ph_conv_exp(const Params& p, int layer, float* smem, int first_blk) {
    unsigned char* ws_ = p.ws; asm volatile("" : "+s"(ws_));
    { int ldz_ = 0; asm volatile("" : "+s"(ldz_)); smem = (float*)(g_smem + ldz_); }
    if ((int)blockIdx.x < first_blk) return;
    auto dec = [&](int t, const float*& s0, const float*& s1, bf16_t*& dst, int& mode, int& K, int& N, int& ld, int& rt, int& kt) {
        if (t >= 12288) t = 12287;
        if (t < 8192) { const int e = t >> 8, u = t & 255; s0 = p.w1 + (size_t)(layer * 32 + e) * 1024 * 512; s1 = p.w3 + (size_t)(layer * 32 + e) * 1024 * 512; mode = 1; K = 1024; N = 512; ld = 512;
            dst = (bf16_t*)(ws_ + OFF_W13) + (size_t)e * 1024 * 1024; rt = u >> 4; kt = u & 15; }
        else { const int v = t - 8192, e = v >> 7, u = v & 127; s0 = p.w2 + (size_t)(layer * 32 + e) * 512 * 1024; s1 = nullptr; mode = 0; K = 512; N = 1024; ld = 1024;
            dst = (bf16_t*)(ws_ + OFF_W2T) + (size_t)e * 1024 * 512; rt = u >> 3; kt = u & 7; }
    };
    const int nb = (int)gridDim.x - first_blk;
    for (int t = ((int)blockIdx.x - first_blk) * 4; t < 12288; t += nb * 4) convert_tiles4(dec, t, (12288 - t < 4) ? (12288 - t) : 4, smem);
}

PHASE_FN void ph_gla_tok(const Params& p, int layer) {
    unsigned char* ws_ = p.ws; asm volatile("" : "+s"(ws_));
    int tid_ = threadIdx.x; asm volatile("" : "+v"(tid_)); const int tid = tid_, lane = tid & 63, wv = tid >> 6, li = layer >> 1;
    const float* AUX = (const float*)(ws_ + OFF_AUX);
    float* LA = (float*)(ws_ + OFF_LA);
    const float* w2 = p.gla_w_gate2 + (size_t)li * 16 * 512; const float* b2 = p.gla_b_gate2 + li * 512;
    for (int t = blockIdx.x * 8 + wv; t < NT; t += gridDim.x * 8) {
        float glr[16];
#pragma unroll
        for (int r = 0; r < 16; ++r) glr[r] = AUX[(size_t)t * 16 + r];
#pragma unroll 1
        for (int i = 0; i < 8; ++i) {
            const int c = lane + 64 * i; float z = b2[c];
#pragma unroll
            for (int r = 0; r < 16; ++r) z += glr[r] * w2[r * 512 + c];
            LA[(size_t)t * 512 + c] = -softplusf_(-z) * (1.f / 16.f);
        }
    }
}

PHASE_FN void ph_gla_chunk(const Params& p, int layer, float* smem) {
    unsigned char* ws_ = p.ws; asm volatile("" : "+s"(ws_));
    int tid_ = threadIdx.x; asm volatile("" : "+v"(tid_)); const int tid = tid_, lane = tid & 63, wv = __builtin_amdgcn_readfirstlane(tid >> 6), q4 = lane >> 4, c16 = lane & 15;
    int ldz_ = 0; asm volatile("" : "+s"(ldz_)); unsigned char* lds = g_smem + ldz_;
    constexpr int SN = 272, ST = 144;
    float* sBc = (float*)lds;
    unsigned char* bQE = lds + 33024;
    unsigned char* bKE = lds + 50432;
    unsigned char* bKD = lds + 67840;
    unsigned char* bVT = lds + 86272;
    unsigned char* bATT = lds + 123136;
    const bf16_t* P = (const bf16_t*)(ws_ + OFF_P); const float* AUX = (const float*)(ws_ + OFF_AUX);
    const float* w2 = p.gla_w_gate2 + (size_t)(layer >> 1) * 16 * 512; const float* b2 = p.gla_b_gate2 + (layer >> 1) * 512;
    float* sGlr = (float*)(lds + 132352);
    uint4* QEF = (uint4*)(ws_ + OFF_GQE); uint2* OIF = (uint2*)(ws_ + OFF_GOI); uint2* HF = (uint2*)(ws_ + OFF_GH); float* EBL = (float*)(ws_ + OFF_GEBL);
    for (int ci = blockIdx.x; ci < 1024; ci += gridDim.x) {
        const int b = ci >> 9, h = (ci >> 7) & 3, n = ci & 127;
        const int t0 = b * 8192 + n * 64;
        __syncthreads();
        for (int e = tid; e < 1024; e += NTHREADS) sGlr[e] = AUX[(size_t)(t0 + (e >> 4)) * 16 + (e & 15)];
        __syncthreads();
        {
            const int d = tid & 127, c = h * 128 + d;
            float wg[16];
#pragma unroll
            for (int r = 0; r < 16; ++r) wg[r] = w2[r * 512 + c];
            const float bz = b2[c];
            for (int i = tid >> 7; i < 64; i += 4) {
                float z = bz;
#pragma unroll
                for (int r = 0; r < 16; ++r) z += sGlr[i * 16 + r] * wg[r];
                sBc[i * 129 + d] = -softplusf_(-z) * (1.f / 16.f);
            }
        }
        for (int e = tid; e < 64 * 36; e += NTHREADS) ((unsigned*)bATT)[e] = 0u;
        __syncthreads();
        if (tid < 128) { float a = 0.f; for (int i = 0; i < 64; ++i) { a += sBc[i * 129 + tid]; sBc[i * 129 + tid] = a; } }
        __syncthreads();
        for (int e = tid; e < 8192; e += NTHREADS) {
            const int i = e >> 7, d = e & 127;
            const float bb = sBc[i * 129 + d], bl = sBc[63 * 129 + d];
            const float qf = PBF(P, t0 + i, h * 128 + d), kf = PBF(P, t0 + i, 512 + h * 128 + d);
            *(bf16_t*)(bQE + i * SN + d * 2) = f2bf(qf * SCALE128 * expf(bb));
            *(bf16_t*)(bKE + i * SN + d * 2) = f2bf(kf * expf(-bb));
            *(bf16_t*)(bKD + d * ST + i * 2) = f2bf(kf * expf(bl - bb));
        }
        for (int e = tid; e < 16384; e += NTHREADS) { const int i = e >> 8, dv = e & 255; *(bf16_t*)(bVT + dv * ST + i * 2) = P[(size_t)(t0 + i) * LDPB + 1024 + h * 256 + dv]; }
        if (tid < 128) EBL[ci * 128 + tid] = expf(sBc[63 * 129 + tid]);
        __syncthreads();
        for (int u = wv; u < 10; u += 8) {
            const int ti = (u >= 6) ? 3 : (u >= 3) ? 2 : (u >= 1) ? 1 : 0, tj = u - ((ti * (ti + 1)) >> 1);
            f32x4 acc = (f32x4){0.f, 0.f, 0.f, 0.f};
            acc = mma_lds(bQE, SN, 16 * ti, bKE, SN, 16 * tj, 128, acc, c16, q4);
            const int j = 16 * tj + c16;
#pragma unroll
            for (int r = 0; r < 4; ++r) { const int i = 16 * ti + 4 * q4 + r; *(bf16_t*)(bATT + i * ST + j * 2) = f2bf((j <= i) ? acc[r] : 0.f); }
        }
        for (int x = 0; x < 2; ++x) {
            const int u = wv * 2 + x, ti = u >> 2, a = u & 3;
            const unsigned char* rp = bQE + (16 * ti + c16) * SN;
            const uint2 lo = *(const uint2*)(rp + (32 * a + 4 * q4) * 2), hi = *(const uint2*)(rp + (32 * a + 16 + 4 * q4) * 2);
            QEF[((size_t)(ci * 4 + ti) * 4 + a) * 64 + lane] = make_uint4(lo.x, lo.y, hi.x, hi.y);
        }
        __syncthreads();
        for (int x = 0; x < 8; ++x) {
            const int u = wv * 8 + x, tdv = u >> 2, ti = u & 3;
            f32x4 acc = (f32x4){0.f, 0.f, 0.f, 0.f};
            acc = mma_lds(bATT, ST, 16 * ti, bVT, ST, 16 * tdv, 64, acc, c16, q4);
            OIF[((size_t)(ci * 16 + tdv) * 4 + ti) * 64 + lane] = pack4(acc);
        }
        for (int x = 0; x < 16; ++x) {
            const int u = wv * 16 + x, tdv = u >> 3, tdk = u & 7;
            f32x4 acc = (f32x4){0.f, 0.f, 0.f, 0.f};
            acc = mma_lds(bKD, ST, 16 * tdk, bVT, ST, 16 * tdv, 64, acc, c16, q4);
            HF[((size_t)(ci * 16 + tdv) * 8 + tdk) * 64 + lane] = pack4(acc);
        }
    }
}

PHASE_FN void ph_gla_scan(const Params& p, float* smem) {
    unsigned char* ws_ = p.ws; asm volatile("" : "+s"(ws_));
    int tid_ = threadIdx.x; asm volatile("" : "+v"(tid_)); const int tid = tid_, lane = tid & 63, wv = __builtin_amdgcn_readfirstlane(tid >> 6), q4 = lane >> 4, c16 = lane & 15;
    int ldz_ = 0; asm volatile("" : "+s"(ldz_)); unsigned char* lds = g_smem + ldz_;
    constexpr int STG = 29184;
    const unsigned char* QEF = ws_ + OFF_GQE; const unsigned char* HF = ws_ + OFF_GH; const unsigned char* OIF = ws_ + OFF_GOI; const unsigned char* EBL = ws_ + OFF_GEBL;
    float* O = (float*)(ws_ + OFF_O);
    for (int it = blockIdx.x; it < 64; it += gridDim.x) {
        const int bh = it >> 3, pair = it & 7, b = bh >> 2, h = bh & 3;
        __syncthreads();
        if (wv >= 2) {
            const int lt = tid - 128;
            const unsigned char* Qb = QEF + (size_t)bh * 128 * 16384;
            const unsigned char* Hb = HF + (size_t)bh * 128 * 65536 + pair * 8192;
            const unsigned char* Ob = OIF + (size_t)bh * 128 * 32768 + pair * 4096;
            const unsigned char* Lb = EBL + (size_t)bh * 128 * 512;
            uint4 ra0, ra1, ra2, ra3, ra4, ra5, ra6, rb0, rb1, rb2, rb3, rb4, rb5, rb6, rc0, rc1, rc2, rc3, rc4, rc5, rc6, rd0, rd1, rd2, rd3, rd4, rd5, rd6;
#define GL_LOAD(X, n_) do { const unsigned char* q_ = Qb + (size_t)(n_) * 16384; const unsigned char* h_ = Hb + (size_t)(n_) * 65536; \
                const unsigned char* o_ = Ob + (size_t)(n_) * 32768; const unsigned char* l_ = Lb + (size_t)(n_) * 512; \
                X##0 = LDC(q_, lt, 1023); X##1 = LDC(q_, lt + 384, 1023); X##2 = LDC(q_, lt + 768, 1023); \
                X##3 = LDC(h_, lt, 511); X##4 = LDC(h_, lt + 384, 511); X##5 = LDC(o_, lt, 255); X##6 = LDC(l_, lt, 31); } while (0)
#define GL_STORE(X, st_) do { unsigned char* sb_ = lds + (st_) * STG; \
                STC(0, lt, 1024, X##0); STC(0, lt + 384, 1024, X##1); STC(0, lt + 768, 1024, X##2); \
                STC(16384, lt, 512, X##3); STC(16384, lt + 384, 512, X##4); STC(24576, lt, 256, X##5); STC(28672, lt, 32, X##6); } while (0)
            GL_LOAD(ra, 0); GL_STORE(ra, 0);
            GL_LOAD(rb, 1); GL_LOAD(rc, 2); GL_LOAD(rd, 3); GL_LOAD(ra, 4);
            __syncthreads();
            for (int n = 0; n < 128; n += 4) {
                GL_STORE(rb, 1); GL_LOAD(rb, CLAMPN(n + 5)); __syncthreads();
                GL_STORE(rc, 0); GL_LOAD(rc, CLAMPN(n + 6)); __syncthreads();
                GL_STORE(rd, 1); GL_LOAD(rd, CLAMPN(n + 7)); __syncthreads();
                if (n + 4 < 128) GL_STORE(ra, 0);
                GL_LOAD(ra, CLAMPN(n + 8)); __syncthreads();
            }
        } else {
            const int tdv = pair * 2 + wv;
            f32x4 S[8];
#pragma unroll
            for (int t = 0; t < 8; ++t) S[t] = (f32x4){0.f, 0.f, 0.f, 0.f};
            __syncthreads();
            for (int n = 0; n < 128; ++n) {
                const unsigned char* base = lds + (n & 1) * STG;
                const unsigned char* Qf = base + lane * 16, *Hf = base + 16384 + wv * 4096 + lane * 8, *Of = base + 24576 + wv * 2048 + lane * 8, *Lf = base + 28672 + q4 * 16;
                bf16x8 Sb[4];
#pragma unroll
                for (int a = 0; a < 4; ++a) { union { uint4 u; bf16x8 v; } cv; const uint2 lo = pack4(S[2 * a]), hi = pack4(S[2 * a + 1]); cv.u.x = lo.x; cv.u.y = lo.y; cv.u.z = hi.x; cv.u.w = hi.y; Sb[a] = cv.v; }
                const int t0 = b * 8192 + n * 64;
                f32x4 oa[4];
#pragma unroll
                for (int ti = 0; ti < 4; ++ti) oa[ti] = unpack4(*(const uint2*)(Of + ti * 512));
#pragma unroll
                for (int a = 0; a < 4; ++a)
#pragma unroll
                    for (int ti = 0; ti < 4; ++ti) oa[ti] = __builtin_amdgcn_mfma_f32_16x16x32_bf16(*(const bf16x8*)(Qf + (ti * 4 + a) * 1024), Sb[a], oa[ti], 0, 0, 0);
#pragma unroll
                for (int ti = 0; ti < 4; ++ti) {
                    float* op = O + (size_t)(t0 + 16 * ti + 4 * q4) * 1024 + h * 256 + 16 * tdv + c16;
                    op[0] = oa[ti][0]; op[1024] = oa[ti][1]; op[2048] = oa[ti][2]; op[3072] = oa[ti][3]; }
#pragma unroll
                for (int t = 0; t < 8; ++t) { const f32x4 lam = *(const f32x4*)(Lf + t * 64); S[t] = S[t] * lam + unpack4(*(const uint2*)(Hf + t * 512)); }
                __syncthreads();
            }
        }
    }
}

PHASE_FN void ph_gla_out(const Params& p, int layer) {
    unsigned char* ws_ = p.ws; asm volatile("" : "+s"(ws_));
    int tid_ = threadIdx.x; asm volatile("" : "+v"(tid_)); const int tid = tid_, lane = tid & 63, wv = tid >> 6;
    const float* O = (const float*)(ws_ + OFF_O); const bf16_t* P = (const bf16_t*)(ws_ + OFF_P); bf16_t* OB = (bf16_t*)(ws_ + OFF_OB);
    const float* onw = p.gla_out_norm + (layer >> 1) * 256;
    for (int t = blockIdx.x * 8 + wv; t < NT; t += gridDim.x * 8) {
#pragma unroll
        for (int h = 0; h < 4; ++h) {
            const float* op = O + (size_t)t * 1024 + h * 256;
            const float4 o = *(const float4*)(op + lane * 4);
            const float ss = wave_sum(o.x * o.x + o.y * o.y + o.z * o.z + o.w * o.w);
            const float r = rsqrtf(ss * (1.f / 256.f) + EPS);
            const f32x4 z = unpack4(*(const uint2*)(P + (size_t)t * LDPB + 2048 + h * 256 + lane * 4));
            const float4 w = *(const float4*)(onw + lane * 4);
            f32x4 ov; ov[0] = o.x * r * w.x * siluf_(z[0]); ov[1] = o.y * r * w.y * siluf_(z[1]); ov[2] = o.z * r * w.z * siluf_(z[2]); ov[3] = o.w * r * w.w * siluf_(z[3]);
            *(uint2*)(OB + (size_t)t * 1024 + h * 256 + lane * 4) = pack4(ov);
        }
    }
}

template <int PH>
__device__ __forceinline__ void run_phase(const Params& p, int layer, float* smem) {
    if (PH == PH_PROLOGUE) { ph_prologue(p, smem); ph_conv_dense(p, smem); }
    else if (PH == PH_NORM_MIX) ph_rows(p, layer, 0, smem);
    else if (PH == PH_GEMM_IN_EVEN) ph_gemm_in(p, layer, true, smem);
    else if (PH == PH_EVEN_TOK) { ph_even_tok(p, layer, smem); ph_gdn_chunk(p, layer, smem); }
    else if (PH == PH_GDN_CHUNK) ph_gdn_chunk(p, layer, smem);
    else if (PH == PH_GDN_SCAN) { ph_gdn_scan(p, smem); ph_conv_exp(p, layer, smem, 32); ph_dsa_topk(p, layer, smem); }
    else if (PH == PH_DSA_TOPK) ph_dsa_topk(p, layer, smem);
    else if (PH == PH_DSA_ATTN) { ph_dsa_attn(p, smem); ph_gdn_out(p, layer); }
    else if (PH == PH_GDN_OUT) ph_gdn_out(p, layer);
    else if (PH == PH_GEMM_OUT) ph_gemm_out(p, layer, smem);
    else if (PH == PH_NORM_FFN) ph_norm_ffn(p, layer);
    else if (PH == PH_MOE1) ph_moe(p, layer, 0, smem);
    else if (PH == PH_MOE2) ph_moe(p, layer, 1, smem);
    else if (PH == PH_GEMM_IN_ODD) ph_gemm_in(p, layer, false, smem);
    else if (PH == PH_GLA_TOK) ph_gla_tok(p, layer);
    else if (PH == PH_GLA_CHUNK) ph_gla_chunk(p, layer, smem);
    else if (PH == PH_GLA_SCAN) { ph_gla_scan(p, smem); ph_conv_exp(p, layer, smem, 64); }
    else if (PH == PH_GLA_OUT) ph_gla_out(p, layer);
    else if (PH == PH_FINAL) ph_rows(p, 0, 1, smem);
}

#if MK_MULTI
template <int PH>
__global__ void __launch_bounds__(NTHREADS, 2) k_phase(Params p, int layer) {
    run_phase<PH>(p, layer, (float*)g_smem);
}
#else
__global__ void __launch_bounds__(NTHREADS, 2) k_mega(Params p) {
    float* smem = (float*)g_smem;
    volatile LAS unsigned* xbw = (volatile LAS unsigned*)(LAS unsigned char*)(g_smem + LDS_BYTES - 16);
    if (threadIdx.x == 0) { xbw[0] = 0u; xbw[1] = 0u; xbw[2] = 0u; xbw[3] = 0u; }
    __syncthreads();
    XcdBarrier bar = xcd_barrier_post((unsigned*)(p.ws + OFF_BAR), xbw);
#define BAR() xcd_barrier(bar)
    run_phase<PH_PROLOGUE>(p, 0, smem); BAR(); if (DUP_MASK & 4096) { run_phase<PH_PROLOGUE>(p, 0, smem); BAR(); }
    for (int lp = 0; lp < 2; ++lp) {
        const int le = 2 * lp, lo = 2 * lp + 1;
        run_phase<PH_NORM_MIX>(p, le, smem); BAR();
        run_phase<PH_GEMM_IN_EVEN>(p, le, smem); BAR(); if (DUP_MASK & 1) { run_phase<PH_GEMM_IN_EVEN>(p, le, smem); BAR(); }
        run_phase<PH_EVEN_TOK>(p, le, smem); BAR(); if (DUP_MASK & 2) { run_phase<PH_EVEN_TOK>(p, le, smem); BAR(); }
        run_phase<PH_GDN_SCAN>(p, le, smem); BAR(); if (DUP_MASK & 8) { run_phase<PH_GDN_SCAN>(p, le, smem); BAR(); }
        run_phase<PH_DSA_ATTN>(p, le, smem); BAR(); if (DUP_MASK & 32) { run_phase<PH_DSA_ATTN>(p, le, smem); BAR(); }
        run_phase<PH_GEMM_OUT>(p, le, smem); BAR();
        run_phase<PH_NORM_FFN>(p, le, smem); BAR();
        run_phase<PH_MOE1>(p, le, smem); BAR(); if (DUP_MASK & 64) { run_phase<PH_MOE1>(p, le, smem); BAR(); }
        run_phase<PH_MOE2>(p, le, smem); BAR(); if (DUP_MASK & 128) { run_phase<PH_MOE2>(p, le, smem); BAR(); }
        run_phase<PH_NORM_MIX>(p, lo, smem); BAR();
        run_phase<PH_GEMM_IN_ODD>(p, lo, smem); BAR(); if (DUP_MASK & 256) { run_phase<PH_GEMM_IN_ODD>(p, lo, smem); BAR(); }
        run_phase<PH_GLA_CHUNK>(p, lo, smem); BAR(); if (DUP_MASK & 1024) { run_phase<PH_GLA_CHUNK>(p, lo, smem); BAR(); }
        run_phase<PH_GLA_SCAN>(p, lo, smem); BAR(); if (DUP_MASK & 2048) { run_phase<PH_GLA_SCAN>(p, lo, smem); BAR(); }
        run_phase<PH_GLA_OUT>(p, lo, smem); BAR();
        run_phase<PH_GEMM_OUT>(p, lo, smem); BAR();
        run_phase<PH_NORM_FFN>(p, lo, smem); BAR();
        run_phase<PH_MOE1>(p, lo, smem); BAR(); if (DUP_MASK & 64) { run_phase<PH_MOE1>(p, lo, smem); BAR(); }
        run_phase<PH_MOE2>(p, lo, smem); BAR(); if (DUP_MASK & 128) { run_phase<PH_MOE2>(p, lo, smem); BAR(); }
    }
    for (int xb = 0; xb < EXTRA_BARS; ++xb) BAR();
    run_phase<PH_FINAL>(p, 0, smem);
}
#endif

}

#if MK_MULTI
template <int PH>
static void launch_phase(const Params& p, int layer, hipStream_t stream) {
    static bool attr_set = false;
    if (!attr_set) { hipFuncSetAttribute((const void*)k_phase<PH>, hipFuncAttributeMaxDynamicSharedMemorySize, (int)LDS_BYTES); attr_set = true; }
    hipLaunchKernelGGL((k_phase<PH>), dim3(256), dim3(NTHREADS), LDS_BYTES, stream, p, layer);
}
#endif

extern "C" void kernel_launch(void* const* d_in, const int* in_sizes, int n_in, void* d_out, int out_size, void* d_ws, size_t ws_size, hipStream_t stream) {
    (void)in_sizes; (void)n_in; (void)out_size;
    if (ws_size < WS_NEEDED) { fprintf(stderr, "workspace too small: %zu < %zu\n", ws_size, (size_t)WS_NEEDED); return; }
    Params p{};
    p.x = (const float*)d_in[0]; p.c = (const float*)d_in[1]; p.pos = (const int*)d_in[2]; p.ada_w = (const float*)d_in[3]; p.ada_b = (const float*)d_in[4];
    p.norm_mix = (const float*)d_in[5]; p.norm_ffn = (const float*)d_in[6]; p.even_w_in = (const float*)d_in[7]; p.conv_w = (const float*)d_in[8];
    p.a_log = (const float*)d_in[9]; p.dt_bias = (const float*)d_in[10]; p.gdn_out_norm = (const float*)d_in[11]; p.even_w_out = (const float*)d_in[12];
    p.gla_w_in = (const float*)d_in[13]; p.gla_w_gate2 = (const float*)d_in[14]; p.gla_b_gate2 = (const float*)d_in[15]; p.gla_out_norm = (const float*)d_in[16]; p.gla_w_out = (const float*)d_in[17];
    p.rg_w = (const float*)d_in[18]; p.rg_b = (const float*)d_in[19]; p.re_w = (const float*)d_in[20]; p.re_b = (const float*)d_in[21];
    p.w1 = (const float*)d_in[22]; p.w3 = (const float*)d_in[23]; p.w2 = (const float*)d_in[24]; p.final_norm = (const float*)d_in[25];
    p.X = (float*)d_out; p.ws = (unsigned char*)d_ws;
    p.rA = pow(10000.0, -2.0 / 128.0); p.rI = pow(10000.0, -2.0 / 64.0);
    hipMemsetAsync(d_ws, 0, ZERO_BYTES, stream);
#if MK_MULTI
    launch_phase<PH_PROLOGUE>(p, 0, stream);
    for (int lp = 0; lp < 2; ++lp) {
        const int le = 2 * lp, lo = 2 * lp + 1;
        launch_phase<PH_NORM_MIX>(p, le, stream);
        launch_phase<PH_GEMM_IN_EVEN>(p, le, stream);
        launch_phase<PH_EVEN_TOK>(p, le, stream);
        launch_phase<PH_GDN_SCAN>(p, le, stream);
        launch_phase<PH_DSA_ATTN>(p, le, stream);
        launch_phase<PH_GEMM_OUT>(p, le, stream);
        launch_phase<PH_NORM_FFN>(p, le, stream);
        launch_phase<PH_MOE1>(p, le, stream);
        launch_phase<PH_MOE2>(p, le, stream);
        launch_phase<PH_NORM_MIX>(p, lo, stream);
        launch_phase<PH_GEMM_IN_ODD>(p, lo, stream);
        launch_phase<PH_GLA_CHUNK>(p, lo, stream);
        launch_phase<PH_GLA_SCAN>(p, lo, stream);
        launch_phase<PH_GLA_OUT>(p, lo, stream);
        launch_phase<PH_GEMM_OUT>(p, lo, stream);
        launch_phase<PH_NORM_FFN>(p, lo, stream);
        launch_phase<PH_MOE1>(p, lo, stream);
        launch_phase<PH_MOE2>(p, lo, stream);
    }
    launch_phase<PH_FINAL>(p, 0, stream);
#else
    static int grid = 0;
    if (!grid) {
        int dev = 0, cus = 0, per_cu = 0;
        hipGetDevice(&dev);
        hipDeviceGetAttribute(&cus, hipDeviceAttributeMultiprocessorCount, dev);
        hipFuncSetAttribute((const void*)k_mega, hipFuncAttributeMaxDynamicSharedMemorySize, (int)LDS_BYTES);
        hipOccupancyMaxActiveBlocksPerMultiprocessor(&per_cu, k_mega, NTHREADS, LDS_BYTES);
        if (cus <= 0) cus = 256;
        grid = cus * (per_cu < 1 ? 1 : 1);
    }
    hipLaunchKernelGGL(k_mega, dim3(grid), dim3(NTHREADS), LDS_BYTES, stream, p);
#endif
}
```

```cpp
#include <hip/hip_runtime.h>
#include <stdint.h>
#include <math.h>
#include <stdio.h>

#define EXTRA_BARS 0
#define TOPK_SEARCH_REP 1
#ifndef DUP_MASK
#define DUP_MASK 0
#endif
#ifndef MK_MULTI
#define MK_MULTI 0
#endif

namespace {

constexpr int NT = 16384, ND = 1024, LDP = 3920, LDPB = 3968;
constexpr float EPS = 1e-6f;
constexpr int NTHREADS = 512;
constexpr size_t LDS_BYTES = 147456;
constexpr float SCALE128 = 0.08838834764831845f;
constexpr int LISTCAP = 32768;
constexpr int CSTR = 16;

constexpr size_t OFF_BAR  = 0;
constexpr size_t OFF_CNT  = 16384;
constexpr size_t ZERO_BYTES = 32768;
constexpr size_t OFF_QCTR = 28672;
constexpr size_t OFF_MOD  = 32768;
constexpr size_t OFF_COSA = OFF_MOD + 4 * 2 * 6144 * 4;
constexpr size_t OFF_SINA = OFF_COSA + (size_t)NT * 64 * 4;
constexpr size_t OFF_COSI = OFF_SINA + (size_t)NT * 64 * 4;
constexpr size_t OFF_SINI = OFF_COSI + (size_t)NT * 32 * 4;
constexpr size_t OFF_H    = OFF_SINI + (size_t)NT * 32 * 4;
constexpr size_t OFF_P    = OFF_H + (size_t)NT * 1024 * 4;
constexpr size_t OFF_HID  = OFF_P;
constexpr size_t OFF_YB   = OFF_HID + (size_t)36864 * 512 * 4;
constexpr size_t OFF_O    = OFF_P + (size_t)NT * LDP * 4;
constexpr size_t OFF_ASG  = OFF_O + (size_t)NT * 1024 * 4;
constexpr size_t OFF_GATE = OFF_ASG + (size_t)NT * 4 * 4;
constexpr size_t OFF_LIST = OFF_GATE + (size_t)NT * 2 * 4;
constexpr size_t OFF_R    = OFF_LIST + (size_t)32 * LISTCAP * 4;
constexpr size_t OFF_QN   = OFF_R;
constexpr size_t OFF_KN   = OFF_QN + (size_t)NT * 512 * 4;
constexpr size_t OFF_VC   = OFF_KN + (size_t)NT * 512 * 4;
constexpr size_t OFF_BETA = OFF_VC + (size_t)NT * 512 * 4;
constexpr size_t OFF_G    = OFF_BETA + (size_t)NT * 4 * 4;
constexpr size_t OFF_W    = OFF_G + (size_t)NT * 4 * 4;
constexpr size_t OFF_U    = OFF_W + (size_t)1024 * 8192 * 4;
constexpr size_t OFF_QG   = OFF_U + (size_t)1024 * 8192 * 4;
constexpr size_t OFF_KD   = OFF_QG + (size_t)1024 * 8192 * 4;
constexpr size_t OFF_AQK  = OFF_KD + (size_t)1024 * 8192 * 4;
constexpr size_t OFF_GL   = OFF_AQK + (size_t)1024 * 4096 * 4;
constexpr size_t OFF_QB   = OFF_GL + 4096;
constexpr size_t OFF_KB   = OFF_QB + (size_t)NT * 512 * 4;
constexpr size_t OFF_QI   = OFF_KB + (size_t)NT * 512 * 4;
constexpr size_t OFF_KI   = OFF_QI + (size_t)NT * 256 * 4;
constexpr size_t OFF_WI   = OFF_KI + (size_t)NT * 64 * 4;
constexpr size_t OFF_SEL  = OFF_WI + (size_t)NT * 4 * 4;
constexpr size_t OFF_EVEN_END = OFF_SEL + (size_t)NT * 256 * 4;
constexpr size_t OFF_PFR  = OFF_W;
constexpr size_t OFF_RFR  = OFF_PFR + (size_t)1024 * 32768;
constexpr size_t OFF_QFR  = OFF_RFR + (size_t)1024 * 16384;
constexpr size_t OFF_OFR  = OFF_QFR + (size_t)1024 * 32768;
static_assert(OFF_OFR + (size_t)1024 * 16384 <= OFF_GL, "gdn v2 buffers overflow");
constexpr size_t OFF_QBB  = OFF_QB;
constexpr size_t OFF_KBB  = OFF_QBB + (size_t)NT * 512 * 2;
constexpr size_t OFF_VT   = OFF_KBB + (size_t)NT * 512 * 2;
constexpr size_t OFF_QIB  = OFF_VT + (size_t)NT * 512 * 2;
constexpr size_t OFF_KIB  = OFF_QIB + (size_t)NT * 256 * 2;
constexpr size_t OFF_M16  = OFF_KIB + (size_t)NT * 64 * 2;
static_assert(OFF_M16 + (size_t)NT * 512 * 2 <= OFF_WI, "dsa v2 buffers overflow");
constexpr size_t OFF_LA   = OFF_R;
constexpr size_t OFF_ATT  = OFF_LA + (size_t)NT * 512 * 4;
constexpr size_t OFF_QE   = OFF_ATT + (size_t)1024 * 4096 * 4;
constexpr size_t OFF_GKD  = OFF_QE + (size_t)1024 * 8192 * 4;
constexpr size_t OFF_EBL  = OFF_GKD + (size_t)1024 * 8192 * 4;
constexpr size_t OFF_GQE  = OFF_LA + (size_t)NT * 512 * 4;
constexpr size_t OFF_GOI  = OFF_GQE + (size_t)1024 * 16384;
constexpr size_t OFF_GH   = OFF_GOI + (size_t)1024 * 32768;
constexpr size_t OFF_GEBL = OFF_GH + (size_t)1024 * 65536;
static_assert(OFF_GEBL + (size_t)1024 * 512 <= OFF_EVEN_END, "gla v2 buffers overflow");
constexpr size_t OFF_WINE = OFF_EVEN_END;
constexpr size_t OFF_WINO = OFF_WINE + (size_t)2 * 3968 * 1024 * 2;
constexpr size_t OFF_WOUT = OFF_WINO + (size_t)2 * 3200 * 1024 * 2;
constexpr size_t OFF_W13  = OFF_WOUT + (size_t)4 * 1024 * 1024 * 2;
constexpr size_t OFF_W2T  = OFF_W13 + (size_t)32 * 1024 * 1024 * 2;
constexpr size_t OFF_OB   = OFF_W2T + (size_t)32 * 1024 * 512 * 2;
constexpr size_t OFF_AUX  = OFF_OB + (size_t)NT * 1024 * 2;
constexpr size_t WS_NEEDED = OFF_AUX + (size_t)NT * 16 * 4;

struct Params {
    const float* x; const float* c; const int* pos; const float* ada_w; const float* ada_b;
    const float* norm_mix; const float* norm_ffn; const float* even_w_in; const float* conv_w;
    const float* a_log; const float* dt_bias; const float* gdn_out_norm; const float* even_w_out;
    const float* gla_w_in; const float* gla_w_gate2; const float* gla_b_gate2; const float* gla_out_norm; const float* gla_w_out;
    const float* rg_w; const float* rg_b; const float* re_w; const float* re_b;
    const float* w1; const float* w3; const float* w2; const float* final_norm;
    float* X;
    unsigned char* ws;
    double rA, rI;
};

#define XB_TMO      128
#define XB_XCNT(j)  (256  + 64 * (j))
#define XB_XSUB(j)  (1280 + 64 * (j))
#define XB_XGEN(j)  (2304 + 64 * (j))
#define XB_TOP      3328
#define XB_TOPGEN   3392
#define XCD_BAR_WORDS 3456
#define XB_SPIN_CAP (1u << 18)
#define LAS __attribute__((address_space(3)))

__device__ __forceinline__ unsigned xb_ld(unsigned* p)              { return __hip_atomic_load(p, __ATOMIC_RELAXED, __HIP_MEMORY_SCOPE_AGENT); }
__device__ __forceinline__ unsigned xb_add(unsigned* p, unsigned v) { return __hip_atomic_fetch_add(p, v, __ATOMIC_RELAXED, __HIP_MEMORY_SCOPE_AGENT); }
__device__ __forceinline__ unsigned xb_xcc_id() { return (unsigned)__builtin_amdgcn_s_getreg((3 << 11) | 20) & 0xFu; }
#define XB_SPIN(cond, bar) do { unsigned _sp = 0; while (cond) { __builtin_amdgcn_s_sleep(1); \
    if ((++_sp & 255u) == 0u) { if (xb_ld(&(bar)[XB_TMO])) break; if (_sp > XB_SPIN_CAP) { atomicAdd(&(bar)[XB_TMO], 1u); break; } } } } while (0)

struct XcdBarrier { unsigned* bar; unsigned x; volatile LAS unsigned* st; };

__device__ __forceinline__ XcdBarrier xcd_barrier_post(unsigned* bar, volatile LAS unsigned* st) {
    XcdBarrier b; b.bar = bar; b.x = xb_xcc_id(); b.st = st;
    if (threadIdx.x == 0) (void)xb_add(&bar[XB_XCNT(b.x)], 1u);
    return b;
}
__device__ __forceinline__ void xcd_barrier_complete(unsigned* bar, unsigned x, unsigned& nloc, unsigned& nx) {
    const unsigned G = gridDim.x * gridDim.y * gridDim.z;
    unsigned sum, cnt, mine, sp = 0u;
    for (;;) {
        sum = 0u; cnt = 0u; mine = 0u;
#pragma unroll
        for (unsigned j = 0; j < 16; ++j) { const unsigned c = xb_ld(&bar[XB_XCNT(j)]); sum += c; cnt += (c > 0u) ? 1u : 0u; mine = (j == x) ? c : mine; }
        if (sum == G) break;
        __builtin_amdgcn_s_sleep(1);
        if ((++sp & 255u) == 0u) { if (xb_ld(&bar[XB_TMO])) break; if (sp > XB_SPIN_CAP) { atomicAdd(&bar[XB_TMO], 1u); break; } }
    }
    nloc = mine > 0u ? mine : 1u; nx = cnt > 0u ? cnt : 1u;
}
__device__ __forceinline__ void xcd_barrier(const XcdBarrier& b) {
    asm volatile("s_waitcnt vmcnt(0)" ::: "memory");
    __syncthreads();
    if (threadIdx.x == 0) {
        unsigned* bar = b.bar;
        __builtin_amdgcn_s_waitcnt(0);
        unsigned nloc = b.st[0], nx = b.st[1];
        if (nloc == 0u) { xcd_barrier_complete(bar, b.x, nloc, nx); b.st[0] = nloc; b.st[1] = nx; }
        const unsigned old = xb_add(&bar[XB_XSUB(b.x)], 1u);
        const unsigned gen = old / nloc;
        if (old + 1u == (gen + 1u) * nloc) {
            __builtin_amdgcn_fence(__ATOMIC_RELEASE, "agent");
            asm volatile("s_waitcnt vmcnt(0)" ::: "memory");
            const unsigned og = xb_add(&bar[XB_TOP], 1u);
            const unsigned tg = og / nx;
            if (og + 1u == (tg + 1u) * nx) xb_add(&bar[XB_TOPGEN], 1u);
            else XB_SPIN(xb_ld(&bar[XB_TOPGEN]) == tg, bar);
            __builtin_amdgcn_fence(__ATOMIC_ACQUIRE, "agent");
            xb_add(&bar[XB_XGEN(b.x)], 1u);
            asm volatile("s_waitcnt vmcnt(0)" ::: "memory");
        } else {
            XB_SPIN(xb_ld(&bar[XB_XGEN(b.x)]) == gen, bar);
            __builtin_amdgcn_fence(__ATOMIC_ACQUIRE, "agent");
            asm volatile("s_waitcnt vmcnt(0)" ::: "memory");
        }
    }
    __syncthreads();
}

__device__ __forceinline__ float wave_sum(float v) {
#pragma unroll
    for (int o = 32; o > 0; o >>= 1) v += __shfl_xor(v, o);
    return v;
}
__device__ __forceinline__ int wave_sum_i(int v) {
#pragma unroll
    for (int o = 32; o > 0; o >>= 1) v += __shfl_xor(v, o);
    return v;
}
__device__ __forceinline__ float wave_max(float v) {
#pragma unroll
    for (int o = 32; o > 0; o >>= 1) v = fmaxf(v, __shfl_xor(v, o));
    return v;
}
__device__ __forceinline__ float sigmoidf_(float x) { return 1.f / (1.f + expf(-x)); }
__device__ __forceinline__ float siluf_(float x) { return x / (1.f + expf(-x)); }
__device__ __forceinline__ float softplusf_(float x) { return fmaxf(x, 0.f) + log1pf(expf(-fabsf(x))); }
__device__ __forceinline__ unsigned ordkey(float f) { const unsigned u = __float_as_uint(f); return (u & 0x80000000u) ? ~u : (u | 0x80000000u); }

__device__ __forceinline__ void sincos_d(double a, double& s, double& c) {
    const double kq = rint(a * 0.63661977236758134308);
    double r = fma(-kq, 1.57079632673412561417e+00, a);
    r = fma(-kq, 6.07710050650619224932e-11, r);
    const int q = (int)((long long)kq & 3);
    const double r2 = r * r;
    const double sp = r * (1.0 + r2 * (-1.0 / 6 + r2 * (1.0 / 120 + r2 * (-1.0 / 5040 + r2 * (1.0 / 362880 + r2 * (-1.0 / 39916800 + r2 * (1.0 / 6227020800.0)))))));
    const double cp = 1.0 + r2 * (-0.5 + r2 * (1.0 / 24 + r2 * (-1.0 / 720 + r2 * (1.0 / 40320 + r2 * (-1.0 / 3628800 + r2 * (1.0 / 479001600.0 + r2 * (-1.0 / 87178291200.0)))))));
    if (q == 0) { s = sp; c = cp; } else if (q == 1) { s = cp; c = -sp; } else if (q == 2) { s = -sp; c = -cp; } else { s = -cp; c = sp; }
}
__device__ __forceinline__ double ipow_d(double b, int e) { double v = 1.0; while (e) { if (e & 1) v *= b; b *= b; e >>= 1; } return v; }

struct GemmArgs { const float* A; int lda; const int* rows; int m0; int mvalid; const float* B; int ldb; int n0; int N; int K; };

template <class Epi>
__device__ __forceinline__ void gemm128(const GemmArgs& g, float* smem, Epi epi) {
    float* As = smem;
    float* Bs = smem + 16 * 132;
    int tid_ = threadIdx.x; asm volatile("" : "+v"(tid_)); const int tid = tid_, ty = tid >> 4, tx = tid & 15;
    const int arow = tid >> 2, kq = (tid & 3) * 4;
    const int bk = tid >> 5, bn = (tid & 31) * 4;
    long asrc = -1;
    if (arow < g.mvalid) { const int r = g.rows ? g.rows[arow] : (g.m0 + arow); if (r >= 0) asrc = (long)r * g.lda; }
    const bool bval = (g.n0 + bn) < g.N;
    float acc[4][8];
#pragma unroll
    for (int i = 0; i < 4; ++i)
#pragma unroll
        for (int j = 0; j < 8; ++j) acc[i][j] = 0.f;
    for (int k0 = 0; k0 < g.K; k0 += 16) {
        float4 av = make_float4(0.f, 0.f, 0.f, 0.f), bv = make_float4(0.f, 0.f, 0.f, 0.f);
        if (asrc >= 0) av = *(const float4*)(g.A + asrc + k0 + kq);
        if (bval) bv = *(const float4*)(g.B + (size_t)(k0 + bk) * g.ldb + g.n0 + bn);
        __syncthreads();
        As[(kq + 0) * 132 + arow] = av.x; As[(kq + 1) * 132 + arow] = av.y; As[(kq + 2) * 132 + arow] = av.z; As[(kq + 3) * 132 + arow] = av.w;
        *(float4*)&Bs[bk * 132 + bn] = bv;
        __syncthreads();
#pragma unroll
        for (int kk = 0; kk < 16; ++kk) {
            const float4 a = *(const float4*)&As[kk * 132 + ty * 4];
            const float4 b0 = *(const float4*)&Bs[kk * 132 + tx * 8];
            const float4 b1 = *(const float4*)&Bs[kk * 132 + tx * 8 + 4];
            const float aa[4] = {a.x, a.y, a.z, a.w};
            const float bb[8] = {b0.x, b0.y, b0.z, b0.w, b1.x, b1.y, b1.z, b1.w};
#pragma unroll
            for (int i = 0; i < 4; ++i)
#pragma unroll
                for (int j = 0; j < 8; ++j) acc[i][j] += aa[i] * bb[j];
        }
    }
#pragma unroll
    for (int i = 0; i < 4; ++i) {
        const int r = ty * 4 + i;
        if (r < g.mvalid) {
#pragma unroll
            for (int j = 0; j < 8; ++j) { const int n = g.n0 + tx * 8 + j; if (n < g.N) epi(r, n, acc[i][j]); }
        }
    }
}


typedef short bf16x8 __attribute__((ext_vector_type(8)));
typedef float f32x4 __attribute__((ext_vector_type(4)));
typedef unsigned short bf16_t;
typedef __bf16 bf16x2_t __attribute__((ext_vector_type(2)));
typedef float f32x2_t __attribute__((ext_vector_type(2)));
__device__ __forceinline__ unsigned cvt_pk_bf16(float lo, float hi) { const f32x2_t v = {lo, hi}; const bf16x2_t r = __builtin_convertvector(v, bf16x2_t); return __builtin_bit_cast(unsigned, r); }
__device__ __forceinline__ bf16_t f2bf(float f) { return (bf16_t)(cvt_pk_bf16(f, 0.f) & 0xffffu); }
__device__ __forceinline__ float bf16_to_f32(bf16_t v) { return __uint_as_float(((unsigned)v) << 16); }
__device__ __forceinline__ uint2 pack4(const f32x4 v) { uint2 r; r.x = cvt_pk_bf16(v[0], v[1]); r.y = cvt_pk_bf16(v[2], v[3]); return r; }
__device__ __forceinline__ f32x4 unpack4(const uint2 u) { f32x4 r; r[0] = __uint_as_float(u.x << 16); r[1] = __uint_as_float(u.x & 0xffff0000u); r[2] = __uint_as_float(u.y << 16); r[3] = __uint_as_float(u.y & 0xffff0000u); return r; }
#define PBF(Pb_, t_, c_) bf16_to_f32((Pb_)[(size_t)(t_) * LDPB + (c_)])
__device__ __forceinline__ uint4 pack8(const float4 a, const float4 b) { uint4 r; r.x = cvt_pk_bf16(a.x, a.y); r.y = cvt_pk_bf16(a.z, a.w); r.z = cvt_pk_bf16(b.x, b.y); r.w = cvt_pk_bf16(b.z, b.w); return r; }
__device__ __forceinline__ int lds_off(int r, int c) { return r * 128 + ((c ^ (r & 7)) << 4); }

template <class ALoad, class BLoad, class Epi>
__device__ __forceinline__ void gemm_tile_bf16(const int K, unsigned char* lds, ALoad aload, BLoad bload, Epi epi, const int mrows = 256) {
    int tid_ = threadIdx.x; asm volatile("" : "+v"(tid_)); const int tid = tid_, lane = tid & 63, wid = tid >> 6, wm = wid >> 1, wn = wid & 1;
    f32x4 acc[4][4];
#pragma unroll
    for (int mi = 0; mi < 4; ++mi)
#pragma unroll
        for (int ni = 0; ni < 4; ++ni) acc[mi][ni] = (f32x4){0.f, 0.f, 0.f, 0.f};
    uint4 ra[4], rb[2];
    const int nk = K >> 6;
#pragma unroll
    for (int i = 0; i < 4; ++i) { const int q = tid + 512 * i; ra[i] = aload(i, q >> 3, (q & 7) * 8); }
#pragma unroll
    for (int i = 0; i < 2; ++i) { const int q = tid + 512 * i; rb[i] = bload(i, q >> 3, (q & 7) * 8); }
    __syncthreads();
#pragma unroll
    for (int i = 0; i < 4; ++i) { const int q = tid + 512 * i; *(uint4*)(lds + lds_off(q >> 3, q & 7)) = ra[i]; }
#pragma unroll
    for (int i = 0; i < 2; ++i) { const int q = tid + 512 * i; *(uint4*)(lds + 32768 + lds_off(q >> 3, q & 7)) = rb[i]; }
    __syncthreads();
    for (int kt = 0; kt < nk; ++kt) {
        if (kt + 1 < nk) {
#pragma unroll
            for (int i = 0; i < 4; ++i) { const int q = tid + 512 * i; ra[i] = aload(i, q >> 3, (kt + 1) * 64 + (q & 7) * 8); }
#pragma unroll
            for (int i = 0; i < 2; ++i) { const int q = tid + 512 * i; rb[i] = bload(i, q >> 3, (kt + 1) * 64 + (q & 7) * 8); }
        }
        const unsigned char* At = lds + (kt & 1) * 49152;
        const unsigned char* Bt = At + 32768;
        if (__builtin_amdgcn_readfirstlane(wm) * 64 < mrows) {
#pragma unroll
        for (int ks = 0; ks < 2; ++ks) {
            bf16x8 af[4], bfr[4];
            const int c = ks * 4 + (lane >> 4);
#pragma unroll
            for (int mi = 0; mi < 4; ++mi) af[mi] = *(const bf16x8*)(At + lds_off(wm * 64 + mi * 16 + (lane & 15), c));
#pragma unroll
            for (int ni = 0; ni < 4; ++ni) bfr[ni] = *(const bf16x8*)(Bt + lds_off(wn * 64 + ni * 16 + (lane & 15), c));
#pragma unroll
            for (int mi = 0; mi < 4; ++mi)
#pragma unroll
                for (int ni = 0; ni < 4; ++ni) acc[mi][ni] = __builtin_amdgcn_mfma_f32_16x16x32_bf16(bfr[ni], af[mi], acc[mi][ni], 0, 0, 0);
        }
        }
        if (kt + 1 < nk) {
            unsigned char* An = lds + ((kt + 1) & 1) * 49152;
#pragma unroll
            for (int i = 0; i < 4; ++i) { const int q = tid + 512 * i; *(uint4*)(An + lds_off(q >> 3, q & 7)) = ra[i]; }
#pragma unroll
            for (int i = 0; i < 2; ++i) { const int q = tid + 512 * i; *(uint4*)(An + 32768 + lds_off(q >> 3, q & 7)) = rb[i]; }
        }
        __syncthreads();
    }
    epi(acc, wm, wn, lane);
}

__device__ __forceinline__ void convert_tile(const float* src0, const float* src1, int mode, int K, int N, int ld, bf16_t* dst, int rt, int kt, float* smem) {
    int tid_ = threadIdx.x; asm volatile("" : "+v"(tid_)); const int tid = tid_;
    __syncthreads();
    { const int k = tid >> 3, R0 = rt * 64 + (tid & 7) * 8;
      const float* sp; int col;
      if (mode == 0) { sp = src0; col = R0; } else { sp = (R0 & 32) ? src1 : src0; col = (R0 >> 6) * 32 + (R0 & 31); }
      float4 a = make_float4(0.f, 0.f, 0.f, 0.f), b = a;
      const float* rp = sp + (size_t)(kt * 64 + k) * ld + col;
      if (col < N) a = *(const float4*)rp;
      if (col + 4 < N) b = *(const float4*)(rp + 4);
      float* d = smem + k * 65 + (tid & 7) * 8;
      d[0] = a.x; d[1] = a.y; d[2] = a.z; d[3] = a.w; d[4] = b.x; d[5] = b.y; d[6] = b.z; d[7] = b.w; }
    __syncthreads();
    { const int R = tid >> 3, kc = (tid & 7) * 8;
      float v[8];
#pragma unroll
      for (int j = 0; j < 8; ++j) v[j] = smem[(kc + j) * 65 + R];
      uint4 o; o.x = cvt_pk_bf16(v[0], v[1]); o.y = cvt_pk_bf16(v[2], v[3]); o.z = cvt_pk_bf16(v[4], v[5]); o.w = cvt_pk_bf16(v[6], v[7]);
      *(uint4*)(dst + (size_t)(rt * 64 + R) * K + kt * 64 + kc) = o; }
}

#define CT_LOAD(S0, S1, MODE, NN, LD, RT, KT, A, B) do { const int k_ = tid >> 3, R0_ = (RT) * 64 + (tid & 7) * 8; const float* sp_; int col_; \
        if ((MODE) == 0) { sp_ = (S0); col_ = R0_; } else { sp_ = (R0_ & 32) ? (S1) : (S0); col_ = (R0_ >> 6) * 32 + (R0_ & 31); } \
        A = make_float4(0.f, 0.f, 0.f, 0.f); B = A; const float* rp_ = sp_ + (size_t)((KT) * 64 + k_) * (LD) + col_; \
        if (col_ < (NN)) A = *(const float4*)rp_; if (col_ + 4 < (NN)) B = *(const float4*)(rp_ + 4); } while (0)
#define CT_WRITE(BUF, A, B) do { float* d_ = smem + (BUF) * 4160 + (tid >> 3) * 65 + (tid & 7) * 8; \
        d_[0] = A.x; d_[1] = A.y; d_[2] = A.z; d_[3] = A.w; d_[4] = B.x; d_[5] = B.y; d_[6] = B.z; d_[7] = B.w; } while (0)
#define CT_STORE(DST, KK, RT, KT, BUF) do { const int R_ = tid >> 3, kc_ = (tid & 7) * 8; const float* sb_ = smem + (BUF) * 4160; \
        uint4 o_; o_.x = cvt_pk_bf16(sb_[(kc_ + 0) * 65 + R_], sb_[(kc_ + 1) * 65 + R_]); o_.y = cvt_pk_bf16(sb_[(kc_ + 2) * 65 + R_], sb_[(kc_ + 3) * 65 + R_]); \
        o_.z = cvt_pk_bf16(sb_[(kc_ + 4) * 65 + R_], sb_[(kc_ + 5) * 65 + R_]); o_.w = cvt_pk_bf16(sb_[(kc_ + 6) * 65 + R_], sb_[(kc_ + 7) * 65 + R_]); \
        *(uint4*)((DST) + (size_t)((RT) * 64 + R_) * (KK) + (KT) * 64 + kc_) = o_; } while (0)
#define CT_DECL(I) const float* s0_##I; const float* s1_##I; bf16_t* d_##I; int md_##I, K_##I, N_##I, ld_##I, rt_##I, kt_##I
#define CT_ARGS(I) s0_##I, s1_##I, d_##I, md_##I, K_##I, N_##I, ld_##I, rt_##I, kt_##I
template <class Dec>
__device__ __forceinline__ void convert_tiles4(const Dec& dec, int t, int nj, float* smem) {
    int tid_ = threadIdx.x; asm volatile("" : "+v"(tid_)); const int tid = tid_;
    CT_DECL(0); CT_DECL(1); CT_DECL(2); CT_DECL(3);
    dec(t, CT_ARGS(0)); dec(t + 1, CT_ARGS(1)); dec(t + 2, CT_ARGS(2)); dec(t + 3, CT_ARGS(3));
    float4 a0, b0, a1, b1, a2, b2, a3, b3;
    a1 = b1 = a2 = b2 = a3 = b3 = make_float4(0.f, 0.f, 0.f, 0.f);
    CT_LOAD(s0_0, s1_0, md_0, N_0, ld_0, rt_0, kt_0, a0, b0);
    if (nj > 1) CT_LOAD(s0_1, s1_1, md_1, N_1, ld_1, rt_1, kt_1, a1, b1);
    if (nj > 2) CT_LOAD(s0_2, s1_2, md_2, N_2, ld_2, rt_2, kt_2, a2, b2);
    if (nj > 3) CT_LOAD(s0_3, s1_3, md_3, N_3, ld_3, rt_3, kt_3, a3, b3);
    __syncthreads();
    CT_WRITE(0, a0, b0); CT_WRITE(1, a1, b1); CT_WRITE(2, a2, b2); CT_WRITE(3, a3, b3);
    __syncthreads();
    CT_STORE(d_0, K_0, rt_0, kt_0, 0);
    if (nj > 1) CT_STORE(d_1, K_1, rt_1, kt_1, 1);
    if (nj > 2) CT_STORE(d_2, K_2, rt_2, kt_2, 2);
    if (nj > 3) CT_STORE(d_3, K_3, rt_3, kt_3, 3);
}

extern __shared__ __attribute__((aligned(16))) unsigned char g_smem[];
#define PHASE_FN __device__ __forceinline__
enum { PH_PROLOGUE = 0, PH_NORM_MIX, PH_GEMM_IN_EVEN, PH_EVEN_TOK, PH_GDN_CHUNK, PH_GDN_SCAN, PH_DSA_TOPK, PH_DSA_ATTN, PH_GDN_OUT,
       PH_GEMM_OUT, PH_NORM_FFN, PH_MOE1, PH_MOE2, PH_GEMM_IN_ODD, PH_GLA_TOK, PH_GLA_CHUNK, PH_GLA_SCAN, PH_GLA_OUT, PH_FINAL };

PHASE_FN void ph_prologue(const Params& p, float* smem) {
    unsigned char* ws_ = p.ws; asm volatile("" : "+s"(ws_));
    { int ldz_ = 0; asm volatile("" : "+s"(ldz_)); smem = (float*)(g_smem + ldz_); }
    int tid_ = threadIdx.x; asm volatile("" : "+v"(tid_)); const int tid = tid_, nthr = gridDim.x * NTHREADS, gid = blockIdx.x * NTHREADS + tid;
    for (int i = tid; i < 2 * ND; i += NTHREADS) smem[i] = siluf_(p.c[i]);
    __syncthreads();
    float* MOD = (float*)(ws_ + OFF_MOD);
    { float* red = smem + 2048;
      const int lane = tid & 63, wv = tid >> 6;
      for (int item = blockIdx.x; item < 4 * 96; item += gridDim.x) {
          const int l = item / 96, n = (item % 96) * 64 + lane;
          const float* w = p.ada_w + (size_t)l * ND * 6144 + n;
          float a0 = 0.f, a1 = 0.f;
#pragma unroll 8
          for (int k = wv * 128; k < wv * 128 + 128; ++k) { const float wv_ = w[(size_t)k * 6144]; a0 += smem[k] * wv_; a1 += smem[ND + k] * wv_; }
          __syncthreads();
          red[(wv * 64 + lane) * 2] = a0; red[(wv * 64 + lane) * 2 + 1] = a1;
          __syncthreads();
          if (tid < 128) { const int c = tid >> 1, bb = tid & 1; float a = 0.f; for (int w8 = 0; w8 < 8; ++w8) a += red[(w8 * 64 + c) * 2 + bb];
              MOD[(l * 2 + bb) * 6144 + (item % 96) * 64 + c] = a + p.ada_b[l * 6144 + (item % 96) * 64 + c]; }
      }
      __syncthreads(); }
    float* COSA = (float*)(ws_ + OFF_COSA); float* SINA = (float*)(ws_ + OFF_SINA);
    float* COSI = (float*)(ws_ + OFF_COSI); float* SINI = (float*)(ws_ + OFF_SINI);
    for (size_t i = gid; i < (size_t)NT * 64; i += nthr) {
        const int t = (int)(i >> 6), j = (int)(i & 63);
        double s, c; sincos_d((double)p.pos[t] * ipow_d(p.rA, j), s, c);
        COSA[i] = (float)c; SINA[i] = (float)s;
    }
    for (size_t i = gid; i < (size_t)NT * 32; i += nthr) {
        const int t = (int)(i >> 5), j = (int)(i & 31);
        double s, c; sincos_d((double)p.pos[t] * ipow_d(p.rI, j), s, c);
        COSI[i] = (float)c; SINI[i] = (float)s;
    }
}

PHASE_FN void ph_rows(const Params& p, int layer, int mode, float* smem) {
    unsigned char* ws_ = p.ws; asm volatile("" : "+s"(ws_));
    { int ldz_ = 0; asm volatile("" : "+s"(ldz_)); smem = (float*)(g_smem + ldz_); }
    int tid_ = threadIdx.x; asm volatile("" : "+v"(tid_)); const int tid = tid_, lane = tid & 63, wv = tid >> 6;
    int* pad = (int*)smem;
    const int moe_layer = (mode == 1) ? 3 : layer - 1;
    if (moe_layer >= 0) {
        if (tid == 0) { const int* cnt = (const int*)(ws_ + OFF_CNT) + moe_layer * 32 * CSTR; int a = 0; for (int e = 0; e < 32; ++e) { pad[e] = a; a += ((cnt[e * CSTR] + 127) / 128) * 128; } }
        __syncthreads();
    }
    const float* MOD = (const float*)(ws_ + OFF_MOD);
    bf16_t* H = (bf16_t*)(ws_ + OFF_H);
    const bf16_t* YB = (const bf16_t*)(ws_ + OFF_YB);
    const int* ASG = (const int*)(ws_ + OFF_ASG);
    const float* GATE = (const float*)(ws_ + OFF_GATE);
    for (int row = blockIdx.x * 8 + wv; row < NT; row += gridDim.x * 8) {
        const int b = row >> 13;
        float* xr = p.X + (size_t)row * ND;
        const float* xin = (mode == 0 && layer == 0) ? (p.x + (size_t)row * ND) : xr;
        float xv[16];
#pragma unroll
        for (int j = 0; j < 4; ++j) { const float4 v = *(const float4*)(xin + j * 256 + lane * 4); xv[4 * j] = v.x; xv[4 * j + 1] = v.y; xv[4 * j + 2] = v.z; xv[4 * j + 3] = v.w; }
        if (moe_layer >= 0) {
            const float* gt = MOD + (size_t)(moe_layer * 2 + b) * 6144 + 5 * 1024;
            const int e0 = ASG[row * 4 + 0], r0 = ASG[row * 4 + 1], e1 = ASG[row * 4 + 2], r1 = ASG[row * 4 + 3];
            const float g0 = GATE[row * 2], g1 = GATE[row * 2 + 1];
            const bf16_t* y0 = YB + (size_t)(pad[e0] + r0) * ND;
            const bf16_t* y1 = YB + (size_t)(pad[e1] + r1) * ND;
#pragma unroll
            for (int j = 0; j < 4; ++j) {
                const int col = j * 256 + lane * 4;
                const f32x4 a = unpack4(*(const uint2*)(y0 + col)), bq = unpack4(*(const uint2*)(y1 + col)); const float4 g = *(const float4*)(gt + col);
                xv[4 * j] += g.x * (g0 * a[0] + g1 * bq[0]); xv[4 * j + 1] += g.y * (g0 * a[1] + g1 * bq[1]);
                xv[4 * j + 2] += g.z * (g0 * a[2] + g1 * bq[2]); xv[4 * j + 3] += g.w * (g0 * a[3] + g1 * bq[3]);
                if (mode == 0) *(float4*)(xr + col) = make_float4(xv[4 * j], xv[4 * j + 1], xv[4 * j + 2], xv[4 * j + 3]);
            }
        }
        float ss = 0.f;
#pragma unroll
        for (int j = 0; j < 16; ++j) ss += xv[j] * xv[j];
        ss = wave_sum(ss);
        const float rstd = rsqrtf(ss * (1.f / 1024.f) + EPS);
        if (mode == 0) {
            const float* nw = p.norm_mix + layer * 1024;
            const float* sh = MOD + (size_t)(layer * 2 + b) * 6144;
            const float* sc = sh + 1024;
#pragma unroll
            for (int j = 0; j < 4; ++j) {
                const int col = j * 256 + lane * 4;
                const float4 w = *(const float4*)(nw + col), s4 = *(const float4*)(sc + col), h4 = *(const float4*)(sh + col);
                float4 o;
                o.x = xv[4 * j] * rstd * w.x * (1.f + s4.x) + h4.x; o.y = xv[4 * j + 1] * rstd * w.y * (1.f + s4.y) + h4.y;
                o.z = xv[4 * j + 2] * rstd * w.z * (1.f + s4.z) + h4.z; o.w = xv[4 * j + 3] * rstd * w.w * (1.f + s4.w) + h4.w;
                { f32x4 ov; ov[0] = o.x; ov[1] = o.y; ov[2] = o.z; ov[3] = o.w; *(uint2*)(H + (size_t)row * ND + col) = pack4(ov); }
            }
        } else {
#pragma unroll
            for (int j = 0; j < 4; ++j) {
                const int col = j * 256 + lane * 4;
                const float4 w = *(const float4*)(p.final_norm + col);
                *(float4*)(xr + col) = make_float4(xv[4 * j] * rstd * w.x, xv[4 * j + 1] * rstd * w.y, xv[4 * j + 2] * rstd * w.z, xv[4 * j + 3] * rstd * w.w);
            }
        }
    }
}

PHASE_FN void ph_gemm_in(const Params& p, int layer, bool even, float* smem) {
    unsigned char* ws_ = p.ws; asm volatile("" : "+s"(ws_));
    { int ldz_ = 0; asm volatile("" : "+s"(ldz_)); smem = (float*)(g_smem + ldz_); }
    const int N = even ? 3916 : 3088, ntn = even ? 31 : 25;
    const bf16_t* Wt = even ? (const bf16_t*)(ws_ + OFF_WINE) + (size_t)(layer >> 1) * 3968 * 1024 : (const bf16_t*)(ws_ + OFF_WINO) + (size_t)(layer >> 1) * 3200 * 1024;
    const bf16_t* H = (const bf16_t*)(ws_ + OFF_H);
    bf16_t* P = (bf16_t*)(ws_ + OFF_P);
    float* AUX = (float*)(ws_ + OFF_AUX);
    for (int tile = blockIdx.x; tile < 64 * ntn; tile += gridDim.x) {
        const int grp_ = tile / (8 * ntn), rr_ = tile % (8 * ntn), mt = grp_ * 8 + (rr_ & 7), nt = rr_ >> 3;
        const bf16_t* Ab = H + (size_t)mt * 256 * 1024;
        const bf16_t* Bb = Wt + (size_t)nt * 128 * 1024;
        bf16_t* Pt = P + (size_t)mt * 256 * LDPB + nt * 128;
        float* At = AUX + (size_t)mt * 256 * 16;
        const int ncol0 = nt * 128;
        const int nrem = N - nt * 128;
        gemm_tile_bf16(1024, (unsigned char*)smem,
            [=](int i, int r, int k) -> uint4 { return *(const uint4*)(Ab + (size_t)r * 1024 + k); },
            [=](int i, int r, int k) -> uint4 { return *(const uint4*)(Bb + (size_t)r * 1024 + k); },
            [=](const f32x4 (&acc)[4][4], int wm, int wn, int lane) {
#pragma unroll
                for (int mi = 0; mi < 4; ++mi)
#pragma unroll
                    for (int ni = 0; ni < 4; ++ni) {
                        const int m = wm * 64 + mi * 16 + (lane & 15), n = wn * 64 + ni * 16 + 4 * (lane >> 4);
                        if (n < nrem) {
                            *(uint2*)(Pt + (size_t)m * LDPB + n) = pack4(acc[mi][ni]);
                            const int gc = ncol0 + n;
                            int ax = -1;
                            if (even) { if (gc == 2048) ax = 0; else if (gc == 2052) ax = 4; else if (gc == 3912) ax = 8; }
                            else { if (gc >= 3072 && gc < 3088) ax = gc - 3072; }
                            if (ax >= 0) *(f32x4*)(At + (size_t)m * 16 + ax) = acc[mi][ni];
                        }
                    }
            });
    }
}

PHASE_FN void ph_even_tok(const Params& p, int layer, float* smem) {
    unsigned char* ws_ = p.ws; asm volatile("" : "+s"(ws_));
    { int ldz_ = 0; asm volatile("" : "+s"(ldz_)); smem = (float*)(g_smem + ldz_); }
    int tid_ = threadIdx.x; asm volatile("" : "+v"(tid_)); const int tid = tid_, lane = tid & 63, wv = tid >> 6, li = layer >> 1;
    const bf16_t* P = (const bf16_t*)(ws_ + OFF_P); const float* AUX = (const float*)(ws_ + OFF_AUX);
    bf16_t* QB = (bf16_t*)(ws_ + OFF_QBB); bf16_t* KB = (bf16_t*)(ws_ + OFF_KBB); bf16_t* QI = (bf16_t*)(ws_ + OFF_QIB); bf16_t* KI = (bf16_t*)(ws_ + OFF_KIB); float* WI = (float*)(ws_ + OFF_WI);
    const float* COSA = (const float*)(ws_ + OFF_COSA); const float* SINA = (const float*)(ws_ + OFF_SINA);
    const float* COSI = (const float*)(ws_ + OFF_COSI); const float* SINI = (const float*)(ws_ + OFF_SINI);
    for (int t = blockIdx.x * 8 + wv; t < NT; t += gridDim.x * 8) {
        const bf16_t* Pt = P + (size_t)t * LDPB;
        if (lane < 4) {
            WI[t * 4 + lane] = AUX[(size_t)t * 16 + 8 + lane] * 0.0625f;
        }
        { const float c = COSA[(size_t)t * 64 + lane], sn = SINA[(size_t)t * 64 + lane];
#pragma unroll
          for (int h = 0; h < 4; ++h) {
              float t1 = bf16_to_f32(Pt[2056 + h * 128 + lane]), t2 = bf16_to_f32(Pt[2056 + h * 128 + 64 + lane]);
              QB[(size_t)t * 512 + h * 128 + lane] = f2bf(t1 * c - t2 * sn); QB[(size_t)t * 512 + h * 128 + 64 + lane] = f2bf(t2 * c + t1 * sn);
              t1 = bf16_to_f32(Pt[2568 + h * 128 + lane]); t2 = bf16_to_f32(Pt[2568 + h * 128 + 64 + lane]);
              KB[(size_t)t * 512 + h * 128 + lane] = f2bf(t1 * c - t2 * sn); KB[(size_t)t * 512 + h * 128 + 64 + lane] = f2bf(t2 * c + t1 * sn);
          } }
#pragma unroll
        for (int r = 0; r < 2; ++r) {
            const int item = lane + 64 * r, hh = item >> 5, ii = item & 31;
            const float c = COSI[(size_t)t * 32 + ii], sn = SINI[(size_t)t * 32 + ii];
            const float t1 = bf16_to_f32(Pt[3592 + hh * 64 + ii]), t2 = bf16_to_f32(Pt[3592 + hh * 64 + 32 + ii]);
            QI[(size_t)t * 256 + hh * 64 + ii] = f2bf(t1 * c - t2 * sn); QI[(size_t)t * 256 + hh * 64 + 32 + ii] = f2bf(t2 * c + t1 * sn);
        }
        if (lane < 32) {
            const float c = COSI[(size_t)t * 32 + lane], sn = SINI[(size_t)t * 32 + lane];
            const float t1 = bf16_to_f32(Pt[3848 + lane]), t2 = bf16_to_f32(Pt[3848 + 32 + lane]);
            KI[(size_t)t * 64 + lane] = f2bf(t1 * c - t2 * sn); KI[(size_t)t * 64 + 32 + lane] = f2bf(t2 * c + t1 * sn);
        }
    }
    { bf16_t* VT = (bf16_t*)(ws_ + OFF_VT);
      bf16_t* sv = (bf16_t*)g_smem;
      for (int item = blockIdx.x; item < 2 * 128 * 4; item += gridDim.x) {
          const int h = item & 3, tt = item >> 2, b = tt >> 7, s0 = (tt & 127) * 64;
          __syncthreads();
          for (int e = tid; e < 64 * 128; e += NTHREADS) { const int i = e >> 7, d = e & 127; sv[d * 72 + i] = P[(size_t)(b * 8192 + s0 + i) * LDPB + 3080 + h * 128 + d]; }
          __syncthreads();
          for (int e = tid; e < 128 * 8; e += NTHREADS) { const int d = e >> 3, c = e & 7;
              *(uint4*)(VT + ((size_t)((b * 4 + h) * 128 + d)) * 8192 + s0 + c * 8) = *(const uint4*)(sv + d * 72 + c * 8); }
      } }
}

__device__ __forceinline__ f32x4 mma_lds(const unsigned char* A, int sa, int a0, const unsigned char* B, int sb, int b0, int K, f32x4 acc, int c16, int q4) {
    const unsigned char* ap = A + (a0 + c16) * sa + q4 * 16;
    const unsigned char* bp = B + (b0 + c16) * sb + q4 * 16;
    for (int kk = 0; kk < K; kk += 32) { acc = __builtin_amdgcn_mfma_f32_16x16x32_bf16(*(const bf16x8*)(ap + kk * 2), *(const bf16x8*)(bp + kk * 2), acc, 0, 0, 0); }
    return acc;
}

PHASE_FN void ph_gdn_chunk(const Params& p, int layer, float* smem) {
    unsigned char* ws_ = p.ws; asm volatile("" : "+s"(ws_));
    int tid_ = threadIdx.x; asm volatile("" : "+v"(tid_)); const int tid = tid_, lane = tid & 63, wv = __builtin_amdgcn_readfirstlane(tid >> 6), q4 = lane >> 4, c16 = lane & 15;
    int ldz_ = 0; asm volatile("" : "+s"(ldz_)); unsigned char* lds = g_smem + ldz_;
    constexpr int SN = 272, ST = 144;
    unsigned char* bKN = lds;
    unsigned char* bQN = lds + 18432;
    unsigned char* bKBG = lds + 35840;
    unsigned char* bVB = lds + 54272;
    unsigned char* bKD = lds + 72704;
    unsigned char* bUT = lds + 91136;
    float* sL = (float*)(lds + 109568);
    unsigned char* bAQK = lds + 126208;
    unsigned char* bTB = lds + 135424;
    float* sG = (float*)(lds + 144640); float* sB = sG + 64; float* sEg = sB + 64;
    const int li = layer >> 1;
    const bf16_t* P = (const bf16_t*)(ws_ + OFF_P); const float* AUX = (const float*)(ws_ + OFF_AUX);
    const float* cw = p.conv_w + (size_t)li * 4 * 1536;
    uint4* PFR = (uint4*)(ws_ + OFF_PFR); uint4* RFR = (uint4*)(ws_ + OFF_RFR); uint2* QFR = (uint2*)(ws_ + OFF_QFR); uint2* OFR = (uint2*)(ws_ + OFF_OFR);
    float* GL = (float*)(ws_ + OFF_GL);
    for (int ci = blockIdx.x; ci < 1024; ci += gridDim.x) {
        const int b = ci >> 9, h = (ci >> 7) & 3, n = ci & 127;
        const int t0 = b * 8192 + n * 64;
        __syncthreads();
        if (tid < 64) { float g = -expf(p.a_log[li * 4 + h]) * softplusf_(AUX[(size_t)(t0 + tid) * 16 + 4 + h] + p.dt_bias[li * 4 + h]);
#pragma unroll
            for (int o = 1; o < 64; o <<= 1) { const float nb = __shfl_up(g, o); if (lane >= o) g += nb; }
            sG[tid] = g; sB[tid] = sigmoidf_(AUX[(size_t)(t0 + tid) * 16 + h]); sEg[tid] = expf(g); }
        for (int e = tid; e < 64 * 36; e += NTHREADS) ((unsigned*)bAQK)[e] = 0u;
        __syncthreads();
        const float gl = sG[63];
        {
            const int d0 = 2 * lane, cb = h * 128 + d0, s00 = n * 64;
            float wq[4][2], wk[4][2], wvv[4][2];
#pragma unroll
            for (int jj = 0; jj < 4; ++jj) { wq[jj][0] = cw[jj * 1536 + cb]; wq[jj][1] = cw[jj * 1536 + cb + 1]; wk[jj][0] = cw[jj * 1536 + 512 + cb]; wk[jj][1] = cw[jj * 1536 + 512 + cb + 1];
                                            wvv[jj][0] = cw[jj * 1536 + 1024 + cb]; wvv[jj][1] = cw[jj * 1536 + 1024 + cb + 1]; }
#pragma unroll 4
            for (int r = 0; r < 8; ++r) {
                const int i = wv + 8 * r;
                float aq0 = 0.f, aq1 = 0.f, ak0 = 0.f, ak1 = 0.f, av0 = 0.f, av1 = 0.f;
#pragma unroll
                for (int jj = 0; jj < 4; ++jj) {
                    if (s00 + i - 3 + jj >= 0) {
                        const bf16_t* rp = P + (size_t)(t0 + i - 3 + jj) * LDPB + cb;
                        const unsigned uq = *(const unsigned*)rp, uk = *(const unsigned*)(rp + 512), uv = *(const unsigned*)(rp + 1024);
                        aq0 += wq[jj][0] * __uint_as_float(uq << 16); aq1 += wq[jj][1] * __uint_as_float(uq & 0xffff0000u);
                        ak0 += wk[jj][0] * __uint_as_float(uk << 16); ak1 += wk[jj][1] * __uint_as_float(uk & 0xffff0000u);
                        av0 += wvv[jj][0] * __uint_as_float(uv << 16); av1 += wvv[jj][1] * __uint_as_float(uv & 0xffff0000u);
                    }
                }
                aq0 = siluf_(aq0); aq1 = siluf_(aq1); ak0 = siluf_(ak0); ak1 = siluf_(ak1); av0 = siluf_(av0); av1 = siluf_(av1);
                const float rq = rsqrtf(wave_sum(aq0 * aq0 + aq1 * aq1) + EPS), rk = rsqrtf(wave_sum(ak0 * ak0 + ak1 * ak1) + EPS);
                aq0 *= rq; aq1 *= rq; ak0 *= rk; ak1 *= rk;
                const float be = sB[i], eg_i = sEg[i], ekd = expf(gl - sG[i]);
                *(unsigned*)(bKN + i * SN + d0 * 2) = cvt_pk_bf16(ak0, ak1);
                *(unsigned*)(bQN + i * SN + d0 * 2) = cvt_pk_bf16(aq0, aq1);
                *(bf16_t*)(bKBG + d0 * ST + i * 2) = f2bf(ak0 * be * eg_i); *(bf16_t*)(bKBG + (d0 + 1) * ST + i * 2) = f2bf(ak1 * be * eg_i);
                *(bf16_t*)(bVB + d0 * ST + i * 2) = f2bf(av0 * be); *(bf16_t*)(bVB + (d0 + 1) * ST + i * 2) = f2bf(av1 * be);
                *(bf16_t*)(bKD + d0 * ST + i * 2) = f2bf(ak0 * ekd); *(bf16_t*)(bKD + (d0 + 1) * ST + i * 2) = f2bf(ak1 * ekd);
            }
        }
        __syncthreads();
        for (int u = wv; u < 20; u += 8) {
            const int kind = (u >= 10) ? 1 : 0, idx = u - kind * 10;
            const int ti = (idx >= 6) ? 3 : (idx >= 3) ? 2 : (idx >= 1) ? 1 : 0, tj = idx - ((ti * (ti + 1)) >> 1);
            f32x4 acc = (f32x4){0.f, 0.f, 0.f, 0.f};
            acc = mma_lds(kind ? bQN : bKN, SN, 16 * ti, bKN, SN, 16 * tj, 128, acc, c16, q4);
            const int j = 16 * tj + c16;
#pragma unroll
            for (int r = 0; r < 4; ++r) { const int i = 16 * ti + 4 * q4 + r;
                const float dec = (j <= i) ? expf(sG[i] - sG[j]) : 0.f;
                if (kind == 0) sL[i * 65 + j] = (j < i) ? sB[i] * acc[r] * dec : 0.f;
                else *(bf16_t*)(bAQK + i * ST + j * 2) = f2bf(acc[r] * SCALE128 * dec); }
        }
        __syncthreads();
        if (wv == 0) {
            float t[64];
            int zz = 0; asm volatile("" : "+v"(zz)); const float* sLo = sL + zz;
#pragma unroll
            for (int i = 0; i < 64; ++i) { float a = (i == lane) ? 1.f : 0.f;
#pragma unroll
                for (int j = 0; j < i; ++j) a -= sLo[i * 65 + j] * t[j];
                t[i] = a; asm volatile("" ::: "memory"); }
#pragma unroll
            for (int i = 0; i < 64; ++i) *(bf16_t*)(bTB + i * ST + lane * 2) = f2bf(t[i]);
        }
        __syncthreads();
        for (int x = 0; x < 8; ++x) {
            const int u = wv * 8 + x, kind = u >> 5, ti = (u >> 3) & 3, td = u & 7;
            f32x4 acc = (f32x4){0.f, 0.f, 0.f, 0.f};
            acc = mma_lds(bTB, ST, 16 * ti, kind ? bVB : bKBG, ST, 16 * td, 64, acc, c16, q4);
            *(uint2*)((kind ? bUT : bKN) + (16 * td + c16) * ST + (16 * ti + 4 * q4) * 2) = pack4(acc);
        }
        __syncthreads();
        unsigned char* bWT = bKN;
        const float eg = expf(gl);
        for (int x = 0; x < 4; ++x) {
            const int u = wv * 4 + x, ti = u >> 2, a = u & 3;
            uint4 fr;
#pragma unroll
            for (int hf = 0; hf < 2; ++hf) { const int tk = 2 * a + hf;
                f32x4 acc = (f32x4){0.f, 0.f, 0.f, 0.f};
                acc = mma_lds(bWT, ST, 16 * tk, bKD, ST, 16 * ti, 64, acc, c16, q4);
                f32x4 v;
#pragma unroll
                for (int r = 0; r < 4; ++r) v[r] = ((16 * tk + 4 * q4 + r) == (16 * ti + c16) ? eg : 0.f) - acc[r];
                const uint2 pk = pack4(v);
                if (hf == 0) { fr.x = pk.x; fr.y = pk.y; } else { fr.z = pk.x; fr.w = pk.y; } }
            PFR[((size_t)(ci * 8 + ti) * 4 + a) * 64 + lane] = fr;
        }
        for (int x = 0; x < 2; ++x) {
            const int u = wv * 2 + x, ti = u >> 2, a = u & 3;
            uint4 fr;
            const int i = 16 * ti + c16;
            const float qs = SCALE128 * sEg[i];
#pragma unroll
            for (int hf = 0; hf < 2; ++hf) { const int tk = 2 * a + hf;
                f32x4 acc = (f32x4){0.f, 0.f, 0.f, 0.f};
                acc = mma_lds(bWT, ST, 16 * tk, bAQK, ST, 16 * ti, 64, acc, c16, q4);
                const f32x4 qv = unpack4(*(const uint2*)(bQN + i * SN + (16 * tk + 4 * q4) * 2));
                const uint2 pk = pack4(qv * qs - acc);
                if (hf == 0) { fr.x = pk.x; fr.y = pk.y; } else { fr.z = pk.x; fr.w = pk.y; } }
            RFR[((size_t)(ci * 4 + ti) * 4 + a) * 64 + lane] = fr;
        }
        for (int x = 0; x < 8; ++x) {
            const int u = wv * 8 + x, tdv = u >> 3, tdk = u & 7;
            f32x4 acc = (f32x4){0.f, 0.f, 0.f, 0.f};
            acc = mma_lds(bKD, ST, 16 * tdk, bUT, ST, 16 * tdv, 64, acc, c16, q4);
            QFR[((size_t)(ci * 8 + tdv) * 8 + tdk) * 64 + lane] = pack4(acc);
        }
        for (int x = 0; x < 4; ++x) {
            const int u = wv * 4 + x, tdv = u >> 2, ti = u & 3;
            f32x4 acc = (f32x4){0.f, 0.f, 0.f, 0.f};
            acc = mma_lds(bAQK, ST, 16 * ti, bUT, ST, 16 * tdv, 64, acc, c16, q4);
            OFR[((size_t)(ci * 8 + tdv) * 4 + ti) * 64 + lane] = pack4(acc);
        }
        if (tid == 0) GL[ci] = gl;
    }
}

__device__ __forceinline__ void gs_load(uint4 (&d)[12], const unsigned char* pp, const unsigned char* rr, const unsigned char* qq, const unsigned char* oo, const int lt) {
#pragma unroll
    for (int i = 0; i < 6; ++i) { int c = lt + 384 * i; c = c < 2048 ? c : 2047; d[i] = *(const uint4*)(pp + c * 16); }
#pragma unroll
    for (int i = 0; i < 3; ++i) { int c = lt + 384 * i; c = c < 1024 ? c : 1023; d[6 + i] = *(const uint4*)(rr + c * 16); }
#pragma unroll
    for (int i = 0; i < 2; ++i) { int c = lt + 384 * i; c = c < 512 ? c : 511; d[9 + i] = *(const uint4*)(qq + c * 16); }
    { const int c = lt < 256 ? lt : 255; d[11] = *(const uint4*)(oo + c * 16); }
}
__device__ __forceinline__ void gs_store(const uint4 (&d)[12], unsigned char* sb, const int lt) {
#pragma unroll
    for (int i = 0; i < 6; ++i) { const int c = lt + 384 * i; if (c < 2048) *(uint4*)(sb + c * 16) = d[i]; }
#pragma unroll
    for (int i = 0; i < 3; ++i) { const int c = lt + 384 * i; if (c < 1024) *(uint4*)(sb + 32768 + c * 16) = d[6 + i]; }
#pragma unroll
    for (int i = 0; i < 2; ++i) { const int c = lt + 384 * i; if (c < 512) *(uint4*)(sb + 49152 + c * 16) = d[9 + i]; }
    if (lt < 256) *(uint4*)(sb + 57344 + lt * 16) = d[11];
}

#define SCAN_BODY                 bf16x8 Sb[4]; \
_Pragma("unroll") \
                for (int a = 0; a < 4; ++a) { union { uint4 u; bf16x8 v; } cv; const uint2 lo = pack4(S[2 * a]), hi = pack4(S[2 * a + 1]); cv.u.x = lo.x; cv.u.y = lo.y; cv.u.z = hi.x; cv.u.w = hi.y; Sb[a] = cv.v; } \
                const int t0 = b * 8192 + n * 64; \
                {   f32x4 oa[4]; \
_Pragma("unroll") \
                    for (int ti = 0; ti < 4; ++ti) oa[ti] = unpack4(*(const uint2*)(Of + ti * 512)); \
_Pragma("unroll") \
                    for (int a = 0; a < 4; ++a) \
_Pragma("unroll") \
                        for (int ti = 0; ti < 4; ++ti) oa[ti] = __builtin_amdgcn_mfma_f32_16x16x32_bf16(*(const bf16x8*)(Rf + (ti * 4 + a) * 1024), Sb[a], oa[ti], 0, 0, 0); \
_Pragma("unroll") \
                    for (int ti = 0; ti < 4; ++ti) { \
                        float* op = O + (size_t)(t0 + 16 * ti + 4 * q4) * 1024 + h * 128 + 16 * tdv + c16; \
                        op[0] = oa[ti][0]; op[1024] = oa[ti][1]; op[2048] = oa[ti][2]; op[3072] = oa[ti][3]; } \
                } \
                asm volatile("" ::: "memory"); \
_Pragma("unroll") \
                for (int g = 0; g < 2; ++g) { \
                    f32x4 sa[4]; \
_Pragma("unroll") \
                    for (int t = 0; t < 4; ++t) sa[t] = unpack4(*(const uint2*)(Qf + (g * 4 + t) * 512)); \
_Pragma("unroll") \
                    for (int a = 0; a < 4; ++a) \
_Pragma("unroll") \
                        for (int t = 0; t < 4; ++t) sa[t] = __builtin_amdgcn_mfma_f32_16x16x32_bf16(*(const bf16x8*)(Pf + ((g * 4 + t) * 4 + a) * 1024), Sb[a], sa[t], 0, 0, 0); \
_Pragma("unroll") \
                    for (int t = 0; t < 4; ++t) S[g * 4 + t] = sa[t]; \
                    asm volatile("" ::: "memory"); \
                }
PHASE_FN void ph_gdn_scan(const Params& p, float* smem) {
    unsigned char* ws_ = p.ws; asm volatile("" : "+s"(ws_));
    int tid_ = threadIdx.x; asm volatile("" : "+v"(tid_)); const int tid = tid_, lane = tid & 63, wv = __builtin_amdgcn_readfirstlane(tid >> 6), q4 = lane >> 4, c16 = lane & 15;
    int ldz_ = 0; asm volatile("" : "+s"(ldz_)); unsigned char* lds = g_smem + ldz_;
    constexpr int STG = 61440;
    const unsigned char* PFR = ws_ + OFF_PFR; const unsigned char* RFR = ws_ + OFF_RFR; const unsigned char* QFR = ws_ + OFF_QFR; const unsigned char* OFR = ws_ + OFF_OFR;
    float* O = (float*)(ws_ + OFF_O);
    for (int it = blockIdx.x; it < 32; it += gridDim.x) {
        const int bh = it >> 2, pair = it & 3, b = bh >> 2, h = bh & 3;
        __syncthreads();
        if (wv >= 2) {
            const int lt = tid - 128;
            const unsigned char* Pb = PFR + (size_t)bh * 128 * 32768;
            const unsigned char* Rb = RFR + (size_t)bh * 128 * 16384;
            const unsigned char* Qb = QFR + (size_t)bh * 128 * 32768 + pair * 8192;
            const unsigned char* Ob = OFR + (size_t)bh * 128 * 16384 + pair * 4096;
            uint4 ra0, ra1, ra2, ra3, ra4, ra5, ra6, ra7, ra8, ra9, ra10, ra11, rb0, rb1, rb2, rb3, rb4, rb5, rb6, rb7, rb8, rb9, rb10, rb11;
            uint4 rc0, rc1, rc2, rc3, rc4, rc5, rc6, rc7, rc8, rc9, rc10, rc11;
#define LDC(base_, c_, mx_) (*(const uint4*)((base_) + (size_t)(((c_) < (mx_)) ? (c_) : (mx_)) * 16))
#define GS_LOAD(X, n_) do { const unsigned char* pp_ = Pb + (size_t)(n_) * 32768; const unsigned char* rr_ = Rb + (size_t)(n_) * 16384; \
                const unsigned char* qq_ = Qb + (size_t)(n_) * 32768; const unsigned char* oo_ = Ob + (size_t)(n_) * 16384; \
                X##0 = LDC(pp_, lt, 2047); X##1 = LDC(pp_, lt + 384, 2047); X##2 = LDC(pp_, lt + 768, 2047); X##3 = LDC(pp_, lt + 1152, 2047); X##4 = LDC(pp_, lt + 1536, 2047); X##5 = LDC(pp_, lt + 1920, 2047); \
                X##6 = LDC(rr_, lt, 1023); X##7 = LDC(rr_, lt + 384, 1023); X##8 = LDC(rr_, lt + 768, 1023); \
                X##9 = LDC(qq_, lt, 511); X##10 = LDC(qq_, lt + 384, 511); X##11 = LDC(oo_, lt, 255); } while (0)
#define STC(off_, c_, lim_, v_) do { if ((c_) < (lim_)) *(uint4*)(sb_ + (off_) + (c_) * 16) = v_; } while (0)
#define GS_STORE(X, st_) do { unsigned char* sb_ = lds + (st_) * STG; \
                STC(0, lt, 2048, X##0); STC(0, lt + 384, 2048, X##1); STC(0, lt + 768, 2048, X##2); STC(0, lt + 1152, 2048, X##3); STC(0, lt + 1536, 2048, X##4); STC(0, lt + 1920, 2048, X##5); \
                STC(32768, lt, 1024, X##6); STC(32768, lt + 384, 1024, X##7); STC(32768, lt + 768, 1024, X##8); \
                STC(49152, lt, 512, X##9); STC(49152, lt + 384, 512, X##10); STC(57344, lt, 256, X##11); } while (0)
            GS_LOAD(ra, 0); GS_STORE(ra, 0);
            GS_LOAD(rb, 1); GS_LOAD(rc, 2); GS_LOAD(ra, 3);
            __syncthreads();
#define CLAMPN(x_) (((x_) < 128) ? (x_) : 127)
            for (int n = 0; n < 128; n += 3) {
                if (n + 1 < 128) GS_STORE(rb, (n + 1) & 1);
                GS_LOAD(rb, CLAMPN(n + 4)); __syncthreads();
                if (n + 1 < 128) { if (n + 2 < 128) GS_STORE(rc, (n + 2) & 1);
                    GS_LOAD(rc, CLAMPN(n + 5)); __syncthreads(); }
                if (n + 2 < 128) { if (n + 3 < 128) GS_STORE(ra, (n + 3) & 1);
                    GS_LOAD(ra, CLAMPN(n + 6)); __syncthreads(); }
            }
        } else {
            const int tdv = pair * 2 + wv;
            f32x4 S[8];
#pragma unroll
            for (int t = 0; t < 8; ++t) S[t] = (f32x4){0.f, 0.f, 0.f, 0.f};
            __syncthreads();
            for (int n = 0; n < 128; ++n) {
                const unsigned char* base = lds + (n & 1) * STG;
                const unsigned char* Pf = base + lane * 16, *Rf = base + 32768 + lane * 16;
                const unsigned char* Qf = base + 49152 + wv * 4096 + lane * 8, *Of = base + 57344 + wv * 2048 + lane * 8;
                SCAN_BODY
                __syncthreads();
            }
        }
    }
}

__device__ __forceinline__ void block_sum4(int (&v)[4], int* buf) {
    const int lane = threadIdx.x & 63, wv = threadIdx.x >> 6;
#pragma unroll
    for (int q = 0; q < 4; ++q) v[q] = wave_sum_i(v[q]);
    if (lane == 0) {
#pragma unroll
        for (int q = 0; q < 4; ++q) buf[wv * 4 + q] = v[q];
    }
    __syncthreads();
#pragma unroll
    for (int q = 0; q < 4; ++q) { int a = 0; for (int w = 0; w < 8; ++w) a += buf[w * 4 + q]; v[q] = a; }
}

PHASE_FN void ph_dsa_topk(const Params& p, int layer, float* smem) {
    unsigned char* ws_ = p.ws; asm volatile("" : "+s"(ws_));
    int tid_ = threadIdx.x; asm volatile("" : "+v"(tid_)); const int tid = tid_, lane = tid & 63, wv = __builtin_amdgcn_readfirstlane(tid >> 6), q4 = lane >> 4, c16 = lane & 15;
    int* sRed = (int*)g_smem;
    const bf16_t* QIb = (const bf16_t*)(ws_ + OFF_QIB); const bf16_t* KIb = (const bf16_t*)(ws_ + OFF_KIB); const float* WI = (const float*)(ws_ + OFF_WI);
    unsigned short* M16 = (unsigned short*)(ws_ + OFF_M16);
    int* qhead = (int*)(ws_ + OFF_QCTR) + layer * 16;
    int* sIt = (int*)(g_smem + 512);
    for (;;) {
        __syncthreads();
        if (tid == 0) *sIt = atomicAdd(qhead, 1);
        __syncthreads();
        const int it = *sIt;
        if (it >= 2048) break;
        const int b = it & 1, gp = 1023 - (it >> 1);
        const int s0 = gp * 8, t0 = b * 8192 + s0;
        const int ntiles = (s0 >> 4) + 1;
        const int nreg = (ntiles > wv) ? ((ntiles - wv + 7) >> 3) : 0;
        const bf16_t* qp = QIb + (size_t)(t0 + (c16 >> 2)) * 256 + (c16 & 3) * 64 + 8 * q4;
        const bf16x8 a0A = *(const bf16x8*)qp, a1A = *(const bf16x8*)(qp + 32), a0B = *(const bf16x8*)(qp + 4 * 256), a1B = *(const bf16x8*)(qp + 4 * 256 + 32);
        const float4 wqA = *(const float4*)(WI + (size_t)(t0 + q4) * 4), wqB = *(const float4*)(WI + (size_t)(t0 + 4 + q4) * 4);
        const int myqA = s0 + q4, myqB = s0 + 4 + q4;
        int c16s = c16; asm volatile("" : "+v"(c16s));
        int wvs = wv; asm volatile("" : "+s"(wvs));
        unsigned kA[64], kB[64];
#pragma unroll
        for (int i = 0; i < 64; ++i) { kA[i] = 0u; kB[i] = 0u; }
#pragma unroll
        for (int blk = 0; blk < 4; ++blk) if (nreg > blk * 16) {
#pragma unroll
            for (int ii = 0; ii < 16; ++ii) { const int i = blk * 16 + ii, tile = wvs + 8 * i;
                if (tile < ntiles) {
                    const bf16_t* kp = KIb + (size_t)(b * 8192 + tile * 16 + c16s) * 64 + 8 * q4;
                    const bf16x8 k0 = *(const bf16x8*)kp, k1 = *(const bf16x8*)(kp + 32);
                    f32x4 accA = (f32x4){0.f, 0.f, 0.f, 0.f}, accB = accA;
                    accA = __builtin_amdgcn_mfma_f32_16x16x32_bf16(a0A, k0, accA, 0, 0, 0);
                    accB = __builtin_amdgcn_mfma_f32_16x16x32_bf16(a0B, k0, accB, 0, 0, 0);
                    accA = __builtin_amdgcn_mfma_f32_16x16x32_bf16(a1A, k1, accA, 0, 0, 0);
                    accB = __builtin_amdgcn_mfma_f32_16x16x32_bf16(a1B, k1, accB, 0, 0, 0);
                    float sa = 0.f, sb = 0.f;
                    sa += wqA.x * fmaxf(accA[0], 0.f); sa += wqA.y * fmaxf(accA[1], 0.f); sa += wqA.z * fmaxf(accA[2], 0.f); sa += wqA.w * fmaxf(accA[3], 0.f);
                    sb += wqB.x * fmaxf(accB[0], 0.f); sb += wqB.y * fmaxf(accB[1], 0.f); sb += wqB.z * fmaxf(accB[2], 0.f); sb += wqB.w * fmaxf(accB[3], 0.f);
                    const int kidx = tile * 16 + c16s;
                    kA[i] = (kidx <= myqA) ? ordkey(sa) : 0u;
                    kB[i] = (kidx <= myqB) ? ordkey(sb) : 0u;
                }
                if ((ii & 3) == 3) asm volatile("" ::: "memory"); }
        }
        const int keffA = (myqA + 1 < 256) ? (myqA + 1) : 256, keffB = (myqB + 1 < 256) ? (myqB + 1) : 256;
        int par = 0;
        auto qsum = [&](int c) -> int {
            c += __shfl_xor(c, 1); c += __shfl_xor(c, 2); c += __shfl_xor(c, 4); c += __shfl_xor(c, 8);
            par ^= 1;
            if (c16 == 0) sRed[par * 32 + wv * 4 + q4] = c;
            __syncthreads();
            int a = 0;
#pragma unroll
            for (int w = 0; w < 8; ++w) a += sRed[par * 32 + w * 4 + q4];
            return a;
        };
        unsigned UA = 0u, UB = 0u;
        for (int rep_ = 0; rep_ < TOPK_SEARCH_REP; ++rep_) { UA = 0u; UB = 0u;
        for (int bit = 31; bit >= 0; --bit) {
            const unsigned candA = UA | (1u << bit), candB = UB | (1u << bit);
            int ca = 0, cb = 0;
#pragma unroll
            for (int blk = 0; blk < 4; ++blk) if (nreg > blk * 16) {
#pragma unroll
                for (int ii = 0; ii < 16; ++ii) { ca += (kA[blk * 16 + ii] >= candA) ? 1 : 0; cb += (kB[blk * 16 + ii] >= candB) ? 1 : 0; }
            }
            const int tot = qsum(ca | (cb << 16));
            if ((tot & 0xffff) >= keffA) UA = candA;
            if ((tot >> 16) >= keffB) UB = candB;
        } }
        int cg = 0, ce = 0;
#pragma unroll
        for (int i = 0; i < 64; ++i) { cg += (kA[i] > UA) ? 1 : 0; ce += (kA[i] == UA) ? 1 : 0; cg += (kB[i] > UB) ? 65536 : 0; ce += (kB[i] == UB) ? 65536 : 0; }
        cg = qsum(cg); ce = qsum(ce);
        const int needA = keffA - (cg & 0xffff), needB = keffB - (cg >> 16);
        int JA = 8191, JB = 8191;
        par ^= 1;
        if (c16 == 0) sRed[par * 32 + wv * 4 + q4] = (((ce & 0xffff) > needA) || ((ce >> 16) > needB)) ? 1 : 0;
        __syncthreads();
        int anyov = 0;
#pragma unroll
        for (int w = 0; w < 32; ++w) anyov |= sRed[par * 32 + w];
        if (anyov) {
            JA = 0; JB = 0;
            int c16j = c16; asm volatile("" : "+v"(c16j));
            int wvj = wv; asm volatile("" : "+s"(wvj));
            for (int bit = 12; bit >= 0; --bit) {
                const int cjA = JA | (1 << bit), cjB = JB | (1 << bit);
                int c = 0;
#pragma unroll
                for (int i = 0; i < 64; ++i) { const int kidx = (wvj + 8 * i) * 16 + c16j; c += (kA[i] == UA && kidx < cjA) ? 1 : 0; c += (kB[i] == UB && kidx < cjB) ? 65536 : 0; }
                const int tot = qsum(c);
                if ((tot & 0xffff) <= needA - 1) JA = cjA;
                if ((tot >> 16) <= needB - 1) JB = cjB;
            }
        }
        unsigned short* sM = (unsigned short*)(g_smem + 1024);
        ((uint4*)sM)[tid] = make_uint4(0u, 0u, 0u, 0u);
        __syncthreads();
        int c16e = c16; asm volatile("" : "+v"(c16e));
        int wve = wv; asm volatile("" : "+s"(wve));
#pragma unroll
        for (int blk = 0; blk < 4; ++blk) if (nreg > blk * 16) {
#pragma unroll
            for (int ii = 0; ii < 16; ++ii) { const int i = blk * 16 + ii;
                const int tile = wve + 8 * i, kidx = tile * 16 + c16e;
                const bool selA = kA[i] > UA || (kA[i] == UA && kidx <= JA);
                const bool selB = kB[i] > UB || (kB[i] == UB && kidx <= JB);
                const unsigned long long balA = __ballot(selA), balB = __ballot(selB);
                if (c16 == 0) { sM[q4 * 512 + tile] = (unsigned short)((balA >> (16 * q4)) & 0xffffull);
                                sM[(4 + q4) * 512 + tile] = (unsigned short)((balB >> (16 * q4)) & 0xffffull); }
            }
        }
        __syncthreads();
        *(uint4*)(M16 + (size_t)(t0 + (tid >> 6)) * 512 + (tid & 63) * 8) = ((const uint4*)sM)[tid];
    }
}

PHASE_FN void ph_dsa_attn(const Params& p, float* smem) {
    unsigned char* ws_ = p.ws; asm volatile("" : "+s"(ws_));
    int tid_ = threadIdx.x; asm volatile("" : "+v"(tid_)); const int tid = tid_, lane = tid & 63, wv = tid >> 6, q4 = lane >> 4, c16 = lane & 15;
    int ldz_ = 0; asm volatile("" : "+s"(ldz_)); unsigned char* lds = g_smem + ldz_;
    const bf16_t* QBb = (const bf16_t*)(ws_ + OFF_QBB); const bf16_t* KBb = (const bf16_t*)(ws_ + OFF_KBB); const bf16_t* VT = (const bf16_t*)(ws_ + OFF_VT);
    const unsigned short* M16 = (const unsigned short*)(ws_ + OFF_M16);
    bf16_t* OB = (bf16_t*)(ws_ + OFF_OB);
    const float SC = SCALE128 * 1.4426950408889634f;
    for (int it = blockIdx.x; it < 256; it += gridDim.x) {
        const int bh = it & 7, jp = it >> 3, b = bh >> 2, h = bh & 3;
        for (int half = 0; half < 2; ++half) {
            const int jq = half ? jp : 63 - jp;
            const int qs = jq * 128, nkt = 2 * jq + 2;
            const int tq = b * 8192 + qs + wv * 16 + c16;
            bf16x8 qf[4];
#pragma unroll
            for (int a = 0; a < 4; ++a) qf[a] = *(const bf16x8*)(QBb + (size_t)tq * 512 + h * 128 + 8 * q4 + 32 * a);
            float m = -1e30f, lsum = 0.f;
            f32x4 oacc[8];
#pragma unroll
            for (int t = 0; t < 8; ++t) oacc[t] = (f32x4){0.f, 0.f, 0.f, 0.f};
            uint4 rk0, rk1, rv0, rv1;
            const int q0 = tid, q1 = tid + 512;
            const bf16_t* kg0 = KBb + (size_t)(b * 8192 + (q0 >> 4)) * 512 + h * 128 + (q0 & 15) * 8;
            const bf16_t* kg1 = KBb + (size_t)(b * 8192 + (q1 >> 4)) * 512 + h * 128 + (q1 & 15) * 8;
            const bf16_t* vg0 = VT + ((size_t)((b * 4 + h) * 128 + (q0 >> 3))) * 8192 + (q0 & 7) * 8;
            const bf16_t* vg1 = VT + ((size_t)((b * 4 + h) * 128 + (q1 >> 3))) * 8192 + (q1 & 7) * 8;
            const int lk0 = (q0 >> 4) * 256 + ((((q0 & 15)) ^ ((q0 >> 4) & 15)) << 4), lk1 = (q1 >> 4) * 256 + ((((q1 & 15)) ^ ((q1 >> 4) & 15)) << 4);
            const int lv0 = 16384 + (q0 >> 3) * 128 + ((((q0 & 7)) ^ ((q0 >> 3) & 7)) << 4), lv1 = 16384 + (q1 >> 3) * 128 + ((((q1 & 7)) ^ ((q1 >> 3) & 7)) << 4);
#define ATT_GLOAD(kt_) do { rk0 = *(const uint4*)(kg0 + (size_t)(kt_) * 64 * 512); rk1 = *(const uint4*)(kg1 + (size_t)(kt_) * 64 * 512); \
                            rv0 = *(const uint4*)(vg0 + (kt_) * 64); rv1 = *(const uint4*)(vg1 + (kt_) * 64); } while (0)
#define ATT_LSTORE(st_) do { unsigned char* base_ = lds + (st_) * 32768; *(uint4*)(base_ + lk0) = rk0; *(uint4*)(base_ + lk1) = rk1; *(uint4*)(base_ + lv0) = rv0; *(uint4*)(base_ + lv1) = rv1; } while (0)
            __syncthreads();
            ATT_GLOAD(0); ATT_LSTORE(0);
            __syncthreads();
            for (int kt = 0; kt < nkt; ++kt) {
                if (kt + 1 < nkt) ATT_GLOAD(kt + 1);
                const unsigned long long mbits = *(const unsigned long long*)(M16 + (size_t)tq * 512 + 4 * kt);
                const unsigned char* Kt = lds + (kt & 1) * 32768;
                const unsigned char* Vt = Kt + 16384;
                f32x4 sacc[4];
#pragma unroll
                for (int ti = 0; ti < 4; ++ti) { sacc[ti] = (f32x4){0.f, 0.f, 0.f, 0.f};
                    const int row = 16 * ti + c16;
#pragma unroll
                    for (int a = 0; a < 4; ++a) { const bf16x8 kf = *(const bf16x8*)(Kt + row * 256 + ((((q4 + 4 * a)) ^ (row & 15)) << 4));
                        sacc[ti] = __builtin_amdgcn_mfma_f32_16x16x32_bf16(kf, qf[a], sacc[ti], 0, 0, 0); } }
                float mx = m;
#pragma unroll
                for (int ti = 0; ti < 4; ++ti)
#pragma unroll
                    for (int r = 0; r < 4; ++r) { const bool valid = (mbits >> (16 * ti + 4 * q4 + r)) & 1ull; const float v = sacc[ti][r] * SC; sacc[ti][r] = v; mx = fmaxf(mx, valid ? v : -1e30f); }
                mx = fmaxf(mx, __shfl_xor(mx, 16)); mx = fmaxf(mx, __shfl_xor(mx, 32));
                const float alpha = __builtin_amdgcn_exp2f(m - mx); m = mx;
                float ps = 0.f;
#pragma unroll
                for (int ti = 0; ti < 4; ++ti)
#pragma unroll
                    for (int r = 0; r < 4; ++r) { const bool valid = (mbits >> (16 * ti + 4 * q4 + r)) & 1ull; const float pv = valid ? __builtin_amdgcn_exp2f(sacc[ti][r] - mx) : 0.f; sacc[ti][r] = pv; ps += pv; }
                lsum = lsum * alpha + ps;
#pragma unroll
                for (int t = 0; t < 8; ++t) oacc[t] = oacc[t] * alpha;
                bf16x8 pb[2];
#pragma unroll
                for (int a = 0; a < 2; ++a) {
                    union { uint4 u; bf16x8 v; } cv;
                    cv.u.x = cvt_pk_bf16(sacc[2 * a][0], sacc[2 * a][1]); cv.u.y = cvt_pk_bf16(sacc[2 * a][2], sacc[2 * a][3]);
                    cv.u.z = cvt_pk_bf16(sacc[2 * a + 1][0], sacc[2 * a + 1][1]); cv.u.w = cvt_pk_bf16(sacc[2 * a + 1][2], sacc[2 * a + 1][3]);
                    pb[a] = cv.v; }
#pragma unroll
                for (int t = 0; t < 8; ++t) { const int row = 16 * t + c16;
#pragma unroll
                    for (int a = 0; a < 2; ++a) {
                        union { uint2 h2[2]; bf16x8 v; } vf;
                        vf.h2[0] = *(const uint2*)(Vt + row * 128 + ((((4 * a + (q4 >> 1))) ^ (row & 7)) << 4) + 8 * (q4 & 1));
                        vf.h2[1] = *(const uint2*)(Vt + row * 128 + ((((4 * a + 2 + (q4 >> 1))) ^ (row & 7)) << 4) + 8 * (q4 & 1));
                        oacc[t] = __builtin_amdgcn_mfma_f32_16x16x32_bf16(vf.v, pb[a], oacc[t], 0, 0, 0); } }
                if (kt + 1 < nkt) ATT_LSTORE((kt + 1) & 1);
                __syncthreads();
            }
            lsum += __shfl_xor(lsum, 16); lsum += __shfl_xor(lsum, 32);
            const float inv = 1.f / lsum;
#pragma unroll
            for (int t = 0; t < 8; ++t) *(uint2*)(OB + (size_t)tq * 1024 + 512 + h * 128 + 16 * t + 4 * q4) = pack4(oacc[t] * inv);
        }
    }
}

PHASE_FN void ph_gdn_out(const Params& p, int layer) {
    unsigned char* ws_ = p.ws; asm volatile("" : "+s"(ws_));
    int tid_ = threadIdx.x; asm volatile("" : "+v"(tid_)); const int tid = tid_, lane = tid & 63, wv = tid >> 6;
    const float* O = (const float*)(ws_ + OFF_O); const bf16_t* P = (const bf16_t*)(ws_ + OFF_P); bf16_t* OB = (bf16_t*)(ws_ + OFF_OB);
    const float* onw = p.gdn_out_norm + (layer >> 1) * 128;
    for (int t = blockIdx.x * 8 + wv; t < NT; t += gridDim.x * 8) {
#pragma unroll
        for (int h = 0; h < 4; ++h) {
            const float* op = O + (size_t)t * 1024 + h * 128; bf16_t* ob = OB + (size_t)t * 1024 + h * 128;
            const float o0 = op[lane], o1 = op[64 + lane];
            const float ss = wave_sum(o0 * o0 + o1 * o1);
            const float r = rsqrtf(ss * (1.f / 128.f) + EPS);
            const float z0 = PBF(P, t, 1536 + h * 128 + lane), z1 = PBF(P, t, 1536 + h * 128 + 64 + lane);
            ob[lane] = f2bf(o0 * r * onw[lane] * siluf_(z0)); ob[64 + lane] = f2bf(o1 * r * onw[64 + lane] * siluf_(z1));
        }
    }
}

PHASE_FN void ph_gemm_out(const Params& p, int layer, float* smem) {
    unsigned char* ws_ = p.ws; asm volatile("" : "+s"(ws_));
    { int ldz_ = 0; asm volatile("" : "+s"(ldz_)); smem = (float*)(g_smem + ldz_); }
    const bf16_t* Wt = (const bf16_t*)(ws_ + OFF_WOUT) + (size_t)layer * 1024 * 1024;
    const float* MOD = (const float*)(ws_ + OFF_MOD);
    const bf16_t* O = (const bf16_t*)(ws_ + OFF_OB);
    for (int tile = blockIdx.x; tile < 64 * 8; tile += gridDim.x) {
        const int mt = (tile >> 6) * 8 + (tile & 7), nt = (tile >> 3) & 7;
        const bf16_t* Ab = O + (size_t)mt * 256 * 1024;
        const bf16_t* Bb = Wt + (size_t)nt * 128 * 1024;
        const int b = (mt * 256) >> 13;
        const float* gt = MOD + (size_t)(layer * 2 + b) * 6144 + 2048 + nt * 128;
        float* Xt = p.X + (size_t)mt * 256 * ND + nt * 128;
        const float* Xr = ((layer == 0) ? p.x : (const float*)p.X) + (size_t)mt * 256 * ND + nt * 128;
        gemm_tile_bf16(1024, (unsigned char*)smem,
            [=](int i, int r, int k) -> uint4 { return *(const uint4*)(Ab + (size_t)r * 1024 + k); },
            [=](int i, int r, int k) -> uint4 { return *(const uint4*)(Bb + (size_t)r * 1024 + k); },
            [=](const f32x4 (&acc)[4][4], int wm, int wn, int lane) {
#pragma unroll
                for (int mi = 0; mi < 4; ++mi)
#pragma unroll
                    for (int ni = 0; ni < 4; ++ni) {
                        const int m = wm * 64 + mi * 16 + (lane & 15), n = wn * 64 + ni * 16 + 4 * (lane >> 4);
                        const f32x4 g = *(const f32x4*)(gt + n);
                        *(f32x4*)(Xt + (size_t)m * ND + n) = *(const f32x4*)(Xr + (size_t)m * ND + n) + g * acc[mi][ni];
                    }
            });
    }
}

PHASE_FN void ph_norm_ffn(const Params& p, int layer) {
    unsigned char* ws_ = p.ws; asm volatile("" : "+s"(ws_));
    int tid_ = threadIdx.x; asm volatile("" : "+v"(tid_)); const int tid = tid_, lane = tid & 63, wv = tid >> 6;
    const float* MOD = (const float*)(ws_ + OFF_MOD);
    bf16_t* H = (bf16_t*)(ws_ + OFF_H);
    int* CNT = (int*)(ws_ + OFF_CNT) + layer * 32 * CSTR;
    int* sCnt = (int*)g_smem; int* sBase = sCnt + 32; int* sE = sBase + 32; int* sR = sE + 256;
    const int nrb = (NT + (int)gridDim.x - 1) / (int)gridDim.x, row_lo = blockIdx.x * nrb, row_hi = (row_lo + nrb < NT) ? row_lo + nrb : NT;
    __syncthreads();
    if (tid < 32) sCnt[tid] = 0;
    __syncthreads();
    int* ASG = (int*)(ws_ + OFF_ASG); float* GATE = (float*)(ws_ + OFF_GATE); int* LIST = (int*)(ws_ + OFF_LIST);
    const float* nw = p.norm_ffn + layer * 1024;
    const float* wg = p.rg_w + (size_t)layer * 1024 * 4;
    for (int row = row_lo + wv; row < row_hi; row += 8) {
        const int b = row >> 13;
        const float* xr = p.X + (size_t)row * ND;
        const float* sh = MOD + (size_t)(layer * 2 + b) * 6144 + 3072;
        const float* sc = sh + 1024;
        float hv[16]; float ss = 0.f;
#pragma unroll
        for (int j = 0; j < 4; ++j) { const float4 v = *(const float4*)(xr + j * 256 + lane * 4); hv[4 * j] = v.x; hv[4 * j + 1] = v.y; hv[4 * j + 2] = v.z; hv[4 * j + 3] = v.w; }
#pragma unroll
        for (int j = 0; j < 16; ++j) ss += hv[j] * hv[j];
        ss = wave_sum(ss);
        const float rstd = rsqrtf(ss * (1.f / 1024.f) + EPS);
#pragma unroll
        for (int j = 0; j < 4; ++j) {
            const int col = j * 256 + lane * 4;
            const float4 w = *(const float4*)(nw + col), s4 = *(const float4*)(sc + col), h4 = *(const float4*)(sh + col);
            hv[4 * j] = hv[4 * j] * rstd * w.x * (1.f + s4.x) + h4.x; hv[4 * j + 1] = hv[4 * j + 1] * rstd * w.y * (1.f + s4.y) + h4.y;
            hv[4 * j + 2] = hv[4 * j + 2] * rstd * w.z * (1.f + s4.z) + h4.z; hv[4 * j + 3] = hv[4 * j + 3] * rstd * w.w * (1.f + s4.w) + h4.w;
            { f32x4 ov; ov[0] = hv[4 * j]; ov[1] = hv[4 * j + 1]; ov[2] = hv[4 * j + 2]; ov[3] = hv[4 * j + 3]; *(uint2*)(H + (size_t)row * ND + col) = pack4(ov); }
        }
        float gl[4] = {0.f, 0.f, 0.f, 0.f};
#pragma unroll
        for (int j = 0; j < 4; ++j)
#pragma unroll
            for (int e = 0; e < 4; ++e) { const int col = j * 256 + lane * 4 + e; const float4 w = *(const float4*)(wg + (size_t)col * 4); const float hh = hv[4 * j + e];
                gl[0] += hh * w.x; gl[1] += hh * w.y; gl[2] += hh * w.z; gl[3] += hh * w.w; }
#pragma unroll
        for (int g = 0; g < 4; ++g) gl[g] = wave_sum(gl[g]) + p.rg_b[layer * 4 + g];
        int gs = 0; float gm = gl[0];
#pragma unroll
        for (int g = 1; g < 4; ++g) if (gl[g] > gm) { gm = gl[g]; gs = g; }
        float gsum = 0.f;
#pragma unroll
        for (int g = 0; g < 4; ++g) gsum += expf(gl[g] - gm);
        const float ggate = 1.f / gsum;
        const float* we = p.re_w + ((size_t)(layer * 4 + gs) * 1024) * 8;
        float el[8] = {0.f, 0.f, 0.f, 0.f, 0.f, 0.f, 0.f, 0.f};
#pragma unroll
        for (int j = 0; j < 4; ++j)
#pragma unroll
            for (int e = 0; e < 4; ++e) { const int col = j * 256 + lane * 4 + e; const float4 w0 = *(const float4*)(we + (size_t)col * 8), w1 = *(const float4*)(we + (size_t)col * 8 + 4); const float hh = hv[4 * j + e];
                el[0] += hh * w0.x; el[1] += hh * w0.y; el[2] += hh * w0.z; el[3] += hh * w0.w; el[4] += hh * w1.x; el[5] += hh * w1.y; el[6] += hh * w1.z; el[7] += hh * w1.w; }
#pragma unroll
        for (int e = 0; e < 8; ++e) el[e] = wave_sum(el[e]) + p.re_b[(layer * 4 + gs) * 8 + e];
        int i1 = 0; float l1 = el[0];
#pragma unroll
        for (int e = 1; e < 8; ++e) if (el[e] > l1) { l1 = el[e]; i1 = e; }
        int i2 = -1; float l2 = -INFINITY;
#pragma unroll
        for (int e = 0; e < 8; ++e) if (e != i1 && el[e] > l2) { l2 = el[e]; i2 = e; }
        const float ex = expf(l2 - l1);
        const float p1 = 1.f / (1.f + ex), p2 = ex / (1.f + ex);
        if (lane == 0) {
            const int e1 = gs * 8 + i1, e2 = gs * 8 + i2, lr = row - row_lo;
            sE[lr * 2] = e1; sE[lr * 2 + 1] = e2;
            sR[lr * 2] = atomicAdd(&sCnt[e1], 1); sR[lr * 2 + 1] = atomicAdd(&sCnt[e2], 1);
            GATE[row * 2] = ggate * p1; GATE[row * 2 + 1] = ggate * p2;
        }
    }
    __syncthreads();
    if (tid < 32) sBase[tid] = (sCnt[tid] > 0) ? atomicAdd(&CNT[tid * CSTR], sCnt[tid]) : 0;
    __syncthreads();
    for (int a = tid; a < (row_hi - row_lo) * 2; a += NTHREADS) {
        const int row = row_lo + (a >> 1), e = sE[a], r = sBase[e] + sR[a];
        LIST[(size_t)e * LISTCAP + r] = row;
        ASG[row * 4 + (a & 1) * 2] = e; ASG[row * 4 + (a & 1) * 2 + 1] = r;
    }
}

PHASE_FN void ph_moe(const Params& p, int layer, int which, float* smem) {
    unsigned char* ws_ = p.ws; asm volatile("" : "+s"(ws_));
    { int ldz_ = 0; asm volatile("" : "+s"(ldz_)); smem = (float*)(g_smem + ldz_); }
    int tid_ = threadIdx.x; asm volatile("" : "+v"(tid_)); const int tid = tid_;
    int* sPad = (int*)((unsigned char*)smem + 98304); int* sTs = sPad + 33;
    const int* CNT = (const int*)(ws_ + OFF_CNT) + layer * 32 * CSTR;
    __syncthreads();
    if (tid == 0) { int a = 0, ts = 0; for (int e = 0; e < 32; ++e) { sPad[e] = a; sTs[e] = ts; a += ((CNT[e * CSTR] + 127) / 128) * 128; ts += (CNT[e * CSTR] + 255) / 256; } sTs[32] = ts; sPad[32] = a; }
    __syncthreads();
    const int total = sTs[32] * 8;
    bf16_t* HID = (bf16_t*)(ws_ + OFF_HID); bf16_t* YB = (bf16_t*)(ws_ + OFF_YB);
    const bf16_t* H = (const bf16_t*)(ws_ + OFF_H);
    const int* LIST = (const int*)(ws_ + OFF_LIST);
    for (int tile = blockIdx.x; tile < total; tile += gridDim.x) {
        const int mt = tile >> 3, nt = tile & 7;
        int e = 0;
        for (int q = 1; q < 32; ++q) if (sTs[q] <= mt) e = q;
        const int mi0 = mt - sTs[e];
        const int cnt = CNT[e * CSTR];
        const int mvalid = (cnt - mi0 * 256 < 256) ? (cnt - mi0 * 256) : 256;
        const int rowbase = sPad[e] + mi0 * 256;
        if (which == 0) {
            long ro[4];
#pragma unroll
            for (int i = 0; i < 4; ++i) { const int r = (tid + 512 * i) >> 3; ro[i] = (r < mvalid) ? (long)LIST[(size_t)e * LISTCAP + mi0 * 256 + r] * 1024 : -1; }
            const long ro0 = ro[0], ro1 = ro[1], ro2 = ro[2], ro3 = ro[3];
            const bf16_t* Bb = (const bf16_t*)(ws_ + OFF_W13) + (size_t)e * 1024 * 1024 + (size_t)nt * 128 * 1024;
            bf16_t* Ht = HID + (size_t)rowbase * 512 + nt * 64;
            gemm_tile_bf16(1024, (unsigned char*)smem,
                [=](int i, int r, int k) -> uint4 { const long o = (i == 0) ? ro0 : (i == 1) ? ro1 : (i == 2) ? ro2 : ro3; if (o < 0) return make_uint4(0u, 0u, 0u, 0u);
                    return *(const uint4*)(H + o + k); },
                [=](int i, int r, int k) -> uint4 { return *(const uint4*)(Bb + (size_t)r * 1024 + k); },
                [=](const f32x4 (&acc)[4][4], int wm, int wn, int lane) {
#pragma unroll
                    for (int mi = 0; mi < 4; ++mi)
#pragma unroll
                        for (int ni = 0; ni < 2; ++ni) {
                            const int m = wm * 64 + mi * 16 + (lane & 15), n = wn * 32 + ni * 16 + 4 * (lane >> 4);
                            const f32x4 a1 = acc[mi][ni], a3 = acc[mi][ni + 2];
                            f32x4 hv; hv[0] = siluf_(a1[0]) * a3[0]; hv[1] = siluf_(a1[1]) * a3[1]; hv[2] = siluf_(a1[2]) * a3[2]; hv[3] = siluf_(a1[3]) * a3[3];
                            if (m < mvalid) *(uint2*)(Ht + (size_t)m * 512 + n) = pack4(hv);
                        }
                }, mvalid);
        } else {
            const bf16_t* Ab = HID + (size_t)rowbase * 512;
            const bf16_t* Bb = (const bf16_t*)(ws_ + OFF_W2T) + (size_t)e * 1024 * 512 + (size_t)nt * 128 * 512;
            bf16_t* Yt = YB + (size_t)rowbase * 1024 + nt * 128;
            gemm_tile_bf16(512, (unsigned char*)smem,
                [=](int i, int r, int k) -> uint4 { if (r >= mvalid) return make_uint4(0u, 0u, 0u, 0u); return *(const uint4*)(Ab + (size_t)r * 512 + k); },
                [=](int i, int r, int k) -> uint4 { return *(const uint4*)(Bb + (size_t)r * 512 + k); },
                [=](const f32x4 (&acc)[4][4], int wm, int wn, int lane) {
#pragma unroll
                    for (int mi = 0; mi < 4; ++mi)
#pragma unroll
                        for (int ni = 0; ni < 4; ++ni) {
                            const int m = wm * 64 + mi * 16 + (lane & 15), n = wn * 64 + ni * 16 + 4 * (lane >> 4);
                            if (m < mvalid) *(uint2*)(Yt + (size_t)m * 1024 + n) = pack4(acc[mi][ni]);
                        }
                }, mvalid);
        }
    }
}

PHASE_FN void ph_conv_dense(const Params& p, float* smem) {
    unsigned char* ws_ = p.ws; asm volatile("" : "+s"(ws_));
    { int ldz_ = 0; asm volatile("" : "+s"(ldz_)); smem = (float*)(g_smem + ldz_); }
    auto dec = [&](int t, const float*& s0, const float*& s1, bf16_t*& dst, int& mode, int& K, int& N, int& ld, int& rt, int& kt) {
        s1 = nullptr; mode = 0; K = 1024;
        if (t >= 4608) t = 4607;
        if (t < 1984) { const int l = t / 992, u = t % 992; s0 = p.even_w_in + (size_t)l * 1024 * 3916; N = 3916; ld = 3916; dst = (bf16_t*)(ws_ + OFF_WINE) + (size_t)l * 3968 * 1024; rt = u >> 4; kt = u & 15; }
        else if (t < 3584) { const int v = t - 1984, l = v / 800, u = v % 800; s0 = p.gla_w_in + (size_t)l * 1024 * 3088; N = 3088; ld = 3088; dst = (bf16_t*)(ws_ + OFF_WINO) + (size_t)l * 3200 * 1024; rt = u >> 4; kt = u & 15; }
        else { const int v = t - 3584, l = v >> 8, u = v & 255; s0 = ((l & 1) ? p.gla_w_out : p.even_w_out) + (size_t)(l >> 1) * 1024 * 1024; N = 1024; ld = 1024; dst = (bf16_t*)(ws_ + OFF_WOUT) + (size_t)l * 1024 * 1024; rt = u >> 4; kt = u & 15; }
    };
    for (int t = blockIdx.x * 4; t < 4608; t += gridDim.x * 4) convert_tiles4(dec, t, (4608 - t < 4) ? (4608 - t) : 4, smem);
}

PHASE_FN void ph_conv_exp(const Params& p, int layer, float* smem, int first_blk) {
    unsigned char* ws_ = p.ws; asm volatile("" : "+s"(ws_));
    { int ldz_ = 0; asm volatile("" : "+s"(ldz_)); smem = (float*)(g_smem + ldz_); }
    if ((int)blockIdx.x < first_blk) return;
    auto dec = [&](int t, const float*& s0, const float*& s1, bf16_t*& dst, int& mode, int& K, int& N, int& ld, int& rt, int& kt) {
        if (t >= 12288) t = 12287;
        if (t < 8192) { const int e = t >> 8, u = t & 255; s0 = p.w1 + (size_t)(layer * 32 + e) * 1024 * 512; s1 = p.w3 + (size_t)(layer * 32 + e) * 1024 * 512; mode = 1; K = 1024; N = 512; ld = 512;
            dst = (bf16_t*)(ws_ + OFF_W13) + (size_t)e * 1024 * 1024; rt = u >> 4; kt = u & 15; }
        else { const int v = t - 8192, e = v >> 7, u = v & 127; s0 = p.w2 + (size_t)(layer * 32 + e) * 512 * 1024; s1 = nullptr; mode = 0; K = 512; N = 1024; ld = 1024;
            dst = (bf16_t*)(ws_ + OFF_W2T) + (size_t)e * 1024 * 512; rt = u >> 3; kt = u & 7; }
    };
    const int nb = (int)gridDim.x - first_blk;
    for (int t = ((int)blockIdx.x - first_blk) * 4; t < 12288; t += nb * 4) convert_tiles4(dec, t, (12288 - t < 4) ? (12288 - t) : 4, smem);
}

PHASE_FN void ph_gla_tok(const Params& p, int layer) {
    unsigned char* ws_ = p.ws; asm volatile("" : "+s"(ws_));
    int tid_ = threadIdx.x; asm volatile("" : "+v"(tid_)); const int tid = tid_, lane = tid & 63, wv = tid >> 6, li = layer >> 1;
    const float* AUX = (const float*)(ws_ + OFF_AUX);
    float* LA = (float*)(ws_ + OFF_LA);
    const float* w2 = p.gla_w_gate2 + (size_t)li * 16 * 512; const float* b2 = p.gla_b_gate2 + li * 512;
    for (int t = blockIdx.x * 8 + wv; t < NT; t += gridDim.x * 8) {
        float glr[16];
#pragma unroll
        for (int r = 0; r < 16; ++r) glr[r] = AUX[(size_t)t * 16 + r];
#pragma unroll 1
        for (int i = 0; i < 8; ++i) {
            const int c = lane + 64 * i; float z = b2[c];
#pragma unroll
            for (int r = 0; r < 16; ++r) z += glr[r] * w2[r * 512 + c];
            LA[(size_t)t * 512 + c] = -softplusf_(-z) * (1.f / 16.f);
        }
    }
}

PHASE_FN void ph_gla_chunk(const Params& p, int layer, float* smem) {
    unsigned char* ws_ = p.ws; asm volatile("" : "+s"(ws_));
    int tid_ = threadIdx.x; asm volatile("" : "+v"(tid_)); const int tid = tid_, lane = tid & 63, wv = __builtin_amdgcn_readfirstlane(tid >> 6), q4 = lane >> 4, c16 = lane & 15;
    int ldz_ = 0; asm volatile("" : "+s"(ldz_)); unsigned char* lds = g_smem + ldz_;
    constexpr int SN = 272, ST = 144;
    float* sBc = (float*)lds;
    unsigned char* bQE = lds + 33024;
    unsigned char* bKE = lds + 50432;
    unsigned char* bKD = lds + 67840;
    unsigned char* bVT = lds + 86272;
    unsigned char* bATT = lds + 123136;
    const bf16_t* P = (const bf16_t*)(ws_ + OFF_P); const float* AUX = (const float*)(ws_ + OFF_AUX);
    const float* w2 = p.gla_w_gate2 + (size_t)(layer >> 1) * 16 * 512; const float* b2 = p.gla_b_gate2 + (layer >> 1) * 512;
    float* sGlr = (float*)(lds + 132352);
    uint4* QEF = (uint4*)(ws_ + OFF_GQE); uint2* OIF = (uint2*)(ws_ + OFF_GOI); uint2* HF = (uint2*)(ws_ + OFF_GH); float* EBL = (float*)(ws_ + OFF_GEBL);
    for (int ci = blockIdx.x; ci < 1024; ci += gridDim.x) {
        const int b = ci >> 9, h = (ci >> 7) & 3, n = ci & 127;
        const int t0 = b * 8192 + n * 64;
        __syncthreads();
        for (int e = tid; e < 1024; e += NTHREADS) sGlr[e] = AUX[(size_t)(t0 + (e >> 4)) * 16 + (e & 15)];
        __syncthreads();
        {
            const int d = tid & 127, c = h * 128 + d;
            float wg[16];
#pragma unroll
            for (int r = 0; r < 16; ++r) wg[r] = w2[r * 512 + c];
            const float bz = b2[c];
            for (int i = tid >> 7; i < 64; i += 4) {
                float z = bz;
#pragma unroll
                for (int r = 0; r < 16; ++r) z += sGlr[i * 16 + r] * wg[r];
                sBc[i * 129 + d] = -softplusf_(-z) * (1.f / 16.f);
            }
        }
        for (int e = tid; e < 64 * 36; e += NTHREADS) ((unsigned*)bATT)[e] = 0u;
        __syncthreads();
        if (tid < 128) { float a = 0.f; for (int i = 0; i < 64; ++i) { a += sBc[i * 129 + tid]; sBc[i * 129 + tid] = a; } }
        __syncthreads();
        for (int e = tid; e < 8192; e += NTHREADS) {
            const int i = e >> 7, d = e & 127;
            const float bb = sBc[i * 129 + d], bl = sBc[63 * 129 + d];
            const float qf = PBF(P, t0 + i, h * 128 + d), kf = PBF(P, t0 + i, 512 + h * 128 + d);
            *(bf16_t*)(bQE + i * SN + d * 2) = f2bf(qf * SCALE128 * expf(bb));
            *(bf16_t*)(bKE + i * SN + d * 2) = f2bf(kf * expf(-bb));
            *(bf16_t*)(bKD + d * ST + i * 2) = f2bf(kf * expf(bl - bb));
        }
        for (int e = tid; e < 16384; e += NTHREADS) { const int i = e >> 8, dv = e & 255; *(bf16_t*)(bVT + dv * ST + i * 2) = P[(size_t)(t0 + i) * LDPB + 1024 + h * 256 + dv]; }
        if (tid < 128) EBL[ci * 128 + tid] = expf(sBc[63 * 129 + tid]);
        __syncthreads();
        for (int u = wv; u < 10; u += 8) {
            const int ti = (u >= 6) ? 3 : (u >= 3) ? 2 : (u >= 1) ? 1 : 0, tj = u - ((ti * (ti + 1)) >> 1);
            f32x4 acc = (f32x4){0.f, 0.f, 0.f, 0.f};
            acc = mma_lds(bQE, SN, 16 * ti, bKE, SN, 16 * tj, 128, acc, c16, q4);
            const int j = 16 * tj + c16;
#pragma unroll
            for (int r = 0; r < 4; ++r) { const int i = 16 * ti + 4 * q4 + r; *(bf16_t*)(bATT + i * ST + j * 2) = f2bf((j <= i) ? acc[r] : 0.f); }
        }
        for (int x = 0; x < 2; ++x) {
            const int u = wv * 2 + x, ti = u >> 2, a = u & 3;
            const unsigned char* rp = bQE + (16 * ti + c16) * SN;
            const uint2 lo = *(const uint2*)(rp + (32 * a + 4 * q4) * 2), hi = *(const uint2*)(rp + (32 * a + 16 + 4 * q4) * 2);
            QEF[((size_t)(ci * 4 + ti) * 4 + a) * 64 + lane] = make_uint4(lo.x, lo.y, hi.x, hi.y);
        }
        __syncthreads();
        for (int x = 0; x < 8; ++x) {
            const int u = wv * 8 + x, tdv = u >> 2, ti = u & 3;
            f32x4 acc = (f32x4){0.f, 0.f, 0.f, 0.f};
            acc = mma_lds(bATT, ST, 16 * ti, bVT, ST, 16 * tdv, 64, acc, c16, q4);
            OIF[((size_t)(ci * 16 + tdv) * 4 + ti) * 64 + lane] = pack4(acc);
        }
        for (int x = 0; x < 16; ++x) {
            const int u = wv * 16 + x, tdv = u >> 3, tdk = u & 7;
            f32x4 acc = (f32x4){0.f, 0.f, 0.f, 0.f};
            acc = mma_lds(bKD, ST, 16 * tdk, bVT, ST, 16 * tdv, 64, acc, c16, q4);
            HF[((size_t)(ci * 16 + tdv) * 8 + tdk) * 64 + lane] = pack4(acc);
        }
    }
}

PHASE_FN void ph_gla_scan(const Params& p, float* smem) {
    unsigned char* ws_ = p.ws; asm volatile("" : "+s"(ws_));
    int tid_ = threadIdx.x; asm volatile("" : "+v"(tid_)); const int tid = tid_, lane = tid & 63, wv = __builtin_amdgcn_readfirstlane(tid >> 6), q4 = lane >> 4, c16 = lane & 15;
    int ldz_ = 0; asm volatile("" : "+s"(ldz_)); unsigned char* lds = g_smem + ldz_;
    constexpr int STG = 29184;
    const unsigned char* QEF = ws_ + OFF_GQE; const unsigned char* HF = ws_ + OFF_GH; const unsigned char* OIF = ws_ + OFF_GOI; const unsigned char* EBL = ws_ + OFF_GEBL;
    float* O = (float*)(ws_ + OFF_O);
    for (int it = blockIdx.x; it < 64; it += gridDim.x) {
        const int bh = it >> 3, pair = it & 7, b = bh >> 2, h = bh & 3;
        __syncthreads();
        if (wv >= 2) {
            const int lt = tid - 128;
            const unsigned char* Qb = QEF + (size_t)bh * 128 * 16384;
            const unsigned char* Hb = HF + (size_t)bh * 128 * 65536 + pair * 8192;
            const unsigned char* Ob = OIF + (size_t)bh * 128 * 32768 + pair * 4096;
            const unsigned char* Lb = EBL + (size_t)bh * 128 * 512;
            uint4 ra0, ra1, ra2, ra3, ra4, ra5, ra6, rb0, rb1, rb2, rb3, rb4, rb5, rb6, rc0, rc1, rc2, rc3, rc4, rc5, rc6, rd0, rd1, rd2, rd3, rd4, rd5, rd6;
#define GL_LOAD(X, n_) do { const unsigned char* q_ = Qb + (size_t)(n_) * 16384; const unsigned char* h_ = Hb + (size_t)(n_) * 65536; \
                const unsigned char* o_ = Ob + (size_t)(n_) * 32768; const unsigned char* l_ = Lb + (size_t)(n_) * 512; \
                X##0 = LDC(q_, lt, 1023); X##1 = LDC(q_, lt + 384, 1023); X##2 = LDC(q_, lt + 768, 1023); \
                X##3 = LDC(h_, lt, 511); X##4 = LDC(h_, lt + 384, 511); X##5 = LDC(o_, lt, 255); X##6 = LDC(l_, lt, 31); } while (0)
#define GL_STORE(X, st_) do { unsigned char* sb_ = lds + (st_) * STG; \
                STC(0, lt, 1024, X##0); STC(0, lt + 384, 1024, X##1); STC(0, lt + 768, 1024, X##2); \
                STC(16384, lt, 512, X##3); STC(16384, lt + 384, 512, X##4); STC(24576, lt, 256, X##5); STC(28672, lt, 32, X##6); } while (0)
            GL_LOAD(ra, 0); GL_STORE(ra, 0);
            GL_LOAD(rb, 1); GL_LOAD(rc, 2); GL_LOAD(rd, 3); GL_LOAD(ra, 4);
            __syncthreads();
            for (int n = 0; n < 128; n += 4) {
                GL_STORE(rb, 1); GL_LOAD(rb, CLAMPN(n + 5)); __syncthreads();
                GL_STORE(rc, 0); GL_LOAD(rc, CLAMPN(n + 6)); __syncthreads();
                GL_STORE(rd, 1); GL_LOAD(rd, CLAMPN(n + 7)); __syncthreads();
                if (n + 4 < 128) GL_STORE(ra, 0);
                GL_LOAD(ra, CLAMPN(n + 8)); __syncthreads();
            }
        } else {
            const int tdv = pair * 2 + wv;
            f32x4 S[8];
#pragma unroll
            for (int t = 0; t < 8; ++t) S[t] = (f32x4){0.f, 0.f, 0.f, 0.f};
            __syncthreads();
            for (int n = 0; n < 128; ++n) {
                const unsigned char* base = lds + (n & 1) * STG;
                const unsigned char* Qf = base + lane * 16, *Hf = base + 16384 + wv * 4096 + lane * 8, *Of = base + 24576 + wv * 2048 + lane * 8, *Lf = base + 28672 + q4 * 16;
                bf16x8 Sb[4];
#pragma unroll
                for (int a = 0; a < 4; ++a) { union { uint4 u; bf16x8 v; } cv; const uint2 lo = pack4(S[2 * a]), hi = pack4(S[2 * a + 1]); cv.u.x = lo.x; cv.u.y = lo.y; cv.u.z = hi.x; cv.u.w = hi.y; Sb[a] = cv.v; }
                const int t0 = b * 8192 + n * 64;
                f32x4 oa[4];
#pragma unroll
                for (int ti = 0; ti < 4; ++ti) oa[ti] = unpack4(*(const uint2*)(Of + ti * 512));
#pragma unroll
                for (int a = 0; a < 4; ++a)
#pragma unroll
                    for (int ti = 0; ti < 4; ++ti) oa[ti] = __builtin_amdgcn_mfma_f32_16x16x32_bf16(*(const bf16x8*)(Qf + (ti * 4 + a) * 1024), Sb[a], oa[ti], 0, 0, 0);
#pragma unroll
                for (int ti = 0; ti < 4; ++ti) {
                    float* op = O + (size_t)(t0 + 16 * ti + 4 * q4) * 1024 + h * 256 + 16 * tdv + c16;
                    op[0] = oa[ti][0]; op[1024] = oa[ti][1]; op[2048] = oa[ti][2]; op[3072] = oa[ti][3]; }
#pragma unroll
                for (int t = 0; t < 8; ++t) { const f32x4 lam = *(const f32x4*)(Lf + t * 64); S[t] = S[t] * lam + unpack4(*(const uint2*)(Hf + t * 512)); }
                __syncthreads();
            }
        }
    }
}

PHASE_FN void ph_gla_out(const Params& p, int layer) {
    unsigned char* ws_ = p.ws; asm volatile("" : "+s"(ws_));
    int tid_ = threadIdx.x; asm volatile("" : "+v"(tid_)); const int tid = tid_, lane = tid & 63, wv = tid >> 6;
    const float* O = (const float*)(ws_ + OFF_O); const bf16_t* P = (const bf16_t*)(ws_ + OFF_P); bf16_t* OB = (bf16_t*)(ws_ + OFF_OB);
    const float* onw = p.gla_out_norm + (layer >> 1) * 256;
    for (int t = blockIdx.x * 8 + wv; t < NT; t += gridDim.x * 8) {
#pragma unroll
        for (int h = 0; h < 4; ++h) {
            const float* op = O + (size_t)t * 1024 + h * 256;
            const float4 o = *(const float4*)(op + lane * 4);
            const float ss = wave_sum(o.x * o.x + o.y * o.y + o.z * o.z + o.w * o.w);
            const float r = rsqrtf(ss * (1.f / 256.f) + EPS);
            const f32x4 z = unpack4(*(const uint2*)(P + (size_t)t * LDPB + 2048 + h * 256 + lane * 4));
            const float4 w = *(const float4*)(onw + lane * 4);
            f32x4 ov; ov[0] = o.x * r * w.x * siluf_(z[0]); ov[1] = o.y * r * w.y * siluf_(z[1]); ov[2] = o.z * r * w.z * siluf_(z[2]); ov[3] = o.w * r * w.w * siluf_(z[3]);
            *(uint2*)(OB + (size_t)t * 1024 + h * 256 + lane * 4) = pack4(ov);
        }
    }
}

template <int PH>
__device__ __forceinline__ void run_phase(const Params& p, int layer, float* smem) {
    if (PH == PH_PROLOGUE) { ph_prologue(p, smem); ph_conv_dense(p, smem); }
    else if (PH == PH_NORM_MIX) ph_rows(p, layer, 0, smem);
    else if (PH == PH_GEMM_IN_EVEN) ph_gemm_in(p, layer, true, smem);
    else if (PH == PH_EVEN_TOK) { ph_even_tok(p, layer, smem); ph_gdn_chunk(p, layer, smem); }
    else if (PH == PH_GDN_CHUNK) ph_gdn_chunk(p, layer, smem);
    else if (PH == PH_GDN_SCAN) { ph_gdn_scan(p, smem); ph_conv_exp(p, layer, smem, 32); ph_dsa_topk(p, layer, smem); }
    else if (PH == PH_DSA_TOPK) ph_dsa_topk(p, layer, smem);
    else if (PH == PH_DSA_ATTN) { ph_dsa_attn(p, smem); ph_gdn_out(p, layer); }
    else if (PH == PH_GDN_OUT) ph_gdn_out(p, layer);
    else if (PH == PH_GEMM_OUT) ph_gemm_out(p, layer, smem);
    else if (PH == PH_NORM_FFN) ph_norm_ffn(p, layer);
    else if (PH == PH_MOE1) ph_moe(p, layer, 0, smem);
    else if (PH == PH_MOE2) ph_moe(p, layer, 1, smem);
    else if (PH == PH_GEMM_IN_ODD) ph_gemm_in(p, layer, false, smem);
    else if (PH == PH_GLA_TOK) ph_gla_tok(p, layer);
    else if (PH == PH_GLA_CHUNK) ph_gla_chunk(p, layer, smem);
    else if (PH == PH_GLA_SCAN) { ph_gla_scan(p, smem); ph_conv_exp(p, layer, smem, 64); }
    else if (PH == PH_GLA_OUT) ph_gla_out(p, layer);
    else if (PH == PH_FINAL) ph_rows(p, 0, 1, smem);
}

#if MK_MULTI
template <int PH>
__global__ void __launch_bounds__(NTHREADS, 2) k_phase(Params p, int layer) {
    run_phase<PH>(p, layer, (float*)g_smem);
}
#else
__global__ void __launch_bounds__(NTHREADS, 2) k_mega(Params p) {
    float* smem = (float*)g_smem;
    volatile LAS unsigned* xbw = (volatile LAS unsigned*)(LAS unsigned char*)(g_smem + LDS_BYTES - 16);
    if (threadIdx.x == 0) { xbw[0] = 0u; xbw[1] = 0u; xbw[2] = 0u; xbw[3] = 0u; }
    __syncthreads();
    XcdBarrier bar = xcd_barrier_post((unsigned*)(p.ws + OFF_BAR), xbw);
#define BAR() xcd_barrier(bar)
    run_phase<PH_PROLOGUE>(p, 0, smem); BAR(); if (DUP_MASK & 4096) { run_phase<PH_PROLOGUE>(p, 0, smem); BAR(); }
    for (int lp = 0; lp < 2; ++lp) {
        const int le = 2 * lp, lo = 2 * lp + 1;
        run_phase<PH_NORM_MIX>(p, le, smem); BAR();
        run_phase<PH_GEMM_IN_EVEN>(p, le, smem); BAR(); if (DUP_MASK & 1) { run_phase<PH_GEMM_IN_EVEN>(p, le, smem); BAR(); }
        run_phase<PH_EVEN_TOK>(p, le, smem); BAR(); if (DUP_MASK & 2) { run_phase<PH_EVEN_TOK>(p, le, smem); BAR(); }
        run_phase<PH_GDN_SCAN>(p, le, smem); BAR(); if (DUP_MASK & 8) { run_phase<PH_GDN_SCAN>(p, le, smem); BAR(); }
        run_phase<PH_DSA_ATTN>(p, le, smem); BAR(); if (DUP_MASK & 32) { run_phase<PH_DSA_ATTN>(p, le, smem); BAR(); }
        run_phase<PH_GEMM_OUT>(p, le, smem); BAR();
        run_phase<PH_NORM_FFN>(p, le, smem); BAR();
        run_phase<PH_MOE1>(p, le, smem); BAR(); if (DUP_MASK & 64) { run_phase<PH_MOE1>(p, le, smem); BAR(); }
        run_phase<PH_MOE2>(p, le, smem); BAR(); if (DUP_MASK & 128) { run_phase<PH_MOE2>(p, le, smem); BAR(); }
        run_phase<PH_NORM_MIX>(p, lo, smem); BAR();
        run_phase<PH_GEMM_IN_ODD>(p, lo, smem); BAR(); if (DUP_MASK & 256) { run_phase<PH_GEMM_IN_ODD>(p, lo, smem); BAR(); }
        run_phase<PH_GLA_CHUNK>(p, lo, smem); BAR(); if (DUP_MASK & 1024) { run_phase<PH_GLA_CHUNK>(p, lo, smem); BAR(); }
        run_phase<PH_GLA_SCAN>(p, lo, smem); BAR(); if (DUP_MASK & 2048) { run_phase<PH_GLA_SCAN>(p, lo, smem); BAR(); }
        run_phase<PH_GLA_OUT>(p, lo, smem); BAR();
        run_phase<PH_GEMM_OUT>(p, lo, smem); BAR();
        run_phase<PH_NORM_FFN>(p, lo, smem); BAR();
        run_phase<PH_MOE1>(p, lo, smem); BAR(); if (DUP_MASK & 64) { run_phase<PH_MOE1>(p, lo, smem); BAR(); }
        run_phase<PH_MOE2>(p, lo, smem); BAR(); if (DUP_MASK & 128) { run_phase<PH_MOE2>(p, lo, smem); BAR(); }
    }
    for (int xb = 0; xb < EXTRA_BARS; ++xb) BAR();
    run_phase<PH_FINAL>(p, 0, smem);
}
#endif

}

#if MK_MULTI
template <int PH>
static void launch_phase(const Params& p, int layer, hipStream_t stream) {
    static bool attr_set = false;
    if (!attr_set) { hipFuncSetAttribute((const void*)k_phase<PH>, hipFuncAttributeMaxDynamicSharedMemorySize, (int)LDS_BYTES); attr_set = true; }
    hipLaunchKernelGGL((k_phase<PH>), dim3(256), dim3(NTHREADS), LDS_BYTES, stream, p, layer);
}
#endif

extern "C" void kernel_launch(void* const* d_in, const int* in_sizes, int n_in, void* d_out, int out_size, void* d_ws, size_t ws_size, hipStream_t stream) {
    (void)in_sizes; (void)n_in; (void)out_size;
    if (ws_size < WS_NEEDED) { fprintf(stderr, "workspace too small: %zu < %zu\n", ws_size, (size_t)WS_NEEDED); return; }
    Params p{};
    p.x = (const float*)d_in[0]; p.c = (const float*)d_in[1]; p.pos = (const int*)d_in[2]; p.ada_w = (const float*)d_in[3]; p.ada_b = (const float*)d_in[4];
    p.norm_mix = (const float*)d_in[5]; p.norm_ffn = (const float*)d_in[6]; p.even_w_in = (const float*)d_in[7]; p.conv_w = (const float*)d_in[8];
    p.a_log = (const float*)d_in[9]; p.dt_bias = (const float*)d_in[10]; p.gdn_out_norm = (const float*)d_in[11]; p.even_w_out = (const float*)d_in[12];
    p.gla_w_in = (const float*)d_in[13]; p.gla_w_gate2 = (const float*)d_in[14]; p.gla_b_gate2 = (const float*)d_in[15]; p.gla_out_norm = (const float*)d_in[16]; p.gla_w_out = (const float*)d_in[17];
    p.rg_w = (const float*)d_in[18]; p.rg_b = (const float*)d_in[19]; p.re_w = (const float*)d_in[20]; p.re_b = (const float*)d_in[21];
    p.w1 = (const float*)d_in[22]; p.w3 = (const float*)d_in[23]; p.w2 = (const float*)d_in[24]; p.final_norm = (const float*)d_in[25];
    p.X = (float*)d_out; p.ws = (unsigned char*)d_ws;
    p.rA = pow(10000.0, -2.0 / 128.0); p.rI = pow(10000.0, -2.0 / 64.0);
    hipMemsetAsync(d_ws, 0, ZERO_BYTES, stream);
#if MK_MULTI
    launch_phase<PH_PROLOGUE>(p, 0, stream);
    for (int lp = 0; lp < 2; ++lp) {
        const int le = 2 * lp, lo = 2 * lp + 1;
        launch_phase<PH_NORM_MIX>(p, le, stream);
        launch_phase<PH_GEMM_IN_EVEN>(p, le, stream);
        launch_phase<PH_EVEN_TOK>(p, le, stream);
        launch_phase<PH_GDN_SCAN>(p, le, stream);
        launch_phase<PH_DSA_ATTN>(p, le, stream);
        launch_phase<PH_GEMM_OUT>(p, le, stream);
        launch_phase<PH_NORM_FFN>(p, le, stream);
        launch_phase<PH_MOE1>(p, le, stream);
        launch_phase<PH_MOE2>(p, le, stream);
        launch_phase<PH_NORM_MIX>(p, lo, stream);
        launch_phase<PH_GEMM_IN_ODD>(p, lo, stream);
        launch_phase<PH_GLA_CHUNK>(p, lo, stream);
        launch_phase<PH_GLA_SCAN>(p, lo, stream);
        launch_phase<PH_GLA_OUT>(p, lo, stream);
        launch_phase<PH_GEMM_OUT>(p, lo, stream);
        launch_phase<PH_NORM_FFN>(p, lo, stream);
        launch_phase<PH_MOE1>(p, lo, stream);
        launch_phase<PH_MOE2>(p, lo, stream);
    }
    launch_phase<PH_FINAL>(p, 0, stream);
#else
    static int grid = 0;
    if (!grid) {
        int dev = 0, cus = 0, per_cu = 0;
        hipGetDevice(&dev);
        hipDeviceGetAttribute(&cus, hipDeviceAttributeMultiprocessorCount, dev);
        hipFuncSetAttribute((const void*)k_mega, hipFuncAttributeMaxDynamicSharedMemorySize, (int)LDS_BYTES);
        hipOccupancyMaxActiveBlocksPerMultiprocessor(&per_cu, k_mega, NTHREADS, LDS_BYTES);
        if (cus <= 0) cus = 256;
        grid = cus * (per_cu < 1 ? 1 : 1);
    }
    hipLaunchKernelGGL(k_mega, dim3(grid), dim3(NTHREADS), LDS_BYTES, stream, p);
#endif
}
```

```cpp
#include <hip/hip_runtime.h>
#include <stdint.h>
#include <math.h>
#include <stdio.h>

#define EXTRA_BARS 0
#ifndef DUP_MASK
#define DUP_MASK 0
#endif
#ifndef MK_MULTI
#define MK_MULTI 0
#endif

namespace {

constexpr int NT = 16384, ND = 1024, LDP = 3920, LDPB = 3968;
constexpr float EPS = 1e-6f;
constexpr int NTHREADS = 512;
constexpr size_t LDS_BYTES = 147456;
constexpr float SCALE128 = 0.08838834764831845f;
constexpr int LISTCAP = 32768;
constexpr int CSTR = 16;

constexpr size_t OFF_BAR  = 0;
constexpr size_t OFF_CNT  = 16384;
constexpr size_t ZERO_BYTES = 32768;
constexpr size_t OFF_QCTR = 28672;
constexpr size_t OFF_MOD  = 32768;
constexpr size_t OFF_COSA = OFF_MOD + 4 * 2 * 6144 * 4;
constexpr size_t OFF_SINA = OFF_COSA + (size_t)NT * 64 * 4;
constexpr size_t OFF_COSI = OFF_SINA + (size_t)NT * 64 * 4;
constexpr size_t OFF_SINI = OFF_COSI + (size_t)NT * 32 * 4;
constexpr size_t OFF_H    = OFF_SINI + (size_t)NT * 32 * 4;
constexpr size_t OFF_P    = OFF_H + (size_t)NT * 1024 * 4;
constexpr size_t OFF_HID  = OFF_P;
constexpr size_t OFF_YB   = OFF_HID + (size_t)36864 * 512 * 4;
constexpr size_t OFF_O    = OFF_P + (size_t)NT * LDP * 4;
constexpr size_t OFF_ASG  = OFF_O + (size_t)NT * 1024 * 4;
constexpr size_t OFF_GATE = OFF_ASG + (size_t)NT * 4 * 4;
constexpr size_t OFF_LIST = OFF_GATE + (size_t)NT * 2 * 4;
constexpr size_t OFF_R    = OFF_LIST + (size_t)32 * LISTCAP * 4;
constexpr size_t OFF_QN   = OFF_R;
constexpr size_t OFF_KN   = OFF_QN + (size_t)NT * 512 * 4;
constexpr size_t OFF_VC   = OFF_KN + (size_t)NT * 512 * 4;
constexpr size_t OFF_BETA = OFF_VC + (size_t)NT * 512 * 4;
constexpr size_t OFF_G    = OFF_BETA + (size_t)NT * 4 * 4;
constexpr size_t OFF_W    = OFF_G + (size_t)NT * 4 * 4;
constexpr size_t OFF_U    = OFF_W + (size_t)1024 * 8192 * 4;
constexpr size_t OFF_QG   = OFF_U + (size_t)1024 * 8192 * 4;
constexpr size_t OFF_KD   = OFF_QG + (size_t)1024 * 8192 * 4;
constexpr size_t OFF_AQK  = OFF_KD + (size_t)1024 * 8192 * 4;
constexpr size_t OFF_GL   = OFF_AQK + (size_t)1024 * 4096 * 4;
constexpr size_t OFF_QB   = OFF_GL + 4096;
constexpr size_t OFF_KB   = OFF_QB + (size_t)NT * 512 * 4;
constexpr size_t OFF_QI   = OFF_KB + (size_t)NT * 512 * 4;
constexpr size_t OFF_KI   = OFF_QI + (size_t)NT * 256 * 4;
constexpr size_t OFF_WI   = OFF_KI + (size_t)NT * 64 * 4;
constexpr size_t OFF_SEL  = OFF_WI + (size_t)NT * 4 * 4;
constexpr size_t OFF_EVEN_END = OFF_SEL + (size_t)NT * 256 * 4;
constexpr size_t OFF_PFR  = OFF_W;
constexpr size_t OFF_RFR  = OFF_PFR + (size_t)1024 * 32768;
constexpr size_t OFF_QFR  = OFF_RFR + (size_t)1024 * 16384;
constexpr size_t OFF_OFR  = OFF_QFR + (size_t)1024 * 32768;
static_assert(OFF_OFR + (size_t)1024 * 16384 <= OFF_GL, "gdn v2 buffers overflow");
constexpr size_t OFF_QBB  = OFF_QB;
constexpr size_t OFF_KBB  = OFF_QBB + (size_t)NT * 512 * 2;
constexpr size_t OFF_VT   = OFF_KBB + (size_t)NT * 512 * 2;
constexpr size_t OFF_QIB  = OFF_VT + (size_t)NT * 512 * 2;
constexpr size_t OFF_KIB  = OFF_QIB + (size_t)NT * 256 * 2;
constexpr size_t OFF_M16  = OFF_KIB + (size_t)NT * 64 * 2;
static_assert(OFF_M16 + (size_t)NT * 512 * 2 <= OFF_WI, "dsa v2 buffers overflow");
constexpr size_t OFF_LA   = OFF_R;
constexpr size_t OFF_ATT  = OFF_LA + (size_t)NT * 512 * 4;
constexpr size_t OFF_QE   = OFF_ATT + (size_t)1024 * 4096 * 4;
constexpr size_t OFF_GKD  = OFF_QE + (size_t)1024 * 8192 * 4;
constexpr size_t OFF_EBL  = OFF_GKD + (size_t)1024 * 8192 * 4;
constexpr size_t OFF_GQE  = OFF_LA + (size_t)NT * 512 * 4;
constexpr size_t OFF_GOI  = OFF_GQE + (size_t)1024 * 16384;
constexpr size_t OFF_GH   = OFF_GOI + (size_t)1024 * 32768;
constexpr size_t OFF_GEBL = OFF_GH + (size_t)1024 * 65536;
static_assert(OFF_GEBL + (size_t)1024 * 512 <= OFF_EVEN_END, "gla v2 buffers overflow");
constexpr size_t OFF_WINE = OFF_EVEN_END;
constexpr size_t OFF_WINO = OFF_WINE + (size_t)2 * 3968 * 1024 * 2;
constexpr size_t OFF_WOUT = OFF_WINO + (size_t)2 * 3200 * 1024 * 2;
constexpr size_t OFF_W13  = OFF_WOUT + (size_t)4 * 1024 * 1024 * 2;
constexpr size_t OFF_W2T  = OFF_W13 + (size_t)32 * 1024 * 1024 * 2;
constexpr size_t OFF_OB   = OFF_W2T + (size_t)32 * 1024 * 512 * 2;
constexpr size_t OFF_AUX  = OFF_OB + (size_t)NT * 1024 * 2;
constexpr size_t WS_NEEDED = OFF_AUX + (size_t)NT * 16 * 4;

struct Params {
    const float* x; const float* c; const int* pos; const float* ada_w; const float* ada_b;
    const float* norm_mix; const float* norm_ffn; const float* even_w_in; const float* conv_w;
    const float* a_log; const float* dt_bias; const float* gdn_out_norm; const float* even_w_out;
    const float* gla_w_in; const float* gla_w_gate2; const float* gla_b_gate2; const float* gla_out_norm; const float* gla_w_out;
    const float* rg_w; const float* rg_b; const float* re_w; const float* re_b;
    const float* w1; const float* w3; const float* w2; const float* final_norm;
    float* X;
    unsigned char* ws;
    double rA, rI;
};

#define XB_TMO      128
#define XB_XCNT(j)  (256  + 64 * (j))
#define XB_XSUB(j)  (1280 + 64 * (j))
#define XB_XGEN(j)  (2304 + 64 * (j))
#define XB_TOP      3328
#define XB_TOPGEN   3392
#define XCD_BAR_WORDS 3456
#define XB_SPIN_CAP (1u << 18)
#define LAS __attribute__((address_space(3)))

__device__ __forceinline__ unsigned xb_ld(unsigned* p)              { return __hip_atomic_load(p, __ATOMIC_RELAXED, __HIP_MEMORY_SCOPE_AGENT); }
__device__ __forceinline__ unsigned xb_add(unsigned* p, unsigned v) { return __hip_atomic_fetch_add(p, v, __ATOMIC_RELAXED, __HIP_MEMORY_SCOPE_AGENT); }
__device__ __forceinline__ unsigned xb_xcc_id() { return (unsigned)__builtin_amdgcn_s_getreg((3 << 11) | 20) & 0xFu; }
#define XB_SPIN(cond, bar) do { unsigned _sp = 0; while (cond) { __builtin_amdgcn_s_sleep(1); \
    if ((++_sp & 255u) == 0u) { if (xb_ld(&(bar)[XB_TMO])) break; if (_sp > XB_SPIN_CAP) { atomicAdd(&(bar)[XB_TMO], 1u); break; } } } } while (0)

struct XcdBarrier { unsigned* bar; unsigned x; volatile LAS unsigned* st; };

__device__ __forceinline__ XcdBarrier xcd_barrier_post(unsigned* bar, volatile LAS unsigned* st) {
    XcdBarrier b; b.bar = bar; b.x = xb_xcc_id(); b.st = st;
    if (threadIdx.x == 0) (void)xb_add(&bar[XB_XCNT(b.x)], 1u);
    return b;
}
__device__ __forceinline__ void xcd_barrier_complete(unsigned* bar, unsigned x, unsigned& nloc, unsigned& nx) {
    const unsigned G = gridDim.x * gridDim.y * gridDim.z;
    unsigned sum, cnt, mine, sp = 0u;
    for (;;) {
        sum = 0u; cnt = 0u; mine = 0u;
#pragma unroll
        for (unsigned j = 0; j < 16; ++j) { const unsigned c = xb_ld(&bar[XB_XCNT(j)]); sum += c; cnt += (c > 0u) ? 1u : 0u; mine = (j == x) ? c : mine; }
        if (sum == G) break;
        __builtin_amdgcn_s_sleep(1);
        if ((++sp & 255u) == 0u) { if (xb_ld(&bar[XB_TMO])) break; if (sp > XB_SPIN_CAP) { atomicAdd(&bar[XB_TMO], 1u); break; } }
    }
    nloc = mine > 0u ? mine : 1u; nx = cnt > 0u ? cnt : 1u;
}
__device__ __forceinline__ void xcd_barrier(const XcdBarrier& b) {
    asm volatile("s_waitcnt vmcnt(0)" ::: "memory");
    __syncthreads();
    if (threadIdx.x == 0) {
        unsigned* bar = b.bar;
        __builtin_amdgcn_s_waitcnt(0);
        unsigned nloc = b.st[0], nx = b.st[1];
        if (nloc == 0u) { xcd_barrier_complete(bar, b.x, nloc, nx); b.st[0] = nloc; b.st[1] = nx; }
        const unsigned old = xb_add(&bar[XB_XSUB(b.x)], 1u);
        const unsigned gen = old / nloc;
        if (old + 1u == (gen + 1u) * nloc) {
            __builtin_amdgcn_fence(__ATOMIC_RELEASE, "agent");
            asm volatile("s_waitcnt vmcnt(0)" ::: "memory");
            const unsigned og = xb_add(&bar[XB_TOP], 1u);
            const unsigned tg = og / nx;
            if (og + 1u == (tg + 1u) * nx) xb_add(&bar[XB_TOPGEN], 1u);
            else XB_SPIN(xb_ld(&bar[XB_TOPGEN]) == tg, bar);
            __builtin_amdgcn_fence(__ATOMIC_ACQUIRE, "agent");
            xb_add(&bar[XB_XGEN(b.x)], 1u);
            asm volatile("s_waitcnt vmcnt(0)" ::: "memory");
        } else {
            XB_SPIN(xb_ld(&bar[XB_XGEN(b.x)]) == gen, bar);
            __builtin_amdgcn_fence(__ATOMIC_ACQUIRE, "agent");
            asm volatile("s_waitcnt vmcnt(0)" ::: "memory");
        }
    }
    __syncthreads();
}

__device__ __forceinline__ float wave_sum(float v) {
#pragma unroll
    for (int o = 32; o > 0; o >>= 1) v += __shfl_xor(v, o);
    return v;
}
__device__ __forceinline__ int wave_sum_i(int v) {
#pragma unroll
    for (int o = 32; o > 0; o >>= 1) v += __shfl_xor(v, o);
    return v;
}
__device__ __forceinline__ float wave_max(float v) {
#pragma unroll
    for (int o = 32; o > 0; o >>= 1) v = fmaxf(v, __shfl_xor(v, o));
    return v;
}
__device__ __forceinline__ float sigmoidf_(float x) { return 1.f / (1.f + expf(-x)); }
__device__ __forceinline__ float siluf_(float x) { return x / (1.f + expf(-x)); }
__device__ __forceinline__ float softplusf_(float x) { return fmaxf(x, 0.f) + log1pf(expf(-fabsf(x))); }
__device__ __forceinline__ unsigned ordkey(float f) { const unsigned u = __float_as_uint(f); return (u & 0x80000000u) ? ~u : (u | 0x80000000u); }

__device__ __forceinline__ void sincos_d(double a, double& s, double& c) {
    const double kq = rint(a * 0.63661977236758134308);
    double r = fma(-kq, 1.57079632673412561417e+00, a);
    r = fma(-kq, 6.07710050650619224932e-11, r);
    const int q = (int)((long long)kq & 3);
    const double r2 = r * r;
    const double sp = r * (1.0 + r2 * (-1.0 / 6 + r2 * (1.0 / 120 + r2 * (-1.0 / 5040 + r2 * (1.0 / 362880 + r2 * (-1.0 / 39916800 + r2 * (1.0 / 6227020800.0)))))));
    const double cp = 1.0 + r2 * (-0.5 + r2 * (1.0 / 24 + r2 * (-1.0 / 720 + r2 * (1.0 / 40320 + r2 * (-1.0 / 3628800 + r2 * (1.0 / 479001600.0 + r2 * (-1.0 / 87178291200.0)))))));
    if (q == 0) { s = sp; c = cp; } else if (q == 1) { s = cp; c = -sp; } else if (q == 2) { s = -sp; c = -cp; } else { s = -cp; c = sp; }
}
__device__ __forceinline__ double ipow_d(double b, int e) { double v = 1.0; while (e) { if (e & 1) v *= b; b *= b; e >>= 1; } return v; }

struct GemmArgs { const float* A; int lda; const int* rows; int m0; int mvalid; const float* B; int ldb; int n0; int N; int K; };

template <class Epi>
__device__ __forceinline__ void gemm128(const GemmArgs& g, float* smem, Epi epi) {
    float* As = smem;
    float* Bs = smem + 16 * 132;
    int tid_ = threadIdx.x; asm volatile("" : "+v"(tid_)); const int tid = tid_, ty = tid >> 4, tx = tid & 15;
    const int arow = tid >> 2, kq = (tid & 3) * 4;
    const int bk = tid >> 5, bn = (tid & 31) * 4;
    long asrc = -1;
    if (arow < g.mvalid) { const int r = g.rows ? g.rows[arow] : (g.m0 + arow); if (r >= 0) asrc = (long)r * g.lda; }
    const bool bval = (g.n0 + bn) < g.N;
    float acc[4][8];
#pragma unroll
    for (int i = 0; i < 4; ++i)
#pragma unroll
        for (int j = 0; j < 8; ++j) acc[i][j] = 0.f;
    for (int k0 = 0; k0 < g.K; k0 += 16) {
        float4 av = make_float4(0.f, 0.f, 0.f, 0.f), bv = make_float4(0.f, 0.f, 0.f, 0.f);
        if (asrc >= 0) av = *(const float4*)(g.A + asrc + k0 + kq);
        if (bval) bv = *(const float4*)(g.B + (size_t)(k0 + bk) * g.ldb + g.n0 + bn);
        __syncthreads();
        As[(kq + 0) * 132 + arow] = av.x; As[(kq + 1) * 132 + arow] = av.y; As[(kq + 2) * 132 + arow] = av.z; As[(kq + 3) * 132 + arow] = av.w;
        *(float4*)&Bs[bk * 132 + bn] = bv;
        __syncthreads();
#pragma unroll
        for (int kk = 0; kk < 16; ++kk) {
            const float4 a = *(const float4*)&As[kk * 132 + ty * 4];
            const float4 b0 = *(const float4*)&Bs[kk * 132 + tx * 8];
            const float4 b1 = *(const float4*)&Bs[kk * 132 + tx * 8 + 4];
            const float aa[4] = {a.x, a.y, a.z, a.w};
            const float bb[8] = {b0.x, b0.y, b0.z, b0.w, b1.x, b1.y, b1.z, b1.w};
#pragma unroll
            for (int i = 0; i < 4; ++i)
#pragma unroll
                for (int j = 0; j < 8; ++j) acc[i][j] += aa[i] * bb[j];
        }
    }
#pragma unroll
    for (int i = 0; i < 4; ++i) {
        const int r = ty * 4 + i;
        if (r < g.mvalid) {
#pragma unroll
            for (int j = 0; j < 8; ++j) { const int n = g.n0 + tx * 8 + j; if (n < g.N) epi(r, n, acc[i][j]); }
        }
    }
}


typedef short bf16x8 __attribute__((ext_vector_type(8)));
typedef float f32x4 __attribute__((ext_vector_type(4)));
typedef unsigned short bf16_t;
typedef __bf16 bf16x2_t __attribute__((ext_vector_type(2)));
typedef float f32x2_t __attribute__((ext_vector_type(2)));
__device__ __forceinline__ unsigned cvt_pk_bf16(float lo, float hi) { const f32x2_t v = {lo, hi}; const bf16x2_t r = __builtin_convertvector(v, bf16x2_t); return __builtin_bit_cast(unsigned, r); }
__device__ __forceinline__ bf16_t f2bf(float f) { return (bf16_t)(cvt_pk_bf16(f, 0.f) & 0xffffu); }
__device__ __forceinline__ float bf16_to_f32(bf16_t v) { return __uint_as_float(((unsigned)v) << 16); }
__device__ __forceinline__ uint2 pack4(const f32x4 v) { uint2 r; r.x = cvt_pk_bf16(v[0], v[1]); r.y = cvt_pk_bf16(v[2], v[3]); return r; }
__device__ __forceinline__ f32x4 unpack4(const uint2 u) { f32x4 r; r[0] = __uint_as_float(u.x << 16); r[1] = __uint_as_float(u.x & 0xffff0000u); r[2] = __uint_as_float(u.y << 16); r[3] = __uint_as_float(u.y & 0xffff0000u); return r; }
#define PBF(Pb_, t_, c_) bf16_to_f32((Pb_)[(size_t)(t_) * LDPB + (c_)])
__device__ __forceinline__ uint4 pack8(const float4 a, const float4 b) { uint4 r; r.x = cvt_pk_bf16(a.x, a.y); r.y = cvt_pk_bf16(a.z, a.w); r.z = cvt_pk_bf16(b.x, b.y); r.w = cvt_pk_bf16(b.z, b.w); return r; }
__device__ __forceinline__ int lds_off(int r, int c) { return r * 128 + ((c ^ (r & 7)) << 4); }

template <class ALoad, class BLoad, class Epi>
__device__ __forceinline__ void gemm_tile_bf16(const int K, unsigned char* lds, ALoad aload, BLoad bload, Epi epi, const int mrows = 256) {
    int tid_ = threadIdx.x; asm volatile("" : "+v"(tid_)); const int tid = tid_, lane = tid & 63, wid = tid >> 6, wm = wid >> 1, wn = wid & 1;
    f32x4 acc[4][4];
#pragma unroll
    for (int mi = 0; mi < 4; ++mi)
#pragma unroll
        for (int ni = 0; ni < 4; ++ni) acc[mi][ni] = (f32x4){0.f, 0.f, 0.f, 0.f};
    uint4 ra[4], rb[2];
    const int nk = K >> 6;
#pragma unroll
    for (int i = 0; i < 4; ++i) { const int q = tid + 512 * i; ra[i] = aload(i, q >> 3, (q & 7) * 8); }
#pragma unroll
    for (int i = 0; i < 2; ++i) { const int q = tid + 512 * i; rb[i] = bload(i, q >> 3, (q & 7) * 8); }
    __syncthreads();
#pragma unroll
    for (int i = 0; i < 4; ++i) { const int q = tid + 512 * i; *(uint4*)(lds + lds_off(q >> 3, q & 7)) = ra[i]; }
#pragma unroll
    for (int i = 0; i < 2; ++i) { const int q = tid + 512 * i; *(uint4*)(lds + 32768 + lds_off(q >> 3, q & 7)) = rb[i]; }
    __syncthreads();
    for (int kt = 0; kt < nk; ++kt) {
        if (kt + 1 < nk) {
#pragma unroll
            for (int i = 0; i < 4; ++i) { const int q = tid + 512 * i; ra[i] = aload(i, q >> 3, (kt + 1) * 64 + (q & 7) * 8); }
#pragma unroll
            for (int i = 0; i < 2; ++i) { const int q = tid + 512 * i; rb[i] = bload(i, q >> 3, (kt + 1) * 64 + (q & 7) * 8); }
        }
        const unsigned char* At = lds + (kt & 1) * 49152;
        const unsigned char* Bt = At + 32768;
        if (__builtin_amdgcn_readfirstlane(wm) * 64 < mrows) {
#pragma unroll
        for (int ks = 0; ks < 2; ++ks) {
            bf16x8 af[4], bfr[4];
            const int c = ks * 4 + (lane >> 4);
#pragma unroll
            for (int mi = 0; mi < 4; ++mi) af[mi] = *(const bf16x8*)(At + lds_off(wm * 64 + mi * 16 + (lane & 15), c));
#pragma unroll
            for (int ni = 0; ni < 4; ++ni) bfr[ni] = *(const bf16x8*)(Bt + lds_off(wn * 64 + ni * 16 + (lane & 15), c));
#pragma unroll
            for (int mi = 0; mi < 4; ++mi)
#pragma unroll
                for (int ni = 0; ni < 4; ++ni) acc[mi][ni] = __builtin_amdgcn_mfma_f32_16x16x32_bf16(bfr[ni], af[mi], acc[mi][ni], 0, 0, 0);
        }
        }
        if (kt + 1 < nk) {
            unsigned char* An = lds + ((kt + 1) & 1) * 49152;
#pragma unroll
            for (int i = 0; i < 4; ++i) { const int q = tid + 512 * i; *(uint4*)(An + lds_off(q >> 3, q & 7)) = ra[i]; }
#pragma unroll
            for (int i = 0; i < 2; ++i) { const int q = tid + 512 * i; *(uint4*)(An + 32768 + lds_off(q >> 3, q & 7)) = rb[i]; }
        }
        __syncthreads();
    }
    epi(acc, wm, wn, lane);
}

__device__ __forceinline__ void convert_tile(const float* src0, const float* src1, int mode, int K, int N, int ld, bf16_t* dst, int rt, int kt, float* smem) {
    int tid_ = threadIdx.x; asm volatile("" : "+v"(tid_)); const int tid = tid_;
    __syncthreads();
    { const int k = tid >> 3, R0 = rt * 64 + (tid & 7) * 8;
      const float* sp; int col;
      if (mode == 0) { sp = src0; col = R0; } else { sp = (R0 & 32) ? src1 : src0; col = (R0 >> 6) * 32 + (R0 & 31); }
      float4 a = make_float4(0.f, 0.f, 0.f, 0.f), b = a;
      const float* rp = sp + (size_t)(kt * 64 + k) * ld + col;
      if (col < N) a = *(const float4*)rp;
      if (col + 4 < N) b = *(const float4*)(rp + 4);
      float* d = smem + k * 65 + (tid & 7) * 8;
      d[0] = a.x; d[1] = a.y; d[2] = a.z; d[3] = a.w; d[4] = b.x; d[5] = b.y; d[6] = b.z; d[7] = b.w; }
    __syncthreads();
    { const int R = tid >> 3, kc = (tid & 7) * 8;
      float v[8];
#pragma unroll
      for (int j = 0; j < 8; ++j) v[j] = smem[(kc + j) * 65 + R];
      uint4 o; o.x = cvt_pk_bf16(v[0], v[1]); o.y = cvt_pk_bf16(v[2], v[3]); o.z = cvt_pk_bf16(v[4], v[5]); o.w = cvt_pk_bf16(v[6], v[7]);
      *(uint4*)(dst + (size_t)(rt * 64 + R) * K + kt * 64 + kc) = o; }
}

#define CT_LOAD(S0, S1, MODE, NN, LD, RT, KT, A, B) do { const int k_ = tid >> 3, R0_ = (RT) * 64 + (tid & 7) * 8; const float* sp_; int col_; \
        if ((MODE) == 0) { sp_ = (S0); col_ = R0_; } else { sp_ = (R0_ & 32) ? (S1) : (S0); col_ = (R0_ >> 6) * 32 + (R0_ & 31); } \
        A = make_float4(0.f, 0.f, 0.f, 0.f); B = A; const float* rp_ = sp_ + (size_t)((KT) * 64 + k_) * (LD) + col_; \
        if (col_ < (NN)) A = *(const float4*)rp_; if (col_ + 4 < (NN)) B = *(const float4*)(rp_ + 4); } while (0)
#define CT_WRITE(BUF, A, B) do { float* d_ = smem + (BUF) * 4160 + (tid >> 3) * 65 + (tid & 7) * 8; \
        d_[0] = A.x; d_[1] = A.y; d_[2] = A.z; d_[3] = A.w; d_[4] = B.x; d_[5] = B.y; d_[6] = B.z; d_[7] = B.w; } while (0)
#define CT_STORE(DST, KK, RT, KT, BUF) do { const int R_ = tid >> 3, kc_ = (tid & 7) * 8; const float* sb_ = smem + (BUF) * 4160; \
        uint4 o_; o_.x = cvt_pk_bf16(sb_[(kc_ + 0) * 65 + R_], sb_[(kc_ + 1) * 65 + R_]); o_.y = cvt_pk_bf16(sb_[(kc_ + 2) * 65 + R_], sb_[(kc_ + 3) * 65 + R_]); \
        o_.z = cvt_pk_bf16(sb_[(kc_ + 4) * 65 + R_], sb_[(kc_ + 5) * 65 + R_]); o_.w = cvt_pk_bf16(sb_[(kc_ + 6) * 65 + R_], sb_[(kc_ + 7) * 65 + R_]); \
        *(uint4*)((DST) + (size_t)((RT) * 64 + R_) * (KK) + (KT) * 64 + kc_) = o_; } while (0)
#define CT_DECL(I) const float* s0_##I; const float* s1_##I; bf16_t* d_##I; int md_##I, K_##I, N_##I, ld_##I, rt_##I, kt_##I
#define CT_ARGS(I) s0_##I, s1_##I, d_##I, md_##I, K_##I, N_##I, ld_##I, rt_##I, kt_##I
template <class Dec>
__device__ __forceinline__ void convert_tiles4(const Dec& dec, int t, int nj, float* smem) {
    int tid_ = threadIdx.x; asm volatile("" : "+v"(tid_)); const int tid = tid_;
    CT_DECL(0); CT_DECL(1); CT_DECL(2); CT_DECL(3);
    dec(t, CT_ARGS(0)); dec(t + 1, CT_ARGS(1)); dec(t + 2, CT_ARGS(2)); dec(t + 3, CT_ARGS(3));
    float4 a0, b0, a1, b1, a2, b2, a3, b3;
    a1 = b1 = a2 = b2 = a3 = b3 = make_float4(0.f, 0.f, 0.f, 0.f);
    CT_LOAD(s0_0, s1_0, md_0, N_0, ld_0, rt_0, kt_0, a0, b0);
    if (nj > 1) CT_LOAD(s0_1, s1_1, md_1, N_1, ld_1, rt_1, kt_1, a1, b1);
    if (nj > 2) CT_LOAD(s0_2, s1_2, md_2, N_2, ld_2, rt_2, kt_2, a2, b2);
    if (nj > 3) CT_LOAD(s0_3, s1_3, md_3, N_3, ld_3, rt_3, kt_3, a3, b3);
    __syncthreads();
    CT_WRITE(0, a0, b0); CT_WRITE(1, a1, b1); CT_WRITE(2, a2, b2); CT_WRITE(3, a3, b3);
    __syncthreads();
    CT_STORE(d_0, K_0, rt_0, kt_0, 0);
    if (nj > 1) CT_STORE(d_1, K_1, rt_1, kt_1, 1);
    if (nj > 2) CT_STORE(d_2, K_2, rt_2, kt_2, 2);
    if (nj > 3) CT_STORE(d_3, K_3, rt_3, kt_3, 3);
}

extern __shared__ __attribute__((aligned(16))) unsigned char g_smem[];
#define PHASE_FN __device__ __forceinline__
enum { PH_PROLOGUE = 0, PH_NORM_MIX, PH_GEMM_IN_EVEN, PH_EVEN_TOK, PH_GDN_CHUNK, PH_GDN_SCAN, PH_DSA_TOPK, PH_DSA_ATTN, PH_GDN_OUT,
       PH_GEMM_OUT, PH_NORM_FFN, PH_MOE1, PH_MOE2, PH_GEMM_IN_ODD, PH_GLA_TOK, PH_GLA_CHUNK, PH_GLA_SCAN, PH_GLA_OUT, PH_FINAL };

PHASE_FN void ph_prologue(const Params& p, float* smem) {
    unsigned char* ws_ = p.ws; asm volatile("" : "+s"(ws_));
    { int ldz_ = 0; asm volatile("" : "+s"(ldz_)); smem = (float*)(g_smem + ldz_); }
    int tid_ = threadIdx.x; asm volatile("" : "+v"(tid_)); const int tid = tid_, nthr = gridDim.x * NTHREADS, gid = blockIdx.x * NTHREADS + tid;
    for (int i = tid; i < 2 * ND; i += NTHREADS) smem[i] = siluf_(p.c[i]);
    __syncthreads();
    float* MOD = (float*)(ws_ + OFF_MOD);
    { float* red = smem + 2048;
      const int lane = tid & 63, wv = tid >> 6;
      for (int item = blockIdx.x; item < 4 * 96; item += gridDim.x) {
          const int l = item / 96, n = (item % 96) * 64 + lane;
          const float* w = p.ada_w + (size_t)l * ND * 6144 + n;
          float a0 = 0.f, a1 = 0.f;
#pragma unroll 8
          for (int k = wv * 128; k < wv * 128 + 128; ++k) { const float wv_ = w[(size_t)k * 6144]; a0 += smem[k] * wv_; a1 += smem[ND + k] * wv_; }
          __syncthreads();
          red[(wv * 64 + lane) * 2] = a0; red[(wv * 64 + lane) * 2 + 1] = a1;
          __syncthreads();
          if (tid < 128) { const int c = tid >> 1, bb = tid & 1; float a = 0.f; for (int w8 = 0; w8 < 8; ++w8) a += red[(w8 * 64 + c) * 2 + bb];
              MOD[(l * 2 + bb) * 6144 + (item % 96) * 64 + c] = a + p.ada_b[l * 6144 + (item % 96) * 64 + c]; }
      }
      __syncthreads(); }
    float* COSA = (float*)(ws_ + OFF_COSA); float* SINA = (float*)(ws_ + OFF_SINA);
    float* COSI = (float*)(ws_ + OFF_COSI); float* SINI = (float*)(ws_ + OFF_SINI);
    for (size_t i = gid; i < (size_t)NT * 64; i += nthr) {
        const int t = (int)(i >> 6), j = (int)(i & 63);
        double s, c; sincos_d((double)p.pos[t] * ipow_d(p.rA, j), s, c);
        COSA[i] = (float)c; SINA[i] = (float)s;
    }
    for (size_t i = gid; i < (size_t)NT * 32; i += nthr) {
        const int t = (int)(i >> 5), j = (int)(i & 31);
        double s, c; sincos_d((double)p.pos[t] * ipow_d(p.rI, j), s, c);
        COSI[i] = (float)c; SINI[i] = (float)s;
    }
}

PHASE_FN void ph_rows(const Params& p, int layer, int mode, float* smem) {
    unsigned char* ws_ = p.ws; asm volatile("" : "+s"(ws_));
    { int ldz_ = 0; asm volatile("" : "+s"(ldz_)); smem = (float*)(g_smem + ldz_); }
    int tid_ = threadIdx.x; asm volatile("" : "+v"(tid_)); const int tid = tid_, lane = tid & 63, wv = tid >> 6;
    int* pad = (int*)smem;
    const int moe_layer = (mode == 1) ? 3 : layer - 1;
    if (moe_layer >= 0) {
        if (tid == 0) { const int* cnt = (const int*)(ws_ + OFF_CNT) + moe_layer * 32 * CSTR; int a = 0; for (int e = 0; e < 32; ++e) { pad[e] = a; a += ((cnt[e * CSTR] + 127) / 128) * 128; } }
        __syncthreads();
    }
    const float* MOD = (const float*)(ws_ + OFF_MOD);
    bf16_t* H = (bf16_t*)(ws_ + OFF_H);
    const bf16_t* YB = (const bf16_t*)(ws_ + OFF_YB);
    const int* ASG = (const int*)(ws_ + OFF_ASG);
    const float* GATE = (const float*)(ws_ + OFF_GATE);
    auto load_x = [&](int row, float (&xv)[16]) {
        const float* xin = (mode == 0 && layer == 0) ? (p.x + (size_t)row * ND) : (p.X + (size_t)row * ND);
#pragma unroll
        for (int j = 0; j < 4; ++j) { const float4 v = *(const float4*)(xin + j * 256 + lane * 4); xv[4 * j] = v.x; xv[4 * j + 1] = v.y; xv[4 * j + 2] = v.z; xv[4 * j + 3] = v.w; }
    };
    auto load_y = [&](int row, uint2 (&ya)[4], uint2 (&yb)[4], float& g0, float& g1) {
        const int4 as = *(const int4*)(ASG + row * 4);
        g0 = GATE[row * 2]; g1 = GATE[row * 2 + 1];
        const bf16_t* y0 = YB + (size_t)(pad[as.x] + as.y) * ND;
        const bf16_t* y1 = YB + (size_t)(pad[as.z] + as.w) * ND;
#pragma unroll
        for (int j = 0; j < 4; ++j) { ya[j] = *(const uint2*)(y0 + j * 256 + lane * 4); yb[j] = *(const uint2*)(y1 + j * 256 + lane * 4); }
    };
    auto finish = [&](int row, float (&xv)[16], const uint2 (&ya)[4], const uint2 (&yb)[4], float g0, float g1) {
        const int b = row >> 13;
        float* xr = p.X + (size_t)row * ND;
        if (moe_layer >= 0) {
            const float* gt = MOD + (size_t)(moe_layer * 2 + b) * 6144 + 5 * 1024;
#pragma unroll
            for (int j = 0; j < 4; ++j) {
                const int col = j * 256 + lane * 4;
                const f32x4 a = unpack4(ya[j]), bq = unpack4(yb[j]); const float4 g = *(const float4*)(gt + col);
                xv[4 * j] += g.x * (g0 * a[0] + g1 * bq[0]); xv[4 * j + 1] += g.y * (g0 * a[1] + g1 * bq[1]);
                xv[4 * j + 2] += g.z * (g0 * a[2] + g1 * bq[2]); xv[4 * j + 3] += g.w * (g0 * a[3] + g1 * bq[3]);
                if (mode == 0) *(float4*)(xr + col) = make_float4(xv[4 * j], xv[4 * j + 1], xv[4 * j + 2], xv[4 * j + 3]);
            }
        }
        float ss = 0.f;
#pragma unroll
        for (int j = 0; j < 16; ++j) ss += xv[j] * xv[j];
        ss = wave_sum(ss);
        const float rstd = rsqrtf(ss * (1.f / 1024.f) + EPS);
        if (mode == 0) {
            const float* nw = p.norm_mix + layer * 1024;
            const float* sh = MOD + (size_t)(layer * 2 + b) * 6144;
            const float* sc = sh + 1024;
#pragma unroll
            for (int j = 0; j < 4; ++j) {
                const int col = j * 256 + lane * 4;
                const float4 w = *(const float4*)(nw + col), s4 = *(const float4*)(sc + col), h4 = *(const float4*)(sh + col);
                f32x4 ov;
                ov[0] = xv[4 * j] * rstd * w.x * (1.f + s4.x) + h4.x; ov[1] = xv[4 * j + 1] * rstd * w.y * (1.f + s4.y) + h4.y;
                ov[2] = xv[4 * j + 2] * rstd * w.z * (1.f + s4.z) + h4.z; ov[3] = xv[4 * j + 3] * rstd * w.w * (1.f + s4.w) + h4.w;
                *(uint2*)(H + (size_t)row * ND + col) = pack4(ov);
            }
        } else {
#pragma unroll
            for (int j = 0; j < 4; ++j) {
                const int col = j * 256 + lane * 4;
                const float4 w = *(const float4*)(p.final_norm + col);
                *(float4*)(xr + col) = make_float4(xv[4 * j] * rstd * w.x, xv[4 * j + 1] * rstd * w.y, xv[4 * j + 2] * rstd * w.z, xv[4 * j + 3] * rstd * w.w);
            }
        }
    };
    const int stride = gridDim.x * 8;
    for (int row = blockIdx.x * 8 + wv; row < NT; row += 2 * stride) {
        const int rowB = row + stride; const bool hasB = rowB < NT; const int rB = hasB ? rowB : row;
        float xa[16], xb[16]; uint2 yaa[4], yab[4], yba[4], ybb[4]; float ga0 = 0.f, ga1 = 0.f, gb0 = 0.f, gb1 = 0.f;
        load_x(row, xa); load_x(rB, xb);
        if (moe_layer >= 0) { load_y(row, yaa, yab, ga0, ga1); load_y(rB, yba, ybb, gb0, gb1); }
        finish(row, xa, yaa, yab, ga0, ga1);
        if (hasB) finish(rowB, xb, yba, ybb, gb0, gb1);
    }
}

PHASE_FN void ph_gemm_in(const Params& p, int layer, bool even, float* smem) {
    unsigned char* ws_ = p.ws; asm volatile("" : "+s"(ws_));
    { int ldz_ = 0; asm volatile("" : "+s"(ldz_)); smem = (float*)(g_smem + ldz_); }
    const int N = even ? 3916 : 3088, ntn = even ? 31 : 25;
    const bf16_t* Wt = even ? (const bf16_t*)(ws_ + OFF_WINE) + (size_t)(layer >> 1) * 3968 * 1024 : (const bf16_t*)(ws_ + OFF_WINO) + (size_t)(layer >> 1) * 3200 * 1024;
    const bf16_t* H = (const bf16_t*)(ws_ + OFF_H);
    bf16_t* P = (bf16_t*)(ws_ + OFF_P);
    float* AUX = (float*)(ws_ + OFF_AUX);
    const int vb_ = ((int)blockIdx.x & 7) * ((int)gridDim.x >> 3) + ((int)blockIdx.x >> 3);
    for (int tile = vb_; tile < 64 * ntn; tile += gridDim.x) {
        const int grp_ = tile / (8 * ntn), rr_ = tile % (8 * ntn), mt = grp_ * 8 + (rr_ & 7), nt = rr_ >> 3;
        const bf16_t* Ab = H + (size_t)mt * 256 * 1024;
        const bf16_t* Bb = Wt + (size_t)nt * 128 * 1024;
        bf16_t* Pt = P + (size_t)mt * 256 * LDPB + nt * 128;
        float* At = AUX + (size_t)mt * 256 * 16;
        const int ncol0 = nt * 128;
        const int nrem = N - nt * 128;
        gemm_tile_bf16(1024, (unsigned char*)smem,
            [=](int i, int r, int k) -> uint4 { return *(const uint4*)(Ab + (size_t)r * 1024 + k); },
            [=](int i, int r, int k) -> uint4 { return *(const uint4*)(Bb + (size_t)r * 1024 + k); },
            [=](const f32x4 (&acc)[4][4], int wm, int wn, int lane) {
#pragma unroll
                for (int mi = 0; mi < 4; ++mi)
#pragma unroll
                    for (int ni = 0; ni < 4; ++ni) {
                        const int m = wm * 64 + mi * 16 + (lane & 15), n = wn * 64 + ni * 16 + 4 * (lane >> 4);
                        if (n < nrem) {
                            *(uint2*)(Pt + (size_t)m * LDPB + n) = pack4(acc[mi][ni]);
                            const int gc = ncol0 + n;
                            int ax = -1;
                            if (even) { if (gc == 2048) ax = 0; else if (gc == 2052) ax = 4; else if (gc == 3912) ax = 8; }
                            else { if (gc >= 3072 && gc < 3088) ax = gc - 3072; }
                            if (ax >= 0) *(f32x4*)(At + (size_t)m * 16 + ax) = acc[mi][ni];
                        }
                    }
            });
    }
}

PHASE_FN void ph_even_tok(const Params& p, int layer, float* smem) {
    unsigned char* ws_ = p.ws; asm volatile("" : "+s"(ws_));
    { int ldz_ = 0; asm volatile("" : "+s"(ldz_)); smem = (float*)(g_smem + ldz_); }
    int tid_ = threadIdx.x; asm volatile("" : "+v"(tid_)); const int tid = tid_, lane = tid & 63, wv = tid >> 6, li = layer >> 1;
    const bf16_t* P = (const bf16_t*)(ws_ + OFF_P); const float* AUX = (const float*)(ws_ + OFF_AUX);
    bf16_t* QB = (bf16_t*)(ws_ + OFF_QBB); bf16_t* KB = (bf16_t*)(ws_ + OFF_KBB); bf16_t* QI = (bf16_t*)(ws_ + OFF_QIB); bf16_t* KI = (bf16_t*)(ws_ + OFF_KIB); float* WI = (float*)(ws_ + OFF_WI);
    const float* COSA = (const float*)(ws_ + OFF_COSA); const float* SINA = (const float*)(ws_ + OFF_SINA);
    const float* COSI = (const float*)(ws_ + OFF_COSI); const float* SINI = (const float*)(ws_ + OFF_SINI);
    for (int t = blockIdx.x * 8 + wv; t < NT; t += gridDim.x * 8) {
        const bf16_t* Pt = P + (size_t)t * LDPB;
        if (lane < 4) {
            WI[t * 4 + lane] = AUX[(size_t)t * 16 + 8 + lane] * 0.0625f;
        }
        { const float c = COSA[(size_t)t * 64 + lane], sn = SINA[(size_t)t * 64 + lane];
#pragma unroll
          for (int h = 0; h < 4; ++h) {
              float t1 = bf16_to_f32(Pt[2056 + h * 128 + lane]), t2 = bf16_to_f32(Pt[2056 + h * 128 + 64 + lane]);
              QB[(size_t)t * 512 + h * 128 + lane] = f2bf(t1 * c - t2 * sn); QB[(size_t)t * 512 + h * 128 + 64 + lane] = f2bf(t2 * c + t1 * sn);
              t1 = bf16_to_f32(Pt[2568 + h * 128 + lane]); t2 = bf16_to_f32(Pt[2568 + h * 128 + 64 + lane]);
              KB[(size_t)t * 512 + h * 128 + lane] = f2bf(t1 * c - t2 * sn); KB[(size_t)t * 512 + h * 128 + 64 + lane] = f2bf(t2 * c + t1 * sn);
          } }
#pragma unroll
        for (int r = 0; r < 2; ++r) {
            const int item = lane + 64 * r, hh = item >> 5, ii = item & 31;
            const float c = COSI[(size_t)t * 32 + ii], sn = SINI[(size_t)t * 32 + ii];
            const float t1 = bf16_to_f32(Pt[3592 + hh * 64 + ii]), t2 = bf16_to_f32(Pt[3592 + hh * 64 + 32 + ii]);
            QI[(size_t)t * 256 + hh * 64 + ii] = f2bf(t1 * c - t2 * sn); QI[(size_t)t * 256 + hh * 64 + 32 + ii] = f2bf(t2 * c + t1 * sn);
        }
        if (lane < 32) {
            const float c = COSI[(size_t)t * 32 + lane], sn = SINI[(size_t)t * 32 + lane];
            const float t1 = bf16_to_f32(Pt[3848 + lane]), t2 = bf16_to_f32(Pt[3848 + 32 + lane]);
            KI[(size_t)t * 64 + lane] = f2bf(t1 * c - t2 * sn); KI[(size_t)t * 64 + 32 + lane] = f2bf(t2 * c + t1 * sn);
        }
    }
    { bf16_t* VT = (bf16_t*)(ws_ + OFF_VT);
      bf16_t* sv = (bf16_t*)g_smem;
      for (int item = blockIdx.x; item < 2 * 128 * 4; item += gridDim.x) {
          const int h = item & 3, tt = item >> 2, b = tt >> 7, s0 = (tt & 127) * 64;
          __syncthreads();
          for (int e = tid; e < 64 * 128; e += NTHREADS) { const int i = e >> 7, d = e & 127; sv[d * 72 + i] = P[(size_t)(b * 8192 + s0 + i) * LDPB + 3080 + h * 128 + d]; }
          __syncthreads();
          for (int e = tid; e < 128 * 8; e += NTHREADS) { const int d = e >> 3, c = e & 7;
              *(uint4*)(VT + ((size_t)((b * 4 + h) * 128 + d)) * 8192 + s0 + c * 8) = *(const uint4*)(sv + d * 72 + c * 8); }
      } }
}

__device__ __forceinline__ f32x4 mma_lds(const unsigned char* A, int sa, int a0, const unsigned char* B, int sb, int b0, int K, f32x4 acc, int c16, int q4) {
    const unsigned char* ap = A + (a0 + c16) * sa + q4 * 16;
    const unsigned char* bp = B + (b0 + c16) * sb + q4 * 16;
    for (int kk = 0; kk < K; kk += 32) { acc = __builtin_amdgcn_mfma_f32_16x16x32_bf16(*(const bf16x8*)(ap + kk * 2), *(const bf16x8*)(bp + kk * 2), acc, 0, 0, 0); }
    return acc;
}

PHASE_FN void ph_gdn_chunk(const Params& p, int layer, float* smem) {
    unsigned char* ws_ = p.ws; asm volatile("" : "+s"(ws_));
    int tid_ = threadIdx.x; asm volatile("" : "+v"(tid_)); const int tid = tid_, lane = tid & 63, wv = __builtin_amdgcn_readfirstlane(tid >> 6), q4 = lane >> 4, c16 = lane & 15;
    int ldz_ = 0; asm volatile("" : "+s"(ldz_)); unsigned char* lds = g_smem + ldz_;
    constexpr int SN = 272, ST = 144;
    unsigned char* bKN = lds;
    unsigned char* bQN = lds + 18432;
    unsigned char* bKBG = lds + 35840;
    unsigned char* bVB = lds + 54272;
    unsigned char* bKD = lds + 72704;
    unsigned char* bUT = lds + 91136;
    float* sL = (float*)(lds + 109568);
    unsigned char* bAQK = lds + 126208;
    unsigned char* bTB = lds + 135424;
    float* sG = (float*)(lds + 144640); float* sB = sG + 64; float* sEg = sB + 64;
    const int li = layer >> 1;
    const bf16_t* P = (const bf16_t*)(ws_ + OFF_P); const float* AUX = (const float*)(ws_ + OFF_AUX);
    const float* cw = p.conv_w + (size_t)li * 4 * 1536;
    uint4* PFR = (uint4*)(ws_ + OFF_PFR); uint4* RFR = (uint4*)(ws_ + OFF_RFR); uint2* QFR = (uint2*)(ws_ + OFF_QFR); uint2* OFR = (uint2*)(ws_ + OFF_OFR);
    float* GL = (float*)(ws_ + OFF_GL);
    for (int ci = blockIdx.x; ci < 1024; ci += gridDim.x) {
        const int b = ci >> 9, h = (ci >> 7) & 3, n = ci & 127;
        const int t0 = b * 8192 + n * 64;
        __syncthreads();
        if (tid < 64) { float g = -expf(p.a_log[li * 4 + h]) * softplusf_(AUX[(size_t)(t0 + tid) * 16 + 4 + h] + p.dt_bias[li * 4 + h]);
#pragma unroll
            for (int o = 1; o < 64; o <<= 1) { const float nb = __shfl_up(g, o); if (lane >= o) g += nb; }
            sG[tid] = g; sB[tid] = sigmoidf_(AUX[(size_t)(t0 + tid) * 16 + h]); sEg[tid] = expf(g); }
        for (int e = tid; e < 64 * 36; e += NTHREADS) ((unsigned*)bAQK)[e] = 0u;
        __syncthreads();
        const float gl = sG[63];
        {
            const int d0 = 2 * lane, cb = h * 128 + d0, s00 = n * 64;
            float wq[4][2], wk[4][2], wvv[4][2];
#pragma unroll
            for (int jj = 0; jj < 4; ++jj) { wq[jj][0] = cw[jj * 1536 + cb]; wq[jj][1] = cw[jj * 1536 + cb + 1]; wk[jj][0] = cw[jj * 1536 + 512 + cb]; wk[jj][1] = cw[jj * 1536 + 512 + cb + 1];
                                            wvv[jj][0] = cw[jj * 1536 + 1024 + cb]; wvv[jj][1] = cw[jj * 1536 + 1024 + cb + 1]; }
#pragma unroll 4
            for (int r = 0; r < 8; ++r) {
                const int i = wv + 8 * r;
                float aq0 = 0.f, aq1 = 0.f, ak0 = 0.f, ak1 = 0.f, av0 = 0.f, av1 = 0.f;
#pragma unroll
                for (int jj = 0; jj < 4; ++jj) {
                    if (s00 + i - 3 + jj >= 0) {
                        const bf16_t* rp = P + (size_t)(t0 + i - 3 + jj) * LDPB + cb;
                        const unsigned uq = *(const unsigned*)rp, uk = *(const unsigned*)(rp + 512), uv = *(const unsigned*)(rp + 1024);
                        aq0 += wq[jj][0] * __uint_as_float(uq << 16); aq1 += wq[jj][1] * __uint_as_float(uq & 0xffff0000u);
                        ak0 += wk[jj][0] * __uint_as_float(uk << 16); ak1 += wk[jj][1] * __uint_as_float(uk & 0xffff0000u);
                        av0 += wvv[jj][0] * __uint_as_float(uv << 16); av1 += wvv[jj][1] * __uint_as_float(uv & 0xffff0000u);
                    }
                }
                aq0 = siluf_(aq0); aq1 = siluf_(aq1); ak0 = siluf_(ak0); ak1 = siluf_(ak1); av0 = siluf_(av0); av1 = siluf_(av1);
                const float rq = rsqrtf(wave_sum(aq0 * aq0 + aq1 * aq1) + EPS), rk = rsqrtf(wave_sum(ak0 * ak0 + ak1 * ak1) + EPS);
                aq0 *= rq; aq1 *= rq; ak0 *= rk; ak1 *= rk;
                const float be = sB[i], eg_i = sEg[i], ekd = expf(gl - sG[i]);
                *(unsigned*)(bKN + i * SN + d0 * 2) = cvt_pk_bf16(ak0, ak1);
                *(unsigned*)(bQN + i * SN + d0 * 2) = cvt_pk_bf16(aq0, aq1);
                *(bf16_t*)(bKBG + d0 * ST + i * 2) = f2bf(ak0 * be * eg_i); *(bf16_t*)(bKBG + (d0 + 1) * ST + i * 2) = f2bf(ak1 * be * eg_i);
                *(bf16_t*)(bVB + d0 * ST + i * 2) = f2bf(av0 * be); *(bf16_t*)(bVB + (d0 + 1) * ST + i * 2) = f2bf(av1 * be);
                *(bf16_t*)(bKD + d0 * ST + i * 2) = f2bf(ak0 * ekd); *(bf16_t*)(bKD + (d0 + 1) * ST + i * 2) = f2bf(ak1 * ekd);
            }
        }
        __syncthreads();
        for (int u = wv; u < 20; u += 8) {
            const int kind = (u >= 10) ? 1 : 0, idx = u - kind * 10;
            const int ti = (idx >= 6) ? 3 : (idx >= 3) ? 2 : (idx >= 1) ? 1 : 0, tj = idx - ((ti * (ti + 1)) >> 1);
            f32x4 acc = (f32x4){0.f, 0.f, 0.f, 0.f};
            acc = mma_lds(kind ? bQN : bKN, SN, 16 * ti, bKN, SN, 16 * tj, 128, acc, c16, q4);
            const int j = 16 * tj + c16;
#pragma unroll
            for (int r = 0; r < 4; ++r) { const int i = 16 * ti + 4 * q4 + r;
                const float dec = (j <= i) ? expf(sG[i] - sG[j]) : 0.f;
                if (kind == 0) sL[i * 65 + j] = (j < i) ? sB[i] * acc[r] * dec : 0.f;
                else *(bf16_t*)(bAQK + i * ST + j * 2) = f2bf(acc[r] * SCALE128 * dec); }
        }
        __syncthreads();
        if (wv == 0) {
            float t[64];
            int zz = 0; asm volatile("" : "+v"(zz)); const float* sLo = sL + zz;
#pragma unroll
            for (int i = 0; i < 64; ++i) { float a = (i == lane) ? 1.f : 0.f;
#pragma unroll
                for (int j = 0; j < i; ++j) a -= sLo[i * 65 + j] * t[j];
                t[i] = a; asm volatile("" ::: "memory"); }
#pragma unroll
            for (int i = 0; i < 64; ++i) *(bf16_t*)(bTB + i * ST + lane * 2) = f2bf(t[i]);
        }
        __syncthreads();
        for (int x = 0; x < 8; ++x) {
            const int u = wv * 8 + x, kind = u >> 5, ti = (u >> 3) & 3, td = u & 7;
            f32x4 acc = (f32x4){0.f, 0.f, 0.f, 0.f};
            acc = mma_lds(bTB, ST, 16 * ti, kind ? bVB : bKBG, ST, 16 * td, 64, acc, c16, q4);
            *(uint2*)((kind ? bUT : bKN) + (16 * td + c16) * ST + (16 * ti + 4 * q4) * 2) = pack4(acc);
        }
        __syncthreads();
        unsigned char* bWT = bKN;
        const float eg = expf(gl);
        for (int x = 0; x < 4; ++x) {
            const int u = wv * 4 + x, ti = u >> 2, a = u & 3;
            uint4 fr;
#pragma unroll
            for (int hf = 0; hf < 2; ++hf) { const int tk = 2 * a + hf;
                f32x4 acc = (f32x4){0.f, 0.f, 0.f, 0.f};
                acc = mma_lds(bWT, ST, 16 * tk, bKD, ST, 16 * ti, 64, acc, c16, q4);
                f32x4 v;
#pragma unroll
                for (int r = 0; r < 4; ++r) v[r] = ((16 * tk + 4 * q4 + r) == (16 * ti + c16) ? eg : 0.f) - acc[r];
                const uint2 pk = pack4(v);
                if (hf == 0) { fr.x = pk.x; fr.y = pk.y; } else { fr.z = pk.x; fr.w = pk.y; } }
            PFR[((size_t)(ci * 8 + ti) * 4 + a) * 64 + lane] = fr;
        }
        for (int x = 0; x < 2; ++x) {
            const int u = wv * 2 + x, ti = u >> 2, a = u & 3;
            uint4 fr;
            const int i = 16 * ti + c16;
            const float qs = SCALE128 * sEg[i];
#pragma unroll
            for (int hf = 0; hf < 2; ++hf) { const int tk = 2 * a + hf;
                f32x4 acc = (f32x4){0.f, 0.f, 0.f, 0.f};
                acc = mma_lds(bWT, ST, 16 * tk, bAQK, ST, 16 * ti, 64, acc, c16, q4);
                const f32x4 qv = unpack4(*(const uint2*)(bQN + i * SN + (16 * tk + 4 * q4) * 2));
                const uint2 pk = pack4(qv * qs - acc);
                if (hf == 0) { fr.x = pk.x; fr.y = pk.y; } else { fr.z = pk.x; fr.w = pk.y; } }
            RFR[((size_t)(ci * 4 + ti) * 4 + a) * 64 + lane] = fr;
        }
        for (int x = 0; x < 8; ++x) {
            const int u = wv * 8 + x, tdv = u >> 3, tdk = u & 7;
            f32x4 acc = (f32x4){0.f, 0.f, 0.f, 0.f};
            acc = mma_lds(bKD, ST, 16 * tdk, bUT, ST, 16 * tdv, 64, acc, c16, q4);
            QFR[((size_t)(ci * 8 + tdv) * 8 + tdk) * 64 + lane] = pack4(acc);
        }
        for (int x = 0; x < 4; ++x) {
            const int u = wv * 4 + x, tdv = u >> 2, ti = u & 3;
            f32x4 acc = (f32x4){0.f, 0.f, 0.f, 0.f};
            acc = mma_lds(bAQK, ST, 16 * ti, bUT, ST, 16 * tdv, 64, acc, c16, q4);
            OFR[((size_t)(ci * 8 + tdv) * 4 + ti) * 64 + lane] = pack4(acc);
        }
        if (tid == 0) GL[ci] = gl;
    }
}

__device__ __forceinline__ void gs_load(uint4 (&d)[12], const unsigned char* pp, const unsigned char* rr, const unsigned char* qq, const unsigned char* oo, const int lt) {
#pragma unroll
    for (int i = 0; i < 6; ++i) { int c = lt + 384 * i; c = c < 2048 ? c : 2047; d[i] = *(const uint4*)(pp + c * 16); }
#pragma unroll
    for (int i = 0; i < 3; ++i) { int c = lt + 384 * i; c = c < 1024 ? c : 1023; d[6 + i] = *(const uint4*)(rr + c * 16); }
#pragma unroll
    for (int i = 0; i < 2; ++i) { int c = lt + 384 * i; c = c < 512 ? c : 511; d[9 + i] = *(const uint4*)(qq + c * 16); }
    { const int c = lt < 256 ? lt : 255; d[11] = *(const uint4*)(oo + c * 16); }
}
__device__ __forceinline__ void gs_store(const uint4 (&d)[12], unsigned char* sb, const int lt) {
#pragma unroll
    for (int i = 0; i < 6; ++i) { const int c = lt + 384 * i; if (c < 2048) *(uint4*)(sb + c * 16) = d[i]; }
#pragma unroll
    for (int i = 0; i < 3; ++i) { const int c = lt + 384 * i; if (c < 1024) *(uint4*)(sb + 32768 + c * 16) = d[6 + i]; }
#pragma unroll
    for (int i = 0; i < 2; ++i) { const int c = lt + 384 * i; if (c < 512) *(uint4*)(sb + 49152 + c * 16) = d[9 + i]; }
    if (lt < 256) *(uint4*)(sb + 57344 + lt * 16) = d[11];
}

#define SCAN_BODY                 bf16x8 Sb[4]; \
_Pragma("unroll") \
                for (int a = 0; a < 4; ++a) { union { uint4 u; bf16x8 v; } cv; const uint2 lo = pack4(S[2 * a]), hi = pack4(S[2 * a + 1]); cv.u.x = lo.x; cv.u.y = lo.y; cv.u.z = hi.x; cv.u.w = hi.y; Sb[a] = cv.v; } \
                const int t0 = b * 8192 + n * 64; \
                {   f32x4 oa[4]; \
_Pragma("unroll") \
                    for (int ti = 0; ti < 4; ++ti) oa[ti] = unpack4(*(const uint2*)(Of + ti * 512)); \
_Pragma("unroll") \
                    for (int a = 0; a < 4; ++a) \
_Pragma("unroll") \
                        for (int ti = 0; ti < 4; ++ti) oa[ti] = __builtin_amdgcn_mfma_f32_16x16x32_bf16(*(const bf16x8*)(Rf + (ti * 4 + a) * 1024), Sb[a], oa[ti], 0, 0, 0); \
_Pragma("unroll") \
                    for (int ti = 0; ti < 4; ++ti) { \
                        float* op = O + (size_t)(t0 + 16 * ti + 4 * q4) * 1024 + h * 128 + 16 * tdv + c16; \
                        op[0] = oa[ti][0]; op[1024] = oa[ti][1]; op[2048] = oa[ti][2]; op[3072] = oa[ti][3]; } \
                } \
                asm volatile("" ::: "memory"); \
_Pragma("unroll") \
                for (int g = 0; g < 2; ++g) { \
                    f32x4 sa[4]; \
_Pragma("unroll") \
                    for (int t = 0; t < 4; ++t) sa[t] = unpack4(*(const uint2*)(Qf + (g * 4 + t) * 512)); \
_Pragma("unroll") \
                    for (int a = 0; a < 4; ++a) \
_Pragma("unroll") \
                        for (int t = 0; t < 4; ++t) sa[t] = __builtin_amdgcn_mfma_f32_16x16x32_bf16(*(const bf16x8*)(Pf + ((g * 4 + t) * 4 + a) * 1024), Sb[a], sa[t], 0, 0, 0); \
_Pragma("unroll") \
                    for (int t = 0; t < 4; ++t) S[g * 4 + t] = sa[t]; \
                    asm volatile("" ::: "memory"); \
                }
PHASE_FN void ph_gdn_scan(const Params& p, float* smem) {
    unsigned char* ws_ = p.ws; asm volatile("" : "+s"(ws_));
    int tid_ = threadIdx.x; asm volatile("" : "+v"(tid_)); const int tid = tid_, lane = tid & 63, wv = __builtin_amdgcn_readfirstlane(tid >> 6), q4 = lane >> 4, c16 = lane & 15;
    int ldz_ = 0; asm volatile("" : "+s"(ldz_)); unsigned char* lds = g_smem + ldz_;
    constexpr int STG = 61440;
    const unsigned char* PFR = ws_ + OFF_PFR; const unsigned char* RFR = ws_ + OFF_RFR; const unsigned char* QFR = ws_ + OFF_QFR; const unsigned char* OFR = ws_ + OFF_OFR;
    float* O = (float*)(ws_ + OFF_O);
    for (int it = blockIdx.x; it < 32; it += gridDim.x) {
        const int bh = it >> 2, pair = it & 3, b = bh >> 2, h = bh & 3;
        __syncthreads();
        if (wv >= 2) {
            const int lt = tid - 128;
            const unsigned char* Pb = PFR + (size_t)bh * 128 * 32768;
            const unsigned char* Rb = RFR + (size_t)bh * 128 * 16384;
            const unsigned char* Qb = QFR + (size_t)bh * 128 * 32768 + pair * 8192;
            const unsigned char* Ob = OFR + (size_t)bh * 128 * 16384 + pair * 4096;
            uint4 ra0, ra1, ra2, ra3, ra4, ra5, ra6, ra7, ra8, ra9, ra10, ra11, rb0, rb1, rb2, rb3, rb4, rb5, rb6, rb7, rb8, rb9, rb10, rb11;
            uint4 rc0, rc1, rc2, rc3, rc4, rc5, rc6, rc7, rc8, rc9, rc10, rc11;
#define LDC(base_, c_, mx_) (*(const uint4*)((base_) + (size_t)(((c_) < (mx_)) ? (c_) : (mx_)) * 16))
#define GS_LOAD(X, n_) do { const unsigned char* pp_ = Pb + (size_t)(n_) * 32768; const unsigned char* rr_ = Rb + (size_t)(n_) * 16384; \
                const unsigned char* qq_ = Qb + (size_t)(n_) * 32768; const unsigned char* oo_ = Ob + (size_t)(n_) * 16384; \
                X##0 = LDC(pp_, lt, 2047); X##1 = LDC(pp_, lt + 384, 2047); X##2 = LDC(pp_, lt + 768, 2047); X##3 = LDC(pp_, lt + 1152, 2047); X##4 = LDC(pp_, lt + 1536, 2047); X##5 = LDC(pp_, lt + 1920, 2047); \
                X##6 = LDC(rr_, lt, 1023); X##7 = LDC(rr_, lt + 384, 1023); X##8 = LDC(rr_, lt + 768, 1023); \
                X##9 = LDC(qq_, lt, 511); X##10 = LDC(qq_, lt + 384, 511); X##11 = LDC(oo_, lt, 255); } while (0)
#define STC(off_, c_, lim_, v_) do { if ((c_) < (lim_)) *(uint4*)(sb_ + (off_) + (c_) * 16) = v_; } while (0)
#define GS_STORE(X, st_) do { unsigned char* sb_ = lds + (st_) * STG; \
                STC(0, lt, 2048, X##0); STC(0, lt + 384, 2048, X##1); STC(0, lt + 768, 2048, X##2); STC(0, lt + 1152, 2048, X##3); STC(0, lt + 1536, 2048, X##4); STC(0, lt + 1920, 2048, X##5); \
                STC(32768, lt, 1024, X##6); STC(32768, lt + 384, 1024, X##7); STC(32768, lt + 768, 1024, X##8); \
                STC(49152, lt, 512, X##9); STC(49152, lt + 384, 512, X##10); STC(57344, lt, 256, X##11); } while (0)
            GS_LOAD(ra, 0); GS_STORE(ra, 0);
            GS_LOAD(rb, 1); GS_LOAD(rc, 2); GS_LOAD(ra, 3);
            __syncthreads();
#define CLAMPN(x_) (((x_) < 128) ? (x_) : 127)
            for (int n = 0; n < 128; n += 3) {
                if (n + 1 < 128) GS_STORE(rb, (n + 1) & 1);
                GS_LOAD(rb, CLAMPN(n + 4)); __syncthreads();
                if (n + 1 < 128) { if (n + 2 < 128) GS_STORE(rc, (n + 2) & 1);
                    GS_LOAD(rc, CLAMPN(n + 5)); __syncthreads(); }
                if (n + 2 < 128) { if (n + 3 < 128) GS_STORE(ra, (n + 3) & 1);
                    GS_LOAD(ra, CLAMPN(n + 6)); __syncthreads(); }
            }
        } else {
            const int tdv = pair * 2 + wv;
            f32x4 S[8];
#pragma unroll
            for (int t = 0; t < 8; ++t) S[t] = (f32x4){0.f, 0.f, 0.f, 0.f};
            __syncthreads();
            for (int n = 0; n < 128; ++n) {
                const unsigned char* base = lds + (n & 1) * STG;
                const unsigned char* Pf = base + lane * 16, *Rf = base + 32768 + lane * 16;
                const unsigned char* Qf = base + 49152 + wv * 4096 + lane * 8, *Of = base + 57344 + wv * 2048 + lane * 8;
                SCAN_BODY
                __syncthreads();
            }
        }
    }
}

__device__ __forceinline__ void block_sum4(int (&v)[4], int* buf) {
    const int lane = threadIdx.x & 63, wv = threadIdx.x >> 6;
#pragma unroll
    for (int q = 0; q < 4; ++q) v[q] = wave_sum_i(v[q]);
    if (lane == 0) {
#pragma unroll
        for (int q = 0; q < 4; ++q) buf[wv * 4 + q] = v[q];
    }
    __syncthreads();
#pragma unroll
    for (int q = 0; q < 4; ++q) { int a = 0; for (int w = 0; w < 8; ++w) a += buf[w * 4 + q]; v[q] = a; }
}

PHASE_FN void ph_dsa_topk(const Params& p, int layer, float* smem) {
    unsigned char* ws_ = p.ws; asm volatile("" : "+s"(ws_));
    int tid_ = threadIdx.x; asm volatile("" : "+v"(tid_)); const int tid = tid_, lane = tid & 63, wv = __builtin_amdgcn_readfirstlane(tid >> 6), q4 = lane >> 4, c16 = lane & 15;
    int* sRed = (int*)g_smem;
    const bf16_t* QIb = (const bf16_t*)(ws_ + OFF_QIB); const bf16_t* KIb = (const bf16_t*)(ws_ + OFF_KIB); const float* WI = (const float*)(ws_ + OFF_WI);
    unsigned short* M16 = (unsigned short*)(ws_ + OFF_M16);
    int* qhead = (int*)(ws_ + OFF_QCTR) + layer * 16;
    int* sIt = (int*)(g_smem + 512);
    for (;;) {
        __syncthreads();
        if (tid == 0) *sIt = atomicAdd(qhead, 1);
        __syncthreads();
        const int it = *sIt;
        if (it >= 2048) break;
        const int b = it & 1, gp = 1023 - (it >> 1);
        const int s0 = gp * 8, t0 = b * 8192 + s0;
        const int ntiles = (s0 >> 4) + 1;
        const int nreg = (ntiles > wv) ? ((ntiles - wv + 7) >> 3) : 0;
        const bf16_t* qp = QIb + (size_t)(t0 + (c16 >> 2)) * 256 + (c16 & 3) * 64 + 8 * q4;
        const bf16x8 a0A = *(const bf16x8*)qp, a1A = *(const bf16x8*)(qp + 32), a0B = *(const bf16x8*)(qp + 4 * 256), a1B = *(const bf16x8*)(qp + 4 * 256 + 32);
        const float4 wqA = *(const float4*)(WI + (size_t)(t0 + q4) * 4), wqB = *(const float4*)(WI + (size_t)(t0 + 4 + q4) * 4);
        const int myqA = s0 + q4, myqB = s0 + 4 + q4;
        int c16s = c16; asm volatile("" : "+v"(c16s));
        int wvs = wv; asm volatile("" : "+s"(wvs));
        unsigned kA[64], kB[64];
#pragma unroll
        for (int i = 0; i < 64; ++i) { kA[i] = 0u; kB[i] = 0u; }
#pragma unroll
        for (int blk = 0; blk < 4; ++blk) if (nreg > blk * 16) {
#pragma unroll
            for (int ii = 0; ii < 16; ++ii) { const int i = blk * 16 + ii, tile = wvs + 8 * i;
                if (tile < ntiles) {
                    const bf16_t* kp = KIb + (size_t)(b * 8192 + tile * 16 + c16s) * 64 + 8 * q4;
                    const bf16x8 k0 = *(const bf16x8*)kp, k1 = *(const bf16x8*)(kp + 32);
                    f32x4 accA = (f32x4){0.f, 0.f, 0.f, 0.f}, accB = accA;
                    accA = __builtin_amdgcn_mfma_f32_16x16x32_bf16(a0A, k0, accA, 0, 0, 0);
                    accB = __builtin_amdgcn_mfma_f32_16x16x32_bf16(a0B, k0, accB, 0, 0, 0);
                    accA = __builtin_amdgcn_mfma_f32_16x16x32_bf16(a1A, k1, accA, 0, 0, 0);
                    accB = __builtin_amdgcn_mfma_f32_16x16x32_bf16(a1B, k1, accB, 0, 0, 0);
                    float sa = 0.f, sb = 0.f;
                    sa += wqA.x * fmaxf(accA[0], 0.f); sa += wqA.y * fmaxf(accA[1], 0.f); sa += wqA.z * fmaxf(accA[2], 0.f); sa += wqA.w * fmaxf(accA[3], 0.f);
                    sb += wqB.x * fmaxf(accB[0], 0.f); sb += wqB.y * fmaxf(accB[1], 0.f); sb += wqB.z * fmaxf(accB[2], 0.f); sb += wqB.w * fmaxf(accB[3], 0.f);
                    const int kidx = tile * 16 + c16s;
                    kA[i] = (kidx <= myqA) ? ordkey(sa) : 0u;
                    kB[i] = (kidx <= myqB) ? ordkey(sb) : 0u;
                }
                if ((ii & 3) == 3) asm volatile("" ::: "memory"); }
        }
        const int keffA = (myqA + 1 < 256) ? (myqA + 1) : 256, keffB = (myqB + 1 < 256) ? (myqB + 1) : 256;
        int par = 0;
        int mydone = 0, alldone = 0;
        int* sDone = sRed + 64;
        auto qsum = [&](int c) -> int {
            c += __shfl_xor(c, 1); c += __shfl_xor(c, 2); c += __shfl_xor(c, 4); c += __shfl_xor(c, 8);
            par ^= 1;
            if (c16 == 0) { sRed[par * 32 + wv * 4 + q4] = c; if (wv == 0) sDone[par * 4 + q4] = (mydone == 3) ? 1 : 0; }
            __syncthreads();
            int a = 0;
#pragma unroll
            for (int w = 0; w < 8; ++w) a += sRed[par * 32 + w * 4 + q4];
            alldone = sDone[par * 4] & sDone[par * 4 + 1] & sDone[par * 4 + 2] & sDone[par * 4 + 3];
            return a;
        };
        unsigned UA = 0u, UB = 0u;
        for (int bit = 31; bit >= 0; --bit) {
            const unsigned candA = UA | (1u << bit), candB = UB | (1u << bit);
            int ca = 0, cb = 0;
            if (!alldone) {
#pragma unroll
            for (int blk = 0; blk < 4; ++blk) if (nreg > blk * 16) {
#pragma unroll
                for (int ii = 0; ii < 16; ++ii) { ca += (kA[blk * 16 + ii] >= candA) ? 1 : 0; cb += (kB[blk * 16 + ii] >= candB) ? 1 : 0; }
            } }
            const int tot = qsum(ca | (cb << 16));
            if ((tot & 0xffff) >= keffA) { UA = candA; mydone = (mydone & 2) | (((tot & 0xffff) == keffA) ? 1 : 0); }
            if ((tot >> 16) >= keffB) { UB = candB; mydone = (mydone & 1) | (((tot >> 16) == keffB) ? 2 : 0); }
        }
        int cg = 0, ce = 0;
#pragma unroll
        for (int i = 0; i < 64; ++i) { cg += (kA[i] > UA) ? 1 : 0; ce += (kA[i] == UA) ? 1 : 0; cg += (kB[i] > UB) ? 65536 : 0; ce += (kB[i] == UB) ? 65536 : 0; }
        cg = qsum(cg); ce = qsum(ce);
        const int needA = keffA - (cg & 0xffff), needB = keffB - (cg >> 16);
        int JA = 8191, JB = 8191;
        par ^= 1;
        if (c16 == 0) sRed[par * 32 + wv * 4 + q4] = (((ce & 0xffff) > needA) || ((ce >> 16) > needB)) ? 1 : 0;
        __syncthreads();
        int anyov = 0;
#pragma unroll
        for (int w = 0; w < 32; ++w) anyov |= sRed[par * 32 + w];
        if (anyov) {
            JA = 0; JB = 0;
            int c16j = c16; asm volatile("" : "+v"(c16j));
            int wvj = wv; asm volatile("" : "+s"(wvj));
            for (int bit = 12; bit >= 0; --bit) {
                const int cjA = JA | (1 << bit), cjB = JB | (1 << bit);
                int c = 0;
#pragma unroll
                for (int i = 0; i < 64; ++i) { const int kidx = (wvj + 8 * i) * 16 + c16j; c += (kA[i] == UA && kidx < cjA) ? 1 : 0; c += (kB[i] == UB && kidx < cjB) ? 65536 : 0; }
                const int tot = qsum(c);
                if ((tot & 0xffff) <= needA - 1) JA = cjA;
                if ((tot >> 16) <= needB - 1) JB = cjB;
            }
        }
        unsigned short* sM = (unsigned short*)(g_smem + 1024);
        ((uint4*)sM)[tid] = make_uint4(0u, 0u, 0u, 0u);
        __syncthreads();
        int c16e = c16; asm volatile("" : "+v"(c16e));
        int wve = wv; asm volatile("" : "+s"(wve));
#pragma unroll
        for (int blk = 0; blk < 4; ++blk) if (nreg > blk * 16) {
#pragma unroll
            for (int ii = 0; ii < 16; ++ii) { const int i = blk * 16 + ii;
                const int tile = wve + 8 * i, kidx = tile * 16 + c16e;
                const bool selA = kA[i] > UA || (kA[i] == UA && kidx <= JA);
                const bool selB = kB[i] > UB || (kB[i] == UB && kidx <= JB);
                const unsigned long long balA = __ballot(selA), balB = __ballot(selB);
                if (c16 == 0) { sM[q4 * 512 + tile] = (unsigned short)((balA >> (16 * q4)) & 0xffffull);
                                sM[(4 + q4) * 512 + tile] = (unsigned short)((balB >> (16 * q4)) & 0xffffull); }
            }
        }
        __syncthreads();
        *(uint4*)(M16 + (size_t)(t0 + (tid >> 6)) * 512 + (tid & 63) * 8) = ((const uint4*)sM)[tid];
    }
}

PHASE_FN void ph_dsa_attn(const Params& p, float* smem) {
    unsigned char* ws_ = p.ws; asm volatile("" : "+s"(ws_));
    int tid_ = threadIdx.x; asm volatile("" : "+v"(tid_)); const int tid = tid_, lane = tid & 63, wv = tid >> 6, q4 = lane >> 4, c16 = lane & 15;
    int ldz_ = 0; asm volatile("" : "+s"(ldz_)); unsigned char* lds = g_smem + ldz_;
    const bf16_t* QBb = (const bf16_t*)(ws_ + OFF_QBB); const bf16_t* KBb = (const bf16_t*)(ws_ + OFF_KBB); const bf16_t* VT = (const bf16_t*)(ws_ + OFF_VT);
    const unsigned short* M16 = (const unsigned short*)(ws_ + OFF_M16);
    bf16_t* OB = (bf16_t*)(ws_ + OFF_OB);
    const float SC = SCALE128 * 1.4426950408889634f;
    for (int it = blockIdx.x; it < 256; it += gridDim.x) {
        const int bh = it & 7, jp = it >> 3, b = bh >> 2, h = bh & 3;
        for (int half = 0; half < 2; ++half) {
            const int jq = half ? jp : 63 - jp;
            const int qs = jq * 128, nkt = 2 * jq + 2;
            const int tq = b * 8192 + qs + wv * 16 + c16;
            bf16x8 qf[4];
#pragma unroll
            for (int a = 0; a < 4; ++a) qf[a] = *(const bf16x8*)(QBb + (size_t)tq * 512 + h * 128 + 8 * q4 + 32 * a);
            float m = -1e30f, lsum = 0.f;
            f32x4 oacc[8];
#pragma unroll
            for (int t = 0; t < 8; ++t) oacc[t] = (f32x4){0.f, 0.f, 0.f, 0.f};
            uint4 rk0, rk1, rv0, rv1;
            const int q0 = tid, q1 = tid + 512;
            const bf16_t* kg0 = KBb + (size_t)(b * 8192 + (q0 >> 4)) * 512 + h * 128 + (q0 & 15) * 8;
            const bf16_t* kg1 = KBb + (size_t)(b * 8192 + (q1 >> 4)) * 512 + h * 128 + (q1 & 15) * 8;
            const bf16_t* vg0 = VT + ((size_t)((b * 4 + h) * 128 + (q0 >> 3))) * 8192 + (q0 & 7) * 8;
            const bf16_t* vg1 = VT + ((size_t)((b * 4 + h) * 128 + (q1 >> 3))) * 8192 + (q1 & 7) * 8;
            const int lk0 = (q0 >> 4) * 256 + ((((q0 & 15)) ^ ((q0 >> 4) & 15)) << 4), lk1 = (q1 >> 4) * 256 + ((((q1 & 15)) ^ ((q1 >> 4) & 15)) << 4);
            const int lv0 = 16384 + (q0 >> 3) * 128 + ((((q0 & 7)) ^ ((q0 >> 3) & 7)) << 4), lv1 = 16384 + (q1 >> 3) * 128 + ((((q1 & 7)) ^ ((q1 >> 3) & 7)) << 4);
#define ATT_GLOAD(kt_) do { rk0 = *(const uint4*)(kg0 + (size_t)(kt_) * 64 * 512); rk1 = *(const uint4*)(kg1 + (size_t)(kt_) * 64 * 512); \
                            rv0 = *(const uint4*)(vg0 + (kt_) * 64); rv1 = *(const uint4*)(vg1 + (kt_) * 64); } while (0)
#define ATT_LSTORE(st_) do { unsigned char* base_ = lds + (st_) * 32768; *(uint4*)(base_ + lk0) = rk0; *(uint4*)(base_ + lk1) = rk1; *(uint4*)(base_ + lv0) = rv0; *(uint4*)(base_ + lv1) = rv1; } while (0)
            __syncthreads();
            ATT_GLOAD(0); ATT_LSTORE(0);
            __syncthreads();
            for (int kt = 0; kt < nkt; ++kt) {
                if (kt + 1 < nkt) ATT_GLOAD(kt + 1);
                const unsigned long long mbits = *(const unsigned long long*)(M16 + (size_t)tq * 512 + 4 * kt);
                const unsigned char* Kt = lds + (kt & 1) * 32768;
                const unsigned char* Vt = Kt + 16384;
                f32x4 sacc[4];
#pragma unroll
                for (int ti = 0; ti < 4; ++ti) { sacc[ti] = (f32x4){0.f, 0.f, 0.f, 0.f};
                    const int row = 16 * ti + c16;
#pragma unroll
                    for (int a = 0; a < 4; ++a) { const bf16x8 kf = *(const bf16x8*)(Kt + row * 256 + ((((q4 + 4 * a)) ^ (row & 15)) << 4));
                        sacc[ti] = __builtin_amdgcn_mfma_f32_16x16x32_bf16(kf, qf[a], sacc[ti], 0, 0, 0); } }
                float mx = m;
#pragma unroll
                for (int ti = 0; ti < 4; ++ti)
#pragma unroll
                    for (int r = 0; r < 4; ++r) { const bool valid = (mbits >> (16 * ti + 4 * q4 + r)) & 1ull; const float v = sacc[ti][r] * SC; sacc[ti][r] = v; mx = fmaxf(mx, valid ? v : -1e30f); }
                mx = fmaxf(mx, __shfl_xor(mx, 16)); mx = fmaxf(mx, __shfl_xor(mx, 32));
                const float alpha = __builtin_amdgcn_exp2f(m - mx); m = mx;
                float ps = 0.f;
#pragma unroll
                for (int ti = 0; ti < 4; ++ti)
#pragma unroll
                    for (int r = 0; r < 4; ++r) { const bool valid = (mbits >> (16 * ti + 4 * q4 + r)) & 1ull; const float pv = valid ? __builtin_amdgcn_exp2f(sacc[ti][r] - mx) : 0.f; sacc[ti][r] = pv; ps += pv; }
                lsum = lsum * alpha + ps;
#pragma unroll
                for (int t = 0; t < 8; ++t) oacc[t] = oacc[t] * alpha;
                bf16x8 pb[2];
#pragma unroll
                for (int a = 0; a < 2; ++a) {
                    union { uint4 u; bf16x8 v; } cv;
                    cv.u.x = cvt_pk_bf16(sacc[2 * a][0], sacc[2 * a][1]); cv.u.y = cvt_pk_bf16(sacc[2 * a][2], sacc[2 * a][3]);
                    cv.u.z = cvt_pk_bf16(sacc[2 * a + 1][0], sacc[2 * a + 1][1]); cv.u.w = cvt_pk_bf16(sacc[2 * a + 1][2], sacc[2 * a + 1][3]);
                    pb[a] = cv.v; }
#pragma unroll
                for (int t = 0; t < 8; ++t) { const int row = 16 * t + c16;
#pragma unroll
                    for (int a = 0; a < 2; ++a) {
                        union { uint2 h2[2]; bf16x8 v; } vf;
                        vf.h2[0] = *(const uint2*)(Vt + row * 128 + ((((4 * a + (q4 >> 1))) ^ (row & 7)) << 4) + 8 * (q4 & 1));
                        vf.h2[1] = *(const uint2*)(Vt + row * 128 + ((((4 * a + 2 + (q4 >> 1))) ^ (row & 7)) << 4) + 8 * (q4 & 1));
                        oacc[t] = __builtin_amdgcn_mfma_f32_16x16x32_bf16(vf.v, pb[a], oacc[t], 0, 0, 0); } }
                if (kt + 1 < nkt) ATT_LSTORE((kt + 1) & 1);
                __syncthreads();
            }
            lsum += __shfl_xor(lsum, 16); lsum += __shfl_xor(lsum, 32);
            const float inv = 1.f / lsum;
#pragma unroll
            for (int t = 0; t < 8; ++t) *(uint2*)(OB + (size_t)tq * 1024 + 512 + h * 128 + 16 * t + 4 * q4) = pack4(oacc[t] * inv);
        }
    }
}

PHASE_FN void ph_gdn_out(const Params& p, int layer) {
    unsigned char* ws_ = p.ws; asm volatile("" : "+s"(ws_));
    int tid_ = threadIdx.x; asm volatile("" : "+v"(tid_)); const int tid = tid_, lane = tid & 63, wv = tid >> 6;
    const float* O = (const float*)(ws_ + OFF_O); const bf16_t* P = (const bf16_t*)(ws_ + OFF_P); bf16_t* OB = (bf16_t*)(ws_ + OFF_OB);
    const float* onw = p.gdn_out_norm + (layer >> 1) * 128;
    for (int t = blockIdx.x * 8 + wv; t < NT; t += gridDim.x * 8) {
#pragma unroll
        for (int h = 0; h < 4; ++h) {
            const float* op = O + (size_t)t * 1024 + h * 128; bf16_t* ob = OB + (size_t)t * 1024 + h * 128;
            const float o0 = op[lane], o1 = op[64 + lane];
            const float ss = wave_sum(o0 * o0 + o1 * o1);
            const float r = rsqrtf(ss * (1.f / 128.f) + EPS);
            const float z0 = PBF(P, t, 1536 + h * 128 + lane), z1 = PBF(P, t, 1536 + h * 128 + 64 + lane);
            ob[lane] = f2bf(o0 * r * onw[lane] * siluf_(z0)); ob[64 + lane] = f2bf(o1 * r * onw[64 + lane] * siluf_(z1));
        }
    }
}

PHASE_FN void ph_gemm_out(const Params& p, int layer, float* smem) {
    unsigned char* ws_ = p.ws; asm volatile("" : "+s"(ws_));
    { int ldz_ = 0; asm volatile("" : "+s"(ldz_)); smem = (float*)(g_smem + ldz_); }
    const bf16_t* Wt = (const bf16_t*)(ws_ + OFF_WOUT) + (size_t)layer * 1024 * 1024;
    const float* MOD = (const float*)(ws_ + OFF_MOD);
    const bf16_t* O = (const bf16_t*)(ws_ + OFF_OB);
    const int vb_ = ((int)blockIdx.x & 7) * ((int)gridDim.x >> 3) + ((int)blockIdx.x >> 3);
    for (int tile = vb_; tile < 64 * 8; tile += gridDim.x) {
        const int mt = (tile >> 6) * 8 + (tile & 7), nt = (tile >> 3) & 7;
        const bf16_t* Ab = O + (size_t)mt * 256 * 1024;
        const bf16_t* Bb = Wt + (size_t)nt * 128 * 1024;
        const int b = (mt * 256) >> 13;
        const float* gt = MOD + (size_t)(layer * 2 + b) * 6144 + 2048 + nt * 128;
        float* Xt = p.X + (size_t)mt * 256 * ND + nt * 128;
        const float* Xr = ((layer == 0) ? p.x : (const float*)p.X) + (size_t)mt * 256 * ND + nt * 128;
        gemm_tile_bf16(1024, (unsigned char*)smem,
            [=](int i, int r, int k) -> uint4 { return *(const uint4*)(Ab + (size_t)r * 1024 + k); },
            [=](int i, int r, int k) -> uint4 { return *(const uint4*)(Bb + (size_t)r * 1024 + k); },
            [=](const f32x4 (&acc)[4][4], int wm, int wn, int lane) {
#pragma unroll
                for (int mi = 0; mi < 4; ++mi)
#pragma unroll
                    for (int ni = 0; ni < 4; ++ni) {
                        const int m = wm * 64 + mi * 16 + (lane & 15), n = wn * 64 + ni * 16 + 4 * (lane >> 4);
                        const f32x4 g = *(const f32x4*)(gt + n);
                        *(f32x4*)(Xt + (size_t)m * ND + n) = *(const f32x4*)(Xr + (size_t)m * ND + n) + g * acc[mi][ni];
                    }
            });
    }
}

PHASE_FN void ph_norm_ffn(const Params& p, int layer) {
    unsigned char* ws_ = p.ws; asm volatile("" : "+s"(ws_));
    int tid_ = threadIdx.x; asm volatile("" : "+v"(tid_)); const int tid = tid_, lane = tid & 63, wv = tid >> 6;
    const float* MOD = (const float*)(ws_ + OFF_MOD);
    bf16_t* H = (bf16_t*)(ws_ + OFF_H);
    int* CNT = (int*)(ws_ + OFF_CNT) + layer * 32 * CSTR;
    int* sCnt = (int*)g_smem; int* sBase = sCnt + 32; int* sE = sBase + 32; int* sR = sE + 256;
    const int nrb = (NT + (int)gridDim.x - 1) / (int)gridDim.x, row_lo = blockIdx.x * nrb, row_hi = (row_lo + nrb < NT) ? row_lo + nrb : NT;
    __syncthreads();
    if (tid < 32) sCnt[tid] = 0;
    __syncthreads();
    int* ASG = (int*)(ws_ + OFF_ASG); float* GATE = (float*)(ws_ + OFF_GATE); int* LIST = (int*)(ws_ + OFF_LIST);
    const float* nw = p.norm_ffn + layer * 1024;
    const float* wg = p.rg_w + (size_t)layer * 1024 * 4;
    for (int row = row_lo + wv; row < row_hi; row += 8) {
        const int b = row >> 13;
        const float* xr = p.X + (size_t)row * ND;
        const float* sh = MOD + (size_t)(layer * 2 + b) * 6144 + 3072;
        const float* sc = sh + 1024;
        float hv[16]; float ss = 0.f;
#pragma unroll
        for (int j = 0; j < 4; ++j) { const float4 v = *(const float4*)(xr + j * 256 + lane * 4); hv[4 * j] = v.x; hv[4 * j + 1] = v.y; hv[4 * j + 2] = v.z; hv[4 * j + 3] = v.w; }
#pragma unroll
        for (int j = 0; j < 16; ++j) ss += hv[j] * hv[j];
        ss = wave_sum(ss);
        const float rstd = rsqrtf(ss * (1.f / 1024.f) + EPS);
#pragma unroll
        for (int j = 0; j < 4; ++j) {
            const int col = j * 256 + lane * 4;
            const float4 w = *(const float4*)(nw + col), s4 = *(const float4*)(sc + col), h4 = *(const float4*)(sh + col);
            hv[4 * j] = hv[4 * j] * rstd * w.x * (1.f + s4.x) + h4.x; hv[4 * j + 1] = hv[4 * j + 1] * rstd * w.y * (1.f + s4.y) + h4.y;
            hv[4 * j + 2] = hv[4 * j + 2] * rstd * w.z * (1.f + s4.z) + h4.z; hv[4 * j + 3] = hv[4 * j + 3] * rstd * w.w * (1.f + s4.w) + h4.w;
            { f32x4 ov; ov[0] = hv[4 * j]; ov[1] = hv[4 * j + 1]; ov[2] = hv[4 * j + 2]; ov[3] = hv[4 * j + 3]; *(uint2*)(H + (size_t)row * ND + col) = pack4(ov); }
        }
        float gl[4] = {0.f, 0.f, 0.f, 0.f};
#pragma unroll
        for (int j = 0; j < 4; ++j)
#pragma unroll
            for (int e = 0; e < 4; ++e) { const int col = j * 256 + lane * 4 + e; const float4 w = *(const float4*)(wg + (size_t)col * 4); const float hh = hv[4 * j + e];
                gl[0] += hh * w.x; gl[1] += hh * w.y; gl[2] += hh * w.z; gl[3] += hh * w.w; }
#pragma unroll
        for (int g = 0; g < 4; ++g) gl[g] = wave_sum(gl[g]) + p.rg_b[layer * 4 + g];
        int gs = 0; float gm = gl[0];
#pragma unroll
        for (int g = 1; g < 4; ++g) if (gl[g] > gm) { gm = gl[g]; gs = g; }
        float gsum = 0.f;
#pragma unroll
        for (int g = 0; g < 4; ++g) gsum += expf(gl[g] - gm);
        const float ggate = 1.f / gsum;
        const float* we = p.re_w + ((size_t)(layer * 4 + gs) * 1024) * 8;
        float el[8] = {0.f, 0.f, 0.f, 0.f, 0.f, 0.f, 0.f, 0.f};
#pragma unroll
        for (int j = 0; j < 4; ++j)
#pragma unroll
            for (int e = 0; e < 4; ++e) { const int col = j * 256 + lane * 4 + e; const float4 w0 = *(const float4*)(we + (size_t)col * 8), w1 = *(const float4*)(we + (size_t)col * 8 + 4); const float hh = hv[4 * j + e];
                el[0] += hh * w0.x; el[1] += hh * w0.y; el[2] += hh * w0.z; el[3] += hh * w0.w; el[4] += hh * w1.x; el[5] += hh * w1.y; el[6] += hh * w1.z; el[7] += hh * w1.w; }
#pragma unroll
        for (int e = 0; e < 8; ++e) el[e] = wave_sum(el[e]) + p.re_b[(layer * 4 + gs) * 8 + e];
        int i1 = 0; float l1 = el[0];
#pragma unroll
        for (int e = 1; e < 8; ++e) if (el[e] > l1) { l1 = el[e]; i1 = e; }
        int i2 = -1; float l2 = -INFINITY;
#pragma unroll
        for (int e = 0; e < 8; ++e) if (e != i1 && el[e] > l2) { l2 = el[e]; i2 = e; }
        const float ex = expf(l2 - l1);
        const float p1 = 1.f / (1.f + ex), p2 = ex / (1.f + ex);
        if (lane == 0) {
            const int e1 = gs * 8 + i1, e2 = gs * 8 + i2, lr = row - row_lo;
            sE[lr * 2] = e1; sE[lr * 2 + 1] = e2;
            sR[lr * 2] = atomicAdd(&sCnt[e1], 1); sR[lr * 2 + 1] = atomicAdd(&sCnt[e2], 1);
            GATE[row * 2] = ggate * p1; GATE[row * 2 + 1] = ggate * p2;
        }
    }
    __syncthreads();
    if (tid < 32) sBase[tid] = (sCnt[tid] > 0) ? atomicAdd(&CNT[tid * CSTR], sCnt[tid]) : 0;
    __syncthreads();
    for (int a = tid; a < (row_hi - row_lo) * 2; a += NTHREADS) {
        const int row = row_lo + (a >> 1), e = sE[a], r = sBase[e] + sR[a];
        LIST[(size_t)e * LISTCAP + r] = row;
        ASG[row * 4 + (a & 1) * 2] = e; ASG[row * 4 + (a & 1) * 2 + 1] = r;
    }
}

PHASE_FN void ph_moe(const Params& p, int layer, int which, float* smem) {
    unsigned char* ws_ = p.ws; asm volatile("" : "+s"(ws_));
    { int ldz_ = 0; asm volatile("" : "+s"(ldz_)); smem = (float*)(g_smem + ldz_); }
    int tid_ = threadIdx.x; asm volatile("" : "+v"(tid_)); const int tid = tid_;
    int* sPad = (int*)((unsigned char*)smem + 98304); int* sTs = sPad + 33;
    const int* CNT = (const int*)(ws_ + OFF_CNT) + layer * 32 * CSTR;
    __syncthreads();
    if (tid == 0) { int a = 0, ts = 0; for (int e = 0; e < 32; ++e) { sPad[e] = a; sTs[e] = ts; a += ((CNT[e * CSTR] + 127) / 128) * 128; ts += (CNT[e * CSTR] + 255) / 256; } sTs[32] = ts; sPad[32] = a; }
    __syncthreads();
    const int total = sTs[32] * 8;
    bf16_t* HID = (bf16_t*)(ws_ + OFF_HID); bf16_t* YB = (bf16_t*)(ws_ + OFF_YB);
    const bf16_t* H = (const bf16_t*)(ws_ + OFF_H);
    const int* LIST = (const int*)(ws_ + OFF_LIST);
    const int vb_ = ((int)blockIdx.x & 7) * ((int)gridDim.x >> 3) + ((int)blockIdx.x >> 3);
    for (int tile = vb_; tile < total; tile += gridDim.x) {
        const int mt = tile >> 3, nt = tile & 7;
        int e = 0;
        for (int q = 1; q < 32; ++q) if (sTs[q] <= mt) e = q;
        const int mi0 = mt - sTs[e];
        const int cnt = CNT[e * CSTR];
        const int mvalid = (cnt - mi0 * 256 < 256) ? (cnt - mi0 * 256) : 256;
        const int rowbase = sPad[e] + mi0 * 256;
        if (which == 0) {
            long ro[4];
#pragma unroll
            for (int i = 0; i < 4; ++i) { const int r = (tid + 512 * i) >> 3; ro[i] = (r < mvalid) ? (long)LIST[(size_t)e * LISTCAP + mi0 * 256 + r] * 1024 : -1; }
            const long ro0 = ro[0], ro1 = ro[1], ro2 = ro[2], ro3 = ro[3];
            const bf16_t* Bb = (const bf16_t*)(ws_ + OFF_W13) + (size_t)e * 1024 * 1024 + (size_t)nt * 128 * 1024;
            bf16_t* Ht = HID + (size_t)rowbase * 512 + nt * 64;
            gemm_tile_bf16(1024, (unsigned char*)smem,
                [=](int i, int r, int k) -> uint4 { const long o = (i == 0) ? ro0 : (i == 1) ? ro1 : (i == 2) ? ro2 : ro3; if (o < 0) return make_uint4(0u, 0u, 0u, 0u);
                    return *(const uint4*)(H + o + k); },
                [=](int i, int r, int k) -> uint4 { return *(const uint4*)(Bb + (size_t)r * 1024 + k); },
                [=](const f32x4 (&acc)[4][4], int wm, int wn, int lane) {
#pragma unroll
                    for (int mi = 0; mi < 4; ++mi)
#pragma unroll
                        for (int ni = 0; ni < 2; ++ni) {
                            const int m = wm * 64 + mi * 16 + (lane & 15), n = wn * 32 + ni * 16 + 4 * (lane >> 4);
                            const f32x4 a1 = acc[mi][ni], a3 = acc[mi][ni + 2];
                            f32x4 hv; hv[0] = siluf_(a1[0]) * a3[0]; hv[1] = siluf_(a1[1]) * a3[1]; hv[2] = siluf_(a1[2]) * a3[2]; hv[3] = siluf_(a1[3]) * a3[3];
                            if (m < mvalid) *(uint2*)(Ht + (size_t)m * 512 + n) = pack4(hv);
                        }
                }, mvalid);
        } else {
            const bf16_t* Ab = HID + (size_t)rowbase * 512;
            const bf16_t* Bb = (const bf16_t*)(ws_ + OFF_W2T) + (size_t)e * 1024 * 512 + (size_t)nt * 128 * 512;
            bf16_t* Yt = YB + (size_t)rowbase * 1024 + nt * 128;
            gemm_tile_bf16(512, (unsigned char*)smem,
                [=](int i, int r, int k) -> uint4 { if (r >= mvalid) return make_uint4(0u, 0u, 0u, 0u); return *(const uint4*)(Ab + (size_t)r * 512 + k); },
                [=](int i, int r, int k) -> uint4 { return *(const uint4*)(Bb + (size_t)r * 512 + k); },
                [=](const f32x4 (&acc)[4][4], int wm, int wn, int lane) {
#pragma unroll
                    for (int mi = 0; mi < 4; ++mi)
#pragma unroll
                        for (int ni = 0; ni < 4; ++ni) {
                            const int m = wm * 64 + mi * 16 + (lane & 15), n = wn * 64 + ni * 16 + 4 * (lane >> 4);
                            if (m < mvalid) *(uint2*)(Yt + (size_t)m * 1024 + n) = pack4(acc[mi][ni]);
                        }
                }, mvalid);
        }
    }
}

PHASE_FN void ph_conv_dense(const Params& p, float* smem) {
    unsigned char* ws_ = p.ws; asm volatile("" : "+s"(ws_));
    { int ldz_ = 0; asm volatile("" : "+s"(ldz_)); smem = (float*)(g_smem + ldz_); }
    auto dec = [&](int t, const float*& s0, const float*& s1, bf16_t*& dst, int& mode, int& K, int& N, int& ld, int& rt, int& kt) {
        s1 = nullptr; mode = 0; K = 1024;
        if (t >= 4608) t = 4607;
        if (t < 1984) { const int l = t / 992, u = t % 992; s0 = p.even_w_in + (size_t)l * 1024 * 3916; N = 3916; ld = 3916; dst = (bf16_t*)(ws_ + OFF_WINE) + (size_t)l * 3968 * 1024; rt = u >> 4; kt = u & 15; }
        else if (t < 3584) { const int v = t - 1984, l = v / 800, u = v % 800; s0 = p.gla_w_in + (size_t)l * 1024 * 3088; N = 3088; ld = 3088; dst = (bf16_t*)(ws_ + OFF_WINO) + (size_t)l * 3200 * 1024; rt = u >> 4; kt = u & 15; }
        else { const int v = t - 3584, l = v >> 8, u = v & 255; s0 = ((l & 1) ? p.gla_w_out : p.even_w_out) + (size_t)(l >> 1) * 1024 * 1024; N = 1024; ld = 1024; dst = (bf16_t*)(ws_ + OFF_WOUT) + (size_t)l * 1024 * 1024; rt = u >> 4; kt = u & 15; }
    };
    for (int t = blockIdx.x * 4; t < 4608; t += gridDim.x * 4) convert_tiles4(dec, t, (4608 - t < 4) ? (4608 - t) : 4, smem);
}

PHASE_FN void ph_conv_exp(const Params& p, int layer, float* smem, int first_blk) {
    unsigned char* ws_ = p.ws; asm volatile("" : "+s"(ws_));
    { int ldz_ = 0; asm volatile("" : "+s"(ldz_)); smem = (float*)(g_smem + ldz_); }
    if ((int)blockIdx.x < first_blk) return;
    auto dec = [&](int t, const float*& s0, const float*& s1, bf16_t*& dst, int& mode, int& K, int& N, int& ld, int& rt, int& kt) {
        if (t >= 12288) t = 12287;
        if (t < 8192) { const int e = t >> 8, u = t & 255; s0 = p.w1 + (size_t)(layer * 32 + e) * 1024 * 512; s1 = p.w3 + (size_t)(layer * 32 + e) * 1024 * 512; mode = 1; K = 1024; N = 512; ld = 512;
            dst = (bf16_t*)(ws_ + OFF_W13) + (size_t)e * 1024 * 1024; rt = u >> 4; kt = u & 15; }
        else { const int v = t - 8192, e = v >> 7, u = v & 127; s0 = p.w2 + (size_t)(layer * 32 + e) * 512 * 1024; s1 = nullptr; mode = 0; K = 512; N = 1024; ld = 1024;
            dst = (bf16_t*)(ws_ + OFF_W2T) + (size_t)e * 1024 * 512; rt = u >> 3; kt = u & 7; }
    };
    const int nb = (int)gridDim.x - first_blk;
    for (int t = ((int)blockIdx.x - first_blk) * 4; t < 12288; t += nb * 4) convert_tiles4(dec, t, (12288 - t < 4) ? (12288 - t) : 4, smem);
}

PHASE_FN void ph_gla_tok(const Params& p, int layer) {
    unsigned char* ws_ = p.ws; asm volatile("" : "+s"(ws_));
    int tid_ = threadIdx.x; asm volatile("" : "+v"(tid_)); const int tid = tid_, lane = tid & 63, wv = tid >> 6, li = layer >> 1;
    const float* AUX = (const float*)(ws_ + OFF_AUX);
    float* LA = (float*)(ws_ + OFF_LA);
    const float* w2 = p.gla_w_gate2 + (size_t)li * 16 * 512; const float* b2 = p.gla_b_gate2 + li * 512;
    for (int t = blockIdx.x * 8 + wv; t < NT; t += gridDim.x * 8) {
        float glr[16];
#pragma unroll
        for (int r = 0; r < 16; ++r) glr[r] = AUX[(size_t)t * 16 + r];
#pragma unroll 1
        for (int i = 0; i < 8; ++i) {
            const int c = lane + 64 * i; float z = b2[c];
#pragma unroll
            for (int r = 0; r < 16; ++r) z += glr[r] * w2[r * 512 + c];
            LA[(size_t)t * 512 + c] = -softplusf_(-z) * (1.f / 16.f);
        }
    }
}

PHASE_FN void ph_gla_chunk(const Params& p, int layer, float* smem) {
    unsigned char* ws_ = p.ws; asm volatile("" : "+s"(ws_));
    int tid_ = threadIdx.x; asm volatile("" : "+v"(tid_)); const int tid = tid_, lane = tid & 63, wv = __builtin_amdgcn_readfirstlane(tid >> 6), q4 = lane >> 4, c16 = lane & 15;
    int ldz_ = 0; asm volatile("" : "+s"(ldz_)); unsigned char* lds = g_smem + ldz_;
    constexpr int SN = 272, ST = 144;
    float* sBc = (float*)lds;
    unsigned char* bQE = lds + 33024;
    unsigned char* bKE = lds + 50432;
    unsigned char* bKD = lds + 67840;
    unsigned char* bVT = lds + 86272;
    unsigned char* bATT = lds + 123136;
    const bf16_t* P = (const bf16_t*)(ws_ + OFF_P); const float* AUX = (const float*)(ws_ + OFF_AUX);
    const float* w2 = p.gla_w_gate2 + (size_t)(layer >> 1) * 16 * 512; const float* b2 = p.gla_b_gate2 + (layer >> 1) * 512;
    float* sGlr = (float*)(lds + 132352);
    uint4* QEF = (uint4*)(ws_ + OFF_GQE); uint2* OIF = (uint2*)(ws_ + OFF_GOI); uint2* HF = (uint2*)(ws_ + OFF_GH); float* EBL = (float*)(ws_ + OFF_GEBL);
    for (int ci = blockIdx.x; ci < 1024; ci += gridDim.x) {
        const int b = ci >> 9, h = (ci >> 7) & 3, n = ci & 127;
        const int t0 = b * 8192 + n * 64;
        __syncthreads();
        for (int e = tid; e < 1024; e += NTHREADS) sGlr[e] = AUX[(size_t)(t0 + (e >> 4)) * 16 + (e & 15)];
        __syncthreads();
        {
            const int d = tid & 127, c = h * 128 + d;
            float wg[16];
#pragma unroll
            for (int r = 0; r < 16; ++r) wg[r] = w2[r * 512 + c];
            const float bz = b2[c];
            for (int i = tid >> 7; i < 64; i += 4) {
                float z = bz;
#pragma unroll
                for (int r = 0; r < 16; ++r) z += sGlr[i * 16 + r] * wg[r];
                sBc[i * 129 + d] = -softplusf_(-z) * (1.f / 16.f);
            }
        }
        for (int e = tid; e < 64 * 36; e += NTHREADS) ((unsigned*)bATT)[e] = 0u;
        __syncthreads();
        if (tid < 128) { float a = 0.f; for (int i = 0; i < 64; ++i) { a += sBc[i * 129 + tid]; sBc[i * 129 + tid] = a; } }
        __syncthreads();
        for (int e = tid; e < 8192; e += NTHREADS) {
            const int i = e >> 7, d = e & 127;
            const float bb = sBc[i * 129 + d], bl = sBc[63 * 129 + d];
            const float qf = PBF(P, t0 + i, h * 128 + d), kf = PBF(P, t0 + i, 512 + h * 128 + d);
            *(bf16_t*)(bQE + i * SN + d * 2) = f2bf(qf * SCALE128 * expf(bb));
            *(bf16_t*)(bKE + i * SN + d * 2) = f2bf(kf * expf(-bb));
            *(bf16_t*)(bKD + d * ST + i * 2) = f2bf(kf * expf(bl - bb));
        }
        for (int e = tid; e < 16384; e += NTHREADS) { const int i = e >> 8, dv = e & 255; *(bf16_t*)(bVT + dv * ST + i * 2) = P[(size_t)(t0 + i) * LDPB + 1024 + h * 256 + dv]; }
        if (tid < 128) EBL[ci * 128 + tid] = expf(sBc[63 * 129 + tid]);
        __syncthreads();
        for (int u = wv; u < 10; u += 8) {
            const int ti = (u >= 6) ? 3 : (u >= 3) ? 2 : (u >= 1) ? 1 : 0, tj = u - ((ti * (ti + 1)) >> 1);
            f32x4 acc = (f32x4){0.f, 0.f, 0.f, 0.f};
            acc = mma_lds(bQE, SN, 16 * ti, bKE, SN, 16 * tj, 128, acc, c16, q4);
            const int j = 16 * tj + c16;
#pragma unroll
            for (int r = 0; r < 4; ++r) { const int i = 16 * ti + 4 * q4 + r; *(bf16_t*)(bATT + i * ST + j * 2) = f2bf((j <= i) ? acc[r] : 0.f); }
        }
        for (int x = 0; x < 2; ++x) {
            const int u = wv * 2 + x, ti = u >> 2, a = u & 3;
            const unsigned char* rp = bQE + (16 * ti + c16) * SN;
            const uint2 lo = *(const uint2*)(rp + (32 * a + 4 * q4) * 2), hi = *(const uint2*)(rp + (32 * a + 16 + 4 * q4) * 2);
            QEF[((size_t)(ci * 4 + ti) * 4 + a) * 64 + lane] = make_uint4(lo.x, lo.y, hi.x, hi.y);
        }
        __syncthreads();
        for (int x = 0; x < 8; ++x) {
            const int u = wv * 8 + x, tdv = u >> 2, ti = u & 3;
            f32x4 acc = (f32x4){0.f, 0.f, 0.f, 0.f};
            acc = mma_lds(bATT, ST, 16 * ti, bVT, ST, 16 * tdv, 64, acc, c16, q4);
            OIF[((size_t)(ci * 16 + tdv) * 4 + ti) * 64 + lane] = pack4(acc);
        }
        for (int x = 0; x < 16; ++x) {
            const int u = wv * 16 + x, tdv = u >> 3, tdk = u & 7;
            f32x4 acc = (f32x4){0.f, 0.f, 0.f, 0.f};
            acc = mma_lds(bKD, ST, 16 * tdk, bVT, ST, 16 * tdv, 64, acc, c16, q4);
            HF[((size_t)(ci * 16 + tdv) * 8 + tdk) * 64 + lane] = pack4(acc);
        }
    }
}

PHASE_FN void ph_gla_scan(const Params& p, float* smem) {
    unsigned char* ws_ = p.ws; asm volatile("" : "+s"(ws_));
    int tid_ = threadIdx.x; asm volatile("" : "+v"(tid_)); const int tid = tid_, lane = tid & 63, wv = __builtin_amdgcn_readfirstlane(tid >> 6), q4 = lane >> 4, c16 = lane & 15;
    int ldz_ = 0; asm volatile("" : "+s"(ldz_)); unsigned char* lds = g_smem + ldz_;
    constexpr int STG = 29184;
    const unsigned char* QEF = ws_ + OFF_GQE; const unsigned char* HF = ws_ + OFF_GH; const unsigned char* OIF = ws_ + OFF_GOI; const unsigned char* EBL = ws_ + OFF_GEBL;
    float* O = (float*)(ws_ + OFF_O);
    for (int it = blockIdx.x; it < 64; it += gridDim.x) {
        const int bh = it >> 3, pair = it & 7, b = bh >> 2, h = bh & 3;
        __syncthreads();
        if (wv >= 2) {
            const int lt = tid - 128;
            const unsigned char* Qb = QEF + (size_t)bh * 128 * 16384;
            const unsigned char* Hb = HF + (size_t)bh * 128 * 65536 + pair * 8192;
            const unsigned char* Ob = OIF + (size_t)bh * 128 * 32768 + pair * 4096;
            const unsigned char* Lb = EBL + (size_t)bh * 128 * 512;
            uint4 ra0, ra1, ra2, ra3, ra4, ra5, ra6, rb0, rb1, rb2, rb3, rb4, rb5, rb6, rc0, rc1, rc2, rc3, rc4, rc5, rc6, rd0, rd1, rd2, rd3, rd4, rd5, rd6;
#define GL_LOAD(X, n_) do { const unsigned char* q_ = Qb + (size_t)(n_) * 16384; const unsigned char* h_ = Hb + (size_t)(n_) * 65536; \
                const unsigned char* o_ = Ob + (size_t)(n_) * 32768; const unsigned char* l_ = Lb + (size_t)(n_) * 512; \
                X##0 = LDC(q_, lt, 1023); X##1 = LDC(q_, lt + 384, 1023); X##2 = LDC(q_, lt + 768, 1023); \
                X##3 = LDC(h_, lt, 511); X##4 = LDC(h_, lt + 384, 511); X##5 = LDC(o_, lt, 255); X##6 = LDC(l_, lt, 31); } while (0)
#define GL_STORE(X, st_) do { unsigned char* sb_ = lds + (st_) * STG; \
                STC(0, lt, 1024, X##0); STC(0, lt + 384, 1024, X##1); STC(0, lt + 768, 1024, X##2); \
                STC(16384, lt, 512, X##3); STC(16384, lt + 384, 512, X##4); STC(24576, lt, 256, X##5); STC(28672, lt, 32, X##6); } while (0)
            GL_LOAD(ra, 0); GL_STORE(ra, 0);
            GL_LOAD(rb, 1); GL_LOAD(rc, 2); GL_LOAD(rd, 3); GL_LOAD(ra, 4);
            __syncthreads();
            for (int n = 0; n < 128; n += 4) {
                GL_STORE(rb, 1); GL_LOAD(rb, CLAMPN(n + 5)); __syncthreads();
                GL_STORE(rc, 0); GL_LOAD(rc, CLAMPN(n + 6)); __syncthreads();
                GL_STORE(rd, 1); GL_LOAD(rd, CLAMPN(n + 7)); __syncthreads();
                if (n + 4 < 128) GL_STORE(ra, 0);
                GL_LOAD(ra, CLAMPN(n + 8)); __syncthreads();
            }
        } else {
            const int tdv = pair * 2 + wv;
            f32x4 S[8];
#pragma unroll
            for (int t = 0; t < 8; ++t) S[t] = (f32x4){0.f, 0.f, 0.f, 0.f};
            __syncthreads();
            for (int n = 0; n < 128; ++n) {
                const unsigned char* base = lds + (n & 1) * STG;
                const unsigned char* Qf = base + lane * 16, *Hf = base + 16384 + wv * 4096 + lane * 8, *Of = base + 24576 + wv * 2048 + lane * 8, *Lf = base + 28672 + q4 * 16;
                bf16x8 Sb[4];
#pragma unroll
                for (int a = 0; a < 4; ++a) { union { uint4 u; bf16x8 v; } cv; const uint2 lo = pack4(S[2 * a]), hi = pack4(S[2 * a + 1]); cv.u.x = lo.x; cv.u.y = lo.y; cv.u.z = hi.x; cv.u.w = hi.y; Sb[a] = cv.v; }
                const int t0 = b * 8192 + n * 64;
                f32x4 oa[4];
#pragma unroll
                for (int ti = 0; ti < 4; ++ti) oa[ti] = unpack4(*(const uint2*)(Of + ti * 512));
#pragma unroll
                for (int a = 0; a < 4; ++a)
#pragma unroll
                    for (int ti = 0; ti < 4; ++ti) oa[ti] = __builtin_amdgcn_mfma_f32_16x16x32_bf16(*(const bf16x8*)(Qf + (ti * 4 + a) * 1024), Sb[a], oa[ti], 0, 0, 0);
#pragma unroll
                for (int ti = 0; ti < 4; ++ti) {
                    float* op = O + (size_t)(t0 + 16 * ti + 4 * q4) * 1024 + h * 256 + 16 * tdv + c16;
                    op[0] = oa[ti][0]; op[1024] = oa[ti][1]; op[2048] = oa[ti][2]; op[3072] = oa[ti][3]; }
#pragma unroll
                for (int t = 0; t < 8; ++t) { const f32x4 lam = *(const f32x4*)(Lf + t * 64); S[t] = S[t] * lam + unpack4(*(const uint2*)(Hf + t * 512)); }
                __syncthreads();
            }
        }
    }
}

PHASE_FN void ph_gla_out(const Params& p, int layer) {
    unsigned char* ws_ = p.ws; asm volatile("" : "+s"(ws_));
    int tid_ = threadIdx.x; asm volatile("" : "+v"(tid_)); const int tid = tid_, lane = tid & 63, wv = tid >> 6;
    const float* O = (const float*)(ws_ + OFF_O); const bf16_t* P = (const bf16_t*)(ws_ + OFF_P); bf16_t* OB = (bf16_t*)(ws_ + OFF_OB);
    const float* onw = p.gla_out_norm + (layer >> 1) * 256;
    for (int t = blockIdx.x * 8 + wv; t < NT; t += gridDim.x * 8) {
#pragma unroll
        for (int h = 0; h < 4; ++h) {
            const float* op = O + (size_t)t * 1024 + h * 256;
            const float4 o = *(const float4*)(op + lane * 4);
            const float ss = wave_sum(o.x * o.x + o.y * o.y + o.z * o.z + o.w * o.w);
            const float r = rsqrtf(ss * (1.f / 256.f) + EPS);
            const f32x4 z = unpack4(*(const uint2*)(P + (size_t)t * LDPB + 2048 + h * 256 + lane * 4));
            const float4 w = *(const float4*)(onw + lane * 4);
            f32x4 ov; ov[0] = o.x * r * w.x * siluf_(z[0]); ov[1] = o.y * r * w.y * siluf_(z[1]); ov[2] = o.z * r * w.z * siluf_(z[2]); ov[3] = o.w * r * w.w * siluf_(z[3]);
            *(uint2*)(OB + (size_t)t * 1024 + h * 256 + lane * 4) = pack4(ov);
        }
    }
}

template <int PH>
__device__ __forceinline__ void run_phase(const Params& p, int layer, float* smem) {
    if (PH == PH_PROLOGUE) { ph_prologue(p, smem); ph_conv_dense(p, smem); }
    else if (PH == PH_NORM_MIX) ph_rows(p, layer, 0, smem);
    else if (PH == PH_GEMM_IN_EVEN) ph_gemm_in(p, layer, true, smem);
    else if (PH == PH_EVEN_TOK) { ph_even_tok(p, layer, smem); ph_gdn_chunk(p, layer, smem); }
    else if (PH == PH_GDN_CHUNK) ph_gdn_chunk(p, layer, smem);
    else if (PH == PH_GDN_SCAN) { ph_gdn_scan(p, smem); ph_conv_exp(p, layer, smem, 32); ph_dsa_topk(p, layer, smem); }
    else if (PH == PH_DSA_TOPK) ph_dsa_topk(p, layer, smem);
    else if (PH == PH_DSA_ATTN) { ph_dsa_attn(p, smem); ph_gdn_out(p, layer); }
    else if (PH == PH_GDN_OUT) ph_gdn_out(p, layer);
    else if (PH == PH_GEMM_OUT) ph_gemm_out(p, layer, smem);
    else if (PH == PH_NORM_FFN) ph_norm_ffn(p, layer);
    else if (PH == PH_MOE1) ph_moe(p, layer, 0, smem);
    else if (PH == PH_MOE2) ph_moe(p, layer, 1, smem);
    else if (PH == PH_GEMM_IN_ODD) ph_gemm_in(p, layer, false, smem);
    else if (PH == PH_GLA_TOK) ph_gla_tok(p, layer);
    else if (PH == PH_GLA_CHUNK) ph_gla_chunk(p, layer, smem);
    else if (PH == PH_GLA_SCAN) { ph_gla_scan(p, smem); ph_conv_exp(p, layer, smem, 64); }
    else if (PH == PH_GLA_OUT) ph_gla_out(p, layer);
    else if (PH == PH_FINAL) ph_rows(p, 0, 1, smem);
}

#if MK_MULTI
template <int PH>
__global__ void __launch_bounds__(NTHREADS, 2) k_phase(Params p, int layer) {
    run_phase<PH>(p, layer, (float*)g_smem);
}
#else
__global__ void __launch_bounds__(NTHREADS, 2) k_mega(Params p) {
    float* smem = (float*)g_smem;
    volatile LAS unsigned* xbw = (volatile LAS unsigned*)(LAS unsigned char*)(g_smem + LDS_BYTES - 16);
    if (threadIdx.x == 0) { xbw[0] = 0u; xbw[1] = 0u; xbw[2] = 0u; xbw[3] = 0u; }
    __syncthreads();
    XcdBarrier bar = xcd_barrier_post((unsigned*)(p.ws + OFF_BAR), xbw);
#define BAR() xcd_barrier(bar)
    run_phase<PH_PROLOGUE>(p, 0, smem); BAR(); if (DUP_MASK & 4096) { run_phase<PH_PROLOGUE>(p, 0, smem); BAR(); }
    for (int lp = 0; lp < 2; ++lp) {
        const int le = 2 * lp, lo = 2 * lp + 1;
        run_phase<PH_NORM_MIX>(p, le, smem); BAR();
        run_phase<PH_GEMM_IN_EVEN>(p, le, smem); BAR(); if (DUP_MASK & 1) { run_phase<PH_GEMM_IN_EVEN>(p, le, smem); BAR(); }
        run_phase<PH_EVEN_TOK>(p, le, smem); BAR(); if (DUP_MASK & 2) { run_phase<PH_EVEN_TOK>(p, le, smem); BAR(); }
        run_phase<PH_GDN_SCAN>(p, le, smem); BAR(); if (DUP_MASK & 8) { run_phase<PH_GDN_SCAN>(p, le, smem); BAR(); }
        run_phase<PH_DSA_ATTN>(p, le, smem); BAR(); if (DUP_MASK & 32) { run_phase<PH_DSA_ATTN>(p, le, smem); BAR(); }
        run_phase<PH_GEMM_OUT>(p, le, smem); BAR();
        run_phase<PH_NORM_FFN>(p, le, smem); BAR();
        run_phase<PH_MOE1>(p, le, smem); BAR(); if (DUP_MASK & 64) { run_phase<PH_MOE1>(p, le, smem); BAR(); }
        run_phase<PH_MOE2>(p, le, smem); BAR(); if (DUP_MASK & 128) { run_phase<PH_MOE2>(p, le, smem); BAR(); }
        run_phase<PH_NORM_MIX>(p, lo, smem); BAR();
        run_phase<PH_GEMM_IN_ODD>(p, lo, smem); BAR(); if (DUP_MASK & 256) { run_phase<PH_GEMM_IN_ODD>(p, lo, smem); BAR(); }
        run_phase<PH_GLA_CHUNK>(p, lo, smem); BAR(); if (DUP_MASK & 1024) { run_phase<PH_GLA_CHUNK>(p, lo, smem); BAR(); }
        run_phase<PH_GLA_SCAN>(p, lo, smem); BAR(); if (DUP_MASK & 2048) { run_phase<PH_GLA_SCAN>(p, lo, smem); BAR(); }
        run_phase<PH_GLA_OUT>(p, lo, smem); BAR();
        run_phase<PH_GEMM_OUT>(p, lo, smem); BAR();
        run_phase<PH_NORM_FFN>(p, lo, smem); BAR();
        run_phase<PH_MOE1>(p, lo, smem); BAR(); if (DUP_MASK & 64) { run_phase<PH_MOE1>(p, lo, smem); BAR(); }
        run_phase<PH_MOE2>(p, lo, smem); BAR(); if (DUP_MASK & 128) { run_phase<PH_MOE2>(p, lo, smem); BAR(); }
    }
    for (int xb = 0; xb < EXTRA_BARS; ++xb) BAR();
    run_phase<PH_FINAL>(p, 0, smem);
}
#endif

}

#if MK_MULTI
template <int PH>
static void launch_phase(const Params& p, int layer, hipStream_t stream) {
    static bool attr_set = false;
    if (!attr_set) { hipFuncSetAttribute((const void*)k_phase<PH>, hipFuncAttributeMaxDynamicSharedMemorySize, (int)LDS_BYTES); attr_set = true; }
    hipLaunchKernelGGL((k_phase<PH>), dim3(256), dim3(NTHREADS), LDS_BYTES, stream, p, layer);
}
#endif

extern "C" void kernel_launch(void* const* d_in, const int* in_sizes, int n_in, void* d_out, int out_size, void* d_ws, size_t ws_size, hipStream_t stream) {
    (void)in_sizes; (void)n_in; (void)out_size;
    if (ws_size < WS_NEEDED) { fprintf(stderr, "workspace too small: %zu < %zu\n", ws_size, (size_t)WS_NEEDED); return; }
    Params p{};
    p.x = (const float*)d_in[0]; p.c = (const float*)d_in[1]; p.pos = (const int*)d_in[2]; p.ada_w = (const float*)d_in[3]; p.ada_b = (const float*)d_in[4];
    p.norm_mix = (const float*)d_in[5]; p.norm_ffn = (const float*)d_in[6]; p.even_w_in = (const float*)d_in[7]; p.conv_w = (const float*)d_in[8];
    p.a_log = (const float*)d_in[9]; p.dt_bias = (const float*)d_in[10]; p.gdn_out_norm = (const float*)d_in[11]; p.even_w_out = (const float*)d_in[12];
    p.gla_w_in = (const float*)d_in[13]; p.gla_w_gate2 = (const float*)d_in[14]; p.gla_b_gate2 = (const float*)d_in[15]; p.gla_out_norm = (const float*)d_in[16]; p.gla_w_out = (const float*)d_in[17];
    p.rg_w = (const float*)d_in[18]; p.rg_b = (const float*)d_in[19]; p.re_w = (const float*)d_in[20]; p.re_b = (const float*)d_in[21];
    p.w1 = (const float*)d_in[22]; p.w3 = (const float*)d_in[23]; p.w2 = (const float*)d_in[24]; p.final_norm = (const float*)d_in[25];
    p.X = (float*)d_out; p.ws = (unsigned char*)d_ws;
    p.rA = pow(10000.0, -2.0 / 128.0); p.rI = pow(10000.0, -2.0 / 64.0);
    hipMemsetAsync(d_ws, 0, ZERO_BYTES, stream);
#if MK_MULTI
    launch_phase<PH_PROLOGUE>(p, 0, stream);
    for (int lp = 0; lp < 2; ++lp) {
        const int le = 2 * lp, lo = 2 * lp + 1;
        launch_phase<PH_NORM_MIX>(p, le, stream);
        launch_phase<PH_GEMM_IN_EVEN>(p, le, stream);
        launch_phase<PH_EVEN_TOK>(p, le, stream);
        launch_phase<PH_GDN_SCAN>(p, le, stream);
        launch_phase<PH_DSA_ATTN>(p, le, stream);
        launch_phase<PH_GEMM_OUT>(p, le, stream);
        launch_phase<PH_NORM_FFN>(p, le, stream);
        launch_phase<PH_MOE1>(p, le, stream);
        launch_phase<PH_MOE2>(p, le, stream);
        launch_phase<PH_NORM_MIX>(p, lo, stream);
        launch_phase<PH_GEMM_IN_ODD>(p, lo, stream);
        launch_phase<PH_GLA_CHUNK>(p, lo, stream);
        launch_phase<PH_GLA_SCAN>(p, lo, stream);
        launch_phase<PH_GLA_OUT>(p, lo, stream);
        launch_phase<PH_GEMM_OUT>(p, lo, stream);
        launch_phase<PH_NORM_FFN>(p, lo, stream);
        launch_phase<PH_MOE1>(p, lo, stream);
        launch_phase<PH_MOE2>(p, lo, stream);
    }
    launch_phase<PH_FINAL>(p, 0, stream);
#else
    static int grid = 0;
    if (!grid) {
        int dev = 0, cus = 0, per_cu = 0;
        hipGetDevice(&dev);
        hipDeviceGetAttribute(&cus, hipDeviceAttributeMultiprocessorCount, dev);
        hipFuncSetAttribute((const void*)k_mega, hipFuncAttributeMaxDynamicSharedMemorySize, (int)LDS_BYTES);
        hipOccupancyMaxActiveBlocksPerMultiprocessor(&per_cu, k_mega, NTHREADS, LDS_BYTES);
        if (cus <= 0) cus = 256;
        grid = cus * (per_cu < 1 ? 1 : 1);
    }
    hipLaunchKernelGGL(k_mega, dim3(grid), dim3(NTHREADS), LDS_BYTES, stream, p);
#endif
}
```

```cpp
#include <hip/hip_runtime.h>
#include <stdint.h>
#include <math.h>
#include <stdio.h>

#define EXTRA_BARS 0
#ifndef DUP_MASK
#define DUP_MASK 0
#endif
#ifndef MK_MULTI
#define MK_MULTI 0
#endif

namespace {

constexpr int NT = 16384, ND = 1024, LDP = 3920, LDPB = 3968;
constexpr float EPS = 1e-6f;
constexpr int NTHREADS = 512;
constexpr size_t LDS_BYTES = 147456;
constexpr float SCALE128 = 0.08838834764831845f;
constexpr int LISTCAP = 32768;
constexpr int CSTR = 16;

constexpr size_t OFF_BAR  = 0;
constexpr size_t OFF_CNT  = 16384;
constexpr size_t ZERO_BYTES = 32768;
constexpr size_t OFF_QCTR = 28672;
constexpr size_t OFF_MOD  = 32768;
constexpr size_t OFF_COSA = OFF_MOD + 4 * 2 * 6144 * 4;
constexpr size_t OFF_SINA = OFF_COSA + (size_t)NT * 64 * 4;
constexpr size_t OFF_COSI = OFF_SINA + (size_t)NT * 64 * 4;
constexpr size_t OFF_SINI = OFF_COSI + (size_t)NT * 32 * 4;
constexpr size_t OFF_H    = OFF_SINI + (size_t)NT * 32 * 4;
constexpr size_t OFF_P    = OFF_H + (size_t)NT * 1024 * 4;
constexpr size_t OFF_HID  = OFF_P;
constexpr size_t OFF_YB   = OFF_HID + (size_t)36864 * 512 * 4;
constexpr size_t OFF_O    = OFF_P + (size_t)NT * LDP * 4;
constexpr size_t OFF_ASG  = OFF_O + (size_t)NT * 1024 * 4;
constexpr size_t OFF_GATE = OFF_ASG + (size_t)NT * 4 * 4;
constexpr size_t OFF_LIST = OFF_GATE + (size_t)NT * 2 * 4;
constexpr size_t OFF_R    = OFF_LIST + (size_t)32 * LISTCAP * 4;
constexpr size_t OFF_QN   = OFF_R;
constexpr size_t OFF_KN   = OFF_QN + (size_t)NT * 512 * 4;
constexpr size_t OFF_VC   = OFF_KN + (size_t)NT * 512 * 4;
constexpr size_t OFF_BETA = OFF_VC + (size_t)NT * 512 * 4;
constexpr size_t OFF_G    = OFF_BETA + (size_t)NT * 4 * 4;
constexpr size_t OFF_W    = OFF_G + (size_t)NT * 4 * 4;
constexpr size_t OFF_U    = OFF_W + (size_t)1024 * 8192 * 4;
constexpr size_t OFF_QG   = OFF_U + (size_t)1024 * 8192 * 4;
constexpr size_t OFF_KD   = OFF_QG + (size_t)1024 * 8192 * 4;
constexpr size_t OFF_AQK  = OFF_KD + (size_t)1024 * 8192 * 4;
constexpr size_t OFF_GL   = OFF_AQK + (size_t)1024 * 4096 * 4;
constexpr size_t OFF_QB   = OFF_GL + 4096;
constexpr size_t OFF_KB   = OFF_QB + (size_t)NT * 512 * 4;
constexpr size_t OFF_QI   = OFF_KB + (size_t)NT * 512 * 4;
constexpr size_t OFF_KI   = OFF_QI + (size_t)NT * 256 * 4;
constexpr size_t OFF_WI   = OFF_KI + (size_t)NT * 64 * 4;
constexpr size_t OFF_SEL  = OFF_WI + (size_t)NT * 4 * 4;
constexpr size_t OFF_EVEN_END = OFF_SEL + (size_t)NT * 256 * 4;
constexpr size_t OFF_PFR  = OFF_W;
constexpr size_t OFF_RFR  = OFF_PFR + (size_t)1024 * 32768;
constexpr size_t OFF_QFR  = OFF_RFR + (size_t)1024 * 16384;
constexpr size_t OFF_OFR  = OFF_QFR + (size_t)1024 * 32768;
static_assert(OFF_OFR + (size_t)1024 * 16384 <= OFF_GL, "gdn v2 buffers overflow");
constexpr size_t OFF_QBB  = OFF_QB;
constexpr size_t OFF_KBB  = OFF_QBB + (size_t)NT * 512 * 2;
constexpr size_t OFF_VT   = OFF_KBB + (size_t)NT * 512 * 2;
constexpr size_t OFF_QIB  = OFF_VT + (size_t)NT * 512 * 2;
constexpr size_t OFF_KIB  = OFF_QIB + (size_t)NT * 256 * 2;
constexpr size_t OFF_M16  = OFF_KIB + (size_t)NT * 64 * 2;
static_assert(OFF_M16 + (size_t)NT * 512 * 2 <= OFF_WI, "dsa v2 buffers overflow");
constexpr size_t OFF_LA   = OFF_R;
constexpr size_t OFF_ATT  = OFF_LA + (size_t)NT * 512 * 4;
constexpr size_t OFF_QE   = OFF_ATT + (size_t)1024 * 4096 * 4;
constexpr size_t OFF_GKD  = OFF_QE + (size_t)1024 * 8192 * 4;
constexpr size_t OFF_EBL  = OFF_GKD + (size_t)1024 * 8192 * 4;
constexpr size_t OFF_GQE  = OFF_LA + (size_t)NT * 512 * 4;
constexpr size_t OFF_GOI  = OFF_GQE + (size_t)1024 * 16384;
constexpr size_t OFF_GH   = OFF_GOI + (size_t)1024 * 32768;
constexpr size_t OFF_GEBL = OFF_GH + (size_t)1024 * 65536;
static_assert(OFF_GEBL + (size_t)1024 * 512 <= OFF_EVEN_END, "gla v2 buffers overflow");
constexpr size_t OFF_WINE = OFF_EVEN_END;
constexpr size_t OFF_WINO = OFF_WINE + (size_t)2 * 3968 * 1024 * 2;
constexpr size_t OFF_WOUT = OFF_WINO + (size_t)2 * 3200 * 1024 * 2;
constexpr size_t OFF_W13  = OFF_WOUT + (size_t)4 * 1024 * 1024 * 2;
constexpr size_t OFF_W2T  = OFF_W13 + (size_t)32 * 1024 * 1024 * 2;
constexpr size_t OFF_OB   = OFF_W2T + (size_t)32 * 1024 * 512 * 2;
constexpr size_t OFF_AUX  = OFF_OB + (size_t)NT * 1024 * 2;
constexpr size_t WS_NEEDED = OFF_AUX + (size_t)NT * 16 * 4;

struct Params {
    const float* x; const float* c; const int* pos; const float* ada_w; const float* ada_b;
    const float* norm_mix; const float* norm_ffn; const float* even_w_in; const float* conv_w;
    const float* a_log; const float* dt_bias; const float* gdn_out_norm; const float* even_w_out;
    const float* gla_w_in; const float* gla_w_gate2; const float* gla_b_gate2; const float* gla_out_norm; const float* gla_w_out;
    const float* rg_w; const float* rg_b; const float* re_w; const float* re_b;
    const float* w1; const float* w3; const float* w2; const float* final_norm;
    float* X;
    unsigned char* ws;
    double rA, rI;
};

#define XB_TMO      128
#define XB_XCNT(j)  (256  + 64 * (j))
#define XB_XSUB(j)  (1280 + 64 * (j))
#define XB_XGEN(j)  (2304 + 64 * (j))
#define XB_TOP      3328
#define XB_TOPGEN   3392
#define XCD_BAR_WORDS 3456
#define XB_SPIN_CAP (1u << 18)
#define LAS __attribute__((address_space(3)))

__device__ __forceinline__ unsigned xb_ld(unsigned* p)              { return __hip_atomic_load(p, __ATOMIC_RELAXED, __HIP_MEMORY_SCOPE_AGENT); }
__device__ __forceinline__ unsigned xb_add(unsigned* p, unsigned v) { return __hip_atomic_fetch_add(p, v, __ATOMIC_RELAXED, __HIP_MEMORY_SCOPE_AGENT); }
__device__ __forceinline__ unsigned xb_xcc_id() { return (unsigned)__builtin_amdgcn_s_getreg((3 << 11) | 20) & 0xFu; }
#define XB_SPIN(cond, bar) do { unsigned _sp = 0; while (cond) { __builtin_amdgcn_s_sleep(1); \
    if ((++_sp & 255u) == 0u) { if (xb_ld(&(bar)[XB_TMO])) break; if (_sp > XB_SPIN_CAP) { atomicAdd(&(bar)[XB_TMO], 1u); break; } } } } while (0)

struct XcdBarrier { unsigned* bar; unsigned x; volatile LAS unsigned* st; };

__device__ __forceinline__ XcdBarrier xcd_barrier_post(unsigned* bar, volatile LAS unsigned* st) {
    XcdBarrier b; b.bar = bar; b.x = xb_xcc_id(); b.st = st;
    if (threadIdx.x == 0) (void)xb_add(&bar[XB_XCNT(b.x)], 1u);
    return b;
}
__device__ __forceinline__ void xcd_barrier_complete(unsigned* bar, unsigned x, unsigned& nloc, unsigned& nx) {
    const unsigned G = gridDim.x * gridDim.y * gridDim.z;
    unsigned sum, cnt, mine, sp = 0u;
    for (;;) {
        sum = 0u; cnt = 0u; mine = 0u;
#pragma unroll
        for (unsigned j = 0; j < 16; ++j) { const unsigned c = xb_ld(&bar[XB_XCNT(j)]); sum += c; cnt += (c > 0u) ? 1u : 0u; mine = (j == x) ? c : mine; }
        if (sum == G) break;
        __builtin_amdgcn_s_sleep(1);
        if ((++sp & 255u) == 0u) { if (xb_ld(&bar[XB_TMO])) break; if (sp > XB_SPIN_CAP) { atomicAdd(&bar[XB_TMO], 1u); break; } }
    }
    nloc = mine > 0u ? mine : 1u; nx = cnt > 0u ? cnt : 1u;
}
__device__ __forceinline__ void xcd_barrier(const XcdBarrier& b) {
    asm volatile("s_waitcnt vmcnt(0)" ::: "memory");
    __syncthreads();
    if (threadIdx.x == 0) {
        unsigned* bar = b.bar;
        __builtin_amdgcn_s_waitcnt(0);
        unsigned nloc = b.st[0], nx = b.st[1];
        if (nloc == 0u) { xcd_barrier_complete(bar, b.x, nloc, nx); b.st[0] = nloc; b.st[1] = nx; }
        const unsigned old = xb_add(&bar[XB_XSUB(b.x)], 1u);
        const unsigned gen = old / nloc;
        if (old + 1u == (gen + 1u) * nloc) {
            __builtin_amdgcn_fence(__ATOMIC_RELEASE, "agent");
            asm volatile("s_waitcnt vmcnt(0)" ::: "memory");
            const unsigned og = xb_add(&bar[XB_TOP], 1u);
            const unsigned tg = og / nx;
            if (og + 1u == (tg + 1u) * nx) xb_add(&bar[XB_TOPGEN], 1u);
            else XB_SPIN(xb_ld(&bar[XB_TOPGEN]) == tg, bar);
            __builtin_amdgcn_fence(__ATOMIC_ACQUIRE, "agent");
            xb_add(&bar[XB_XGEN(b.x)], 1u);
            asm volatile("s_waitcnt vmcnt(0)" ::: "memory");
        } else {
            XB_SPIN(xb_ld(&bar[XB_XGEN(b.x)]) == gen, bar);
            __builtin_amdgcn_fence(__ATOMIC_ACQUIRE, "agent");
            asm volatile("s_waitcnt vmcnt(0)" ::: "memory");
        }
    }
    __syncthreads();
}

__device__ __forceinline__ float wave_sum(float v) {
#pragma unroll
    for (int o = 32; o > 0; o >>= 1) v += __shfl_xor(v, o);
    return v;
}
__device__ __forceinline__ int wave_sum_i(int v) {
#pragma unroll
    for (int o = 32; o > 0; o >>= 1) v += __shfl_xor(v, o);
    return v;
}
__device__ __forceinline__ float wave_max(float v) {
#pragma unroll
    for (int o = 32; o > 0; o >>= 1) v = fmaxf(v, __shfl_xor(v, o));
    return v;
}
__device__ __forceinline__ float sigmoidf_(float x) { return 1.f / (1.f + expf(-x)); }
__device__ __forceinline__ float siluf_(float x) { return x / (1.f + expf(-x)); }
__device__ __forceinline__ float softplusf_(float x) { return fmaxf(x, 0.f) + log1pf(expf(-fabsf(x))); }
__device__ __forceinline__ unsigned ordkey(float f) { const unsigned u = __float_as_uint(f); return (u & 0x80000000u) ? ~u : (u | 0x80000000u); }

__device__ __forceinline__ void sincos_d(double a, double& s, double& c) {
    const double kq = rint(a * 0.63661977236758134308);
    double r = fma(-kq, 1.57079632673412561417e+00, a);
    r = fma(-kq, 6.07710050650619224932e-11, r);
    const int q = (int)((long long)kq & 3);
    const double r2 = r * r;
    const double sp = r * (1.0 + r2 * (-1.0 / 6 + r2 * (1.0 / 120 + r2 * (-1.0 / 5040 + r2 * (1.0 / 362880 + r2 * (-1.0 / 39916800 + r2 * (1.0 / 6227020800.0)))))));
    const double cp = 1.0 + r2 * (-0.5 + r2 * (1.0 / 24 + r2 * (-1.0 / 720 + r2 * (1.0 / 40320 + r2 * (-1.0 / 3628800 + r2 * (1.0 / 479001600.0 + r2 * (-1.0 / 87178291200.0)))))));
    if (q == 0) { s = sp; c = cp; } else if (q == 1) { s = cp; c = -sp; } else if (q == 2) { s = -sp; c = -cp; } else { s = -cp; c = sp; }
}
__device__ __forceinline__ double ipow_d(double b, int e) { double v = 1.0; while (e) { if (e & 1) v *= b; b *= b; e >>= 1; } return v; }

struct GemmArgs { const float* A; int lda; const int* rows; int m0; int mvalid; const float* B; int ldb; int n0; int N; int K; };

template <class Epi>
__device__ __forceinline__ void gemm128(const GemmArgs& g, float* smem, Epi epi) {
    float* As = smem;
    float* Bs = smem + 16 * 132;
    int tid_ = threadIdx.x; asm volatile("" : "+v"(tid_)); const int tid = tid_, ty = tid >> 4, tx = tid & 15;
    const int arow = tid >> 2, kq = (tid & 3) * 4;
    const int bk = tid >> 5, bn = (tid & 31) * 4;
    long asrc = -1;
    if (arow < g.mvalid) { const int r = g.rows ? g.rows[arow] : (g.m0 + arow); if (r >= 0) asrc = (long)r * g.lda; }
    const bool bval = (g.n0 + bn) < g.N;
    float acc[4][8];
#pragma unroll
    for (int i = 0; i < 4; ++i)
#pragma unroll
        for (int j = 0; j < 8; ++j) acc[i][j] = 0.f;
    for (int k0 = 0; k0 < g.K; k0 += 16) {
        float4 av = make_float4(0.f, 0.f, 0.f, 0.f), bv = make_float4(0.f, 0.f, 0.f, 0.f);
        if (asrc >= 0) av = *(const float4*)(g.A + asrc + k0 + kq);
        if (bval) bv = *(const float4*)(g.B + (size_t)(k0 + bk) * g.ldb + g.n0 + bn);
        __syncthreads();
        As[(kq + 0) * 132 + arow] = av.x; As[(kq + 1) * 132 + arow] = av.y; As[(kq + 2) * 132 + arow] = av.z; As[(kq + 3) * 132 + arow] = av.w;
        *(float4*)&Bs[bk * 132 + bn] = bv;
        __syncthreads();
#pragma unroll
        for (int kk = 0; kk < 16; ++kk) {
            const float4 a = *(const float4*)&As[kk * 132 + ty * 4];
            const float4 b0 = *(const float4*)&Bs[kk * 132 + tx * 8];
            const float4 b1 = *(const float4*)&Bs[kk * 132 + tx * 8 + 4];
            const float aa[4] = {a.x, a.y, a.z, a.w};
            const float bb[8] = {b0.x, b0.y, b0.z, b0.w, b1.x, b1.y, b1.z, b1.w};
#pragma unroll
            for (int i = 0; i < 4; ++i)
#pragma unroll
                for (int j = 0; j < 8; ++j) acc[i][j] += aa[i] * bb[j];
        }
    }
#pragma unroll
    for (int i = 0; i < 4; ++i) {
        const int r = ty * 4 + i;
        if (r < g.mvalid) {
#pragma unroll
            for (int j = 0; j < 8; ++j) { const int n = g.n0 + tx * 8 + j; if (n < g.N) epi(r, n, acc[i][j]); }
        }
    }
}


typedef short bf16x8 __attribute__((ext_vector_type(8)));
typedef float f32x4 __attribute__((ext_vector_type(4)));
typedef unsigned short bf16_t;
typedef __bf16 bf16x2_t __attribute__((ext_vector_type(2)));
typedef float f32x2_t __attribute__((ext_vector_type(2)));
__device__ __forceinline__ unsigned cvt_pk_bf16(float lo, float hi) { const f32x2_t v = {lo, hi}; const bf16x2_t r = __builtin_convertvector(v, bf16x2_t); return __builtin_bit_cast(unsigned, r); }
__device__ __forceinline__ bf16_t f2bf(float f) { return (bf16_t)(cvt_pk_bf16(f, 0.f) & 0xffffu); }
__device__ __forceinline__ float bf16_to_f32(bf16_t v) { return __uint_as_float(((unsigned)v) << 16); }
__device__ __forceinline__ uint2 pack4(const f32x4 v) { uint2 r; r.x = cvt_pk_bf16(v[0], v[1]); r.y = cvt_pk_bf16(v[2], v[3]); return r; }
__device__ __forceinline__ f32x4 unpack4(const uint2 u) { f32x4 r; r[0] = __uint_as_float(u.x << 16); r[1] = __uint_as_float(u.x & 0xffff0000u); r[2] = __uint_as_float(u.y << 16); r[3] = __uint_as_float(u.y & 0xffff0000u); return r; }
#define PBF(Pb_, t_, c_) bf16_to_f32((Pb_)[(size_t)(t_) * LDPB + (c_)])
__device__ __forceinline__ uint4 pack8(const float4 a, const float4 b) { uint4 r; r.x = cvt_pk_bf16(a.x, a.y); r.y = cvt_pk_bf16(a.z, a.w); r.z = cvt_pk_bf16(b.x, b.y); r.w = cvt_pk_bf16(b.z, b.w); return r; }
__device__ __forceinline__ int lds_off(int r, int c) { return r * 128 + ((c ^ (r & 7)) << 4); }

template <class ALoad, class BLoad, class Epi>
__device__ __forceinline__ void gemm_tile_bf16(const int K, unsigned char* lds, ALoad aload, BLoad bload, Epi epi, const int mrows = 256) {
    int tid_ = threadIdx.x; asm volatile("" : "+v"(tid_)); const int tid = tid_, lane = tid & 63, wid = tid >> 6, wm = wid >> 1, wn = wid & 1;
    f32x4 acc[4][4];
#pragma unroll
    for (int mi = 0; mi < 4; ++mi)
#pragma unroll
        for (int ni = 0; ni < 4; ++ni) acc[mi][ni] = (f32x4){0.f, 0.f, 0.f, 0.f};
    uint4 ra[4], rb[2];
    const int nk = K >> 6;
#pragma unroll
    for (int i = 0; i < 4; ++i) { const int q = tid + 512 * i; ra[i] = aload(i, q >> 3, (q & 7) * 8); }
#pragma unroll
    for (int i = 0; i < 2; ++i) { const int q = tid + 512 * i; rb[i] = bload(i, q >> 3, (q & 7) * 8); }
    __syncthreads();
#pragma unroll
    for (int i = 0; i < 4; ++i) { const int q = tid + 512 * i; *(uint4*)(lds + lds_off(q >> 3, q & 7)) = ra[i]; }
#pragma unroll
    for (int i = 0; i < 2; ++i) { const int q = tid + 512 * i; *(uint4*)(lds + 32768 + lds_off(q >> 3, q & 7)) = rb[i]; }
    __syncthreads();
    for (int kt = 0; kt < nk; ++kt) {
        if (kt + 1 < nk) {
#pragma unroll
            for (int i = 0; i < 4; ++i) { const int q = tid + 512 * i; ra[i] = aload(i, q >> 3, (kt + 1) * 64 + (q & 7) * 8); }
#pragma unroll
            for (int i = 0; i < 2; ++i) { const int q = tid + 512 * i; rb[i] = bload(i, q >> 3, (kt + 1) * 64 + (q & 7) * 8); }
        }
        const unsigned char* At = lds + (kt & 1) * 49152;
        const unsigned char* Bt = At + 32768;
        if (__builtin_amdgcn_readfirstlane(wm) * 64 < mrows) {
#pragma unroll
        for (int ks = 0; ks < 2; ++ks) {
            bf16x8 af[4], bfr[4];
            const int c = ks * 4 + (lane >> 4);
#pragma unroll
            for (int mi = 0; mi < 4; ++mi) af[mi] = *(const bf16x8*)(At + lds_off(wm * 64 + mi * 16 + (lane & 15), c));
#pragma unroll
            for (int ni = 0; ni < 4; ++ni) bfr[ni] = *(const bf16x8*)(Bt + lds_off(wn * 64 + ni * 16 + (lane & 15), c));
#pragma unroll
            for (int mi = 0; mi < 4; ++mi)
#pragma unroll
                for (int ni = 0; ni < 4; ++ni) acc[mi][ni] = __builtin_amdgcn_mfma_f32_16x16x32_bf16(bfr[ni], af[mi], acc[mi][ni], 0, 0, 0);
        }
        }
        if (kt + 1 < nk) {
            unsigned char* An = lds + ((kt + 1) & 1) * 49152;
#pragma unroll
            for (int i = 0; i < 4; ++i) { const int q = tid + 512 * i; *(uint4*)(An + lds_off(q >> 3, q & 7)) = ra[i]; }
#pragma unroll
            for (int i = 0; i < 2; ++i) { const int q = tid + 512 * i; *(uint4*)(An + 32768 + lds_off(q >> 3, q & 7)) = rb[i]; }
        }
        __syncthreads();
    }
    epi(acc, wm, wn, lane);
}

__device__ __forceinline__ void convert_tile(const float* src0, const float* src1, int mode, int K, int N, int ld, bf16_t* dst, int rt, int kt, float* smem) {
    int tid_ = threadIdx.x; asm volatile("" : "+v"(tid_)); const int tid = tid_;
    __syncthreads();
    { const int k = tid >> 3, R0 = rt * 64 + (tid & 7) * 8;
      const float* sp; int col;
      if (mode == 0) { sp = src0; col = R0; } else { sp = (R0 & 32) ? src1 : src0; col = (R0 >> 6) * 32 + (R0 & 31); }
      float4 a = make_float4(0.f, 0.f, 0.f, 0.f), b = a;
      const float* rp = sp + (size_t)(kt * 64 + k) * ld + col;
      if (col < N) a = *(const float4*)rp;
      if (col + 4 < N) b = *(const float4*)(rp + 4);
      float* d = smem + k * 65 + (tid & 7) * 8;
      d[0] = a.x; d[1] = a.y; d[2] = a.z; d[3] = a.w; d[4] = b.x; d[5] = b.y; d[6] = b.z; d[7] = b.w; }
    __syncthreads();
    { const int R = tid >> 3, kc = (tid & 7) * 8;
      float v[8];
#pragma unroll
      for (int j = 0; j < 8; ++j) v[j] = smem[(kc + j) * 65 + R];
      uint4 o; o.x = cvt_pk_bf16(v[0], v[1]); o.y = cvt_pk_bf16(v[2], v[3]); o.z = cvt_pk_bf16(v[4], v[5]); o.w = cvt_pk_bf16(v[6], v[7]);
      *(uint4*)(dst + (size_t)(rt * 64 + R) * K + kt * 64 + kc) = o; }
}

#define CT_LOAD(S0, S1, MODE, NN, LD, RT, KT, A, B) do { const int k_ = tid >> 3, R0_ = (RT) * 64 + (tid & 7) * 8; const float* sp_; int col_; \
        if ((MODE) == 0) { sp_ = (S0); col_ = R0_; } else { sp_ = (R0_ & 32) ? (S1) : (S0); col_ = (R0_ >> 6) * 32 + (R0_ & 31); } \
        A = make_float4(0.f, 0.f, 0.f, 0.f); B = A; const float* rp_ = sp_ + (size_t)((KT) * 64 + k_) * (LD) + col_; \
        if (col_ < (NN)) A = *(const float4*)rp_; if (col_ + 4 < (NN)) B = *(const float4*)(rp_ + 4); } while (0)
#define CT_WRITE(BUF, A, B) do { float* d_ = smem + (BUF) * 4160 + (tid >> 3) * 65 + (tid & 7) * 8; \
        d_[0] = A.x; d_[1] = A.y; d_[2] = A.z; d_[3] = A.w; d_[4] = B.x; d_[5] = B.y; d_[6] = B.z; d_[7] = B.w; } while (0)
#define CT_STORE(DST, KK, RT, KT, BUF) do { const int R_ = tid >> 3, kc_ = (tid & 7) * 8; const float* sb_ = smem + (BUF) * 4160; \
        uint4 o_; o_.x = cvt_pk_bf16(sb_[(kc_ + 0) * 65 + R_], sb_[(kc_ + 1) * 65 + R_]); o_.y = cvt_pk_bf16(sb_[(kc_ + 2) * 65 + R_], sb_[(kc_ + 3) * 65 + R_]); \
        o_.z = cvt_pk_bf16(sb_[(kc_ + 4) * 65 + R_], sb_[(kc_ + 5) * 65 + R_]); o_.w = cvt_pk_bf16(sb_[(kc_ + 6) * 65 + R_], sb_[(kc_ + 7) * 65 + R_]); \
        *(uint4*)((DST) + (size_t)((RT) * 64 + R_) * (KK) + (KT) * 64 + kc_) = o_; } while (0)
#define CT_DECL(I) const float* s0_##I; const float* s1_##I; bf16_t* d_##I; int md_##I, K_##I, N_##I, ld_##I, rt_##I, kt_##I
#define CT_ARGS(I) s0_##I, s1_##I, d_##I, md_##I, K_##I, N_##I, ld_##I, rt_##I, kt_##I
template <class Dec>
__device__ __forceinline__ void convert_tiles4(const Dec& dec, int t, int nj, float* smem) {
    int tid_ = threadIdx.x; asm volatile("" : "+v"(tid_)); const int tid = tid_;
    CT_DECL(0); CT_DECL(1); CT_DECL(2); CT_DECL(3);
    dec(t, CT_ARGS(0)); dec(t + 1, CT_ARGS(1)); dec(t + 2, CT_ARGS(2)); dec(t + 3, CT_ARGS(3));
    float4 a0, b0, a1, b1, a2, b2, a3, b3;
    a1 = b1 = a2 = b2 = a3 = b3 = make_float4(0.f, 0.f, 0.f, 0.f);
    CT_LOAD(s0_0, s1_0, md_0, N_0, ld_0, rt_0, kt_0, a0, b0);
    if (nj > 1) CT_LOAD(s0_1, s1_1, md_1, N_1, ld_1, rt_1, kt_1, a1, b1);
    if (nj > 2) CT_LOAD(s0_2, s1_2, md_2, N_2, ld_2, rt_2, kt_2, a2, b2);
    if (nj > 3) CT_LOAD(s0_3, s1_3, md_3, N_3, ld_3, rt_3, kt_3, a3, b3);
    __syncthreads();
    CT_WRITE(0, a0, b0); CT_WRITE(1, a1, b1); CT_WRITE(2, a2, b2); CT_WRITE(3, a3, b3);
    __syncthreads();
    CT_STORE(d_0, K_0, rt_0, kt_0, 0);
    if (nj > 1) CT_STORE(d_1, K_1, rt_1, kt_1, 1);
    if (nj > 2) CT_STORE(d_2, K_2, rt_2, kt_2, 2);
    if (nj > 3) CT_STORE(d_3, K_3, rt_3, kt_3, 3);
}

extern __shared__ __attribute__((aligned(16))) unsigned char g_smem[];
#define PHASE_FN __device__ __forceinline__
enum { PH_PROLOGUE = 0, PH_NORM_MIX, PH_GEMM_IN_EVEN, PH_EVEN_TOK, PH_GDN_CHUNK, PH_GDN_SCAN, PH_DSA_TOPK, PH_DSA_ATTN, PH_GDN_OUT,
       PH_GEMM_OUT, PH_NORM_FFN, PH_MOE1, PH_MOE2, PH_GEMM_IN_ODD, PH_GLA_TOK, PH_GLA_CHUNK, PH_GLA_SCAN, PH_GLA_OUT, PH_FINAL };

PHASE_FN void ph_prologue(const Params& p, float* smem) {
    unsigned char* ws_ = p.ws; asm volatile("" : "+s"(ws_));
    { int ldz_ = 0; asm volatile("" : "+s"(ldz_)); smem = (float*)(g_smem + ldz_); }
    int tid_ = threadIdx.x; asm volatile("" : "+v"(tid_)); const int tid = tid_, nthr = gridDim.x * NTHREADS, gid = blockIdx.x * NTHREADS + tid;
    for (int i = tid; i < 2 * ND; i += NTHREADS) smem[i] = siluf_(p.c[i]);
    __syncthreads();
    float* MOD = (float*)(ws_ + OFF_MOD);
    { float* red = smem + 2048;
      const int lane = tid & 63, wv = tid >> 6;
      for (int item = blockIdx.x; item < 4 * 96; item += gridDim.x) {
          const int l = item / 96, n = (item % 96) * 64 + lane;
          const float* w = p.ada_w + (size_t)l * ND * 6144 + n;
          float a0 = 0.f, a1 = 0.f;
#pragma unroll 8
          for (int k = wv * 128; k < wv * 128 + 128; ++k) { const float wv_ = w[(size_t)k * 6144]; a0 += smem[k] * wv_; a1 += smem[ND + k] * wv_; }
          __syncthreads();
          red[(wv * 64 + lane) * 2] = a0; red[(wv * 64 + lane) * 2 + 1] = a1;
          __syncthreads();
          if (tid < 128) { const int c = tid >> 1, bb = tid & 1; float a = 0.f; for (int w8 = 0; w8 < 8; ++w8) a += red[(w8 * 64 + c) * 2 + bb];
              MOD[(l * 2 + bb) * 6144 + (item % 96) * 64 + c] = a + p.ada_b[l * 6144 + (item % 96) * 64 + c]; }
      }
      __syncthreads(); }
    float* COSA = (float*)(ws_ + OFF_COSA); float* SINA = (float*)(ws_ + OFF_SINA);
    float* COSI = (float*)(ws_ + OFF_COSI); float* SINI = (float*)(ws_ + OFF_SINI);
    for (size_t i = gid; i < (size_t)NT * 64; i += nthr) {
        const int t = (int)(i >> 6), j = (int)(i & 63);
        double s, c; sincos_d((double)p.pos[t] * ipow_d(p.rA, j), s, c);
        COSA[i] = (float)c; SINA[i] = (float)s;
    }
    for (size_t i = gid; i < (size_t)NT * 32; i += nthr) {
        const int t = (int)(i >> 5), j = (int)(i & 31);
        double s, c; sincos_d((double)p.pos[t] * ipow_d(p.rI, j), s, c);
        COSI[i] = (float)c; SINI[i] = (float)s;
    }
}

PHASE_FN void ph_rows(const Params& p, int layer, int mode, float* smem) {
    unsigned char* ws_ = p.ws; asm volatile("" : "+s"(ws_));
    { int ldz_ = 0; asm volatile("" : "+s"(ldz_)); smem = (float*)(g_smem + ldz_); }
    int tid_ = threadIdx.x; asm volatile("" : "+v"(tid_)); const int tid = tid_, lane = tid & 63, wv = tid >> 6;
    int* pad = (int*)smem;
    const int moe_layer = (mode == 1) ? 3 : layer - 1;
    if (moe_layer >= 0) {
        if (tid == 0) { const int* cnt = (const int*)(ws_ + OFF_CNT) + moe_layer * 32 * CSTR; int a = 0; for (int e = 0; e < 32; ++e) { pad[e] = a; a += ((cnt[e * CSTR] + 127) / 128) * 128; } }
        __syncthreads();
    }
    const float* MOD = (const float*)(ws_ + OFF_MOD);
    bf16_t* H = (bf16_t*)(ws_ + OFF_H);
    const bf16_t* YB = (const bf16_t*)(ws_ + OFF_YB);
    const int* ASG = (const int*)(ws_ + OFF_ASG);
    const float* GATE = (const float*)(ws_ + OFF_GATE);
    auto load_x = [&](int row, float (&xv)[16]) {
        const float* xin = (mode == 0 && layer == 0) ? (p.x + (size_t)row * ND) : (p.X + (size_t)row * ND);
#pragma unroll
        for (int j = 0; j < 4; ++j) { const float4 v = *(const float4*)(xin + j * 256 + lane * 4); xv[4 * j] = v.x; xv[4 * j + 1] = v.y; xv[4 * j + 2] = v.z; xv[4 * j + 3] = v.w; }
    };
    auto load_y = [&](int row, uint2 (&ya)[4], uint2 (&yb)[4], float& g0, float& g1) {
        const int4 as = *(const int4*)(ASG + row * 4);
        g0 = GATE[row * 2]; g1 = GATE[row * 2 + 1];
        const bf16_t* y0 = YB + (size_t)(pad[as.x] + as.y) * ND;
        const bf16_t* y1 = YB + (size_t)(pad[as.z] + as.w) * ND;
#pragma unroll
        for (int j = 0; j < 4; ++j) { ya[j] = *(const uint2*)(y0 + j * 256 + lane * 4); yb[j] = *(const uint2*)(y1 + j * 256 + lane * 4); }
    };
    auto finish = [&](int row, float (&xv)[16], const uint2 (&ya)[4], const uint2 (&yb)[4], float g0, float g1) {
        const int b = row >> 13;
        float* xr = p.X + (size_t)row * ND;
        if (moe_layer >= 0) {
            const float* gt = MOD + (size_t)(moe_layer * 2 + b) * 6144 + 5 * 1024;
#pragma unroll
            for (int j = 0; j < 4; ++j) {
                const int col = j * 256 + lane * 4;
                const f32x4 a = unpack4(ya[j]), bq = unpack4(yb[j]); const float4 g = *(const float4*)(gt + col);
                xv[4 * j] += g.x * (g0 * a[0] + g1 * bq[0]); xv[4 * j + 1] += g.y * (g0 * a[1] + g1 * bq[1]);
                xv[4 * j + 2] += g.z * (g0 * a[2] + g1 * bq[2]); xv[4 * j + 3] += g.w * (g0 * a[3] + g1 * bq[3]);
                if (mode == 0) *(float4*)(xr + col) = make_float4(xv[4 * j], xv[4 * j + 1], xv[4 * j + 2], xv[4 * j + 3]);
            }
        }
        float ss = 0.f;
#pragma unroll
        for (int j = 0; j < 16; ++j) ss += xv[j] * xv[j];
        ss = wave_sum(ss);
        const float rstd = rsqrtf(ss * (1.f / 1024.f) + EPS);
        if (mode == 0) {
            const float* nw = p.norm_mix + layer * 1024;
            const float* sh = MOD + (size_t)(layer * 2 + b) * 6144;
            const float* sc = sh + 1024;
#pragma unroll
            for (int j = 0; j < 4; ++j) {
                const int col = j * 256 + lane * 4;
                const float4 w = *(const float4*)(nw + col), s4 = *(const float4*)(sc + col), h4 = *(const float4*)(sh + col);
                f32x4 ov;
                ov[0] = xv[4 * j] * rstd * w.x * (1.f + s4.x) + h4.x; ov[1] = xv[4 * j + 1] * rstd * w.y * (1.f + s4.y) + h4.y;
                ov[2] = xv[4 * j + 2] * rstd * w.z * (1.f + s4.z) + h4.z; ov[3] = xv[4 * j + 3] * rstd * w.w * (1.f + s4.w) + h4.w;
                *(uint2*)(H + (size_t)row * ND + col) = pack4(ov);
            }
        } else {
#pragma unroll
            for (int j = 0; j < 4; ++j) {
                const int col = j * 256 + lane * 4;
                const float4 w = *(const float4*)(p.final_norm + col);
                *(float4*)(xr + col) = make_float4(xv[4 * j] * rstd * w.x, xv[4 * j + 1] * rstd * w.y, xv[4 * j + 2] * rstd * w.z, xv[4 * j + 3] * rstd * w.w);
            }
        }
    };
    const int stride = gridDim.x * 8;
    for (int row = blockIdx.x * 8 + wv; row < NT; row += 2 * stride) {
        const int rowB = row + stride; const bool hasB = rowB < NT; const int rB = hasB ? rowB : row;
        float xa[16], xb[16]; uint2 yaa[4], yab[4], yba[4], ybb[4]; float ga0 = 0.f, ga1 = 0.f, gb0 = 0.f, gb1 = 0.f;
        load_x(row, xa); load_x(rB, xb);
        if (moe_layer >= 0) { load_y(row, yaa, yab, ga0, ga1); load_y(rB, yba, ybb, gb0, gb1); }
        finish(row, xa, yaa, yab, ga0, ga1);
        if (hasB) finish(rowB, xb, yba, ybb, gb0, gb1);
    }
}

PHASE_FN void ph_gemm_in(const Params& p, int layer, bool even, float* smem) {
    unsigned char* ws_ = p.ws; asm volatile("" : "+s"(ws_));
    { int ldz_ = 0; asm volatile("" : "+s"(ldz_)); smem = (float*)(g_smem + ldz_); }
    const int N = even ? 3916 : 3088, ntn = even ? 31 : 25;
    const bf16_t* Wt = even ? (const bf16_t*)(ws_ + OFF_WINE) + (size_t)(layer >> 1) * 3968 * 1024 : (const bf16_t*)(ws_ + OFF_WINO) + (size_t)(layer >> 1) * 3200 * 1024;
    const bf16_t* H = (const bf16_t*)(ws_ + OFF_H);
    bf16_t* P = (bf16_t*)(ws_ + OFF_P);
    float* AUX = (float*)(ws_ + OFF_AUX);
    const int vb_ = ((int)blockIdx.x & 7) * ((int)gridDim.x >> 3) + ((int)blockIdx.x >> 3);
    for (int tile = vb_; tile < 64 * ntn; tile += gridDim.x) {
        const int grp_ = tile / (8 * ntn), rr_ = tile % (8 * ntn), mt = grp_ * 8 + (rr_ & 7), nt = rr_ >> 3;
        const bf16_t* Ab = H + (size_t)mt * 256 * 1024;
        const bf16_t* Bb = Wt + (size_t)nt * 128 * 1024;
        bf16_t* Pt = P + (size_t)mt * 256 * LDPB + nt * 128;
        float* At = AUX + (size_t)mt * 256 * 16;
        const int ncol0 = nt * 128;
        const int nrem = N - nt * 128;
        gemm_tile_bf16(1024, (unsigned char*)smem,
            [=](int i, int r, int k) -> uint4 { return *(const uint4*)(Ab + (size_t)r * 1024 + k); },
            [=](int i, int r, int k) -> uint4 { return *(const uint4*)(Bb + (size_t)r * 1024 + k); },
            [=](const f32x4 (&acc)[4][4], int wm, int wn, int lane) {
#pragma unroll
                for (int mi = 0; mi < 4; ++mi)
#pragma unroll
                    for (int ni = 0; ni < 4; ++ni) {
                        const int m = wm * 64 + mi * 16 + (lane & 15), n = wn * 64 + ni * 16 + 4 * (lane >> 4);
                        if (n < nrem) {
                            *(uint2*)(Pt + (size_t)m * LDPB + n) = pack4(acc[mi][ni]);
                            const int gc = ncol0 + n;
                            int ax = -1;
                            if (even) { if (gc == 2048) ax = 0; else if (gc == 2052) ax = 4; else if (gc == 3912) ax = 8; }
                            else { if (gc >= 3072 && gc < 3088) ax = gc - 3072; }
                            if (ax >= 0) *(f32x4*)(At + (size_t)m * 16 + ax) = acc[mi][ni];
                        }
                    }
            });
    }
}

PHASE_FN void ph_even_tok(const Params& p, int layer, float* smem) {
    unsigned char* ws_ = p.ws; asm volatile("" : "+s"(ws_));
    { int ldz_ = 0; asm volatile("" : "+s"(ldz_)); smem = (float*)(g_smem + ldz_); }
    int tid_ = threadIdx.x; asm volatile("" : "+v"(tid_)); const int tid = tid_, lane = tid & 63, wv = tid >> 6, li = layer >> 1;
    const bf16_t* P = (const bf16_t*)(ws_ + OFF_P); const float* AUX = (const float*)(ws_ + OFF_AUX);
    bf16_t* QB = (bf16_t*)(ws_ + OFF_QBB); bf16_t* KB = (bf16_t*)(ws_ + OFF_KBB); bf16_t* QI = (bf16_t*)(ws_ + OFF_QIB); bf16_t* KI = (bf16_t*)(ws_ + OFF_KIB); float* WI = (float*)(ws_ + OFF_WI);
    const float* COSA = (const float*)(ws_ + OFF_COSA); const float* SINA = (const float*)(ws_ + OFF_SINA);
    const float* COSI = (const float*)(ws_ + OFF_COSI); const float* SINI = (const float*)(ws_ + OFF_SINI);
    for (int t = blockIdx.x * 8 + wv; t < NT; t += gridDim.x * 8) {
        const bf16_t* Pt = P + (size_t)t * LDPB;
        if (lane < 4) {
            WI[t * 4 + lane] = AUX[(size_t)t * 16 + 8 + lane] * 0.0625f;
        }
        { const float c = COSA[(size_t)t * 64 + lane], sn = SINA[(size_t)t * 64 + lane];
#pragma unroll
          for (int h = 0; h < 4; ++h) {
              float t1 = bf16_to_f32(Pt[2056 + h * 128 + lane]), t2 = bf16_to_f32(Pt[2056 + h * 128 + 64 + lane]);
              QB[(size_t)t * 512 + h * 128 + lane] = f2bf(t1 * c - t2 * sn); QB[(size_t)t * 512 + h * 128 + 64 + lane] = f2bf(t2 * c + t1 * sn);
              t1 = bf16_to_f32(Pt[2568 + h * 128 + lane]); t2 = bf16_to_f32(Pt[2568 + h * 128 + 64 + lane]);
              KB[(size_t)t * 512 + h * 128 + lane] = f2bf(t1 * c - t2 * sn); KB[(size_t)t * 512 + h * 128 + 64 + lane] = f2bf(t2 * c + t1 * sn);
          } }
#pragma unroll
        for (int r = 0; r < 2; ++r) {
            const int item = lane + 64 * r, hh = item >> 5, ii = item & 31;
            const float c = COSI[(size_t)t * 32 + ii], sn = SINI[(size_t)t * 32 + ii];
            const float t1 = bf16_to_f32(Pt[3592 + hh * 64 + ii]), t2 = bf16_to_f32(Pt[3592 + hh * 64 + 32 + ii]);
            QI[(size_t)t * 256 + hh * 64 + ii] = f2bf(t1 * c - t2 * sn); QI[(size_t)t * 256 + hh * 64 + 32 + ii] = f2bf(t2 * c + t1 * sn);
        }
        if (lane < 32) {
            const float c = COSI[(size_t)t * 32 + lane], sn = SINI[(size_t)t * 32 + lane];
            const float t1 = bf16_to_f32(Pt[3848 + lane]), t2 = bf16_to_f32(Pt[3848 + 32 + lane]);
            KI[(size_t)t * 64 + lane] = f2bf(t1 * c - t2 * sn); KI[(size_t)t * 64 + 32 + lane] = f2bf(t2 * c + t1 * sn);
        }
    }
    { bf16_t* VT = (bf16_t*)(ws_ + OFF_VT);
      bf16_t* sv = (bf16_t*)g_smem;
      for (int item = blockIdx.x; item < 2 * 128 * 4; item += gridDim.x) {
          const int h = item & 3, tt = item >> 2, b = tt >> 7, s0 = (tt & 127) * 64;
          __syncthreads();
          for (int e = tid; e < 64 * 128; e += NTHREADS) { const int i = e >> 7, d = e & 127; sv[d * 72 + i] = P[(size_t)(b * 8192 + s0 + i) * LDPB + 3080 + h * 128 + d]; }
          __syncthreads();
          for (int e = tid; e < 128 * 8; e += NTHREADS) { const int d = e >> 3, c = e & 7;
              *(uint4*)(VT + ((size_t)((b * 4 + h) * 128 + d)) * 8192 + s0 + c * 8) = *(const uint4*)(sv + d * 72 + c * 8); }
      } }
}

__device__ __forceinline__ f32x4 mma_lds(const unsigned char* A, int sa, int a0, const unsigned char* B, int sb, int b0, int K, f32x4 acc, int c16, int q4) {
    const unsigned char* ap = A + (a0 + c16) * sa + q4 * 16;
    const unsigned char* bp = B + (b0 + c16) * sb + q4 * 16;
    for (int kk = 0; kk < K; kk += 32) { acc = __builtin_amdgcn_mfma_f32_16x16x32_bf16(*(const bf16x8*)(ap + kk * 2), *(const bf16x8*)(bp + kk * 2), acc, 0, 0, 0); }
    return acc;
}

PHASE_FN void ph_gdn_chunk(const Params& p, int layer, float* smem) {
    unsigned char* ws_ = p.ws; asm volatile("" : "+s"(ws_));
    int tid_ = threadIdx.x; asm volatile("" : "+v"(tid_)); const int tid = tid_, lane = tid & 63, wv = __builtin_amdgcn_readfirstlane(tid >> 6), q4 = lane >> 4, c16 = lane & 15;
    int ldz_ = 0; asm volatile("" : "+s"(ldz_)); unsigned char* lds = g_smem + ldz_;
    constexpr int SN = 272, ST = 144;
    unsigned char* bKN = lds;
    unsigned char* bQN = lds + 18432;
    unsigned char* bKBG = lds + 35840;
    unsigned char* bVB = lds + 54272;
    unsigned char* bKD = lds + 72704;
    unsigned char* bUT = lds + 91136;
    float* sL = (float*)(lds + 109568);
    unsigned char* bAQK = lds + 126208;
    unsigned char* bTB = lds + 135424;
    float* sG = (float*)(lds + 144640); float* sB = sG + 64; float* sEg = sB + 64;
    const int li = layer >> 1;
    const bf16_t* P = (const bf16_t*)(ws_ + OFF_P); const float* AUX = (const float*)(ws_ + OFF_AUX);
    const float* cw = p.conv_w + (size_t)li * 4 * 1536;
    uint4* PFR = (uint4*)(ws_ + OFF_PFR); uint4* RFR = (uint4*)(ws_ + OFF_RFR); uint2* QFR = (uint2*)(ws_ + OFF_QFR); uint2* OFR = (uint2*)(ws_ + OFF_OFR);
    float* GL = (float*)(ws_ + OFF_GL);
    for (int ci = blockIdx.x; ci < 1024; ci += gridDim.x) {
        const int b = ci >> 9, h = (ci >> 7) & 3, n = ci & 127;
        const int t0 = b * 8192 + n * 64;
        __syncthreads();
        if (tid < 64) { float g = -expf(p.a_log[li * 4 + h]) * softplusf_(AUX[(size_t)(t0 + tid) * 16 + 4 + h] + p.dt_bias[li * 4 + h]);
#pragma unroll
            for (int o = 1; o < 64; o <<= 1) { const float nb = __shfl_up(g, o); if (lane >= o) g += nb; }
            sG[tid] = g; sB[tid] = sigmoidf_(AUX[(size_t)(t0 + tid) * 16 + h]); sEg[tid] = expf(g); }
        for (int e = tid; e < 64 * 36; e += NTHREADS) ((unsigned*)bAQK)[e] = 0u;
        __syncthreads();
        const float gl = sG[63];
        {
            const int d0 = 2 * lane, cb = h * 128 + d0, s00 = n * 64;
            float wq[4][2], wk[4][2], wvv[4][2];
#pragma unroll
            for (int jj = 0; jj < 4; ++jj) { wq[jj][0] = cw[jj * 1536 + cb]; wq[jj][1] = cw[jj * 1536 + cb + 1]; wk[jj][0] = cw[jj * 1536 + 512 + cb]; wk[jj][1] = cw[jj * 1536 + 512 + cb + 1];
                                            wvv[jj][0] = cw[jj * 1536 + 1024 + cb]; wvv[jj][1] = cw[jj * 1536 + 1024 + cb + 1]; }
#pragma unroll 4
            for (int r = 0; r < 8; ++r) {
                const int i = wv + 8 * r;
                float aq0 = 0.f, aq1 = 0.f, ak0 = 0.f, ak1 = 0.f, av0 = 0.f, av1 = 0.f;
#pragma unroll
                for (int jj = 0; jj < 4; ++jj) {
                    if (s00 + i - 3 + jj >= 0) {
                        const bf16_t* rp = P + (size_t)(t0 + i - 3 + jj) * LDPB + cb;
                        const unsigned uq = *(const unsigned*)rp, uk = *(const unsigned*)(rp + 512), uv = *(const unsigned*)(rp + 1024);
                        aq0 += wq[jj][0] * __uint_as_float(uq << 16); aq1 += wq[jj][1] * __uint_as_float(uq & 0xffff0000u);
                        ak0 += wk[jj][0] * __uint_as_float(uk << 16); ak1 += wk[jj][1] * __uint_as_float(uk & 0xffff0000u);
                        av0 += wvv[jj][0] * __uint_as_float(uv << 16); av1 += wvv[jj][1] * __uint_as_float(uv & 0xffff0000u);
                    }
                }
                aq0 = siluf_(aq0); aq1 = siluf_(aq1); ak0 = siluf_(ak0); ak1 = siluf_(ak1); av0 = siluf_(av0); av1 = siluf_(av1);
                const float rq = rsqrtf(wave_sum(aq0 * aq0 + aq1 * aq1) + EPS), rk = rsqrtf(wave_sum(ak0 * ak0 + ak1 * ak1) + EPS);
                aq0 *= rq; aq1 *= rq; ak0 *= rk; ak1 *= rk;
                const float be = sB[i], eg_i = sEg[i], ekd = expf(gl - sG[i]);
                *(unsigned*)(bKN + i * SN + d0 * 2) = cvt_pk_bf16(ak0, ak1);
                *(unsigned*)(bQN + i * SN + d0 * 2) = cvt_pk_bf16(aq0, aq1);
                *(bf16_t*)(bKBG + d0 * ST + i * 2) = f2bf(ak0 * be * eg_i); *(bf16_t*)(bKBG + (d0 + 1) * ST + i * 2) = f2bf(ak1 * be * eg_i);
                *(bf16_t*)(bVB + d0 * ST + i * 2) = f2bf(av0 * be); *(bf16_t*)(bVB + (d0 + 1) * ST + i * 2) = f2bf(av1 * be);
                *(bf16_t*)(bKD + d0 * ST + i * 2) = f2bf(ak0 * ekd); *(bf16_t*)(bKD + (d0 + 1) * ST + i * 2) = f2bf(ak1 * ekd);
            }
        }
        __syncthreads();
        for (int u = wv; u < 20; u += 8) {
            const int kind = (u >= 10) ? 1 : 0, idx = u - kind * 10;
            const int ti = (idx >= 6) ? 3 : (idx >= 3) ? 2 : (idx >= 1) ? 1 : 0, tj = idx - ((ti * (ti + 1)) >> 1);
            f32x4 acc = (f32x4){0.f, 0.f, 0.f, 0.f};
            acc = mma_lds(kind ? bQN : bKN, SN, 16 * ti, bKN, SN, 16 * tj, 128, acc, c16, q4);
            const int j = 16 * tj + c16;
#pragma unroll
            for (int r = 0; r < 4; ++r) { const int i = 16 * ti + 4 * q4 + r;
                const float dec = (j <= i) ? expf(sG[i] - sG[j]) : 0.f;
                if (kind == 0) sL[i * 65 + j] = (j < i) ? sB[i] * acc[r] * dec : 0.f;
                else *(bf16_t*)(bAQK + i * ST + j * 2) = f2bf(acc[r] * SCALE128 * dec); }
        }
        __syncthreads();
        if (wv == 0) {
            float t[64];
            int zz = 0; asm volatile("" : "+v"(zz)); const float* sLo = sL + zz;
#pragma unroll
            for (int i = 0; i < 64; ++i) { float a = (i == lane) ? 1.f : 0.f;
#pragma unroll
                for (int j = 0; j < i; ++j) a -= sLo[i * 65 + j] * t[j];
                t[i] = a; asm volatile("" ::: "memory"); }
#pragma unroll
            for (int i = 0; i < 64; ++i) *(bf16_t*)(bTB + i * ST + lane * 2) = f2bf(t[i]);
        }
        __syncthreads();
        for (int x = 0; x < 8; ++x) {
            const int u = wv * 8 + x, kind = u >> 5, ti = (u >> 3) & 3, td = u & 7;
            f32x4 acc = (f32x4){0.f, 0.f, 0.f, 0.f};
            acc = mma_lds(bTB, ST, 16 * ti, kind ? bVB : bKBG, ST, 16 * td, 64, acc, c16, q4);
            *(uint2*)((kind ? bUT : bKN) + (16 * td + c16) * ST + (16 * ti + 4 * q4) * 2) = pack4(acc);
        }
        __syncthreads();
        unsigned char* bWT = bKN;
        const float eg = expf(gl);
        for (int x = 0; x < 4; ++x) {
            const int u = wv * 4 + x, ti = u >> 2, a = u & 3;
            uint4 fr;
#pragma unroll
            for (int hf = 0; hf < 2; ++hf) { const int tk = 2 * a + hf;
                f32x4 acc = (f32x4){0.f, 0.f, 0.f, 0.f};
                acc = mma_lds(bWT, ST, 16 * tk, bKD, ST, 16 * ti, 64, acc, c16, q4);
                f32x4 v;
#pragma unroll
                for (int r = 0; r < 4; ++r) v[r] = ((16 * tk + 4 * q4 + r) == (16 * ti + c16) ? eg : 0.f) - acc[r];
                const uint2 pk = pack4(v);
                if (hf == 0) { fr.x = pk.x; fr.y = pk.y; } else { fr.z = pk.x; fr.w = pk.y; } }
            PFR[((size_t)(ci * 8 + ti) * 4 + a) * 64 + lane] = fr;
        }
        for (int x = 0; x < 2; ++x) {
            const int u = wv * 2 + x, ti = u >> 2, a = u & 3;
            uint4 fr;
            const int i = 16 * ti + c16;
            const float qs = SCALE128 * sEg[i];
#pragma unroll
            for (int hf = 0; hf < 2; ++hf) { const int tk = 2 * a + hf;
                f32x4 acc = (f32x4){0.f, 0.f, 0.f, 0.f};
                acc = mma_lds(bWT, ST, 16 * tk, bAQK, ST, 16 * ti, 64, acc, c16, q4);
                const f32x4 qv = unpack4(*(const uint2*)(bQN + i * SN + (16 * tk + 4 * q4) * 2));
                const uint2 pk = pack4(qv * qs - acc);
                if (hf == 0) { fr.x = pk.x; fr.y = pk.y; } else { fr.z = pk.x; fr.w = pk.y; } }
            RFR[((size_t)(ci * 4 + ti) * 4 + a) * 64 + lane] = fr;
        }
        for (int x = 0; x < 8; ++x) {
            const int u = wv * 8 + x, tdv = u >> 3, tdk = u & 7;
            f32x4 acc = (f32x4){0.f, 0.f, 0.f, 0.f};
            acc = mma_lds(bKD, ST, 16 * tdk, bUT, ST, 16 * tdv, 64, acc, c16, q4);
            QFR[((size_t)(ci * 8 + tdv) * 8 + tdk) * 64 + lane] = pack4(acc);
        }
        for (int x = 0; x < 4; ++x) {
            const int u = wv * 4 + x, tdv = u >> 2, ti = u & 3;
            f32x4 acc = (f32x4){0.f, 0.f, 0.f, 0.f};
            acc = mma_lds(bAQK, ST, 16 * ti, bUT, ST, 16 * tdv, 64, acc, c16, q4);
            OFR[((size_t)(ci * 8 + tdv) * 4 + ti) * 64 + lane] = pack4(acc);
        }
        if (tid == 0) GL[ci] = gl;
    }
}

__device__ __forceinline__ void gs_load(uint4 (&d)[12], const unsigned char* pp, const unsigned char* rr, const unsigned char* qq, const unsigned char* oo, const int lt) {
#pragma unroll
    for (int i = 0; i < 6; ++i) { int c = lt + 384 * i; c = c < 2048 ? c : 2047; d[i] = *(const uint4*)(pp + c * 16); }
#pragma unroll
    for (int i = 0; i < 3; ++i) { int c = lt + 384 * i; c = c < 1024 ? c : 1023; d[6 + i] = *(const uint4*)(rr + c * 16); }
#pragma unroll
    for (int i = 0; i < 2; ++i) { int c = lt + 384 * i; c = c < 512 ? c : 511; d[9 + i] = *(const uint4*)(qq + c * 16); }
    { const int c = lt < 256 ? lt : 255; d[11] = *(const uint4*)(oo + c * 16); }
}
__device__ __forceinline__ void gs_store(const uint4 (&d)[12], unsigned char* sb, const int lt) {
#pragma unroll
    for (int i = 0; i < 6; ++i) { const int c = lt + 384 * i; if (c < 2048) *(uint4*)(sb + c * 16) = d[i]; }
#pragma unroll
    for (int i = 0; i < 3; ++i) { const int c = lt + 384 * i; if (c < 1024) *(uint4*)(sb + 32768 + c * 16) = d[6 + i]; }
#pragma unroll
    for (int i = 0; i < 2; ++i) { const int c = lt + 384 * i; if (c < 512) *(uint4*)(sb + 49152 + c * 16) = d[9 + i]; }
    if (lt < 256) *(uint4*)(sb + 57344 + lt * 16) = d[11];
}

#define SCAN_BODY                 bf16x8 Sb[4]; \
_Pragma("unroll") \
                for (int a = 0; a < 4; ++a) { union { uint4 u; bf16x8 v; } cv; const uint2 lo = pack4(S[2 * a]), hi = pack4(S[2 * a + 1]); cv.u.x = lo.x; cv.u.y = lo.y; cv.u.z = hi.x; cv.u.w = hi.y; Sb[a] = cv.v; } \
                const int t0 = b * 8192 + n * 64; \
                {   f32x4 oa[4]; \
_Pragma("unroll") \
                    for (int ti = 0; ti < 4; ++ti) oa[ti] = unpack4(*(const uint2*)(Of + ti * 512)); \
_Pragma("unroll") \
                    for (int a = 0; a < 4; ++a) \
_Pragma("unroll") \
                        for (int ti = 0; ti < 4; ++ti) oa[ti] = __builtin_amdgcn_mfma_f32_16x16x32_bf16(*(const bf16x8*)(Rf + (ti * 4 + a) * 1024), Sb[a], oa[ti], 0, 0, 0); \
_Pragma("unroll") \
                    for (int ti = 0; ti < 4; ++ti) { \
                        float* op = O + (size_t)(t0 + 16 * ti + 4 * q4) * 1024 + h * 128 + 16 * tdv + c16; \
                        op[0] = oa[ti][0]; op[1024] = oa[ti][1]; op[2048] = oa[ti][2]; op[3072] = oa[ti][3]; } \
                } \
                asm volatile("" ::: "memory"); \
_Pragma("unroll") \
                for (int g = 0; g < 2; ++g) { \
                    f32x4 sa[4]; \
_Pragma("unroll") \
                    for (int t = 0; t < 4; ++t) sa[t] = unpack4(*(const uint2*)(Qf + (g * 4 + t) * 512)); \
_Pragma("unroll") \
                    for (int a = 0; a < 4; ++a) \
_Pragma("unroll") \
                        for (int t = 0; t < 4; ++t) sa[t] = __builtin_amdgcn_mfma_f32_16x16x32_bf16(*(const bf16x8*)(Pf + ((g * 4 + t) * 4 + a) * 1024), Sb[a], sa[t], 0, 0, 0); \
_Pragma("unroll") \
                    for (int t = 0; t < 4; ++t) S[g * 4 + t] = sa[t]; \
                    asm volatile("" ::: "memory"); \
                }
PHASE_FN void ph_gdn_scan(const Params& p, float* smem) {
    unsigned char* ws_ = p.ws; asm volatile("" : "+s"(ws_));
    int tid_ = threadIdx.x; asm volatile("" : "+v"(tid_)); const int tid = tid_, lane = tid & 63, wv = __builtin_amdgcn_readfirstlane(tid >> 6), q4 = lane >> 4, c16 = lane & 15;
    int ldz_ = 0; asm volatile("" : "+s"(ldz_)); unsigned char* lds = g_smem + ldz_;
    constexpr int STG = 61440;
    const unsigned char* PFR = ws_ + OFF_PFR; const unsigned char* RFR = ws_ + OFF_RFR; const unsigned char* QFR = ws_ + OFF_QFR; const unsigned char* OFR = ws_ + OFF_OFR;
    float* O = (float*)(ws_ + OFF_O);
    for (int it = blockIdx.x; it < 32; it += gridDim.x) {
        const int bh = it >> 2, pair = it & 3, b = bh >> 2, h = bh & 3;
        __syncthreads();
        if (wv >= 2) {
            const int lt = tid - 128;
            const unsigned char* Pb = PFR + (size_t)bh * 128 * 32768;
            const unsigned char* Rb = RFR + (size_t)bh * 128 * 16384;
            const unsigned char* Qb = QFR + (size_t)bh * 128 * 32768 + pair * 8192;
            const unsigned char* Ob = OFR + (size_t)bh * 128 * 16384 + pair * 4096;
            uint4 ra0, ra1, ra2, ra3, ra4, ra5, ra6, ra7, ra8, ra9, ra10, ra11, rb0, rb1, rb2, rb3, rb4, rb5, rb6, rb7, rb8, rb9, rb10, rb11;
            uint4 rc0, rc1, rc2, rc3, rc4, rc5, rc6, rc7, rc8, rc9, rc10, rc11;
#define LDC(base_, c_, mx_) (*(const uint4*)((base_) + (size_t)(((c_) < (mx_)) ? (c_) : (mx_)) * 16))
#define GS_LOAD(X, n_) do { const unsigned char* pp_ = Pb + (size_t)(n_) * 32768; const unsigned char* rr_ = Rb + (size_t)(n_) * 16384; \
                const unsigned char* qq_ = Qb + (size_t)(n_) * 32768; const unsigned char* oo_ = Ob + (size_t)(n_) * 16384; \
                X##0 = LDC(pp_, lt, 2047); X##1 = LDC(pp_, lt + 384, 2047); X##2 = LDC(pp_, lt + 768, 2047); X##3 = LDC(pp_, lt + 1152, 2047); X##4 = LDC(pp_, lt + 1536, 2047); X##5 = LDC(pp_, lt + 1920, 2047); \
                X##6 = LDC(rr_, lt, 1023); X##7 = LDC(rr_, lt + 384, 1023); X##8 = LDC(rr_, lt + 768, 1023); \
                X##9 = LDC(qq_, lt, 511); X##10 = LDC(qq_, lt + 384, 511); X##11 = LDC(oo_, lt, 255); } while (0)
#define STC(off_, c_, lim_, v_) do { if ((c_) < (lim_)) *(uint4*)(sb_ + (off_) + (c_) * 16) = v_; } while (0)
#define GS_STORE(X, st_) do { unsigned char* sb_ = lds + (st_) * STG; \
                STC(0, lt, 2048, X##0); STC(0, lt + 384, 2048, X##1); STC(0, lt + 768, 2048, X##2); STC(0, lt + 1152, 2048, X##3); STC(0, lt + 1536, 2048, X##4); STC(0, lt + 1920, 2048, X##5); \
                STC(32768, lt, 1024, X##6); STC(32768, lt + 384, 1024, X##7); STC(32768, lt + 768, 1024, X##8); \
                STC(49152, lt, 512, X##9); STC(49152, lt + 384, 512, X##10); STC(57344, lt, 256, X##11); } while (0)
            GS_LOAD(ra, 0); GS_STORE(ra, 0);
            GS_LOAD(rb, 1); GS_LOAD(rc, 2); GS_LOAD(ra, 3);
            __syncthreads();
#define CLAMPN(x_) (((x_) < 128) ? (x_) : 127)
            for (int n = 0; n < 128; n += 3) {
                if (n + 1 < 128) GS_STORE(rb, (n + 1) & 1);
                GS_LOAD(rb, CLAMPN(n + 4)); __syncthreads();
                if (n + 1 < 128) { if (n + 2 < 128) GS_STORE(rc, (n + 2) & 1);
                    GS_LOAD(rc, CLAMPN(n + 5)); __syncthreads(); }
                if (n + 2 < 128) { if (n + 3 < 128) GS_STORE(ra, (n + 3) & 1);
                    GS_LOAD(ra, CLAMPN(n + 6)); __syncthreads(); }
            }
        } else {
            const int tdv = pair * 2 + wv;
            f32x4 S[8];
#pragma unroll
            for (int t = 0; t < 8; ++t) S[t] = (f32x4){0.f, 0.f, 0.f, 0.f};
            __syncthreads();
            for (int n = 0; n < 128; ++n) {
                const unsigned char* base = lds + (n & 1) * STG;
                const unsigned char* Pf = base + lane * 16, *Rf = base + 32768 + lane * 16;
                const unsigned char* Qf = base + 49152 + wv * 4096 + lane * 8, *Of = base + 57344 + wv * 2048 + lane * 8;
                SCAN_BODY
                __syncthreads();
            }
        }
    }
}

__device__ __forceinline__ void block_sum4(int (&v)[4], int* buf) {
    const int lane = threadIdx.x & 63, wv = threadIdx.x >> 6;
#pragma unroll
    for (int q = 0; q < 4; ++q) v[q] = wave_sum_i(v[q]);
    if (lane == 0) {
#pragma unroll
        for (int q = 0; q < 4; ++q) buf[wv * 4 + q] = v[q];
    }
    __syncthreads();
#pragma unroll
    for (int q = 0; q < 4; ++q) { int a = 0; for (int w = 0; w < 8; ++w) a += buf[w * 4 + q]; v[q] = a; }
}

PHASE_FN void ph_dsa_topk(const Params& p, int layer, float* smem) {
    unsigned char* ws_ = p.ws; asm volatile("" : "+s"(ws_));
    int tid_ = threadIdx.x; asm volatile("" : "+v"(tid_)); const int tid = tid_, lane = tid & 63, wv = __builtin_amdgcn_readfirstlane(tid >> 6), q4 = lane >> 4, c16 = lane & 15;
    int* sRed = (int*)g_smem;
    const bf16_t* QIb = (const bf16_t*)(ws_ + OFF_QIB); const bf16_t* KIb = (const bf16_t*)(ws_ + OFF_KIB); const float* WI = (const float*)(ws_ + OFF_WI);
    unsigned short* M16 = (unsigned short*)(ws_ + OFF_M16);
    int* qhead = (int*)(ws_ + OFF_QCTR) + layer * 16;
    int* sIt = (int*)(g_smem + 512);
    for (;;) {
        __syncthreads();
        if (tid == 0) *sIt = atomicAdd(qhead, 1);
        __syncthreads();
        const int it = *sIt;
        if (it >= 2048) break;
        const int b = it & 1, gp = 1023 - (it >> 1);
        const int s0 = gp * 8, t0 = b * 8192 + s0;
        const int ntiles = (s0 >> 4) + 1;
        const int nreg = (ntiles > wv) ? ((ntiles - wv + 7) >> 3) : 0;
        const bf16_t* qp = QIb + (size_t)(t0 + (c16 >> 2)) * 256 + (c16 & 3) * 64 + 8 * q4;
        const bf16x8 a0A = *(const bf16x8*)qp, a1A = *(const bf16x8*)(qp + 32), a0B = *(const bf16x8*)(qp + 4 * 256), a1B = *(const bf16x8*)(qp + 4 * 256 + 32);
        const float4 wqA = *(const float4*)(WI + (size_t)(t0 + q4) * 4), wqB = *(const float4*)(WI + (size_t)(t0 + 4 + q4) * 4);
        const int myqA = s0 + q4, myqB = s0 + 4 + q4;
        int c16s = c16; asm volatile("" : "+v"(c16s));
        int wvs = wv; asm volatile("" : "+s"(wvs));
        unsigned kA[64], kB[64];
#pragma unroll
        for (int i = 0; i < 64; ++i) { kA[i] = 0u; kB[i] = 0u; }
#pragma unroll
        for (int blk = 0; blk < 4; ++blk) if (nreg > blk * 16) {
#pragma unroll
            for (int ii = 0; ii < 16; ++ii) { const int i = blk * 16 + ii, tile = wvs + 8 * i;
                if (tile < ntiles) {
                    const bf16_t* kp = KIb + (size_t)(b * 8192 + tile * 16 + c16s) * 64 + 8 * q4;
                    const bf16x8 k0 = *(const bf16x8*)kp, k1 = *(const bf16x8*)(kp + 32);
                    f32x4 accA = (f32x4){0.f, 0.f, 0.f, 0.f}, accB = accA;
                    accA = __builtin_amdgcn_mfma_f32_16x16x32_bf16(a0A, k0, accA, 0, 0, 0);
                    accB = __builtin_amdgcn_mfma_f32_16x16x32_bf16(a0B, k0, accB, 0, 0, 0);
                    accA = __builtin_amdgcn_mfma_f32_16x16x32_bf16(a1A, k1, accA, 0, 0, 0);
                    accB = __builtin_amdgcn_mfma_f32_16x16x32_bf16(a1B, k1, accB, 0, 0, 0);
                    float sa = 0.f, sb = 0.f;
                    sa += wqA.x * fmaxf(accA[0], 0.f); sa += wqA.y * fmaxf(accA[1], 0.f); sa += wqA.z * fmaxf(accA[2], 0.f); sa += wqA.w * fmaxf(accA[3], 0.f);
                    sb += wqB.x * fmaxf(accB[0], 0.f); sb += wqB.y * fmaxf(accB[1], 0.f); sb += wqB.z * fmaxf(accB[2], 0.f); sb += wqB.w * fmaxf(accB[3], 0.f);
                    const int kidx = tile * 16 + c16s;
                    kA[i] = (kidx <= myqA) ? ordkey(sa) : 0u;
                    kB[i] = (kidx <= myqB) ? ordkey(sb) : 0u;
                }
                if ((ii & 3) == 3) asm volatile("" ::: "memory"); }
        }
        const int keffA = (myqA + 1 < 256) ? (myqA + 1) : 256, keffB = (myqB + 1 < 256) ? (myqB + 1) : 256;
        int par = 0;
        int mydone = 0, alldone = 0;
        int* sDone = sRed + 64;
        auto qsum = [&](int c) -> int {
            c += __builtin_amdgcn_update_dpp(0, c, 0xB1, 0xF, 0xF, false);
            c += __builtin_amdgcn_update_dpp(0, c, 0x4E, 0xF, 0xF, false);
            c += __builtin_amdgcn_update_dpp(0, c, 0x141, 0xF, 0xF, false);
            c += __builtin_amdgcn_update_dpp(0, c, 0x140, 0xF, 0xF, false);
            par ^= 1;
            if (c16 == 0) { sRed[par * 32 + wv * 4 + q4] = c; if (wv == 0) sDone[par * 4 + q4] = (mydone == 3) ? 1 : 0; }
            __syncthreads();
            int a = 0;
#pragma unroll
            for (int w = 0; w < 8; ++w) a += sRed[par * 32 + w * 4 + q4];
            alldone = sDone[par * 4] & sDone[par * 4 + 1] & sDone[par * 4 + 2] & sDone[par * 4 + 3];
            return a;
        };
        unsigned UA = 0u, UB = 0u;
        for (int bit = 31; bit >= 0; --bit) {
            const unsigned candA = UA | (1u << bit), candB = UB | (1u << bit);
            int ca = 0, cb = 0;
            if (!alldone) {
#pragma unroll
            for (int blk = 0; blk < 4; ++blk) if (nreg > blk * 16) {
#pragma unroll
                for (int ii = 0; ii < 16; ++ii) { ca += (kA[blk * 16 + ii] >= candA) ? 1 : 0; cb += (kB[blk * 16 + ii] >= candB) ? 1 : 0; }
            } }
            const int tot = qsum(ca | (cb << 16));
            if ((tot & 0xffff) >= keffA) { UA = candA; mydone = (mydone & 2) | (((tot & 0xffff) == keffA) ? 1 : 0); }
            if ((tot >> 16) >= keffB) { UB = candB; mydone = (mydone & 1) | (((tot >> 16) == keffB) ? 2 : 0); }
        }
        int cg = 0, ce = 0;
#pragma unroll
        for (int i = 0; i < 64; ++i) { cg += (kA[i] > UA) ? 1 : 0; ce += (kA[i] == UA) ? 1 : 0; cg += (kB[i] > UB) ? 65536 : 0; ce += (kB[i] == UB) ? 65536 : 0; }
        cg = qsum(cg); ce = qsum(ce);
        const int needA = keffA - (cg & 0xffff), needB = keffB - (cg >> 16);
        int JA = 8191, JB = 8191;
        par ^= 1;
        if (c16 == 0) sRed[par * 32 + wv * 4 + q4] = (((ce & 0xffff) > needA) || ((ce >> 16) > needB)) ? 1 : 0;
        __syncthreads();
        int anyov = 0;
#pragma unroll
        for (int w = 0; w < 32; ++w) anyov |= sRed[par * 32 + w];
        if (anyov) {
            JA = 0; JB = 0;
            int c16j = c16; asm volatile("" : "+v"(c16j));
            int wvj = wv; asm volatile("" : "+s"(wvj));
            for (int bit = 12; bit >= 0; --bit) {
                const int cjA = JA | (1 << bit), cjB = JB | (1 << bit);
                int c = 0;
#pragma unroll
                for (int i = 0; i < 64; ++i) { const int kidx = (wvj + 8 * i) * 16 + c16j; c += (kA[i] == UA && kidx < cjA) ? 1 : 0; c += (kB[i] == UB && kidx < cjB) ? 65536 : 0; }
                const int tot = qsum(c);
                if ((tot & 0xffff) <= needA - 1) JA = cjA;
                if ((tot >> 16) <= needB - 1) JB = cjB;
            }
        }
        unsigned short* sM = (unsigned short*)(g_smem + 1024);
        ((uint4*)sM)[tid] = make_uint4(0u, 0u, 0u, 0u);
        __syncthreads();
        int c16e = c16; asm volatile("" : "+v"(c16e));
        int wve = wv; asm volatile("" : "+s"(wve));
#pragma unroll
        for (int blk = 0; blk < 4; ++blk) if (nreg > blk * 16) {
#pragma unroll
            for (int ii = 0; ii < 16; ++ii) { const int i = blk * 16 + ii;
                const int tile = wve + 8 * i, kidx = tile * 16 + c16e;
                const bool selA = kA[i] > UA || (kA[i] == UA && kidx <= JA);
                const bool selB = kB[i] > UB || (kB[i] == UB && kidx <= JB);
                const unsigned long long balA = __ballot(selA), balB = __ballot(selB);
                if (c16 == 0) { sM[q4 * 512 + tile] = (unsigned short)((balA >> (16 * q4)) & 0xffffull);
                                sM[(4 + q4) * 512 + tile] = (unsigned short)((balB >> (16 * q4)) & 0xffffull); }
            }
        }
        __syncthreads();
        *(uint4*)(M16 + (size_t)(t0 + (tid >> 6)) * 512 + (tid & 63) * 8) = ((const uint4*)sM)[tid];
    }
}

PHASE_FN void ph_dsa_attn(const Params& p, float* smem) {
    unsigned char* ws_ = p.ws; asm volatile("" : "+s"(ws_));
    int tid_ = threadIdx.x; asm volatile("" : "+v"(tid_)); const int tid = tid_, lane = tid & 63, wv = tid >> 6, q4 = lane >> 4, c16 = lane & 15;
    int ldz_ = 0; asm volatile("" : "+s"(ldz_)); unsigned char* lds = g_smem + ldz_;
    const bf16_t* QBb = (const bf16_t*)(ws_ + OFF_QBB); const bf16_t* KBb = (const bf16_t*)(ws_ + OFF_KBB); const bf16_t* VT = (const bf16_t*)(ws_ + OFF_VT);
    const unsigned short* M16 = (const unsigned short*)(ws_ + OFF_M16);
    bf16_t* OB = (bf16_t*)(ws_ + OFF_OB);
    const float SC = SCALE128 * 1.4426950408889634f;
    for (int it = blockIdx.x; it < 256; it += gridDim.x) {
        const int bh = it & 7, jp = it >> 3, b = bh >> 2, h = bh & 3;
        for (int half = 0; half < 2; ++half) {
            const int jq = half ? jp : 63 - jp;
            const int qs = jq * 128, nkt = 2 * jq + 2;
            const int tq = b * 8192 + qs + wv * 16 + c16;
            bf16x8 qf[4];
#pragma unroll
            for (int a = 0; a < 4; ++a) qf[a] = *(const bf16x8*)(QBb + (size_t)tq * 512 + h * 128 + 8 * q4 + 32 * a);
            float m = -1e30f, lsum = 0.f;
            f32x4 oacc[8];
#pragma unroll
            for (int t = 0; t < 8; ++t) oacc[t] = (f32x4){0.f, 0.f, 0.f, 0.f};
            uint4 rk0, rk1, rv0, rv1;
            const int q0 = tid, q1 = tid + 512;
            const bf16_t* kg0 = KBb + (size_t)(b * 8192 + (q0 >> 4)) * 512 + h * 128 + (q0 & 15) * 8;
            const bf16_t* kg1 = KBb + (size_t)(b * 8192 + (q1 >> 4)) * 512 + h * 128 + (q1 & 15) * 8;
            const bf16_t* vg0 = VT + ((size_t)((b * 4 + h) * 128 + (q0 >> 3))) * 8192 + (q0 & 7) * 8;
            const bf16_t* vg1 = VT + ((size_t)((b * 4 + h) * 128 + (q1 >> 3))) * 8192 + (q1 & 7) * 8;
            const int lk0 = (q0 >> 4) * 256 + ((((q0 & 15)) ^ ((q0 >> 4) & 15)) << 4), lk1 = (q1 >> 4) * 256 + ((((q1 & 15)) ^ ((q1 >> 4) & 15)) << 4);
            const int lv0 = 16384 + (q0 >> 3) * 128 + ((((q0 & 7)) ^ ((q0 >> 3) & 7)) << 4), lv1 = 16384 + (q1 >> 3) * 128 + ((((q1 & 7)) ^ ((q1 >> 3) & 7)) << 4);
#define ATT_GLOAD(kt_) do { rk0 = *(const uint4*)(kg0 + (size_t)(kt_) * 64 * 512); rk1 = *(const uint4*)(kg1 + (size_t)(kt_) * 64 * 512); \
                            rv0 = *(const uint4*)(vg0 + (kt_) * 64); rv1 = *(const uint4*)(vg1 + (kt_) * 64); } while (0)
#define ATT_LSTORE(st_) do { unsigned char* base_ = lds + (st_) * 32768; *(uint4*)(base_ + lk0) = rk0; *(uint4*)(base_ + lk1) = rk1; *(uint4*)(base_ + lv0) = rv0; *(uint4*)(base_ + lv1) = rv1; } while (0)
            __syncthreads();
            ATT_GLOAD(0); ATT_LSTORE(0);
            __syncthreads();
            for (int kt = 0; kt < nkt; ++kt) {
                if (kt + 1 < nkt) ATT_GLOAD(kt + 1);
                const unsigned long long mbits = *(const unsigned long long*)(M16 + (size_t)tq * 512 + 4 * kt);
                const unsigned char* Kt = lds + (kt & 1) * 32768;
                const unsigned char* Vt = Kt + 16384;
                f32x4 sacc[4];
#pragma unroll
                for (int ti = 0; ti < 4; ++ti) { sacc[ti] = (f32x4){0.f, 0.f, 0.f, 0.f};
                    const int row = 16 * ti + c16;
#pragma unroll
                    for (int a = 0; a < 4; ++a) { const bf16x8 kf = *(const bf16x8*)(Kt + row * 256 + ((((q4 + 4 * a)) ^ (row & 15)) << 4));
                        sacc[ti] = __builtin_amdgcn_mfma_f32_16x16x32_bf16(kf, qf[a], sacc[ti], 0, 0, 0); } }
                float mx = m;
                unsigned m4[4];
#pragma unroll
                for (int ti = 0; ti < 4; ++ti) m4[ti] = (unsigned)(mbits >> (16 * ti + 4 * q4)) & 0xFu;
#pragma unroll
                for (int ti = 0; ti < 4; ++ti)
#pragma unroll
                    for (int r = 0; r < 4; ++r) { const bool valid = (m4[ti] >> r) & 1u; const float v = sacc[ti][r] * SC; sacc[ti][r] = v; mx = fmaxf(mx, valid ? v : -1e30f); }
                mx = fmaxf(mx, __shfl_xor(mx, 16)); mx = fmaxf(mx, __shfl_xor(mx, 32));
                const float alpha = __builtin_amdgcn_exp2f(m - mx); m = mx;
                float ps = 0.f;
#pragma unroll
                for (int ti = 0; ti < 4; ++ti)
#pragma unroll
                    for (int r = 0; r < 4; ++r) { const bool valid = (m4[ti] >> r) & 1u; const float pv = valid ? __builtin_amdgcn_exp2f(sacc[ti][r] - mx) : 0.f; sacc[ti][r] = pv; ps += pv; }
                lsum = lsum * alpha + ps;
#pragma unroll
                for (int t = 0; t < 8; ++t) oacc[t] = oacc[t] * alpha;
                bf16x8 pb[2];
#pragma unroll
                for (int a = 0; a < 2; ++a) {
                    union { uint4 u; bf16x8 v; } cv;
                    cv.u.x = cvt_pk_bf16(sacc[2 * a][0], sacc[2 * a][1]); cv.u.y = cvt_pk_bf16(sacc[2 * a][2], sacc[2 * a][3]);
                    cv.u.z = cvt_pk_bf16(sacc[2 * a + 1][0], sacc[2 * a + 1][1]); cv.u.w = cvt_pk_bf16(sacc[2 * a + 1][2], sacc[2 * a + 1][3]);
                    pb[a] = cv.v; }
#pragma unroll
                for (int t = 0; t < 8; ++t) { const int row = 16 * t + c16;
#pragma unroll
                    for (int a = 0; a < 2; ++a) {
                        union { uint2 h2[2]; bf16x8 v; } vf;
                        vf.h2[0] = *(const uint2*)(Vt + row * 128 + ((((4 * a + (q4 >> 1))) ^ (row & 7)) << 4) + 8 * (q4 & 1));
                        vf.h2[1] = *(const uint2*)(Vt + row * 128 + ((((4 * a + 2 + (q4 >> 1))) ^ (row & 7)) << 4) + 8 * (q4 & 1));
                        oacc[t] = __builtin_amdgcn_mfma_f32_16x16x32_bf16(vf.v, pb[a], oacc[t], 0, 0, 0); } }
                if (kt + 1 < nkt) ATT_LSTORE((kt + 1) & 1);
                __syncthreads();
            }
            lsum += __shfl_xor(lsum, 16); lsum += __shfl_xor(lsum, 32);
            const float inv = 1.f / lsum;
#pragma unroll
            for (int t = 0; t < 8; ++t) *(uint2*)(OB + (size_t)tq * 1024 + 512 + h * 128 + 16 * t + 4 * q4) = pack4(oacc[t] * inv);
        }
    }
}

PHASE_FN void ph_gdn_out(const Params& p, int layer) {
    unsigned char* ws_ = p.ws; asm volatile("" : "+s"(ws_));
    int tid_ = threadIdx.x; asm volatile("" : "+v"(tid_)); const int tid = tid_, lane = tid & 63, wv = tid >> 6;
    const float* O = (const float*)(ws_ + OFF_O); const bf16_t* P = (const bf16_t*)(ws_ + OFF_P); bf16_t* OB = (bf16_t*)(ws_ + OFF_OB);
    const float* onw = p.gdn_out_norm + (layer >> 1) * 128;
    for (int t = blockIdx.x * 8 + wv; t < NT; t += gridDim.x * 8) {
#pragma unroll
        for (int h = 0; h < 4; ++h) {
            const float* op = O + (size_t)t * 1024 + h * 128; bf16_t* ob = OB + (size_t)t * 1024 + h * 128;
            const float o0 = op[lane], o1 = op[64 + lane];
            const float ss = wave_sum(o0 * o0 + o1 * o1);
            const float r = rsqrtf(ss * (1.f / 128.f) + EPS);
            const float z0 = PBF(P, t, 1536 + h * 128 + lane), z1 = PBF(P, t, 1536 + h * 128 + 64 + lane);
            ob[lane] = f2bf(o0 * r * onw[lane] * siluf_(z0)); ob[64 + lane] = f2bf(o1 * r * onw[64 + lane] * siluf_(z1));
        }
    }
}

PHASE_FN void ph_gemm_out(const Params& p, int layer, float* smem) {
    unsigned char* ws_ = p.ws; asm volatile("" : "+s"(ws_));
    { int ldz_ = 0; asm volatile("" : "+s"(ldz_)); smem = (float*)(g_smem + ldz_); }
    const bf16_t* Wt = (const bf16_t*)(ws_ + OFF_WOUT) + (size_t)layer * 1024 * 1024;
    const float* MOD = (const float*)(ws_ + OFF_MOD);
    const bf16_t* O = (const bf16_t*)(ws_ + OFF_OB);
    const int vb_ = ((int)blockIdx.x & 7) * ((int)gridDim.x >> 3) + ((int)blockIdx.x >> 3);
    for (int tile = vb_; tile < 64 * 8; tile += gridDim.x) {
        const int mt = (tile >> 6) * 8 + (tile & 7), nt = (tile >> 3) & 7;
        const bf16_t* Ab = O + (size_t)mt * 256 * 1024;
        const bf16_t* Bb = Wt + (size_t)nt * 128 * 1024;
        const int b = (mt * 256) >> 13;
        const float* gt = MOD + (size_t)(layer * 2 + b) * 6144 + 2048 + nt * 128;
        float* Xt = p.X + (size_t)mt * 256 * ND + nt * 128;
        const float* Xr = ((layer == 0) ? p.x : (const float*)p.X) + (size_t)mt * 256 * ND + nt * 128;
        gemm_tile_bf16(1024, (unsigned char*)smem,
            [=](int i, int r, int k) -> uint4 { return *(const uint4*)(Ab + (size_t)r * 1024 + k); },
            [=](int i, int r, int k) -> uint4 { return *(const uint4*)(Bb + (size_t)r * 1024 + k); },
            [=](const f32x4 (&acc)[4][4], int wm, int wn, int lane) {
#pragma unroll
                for (int mi = 0; mi < 4; ++mi)
#pragma unroll
                    for (int ni = 0; ni < 4; ++ni) {
                        const int m = wm * 64 + mi * 16 + (lane & 15), n = wn * 64 + ni * 16 + 4 * (lane >> 4);
                        const f32x4 g = *(const f32x4*)(gt + n);
                        *(f32x4*)(Xt + (size_t)m * ND + n) = *(const f32x4*)(Xr + (size_t)m * ND + n) + g * acc[mi][ni];
                    }
            });
    }
}

PHASE_FN void ph_norm_ffn(const Params& p, int layer) {
    unsigned char* ws_ = p.ws; asm volatile("" : "+s"(ws_));
    int tid_ = threadIdx.x; asm volatile("" : "+v"(tid_)); const int tid = tid_, lane = tid & 63, wv = tid >> 6;
    const float* MOD = (const float*)(ws_ + OFF_MOD);
    bf16_t* H = (bf16_t*)(ws_ + OFF_H);
    int* CNT = (int*)(ws_ + OFF_CNT) + layer * 32 * CSTR;
    int* sCnt = (int*)g_smem; int* sBase = sCnt + 32; int* sE = sBase + 32; int* sR = sE + 256;
    const int nrb = (NT + (int)gridDim.x - 1) / (int)gridDim.x, row_lo = blockIdx.x * nrb, row_hi = (row_lo + nrb < NT) ? row_lo + nrb : NT;
    __syncthreads();
    if (tid < 32) sCnt[tid] = 0;
    __syncthreads();
    int* ASG = (int*)(ws_ + OFF_ASG); float* GATE = (float*)(ws_ + OFF_GATE); int* LIST = (int*)(ws_ + OFF_LIST);
    const float* nw = p.norm_ffn + layer * 1024;
    const float* wg = p.rg_w + (size_t)layer * 1024 * 4;
    for (int row = row_lo + wv; row < row_hi; row += 8) {
        const int b = row >> 13;
        const float* xr = p.X + (size_t)row * ND;
        const float* sh = MOD + (size_t)(layer * 2 + b) * 6144 + 3072;
        const float* sc = sh + 1024;
        float hv[16]; float ss = 0.f;
#pragma unroll
        for (int j = 0; j < 4; ++j) { const float4 v = *(const float4*)(xr + j * 256 + lane * 4); hv[4 * j] = v.x; hv[4 * j + 1] = v.y; hv[4 * j + 2] = v.z; hv[4 * j + 3] = v.w; }
#pragma unroll
        for (int j = 0; j < 16; ++j) ss += hv[j] * hv[j];
        ss = wave_sum(ss);
        const float rstd = rsqrtf(ss * (1.f / 1024.f) + EPS);
#pragma unroll
        for (int j = 0; j < 4; ++j) {
            const int col = j * 256 + lane * 4;
            const float4 w = *(const float4*)(nw + col), s4 = *(const float4*)(sc + col), h4 = *(const float4*)(sh + col);
            hv[4 * j] = hv[4 * j] * rstd * w.x * (1.f + s4.x) + h4.x; hv[4 * j + 1] = hv[4 * j + 1] * rstd * w.y * (1.f + s4.y) + h4.y;
            hv[4 * j + 2] = hv[4 * j + 2] * rstd * w.z * (1.f + s4.z) + h4.z; hv[4 * j + 3] = hv[4 * j + 3] * rstd * w.w * (1.f + s4.w) + h4.w;
            { f32x4 ov; ov[0] = hv[4 * j]; ov[1] = hv[4 * j + 1]; ov[2] = hv[4 * j + 2]; ov[3] = hv[4 * j + 3]; *(uint2*)(H + (size_t)row * ND + col) = pack4(ov); }
        }
        float gl[4] = {0.f, 0.f, 0.f, 0.f};
#pragma unroll
        for (int j = 0; j < 4; ++j)
#pragma unroll
            for (int e = 0; e < 4; ++e) { const int col = j * 256 + lane * 4 + e; const float4 w = *(const float4*)(wg + (size_t)col * 4); const float hh = hv[4 * j + e];
                gl[0] += hh * w.x; gl[1] += hh * w.y; gl[2] += hh * w.z; gl[3] += hh * w.w; }
#pragma unroll
        for (int g = 0; g < 4; ++g) gl[g] = wave_sum(gl[g]) + p.rg_b[layer * 4 + g];
        int gs = 0; float gm = gl[0];
#pragma unroll
        for (int g = 1; g < 4; ++g) if (gl[g] > gm) { gm = gl[g]; gs = g; }
        float gsum = 0.f;
#pragma unroll
        for (int g = 0; g < 4; ++g) gsum += expf(gl[g] - gm);
        const float ggate = 1.f / gsum;
        const float* we = p.re_w + ((size_t)(layer * 4 + gs) * 1024) * 8;
        float el[8] = {0.f, 0.f, 0.f, 0.f, 0.f, 0.f, 0.f, 0.f};
#pragma unroll
        for (int j = 0; j < 4; ++j)
#pragma unroll
            for (int e = 0; e < 4; ++e) { const int col = j * 256 + lane * 4 + e; const float4 w0 = *(const float4*)(we + (size_t)col * 8), w1 = *(const float4*)(we + (size_t)col * 8 + 4); const float hh = hv[4 * j + e];
                el[0] += hh * w0.x; el[1] += hh * w0.y; el[2] += hh * w0.z; el[3] += hh * w0.w; el[4] += hh * w1.x; el[5] += hh * w1.y; el[6] += hh * w1.z; el[7] += hh * w1.w; }
#pragma unroll
        for (int e = 0; e < 8; ++e) el[e] = wave_sum(el[e]) + p.re_b[(layer * 4 + gs) * 8 + e];
        int i1 = 0; float l1 = el[0];
#pragma unroll
        for (int e = 1; e < 8; ++e) if (el[e] > l1) { l1 = el[e]; i1 = e; }
        int i2 = -1; float l2 = -INFINITY;
#pragma unroll
        for (int e = 0; e < 8; ++e) if (e != i1 && el[e] > l2) { l2 = el[e]; i2 = e; }
        const float ex = expf(l2 - l1);
        const float p1 = 1.f / (1.f + ex), p2 = ex / (1.f + ex);
        if (lane == 0) {
            const int e1 = gs * 8 + i1, e2 = gs * 8 + i2, lr = row - row_lo;
            sE[lr * 2] = e1; sE[lr * 2 + 1] = e2;
            sR[lr * 2] = atomicAdd(&sCnt[e1], 1); sR[lr * 2 + 1] = atomicAdd(&sCnt[e2], 1);
            GATE[row * 2] = ggate * p1; GATE[row * 2 + 1] = ggate * p2;
        }
    }
    __syncthreads();
    if (tid < 32) sBase[tid] = (sCnt[tid] > 0) ? atomicAdd(&CNT[tid * CSTR], sCnt[tid]) : 0;
    __syncthreads();
    for (int a = tid; a < (row_hi - row_lo) * 2; a += NTHREADS) {
        const int row = row_lo + (a >> 1), e = sE[a], r = sBase[e] + sR[a];
        LIST[(size_t)e * LISTCAP + r] = row;
        ASG[row * 4 + (a & 1) * 2] = e; ASG[row * 4 + (a & 1) * 2 + 1] = r;
    }
}

PHASE_FN void ph_moe(const Params& p, int layer, int which, float* smem) {
    unsigned char* ws_ = p.ws; asm volatile("" : "+s"(ws_));
    { int ldz_ = 0; asm volatile("" : "+s"(ldz_)); smem = (float*)(g_smem + ldz_); }
    int tid_ = threadIdx.x; asm volatile("" : "+v"(tid_)); const int tid = tid_;
    int* sPad = (int*)((unsigned char*)smem + 98304); int* sTs = sPad + 33;
    const int* CNT = (const int*)(ws_ + OFF_CNT) + layer * 32 * CSTR;
    __syncthreads();
    if (tid == 0) { int a = 0, ts = 0; for (int e = 0; e < 32; ++e) { sPad[e] = a; sTs[e] = ts; a += ((CNT[e * CSTR] + 127) / 128) * 128; ts += (CNT[e * CSTR] + 255) / 256; } sTs[32] = ts; sPad[32] = a; }
    __syncthreads();
    const int total = sTs[32] * 8;
    bf16_t* HID = (bf16_t*)(ws_ + OFF_HID); bf16_t* YB = (bf16_t*)(ws_ + OFF_YB);
    const bf16_t* H = (const bf16_t*)(ws_ + OFF_H);
    const int* LIST = (const int*)(ws_ + OFF_LIST);
    const int vb_ = ((int)blockIdx.x & 7) * ((int)gridDim.x >> 3) + ((int)blockIdx.x >> 3);
    for (int tile = vb_; tile < total; tile += gridDim.x) {
        const int mt = tile >> 3, nt = tile & 7;
        int e = 0;
        for (int q = 1; q < 32; ++q) if (sTs[q] <= mt) e = q;
        const int mi0 = mt - sTs[e];
        const int cnt = CNT[e * CSTR];
        const int mvalid = (cnt - mi0 * 256 < 256) ? (cnt - mi0 * 256) : 256;
        const int rowbase = sPad[e] + mi0 * 256;
        if (which == 0) {
            long ro[4];
#pragma unroll
            for (int i = 0; i < 4; ++i) { const int r = (tid + 512 * i) >> 3; ro[i] = (r < mvalid) ? (long)LIST[(size_t)e * LISTCAP + mi0 * 256 + r] * 1024 : -1; }
            const long ro0 = ro[0], ro1 = ro[1], ro2 = ro[2], ro3 = ro[3];
            const bf16_t* Bb = (const bf16_t*)(ws_ + OFF_W13) + (size_t)e * 1024 * 1024 + (size_t)nt * 128 * 1024;
            bf16_t* Ht = HID + (size_t)rowbase * 512 + nt * 64;
            gemm_tile_bf16(1024, (unsigned char*)smem,
                [=](int i, int r, int k) -> uint4 { const long o = (i == 0) ? ro0 : (i == 1) ? ro1 : (i == 2) ? ro2 : ro3; if (o < 0) return make_uint4(0u, 0u, 0u, 0u);
                    return *(const uint4*)(H + o + k); },
                [=](int i, int r, int k) -> uint4 { return *(const uint4*)(Bb + (size_t)r * 1024 + k); },
                [=](const f32x4 (&acc)[4][4], int wm, int wn, int lane) {
#pragma unroll
                    for (int mi = 0; mi < 4; ++mi)
#pragma unroll
                        for (int ni = 0; ni < 2; ++ni) {
                            const int m = wm * 64 + mi * 16 + (lane & 15), n = wn * 32 + ni * 16 + 4 * (lane >> 4);
                            const f32x4 a1 = acc[mi][ni], a3 = acc[mi][ni + 2];
                            f32x4 hv; hv[0] = siluf_(a1[0]) * a3[0]; hv[1] = siluf_(a1[1]) * a3[1]; hv[2] = siluf_(a1[2]) * a3[2]; hv[3] = siluf_(a1[3]) * a3[3];
                            if (m < mvalid) *(uint2*)(Ht + (size_t)m * 512 + n) = pack4(hv);
                        }
                }, mvalid);
        } else {
            const bf16_t* Ab = HID + (size_t)rowbase * 512;
            const bf16_t* Bb = (const bf16_t*)(ws_ + OFF_W2T) + (size_t)e * 1024 * 512 + (size_t)nt * 128 * 512;
            bf16_t* Yt = YB + (size_t)rowbase * 1024 + nt * 128;
            gemm_tile_bf16(512, (unsigned char*)smem,
                [=](int i, int r, int k) -> uint4 { if (r >= mvalid) return make_uint4(0u, 0u, 0u, 0u); return *(const uint4*)(Ab + (size_t)r * 512 + k); },
                [=](int i, int r, int k) -> uint4 { return *(const uint4*)(Bb + (size_t)r * 512 + k); },
                [=](const f32x4 (&acc)[4][4], int wm, int wn, int lane) {
#pragma unroll
                    for (int mi = 0; mi < 4; ++mi)
#pragma unroll
                        for (int ni = 0; ni < 4; ++ni) {
                            const int m = wm * 64 + mi * 16 + (lane & 15), n = wn * 64 + ni * 16 + 4 * (lane >> 4);
                            if (m < mvalid) *(uint2*)(Yt + (size_t)m * 1024 + n) = pack4(acc[mi][ni]);
                        }
                }, mvalid);
        }
    }
}

PHASE_FN void ph_conv_dense(const Params& p, float* smem) {
    unsigned char* ws_ = p.ws; asm volatile("" : "+s"(ws_));
    { int ldz_ = 0; asm volatile("" : "+s"(ldz_)); smem = (float*)(g_smem + ldz_); }
    auto dec = [&](int t, const float*& s0, const float*& s1, bf16_t*& dst, int& mode, int& K, int& N, int& ld, int& rt, int& kt) {
        s1 = nullptr; mode = 0; K = 1024;
        if (t >= 4608) t = 4607;
        if (t < 1984) { const int l = t / 992, u = t % 992; s0 = p.even_w_in + (size_t)l * 1024 * 3916; N = 3916; ld = 3916; dst = (bf16_t*)(ws_ + OFF_WINE) + (size_t)l * 3968 * 1024; rt = u >> 4; kt = u & 15; }
        else if (t < 3584) { const int v = t - 1984, l = v / 800, u = v % 800; s0 = p.gla_w_in + (size_t)l * 1024 * 3088; N = 3088; ld = 3088; dst = (bf16_t*)(ws_ + OFF_WINO) + (size_t)l * 3200 * 1024; rt = u >> 4; kt = u & 15; }
        else { const int v = t - 3584, l = v >> 8, u = v & 255; s0 = ((l & 1) ? p.gla_w_out : p.even_w_out) + (size_t)(l >> 1) * 1024 * 1024; N = 1024; ld = 1024; dst = (bf16_t*)(ws_ + OFF_WOUT) + (size_t)l * 1024 * 1024; rt = u >> 4; kt = u & 15; }
    };
    for (int t = blockIdx.x * 4; t < 4608; t += gridDim.x * 4) convert_tiles4(dec, t, (4608 - t < 4) ? (4608 - t) : 4, smem);
}

PHASE_FN void ph_conv_exp(const Params& p, int layer, float* smem, int first_blk) {
    unsigned char* ws_ = p.ws; asm volatile("" : "+s"(ws_));
    { int ldz_ = 0; asm volatile("" : "+s"(ldz_)); smem = (float*)(g_smem + ldz_); }
    if ((int)blockIdx.x < first_blk) return;
    auto dec = [&](int t, const float*& s0, const float*& s1, bf16_t*& dst, int& mode, int& K, int& N, int& ld, int& rt, int& kt) {
        if (t >= 12288) t = 12287;
        if (t < 8192) { const int e = t >> 8, u = t & 255; s0 = p.w1 + (size_t)(layer * 32 + e) * 1024 * 512; s1 = p.w3 + (size_t)(layer * 32 + e) * 1024 * 512; mode = 1; K = 1024; N = 512; ld = 512;
            dst = (bf16_t*)(ws_ + OFF_W13) + (size_t)e * 1024 * 1024; rt = u >> 4; kt = u & 15; }
        else { const int v = t - 8192, e = v >> 7, u = v & 127; s0 = p.w2 + (size_t)(layer * 32 + e) * 512 * 1024; s1 = nullptr; mode = 0; K = 512; N = 1024; ld = 1024;
            dst = (bf16_t*)(ws_ + OFF_W2T) + (size_t)e * 1024 * 512; rt = u >> 3; kt = u & 7; }
    };
    const int nb = (int)gridDim.x - first_blk;
    for (int t = ((int)blockIdx.x - first_blk) * 4; t < 12288; t += nb * 4) convert_tiles4(dec, t, (12288 - t < 4) ? (12288 - t) : 4, smem);
}

PHASE_FN void ph_gla_tok(const Params& p, int layer) {
    unsigned char* ws_ = p.ws; asm volatile("" : "+s"(ws_));
    int tid_ = threadIdx.x; asm volatile("" : "+v"(tid_)); const int tid = tid_, lane = tid & 63, wv = tid >> 6, li = layer >> 1;
    const float* AUX = (const float*)(ws_ + OFF_AUX);
    float* LA = (float*)(ws_ + OFF_LA);
    const float* w2 = p.gla_w_gate2 + (size_t)li * 16 * 512; const float* b2 = p.gla_b_gate2 + li * 512;
    for (int t = blockIdx.x * 8 + wv; t < NT; t += gridDim.x * 8) {
        float glr[16];
#pragma unroll
        for (int r = 0; r < 16; ++r) glr[r] = AUX[(size_t)t * 16 + r];
#pragma unroll 1
        for (int i = 0; i < 8; ++i) {
            const int c = lane + 64 * i; float z = b2[c];
#pragma unroll
            for (int r = 0; r < 16; ++r) z += glr[r] * w2[r * 512 + c];
            LA[(size_t)t * 512 + c] = -softplusf_(-z) * (1.f / 16.f);
        }
    }
}

PHASE_FN void ph_gla_chunk(const Params& p, int layer, float* smem) {
    unsigned char* ws_ = p.ws; asm volatile("" : "+s"(ws_));
    int tid_ = threadIdx.x; asm volatile("" : "+v"(tid_)); const int tid = tid_, lane = tid & 63, wv = __builtin_amdgcn_readfirstlane(tid >> 6), q4 = lane >> 4, c16 = lane & 15;
    int ldz_ = 0; asm volatile("" : "+s"(ldz_)); unsigned char* lds = g_smem + ldz_;
    constexpr int SN = 272, ST = 144;
    float* sBc = (float*)lds;
    unsigned char* bQE = lds + 33024;
    unsigned char* bKE = lds + 50432;
    unsigned char* bKD = lds + 67840;
    unsigned char* bVT = lds + 86272;
    unsigned char* bATT = lds + 123136;
    const bf16_t* P = (const bf16_t*)(ws_ + OFF_P); const float* AUX = (const float*)(ws_ + OFF_AUX);
    const float* w2 = p.gla_w_gate2 + (size_t)(layer >> 1) * 16 * 512; const float* b2 = p.gla_b_gate2 + (layer >> 1) * 512;
    float* sGlr = (float*)(lds + 132352);
    uint4* QEF = (uint4*)(ws_ + OFF_GQE); uint2* OIF = (uint2*)(ws_ + OFF_GOI); uint2* HF = (uint2*)(ws_ + OFF_GH); float* EBL = (float*)(ws_ + OFF_GEBL);
    for (int ci = blockIdx.x; ci < 1024; ci += gridDim.x) {
        const int b = ci >> 9, h = (ci >> 7) & 3, n = ci & 127;
        const int t0 = b * 8192 + n * 64;
        __syncthreads();
        for (int e = tid; e < 1024; e += NTHREADS) sGlr[e] = AUX[(size_t)(t0 + (e >> 4)) * 16 + (e & 15)];
        __syncthreads();
        {
            const int d = tid & 127, c = h * 128 + d;
            float wg[16];
#pragma unroll
            for (int r = 0; r < 16; ++r) wg[r] = w2[r * 512 + c];
            const float bz = b2[c];
            for (int i = tid >> 7; i < 64; i += 4) {
                float z = bz;
#pragma unroll
                for (int r = 0; r < 16; ++r) z += sGlr[i * 16 + r] * wg[r];
                sBc[i * 129 + d] = -softplusf_(-z) * (1.f / 16.f);
            }
        }
        for (int e = tid; e < 64 * 36; e += NTHREADS) ((unsigned*)bATT)[e] = 0u;
        __syncthreads();
        if (tid < 128) { float a = 0.f; for (int i = 0; i < 64; ++i) { a += sBc[i * 129 + tid]; sBc[i * 129 + tid] = a; } }
        __syncthreads();
        for (int e = tid; e < 8192; e += NTHREADS) {
            const int i = e >> 7, d = e & 127;
            const float bb = sBc[i * 129 + d], bl = sBc[63 * 129 + d];
            const float qf = PBF(P, t0 + i, h * 128 + d), kf = PBF(P, t0 + i, 512 + h * 128 + d);
            *(bf16_t*)(bQE + i * SN + d * 2) = f2bf(qf * SCALE128 * expf(bb));
            *(bf16_t*)(bKE + i * SN + d * 2) = f2bf(kf * expf(-bb));
            *(bf16_t*)(bKD + d * ST + i * 2) = f2bf(kf * expf(bl - bb));
        }
        for (int e = tid; e < 16384; e += NTHREADS) { const int i = e >> 8, dv = e & 255; *(bf16_t*)(bVT + dv * ST + i * 2) = P[(size_t)(t0 + i) * LDPB + 1024 + h * 256 + dv]; }
        if (tid < 128) EBL[ci * 128 + tid] = expf(sBc[63 * 129 + tid]);
        __syncthreads();
        for (int u = wv; u < 10; u += 8) {
            const int ti = (u >= 6) ? 3 : (u >= 3) ? 2 : (u >= 1) ? 1 : 0, tj = u - ((ti * (ti + 1)) >> 1);
            f32x4 acc = (f32x4){0.f, 0.f, 0.f, 0.f};
            acc = mma_lds(bQE, SN, 16 * ti, bKE, SN, 16 * tj, 128, acc, c16, q4);
            const int j = 16 * tj + c16;
#pragma unroll
            for (int r = 0; r < 4; ++r) { const int i = 16 * ti + 4 * q4 + r; *(bf16_t*)(bATT + i * ST + j * 2) = f2bf((j <= i) ? acc[r] : 0.f); }
        }
        for (int x = 0; x < 2; ++x) {
            const int u = wv * 2 + x, ti = u >> 2, a = u & 3;
            const unsigned char* rp = bQE + (16 * ti + c16) * SN;
            const uint2 lo = *(const uint2*)(rp + (32 * a + 4 * q4) * 2), hi = *(const uint2*)(rp + (32 * a + 16 + 4 * q4) * 2);
            QEF[((size_t)(ci * 4 + ti) * 4 + a) * 64 + lane] = make_uint4(lo.x, lo.y, hi.x, hi.y);
        }
        __syncthreads();
        for (int x = 0; x < 8; ++x) {
            const int u = wv * 8 + x, tdv = u >> 2, ti = u & 3;
            f32x4 acc = (f32x4){0.f, 0.f, 0.f, 0.f};
            acc = mma_lds(bATT, ST, 16 * ti, bVT, ST, 16 * tdv, 64, acc, c16, q4);
            OIF[((size_t)(ci * 16 + tdv) * 4 + ti) * 64 + lane] = pack4(acc);
        }
        for (int x = 0; x < 16; ++x) {
            const int u = wv * 16 + x, tdv = u >> 3, tdk = u & 7;
            f32x4 acc = (f32x4){0.f, 0.f, 0.f, 0.f};
            acc = mma_lds(bKD, ST, 16 * tdk, bVT, ST, 16 * tdv, 64, acc, c16, q4);
            HF[((size_t)(ci * 16 + tdv) * 8 + tdk) * 64 + lane] = pack4(acc);
        }
    }
}

PHASE_FN void ph_gla_scan(const Params& p, float* smem) {
    unsigned char* ws_ = p.ws; asm volatile("" : "+s"(ws_));
    int tid_ = threadIdx.x; asm volatile("" : "+v"(tid_)); const int tid = tid_, lane = tid & 63, wv = __builtin_amdgcn_readfirstlane(tid >> 6), q4 = lane >> 4, c16 = lane & 15;
    int ldz_ = 0; asm volatile("" : "+s"(ldz_)); unsigned char* lds = g_smem + ldz_;
    constexpr int STG = 29184;
    const unsigned char* QEF = ws_ + OFF_GQE; const unsigned char* HF = ws_ + OFF_GH; const unsigned char* OIF = ws_ + OFF_GOI; const unsigned char* EBL = ws_ + OFF_GEBL;
    float* O = (float*)(ws_ + OFF_O);
    for (int it = blockIdx.x; it < 64; it += gridDim.x) {
        const int bh = it >> 3, pair = it & 7, b = bh >> 2, h = bh & 3;
        __syncthreads();
        if (wv >= 2) {
            const int lt = tid - 128;
            const unsigned char* Qb = QEF + (size_t)bh * 128 * 16384;
            const unsigned char* Hb = HF + (size_t)bh * 128 * 65536 + pair * 8192;
            const unsigned char* Ob = OIF + (size_t)bh * 128 * 32768 + pair * 4096;
            const unsigned char* Lb = EBL + (size_t)bh * 128 * 512;
            uint4 ra0, ra1, ra2, ra3, ra4, ra5, ra6, rb0, rb1, rb2, rb3, rb4, rb5, rb6, rc0, rc1, rc2, rc3, rc4, rc5, rc6, rd0, rd1, rd2, rd3, rd4, rd5, rd6;
#define GL_LOAD(X, n_) do { const unsigned char* q_ = Qb + (size_t)(n_) * 16384; const unsigned char* h_ = Hb + (size_t)(n_) * 65536; \
                const unsigned char* o_ = Ob + (size_t)(n_) * 32768; const unsigned char* l_ = Lb + (size_t)(n_) * 512; \
                X##0 = LDC(q_, lt, 1023); X##1 = LDC(q_, lt + 384, 1023); X##2 = LDC(q_, lt + 768, 1023); \
                X##3 = LDC(h_, lt, 511); X##4 = LDC(h_, lt + 384, 511); X##5 = LDC(o_, lt, 255); X##6 = LDC(l_, lt, 31); } while (0)
#define GL_STORE(X, st_) do { unsigned char* sb_ = lds + (st_) * STG; \
                STC(0, lt, 1024, X##0); STC(0, lt + 384, 1024, X##1); STC(0, lt + 768, 1024, X##2); \
                STC(16384, lt, 512, X##3); STC(16384, lt + 384, 512, X##4); STC(24576, lt, 256, X##5); STC(28672, lt, 32, X##6); } while (0)
            GL_LOAD(ra, 0); GL_STORE(ra, 0);
            GL_LOAD(rb, 1); GL_LOAD(rc, 2); GL_LOAD(rd, 3); GL_LOAD(ra, 4);
            __syncthreads();
            for (int n = 0; n < 128; n += 4) {
                GL_STORE(rb, 1); GL_LOAD(rb, CLAMPN(n + 5)); __syncthreads();
                GL_STORE(rc, 0); GL_LOAD(rc, CLAMPN(n + 6)); __syncthreads();
                GL_STORE(rd, 1); GL_LOAD(rd, CLAMPN(n + 7)); __syncthreads();
                if (n + 4 < 128) GL_STORE(ra, 0);
                GL_LOAD(ra, CLAMPN(n + 8)); __syncthreads();
            }
        } else {
            const int tdv = pair * 2 + wv;
            f32x4 S[8];
#pragma unroll
            for (int t = 0; t < 8; ++t) S[t] = (f32x4){0.f, 0.f, 0.f, 0.f};
            __syncthreads();
            for (int n = 0; n < 128; ++n) {
                const unsigned char* base = lds + (n & 1) * STG;
                const unsigned char* Qf = base + lane * 16, *Hf = base + 16384 + wv * 4096 + lane * 8, *Of = base + 24576 + wv * 2048 + lane * 8, *Lf = base + 28672 + q4 * 16;
                bf16x8 Sb[4];
#pragma unroll
                for (int a = 0; a < 4; ++a) { union { uint4 u; bf16x8 v; } cv; const uint2 lo = pack4(S[2 * a]), hi = pack4(S[2 * a + 1]); cv.u.x = lo.x; cv.u.y = lo.y; cv.u.z = hi.x; cv.u.w = hi.y; Sb[a] = cv.v; }
                const int t0 = b * 8192 + n * 64;
                f32x4 oa[4];
#pragma unroll
                for (int ti = 0; ti < 4; ++ti) oa[ti] = unpack4(*(const uint2*)(Of + ti * 512));
#pragma unroll
                for (int a = 0; a < 4; ++a)
#pragma unroll
                    for (int ti = 0; ti < 4; ++ti) oa[ti] = __builtin_amdgcn_mfma_f32_16x16x32_bf16(*(const bf16x8*)(Qf + (ti * 4 + a) * 1024), Sb[a], oa[ti], 0, 0, 0);
#pragma unroll
                for (int ti = 0; ti < 4; ++ti) {
                    float* op = O + (size_t)(t0 + 16 * ti + 4 * q4) * 1024 + h * 256 + 16 * tdv + c16;
                    op[0] = oa[ti][0]; op[1024] = oa[ti][1]; op[2048] = oa[ti][2]; op[3072] = oa[ti][3]; }
#pragma unroll
                for (int t = 0; t < 8; ++t) { const f32x4 lam = *(const f32x4*)(Lf + t * 64); S[t] = S[t] * lam + unpack4(*(const uint2*)(Hf + t * 512)); }
                __syncthreads();
            }
        }
    }
}

PHASE_FN void ph_gla_out(const Params& p, int layer) {
    unsigned char* ws_ = p.ws; asm volatile("" : "+s"(ws_));
    int tid_ = threadIdx.x; asm volatile("" : "+v"(tid_)); const int tid = tid_, lane = tid & 63, wv = tid >> 6;
    const float* O = (const float*)(ws_ + OFF_O); const bf16_t* P = (const bf16_t*)(ws_ + OFF_P); bf16_t* OB = (bf16_t*)(ws_ + OFF_OB);
    const float* onw = p.gla_out_norm + (layer >> 1) * 256;
    for (int t = blockIdx.x * 8 + wv; t < NT; t += gridDim.x * 8) {
#pragma unroll
        for (int h = 0; h < 4; ++h) {
            const float* op = O + (size_t)t * 1024 + h * 256;
            const float4 o = *(const float4*)(op + lane * 4);
            const float ss = wave_sum(o.x * o.x + o.y * o.y + o.z * o.z + o.w * o.w);
            const float r = rsqrtf(ss * (1.f / 256.f) + EPS);
            const f32x4 z = unpack4(*(const uint2*)(P + (size_t)t * LDPB + 2048 + h * 256 + lane * 4));
            const float4 w = *(const float4*)(onw + lane * 4);
            f32x4 ov; ov[0] = o.x * r * w.x * siluf_(z[0]); ov[1] = o.y * r * w.y * siluf_(z[1]); ov[2] = o.z * r * w.z * siluf_(z[2]); ov[3] = o.w * r * w.w * siluf_(z[3]);
            *(uint2*)(OB + (size_t)t * 1024 + h * 256 + lane * 4) = pack4(ov);
        }
    }
}

template <int PH>
__device__ __forceinline__ void run_phase(const Params& p, int layer, float* smem) {
    if (PH == PH_PROLOGUE) { ph_prologue(p, smem); ph_conv_dense(p, smem); }
    else if (PH == PH_NORM_MIX) ph_rows(p, layer, 0, smem);
    else if (PH == PH_GEMM_IN_EVEN) ph_gemm_in(p, layer, true, smem);
    else if (PH == PH_EVEN_TOK) { ph_even_tok(p, layer, smem); ph_gdn_chunk(p, layer, smem); }
    else if (PH == PH_GDN_CHUNK) ph_gdn_chunk(p, layer, smem);
    else if (PH == PH_GDN_SCAN) { ph_gdn_scan(p, smem); ph_conv_exp(p, layer, smem, 32); ph_dsa_topk(p, layer, smem); }
    else if (PH == PH_DSA_TOPK) ph_dsa_topk(p, layer, smem);
    else if (PH == PH_DSA_ATTN) { ph_dsa_attn(p, smem); ph_gdn_out(p, layer); }
    else if (PH == PH_GDN_OUT) ph_gdn_out(p, layer);
    else if (PH == PH_GEMM_OUT) ph_gemm_out(p, layer, smem);
    else if (PH == PH_NORM_FFN) ph_norm_ffn(p, layer);
    else if (PH == PH_MOE1) ph_moe(p, layer, 0, smem);
    else if (PH == PH_MOE2) ph_moe(p, layer, 1, smem);
    else if (PH == PH_GEMM_IN_ODD) ph_gemm_in(p, layer, false, smem);
    else if (PH == PH_GLA_TOK) ph_gla_tok(p, layer);
    else if (PH == PH_GLA_CHUNK) ph_gla_chunk(p, layer, smem);
    else if (PH == PH_GLA_SCAN) { ph_gla_scan(p, smem); ph_conv_exp(p, layer, smem, 64); }
    else if (PH == PH_GLA_OUT) ph_gla_out(p, layer);
    else if (PH == PH_FINAL) ph_rows(p, 0, 1, smem);
}

#if MK_MULTI
template <int PH>
__global__ void __launch_bounds__(NTHREADS, 2) k_phase(Params p, int layer) {
    run_phase<PH>(p, layer, (float*)g_smem);
}
#else
__global__ void __launch_bounds__(NTHREADS, 2) k_mega(Params p) {
    float* smem = (float*)g_smem;
    volatile LAS unsigned* xbw = (volatile LAS unsigned*)(LAS unsigned char*)(g_smem + LDS_BYTES - 16);
    if (threadIdx.x == 0) { xbw[0] = 0u; xbw[1] = 0u; xbw[2] = 0u; xbw[3] = 0u; }
    __syncthreads();
    XcdBarrier bar = xcd_barrier_post((unsigned*)(p.ws + OFF_BAR), xbw);
#define BAR() xcd_barrier(bar)
    run_phase<PH_PROLOGUE>(p, 0, smem); BAR(); if (DUP_MASK & 4096) { run_phase<PH_PROLOGUE>(p, 0, smem); BAR(); }
    for (int lp = 0; lp < 2; ++lp) {
        const int le = 2 * lp, lo = 2 * lp + 1;
        run_phase<PH_NORM_MIX>(p, le, smem); BAR();
        run_phase<PH_GEMM_IN_EVEN>(p, le, smem); BAR(); if (DUP_MASK & 1) { run_phase<PH_GEMM_IN_EVEN>(p, le, smem); BAR(); }
        run_phase<PH_EVEN_TOK>(p, le, smem); BAR(); if (DUP_MASK & 2) { run_phase<PH_EVEN_TOK>(p, le, smem); BAR(); }
        run_phase<PH_GDN_SCAN>(p, le, smem); BAR(); if (DUP_MASK & 8) { run_phase<PH_GDN_SCAN>(p, le, smem); BAR(); }
        run_phase<PH_DSA_ATTN>(p, le, smem); BAR(); if (DUP_MASK & 32) { run_phase<PH_DSA_ATTN>(p, le, smem); BAR(); }
        run_phase<PH_GEMM_OUT>(p, le, smem); BAR();
        run_phase<PH_NORM_FFN>(p, le, smem); BAR();
        run_phase<PH_MOE1>(p, le, smem); BAR(); if (DUP_MASK & 64) { run_phase<PH_MOE1>(p, le, smem); BAR(); }
        run_phase<PH_MOE2>(p, le, smem); BAR(); if (DUP_MASK & 128) { run_phase<PH_MOE2>(p, le, smem); BAR(); }
        run_phase<PH_NORM_MIX>(p, lo, smem); BAR();
        run_phase<PH_GEMM_IN_ODD>(p, lo, smem); BAR(); if (DUP_MASK & 256) { run_phase<PH_GEMM_IN_ODD>(p, lo, smem); BAR(); }
        run_phase<PH_GLA_CHUNK>(p, lo, smem); BAR(); if (DUP_MASK & 1024) { run_phase<PH_GLA_CHUNK>(p, lo, smem); BAR(); }
        run_phase<PH_GLA_SCAN>(p, lo, smem); BAR(); if (DUP_MASK & 2048) { run_phase<PH_GLA_SCAN>(p, lo, smem); BAR(); }
        run_phase<PH_GLA_OUT>(p, lo, smem); BAR();
        run_phase<PH_GEMM_OUT>(p, lo, smem); BAR();
        run_phase<PH_NORM_FFN>(p, lo, smem); BAR();
        run_phase<PH_MOE1>(p, lo, smem); BAR(); if (DUP_MASK & 64) { run_phase<PH_MOE1>(p, lo, smem); BAR(); }
        run_phase<PH_MOE2>(p, lo, smem); BAR(); if (DUP_MASK & 128) { run_phase<PH_MOE2>(p, lo, smem); BAR(); }
    }
    for (int xb = 0; xb < EXTRA_BARS; ++xb) BAR();
    run_phase<PH_FINAL>(p, 0, smem);
}
#endif

}

#if MK_MULTI
template <int PH>
static void launch_phase(const Params& p, int layer, hipStream_t stream) {
    static bool attr_set = false;
    if (!attr_set) { hipFuncSetAttribute((const void*)k_phase<PH>, hipFuncAttributeMaxDynamicSharedMemorySize, (int)LDS_BYTES); attr_set = true; }
    hipLaunchKernelGGL((k_phase<PH>), dim3(256), dim3(NTHREADS), LDS_BYTES, stream, p, layer);
}
#endif

extern "C" void kernel_launch(void* const* d_in, const int* in_sizes, int n_in, void* d_out, int out_size, void* d_ws, size_t ws_size, hipStream_t stream) {
    (void)in_sizes; (void)n_in; (void)out_size;
    if (ws_size < WS_NEEDED) { fprintf(stderr, "workspace too small: %zu < %zu\n", ws_size, (size_t)WS_NEEDED); return; }
    Params p{};
    p.x = (const float*)d_in[0]; p.c = (const float*)d_in[1]; p.pos = (const int*)d_in[2]; p.ada_w = (const float*)d_in[3]; p.ada_b = (const float*)d_in[4];
    p.norm_mix = (const float*)d_in[5]; p.norm_ffn = (const float*)d_in[6]; p.even_w_in = (const float*)d_in[7]; p.conv_w = (const float*)d_in[8];
    p.a_log = (const float*)d_in[9]; p.dt_bias = (const float*)d_in[10]; p.gdn_out_norm = (const float*)d_in[11]; p.even_w_out = (const float*)d_in[12];
    p.gla_w_in = (const float*)d_in[13]; p.gla_w_gate2 = (const float*)d_in[14]; p.gla_b_gate2 = (const float*)d_in[15]; p.gla_out_norm = (const float*)d_in[16]; p.gla_w_out = (const float*)d_in[17];
    p.rg_w = (const float*)d_in[18]; p.rg_b = (const float*)d_in[19]; p.re_w = (const float*)d_in[20]; p.re_b = (const float*)d_in[21];
    p.w1 = (const float*)d_in[22]; p.w3 = (const float*)d_in[23]; p.w2 = (const float*)d_in[24]; p.final_norm = (const float*)d_in[25];
    p.X = (float*)d_out; p.ws = (unsigned char*)d_ws;
    p.rA = pow(10000.0, -2.0 / 128.0); p.rI = pow(10000.0, -2.0 / 64.0);
    hipMemsetAsync(d_ws, 0, ZERO_BYTES, stream);
#if MK_MULTI
    launch_phase<PH_PROLOGUE>(p, 0, stream);
    for (int lp = 0; lp < 2; ++lp) {
        const int le = 2 * lp, lo = 2 * lp + 1;
        launch_phase<PH_NORM_MIX>(p, le, stream);
        launch_phase<PH_GEMM_IN_EVEN>(p, le, stream);
        launch_phase<PH_EVEN_TOK>(p, le, stream);
        launch_phase<PH_GDN_SCAN>(p, le, stream);
        launch_phase<PH_DSA_ATTN>(p, le, stream);
        launch_phase<PH_GEMM_OUT>(p, le, stream);
        launch_phase<PH_NORM_FFN>(p, le, stream);
        launch_phase<PH_MOE1>(p, le, stream);
        launch_phase<PH_MOE2>(p, le, stream);
        launch_phase<PH_NORM_MIX>(p, lo, stream);
        launch_phase<PH_GEMM_IN_ODD>(p, lo, stream);
        launch_phase<PH_GLA_CHUNK>(p, lo, stream);
        launch_phase<PH_GLA_SCAN>(p, lo, stream);
        launch_phase<PH_GLA_OUT>(p, lo, stream);
        launch_phase<PH_GEMM_OUT>(p, lo, stream);
        launch_phase<PH_NORM_FFN>(p, lo, stream);
        launch_phase<PH_MOE1>(p, lo, stream);
        launch_phase<PH_MOE2>(p, lo, stream);
    }
    launch_phase<PH_FINAL>(p, 0, stream);
#else
    static int grid = 0;
    if (!grid) {
        int dev = 0, cus = 0, per_cu = 0;
        hipGetDevice(&dev);
        hipDeviceGetAttribute(&cus, hipDeviceAttributeMultiprocessorCount, dev);
        hipFuncSetAttribute((const void*)k_mega, hipFuncAttributeMaxDynamicSharedMemorySize, (int)LDS_BYTES);
        hipOccupancyMaxActiveBlocksPerMultiprocessor(&per_cu, k_mega, NTHREADS, LDS_BYTES);
        if (cus <= 0) cus = 256;
        grid = cus * (per_cu < 1 ? 1 : 1);
    }
    hipLaunchKernelGGL(k_mega, dim3(grid), dim3(NTHREADS), LDS_BYTES, stream, p);
#endif
}
```

```cpp
#include <hip/hip_runtime.h>
#include <stdint.h>
#include <math.h>
#include <stdio.h>

#define EXTRA_BARS 0
#ifndef DUP_MASK
#define DUP_MASK 0
#endif
#ifndef MK_MULTI
#define MK_MULTI 0
#endif

namespace {

constexpr int NT = 16384, ND = 1024, LDP = 3920, LDPB = 3968;
constexpr float EPS = 1e-6f;
constexpr int NTHREADS = 512;
constexpr size_t LDS_BYTES = 147456;
constexpr float SCALE128 = 0.08838834764831845f;
constexpr int LISTCAP = 32768;
constexpr int CSTR = 16;

constexpr size_t OFF_BAR  = 0;
constexpr size_t OFF_CNT  = 16384;
constexpr size_t ZERO_BYTES = 32768;
constexpr size_t OFF_QCTR = 28672;
constexpr size_t OFF_MOD  = 32768;
constexpr size_t OFF_COSA = OFF_MOD + 4 * 2 * 6144 * 4;
constexpr size_t OFF_SINA = OFF_COSA + (size_t)NT * 64 * 4;
constexpr size_t OFF_COSI = OFF_SINA + (size_t)NT * 64 * 4;
constexpr size_t OFF_SINI = OFF_COSI + (size_t)NT * 32 * 4;
constexpr size_t OFF_H    = OFF_SINI + (size_t)NT * 32 * 4;
constexpr size_t OFF_P    = OFF_H + (size_t)NT * 1024 * 4;
constexpr size_t OFF_HID  = OFF_P;
constexpr size_t OFF_YB   = OFF_HID + (size_t)36864 * 512 * 4;
constexpr size_t OFF_O    = OFF_P + (size_t)NT * LDP * 4;
constexpr size_t OFF_ASG  = OFF_O + (size_t)NT * 1024 * 4;
constexpr size_t OFF_GATE = OFF_ASG + (size_t)NT * 4 * 4;
constexpr size_t OFF_LIST = OFF_GATE + (size_t)NT * 2 * 4;
constexpr size_t OFF_R    = OFF_LIST + (size_t)32 * LISTCAP * 4;
constexpr size_t OFF_QN   = OFF_R;
constexpr size_t OFF_KN   = OFF_QN + (size_t)NT * 512 * 4;
constexpr size_t OFF_VC   = OFF_KN + (size_t)NT * 512 * 4;
constexpr size_t OFF_BETA = OFF_VC + (size_t)NT * 512 * 4;
constexpr size_t OFF_G    = OFF_BETA + (size_t)NT * 4 * 4;
constexpr size_t OFF_W    = OFF_G + (size_t)NT * 4 * 4;
constexpr size_t OFF_U    = OFF_W + (size_t)1024 * 8192 * 4;
constexpr size_t OFF_QG   = OFF_U + (size_t)1024 * 8192 * 4;
constexpr size_t OFF_KD   = OFF_QG + (size_t)1024 * 8192 * 4;
constexpr size_t OFF_AQK  = OFF_KD + (size_t)1024 * 8192 * 4;
constexpr size_t OFF_GL   = OFF_AQK + (size_t)1024 * 4096 * 4;
constexpr size_t OFF_QB   = OFF_GL + 4096;
constexpr size_t OFF_KB   = OFF_QB + (size_t)NT * 512 * 4;
constexpr size_t OFF_QI   = OFF_KB + (size_t)NT * 512 * 4;
constexpr size_t OFF_KI   = OFF_QI + (size_t)NT * 256 * 4;
constexpr size_t OFF_WI   = OFF_KI + (size_t)NT * 64 * 4;
constexpr size_t OFF_SEL  = OFF_WI + (size_t)NT * 4 * 4;
constexpr size_t OFF_EVEN_END = OFF_SEL + (size_t)NT * 256 * 4;
constexpr size_t OFF_PFR  = OFF_W;
constexpr size_t OFF_RFR  = OFF_PFR + (size_t)1024 * 32768;
constexpr size_t OFF_QFR  = OFF_RFR + (size_t)1024 * 16384;
constexpr size_t OFF_OFR  = OFF_QFR + (size_t)1024 * 32768;
static_assert(OFF_OFR + (size_t)1024 * 16384 <= OFF_GL, "gdn v2 buffers overflow");
constexpr size_t OFF_QBB  = OFF_QB;
constexpr size_t OFF_KBB  = OFF_QBB + (size_t)NT * 512 * 2;
constexpr size_t OFF_VT   = OFF_KBB + (size_t)NT * 512 * 2;
constexpr size_t OFF_QIB  = OFF_VT + (size_t)NT * 512 * 2;
constexpr size_t OFF_KIB  = OFF_QIB + (size_t)NT * 256 * 2;
constexpr size_t OFF_M16  = OFF_KIB + (size_t)NT * 64 * 2;
static_assert(OFF_M16 + (size_t)NT * 512 * 2 <= OFF_WI, "dsa v2 buffers overflow");
constexpr size_t OFF_LA   = OFF_R;
constexpr size_t OFF_ATT  = OFF_LA + (size_t)NT * 512 * 4;
constexpr size_t OFF_QE   = OFF_ATT + (size_t)1024 * 4096 * 4;
constexpr size_t OFF_GKD  = OFF_QE + (size_t)1024 * 8192 * 4;
constexpr size_t OFF_EBL  = OFF_GKD + (size_t)1024 * 8192 * 4;
constexpr size_t OFF_GQE  = OFF_LA + (size_t)NT * 512 * 4;
constexpr size_t OFF_GOI  = OFF_GQE + (size_t)1024 * 16384;
constexpr size_t OFF_GH   = OFF_GOI + (size_t)1024 * 32768;
constexpr size_t OFF_GEBL = OFF_GH + (size_t)1024 * 65536;
static_assert(OFF_GEBL + (size_t)1024 * 512 <= OFF_EVEN_END, "gla v2 buffers overflow");
constexpr size_t OFF_WINE = OFF_EVEN_END;
constexpr size_t OFF_WINO = OFF_WINE + (size_t)2 * 3968 * 1024 * 2;
constexpr size_t OFF_WOUT = OFF_WINO + (size_t)2 * 3200 * 1024 * 2;
constexpr size_t OFF_W13  = OFF_WOUT + (size_t)4 * 1024 * 1024 * 2;
constexpr size_t OFF_W2T  = OFF_W13 + (size_t)32 * 1024 * 1024 * 2;
constexpr size_t OFF_OB   = OFF_W2T + (size_t)32 * 1024 * 512 * 2;
constexpr size_t OFF_AUX  = OFF_OB + (size_t)NT * 1024 * 2;
constexpr size_t WS_NEEDED = OFF_AUX + (size_t)NT * 16 * 4;

struct Params {
    const float* x; const float* c; const int* pos; const float* ada_w; const float* ada_b;
    const float* norm_mix; const float* norm_ffn; const float* even_w_in; const float* conv_w;
    const float* a_log; const float* dt_bias; const float* gdn_out_norm; const float* even_w_out;
    const float* gla_w_in; const float* gla_w_gate2; const float* gla_b_gate2; const float* gla_out_norm; const float* gla_w_out;
    const float* rg_w; const float* rg_b; const float* re_w; const float* re_b;
    const float* w1; const float* w3; const float* w2; const float* final_norm;
    float* X;
    unsigned char* ws;
    double rA, rI;
};

#define XB_TMO      128
#define XB_XCNT(j)  (256  + 64 * (j))
#define XB_XSUB(j)  (1280 + 64 * (j))
#define XB_XGEN(j)  (2304 + 64 * (j))
#define XB_TOP      3328
#define XB_TOPGEN   3392
#define XCD_BAR_WORDS 3456
#define XB_SPIN_CAP (1u << 18)
#define LAS __attribute__((address_space(3)))

__device__ __forceinline__ unsigned xb_ld(unsigned* p)              { return __hip_atomic_load(p, __ATOMIC_RELAXED, __HIP_MEMORY_SCOPE_AGENT); }
__device__ __forceinline__ unsigned xb_add(unsigned* p, unsigned v) { return __hip_atomic_fetch_add(p, v, __ATOMIC_RELAXED, __HIP_MEMORY_SCOPE_AGENT); }
__device__ __forceinline__ unsigned xb_xcc_id() { return (unsigned)__builtin_amdgcn_s_getreg((3 << 11) | 20) & 0xFu; }
#define XB_SPIN(cond, bar) do { unsigned _sp = 0; while (cond) { __builtin_amdgcn_s_sleep(1); \
    if ((++_sp & 255u) == 0u) { if (xb_ld(&(bar)[XB_TMO])) break; if (_sp > XB_SPIN_CAP) { atomicAdd(&(bar)[XB_TMO], 1u); break; } } } } while (0)

struct XcdBarrier { unsigned* bar; unsigned x; volatile LAS unsigned* st; };

__device__ __forceinline__ XcdBarrier xcd_barrier_post(unsigned* bar, volatile LAS unsigned* st) {
    XcdBarrier b; b.bar = bar; b.x = xb_xcc_id(); b.st = st;
    if (threadIdx.x == 0) (void)xb_add(&bar[XB_XCNT(b.x)], 1u);
    return b;
}
__device__ __forceinline__ void xcd_barrier_complete(unsigned* bar, unsigned x, unsigned& nloc, unsigned& nx) {
    const unsigned G = gridDim.x * gridDim.y * gridDim.z;
    unsigned sum, cnt, mine, sp = 0u;
    for (;;) {
        sum = 0u; cnt = 0u; mine = 0u;
#pragma unroll
        for (unsigned j = 0; j < 16; ++j) { const unsigned c = xb_ld(&bar[XB_XCNT(j)]); sum += c; cnt += (c > 0u) ? 1u : 0u; mine = (j == x) ? c : mine; }
        if (sum == G) break;
        __builtin_amdgcn_s_sleep(1);
        if ((++sp & 255u) == 0u) { if (xb_ld(&bar[XB_TMO])) break; if (sp > XB_SPIN_CAP) { atomicAdd(&bar[XB_TMO], 1u); break; } }
    }
    nloc = mine > 0u ? mine : 1u; nx = cnt > 0u ? cnt : 1u;
}
__device__ __forceinline__ void xcd_barrier(const XcdBarrier& b) {
    asm volatile("s_waitcnt vmcnt(0)" ::: "memory");
    __syncthreads();
    if (threadIdx.x == 0) {
        unsigned* bar = b.bar;
        __builtin_amdgcn_s_waitcnt(0);
        unsigned nloc = b.st[0], nx = b.st[1];
        if (nloc == 0u) { xcd_barrier_complete(bar, b.x, nloc, nx); b.st[0] = nloc; b.st[1] = nx; }
        const unsigned old = xb_add(&bar[XB_XSUB(b.x)], 1u);
        const unsigned gen = old / nloc;
        if (old + 1u == (gen + 1u) * nloc) {
            __builtin_amdgcn_fence(__ATOMIC_RELEASE, "agent");
            asm volatile("s_waitcnt vmcnt(0)" ::: "memory");
            const unsigned og = xb_add(&bar[XB_TOP], 1u);
            const unsigned tg = og / nx;
            if (og + 1u == (tg + 1u) * nx) xb_add(&bar[XB_TOPGEN], 1u);
            else XB_SPIN(xb_ld(&bar[XB_TOPGEN]) == tg, bar);
            __builtin_amdgcn_fence(__ATOMIC_ACQUIRE, "agent");
            xb_add(&bar[XB_XGEN(b.x)], 1u);
            asm volatile("s_waitcnt vmcnt(0)" ::: "memory");
        } else {
            XB_SPIN(xb_ld(&bar[XB_XGEN(b.x)]) == gen, bar);
            __builtin_amdgcn_fence(__ATOMIC_ACQUIRE, "agent");
            asm volatile("s_waitcnt vmcnt(0)" ::: "memory");
        }
    }
    __syncthreads();
}

__device__ __forceinline__ float wave_sum(float v) {
#pragma unroll
    for (int o = 32; o > 0; o >>= 1) v += __shfl_xor(v, o);
    return v;
}
__device__ __forceinline__ int wave_sum_i(int v) {
#pragma unroll
    for (int o = 32; o > 0; o >>= 1) v += __shfl_xor(v, o);
    return v;
}
__device__ __forceinline__ float wave_max(float v) {
#pragma unroll
    for (int o = 32; o > 0; o >>= 1) v = fmaxf(v, __shfl_xor(v, o));
    return v;
}
__device__ __forceinline__ float sigmoidf_(float x) { return 1.f / (1.f + expf(-x)); }
__device__ __forceinline__ float siluf_(float x) { return x / (1.f + expf(-x)); }
__device__ __forceinline__ float softplusf_(float x) { return fmaxf(x, 0.f) + log1pf(expf(-fabsf(x))); }
__device__ __forceinline__ unsigned ordkey(float f) { const unsigned u = __float_as_uint(f); return (u & 0x80000000u) ? ~u : (u | 0x80000000u); }

__device__ __forceinline__ void sincos_d(double a, double& s, double& c) {
    const double kq = rint(a * 0.63661977236758134308);
    double r = fma(-kq, 1.57079632673412561417e+00, a);
    r = fma(-kq, 6.07710050650619224932e-11, r);
    const int q = (int)((long long)kq & 3);
    const double r2 = r * r;
    const double sp = r * (1.0 + r2 * (-1.0 / 6 + r2 * (1.0 / 120 + r2 * (-1.0 / 5040 + r2 * (1.0 / 362880 + r2 * (-1.0 / 39916800 + r2 * (1.0 / 6227020800.0)))))));
    const double cp = 1.0 + r2 * (-0.5 + r2 * (1.0 / 24 + r2 * (-1.0 / 720 + r2 * (1.0 / 40320 + r2 * (-1.0 / 3628800 + r2 * (1.0 / 479001600.0 + r2 * (-1.0 / 87178291200.0)))))));
    if (q == 0) { s = sp; c = cp; } else if (q == 1) { s = cp; c = -sp; } else if (q == 2) { s = -sp; c = -cp; } else { s = -cp; c = sp; }
}
__device__ __forceinline__ double ipow_d(double b, int e) { double v = 1.0; while (e) { if (e & 1) v *= b; b *= b; e >>= 1; } return v; }

struct GemmArgs { const float* A; int lda; const int* rows; int m0; int mvalid; const float* B; int ldb; int n0; int N; int K; };

template <class Epi>
__device__ __forceinline__ void gemm128(const GemmArgs& g, float* smem, Epi epi) {
    float* As = smem;
    float* Bs = smem + 16 * 132;
    int tid_ = threadIdx.x; asm volatile("" : "+v"(tid_)); const int tid = tid_, ty = tid >> 4, tx = tid & 15;
    const int arow = tid >> 2, kq = (tid & 3) * 4;
    const int bk = tid >> 5, bn = (tid & 31) * 4;
    long asrc = -1;
    if (arow < g.mvalid) { const int r = g.rows ? g.rows[arow] : (g.m0 + arow); if (r >= 0) asrc = (long)r * g.lda; }
    const bool bval = (g.n0 + bn) < g.N;
    float acc[4][8];
#pragma unroll
    for (int i = 0; i < 4; ++i)
#pragma unroll
        for (int j = 0; j < 8; ++j) acc[i][j] = 0.f;
    for (int k0 = 0; k0 < g.K; k0 += 16) {
        float4 av = make_float4(0.f, 0.f, 0.f, 0.f), bv = make_float4(0.f, 0.f, 0.f, 0.f);
        if (asrc >= 0) av = *(const float4*)(g.A + asrc + k0 + kq);
        if (bval) bv = *(const float4*)(g.B + (size_t)(k0 + bk) * g.ldb + g.n0 + bn);
        __syncthreads();
        As[(kq + 0) * 132 + arow] = av.x; As[(kq + 1) * 132 + arow] = av.y; As[(kq + 2) * 132 + arow] = av.z; As[(kq + 3) * 132 + arow] = av.w;
        *(float4*)&Bs[bk * 132 + bn] = bv;
        __syncthreads();
#pragma unroll
        for (int kk = 0; kk < 16; ++kk) {
            const float4 a = *(const float4*)&As[kk * 132 + ty * 4];
            const float4 b0 = *(const float4*)&Bs[kk * 132 + tx * 8];
            const float4 b1 = *(const float4*)&Bs[kk * 132 + tx * 8 + 4];
            const float aa[4] = {a.x, a.y, a.z, a.w};
            const float bb[8] = {b0.x, b0.y, b0.z, b0.w, b1.x, b1.y, b1.z, b1.w};
#pragma unroll
            for (int i = 0; i < 4; ++i)
#pragma unroll
                for (int j = 0; j < 8; ++j) acc[i][j] += aa[i] * bb[j];
        }
    }
#pragma unroll
    for (int i = 0; i < 4; ++i) {
        const int r = ty * 4 + i;
        if (r < g.mvalid) {
#pragma unroll
            for (int j = 0; j < 8; ++j) { const int n = g.n0 + tx * 8 + j; if (n < g.N) epi(r, n, acc[i][j]); }
        }
    }
}


typedef short bf16x8 __attribute__((ext_vector_type(8)));
typedef float f32x4 __attribute__((ext_vector_type(4)));
typedef unsigned short bf16_t;
typedef __bf16 bf16x2_t __attribute__((ext_vector_type(2)));
typedef float f32x2_t __attribute__((ext_vector_type(2)));
__device__ __forceinline__ unsigned cvt_pk_bf16(float lo, float hi) { const f32x2_t v = {lo, hi}; const bf16x2_t r = __builtin_convertvector(v, bf16x2_t); return __builtin_bit_cast(unsigned, r); }
__device__ __forceinline__ bf16_t f2bf(float f) { return (bf16_t)(cvt_pk_bf16(f, 0.f) & 0xffffu); }
__device__ __forceinline__ float bf16_to_f32(bf16_t v) { return __uint_as_float(((unsigned)v) << 16); }
__device__ __forceinline__ uint2 pack4(const f32x4 v) { uint2 r; r.x = cvt_pk_bf16(v[0], v[1]); r.y = cvt_pk_bf16(v[2], v[3]); return r; }
__device__ __forceinline__ f32x4 unpack4(const uint2 u) { f32x4 r; r[0] = __uint_as_float(u.x << 16); r[1] = __uint_as_float(u.x & 0xffff0000u); r[2] = __uint_as_float(u.y << 16); r[3] = __uint_as_float(u.y & 0xffff0000u); return r; }
#define PBF(Pb_, t_, c_) bf16_to_f32((Pb_)[(size_t)(t_) * LDPB + (c_)])
__device__ __forceinline__ uint4 pack8(const float4 a, const float4 b) { uint4 r; r.x = cvt_pk_bf16(a.x, a.y); r.y = cvt_pk_bf16(a.z, a.w); r.z = cvt_pk_bf16(b.x, b.y); r.w = cvt_pk_bf16(b.z, b.w); return r; }
__device__ __forceinline__ int lds_off(int r, int c) { return r * 128 + ((c ^ (r & 7)) << 4); }

template <class ALoad, class BLoad, class Epi>
__device__ __forceinline__ void gemm_tile_bf16(const int K, unsigned char* lds, ALoad aload, BLoad bload, Epi epi, const int mrows = 256) {
    int tid_ = threadIdx.x; asm volatile("" : "+v"(tid_)); const int tid = tid_, lane = tid & 63, wid = tid >> 6, wm = wid >> 1, wn = wid & 1;
    f32x4 acc[4][4];
#pragma unroll
    for (int mi = 0; mi < 4; ++mi)
#pragma unroll
        for (int ni = 0; ni < 4; ++ni) acc[mi][ni] = (f32x4){0.f, 0.f, 0.f, 0.f};
    uint4 ra[4], rb[2];
    const int nk = K >> 6;
#pragma unroll
    for (int i = 0; i < 4; ++i) { const int q = tid + 512 * i; ra[i] = aload(i, q >> 3, (q & 7) * 8); }
#pragma unroll
    for (int i = 0; i < 2; ++i) { const int q = tid + 512 * i; rb[i] = bload(i, q >> 3, (q & 7) * 8); }
    __syncthreads();
#pragma unroll
    for (int i = 0; i < 4; ++i) { const int q = tid + 512 * i; *(uint4*)(lds + lds_off(q >> 3, q & 7)) = ra[i]; }
#pragma unroll
    for (int i = 0; i < 2; ++i) { const int q = tid + 512 * i; *(uint4*)(lds + 32768 + lds_off(q >> 3, q & 7)) = rb[i]; }
    __syncthreads();
    for (int kt = 0; kt < nk; ++kt) {
        if (kt + 1 < nk) {
#pragma unroll
            for (int i = 0; i < 4; ++i) { const int q = tid + 512 * i; ra[i] = aload(i, q >> 3, (kt + 1) * 64 + (q & 7) * 8); }
#pragma unroll
            for (int i = 0; i < 2; ++i) { const int q = tid + 512 * i; rb[i] = bload(i, q >> 3, (kt + 1) * 64 + (q & 7) * 8); }
        }
        const unsigned char* At = lds + (kt & 1) * 49152;
        const unsigned char* Bt = At + 32768;
        if (__builtin_amdgcn_readfirstlane(wm) * 64 < mrows) {
#pragma unroll
        for (int ks = 0; ks < 2; ++ks) {
            bf16x8 af[4], bfr[4];
            const int c = ks * 4 + (lane >> 4);
#pragma unroll
            for (int mi = 0; mi < 4; ++mi) af[mi] = *(const bf16x8*)(At + lds_off(wm * 64 + mi * 16 + (lane & 15), c));
#pragma unroll
            for (int ni = 0; ni < 4; ++ni) bfr[ni] = *(const bf16x8*)(Bt + lds_off(wn * 64 + ni * 16 + (lane & 15), c));
#pragma unroll
            for (int mi = 0; mi < 4; ++mi)
#pragma unroll
                for (int ni = 0; ni < 4; ++ni) acc[mi][ni] = __builtin_amdgcn_mfma_f32_16x16x32_bf16(bfr[ni], af[mi], acc[mi][ni], 0, 0, 0);
        }
        }
        if (kt + 1 < nk) {
            unsigned char* An = lds + ((kt + 1) & 1) * 49152;
#pragma unroll
            for (int i = 0; i < 4; ++i) { const int q = tid + 512 * i; *(uint4*)(An + lds_off(q >> 3, q & 7)) = ra[i]; }
#pragma unroll
            for (int i = 0; i < 2; ++i) { const int q = tid + 512 * i; *(uint4*)(An + 32768 + lds_off(q >> 3, q & 7)) = rb[i]; }
        }
        __syncthreads();
    }
    epi(acc, wm, wn, lane);
}

__device__ __forceinline__ void convert_tile(const float* src0, const float* src1, int mode, int K, int N, int ld, bf16_t* dst, int rt, int kt, float* smem) {
    int tid_ = threadIdx.x; asm volatile("" : "+v"(tid_)); const int tid = tid_;
    __syncthreads();
    { const int k = tid >> 3, R0 = rt * 64 + (tid & 7) * 8;
      const float* sp; int col;
      if (mode == 0) { sp = src0; col = R0; } else { sp = (R0 & 32) ? src1 : src0; col = (R0 >> 6) * 32 + (R0 & 31); }
      float4 a = make_float4(0.f, 0.f, 0.f, 0.f), b = a;
      const float* rp = sp + (size_t)(kt * 64 + k) * ld + col;
      if (col < N) a = *(const float4*)rp;
      if (col + 4 < N) b = *(const float4*)(rp + 4);
      float* d = smem + k * 65 + (tid & 7) * 8;
      d[0] = a.x; d[1] = a.y; d[2] = a.z; d[3] = a.w; d[4] = b.x; d[5] = b.y; d[6] = b.z; d[7] = b.w; }
    __syncthreads();
    { const int R = tid >> 3, kc = (tid & 7) * 8;
      float v[8];
#pragma unroll
      for (int j = 0; j < 8; ++j) v[j] = smem[(kc + j) * 65 + R];
      uint4 o; o.x = cvt_pk_bf16(v[0], v[1]); o.y = cvt_pk_bf16(v[2], v[3]); o.z = cvt_pk_bf16(v[4], v[5]); o.w = cvt_pk_bf16(v[6], v[7]);
      *(uint4*)(dst + (size_t)(rt * 64 + R) * K + kt * 64 + kc) = o; }
}

#define CT_LOAD(S0, S1, MODE, NN, LD, RT, KT, A, B) do { const int k_ = tid >> 3, R0_ = (RT) * 64 + (tid & 7) * 8; const float* sp_; int col_; \
        if ((MODE) == 0) { sp_ = (S0); col_ = R0_; } else { sp_ = (R0_ & 32) ? (S1) : (S0); col_ = (R0_ >> 6) * 32 + (R0_ & 31); } \
        A = make_float4(0.f, 0.f, 0.f, 0.f); B = A; const float* rp_ = sp_ + (size_t)((KT) * 64 + k_) * (LD) + col_; \
        if (col_ < (NN)) A = *(const float4*)rp_; if (col_ + 4 < (NN)) B = *(const float4*)(rp_ + 4); } while (0)
#define CT_WRITE(BUF, A, B) do { float* d_ = smem + (BUF) * 4160 + (tid >> 3) * 65 + (tid & 7) * 8; \
        d_[0] = A.x; d_[1] = A.y; d_[2] = A.z; d_[3] = A.w; d_[4] = B.x; d_[5] = B.y; d_[6] = B.z; d_[7] = B.w; } while (0)
#define CT_STORE(DST, KK, RT, KT, BUF) do { const int R_ = tid >> 3, kc_ = (tid & 7) * 8; const float* sb_ = smem + (BUF) * 4160; \
        uint4 o_; o_.x = cvt_pk_bf16(sb_[(kc_ + 0) * 65 + R_], sb_[(kc_ + 1) * 65 + R_]); o_.y = cvt_pk_bf16(sb_[(kc_ + 2) * 65 + R_], sb_[(kc_ + 3) * 65 + R_]); \
        o_.z = cvt_pk_bf16(sb_[(kc_ + 4) * 65 + R_], sb_[(kc_ + 5) * 65 + R_]); o_.w = cvt_pk_bf16(sb_[(kc_ + 6) * 65 + R_], sb_[(kc_ + 7) * 65 + R_]); \
        *(uint4*)((DST) + (size_t)((RT) * 64 + R_) * (KK) + (KT) * 64 + kc_) = o_; } while (0)
#define CT_DECL(I) const float* s0_##I; const float* s1_##I; bf16_t* d_##I; int md_##I, K_##I, N_##I, ld_##I, rt_##I, kt_##I
#define CT_ARGS(I) s0_##I, s1_##I, d_##I, md_##I, K_##I, N_##I, ld_##I, rt_##I, kt_##I
template <class Dec>
__device__ __forceinline__ void convert_tiles4(const Dec& dec, int t, int nj, float* smem) {
    int tid_ = threadIdx.x; asm volatile("" : "+v"(tid_)); const int tid = tid_;
    CT_DECL(0); CT_DECL(1); CT_DECL(2); CT_DECL(3);
    dec(t, CT_ARGS(0)); dec(t + 1, CT_ARGS(1)); dec(t + 2, CT_ARGS(2)); dec(t + 3, CT_ARGS(3));
    float4 a0, b0, a1, b1, a2, b2, a3, b3;
    a1 = b1 = a2 = b2 = a3 = b3 = make_float4(0.f, 0.f, 0.f, 0.f);
    CT_LOAD(s0_0, s1_0, md_0, N_0, ld_0, rt_0, kt_0, a0, b0);
    if (nj > 1) CT_LOAD(s0_1, s1_1, md_1, N_1, ld_1, rt_1, kt_1, a1, b1);
    if (nj > 2) CT_LOAD(s0_2, s1_2, md_2, N_2, ld_2, rt_2, kt_2, a2, b2);
    if (nj > 3) CT_LOAD(s0_3, s1_3, md_3, N_3, ld_3, rt_3, kt_3, a3, b3);
    __syncthreads();
    CT_WRITE(0, a0, b0); CT_WRITE(1, a1, b1); CT_WRITE(2, a2, b2); CT_WRITE(3, a3, b3);
    __syncthreads();
    CT_STORE(d_0, K_0, rt_0, kt_0, 0);
    if (nj > 1) CT_STORE(d_1, K_1, rt_1, kt_1, 1);
    if (nj > 2) CT_STORE(d_2, K_2, rt_2, kt_2, 2);
    if (nj > 3) CT_STORE(d_3, K_3, rt_3, kt_3, 3);
}

extern __shared__ __attribute__((aligned(16))) unsigned char g_smem[];
#define PHASE_FN __device__ __forceinline__
enum { PH_PROLOGUE = 0, PH_NORM_MIX, PH_GEMM_IN_EVEN, PH_EVEN_TOK, PH_GDN_CHUNK, PH_GDN_SCAN, PH_DSA_TOPK, PH_DSA_ATTN, PH_GDN_OUT,
       PH_GEMM_OUT, PH_NORM_FFN, PH_MOE1, PH_MOE2, PH_GEMM_IN_ODD, PH_GLA_TOK, PH_GLA_CHUNK, PH_GLA_SCAN, PH_GLA_OUT, PH_FINAL };

PHASE_FN void ph_prologue(const Params& p, float* smem) {
    unsigned char* ws_ = p.ws; asm volatile("" : "+s"(ws_));
    { int ldz_ = 0; asm volatile("" : "+s"(ldz_)); smem = (float*)(g_smem + ldz_); }
    int tid_ = threadIdx.x; asm volatile("" : "+v"(tid_)); const int tid = tid_, nthr = gridDim.x * NTHREADS, gid = blockIdx.x * NTHREADS + tid;
    for (int i = tid; i < 2 * ND; i += NTHREADS) smem[i] = siluf_(p.c[i]);
    __syncthreads();
    float* MOD = (float*)(ws_ + OFF_MOD);
    { float* red = smem + 2048;
      const int lane = tid & 63, wv = tid >> 6;
      for (int item = blockIdx.x; item < 4 * 96; item += gridDim.x) {
          const int l = item / 96, n = (item % 96) * 64 + lane;
          const float* w = p.ada_w + (size_t)l * ND * 6144 + n;
          float a0 = 0.f, a1 = 0.f;
#pragma unroll 8
          for (int k = wv * 128; k < wv * 128 + 128; ++k) { const float wv_ = w[(size_t)k * 6144]; a0 += smem[k] * wv_; a1 += smem[ND + k] * wv_; }
          __syncthreads();
          red[(wv * 64 + lane) * 2] = a0; red[(wv * 64 + lane) * 2 + 1] = a1;
          __syncthreads();
          if (tid < 128) { const int c = tid >> 1, bb = tid & 1; float a = 0.f; for (int w8 = 0; w8 < 8; ++w8) a += red[(w8 * 64 + c) * 2 + bb];
              MOD[(l * 2 + bb) * 6144 + (item % 96) * 64 + c] = a + p.ada_b[l * 6144 + (item % 96) * 64 + c]; }
      }
      __syncthreads(); }
    float* COSA = (float*)(ws_ + OFF_COSA); float* SINA = (float*)(ws_ + OFF_SINA);
    float* COSI = (float*)(ws_ + OFF_COSI); float* SINI = (float*)(ws_ + OFF_SINI);
    for (size_t i = gid; i < (size_t)NT * 64; i += nthr) {
        const int t = (int)(i >> 6), j = (int)(i & 63);
        double s, c; sincos_d((double)p.pos[t] * ipow_d(p.rA, j), s, c);
        COSA[i] = (float)c; SINA[i] = (float)s;
    }
    for (size_t i = gid; i < (size_t)NT * 32; i += nthr) {
        const int t = (int)(i >> 5), j = (int)(i & 31);
        double s, c; sincos_d((double)p.pos[t] * ipow_d(p.rI, j), s, c);
        COSI[i] = (float)c; SINI[i] = (float)s;
    }
}

PHASE_FN void ph_rows(const Params& p, int layer, int mode, float* smem) {
    unsigned char* ws_ = p.ws; asm volatile("" : "+s"(ws_));
    { int ldz_ = 0; asm volatile("" : "+s"(ldz_)); smem = (float*)(g_smem + ldz_); }
    int tid_ = threadIdx.x; asm volatile("" : "+v"(tid_)); const int tid = tid_, lane = tid & 63, wv = tid >> 6;
    int* pad = (int*)smem;
    const int moe_layer = (mode == 1) ? 3 : layer - 1;
    if (moe_layer >= 0) {
        if (tid == 0) { const int* cnt = (const int*)(ws_ + OFF_CNT) + moe_layer * 32 * CSTR; int a = 0; for (int e = 0; e < 32; ++e) { pad[e] = a; a += ((cnt[e * CSTR] + 127) / 128) * 128; } }
        __syncthreads();
    }
    const float* MOD = (const float*)(ws_ + OFF_MOD);
    bf16_t* H = (bf16_t*)(ws_ + OFF_H);
    const bf16_t* YB = (const bf16_t*)(ws_ + OFF_YB);
    const int* ASG = (const int*)(ws_ + OFF_ASG);
    const float* GATE = (const float*)(ws_ + OFF_GATE);
    auto load_x = [&](int row, float (&xv)[16]) {
        const float* xin = (mode == 0 && layer == 0) ? (p.x + (size_t)row * ND) : (p.X + (size_t)row * ND);
#pragma unroll
        for (int j = 0; j < 4; ++j) { const float4 v = *(const float4*)(xin + j * 256 + lane * 4); xv[4 * j] = v.x; xv[4 * j + 1] = v.y; xv[4 * j + 2] = v.z; xv[4 * j + 3] = v.w; }
    };
    auto load_y = [&](int row, uint2 (&ya)[4], uint2 (&yb)[4], float& g0, float& g1) {
        const int4 as = *(const int4*)(ASG + row * 4);
        g0 = GATE[row * 2]; g1 = GATE[row * 2 + 1];
        const bf16_t* y0 = YB + (size_t)(pad[as.x] + as.y) * ND;
        const bf16_t* y1 = YB + (size_t)(pad[as.z] + as.w) * ND;
#pragma unroll
        for (int j = 0; j < 4; ++j) { ya[j] = *(const uint2*)(y0 + j * 256 + lane * 4); yb[j] = *(const uint2*)(y1 + j * 256 + lane * 4); }
    };
    auto finish = [&](int row, float (&xv)[16], const uint2 (&ya)[4], const uint2 (&yb)[4], float g0, float g1) {
        const int b = row >> 13;
        float* xr = p.X + (size_t)row * ND;
        if (moe_layer >= 0) {
            const float* gt = MOD + (size_t)(moe_layer * 2 + b) * 6144 + 5 * 1024;
#pragma unroll
            for (int j = 0; j < 4; ++j) {
                const int col = j * 256 + lane * 4;
                const f32x4 a = unpack4(ya[j]), bq = unpack4(yb[j]); const float4 g = *(const float4*)(gt + col);
                xv[4 * j] += g.x * (g0 * a[0] + g1 * bq[0]); xv[4 * j + 1] += g.y * (g0 * a[1] + g1 * bq[1]);
                xv[4 * j + 2] += g.z * (g0 * a[2] + g1 * bq[2]); xv[4 * j + 3] += g.w * (g0 * a[3] + g1 * bq[3]);
                if (mode == 0) *(float4*)(xr + col) = make_float4(xv[4 * j], xv[4 * j + 1], xv[4 * j + 2], xv[4 * j + 3]);
            }
        }
        float ss = 0.f;
#pragma unroll
        for (int j = 0; j < 16; ++j) ss += xv[j] * xv[j];
        ss = wave_sum(ss);
        const float rstd = rsqrtf(ss * (1.f / 1024.f) + EPS);
        if (mode == 0) {
            const float* nw = p.norm_mix + layer * 1024;
            const float* sh = MOD + (size_t)(layer * 2 + b) * 6144;
            const float* sc = sh + 1024;
#pragma unroll
            for (int j = 0; j < 4; ++j) {
                const int col = j * 256 + lane * 4;
                const float4 w = *(const float4*)(nw + col), s4 = *(const float4*)(sc + col), h4 = *(const float4*)(sh + col);
                f32x4 ov;
                ov[0] = xv[4 * j] * rstd * w.x * (1.f + s4.x) + h4.x; ov[1] = xv[4 * j + 1] * rstd * w.y * (1.f + s4.y) + h4.y;
                ov[2] = xv[4 * j + 2] * rstd * w.z * (1.f + s4.z) + h4.z; ov[3] = xv[4 * j + 3] * rstd * w.w * (1.f + s4.w) + h4.w;
                *(uint2*)(H + (size_t)row * ND + col) = pack4(ov);
            }
        } else {
#pragma unroll
            for (int j = 0; j < 4; ++j) {
                const int col = j * 256 + lane * 4;
                const float4 w = *(const float4*)(p.final_norm + col);
                *(float4*)(xr + col) = make_float4(xv[4 * j] * rstd * w.x, xv[4 * j + 1] * rstd * w.y, xv[4 * j + 2] * rstd * w.z, xv[4 * j + 3] * rstd * w.w);
            }
        }
    };
    const int stride = gridDim.x * 8;
    for (int row = blockIdx.x * 8 + wv; row < NT; row += 2 * stride) {
        const int rowB = row + stride; const bool hasB = rowB < NT; const int rB = hasB ? rowB : row;
        float xa[16], xb[16]; uint2 yaa[4], yab[4], yba[4], ybb[4]; float ga0 = 0.f, ga1 = 0.f, gb0 = 0.f, gb1 = 0.f;
        load_x(row, xa); load_x(rB, xb);
        if (moe_layer >= 0) { load_y(row, yaa, yab, ga0, ga1); load_y(rB, yba, ybb, gb0, gb1); }
        finish(row, xa, yaa, yab, ga0, ga1);
        if (hasB) finish(rowB, xb, yba, ybb, gb0, gb1);
    }
}

PHASE_FN void ph_gemm_in(const Params& p, int layer, bool even, float* smem) {
    unsigned char* ws_ = p.ws; asm volatile("" : "+s"(ws_));
    { int ldz_ = 0; asm volatile("" : "+s"(ldz_)); smem = (float*)(g_smem + ldz_); }
    const int N = even ? 3916 : 3088, ntn = even ? 31 : 25;
    const bf16_t* Wt = even ? (const bf16_t*)(ws_ + OFF_WINE) + (size_t)(layer >> 1) * 3968 * 1024 : (const bf16_t*)(ws_ + OFF_WINO) + (size_t)(layer >> 1) * 3200 * 1024;
    const bf16_t* H = (const bf16_t*)(ws_ + OFF_H);
    bf16_t* P = (bf16_t*)(ws_ + OFF_P);
    float* AUX = (float*)(ws_ + OFF_AUX);
    const int vb_ = (((int)gridDim.x & 7) == 0) ? (((int)blockIdx.x & 7) * ((int)gridDim.x >> 3) + ((int)blockIdx.x >> 3)) : (int)blockIdx.x;
    for (int tile = vb_; tile < 64 * ntn; tile += gridDim.x) {
        const int grp_ = tile / (8 * ntn), rr_ = tile % (8 * ntn), mt = grp_ * 8 + (rr_ & 7), nt = rr_ >> 3;
        const bf16_t* Ab = H + (size_t)mt * 256 * 1024;
        const bf16_t* Bb = Wt + (size_t)nt * 128 * 1024;
        bf16_t* Pt = P + (size_t)mt * 256 * LDPB + nt * 128;
        float* At = AUX + (size_t)mt * 256 * 16;
        const int ncol0 = nt * 128;
        const int nrem = N - nt * 128;
        gemm_tile_bf16(1024, (unsigned char*)smem,
            [=](int i, int r, int k) -> uint4 { return *(const uint4*)(Ab + (size_t)r * 1024 + k); },
            [=](int i, int r, int k) -> uint4 { return *(const uint4*)(Bb + (size_t)r * 1024 + k); },
            [=](const f32x4 (&acc)[4][4], int wm, int wn, int lane) {
#pragma unroll
                for (int mi = 0; mi < 4; ++mi)
#pragma unroll
                    for (int ni = 0; ni < 4; ++ni) {
                        const int m = wm * 64 + mi * 16 + (lane & 15), n = wn * 64 + ni * 16 + 4 * (lane >> 4);
                        if (n < nrem) {
                            *(uint2*)(Pt + (size_t)m * LDPB + n) = pack4(acc[mi][ni]);
                            const int gc = ncol0 + n;
                            int ax = -1;
                            if (even) { if (gc == 2048) ax = 0; else if (gc == 2052) ax = 4; else if (gc == 3912) ax = 8; }
                            else { if (gc >= 3072 && gc < 3088) ax = gc - 3072; }
                            if (ax >= 0) *(f32x4*)(At + (size_t)m * 16 + ax) = acc[mi][ni];
                        }
                    }
            });
    }
}

PHASE_FN void ph_even_tok(const Params& p, int layer, float* smem) {
    unsigned char* ws_ = p.ws; asm volatile("" : "+s"(ws_));
    { int ldz_ = 0; asm volatile("" : "+s"(ldz_)); smem = (float*)(g_smem + ldz_); }
    int tid_ = threadIdx.x; asm volatile("" : "+v"(tid_)); const int tid = tid_, lane = tid & 63, wv = tid >> 6, li = layer >> 1;
    const bf16_t* P = (const bf16_t*)(ws_ + OFF_P); const float* AUX = (const float*)(ws_ + OFF_AUX);
    bf16_t* QB = (bf16_t*)(ws_ + OFF_QBB); bf16_t* KB = (bf16_t*)(ws_ + OFF_KBB); bf16_t* QI = (bf16_t*)(ws_ + OFF_QIB); bf16_t* KI = (bf16_t*)(ws_ + OFF_KIB); float* WI = (float*)(ws_ + OFF_WI);
    const float* COSA = (const float*)(ws_ + OFF_COSA); const float* SINA = (const float*)(ws_ + OFF_SINA);
    const float* COSI = (const float*)(ws_ + OFF_COSI); const float* SINI = (const float*)(ws_ + OFF_SINI);
    for (int t = blockIdx.x * 8 + wv; t < NT; t += gridDim.x * 8) {
        const bf16_t* Pt = P + (size_t)t * LDPB;
        if (lane < 4) {
            WI[t * 4 + lane] = AUX[(size_t)t * 16 + 8 + lane] * 0.0625f;
        }
        { const float c = COSA[(size_t)t * 64 + lane], sn = SINA[(size_t)t * 64 + lane];
#pragma unroll
          for (int h = 0; h < 4; ++h) {
              float t1 = bf16_to_f32(Pt[2056 + h * 128 + lane]), t2 = bf16_to_f32(Pt[2056 + h * 128 + 64 + lane]);
              QB[(size_t)t * 512 + h * 128 + lane] = f2bf(t1 * c - t2 * sn); QB[(size_t)t * 512 + h * 128 + 64 + lane] = f2bf(t2 * c + t1 * sn);
              t1 = bf16_to_f32(Pt[2568 + h * 128 + lane]); t2 = bf16_to_f32(Pt[2568 + h * 128 + 64 + lane]);
              KB[(size_t)t * 512 + h * 128 + lane] = f2bf(t1 * c - t2 * sn); KB[(size_t)t * 512 + h * 128 + 64 + lane] = f2bf(t2 * c + t1 * sn);
          } }
#pragma unroll
        for (int r = 0; r < 2; ++r) {
            const int item = lane + 64 * r, hh = item >> 5, ii = item & 31;
            const float c = COSI[(size_t)t * 32 + ii], sn = SINI[(size_t)t * 32 + ii];
            const float t1 = bf16_to_f32(Pt[3592 + hh * 64 + ii]), t2 = bf16_to_f32(Pt[3592 + hh * 64 + 32 + ii]);
            QI[(size_t)t * 256 + hh * 64 + ii] = f2bf(t1 * c - t2 * sn); QI[(size_t)t * 256 + hh * 64 + 32 + ii] = f2bf(t2 * c + t1 * sn);
        }
        if (lane < 32) {
            const float c = COSI[(size_t)t * 32 + lane], sn = SINI[(size_t)t * 32 + lane];
            const float t1 = bf16_to_f32(Pt[3848 + lane]), t2 = bf16_to_f32(Pt[3848 + 32 + lane]);
            KI[(size_t)t * 64 + lane] = f2bf(t1 * c - t2 * sn); KI[(size_t)t * 64 + 32 + lane] = f2bf(t2 * c + t1 * sn);
        }
    }
    { bf16_t* VT = (bf16_t*)(ws_ + OFF_VT);
      bf16_t* sv = (bf16_t*)g_smem;
      for (int item = blockIdx.x; item < 2 * 128 * 4; item += gridDim.x) {
          const int h = item & 3, tt = item >> 2, b = tt >> 7, s0 = (tt & 127) * 64;
          __syncthreads();
          for (int e = tid; e < 64 * 128; e += NTHREADS) { const int i = e >> 7, d = e & 127; sv[d * 72 + i] = P[(size_t)(b * 8192 + s0 + i) * LDPB + 3080 + h * 128 + d]; }
          __syncthreads();
          for (int e = tid; e < 128 * 8; e += NTHREADS) { const int d = e >> 3, c = e & 7;
              *(uint4*)(VT + ((size_t)((b * 4 + h) * 128 + d)) * 8192 + s0 + c * 8) = *(const uint4*)(sv + d * 72 + c * 8); }
      } }
}

__device__ __forceinline__ f32x4 mma_lds(const unsigned char* A, int sa, int a0, const unsigned char* B, int sb, int b0, int K, f32x4 acc, int c16, int q4) {
    const unsigned char* ap = A + (a0 + c16) * sa + q4 * 16;
    const unsigned char* bp = B + (b0 + c16) * sb + q4 * 16;
    for (int kk = 0; kk < K; kk += 32) { acc = __builtin_amdgcn_mfma_f32_16x16x32_bf16(*(const bf16x8*)(ap + kk * 2), *(const bf16x8*)(bp + kk * 2), acc, 0, 0, 0); }
    return acc;
}

PHASE_FN void ph_gdn_chunk(const Params& p, int layer, float* smem) {
    unsigned char* ws_ = p.ws; asm volatile("" : "+s"(ws_));
    int tid_ = threadIdx.x; asm volatile("" : "+v"(tid_)); const int tid = tid_, lane = tid & 63, wv = __builtin_amdgcn_readfirstlane(tid >> 6), q4 = lane >> 4, c16 = lane & 15;
    int ldz_ = 0; asm volatile("" : "+s"(ldz_)); unsigned char* lds = g_smem + ldz_;
    constexpr int SN = 272, ST = 144;
    unsigned char* bKN = lds;
    unsigned char* bQN = lds + 18432;
    unsigned char* bKBG = lds + 35840;
    unsigned char* bVB = lds + 54272;
    unsigned char* bKD = lds + 72704;
    unsigned char* bUT = lds + 91136;
    float* sL = (float*)(lds + 109568);
    unsigned char* bAQK = lds + 126208;
    unsigned char* bTB = lds + 135424;
    float* sG = (float*)(lds + 144640); float* sB = sG + 64; float* sEg = sB + 64;
    const int li = layer >> 1;
    const bf16_t* P = (const bf16_t*)(ws_ + OFF_P); const float* AUX = (const float*)(ws_ + OFF_AUX);
    const float* cw = p.conv_w + (size_t)li * 4 * 1536;
    uint4* PFR = (uint4*)(ws_ + OFF_PFR); uint4* RFR = (uint4*)(ws_ + OFF_RFR); uint2* QFR = (uint2*)(ws_ + OFF_QFR); uint2* OFR = (uint2*)(ws_ + OFF_OFR);
    float* GL = (float*)(ws_ + OFF_GL);
    for (int ci = blockIdx.x; ci < 1024; ci += gridDim.x) {
        const int b = ci >> 9, h = (ci >> 7) & 3, n = ci & 127;
        const int t0 = b * 8192 + n * 64;
        __syncthreads();
        if (tid < 64) { float g = -expf(p.a_log[li * 4 + h]) * softplusf_(AUX[(size_t)(t0 + tid) * 16 + 4 + h] + p.dt_bias[li * 4 + h]);
#pragma unroll
            for (int o = 1; o < 64; o <<= 1) { const float nb = __shfl_up(g, o); if (lane >= o) g += nb; }
            sG[tid] = g; sB[tid] = sigmoidf_(AUX[(size_t)(t0 + tid) * 16 + h]); sEg[tid] = expf(g); }
        for (int e = tid; e < 64 * 36; e += NTHREADS) ((unsigned*)bAQK)[e] = 0u;
        __syncthreads();
        const float gl = sG[63];
        {
            const int d0 = 2 * lane, cb = h * 128 + d0, s00 = n * 64;
            float wq[4][2], wk[4][2], wvv[4][2];
#pragma unroll
            for (int jj = 0; jj < 4; ++jj) { wq[jj][0] = cw[jj * 1536 + cb]; wq[jj][1] = cw[jj * 1536 + cb + 1]; wk[jj][0] = cw[jj * 1536 + 512 + cb]; wk[jj][1] = cw[jj * 1536 + 512 + cb + 1];
                                            wvv[jj][0] = cw[jj * 1536 + 1024 + cb]; wvv[jj][1] = cw[jj * 1536 + 1024 + cb + 1]; }
#pragma unroll 4
            for (int r = 0; r < 8; ++r) {
                const int i = wv + 8 * r;
                float aq0 = 0.f, aq1 = 0.f, ak0 = 0.f, ak1 = 0.f, av0 = 0.f, av1 = 0.f;
#pragma unroll
                for (int jj = 0; jj < 4; ++jj) {
                    if (s00 + i - 3 + jj >= 0) {
                        const bf16_t* rp = P + (size_t)(t0 + i - 3 + jj) * LDPB + cb;
                        const unsigned uq = *(const unsigned*)rp, uk = *(const unsigned*)(rp + 512), uv = *(const unsigned*)(rp + 1024);
                        aq0 += wq[jj][0] * __uint_as_float(uq << 16); aq1 += wq[jj][1] * __uint_as_float(uq & 0xffff0000u);
                        ak0 += wk[jj][0] * __uint_as_float(uk << 16); ak1 += wk[jj][1] * __uint_as_float(uk & 0xffff0000u);
                        av0 += wvv[jj][0] * __uint_as_float(uv << 16); av1 += wvv[jj][1] * __uint_as_float(uv & 0xffff0000u);
                    }
                }
                aq0 = siluf_(aq0); aq1 = siluf_(aq1); ak0 = siluf_(ak0); ak1 = siluf_(ak1); av0 = siluf_(av0); av1 = siluf_(av1);
                const float rq = rsqrtf(wave_sum(aq0 * aq0 + aq1 * aq1) + EPS), rk = rsqrtf(wave_sum(ak0 * ak0 + ak1 * ak1) + EPS);
                aq0 *= rq; aq1 *= rq; ak0 *= rk; ak1 *= rk;
                const float be = sB[i], eg_i = sEg[i], ekd = expf(gl - sG[i]);
                *(unsigned*)(bKN + i * SN + d0 * 2) = cvt_pk_bf16(ak0, ak1);
                *(unsigned*)(bQN + i * SN + d0 * 2) = cvt_pk_bf16(aq0, aq1);
                *(bf16_t*)(bKBG + d0 * ST + i * 2) = f2bf(ak0 * be * eg_i); *(bf16_t*)(bKBG + (d0 + 1) * ST + i * 2) = f2bf(ak1 * be * eg_i);
                *(bf16_t*)(bVB + d0 * ST + i * 2) = f2bf(av0 * be); *(bf16_t*)(bVB + (d0 + 1) * ST + i * 2) = f2bf(av1 * be);
                *(bf16_t*)(bKD + d0 * ST + i * 2) = f2bf(ak0 * ekd); *(bf16_t*)(bKD + (d0 + 1) * ST + i * 2) = f2bf(ak1 * ekd);
            }
        }
        __syncthreads();
        for (int u = wv; u < 20; u += 8) {
            const int kind = (u >= 10) ? 1 : 0, idx = u - kind * 10;
            const int ti = (idx >= 6) ? 3 : (idx >= 3) ? 2 : (idx >= 1) ? 1 : 0, tj = idx - ((ti * (ti + 1)) >> 1);
            f32x4 acc = (f32x4){0.f, 0.f, 0.f, 0.f};
            acc = mma_lds(kind ? bQN : bKN, SN, 16 * ti, bKN, SN, 16 * tj, 128, acc, c16, q4);
            const int j = 16 * tj + c16;
#pragma unroll
            for (int r = 0; r < 4; ++r) { const int i = 16 * ti + 4 * q4 + r;
                const float dec = (j <= i) ? expf(sG[i] - sG[j]) : 0.f;
                if (kind == 0) sL[i * 65 + j] = (j < i) ? sB[i] * acc[r] * dec : 0.f;
                else *(bf16_t*)(bAQK + i * ST + j * 2) = f2bf(acc[r] * SCALE128 * dec); }
        }
        __syncthreads();
        if (wv == 0) {
            float t[64];
            int zz = 0; asm volatile("" : "+v"(zz)); const float* sLo = sL + zz;
#pragma unroll
            for (int i = 0; i < 64; ++i) { float a = (i == lane) ? 1.f : 0.f;
#pragma unroll
                for (int j = 0; j < i; ++j) a -= sLo[i * 65 + j] * t[j];
                t[i] = a; asm volatile("" ::: "memory"); }
#pragma unroll
            for (int i = 0; i < 64; ++i) *(bf16_t*)(bTB + i * ST + lane * 2) = f2bf(t[i]);
        }
        __syncthreads();
        for (int x = 0; x < 8; ++x) {
            const int u = wv * 8 + x, kind = u >> 5, ti = (u >> 3) & 3, td = u & 7;
            f32x4 acc = (f32x4){0.f, 0.f, 0.f, 0.f};
            acc = mma_lds(bTB, ST, 16 * ti, kind ? bVB : bKBG, ST, 16 * td, 64, acc, c16, q4);
            *(uint2*)((kind ? bUT : bKN) + (16 * td + c16) * ST + (16 * ti + 4 * q4) * 2) = pack4(acc);
        }
        __syncthreads();
        unsigned char* bWT = bKN;
        const float eg = expf(gl);
        for (int x = 0; x < 4; ++x) {
            const int u = wv * 4 + x, ti = u >> 2, a = u & 3;
            uint4 fr;
#pragma unroll
            for (int hf = 0; hf < 2; ++hf) { const int tk = 2 * a + hf;
                f32x4 acc = (f32x4){0.f, 0.f, 0.f, 0.f};
                acc = mma_lds(bWT, ST, 16 * tk, bKD, ST, 16 * ti, 64, acc, c16, q4);
                f32x4 v;
#pragma unroll
                for (int r = 0; r < 4; ++r) v[r] = ((16 * tk + 4 * q4 + r) == (16 * ti + c16) ? eg : 0.f) - acc[r];
                const uint2 pk = pack4(v);
                if (hf == 0) { fr.x = pk.x; fr.y = pk.y; } else { fr.z = pk.x; fr.w = pk.y; } }
            PFR[((size_t)(ci * 8 + ti) * 4 + a) * 64 + lane] = fr;
        }
        for (int x = 0; x < 2; ++x) {
            const int u = wv * 2 + x, ti = u >> 2, a = u & 3;
            uint4 fr;
            const int i = 16 * ti + c16;
            const float qs = SCALE128 * sEg[i];
#pragma unroll
            for (int hf = 0; hf < 2; ++hf) { const int tk = 2 * a + hf;
                f32x4 acc = (f32x4){0.f, 0.f, 0.f, 0.f};
                acc = mma_lds(bWT, ST, 16 * tk, bAQK, ST, 16 * ti, 64, acc, c16, q4);
                const f32x4 qv = unpack4(*(const uint2*)(bQN + i * SN + (16 * tk + 4 * q4) * 2));
                const uint2 pk = pack4(qv * qs - acc);
                if (hf == 0) { fr.x = pk.x; fr.y = pk.y; } else { fr.z = pk.x; fr.w = pk.y; } }
            RFR[((size_t)(ci * 4 + ti) * 4 + a) * 64 + lane] = fr;
        }
        for (int x = 0; x < 8; ++x) {
            const int u = wv * 8 + x, tdv = u >> 3, tdk = u & 7;
            f32x4 acc = (f32x4){0.f, 0.f, 0.f, 0.f};
            acc = mma_lds(bKD, ST, 16 * tdk, bUT, ST, 16 * tdv, 64, acc, c16, q4);
            QFR[((size_t)(ci * 8 + tdv) * 8 + tdk) * 64 + lane] = pack4(acc);
        }
        for (int x = 0; x < 4; ++x) {
            const int u = wv * 4 + x, tdv = u >> 2, ti = u & 3;
            f32x4 acc = (f32x4){0.f, 0.f, 0.f, 0.f};
            acc = mma_lds(bAQK, ST, 16 * ti, bUT, ST, 16 * tdv, 64, acc, c16, q4);
            OFR[((size_t)(ci * 8 + tdv) * 4 + ti) * 64 + lane] = pack4(acc);
        }
        if (tid == 0) GL[ci] = gl;
    }
}

__device__ __forceinline__ void gs_load(uint4 (&d)[12], const unsigned char* pp, const unsigned char* rr, const unsigned char* qq, const unsigned char* oo, const int lt) {
#pragma unroll
    for (int i = 0; i < 6; ++i) { int c = lt + 384 * i; c = c < 2048 ? c : 2047; d[i] = *(const uint4*)(pp + c * 16); }
#pragma unroll
    for (int i = 0; i < 3; ++i) { int c = lt + 384 * i; c = c < 1024 ? c : 1023; d[6 + i] = *(const uint4*)(rr + c * 16); }
#pragma unroll
    for (int i = 0; i < 2; ++i) { int c = lt + 384 * i; c = c < 512 ? c : 511; d[9 + i] = *(const uint4*)(qq + c * 16); }
    { const int c = lt < 256 ? lt : 255; d[11] = *(const uint4*)(oo + c * 16); }
}
__device__ __forceinline__ void gs_store(const uint4 (&d)[12], unsigned char* sb, const int lt) {
#pragma unroll
    for (int i = 0; i < 6; ++i) { const int c = lt + 384 * i; if (c < 2048) *(uint4*)(sb + c * 16) = d[i]; }
#pragma unroll
    for (int i = 0; i < 3; ++i) { const int c = lt + 384 * i; if (c < 1024) *(uint4*)(sb + 32768 + c * 16) = d[6 + i]; }
#pragma unroll
    for (int i = 0; i < 2; ++i) { const int c = lt + 384 * i; if (c < 512) *(uint4*)(sb + 49152 + c * 16) = d[9 + i]; }
    if (lt < 256) *(uint4*)(sb + 57344 + lt * 16) = d[11];
}

#define SCAN_BODY                 bf16x8 Sb[4]; \
_Pragma("unroll") \
                for (int a = 0; a < 4; ++a) { union { uint4 u; bf16x8 v; } cv; const uint2 lo = pack4(S[2 * a]), hi = pack4(S[2 * a + 1]); cv.u.x = lo.x; cv.u.y = lo.y; cv.u.z = hi.x; cv.u.w = hi.y; Sb[a] = cv.v; } \
                const int t0 = b * 8192 + n * 64; \
                {   f32x4 oa[4]; \
_Pragma("unroll") \
                    for (int ti = 0; ti < 4; ++ti) oa[ti] = unpack4(*(const uint2*)(Of + ti * 512)); \
_Pragma("unroll") \
                    for (int a = 0; a < 4; ++a) \
_Pragma("unroll") \
                        for (int ti = 0; ti < 4; ++ti) oa[ti] = __builtin_amdgcn_mfma_f32_16x16x32_bf16(*(const bf16x8*)(Rf + (ti * 4 + a) * 1024), Sb[a], oa[ti], 0, 0, 0); \
_Pragma("unroll") \
                    for (int ti = 0; ti < 4; ++ti) { \
                        float* op = O + (size_t)(t0 + 16 * ti + 4 * q4) * 1024 + h * 128 + 16 * tdv + c16; \
                        op[0] = oa[ti][0]; op[1024] = oa[ti][1]; op[2048] = oa[ti][2]; op[3072] = oa[ti][3]; } \
                } \
                asm volatile("" ::: "memory"); \
_Pragma("unroll") \
                for (int g = 0; g < 2; ++g) { \
                    f32x4 sa[4]; \
_Pragma("unroll") \
                    for (int t = 0; t < 4; ++t) sa[t] = unpack4(*(const uint2*)(Qf + (g * 4 + t) * 512)); \
_Pragma("unroll") \
                    for (int a = 0; a < 4; ++a) \
_Pragma("unroll") \
                        for (int t = 0; t < 4; ++t) sa[t] = __builtin_amdgcn_mfma_f32_16x16x32_bf16(*(const bf16x8*)(Pf + ((g * 4 + t) * 4 + a) * 1024), Sb[a], sa[t], 0, 0, 0); \
_Pragma("unroll") \
                    for (int t = 0; t < 4; ++t) S[g * 4 + t] = sa[t]; \
                    asm volatile("" ::: "memory"); \
                }
PHASE_FN void ph_gdn_scan(const Params& p, float* smem) {
    unsigned char* ws_ = p.ws; asm volatile("" : "+s"(ws_));
    int tid_ = threadIdx.x; asm volatile("" : "+v"(tid_)); const int tid = tid_, lane = tid & 63, wv = __builtin_amdgcn_readfirstlane(tid >> 6), q4 = lane >> 4, c16 = lane & 15;
    int ldz_ = 0; asm volatile("" : "+s"(ldz_)); unsigned char* lds = g_smem + ldz_;
    constexpr int STG = 61440;
    const unsigned char* PFR = ws_ + OFF_PFR; const unsigned char* RFR = ws_ + OFF_RFR; const unsigned char* QFR = ws_ + OFF_QFR; const unsigned char* OFR = ws_ + OFF_OFR;
    float* O = (float*)(ws_ + OFF_O);
    for (int it = blockIdx.x; it < 32; it += gridDim.x) {
        const int bh = it >> 2, pair = it & 3, b = bh >> 2, h = bh & 3;
        __syncthreads();
        if (wv >= 2) {
            const int lt = tid - 128;
            const unsigned char* Pb = PFR + (size_t)bh * 128 * 32768;
            const unsigned char* Rb = RFR + (size_t)bh * 128 * 16384;
            const unsigned char* Qb = QFR + (size_t)bh * 128 * 32768 + pair * 8192;
            const unsigned char* Ob = OFR + (size_t)bh * 128 * 16384 + pair * 4096;
            uint4 ra0, ra1, ra2, ra3, ra4, ra5, ra6, ra7, ra8, ra9, ra10, ra11, rb0, rb1, rb2, rb3, rb4, rb5, rb6, rb7, rb8, rb9, rb10, rb11;
            uint4 rc0, rc1, rc2, rc3, rc4, rc5, rc6, rc7, rc8, rc9, rc10, rc11;
#define LDC(base_, c_, mx_) (*(const uint4*)((base_) + (size_t)(((c_) < (mx_)) ? (c_) : (mx_)) * 16))
#define GS_LOAD(X, n_) do { const unsigned char* pp_ = Pb + (size_t)(n_) * 32768; const unsigned char* rr_ = Rb + (size_t)(n_) * 16384; \
                const unsigned char* qq_ = Qb + (size_t)(n_) * 32768; const unsigned char* oo_ = Ob + (size_t)(n_) * 16384; \
                X##0 = LDC(pp_, lt, 2047); X##1 = LDC(pp_, lt + 384, 2047); X##2 = LDC(pp_, lt + 768, 2047); X##3 = LDC(pp_, lt + 1152, 2047); X##4 = LDC(pp_, lt + 1536, 2047); X##5 = LDC(pp_, lt + 1920, 2047); \
                X##6 = LDC(rr_, lt, 1023); X##7 = LDC(rr_, lt + 384, 1023); X##8 = LDC(rr_, lt + 768, 1023); \
                X##9 = LDC(qq_, lt, 511); X##10 = LDC(qq_, lt + 384, 511); X##11 = LDC(oo_, lt, 255); } while (0)
#define STC(off_, c_, lim_, v_) do { if ((c_) < (lim_)) *(uint4*)(sb_ + (off_) + (c_) * 16) = v_; } while (0)
#define GS_STORE(X, st_) do { unsigned char* sb_ = lds + (st_) * STG; \
                STC(0, lt, 2048, X##0); STC(0, lt + 384, 2048, X##1); STC(0, lt + 768, 2048, X##2); STC(0, lt + 1152, 2048, X##3); STC(0, lt + 1536, 2048, X##4); STC(0, lt + 1920, 2048, X##5); \
                STC(32768, lt, 1024, X##6); STC(32768, lt + 384, 1024, X##7); STC(32768, lt + 768, 1024, X##8); \
                STC(49152, lt, 512, X##9); STC(49152, lt + 384, 512, X##10); STC(57344, lt, 256, X##11); } while (0)
            GS_LOAD(ra, 0); GS_STORE(ra, 0);
            GS_LOAD(rb, 1); GS_LOAD(rc, 2); GS_LOAD(ra, 3);
            __syncthreads();
#define CLAMPN(x_) (((x_) < 128) ? (x_) : 127)
            for (int n = 0; n < 128; n += 3) {
                if (n + 1 < 128) GS_STORE(rb, (n + 1) & 1);
                GS_LOAD(rb, CLAMPN(n + 4)); __syncthreads();
                if (n + 1 < 128) { if (n + 2 < 128) GS_STORE(rc, (n + 2) & 1);
                    GS_LOAD(rc, CLAMPN(n + 5)); __syncthreads(); }
                if (n + 2 < 128) { if (n + 3 < 128) GS_STORE(ra, (n + 3) & 1);
                    GS_LOAD(ra, CLAMPN(n + 6)); __syncthreads(); }
            }
        } else {
            const int tdv = pair * 2 + wv;
            f32x4 S[8];
#pragma unroll
            for (int t = 0; t < 8; ++t) S[t] = (f32x4){0.f, 0.f, 0.f, 0.f};
            __syncthreads();
            for (int n = 0; n < 128; ++n) {
                const unsigned char* base = lds + (n & 1) * STG;
                const unsigned char* Pf = base + lane * 16, *Rf = base + 32768 + lane * 16;
                const unsigned char* Qf = base + 49152 + wv * 4096 + lane * 8, *Of = base + 57344 + wv * 2048 + lane * 8;
                SCAN_BODY
                __syncthreads();
            }
        }
    }
}

__device__ __forceinline__ void block_sum4(int (&v)[4], int* buf) {
    const int lane = threadIdx.x & 63, wv = threadIdx.x >> 6;
#pragma unroll
    for (int q = 0; q < 4; ++q) v[q] = wave_sum_i(v[q]);
    if (lane == 0) {
#pragma unroll
        for (int q = 0; q < 4; ++q) buf[wv * 4 + q] = v[q];
    }
    __syncthreads();
#pragma unroll
    for (int q = 0; q < 4; ++q) { int a = 0; for (int w = 0; w < 8; ++w) a += buf[w * 4 + q]; v[q] = a; }
}

PHASE_FN void ph_dsa_topk(const Params& p, int layer, float* smem) {
    unsigned char* ws_ = p.ws; asm volatile("" : "+s"(ws_));
    int tid_ = threadIdx.x; asm volatile("" : "+v"(tid_)); const int tid = tid_, lane = tid & 63, wv = __builtin_amdgcn_readfirstlane(tid >> 6), q4 = lane >> 4, c16 = lane & 15;
    int* sRed = (int*)g_smem;
    const bf16_t* QIb = (const bf16_t*)(ws_ + OFF_QIB); const bf16_t* KIb = (const bf16_t*)(ws_ + OFF_KIB); const float* WI = (const float*)(ws_ + OFF_WI);
    unsigned short* M16 = (unsigned short*)(ws_ + OFF_M16);
    int* qhead = (int*)(ws_ + OFF_QCTR) + layer * 16;
    int* sIt = (int*)(g_smem + 512);
    for (;;) {
        __syncthreads();
        if (tid == 0) *sIt = atomicAdd(qhead, 1);
        __syncthreads();
        const int it = *sIt;
        if (it >= 2048) break;
        const int b = it & 1, gp = 1023 - (it >> 1);
        const int s0 = gp * 8, t0 = b * 8192 + s0;
        const int ntiles = (s0 >> 4) + 1;
        const int nreg = (ntiles > wv) ? ((ntiles - wv + 7) >> 3) : 0;
        const bf16_t* qp = QIb + (size_t)(t0 + (c16 >> 2)) * 256 + (c16 & 3) * 64 + 8 * q4;
        const bf16x8 a0A = *(const bf16x8*)qp, a1A = *(const bf16x8*)(qp + 32), a0B = *(const bf16x8*)(qp + 4 * 256), a1B = *(const bf16x8*)(qp + 4 * 256 + 32);
        const float4 wqA = *(const float4*)(WI + (size_t)(t0 + q4) * 4), wqB = *(const float4*)(WI + (size_t)(t0 + 4 + q4) * 4);
        const int myqA = s0 + q4, myqB = s0 + 4 + q4;
        int c16s = c16; asm volatile("" : "+v"(c16s));
        int wvs = wv; asm volatile("" : "+s"(wvs));
        unsigned kA[64], kB[64];
#pragma unroll
        for (int i = 0; i < 64; ++i) { kA[i] = 0u; kB[i] = 0u; }
#pragma unroll
        for (int blk = 0; blk < 4; ++blk) if (nreg > blk * 16) {
#pragma unroll
            for (int ii = 0; ii < 16; ++ii) { const int i = blk * 16 + ii, tile = wvs + 8 * i;
                if (tile < ntiles) {
                    const bf16_t* kp = KIb + (size_t)(b * 8192 + tile * 16 + c16s) * 64 + 8 * q4;
                    const bf16x8 k0 = *(const bf16x8*)kp, k1 = *(const bf16x8*)(kp + 32);
                    f32x4 accA = (f32x4){0.f, 0.f, 0.f, 0.f}, accB = accA;
                    accA = __builtin_amdgcn_mfma_f32_16x16x32_bf16(a0A, k0, accA, 0, 0, 0);
                    accB = __builtin_amdgcn_mfma_f32_16x16x32_bf16(a0B, k0, accB, 0, 0, 0);
                    accA = __builtin_amdgcn_mfma_f32_16x16x32_bf16(a1A, k1, accA, 0, 0, 0);
                    accB = __builtin_amdgcn_mfma_f32_16x16x32_bf16(a1B, k1, accB, 0, 0, 0);
                    float sa = 0.f, sb = 0.f;
                    sa += wqA.x * fmaxf(accA[0], 0.f); sa += wqA.y * fmaxf(accA[1], 0.f); sa += wqA.z * fmaxf(accA[2], 0.f); sa += wqA.w * fmaxf(accA[3], 0.f);
                    sb += wqB.x * fmaxf(accB[0], 0.f); sb += wqB.y * fmaxf(accB[1], 0.f); sb += wqB.z * fmaxf(accB[2], 0.f); sb += wqB.w * fmaxf(accB[3], 0.f);
                    const int kidx = tile * 16 + c16s;
                    kA[i] = (kidx <= myqA) ? ordkey(sa) : 0u;
                    kB[i] = (kidx <= myqB) ? ordkey(sb) : 0u;
                }
                if ((ii & 3) == 3) asm volatile("" ::: "memory"); }
        }
        const int keffA = (myqA + 1 < 256) ? (myqA + 1) : 256, keffB = (myqB + 1 < 256) ? (myqB + 1) : 256;
        int par = 0;
        int mydone = 0, alldone = 0;
        int* sDone = sRed + 64;
        auto qsum = [&](int c) -> int {
            c += __shfl_xor(c, 1); c += __shfl_xor(c, 2); c += __shfl_xor(c, 4); c += __shfl_xor(c, 8);
            par ^= 1;
            if (c16 == 0) { sRed[par * 32 + wv * 4 + q4] = c; if (wv == 0) sDone[par * 4 + q4] = (mydone == 3) ? 1 : 0; }
            __syncthreads();
            int a = 0;
#pragma unroll
            for (int w = 0; w < 8; ++w) a += sRed[par * 32 + w * 4 + q4];
            alldone = sDone[par * 4] & sDone[par * 4 + 1] & sDone[par * 4 + 2] & sDone[par * 4 + 3];
            return a;
        };
        unsigned UA = 0u, UB = 0u;
        for (int bit = 31; bit >= 0; --bit) {
            const unsigned candA = UA | (1u << bit), candB = UB | (1u << bit);
            int ca = 0, cb = 0;
            if (!alldone) {
#pragma unroll
            for (int blk = 0; blk < 4; ++blk) if (nreg > blk * 16) {
#pragma unroll
                for (int ii = 0; ii < 16; ++ii) { ca += (kA[blk * 16 + ii] >= candA) ? 1 : 0; cb += (kB[blk * 16 + ii] >= candB) ? 1 : 0; }
            } }
            const int tot = qsum(ca | (cb << 16));
            if ((tot & 0xffff) >= keffA) { UA = candA; mydone = (mydone & 2) | (((tot & 0xffff) == keffA) ? 1 : 0); }
            if ((tot >> 16) >= keffB) { UB = candB; mydone = (mydone & 1) | (((tot >> 16) == keffB) ? 2 : 0); }
        }
        int cg = 0, ce = 0;
#pragma unroll
        for (int i = 0; i < 64; ++i) { cg += (kA[i] > UA) ? 1 : 0; ce += (kA[i] == UA) ? 1 : 0; cg += (kB[i] > UB) ? 65536 : 0; ce += (kB[i] == UB) ? 65536 : 0; }
        cg = qsum(cg); ce = qsum(ce);
        const int needA = keffA - (cg & 0xffff), needB = keffB - (cg >> 16);
        int JA = 8191, JB = 8191;
        par ^= 1;
        if (c16 == 0) sRed[par * 32 + wv * 4 + q4] = (((ce & 0xffff) > needA) || ((ce >> 16) > needB)) ? 1 : 0;
        __syncthreads();
        int anyov = 0;
#pragma unroll
        for (int w = 0; w < 32; ++w) anyov |= sRed[par * 32 + w];
        if (anyov) {
            JA = 0; JB = 0;
            int c16j = c16; asm volatile("" : "+v"(c16j));
            int wvj = wv; asm volatile("" : "+s"(wvj));
            for (int bit = 12; bit >= 0; --bit) {
                const int cjA = JA | (1 << bit), cjB = JB | (1 << bit);
                int c = 0;
#pragma unroll
                for (int i = 0; i < 64; ++i) { const int kidx = (wvj + 8 * i) * 16 + c16j; c += (kA[i] == UA && kidx < cjA) ? 1 : 0; c += (kB[i] == UB && kidx < cjB) ? 65536 : 0; }
                const int tot = qsum(c);
                if ((tot & 0xffff) <= needA - 1) JA = cjA;
                if ((tot >> 16) <= needB - 1) JB = cjB;
            }
        }
        unsigned short* sM = (unsigned short*)(g_smem + 1024);
        ((uint4*)sM)[tid] = make_uint4(0u, 0u, 0u, 0u);
        __syncthreads();
        int c16e = c16; asm volatile("" : "+v"(c16e));
        int wve = wv; asm volatile("" : "+s"(wve));
#pragma unroll
        for (int blk = 0; blk < 4; ++blk) if (nreg > blk * 16) {
#pragma unroll
            for (int ii = 0; ii < 16; ++ii) { const int i = blk * 16 + ii;
                const int tile = wve + 8 * i, kidx = tile * 16 + c16e;
                const bool selA = kA[i] > UA || (kA[i] == UA && kidx <= JA);
                const bool selB = kB[i] > UB || (kB[i] == UB && kidx <= JB);
                const unsigned long long balA = __ballot(selA), balB = __ballot(selB);
                if (c16 == 0) { sM[q4 * 512 + tile] = (unsigned short)((balA >> (16 * q4)) & 0xffffull);
                                sM[(4 + q4) * 512 + tile] = (unsigned short)((balB >> (16 * q4)) & 0xffffull); }
            }
        }
        __syncthreads();
        *(uint4*)(M16 + (size_t)(t0 + (tid >> 6)) * 512 + (tid & 63) * 8) = ((const uint4*)sM)[tid];
    }
}

PHASE_FN void ph_dsa_attn(const Params& p, float* smem) {
    unsigned char* ws_ = p.ws; asm volatile("" : "+s"(ws_));
    int tid_ = threadIdx.x; asm volatile("" : "+v"(tid_)); const int tid = tid_, lane = tid & 63, wv = tid >> 6, q4 = lane >> 4, c16 = lane & 15;
    int ldz_ = 0; asm volatile("" : "+s"(ldz_)); unsigned char* lds = g_smem + ldz_;
    const bf16_t* QBb = (const bf16_t*)(ws_ + OFF_QBB); const bf16_t* KBb = (const bf16_t*)(ws_ + OFF_KBB); const bf16_t* VT = (const bf16_t*)(ws_ + OFF_VT);
    const unsigned short* M16 = (const unsigned short*)(ws_ + OFF_M16);
    bf16_t* OB = (bf16_t*)(ws_ + OFF_OB);
    const float SC = SCALE128 * 1.4426950408889634f;
    for (int it = blockIdx.x; it < 256; it += gridDim.x) {
        const int bh = it & 7, jp = it >> 3, b = bh >> 2, h = bh & 3;
        for (int half = 0; half < 2; ++half) {
            const int jq = half ? jp : 63 - jp;
            const int qs = jq * 128, nkt = 2 * jq + 2;
            const int tq = b * 8192 + qs + wv * 16 + c16;
            bf16x8 qf[4];
#pragma unroll
            for (int a = 0; a < 4; ++a) qf[a] = *(const bf16x8*)(QBb + (size_t)tq * 512 + h * 128 + 8 * q4 + 32 * a);
            float m = -1e30f, lsum = 0.f;
            f32x4 oacc[8];
#pragma unroll
            for (int t = 0; t < 8; ++t) oacc[t] = (f32x4){0.f, 0.f, 0.f, 0.f};
            uint4 rk0, rk1, rv0, rv1;
            const int q0 = tid, q1 = tid + 512;
            const bf16_t* kg0 = KBb + (size_t)(b * 8192 + (q0 >> 4)) * 512 + h * 128 + (q0 & 15) * 8;
            const bf16_t* kg1 = KBb + (size_t)(b * 8192 + (q1 >> 4)) * 512 + h * 128 + (q1 & 15) * 8;
            const bf16_t* vg0 = VT + ((size_t)((b * 4 + h) * 128 + (q0 >> 3))) * 8192 + (q0 & 7) * 8;
            const bf16_t* vg1 = VT + ((size_t)((b * 4 + h) * 128 + (q1 >> 3))) * 8192 + (q1 & 7) * 8;
            const int lk0 = (q0 >> 4) * 256 + ((((q0 & 15)) ^ ((q0 >> 4) & 15)) << 4), lk1 = (q1 >> 4) * 256 + ((((q1 & 15)) ^ ((q1 >> 4) & 15)) << 4);
            const int lv0 = 16384 + (q0 >> 3) * 128 + ((((q0 & 7)) ^ ((q0 >> 3) & 7)) << 4), lv1 = 16384 + (q1 >> 3) * 128 + ((((q1 & 7)) ^ ((q1 >> 3) & 7)) << 4);
#define ATT_GLOAD(kt_) do { rk0 = *(const uint4*)(kg0 + (size_t)(kt_) * 64 * 512); rk1 = *(const uint4*)(kg1 + (size_t)(kt_) * 64 * 512); \
                            rv0 = *(const uint4*)(vg0 + (kt_) * 64); rv1 = *(const uint4*)(vg1 + (kt_) * 64); } while (0)
#define ATT_LSTORE(st_) do { unsigned char* base_ = lds + (st_) * 32768; *(uint4*)(base_ + lk0) = rk0; *(uint4*)(base_ + lk1) = rk1; *(uint4*)(base_ + lv0) = rv0; *(uint4*)(base_ + lv1) = rv1; } while (0)
            __syncthreads();
            ATT_GLOAD(0); ATT_LSTORE(0);
            __syncthreads();
            for (int kt = 0; kt < nkt; ++kt) {
                if (kt + 1 < nkt) ATT_GLOAD(kt + 1);
                const unsigned long long mbits = *(const unsigned long long*)(M16 + (size_t)tq * 512 + 4 * kt);
                const unsigned char* Kt = lds + (kt & 1) * 32768;
                const unsigned char* Vt = Kt + 16384;
                f32x4 sacc[4];
#pragma unroll
                for (int ti = 0; ti < 4; ++ti) { sacc[ti] = (f32x4){0.f, 0.f, 0.f, 0.f};
                    const int row = 16 * ti + c16;
#pragma unroll
                    for (int a = 0; a < 4; ++a) { const bf16x8 kf = *(const bf16x8*)(Kt + row * 256 + ((((q4 + 4 * a)) ^ (row & 15)) << 4));
                        sacc[ti] = __builtin_amdgcn_mfma_f32_16x16x32_bf16(kf, qf[a], sacc[ti], 0, 0, 0); } }
                float mx = m;
#pragma unroll
                for (int ti = 0; ti < 4; ++ti)
#pragma unroll
                    for (int r = 0; r < 4; ++r) { const bool valid = (mbits >> (16 * ti + 4 * q4 + r)) & 1ull; const float v = sacc[ti][r] * SC; sacc[ti][r] = v; mx = fmaxf(mx, valid ? v : -1e30f); }
                mx = fmaxf(mx, __shfl_xor(mx, 16)); mx = fmaxf(mx, __shfl_xor(mx, 32));
                const float alpha = __builtin_amdgcn_exp2f(m - mx); m = mx;
                float ps = 0.f;
#pragma unroll
                for (int ti = 0; ti < 4; ++ti)
#pragma unroll
                    for (int r = 0; r < 4; ++r) { const bool valid = (mbits >> (16 * ti + 4 * q4 + r)) & 1ull; const float pv = valid ? __builtin_amdgcn_exp2f(sacc[ti][r] - mx) : 0.f; sacc[ti][r] = pv; ps += pv; }
                lsum = lsum * alpha + ps;
#pragma unroll
                for (int t = 0; t < 8; ++t) oacc[t] = oacc[t] * alpha;
                bf16x8 pb[2];
#pragma unroll
                for (int a = 0; a < 2; ++a) {
                    union { uint4 u; bf16x8 v; } cv;
                    cv.u.x = cvt_pk_bf16(sacc[2 * a][0], sacc[2 * a][1]); cv.u.y = cvt_pk_bf16(sacc[2 * a][2], sacc[2 * a][3]);
                    cv.u.z = cvt_pk_bf16(sacc[2 * a + 1][0], sacc[2 * a + 1][1]); cv.u.w = cvt_pk_bf16(sacc[2 * a + 1][2], sacc[2 * a + 1][3]);
                    pb[a] = cv.v; }
#pragma unroll
                for (int t = 0; t < 8; ++t) { const int row = 16 * t + c16;
#pragma unroll
                    for (int a = 0; a < 2; ++a) {
                        union { uint2 h2[2]; bf16x8 v; } vf;
                        vf.h2[0] = *(const uint2*)(Vt + row * 128 + ((((4 * a + (q4 >> 1))) ^ (row & 7)) << 4) + 8 * (q4 & 1));
                        vf.h2[1] = *(const uint2*)(Vt + row * 128 + ((((4 * a + 2 + (q4 >> 1))) ^ (row & 7)) << 4) + 8 * (q4 & 1));
                        oacc[t] = __builtin_amdgcn_mfma_f32_16x16x32_bf16(vf.v, pb[a], oacc[t], 0, 0, 0); } }
                if (kt + 1 < nkt) ATT_LSTORE((kt + 1) & 1);
                __syncthreads();
            }
            lsum += __shfl_xor(lsum, 16); lsum += __shfl_xor(lsum, 32);
            const float inv = 1.f / lsum;
#pragma unroll
            for (int t = 0; t < 8; ++t) *(uint2*)(OB + (size_t)tq * 1024 + 512 + h * 128 + 16 * t + 4 * q4) = pack4(oacc[t] * inv);
        }
    }
}

PHASE_FN void ph_gdn_out(const Params& p, int layer) {
    unsigned char* ws_ = p.ws; asm volatile("" : "+s"(ws_));
    int tid_ = threadIdx.x; asm volatile("" : "+v"(tid_)); const int tid = tid_, lane = tid & 63, wv = tid >> 6;
    const float* O = (const float*)(ws_ + OFF_O); const bf16_t* P = (const bf16_t*)(ws_ + OFF_P); bf16_t* OB = (bf16_t*)(ws_ + OFF_OB);
    const float* onw = p.gdn_out_norm + (layer >> 1) * 128;
    for (int t = blockIdx.x * 8 + wv; t < NT; t += gridDim.x * 8) {
#pragma unroll
        for (int h = 0; h < 4; ++h) {
            const float* op = O + (size_t)t * 1024 + h * 128; bf16_t* ob = OB + (size_t)t * 1024 + h * 128;
            const float o0 = op[lane], o1 = op[64 + lane];
            const float ss = wave_sum(o0 * o0 + o1 * o1);
            const float r = rsqrtf(ss * (1.f / 128.f) + EPS);
            const float z0 = PBF(P, t, 1536 + h * 128 + lane), z1 = PBF(P, t, 1536 + h * 128 + 64 + lane);
            ob[lane] = f2bf(o0 * r * onw[lane] * siluf_(z0)); ob[64 + lane] = f2bf(o1 * r * onw[64 + lane] * siluf_(z1));
        }
    }
}

PHASE_FN void ph_gemm_out(const Params& p, int layer, float* smem) {
    unsigned char* ws_ = p.ws; asm volatile("" : "+s"(ws_));
    { int ldz_ = 0; asm volatile("" : "+s"(ldz_)); smem = (float*)(g_smem + ldz_); }
    const bf16_t* Wt = (const bf16_t*)(ws_ + OFF_WOUT) + (size_t)layer * 1024 * 1024;
    const float* MOD = (const float*)(ws_ + OFF_MOD);
    const bf16_t* O = (const bf16_t*)(ws_ + OFF_OB);
    const int vb_ = (((int)gridDim.x & 7) == 0) ? (((int)blockIdx.x & 7) * ((int)gridDim.x >> 3) + ((int)blockIdx.x >> 3)) : (int)blockIdx.x;
    for (int tile = vb_; tile < 64 * 8; tile += gridDim.x) {
        const int mt = (tile >> 6) * 8 + (tile & 7), nt = (tile >> 3) & 7;
        const bf16_t* Ab = O + (size_t)mt * 256 * 1024;
        const bf16_t* Bb = Wt + (size_t)nt * 128 * 1024;
        const int b = (mt * 256) >> 13;
        const float* gt = MOD + (size_t)(layer * 2 + b) * 6144 + 2048 + nt * 128;
        float* Xt = p.X + (size_t)mt * 256 * ND + nt * 128;
        const float* Xr = ((layer == 0) ? p.x : (const float*)p.X) + (size_t)mt * 256 * ND + nt * 128;
        gemm_tile_bf16(1024, (unsigned char*)smem,
            [=](int i, int r, int k) -> uint4 { return *(const uint4*)(Ab + (size_t)r * 1024 + k); },
            [=](int i, int r, int k) -> uint4 { return *(const uint4*)(Bb + (size_t)r * 1024 + k); },
            [=](const f32x4 (&acc)[4][4], int wm, int wn, int lane) {
#pragma unroll
                for (int mi = 0; mi < 4; ++mi)
#pragma unroll
                    for (int ni = 0; ni < 4; ++ni) {
                        const int m = wm * 64 + mi * 16 + (lane & 15), n = wn * 64 + ni * 16 + 4 * (lane >> 4);
                        const f32x4 g = *(const f32x4*)(gt + n);
                        *(f32x4*)(Xt + (size_t)m * ND + n) = *(const f32x4*)(Xr + (size_t)m * ND + n) + g * acc[mi][ni];
                    }
            });
    }
}

PHASE_FN void ph_norm_ffn(const Params& p, int layer) {
    unsigned char* ws_ = p.ws; asm volatile("" : "+s"(ws_));
    int tid_ = threadIdx.x; asm volatile("" : "+v"(tid_)); const int tid = tid_, lane = tid & 63, wv = tid >> 6;
    const float* MOD = (const float*)(ws_ + OFF_MOD);
    bf16_t* H = (bf16_t*)(ws_ + OFF_H);
    int* CNT = (int*)(ws_ + OFF_CNT) + layer * 32 * CSTR;
    int* sCnt = (int*)g_smem; int* sBase = sCnt + 32; int* sE = sBase + 32; int* sR = sE + 256;
    const int nrb = (NT + (int)gridDim.x - 1) / (int)gridDim.x, row_lo = blockIdx.x * nrb, row_hi = (row_lo + nrb < NT) ? row_lo + nrb : NT;
    __syncthreads();
    if (tid < 32) sCnt[tid] = 0;
    __syncthreads();
    int* ASG = (int*)(ws_ + OFF_ASG); float* GATE = (float*)(ws_ + OFF_GATE); int* LIST = (int*)(ws_ + OFF_LIST);
    const float* nw = p.norm_ffn + layer * 1024;
    const float* wg = p.rg_w + (size_t)layer * 1024 * 4;
    for (int row = row_lo + wv; row < row_hi; row += 8) {
        const int b = row >> 13;
        const float* xr = p.X + (size_t)row * ND;
        const float* sh = MOD + (size_t)(layer * 2 + b) * 6144 + 3072;
        const float* sc = sh + 1024;
        float hv[16]; float ss = 0.f;
#pragma unroll
        for (int j = 0; j < 4; ++j) { const float4 v = *(const float4*)(xr + j * 256 + lane * 4); hv[4 * j] = v.x; hv[4 * j + 1] = v.y; hv[4 * j + 2] = v.z; hv[4 * j + 3] = v.w; }
#pragma unroll
        for (int j = 0; j < 16; ++j) ss += hv[j] * hv[j];
        ss = wave_sum(ss);
        const float rstd = rsqrtf(ss * (1.f / 1024.f) + EPS);
#pragma unroll
        for (int j = 0; j < 4; ++j) {
            const int col = j * 256 + lane * 4;
            const float4 w = *(const float4*)(nw + col), s4 = *(const float4*)(sc + col), h4 = *(const float4*)(sh + col);
            hv[4 * j] = hv[4 * j] * rstd * w.x * (1.f + s4.x) + h4.x; hv[4 * j + 1] = hv[4 * j + 1] * rstd * w.y * (1.f + s4.y) + h4.y;
            hv[4 * j + 2] = hv[4 * j + 2] * rstd * w.z * (1.f + s4.z) + h4.z; hv[4 * j + 3] = hv[4 * j + 3] * rstd * w.w * (1.f + s4.w) + h4.w;
            { f32x4 ov; ov[0] = hv[4 * j]; ov[1] = hv[4 * j + 1]; ov[2] = hv[4 * j + 2]; ov[3] = hv[4 * j + 3]; *(uint2*)(H + (size_t)row * ND + col) = pack4(ov); }
        }
        float gl[4] = {0.f, 0.f, 0.f, 0.f};
#pragma unroll
        for (int j = 0; j < 4; ++j)
#pragma unroll
            for (int e = 0; e < 4; ++e) { const int col = j * 256 + lane * 4 + e; const float4 w = *(const float4*)(wg + (size_t)col * 4); const float hh = hv[4 * j + e];
                gl[0] += hh * w.x; gl[1] += hh * w.y; gl[2] += hh * w.z; gl[3] += hh * w.w; }
#pragma unroll
        for (int g = 0; g < 4; ++g) gl[g] = wave_sum(gl[g]) + p.rg_b[layer * 4 + g];
        int gs = 0; float gm = gl[0];
#pragma unroll
        for (int g = 1; g < 4; ++g) if (gl[g] > gm) { gm = gl[g]; gs = g; }
        float gsum = 0.f;
#pragma unroll
        for (int g = 0; g < 4; ++g) gsum += expf(gl[g] - gm);
        const float ggate = 1.f / gsum;
        const float* we = p.re_w + ((size_t)(layer * 4 + gs) * 1024) * 8;
        float el[8] = {0.f, 0.f, 0.f, 0.f, 0.f, 0.f, 0.f, 0.f};
#pragma unroll
        for (int j = 0; j < 4; ++j)
#pragma unroll
            for (int e = 0; e < 4; ++e) { const int col = j * 256 + lane * 4 + e; const float4 w0 = *(const float4*)(we + (size_t)col * 8), w1 = *(const float4*)(we + (size_t)col * 8 + 4); const float hh = hv[4 * j + e];
                el[0] += hh * w0.x; el[1] += hh * w0.y; el[2] += hh * w0.z; el[3] += hh * w0.w; el[4] += hh * w1.x; el[5] += hh * w1.y; el[6] += hh * w1.z; el[7] += hh * w1.w; }
#pragma unroll
        for (int e = 0; e < 8; ++e) el[e] = wave_sum(el[e]) + p.re_b[(layer * 4 + gs) * 8 + e];
        int i1 = 0; float l1 = el[0];
#pragma unroll
        for (int e = 1; e < 8; ++e) if (el[e] > l1) { l1 = el[e]; i1 = e; }
        int i2 = -1; float l2 = -INFINITY;
#pragma unroll
        for (int e = 0; e < 8; ++e) if (e != i1 && el[e] > l2) { l2 = el[e]; i2 = e; }
        const float ex = expf(l2 - l1);
        const float p1 = 1.f / (1.f + ex), p2 = ex / (1.f + ex);
        if (lane == 0) {
            const int e1 = gs * 8 + i1, e2 = gs * 8 + i2, lr = row - row_lo;
            sE[lr * 2] = e1; sE[lr * 2 + 1] = e2;
            sR[lr * 2] = atomicAdd(&sCnt[e1], 1); sR[lr * 2 + 1] = atomicAdd(&sCnt[e2], 1);
            GATE[row * 2] = ggate * p1; GATE[row * 2 + 1] = ggate * p2;
        }
    }
    __syncthreads();
    if (tid < 32) sBase[tid] = (sCnt[tid] > 0) ? atomicAdd(&CNT[tid * CSTR], sCnt[tid]) : 0;
    __syncthreads();
    for (int a = tid; a < (row_hi - row_lo) * 2; a += NTHREADS) {
        const int row = row_lo + (a >> 1), e = sE[a], r = sBase[e] + sR[a];
        LIST[(size_t)e * LISTCAP + r] = row;
        ASG[row * 4 + (a & 1) * 2] = e; ASG[row * 4 + (a & 1) * 2 + 1] = r;
    }
}

PHASE_FN void ph_moe(const Params& p, int layer, int which, float* smem) {
    unsigned char* ws_ = p.ws; asm volatile("" : "+s"(ws_));
    { int ldz_ = 0; asm volatile("" : "+s"(ldz_)); smem = (float*)(g_smem + ldz_); }
    int tid_ = threadIdx.x; asm volatile("" : "+v"(tid_)); const int tid = tid_;
    int* sPad = (int*)((unsigned char*)smem + 98304); int* sTs = sPad + 33;
    const int* CNT = (const int*)(ws_ + OFF_CNT) + layer * 32 * CSTR;
    __syncthreads();
    if (tid == 0) { int a = 0, ts = 0; for (int e = 0; e < 32; ++e) { sPad[e] = a; sTs[e] = ts; a += ((CNT[e * CSTR] + 127) / 128) * 128; ts += (CNT[e * CSTR] + 255) / 256; } sTs[32] = ts; sPad[32] = a; }
    __syncthreads();
    const int total = sTs[32] * 8;
    bf16_t* HID = (bf16_t*)(ws_ + OFF_HID); bf16_t* YB = (bf16_t*)(ws_ + OFF_YB);
    const bf16_t* H = (const bf16_t*)(ws_ + OFF_H);
    const int* LIST = (const int*)(ws_ + OFF_LIST);
    const int vb_ = (((int)gridDim.x & 7) == 0) ? (((int)blockIdx.x & 7) * ((int)gridDim.x >> 3) + ((int)blockIdx.x >> 3)) : (int)blockIdx.x;
    for (int tile = vb_; tile < total; tile += gridDim.x) {
        const int mt = tile >> 3, nt = tile & 7;
        int e = 0;
        for (int q = 1; q < 32; ++q) if (sTs[q] <= mt) e = q;
        const int mi0 = mt - sTs[e];
        const int cnt = CNT[e * CSTR];
        const int mvalid = (cnt - mi0 * 256 < 256) ? (cnt - mi0 * 256) : 256;
        const int rowbase = sPad[e] + mi0 * 256;
        if (which == 0) {
            long ro[4];
#pragma unroll
            for (int i = 0; i < 4; ++i) { const int r = (tid + 512 * i) >> 3; ro[i] = (r < mvalid) ? (long)LIST[(size_t)e * LISTCAP + mi0 * 256 + r] * 1024 : -1; }
            const long ro0 = ro[0], ro1 = ro[1], ro2 = ro[2], ro3 = ro[3];
            const bf16_t* Bb = (const bf16_t*)(ws_ + OFF_W13) + (size_t)e * 1024 * 1024 + (size_t)nt * 128 * 1024;
            bf16_t* Ht = HID + (size_t)rowbase * 512 + nt * 64;
            gemm_tile_bf16(1024, (unsigned char*)smem,
                [=](int i, int r, int k) -> uint4 { const long o = (i == 0) ? ro0 : (i == 1) ? ro1 : (i == 2) ? ro2 : ro3; if (o < 0) return make_uint4(0u, 0u, 0u, 0u);
                    return *(const uint4*)(H + o + k); },
                [=](int i, int r, int k) -> uint4 { return *(const uint4*)(Bb + (size_t)r * 1024 + k); },
                [=](const f32x4 (&acc)[4][4], int wm, int wn, int lane) {
#pragma unroll
                    for (int mi = 0; mi < 4; ++mi)
#pragma unroll
                        for (int ni = 0; ni < 2; ++ni) {
                            const int m = wm * 64 + mi * 16 + (lane & 15), n = wn * 32 + ni * 16 + 4 * (lane >> 4);
                            const f32x4 a1 = acc[mi][ni], a3 = acc[mi][ni + 2];
                            f32x4 hv; hv[0] = siluf_(a1[0]) * a3[0]; hv[1] = siluf_(a1[1]) * a3[1]; hv[2] = siluf_(a1[2]) * a3[2]; hv[3] = siluf_(a1[3]) * a3[3];
                            if (m < mvalid) *(uint2*)(Ht + (size_t)m * 512 + n) = pack4(hv);
                        }
                }, mvalid);
        } else {
            const bf16_t* Ab = HID + (size_t)rowbase * 512;
            const bf16_t* Bb = (const bf16_t*)(ws_ + OFF_W2T) + (size_t)e * 1024 * 512 + (size_t)nt * 128 * 512;
            bf16_t* Yt = YB + (size_t)rowbase * 1024 + nt * 128;
            gemm_tile_bf16(512, (unsigned char*)smem,
                [=](int i, int r, int k) -> uint4 { if (r >= mvalid) return make_uint4(0u, 0u, 0u, 0u); return *(const uint4*)(Ab + (size_t)r * 512 + k); },
                [=](int i, int r, int k) -> uint4 { return *(const uint4*)(Bb + (size_t)r * 512 + k); },
                [=](const f32x4 (&acc)[4][4], int wm, int wn, int lane) {
#pragma unroll
                    for (int mi = 0; mi < 4; ++mi)
#pragma unroll
                        for (int ni = 0; ni < 4; ++ni) {
                            const int m = wm * 64 + mi * 16 + (lane & 15), n = wn * 64 + ni * 16 + 4 * (lane >> 4);
                            if (m < mvalid) *(uint2*)(Yt + (size_t)m * 1024 + n) = pack4(acc[mi][ni]);
                        }
                }, mvalid);
        }
    }
}

PHASE_FN void ph_conv_dense(const Params& p, float* smem) {
    unsigned char* ws_ = p.ws; asm volatile("" : "+s"(ws_));
    { int ldz_ = 0; asm volatile("" : "+s"(ldz_)); smem = (float*)(g_smem + ldz_); }
    auto dec = [&](int t, const float*& s0, const float*& s1, bf16_t*& dst, int& mode, int& K, int& N, int& ld, int& rt, int& kt) {
        s1 = nullptr; mode = 0; K = 1024;
        if (t >= 4608) t = 4607;
        if (t < 1984) { const int l = t / 992, u = t % 992; s0 = p.even_w_in + (size_t)l * 1024 * 3916; N = 3916; ld = 3916; dst = (bf16_t*)(ws_ + OFF_WINE) + (size_t)l * 3968 * 1024; rt = u >> 4; kt = u & 15; }
        else if (t < 3584) { const int v = t - 1984, l = v / 800, u = v % 800; s0 = p.gla_w_in + (size_t)l * 1024 * 3088; N = 3088; ld = 3088; dst = (bf16_t*)(ws_ + OFF_WINO) + (size_t)l * 3200 * 1024; rt = u >> 4; kt = u & 15; }
        else { const int v = t - 3584, l = v >> 8, u = v & 255; s0 = ((l & 1) ? p.gla_w_out : p.even_w_out) + (size_t)(l >> 1) * 1024 * 1024; N = 1024; ld = 1024; dst = (bf16_t*)(ws_ + OFF_WOUT) + (size_t)l * 1024 * 1024; rt = u >> 4; kt = u & 15; }
    };
    for (int t = blockIdx.x * 4; t < 4608; t += gridDim.x * 4) convert_tiles4(dec, t, (4608 - t < 4) ? (4608 - t) : 4, smem);
}

PHASE_FN void ph_conv_exp(const Params& p, int layer, float* smem, int first_blk) {
    unsigned char* ws_ = p.ws; asm volatile("" : "+s"(ws_));
    { int ldz_ = 0; asm volatile("" : "+s"(ldz_)); smem = (float*)(g_smem + ldz_); }
    if ((int)blockIdx.x < first_blk) return;
    auto dec = [&](int t, const float*& s0, const float*& s1, bf16_t*& dst, int& mode, int& K, int& N, int& ld, int& rt, int& kt) {
        if (t >= 12288) t = 12287;
        if (t < 8192) { const int e = t >> 8, u = t & 255; s0 = p.w1 + (size_t)(layer * 32 + e) * 1024 * 512; s1 = p.w3 + (size_t)(layer * 32 + e) * 1024 * 512; mode = 1; K = 1024; N = 512; ld = 512;
            dst = (bf16_t*)(ws_ + OFF_W13) + (size_t)e * 1024 * 1024; rt = u >> 4; kt = u & 15; }
        else { const int v = t - 8192, e = v >> 7, u = v & 127; s0 = p.w2 + (size_t)(layer * 32 + e) * 512 * 1024; s1 = nullptr; mode = 0; K = 512; N = 1024; ld = 1024;
            dst = (bf16_t*)(ws_ + OFF_W2T) + (size_t)e * 1024 * 512; rt = u >> 3; kt = u & 7; }
    };
    const int nb = (int)gridDim.x - first_blk;
    for (int t = ((int)blockIdx.x - first_blk) * 4; t < 12288; t += nb * 4) convert_tiles4(dec, t, (12288 - t < 4) ? (12288 - t) : 4, smem);
}

PHASE_FN void ph_gla_tok(const Params& p, int layer) {
    unsigned char* ws_ = p.ws; asm volatile("" : "+s"(ws_));
    int tid_ = threadIdx.x; asm volatile("" : "+v"(tid_)); const int tid = tid_, lane = tid & 63, wv = tid >> 6, li = layer >> 1;
    const float* AUX = (const float*)(ws_ + OFF_AUX);
    float* LA = (float*)(ws_ + OFF_LA);
    const float* w2 = p.gla_w_gate2 + (size_t)li * 16 * 512; const float* b2 = p.gla_b_gate2 + li * 512;
    for (int t = blockIdx.x * 8 + wv; t < NT; t += gridDim.x * 8) {
        float glr[16];
#pragma unroll
        for (int r = 0; r < 16; ++r) glr[r] = AUX[(size_t)t * 16 + r];
#pragma unroll 1
        for (int i = 0; i < 8; ++i) {
            const int c = lane + 64 * i; float z = b2[c];
#pragma unroll
            for (int r = 0; r < 16; ++r) z += glr[r] * w2[r * 512 + c];
            LA[(size_t)t * 512 + c] = -softplusf_(-z) * (1.f / 16.f);
        }
    }
}

PHASE_FN void ph_gla_chunk(const Params& p, int layer, float* smem) {
    unsigned char* ws_ = p.ws; asm volatile("" : "+s"(ws_));
    int tid_ = threadIdx.x; asm volatile("" : "+v"(tid_)); const int tid = tid_, lane = tid & 63, wv = __builtin_amdgcn_readfirstlane(tid >> 6), q4 = lane >> 4, c16 = lane & 15;
    int ldz_ = 0; asm volatile("" : "+s"(ldz_)); unsigned char* lds = g_smem + ldz_;
    constexpr int SN = 272, ST = 144;
    float* sBc = (float*)lds;
    unsigned char* bQE = lds + 33024;
    unsigned char* bKE = lds + 50432;
    unsigned char* bKD = lds + 67840;
    unsigned char* bVT = lds + 86272;
    unsigned char* bATT = lds + 123136;
    const bf16_t* P = (const bf16_t*)(ws_ + OFF_P); const float* AUX = (const float*)(ws_ + OFF_AUX);
    const float* w2 = p.gla_w_gate2 + (size_t)(layer >> 1) * 16 * 512; const float* b2 = p.gla_b_gate2 + (layer >> 1) * 512;
    float* sGlr = (float*)(lds + 132352);
    uint4* QEF = (uint4*)(ws_ + OFF_GQE); uint2* OIF = (uint2*)(ws_ + OFF_GOI); uint2* HF = (uint2*)(ws_ + OFF_GH); float* EBL = (float*)(ws_ + OFF_GEBL);
    for (int ci = blockIdx.x; ci < 1024; ci += gridDim.x) {
        const int b = ci >> 9, h = (ci >> 7) & 3, n = ci & 127;
        const int t0 = b * 8192 + n * 64;
        __syncthreads();
        for (int e = tid; e < 1024; e += NTHREADS) sGlr[e] = AUX[(size_t)(t0 + (e >> 4)) * 16 + (e & 15)];
        __syncthreads();
        {
            const int d = tid & 127, c = h * 128 + d;
            float wg[16];
#pragma unroll
            for (int r = 0; r < 16; ++r) wg[r] = w2[r * 512 + c];
            const float bz = b2[c];
            for (int i = tid >> 7; i < 64; i += 4) {
                float z = bz;
#pragma unroll
                for (int r = 0; r < 16; ++r) z += sGlr[i * 16 + r] * wg[r];
                sBc[i * 129 + d] = -softplusf_(-z) * (1.f / 16.f);
            }
        }
        for (int e = tid; e < 64 * 36; e += NTHREADS) ((unsigned*)bATT)[e] = 0u;
        __syncthreads();
        if (tid < 128) { float a = 0.f; for (int i = 0; i < 64; ++i) { a += sBc[i * 129 + tid]; sBc[i * 129 + tid] = a; } }
        __syncthreads();
        for (int e = tid; e < 8192; e += NTHREADS) {
            const int i = e >> 7, d = e & 127;
            const float bb = sBc[i * 129 + d], bl = sBc[63 * 129 + d];
            const float qf = PBF(P, t0 + i, h * 128 + d), kf = PBF(P, t0 + i, 512 + h * 128 + d);
            *(bf16_t*)(bQE + i * SN + d * 2) = f2bf(qf * SCALE128 * expf(bb));
            *(bf16_t*)(bKE + i * SN + d * 2) = f2bf(kf * expf(-bb));
            *(bf16_t*)(bKD + d * ST + i * 2) = f2bf(kf * expf(bl - bb));
        }
        for (int e = tid; e < 16384; e += NTHREADS) { const int i = e >> 8, dv = e & 255; *(bf16_t*)(bVT + dv * ST + i * 2) = P[(size_t)(t0 + i) * LDPB + 1024 + h * 256 + dv]; }
        if (tid < 128) EBL[ci * 128 + tid] = expf(sBc[63 * 129 + tid]);
        __syncthreads();
        for (int u = wv; u < 10; u += 8) {
            const int ti = (u >= 6) ? 3 : (u >= 3) ? 2 : (u >= 1) ? 1 : 0, tj = u - ((ti * (ti + 1)) >> 1);
            f32x4 acc = (f32x4){0.f, 0.f, 0.f, 0.f};
            acc = mma_lds(bQE, SN, 16 * ti, bKE, SN, 16 * tj, 128, acc, c16, q4);
            const int j = 16 * tj + c16;
#pragma unroll
            for (int r = 0; r < 4; ++r) { const int i = 16 * ti + 4 * q4 + r; *(bf16_t*)(bATT + i * ST + j * 2) = f2bf((j <= i) ? acc[r] : 0.f); }
        }
        for (int x = 0; x < 2; ++x) {
            const int u = wv * 2 + x, ti = u >> 2, a = u & 3;
            const unsigned char* rp = bQE + (16 * ti + c16) * SN;
            const uint2 lo = *(const uint2*)(rp + (32 * a + 4 * q4) * 2), hi = *(const uint2*)(rp + (32 * a + 16 + 4 * q4) * 2);
            QEF[((size_t)(ci * 4 + ti) * 4 + a) * 64 + lane] = make_uint4(lo.x, lo.y, hi.x, hi.y);
        }
        __syncthreads();
        for (int x = 0; x < 8; ++x) {
            const int u = wv * 8 + x, tdv = u >> 2, ti = u & 3;
            f32x4 acc = (f32x4){0.f, 0.f, 0.f, 0.f};
            acc = mma_lds(bATT, ST, 16 * ti, bVT, ST, 16 * tdv, 64, acc, c16, q4);
            OIF[((size_t)(ci * 16 + tdv) * 4 + ti) * 64 + lane] = pack4(acc);
        }
        for (int x = 0; x < 16; ++x) {
            const int u = wv * 16 + x, tdv = u >> 3, tdk = u & 7;
            f32x4 acc = (f32x4){0.f, 0.f, 0.f, 0.f};
            acc = mma_lds(bKD, ST, 16 * tdk, bVT, ST, 16 * tdv, 64, acc, c16, q4);
            HF[((size_t)(ci * 16 + tdv) * 8 + tdk) * 64 + lane] = pack4(acc);
        }
    }
}

PHASE_FN void ph_gla_scan(const Params& p, float* smem) {
    unsigned char* ws_ = p.ws; asm volatile("" : "+s"(ws_));
    int tid_ = threadIdx.x; asm volatile("" : "+v"(tid_)); const int tid = tid_, lane = tid & 63, wv = __builtin_amdgcn_readfirstlane(tid >> 6), q4 = lane >> 4, c16 = lane & 15;
    int ldz_ = 0; asm volatile("" : "+s"(ldz_)); unsigned char* lds = g_smem + ldz_;
    constexpr int STG = 29184;
    const unsigned char* QEF = ws_ + OFF_GQE; const unsigned char* HF = ws_ + OFF_GH; const unsigned char* OIF = ws_ + OFF_GOI; const unsigned char* EBL = ws_ + OFF_GEBL;
    float* O = (float*)(ws_ + OFF_O);
    for (int it = blockIdx.x; it < 64; it += gridDim.x) {
        const int bh = it >> 3, pair = it & 7, b = bh >> 2, h = bh & 3;
        __syncthreads();
        if (wv >= 2) {
            const int lt = tid - 128;
            const unsigned char* Qb = QEF + (size_t)bh * 128 * 16384;
            const unsigned char* Hb = HF + (size_t)bh * 128 * 65536 + pair * 8192;
            const unsigned char* Ob = OIF + (size_t)bh * 128 * 32768 + pair * 4096;
            const unsigned char* Lb = EBL + (size_t)bh * 128 * 512;
            uint4 ra0, ra1, ra2, ra3, ra4, ra5, ra6, rb0, rb1, rb2, rb3, rb4, rb5, rb6, rc0, rc1, rc2, rc3, rc4, rc5, rc6, rd0, rd1, rd2, rd3, rd4, rd5, rd6;
#define GL_LOAD(X, n_) do { const unsigned char* q_ = Qb + (size_t)(n_) * 16384; const unsigned char* h_ = Hb + (size_t)(n_) * 65536; \
                const unsigned char* o_ = Ob + (size_t)(n_) * 32768; const unsigned char* l_ = Lb + (size_t)(n_) * 512; \
                X##0 = LDC(q_, lt, 1023); X##1 = LDC(q_, lt + 384, 1023); X##2 = LDC(q_, lt + 768, 1023); \
                X##3 = LDC(h_, lt, 511); X##4 = LDC(h_, lt + 384, 511); X##5 = LDC(o_, lt, 255); X##6 = LDC(l_, lt, 31); } while (0)
#define GL_STORE(X, st_) do { unsigned char* sb_ = lds + (st_) * STG; \
                STC(0, lt, 1024, X##0); STC(0, lt + 384, 1024, X##1); STC(0, lt + 768, 1024, X##2); \
                STC(16384, lt, 512, X##3); STC(16384, lt + 384, 512, X##4); STC(24576, lt, 256, X##5); STC(28672, lt, 32, X##6); } while (0)
            GL_LOAD(ra, 0); GL_STORE(ra, 0);
            GL_LOAD(rb, 1); GL_LOAD(rc, 2); GL_LOAD(rd, 3); GL_LOAD(ra, 4);
            __syncthreads();
            for (int n = 0; n < 128; n += 4) {
                GL_STORE(rb, 1); GL_LOAD(rb, CLAMPN(n + 5)); __syncthreads();
                GL_STORE(rc, 0); GL_LOAD(rc, CLAMPN(n + 6)); __syncthreads();
                GL_STORE(rd, 1); GL_LOAD(rd, CLAMPN(n + 7)); __syncthreads();
                if (n + 4 < 128) GL_STORE(ra, 0);
                GL_LOAD(ra, CLAMPN(n + 8)); __syncthreads();
            }
        } else {
            const int tdv = pair * 2 + wv;
            f32x4 S[8];
#pragma unroll
            for (int t = 0; t < 8; ++t) S[t] = (f32x4){0.f, 0.f, 0.f, 0.f};
            __syncthreads();
            for (int n = 0; n < 128; ++n) {
                const unsigned char* base = lds + (n & 1) * STG;
                const unsigned char* Qf = base + lane * 16, *Hf = base + 16384 + wv * 4096 + lane * 8, *Of = base + 24576 + wv * 2048 + lane * 8, *Lf = base + 28672 + q4 * 16;
                bf16x8 Sb[4];
#pragma unroll
                for (int a = 0; a < 4; ++a) { union { uint4 u; bf16x8 v; } cv; const uint2 lo = pack4(S[2 * a]), hi = pack4(S[2 * a + 1]); cv.u.x = lo.x; cv.u.y = lo.y; cv.u.z = hi.x; cv.u.w = hi.y; Sb[a] = cv.v; }
                const int t0 = b * 8192 + n * 64;
                f32x4 oa[4];
#pragma unroll
                for (int ti = 0; ti < 4; ++ti) oa[ti] = unpack4(*(const uint2*)(Of + ti * 512));
#pragma unroll
                for (int a = 0; a < 4; ++a)
#pragma unroll
                    for (int ti = 0; ti < 4; ++ti) oa[ti] = __builtin_amdgcn_mfma_f32_16x16x32_bf16(*(const bf16x8*)(Qf + (ti * 4 + a) * 1024), Sb[a], oa[ti], 0, 0, 0);
#pragma unroll
                for (int ti = 0; ti < 4; ++ti) {
                    float* op = O + (size_t)(t0 + 16 * ti + 4 * q4) * 1024 + h * 256 + 16 * tdv + c16;
                    op[0] = oa[ti][0]; op[1024] = oa[ti][1]; op[2048] = oa[ti][2]; op[3072] = oa[ti][3]; }
#pragma unroll
                for (int t = 0; t < 8; ++t) { const f32x4 lam = *(const f32x4*)(Lf + t * 64); S[t] = S[t] * lam + unpack4(*(const uint2*)(Hf + t * 512)); }
                __syncthreads();
            }
        }
    }
}

PHASE_FN void ph_gla_out(const Params& p, int layer) {
    unsigned char* ws_ = p.ws; asm volatile("" : "+s"(ws_));
    int tid_ = threadIdx.x; asm volatile("" : "+v"(tid_)); const int tid = tid_, lane = tid & 63, wv = tid >> 6;
    const float* O = (const float*)(ws_ + OFF_O); const bf16_t* P = (const bf16_t*)(ws_ + OFF_P); bf16_t* OB = (bf16_t*)(ws_ + OFF_OB);
    const float* onw = p.gla_out_norm + (layer >> 1) * 256;
    for (int t = blockIdx.x * 8 + wv; t < NT; t += gridDim.x * 8) {
#pragma unroll
        for (int h = 0; h < 4; ++h) {
            const float* op = O + (size_t)t * 1024 + h * 256;
            const float4 o = *(const float4*)(op + lane * 4);
            const float ss = wave_sum(o.x * o.x + o.y * o.y + o.z * o.z + o.w * o.w);
            const float r = rsqrtf(ss * (1.f / 256.f) + EPS);
            const f32x4 z = unpack4(*(const uint2*)(P + (size_t)t * LDPB + 2048 + h * 256 + lane * 4));
            const float4 w = *(const float4*)(onw + lane * 4);
            f32x4 ov; ov[0] = o.x * r * w.x * siluf_(z[0]); ov[1] = o.y * r * w.y * siluf_(z[1]); ov[2] = o.z * r * w.z * siluf_(z[2]); ov[3] = o.w * r * w.w * siluf_(z[3]);
            *(uint2*)(OB + (size_t)t * 1024 + h * 256 + lane * 4) = pack4(ov);
        }
    }
}

template <int PH>
__device__ __forceinline__ void run_phase(const Params& p, int layer, float* smem) {
    if (PH == PH_PROLOGUE) { ph_prologue(p, smem); ph_conv_dense(p, smem); }
    else if (PH == PH_NORM_MIX) ph_rows(p, layer, 0, smem);
    else if (PH == PH_GEMM_IN_EVEN) ph_gemm_in(p, layer, true, smem);
    else if (PH == PH_EVEN_TOK) { ph_even_tok(p, layer, smem); ph_gdn_chunk(p, layer, smem); }
    else if (PH == PH_GDN_CHUNK) ph_gdn_chunk(p, layer, smem);
    else if (PH == PH_GDN_SCAN) { ph_gdn_scan(p, smem); ph_conv_exp(p, layer, smem, 32); ph_dsa_topk(p, layer, smem); }
    else if (PH == PH_DSA_TOPK) ph_dsa_topk(p, layer, smem);
    else if (PH == PH_DSA_ATTN) { ph_dsa_attn(p, smem); ph_gdn_out(p, layer); }
    else if (PH == PH_GDN_OUT) ph_gdn_out(p, layer);
    else if (PH == PH_GEMM_OUT) ph_gemm_out(p, layer, smem);
    else if (PH == PH_NORM_FFN) ph_norm_ffn(p, layer);
    else if (PH == PH_MOE1) ph_moe(p, layer, 0, smem);
    else if (PH == PH_MOE2) ph_moe(p, layer, 1, smem);
    else if (PH == PH_GEMM_IN_ODD) ph_gemm_in(p, layer, false, smem);
    else if (PH == PH_GLA_TOK) ph_gla_tok(p, layer);
    else if (PH == PH_GLA_CHUNK) ph_gla_chunk(p, layer, smem);
    else if (PH == PH_GLA_SCAN) { ph_gla_scan(p, smem); ph_conv_exp(p, layer, smem, 64); }
    else if (PH == PH_GLA_OUT) ph_gla_out(p, layer);
    else if (PH == PH_FINAL) ph_rows(p, 0, 1, smem);
}

#if MK_MULTI
template <int PH>
__global__ void __launch_bounds__(NTHREADS, 2) k_phase(Params p, int layer) {
    run_phase<PH>(p, layer, (float*)g_smem);
}
#else
__global__ void __launch_bounds__(NTHREADS, 2) k_mega(Params p) {
    float* smem = (float*)g_smem;
    volatile LAS unsigned* xbw = (volatile LAS unsigned*)(LAS unsigned char*)(g_smem + LDS_BYTES - 16);
    if (threadIdx.x == 0) { xbw[0] = 0u; xbw[1] = 0u; xbw[2] = 0u; xbw[3] = 0u; }
    __syncthreads();
    XcdBarrier bar = xcd_barrier_post((unsigned*)(p.ws + OFF_BAR), xbw);
#define BAR() xcd_barrier(bar)
    run_phase<PH_PROLOGUE>(p, 0, smem); BAR(); if (DUP_MASK & 4096) { run_phase<PH_PROLOGUE>(p, 0, smem); BAR(); }
    for (int lp = 0; lp < 2; ++lp) {
        const int le = 2 * lp, lo = 2 * lp + 1;
        run_phase<PH_NORM_MIX>(p, le, smem); BAR();
        run_phase<PH_GEMM_IN_EVEN>(p, le, smem); BAR(); if (DUP_MASK & 1) { run_phase<PH_GEMM_IN_EVEN>(p, le, smem); BAR(); }
        run_phase<PH_EVEN_TOK>(p, le, smem); BAR(); if (DUP_MASK & 2) { run_phase<PH_EVEN_TOK>(p, le, smem); BAR(); }
        run_phase<PH_GDN_SCAN>(p, le, smem); BAR(); if (DUP_MASK & 8) { run_phase<PH_GDN_SCAN>(p, le, smem); BAR(); }
        run_phase<PH_DSA_ATTN>(p, le, smem); BAR(); if (DUP_MASK & 32) { run_phase<PH_DSA_ATTN>(p, le, smem); BAR(); }
        run_phase<PH_GEMM_OUT>(p, le, smem); BAR();
        run_phase<PH_NORM_FFN>(p, le, smem); BAR();
        run_phase<PH_MOE1>(p, le, smem); BAR(); if (DUP_MASK & 64) { run_phase<PH_MOE1>(p, le, smem); BAR(); }
        run_phase<PH_MOE2>(p, le, smem); BAR(); if (DUP_MASK & 128) { run_phase<PH_MOE2>(p, le, smem); BAR(); }
        run_phase<PH_NORM_MIX>(p, lo, smem); BAR();
        run_phase<PH_GEMM_IN_ODD>(p, lo, smem); BAR(); if (DUP_MASK & 256) { run_phase<PH_GEMM_IN_ODD>(p, lo, smem); BAR(); }
        run_phase<PH_GLA_CHUNK>(p, lo, smem); BAR(); if (DUP_MASK & 1024) { run_phase<PH_GLA_CHUNK>(p, lo, smem); BAR(); }
        run_phase<PH_GLA_SCAN>(p, lo, smem); BAR(); if (DUP_MASK & 2048) { run_phase<PH_GLA_SCAN>(p, lo, smem); BAR(); }
        run_phase<PH_GLA_OUT>(p, lo, smem); BAR();
        run_phase<PH_GEMM_OUT>(p, lo, smem); BAR();
        run_phase<PH_NORM_FFN>(p, lo, smem); BAR();
        run_phase<PH_MOE1>(p, lo, smem); BAR(); if (DUP_MASK & 64) { run_phase<PH_MOE1>(p, lo, smem); BAR(); }
        run_phase<PH_MOE2>(p, lo, smem); BAR(); if (DUP_MASK & 128) { run_phase<PH_MOE2>(p, lo, smem); BAR(); }
    }
    for (int xb = 0; xb < EXTRA_BARS; ++xb) BAR();
    run_phase<PH_FINAL>(p, 0, smem);
}
#endif

}

#if MK_MULTI
template <int PH>
static void launch_phase(const Params& p, int layer, hipStream_t stream) {
    static bool attr_set = false;
    if (!attr_set) { hipFuncSetAttribute((const void*)k_phase<PH>, hipFuncAttributeMaxDynamicSharedMemorySize, (int)LDS_BYTES); attr_set = true; }
    hipLaunchKernelGGL((k_phase<PH>), dim3(256), dim3(NTHREADS), LDS_BYTES, stream, p, layer);
}
#endif

extern "C" void kernel_launch(void* const* d_in, const int* in_sizes, int n_in, void* d_out, int out_size, void* d_ws, size_t ws_size, hipStream_t stream) {
    (void)in_sizes; (void)n_in; (void)out_size;
    if (ws_size < WS_NEEDED) { fprintf(stderr, "workspace too small: %zu < %zu\n", ws_size, (size_t)WS_NEEDED); return; }
    Params p{};
    p.x = (const float*)d_in[0]; p.c = (const float*)d_in[1]; p.pos = (const int*)d_in[2]; p.ada_w = (const float*)d_in[3]; p.ada_b = (const float*)d_in[4];
    p.norm_mix = (const float*)d_in[5]; p.norm_ffn = (const float*)d_in[6]; p.even_w_in = (const float*)d_in[7]; p.conv_w = (const float*)d_in[8];
    p.a_log = (const float*)d_in[9]; p.dt_bias = (const float*)d_in[10]; p.gdn_out_norm = (const float*)d_in[11]; p.even_w_out = (const float*)d_in[12];
    p.gla_w_in = (const float*)d_in[13]; p.gla_w_gate2 = (const float*)d_in[14]; p.gla_b_gate2 = (const float*)d_in[15]; p.gla_out_norm = (const float*)d_in[16]; p.gla_w_out = (const float*)d_in[17];
    p.rg_w = (const float*)d_in[18]; p.rg_b = (const float*)d_in[19]; p.re_w = (const float*)d_in[20]; p.re_b = (const float*)d_in[21];
    p.w1 = (const float*)d_in[22]; p.w3 = (const float*)d_in[23]; p.w2 = (const float*)d_in[24]; p.final_norm = (const float*)d_in[25];
    p.X = (float*)d_out; p.ws = (unsigned char*)d_ws;
    p.rA = pow(10000.0, -2.0 / 128.0); p.rI = pow(10000.0, -2.0 / 64.0);
    hipMemsetAsync(d_ws, 0, ZERO_BYTES, stream);
#if MK_MULTI
    launch_phase<PH_PROLOGUE>(p, 0, stream);
    for (int lp = 0; lp < 2; ++lp) {
        const int le = 2 * lp, lo = 2 * lp + 1;
        launch_phase<PH_NORM_MIX>(p, le, stream);
        launch_phase<PH_GEMM_IN_EVEN>(p, le, stream);
        launch_phase<PH_EVEN_TOK>(p, le, stream);
        launch_phase<PH_GDN_SCAN>(p, le, stream);
        launch_phase<PH_DSA_ATTN>(p, le, stream);
        launch_phase<PH_GEMM_OUT>(p, le, stream);
        launch_phase<PH_NORM_FFN>(p, le, stream);
        launch_phase<PH_MOE1>(p, le, stream);
        launch_phase<PH_MOE2>(p, le, stream);
        launch_phase<PH_NORM_MIX>(p, lo, stream);
        launch_phase<PH_GEMM_IN_ODD>(p, lo, stream);
        launch_phase<PH_GLA_CHUNK>(p, lo, stream);
        launch_phase<PH_GLA_SCAN>(p, lo, stream);
        launch_phase<PH_GLA_OUT>(p, lo, stream);
        launch_phase<PH_GEMM_OUT>(p, lo, stream);
        launch_phase<PH_NORM_FFN>(p, lo, stream);
        launch_phase<PH_MOE1>(p, lo, stream);
        launch_phase<PH_MOE2>(p, lo, stream);
    }
    launch_phase<PH_FINAL>(p, 0, stream);
#else
    static int grid = 0;
    if (!grid) {
        int dev = 0, cus = 0, per_cu = 0;
        hipGetDevice(&dev);
        hipDeviceGetAttribute(&cus, hipDeviceAttributeMultiprocessorCount, dev);
        hipFuncSetAttribute((const void*)k_mega, hipFuncAttributeMaxDynamicSharedMemorySize, (int)LDS_BYTES);
        hipOccupancyMaxActiveBlocksPerMultiprocessor(&per_cu, k_mega, NTHREADS, LDS_BYTES);
        if (cus <= 0) cus = 256;
        grid = cus * (per_cu < 1 ? 1 : 1);
    }
    hipLaunchKernelGGL(k_mega, dim3(grid), dim3(NTHREADS), LDS_BYTES, stream, p);
#endif
}
```

```cpp
#include <hip/hip_runtime.h>
#include <stdint.h>
#include <math.h>
#include <stdio.h>

#define EXTRA_BARS 0
#ifndef DUP_MASK
#define DUP_MASK 0
#endif
#ifndef MK_MULTI
#define MK_MULTI 0
#endif

namespace {

constexpr int NT = 16384, ND = 1024, LDP = 3920, LDPB = 3968;
constexpr float EPS = 1e-6f;
constexpr int NTHREADS = 512;
constexpr size_t LDS_BYTES = 147456;
constexpr float SCALE128 = 0.08838834764831845f;
constexpr int LISTCAP = 32768;
constexpr int CSTR = 16;

constexpr size_t OFF_BAR  = 0;
constexpr size_t OFF_CNT  = 16384;
constexpr size_t ZERO_BYTES = 32768;
constexpr size_t OFF_QCTR = 28672;
constexpr size_t OFF_MOD  = 32768;
constexpr size_t OFF_COSA = OFF_MOD + 4 * 2 * 6144 * 4;
constexpr size_t OFF_SINA = OFF_COSA + (size_t)NT * 64 * 4;
constexpr size_t OFF_COSI = OFF_SINA + (size_t)NT * 64 * 4;
constexpr size_t OFF_SINI = OFF_COSI + (size_t)NT * 32 * 4;
constexpr size_t OFF_H    = OFF_SINI + (size_t)NT * 32 * 4;
constexpr size_t OFF_P    = OFF_H + (size_t)NT * 1024 * 4;
constexpr size_t OFF_HID  = OFF_P;
constexpr size_t OFF_YB   = OFF_HID + (size_t)36864 * 512 * 4;
constexpr size_t OFF_O    = OFF_P + (size_t)NT * LDP * 4;
constexpr size_t OFF_ASG  = OFF_O + (size_t)NT * 1024 * 4;
constexpr size_t OFF_GATE = OFF_ASG + (size_t)NT * 4 * 4;
constexpr size_t OFF_LIST = OFF_GATE + (size_t)NT * 2 * 4;
constexpr size_t OFF_R    = OFF_LIST + (size_t)32 * LISTCAP * 4;
constexpr size_t OFF_QN   = OFF_R;
constexpr size_t OFF_KN   = OFF_QN + (size_t)NT * 512 * 4;
constexpr size_t OFF_VC   = OFF_KN + (size_t)NT * 512 * 4;
constexpr size_t OFF_BETA = OFF_VC + (size_t)NT * 512 * 4;
constexpr size_t OFF_G    = OFF_BETA + (size_t)NT * 4 * 4;
constexpr size_t OFF_W    = OFF_G + (size_t)NT * 4 * 4;
constexpr size_t OFF_U    = OFF_W + (size_t)1024 * 8192 * 4;
constexpr size_t OFF_QG   = OFF_U + (size_t)1024 * 8192 * 4;
constexpr size_t OFF_KD   = OFF_QG + (size_t)1024 * 8192 * 4;
constexpr size_t OFF_AQK  = OFF_KD + (size_t)1024 * 8192 * 4;
constexpr size_t OFF_GL   = OFF_AQK + (size_t)1024 * 4096 * 4;
constexpr size_t OFF_QB   = OFF_GL + 4096;
constexpr size_t OFF_KB   = OFF_QB + (size_t)NT * 512 * 4;
constexpr size_t OFF_QI   = OFF_KB + (size_t)NT * 512 * 4;
constexpr size_t OFF_KI   = OFF_QI + (size_t)NT * 256 * 4;
constexpr size_t OFF_WI   = OFF_KI + (size_t)NT * 64 * 4;
constexpr size_t OFF_SEL  = OFF_WI + (size_t)NT * 4 * 4;
constexpr size_t OFF_EVEN_END = OFF_SEL + (size_t)NT * 256 * 4;
constexpr size_t OFF_PFR  = OFF_W;
constexpr size_t OFF_RFR  = OFF_PFR + (size_t)1024 * 32768;
constexpr size_t OFF_QFR  = OFF_RFR + (size_t)1024 * 16384;
constexpr size_t OFF_OFR  = OFF_QFR + (size_t)1024 * 32768;
static_assert(OFF_OFR + (size_t)1024 * 16384 <= OFF_GL, "gdn v2 buffers overflow");
constexpr size_t OFF_QBB  = OFF_QB;
constexpr size_t OFF_KBB  = OFF_QBB + (size_t)NT * 512 * 2;
constexpr size_t OFF_VT   = OFF_KBB + (size_t)NT * 512 * 2;
constexpr size_t OFF_QIB  = OFF_VT + (size_t)NT * 512 * 2;
constexpr size_t OFF_KIB  = OFF_QIB + (size_t)NT * 256 * 2;
constexpr size_t OFF_M16  = OFF_KIB + (size_t)NT * 64 * 2;
static_assert(OFF_M16 + (size_t)NT * 512 * 2 <= OFF_WI, "dsa v2 buffers overflow");
constexpr size_t OFF_LA   = OFF_R;
constexpr size_t OFF_ATT  = OFF_LA + (size_t)NT * 512 * 4;
constexpr size_t OFF_QE   = OFF_ATT + (size_t)1024 * 4096 * 4;
constexpr size_t OFF_GKD  = OFF_QE + (size_t)1024 * 8192 * 4;
constexpr size_t OFF_EBL  = OFF_GKD + (size_t)1024 * 8192 * 4;
constexpr size_t OFF_GQE  = OFF_LA + (size_t)NT * 512 * 4;
constexpr size_t OFF_GOI  = OFF_GQE + (size_t)1024 * 16384;
constexpr size_t OFF_GH   = OFF_GOI + (size_t)1024 * 32768;
constexpr size_t OFF_GEBL = OFF_GH + (size_t)1024 * 65536;
static_assert(OFF_GEBL + (size_t)1024 * 512 <= OFF_EVEN_END, "gla v2 buffers overflow");
constexpr size_t OFF_WINE = OFF_EVEN_END;
constexpr size_t OFF_WINO = OFF_WINE + (size_t)2 * 3968 * 1024 * 2;
constexpr size_t OFF_WOUT = OFF_WINO + (size_t)2 * 3200 * 1024 * 2;
constexpr size_t OFF_W13  = OFF_WOUT + (size_t)4 * 1024 * 1024 * 2;
constexpr size_t OFF_W2T  = OFF_W13 + (size_t)32 * 1024 * 1024 * 2;
constexpr size_t OFF_OB   = OFF_W2T + (size_t)32 * 1024 * 512 * 2;
constexpr size_t OFF_AUX  = OFF_OB + (size_t)NT * 1024 * 2;
constexpr size_t WS_NEEDED = OFF_AUX + (size_t)NT * 16 * 4;

struct Params {
    const float* x; const float* c; const int* pos; const float* ada_w; const float* ada_b;
    const float* norm_mix; const float* norm_ffn; const float* even_w_in; const float* conv_w;
    const float* a_log; const float* dt_bias; const float* gdn_out_norm; const float* even_w_out;
    const float* gla_w_in; const float* gla_w_gate2; const float* gla_b_gate2; const float* gla_out_norm; const float* gla_w_out;
    const float* rg_w; const float* rg_b; const float* re_w; const float* re_b;
    const float* w1; const float* w3; const float* w2; const float* final_norm;
    float* X;
    unsigned char* ws;
    double rA, rI;
};

#define XB_TMO      128
#define XB_XCNT(j)  (256  + 64 * (j))
#define XB_XSUB(j)  (1280 + 64 * (j))
#define XB_XGEN(j)  (2304 + 64 * (j))
#define XB_TOP      3328
#define XB_TOPGEN   3392
#define XCD_BAR_WORDS 3456
#define XB_SPIN_CAP (1u << 18)
#define LAS __attribute__((address_space(3)))

__device__ __forceinline__ unsigned xb_ld(unsigned* p)              { return __hip_atomic_load(p, __ATOMIC_RELAXED, __HIP_MEMORY_SCOPE_AGENT); }
__device__ __forceinline__ unsigned xb_add(unsigned* p, unsigned v) { return __hip_atomic_fetch_add(p, v, __ATOMIC_RELAXED, __HIP_MEMORY_SCOPE_AGENT); }
__device__ __forceinline__ unsigned xb_xcc_id() { return (unsigned)__builtin_amdgcn_s_getreg((3 << 11) | 20) & 0xFu; }
#define XB_SPIN(cond, bar) do { unsigned _sp = 0; while (cond) { __builtin_amdgcn_s_sleep(1); \
    if ((++_sp & 255u) == 0u) { if (xb_ld(&(bar)[XB_TMO])) break; if (_sp > XB_SPIN_CAP) { atomicAdd(&(bar)[XB_TMO], 1u); break; } } } } while (0)

struct XcdBarrier { unsigned* bar; unsigned x; volatile LAS unsigned* st; };

__device__ __forceinline__ XcdBarrier xcd_barrier_post(unsigned* bar, volatile LAS unsigned* st) {
    XcdBarrier b; b.bar = bar; b.x = xb_xcc_id(); b.st = st;
    if (threadIdx.x == 0) (void)xb_add(&bar[XB_XCNT(b.x)], 1u);
    return b;
}
__device__ __forceinline__ void xcd_barrier_complete(unsigned* bar, unsigned x, unsigned& nloc, unsigned& nx) {
    const unsigned G = gridDim.x * gridDim.y * gridDim.z;
    unsigned sum, cnt, mine, sp = 0u;
    for (;;) {
        sum = 0u; cnt = 0u; mine = 0u;
#pragma unroll
        for (unsigned j = 0; j < 16; ++j) { const unsigned c = xb_ld(&bar[XB_XCNT(j)]); sum += c; cnt += (c > 0u) ? 1u : 0u; mine = (j == x) ? c : mine; }
        if (sum == G) break;
        __builtin_amdgcn_s_sleep(1);
        if ((++sp & 255u) == 0u) { if (xb_ld(&bar[XB_TMO])) break; if (sp > XB_SPIN_CAP) { atomicAdd(&bar[XB_TMO], 1u); break; } }
    }
    nloc = mine > 0u ? mine : 1u; nx = cnt > 0u ? cnt : 1u;
}
__device__ __forceinline__ void xcd_barrier(const XcdBarrier& b) {
    asm volatile("s_waitcnt vmcnt(0)" ::: "memory");
    __syncthreads();
    if (threadIdx.x == 0) {
        unsigned* bar = b.bar;
        __builtin_amdgcn_s_waitcnt(0);
        unsigned nloc = b.st[0], nx = b.st[1];
        if (nloc == 0u) { xcd_barrier_complete(bar, b.x, nloc, nx); b.st[0] = nloc; b.st[1] = nx; }
        const unsigned old = xb_add(&bar[XB_XSUB(b.x)], 1u);
        const unsigned gen = old / nloc;
        if (old + 1u == (gen + 1u) * nloc) {
            __builtin_amdgcn_fence(__ATOMIC_RELEASE, "agent");
            asm volatile("s_waitcnt vmcnt(0)" ::: "memory");
            const unsigned og = xb_add(&bar[XB_TOP], 1u);
            const unsigned tg = og / nx;
            if (og + 1u == (tg + 1u) * nx) xb_add(&bar[XB_TOPGEN], 1u);
            else XB_SPIN(xb_ld(&bar[XB_TOPGEN]) == tg, bar);
            __builtin_amdgcn_fence(__ATOMIC_ACQUIRE, "agent");
            xb_add(&bar[XB_XGEN(b.x)], 1u);
            asm volatile("s_waitcnt vmcnt(0)" ::: "memory");
        } else {
            XB_SPIN(xb_ld(&bar[XB_XGEN(b.x)]) == gen, bar);
            __builtin_amdgcn_fence(__ATOMIC_ACQUIRE, "agent");
            asm volatile("s_waitcnt vmcnt(0)" ::: "memory");
        }
    }
    __syncthreads();
}

__device__ __forceinline__ float wave_sum(float v) {
#pragma unroll
    for (int o = 32; o > 0; o >>= 1) v += __shfl_xor(v, o);
    return v;
}
__device__ __forceinline__ int wave_sum_i(int v) {
#pragma unroll
    for (int o = 32; o > 0; o >>= 1) v += __shfl_xor(v, o);
    return v;
}
__device__ __forceinline__ float wave_max(float v) {
#pragma unroll
    for (int o = 32; o > 0; o >>= 1) v = fmaxf(v, __shfl_xor(v, o));
    return v;
}
__device__ __forceinline__ float sigmoidf_(float x) { return 1.f / (1.f + expf(-x)); }
__device__ __forceinline__ float siluf_(float x) { return x / (1.f + expf(-x)); }
__device__ __forceinline__ float softplusf_(float x) { return fmaxf(x, 0.f) + log1pf(expf(-fabsf(x))); }
__device__ __forceinline__ unsigned ordkey(float f) { const unsigned u = __float_as_uint(f); return (u & 0x80000000u) ? ~u : (u | 0x80000000u); }

__device__ __forceinline__ void sincos_d(double a, double& s, double& c) {
    const double kq = rint(a * 0.63661977236758134308);
    double r = fma(-kq, 1.57079632673412561417e+00, a);
    r = fma(-kq, 6.07710050650619224932e-11, r);
    const int q = (int)((long long)kq & 3);
    const double r2 = r * r;
    const double sp = r * (1.0 + r2 * (-1.0 / 6 + r2 * (1.0 / 120 + r2 * (-1.0 / 5040 + r2 * (1.0 / 362880 + r2 * (-1.0 / 39916800 + r2 * (1.0 / 6227020800.0)))))));
    const double cp = 1.0 + r2 * (-0.5 + r2 * (1.0 / 24 + r2 * (-1.0 / 720 + r2 * (1.0 / 40320 + r2 * (-1.0 / 3628800 + r2 * (1.0 / 479001600.0 + r2 * (-1.0 / 87178291200.0)))))));
    if (q == 0) { s = sp; c = cp; } else if (q == 1) { s = cp; c = -sp; } else if (q == 2) { s = -sp; c = -cp; } else { s = -cp; c = sp; }
}
__device__ __forceinline__ double ipow_d(double b, int e) { double v = 1.0; while (e) { if (e & 1) v *= b; b *= b; e >>= 1; } return v; }

struct GemmArgs { const float* A; int lda; const int* rows; int m0; int mvalid; const float* B; int ldb; int n0; int N; int K; };

template <class Epi>
__device__ __forceinline__ void gemm128(const GemmArgs& g, float* smem, Epi epi) {
    float* As = smem;
    float* Bs = smem + 16 * 132;
    int tid_ = threadIdx.x; asm volatile("" : "+v"(tid_)); const int tid = tid_, ty = tid >> 4, tx = tid & 15;
    const int arow = tid >> 2, kq = (tid & 3) * 4;
    const int bk = tid >> 5, bn = (tid & 31) * 4;
    long asrc = -1;
    if (arow < g.mvalid) { const int r = g.rows ? g.rows[arow] : (g.m0 + arow); if (r >= 0) asrc = (long)r * g.lda; }
    const bool bval = (g.n0 + bn) < g.N;
    float acc[4][8];
#pragma unroll
    for (int i = 0; i < 4; ++i)
#pragma unroll
        for (int j = 0; j < 8; ++j) acc[i][j] = 0.f;
    for (int k0 = 0; k0 < g.K; k0 += 16) {
        float4 av = make_float4(0.f, 0.f, 0.f, 0.f), bv = make_float4(0.f, 0.f, 0.f, 0.f);
        if (asrc >= 0) av = *(const float4*)(g.A + asrc + k0 + kq);
        if (bval) bv = *(const float4*)(g.B + (size_t)(k0 + bk) * g.ldb + g.n0 + bn);
        __syncthreads();
        As[(kq + 0) * 132 + arow] = av.x; As[(kq + 1) * 132 + arow] = av.y; As[(kq + 2) * 132 + arow] = av.z; As[(kq + 3) * 132 + arow] = av.w;
        *(float4*)&Bs[bk * 132 + bn] = bv;
        __syncthreads();
#pragma unroll
        for (int kk = 0; kk < 16; ++kk) {
            const float4 a = *(const float4*)&As[kk * 132 + ty * 4];
            const float4 b0 = *(const float4*)&Bs[kk * 132 + tx * 8];
            const float4 b1 = *(const float4*)&Bs[kk * 132 + tx * 8 + 4];
            const float aa[4] = {a.x, a.y, a.z, a.w};
            const float bb[8] = {b0.x, b0.y, b0.z, b0.w, b1.x, b1.y, b1.z, b1.w};
#pragma unroll
            for (int i = 0; i < 4; ++i)
#pragma unroll
                for (int j = 0; j < 8; ++j) acc[i][j] += aa[i] * bb[j];
        }
    }
#pragma unroll
    for (int i = 0; i < 4; ++i) {
        const int r = ty * 4 + i;
        if (r < g.mvalid) {
#pragma unroll
            for (int j = 0; j < 8; ++j) { const int n = g.n0 + tx * 8 + j; if (n < g.N) epi(r, n, acc[i][j]); }
        }
    }
}


typedef short bf16x8 __attribute__((ext_vector_type(8)));
typedef float f32x4 __attribute__((ext_vector_type(4)));
typedef unsigned short bf16_t;
typedef __bf16 bf16x2_t __attribute__((ext_vector_type(2)));
typedef float f32x2_t __attribute__((ext_vector_type(2)));
__device__ __forceinline__ unsigned cvt_pk_bf16(float lo, float hi) { const f32x2_t v = {lo, hi}; const bf16x2_t r = __builtin_convertvector(v, bf16x2_t); return __builtin_bit_cast(unsigned, r); }
__device__ __forceinline__ bf16_t f2bf(float f) { return (bf16_t)(cvt_pk_bf16(f, 0.f) & 0xffffu); }
__device__ __forceinline__ float bf16_to_f32(bf16_t v) { return __uint_as_float(((unsigned)v) << 16); }
__device__ __forceinline__ uint2 pack4(const f32x4 v) { uint2 r; r.x = cvt_pk_bf16(v[0], v[1]); r.y = cvt_pk_bf16(v[2], v[3]); return r; }
__device__ __forceinline__ f32x4 unpack4(const uint2 u) { f32x4 r; r[0] = __uint_as_float(u.x << 16); r[1] = __uint_as_float(u.x & 0xffff0000u); r[2] = __uint_as_float(u.y << 16); r[3] = __uint_as_float(u.y & 0xffff0000u); return r; }
#define PBF(Pb_, t_, c_) bf16_to_f32((Pb_)[(size_t)(t_) * LDPB + (c_)])
__device__ __forceinline__ uint4 pack8(const float4 a, const float4 b) { uint4 r; r.x = cvt_pk_bf16(a.x, a.y); r.y = cvt_pk_bf16(a.z, a.w); r.z = cvt_pk_bf16(b.x, b.y); r.w = cvt_pk_bf16(b.z, b.w); return r; }
__device__ __forceinline__ int lds_off(int r, int c) { return r * 128 + ((c ^ (r & 7)) << 4); }

template <class ALoad, class BLoad, class Epi>
__device__ __forceinline__ void gemm_tile_bf16(const int K, unsigned char* lds, ALoad aload, BLoad bload, Epi epi, const int mrows = 256) {
    int tid_ = threadIdx.x; asm volatile("" : "+v"(tid_)); const int tid = tid_, lane = tid & 63, wid = tid >> 6, wm = wid >> 1, wn = wid & 1;
    f32x4 acc[4][4];
#pragma unroll
    for (int mi = 0; mi < 4; ++mi)
#pragma unroll
        for (int ni = 0; ni < 4; ++ni) acc[mi][ni] = (f32x4){0.f, 0.f, 0.f, 0.f};
    uint4 ra[4], rb[2];
    const int nk = K >> 6;
#pragma unroll
    for (int i = 0; i < 4; ++i) { const int q = tid + 512 * i; ra[i] = aload(i, q >> 3, (q & 7) * 8); }
#pragma unroll
    for (int i = 0; i < 2; ++i) { const int q = tid + 512 * i; rb[i] = bload(i, q >> 3, (q & 7) * 8); }
    __syncthreads();
#pragma unroll
    for (int i = 0; i < 4; ++i) { const int q = tid + 512 * i; *(uint4*)(lds + lds_off(q >> 3, q & 7)) = ra[i]; }
#pragma unroll
    for (int i = 0; i < 2; ++i) { const int q = tid + 512 * i; *(uint4*)(lds + 32768 + lds_off(q >> 3, q & 7)) = rb[i]; }
    __syncthreads();
    for (int kt = 0; kt < nk; ++kt) {
        if (kt + 1 < nk) {
#pragma unroll
            for (int i = 0; i < 4; ++i) { const int q = tid + 512 * i; ra[i] = aload(i, q >> 3, (kt + 1) * 64 + (q & 7) * 8); }
#pragma unroll
            for (int i = 0; i < 2; ++i) { const int q = tid + 512 * i; rb[i] = bload(i, q >> 3, (kt + 1) * 64 + (q & 7) * 8); }
        }
        const unsigned char* At = lds + (kt & 1) * 49152;
        const unsigned char* Bt = At + 32768;
        if (__builtin_amdgcn_readfirstlane(wm) * 64 < mrows) {
#pragma unroll
        for (int ks = 0; ks < 2; ++ks) {
            bf16x8 af[4], bfr[4];
            const int c = ks * 4 + (lane >> 4);
#pragma unroll
            for (int mi = 0; mi < 4; ++mi) af[mi] = *(const bf16x8*)(At + lds_off(wm * 64 + mi * 16 + (lane & 15), c));
#pragma unroll
            for (int ni = 0; ni < 4; ++ni) bfr[ni] = *(const bf16x8*)(Bt + lds_off(wn * 64 + ni * 16 + (lane & 15), c));
            __builtin_amdgcn_s_setprio(1);
#pragma unroll
            for (int mi = 0; mi < 4; ++mi)
#pragma unroll
                for (int ni = 0; ni < 4; ++ni) acc[mi][ni] = __builtin_amdgcn_mfma_f32_16x16x32_bf16(bfr[ni], af[mi], acc[mi][ni], 0, 0, 0);
            __builtin_amdgcn_s_setprio(0);
        }
        }
        if (kt + 1 < nk) {
            unsigned char* An = lds + ((kt + 1) & 1) * 49152;
#pragma unroll
            for (int i = 0; i < 4; ++i) { const int q = tid + 512 * i; *(uint4*)(An + lds_off(q >> 3, q & 7)) = ra[i]; }
#pragma unroll
            for (int i = 0; i < 2; ++i) { const int q = tid + 512 * i; *(uint4*)(An + 32768 + lds_off(q >> 3, q & 7)) = rb[i]; }
        }
        __syncthreads();
    }
    epi(acc, wm, wn, lane);
}

__device__ __forceinline__ void convert_tile(const float* src0, const float* src1, int mode, int K, int N, int ld, bf16_t* dst, int rt, int kt, float* smem) {
    int tid_ = threadIdx.x; asm volatile("" : "+v"(tid_)); const int tid = tid_;
    __syncthreads();
    { const int k = tid >> 3, R0 = rt * 64 + (tid & 7) * 8;
      const float* sp; int col;
      if (mode == 0) { sp = src0; col = R0; } else { sp = (R0 & 32) ? src1 : src0; col = (R0 >> 6) * 32 + (R0 & 31); }
      float4 a = make_float4(0.f, 0.f, 0.f, 0.f), b = a;
      const float* rp = sp + (size_t)(kt * 64 + k) * ld + col;
      if (col < N) a = *(const float4*)rp;
      if (col + 4 < N) b = *(const float4*)(rp + 4);
      float* d = smem + k * 65 + (tid & 7) * 8;
      d[0] = a.x; d[1] = a.y; d[2] = a.z; d[3] = a.w; d[4] = b.x; d[5] = b.y; d[6] = b.z; d[7] = b.w; }
    __syncthreads();
    { const int R = tid >> 3, kc = (tid & 7) * 8;
      float v[8];
#pragma unroll
      for (int j = 0; j < 8; ++j) v[j] = smem[(kc + j) * 65 + R];
      uint4 o; o.x = cvt_pk_bf16(v[0], v[1]); o.y = cvt_pk_bf16(v[2], v[3]); o.z = cvt_pk_bf16(v[4], v[5]); o.w = cvt_pk_bf16(v[6], v[7]);
      *(uint4*)(dst + (size_t)(rt * 64 + R) * K + kt * 64 + kc) = o; }
}

#define CT_LOAD(S0, S1, MODE, NN, LD, RT, KT, A, B) do { const int k_ = tid >> 3, R0_ = (RT) * 64 + (tid & 7) * 8; const float* sp_; int col_; \
        if ((MODE) == 0) { sp_ = (S0); col_ = R0_; } else { sp_ = (R0_ & 32) ? (S1) : (S0); col_ = (R0_ >> 6) * 32 + (R0_ & 31); } \
        A = make_float4(0.f, 0.f, 0.f, 0.f); B = A; const float* rp_ = sp_ + (size_t)((KT) * 64 + k_) * (LD) + col_; \
        if (col_ < (NN)) A = *(const float4*)rp_; if (col_ + 4 < (NN)) B = *(const float4*)(rp_ + 4); } while (0)
#define CT_WRITE(BUF, A, B) do { float* d_ = smem + (BUF) * 4160 + (tid >> 3) * 65 + (tid & 7) * 8; \
        d_[0] = A.x; d_[1] = A.y; d_[2] = A.z; d_[3] = A.w; d_[4] = B.x; d_[5] = B.y; d_[6] = B.z; d_[7] = B.w; } while (0)
#define CT_STORE(DST, KK, RT, KT, BUF) do { const int R_ = tid >> 3, kc_ = (tid & 7) * 8; const float* sb_ = smem + (BUF) * 4160; \
        uint4 o_; o_.x = cvt_pk_bf16(sb_[(kc_ + 0) * 65 + R_], sb_[(kc_ + 1) * 65 + R_]); o_.y = cvt_pk_bf16(sb_[(kc_ + 2) * 65 + R_], sb_[(kc_ + 3) * 65 + R_]); \
        o_.z = cvt_pk_bf16(sb_[(kc_ + 4) * 65 + R_], sb_[(kc_ + 5) * 65 + R_]); o_.w = cvt_pk_bf16(sb_[(kc_ + 6) * 65 + R_], sb_[(kc_ + 7) * 65 + R_]); \
        *(uint4*)((DST) + (size_t)((RT) * 64 + R_) * (KK) + (KT) * 64 + kc_) = o_; } while (0)
#define CT_DECL(I) const float* s0_##I; const float* s1_##I; bf16_t* d_##I; int md_##I, K_##I, N_##I, ld_##I, rt_##I, kt_##I
#define CT_ARGS(I) s0_##I, s1_##I, d_##I, md_##I, K_##I, N_##I, ld_##I, rt_##I, kt_##I
template <class Dec>
__device__ __forceinline__ void convert_tiles4(const Dec& dec, int t, int nj, float* smem) {
    int tid_ = threadIdx.x; asm volatile("" : "+v"(tid_)); const int tid = tid_;
    CT_DECL(0); CT_DECL(1); CT_DECL(2); CT_DECL(3);
    dec(t, CT_ARGS(0)); dec(t + 1, CT_ARGS(1)); dec(t + 2, CT_ARGS(2)); dec(t + 3, CT_ARGS(3));
    float4 a0, b0, a1, b1, a2, b2, a3, b3;
    a1 = b1 = a2 = b2 = a3 = b3 = make_float4(0.f, 0.f, 0.f, 0.f);
    CT_LOAD(s0_0, s1_0, md_0, N_0, ld_0, rt_0, kt_0, a0, b0);
    if (nj > 1) CT_LOAD(s0_1, s1_1, md_1, N_1, ld_1, rt_1, kt_1, a1, b1);
    if (nj > 2) CT_LOAD(s0_2, s1_2, md_2, N_2, ld_2, rt_2, kt_2, a2, b2);
    if (nj > 3) CT_LOAD(s0_3, s1_3, md_3, N_3, ld_3, rt_3, kt_3, a3, b3);
    __syncthreads();
    CT_WRITE(0, a0, b0); CT_WRITE(1, a1, b1); CT_WRITE(2, a2, b2); CT_WRITE(3, a3, b3);
    __syncthreads();
    CT_STORE(d_0, K_0, rt_0, kt_0, 0);
    if (nj > 1) CT_STORE(d_1, K_1, rt_1, kt_1, 1);
    if (nj > 2) CT_STORE(d_2, K_2, rt_2, kt_2, 2);
    if (nj > 3) CT_STORE(d_3, K_3, rt_3, kt_3, 3);
}

extern __shared__ __attribute__((aligned(16))) unsigned char g_smem[];
#define PHASE_FN __device__ __forceinline__
enum { PH_PROLOGUE = 0, PH_NORM_MIX, PH_GEMM_IN_EVEN, PH_EVEN_TOK, PH_GDN_CHUNK, PH_GDN_SCAN, PH_DSA_TOPK, PH_DSA_ATTN, PH_GDN_OUT,
       PH_GEMM_OUT, PH_NORM_FFN, PH_MOE1, PH_MOE2, PH_GEMM_IN_ODD, PH_GLA_TOK, PH_GLA_CHUNK, PH_GLA_SCAN, PH_GLA_OUT, PH_FINAL };

PHASE_FN void ph_prologue(const Params& p, float* smem) {
    unsigned char* ws_ = p.ws; asm volatile("" : "+s"(ws_));
    { int ldz_ = 0; asm volatile("" : "+s"(ldz_)); smem = (float*)(g_smem + ldz_); }
    int tid_ = threadIdx.x; asm volatile("" : "+v"(tid_)); const int tid = tid_, nthr = gridDim.x * NTHREADS, gid = blockIdx.x * NTHREADS + tid;
    for (int i = tid; i < 2 * ND; i += NTHREADS) smem[i] = siluf_(p.c[i]);
    __syncthreads();
    float* MOD = (float*)(ws_ + OFF_MOD);
    { float* red = smem + 2048;
      const int lane = tid & 63, wv = tid >> 6;
      for (int item = blockIdx.x; item < 4 * 96; item += gridDim.x) {
          const int l = item / 96, n = (item % 96) * 64 + lane;
          const float* w = p.ada_w + (size_t)l * ND * 6144 + n;
          float a0 = 0.f, a1 = 0.f;
#pragma unroll 8
          for (int k = wv * 128; k < wv * 128 + 128; ++k) { const float wv_ = w[(size_t)k * 6144]; a0 += smem[k] * wv_; a1 += smem[ND + k] * wv_; }
          __syncthreads();
          red[(wv * 64 + lane) * 2] = a0; red[(wv * 64 + lane) * 2 + 1] = a1;
          __syncthreads();
          if (tid < 128) { const int c = tid >> 1, bb = tid & 1; float a = 0.f; for (int w8 = 0; w8 < 8; ++w8) a += red[(w8 * 64 + c) * 2 + bb];
              MOD[(l * 2 + bb) * 6144 + (item % 96) * 64 + c] = a + p.ada_b[l * 6144 + (item % 96) * 64 + c]; }
      }
      __syncthreads(); }
    float* COSA = (float*)(ws_ + OFF_COSA); float* SINA = (float*)(ws_ + OFF_SINA);
    float* COSI = (float*)(ws_ + OFF_COSI); float* SINI = (float*)(ws_ + OFF_SINI);
    for (size_t i = gid; i < (size_t)NT * 64; i += nthr) {
        const int t = (int)(i >> 6), j = (int)(i & 63);
        double s, c; sincos_d((double)p.pos[t] * ipow_d(p.rA, j), s, c);
        COSA[i] = (float)c; SINA[i] = (float)s;
    }
    for (size_t i = gid; i < (size_t)NT * 32; i += nthr) {
        const int t = (int)(i >> 5), j = (int)(i & 31);
        double s, c; sincos_d((double)p.pos[t] * ipow_d(p.rI, j), s, c);
        COSI[i] = (float)c; SINI[i] = (float)s;
    }
}

PHASE_FN void ph_rows(const Params& p, int layer, int mode, float* smem) {
    unsigned char* ws_ = p.ws; asm volatile("" : "+s"(ws_));
    { int ldz_ = 0; asm volatile("" : "+s"(ldz_)); smem = (float*)(g_smem + ldz_); }
    int tid_ = threadIdx.x; asm volatile("" : "+v"(tid_)); const int tid = tid_, lane = tid & 63, wv = tid >> 6;
    int* pad = (int*)smem;
    const int moe_layer = (mode == 1) ? 3 : layer - 1;
    if (moe_layer >= 0) {
        if (tid == 0) { const int* cnt = (const int*)(ws_ + OFF_CNT) + moe_layer * 32 * CSTR; int a = 0; for (int e = 0; e < 32; ++e) { pad[e] = a; a += ((cnt[e * CSTR] + 127) / 128) * 128; } }
        __syncthreads();
    }
    const float* MOD = (const float*)(ws_ + OFF_MOD);
    bf16_t* H = (bf16_t*)(ws_ + OFF_H);
    const bf16_t* YB = (const bf16_t*)(ws_ + OFF_YB);
    const int* ASG = (const int*)(ws_ + OFF_ASG);
    const float* GATE = (const float*)(ws_ + OFF_GATE);
    auto load_x = [&](int row, float (&xv)[16]) {
        const float* xin = (mode == 0 && layer == 0) ? (p.x + (size_t)row * ND) : (p.X + (size_t)row * ND);
#pragma unroll
        for (int j = 0; j < 4; ++j) { const float4 v = *(const float4*)(xin + j * 256 + lane * 4); xv[4 * j] = v.x; xv[4 * j + 1] = v.y; xv[4 * j + 2] = v.z; xv[4 * j + 3] = v.w; }
    };
    auto load_y = [&](int row, uint2 (&ya)[4], uint2 (&yb)[4], float& g0, float& g1) {
        const int4 as = *(const int4*)(ASG + row * 4);
        g0 = GATE[row * 2]; g1 = GATE[row * 2 + 1];
        const bf16_t* y0 = YB + (size_t)(pad[as.x] + as.y) * ND;
        const bf16_t* y1 = YB + (size_t)(pad[as.z] + as.w) * ND;
#pragma unroll
        for (int j = 0; j < 4; ++j) { ya[j] = *(const uint2*)(y0 + j * 256 + lane * 4); yb[j] = *(const uint2*)(y1 + j * 256 + lane * 4); }
    };
    auto finish = [&](int row, float (&xv)[16], const uint2 (&ya)[4], const uint2 (&yb)[4], float g0, float g1) {
        const int b = row >> 13;
        float* xr = p.X + (size_t)row * ND;
        if (moe_layer >= 0) {
            const float* gt = MOD + (size_t)(moe_layer * 2 + b) * 6144 + 5 * 1024;
#pragma unroll
            for (int j = 0; j < 4; ++j) {
                const int col = j * 256 + lane * 4;
                const f32x4 a = unpack4(ya[j]), bq = unpack4(yb[j]); const float4 g = *(const float4*)(gt + col);
                xv[4 * j] += g.x * (g0 * a[0] + g1 * bq[0]); xv[4 * j + 1] += g.y * (g0 * a[1] + g1 * bq[1]);
                xv[4 * j + 2] += g.z * (g0 * a[2] + g1 * bq[2]); xv[4 * j + 3] += g.w * (g0 * a[3] + g1 * bq[3]);
                if (mode == 0) *(float4*)(xr + col) = make_float4(xv[4 * j], xv[4 * j + 1], xv[4 * j + 2], xv[4 * j + 3]);
            }
        }
        float ss = 0.f;
#pragma unroll
        for (int j = 0; j < 16; ++j) ss += xv[j] * xv[j];
        ss = wave_sum(ss);
        const float rstd = rsqrtf(ss * (1.f / 1024.f) + EPS);
        if (mode == 0) {
            const float* nw = p.norm_mix + layer * 1024;
            const float* sh = MOD + (size_t)(layer * 2 + b) * 6144;
            const float* sc = sh + 1024;
#pragma unroll
            for (int j = 0; j < 4; ++j) {
                const int col = j * 256 + lane * 4;
                const float4 w = *(const float4*)(nw + col), s4 = *(const float4*)(sc + col), h4 = *(const float4*)(sh + col);
                f32x4 ov;
                ov[0] = xv[4 * j] * rstd * w.x * (1.f + s4.x) + h4.x; ov[1] = xv[4 * j + 1] * rstd * w.y * (1.f + s4.y) + h4.y;
                ov[2] = xv[4 * j + 2] * rstd * w.z * (1.f + s4.z) + h4.z; ov[3] = xv[4 * j + 3] * rstd * w.w * (1.f + s4.w) + h4.w;
                *(uint2*)(H + (size_t)row * ND + col) = pack4(ov);
            }
        } else {
#pragma unroll
            for (int j = 0; j < 4; ++j) {
                const int col = j * 256 + lane * 4;
                const float4 w = *(const float4*)(p.final_norm + col);
                *(float4*)(xr + col) = make_float4(xv[4 * j] * rstd * w.x, xv[4 * j + 1] * rstd * w.y, xv[4 * j + 2] * rstd * w.z, xv[4 * j + 3] * rstd * w.w);
            }
        }
    };
    const int stride = gridDim.x * 8;
    for (int row = blockIdx.x * 8 + wv; row < NT; row += 2 * stride) {
        const int rowB = row + stride; const bool hasB = rowB < NT; const int rB = hasB ? rowB : row;
        float xa[16], xb[16]; uint2 yaa[4], yab[4], yba[4], ybb[4]; float ga0 = 0.f, ga1 = 0.f, gb0 = 0.f, gb1 = 0.f;
        load_x(row, xa); load_x(rB, xb);
        if (moe_layer >= 0) { load_y(row, yaa, yab, ga0, ga1); load_y(rB, yba, ybb, gb0, gb1); }
        finish(row, xa, yaa, yab, ga0, ga1);
        if (hasB) finish(rowB, xb, yba, ybb, gb0, gb1);
    }
}

PHASE_FN void ph_gemm_in(const Params& p, int layer, bool even, float* smem) {
    unsigned char* ws_ = p.ws; asm volatile("" : "+s"(ws_));
    { int ldz_ = 0; asm volatile("" : "+s"(ldz_)); smem = (float*)(g_smem + ldz_); }
    const int N = even ? 3916 : 3088, ntn = even ? 31 : 25;
    const bf16_t* Wt = even ? (const bf16_t*)(ws_ + OFF_WINE) + (size_t)(layer >> 1) * 3968 * 1024 : (const bf16_t*)(ws_ + OFF_WINO) + (size_t)(layer >> 1) * 3200 * 1024;
    const bf16_t* H = (const bf16_t*)(ws_ + OFF_H);
    bf16_t* P = (bf16_t*)(ws_ + OFF_P);
    float* AUX = (float*)(ws_ + OFF_AUX);
    const int vb_ = (((int)gridDim.x & 7) == 0) ? (((int)blockIdx.x & 7) * ((int)gridDim.x >> 3) + ((int)blockIdx.x >> 3)) : (int)blockIdx.x;
    for (int tile = vb_; tile < 64 * ntn; tile += gridDim.x) {
        const int grp_ = tile / (8 * ntn), rr_ = tile % (8 * ntn), mt = grp_ * 8 + (rr_ & 7), nt = rr_ >> 3;
        const bf16_t* Ab = H + (size_t)mt * 256 * 1024;
        const bf16_t* Bb = Wt + (size_t)nt * 128 * 1024;
        bf16_t* Pt = P + (size_t)mt * 256 * LDPB + nt * 128;
        float* At = AUX + (size_t)mt * 256 * 16;
        const int ncol0 = nt * 128;
        const int nrem = N - nt * 128;
        gemm_tile_bf16(1024, (unsigned char*)smem,
            [=](int i, int r, int k) -> uint4 { return *(const uint4*)(Ab + (size_t)r * 1024 + k); },
            [=](int i, int r, int k) -> uint4 { return *(const uint4*)(Bb + (size_t)r * 1024 + k); },
            [=](const f32x4 (&acc)[4][4], int wm, int wn, int lane) {
#pragma unroll
                for (int mi = 0; mi < 4; ++mi)
#pragma unroll
                    for (int ni = 0; ni < 4; ++ni) {
                        const int m = wm * 64 + mi * 16 + (lane & 15), n = wn * 64 + ni * 16 + 4 * (lane >> 4);
                        if (n < nrem) {
                            *(uint2*)(Pt + (size_t)m * LDPB + n) = pack4(acc[mi][ni]);
                            const int gc = ncol0 + n;
                            int ax = -1;
                            if (even) { if (gc == 2048) ax = 0; else if (gc == 2052) ax = 4; else if (gc == 3912) ax = 8; }
                            else { if (gc >= 3072 && gc < 3088) ax = gc - 3072; }
                            if (ax >= 0) *(f32x4*)(At + (size_t)m * 16 + ax) = acc[mi][ni];
                        }
                    }
            });
    }
}

PHASE_FN void ph_even_tok(const Params& p, int layer, float* smem) {
    unsigned char* ws_ = p.ws; asm volatile("" : "+s"(ws_));
    { int ldz_ = 0; asm volatile("" : "+s"(ldz_)); smem = (float*)(g_smem + ldz_); }
    int tid_ = threadIdx.x; asm volatile("" : "+v"(tid_)); const int tid = tid_, lane = tid & 63, wv = tid >> 6, li = layer >> 1;
    const bf16_t* P = (const bf16_t*)(ws_ + OFF_P); const float* AUX = (const float*)(ws_ + OFF_AUX);
    bf16_t* QB = (bf16_t*)(ws_ + OFF_QBB); bf16_t* KB = (bf16_t*)(ws_ + OFF_KBB); bf16_t* QI = (bf16_t*)(ws_ + OFF_QIB); bf16_t* KI = (bf16_t*)(ws_ + OFF_KIB); float* WI = (float*)(ws_ + OFF_WI);
    const float* COSA = (const float*)(ws_ + OFF_COSA); const float* SINA = (const float*)(ws_ + OFF_SINA);
    const float* COSI = (const float*)(ws_ + OFF_COSI); const float* SINI = (const float*)(ws_ + OFF_SINI);
    for (int t = blockIdx.x * 8 + wv; t < NT; t += gridDim.x * 8) {
        const bf16_t* Pt = P + (size_t)t * LDPB;
        if (lane < 4) {
            WI[t * 4 + lane] = AUX[(size_t)t * 16 + 8 + lane] * 0.0625f;
        }
        { const float c = COSA[(size_t)t * 64 + lane], sn = SINA[(size_t)t * 64 + lane];
#pragma unroll
          for (int h = 0; h < 4; ++h) {
              float t1 = bf16_to_f32(Pt[2056 + h * 128 + lane]), t2 = bf16_to_f32(Pt[2056 + h * 128 + 64 + lane]);
              QB[(size_t)t * 512 + h * 128 + lane] = f2bf(t1 * c - t2 * sn); QB[(size_t)t * 512 + h * 128 + 64 + lane] = f2bf(t2 * c + t1 * sn);
              t1 = bf16_to_f32(Pt[2568 + h * 128 + lane]); t2 = bf16_to_f32(Pt[2568 + h * 128 + 64 + lane]);
              KB[(size_t)t * 512 + h * 128 + lane] = f2bf(t1 * c - t2 * sn); KB[(size_t)t * 512 + h * 128 + 64 + lane] = f2bf(t2 * c + t1 * sn);
          } }
#pragma unroll
        for (int r = 0; r < 2; ++r) {
            const int item = lane + 64 * r, hh = item >> 5, ii = item & 31;
            const float c = COSI[(size_t)t * 32 + ii], sn = SINI[(size_t)t * 32 + ii];
            const float t1 = bf16_to_f32(Pt[3592 + hh * 64 + ii]), t2 = bf16_to_f32(Pt[3592 + hh * 64 + 32 + ii]);
            QI[(size_t)t * 256 + hh * 64 + ii] = f2bf(t1 * c - t2 * sn); QI[(size_t)t * 256 + hh * 64 + 32 + ii] = f2bf(t2 * c + t1 * sn);
        }
        if (lane < 32) {
            const float c = COSI[(size_t)t * 32 + lane], sn = SINI[(size_t)t * 32 + lane];
            const float t1 = bf16_to_f32(Pt[3848 + lane]), t2 = bf16_to_f32(Pt[3848 + 32 + lane]);
            KI[(size_t)t * 64 + lane] = f2bf(t1 * c - t2 * sn); KI[(size_t)t * 64 + 32 + lane] = f2bf(t2 * c + t1 * sn);
        }
    }
    { bf16_t* VT = (bf16_t*)(ws_ + OFF_VT);
      bf16_t* sv = (bf16_t*)g_smem;
      for (int item = blockIdx.x; item < 2 * 128 * 4; item += gridDim.x) {
          const int h = item & 3, tt = item >> 2, b = tt >> 7, s0 = (tt & 127) * 64;
          __syncthreads();
          for (int e = tid; e < 64 * 128; e += NTHREADS) { const int i = e >> 7, d = e & 127; sv[d * 72 + i] = P[(size_t)(b * 8192 + s0 + i) * LDPB + 3080 + h * 128 + d]; }
          __syncthreads();
          for (int e = tid; e < 128 * 8; e += NTHREADS) { const int d = e >> 3, c = e & 7;
              *(uint4*)(VT + ((size_t)((b * 4 + h) * 128 + d)) * 8192 + s0 + c * 8) = *(const uint4*)(sv + d * 72 + c * 8); }
      } }
}

__device__ __forceinline__ f32x4 mma_lds(const unsigned char* A, int sa, int a0, const unsigned char* B, int sb, int b0, int K, f32x4 acc, int c16, int q4) {
    const unsigned char* ap = A + (a0 + c16) * sa + q4 * 16;
    const unsigned char* bp = B + (b0 + c16) * sb + q4 * 16;
    for (int kk = 0; kk < K; kk += 32) { acc = __builtin_amdgcn_mfma_f32_16x16x32_bf16(*(const bf16x8*)(ap + kk * 2), *(const bf16x8*)(bp + kk * 2), acc, 0, 0, 0); }
    return acc;
}

PHASE_FN void ph_gdn_chunk(const Params& p, int layer, float* smem) {
    unsigned char* ws_ = p.ws; asm volatile("" : "+s"(ws_));
    int tid_ = threadIdx.x; asm volatile("" : "+v"(tid_)); const int tid = tid_, lane = tid & 63, wv = __builtin_amdgcn_readfirstlane(tid >> 6), q4 = lane >> 4, c16 = lane & 15;
    int ldz_ = 0; asm volatile("" : "+s"(ldz_)); unsigned char* lds = g_smem + ldz_;
    constexpr int SN = 272, ST = 144;
    unsigned char* bKN = lds;
    unsigned char* bQN = lds + 18432;
    unsigned char* bKBG = lds + 35840;
    unsigned char* bVB = lds + 54272;
    unsigned char* bKD = lds + 72704;
    unsigned char* bUT = lds + 91136;
    float* sL = (float*)(lds + 109568);
    unsigned char* bAQK = lds + 126208;
    unsigned char* bTB = lds + 135424;
    float* sG = (float*)(lds + 144640); float* sB = sG + 64; float* sEg = sB + 64;
    const int li = layer >> 1;
    const bf16_t* P = (const bf16_t*)(ws_ + OFF_P); const float* AUX = (const float*)(ws_ + OFF_AUX);
    const float* cw = p.conv_w + (size_t)li * 4 * 1536;
    uint4* PFR = (uint4*)(ws_ + OFF_PFR); uint4* RFR = (uint4*)(ws_ + OFF_RFR); uint2* QFR = (uint2*)(ws_ + OFF_QFR); uint2* OFR = (uint2*)(ws_ + OFF_OFR);
    float* GL = (float*)(ws_ + OFF_GL);
    for (int ci = blockIdx.x; ci < 1024; ci += gridDim.x) {
        const int b = ci >> 9, h = (ci >> 7) & 3, n = ci & 127;
        const int t0 = b * 8192 + n * 64;
        __syncthreads();
        if (tid < 64) { float g = -expf(p.a_log[li * 4 + h]) * softplusf_(AUX[(size_t)(t0 + tid) * 16 + 4 + h] + p.dt_bias[li * 4 + h]);
#pragma unroll
            for (int o = 1; o < 64; o <<= 1) { const float nb = __shfl_up(g, o); if (lane >= o) g += nb; }
            sG[tid] = g; sB[tid] = sigmoidf_(AUX[(size_t)(t0 + tid) * 16 + h]); sEg[tid] = expf(g); }
        for (int e = tid; e < 64 * 36; e += NTHREADS) ((unsigned*)bAQK)[e] = 0u;
        __syncthreads();
        const float gl = sG[63];
        {
            const int d0 = 2 * lane, cb = h * 128 + d0, s00 = n * 64;
            float wq[4][2], wk[4][2], wvv[4][2];
#pragma unroll
            for (int jj = 0; jj < 4; ++jj) { wq[jj][0] = cw[jj * 1536 + cb]; wq[jj][1] = cw[jj * 1536 + cb + 1]; wk[jj][0] = cw[jj * 1536 + 512 + cb]; wk[jj][1] = cw[jj * 1536 + 512 + cb + 1];
                                            wvv[jj][0] = cw[jj * 1536 + 1024 + cb]; wvv[jj][1] = cw[jj * 1536 + 1024 + cb + 1]; }
#pragma unroll 4
            for (int r = 0; r < 8; ++r) {
                const int i = wv + 8 * r;
                float aq0 = 0.f, aq1 = 0.f, ak0 = 0.f, ak1 = 0.f, av0 = 0.f, av1 = 0.f;
#pragma unroll
                for (int jj = 0; jj < 4; ++jj) {
                    if (s00 + i - 3 + jj >= 0) {
                        const bf16_t* rp = P + (size_t)(t0 + i - 3 + jj) * LDPB + cb;
                        const unsigned uq = *(const unsigned*)rp, uk = *(const unsigned*)(rp + 512), uv = *(const unsigned*)(rp + 1024);
                        aq0 += wq[jj][0] * __uint_as_float(uq << 16); aq1 += wq[jj][1] * __uint_as_float(uq & 0xffff0000u);
                        ak0 += wk[jj][0] * __uint_as_float(uk << 16); ak1 += wk[jj][1] * __uint_as_float(uk & 0xffff0000u);
                        av0 += wvv[jj][0] * __uint_as_float(uv << 16); av1 += wvv[jj][1] * __uint_as_float(uv & 0xffff0000u);
                    }
                }
                aq0 = siluf_(aq0); aq1 = siluf_(aq1); ak0 = siluf_(ak0); ak1 = siluf_(ak1); av0 = siluf_(av0); av1 = siluf_(av1);
                const float rq = rsqrtf(wave_sum(aq0 * aq0 + aq1 * aq1) + EPS), rk = rsqrtf(wave_sum(ak0 * ak0 + ak1 * ak1) + EPS);
                aq0 *= rq; aq1 *= rq; ak0 *= rk; ak1 *= rk;
                const float be = sB[i], eg_i = sEg[i], ekd = expf(gl - sG[i]);
                *(unsigned*)(bKN + i * SN + d0 * 2) = cvt_pk_bf16(ak0, ak1);
                *(unsigned*)(bQN + i * SN + d0 * 2) = cvt_pk_bf16(aq0, aq1);
                *(bf16_t*)(bKBG + d0 * ST + i * 2) = f2bf(ak0 * be * eg_i); *(bf16_t*)(bKBG + (d0 + 1) * ST + i * 2) = f2bf(ak1 * be * eg_i);
                *(bf16_t*)(bVB + d0 * ST + i * 2) = f2bf(av0 * be); *(bf16_t*)(bVB + (d0 + 1) * ST + i * 2) = f2bf(av1 * be);
                *(bf16_t*)(bKD + d0 * ST + i * 2) = f2bf(ak0 * ekd); *(bf16_t*)(bKD + (d0 + 1) * ST + i * 2) = f2bf(ak1 * ekd);
            }
        }
        __syncthreads();
        for (int u = wv; u < 20; u += 8) {
            const int kind = (u >= 10) ? 1 : 0, idx = u - kind * 10;
            const int ti = (idx >= 6) ? 3 : (idx >= 3) ? 2 : (idx >= 1) ? 1 : 0, tj = idx - ((ti * (ti + 1)) >> 1);
            f32x4 acc = (f32x4){0.f, 0.f, 0.f, 0.f};
            acc = mma_lds(kind ? bQN : bKN, SN, 16 * ti, bKN, SN, 16 * tj, 128, acc, c16, q4);
            const int j = 16 * tj + c16;
#pragma unroll
            for (int r = 0; r < 4; ++r) { const int i = 16 * ti + 4 * q4 + r;
                const float dec = (j <= i) ? expf(sG[i] - sG[j]) : 0.f;
                if (kind == 0) sL[i * 65 + j] = (j < i) ? sB[i] * acc[r] * dec : 0.f;
                else *(bf16_t*)(bAQK + i * ST + j * 2) = f2bf(acc[r] * SCALE128 * dec); }
        }
        __syncthreads();
        if (wv == 0) {
            float t[64];
            int zz = 0; asm volatile("" : "+v"(zz)); const float* sLo = sL + zz;
#pragma unroll
            for (int i = 0; i < 64; ++i) { float a = (i == lane) ? 1.f : 0.f;
#pragma unroll
                for (int j = 0; j < i; ++j) a -= sLo[i * 65 + j] * t[j];
                t[i] = a; asm volatile("" ::: "memory"); }
#pragma unroll
            for (int i = 0; i < 64; ++i) *(bf16_t*)(bTB + i * ST + lane * 2) = f2bf(t[i]);
        }
        __syncthreads();
        for (int x = 0; x < 8; ++x) {
            const int u = wv * 8 + x, kind = u >> 5, ti = (u >> 3) & 3, td = u & 7;
            f32x4 acc = (f32x4){0.f, 0.f, 0.f, 0.f};
            acc = mma_lds(bTB, ST, 16 * ti, kind ? bVB : bKBG, ST, 16 * td, 64, acc, c16, q4);
            *(uint2*)((kind ? bUT : bKN) + (16 * td + c16) * ST + (16 * ti + 4 * q4) * 2) = pack4(acc);
        }
        __syncthreads();
        unsigned char* bWT = bKN;
        const float eg = expf(gl);
        for (int x = 0; x < 4; ++x) {
            const int u = wv * 4 + x, ti = u >> 2, a = u & 3;
            uint4 fr;
#pragma unroll
            for (int hf = 0; hf < 2; ++hf) { const int tk = 2 * a + hf;
                f32x4 acc = (f32x4){0.f, 0.f, 0.f, 0.f};
                acc = mma_lds(bWT, ST, 16 * tk, bKD, ST, 16 * ti, 64, acc, c16, q4);
                f32x4 v;
#pragma unroll
                for (int r = 0; r < 4; ++r) v[r] = ((16 * tk + 4 * q4 + r) == (16 * ti + c16) ? eg : 0.f) - acc[r];
                const uint2 pk = pack4(v);
                if (hf == 0) { fr.x = pk.x; fr.y = pk.y; } else { fr.z = pk.x; fr.w = pk.y; } }
            PFR[((size_t)(ci * 8 + ti) * 4 + a) * 64 + lane] = fr;
        }
        for (int x = 0; x < 2; ++x) {
            const int u = wv * 2 + x, ti = u >> 2, a = u & 3;
            uint4 fr;
            const int i = 16 * ti + c16;
            const float qs = SCALE128 * sEg[i];
#pragma unroll
            for (int hf = 0; hf < 2; ++hf) { const int tk = 2 * a + hf;
                f32x4 acc = (f32x4){0.f, 0.f, 0.f, 0.f};
                acc = mma_lds(bWT, ST, 16 * tk, bAQK, ST, 16 * ti, 64, acc, c16, q4);
                const f32x4 qv = unpack4(*(const uint2*)(bQN + i * SN + (16 * tk + 4 * q4) * 2));
                const uint2 pk = pack4(qv * qs - acc);
                if (hf == 0) { fr.x = pk.x; fr.y = pk.y; } else { fr.z = pk.x; fr.w = pk.y; } }
            RFR[((size_t)(ci * 4 + ti) * 4 + a) * 64 + lane] = fr;
        }
        for (int x = 0; x < 8; ++x) {
            const int u = wv * 8 + x, tdv = u >> 3, tdk = u & 7;
            f32x4 acc = (f32x4){0.f, 0.f, 0.f, 0.f};
            acc = mma_lds(bKD, ST, 16 * tdk, bUT, ST, 16 * tdv, 64, acc, c16, q4);
            QFR[((size_t)(ci * 8 + tdv) * 8 + tdk) * 64 + lane] = pack4(acc);
        }
        for (int x = 0; x < 4; ++x) {
            const int u = wv * 4 + x, tdv = u >> 2, ti = u & 3;
            f32x4 acc = (f32x4){0.f, 0.f, 0.f, 0.f};
            acc = mma_lds(bAQK, ST, 16 * ti, bUT, ST, 16 * tdv, 64, acc, c16, q4);
            OFR[((size_t)(ci * 8 + tdv) * 4 + ti) * 64 + lane] = pack4(acc);
        }
        if (tid == 0) GL[ci] = gl;
    }
}

__device__ __forceinline__ void gs_load(uint4 (&d)[12], const unsigned char* pp, const unsigned char* rr, const unsigned char* qq, const unsigned char* oo, const int lt) {
#pragma unroll
    for (int i = 0; i < 6; ++i) { int c = lt + 384 * i; c = c < 2048 ? c : 2047; d[i] = *(const uint4*)(pp + c * 16); }
#pragma unroll
    for (int i = 0; i < 3; ++i) { int c = lt + 384 * i; c = c < 1024 ? c : 1023; d[6 + i] = *(const uint4*)(rr + c * 16); }
#pragma unroll
    for (int i = 0; i < 2; ++i) { int c = lt + 384 * i; c = c < 512 ? c : 511; d[9 + i] = *(const uint4*)(qq + c * 16); }
    { const int c = lt < 256 ? lt : 255; d[11] = *(const uint4*)(oo + c * 16); }
}
__device__ __forceinline__ void gs_store(const uint4 (&d)[12], unsigned char* sb, const int lt) {
#pragma unroll
    for (int i = 0; i < 6; ++i) { const int c = lt + 384 * i; if (c < 2048) *(uint4*)(sb + c * 16) = d[i]; }
#pragma unroll
    for (int i = 0; i < 3; ++i) { const int c = lt + 384 * i; if (c < 1024) *(uint4*)(sb + 32768 + c * 16) = d[6 + i]; }
#pragma unroll
    for (int i = 0; i < 2; ++i) { const int c = lt + 384 * i; if (c < 512) *(uint4*)(sb + 49152 + c * 16) = d[9 + i]; }
    if (lt < 256) *(uint4*)(sb + 57344 + lt * 16) = d[11];
}

#define SCAN_BODY                 bf16x8 Sb[4]; \
_Pragma("unroll") \
                for (int a = 0; a < 4; ++a) { union { uint4 u; bf16x8 v; } cv; const uint2 lo = pack4(S[2 * a]), hi = pack4(S[2 * a + 1]); cv.u.x = lo.x; cv.u.y = lo.y; cv.u.z = hi.x; cv.u.w = hi.y; Sb[a] = cv.v; } \
                const int t0 = b * 8192 + n * 64; \
                {   f32x4 oa[4]; \
_Pragma("unroll") \
                    for (int ti = 0; ti < 4; ++ti) oa[ti] = unpack4(*(const uint2*)(Of + ti * 512)); \
_Pragma("unroll") \
                    for (int a = 0; a < 4; ++a) \
_Pragma("unroll") \
                        for (int ti = 0; ti < 4; ++ti) oa[ti] = __builtin_amdgcn_mfma_f32_16x16x32_bf16(*(const bf16x8*)(Rf + (ti * 4 + a) * 1024), Sb[a], oa[ti], 0, 0, 0); \
_Pragma("unroll") \
                    for (int ti = 0; ti < 4; ++ti) { \
                        float* op = O + (size_t)(t0 + 16 * ti + 4 * q4) * 1024 + h * 128 + 16 * tdv + c16; \
                        op[0] = oa[ti][0]; op[1024] = oa[ti][1]; op[2048] = oa[ti][2]; op[3072] = oa[ti][3]; } \
                } \
                asm volatile("" ::: "memory"); \
_Pragma("unroll") \
                for (int g = 0; g < 2; ++g) { \
                    f32x4 sa[4]; \
_Pragma("unroll") \
                    for (int t = 0; t < 4; ++t) sa[t] = unpack4(*(const uint2*)(Qf + (g * 4 + t) * 512)); \
_Pragma("unroll") \
                    for (int a = 0; a < 4; ++a) \
_Pragma("unroll") \
                        for (int t = 0; t < 4; ++t) sa[t] = __builtin_amdgcn_mfma_f32_16x16x32_bf16(*(const bf16x8*)(Pf + ((g * 4 + t) * 4 + a) * 1024), Sb[a], sa[t], 0, 0, 0); \
_Pragma("unroll") \
                    for (int t = 0; t < 4; ++t) S[g * 4 + t] = sa[t]; \
                    asm volatile("" ::: "memory"); \
                }
PHASE_FN void ph_gdn_scan(const Params& p, float* smem) {
    unsigned char* ws_ = p.ws; asm volatile("" : "+s"(ws_));
    int tid_ = threadIdx.x; asm volatile("" : "+v"(tid_)); const int tid = tid_, lane = tid & 63, wv = __builtin_amdgcn_readfirstlane(tid >> 6), q4 = lane >> 4, c16 = lane & 15;
    int ldz_ = 0; asm volatile("" : "+s"(ldz_)); unsigned char* lds = g_smem + ldz_;
    constexpr int STG = 61440;
    const unsigned char* PFR = ws_ + OFF_PFR; const unsigned char* RFR = ws_ + OFF_RFR; const unsigned char* QFR = ws_ + OFF_QFR; const unsigned char* OFR = ws_ + OFF_OFR;
    float* O = (float*)(ws_ + OFF_O);
    for (int it = blockIdx.x; it < 32; it += gridDim.x) {
        const int bh = it >> 2, pair = it & 3, b = bh >> 2, h = bh & 3;
        __syncthreads();
        if (wv >= 2) {
            const int lt = tid - 128;
            const unsigned char* Pb = PFR + (size_t)bh * 128 * 32768;
            const unsigned char* Rb = RFR + (size_t)bh * 128 * 16384;
            const unsigned char* Qb = QFR + (size_t)bh * 128 * 32768 + pair * 8192;
            const unsigned char* Ob = OFR + (size_t)bh * 128 * 16384 + pair * 4096;
            uint4 ra0, ra1, ra2, ra3, ra4, ra5, ra6, ra7, ra8, ra9, ra10, ra11, rb0, rb1, rb2, rb3, rb4, rb5, rb6, rb7, rb8, rb9, rb10, rb11;
            uint4 rc0, rc1, rc2, rc3, rc4, rc5, rc6, rc7, rc8, rc9, rc10, rc11;
#define LDC(base_, c_, mx_) (*(const uint4*)((base_) + (size_t)(((c_) < (mx_)) ? (c_) : (mx_)) * 16))
#define GS_LOAD(X, n_) do { const unsigned char* pp_ = Pb + (size_t)(n_) * 32768; const unsigned char* rr_ = Rb + (size_t)(n_) * 16384; \
                const unsigned char* qq_ = Qb + (size_t)(n_) * 32768; const unsigned char* oo_ = Ob + (size_t)(n_) * 16384; \
                X##0 = LDC(pp_, lt, 2047); X##1 = LDC(pp_, lt + 384, 2047); X##2 = LDC(pp_, lt + 768, 2047); X##3 = LDC(pp_, lt + 1152, 2047); X##4 = LDC(pp_, lt + 1536, 2047); X##5 = LDC(pp_, lt + 1920, 2047); \
                X##6 = LDC(rr_, lt, 1023); X##7 = LDC(rr_, lt + 384, 1023); X##8 = LDC(rr_, lt + 768, 1023); \
                X##9 = LDC(qq_, lt, 511); X##10 = LDC(qq_, lt + 384, 511); X##11 = LDC(oo_, lt, 255); } while (0)
#define STC(off_, c_, lim_, v_) do { if ((c_) < (lim_)) *(uint4*)(sb_ + (off_) + (c_) * 16) = v_; } while (0)
#define GS_STORE(X, st_) do { unsigned char* sb_ = lds + (st_) * STG; \
                STC(0, lt, 2048, X##0); STC(0, lt + 384, 2048, X##1); STC(0, lt + 768, 2048, X##2); STC(0, lt + 1152, 2048, X##3); STC(0, lt + 1536, 2048, X##4); STC(0, lt + 1920, 2048, X##5); \
                STC(32768, lt, 1024, X##6); STC(32768, lt + 384, 1024, X##7); STC(32768, lt + 768, 1024, X##8); \
                STC(49152, lt, 512, X##9); STC(49152, lt + 384, 512, X##10); STC(57344, lt, 256, X##11); } while (0)
            GS_LOAD(ra, 0); GS_STORE(ra, 0);
            GS_LOAD(rb, 1); GS_LOAD(rc, 2); GS_LOAD(ra, 3);
            __syncthreads();
#define CLAMPN(x_) (((x_) < 128) ? (x_) : 127)
            for (int n = 0; n < 128; n += 3) {
                if (n + 1 < 128) GS_STORE(rb, (n + 1) & 1);
                GS_LOAD(rb, CLAMPN(n + 4)); __syncthreads();
                if (n + 1 < 128) { if (n + 2 < 128) GS_STORE(rc, (n + 2) & 1);
                    GS_LOAD(rc, CLAMPN(n + 5)); __syncthreads(); }
                if (n + 2 < 128) { if (n + 3 < 128) GS_STORE(ra, (n + 3) & 1);
                    GS_LOAD(ra, CLAMPN(n + 6)); __syncthreads(); }
            }
        } else {
            const int tdv = pair * 2 + wv;
            f32x4 S[8];
#pragma unroll
            for (int t = 0; t < 8; ++t) S[t] = (f32x4){0.f, 0.f, 0.f, 0.f};
            __syncthreads();
            for (int n = 0; n < 128; ++n) {
                const unsigned char* base = lds + (n & 1) * STG;
                const unsigned char* Pf = base + lane * 16, *Rf = base + 32768 + lane * 16;
                const unsigned char* Qf = base + 49152 + wv * 4096 + lane * 8, *Of = base + 57344 + wv * 2048 + lane * 8;
                SCAN_BODY
                __syncthreads();
            }
        }
    }
}

__device__ __forceinline__ void block_sum4(int (&v)[4], int* buf) {
    const int lane = threadIdx.x & 63, wv = threadIdx.x >> 6;
#pragma unroll
    for (int q = 0; q < 4; ++q) v[q] = wave_sum_i(v[q]);
    if (lane == 0) {
#pragma unroll
        for (int q = 0; q < 4; ++q) buf[wv * 4 + q] = v[q];
    }
    __syncthreads();
#pragma unroll
    for (int q = 0; q < 4; ++q) { int a = 0; for (int w = 0; w < 8; ++w) a += buf[w * 4 + q]; v[q] = a; }
}

PHASE_FN void ph_dsa_topk(const Params& p, int layer, float* smem) {
    unsigned char* ws_ = p.ws; asm volatile("" : "+s"(ws_));
    int tid_ = threadIdx.x; asm volatile("" : "+v"(tid_)); const int tid = tid_, lane = tid & 63, wv = __builtin_amdgcn_readfirstlane(tid >> 6), q4 = lane >> 4, c16 = lane & 15;
    int* sRed = (int*)g_smem;
    const bf16_t* QIb = (const bf16_t*)(ws_ + OFF_QIB); const bf16_t* KIb = (const bf16_t*)(ws_ + OFF_KIB); const float* WI = (const float*)(ws_ + OFF_WI);
    unsigned short* M16 = (unsigned short*)(ws_ + OFF_M16);
    int* qhead = (int*)(ws_ + OFF_QCTR) + layer * 16;
    int* sIt = (int*)(g_smem + 512);
    for (;;) {
        __syncthreads();
        if (tid == 0) *sIt = atomicAdd(qhead, 1);
        __syncthreads();
        const int it = *sIt;
        if (it >= 2048) break;
        const int b = it & 1, gp = 1023 - (it >> 1);
        const int s0 = gp * 8, t0 = b * 8192 + s0;
        const int ntiles = (s0 >> 4) + 1;
        const int nreg = (ntiles > wv) ? ((ntiles - wv + 7) >> 3) : 0;
        const bf16_t* qp = QIb + (size_t)(t0 + (c16 >> 2)) * 256 + (c16 & 3) * 64 + 8 * q4;
        const bf16x8 a0A = *(const bf16x8*)qp, a1A = *(const bf16x8*)(qp + 32), a0B = *(const bf16x8*)(qp + 4 * 256), a1B = *(const bf16x8*)(qp + 4 * 256 + 32);
        const float4 wqA = *(const float4*)(WI + (size_t)(t0 + q4) * 4), wqB = *(const float4*)(WI + (size_t)(t0 + 4 + q4) * 4);
        const int myqA = s0 + q4, myqB = s0 + 4 + q4;
        int c16s = c16; asm volatile("" : "+v"(c16s));
        int wvs = wv; asm volatile("" : "+s"(wvs));
        unsigned kA[64], kB[64];
#pragma unroll
        for (int i = 0; i < 64; ++i) { kA[i] = 0u; kB[i] = 0u; }
#pragma unroll
        for (int blk = 0; blk < 4; ++blk) if (nreg > blk * 16) {
#pragma unroll
            for (int ii = 0; ii < 16; ++ii) { const int i = blk * 16 + ii, tile = wvs + 8 * i;
                if (tile < ntiles) {
                    const bf16_t* kp = KIb + (size_t)(b * 8192 + tile * 16 + c16s) * 64 + 8 * q4;
                    const bf16x8 k0 = *(const bf16x8*)kp, k1 = *(const bf16x8*)(kp + 32);
                    f32x4 accA = (f32x4){0.f, 0.f, 0.f, 0.f}, accB = accA;
                    accA = __builtin_amdgcn_mfma_f32_16x16x32_bf16(a0A, k0, accA, 0, 0, 0);
                    accB = __builtin_amdgcn_mfma_f32_16x16x32_bf16(a0B, k0, accB, 0, 0, 0);
                    accA = __builtin_amdgcn_mfma_f32_16x16x32_bf16(a1A, k1, accA, 0, 0, 0);
                    accB = __builtin_amdgcn_mfma_f32_16x16x32_bf16(a1B, k1, accB, 0, 0, 0);
                    float sa = 0.f, sb = 0.f;
                    sa += wqA.x * fmaxf(accA[0], 0.f); sa += wqA.y * fmaxf(accA[1], 0.f); sa += wqA.z * fmaxf(accA[2], 0.f); sa += wqA.w * fmaxf(accA[3], 0.f);
                    sb += wqB.x * fmaxf(accB[0], 0.f); sb += wqB.y * fmaxf(accB[1], 0.f); sb += wqB.z * fmaxf(accB[2], 0.f); sb += wqB.w * fmaxf(accB[3], 0.f);
                    const int kidx = tile * 16 + c16s;
                    kA[i] = (kidx <= myqA) ? ordkey(sa) : 0u;
                    kB[i] = (kidx <= myqB) ? ordkey(sb) : 0u;
                }
                if ((ii & 3) == 3) asm volatile("" ::: "memory"); }
        }
        const int keffA = (myqA + 1 < 256) ? (myqA + 1) : 256, keffB = (myqB + 1 < 256) ? (myqB + 1) : 256;
        int par = 0;
        int mydone = 0, alldone = 0;
        int* sDone = sRed + 64;
        auto qsum = [&](int c) -> int {
            c += __shfl_xor(c, 1); c += __shfl_xor(c, 2); c += __shfl_xor(c, 4); c += __shfl_xor(c, 8);
            par ^= 1;
            if (c16 == 0) { sRed[par * 32 + wv * 4 + q4] = c; if (wv == 0) sDone[par * 4 + q4] = (mydone == 3) ? 1 : 0; }
            __syncthreads();
            int a = 0;
#pragma unroll
            for (int w = 0; w < 8; ++w) a += sRed[par * 32 + w * 4 + q4];
            alldone = sDone[par * 4] & sDone[par * 4 + 1] & sDone[par * 4 + 2] & sDone[par * 4 + 3];
            return a;
        };
        unsigned UA = 0u, UB = 0u;
        for (int bit = 31; bit >= 0; --bit) {
            const unsigned candA = UA | (1u << bit), candB = UB | (1u << bit);
            int ca = 0, cb = 0;
            if (!alldone) {
#pragma unroll
            for (int blk = 0; blk < 4; ++blk) if (nreg > blk * 16) {
#pragma unroll
                for (int ii = 0; ii < 16; ++ii) { ca += (kA[blk * 16 + ii] >= candA) ? 1 : 0; cb += (kB[blk * 16 + ii] >= candB) ? 1 : 0; }
            } }
            const int tot = qsum(ca | (cb << 16));
            if ((tot & 0xffff) >= keffA) { UA = candA; mydone = (mydone & 2) | (((tot & 0xffff) == keffA) ? 1 : 0); }
            if ((tot >> 16) >= keffB) { UB = candB; mydone = (mydone & 1) | (((tot >> 16) == keffB) ? 2 : 0); }
        }
        int cg = 0, ce = 0;
#pragma unroll
        for (int i = 0; i < 64; ++i) { cg += (kA[i] > UA) ? 1 : 0; ce += (kA[i] == UA) ? 1 : 0; cg += (kB[i] > UB) ? 65536 : 0; ce += (kB[i] == UB) ? 65536 : 0; }
        cg = qsum(cg); ce = qsum(ce);
        const int needA = keffA - (cg & 0xffff), needB = keffB - (cg >> 16);
        int JA = 8191, JB = 8191;
        par ^= 1;
        if (c16 == 0) sRed[par * 32 + wv * 4 + q4] = (((ce & 0xffff) > needA) || ((ce >> 16) > needB)) ? 1 : 0;
        __syncthreads();
        int anyov = 0;
#pragma unroll
        for (int w = 0; w < 32; ++w) anyov |= sRed[par * 32 + w];
        if (anyov) {
            JA = 0; JB = 0;
            int c16j = c16; asm volatile("" : "+v"(c16j));
            int wvj = wv; asm volatile("" : "+s"(wvj));
            for (int bit = 12; bit >= 0; --bit) {
                const int cjA = JA | (1 << bit), cjB = JB | (1 << bit);
                int c = 0;
#pragma unroll
                for (int i = 0; i < 64; ++i) { const int kidx = (wvj + 8 * i) * 16 + c16j; c += (kA[i] == UA && kidx < cjA) ? 1 : 0; c += (kB[i] == UB && kidx < cjB) ? 65536 : 0; }
                const int tot = qsum(c);
                if ((tot & 0xffff) <= needA - 1) JA = cjA;
                if ((tot >> 16) <= needB - 1) JB = cjB;
            }
        }
        unsigned short* sM = (unsigned short*)(g_smem + 1024);
        ((uint4*)sM)[tid] = make_uint4(0u, 0u, 0u, 0u);
        __syncthreads();
        int c16e = c16; asm volatile("" : "+v"(c16e));
        int wve = wv; asm volatile("" : "+s"(wve));
#pragma unroll
        for (int blk = 0; blk < 4; ++blk) if (nreg > blk * 16) {
#pragma unroll
            for (int ii = 0; ii < 16; ++ii) { const int i = blk * 16 + ii;
                const int tile = wve + 8 * i, kidx = tile * 16 + c16e;
                const bool selA = kA[i] > UA || (kA[i] == UA && kidx <= JA);
                const bool selB = kB[i] > UB || (kB[i] == UB && kidx <= JB);
                const unsigned long long balA = __ballot(selA), balB = __ballot(selB);
                if (c16 == 0) { sM[q4 * 512 + tile] = (unsigned short)((balA >> (16 * q4)) & 0xffffull);
                                sM[(4 + q4) * 512 + tile] = (unsigned short)((balB >> (16 * q4)) & 0xffffull); }
            }
        }
        __syncthreads();
        *(uint4*)(M16 + (size_t)(t0 + (tid >> 6)) * 512 + (tid & 63) * 8) = ((const uint4*)sM)[tid];
    }
}

PHASE_FN void ph_dsa_attn(const Params& p, float* smem) {
    unsigned char* ws_ = p.ws; asm volatile("" : "+s"(ws_));
    int tid_ = threadIdx.x; asm volatile("" : "+v"(tid_)); const int tid = tid_, lane = tid & 63, wv = tid >> 6, q4 = lane >> 4, c16 = lane & 15;
    int ldz_ = 0; asm volatile("" : "+s"(ldz_)); unsigned char* lds = g_smem + ldz_;
    const bf16_t* QBb = (const bf16_t*)(ws_ + OFF_QBB); const bf16_t* KBb = (const bf16_t*)(ws_ + OFF_KBB); const bf16_t* VT = (const bf16_t*)(ws_ + OFF_VT);
    const unsigned short* M16 = (const unsigned short*)(ws_ + OFF_M16);
    bf16_t* OB = (bf16_t*)(ws_ + OFF_OB);
    const float SC = SCALE128 * 1.4426950408889634f;
    for (int it = blockIdx.x; it < 256; it += gridDim.x) {
        const int bh = it & 7, jp = it >> 3, b = bh >> 2, h = bh & 3;
        for (int half = 0; half < 2; ++half) {
            const int jq = half ? jp : 63 - jp;
            const int qs = jq * 128, nkt = 2 * jq + 2;
            const int tq = b * 8192 + qs + wv * 16 + c16;
            bf16x8 qf[4];
#pragma unroll
            for (int a = 0; a < 4; ++a) qf[a] = *(const bf16x8*)(QBb + (size_t)tq * 512 + h * 128 + 8 * q4 + 32 * a);
            float m = -1e30f, lsum = 0.f;
            f32x4 oacc[8];
#pragma unroll
            for (int t = 0; t < 8; ++t) oacc[t] = (f32x4){0.f, 0.f, 0.f, 0.f};
            uint4 rk0, rk1, rv0, rv1;
            const int q0 = tid, q1 = tid + 512;
            const bf16_t* kg0 = KBb + (size_t)(b * 8192 + (q0 >> 4)) * 512 + h * 128 + (q0 & 15) * 8;
            const bf16_t* kg1 = KBb + (size_t)(b * 8192 + (q1 >> 4)) * 512 + h * 128 + (q1 & 15) * 8;
            const bf16_t* vg0 = VT + ((size_t)((b * 4 + h) * 128 + (q0 >> 3))) * 8192 + (q0 & 7) * 8;
            const bf16_t* vg1 = VT + ((size_t)((b * 4 + h) * 128 + (q1 >> 3))) * 8192 + (q1 & 7) * 8;
            const int lk0 = (q0 >> 4) * 256 + ((((q0 & 15)) ^ ((q0 >> 4) & 15)) << 4), lk1 = (q1 >> 4) * 256 + ((((q1 & 15)) ^ ((q1 >> 4) & 15)) << 4);
            const int lv0 = 16384 + (q0 >> 3) * 128 + ((((q0 & 7)) ^ ((q0 >> 3) & 7)) << 4), lv1 = 16384 + (q1 >> 3) * 128 + ((((q1 & 7)) ^ ((q1 >> 3) & 7)) << 4);
#define ATT_GLOAD(kt_) do { rk0 = *(const uint4*)(kg0 + (size_t)(kt_) * 64 * 512); rk1 = *(const uint4*)(kg1 + (size_t)(kt_) * 64 * 512); \
                            rv0 = *(const uint4*)(vg0 + (kt_) * 64); rv1 = *(const uint4*)(vg1 + (kt_) * 64); } while (0)
#define ATT_LSTORE(st_) do { unsigned char* base_ = lds + (st_) * 32768; *(uint4*)(base_ + lk0) = rk0; *(uint4*)(base_ + lk1) = rk1; *(uint4*)(base_ + lv0) = rv0; *(uint4*)(base_ + lv1) = rv1; } while (0)
            __syncthreads();
            ATT_GLOAD(0); ATT_LSTORE(0);
            __syncthreads();
            for (int kt = 0; kt < nkt; ++kt) {
                if (kt + 1 < nkt) ATT_GLOAD(kt + 1);
                const unsigned long long mbits = *(const unsigned long long*)(M16 + (size_t)tq * 512 + 4 * kt);
                const unsigned char* Kt = lds + (kt & 1) * 32768;
                const unsigned char* Vt = Kt + 16384;
                f32x4 sacc[4];
#pragma unroll
                for (int ti = 0; ti < 4; ++ti) { sacc[ti] = (f32x4){0.f, 0.f, 0.f, 0.f};
                    const int row = 16 * ti + c16;
#pragma unroll
                    for (int a = 0; a < 4; ++a) { const bf16x8 kf = *(const bf16x8*)(Kt + row * 256 + ((((q4 + 4 * a)) ^ (row & 15)) << 4));
                        sacc[ti] = __builtin_amdgcn_mfma_f32_16x16x32_bf16(kf, qf[a], sacc[ti], 0, 0, 0); } }
                float mx = m;
#pragma unroll
                for (int ti = 0; ti < 4; ++ti)
#pragma unroll
                    for (int r = 0; r < 4; ++r) { const bool valid = (mbits >> (16 * ti + 4 * q4 + r)) & 1ull; const float v = sacc[ti][r] * SC; sacc[ti][r] = v; mx = fmaxf(mx, valid ? v : -1e30f); }
                mx = fmaxf(mx, __shfl_xor(mx, 16)); mx = fmaxf(mx, __shfl_xor(mx, 32));
                const float alpha = __builtin_amdgcn_exp2f(m - mx); m = mx;
                float ps = 0.f;
#pragma unroll
                for (int ti = 0; ti < 4; ++ti)
#pragma unroll
                    for (int r = 0; r < 4; ++r) { const bool valid = (mbits >> (16 * ti + 4 * q4 + r)) & 1ull; const float pv = valid ? __builtin_amdgcn_exp2f(sacc[ti][r] - mx) : 0.f; sacc[ti][r] = pv; ps += pv; }
                lsum = lsum * alpha + ps;
#pragma unroll
                for (int t = 0; t < 8; ++t) oacc[t] = oacc[t] * alpha;
                bf16x8 pb[2];
#pragma unroll
                for (int a = 0; a < 2; ++a) {
                    union { uint4 u; bf16x8 v; } cv;
                    cv.u.x = cvt_pk_bf16(sacc[2 * a][0], sacc[2 * a][1]); cv.u.y = cvt_pk_bf16(sacc[2 * a][2], sacc[2 * a][3]);
                    cv.u.z = cvt_pk_bf16(sacc[2 * a + 1][0], sacc[2 * a + 1][1]); cv.u.w = cvt_pk_bf16(sacc[2 * a + 1][2], sacc[2 * a + 1][3]);
                    pb[a] = cv.v; }
#pragma unroll
                for (int t = 0; t < 8; ++t) { const int row = 16 * t + c16;
#pragma unroll
                    for (int a = 0; a < 2; ++a) {
                        union { uint2 h2[2]; bf16x8 v; } vf;
                        vf.h2[0] = *(const uint2*)(Vt + row * 128 + ((((4 * a + (q4 >> 1))) ^ (row & 7)) << 4) + 8 * (q4 & 1));
                        vf.h2[1] = *(const uint2*)(Vt + row * 128 + ((((4 * a + 2 + (q4 >> 1))) ^ (row & 7)) << 4) + 8 * (q4 & 1));
                        oacc[t] = __builtin_amdgcn_mfma_f32_16x16x32_bf16(vf.v, pb[a], oacc[t], 0, 0, 0); } }
                if (kt + 1 < nkt) ATT_LSTORE((kt + 1) & 1);
                __syncthreads();
            }
            lsum += __shfl_xor(lsum, 16); lsum += __shfl_xor(lsum, 32);
            const float inv = 1.f / lsum;
#pragma unroll
            for (int t = 0; t < 8; ++t) *(uint2*)(OB + (size_t)tq * 1024 + 512 + h * 128 + 16 * t + 4 * q4) = pack4(oacc[t] * inv);
        }
    }
}

PHASE_FN void ph_gdn_out(const Params& p, int layer) {
    unsigned char* ws_ = p.ws; asm volatile("" : "+s"(ws_));
    int tid_ = threadIdx.x; asm volatile("" : "+v"(tid_)); const int tid = tid_, lane = tid & 63, wv = tid >> 6;
    const float* O = (const float*)(ws_ + OFF_O); const bf16_t* P = (const bf16_t*)(ws_ + OFF_P); bf16_t* OB = (bf16_t*)(ws_ + OFF_OB);
    const float* onw = p.gdn_out_norm + (layer >> 1) * 128;
    for (int t = blockIdx.x * 8 + wv; t < NT; t += gridDim.x * 8) {
#pragma unroll
        for (int h = 0; h < 4; ++h) {
            const float* op = O + (size_t)t * 1024 + h * 128; bf16_t* ob = OB + (size_t)t * 1024 + h * 128;
            const float o0 = op[lane], o1 = op[64 + lane];
            const float ss = wave_sum(o0 * o0 + o1 * o1);
            const float r = rsqrtf(ss * (1.f / 128.f) + EPS);
            const float z0 = PBF(P, t, 1536 + h * 128 + lane), z1 = PBF(P, t, 1536 + h * 128 + 64 + lane);
            ob[lane] = f2bf(o0 * r * onw[lane] * siluf_(z0)); ob[64 + lane] = f2bf(o1 * r * onw[64 + lane] * siluf_(z1));
        }
    }
}

PHASE_FN void ph_gemm_out(const Params& p, int layer, float* smem) {
    unsigned char* ws_ = p.ws; asm volatile("" : "+s"(ws_));
    { int ldz_ = 0; asm volatile("" : "+s"(ldz_)); smem = (float*)(g_smem + ldz_); }
    const bf16_t* Wt = (const bf16_t*)(ws_ + OFF_WOUT) + (size_t)layer * 1024 * 1024;
    const float* MOD = (const float*)(ws_ + OFF_MOD);
    const bf16_t* O = (const bf16_t*)(ws_ + OFF_OB);
    const int vb_ = (((int)gridDim.x & 7) == 0) ? (((int)blockIdx.x & 7) * ((int)gridDim.x >> 3) + ((int)blockIdx.x >> 3)) : (int)blockIdx.x;
    for (int tile = vb_; tile < 64 * 8; tile += gridDim.x) {
        const int mt = (tile >> 6) * 8 + (tile & 7), nt = (tile >> 3) & 7;
        const bf16_t* Ab = O + (size_t)mt * 256 * 1024;
        const bf16_t* Bb = Wt + (size_t)nt * 128 * 1024;
        const int b = (mt * 256) >> 13;
        const float* gt = MOD + (size_t)(layer * 2 + b) * 6144 + 2048 + nt * 128;
        float* Xt = p.X + (size_t)mt * 256 * ND + nt * 128;
        const float* Xr = ((layer == 0) ? p.x : (const float*)p.X) + (size_t)mt * 256 * ND + nt * 128;
        gemm_tile_bf16(1024, (unsigned char*)smem,
            [=](int i, int r, int k) -> uint4 { return *(const uint4*)(Ab + (size_t)r * 1024 + k); },
            [=](int i, int r, int k) -> uint4 { return *(const uint4*)(Bb + (size_t)r * 1024 + k); },
            [=](const f32x4 (&acc)[4][4], int wm, int wn, int lane) {
#pragma unroll
                for (int mi = 0; mi < 4; ++mi)
#pragma unroll
                    for (int ni = 0; ni < 4; ++ni) {
                        const int m = wm * 64 + mi * 16 + (lane & 15), n = wn * 64 + ni * 16 + 4 * (lane >> 4);
                        const f32x4 g = *(const f32x4*)(gt + n);
                        *(f32x4*)(Xt + (size_t)m * ND + n) = *(const f32x4*)(Xr + (size_t)m * ND + n) + g * acc[mi][ni];
                    }
            });
    }
}

PHASE_FN void ph_norm_ffn(const Params& p, int layer) {
    unsigned char* ws_ = p.ws; asm volatile("" : "+s"(ws_));
    int tid_ = threadIdx.x; asm volatile("" : "+v"(tid_)); const int tid = tid_, lane = tid & 63, wv = tid >> 6;
    const float* MOD = (const float*)(ws_ + OFF_MOD);
    bf16_t* H = (bf16_t*)(ws_ + OFF_H);
    int* CNT = (int*)(ws_ + OFF_CNT) + layer * 32 * CSTR;
    int* sCnt = (int*)g_smem; int* sBase = sCnt + 32; int* sE = sBase + 32; int* sR = sE + 256;
    const int nrb = (NT + (int)gridDim.x - 1) / (int)gridDim.x, row_lo = blockIdx.x * nrb, row_hi = (row_lo + nrb < NT) ? row_lo + nrb : NT;
    __syncthreads();
    if (tid < 32) sCnt[tid] = 0;
    __syncthreads();
    int* ASG = (int*)(ws_ + OFF_ASG); float* GATE = (float*)(ws_ + OFF_GATE); int* LIST = (int*)(ws_ + OFF_LIST);
    const float* nw = p.norm_ffn + layer * 1024;
    const float* wg = p.rg_w + (size_t)layer * 1024 * 4;
    for (int row = row_lo + wv; row < row_hi; row += 8) {
        const int b = row >> 13;
        const float* xr = p.X + (size_t)row * ND;
        const float* sh = MOD + (size_t)(layer * 2 + b) * 6144 + 3072;
        const float* sc = sh + 1024;
        float hv[16]; float ss = 0.f;
#pragma unroll
        for (int j = 0; j < 4; ++j) { const float4 v = *(const float4*)(xr + j * 256 + lane * 4); hv[4 * j] = v.x; hv[4 * j + 1] = v.y; hv[4 * j + 2] = v.z; hv[4 * j + 3] = v.w; }
#pragma unroll
        for (int j = 0; j < 16; ++j) ss += hv[j] * hv[j];
        ss = wave_sum(ss);
        const float rstd = rsqrtf(ss * (1.f / 1024.f) + EPS);
#pragma unroll
        for (int j = 0; j < 4; ++j) {
            const int col = j * 256 + lane * 4;
            const float4 w = *(const float4*)(nw + col), s4 = *(const float4*)(sc + col), h4 = *(const float4*)(sh + col);
            hv[4 * j] = hv[4 * j] * rstd * w.x * (1.f + s4.x) + h4.x; hv[4 * j + 1] = hv[4 * j + 1] * rstd * w.y * (1.f + s4.y) + h4.y;
            hv[4 * j + 2] = hv[4 * j + 2] * rstd * w.z * (1.f + s4.z) + h4.z; hv[4 * j + 3] = hv[4 * j + 3] * rstd * w.w * (1.f + s4.w) + h4.w;
            { f32x4 ov; ov[0] = hv[4 * j]; ov[1] = hv[4 * j + 1]; ov[2] = hv[4 * j + 2]; ov[3] = hv[4 * j + 3]; *(uint2*)(H + (size_t)row * ND + col) = pack4(ov); }
        }
        float gl[4] = {0.f, 0.f, 0.f, 0.f};
#pragma unroll
        for (int j = 0; j < 4; ++j)
#pragma unroll
            for (int e = 0; e < 4; ++e) { const int col = j * 256 + lane * 4 + e; const float4 w = *(const float4*)(wg + (size_t)col * 4); const float hh = hv[4 * j + e];
                gl[0] += hh * w.x; gl[1] += hh * w.y; gl[2] += hh * w.z; gl[3] += hh * w.w; }
#pragma unroll
        for (int g = 0; g < 4; ++g) gl[g] = wave_sum(gl[g]) + p.rg_b[layer * 4 + g];
        int gs = 0; float gm = gl[0];
#pragma unroll
        for (int g = 1; g < 4; ++g) if (gl[g] > gm) { gm = gl[g]; gs = g; }
        float gsum = 0.f;
#pragma unroll
        for (int g = 0; g < 4; ++g) gsum += expf(gl[g] - gm);
        const float ggate = 1.f / gsum;
        const float* we = p.re_w + ((size_t)(layer * 4 + gs) * 1024) * 8;
        float el[8] = {0.f, 0.f, 0.f, 0.f, 0.f, 0.f, 0.f, 0.f};
#pragma unroll
        for (int j = 0; j < 4; ++j)
#pragma unroll
            for (int e = 0; e < 4; ++e) { const int col = j * 256 + lane * 4 + e; const float4 w0 = *(const float4*)(we + (size_t)col * 8), w1 = *(const float4*)(we + (size_t)col * 8 + 4); const float hh = hv[4 * j + e];
                el[0] += hh * w0.x; el[1] += hh * w0.y; el[2] += hh * w0.z; el[3] += hh * w0.w; el[4] += hh * w1.x; el[5] += hh * w1.y; el[6] += hh * w1.z; el[7] += hh * w1.w; }
#pragma unroll
        for (int e = 0; e < 8; ++e) el[e] = wave_sum(el[e]) + p.re_b[(layer * 4 + gs) * 8 + e];
        int i1 = 0; float l1 = el[0];
#pragma unroll
        for (int e = 1; e < 8; ++e) if (el[e] > l1) { l1 = el[e]; i1 = e; }
        int i2 = -1; float l2 = -INFINITY;
#pragma unroll
        for (int e = 0; e < 8; ++e) if (e != i1 && el[e] > l2) { l2 = el[e]; i2 = e; }
        const float ex = expf(l2 - l1);
        const float p1 = 1.f / (1.f + ex), p2 = ex / (1.f + ex);
        if (lane == 0) {
            const int e1 = gs * 8 + i1, e2 = gs * 8 + i2, lr = row - row_lo;
            sE[lr * 2] = e1; sE[lr * 2 + 1] = e2;
            sR[lr * 2] = atomicAdd(&sCnt[e1], 1); sR[lr * 2 + 1] = atomicAdd(&sCnt[e2], 1);
            GATE[row * 2] = ggate * p1; GATE[row * 2 + 1] = ggate * p2;
        }
    }
    __syncthreads();
    if (tid < 32) sBase[tid] = (sCnt[tid] > 0) ? atomicAdd(&CNT[tid * CSTR], sCnt[tid]) : 0;
    __syncthreads();
    for (int a = tid; a < (row_hi - row_lo) * 2; a += NTHREADS) {
        const int row = row_lo + (a >> 1), e = sE[a], r = sBase[e] + sR[a];
        LIST[(size_t)e * LISTCAP + r] = row;
        ASG[row * 4 + (a & 1) * 2] = e; ASG[row * 4 + (a & 1) * 2 + 1] = r;
    }
}

PHASE_FN void ph_moe(const Params& p, int layer, int which, float* smem) {
    unsigned char* ws_ = p.ws; asm volatile("" : "+s"(ws_));
    { int ldz_ = 0; asm volatile("" : "+s"(ldz_)); smem = (float*)(g_smem + ldz_); }
    int tid_ = threadIdx.x; asm volatile("" : "+v"(tid_)); const int tid = tid_;
    int* sPad = (int*)((unsigned char*)smem + 98304); int* sTs = sPad + 33;
    const int* CNT = (const int*)(ws_ + OFF_CNT) + layer * 32 * CSTR;
    __syncthreads();
    if (tid == 0) { int a = 0, ts = 0; for (int e = 0; e < 32; ++e) { sPad[e] = a; sTs[e] = ts; a += ((CNT[e * CSTR] + 127) / 128) * 128; ts += (CNT[e * CSTR] + 255) / 256; } sTs[32] = ts; sPad[32] = a; }
    __syncthreads();
    const int total = sTs[32] * 8;
    bf16_t* HID = (bf16_t*)(ws_ + OFF_HID); bf16_t* YB = (bf16_t*)(ws_ + OFF_YB);
    const bf16_t* H = (const bf16_t*)(ws_ + OFF_H);
    const int* LIST = (const int*)(ws_ + OFF_LIST);
    const int vb_ = (((int)gridDim.x & 7) == 0) ? (((int)blockIdx.x & 7) * ((int)gridDim.x >> 3) + ((int)blockIdx.x >> 3)) : (int)blockIdx.x;
    for (int tile = vb_; tile < total; tile += gridDim.x) {
        const int mt = tile >> 3, nt = tile & 7;
        int e = 0;
        for (int q = 1; q < 32; ++q) if (sTs[q] <= mt) e = q;
        const int mi0 = mt - sTs[e];
        const int cnt = CNT[e * CSTR];
        const int mvalid = (cnt - mi0 * 256 < 256) ? (cnt - mi0 * 256) : 256;
        const int rowbase = sPad[e] + mi0 * 256;
        if (which == 0) {
            long ro[4];
#pragma unroll
            for (int i = 0; i < 4; ++i) { const int r = (tid + 512 * i) >> 3; ro[i] = (r < mvalid) ? (long)LIST[(size_t)e * LISTCAP + mi0 * 256 + r] * 1024 : -1; }
            const long ro0 = ro[0], ro1 = ro[1], ro2 = ro[2], ro3 = ro[3];
            const bf16_t* Bb = (const bf16_t*)(ws_ + OFF_W13) + (size_t)e * 1024 * 1024 + (size_t)nt * 128 * 1024;
            bf16_t* Ht = HID + (size_t)rowbase * 512 + nt * 64;
            gemm_tile_bf16(1024, (unsigned char*)smem,
                [=](int i, int r, int k) -> uint4 { const long o = (i == 0) ? ro0 : (i == 1) ? ro1 : (i == 2) ? ro2 : ro3; if (o < 0) return make_uint4(0u, 0u, 0u, 0u);
                    return *(const uint4*)(H + o + k); },
                [=](int i, int r, int k) -> uint4 { return *(const uint4*)(Bb + (size_t)r * 1024 + k); },
                [=](const f32x4 (&acc)[4][4], int wm, int wn, int lane) {
#pragma unroll
                    for (int mi = 0; mi < 4; ++mi)
#pragma unroll
                        for (int ni = 0; ni < 2; ++ni) {
                            const int m = wm * 64 + mi * 16 + (lane & 15), n = wn * 32 + ni * 16 + 4 * (lane >> 4);
                            const f32x4 a1 = acc[mi][ni], a3 = acc[mi][ni + 2];
                            f32x4 hv; hv[0] = siluf_(a1[0]) * a3[0]; hv[1] = siluf_(a1[1]) * a3[1]; hv[2] = siluf_(a1[2]) * a3[2]; hv[3] = siluf_(a1[3]) * a3[3];
                            if (m < mvalid) *(uint2*)(Ht + (size_t)m * 512 + n) = pack4(hv);
                        }
                }, mvalid);
        } else {
            const bf16_t* Ab = HID + (size_t)rowbase * 512;
            const bf16_t* Bb = (const bf16_t*)(ws_ + OFF_W2T) + (size_t)e * 1024 * 512 + (size_t)nt * 128 * 512;
            bf16_t* Yt = YB + (size_t)rowbase * 1024 + nt * 128;
            gemm_tile_bf16(512, (unsigned char*)smem,
                [=](int i, int r, int k) -> uint4 { if (r >= mvalid) return make_uint4(0u, 0u, 0u, 0u); return *(const uint4*)(Ab + (size_t)r * 512 + k); },
                [=](int i, int r, int k) -> uint4 { return *(const uint4*)(Bb + (size_t)r * 512 + k); },
                [=](const f32x4 (&acc)[4][4], int wm, int wn, int lane) {
#pragma unroll
                    for (int mi = 0; mi < 4; ++mi)
#pragma unroll
                        for (int ni = 0; ni < 4; ++ni) {
                            const int m = wm * 64 + mi * 16 + (lane & 15), n = wn * 64 + ni * 16 + 4 * (lane >> 4);
                            if (m < mvalid) *(uint2*)(Yt + (size_t)m * 1024 + n) = pack4(acc[mi][ni]);
                        }
                }, mvalid);
        }
    }
}

PHASE_FN void ph_conv_dense(const Params& p, float* smem) {
    unsigned char* ws_ = p.ws; asm volatile("" : "+s"(ws_));
    { int ldz_ = 0; asm volatile("" : "+s"(ldz_)); smem = (float*)(g_smem + ldz_); }
    auto dec = [&](int t, const float*& s0, const float*& s1, bf16_t*& dst, int& mode, int& K, int& N, int& ld, int& rt, int& kt) {
        s1 = nullptr; mode = 0; K = 1024;
        if (t >= 4608) t = 4607;
        if (t < 1984) { const int l = t / 992, u = t % 992; s0 = p.even_w_in + (size_t)l * 1024 * 3916; N = 3916; ld = 3916; dst = (bf16_t*)(ws_ + OFF_WINE) + (size_t)l * 3968 * 1024; rt = u >> 4; kt = u & 15; }
        else if (t < 3584) { const int v = t - 1984, l = v / 800, u = v % 800; s0 = p.gla_w_in + (size_t)l * 1024 * 3088; N = 3088; ld = 3088; dst = (bf16_t*)(ws_ + OFF_WINO) + (size_t)l * 3200 * 1024; rt = u >> 4; kt = u & 15; }
        else { const int v = t - 3584, l = v >> 8, u = v & 255; s0 = ((l & 1) ? p.gla_w_out : p.even_w_out) + (size_t)(l >> 1) * 1024 * 1024; N = 1024; ld = 1024; dst = (bf16_t*)(ws_ + OFF_WOUT) + (size_t)l * 1024 * 1024; rt = u >> 4; kt = u & 15; }
    };
    for (int t = blockIdx.x * 4; t < 4608; t += gridDim.x * 4) convert_tiles4(dec, t, (4608 - t < 4) ? (4608 - t) : 4, smem);
}

PHASE_FN void ph_conv_exp(const Params& p, int layer, float* smem, int first_blk) {
    unsigned char* ws_ = p.ws; asm volatile("" : "+s"(ws_));
    { int ldz_ = 0; asm volatile("" : "+s"(ldz_)); smem = (float*)(g_smem + ldz_); }
    if ((int)blockIdx.x < first_blk) return;
    auto dec = [&](int t, const float*& s0, const float*& s1, bf16_t*& dst, int& mode, int& K, int& N, int& ld, int& rt, int& kt) {
        if (t >= 12288) t = 12287;
        if (t < 8192) { const int e = t >> 8, u = t & 255; s0 = p.w1 + (size_t)(layer * 32 + e) * 1024 * 512; s1 = p.w3 + (size_t)(layer * 32 + e) * 1024 * 512; mode = 1; K = 1024; N = 512; ld = 512;
            dst = (bf16_t*)(ws_ + OFF_W13) + (size_t)e * 1024 * 1024; rt = u >> 4; kt = u & 15; }
        else { const int v = t - 8192, e = v >> 7, u = v & 127; s0 = p.w2 + (size_t)(layer * 32 + e) * 512 * 1024; s1 = nullptr; mode = 0; K = 512; N = 1024; ld = 1024;
            dst = (bf16_t*)(ws_ + OFF_W2T) + (size_t)e * 1024 * 512; rt = u >> 3; kt = u & 7; }
    };
    const int nb = (int)gridDim.x - first_blk;
    for (int t = ((int)blockIdx.x - first_blk) * 4; t < 12288; t += nb * 4) convert_tiles4(dec, t, (12288 - t < 4) ? (12288 - t) : 4, smem);
}

PHASE_FN void ph_gla_tok(const Params& p, int layer) {
    unsigned char* ws_ = p.ws; asm volatile("" : "+s"(ws_));
    int tid_ = threadIdx.x; asm volatile("" : "+v"(tid_)); const int tid = tid_, lane = tid & 63, wv = tid >> 6, li = layer >> 1;
    const float* AUX = (const float*)(ws_ + OFF_AUX);
    float* LA = (float*)(ws_ + OFF_LA);
    const float* w2 = p.gla_w_gate2 + (size_t)li * 16 * 512; const float* b2 = p.gla_b_gate2 + li * 512;
    for (int t = blockIdx.x * 8 + wv; t < NT; t += gridDim.x * 8) {
        float glr[16];
#pragma unroll
        for (int r = 0; r < 16; ++r) glr[r] = AUX[(size_t)t * 16 + r];
#pragma unroll 1
        for (int i = 0; i < 8; ++i) {
            const int c = lane + 64 * i; float z = b2[c];
#pragma unroll
            for (int r = 0; r < 16; ++r) z += glr[r] * w2[r * 512 + c];
            LA[(size_t)t * 512 + c] = -softplusf_(-z) * (1.f / 16.f);
        }
    }
}

PHASE_FN void ph_gla_chunk(const Params& p, int layer, float* smem) {
    unsigned char* ws_ = p.ws; asm volatile("" : "+s"(ws_));
    int tid_ = threadIdx.x; asm volatile("" : "+v"(tid_)); const int tid = tid_, lane = tid & 63, wv = __builtin_amdgcn_readfirstlane(tid >> 6), q4 = lane >> 4, c16 = lane & 15;
    int ldz_ = 0; asm volatile("" : "+s"(ldz_)); unsigned char* lds = g_smem + ldz_;
    constexpr int SN = 272, ST = 144;
    float* sBc = (float*)lds;
    unsigned char* bQE = lds + 33024;
    unsigned char* bKE = lds + 50432;
    unsigned char* bKD = lds + 67840;
    unsigned char* bVT = lds + 86272;
    unsigned char* bATT = lds + 123136;
    const bf16_t* P = (const bf16_t*)(ws_ + OFF_P); const float* AUX = (const float*)(ws_ + OFF_AUX);
    const float* w2 = p.gla_w_gate2 + (size_t)(layer >> 1) * 16 * 512; const float* b2 = p.gla_b_gate2 + (layer >> 1) * 512;
    float* sGlr = (float*)(lds + 132352);
    uint4* QEF = (uint4*)(ws_ + OFF_GQE); uint2* OIF = (uint2*)(ws_ + OFF_GOI); uint2* HF = (uint2*)(ws_ + OFF_GH); float* EBL = (float*)(ws_ + OFF_GEBL);
    for (int ci = blockIdx.x; ci < 1024; ci += gridDim.x) {
        const int b = ci >> 9, h = (ci >> 7) & 3, n = ci & 127;
        const int t0 = b * 8192 + n * 64;
        __syncthreads();
        for (int e = tid; e < 1024; e += NTHREADS) sGlr[e] = AUX[(size_t)(t0 + (e >> 4)) * 16 + (e & 15)];
        __syncthreads();
        {
            const int d = tid & 127, c = h * 128 + d;
            float wg[16];
#pragma unroll
            for (int r = 0; r < 16; ++r) wg[r] = w2[r * 512 + c];
            const float bz = b2[c];
            for (int i = tid >> 7; i < 64; i += 4) {
                float z = bz;
#pragma unroll
                for (int r = 0; r < 16; ++r) z += sGlr[i * 16 + r] * wg[r];
                sBc[i * 129 + d] = -softplusf_(-z) * (1.f / 16.f);
            }
        }
        for (int e = tid; e < 64 * 36; e += NTHREADS) ((unsigned*)bATT)[e] = 0u;
        __syncthreads();
        if (tid < 128) { float a = 0.f; for (int i = 0; i < 64; ++i) { a += sBc[i * 129 + tid]; sBc[i * 129 + tid] = a; } }
        __syncthreads();
        for (int e = tid; e < 8192; e += NTHREADS) {
            const int i = e >> 7, d = e & 127;
            const float bb = sBc[i * 129 + d], bl = sBc[63 * 129 + d];
            const float qf = PBF(P, t0 + i, h * 128 + d), kf = PBF(P, t0 + i, 512 + h * 128 + d);
            *(bf16_t*)(bQE + i * SN + d * 2) = f2bf(qf * SCALE128 * expf(bb));
            *(bf16_t*)(bKE + i * SN + d * 2) = f2bf(kf * expf(-bb));
            *(bf16_t*)(bKD + d * ST + i * 2) = f2bf(kf * expf(bl - bb));
        }
        for (int e = tid; e < 16384; e += NTHREADS) { const int i = e >> 8, dv = e & 255; *(bf16_t*)(bVT + dv * ST + i * 2) = P[(size_t)(t0 + i) * LDPB + 1024 + h * 256 + dv]; }
        if (tid < 128) EBL[ci * 128 + tid] = expf(sBc[63 * 129 + tid]);
        __syncthreads();
        for (int u = wv; u < 10; u += 8) {
            const int ti = (u >= 6) ? 3 : (u >= 3) ? 2 : (u >= 1) ? 1 : 0, tj = u - ((ti * (ti + 1)) >> 1);
            f32x4 acc = (f32x4){0.f, 0.f, 0.f, 0.f};
            acc = mma_lds(bQE, SN, 16 * ti, bKE, SN, 16 * tj, 128, acc, c16, q4);
            const int j = 16 * tj + c16;
#pragma unroll
            for (int r = 0; r < 4; ++r) { const int i = 16 * ti + 4 * q4 + r; *(bf16_t*)(bATT + i * ST + j * 2) = f2bf((j <= i) ? acc[r] : 0.f); }
        }
        for (int x = 0; x < 2; ++x) {
            const int u = wv * 2 + x, ti = u >> 2, a = u & 3;
            const unsigned char* rp = bQE + (16 * ti + c16) * SN;
            const uint2 lo = *(const uint2*)(rp + (32 * a + 4 * q4) * 2), hi = *(const uint2*)(rp + (32 * a + 16 + 4 * q4) * 2);
            QEF[((size_t)(ci * 4 + ti) * 4 + a) * 64 + lane] = make_uint4(lo.x, lo.y, hi.x, hi.y);
        }
        __syncthreads();
        for (int x = 0; x < 8; ++x) {
            const int u = wv * 8 + x, tdv = u >> 2, ti = u & 3;
            f32x4 acc = (f32x4){0.f, 0.f, 0.f, 0.f};
            acc = mma_lds(bATT, ST, 16 * ti, bVT, ST, 16 * tdv, 64, acc, c16, q4);
            OIF[((size_t)(ci * 16 + tdv) * 4 + ti) * 64 + lane] = pack4(acc);
        }
        for (int x = 0; x < 16; ++x) {
            const int u = wv * 16 + x, tdv = u >> 3, tdk = u & 7;
            f32x4 acc = (f32x4){0.f, 0.f, 0.f, 0.f};
            acc = mma_lds(bKD, ST, 16 * tdk, bVT, ST, 16 * tdv, 64, acc, c16, q4);
            HF[((size_t)(ci * 16 + tdv) * 8 + tdk) * 64 + lane] = pack4(acc);
        }
    }
}

PHASE_FN void ph_gla_scan(const Params& p, float* smem) {
    unsigned char* ws_ = p.ws; asm volatile("" : "+s"(ws_));
    int tid_ = threadIdx.x; asm volatile("" : "+v"(tid_)); const int tid = tid_, lane = tid & 63, wv = __builtin_amdgcn_readfirstlane(tid >> 6), q4 = lane >> 4, c16 = lane & 15;
    int ldz_ = 0; asm volatile("" : "+s"(ldz_)); unsigned char* lds = g_smem + ldz_;
    constexpr int STG = 29184;
    const unsigned char* QEF = ws_ + OFF_GQE; const unsigned char* HF = ws_ + OFF_GH; const unsigned char* OIF = ws_ + OFF_GOI; const unsigned char* EBL = ws_ + OFF_GEBL;
    float* O = (float*)(ws_ + OFF_O);
    for (int it = blockIdx.x; it < 64; it += gridDim.x) {
        const int bh = it >> 3, pair = it & 7, b = bh >> 2, h = bh & 3;
        __syncthreads();
        if (wv >= 2) {
            const int lt = tid - 128;
            const unsigned char* Qb = QEF + (size_t)bh * 128 * 16384;
            const unsigned char* Hb = HF + (size_t)bh * 128 * 65536 + pair * 8192;
            const unsigned char* Ob = OIF + (size_t)bh * 128 * 32768 + pair * 4096;
            const unsigned char* Lb = EBL + (size_t)bh * 128 * 512;
            uint4 ra0, ra1, ra2, ra3, ra4, ra5, ra6, rb0, rb1, rb2, rb3, rb4, rb5, rb6, rc0, rc1, rc2, rc3, rc4, rc5, rc6, rd0, rd1, rd2, rd3, rd4, rd5, rd6;
#define GL_LOAD(X, n_) do { const unsigned char* q_ = Qb + (size_t)(n_) * 16384; const unsigned char* h_ = Hb + (size_t)(n_) * 65536; \
                const unsigned char* o_ = Ob + (size_t)(n_) * 32768; const unsigned char* l_ = Lb + (size_t)(n_) * 512; \
                X##0 = LDC(q_, lt, 1023); X##1 = LDC(q_, lt + 384, 1023); X##2 = LDC(q_, lt + 768, 1023); \
                X##3 = LDC(h_, lt, 511); X##4 = LDC(h_, lt + 384, 511); X##5 = LDC(o_, lt, 255); X##6 = LDC(l_, lt, 31); } while (0)
#define GL_STORE(X, st_) do { unsigned char* sb_ = lds + (st_) * STG; \
                STC(0, lt, 1024, X##0); STC(0, lt + 384, 1024, X##1); STC(0, lt + 768, 1024, X##2); \
                STC(16384, lt, 512, X##3); STC(16384, lt + 384, 512, X##4); STC(24576, lt, 256, X##5); STC(28672, lt, 32, X##6); } while (0)
            GL_LOAD(ra, 0); GL_STORE(ra, 0);
            GL_LOAD(rb, 1); GL_LOAD(rc, 2); GL_LOAD(rd, 3); GL_LOAD(ra, 4);
            __syncthreads();
            for (int n = 0; n < 128; n += 4) {
                GL_STORE(rb, 1); GL_LOAD(rb, CLAMPN(n + 5)); __syncthreads();
                GL_STORE(rc, 0); GL_LOAD(rc, CLAMPN(n + 6)); __syncthreads();
                GL_STORE(rd, 1); GL_LOAD(rd, CLAMPN(n + 7)); __syncthreads();
                if (n + 4 < 128) GL_STORE(ra, 0);
                GL_LOAD(ra, CLAMPN(n + 8)); __syncthreads();
            }
        } else {
            const int tdv = pair * 2 + wv;
            f32x4 S[8];
#pragma unroll
            for (int t = 0; t < 8; ++t) S[t] = (f32x4){0.f, 0.f, 0.f, 0.f};
            __syncthreads();
            for (int n = 0; n < 128; ++n) {
                const unsigned char* base = lds + (n & 1) * STG;
                const unsigned char* Qf = base + lane * 16, *Hf = base + 16384 + wv * 4096 + lane * 8, *Of = base + 24576 + wv * 2048 + lane * 8, *Lf = base + 28672 + q4 * 16;
                bf16x8 Sb[4];
#pragma unroll
                for (int a = 0; a < 4; ++a) { union { uint4 u; bf16x8 v; } cv; const uint2 lo = pack4(S[2 * a]), hi = pack4(S[2 * a + 1]); cv.u.x = lo.x; cv.u.y = lo.y; cv.u.z = hi.x; cv.u.w = hi.y; Sb[a] = cv.v; }
                const int t0 = b * 8192 + n * 64;
                f32x4 oa[4];
#pragma unroll
                for (int ti = 0; ti < 4; ++ti) oa[ti] = unpack4(*(const uint2*)(Of + ti * 512));
#pragma unroll
                for (int a = 0; a < 4; ++a)
#pragma unroll
                    for (int ti = 0; ti < 4; ++ti) oa[ti] = __builtin_amdgcn_mfma_f32_16x16x32_bf16(*(const bf16x8*)(Qf + (ti * 4 + a) * 1024), Sb[a], oa[ti], 0, 0, 0);
#pragma unroll
                for (int ti = 0; ti < 4; ++ti) {
                    float* op = O + (size_t)(t0 + 16 * ti + 4 * q4) * 1024 + h * 256 + 16 * tdv + c16;
                    op[0] = oa[ti][0]; op[1024] = oa[ti][1]; op[2048] = oa[ti][2]; op[3072] = oa[ti][3]; }
#pragma unroll
                for (int t = 0; t < 8; ++t) { const f32x4 lam = *(const f32x4*)(Lf + t * 64); S[t] = S[t] * lam + unpack4(*(const uint2*)(Hf + t * 512)); }
                __syncthreads();
            }
        }
    }
}

PHASE_FN void ph_gla_out(const Params& p, int layer) {
    unsigned char* ws_ = p.ws; asm volatile("" : "+s"(ws_));
    int tid_ = threadIdx.x; asm volatile("" : "+v"(tid_)); const int tid = tid_, lane = tid & 63, wv = tid >> 6;
    const float* O = (const float*)(ws_ + OFF_O); const bf16_t* P = (const bf16_t*)(ws_ + OFF_P); bf16_t* OB = (bf16_t*)(ws_ + OFF_OB);
    const float* onw = p.gla_out_norm + (layer >> 1) * 256;
    for (int t = blockIdx.x * 8 + wv; t < NT; t += gridDim.x * 8) {
#pragma unroll
        for (int h = 0; h < 4; ++h) {
            const float* op = O + (size_t)t * 1024 + h * 256;
            const float4 o = *(const float4*)(op + lane * 4);
            const float ss = wave_sum(o.x * o.x + o.y * o.y + o.z * o.z + o.w * o.w);
            const float r = rsqrtf(ss * (1.f / 256.f) + EPS);
            const f32x4 z = unpack4(*(const uint2*)(P + (size_t)t * LDPB + 2048 + h * 256 + lane * 4));
            const float4 w = *(const float4*)(onw + lane * 4);
            f32x4 ov; ov[0] = o.x * r * w.x * siluf_(z[0]); ov[1] = o.y * r * w.y * siluf_(z[1]); ov[2] = o.z * r * w.z * siluf_(z[2]); ov[3] = o.w * r * w.w * siluf_(z[3]);
            *(uint2*)(OB + (size_t)t * 1024 + h * 256 + lane * 4) = pack4(ov);
        }
    }
}

template <int PH>
__device__ __forceinline__ void run_phase(const Params& p, int layer, float* smem) {
    if (PH == PH_PROLOGUE) { ph_prologue(p, smem); ph_conv_dense(p, smem); }
    else if (PH == PH_NORM_MIX) ph_rows(p, layer, 0, smem);
    else if (PH == PH_GEMM_IN_EVEN) ph_gemm_in(p, layer, true, smem);
    else if (PH == PH_EVEN_TOK) { ph_even_tok(p, layer, smem); ph_gdn_chunk(p, layer, smem); }
    else if (PH == PH_GDN_CHUNK) ph_gdn_chunk(p, layer, smem);
    else if (PH == PH_GDN_SCAN) { ph_gdn_scan(p, smem); ph_conv_exp(p, layer, smem, 32); ph_dsa_topk(p, layer, smem); }
    else if (PH == PH_DSA_TOPK) ph_dsa_topk(p, layer, smem);
    else if (PH == PH_DSA_ATTN) { ph_dsa_attn(p, smem); ph_gdn_out(p, layer); }
    else if (PH == PH_GDN_OUT) ph_gdn_out(p, layer);
    else if (PH == PH_GEMM_OUT) ph_gemm_out(p, layer, smem);
    else if (PH == PH_NORM_FFN) ph_norm_ffn(p, layer);
    else if (PH == PH_MOE1) ph_moe(p, layer, 0, smem);
    else if (PH == PH_MOE2) ph_moe(p, layer, 1, smem);
    else if (PH == PH_GEMM_IN_ODD) ph_gemm_in(p, layer, false, smem);
    else if (PH == PH_GLA_TOK) ph_gla_tok(p, layer);
    else if (PH == PH_GLA_CHUNK) ph_gla_chunk(p, layer, smem);
    else if (PH == PH_GLA_SCAN) { ph_gla_scan(p, smem); ph_conv_exp(p, layer, smem, 64); }
    else if (PH == PH_GLA_OUT) ph_gla_out(p, layer);
    else if (PH == PH_FINAL) ph_rows(p, 0, 1, smem);
}

#if MK_MULTI
template <int PH>
__global__ void __launch_bounds__(NTHREADS, 2) k_phase(Params p, int layer) {
    run_phase<PH>(p, layer, (float*)g_smem);
}
#else
__global__ void __launch_bounds__(NTHREADS, 2) k_mega(Params p) {
    float* smem = (float*)g_smem;
    volatile LAS unsigned* xbw = (volatile LAS unsigned*)(LAS unsigned char*)(g_smem + LDS_BYTES - 16);
    if (threadIdx.x == 0) { xbw[0] = 0u; xbw[1] = 0u; xbw[2] = 0u; xbw[3] = 0u; }
    __syncthreads();
    XcdBarrier bar = xcd_barrier_post((unsigned*)(p.ws + OFF_BAR), xbw);
#define BAR() xcd_barrier(bar)
    run_phase<PH_PROLOGUE>(p, 0, smem); BAR(); if (DUP_MASK & 4096) { run_phase<PH_PROLOGUE>(p, 0, smem); BAR(); }
    for (int lp = 0; lp < 2; ++lp) {
        const int le = 2 * lp, lo = 2 * lp + 1;
        run_phase<PH_NORM_MIX>(p, le, smem); BAR();
        run_phase<PH_GEMM_IN_EVEN>(p, le, smem); BAR(); if (DUP_MASK & 1) { run_phase<PH_GEMM_IN_EVEN>(p, le, smem); BAR(); }
        run_phase<PH_EVEN_TOK>(p, le, smem); BAR(); if (DUP_MASK & 2) { run_phase<PH_EVEN_TOK>(p, le, smem); BAR(); }
        run_phase<PH_GDN_SCAN>(p, le, smem); BAR(); if (DUP_MASK & 8) { run_phase<PH_GDN_SCAN>(p, le, smem); BAR(); }
        run_phase<PH_DSA_ATTN>(p, le, smem); BAR(); if (DUP_MASK & 32) { run_phase<PH_DSA_ATTN>(p, le, smem); BAR(); }
        run_phase<PH_GEMM_OUT>(p, le, smem); BAR();
        run_phase<PH_NORM_FFN>(p, le, smem); BAR();
        run_phase<PH_MOE1>(p, le, smem); BAR(); if (DUP_MASK & 64) { run_phase<PH_MOE1>(p, le, smem); BAR(); }
        run_phase<PH_MOE2>(p, le, smem); BAR(); if (DUP_MASK & 128) { run_phase<PH_MOE2>(p, le, smem); BAR(); }
        run_phase<PH_NORM_MIX>(p, lo, smem); BAR();
        run_phase<PH_GEMM_IN_ODD>(p, lo, smem); BAR(); if (DUP_MASK & 256) { run_phase<PH_GEMM_IN_ODD>(p, lo, smem); BAR(); }
        run_phase<PH_GLA_CHUNK>(p, lo, smem); BAR(); if (DUP_MASK & 1024) { run_phase<PH_GLA_CHUNK>(p, lo, smem); BAR(); }
        run_phase<PH_GLA_SCAN>(p, lo, smem); BAR(); if (DUP_MASK & 2048) { run_phase<PH_GLA_SCAN>(p, lo, smem); BAR(); }
        run_phase<PH_GLA_OUT>(p, lo, smem); BAR();
        run_phase<PH_GEMM_OUT>(p, lo, smem); BAR();
        run_phase<PH_NORM_FFN>(p, lo, smem); BAR();
        run_phase<PH_MOE1>(p, lo, smem); BAR(); if (DUP_MASK & 64) { run_phase<PH_MOE1>(p, lo, smem); BAR(); }
        run_phase<PH_MOE2>(p, lo, smem); BAR(); if (DUP_MASK & 128) { run_phase<PH_MOE2>(p, lo, smem); BAR(); }
    }
    for (int xb = 0; xb < EXTRA_BARS; ++xb) BAR();
    run_phase<PH_FINAL>(p, 0, smem);
}
#endif

}

#if MK_MULTI
template <int PH>
static void launch_phase(const Params& p, int layer, hipStream_t stream) {
    static bool attr_set = false;
    if (!attr_set) { hipFuncSetAttribute((const void*)k_phase<PH>, hipFuncAttributeMaxDynamicSharedMemorySize, (int)LDS_BYTES); attr_set = true; }
    hipLaunchKernelGGL((k_phase<PH>), dim3(256), dim3(NTHREADS), LDS_BYTES, stream, p, layer);
}
#endif

extern "C" void kernel_launch(void* const* d_in, const int* in_sizes, int n_in, void* d_out, int out_size, void* d_ws, size_t ws_size, hipStream_t stream) {
    (void)in_sizes; (void)n_in; (void)out_size;
    if (ws_size < WS_NEEDED) { fprintf(stderr, "workspace too small: %zu < %zu\n", ws_size, (size_t)WS_NEEDED); return; }
    Params p{};
    p.x = (const float*)d_in[0]; p.c = (const float*)d_in[1]; p.pos = (const int*)d_in[2]; p.ada_w = (const float*)d_in[3]; p.ada_b = (const float*)d_in[4];
    p.norm_mix = (const float*)d_in[5]; p.norm_ffn = (const float*)d_in[6]; p.even_w_in = (const float*)d_in[7]; p.conv_w = (const float*)d_in[8];
    p.a_log = (const float*)d_in[9]; p.dt_bias = (const float*)d_in[10]; p.gdn_out_norm = (const float*)d_in[11]; p.even_w_out = (const float*)d_in[12];
    p.gla_w_in = (const float*)d_in[13]; p.gla_w_gate2 = (const float*)d_in[14]; p.gla_b_gate2 = (const float*)d_in[15]; p.gla_out_norm = (const float*)d_in[16]; p.gla_w_out = (const float*)d_in[17];
    p.rg_w = (const float*)d_in[18]; p.rg_b = (const float*)d_in[19]; p.re_w = (const float*)d_in[20]; p.re_b = (const float*)d_in[21];
    p.w1 = (const float*)d_in[22]; p.w3 = (const float*)d_in[23]; p.w2 = (const float*)d_in[24]; p.final_norm = (const float*)d_in[25];
    p.X = (float*)d_out; p.ws = (unsigned char*)d_ws;
    p.rA = pow(10000.0, -2.0 / 128.0); p.rI = pow(10000.0, -2.0 / 64.0);
    hipMemsetAsync(d_ws, 0, ZERO_BYTES, stream);
#if MK_MULTI
    launch_phase<PH_PROLOGUE>(p, 0, stream);
    for (int lp = 0; lp < 2; ++lp) {
        const int le = 2 * lp, lo = 2 * lp + 1;
        launch_phase<PH_NORM_MIX>(p, le, stream);
        launch_phase<PH_GEMM_IN_EVEN>(p, le, stream);
        launch_phase<PH_EVEN_TOK>(p, le, stream);
        launch_phase<PH_GDN_SCAN>(p, le, stream);
        launch_phase<PH_DSA_ATTN>(p, le, stream);
        launch_phase<PH_GEMM_OUT>(p, le, stream);
        launch_phase<PH_NORM_FFN>(p, le, stream);
        launch_phase<PH_MOE1>(p, le, stream);
        launch_phase<PH_MOE2>(p, le, stream);
        launch_phase<PH_NORM_MIX>(p, lo, stream);
        launch_phase<PH_GEMM_IN_ODD>(p, lo, stream);
        launch_phase<PH_GLA_CHUNK>(p, lo, stream);
        launch_phase<PH_GLA_SCAN>(p, lo, stream);
        launch_phase<PH_GLA_OUT>(p, lo, stream);
        launch_phase<PH_GEMM_OUT>(p, lo, stream);
        launch_phase<PH_NORM_FFN>(p, lo, stream);
        launch_phase<PH_MOE1>(p, lo, stream);
        launch_phase<PH_MOE2>(p, lo, stream);
    }
    launch_phase<PH_FINAL>(p, 0, stream);
#else
    static int grid = 0;
    if (!grid) {
        int dev = 0, cus = 0, per_cu = 0;
        hipGetDevice(&dev);
        hipDeviceGetAttribute(&cus, hipDeviceAttributeMultiprocessorCount, dev);
        hipFuncSetAttribute((const void*)k_mega, hipFuncAttributeMaxDynamicSharedMemorySize, (int)LDS_BYTES);
        hipOccupancyMaxActiveBlocksPerMultiprocessor(&per_cu, k_mega, NTHREADS, LDS_BYTES);
        if (cus <= 0) cus = 256;
        grid = cus * (per_cu < 1 ? 1 : 1);
    }
    hipLaunchKernelGGL(k_mega, dim3(grid), dim3(NTHREADS), LDS_BYTES, stream, p);
#endif
}
```

```cpp
#include <hip/hip_runtime.h>
#include <stdint.h>
#include <math.h>
#include <stdio.h>

#define EXTRA_BARS 0
#ifndef DUP_MASK
#define DUP_MASK 0
#endif
#ifndef MK_MULTI
#define MK_MULTI 0
#endif

namespace {

constexpr int NT = 16384, ND = 1024, LDP = 3920, LDPB = 3968;
constexpr float EPS = 1e-6f;
constexpr int NTHREADS = 512;
constexpr size_t LDS_BYTES = 147456;
constexpr float SCALE128 = 0.08838834764831845f;
constexpr int LISTCAP = 32768;
constexpr int CSTR = 16;

constexpr size_t OFF_BAR  = 0;
constexpr size_t OFF_CNT  = 16384;
constexpr size_t ZERO_BYTES = 32768;
constexpr size_t OFF_QCTR = 28672;
constexpr size_t OFF_MOD  = 32768;
constexpr size_t OFF_COSA = OFF_MOD + 4 * 2 * 6144 * 4;
constexpr size_t OFF_SINA = OFF_COSA + (size_t)NT * 64 * 4;
constexpr size_t OFF_COSI = OFF_SINA + (size_t)NT * 64 * 4;
constexpr size_t OFF_SINI = OFF_COSI + (size_t)NT * 32 * 4;
constexpr size_t OFF_H    = OFF_SINI + (size_t)NT * 32 * 4;
constexpr size_t OFF_P    = OFF_H + (size_t)NT * 1024 * 4;
constexpr size_t OFF_HID  = OFF_P;
constexpr size_t OFF_YB   = OFF_HID + (size_t)36864 * 512 * 4;
constexpr size_t OFF_O    = OFF_P + (size_t)NT * LDP * 4;
constexpr size_t OFF_ASG  = OFF_O + (size_t)NT * 1024 * 4;
constexpr size_t OFF_GATE = OFF_ASG + (size_t)NT * 4 * 4;
constexpr size_t OFF_LIST = OFF_GATE + (size_t)NT * 2 * 4;
constexpr size_t OFF_R    = OFF_LIST + (size_t)32 * LISTCAP * 4;
constexpr size_t OFF_QN   = OFF_R;
constexpr size_t OFF_KN   = OFF_QN + (size_t)NT * 512 * 4;
constexpr size_t OFF_VC   = OFF_KN + (size_t)NT * 512 * 4;
constexpr size_t OFF_BETA = OFF_VC + (size_t)NT * 512 * 4;
constexpr size_t OFF_G    = OFF_BETA + (size_t)NT * 4 * 4;
constexpr size_t OFF_W    = OFF_G + (size_t)NT * 4 * 4;
constexpr size_t OFF_U    = OFF_W + (size_t)1024 * 8192 * 4;
constexpr size_t OFF_QG   = OFF_U + (size_t)1024 * 8192 * 4;
constexpr size_t OFF_KD   = OFF_QG + (size_t)1024 * 8192 * 4;
constexpr size_t OFF_AQK  = OFF_KD + (size_t)1024 * 8192 * 4;
constexpr size_t OFF_GL   = OFF_AQK + (size_t)1024 * 4096 * 4;
constexpr size_t OFF_QB   = OFF_GL + 4096;
constexpr size_t OFF_KB   = OFF_QB + (size_t)NT * 512 * 4;
constexpr size_t OFF_QI   = OFF_KB + (size_t)NT * 512 * 4;
constexpr size_t OFF_KI   = OFF_QI + (size_t)NT * 256 * 4;
constexpr size_t OFF_WI   = OFF_KI + (size_t)NT * 64 * 4;
constexpr size_t OFF_SEL  = OFF_WI + (size_t)NT * 4 * 4;
constexpr size_t OFF_EVEN_END = OFF_SEL + (size_t)NT * 256 * 4;
constexpr size_t OFF_PFR  = OFF_W;
constexpr size_t OFF_RFR  = OFF_PFR + (size_t)1024 * 32768;
constexpr size_t OFF_QFR  = OFF_RFR + (size_t)1024 * 16384;
constexpr size_t OFF_OFR  = OFF_QFR + (size_t)1024 * 32768;
static_assert(OFF_OFR + (size_t)1024 * 16384 <= OFF_GL, "gdn v2 buffers overflow");
constexpr size_t OFF_QBB  = OFF_QB;
constexpr size_t OFF_KBB  = OFF_QBB + (size_t)NT * 512 * 2;
constexpr size_t OFF_VT   = OFF_KBB + (size_t)NT * 512 * 2;
constexpr size_t OFF_QIB  = OFF_VT + (size_t)NT * 512 * 2;
constexpr size_t OFF_KIB  = OFF_QIB + (size_t)NT * 256 * 2;
constexpr size_t OFF_M16  = OFF_KIB + (size_t)NT * 64 * 2;
static_assert(OFF_M16 + (size_t)NT * 512 * 2 <= OFF_WI, "dsa v2 buffers overflow");
constexpr size_t OFF_LA   = OFF_R;
constexpr size_t OFF_ATT  = OFF_LA + (size_t)NT * 512 * 4;
constexpr size_t OFF_QE   = OFF_ATT + (size_t)1024 * 4096 * 4;
constexpr size_t OFF_GKD  = OFF_QE + (size_t)1024 * 8192 * 4;
constexpr size_t OFF_EBL  = OFF_GKD + (size_t)1024 * 8192 * 4;
constexpr size_t OFF_GQE  = OFF_LA + (size_t)NT * 512 * 4;
constexpr size_t OFF_GOI  = OFF_GQE + (size_t)1024 * 16384;
constexpr size_t OFF_GH   = OFF_GOI + (size_t)1024 * 32768;
constexpr size_t OFF_GEBL = OFF_GH + (size_t)1024 * 65536;
static_assert(OFF_GEBL + (size_t)1024 * 512 <= OFF_EVEN_END, "gla v2 buffers overflow");
constexpr size_t OFF_WINE = OFF_EVEN_END;
constexpr size_t OFF_WINO = OFF_WINE + (size_t)2 * 4096 * 1024 * 2;
constexpr size_t OFF_WOUT = OFF_WINO + (size_t)2 * 3200 * 1024 * 2;
constexpr size_t OFF_W13  = OFF_WOUT + (size_t)4 * 1024 * 1024 * 2;
constexpr size_t OFF_W2T  = OFF_W13 + (size_t)32 * 1024 * 1024 * 2;
constexpr size_t OFF_OB   = OFF_W2T + (size_t)32 * 1024 * 512 * 2;
constexpr size_t OFF_AUX  = OFF_OB + (size_t)NT * 1024 * 2;
constexpr size_t OFF_WGL  = OFF_AUX + (size_t)NT * 16 * 4;
constexpr size_t WS_NEEDED = OFF_WGL + (size_t)2 * 128 * 1024 * 2;

struct Params {
    const float* x; const float* c; const int* pos; const float* ada_w; const float* ada_b;
    const float* norm_mix; const float* norm_ffn; const float* even_w_in; const float* conv_w;
    const float* a_log; const float* dt_bias; const float* gdn_out_norm; const float* even_w_out;
    const float* gla_w_in; const float* gla_w_gate2; const float* gla_b_gate2; const float* gla_out_norm; const float* gla_w_out;
    const float* rg_w; const float* rg_b; const float* re_w; const float* re_b;
    const float* w1; const float* w3; const float* w2; const float* final_norm;
    float* X;
    unsigned char* ws;
    double rA, rI;
};

#define XB_TMO      128
#define XB_XCNT(j)  (256  + 64 * (j))
#define XB_XSUB(j)  (1280 + 64 * (j))
#define XB_XGEN(j)  (2304 + 64 * (j))
#define XB_TOP      3328
#define XB_TOPGEN   3392
#define XCD_BAR_WORDS 3456
#define XB_SPIN_CAP (1u << 18)
#define LAS __attribute__((address_space(3)))

__device__ __forceinline__ unsigned xb_ld(unsigned* p)              { return __hip_atomic_load(p, __ATOMIC_RELAXED, __HIP_MEMORY_SCOPE_AGENT); }
__device__ __forceinline__ unsigned xb_add(unsigned* p, unsigned v) { return __hip_atomic_fetch_add(p, v, __ATOMIC_RELAXED, __HIP_MEMORY_SCOPE_AGENT); }
__device__ __forceinline__ unsigned xb_xcc_id() { return (unsigned)__builtin_amdgcn_s_getreg((3 << 11) | 20) & 0xFu; }
#define XB_SPIN(cond, bar) do { unsigned _sp = 0; while (cond) { __builtin_amdgcn_s_sleep(1); \
    if ((++_sp & 255u) == 0u) { if (xb_ld(&(bar)[XB_TMO])) break; if (_sp > XB_SPIN_CAP) { atomicAdd(&(bar)[XB_TMO], 1u); break; } } } } while (0)

struct XcdBarrier { unsigned* bar; unsigned x; volatile LAS unsigned* st; };

__device__ __forceinline__ XcdBarrier xcd_barrier_post(unsigned* bar, volatile LAS unsigned* st) {
    XcdBarrier b; b.bar = bar; b.x = xb_xcc_id(); b.st = st;
    if (threadIdx.x == 0) (void)xb_add(&bar[XB_XCNT(b.x)], 1u);
    return b;
}
__device__ __forceinline__ void xcd_barrier_complete(unsigned* bar, unsigned x, unsigned& nloc, unsigned& nx) {
    const unsigned G = gridDim.x * gridDim.y * gridDim.z;
    unsigned sum, cnt, mine, sp = 0u;
    for (;;) {
        sum = 0u; cnt = 0u; mine = 0u;
#pragma unroll
        for (unsigned j = 0; j < 16; ++j) { const unsigned c = xb_ld(&bar[XB_XCNT(j)]); sum += c; cnt += (c > 0u) ? 1u : 0u; mine = (j == x) ? c : mine; }
        if (sum == G) break;
        __builtin_amdgcn_s_sleep(1);
        if ((++sp & 255u) == 0u) { if (xb_ld(&bar[XB_TMO])) break; if (sp > XB_SPIN_CAP) { atomicAdd(&bar[XB_TMO], 1u); break; } }
    }
    nloc = mine > 0u ? mine : 1u; nx = cnt > 0u ? cnt : 1u;
}
__device__ __forceinline__ void xcd_barrier(const XcdBarrier& b) {
    asm volatile("s_waitcnt vmcnt(0)" ::: "memory");
    __syncthreads();
    if (threadIdx.x == 0) {
        unsigned* bar = b.bar;
        __builtin_amdgcn_s_waitcnt(0);
        unsigned nloc = b.st[0], nx = b.st[1];
        if (nloc == 0u) { xcd_barrier_complete(bar, b.x, nloc, nx); b.st[0] = nloc; b.st[1] = nx; }
        const unsigned old = xb_add(&bar[XB_XSUB(b.x)], 1u);
        const unsigned gen = old / nloc;
        if (old + 1u == (gen + 1u) * nloc) {
            __builtin_amdgcn_fence(__ATOMIC_RELEASE, "agent");
            asm volatile("s_waitcnt vmcnt(0)" ::: "memory");
            const unsigned og = xb_add(&bar[XB_TOP], 1u);
            const unsigned tg = og / nx;
            if (og + 1u == (tg + 1u) * nx) xb_add(&bar[XB_TOPGEN], 1u);
            else XB_SPIN(xb_ld(&bar[XB_TOPGEN]) == tg, bar);
            __builtin_amdgcn_fence(__ATOMIC_ACQUIRE, "agent");
            xb_add(&bar[XB_XGEN(b.x)], 1u);
            asm volatile("s_waitcnt vmcnt(0)" ::: "memory");
        } else {
            XB_SPIN(xb_ld(&bar[XB_XGEN(b.x)]) == gen, bar);
            __builtin_amdgcn_fence(__ATOMIC_ACQUIRE, "agent");
            asm volatile("s_waitcnt vmcnt(0)" ::: "memory");
        }
    }
    __syncthreads();
}

__device__ __forceinline__ float wave_sum(float v) {
#pragma unroll
    for (int o = 32; o > 0; o >>= 1) v += __shfl_xor(v, o);
    return v;
}
__device__ __forceinline__ int wave_sum_i(int v) {
#pragma unroll
    for (int o = 32; o > 0; o >>= 1) v += __shfl_xor(v, o);
    return v;
}
__device__ __forceinline__ float wave_max(float v) {
#pragma unroll
    for (int o = 32; o > 0; o >>= 1) v = fmaxf(v, __shfl_xor(v, o));
    return v;
}
__device__ __forceinline__ float sigmoidf_(float x) { return 1.f / (1.f + expf(-x)); }
__device__ __forceinline__ float siluf_(float x) { return x / (1.f + expf(-x)); }
__device__ __forceinline__ float softplusf_(float x) { return fmaxf(x, 0.f) + log1pf(expf(-fabsf(x))); }
__device__ __forceinline__ unsigned ordkey(float f) { const unsigned u = __float_as_uint(f); return (u & 0x80000000u) ? ~u : (u | 0x80000000u); }

__device__ __forceinline__ void sincos_d(double a, double& s, double& c) {
    const double kq = rint(a * 0.63661977236758134308);
    double r = fma(-kq, 1.57079632673412561417e+00, a);
    r = fma(-kq, 6.07710050650619224932e-11, r);
    const int q = (int)((long long)kq & 3);
    const double r2 = r * r;
    const double sp = r * (1.0 + r2 * (-1.0 / 6 + r2 * (1.0 / 120 + r2 * (-1.0 / 5040 + r2 * (1.0 / 362880 + r2 * (-1.0 / 39916800 + r2 * (1.0 / 6227020800.0)))))));
    const double cp = 1.0 + r2 * (-0.5 + r2 * (1.0 / 24 + r2 * (-1.0 / 720 + r2 * (1.0 / 40320 + r2 * (-1.0 / 3628800 + r2 * (1.0 / 479001600.0 + r2 * (-1.0 / 87178291200.0)))))));
    if (q == 0) { s = sp; c = cp; } else if (q == 1) { s = cp; c = -sp; } else if (q == 2) { s = -sp; c = -cp; } else { s = -cp; c = sp; }
}
__device__ __forceinline__ double ipow_d(double b, int e) { double v = 1.0; while (e) { if (e & 1) v *= b; b *= b; e >>= 1; } return v; }

struct GemmArgs { const float* A; int lda; const int* rows; int m0; int mvalid; const float* B; int ldb; int n0; int N; int K; };

template <class Epi>
__device__ __forceinline__ void gemm128(const GemmArgs& g, float* smem, Epi epi) {
    float* As = smem;
    float* Bs = smem + 16 * 132;
    int tid_ = threadIdx.x; asm volatile("" : "+v"(tid_)); const int tid = tid_, ty = tid >> 4, tx = tid & 15;
    const int arow = tid >> 2, kq = (tid & 3) * 4;
    const int bk = tid >> 5, bn = (tid & 31) * 4;
    long asrc = -1;
    if (arow < g.mvalid) { const int r = g.rows ? g.rows[arow] : (g.m0 + arow); if (r >= 0) asrc = (long)r * g.lda; }
    const bool bval = (g.n0 + bn) < g.N;
    float acc[4][8];
#pragma unroll
    for (int i = 0; i < 4; ++i)
#pragma unroll
        for (int j = 0; j < 8; ++j) acc[i][j] = 0.f;
    for (int k0 = 0; k0 < g.K; k0 += 16) {
        float4 av = make_float4(0.f, 0.f, 0.f, 0.f), bv = make_float4(0.f, 0.f, 0.f, 0.f);
        if (asrc >= 0) av = *(const float4*)(g.A + asrc + k0 + kq);
        if (bval) bv = *(const float4*)(g.B + (size_t)(k0 + bk) * g.ldb + g.n0 + bn);
        __syncthreads();
        As[(kq + 0) * 132 + arow] = av.x; As[(kq + 1) * 132 + arow] = av.y; As[(kq + 2) * 132 + arow] = av.z; As[(kq + 3) * 132 + arow] = av.w;
        *(float4*)&Bs[bk * 132 + bn] = bv;
        __syncthreads();
#pragma unroll
        for (int kk = 0; kk < 16; ++kk) {
            const float4 a = *(const float4*)&As[kk * 132 + ty * 4];
            const float4 b0 = *(const float4*)&Bs[kk * 132 + tx * 8];
            const float4 b1 = *(const float4*)&Bs[kk * 132 + tx * 8 + 4];
            const float aa[4] = {a.x, a.y, a.z, a.w};
            const float bb[8] = {b0.x, b0.y, b0.z, b0.w, b1.x, b1.y, b1.z, b1.w};
#pragma unroll
            for (int i = 0; i < 4; ++i)
#pragma unroll
                for (int j = 0; j < 8; ++j) acc[i][j] += aa[i] * bb[j];
        }
    }
#pragma unroll
    for (int i = 0; i < 4; ++i) {
        const int r = ty * 4 + i;
        if (r < g.mvalid) {
#pragma unroll
            for (int j = 0; j < 8; ++j) { const int n = g.n0 + tx * 8 + j; if (n < g.N) epi(r, n, acc[i][j]); }
        }
    }
}


typedef short bf16x8 __attribute__((ext_vector_type(8)));
typedef float f32x4 __attribute__((ext_vector_type(4)));
typedef unsigned short bf16_t;
typedef __bf16 bf16x2_t __attribute__((ext_vector_type(2)));
typedef float f32x2_t __attribute__((ext_vector_type(2)));
__device__ __forceinline__ unsigned cvt_pk_bf16(float lo, float hi) { const f32x2_t v = {lo, hi}; const bf16x2_t r = __builtin_convertvector(v, bf16x2_t); return __builtin_bit_cast(unsigned, r); }
__device__ __forceinline__ bf16_t f2bf(float f) { return (bf16_t)(cvt_pk_bf16(f, 0.f) & 0xffffu); }
__device__ __forceinline__ float bf16_to_f32(bf16_t v) { return __uint_as_float(((unsigned)v) << 16); }
__device__ __forceinline__ uint2 pack4(const f32x4 v) { uint2 r; r.x = cvt_pk_bf16(v[0], v[1]); r.y = cvt_pk_bf16(v[2], v[3]); return r; }
__device__ __forceinline__ f32x4 unpack4(const uint2 u) { f32x4 r; r[0] = __uint_as_float(u.x << 16); r[1] = __uint_as_float(u.x & 0xffff0000u); r[2] = __uint_as_float(u.y << 16); r[3] = __uint_as_float(u.y & 0xffff0000u); return r; }
#define PBF(Pb_, t_, c_) bf16_to_f32((Pb_)[(size_t)(t_) * LDPB + (c_)])
__device__ __forceinline__ uint4 pack8(const float4 a, const float4 b) { uint4 r; r.x = cvt_pk_bf16(a.x, a.y); r.y = cvt_pk_bf16(a.z, a.w); r.z = cvt_pk_bf16(b.x, b.y); r.w = cvt_pk_bf16(b.z, b.w); return r; }
__device__ __forceinline__ int lds_off(int r, int c) { return r * 128 + ((c ^ (r & 7)) << 4); }

template <class ALoad, class BLoad, class Epi>
__device__ __forceinline__ void gemm_tile_bf16(const int K, unsigned char* lds, ALoad aload, BLoad bload, Epi epi, const int mrows = 256) {
    int tid_ = threadIdx.x; asm volatile("" : "+v"(tid_)); const int tid = tid_, lane = tid & 63, wid = tid >> 6, wm = wid >> 1, wn = wid & 1;
    f32x4 acc[4][4];
#pragma unroll
    for (int mi = 0; mi < 4; ++mi)
#pragma unroll
        for (int ni = 0; ni < 4; ++ni) acc[mi][ni] = (f32x4){0.f, 0.f, 0.f, 0.f};
    uint4 ra[4], rb[2];
    const int nk = K >> 6;
#pragma unroll
    for (int i = 0; i < 4; ++i) { const int q = tid + 512 * i; ra[i] = aload(i, q >> 3, (q & 7) * 8); }
#pragma unroll
    for (int i = 0; i < 2; ++i) { const int q = tid + 512 * i; rb[i] = bload(i, q >> 3, (q & 7) * 8); }
    __syncthreads();
#pragma unroll
    for (int i = 0; i < 4; ++i) { const int q = tid + 512 * i; *(uint4*)(lds + lds_off(q >> 3, q & 7)) = ra[i]; }
#pragma unroll
    for (int i = 0; i < 2; ++i) { const int q = tid + 512 * i; *(uint4*)(lds + 32768 + lds_off(q >> 3, q & 7)) = rb[i]; }
    __syncthreads();
    for (int kt = 0; kt < nk; ++kt) {
        if (kt + 1 < nk) {
#pragma unroll
            for (int i = 0; i < 4; ++i) { const int q = tid + 512 * i; ra[i] = aload(i, q >> 3, (kt + 1) * 64 + (q & 7) * 8); }
#pragma unroll
            for (int i = 0; i < 2; ++i) { const int q = tid + 512 * i; rb[i] = bload(i, q >> 3, (kt + 1) * 64 + (q & 7) * 8); }
        }
        const unsigned char* At = lds + (kt & 1) * 49152;
        const unsigned char* Bt = At + 32768;
        if (__builtin_amdgcn_readfirstlane(wm) * 64 < mrows) {
#pragma unroll
        for (int ks = 0; ks < 2; ++ks) {
            bf16x8 af[4], bfr[4];
            const int c = ks * 4 + (lane >> 4);
#pragma unroll
            for (int mi = 0; mi < 4; ++mi) af[mi] = *(const bf16x8*)(At + lds_off(wm * 64 + mi * 16 + (lane & 15), c));
#pragma unroll
            for (int ni = 0; ni < 4; ++ni) bfr[ni] = *(const bf16x8*)(Bt + lds_off(wn * 64 + ni * 16 + (lane & 15), c));
            __builtin_amdgcn_s_setprio(1);
#pragma unroll
            for (int mi = 0; mi < 4; ++mi)
#pragma unroll
                for (int ni = 0; ni < 4; ++ni) acc[mi][ni] = __builtin_amdgcn_mfma_f32_16x16x32_bf16(bfr[ni], af[mi], acc[mi][ni], 0, 0, 0);
            __builtin_amdgcn_s_setprio(0);
        }
        }
        if (kt + 1 < nk) {
            unsigned char* An = lds + ((kt + 1) & 1) * 49152;
#pragma unroll
            for (int i = 0; i < 4; ++i) { const int q = tid + 512 * i; *(uint4*)(An + lds_off(q >> 3, q & 7)) = ra[i]; }
#pragma unroll
            for (int i = 0; i < 2; ++i) { const int q = tid + 512 * i; *(uint4*)(An + 32768 + lds_off(q >> 3, q & 7)) = rb[i]; }
        }
        __syncthreads();
    }
    epi(acc, wm, wn, lane);
}

__device__ __forceinline__ void convert_tile(const float* src0, const float* src1, int mode, int K, int N, int ld, bf16_t* dst, int rt, int kt, float* smem) {
    int tid_ = threadIdx.x; asm volatile("" : "+v"(tid_)); const int tid = tid_;
    __syncthreads();
    { const int k = tid >> 3, R0 = rt * 64 + (tid & 7) * 8;
      const float* sp; int col;
      if (mode == 0) { sp = src0; col = R0; } else { sp = (R0 & 32) ? src1 : src0; col = (R0 >> 6) * 32 + (R0 & 31); }
      float4 a = make_float4(0.f, 0.f, 0.f, 0.f), b = a;
      const float* rp = sp + (size_t)(kt * 64 + k) * ld + col;
      if (col < N) a = *(const float4*)rp;
      if (col + 4 < N) b = *(const float4*)(rp + 4);
      float* d = smem + k * 65 + (tid & 7) * 8;
      d[0] = a.x; d[1] = a.y; d[2] = a.z; d[3] = a.w; d[4] = b.x; d[5] = b.y; d[6] = b.z; d[7] = b.w; }
    __syncthreads();
    { const int R = tid >> 3, kc = (tid & 7) * 8;
      float v[8];
#pragma unroll
      for (int j = 0; j < 8; ++j) v[j] = smem[(kc + j) * 65 + R];
      uint4 o; o.x = cvt_pk_bf16(v[0], v[1]); o.y = cvt_pk_bf16(v[2], v[3]); o.z = cvt_pk_bf16(v[4], v[5]); o.w = cvt_pk_bf16(v[6], v[7]);
      *(uint4*)(dst + (size_t)(rt * 64 + R) * K + kt * 64 + kc) = o; }
}

#define CT_LOAD(S0, S1, MODE, NN, LD, RT, KT, A, B) do { const int k_ = tid >> 3, R0_ = (RT) * 64 + (tid & 7) * 8; const float* sp_; int col_; \
        if ((MODE) == 0) { sp_ = (S0); col_ = R0_; } else { sp_ = (R0_ & 16) ? (S1) : (S0); col_ = (R0_ >> 5) * 16 + (R0_ & 15); } \
        A = make_float4(0.f, 0.f, 0.f, 0.f); B = A; const float* rp_ = sp_ + (size_t)((KT) * 64 + k_) * (LD) + col_; \
        if (col_ < (NN)) A = *(const float4*)rp_; if (col_ + 4 < (NN)) B = *(const float4*)(rp_ + 4); } while (0)
#define CT_WRITE(BUF, A, B) do { float* d_ = smem + (BUF) * 4160 + (tid >> 3) * 65 + (tid & 7) * 8; \
        d_[0] = A.x; d_[1] = A.y; d_[2] = A.z; d_[3] = A.w; d_[4] = B.x; d_[5] = B.y; d_[6] = B.z; d_[7] = B.w; } while (0)
#define CT_STORE(DST, KK, RT, KT, BUF) do { const int R_ = tid >> 3, kc_ = (tid & 7) * 8; const float* sb_ = smem + (BUF) * 4160; \
        uint4 o_; o_.x = cvt_pk_bf16(sb_[(kc_ + 0) * 65 + R_], sb_[(kc_ + 1) * 65 + R_]); o_.y = cvt_pk_bf16(sb_[(kc_ + 2) * 65 + R_], sb_[(kc_ + 3) * 65 + R_]); \
        o_.z = cvt_pk_bf16(sb_[(kc_ + 4) * 65 + R_], sb_[(kc_ + 5) * 65 + R_]); o_.w = cvt_pk_bf16(sb_[(kc_ + 6) * 65 + R_], sb_[(kc_ + 7) * 65 + R_]); \
        *(uint4*)((DST) + (size_t)((RT) * 64 + R_) * (KK) + (KT) * 64 + kc_) = o_; } while (0)
#define CT_DECL(I) const float* s0_##I; const float* s1_##I; bf16_t* d_##I; int md_##I, K_##I, N_##I, ld_##I, rt_##I, kt_##I
#define CT_ARGS(I) s0_##I, s1_##I, d_##I, md_##I, K_##I, N_##I, ld_##I, rt_##I, kt_##I
template <class Dec>
__device__ __forceinline__ void convert_tiles4(const Dec& dec, int t, int nj, float* smem) {
    int tid_ = threadIdx.x; asm volatile("" : "+v"(tid_)); const int tid = tid_;
    CT_DECL(0); CT_DECL(1); CT_DECL(2); CT_DECL(3);
    dec(t, CT_ARGS(0)); dec(t + 1, CT_ARGS(1)); dec(t + 2, CT_ARGS(2)); dec(t + 3, CT_ARGS(3));
    float4 a0, b0, a1, b1, a2, b2, a3, b3;
    a1 = b1 = a2 = b2 = a3 = b3 = make_float4(0.f, 0.f, 0.f, 0.f);
    CT_LOAD(s0_0, s1_0, md_0, N_0, ld_0, rt_0, kt_0, a0, b0);
    if (nj > 1) CT_LOAD(s0_1, s1_1, md_1, N_1, ld_1, rt_1, kt_1, a1, b1);
    if (nj > 2) CT_LOAD(s0_2, s1_2, md_2, N_2, ld_2, rt_2, kt_2, a2, b2);
    if (nj > 3) CT_LOAD(s0_3, s1_3, md_3, N_3, ld_3, rt_3, kt_3, a3, b3);
    __syncthreads();
    CT_WRITE(0, a0, b0); CT_WRITE(1, a1, b1); CT_WRITE(2, a2, b2); CT_WRITE(3, a3, b3);
    __syncthreads();
    CT_STORE(d_0, K_0, rt_0, kt_0, 0);
    if (nj > 1) CT_STORE(d_1, K_1, rt_1, kt_1, 1);
    if (nj > 2) CT_STORE(d_2, K_2, rt_2, kt_2, 2);
    if (nj > 3) CT_STORE(d_3, K_3, rt_3, kt_3, 3);
}


namespace pg8 {
constexpr int BM = 256, BK = 64, HALF = 128, HTB = HALF * BK * 2, STAGE_BYTES = 8 * HTB;
__host__ __device__ __forceinline__ int lds_byte(int r, int c) { const int st = (r >> 4) * 2 + (c >> 5), rr = r & 15, cc = c & 31, ob = rr * 64 + cc * 2; return st * 1024 + (ob ^ (((ob >> 9) & 1) << 5)); }
__host__ __device__ __forceinline__ void stage_rc(int b, int& R, int& C) { const int st = b / 1024, sb = b % 1024, swz = sb ^ (((sb >> 9) & 1) << 5); R = (st >> 1) * 16 + swz / 64; C = (st & 1) * 32 + (swz % 64) / 2; }
__host__ __device__ __forceinline__ int perm32(int rho) { const int n = rho >> 4, i = rho & 15; return 8 * (i >> 2) + 4 * n + (i & 3); }

struct Unit { size_t aoff, boff; int pm, pn, e, mvalid, rowbase, mi; };
template <class Epi, class Sched, bool GATHER>
__device__ __forceinline__ void gemm_phase(LAS unsigned char* lds, const bf16_t* Abase, const bf16_t* Bbase, const int K, const Sched& S, const Epi& E) {
    int tid_ = threadIdx.x; asm volatile("" : "+v"(tid_));
    const int tid = tid_, wid = __builtin_amdgcn_readfirstlane(tid >> 6), lane = tid & 63, wr = wid >> 2, wc = wid & 3, fr = lane & 15, fq = lane >> 4;
    const int nt = K / BK;
    int sR[2], sC[2]; unsigned voffB[2];
#pragma unroll
    for (int i = 0; i < 2; ++i) { int R, C; stage_rc(tid * 16 + i * 8192, R, C); sR[i] = R; sC[i] = C; const int Rb = Epi::PERM ? ((R & ~31) + perm32(R & 31)) : R; voffB[i] = (unsigned)(Rb * K + C) * 2u; }
    const size_t kstep = (size_t)(BK * 2);
    const size_t hstep = (size_t)HALF * K * 2;
    const unsigned ldsw = (unsigned)wid * 1024u;
    const int aoff = lds_byte(wr * 64 + fr, fq * 8), boff = lds_byte(wc * 32 + fr, fq * 8);
#define PG8_SA(b, h) (((b) * 2 + (h)) * HTB)
#define PG8_SB(b, h) ((4 + (b) * 2 + (h)) * HTB)
#define PG8_STAGE(bufoff, gbase, voff) do { _Pragma("unroll") for (int _i = 0; _i < 2; ++_i) \
        __builtin_amdgcn_global_load_lds((const unsigned*)((const char*)(gbase) + (voff)[_i]), (LAS unsigned*)(lds + (bufoff) + ldsw + _i * 8192), 16, 0, 0); } while (0)
#define PG8_LDA(dst, b, h) do { _Pragma("unroll") for (int m = 0; m < 4; ++m) _Pragma("unroll") for (int k = 0; k < 2; ++k) dst[m][k] = *(const LAS bf16x8*)(lds + PG8_SA(b, h) + aoff + m * 2048 + k * 1024); } while (0)
#define PG8_LDB(dst, b, h) do { _Pragma("unroll") for (int n = 0; n < 2; ++n) _Pragma("unroll") for (int k = 0; k < 2; ++k) dst[n][k] = *(const LAS bf16x8*)(lds + PG8_SB(b, h) + boff + n * 2048 + k * 1024); } while (0)
#define PG8_MMA(ai, bj, At, Bt) do { __builtin_amdgcn_s_setprio(1); _Pragma("unroll") for (int m = 0; m < 4; ++m) _Pragma("unroll") for (int n = 0; n < 2; ++n) _Pragma("unroll") for (int k = 0; k < 2; ++k) \
        acc[ai][bj][m][n] = __builtin_amdgcn_mfma_f32_16x16x32_bf16(Bt[n][k], At[m][k], acc[ai][bj][m][n], 0, 0, 0); __builtin_amdgcn_s_setprio(0); } while (0)
#define PG8_WAIT_V(n) asm volatile("s_waitcnt vmcnt(" #n ")" ::: "memory")
#define PG8_WAIT_L(n) asm volatile("s_waitcnt lgkmcnt(" #n ")" ::: "memory")
#define PG8_BAR __builtin_amdgcn_s_barrier()
#define PG8_SCHED __builtin_amdgcn_sched_barrier(0)
#define PG8_AVOFF(U, V0, V1) do { _Pragma("unroll") for (int _i = 0; _i < 2; ++_i) { \
        if (GATHER) { V0[_i] = (unsigned)((size_t)S.row(U, sR[_i]) * K + sC[_i]) * 2u; V1[_i] = (unsigned)((size_t)S.row(U, 128 + sR[_i]) * K + sC[_i]) * 2u; } \
        else { V0[_i] = (unsigned)(sR[_i] * K + sC[_i]) * 2u; V1[_i] = V0[_i] + (unsigned)hstep; } } } while (0)
    Unit cur, nxt; int ui = 0;
    if (!S.next(0, cur)) return;
    f32x4 acc[2][2][4][2];
#pragma unroll
    for (int a = 0; a < 2; ++a)
#pragma unroll
        for (int b = 0; b < 2; ++b)
#pragma unroll
            for (int m = 0; m < 4; ++m)
#pragma unroll
                for (int n = 0; n < 2; ++n) acc[a][b][m][n] = (f32x4){0.f, 0.f, 0.f, 0.f};
    bf16x8 At[4][2], B0[2][2], B1[2][2];
    unsigned cv0[2], cv1[2], nv0[2], nv1[2];
    PG8_AVOFF(cur, cv0, cv1);
    const char* cA = (const char*)Abase + cur.aoff; const char* cB = (const char*)Bbase + cur.boff;
    PG8_STAGE(PG8_SB(0, 0), cB, voffB); PG8_STAGE(PG8_SA(0, 0), cA, cv0); PG8_STAGE(PG8_SB(0, 1), cB + hstep, voffB); PG8_STAGE(PG8_SA(0, 1), cA, cv1);
    if (wr == 1) PG8_BAR;
    PG8_WAIT_V(4); PG8_BAR;
    PG8_STAGE(PG8_SB(1, 0), cB + kstep, voffB); PG8_STAGE(PG8_SA(1, 0), cA + kstep, cv0); PG8_STAGE(PG8_SB(1, 1), cB + hstep + kstep, voffB);
    PG8_WAIT_V(6); PG8_BAR;
    for (;;) {
        const bool has_next = S.next(ui + 1, nxt);
        const char* nA = has_next ? (const char*)Abase + nxt.aoff : cA; const char* nB = has_next ? (const char*)Bbase + nxt.boff : cB;
        if (has_next) { PG8_AVOFF(nxt, nv0, nv1); } else { nv0[0] = cv0[0]; nv0[1] = cv0[1]; nv1[0] = cv1[0]; nv1[1] = cv1[1]; }
        for (int t = 0; t < nt; t += 2) {
            const bool last = (t == nt - 2);
            const char* a1 = cA + (size_t)(t + 1) * kstep;
            const char* a2 = last ? nA : cA + (size_t)(t + 2) * kstep; const char* b2 = last ? nB : cB + (size_t)(t + 2) * kstep;
            const char* a3 = a2 + kstep; const char* b3 = b2 + kstep;
            unsigned sv0[2], sv1[2];
            sv0[0] = last ? nv0[0] : cv0[0]; sv0[1] = last ? nv0[1] : cv0[1]; sv1[0] = last ? nv1[0] : cv1[0]; sv1[1] = last ? nv1[1] : cv1[1];
            PG8_LDB(B0, 0, 0); PG8_SCHED; PG8_LDA(At, 0, 0); PG8_STAGE(PG8_SA(1, 1), a1, cv1);
            PG8_WAIT_L(8); PG8_BAR; PG8_WAIT_L(0); PG8_MMA(0, 0, At, B0); PG8_BAR; PG8_SCHED;
            PG8_LDB(B1, 0, 1); PG8_STAGE(PG8_SB(0, 0), b2, voffB);
            PG8_BAR; PG8_WAIT_L(0); PG8_MMA(0, 1, At, B1); PG8_BAR;
            PG8_LDA(At, 0, 1); PG8_STAGE(PG8_SA(0, 0), a2, sv0);
            PG8_BAR; PG8_WAIT_L(0); PG8_MMA(1, 0, At, B0); PG8_BAR; PG8_SCHED;
            PG8_STAGE(PG8_SB(0, 1), b2 + hstep, voffB);
            PG8_WAIT_V(6); PG8_BAR; PG8_MMA(1, 1, At, B1); PG8_BAR;
            PG8_LDB(B0, 1, 0); PG8_SCHED; PG8_LDA(At, 1, 0); PG8_STAGE(PG8_SA(0, 1), a2, sv1);
            PG8_WAIT_L(8); PG8_BAR; PG8_WAIT_L(0); PG8_MMA(0, 0, At, B0); PG8_BAR; PG8_SCHED;
            PG8_LDB(B1, 1, 1); PG8_STAGE(PG8_SB(1, 0), b3, voffB);
            PG8_BAR; PG8_WAIT_L(0); PG8_MMA(0, 1, At, B1); PG8_BAR;
            PG8_LDA(At, 1, 1); PG8_STAGE(PG8_SA(1, 0), a3, sv0);
            PG8_BAR; PG8_WAIT_L(0); PG8_MMA(1, 0, At, B0); PG8_BAR; PG8_SCHED;
            PG8_STAGE(PG8_SB(1, 1), b3 + hstep, voffB);
            PG8_WAIT_V(6); PG8_BAR; PG8_MMA(1, 1, At, B1); PG8_BAR;
        }
        E(acc, cur, wr, wc, fr, fq);
        if (!has_next) break;
#pragma unroll
        for (int a = 0; a < 2; ++a)
#pragma unroll
            for (int b = 0; b < 2; ++b)
#pragma unroll
                for (int m = 0; m < 4; ++m)
#pragma unroll
                    for (int n = 0; n < 2; ++n) acc[a][b][m][n] = (f32x4){0.f, 0.f, 0.f, 0.f};
        cur = nxt; cA = nA; cB = nB; ++ui;
        cv0[0] = nv0[0]; cv0[1] = nv0[1]; cv1[0] = nv1[0]; cv1[1] = nv1[1];
    }
    PG8_WAIT_V(0);
    if (wr == 0) PG8_BAR;
    PG8_BAR;
#undef PG8_SA
#undef PG8_SB
#undef PG8_STAGE
#undef PG8_LDA
#undef PG8_LDB
#undef PG8_MMA
#undef PG8_WAIT_V
#undef PG8_WAIT_L
#undef PG8_BAR
#undef PG8_SCHED
#undef PG8_AVOFF
}
struct DenseOrder {
    int nM, nN, nwg, G, c, K;
    __device__ __forceinline__ void init(int nM_, int nN_, int G_, int c_, int K_) { nM = nM_; nN = nN_; nwg = nM * nN; G = G_; c = c_; K = K_; }
    __device__ __forceinline__ bool next(int i, Unit& u) const {
        const long L = (long)i * G + c; if (L >= nwg) return false;
        int wgid = (int)L; { const int q = nwg / 8, r = nwg % 8, xcd = wgid % 8, off = wgid / 8; wgid = (xcd < r ? xcd * (q + 1) : r * (q + 1) + (xcd - r) * q) + off; }
        const int nig = 8 * nN, gid = wgid / nig, fm = gid * 8, gsz = (nM - fm) < 8 ? (nM - fm) : 8;
        u.pm = fm + ((wgid % nig) % gsz); u.pn = (wgid % nig) / gsz;
        u.aoff = (size_t)u.pm * 256 * K * 2; u.boff = (size_t)u.pn * 256 * K * 2; u.e = 0; u.mvalid = 256; u.rowbase = u.pm * 256; u.mi = 0;
        return true;
    }
    __device__ __forceinline__ int row(const Unit&, int r) const { return r; }
};
}

extern __shared__ __attribute__((aligned(16))) unsigned char g_smem[];
#define PHASE_FN __device__ __forceinline__
enum { PH_PROLOGUE = 0, PH_NORM_MIX, PH_GEMM_IN_EVEN, PH_EVEN_TOK, PH_GDN_CHUNK, PH_GDN_SCAN, PH_DSA_TOPK, PH_DSA_ATTN, PH_GDN_OUT,
       PH_GEMM_OUT, PH_NORM_FFN, PH_MOE1, PH_MOE2, PH_GEMM_IN_ODD, PH_GLA_TOK, PH_GLA_CHUNK, PH_GLA_SCAN, PH_GLA_OUT, PH_FINAL };

PHASE_FN void ph_prologue(const Params& p, float* smem) {
    unsigned char* ws_ = p.ws; asm volatile("" : "+s"(ws_));
    { int ldz_ = 0; asm volatile("" : "+s"(ldz_)); smem = (float*)(g_smem + ldz_); }
    int tid_ = threadIdx.x; asm volatile("" : "+v"(tid_)); const int tid = tid_, nthr = gridDim.x * NTHREADS, gid = blockIdx.x * NTHREADS + tid;
    for (int i = tid; i < 2 * ND; i += NTHREADS) smem[i] = siluf_(p.c[i]);
    __syncthreads();
    float* MOD = (float*)(ws_ + OFF_MOD);
    { float* red = smem + 2048;
      const int lane = tid & 63, wv = tid >> 6;
      for (int item = blockIdx.x; item < 4 * 96; item += gridDim.x) {
          const int l = item / 96, n = (item % 96) * 64 + lane;
          const float* w = p.ada_w + (size_t)l * ND * 6144 + n;
          float a0 = 0.f, a1 = 0.f;
#pragma unroll 8
          for (int k = wv * 128; k < wv * 128 + 128; ++k) { const float wv_ = w[(size_t)k * 6144]; a0 += smem[k] * wv_; a1 += smem[ND + k] * wv_; }
          __syncthreads();
          red[(wv * 64 + lane) * 2] = a0; red[(wv * 64 + lane) * 2 + 1] = a1;
          __syncthreads();
          if (tid < 128) { const int c = tid >> 1, bb = tid & 1; float a = 0.f; for (int w8 = 0; w8 < 8; ++w8) a += red[(w8 * 64 + c) * 2 + bb];
              MOD[(l * 2 + bb) * 6144 + (item % 96) * 64 + c] = a + p.ada_b[l * 6144 + (item % 96) * 64 + c]; }
      }
      __syncthreads(); }
    float* COSA = (float*)(ws_ + OFF_COSA); float* SINA = (float*)(ws_ + OFF_SINA);
    float* COSI = (float*)(ws_ + OFF_COSI); float* SINI = (float*)(ws_ + OFF_SINI);
    for (size_t i = gid; i < (size_t)NT * 64; i += nthr) {
        const int t = (int)(i >> 6), j = (int)(i & 63);
        double s, c; sincos_d((double)p.pos[t] * ipow_d(p.rA, j), s, c);
        COSA[i] = (float)c; SINA[i] = (float)s;
    }
    for (size_t i = gid; i < (size_t)NT * 32; i += nthr) {
        const int t = (int)(i >> 5), j = (int)(i & 31);
        double s, c; sincos_d((double)p.pos[t] * ipow_d(p.rI, j), s, c);
        COSI[i] = (float)c; SINI[i] = (float)s;
    }
}

PHASE_FN void ph_rows(const Params& p, int layer, int mode, float* smem) {
    unsigned char* ws_ = p.ws; asm volatile("" : "+s"(ws_));
    { int ldz_ = 0; asm volatile("" : "+s"(ldz_)); smem = (float*)(g_smem + ldz_); }
    int tid_ = threadIdx.x; asm volatile("" : "+v"(tid_)); const int tid = tid_, lane = tid & 63, wv = tid >> 6;
    int* pad = (int*)smem;
    const int moe_layer = (mode == 1) ? 3 : layer - 1;
    if (moe_layer >= 0) {
        if (tid == 0) { const int* cnt = (const int*)(ws_ + OFF_CNT) + moe_layer * 32 * CSTR; int a = 0; for (int e = 0; e < 32; ++e) { pad[e] = a; a += ((cnt[e * CSTR] + 127) / 128) * 128; } }
        __syncthreads();
    }
    const float* MOD = (const float*)(ws_ + OFF_MOD);
    bf16_t* H = (bf16_t*)(ws_ + OFF_H);
    const bf16_t* YB = (const bf16_t*)(ws_ + OFF_YB);
    const int* ASG = (const int*)(ws_ + OFF_ASG);
    const float* GATE = (const float*)(ws_ + OFF_GATE);
    auto load_x = [&](int row, float (&xv)[16]) {
        const float* xin = (mode == 0 && layer == 0) ? (p.x + (size_t)row * ND) : (p.X + (size_t)row * ND);
#pragma unroll
        for (int j = 0; j < 4; ++j) { const float4 v = *(const float4*)(xin + j * 256 + lane * 4); xv[4 * j] = v.x; xv[4 * j + 1] = v.y; xv[4 * j + 2] = v.z; xv[4 * j + 3] = v.w; }
    };
    auto load_y = [&](int row, uint2 (&ya)[4], uint2 (&yb)[4], float& g0, float& g1) {
        const int4 as = *(const int4*)(ASG + row * 4);
        g0 = GATE[row * 2]; g1 = GATE[row * 2 + 1];
        const bf16_t* y0 = YB + (size_t)(pad[as.x] + as.y) * ND;
        const bf16_t* y1 = YB + (size_t)(pad[as.z] + as.w) * ND;
#pragma unroll
        for (int j = 0; j < 4; ++j) { ya[j] = *(const uint2*)(y0 + j * 256 + lane * 4); yb[j] = *(const uint2*)(y1 + j * 256 + lane * 4); }
    };
    auto finish = [&](int row, float (&xv)[16], const uint2 (&ya)[4], const uint2 (&yb)[4], float g0, float g1) {
        const int b = row >> 13;
        float* xr = p.X + (size_t)row * ND;
        if (moe_layer >= 0) {
            const float* gt = MOD + (size_t)(moe_layer * 2 + b) * 6144 + 5 * 1024;
#pragma unroll
            for (int j = 0; j < 4; ++j) {
                const int col = j * 256 + lane * 4;
                const f32x4 a = unpack4(ya[j]), bq = unpack4(yb[j]); const float4 g = *(const float4*)(gt + col);
                xv[4 * j] += g.x * (g0 * a[0] + g1 * bq[0]); xv[4 * j + 1] += g.y * (g0 * a[1] + g1 * bq[1]);
                xv[4 * j + 2] += g.z * (g0 * a[2] + g1 * bq[2]); xv[4 * j + 3] += g.w * (g0 * a[3] + g1 * bq[3]);
                if (mode == 0) *(float4*)(xr + col) = make_float4(xv[4 * j], xv[4 * j + 1], xv[4 * j + 2], xv[4 * j + 3]);
            }
        }
        float ss = 0.f;
#pragma unroll
        for (int j = 0; j < 16; ++j) ss += xv[j] * xv[j];
        ss = wave_sum(ss);
        const float rstd = rsqrtf(ss * (1.f / 1024.f) + EPS);
        if (mode == 0) {
            const float* nw = p.norm_mix + layer * 1024;
            const float* sh = MOD + (size_t)(layer * 2 + b) * 6144;
            const float* sc = sh + 1024;
#pragma unroll
            for (int j = 0; j < 4; ++j) {
                const int col = j * 256 + lane * 4;
                const float4 w = *(const float4*)(nw + col), s4 = *(const float4*)(sc + col), h4 = *(const float4*)(sh + col);
                f32x4 ov;
                ov[0] = xv[4 * j] * rstd * w.x * (1.f + s4.x) + h4.x; ov[1] = xv[4 * j + 1] * rstd * w.y * (1.f + s4.y) + h4.y;
                ov[2] = xv[4 * j + 2] * rstd * w.z * (1.f + s4.z) + h4.z; ov[3] = xv[4 * j + 3] * rstd * w.w * (1.f + s4.w) + h4.w;
                *(uint2*)(H + (size_t)row * ND + col) = pack4(ov);
            }
        } else {
#pragma unroll
            for (int j = 0; j < 4; ++j) {
                const int col = j * 256 + lane * 4;
                const float4 w = *(const float4*)(p.final_norm + col);
                *(float4*)(xr + col) = make_float4(xv[4 * j] * rstd * w.x, xv[4 * j + 1] * rstd * w.y, xv[4 * j + 2] * rstd * w.z, xv[4 * j + 3] * rstd * w.w);
            }
        }
    };
    const int stride = gridDim.x * 8;
    for (int row = blockIdx.x * 8 + wv; row < NT; row += 2 * stride) {
        const int rowB = row + stride; const bool hasB = rowB < NT; const int rB = hasB ? rowB : row;
        float xa[16], xb[16]; uint2 yaa[4], yab[4], yba[4], ybb[4]; float ga0 = 0.f, ga1 = 0.f, gb0 = 0.f, gb1 = 0.f;
        load_x(row, xa); load_x(rB, xb);
        if (moe_layer >= 0) { load_y(row, yaa, yab, ga0, ga1); load_y(rB, yba, ybb, gb0, gb1); }
        finish(row, xa, yaa, yab, ga0, ga1);
        if (hasB) finish(rowB, xb, yba, ybb, gb0, gb1);
    }
}

struct EpiIn {
    static constexpr bool PERM = true;
    bf16_t* P; float* AUX; int ncols; int even;
    __device__ __forceinline__ void operator()(const f32x4 (&acc)[2][2][4][2], const pg8::Unit& u, int wr, int wc, int fr, int fq) const {
        const int row0 = u.pm * 256 + wr * 64 + fr, col0 = u.pn * 256 + wc * 32 + 8 * fq;
#pragma unroll
        for (int ai = 0; ai < 2; ++ai)
#pragma unroll
            for (int m = 0; m < 4; ++m) { const int r = row0 + ai * 128 + m * 16;
#pragma unroll
                for (int bj = 0; bj < 2; ++bj) { const int c = col0 + bj * 128;
                    if (c < ncols) { const uint2 lo = pack4(acc[ai][bj][m][0]), hi = pack4(acc[ai][bj][m][1]); *(uint4*)(P + (size_t)r * LDPB + c) = make_uint4(lo.x, lo.y, hi.x, hi.y); }
                    if (even) {
                        if (c == 2048) { *(f32x4*)(AUX + (size_t)r * 16) = acc[ai][bj][m][0]; *(f32x4*)(AUX + (size_t)r * 16 + 4) = acc[ai][bj][m][1]; }
                        if (c == 3912) *(f32x4*)(AUX + (size_t)r * 16 + 8) = acc[ai][bj][m][0];
                    } } }
    }
};

PHASE_FN void ph_gemm_in(const Params& p, int layer, bool even, float* smem) {
    unsigned char* ws_ = p.ws; asm volatile("" : "+s"(ws_));
    int ldz_ = 0; asm volatile("" : "+s"(ldz_));
    const bf16_t* Wt = even ? (const bf16_t*)(ws_ + OFF_WINE) + (size_t)(layer >> 1) * 4096 * 1024 : (const bf16_t*)(ws_ + OFF_WINO) + (size_t)(layer >> 1) * 3072 * 1024;
    EpiIn E; E.P = (bf16_t*)(ws_ + OFF_P); E.AUX = (float*)(ws_ + OFF_AUX); E.ncols = even ? 3920 : 3072; E.even = even ? 1 : 0;
    pg8::DenseOrder S; S.init(64, even ? 16 : 12, gridDim.x, blockIdx.x, 1024);
    __syncthreads();
    pg8::gemm_phase<EpiIn, pg8::DenseOrder, false>((LAS unsigned char*)(g_smem + ldz_), (const bf16_t*)(ws_ + OFF_H), Wt, 1024, S, E);
    __syncthreads();
    if (!even) {
        const bf16_t* H = (const bf16_t*)(ws_ + OFF_H);
        const bf16_t* Wg = (const bf16_t*)(ws_ + OFF_WGL) + (size_t)(layer >> 1) * 128 * 1024;
        float* AUX = (float*)(ws_ + OFF_AUX);
        for (int mt = blockIdx.x; mt < 64; mt += gridDim.x) {
            const bf16_t* Ab = H + (size_t)mt * 256 * 1024;
            float* At = AUX + (size_t)mt * 256 * 16;
            gemm_tile_bf16(1024, g_smem + ldz_,
                [=](int i, int r, int k) -> uint4 { return *(const uint4*)(Ab + (size_t)r * 1024 + k); },
                [=](int i, int r, int k) -> uint4 { return *(const uint4*)(Wg + (size_t)r * 1024 + k); },
                [=](const f32x4 (&acc)[4][4], int wm, int wn, int lane) {
                    if (wn == 0 && (lane >> 4) < 4) {
#pragma unroll
                        for (int mi = 0; mi < 4; ++mi) { const int m = wm * 64 + mi * 16 + (lane & 15); *(f32x4*)(At + (size_t)m * 16 + 4 * (lane >> 4)) = acc[mi][0]; }
                    }
                });
        }
        __syncthreads();
    }
}

PHASE_FN void ph_even_tok(const Params& p, int layer, float* smem) {
    unsigned char* ws_ = p.ws; asm volatile("" : "+s"(ws_));
    { int ldz_ = 0; asm volatile("" : "+s"(ldz_)); smem = (float*)(g_smem + ldz_); }
    int tid_ = threadIdx.x; asm volatile("" : "+v"(tid_)); const int tid = tid_, lane = tid & 63, wv = tid >> 6, li = layer >> 1;
    const bf16_t* P = (const bf16_t*)(ws_ + OFF_P); const float* AUX = (const float*)(ws_ + OFF_AUX);
    bf16_t* QB = (bf16_t*)(ws_ + OFF_QBB); bf16_t* KB = (bf16_t*)(ws_ + OFF_KBB); bf16_t* QI = (bf16_t*)(ws_ + OFF_QIB); bf16_t* KI = (bf16_t*)(ws_ + OFF_KIB); float* WI = (float*)(ws_ + OFF_WI);
    const float* COSA = (const float*)(ws_ + OFF_COSA); const float* SINA = (const float*)(ws_ + OFF_SINA);
    const float* COSI = (const float*)(ws_ + OFF_COSI); const float* SINI = (const float*)(ws_ + OFF_SINI);
    for (int t = blockIdx.x * 8 + wv; t < NT; t += gridDim.x * 8) {
        const bf16_t* Pt = P + (size_t)t * LDPB;
        if (lane < 4) {
            WI[t * 4 + lane] = AUX[(size_t)t * 16 + 8 + lane] * 0.0625f;
        }
        { const float c = COSA[(size_t)t * 64 + lane], sn = SINA[(size_t)t * 64 + lane];
#pragma unroll
          for (int h = 0; h < 4; ++h) {
              float t1 = bf16_to_f32(Pt[2056 + h * 128 + lane]), t2 = bf16_to_f32(Pt[2056 + h * 128 + 64 + lane]);
              QB[(size_t)t * 512 + h * 128 + lane] = f2bf(t1 * c - t2 * sn); QB[(size_t)t * 512 + h * 128 + 64 + lane] = f2bf(t2 * c + t1 * sn);
              t1 = bf16_to_f32(Pt[2568 + h * 128 + lane]); t2 = bf16_to_f32(Pt[2568 + h * 128 + 64 + lane]);
              KB[(size_t)t * 512 + h * 128 + lane] = f2bf(t1 * c - t2 * sn); KB[(size_t)t * 512 + h * 128 + 64 + lane] = f2bf(t2 * c + t1 * sn);
          } }
#pragma unroll
        for (int r = 0; r < 2; ++r) {
            const int item = lane + 64 * r, hh = item >> 5, ii = item & 31;
            const float c = COSI[(size_t)t * 32 + ii], sn = SINI[(size_t)t * 32 + ii];
            const float t1 = bf16_to_f32(Pt[3592 + hh * 64 + ii]), t2 = bf16_to_f32(Pt[3592 + hh * 64 + 32 + ii]);
            QI[(size_t)t * 256 + hh * 64 + ii] = f2bf(t1 * c - t2 * sn); QI[(size_t)t * 256 + hh * 64 + 32 + ii] = f2bf(t2 * c + t1 * sn);
        }
        if (lane < 32) {
            const float c = COSI[(size_t)t * 32 + lane], sn = SINI[(size_t)t * 32 + lane];
            const float t1 = bf16_to_f32(Pt[3848 + lane]), t2 = bf16_to_f32(Pt[3848 + 32 + lane]);
            KI[(size_t)t * 64 + lane] = f2bf(t1 * c - t2 * sn); KI[(size_t)t * 64 + 32 + lane] = f2bf(t2 * c + t1 * sn);
        }
    }
    { bf16_t* VT = (bf16_t*)(ws_ + OFF_VT);
      bf16_t* sv = (bf16_t*)g_smem;
      for (int item = blockIdx.x; item < 2 * 128 * 4; item += gridDim.x) {
          const int h = item & 3, tt = item >> 2, b = tt >> 7, s0 = (tt & 127) * 64;
          __syncthreads();
          for (int e = tid; e < 64 * 128; e += NTHREADS) { const int i = e >> 7, d = e & 127; sv[d * 72 + i] = P[(size_t)(b * 8192 + s0 + i) * LDPB + 3080 + h * 128 + d]; }
          __syncthreads();
          for (int e = tid; e < 128 * 8; e += NTHREADS) { const int d = e >> 3, c = e & 7;
              *(uint4*)(VT + ((size_t)((b * 4 + h) * 128 + d)) * 8192 + s0 + c * 8) = *(const uint4*)(sv + d * 72 + c * 8); }
      } }
}

__device__ __forceinline__ f32x4 mma_lds(const unsigned char* A, int sa, int a0, const unsigned char* B, int sb, int b0, int K, f32x4 acc, int c16, int q4) {
    const unsigned char* ap = A + (a0 + c16) * sa + q4 * 16;
    const unsigned char* bp = B + (b0 + c16) * sb + q4 * 16;
    for (int kk = 0; kk < K; kk += 32) { acc = __builtin_amdgcn_mfma_f32_16x16x32_bf16(*(const bf16x8*)(ap + kk * 2), *(const bf16x8*)(bp + kk * 2), acc, 0, 0, 0); }
    return acc;
}

PHASE_FN void ph_gdn_chunk(const Params& p, int layer, float* smem) {
    unsigned char* ws_ = p.ws; asm volatile("" : "+s"(ws_));
    int tid_ = threadIdx.x; asm volatile("" : "+v"(tid_)); const int tid = tid_, lane = tid & 63, wv = __builtin_amdgcn_readfirstlane(tid >> 6), q4 = lane >> 4, c16 = lane & 15;
    int ldz_ = 0; asm volatile("" : "+s"(ldz_)); unsigned char* lds = g_smem + ldz_;
    constexpr int SN = 272, ST = 144;
    unsigned char* bKN = lds;
    unsigned char* bQN = lds + 18432;
    unsigned char* bKBG = lds + 35840;
    unsigned char* bVB = lds + 54272;
    unsigned char* bKD = lds + 72704;
    unsigned char* bUT = lds + 91136;
    float* sL = (float*)(lds + 109568);
    unsigned char* bAQK = lds + 126208;
    unsigned char* bTB = lds + 135424;
    float* sG = (float*)(lds + 144640); float* sB = sG + 64; float* sEg = sB + 64;
    const int li = layer >> 1;
    const bf16_t* P = (const bf16_t*)(ws_ + OFF_P); const float* AUX = (const float*)(ws_ + OFF_AUX);
    const float* cw = p.conv_w + (size_t)li * 4 * 1536;
    uint4* PFR = (uint4*)(ws_ + OFF_PFR); uint4* RFR = (uint4*)(ws_ + OFF_RFR); uint2* QFR = (uint2*)(ws_ + OFF_QFR); uint2* OFR = (uint2*)(ws_ + OFF_OFR);
    float* GL = (float*)(ws_ + OFF_GL);
    for (int ci = blockIdx.x; ci < 1024; ci += gridDim.x) {
        const int b = ci >> 9, h = (ci >> 7) & 3, n = ci & 127;
        const int t0 = b * 8192 + n * 64;
        __syncthreads();
        if (tid < 64) { float g = -expf(p.a_log[li * 4 + h]) * softplusf_(AUX[(size_t)(t0 + tid) * 16 + 4 + h] + p.dt_bias[li * 4 + h]);
#pragma unroll
            for (int o = 1; o < 64; o <<= 1) { const float nb = __shfl_up(g, o); if (lane >= o) g += nb; }
            sG[tid] = g; sB[tid] = sigmoidf_(AUX[(size_t)(t0 + tid) * 16 + h]); sEg[tid] = expf(g); }
        for (int e = tid; e < 64 * 36; e += NTHREADS) ((unsigned*)bAQK)[e] = 0u;
        __syncthreads();
        const float gl = sG[63];
        {
            const int d0 = 2 * lane, cb = h * 128 + d0, s00 = n * 64;
            float wq[4][2], wk[4][2], wvv[4][2];
#pragma unroll
            for (int jj = 0; jj < 4; ++jj) { wq[jj][0] = cw[jj * 1536 + cb]; wq[jj][1] = cw[jj * 1536 + cb + 1]; wk[jj][0] = cw[jj * 1536 + 512 + cb]; wk[jj][1] = cw[jj * 1536 + 512 + cb + 1];
                                            wvv[jj][0] = cw[jj * 1536 + 1024 + cb]; wvv[jj][1] = cw[jj * 1536 + 1024 + cb + 1]; }
#pragma unroll 4
            for (int r = 0; r < 8; ++r) {
                const int i = wv + 8 * r;
                float aq0 = 0.f, aq1 = 0.f, ak0 = 0.f, ak1 = 0.f, av0 = 0.f, av1 = 0.f;
#pragma unroll
                for (int jj = 0; jj < 4; ++jj) {
                    if (s00 + i - 3 + jj >= 0) {
                        const bf16_t* rp = P + (size_t)(t0 + i - 3 + jj) * LDPB + cb;
                        const unsigned uq = *(const unsigned*)rp, uk = *(const unsigned*)(rp + 512), uv = *(const unsigned*)(rp + 1024);
                        aq0 += wq[jj][0] * __uint_as_float(uq << 16); aq1 += wq[jj][1] * __uint_as_float(uq & 0xffff0000u);
                        ak0 += wk[jj][0] * __uint_as_float(uk << 16); ak1 += wk[jj][1] * __uint_as_float(uk & 0xffff0000u);
                        av0 += wvv[jj][0] * __uint_as_float(uv << 16); av1 += wvv[jj][1] * __uint_as_float(uv & 0xffff0000u);
                    }
                }
                aq0 = siluf_(aq0); aq1 = siluf_(aq1); ak0 = siluf_(ak0); ak1 = siluf_(ak1); av0 = siluf_(av0); av1 = siluf_(av1);
                const float rq = rsqrtf(wave_sum(aq0 * aq0 + aq1 * aq1) + EPS), rk = rsqrtf(wave_sum(ak0 * ak0 + ak1 * ak1) + EPS);
                aq0 *= rq; aq1 *= rq; ak0 *= rk; ak1 *= rk;
                const float be = sB[i], eg_i = sEg[i], ekd = expf(gl - sG[i]);
                *(unsigned*)(bKN + i * SN + d0 * 2) = cvt_pk_bf16(ak0, ak1);
                *(unsigned*)(bQN + i * SN + d0 * 2) = cvt_pk_bf16(aq0, aq1);
                *(bf16_t*)(bKBG + d0 * ST + i * 2) = f2bf(ak0 * be * eg_i); *(bf16_t*)(bKBG + (d0 + 1) * ST + i * 2) = f2bf(ak1 * be * eg_i);
                *(bf16_t*)(bVB + d0 * ST + i * 2) = f2bf(av0 * be); *(bf16_t*)(bVB + (d0 + 1) * ST + i * 2) = f2bf(av1 * be);
                *(bf16_t*)(bKD + d0 * ST + i * 2) = f2bf(ak0 * ekd); *(bf16_t*)(bKD + (d0 + 1) * ST + i * 2) = f2bf(ak1 * ekd);
            }
        }
        __syncthreads();
        for (int u = wv; u < 20; u += 8) {
            const int kind = (u >= 10) ? 1 : 0, idx = u - kind * 10;
            const int ti = (idx >= 6) ? 3 : (idx >= 3) ? 2 : (idx >= 1) ? 1 : 0, tj = idx - ((ti * (ti + 1)) >> 1);
            f32x4 acc = (f32x4){0.f, 0.f, 0.f, 0.f};
            acc = mma_lds(kind ? bQN : bKN, SN, 16 * ti, bKN, SN, 16 * tj, 128, acc, c16, q4);
            const int j = 16 * tj + c16;
#pragma unroll
            for (int r = 0; r < 4; ++r) { const int i = 16 * ti + 4 * q4 + r;
                const float dec = (j <= i) ? expf(sG[i] - sG[j]) : 0.f;
                if (kind == 0) sL[i * 65 + j] = (j < i) ? sB[i] * acc[r] * dec : 0.f;
                else *(bf16_t*)(bAQK + i * ST + j * 2) = f2bf(acc[r] * SCALE128 * dec); }
        }
        __syncthreads();
        if (wv == 0) {
            float t[64];
            int zz = 0; asm volatile("" : "+v"(zz)); const float* sLo = sL + zz;
#pragma unroll
            for (int i = 0; i < 64; ++i) { float a = (i == lane) ? 1.f : 0.f;
#pragma unroll
                for (int j = 0; j < i; ++j) a -= sLo[i * 65 + j] * t[j];
                t[i] = a; asm volatile("" ::: "memory"); }
#pragma unroll
            for (int i = 0; i < 64; ++i) *(bf16_t*)(bTB + i * ST + lane * 2) = f2bf(t[i]);
        }
        __syncthreads();
        for (int x = 0; x < 8; ++x) {
            const int u = wv * 8 + x, kind = u >> 5, ti = (u >> 3) & 3, td = u & 7;
            f32x4 acc = (f32x4){0.f, 0.f, 0.f, 0.f};
            acc = mma_lds(bTB, ST, 16 * ti, kind ? bVB : bKBG, ST, 16 * td, 64, acc, c16, q4);
            *(uint2*)((kind ? bUT : bKN) + (16 * td + c16) * ST + (16 * ti + 4 * q4) * 2) = pack4(acc);
        }
        __syncthreads();
        unsigned char* bWT = bKN;
        const float eg = expf(gl);
        for (int x = 0; x < 4; ++x) {
            const int u = wv * 4 + x, ti = u >> 2, a = u & 3;
            uint4 fr;
#pragma unroll
            for (int hf = 0; hf < 2; ++hf) { const int tk = 2 * a + hf;
                f32x4 acc = (f32x4){0.f, 0.f, 0.f, 0.f};
                acc = mma_lds(bWT, ST, 16 * tk, bKD, ST, 16 * ti, 64, acc, c16, q4);
                f32x4 v;
#pragma unroll
                for (int r = 0; r < 4; ++r) v[r] = ((16 * tk + 4 * q4 + r) == (16 * ti + c16) ? eg : 0.f) - acc[r];
                const uint2 pk = pack4(v);
                if (hf == 0) { fr.x = pk.x; fr.y = pk.y; } else { fr.z = pk.x; fr.w = pk.y; } }
            PFR[((size_t)(ci * 8 + ti) * 4 + a) * 64 + lane] = fr;
        }
        for (int x = 0; x < 2; ++x) {
            const int u = wv * 2 + x, ti = u >> 2, a = u & 3;
            uint4 fr;
            const int i = 16 * ti + c16;
            const float qs = SCALE128 * sEg[i];
#pragma unroll
            for (int hf = 0; hf < 2; ++hf) { const int tk = 2 * a + hf;
                f32x4 acc = (f32x4){0.f, 0.f, 0.f, 0.f};
                acc = mma_lds(bWT, ST, 16 * tk, bAQK, ST, 16 * ti, 64, acc, c16, q4);
                const f32x4 qv = unpack4(*(const uint2*)(bQN + i * SN + (16 * tk + 4 * q4) * 2));
                const uint2 pk = pack4(qv * qs - acc);
                if (hf == 0) { fr.x = pk.x; fr.y = pk.y; } else { fr.z = pk.x; fr.w = pk.y; } }
            RFR[((size_t)(ci * 4 + ti) * 4 + a) * 64 + lane] = fr;
        }
        for (int x = 0; x < 8; ++x) {
            const int u = wv * 8 + x, tdv = u >> 3, tdk = u & 7;
            f32x4 acc = (f32x4){0.f, 0.f, 0.f, 0.f};
            acc = mma_lds(bKD, ST, 16 * tdk, bUT, ST, 16 * tdv, 64, acc, c16, q4);
            QFR[((size_t)(ci * 8 + tdv) * 8 + tdk) * 64 + lane] = pack4(acc);
        }
        for (int x = 0; x < 4; ++x) {
            const int u = wv * 4 + x, tdv = u >> 2, ti = u & 3;
            f32x4 acc = (f32x4){0.f, 0.f, 0.f, 0.f};
            acc = mma_lds(bAQK, ST, 16 * ti, bUT, ST, 16 * tdv, 64, acc, c16, q4);
            OFR[((size_t)(ci * 8 + tdv) * 4 + ti) * 64 + lane] = pack4(acc);
        }
        if (tid == 0) GL[ci] = gl;
    }
}

__device__ __forceinline__ void gs_load(uint4 (&d)[12], const unsigned char* pp, const unsigned char* rr, const unsigned char* qq, const unsigned char* oo, const int lt) {
#pragma unroll
    for (int i = 0; i < 6; ++i) { int c = lt + 384 * i; c = c < 2048 ? c : 2047; d[i] = *(const uint4*)(pp + c * 16); }
#pragma unroll
    for (int i = 0; i < 3; ++i) { int c = lt + 384 * i; c = c < 1024 ? c : 1023; d[6 + i] = *(const uint4*)(rr + c * 16); }
#pragma unroll
    for (int i = 0; i < 2; ++i) { int c = lt + 384 * i; c = c < 512 ? c : 511; d[9 + i] = *(const uint4*)(qq + c * 16); }
    { const int c = lt < 256 ? lt : 255; d[11] = *(const uint4*)(oo + c * 16); }
}
__device__ __forceinline__ void gs_store(const uint4 (&d)[12], unsigned char* sb, const int lt) {
#pragma unroll
    for (int i = 0; i < 6; ++i) { const int c = lt + 384 * i; if (c < 2048) *(uint4*)(sb + c * 16) = d[i]; }
#pragma unroll
    for (int i = 0; i < 3; ++i) { const int c = lt + 384 * i; if (c < 1024) *(uint4*)(sb + 32768 + c * 16) = d[6 + i]; }
#pragma unroll
    for (int i = 0; i < 2; ++i) { const int c = lt + 384 * i; if (c < 512) *(uint4*)(sb + 49152 + c * 16) = d[9 + i]; }
    if (lt < 256) *(uint4*)(sb + 57344 + lt * 16) = d[11];
}

#define SCAN_BODY                 bf16x8 Sb[4]; \
_Pragma("unroll") \
                for (int a = 0; a < 4; ++a) { union { uint4 u; bf16x8 v; } cv; const uint2 lo = pack4(S[2 * a]), hi = pack4(S[2 * a + 1]); cv.u.x = lo.x; cv.u.y = lo.y; cv.u.z = hi.x; cv.u.w = hi.y; Sb[a] = cv.v; } \
                const int t0 = b * 8192 + n * 64; \
                {   f32x4 oa[4]; \
_Pragma("unroll") \
                    for (int ti = 0; ti < 4; ++ti) oa[ti] = unpack4(*(const uint2*)(Of + ti * 512)); \
_Pragma("unroll") \
                    for (int a = 0; a < 4; ++a) \
_Pragma("unroll") \
                        for (int ti = 0; ti < 4; ++ti) oa[ti] = __builtin_amdgcn_mfma_f32_16x16x32_bf16(*(const bf16x8*)(Rf + (ti * 4 + a) * 1024), Sb[a], oa[ti], 0, 0, 0); \
_Pragma("unroll") \
                    for (int ti = 0; ti < 4; ++ti) { \
                        float* op = O + (size_t)(t0 + 16 * ti + 4 * q4) * 1024 + h * 128 + 16 * tdv + c16; \
                        op[0] = oa[ti][0]; op[1024] = oa[ti][1]; op[2048] = oa[ti][2]; op[3072] = oa[ti][3]; } \
                } \
                asm volatile("" ::: "memory"); \
_Pragma("unroll") \
                for (int g = 0; g < 2; ++g) { \
                    f32x4 sa[4]; \
_Pragma("unroll") \
                    for (int t = 0; t < 4; ++t) sa[t] = unpack4(*(const uint2*)(Qf + (g * 4 + t) * 512)); \
_Pragma("unroll") \
                    for (int a = 0; a < 4; ++a) \
_Pragma("unroll") \
                        for (int t = 0; t < 4; ++t) sa[t] = __builtin_amdgcn_mfma_f32_16x16x32_bf16(*(const bf16x8*)(Pf + ((g * 4 + t) * 4 + a) * 1024), Sb[a], sa[t], 0, 0, 0); \
_Pragma("unroll") \
                    for (int t = 0; t < 4; ++t) S[g * 4 + t] = sa[t]; \
                    asm volatile("" ::: "memory"); \
                }
PHASE_FN void ph_gdn_scan(const Params& p, float* smem) {
    unsigned char* ws_ = p.ws; asm volatile("" : "+s"(ws_));
    int tid_ = threadIdx.x; asm volatile("" : "+v"(tid_)); const int tid = tid_, lane = tid & 63, wv = __builtin_amdgcn_readfirstlane(tid >> 6), q4 = lane >> 4, c16 = lane & 15;
    int ldz_ = 0; asm volatile("" : "+s"(ldz_)); unsigned char* lds = g_smem + ldz_;
    constexpr int STG = 61440;
    const unsigned char* PFR = ws_ + OFF_PFR; const unsigned char* RFR = ws_ + OFF_RFR; const unsigned char* QFR = ws_ + OFF_QFR; const unsigned char* OFR = ws_ + OFF_OFR;
    float* O = (float*)(ws_ + OFF_O);
    for (int it = blockIdx.x; it < 32; it += gridDim.x) {
        const int bh = it >> 2, pair = it & 3, b = bh >> 2, h = bh & 3;
        __syncthreads();
        if (wv >= 2) {
            const int lt = tid - 128;
            const unsigned char* Pb = PFR + (size_t)bh * 128 * 32768;
            const unsigned char* Rb = RFR + (size_t)bh * 128 * 16384;
            const unsigned char* Qb = QFR + (size_t)bh * 128 * 32768 + pair * 8192;
            const unsigned char* Ob = OFR + (size_t)bh * 128 * 16384 + pair * 4096;
            uint4 ra0, ra1, ra2, ra3, ra4, ra5, ra6, ra7, ra8, ra9, ra10, ra11, rb0, rb1, rb2, rb3, rb4, rb5, rb6, rb7, rb8, rb9, rb10, rb11;
            uint4 rc0, rc1, rc2, rc3, rc4, rc5, rc6, rc7, rc8, rc9, rc10, rc11;
#define LDC(base_, c_, mx_) (*(const uint4*)((base_) + (size_t)(((c_) < (mx_)) ? (c_) : (mx_)) * 16))
#define GS_LOAD(X, n_) do { const unsigned char* pp_ = Pb + (size_t)(n_) * 32768; const unsigned char* rr_ = Rb + (size_t)(n_) * 16384; \
                const unsigned char* qq_ = Qb + (size_t)(n_) * 32768; const unsigned char* oo_ = Ob + (size_t)(n_) * 16384; \
                X##0 = LDC(pp_, lt, 2047); X##1 = LDC(pp_, lt + 384, 2047); X##2 = LDC(pp_, lt + 768, 2047); X##3 = LDC(pp_, lt + 1152, 2047); X##4 = LDC(pp_, lt + 1536, 2047); X##5 = LDC(pp_, lt + 1920, 2047); \
                X##6 = LDC(rr_, lt, 1023); X##7 = LDC(rr_, lt + 384, 1023); X##8 = LDC(rr_, lt + 768, 1023); \
                X##9 = LDC(qq_, lt, 511); X##10 = LDC(qq_, lt + 384, 511); X##11 = LDC(oo_, lt, 255); } while (0)
#define STC(off_, c_, lim_, v_) do { if ((c_) < (lim_)) *(uint4*)(sb_ + (off_) + (c_) * 16) = v_; } while (0)
#define GS_STORE(X, st_) do { unsigned char* sb_ = lds + (st_) * STG; \
                STC(0, lt, 2048, X##0); STC(0, lt + 384, 2048, X##1); STC(0, lt + 768, 2048, X##2); STC(0, lt + 1152, 2048, X##3); STC(0, lt + 1536, 2048, X##4); STC(0, lt + 1920, 2048, X##5); \
                STC(32768, lt, 1024, X##6); STC(32768, lt + 384, 1024, X##7); STC(32768, lt + 768, 1024, X##8); \
                STC(49152, lt, 512, X##9); STC(49152, lt + 384, 512, X##10); STC(57344, lt, 256, X##11); } while (0)
            GS_LOAD(ra, 0); GS_STORE(ra, 0);
            GS_LOAD(rb, 1); GS_LOAD(rc, 2); GS_LOAD(ra, 3);
            __syncthreads();
#define CLAMPN(x_) (((x_) < 128) ? (x_) : 127)
            for (int n = 0; n < 128; n += 3) {
                if (n + 1 < 128) GS_STORE(rb, (n + 1) & 1);
                GS_LOAD(rb, CLAMPN(n + 4)); __syncthreads();
                if (n + 1 < 128) { if (n + 2 < 128) GS_STORE(rc, (n + 2) & 1);
                    GS_LOAD(rc, CLAMPN(n + 5)); __syncthreads(); }
                if (n + 2 < 128) { if (n + 3 < 128) GS_STORE(ra, (n + 3) & 1);
                    GS_LOAD(ra, CLAMPN(n + 6)); __syncthreads(); }
            }
        } else {
            const int tdv = pair * 2 + wv;
            f32x4 S[8];
#pragma unroll
            for (int t = 0; t < 8; ++t) S[t] = (f32x4){0.f, 0.f, 0.f, 0.f};
            __syncthreads();
            for (int n = 0; n < 128; ++n) {
                const unsigned char* base = lds + (n & 1) * STG;
                const unsigned char* Pf = base + lane * 16, *Rf = base + 32768 + lane * 16;
                const unsigned char* Qf = base + 49152 + wv * 4096 + lane * 8, *Of = base + 57344 + wv * 2048 + lane * 8;
                SCAN_BODY
                __syncthreads();
            }
        }
    }
}

__device__ __forceinline__ void block_sum4(int (&v)[4], int* buf) {
    const int lane = threadIdx.x & 63, wv = threadIdx.x >> 6;
#pragma unroll
    for (int q = 0; q < 4; ++q) v[q] = wave_sum_i(v[q]);
    if (lane == 0) {
#pragma unroll
        for (int q = 0; q < 4; ++q) buf[wv * 4 + q] = v[q];
    }
    __syncthreads();
#pragma unroll
    for (int q = 0; q < 4; ++q) { int a = 0; for (int w = 0; w < 8; ++w) a += buf[w * 4 + q]; v[q] = a; }
}

PHASE_FN void ph_dsa_topk(const Params& p, int layer, float* smem) {
    unsigned char* ws_ = p.ws; asm volatile("" : "+s"(ws_));
    int tid_ = threadIdx.x; asm volatile("" : "+v"(tid_)); const int tid = tid_, lane = tid & 63, wv = __builtin_amdgcn_readfirstlane(tid >> 6), q4 = lane >> 4, c16 = lane & 15;
    int* sRed = (int*)g_smem;
    const bf16_t* QIb = (const bf16_t*)(ws_ + OFF_QIB); const bf16_t* KIb = (const bf16_t*)(ws_ + OFF_KIB); const float* WI = (const float*)(ws_ + OFF_WI);
    unsigned short* M16 = (unsigned short*)(ws_ + OFF_M16);
    int* qhead = (int*)(ws_ + OFF_QCTR) + layer * 16;
    int* sIt = (int*)(g_smem + 512);
    for (;;) {
        __syncthreads();
        if (tid == 0) *sIt = atomicAdd(qhead, 1);
        __syncthreads();
        const int it = *sIt;
        if (it >= 2048) break;
        const int b = it & 1, gp = 1023 - (it >> 1);
        const int s0 = gp * 8, t0 = b * 8192 + s0;
        const int ntiles = (s0 >> 4) + 1;
        const int nreg = (ntiles > wv) ? ((ntiles - wv + 7) >> 3) : 0;
        const bf16_t* qp = QIb + (size_t)(t0 + (c16 >> 2)) * 256 + (c16 & 3) * 64 + 8 * q4;
        const bf16x8 a0A = *(const bf16x8*)qp, a1A = *(const bf16x8*)(qp + 32), a0B = *(const bf16x8*)(qp + 4 * 256), a1B = *(const bf16x8*)(qp + 4 * 256 + 32);
        const float4 wqA = *(const float4*)(WI + (size_t)(t0 + q4) * 4), wqB = *(const float4*)(WI + (size_t)(t0 + 4 + q4) * 4);
        const int myqA = s0 + q4, myqB = s0 + 4 + q4;
        int c16s = c16; asm volatile("" : "+v"(c16s));
        int wvs = wv; asm volatile("" : "+s"(wvs));
        unsigned kA[64], kB[64];
#pragma unroll
        for (int i = 0; i < 64; ++i) { kA[i] = 0u; kB[i] = 0u; }
#pragma unroll
        for (int blk = 0; blk < 4; ++blk) if (nreg > blk * 16) {
#pragma unroll
            for (int ii = 0; ii < 16; ++ii) { const int i = blk * 16 + ii, tile = wvs + 8 * i;
                if (tile < ntiles) {
                    const bf16_t* kp = KIb + (size_t)(b * 8192 + tile * 16 + c16s) * 64 + 8 * q4;
                    const bf16x8 k0 = *(const bf16x8*)kp, k1 = *(const bf16x8*)(kp + 32);
                    f32x4 accA = (f32x4){0.f, 0.f, 0.f, 0.f}, accB = accA;
                    accA = __builtin_amdgcn_mfma_f32_16x16x32_bf16(a0A, k0, accA, 0, 0, 0);
                    accB = __builtin_amdgcn_mfma_f32_16x16x32_bf16(a0B, k0, accB, 0, 0, 0);
                    accA = __builtin_amdgcn_mfma_f32_16x16x32_bf16(a1A, k1, accA, 0, 0, 0);
                    accB = __builtin_amdgcn_mfma_f32_16x16x32_bf16(a1B, k1, accB, 0, 0, 0);
                    float sa = 0.f, sb = 0.f;
                    sa += wqA.x * fmaxf(accA[0], 0.f); sa += wqA.y * fmaxf(accA[1], 0.f); sa += wqA.z * fmaxf(accA[2], 0.f); sa += wqA.w * fmaxf(accA[3], 0.f);
                    sb += wqB.x * fmaxf(accB[0], 0.f); sb += wqB.y * fmaxf(accB[1], 0.f); sb += wqB.z * fmaxf(accB[2], 0.f); sb += wqB.w * fmaxf(accB[3], 0.f);
                    const int kidx = tile * 16 + c16s;
                    kA[i] = (kidx <= myqA) ? ordkey(sa) : 0u;
                    kB[i] = (kidx <= myqB) ? ordkey(sb) : 0u;
                }
                if ((ii & 3) == 3) asm volatile("" ::: "memory"); }
        }
        const int keffA = (myqA + 1 < 256) ? (myqA + 1) : 256, keffB = (myqB + 1 < 256) ? (myqB + 1) : 256;
        int par = 0;
        int mydone = 0, alldone = 0;
        int* sDone = sRed + 64;
        auto qsum = [&](int c) -> int {
            c += __shfl_xor(c, 1); c += __shfl_xor(c, 2); c += __shfl_xor(c, 4); c += __shfl_xor(c, 8);
            par ^= 1;
            if (c16 == 0) { sRed[par * 32 + wv * 4 + q4] = c; if (wv == 0) sDone[par * 4 + q4] = (mydone == 3) ? 1 : 0; }
            __syncthreads();
            int a = 0;
#pragma unroll
            for (int w = 0; w < 8; ++w) a += sRed[par * 32 + w * 4 + q4];
            alldone = sDone[par * 4] & sDone[par * 4 + 1] & sDone[par * 4 + 2] & sDone[par * 4 + 3];
            return a;
        };
        unsigned UA = 0u, UB = 0u;
        for (int bit = 31; bit >= 0; --bit) {
            const unsigned candA = UA | (1u << bit), candB = UB | (1u << bit);
            int ca = 0, cb = 0;
            if (!alldone) {
#pragma unroll
            for (int blk = 0; blk < 4; ++blk) if (nreg > blk * 16) {
#pragma unroll
                for (int ii = 0; ii < 16; ++ii) { ca += (kA[blk * 16 + ii] >= candA) ? 1 : 0; cb += (kB[blk * 16 + ii] >= candB) ? 1 : 0; }
            } }
            const int tot = qsum(ca | (cb << 16));
            if ((tot & 0xffff) >= keffA) { UA = candA; mydone = (mydone & 2) | (((tot & 0xffff) == keffA) ? 1 : 0); }
            if ((tot >> 16) >= keffB) { UB = candB; mydone = (mydone & 1) | (((tot >> 16) == keffB) ? 2 : 0); }
        }
        int cg = 0, ce = 0;
#pragma unroll
        for (int i = 0; i < 64; ++i) { cg += (kA[i] > UA) ? 1 : 0; ce += (kA[i] == UA) ? 1 : 0; cg += (kB[i] > UB) ? 65536 : 0; ce += (kB[i] == UB) ? 65536 : 0; }
        cg = qsum(cg); ce = qsum(ce);
        const int needA = keffA - (cg & 0xffff), needB = keffB - (cg >> 16);
        int JA = 8191, JB = 8191;
        par ^= 1;
        if (c16 == 0) sRed[par * 32 + wv * 4 + q4] = (((ce & 0xffff) > needA) || ((ce >> 16) > needB)) ? 1 : 0;
        __syncthreads();
        int anyov = 0;
#pragma unroll
        for (int w = 0; w < 32; ++w) anyov |= sRed[par * 32 + w];
        if (anyov) {
            JA = 0; JB = 0;
            int c16j = c16; asm volatile("" : "+v"(c16j));
            int wvj = wv; asm volatile("" : "+s"(wvj));
            for (int bit = 12; bit >= 0; --bit) {
                const int cjA = JA | (1 << bit), cjB = JB | (1 << bit);
                int c = 0;
#pragma unroll
                for (int i = 0; i < 64; ++i) { const int kidx = (wvj + 8 * i) * 16 + c16j; c += (kA[i] == UA && kidx < cjA) ? 1 : 0; c += (kB[i] == UB && kidx < cjB) ? 65536 : 0; }
                const int tot = qsum(c);
                if ((tot & 0xffff) <= needA - 1) JA = cjA;
                if ((tot >> 16) <= needB - 1) JB = cjB;
            }
        }
        unsigned short* sM = (unsigned short*)(g_smem + 1024);
        { unsigned z_ = 0u; asm volatile("" : "+v"(z_)); ((uint4*)sM)[tid] = make_uint4(z_, z_, z_, z_); }
        __syncthreads();
        int c16e = c16; asm volatile("" : "+v"(c16e));
        int wve = wv; asm volatile("" : "+s"(wve));
#pragma unroll
        for (int blk = 0; blk < 4; ++blk) if (nreg > blk * 16) {
#pragma unroll
            for (int ii = 0; ii < 16; ++ii) { const int i = blk * 16 + ii;
                const int tile = wve + 8 * i, kidx = tile * 16 + c16e;
                const bool selA = kA[i] > UA || (kA[i] == UA && kidx <= JA);
                const bool selB = kB[i] > UB || (kB[i] == UB && kidx <= JB);
                const unsigned long long balA = __ballot(selA), balB = __ballot(selB);
                if (c16 == 0) { sM[q4 * 512 + tile] = (unsigned short)((balA >> (16 * q4)) & 0xffffull);
                                sM[(4 + q4) * 512 + tile] = (unsigned short)((balB >> (16 * q4)) & 0xffffull); }
            }
        }
        __syncthreads();
        *(uint4*)(M16 + (size_t)(t0 + (tid >> 6)) * 512 + (tid & 63) * 8) = ((const uint4*)sM)[tid];
    }
}

PHASE_FN void ph_dsa_attn(const Params& p, float* smem) {
    unsigned char* ws_ = p.ws; asm volatile("" : "+s"(ws_));
    int tid_ = threadIdx.x; asm volatile("" : "+v"(tid_)); const int tid = tid_, lane = tid & 63, wv = tid >> 6, q4 = lane >> 4, c16 = lane & 15;
    int ldz_ = 0; asm volatile("" : "+s"(ldz_)); unsigned char* lds = g_smem + ldz_;
    const bf16_t* QBb = (const bf16_t*)(ws_ + OFF_QBB); const bf16_t* KBb = (const bf16_t*)(ws_ + OFF_KBB); const bf16_t* VT = (const bf16_t*)(ws_ + OFF_VT);
    const unsigned short* M16 = (const unsigned short*)(ws_ + OFF_M16);
    bf16_t* OB = (bf16_t*)(ws_ + OFF_OB);
    const float SC = SCALE128 * 1.4426950408889634f;
    for (int it = blockIdx.x; it < 256; it += gridDim.x) {
        const int bh = it & 7, jp = it >> 3, b = bh >> 2, h = bh & 3;
        for (int half = 0; half < 2; ++half) {
            const int jq = half ? jp : 63 - jp;
            const int qs = jq * 128, nkt = 2 * jq + 2;
            const int tq = b * 8192 + qs + wv * 16 + c16;
            bf16x8 qf[4];
#pragma unroll
            for (int a = 0; a < 4; ++a) qf[a] = *(const bf16x8*)(QBb + (size_t)tq * 512 + h * 128 + 8 * q4 + 32 * a);
            float m = -1e30f, lsum = 0.f;
            f32x4 oacc[8];
#pragma unroll
            for (int t = 0; t < 8; ++t) oacc[t] = (f32x4){0.f, 0.f, 0.f, 0.f};
            uint4 rk0, rk1, rv0, rv1;
            const int q0 = tid, q1 = tid + 512;
            const bf16_t* kg0 = KBb + (size_t)(b * 8192 + (q0 >> 4)) * 512 + h * 128 + (q0 & 15) * 8;
            const bf16_t* kg1 = KBb + (size_t)(b * 8192 + (q1 >> 4)) * 512 + h * 128 + (q1 & 15) * 8;
            const bf16_t* vg0 = VT + ((size_t)((b * 4 + h) * 128 + (q0 >> 3))) * 8192 + (q0 & 7) * 8;
            const bf16_t* vg1 = VT + ((size_t)((b * 4 + h) * 128 + (q1 >> 3))) * 8192 + (q1 & 7) * 8;
            const int lk0 = (q0 >> 4) * 256 + ((((q0 & 15)) ^ ((q0 >> 4) & 15)) << 4), lk1 = (q1 >> 4) * 256 + ((((q1 & 15)) ^ ((q1 >> 4) & 15)) << 4);
            const int lv0 = 16384 + (q0 >> 3) * 128 + ((((q0 & 7)) ^ ((q0 >> 3) & 7)) << 4), lv1 = 16384 + (q1 >> 3) * 128 + ((((q1 & 7)) ^ ((q1 >> 3) & 7)) << 4);
#define ATT_GLOAD(kt_) do { rk0 = *(const uint4*)(kg0 + (size_t)(kt_) * 64 * 512); rk1 = *(const uint4*)(kg1 + (size_t)(kt_) * 64 * 512); \
                            rv0 = *(const uint4*)(vg0 + (kt_) * 64); rv1 = *(const uint4*)(vg1 + (kt_) * 64); } while (0)
#define ATT_LSTORE(st_) do { unsigned char* base_ = lds + (st_) * 32768; *(uint4*)(base_ + lk0) = rk0; *(uint4*)(base_ + lk1) = rk1; *(uint4*)(base_ + lv0) = rv0; *(uint4*)(base_ + lv1) = rv1; } while (0)
            __syncthreads();
            ATT_GLOAD(0); ATT_LSTORE(0);
            __syncthreads();
            for (int kt = 0; kt < nkt; ++kt) {
                if (kt + 1 < nkt) ATT_GLOAD(kt + 1);
                const unsigned long long mbits = *(const unsigned long long*)(M16 + (size_t)tq * 512 + 4 * kt);
                const unsigned char* Kt = lds + (kt & 1) * 32768;
                const unsigned char* Vt = Kt + 16384;
                f32x4 sacc[4];
#pragma unroll
                for (int ti = 0; ti < 4; ++ti) { sacc[ti] = (f32x4){0.f, 0.f, 0.f, 0.f};
                    const int row = 16 * ti + c16;
#pragma unroll
                    for (int a = 0; a < 4; ++a) { const bf16x8 kf = *(const bf16x8*)(Kt + row * 256 + ((((q4 + 4 * a)) ^ (row & 15)) << 4));
                        sacc[ti] = __builtin_amdgcn_mfma_f32_16x16x32_bf16(kf, qf[a], sacc[ti], 0, 0, 0); } }
                float mx = m;
#pragma unroll
                for (int ti = 0; ti < 4; ++ti)
#pragma unroll
                    for (int r = 0; r < 4; ++r) { const bool valid = (mbits >> (16 * ti + 4 * q4 + r)) & 1ull; const float v = sacc[ti][r] * SC; sacc[ti][r] = v; mx = fmaxf(mx, valid ? v : -1e30f); }
                mx = fmaxf(mx, __shfl_xor(mx, 16)); mx = fmaxf(mx, __shfl_xor(mx, 32));
                const float alpha = __builtin_amdgcn_exp2f(m - mx); m = mx;
                float ps = 0.f;
#pragma unroll
                for (int ti = 0; ti < 4; ++ti)
#pragma unroll
                    for (int r = 0; r < 4; ++r) { const bool valid = (mbits >> (16 * ti + 4 * q4 + r)) & 1ull; const float pv = valid ? __builtin_amdgcn_exp2f(sacc[ti][r] - mx) : 0.f; sacc[ti][r] = pv; ps += pv; }
                lsum = lsum * alpha + ps;
#pragma unroll
                for (int t = 0; t < 8; ++t) oacc[t] = oacc[t] * alpha;
                bf16x8 pb[2];
#pragma unroll
                for (int a = 0; a < 2; ++a) {
                    union { uint4 u; bf16x8 v; } cv;
                    cv.u.x = cvt_pk_bf16(sacc[2 * a][0], sacc[2 * a][1]); cv.u.y = cvt_pk_bf16(sacc[2 * a][2], sacc[2 * a][3]);
                    cv.u.z = cvt_pk_bf16(sacc[2 * a + 1][0], sacc[2 * a + 1][1]); cv.u.w = cvt_pk_bf16(sacc[2 * a + 1][2], sacc[2 * a + 1][3]);
                    pb[a] = cv.v; }
#pragma unroll
                for (int t = 0; t < 8; ++t) { const int row = 16 * t + c16;
#pragma unroll
                    for (int a = 0; a < 2; ++a) {
                        union { uint2 h2[2]; bf16x8 v; } vf;
                        vf.h2[0] = *(const uint2*)(Vt + row * 128 + ((((4 * a + (q4 >> 1))) ^ (row & 7)) << 4) + 8 * (q4 & 1));
                        vf.h2[1] = *(const uint2*)(Vt + row * 128 + ((((4 * a + 2 + (q4 >> 1))) ^ (row & 7)) << 4) + 8 * (q4 & 1));
                        oacc[t] = __builtin_amdgcn_mfma_f32_16x16x32_bf16(vf.v, pb[a], oacc[t], 0, 0, 0); } }
                if (kt + 1 < nkt) ATT_LSTORE((kt + 1) & 1);
                __syncthreads();
            }
            lsum += __shfl_xor(lsum, 16); lsum += __shfl_xor(lsum, 32);
            const float inv = 1.f / lsum;
#pragma unroll
            for (int t = 0; t < 8; ++t) *(uint2*)(OB + (size_t)tq * 1024 + 512 + h * 128 + 16 * t + 4 * q4) = pack4(oacc[t] * inv);
        }
    }
}

PHASE_FN void ph_gdn_out(const Params& p, int layer) {
    unsigned char* ws_ = p.ws; asm volatile("" : "+s"(ws_));
    int tid_ = threadIdx.x; asm volatile("" : "+v"(tid_)); const int tid = tid_, lane = tid & 63, wv = tid >> 6;
    const float* O = (const float*)(ws_ + OFF_O); const bf16_t* P = (const bf16_t*)(ws_ + OFF_P); bf16_t* OB = (bf16_t*)(ws_ + OFF_OB);
    const float* onw = p.gdn_out_norm + (layer >> 1) * 128;
    for (int t = blockIdx.x * 8 + wv; t < NT; t += gridDim.x * 8) {
#pragma unroll
        for (int h = 0; h < 4; ++h) {
            const float* op = O + (size_t)t * 1024 + h * 128; bf16_t* ob = OB + (size_t)t * 1024 + h * 128;
            const float o0 = op[lane], o1 = op[64 + lane];
            const float ss = wave_sum(o0 * o0 + o1 * o1);
            const float r = rsqrtf(ss * (1.f / 128.f) + EPS);
            const float z0 = PBF(P, t, 1536 + h * 128 + lane), z1 = PBF(P, t, 1536 + h * 128 + 64 + lane);
            ob[lane] = f2bf(o0 * r * onw[lane] * siluf_(z0)); ob[64 + lane] = f2bf(o1 * r * onw[64 + lane] * siluf_(z1));
        }
    }
}

struct EpiOut {
    static constexpr bool PERM = false;
    const float* Xres; float* X; const float* gt0;
    __device__ __forceinline__ void operator()(const f32x4 (&acc)[2][2][4][2], const pg8::Unit& u, int wr, int wc, int fr, int fq) const {
        const int row0 = u.pm * 256 + wr * 64 + fr, col0 = u.pn * 256 + wc * 32 + 4 * fq;
        const float* gt = gt0 + (size_t)(row0 >> 13) * 6144 + col0;
        f32x4 gv[2][2];
#pragma unroll
        for (int bj = 0; bj < 2; ++bj)
#pragma unroll
            for (int n = 0; n < 2; ++n) gv[bj][n] = *(const f32x4*)(gt + bj * 128 + n * 16);
#pragma unroll
        for (int ai = 0; ai < 2; ++ai)
#pragma unroll
            for (int m = 0; m < 4; ++m) { const size_t off = (size_t)(row0 + ai * 128 + m * 16) * ND + col0;
#pragma unroll
                for (int bj = 0; bj < 2; ++bj)
#pragma unroll
                    for (int n = 0; n < 2; ++n) *(f32x4*)(X + off + bj * 128 + n * 16) = *(const f32x4*)(Xres + off + bj * 128 + n * 16) + gv[bj][n] * acc[ai][bj][m][n]; }
    }
};

PHASE_FN void ph_gemm_out(const Params& p, int layer, float* smem) {
    unsigned char* ws_ = p.ws; asm volatile("" : "+s"(ws_));
    int ldz_ = 0; asm volatile("" : "+s"(ldz_));
    const bf16_t* Wt = (const bf16_t*)(ws_ + OFF_WOUT) + (size_t)layer * 1024 * 1024;
    EpiOut E; E.Xres = (layer == 0) ? p.x : (const float*)p.X; E.X = p.X; E.gt0 = (const float*)(ws_ + OFF_MOD) + (size_t)(layer * 2) * 6144 + 2048;
    pg8::DenseOrder S; S.init(64, 4, gridDim.x, blockIdx.x, 1024);
    __syncthreads();
    pg8::gemm_phase<EpiOut, pg8::DenseOrder, false>((LAS unsigned char*)(g_smem + ldz_), (const bf16_t*)(ws_ + OFF_OB), Wt, 1024, S, E);
    __syncthreads();
}

PHASE_FN void ph_norm_ffn(const Params& p, int layer) {
    unsigned char* ws_ = p.ws; asm volatile("" : "+s"(ws_));
    int tid_ = threadIdx.x; asm volatile("" : "+v"(tid_)); const int tid = tid_, lane = tid & 63, wv = tid >> 6;
    const float* MOD = (const float*)(ws_ + OFF_MOD);
    bf16_t* H = (bf16_t*)(ws_ + OFF_H);
    int* CNT = (int*)(ws_ + OFF_CNT) + layer * 32 * CSTR;
    int* sCnt = (int*)g_smem; int* sBase = sCnt + 32; int* sE = sBase + 32; int* sR = sE + 256;
    const int nrb = (NT + (int)gridDim.x - 1) / (int)gridDim.x, row_lo = blockIdx.x * nrb, row_hi = (row_lo + nrb < NT) ? row_lo + nrb : NT;
    __syncthreads();
    if (tid < 32) sCnt[tid] = 0;
    __syncthreads();
    int* ASG = (int*)(ws_ + OFF_ASG); float* GATE = (float*)(ws_ + OFF_GATE); int* LIST = (int*)(ws_ + OFF_LIST);
    const float* nw = p.norm_ffn + layer * 1024;
    const float* wg = p.rg_w + (size_t)layer * 1024 * 4;
    for (int row = row_lo + wv; row < row_hi; row += 8) {
        const int b = row >> 13;
        const float* xr = p.X + (size_t)row * ND;
        const float* sh = MOD + (size_t)(layer * 2 + b) * 6144 + 3072;
        const float* sc = sh + 1024;
        float hv[16]; float ss = 0.f;
#pragma unroll
        for (int j = 0; j < 4; ++j) { const float4 v = *(const float4*)(xr + j * 256 + lane * 4); hv[4 * j] = v.x; hv[4 * j + 1] = v.y; hv[4 * j + 2] = v.z; hv[4 * j + 3] = v.w; }
#pragma unroll
        for (int j = 0; j < 16; ++j) ss += hv[j] * hv[j];
        ss = wave_sum(ss);
        const float rstd = rsqrtf(ss * (1.f / 1024.f) + EPS);
#pragma unroll
        for (int j = 0; j < 4; ++j) {
            const int col = j * 256 + lane * 4;
            const float4 w = *(const float4*)(nw + col), s4 = *(const float4*)(sc + col), h4 = *(const float4*)(sh + col);
            hv[4 * j] = hv[4 * j] * rstd * w.x * (1.f + s4.x) + h4.x; hv[4 * j + 1] = hv[4 * j + 1] * rstd * w.y * (1.f + s4.y) + h4.y;
            hv[4 * j + 2] = hv[4 * j + 2] * rstd * w.z * (1.f + s4.z) + h4.z; hv[4 * j + 3] = hv[4 * j + 3] * rstd * w.w * (1.f + s4.w) + h4.w;
            { f32x4 ov; ov[0] = hv[4 * j]; ov[1] = hv[4 * j + 1]; ov[2] = hv[4 * j + 2]; ov[3] = hv[4 * j + 3]; *(uint2*)(H + (size_t)row * ND + col) = pack4(ov); }
        }
        float gl[4] = {0.f, 0.f, 0.f, 0.f};
#pragma unroll
        for (int j = 0; j < 4; ++j)
#pragma unroll
            for (int e = 0; e < 4; ++e) { const int col = j * 256 + lane * 4 + e; const float4 w = *(const float4*)(wg + (size_t)col * 4); const float hh = hv[4 * j + e];
                gl[0] += hh * w.x; gl[1] += hh * w.y; gl[2] += hh * w.z; gl[3] += hh * w.w; }
#pragma unroll
        for (int g = 0; g < 4; ++g) gl[g] = wave_sum(gl[g]) + p.rg_b[layer * 4 + g];
        int gs = 0; float gm = gl[0];
#pragma unroll
        for (int g = 1; g < 4; ++g) if (gl[g] > gm) { gm = gl[g]; gs = g; }
        float gsum = 0.f;
#pragma unroll
        for (int g = 0; g < 4; ++g) gsum += expf(gl[g] - gm);
        const float ggate = 1.f / gsum;
        const float* we = p.re_w + ((size_t)(layer * 4 + gs) * 1024) * 8;
        float el[8] = {0.f, 0.f, 0.f, 0.f, 0.f, 0.f, 0.f, 0.f};
#pragma unroll
        for (int j = 0; j < 4; ++j)
#pragma unroll
            for (int e = 0; e < 4; ++e) { const int col = j * 256 + lane * 4 + e; const float4 w0 = *(const float4*)(we + (size_t)col * 8), w1 = *(const float4*)(we + (size_t)col * 8 + 4); const float hh = hv[4 * j + e];
                el[0] += hh * w0.x; el[1] += hh * w0.y; el[2] += hh * w0.z; el[3] += hh * w0.w; el[4] += hh * w1.x; el[5] += hh * w1.y; el[6] += hh * w1.z; el[7] += hh * w1.w; }
#pragma unroll
        for (int e = 0; e < 8; ++e) el[e] = wave_sum(el[e]) + p.re_b[(layer * 4 + gs) * 8 + e];
        int i1 = 0; float l1 = el[0];
#pragma unroll
        for (int e = 1; e < 8; ++e) if (el[e] > l1) { l1 = el[e]; i1 = e; }
        int i2 = -1; float l2 = -INFINITY;
#pragma unroll
        for (int e = 0; e < 8; ++e) if (e != i1 && el[e] > l2) { l2 = el[e]; i2 = e; }
        const float ex = expf(l2 - l1);
        const float p1 = 1.f / (1.f + ex), p2 = ex / (1.f + ex);
        if (lane == 0) {
            const int e1 = gs * 8 + i1, e2 = gs * 8 + i2, lr = row - row_lo;
            sE[lr * 2] = e1; sE[lr * 2 + 1] = e2;
            sR[lr * 2] = atomicAdd(&sCnt[e1], 1); sR[lr * 2 + 1] = atomicAdd(&sCnt[e2], 1);
            GATE[row * 2] = ggate * p1; GATE[row * 2 + 1] = ggate * p2;
        }
    }
    __syncthreads();
    if (tid < 32) sBase[tid] = (sCnt[tid] > 0) ? atomicAdd(&CNT[tid * CSTR], sCnt[tid]) : 0;
    __syncthreads();
    for (int a = tid; a < (row_hi - row_lo) * 2; a += NTHREADS) {
        const int row = row_lo + (a >> 1), e = sE[a], r = sBase[e] + sR[a];
        LIST[(size_t)e * LISTCAP + r] = row;
        ASG[row * 4 + (a & 1) * 2] = e; ASG[row * 4 + (a & 1) * 2 + 1] = r;
    }
}

struct MoeOrder {
    const int* sTs; const int* sPad; const int* CNT; const int* LIST; int G, c, which, K;
    __device__ __forceinline__ bool next(int i, pg8::Unit& u) const {
        const long L = (long)i * G + c; if (L >= (long)__builtin_amdgcn_readfirstlane(sTs[32]) * 4) return false;
        const int mt = (int)(L >> 2), nt = (int)(L & 3);
        int e = 0;
        for (int q = 1; q < 32; ++q) if (__builtin_amdgcn_readfirstlane(sTs[q]) <= mt) e = q;
        const int mi = mt - __builtin_amdgcn_readfirstlane(sTs[e]), cnt = __builtin_amdgcn_readfirstlane(CNT[e * CSTR]);
        u.pm = mt; u.pn = nt; u.e = e; u.mi = mi; u.mvalid = (cnt - mi * 256 < 256) ? (cnt - mi * 256) : 256; u.rowbase = __builtin_amdgcn_readfirstlane(sPad[e]) + mi * 256;
        u.boff = ((size_t)e * 1024 + nt * 256) * K * 2;
        u.aoff = which ? (size_t)u.rowbase * 512 * 2 : 0;
        return true;
    }
    __device__ __forceinline__ int row(const pg8::Unit& u, int r) const { const int rr = (r < u.mvalid) ? r : 0; return LIST[(size_t)u.e * LISTCAP + u.mi * 256 + rr]; }
};
struct EpiMoe1 {
    static constexpr bool PERM = false;
    bf16_t* HID;
    __device__ __forceinline__ void operator()(const f32x4 (&acc)[2][2][4][2], const pg8::Unit& u, int wr, int wc, int fr, int fq) const {
#pragma unroll
        for (int ai = 0; ai < 2; ++ai)
#pragma unroll
            for (int m = 0; m < 4; ++m) { const int rl = ai * 128 + wr * 64 + m * 16 + fr;
                if (rl < u.mvalid) {
#pragma unroll
                    for (int bj = 0; bj < 2; ++bj) { const f32x4 a1 = acc[ai][bj][m][0], a3 = acc[ai][bj][m][1]; f32x4 hv;
                        hv[0] = siluf_(a1[0]) * a3[0]; hv[1] = siluf_(a1[1]) * a3[1]; hv[2] = siluf_(a1[2]) * a3[2]; hv[3] = siluf_(a1[3]) * a3[3];
                        *(uint2*)(HID + (size_t)(u.rowbase + rl) * 512 + u.pn * 128 + bj * 64 + wc * 16 + 4 * fq) = pack4(hv); } } }
    }
};
struct EpiMoe2 {
    static constexpr bool PERM = true;
    bf16_t* YB;
    __device__ __forceinline__ void operator()(const f32x4 (&acc)[2][2][4][2], const pg8::Unit& u, int wr, int wc, int fr, int fq) const {
#pragma unroll
        for (int ai = 0; ai < 2; ++ai)
#pragma unroll
            for (int m = 0; m < 4; ++m) { const int rl = ai * 128 + wr * 64 + m * 16 + fr;
                if (rl < u.mvalid) {
#pragma unroll
                    for (int bj = 0; bj < 2; ++bj) { const uint2 lo = pack4(acc[ai][bj][m][0]), hi = pack4(acc[ai][bj][m][1]);
                        *(uint4*)(YB + (size_t)(u.rowbase + rl) * 1024 + u.pn * 256 + bj * 128 + wc * 32 + 8 * fq) = make_uint4(lo.x, lo.y, hi.x, hi.y); } } }
    }
};

PHASE_FN void ph_moe(const Params& p, int layer, int which, float* smem) {
    unsigned char* ws_ = p.ws; asm volatile("" : "+s"(ws_));
    int ldz_ = 0; asm volatile("" : "+s"(ldz_));
    int tid_ = threadIdx.x; asm volatile("" : "+v"(tid_)); const int tid = tid_;
    int* sPad = (int*)(g_smem + ldz_ + 131072); int* sTs = sPad + 40;
    const int* CNT = (const int*)(ws_ + OFF_CNT) + layer * 32 * CSTR;
    __syncthreads();
    if (tid == 0) { int a = 0, ts = 0; for (int e = 0; e < 32; ++e) { sPad[e] = a; sTs[e] = ts; a += ((CNT[e * CSTR] + 127) / 128) * 128; ts += (CNT[e * CSTR] + 255) / 256; } sTs[32] = ts; sPad[32] = a; }
    __syncthreads();
    MoeOrder S; S.sTs = sTs; S.sPad = sPad; S.CNT = CNT; S.LIST = (const int*)(ws_ + OFF_LIST); S.G = gridDim.x; S.which = which; S.K = which ? 512 : 1024;
    S.c = (((int)gridDim.x & 7) == 0) ? (((int)blockIdx.x & 7) * ((int)gridDim.x >> 3) + ((int)blockIdx.x >> 3)) : (int)blockIdx.x;
    if (which == 0) {
        EpiMoe1 E; E.HID = (bf16_t*)(ws_ + OFF_HID);
        pg8::gemm_phase<EpiMoe1, MoeOrder, true>((LAS unsigned char*)(g_smem + ldz_), (const bf16_t*)(ws_ + OFF_H), (const bf16_t*)(ws_ + OFF_W13), 1024, S, E);
    } else {
        EpiMoe2 E; E.YB = (bf16_t*)(ws_ + OFF_YB);
        pg8::gemm_phase<EpiMoe2, MoeOrder, false>((LAS unsigned char*)(g_smem + ldz_), (const bf16_t*)(ws_ + OFF_HID), (const bf16_t*)(ws_ + OFF_W2T), 512, S, E);
    }
    __syncthreads();
}

PHASE_FN void ph_conv_dense(const Params& p, float* smem) {
    unsigned char* ws_ = p.ws; asm volatile("" : "+s"(ws_));
    { int ldz_ = 0; asm volatile("" : "+s"(ldz_)); smem = (float*)(g_smem + ldz_); }
    auto dec = [&](int t, const float*& s0, const float*& s1, bf16_t*& dst, int& mode, int& K, int& N, int& ld, int& rt, int& kt) {
        s1 = nullptr; mode = 0; K = 1024;
        if (t >= 4672) t = 4671;
        if (t >= 4608) { const int v = t - 4608, l = v >> 5, u = v & 31; s0 = p.gla_w_in + (size_t)l * 1024 * 3088 + 3072; N = 16; ld = 3088; dst = (bf16_t*)(ws_ + OFF_WGL) + (size_t)l * 128 * 1024; rt = u >> 4; kt = u & 15; }
        else if (t < 2048) { const int l = t >> 10, u = t & 1023; s0 = p.even_w_in + (size_t)l * 1024 * 3916; N = 3916; ld = 3916; dst = (bf16_t*)(ws_ + OFF_WINE) + (size_t)l * 4096 * 1024; rt = u >> 4; kt = u & 15; }
        else if (t < 3584) { const int v = t - 2048, l = v / 768, u = v % 768; s0 = p.gla_w_in + (size_t)l * 1024 * 3088; N = 3072; ld = 3088; dst = (bf16_t*)(ws_ + OFF_WINO) + (size_t)l * 3072 * 1024; rt = u >> 4; kt = u & 15; }
        else { const int v = t - 3584, l = v >> 8, u = v & 255; s0 = ((l & 1) ? p.gla_w_out : p.even_w_out) + (size_t)(l >> 1) * 1024 * 1024; N = 1024; ld = 1024; dst = (bf16_t*)(ws_ + OFF_WOUT) + (size_t)l * 1024 * 1024; rt = u >> 4; kt = u & 15; }
    };
    for (int t = blockIdx.x * 4; t < 4672; t += gridDim.x * 4) convert_tiles4(dec, t, (4672 - t < 4) ? (4672 - t) : 4, smem);
}

PHASE_FN void ph_conv_exp(const Params& p, int layer, float* smem, int first_blk) {
    unsigned char* ws_ = p.ws; asm volatile("" : "+s"(ws_));
    { int ldz_ = 0; asm volatile("" : "+s"(ldz_)); smem = (float*)(g_smem + ldz_); }
    if ((int)blockIdx.x < first_blk) return;
    auto dec = [&](int t, const float*& s0, const float*& s1, bf16_t*& dst, int& mode, int& K, int& N, int& ld, int& rt, int& kt) {
        if (t >= 12288) t = 12287;
        if (t < 8192) { const int e = t >> 8, u = t & 255; s0 = p.w1 + (size_t)(layer * 32 + e) * 1024 * 512; s1 = p.w3 + (size_t)(layer * 32 + e) * 1024 * 512; mode = 1; K = 1024; N = 512; ld = 512;
            dst = (bf16_t*)(ws_ + OFF_W13) + (size_t)e * 1024 * 1024; rt = u >> 4; kt = u & 15; }
        else { const int v = t - 8192, e = v >> 7, u = v & 127; s0 = p.w2 + (size_t)(layer * 32 + e) * 512 * 1024; s1 = nullptr; mode = 0; K = 512; N = 1024; ld = 1024;
            dst = (bf16_t*)(ws_ + OFF_W2T) + (size_t)e * 1024 * 512; rt = u >> 3; kt = u & 7; }
    };
    const int nb = (int)gridDim.x - first_blk;
    for (int t = ((int)blockIdx.x - first_blk) * 4; t < 12288; t += nb * 4) convert_tiles4(dec, t, (12288 - t < 4) ? (12288 - t) : 4, smem);
}

PHASE_FN void ph_gla_tok(const Params& p, int layer) {
    unsigned char* ws_ = p.ws; asm volatile("" : "+s"(ws_));
    int tid_ = threadIdx.x; asm volatile("" : "+v"(tid_)); const int tid = tid_, lane = tid & 63, wv = tid >> 6, li = layer >> 1;
    const float* AUX = (const float*)(ws_ + OFF_AUX);
    float* LA = (float*)(ws_ + OFF_LA);
    const float* w2 = p.gla_w_gate2 + (size_t)li * 16 * 512; const float* b2 = p.gla_b_gate2 + li * 512;
    for (int t = blockIdx.x * 8 + wv; t < NT; t += gridDim.x * 8) {
        float glr[16];
#pragma unroll
        for (int r = 0; r < 16; ++r) glr[r] = AUX[(size_t)t * 16 + r];
#pragma unroll 1
        for (int i = 0; i < 8; ++i) {
            const int c = lane + 64 * i; float z = b2[c];
#pragma unroll
            for (int r = 0; r < 16; ++r) z += glr[r] * w2[r * 512 + c];
            LA[(size_t)t * 512 + c] = -softplusf_(-z) * (1.f / 16.f);
        }
    }
}

PHASE_FN void ph_gla_chunk(const Params& p, int layer, float* smem) {
    unsigned char* ws_ = p.ws; asm volatile("" : "+s"(ws_));
    int tid_ = threadIdx.x; asm volatile("" : "+v"(tid_)); const int tid = tid_, lane = tid & 63, wv = __builtin_amdgcn_readfirstlane(tid >> 6), q4 = lane >> 4, c16 = lane & 15;
    int ldz_ = 0; asm volatile("" : "+s"(ldz_)); unsigned char* lds = g_smem + ldz_;
    constexpr int SN = 272, ST = 144;
    float* sBc = (float*)lds;
    unsigned char* bQE = lds + 33024;
    unsigned char* bKE = lds + 50432;
    unsigned char* bKD = lds + 67840;
    unsigned char* bVT = lds + 86272;
    unsigned char* bATT = lds + 123136;
    const bf16_t* P = (const bf16_t*)(ws_ + OFF_P); const float* AUX = (const float*)(ws_ + OFF_AUX);
    const float* w2 = p.gla_w_gate2 + (size_t)(layer >> 1) * 16 * 512; const float* b2 = p.gla_b_gate2 + (layer >> 1) * 512;
    float* sGlr = (float*)(lds + 132352);
    uint4* QEF = (uint4*)(ws_ + OFF_GQE); uint2* OIF = (uint2*)(ws_ + OFF_GOI); uint2* HF = (uint2*)(ws_ + OFF_GH); float* EBL = (float*)(ws_ + OFF_GEBL);
    for (int ci = blockIdx.x; ci < 1024; ci += gridDim.x) {
        const int b = ci >> 9, h = (ci >> 7) & 3, n = ci & 127;
        const int t0 = b * 8192 + n * 64;
        __syncthreads();
        for (int e = tid; e < 1024; e += NTHREADS) sGlr[e] = AUX[(size_t)(t0 + (e >> 4)) * 16 + (e & 15)];
        __syncthreads();
        {
            const int d = tid & 127, c = h * 128 + d;
            float wg[16];
#pragma unroll
            for (int r = 0; r < 16; ++r) wg[r] = w2[r * 512 + c];
            const float bz = b2[c];
            for (int i = tid >> 7; i < 64; i += 4) {
                float z = bz;
#pragma unroll
                for (int r = 0; r < 16; ++r) z += sGlr[i * 16 + r] * wg[r];
                sBc[i * 129 + d] = -softplusf_(-z) * (1.f / 16.f);
            }
        }
        for (int e = tid; e < 64 * 36; e += NTHREADS) ((unsigned*)bATT)[e] = 0u;
        __syncthreads();
        if (tid < 128) { float a = 0.f; for (int i = 0; i < 64; ++i) { a += sBc[i * 129 + tid]; sBc[i * 129 + tid] = a; } }
        __syncthreads();
        for (int e = tid; e < 8192; e += NTHREADS) {
            const int i = e >> 7, d = e & 127;
            const float bb = sBc[i * 129 + d], bl = sBc[63 * 129 + d];
            const float qf = PBF(P, t0 + i, h * 128 + d), kf = PBF(P, t0 + i, 512 + h * 128 + d);
            *(bf16_t*)(bQE + i * SN + d * 2) = f2bf(qf * SCALE128 * expf(bb));
            *(bf16_t*)(bKE + i * SN + d * 2) = f2bf(kf * expf(-bb));
            *(bf16_t*)(bKD + d * ST + i * 2) = f2bf(kf * expf(bl - bb));
        }
        for (int e = tid; e < 16384; e += NTHREADS) { const int i = e >> 8, dv = e & 255; *(bf16_t*)(bVT + dv * ST + i * 2) = P[(size_t)(t0 + i) * LDPB + 1024 + h * 256 + dv]; }
        if (tid < 128) EBL[ci * 128 + tid] = expf(sBc[63 * 129 + tid]);
        __syncthreads();
        for (int u = wv; u < 10; u += 8) {
            const int ti = (u >= 6) ? 3 : (u >= 3) ? 2 : (u >= 1) ? 1 : 0, tj = u - ((ti * (ti + 1)) >> 1);
            f32x4 acc = (f32x4){0.f, 0.f, 0.f, 0.f};
            acc = mma_lds(bQE, SN, 16 * ti, bKE, SN, 16 * tj, 128, acc, c16, q4);
            const int j = 16 * tj + c16;
#pragma unroll
            for (int r = 0; r < 4; ++r) { const int i = 16 * ti + 4 * q4 + r; *(bf16_t*)(bATT + i * ST + j * 2) = f2bf((j <= i) ? acc[r] : 0.f); }
        }
        for (int x = 0; x < 2; ++x) {
            const int u = wv * 2 + x, ti = u >> 2, a = u & 3;
            const unsigned char* rp = bQE + (16 * ti + c16) * SN;
            const uint2 lo = *(const uint2*)(rp + (32 * a + 4 * q4) * 2), hi = *(const uint2*)(rp + (32 * a + 16 + 4 * q4) * 2);
            QEF[((size_t)(ci * 4 + ti) * 4 + a) * 64 + lane] = make_uint4(lo.x, lo.y, hi.x, hi.y);
        }
        __syncthreads();
        for (int x = 0; x < 8; ++x) {
            const int u = wv * 8 + x, tdv = u >> 2, ti = u & 3;
            f32x4 acc = (f32x4){0.f, 0.f, 0.f, 0.f};
            acc = mma_lds(bATT, ST, 16 * ti, bVT, ST, 16 * tdv, 64, acc, c16, q4);
            OIF[((size_t)(ci * 16 + tdv) * 4 + ti) * 64 + lane] = pack4(acc);
        }
        for (int x = 0; x < 16; ++x) {
            const int u = wv * 16 + x, tdv = u >> 3, tdk = u & 7;
            f32x4 acc = (f32x4){0.f, 0.f, 0.f, 0.f};
            acc = mma_lds(bKD, ST, 16 * tdk, bVT, ST, 16 * tdv, 64, acc, c16, q4);
            HF[((size_t)(ci * 16 + tdv) * 8 + tdk) * 64 + lane] = pack4(acc);
        }
    }
}

PHASE_FN void ph_gla_scan(const Params& p, float* smem) {
    unsigned char* ws_ = p.ws; asm volatile("" : "+s"(ws_));
    int tid_ = threadIdx.x; asm volatile("" : "+v"(tid_)); const int tid = tid_, lane = tid & 63, wv = __builtin_amdgcn_readfirstlane(tid >> 6), q4 = lane >> 4, c16 = lane & 15;
    int ldz_ = 0; asm volatile("" : "+s"(ldz_)); unsigned char* lds = g_smem + ldz_;
    constexpr int STG = 29184;
    const unsigned char* QEF = ws_ + OFF_GQE; const unsigned char* HF = ws_ + OFF_GH; const unsigned char* OIF = ws_ + OFF_GOI; const unsigned char* EBL = ws_ + OFF_GEBL;
    float* O = (float*)(ws_ + OFF_O);
    for (int it = blockIdx.x; it < 64; it += gridDim.x) {
        const int bh = it >> 3, pair = it & 7, b = bh >> 2, h = bh & 3;
        __syncthreads();
        if (wv >= 2) {
            const int lt = tid - 128;
            const unsigned char* Qb = QEF + (size_t)bh * 128 * 16384;
            const unsigned char* Hb = HF + (size_t)bh * 128 * 65536 + pair * 8192;
            const unsigned char* Ob = OIF + (size_t)bh * 128 * 32768 + pair * 4096;
            const unsigned char* Lb = EBL + (size_t)bh * 128 * 512;
            uint4 ra0, ra1, ra2, ra3, ra4, ra5, ra6, rb0, rb1, rb2, rb3, rb4, rb5, rb6, rc0, rc1, rc2, rc3, rc4, rc5, rc6, rd0, rd1, rd2, rd3, rd4, rd5, rd6;
#define GL_LOAD(X, n_) do { const unsigned char* q_ = Qb + (size_t)(n_) * 16384; const unsigned char* h_ = Hb + (size_t)(n_) * 65536; \
                const unsigned char* o_ = Ob + (size_t)(n_) * 32768; const unsigned char* l_ = Lb + (size_t)(n_) * 512; \
                X##0 = LDC(q_, lt, 1023); X##1 = LDC(q_, lt + 384, 1023); X##2 = LDC(q_, lt + 768, 1023); \
                X##3 = LDC(h_, lt, 511); X##4 = LDC(h_, lt + 384, 511); X##5 = LDC(o_, lt, 255); X##6 = LDC(l_, lt, 31); } while (0)
#define GL_STORE(X, st_) do { unsigned char* sb_ = lds + (st_) * STG; \
                STC(0, lt, 1024, X##0); STC(0, lt + 384, 1024, X##1); STC(0, lt + 768, 1024, X##2); \
                STC(16384, lt, 512, X##3); STC(16384, lt + 384, 512, X##4); STC(24576, lt, 256, X##5); STC(28672, lt, 32, X##6); } while (0)
            GL_LOAD(ra, 0); GL_STORE(ra, 0);
            GL_LOAD(rb, 1); GL_LOAD(rc, 2); GL_LOAD(rd, 3); GL_LOAD(ra, 4);
            __syncthreads();
            for (int n = 0; n < 128; n += 4) {
                GL_STORE(rb, 1); GL_LOAD(rb, CLAMPN(n + 5)); __syncthreads();
                GL_STORE(rc, 0); GL_LOAD(rc, CLAMPN(n + 6)); __syncthreads();
                GL_STORE(rd, 1); GL_LOAD(rd, CLAMPN(n + 7)); __syncthreads();
                if (n + 4 < 128) GL_STORE(ra, 0);
                GL_LOAD(ra, CLAMPN(n + 8)); __syncthreads();
            }
        } else {
            const int tdv = pair * 2 + wv;
            f32x4 S[8];
#pragma unroll
            for (int t = 0; t < 8; ++t) S[t] = (f32x4){0.f, 0.f, 0.f, 0.f};
            __syncthreads();
            for (int n = 0; n < 128; ++n) {
                const unsigned char* base = lds + (n & 1) * STG;
                const unsigned char* Qf = base + lane * 16, *Hf = base + 16384 + wv * 4096 + lane * 8, *Of = base + 24576 + wv * 2048 + lane * 8, *Lf = base + 28672 + q4 * 16;
                bf16x8 Sb[4];
#pragma unroll
                for (int a = 0; a < 4; ++a) { union { uint4 u; bf16x8 v; } cv; const uint2 lo = pack4(S[2 * a]), hi = pack4(S[2 * a + 1]); cv.u.x = lo.x; cv.u.y = lo.y; cv.u.z = hi.x; cv.u.w = hi.y; Sb[a] = cv.v; }
                const int t0 = b * 8192 + n * 64;
                f32x4 oa[4];
#pragma unroll
                for (int ti = 0; ti < 4; ++ti) oa[ti] = unpack4(*(const uint2*)(Of + ti * 512));
#pragma unroll
                for (int a = 0; a < 4; ++a)
#pragma unroll
                    for (int ti = 0; ti < 4; ++ti) oa[ti] = __builtin_amdgcn_mfma_f32_16x16x32_bf16(*(const bf16x8*)(Qf + (ti * 4 + a) * 1024), Sb[a], oa[ti], 0, 0, 0);
#pragma unroll
                for (int ti = 0; ti < 4; ++ti) {
                    float* op = O + (size_t)(t0 + 16 * ti + 4 * q4) * 1024 + h * 256 + 16 * tdv + c16;
                    op[0] = oa[ti][0]; op[1024] = oa[ti][1]; op[2048] = oa[ti][2]; op[3072] = oa[ti][3]; }
#pragma unroll
                for (int t = 0; t < 8; ++t) { const f32x4 lam = *(const f32x4*)(Lf + t * 64); S[t] = S[t] * lam + unpack4(*(const uint2*)(Hf + t * 512)); }
                __syncthreads();
            }
        }
    }
}

PHASE_FN void ph_gla_out(const Params& p, int layer) {
    unsigned char* ws_ = p.ws; asm volatile("" : "+s"(ws_));
    int tid_ = threadIdx.x; asm volatile("" : "+v"(tid_)); const int tid = tid_, lane = tid & 63, wv = tid >> 6;
    const float* O = (const float*)(ws_ + OFF_O); const bf16_t* P = (const bf16_t*)(ws_ + OFF_P); bf16_t* OB = (bf16_t*)(ws_ + OFF_OB);
    const float* onw = p.gla_out_norm + (layer >> 1) * 256;
    for (int t = blockIdx.x * 8 + wv; t < NT; t += gridDim.x * 8) {
#pragma unroll
        for (int h = 0; h < 4; ++h) {
            const float* op = O + (size_t)t * 1024 + h * 256;
            const float4 o = *(const float4*)(op + lane * 4);
            const float ss = wave_sum(o.x * o.x + o.y * o.y + o.z * o.z + o.w * o.w);
            const float r = rsqrtf(ss * (1.f / 256.f) + EPS);
            const f32x4 z = unpack4(*(const uint2*)(P + (size_t)t * LDPB + 2048 + h * 256 + lane * 4));
            const float4 w = *(const float4*)(onw + lane * 4);
            f32x4 ov; ov[0] = o.x * r * w.x * siluf_(z[0]); ov[1] = o.y * r * w.y * siluf_(z[1]); ov[2] = o.z * r * w.z * siluf_(z[2]); ov[3] = o.w * r * w.w * siluf_(z[3]);
            *(uint2*)(OB + (size_t)t * 1024 + h * 256 + lane * 4) = pack4(ov);
        }
    }
}

template <int PH>
__device__ __forceinline__ void run_phase(const Params& p, int layer, float* smem) {
    if (PH == PH_PROLOGUE) { ph_prologue(p, smem); ph_conv_dense(p, smem); }
    else if (PH == PH_NORM_MIX) ph_rows(p, layer, 0, smem);
    else if (PH == PH_GEMM_IN_EVEN) ph_gemm_in(p, layer, true, smem);
    else if (PH == PH_EVEN_TOK) { ph_even_tok(p, layer, smem); ph_gdn_chunk(p, layer, smem); }
    else if (PH == PH_GDN_CHUNK) ph_gdn_chunk(p, layer, smem);
    else if (PH == PH_GDN_SCAN) { ph_gdn_scan(p, smem); ph_conv_exp(p, layer, smem, 32); ph_dsa_topk(p, layer, smem); }
    else if (PH == PH_DSA_TOPK) ph_dsa_topk(p, layer, smem);
    else if (PH == PH_DSA_ATTN) { ph_dsa_attn(p, smem); ph_gdn_out(p, layer); }
    else if (PH == PH_GDN_OUT) ph_gdn_out(p, layer);
    else if (PH == PH_GEMM_OUT) ph_gemm_out(p, layer, smem);
    else if (PH == PH_NORM_FFN) ph_norm_ffn(p, layer);
    else if (PH == PH_MOE1) ph_moe(p, layer, 0, smem);
    else if (PH == PH_MOE2) ph_moe(p, layer, 1, smem);
    else if (PH == PH_GEMM_IN_ODD) ph_gemm_in(p, layer, false, smem);
    else if (PH == PH_GLA_TOK) ph_gla_tok(p, layer);
    else if (PH == PH_GLA_CHUNK) ph_gla_chunk(p, layer, smem);
    else if (PH == PH_GLA_SCAN) { ph_gla_scan(p, smem); ph_conv_exp(p, layer, smem, 64); }
    else if (PH == PH_GLA_OUT) ph_gla_out(p, layer);
    else if (PH == PH_FINAL) ph_rows(p, 0, 1, smem);
}

#if MK_MULTI
template <int PH>
__global__ void __launch_bounds__(NTHREADS, 2) k_phase(Params p, int layer) {
    run_phase<PH>(p, layer, (float*)g_smem);
}
#else
__global__ void __launch_bounds__(NTHREADS, 2) k_mega(Params p) {
    float* smem = (float*)g_smem;
    volatile LAS unsigned* xbw = (volatile LAS unsigned*)(LAS unsigned char*)(g_smem + LDS_BYTES - 16);
    if (threadIdx.x == 0) { xbw[0] = 0u; xbw[1] = 0u; xbw[2] = 0u; xbw[3] = 0u; }
    __syncthreads();
    XcdBarrier bar = xcd_barrier_post((unsigned*)(p.ws + OFF_BAR), xbw);
#define BAR() do { XcdBarrier bb_ = bar; asm volatile("" : "+s"(bb_.x)); asm volatile("" : "+s"(bb_.bar)); xcd_barrier(bb_); } while (0)
    run_phase<PH_PROLOGUE>(p, 0, smem); BAR(); if (DUP_MASK & 4096) { run_phase<PH_PROLOGUE>(p, 0, smem); BAR(); }
    for (int lp = 0; lp < 2; ++lp) {
        const int le = 2 * lp, lo = 2 * lp + 1;
        run_phase<PH_NORM_MIX>(p, le, smem); BAR();
        run_phase<PH_GEMM_IN_EVEN>(p, le, smem); BAR(); if (DUP_MASK & 1) { run_phase<PH_GEMM_IN_EVEN>(p, le, smem); BAR(); }
        run_phase<PH_EVEN_TOK>(p, le, smem); BAR(); if (DUP_MASK & 2) { run_phase<PH_EVEN_TOK>(p, le, smem); BAR(); }
        run_phase<PH_GDN_SCAN>(p, le, smem); BAR(); if (DUP_MASK & 8) { run_phase<PH_GDN_SCAN>(p, le, smem); BAR(); }
        run_phase<PH_DSA_ATTN>(p, le, smem); BAR(); if (DUP_MASK & 32) { run_phase<PH_DSA_ATTN>(p, le, smem); BAR(); }
        run_phase<PH_GEMM_OUT>(p, le, smem); BAR();
        run_phase<PH_NORM_FFN>(p, le, smem); BAR();
        run_phase<PH_MOE1>(p, le, smem); BAR(); if (DUP_MASK & 64) { run_phase<PH_MOE1>(p, le, smem); BAR(); }
        run_phase<PH_MOE2>(p, le, smem); BAR(); if (DUP_MASK & 128) { run_phase<PH_MOE2>(p, le, smem); BAR(); }
        run_phase<PH_NORM_MIX>(p, lo, smem); BAR();
        run_phase<PH_GEMM_IN_ODD>(p, lo, smem); BAR(); if (DUP_MASK & 256) { run_phase<PH_GEMM_IN_ODD>(p, lo, smem); BAR(); }
        run_phase<PH_GLA_CHUNK>(p, lo, smem); BAR(); if (DUP_MASK & 1024) { run_phase<PH_GLA_CHUNK>(p, lo, smem); BAR(); }
        run_phase<PH_GLA_SCAN>(p, lo, smem); BAR(); if (DUP_MASK & 2048) { run_phase<PH_GLA_SCAN>(p, lo, smem); BAR(); }
        run_phase<PH_GLA_OUT>(p, lo, smem); BAR();
        run_phase<PH_GEMM_OUT>(p, lo, smem); BAR();
        run_phase<PH_NORM_FFN>(p, lo, smem); BAR();
        run_phase<PH_MOE1>(p, lo, smem); BAR(); if (DUP_MASK & 64) { run_phase<PH_MOE1>(p, lo, smem); BAR(); }
        run_phase<PH_MOE2>(p, lo, smem); BAR(); if (DUP_MASK & 128) { run_phase<PH_MOE2>(p, lo, smem); BAR(); }
    }
    for (int xb = 0; xb < EXTRA_BARS; ++xb) BAR();
    run_phase<PH_FINAL>(p, 0, smem);
}
#endif

}

#if MK_MULTI
template <int PH>
static void launch_phase(const Params& p, int layer, hipStream_t stream) {
    static bool attr_set = false;
    if (!attr_set) { hipFuncSetAttribute((const void*)k_phase<PH>, hipFuncAttributeMaxDynamicSharedMemorySize, (int)LDS_BYTES); attr_set = true; }
    hipLaunchKernelGGL((k_phase<PH>), dim3(256), dim3(NTHREADS), LDS_BYTES, stream, p, layer);
}
#endif

extern "C" void kernel_launch(void* const* d_in, const int* in_sizes, int n_in, void* d_out, int out_size, void* d_ws, size_t ws_size, hipStream_t stream) {
    (void)in_sizes; (void)n_in; (void)out_size;
    if (ws_size < WS_NEEDED) { fprintf(stderr, "workspace too small: %zu < %zu\n", ws_size, (size_t)WS_NEEDED); return; }
    Params p{};
    p.x = (const float*)d_in[0]; p.c = (const float*)d_in[1]; p.pos = (const int*)d_in[2]; p.ada_w = (const float*)d_in[3]; p.ada_b = (const float*)d_in[4];
    p.norm_mix = (const float*)d_in[5]; p.norm_ffn = (const float*)d_in[6]; p.even_w_in = (const float*)d_in[7]; p.conv_w = (const float*)d_in[8];
    p.a_log = (const float*)d_in[9]; p.dt_bias = (const float*)d_in[10]; p.gdn_out_norm = (const float*)d_in[11]; p.even_w_out = (const float*)d_in[12];
    p.gla_w_in = (const float*)d_in[13]; p.gla_w_gate2 = (const float*)d_in[14]; p.gla_b_gate2 = (const float*)d_in[15]; p.gla_out_norm = (const float*)d_in[16]; p.gla_w_out = (const float*)d_in[17];
    p.rg_w = (const float*)d_in[18]; p.rg_b = (const float*)d_in[19]; p.re_w = (const float*)d_in[20]; p.re_b = (const float*)d_in[21];
    p.w1 = (const float*)d_in[22]; p.w3 = (const float*)d_in[23]; p.w2 = (const float*)d_in[24]; p.final_norm = (const float*)d_in[25];
    p.X = (float*)d_out; p.ws = (unsigned char*)d_ws;
    p.rA = pow(10000.0, -2.0 / 128.0); p.rI = pow(10000.0, -2.0 / 64.0);
    hipMemsetAsync(d_ws, 0, ZERO_BYTES, stream);
#if MK_MULTI
    launch_phase<PH_PROLOGUE>(p, 0, stream);
    for (int lp = 0; lp < 2; ++lp) {
        const int le = 2 * lp, lo = 2 * lp + 1;
        launch_phase<PH_NORM_MIX>(p, le, stream);
        launch_phase<PH_GEMM_IN_EVEN>(p, le, stream);
        launch_phase<PH_EVEN_TOK>(p, le, stream);
        launch_phase<PH_GDN_SCAN>(p, le, stream);
        launch_phase<PH_DSA_ATTN>(p, le, stream);
        launch_phase<PH_GEMM_OUT>(p, le, stream);
        launch_phase<PH_NORM_FFN>(p, le, stream);
        launch_phase<PH_MOE1>(p, le, stream);
        launch_phase<PH_MOE2>(p, le, stream);
        launch_phase<PH_NORM_MIX>(p, lo, stream);
        launch_phase<PH_GEMM_IN_ODD>(p, lo, stream);
        launch_phase<PH_GLA_CHUNK>(p, lo, stream);
        launch_phase<PH_GLA_SCAN>(p, lo, stream);
        launch_phase<PH_GLA_OUT>(p, lo, stream);
        launch_phase<PH_GEMM_OUT>(p, lo, stream);
        launch_phase<PH_NORM_FFN>(p, lo, stream);
        launch_phase<PH_MOE1>(p, lo, stream);
        launch_phase<PH_MOE2>(p, lo, stream);
    }
    launch_phase<PH_FINAL>(p, 0, stream);
#else
    static int grid = 0;
    if (!grid) {
        int dev = 0, cus = 0, per_cu = 0;
        hipGetDevice(&dev);
        hipDeviceGetAttribute(&cus, hipDeviceAttributeMultiprocessorCount, dev);
        hipFuncSetAttribute((const void*)k_mega, hipFuncAttributeMaxDynamicSharedMemorySize, (int)LDS_BYTES);
        hipOccupancyMaxActiveBlocksPerMultiprocessor(&per_cu, k_mega, NTHREADS, LDS_BYTES);
        if (cus <= 0) cus = 256;
        grid = cus * (per_cu < 1 ? 1 : 1);
    }
    hipLaunchKernelGGL(k_mega, dim3(grid), dim3(NTHREADS), LDS_BYTES, stream, p);
#endif
}
```

```cpp
#include <hip/hip_runtime.h>
#include <stdint.h>
#include <math.h>
#include <stdio.h>

#define EXTRA_BARS 0
#define REP_A 1
#define REP_B 1
#define REP_C 1
#ifndef DUP_MASK
#define DUP_MASK 0
#endif
#ifndef MK_MULTI
#define MK_MULTI 0
#endif

namespace {

constexpr int NT = 16384, ND = 1024, LDP = 3920, LDPB = 3968;
constexpr float EPS = 1e-6f;
constexpr int NTHREADS = 512;
constexpr size_t LDS_BYTES = 147456;
constexpr float SCALE128 = 0.08838834764831845f;
constexpr int LISTCAP = 32768;
constexpr int CSTR = 16;

constexpr size_t OFF_BAR  = 0;
constexpr size_t OFF_CNT  = 16384;
constexpr size_t ZERO_BYTES = 32768;
constexpr size_t OFF_QCTR = 28672;
constexpr size_t OFF_MOD  = 32768;
constexpr size_t OFF_COSA = OFF_MOD + 4 * 2 * 6144 * 4;
constexpr size_t OFF_SINA = OFF_COSA + (size_t)NT * 64 * 4;
constexpr size_t OFF_COSI = OFF_SINA + (size_t)NT * 64 * 4;
constexpr size_t OFF_SINI = OFF_COSI + (size_t)NT * 32 * 4;
constexpr size_t OFF_H    = OFF_SINI + (size_t)NT * 32 * 4;
constexpr size_t OFF_P    = OFF_H + (size_t)NT * 1024 * 4;
constexpr size_t OFF_HID  = OFF_P;
constexpr size_t OFF_YB   = OFF_HID + (size_t)36864 * 512 * 4;
constexpr size_t OFF_O    = OFF_P + (size_t)NT * LDP * 4;
constexpr size_t OFF_ASG  = OFF_O + (size_t)NT * 1024 * 4;
constexpr size_t OFF_GATE = OFF_ASG + (size_t)NT * 4 * 4;
constexpr size_t OFF_LIST = OFF_GATE + (size_t)NT * 2 * 4;
constexpr size_t OFF_R    = OFF_LIST + (size_t)32 * LISTCAP * 4;
constexpr size_t OFF_QN   = OFF_R;
constexpr size_t OFF_KN   = OFF_QN + (size_t)NT * 512 * 4;
constexpr size_t OFF_VC   = OFF_KN + (size_t)NT * 512 * 4;
constexpr size_t OFF_BETA = OFF_VC + (size_t)NT * 512 * 4;
constexpr size_t OFF_G    = OFF_BETA + (size_t)NT * 4 * 4;
constexpr size_t OFF_W    = OFF_G + (size_t)NT * 4 * 4;
constexpr size_t OFF_U    = OFF_W + (size_t)1024 * 8192 * 4;
constexpr size_t OFF_QG   = OFF_U + (size_t)1024 * 8192 * 4;
constexpr size_t OFF_KD   = OFF_QG + (size_t)1024 * 8192 * 4;
constexpr size_t OFF_AQK  = OFF_KD + (size_t)1024 * 8192 * 4;
constexpr size_t OFF_GL   = OFF_AQK + (size_t)1024 * 4096 * 4;
constexpr size_t OFF_QB   = OFF_GL + 4096;
constexpr size_t OFF_KB   = OFF_QB + (size_t)NT * 512 * 4;
constexpr size_t OFF_QI   = OFF_KB + (size_t)NT * 512 * 4;
constexpr size_t OFF_KI   = OFF_QI + (size_t)NT * 256 * 4;
constexpr size_t OFF_WI   = OFF_KI + (size_t)NT * 64 * 4;
constexpr size_t OFF_SEL  = OFF_WI + (size_t)NT * 4 * 4;
constexpr size_t OFF_EVEN_END = OFF_SEL + (size_t)NT * 256 * 4;
constexpr size_t OFF_PFR  = OFF_W;
constexpr size_t OFF_RFR  = OFF_PFR + (size_t)1024 * 32768;
constexpr size_t OFF_QFR  = OFF_RFR + (size_t)1024 * 16384;
constexpr size_t OFF_OFR  = OFF_QFR + (size_t)1024 * 32768;
static_assert(OFF_OFR + (size_t)1024 * 16384 <= OFF_GL, "gdn v2 buffers overflow");
constexpr size_t OFF_QBB  = OFF_QB;
constexpr size_t OFF_KBB  = OFF_QBB + (size_t)NT * 512 * 2;
constexpr size_t OFF_VT   = OFF_KBB + (size_t)NT * 512 * 2;
constexpr size_t OFF_QIB  = OFF_VT + (size_t)NT * 512 * 2;
constexpr size_t OFF_KIB  = OFF_QIB + (size_t)NT * 256 * 2;
constexpr size_t OFF_M16  = OFF_KIB + (size_t)NT * 64 * 2;
static_assert(OFF_M16 + (size_t)NT * 512 * 2 <= OFF_WI, "dsa v2 buffers overflow");
constexpr size_t OFF_LA   = OFF_R;
constexpr size_t OFF_ATT  = OFF_LA + (size_t)NT * 512 * 4;
constexpr size_t OFF_QE   = OFF_ATT + (size_t)1024 * 4096 * 4;
constexpr size_t OFF_GKD  = OFF_QE + (size_t)1024 * 8192 * 4;
constexpr size_t OFF_EBL  = OFF_GKD + (size_t)1024 * 8192 * 4;
constexpr size_t OFF_GQE  = OFF_LA + (size_t)NT * 512 * 4;
constexpr size_t OFF_GOI  = OFF_GQE + (size_t)1024 * 16384;
constexpr size_t OFF_GH   = OFF_GOI + (size_t)1024 * 32768;
constexpr size_t OFF_GEBL = OFF_GH + (size_t)1024 * 65536;
static_assert(OFF_GEBL + (size_t)1024 * 512 <= OFF_EVEN_END, "gla v2 buffers overflow");
constexpr size_t OFF_WINE = OFF_EVEN_END;
constexpr size_t OFF_WINO = OFF_WINE + (size_t)2 * 4096 * 1024 * 2;
constexpr size_t OFF_WOUT = OFF_WINO + (size_t)2 * 3200 * 1024 * 2;
constexpr size_t OFF_W13  = OFF_WOUT + (size_t)4 * 1024 * 1024 * 2;
constexpr size_t OFF_W2T  = OFF_W13 + (size_t)32 * 1024 * 1024 * 2;
constexpr size_t OFF_OB   = OFF_W2T + (size_t)32 * 1024 * 512 * 2;
constexpr size_t OFF_AUX  = OFF_OB + (size_t)NT * 1024 * 2;
constexpr size_t OFF_WGL  = OFF_AUX + (size_t)NT * 16 * 4;
constexpr size_t WS_NEEDED = OFF_WGL + (size_t)2 * 128 * 1024 * 2;

struct Params {
    const float* x; const float* c; const int* pos; const float* ada_w; const float* ada_b;
    const float* norm_mix; const float* norm_ffn; const float* even_w_in; const float* conv_w;
    const float* a_log; const float* dt_bias; const float* gdn_out_norm; const float* even_w_out;
    const float* gla_w_in; const float* gla_w_gate2; const float* gla_b_gate2; const float* gla_out_norm; const float* gla_w_out;
    const float* rg_w; const float* rg_b; const float* re_w; const float* re_b;
    const float* w1; const float* w3; const float* w2; const float* final_norm;
    float* X;
    unsigned char* ws;
    double rA, rI;
};

#define XB_TMO      128
#define XB_XCNT(j)  (256  + 64 * (j))
#define XB_XSUB(j)  (1280 + 64 * (j))
#define XB_XGEN(j)  (2304 + 64 * (j))
#define XB_TOP      3328
#define XB_TOPGEN   3392
#define XCD_BAR_WORDS 3456
#define XB_SPIN_CAP (1u << 18)
#define LAS __attribute__((address_space(3)))

__device__ __forceinline__ unsigned xb_ld(unsigned* p)              { return __hip_atomic_load(p, __ATOMIC_RELAXED, __HIP_MEMORY_SCOPE_AGENT); }
__device__ __forceinline__ unsigned xb_add(unsigned* p, unsigned v) { return __hip_atomic_fetch_add(p, v, __ATOMIC_RELAXED, __HIP_MEMORY_SCOPE_AGENT); }
__device__ __forceinline__ unsigned xb_xcc_id() { return (unsigned)__builtin_amdgcn_s_getreg((3 << 11) | 20) & 0xFu; }
#define XB_SPIN(cond, bar) do { unsigned _sp = 0; while (cond) { __builtin_amdgcn_s_sleep(1); \
    if ((++_sp & 255u) == 0u) { if (xb_ld(&(bar)[XB_TMO])) break; if (_sp > XB_SPIN_CAP) { atomicAdd(&(bar)[XB_TMO], 1u); break; } } } } while (0)

struct XcdBarrier { unsigned* bar; unsigned x; volatile LAS unsigned* st; };

__device__ __forceinline__ XcdBarrier xcd_barrier_post(unsigned* bar, volatile LAS unsigned* st) {
    XcdBarrier b; b.bar = bar; b.x = xb_xcc_id(); b.st = st;
    if (threadIdx.x == 0) (void)xb_add(&bar[XB_XCNT(b.x)], 1u);
    return b;
}
__device__ __forceinline__ void xcd_barrier_complete(unsigned* bar, unsigned x, unsigned& nloc, unsigned& nx) {
    const unsigned G = gridDim.x * gridDim.y * gridDim.z;
    unsigned sum, cnt, mine, sp = 0u;
    for (;;) {
        sum = 0u; cnt = 0u; mine = 0u;
#pragma unroll
        for (unsigned j = 0; j < 16; ++j) { const unsigned c = xb_ld(&bar[XB_XCNT(j)]); sum += c; cnt += (c > 0u) ? 1u : 0u; mine = (j == x) ? c : mine; }
        if (sum == G) break;
        __builtin_amdgcn_s_sleep(1);
        if ((++sp & 255u) == 0u) { if (xb_ld(&bar[XB_TMO])) break; if (sp > XB_SPIN_CAP) { atomicAdd(&bar[XB_TMO], 1u); break; } }
    }
    nloc = mine > 0u ? mine : 1u; nx = cnt > 0u ? cnt : 1u;
}
__device__ __forceinline__ void xcd_barrier(const XcdBarrier& b) {
    asm volatile("s_waitcnt vmcnt(0)" ::: "memory");
    __syncthreads();
    if (threadIdx.x == 0) {
        unsigned* bar = b.bar;
        __builtin_amdgcn_s_waitcnt(0);
        unsigned nloc = b.st[0], nx = b.st[1];
        if (nloc == 0u) { xcd_barrier_complete(bar, b.x, nloc, nx); b.st[0] = nloc; b.st[1] = nx; }
        const unsigned old = xb_add(&bar[XB_XSUB(b.x)], 1u);
        const unsigned gen = old / nloc;
        if (old + 1u == (gen + 1u) * nloc) {
            __builtin_amdgcn_fence(__ATOMIC_RELEASE, "agent");
            asm volatile("s_waitcnt vmcnt(0)" ::: "memory");
            const unsigned og = xb_add(&bar[XB_TOP], 1u);
            const unsigned tg = og / nx;
            if (og + 1u == (tg + 1u) * nx) xb_add(&bar[XB_TOPGEN], 1u);
            else XB_SPIN(xb_ld(&bar[XB_TOPGEN]) == tg, bar);
            __builtin_amdgcn_fence(__ATOMIC_ACQUIRE, "agent");
            xb_add(&bar[XB_XGEN(b.x)], 1u);
            asm volatile("s_waitcnt vmcnt(0)" ::: "memory");
        } else {
            XB_SPIN(xb_ld(&bar[XB_XGEN(b.x)]) == gen, bar);
            __builtin_amdgcn_fence(__ATOMIC_ACQUIRE, "agent");
            asm volatile("s_waitcnt vmcnt(0)" ::: "memory");
        }
    }
    __syncthreads();
}

__device__ __forceinline__ float wave_sum(float v) {
#pragma unroll
    for (int o = 32; o > 0; o >>= 1) v += __shfl_xor(v, o);
    return v;
}
__device__ __forceinline__ int wave_sum_i(int v) {
#pragma unroll
    for (int o = 32; o > 0; o >>= 1) v += __shfl_xor(v, o);
    return v;
}
__device__ __forceinline__ float wave_max(float v) {
#pragma unroll
    for (int o = 32; o > 0; o >>= 1) v = fmaxf(v, __shfl_xor(v, o));
    return v;
}
__device__ __forceinline__ float sigmoidf_(float x) { return 1.f / (1.f + expf(-x)); }
__device__ __forceinline__ float siluf_(float x) { return x / (1.f + expf(-x)); }
__device__ __forceinline__ float softplusf_(float x) { return fmaxf(x, 0.f) + log1pf(expf(-fabsf(x))); }
__device__ __forceinline__ unsigned ordkey(float f) { const unsigned u = __float_as_uint(f); return (u & 0x80000000u) ? ~u : (u | 0x80000000u); }

__device__ __forceinline__ void sincos_d(double a, double& s, double& c) {
    const double kq = rint(a * 0.63661977236758134308);
    double r = fma(-kq, 1.57079632673412561417e+00, a);
    r = fma(-kq, 6.07710050650619224932e-11, r);
    const int q = (int)((long long)kq & 3);
    const double r2 = r * r;
    const double sp = r * (1.0 + r2 * (-1.0 / 6 + r2 * (1.0 / 120 + r2 * (-1.0 / 5040 + r2 * (1.0 / 362880 + r2 * (-1.0 / 39916800 + r2 * (1.0 / 6227020800.0)))))));
    const double cp = 1.0 + r2 * (-0.5 + r2 * (1.0 / 24 + r2 * (-1.0 / 720 + r2 * (1.0 / 40320 + r2 * (-1.0 / 3628800 + r2 * (1.0 / 479001600.0 + r2 * (-1.0 / 87178291200.0)))))));
    if (q == 0) { s = sp; c = cp; } else if (q == 1) { s = cp; c = -sp; } else if (q == 2) { s = -sp; c = -cp; } else { s = -cp; c = sp; }
}
__device__ __forceinline__ double ipow_d(double b, int e) { double v = 1.0; while (e) { if (e & 1) v *= b; b *= b; e >>= 1; } return v; }

struct GemmArgs { const float* A; int lda; const int* rows; int m0; int mvalid; const float* B; int ldb; int n0; int N; int K; };

template <class Epi>
__device__ __forceinline__ void gemm128(const GemmArgs& g, float* smem, Epi epi) {
    float* As = smem;
    float* Bs = smem + 16 * 132;
    int tid_ = threadIdx.x; asm volatile("" : "+v"(tid_)); const int tid = tid_, ty = tid >> 4, tx = tid & 15;
    const int arow = tid >> 2, kq = (tid & 3) * 4;
    const int bk = tid >> 5, bn = (tid & 31) * 4;
    long asrc = -1;
    if (arow < g.mvalid) { const int r = g.rows ? g.rows[arow] : (g.m0 + arow); if (r >= 0) asrc = (long)r * g.lda; }
    const bool bval = (g.n0 + bn) < g.N;
    float acc[4][8];
#pragma unroll
    for (int i = 0; i < 4; ++i)
#pragma unroll
        for (int j = 0; j < 8; ++j) acc[i][j] = 0.f;
    for (int k0 = 0; k0 < g.K; k0 += 16) {
        float4 av = make_float4(0.f, 0.f, 0.f, 0.f), bv = make_float4(0.f, 0.f, 0.f, 0.f);
        if (asrc >= 0) av = *(const float4*)(g.A + asrc + k0 + kq);
        if (bval) bv = *(const float4*)(g.B + (size_t)(k0 + bk) * g.ldb + g.n0 + bn);
        __syncthreads();
        As[(kq + 0) * 132 + arow] = av.x; As[(kq + 1) * 132 + arow] = av.y; As[(kq + 2) * 132 + arow] = av.z; As[(kq + 3) * 132 + arow] = av.w;
        *(float4*)&Bs[bk * 132 + bn] = bv;
        __syncthreads();
#pragma unroll
        for (int kk = 0; kk < 16; ++kk) {
            const float4 a = *(const float4*)&As[kk * 132 + ty * 4];
            const float4 b0 = *(const float4*)&Bs[kk * 132 + tx * 8];
            const float4 b1 = *(const float4*)&Bs[kk * 132 + tx * 8 + 4];
            const float aa[4] = {a.x, a.y, a.z, a.w};
            const float bb[8] = {b0.x, b0.y, b0.z, b0.w, b1.x, b1.y, b1.z, b1.w};
#pragma unroll
            for (int i = 0; i < 4; ++i)
#pragma unroll
                for (int j = 0; j < 8; ++j) acc[i][j] += aa[i] * bb[j];
        }
    }
#pragma unroll
    for (int i = 0; i < 4; ++i) {
        const int r = ty * 4 + i;
        if (r < g.mvalid) {
#pragma unroll
            for (int j = 0; j < 8; ++j) { const int n = g.n0 + tx * 8 + j; if (n < g.N) epi(r, n, acc[i][j]); }
        }
    }
}


typedef short bf16x8 __attribute__((ext_vector_type(8)));
typedef float f32x4 __attribute__((ext_vector_type(4)));
typedef unsigned short bf16_t;
typedef __bf16 bf16x2_t __attribute__((ext_vector_type(2)));
typedef float f32x2_t __attribute__((ext_vector_type(2)));
__device__ __forceinline__ unsigned cvt_pk_bf16(float lo, float hi) { const f32x2_t v = {lo, hi}; const bf16x2_t r = __builtin_convertvector(v, bf16x2_t); return __builtin_bit_cast(unsigned, r); }
__device__ __forceinline__ bf16_t f2bf(float f) { return (bf16_t)(cvt_pk_bf16(f, 0.f) & 0xffffu); }
__device__ __forceinline__ float bf16_to_f32(bf16_t v) { return __uint_as_float(((unsigned)v) << 16); }
__device__ __forceinline__ uint2 pack4(const f32x4 v) { uint2 r; r.x = cvt_pk_bf16(v[0], v[1]); r.y = cvt_pk_bf16(v[2], v[3]); return r; }
__device__ __forceinline__ f32x4 unpack4(const uint2 u) { f32x4 r; r[0] = __uint_as_float(u.x << 16); r[1] = __uint_as_float(u.x & 0xffff0000u); r[2] = __uint_as_float(u.y << 16); r[3] = __uint_as_float(u.y & 0xffff0000u); return r; }
#define PBF(Pb_, t_, c_) bf16_to_f32((Pb_)[(size_t)(t_) * LDPB + (c_)])
__device__ __forceinline__ uint4 pack8(const float4 a, const float4 b) { uint4 r; r.x = cvt_pk_bf16(a.x, a.y); r.y = cvt_pk_bf16(a.z, a.w); r.z = cvt_pk_bf16(b.x, b.y); r.w = cvt_pk_bf16(b.z, b.w); return r; }
__device__ __forceinline__ int lds_off(int r, int c) { return r * 128 + ((c ^ (r & 7)) << 4); }

template <class ALoad, class BLoad, class Epi>
__device__ __forceinline__ void gemm_tile_bf16(const int K, unsigned char* lds, ALoad aload, BLoad bload, Epi epi, const int mrows = 256) {
    int tid_ = threadIdx.x; asm volatile("" : "+v"(tid_)); const int tid = tid_, lane = tid & 63, wid = tid >> 6, wm = wid >> 1, wn = wid & 1;
    f32x4 acc[4][4];
#pragma unroll
    for (int mi = 0; mi < 4; ++mi)
#pragma unroll
        for (int ni = 0; ni < 4; ++ni) acc[mi][ni] = (f32x4){0.f, 0.f, 0.f, 0.f};
    uint4 ra[4], rb[2];
    const int nk = K >> 6;
#pragma unroll
    for (int i = 0; i < 4; ++i) { const int q = tid + 512 * i; ra[i] = aload(i, q >> 3, (q & 7) * 8); }
#pragma unroll
    for (int i = 0; i < 2; ++i) { const int q = tid + 512 * i; rb[i] = bload(i, q >> 3, (q & 7) * 8); }
    __syncthreads();
#pragma unroll
    for (int i = 0; i < 4; ++i) { const int q = tid + 512 * i; *(uint4*)(lds + lds_off(q >> 3, q & 7)) = ra[i]; }
#pragma unroll
    for (int i = 0; i < 2; ++i) { const int q = tid + 512 * i; *(uint4*)(lds + 32768 + lds_off(q >> 3, q & 7)) = rb[i]; }
    __syncthreads();
    for (int kt = 0; kt < nk; ++kt) {
        if (kt + 1 < nk) {
#pragma unroll
            for (int i = 0; i < 4; ++i) { const int q = tid + 512 * i; ra[i] = aload(i, q >> 3, (kt + 1) * 64 + (q & 7) * 8); }
#pragma unroll
            for (int i = 0; i < 2; ++i) { const int q = tid + 512 * i; rb[i] = bload(i, q >> 3, (kt + 1) * 64 + (q & 7) * 8); }
        }
        const unsigned char* At = lds + (kt & 1) * 49152;
        const unsigned char* Bt = At + 32768;
        if (__builtin_amdgcn_readfirstlane(wm) * 64 < mrows) {
#pragma unroll
        for (int ks = 0; ks < 2; ++ks) {
            bf16x8 af[4], bfr[4];
            const int c = ks * 4 + (lane >> 4);
#pragma unroll
            for (int mi = 0; mi < 4; ++mi) af[mi] = *(const bf16x8*)(At + lds_off(wm * 64 + mi * 16 + (lane & 15), c));
#pragma unroll
            for (int ni = 0; ni < 4; ++ni) bfr[ni] = *(const bf16x8*)(Bt + lds_off(wn * 64 + ni * 16 + (lane & 15), c));
            __builtin_amdgcn_s_setprio(1);
#pragma unroll
            for (int mi = 0; mi < 4; ++mi)
#pragma unroll
                for (int ni = 0; ni < 4; ++ni) acc[mi][ni] = __builtin_amdgcn_mfma_f32_16x16x32_bf16(bfr[ni], af[mi], acc[mi][ni], 0, 0, 0);
            __builtin_amdgcn_s_setprio(0);
        }
        }
        if (kt + 1 < nk) {
            unsigned char* An = lds + ((kt + 1) & 1) * 49152;
#pragma unroll
            for (int i = 0; i < 4; ++i) { const int q = tid + 512 * i; *(uint4*)(An + lds_off(q >> 3, q & 7)) = ra[i]; }
#pragma unroll
            for (int i = 0; i < 2; ++i) { const int q = tid + 512 * i; *(uint4*)(An + 32768 + lds_off(q >> 3, q & 7)) = rb[i]; }
        }
        __syncthreads();
    }
    epi(acc, wm, wn, lane);
}

__device__ __forceinline__ void convert_tile(const float* src0, const float* src1, int mode, int K, int N, int ld, bf16_t* dst, int rt, int kt, float* smem) {
    int tid_ = threadIdx.x; asm volatile("" : "+v"(tid_)); const int tid = tid_;
    __syncthreads();
    { const int k = tid >> 3, R0 = rt * 64 + (tid & 7) * 8;
      const float* sp; int col;
      if (mode == 0) { sp = src0; col = R0; } else { sp = (R0 & 32) ? src1 : src0; col = (R0 >> 6) * 32 + (R0 & 31); }
      float4 a = make_float4(0.f, 0.f, 0.f, 0.f), b = a;
      const float* rp = sp + (size_t)(kt * 64 + k) * ld + col;
      if (col < N) a = *(const float4*)rp;
      if (col + 4 < N) b = *(const float4*)(rp + 4);
      float* d = smem + k * 65 + (tid & 7) * 8;
      d[0] = a.x; d[1] = a.y; d[2] = a.z; d[3] = a.w; d[4] = b.x; d[5] = b.y; d[6] = b.z; d[7] = b.w; }
    __syncthreads();
    { const int R = tid >> 3, kc = (tid & 7) * 8;
      float v[8];
#pragma unroll
      for (int j = 0; j < 8; ++j) v[j] = smem[(kc + j) * 65 + R];
      uint4 o; o.x = cvt_pk_bf16(v[0], v[1]); o.y = cvt_pk_bf16(v[2], v[3]); o.z = cvt_pk_bf16(v[4], v[5]); o.w = cvt_pk_bf16(v[6], v[7]);
      *(uint4*)(dst + (size_t)(rt * 64 + R) * K + kt * 64 + kc) = o; }
}

#define CT_LOAD(S0, S1, MODE, NN, LD, RT, KT, A, B) do { const int k_ = tid >> 3, R0_ = (RT) * 64 + (tid & 7) * 8; const float* sp_; int col_; \
        if ((MODE) == 0) { sp_ = (S0); col_ = R0_; } else { sp_ = (R0_ & 16) ? (S1) : (S0); col_ = (R0_ >> 5) * 16 + (R0_ & 15); } \
        A = make_float4(0.f, 0.f, 0.f, 0.f); B = A; const float* rp_ = sp_ + (size_t)((KT) * 64 + k_) * (LD) + col_; \
        if (col_ < (NN)) A = *(const float4*)rp_; if (col_ + 4 < (NN)) B = *(const float4*)(rp_ + 4); } while (0)
#define CT_WRITE(BUF, A, B) do { float* d_ = smem + (BUF) * 4160 + (tid >> 3) * 65 + (tid & 7) * 8; \
        d_[0] = A.x; d_[1] = A.y; d_[2] = A.z; d_[3] = A.w; d_[4] = B.x; d_[5] = B.y; d_[6] = B.z; d_[7] = B.w; } while (0)
#define CT_STORE(DST, KK, RT, KT, BUF) do { const int R_ = tid >> 3, kc_ = (tid & 7) * 8; const float* sb_ = smem + (BUF) * 4160; \
        uint4 o_; o_.x = cvt_pk_bf16(sb_[(kc_ + 0) * 65 + R_], sb_[(kc_ + 1) * 65 + R_]); o_.y = cvt_pk_bf16(sb_[(kc_ + 2) * 65 + R_], sb_[(kc_ + 3) * 65 + R_]); \
        o_.z = cvt_pk_bf16(sb_[(kc_ + 4) * 65 + R_], sb_[(kc_ + 5) * 65 + R_]); o_.w = cvt_pk_bf16(sb_[(kc_ + 6) * 65 + R_], sb_[(kc_ + 7) * 65 + R_]); \
        *(uint4*)((DST) + (size_t)((RT) * 64 + R_) * (KK) + (KT) * 64 + kc_) = o_; } while (0)
#define CT_DECL(I) const float* s0_##I; const float* s1_##I; bf16_t* d_##I; int md_##I, K_##I, N_##I, ld_##I, rt_##I, kt_##I
#define CT_ARGS(I) s0_##I, s1_##I, d_##I, md_##I, K_##I, N_##I, ld_##I, rt_##I, kt_##I
template <class Dec>
__device__ __forceinline__ void convert_tiles4(const Dec& dec, int t, int nj, float* smem) {
    int tid_ = threadIdx.x; asm volatile("" : "+v"(tid_)); const int tid = tid_;
    CT_DECL(0); CT_DECL(1); CT_DECL(2); CT_DECL(3);
    dec(t, CT_ARGS(0)); dec(t + 1, CT_ARGS(1)); dec(t + 2, CT_ARGS(2)); dec(t + 3, CT_ARGS(3));
    float4 a0, b0, a1, b1, a2, b2, a3, b3;
    a1 = b1 = a2 = b2 = a3 = b3 = make_float4(0.f, 0.f, 0.f, 0.f);
    CT_LOAD(s0_0, s1_0, md_0, N_0, ld_0, rt_0, kt_0, a0, b0);
    if (nj > 1) CT_LOAD(s0_1, s1_1, md_1, N_1, ld_1, rt_1, kt_1, a1, b1);
    if (nj > 2) CT_LOAD(s0_2, s1_2, md_2, N_2, ld_2, rt_2, kt_2, a2, b2);
    if (nj > 3) CT_LOAD(s0_3, s1_3, md_3, N_3, ld_3, rt_3, kt_3, a3, b3);
    __syncthreads();
    CT_WRITE(0, a0, b0); CT_WRITE(1, a1, b1); CT_WRITE(2, a2, b2); CT_WRITE(3, a3, b3);
    __syncthreads();
    CT_STORE(d_0, K_0, rt_0, kt_0, 0);
    if (nj > 1) CT_STORE(d_1, K_1, rt_1, kt_1, 1);
    if (nj > 2) CT_STORE(d_2, K_2, rt_2, kt_2, 2);
    if (nj > 3) CT_STORE(d_3, K_3, rt_3, kt_3, 3);
}


namespace pg8 {
constexpr int BM = 256, BK = 64, HALF = 128, HTB = HALF * BK * 2, STAGE_BYTES = 8 * HTB;
__host__ __device__ __forceinline__ int lds_byte(int r, int c) { const int st = (r >> 4) * 2 + (c >> 5), rr = r & 15, cc = c & 31, ob = rr * 64 + cc * 2; return st * 1024 + (ob ^ (((ob >> 9) & 1) << 5)); }
__host__ __device__ __forceinline__ void stage_rc(int b, int& R, int& C) { const int st = b / 1024, sb = b % 1024, swz = sb ^ (((sb >> 9) & 1) << 5); R = (st >> 1) * 16 + swz / 64; C = (st & 1) * 32 + (swz % 64) / 2; }
__host__ __device__ __forceinline__ int perm32(int rho) { const int n = rho >> 4, i = rho & 15; return 8 * (i >> 2) + 4 * n + (i & 3); }

struct Unit { size_t aoff, boff; int pm, pn, e, mvalid, rowbase, mi; };
template <class Epi, class Sched, bool GATHER>
__device__ __forceinline__ void gemm_phase(LAS unsigned char* lds, const bf16_t* Abase, const bf16_t* Bbase, const int K, const Sched& S, const Epi& E) {
    int tid_ = threadIdx.x; asm volatile("" : "+v"(tid_));
    const int tid = tid_, wid = __builtin_amdgcn_readfirstlane(tid >> 6), lane = tid & 63, wr = wid >> 2, wc = wid & 3, fr = lane & 15, fq = lane >> 4;
    const int nt = K / BK;
    int sR[2], sC[2]; unsigned voffB[2];
#pragma unroll
    for (int i = 0; i < 2; ++i) { int R, C; stage_rc(tid * 16 + i * 8192, R, C); sR[i] = R; sC[i] = C; const int Rb = Epi::PERM ? ((R & ~31) + perm32(R & 31)) : R; voffB[i] = (unsigned)(Rb * K + C) * 2u; }
    const size_t kstep = (size_t)(BK * 2);
    const size_t hstep = (size_t)HALF * K * 2;
    const unsigned ldsw = (unsigned)wid * 1024u;
    const int aoff = lds_byte(wr * 64 + fr, fq * 8), boff = lds_byte(wc * 32 + fr, fq * 8);
#define PG8_SA(b, h) (((b) * 2 + (h)) * HTB)
#define PG8_SB(b, h) ((4 + (b) * 2 + (h)) * HTB)
#define PG8_STAGE(bufoff, gbase, voff) do { _Pragma("unroll") for (int _i = 0; _i < 2; ++_i) \
        __builtin_amdgcn_global_load_lds((const unsigned*)((const char*)(gbase) + (voff)[_i]), (LAS unsigned*)(lds + (bufoff) + ldsw + _i * 8192), 16, 0, 0); } while (0)
#define PG8_LDA(dst, b, h) do { _Pragma("unroll") for (int m = 0; m < 4; ++m) _Pragma("unroll") for (int k = 0; k < 2; ++k) dst[m][k] = *(const LAS bf16x8*)(lds + PG8_SA(b, h) + aoff + m * 2048 + k * 1024); } while (0)
#define PG8_LDB(dst, b, h) do { _Pragma("unroll") for (int n = 0; n < 2; ++n) _Pragma("unroll") for (int k = 0; k < 2; ++k) dst[n][k] = *(const LAS bf16x8*)(lds + PG8_SB(b, h) + boff + n * 2048 + k * 1024); } while (0)
#define PG8_MMA(ai, bj, At, Bt) do { __builtin_amdgcn_s_setprio(1); _Pragma("unroll") for (int m = 0; m < 4; ++m) _Pragma("unroll") for (int n = 0; n < 2; ++n) _Pragma("unroll") for (int k = 0; k < 2; ++k) \
        acc[ai][bj][m][n] = __builtin_amdgcn_mfma_f32_16x16x32_bf16(Bt[n][k], At[m][k], acc[ai][bj][m][n], 0, 0, 0); __builtin_amdgcn_s_setprio(0); } while (0)
#define PG8_WAIT_V(n) asm volatile("s_waitcnt vmcnt(" #n ")" ::: "memory")
#define PG8_WAIT_L(n) asm volatile("s_waitcnt lgkmcnt(" #n ")" ::: "memory")
#define PG8_BAR __builtin_amdgcn_s_barrier()
#define PG8_SCHED __builtin_amdgcn_sched_barrier(0)
#define PG8_AVOFF(U, V0, V1) do { _Pragma("unroll") for (int _i = 0; _i < 2; ++_i) { \
        if (GATHER) { V0[_i] = (unsigned)((size_t)S.row(U, sR[_i]) * K + sC[_i]) * 2u; V1[_i] = (unsigned)((size_t)S.row(U, 128 + sR[_i]) * K + sC[_i]) * 2u; } \
        else { V0[_i] = (unsigned)(sR[_i] * K + sC[_i]) * 2u; V1[_i] = V0[_i] + (unsigned)hstep; } } } while (0)
    Unit cur, nxt; int ui = 0;
    if (!S.next(0, cur)) return;
    f32x4 acc[2][2][4][2];
#pragma unroll
    for (int a = 0; a < 2; ++a)
#pragma unroll
        for (int b = 0; b < 2; ++b)
#pragma unroll
            for (int m = 0; m < 4; ++m)
#pragma unroll
                for (int n = 0; n < 2; ++n) acc[a][b][m][n] = (f32x4){0.f, 0.f, 0.f, 0.f};
    bf16x8 At[4][2], B0[2][2], B1[2][2];
    unsigned cv0[2], cv1[2], nv0[2], nv1[2];
    PG8_AVOFF(cur, cv0, cv1);
    const char* cA = (const char*)Abase + cur.aoff; const char* cB = (const char*)Bbase + cur.boff;
    PG8_STAGE(PG8_SB(0, 0), cB, voffB); PG8_STAGE(PG8_SA(0, 0), cA, cv0); PG8_STAGE(PG8_SB(0, 1), cB + hstep, voffB); PG8_STAGE(PG8_SA(0, 1), cA, cv1);
    if (wr == 1) PG8_BAR;
    PG8_WAIT_V(4); PG8_BAR;
    PG8_STAGE(PG8_SB(1, 0), cB + kstep, voffB); PG8_STAGE(PG8_SA(1, 0), cA + kstep, cv0); PG8_STAGE(PG8_SB(1, 1), cB + hstep + kstep, voffB);
    PG8_WAIT_V(6); PG8_BAR;
    for (;;) {
        const bool has_next = S.next(ui + 1, nxt);
        const char* nA = has_next ? (const char*)Abase + nxt.aoff : cA; const char* nB = has_next ? (const char*)Bbase + nxt.boff : cB;
        if (has_next) { PG8_AVOFF(nxt, nv0, nv1); } else { nv0[0] = cv0[0]; nv0[1] = cv0[1]; nv1[0] = cv1[0]; nv1[1] = cv1[1]; }
        for (int t = 0; t < nt; t += 2) {
            const bool last = (t == nt - 2);
            const char* a1 = cA + (size_t)(t + 1) * kstep;
            const char* a2 = last ? nA : cA + (size_t)(t + 2) * kstep; const char* b2 = last ? nB : cB + (size_t)(t + 2) * kstep;
            const char* a3 = a2 + kstep; const char* b3 = b2 + kstep;
            unsigned sv0[2], sv1[2];
            sv0[0] = last ? nv0[0] : cv0[0]; sv0[1] = last ? nv0[1] : cv0[1]; sv1[0] = last ? nv1[0] : cv1[0]; sv1[1] = last ? nv1[1] : cv1[1];
            PG8_LDB(B0, 0, 0); PG8_SCHED; PG8_LDA(At, 0, 0); PG8_STAGE(PG8_SA(1, 1), a1, cv1);
            PG8_WAIT_L(8); PG8_BAR; PG8_WAIT_L(0); PG8_MMA(0, 0, At, B0); PG8_BAR; PG8_SCHED;
            PG8_LDB(B1, 0, 1); PG8_STAGE(PG8_SB(0, 0), b2, voffB);
            PG8_BAR; PG8_WAIT_L(0); PG8_MMA(0, 1, At, B1); PG8_BAR;
            PG8_LDA(At, 0, 1); PG8_STAGE(PG8_SA(0, 0), a2, sv0);
            PG8_BAR; PG8_WAIT_L(0); PG8_MMA(1, 0, At, B0); PG8_BAR; PG8_SCHED;
            PG8_STAGE(PG8_SB(0, 1), b2 + hstep, voffB);
            PG8_WAIT_V(6); PG8_BAR; PG8_MMA(1, 1, At, B1); PG8_BAR;
            PG8_LDB(B0, 1, 0); PG8_SCHED; PG8_LDA(At, 1, 0); PG8_STAGE(PG8_SA(0, 1), a2, sv1);
            PG8_WAIT_L(8); PG8_BAR; PG8_WAIT_L(0); PG8_MMA(0, 0, At, B0); PG8_BAR; PG8_SCHED;
            PG8_LDB(B1, 1, 1); PG8_STAGE(PG8_SB(1, 0), b3, voffB);
            PG8_BAR; PG8_WAIT_L(0); PG8_MMA(0, 1, At, B1); PG8_BAR;
            PG8_LDA(At, 1, 1); PG8_STAGE(PG8_SA(1, 0), a3, sv0);
            PG8_BAR; PG8_WAIT_L(0); PG8_MMA(1, 0, At, B0); PG8_BAR; PG8_SCHED;
            PG8_STAGE(PG8_SB(1, 1), b3 + hstep, voffB);
            PG8_WAIT_V(6); PG8_BAR; PG8_MMA(1, 1, At, B1); PG8_BAR;
        }
        E(acc, cur, wr, wc, fr, fq);
        if (!has_next) break;
#pragma unroll
        for (int a = 0; a < 2; ++a)
#pragma unroll
            for (int b = 0; b < 2; ++b)
#pragma unroll
                for (int m = 0; m < 4; ++m)
#pragma unroll
                    for (int n = 0; n < 2; ++n) acc[a][b][m][n] = (f32x4){0.f, 0.f, 0.f, 0.f};
        cur = nxt; cA = nA; cB = nB; ++ui;
        cv0[0] = nv0[0]; cv0[1] = nv0[1]; cv1[0] = nv1[0]; cv1[1] = nv1[1];
    }
    PG8_WAIT_V(0);
    if (wr == 0) PG8_BAR;
    PG8_BAR;
#undef PG8_SA
#undef PG8_SB
#undef PG8_STAGE
#undef PG8_LDA
#undef PG8_LDB
#undef PG8_MMA
#undef PG8_WAIT_V
#undef PG8_WAIT_L
#undef PG8_BAR
#undef PG8_SCHED
#undef PG8_AVOFF
}
struct DenseOrder {
    int nM, nN, nwg, G, c, K;
    __device__ __forceinline__ void init(int nM_, int nN_, int G_, int c_, int K_) { nM = nM_; nN = nN_; nwg = nM * nN; G = G_; c = c_; K = K_; }
    __device__ __forceinline__ bool next(int i, Unit& u) const {
        const long L = (long)i * G + c; if (L >= nwg) return false;
        int wgid = (int)L; { const int q = nwg / 8, r = nwg % 8, xcd = wgid % 8, off = wgid / 8; wgid = (xcd < r ? xcd * (q + 1) : r * (q + 1) + (xcd - r) * q) + off; }
        const int nig = 8 * nN, gid = wgid / nig, fm = gid * 8, gsz = (nM - fm) < 8 ? (nM - fm) : 8;
        u.pm = fm + ((wgid % nig) % gsz); u.pn = (wgid % nig) / gsz;
        u.aoff = (size_t)u.pm * 256 * K * 2; u.boff = (size_t)u.pn * 256 * K * 2; u.e = 0; u.mvalid = 256; u.rowbase = u.pm * 256; u.mi = 0;
        return true;
    }
    __device__ __forceinline__ int row(const Unit&, int r) const { return r; }
};
}

extern __shared__ __attribute__((aligned(16))) unsigned char g_smem[];
#define PHASE_FN __device__ __forceinline__
enum { PH_PROLOGUE = 0, PH_NORM_MIX, PH_GEMM_IN_EVEN, PH_EVEN_TOK, PH_GDN_CHUNK, PH_GDN_SCAN, PH_DSA_TOPK, PH_DSA_ATTN, PH_GDN_OUT,
       PH_GEMM_OUT, PH_NORM_FFN, PH_MOE1, PH_MOE2, PH_GEMM_IN_ODD, PH_GLA_TOK, PH_GLA_CHUNK, PH_GLA_SCAN, PH_GLA_OUT, PH_FINAL };

PHASE_FN void ph_prologue(const Params& p, float* smem) {
    unsigned char* ws_ = p.ws; asm volatile("" : "+s"(ws_));
    { int ldz_ = 0; asm volatile("" : "+s"(ldz_)); smem = (float*)(g_smem + ldz_); }
    int tid_ = threadIdx.x; asm volatile("" : "+v"(tid_)); const int tid = tid_, nthr = gridDim.x * NTHREADS, gid = blockIdx.x * NTHREADS + tid;
    for (int i = tid; i < 2 * ND; i += NTHREADS) smem[i] = siluf_(p.c[i]);
    __syncthreads();
    float* MOD = (float*)(ws_ + OFF_MOD);
    { float* red = smem + 2048;
      const int lane = tid & 63, wv = tid >> 6;
      for (int item = blockIdx.x; item < 4 * 96; item += gridDim.x) {
          const int l = item / 96, n = (item % 96) * 64 + lane;
          const float* w = p.ada_w + (size_t)l * ND * 6144 + n;
          float a0 = 0.f, a1 = 0.f;
#pragma unroll 8
          for (int k = wv * 128; k < wv * 128 + 128; ++k) { const float wv_ = w[(size_t)k * 6144]; a0 += smem[k] * wv_; a1 += smem[ND + k] * wv_; }
          __syncthreads();
          red[(wv * 64 + lane) * 2] = a0; red[(wv * 64 + lane) * 2 + 1] = a1;
          __syncthreads();
          if (tid < 128) { const int c = tid >> 1, bb = tid & 1; float a = 0.f; for (int w8 = 0; w8 < 8; ++w8) a += red[(w8 * 64 + c) * 2 + bb];
              MOD[(l * 2 + bb) * 6144 + (item % 96) * 64 + c] = a + p.ada_b[l * 6144 + (item % 96) * 64 + c]; }
      }
      __syncthreads(); }
    float* COSA = (float*)(ws_ + OFF_COSA); float* SINA = (float*)(ws_ + OFF_SINA);
    float* COSI = (float*)(ws_ + OFF_COSI); float* SINI = (float*)(ws_ + OFF_SINI);
    for (size_t i = gid; i < (size_t)NT * 64; i += nthr) {
        const int t = (int)(i >> 6), j = (int)(i & 63);
        double s, c; sincos_d((double)p.pos[t] * ipow_d(p.rA, j), s, c);
        COSA[i] = (float)c; SINA[i] = (float)s;
    }
    for (size_t i = gid; i < (size_t)NT * 32; i += nthr) {
        const int t = (int)(i >> 5), j = (int)(i & 31);
        double s, c; sincos_d((double)p.pos[t] * ipow_d(p.rI, j), s, c);
        COSI[i] = (float)c; SINI[i] = (float)s;
    }
}

PHASE_FN void ph_rows(const Params& p, int layer, int mode, float* smem) {
    unsigned char* ws_ = p.ws; asm volatile("" : "+s"(ws_));
    { int ldz_ = 0; asm volatile("" : "+s"(ldz_)); smem = (float*)(g_smem + ldz_); }
    int tid_ = threadIdx.x; asm volatile("" : "+v"(tid_)); const int tid = tid_, lane = tid & 63, wv = tid >> 6;
    int* pad = (int*)smem;
    const int moe_layer = (mode == 1) ? 3 : layer - 1;
    if (moe_layer >= 0) {
        if (tid == 0) { const int* cnt = (const int*)(ws_ + OFF_CNT) + moe_layer * 32 * CSTR; int a = 0; for (int e = 0; e < 32; ++e) { pad[e] = a; a += ((cnt[e * CSTR] + 127) / 128) * 128; } }
        __syncthreads();
    }
    const float* MOD = (const float*)(ws_ + OFF_MOD);
    bf16_t* H = (bf16_t*)(ws_ + OFF_H);
    const bf16_t* YB = (const bf16_t*)(ws_ + OFF_YB);
    const int* ASG = (const int*)(ws_ + OFF_ASG);
    const float* GATE = (const float*)(ws_ + OFF_GATE);
    auto load_x = [&](int row, float (&xv)[16]) {
        const float* xin = (mode == 0 && layer == 0) ? (p.x + (size_t)row * ND) : (p.X + (size_t)row * ND);
#pragma unroll
        for (int j = 0; j < 4; ++j) { const float4 v = *(const float4*)(xin + j * 256 + lane * 4); xv[4 * j] = v.x; xv[4 * j + 1] = v.y; xv[4 * j + 2] = v.z; xv[4 * j + 3] = v.w; }
    };
    auto load_y = [&](int row, uint2 (&ya)[4], uint2 (&yb)[4], float& g0, float& g1) {
        const int4 as = *(const int4*)(ASG + row * 4);
        g0 = GATE[row * 2]; g1 = GATE[row * 2 + 1];
        const bf16_t* y0 = YB + (size_t)(pad[as.x] + as.y) * ND;
        const bf16_t* y1 = YB + (size_t)(pad[as.z] + as.w) * ND;
#pragma unroll
        for (int j = 0; j < 4; ++j) { ya[j] = *(const uint2*)(y0 + j * 256 + lane * 4); yb[j] = *(const uint2*)(y1 + j * 256 + lane * 4); }
    };
    auto finish = [&](int row, float (&xv)[16], const uint2 (&ya)[4], const uint2 (&yb)[4], float g0, float g1) {
        const int b = row >> 13;
        float* xr = p.X + (size_t)row * ND;
        if (moe_layer >= 0) {
            const float* gt = MOD + (size_t)(moe_layer * 2 + b) * 6144 + 5 * 1024;
#pragma unroll
            for (int j = 0; j < 4; ++j) {
                const int col = j * 256 + lane * 4;
                const f32x4 a = unpack4(ya[j]), bq = unpack4(yb[j]); const float4 g = *(const float4*)(gt + col);
                xv[4 * j] += g.x * (g0 * a[0] + g1 * bq[0]); xv[4 * j + 1] += g.y * (g0 * a[1] + g1 * bq[1]);
                xv[4 * j + 2] += g.z * (g0 * a[2] + g1 * bq[2]); xv[4 * j + 3] += g.w * (g0 * a[3] + g1 * bq[3]);
                if (mode == 0) *(float4*)(xr + col) = make_float4(xv[4 * j], xv[4 * j + 1], xv[4 * j + 2], xv[4 * j + 3]);
            }
        }
        float ss = 0.f;
#pragma unroll
        for (int j = 0; j < 16; ++j) ss += xv[j] * xv[j];
        ss = wave_sum(ss);
        const float rstd = rsqrtf(ss * (1.f / 1024.f) + EPS);
        if (mode == 0) {
            const float* nw = p.norm_mix + layer * 1024;
            const float* sh = MOD + (size_t)(layer * 2 + b) * 6144;
            const float* sc = sh + 1024;
#pragma unroll
            for (int j = 0; j < 4; ++j) {
                const int col = j * 256 + lane * 4;
                const float4 w = *(const float4*)(nw + col), s4 = *(const float4*)(sc + col), h4 = *(const float4*)(sh + col);
                f32x4 ov;
                ov[0] = xv[4 * j] * rstd * w.x * (1.f + s4.x) + h4.x; ov[1] = xv[4 * j + 1] * rstd * w.y * (1.f + s4.y) + h4.y;
                ov[2] = xv[4 * j + 2] * rstd * w.z * (1.f + s4.z) + h4.z; ov[3] = xv[4 * j + 3] * rstd * w.w * (1.f + s4.w) + h4.w;
                *(uint2*)(H + (size_t)row * ND + col) = pack4(ov);
            }
        } else {
#pragma unroll
            for (int j = 0; j < 4; ++j) {
                const int col = j * 256 + lane * 4;
                const float4 w = *(const float4*)(p.final_norm + col);
                *(float4*)(xr + col) = make_float4(xv[4 * j] * rstd * w.x, xv[4 * j + 1] * rstd * w.y, xv[4 * j + 2] * rstd * w.z, xv[4 * j + 3] * rstd * w.w);
            }
        }
    };
    const int stride = gridDim.x * 8;
    for (int row = blockIdx.x * 8 + wv; row < NT; row += 2 * stride) {
        const int rowB = row + stride; const bool hasB = rowB < NT; const int rB = hasB ? rowB : row;
        float xa[16], xb[16]; uint2 yaa[4], yab[4], yba[4], ybb[4]; float ga0 = 0.f, ga1 = 0.f, gb0 = 0.f, gb1 = 0.f;
        load_x(row, xa); load_x(rB, xb);
        if (moe_layer >= 0) { load_y(row, yaa, yab, ga0, ga1); load_y(rB, yba, ybb, gb0, gb1); }
        finish(row, xa, yaa, yab, ga0, ga1);
        if (hasB) finish(rowB, xb, yba, ybb, gb0, gb1);
    }
}

struct EpiIn {
    static constexpr bool PERM = true;
    bf16_t* P; float* AUX; int ncols; int even;
    __device__ __forceinline__ void operator()(const f32x4 (&acc)[2][2][4][2], const pg8::Unit& u, int wr, int wc, int fr, int fq) const {
        const int row0 = u.pm * 256 + wr * 64 + fr, col0 = u.pn * 256 + wc * 32 + 8 * fq;
#pragma unroll
        for (int ai = 0; ai < 2; ++ai)
#pragma unroll
            for (int m = 0; m < 4; ++m) { const int r = row0 + ai * 128 + m * 16;
#pragma unroll
                for (int bj = 0; bj < 2; ++bj) { const int c = col0 + bj * 128;
                    if (c < ncols) { const uint2 lo = pack4(acc[ai][bj][m][0]), hi = pack4(acc[ai][bj][m][1]); *(uint4*)(P + (size_t)r * LDPB + c) = make_uint4(lo.x, lo.y, hi.x, hi.y); }
                    if (even) {
                        if (c == 2048) { *(f32x4*)(AUX + (size_t)r * 16) = acc[ai][bj][m][0]; *(f32x4*)(AUX + (size_t)r * 16 + 4) = acc[ai][bj][m][1]; }
                        if (c == 3912) *(f32x4*)(AUX + (size_t)r * 16 + 8) = acc[ai][bj][m][0];
                    } } }
    }
};

PHASE_FN void ph_gemm_in(const Params& p, int layer, bool even, float* smem) {
    unsigned char* ws_ = p.ws; asm volatile("" : "+s"(ws_));
    int ldz_ = 0; asm volatile("" : "+s"(ldz_));
    const bf16_t* Wt = even ? (const bf16_t*)(ws_ + OFF_WINE) + (size_t)(layer >> 1) * 4096 * 1024 : (const bf16_t*)(ws_ + OFF_WINO) + (size_t)(layer >> 1) * 3072 * 1024;
    EpiIn E; E.P = (bf16_t*)(ws_ + OFF_P); E.AUX = (float*)(ws_ + OFF_AUX); E.ncols = even ? 3920 : 3072; E.even = even ? 1 : 0;
    pg8::DenseOrder S; S.init(64, even ? 16 : 12, gridDim.x, blockIdx.x, 1024);
    __syncthreads();
    pg8::gemm_phase<EpiIn, pg8::DenseOrder, false>((LAS unsigned char*)(g_smem + ldz_), (const bf16_t*)(ws_ + OFF_H), Wt, 1024, S, E);
    __syncthreads();
    if (!even) {
        const bf16_t* H = (const bf16_t*)(ws_ + OFF_H);
        const bf16_t* Wg = (const bf16_t*)(ws_ + OFF_WGL) + (size_t)(layer >> 1) * 128 * 1024;
        float* AUX = (float*)(ws_ + OFF_AUX);
        for (int mt = blockIdx.x; mt < 64; mt += gridDim.x) {
            const bf16_t* Ab = H + (size_t)mt * 256 * 1024;
            float* At = AUX + (size_t)mt * 256 * 16;
            gemm_tile_bf16(1024, g_smem + ldz_,
                [=](int i, int r, int k) -> uint4 { return *(const uint4*)(Ab + (size_t)r * 1024 + k); },
                [=](int i, int r, int k) -> uint4 { return *(const uint4*)(Wg + (size_t)r * 1024 + k); },
                [=](const f32x4 (&acc)[4][4], int wm, int wn, int lane) {
                    if (wn == 0 && (lane >> 4) < 4) {
#pragma unroll
                        for (int mi = 0; mi < 4; ++mi) { const int m = wm * 64 + mi * 16 + (lane & 15); *(f32x4*)(At + (size_t)m * 16 + 4 * (lane >> 4)) = acc[mi][0]; }
                    }
                });
        }
        __syncthreads();
    }
}

PHASE_FN void ph_even_tok(const Params& p, int layer, float* smem) {
    unsigned char* ws_ = p.ws; asm volatile("" : "+s"(ws_));
    { int ldz_ = 0; asm volatile("" : "+s"(ldz_)); smem = (float*)(g_smem + ldz_); }
    int tid_ = threadIdx.x; asm volatile("" : "+v"(tid_)); const int tid = tid_, lane = tid & 63, wv = tid >> 6, li = layer >> 1;
    const bf16_t* P = (const bf16_t*)(ws_ + OFF_P); const float* AUX = (const float*)(ws_ + OFF_AUX);
    bf16_t* QB = (bf16_t*)(ws_ + OFF_QBB); bf16_t* KB = (bf16_t*)(ws_ + OFF_KBB); bf16_t* QI = (bf16_t*)(ws_ + OFF_QIB); bf16_t* KI = (bf16_t*)(ws_ + OFF_KIB); float* WI = (float*)(ws_ + OFF_WI);
    const float* COSA = (const float*)(ws_ + OFF_COSA); const float* SINA = (const float*)(ws_ + OFF_SINA);
    const float* COSI = (const float*)(ws_ + OFF_COSI); const float* SINI = (const float*)(ws_ + OFF_SINI);
    for (int t = blockIdx.x * 8 + wv; t < NT; t += gridDim.x * 8) {
        const bf16_t* Pt = P + (size_t)t * LDPB;
        if (lane < 4) {
            WI[t * 4 + lane] = AUX[(size_t)t * 16 + 8 + lane] * 0.0625f;
        }
        { const float c = COSA[(size_t)t * 64 + lane], sn = SINA[(size_t)t * 64 + lane];
#pragma unroll
          for (int h = 0; h < 4; ++h) {
              float t1 = bf16_to_f32(Pt[2056 + h * 128 + lane]), t2 = bf16_to_f32(Pt[2056 + h * 128 + 64 + lane]);
              QB[(size_t)t * 512 + h * 128 + lane] = f2bf(t1 * c - t2 * sn); QB[(size_t)t * 512 + h * 128 + 64 + lane] = f2bf(t2 * c + t1 * sn);
              t1 = bf16_to_f32(Pt[2568 + h * 128 + lane]); t2 = bf16_to_f32(Pt[2568 + h * 128 + 64 + lane]);
              KB[(size_t)t * 512 + h * 128 + lane] = f2bf(t1 * c - t2 * sn); KB[(size_t)t * 512 + h * 128 + 64 + lane] = f2bf(t2 * c + t1 * sn);
          } }
#pragma unroll
        for (int r = 0; r < 2; ++r) {
            const int item = lane + 64 * r, hh = item >> 5, ii = item & 31;
            const float c = COSI[(size_t)t * 32 + ii], sn = SINI[(size_t)t * 32 + ii];
            const float t1 = bf16_to_f32(Pt[3592 + hh * 64 + ii]), t2 = bf16_to_f32(Pt[3592 + hh * 64 + 32 + ii]);
            QI[(size_t)t * 256 + hh * 64 + ii] = f2bf(t1 * c - t2 * sn); QI[(size_t)t * 256 + hh * 64 + 32 + ii] = f2bf(t2 * c + t1 * sn);
        }
        if (lane < 32) {
            const float c = COSI[(size_t)t * 32 + lane], sn = SINI[(size_t)t * 32 + lane];
            const float t1 = bf16_to_f32(Pt[3848 + lane]), t2 = bf16_to_f32(Pt[3848 + 32 + lane]);
            KI[(size_t)t * 64 + lane] = f2bf(t1 * c - t2 * sn); KI[(size_t)t * 64 + 32 + lane] = f2bf(t2 * c + t1 * sn);
        }
    }
    { bf16_t* VT = (bf16_t*)(ws_ + OFF_VT);
      bf16_t* sv = (bf16_t*)g_smem;
      for (int item = blockIdx.x; item < 2 * 128 * 4; item += gridDim.x) {
          const int h = item & 3, tt = item >> 2, b = tt >> 7, s0 = (tt & 127) * 64;
          __syncthreads();
          for (int e = tid; e < 64 * 128; e += NTHREADS) { const int i = e >> 7, d = e & 127; sv[d * 72 + i] = P[(size_t)(b * 8192 + s0 + i) * LDPB + 3080 + h * 128 + d]; }
          __syncthreads();
          for (int e = tid; e < 128 * 8; e += NTHREADS) { const int d = e >> 3, c = e & 7;
              *(uint4*)(VT + ((size_t)((b * 4 + h) * 128 + d)) * 8192 + s0 + c * 8) = *(const uint4*)(sv + d * 72 + c * 8); }
      } }
}

__device__ __forceinline__ f32x4 mma_lds(const unsigned char* A, int sa, int a0, const unsigned char* B, int sb, int b0, int K, f32x4 acc, int c16, int q4) {
    const unsigned char* ap = A + (a0 + c16) * sa + q4 * 16;
    const unsigned char* bp = B + (b0 + c16) * sb + q4 * 16;
    for (int kk = 0; kk < K; kk += 32) { acc = __builtin_amdgcn_mfma_f32_16x16x32_bf16(*(const bf16x8*)(ap + kk * 2), *(const bf16x8*)(bp + kk * 2), acc, 0, 0, 0); }
    return acc;
}

PHASE_FN void ph_gdn_chunk(const Params& p, int layer, float* smem) {
    unsigned char* ws_ = p.ws; asm volatile("" : "+s"(ws_));
    int tid_ = threadIdx.x; asm volatile("" : "+v"(tid_)); const int tid = tid_, lane = tid & 63, wv = __builtin_amdgcn_readfirstlane(tid >> 6), q4 = lane >> 4, c16 = lane & 15;
    int ldz_ = 0; asm volatile("" : "+s"(ldz_)); unsigned char* lds = g_smem + ldz_;
    constexpr int SN = 272, ST = 144;
    unsigned char* bKN = lds;
    unsigned char* bQN = lds + 18432;
    unsigned char* bKBG = lds + 35840;
    unsigned char* bVB = lds + 54272;
    unsigned char* bKD = lds + 72704;
    unsigned char* bUT = lds + 91136;
    float* sL = (float*)(lds + 109568);
    unsigned char* bAQK = lds + 126976;
    unsigned char* bTB = lds + 136192;
    float* sG = (float*)(lds + 145408); float* sB = sG + 64; float* sEg = sB + 64;
    const int li = layer >> 1;
    const bf16_t* P = (const bf16_t*)(ws_ + OFF_P); const float* AUX = (const float*)(ws_ + OFF_AUX);
    const float* cw = p.conv_w + (size_t)li * 4 * 1536;
    uint4* PFR = (uint4*)(ws_ + OFF_PFR); uint4* RFR = (uint4*)(ws_ + OFF_RFR); uint2* QFR = (uint2*)(ws_ + OFF_QFR); uint2* OFR = (uint2*)(ws_ + OFF_OFR);
    float* GL = (float*)(ws_ + OFF_GL);
    for (int ci = blockIdx.x; ci < 1024; ci += gridDim.x) {
        const int b = ci >> 9, h = (ci >> 7) & 3, n = ci & 127;
        const int t0 = b * 8192 + n * 64;
        __syncthreads();
        if (tid < 64) { float g = -expf(p.a_log[li * 4 + h]) * softplusf_(AUX[(size_t)(t0 + tid) * 16 + 4 + h] + p.dt_bias[li * 4 + h]);
#pragma unroll
            for (int o = 1; o < 64; o <<= 1) { const float nb = __shfl_up(g, o); if (lane >= o) g += nb; }
            sG[tid] = g; sB[tid] = sigmoidf_(AUX[(size_t)(t0 + tid) * 16 + h]); sEg[tid] = expf(g); }
        for (int e = tid; e < 64 * 36; e += NTHREADS) ((unsigned*)bAQK)[e] = 0u;
        __syncthreads();
        const float gl = sG[63];
        for (int rep_a = 0; rep_a < REP_A; ++rep_a)
        {
            const int d0 = 2 * lane, cb = h * 128 + d0, s00 = n * 64;
            float wq[4][2], wk[4][2], wvv[4][2];
#pragma unroll
            for (int jj = 0; jj < 4; ++jj) { wq[jj][0] = cw[jj * 1536 + cb]; wq[jj][1] = cw[jj * 1536 + cb + 1]; wk[jj][0] = cw[jj * 1536 + 512 + cb]; wk[jj][1] = cw[jj * 1536 + 512 + cb + 1];
                                            wvv[jj][0] = cw[jj * 1536 + 1024 + cb]; wvv[jj][1] = cw[jj * 1536 + 1024 + cb + 1]; }
            float tk0[8], tk1[8], tv0[8], tv1[8], td0[8], td1[8];
#pragma unroll
            for (int r = 0; r < 8; ++r) {
                const int i = wv * 8 + r;
                float aq0 = 0.f, aq1 = 0.f, ak0 = 0.f, ak1 = 0.f, av0 = 0.f, av1 = 0.f;
#pragma unroll
                for (int jj = 0; jj < 4; ++jj) {
                    if (s00 + i - 3 + jj >= 0) {
                        const bf16_t* rp = P + (size_t)(t0 + i - 3 + jj) * LDPB + cb;
                        const unsigned uq = *(const unsigned*)rp, uk = *(const unsigned*)(rp + 512), uv = *(const unsigned*)(rp + 1024);
                        aq0 += wq[jj][0] * __uint_as_float(uq << 16); aq1 += wq[jj][1] * __uint_as_float(uq & 0xffff0000u);
                        ak0 += wk[jj][0] * __uint_as_float(uk << 16); ak1 += wk[jj][1] * __uint_as_float(uk & 0xffff0000u);
                        av0 += wvv[jj][0] * __uint_as_float(uv << 16); av1 += wvv[jj][1] * __uint_as_float(uv & 0xffff0000u);
                    }
                }
                aq0 = siluf_(aq0); aq1 = siluf_(aq1); ak0 = siluf_(ak0); ak1 = siluf_(ak1); av0 = siluf_(av0); av1 = siluf_(av1);
                const float rq = rsqrtf(wave_sum(aq0 * aq0 + aq1 * aq1) + EPS), rk = rsqrtf(wave_sum(ak0 * ak0 + ak1 * ak1) + EPS);
                aq0 *= rq; aq1 *= rq; ak0 *= rk; ak1 *= rk;
                const float be = sB[i], eg_i = sEg[i], ekd = expf(gl - sG[i]);
                *(unsigned*)(bKN + i * SN + d0 * 2) = cvt_pk_bf16(ak0, ak1);
                *(unsigned*)(bQN + i * SN + d0 * 2) = cvt_pk_bf16(aq0, aq1);
                tk0[r] = ak0 * be * eg_i; tk1[r] = ak1 * be * eg_i; tv0[r] = av0 * be; tv1[r] = av1 * be; td0[r] = ak0 * ekd; td1[r] = ak1 * ekd;
                if ((r & 1) == 1) asm volatile("" ::: "memory");
            }
#define PK8(T) make_uint4(cvt_pk_bf16(T[0], T[1]), cvt_pk_bf16(T[2], T[3]), cvt_pk_bf16(T[4], T[5]), cvt_pk_bf16(T[6], T[7]))
            *(uint4*)(bKBG + d0 * ST + wv * 16) = PK8(tk0); *(uint4*)(bKBG + (d0 + 1) * ST + wv * 16) = PK8(tk1);
            *(uint4*)(bVB + d0 * ST + wv * 16) = PK8(tv0); *(uint4*)(bVB + (d0 + 1) * ST + wv * 16) = PK8(tv1);
            *(uint4*)(bKD + d0 * ST + wv * 16) = PK8(td0); *(uint4*)(bKD + (d0 + 1) * ST + wv * 16) = PK8(td1);
        }
        __syncthreads();
        for (int u = wv; u < 20; u += 8) {
            const int kind = (u >= 10) ? 1 : 0, idx = u - kind * 10;
            const int ti = (idx >= 6) ? 3 : (idx >= 3) ? 2 : (idx >= 1) ? 1 : 0, tj = idx - ((ti * (ti + 1)) >> 1);
            f32x4 acc = (f32x4){0.f, 0.f, 0.f, 0.f};
            acc = mma_lds(kind ? bQN : bKN, SN, 16 * ti, bKN, SN, 16 * tj, 128, acc, c16, q4);
            const int j = 16 * tj + c16;
#pragma unroll
            for (int r = 0; r < 4; ++r) { const int i = 16 * ti + 4 * q4 + r;
                const float dec = (j <= i) ? expf(sG[i] - sG[j]) : 0.f;
                if (kind == 0) sL[i * 68 + j] = (j < i) ? sB[i] * acc[r] * dec : 0.f;
                else *(bf16_t*)(bAQK + i * ST + j * 2) = f2bf(acc[r] * SCALE128 * dec); }
        }
        __syncthreads();
        for (int rep_b = 0; rep_b < REP_B; ++rep_b)
        if (wv == 0) {
            float t[64];
            int zz = 0; asm volatile("" : "+v"(zz)); const float* sLo = sL + zz;
#pragma clang loop unroll(full)
            for (int i = 0; i < 64; ++i) { float a0 = (i == lane) ? 1.f : 0.f, a1 = 0.f, a2 = 0.f, a3 = 0.f;
#define LQ(q) float4 lv##q = make_float4(0.f, 0.f, 0.f, 0.f); if (4 * q < i) lv##q = *(const float4*)(sLo + i * 68 + 4 * q);
#define FQ(q) if (4 * q < i) { a0 -= lv##q.x * t[4 * q]; if (4 * q + 1 < i) a1 -= lv##q.y * t[4 * q + 1]; if (4 * q + 2 < i) a2 -= lv##q.z * t[4 * q + 2]; if (4 * q + 3 < i) a3 -= lv##q.w * t[4 * q + 3]; }
                { LQ(0) LQ(1) LQ(2) LQ(3) LQ(4) LQ(5) LQ(6) LQ(7)
                  FQ(0) FQ(1) FQ(2) FQ(3) FQ(4) FQ(5) FQ(6) FQ(7) }
                if (i > 32) { asm volatile("" ::: "memory");
                  LQ(8) LQ(9) LQ(10) LQ(11) LQ(12) LQ(13) LQ(14) LQ(15)
                  FQ(8) FQ(9) FQ(10) FQ(11) FQ(12) FQ(13) FQ(14) FQ(15) }
                t[i] = (a0 + a1) + (a2 + a3); asm volatile("" ::: "memory"); }
#pragma unroll
            for (int i = 0; i < 64; ++i) *(bf16_t*)(bTB + i * ST + lane * 2) = f2bf(t[i]);
        }
        __syncthreads();
        for (int x = 0; x < 8; ++x) {
            const int u = wv * 8 + x, kind = u >> 5, ti = (u >> 3) & 3, td = u & 7;
            f32x4 acc = (f32x4){0.f, 0.f, 0.f, 0.f};
            acc = mma_lds(bTB, ST, 16 * ti, kind ? bVB : bKBG, ST, 16 * td, 64, acc, c16, q4);
            *(uint2*)((kind ? bUT : bKN) + (16 * td + c16) * ST + (16 * ti + 4 * q4) * 2) = pack4(acc);
        }
        __syncthreads();
        unsigned char* bWT = bKN;
        const float eg = expf(gl);
        for (int rep_c = 0; rep_c < REP_C; ++rep_c) {
        for (int x = 0; x < 4; ++x) {
            const int u = wv * 4 + x, ti = u >> 2, a = u & 3;
            uint4 fr;
#pragma unroll
            for (int hf = 0; hf < 2; ++hf) { const int tk = 2 * a + hf;
                f32x4 acc = (f32x4){0.f, 0.f, 0.f, 0.f};
                acc = mma_lds(bWT, ST, 16 * tk, bKD, ST, 16 * ti, 64, acc, c16, q4);
                f32x4 v;
#pragma unroll
                for (int r = 0; r < 4; ++r) v[r] = ((16 * tk + 4 * q4 + r) == (16 * ti + c16) ? eg : 0.f) - acc[r];
                const uint2 pk = pack4(v);
                if (hf == 0) { fr.x = pk.x; fr.y = pk.y; } else { fr.z = pk.x; fr.w = pk.y; } }
            PFR[((size_t)(ci * 8 + ti) * 4 + a) * 64 + lane] = fr;
        }
        for (int x = 0; x < 2; ++x) {
            const int u = wv * 2 + x, ti = u >> 2, a = u & 3;
            uint4 fr;
            const int i = 16 * ti + c16;
            const float qs = SCALE128 * sEg[i];
#pragma unroll
            for (int hf = 0; hf < 2; ++hf) { const int tk = 2 * a + hf;
                f32x4 acc = (f32x4){0.f, 0.f, 0.f, 0.f};
                acc = mma_lds(bWT, ST, 16 * tk, bAQK, ST, 16 * ti, 64, acc, c16, q4);
                const f32x4 qv = unpack4(*(const uint2*)(bQN + i * SN + (16 * tk + 4 * q4) * 2));
                const uint2 pk = pack4(qv * qs - acc);
                if (hf == 0) { fr.x = pk.x; fr.y = pk.y; } else { fr.z = pk.x; fr.w = pk.y; } }
            RFR[((size_t)(ci * 4 + ti) * 4 + a) * 64 + lane] = fr;
        }
        for (int x = 0; x < 8; ++x) {
            const int u = wv * 8 + x, tdv = u >> 3, tdk = u & 7;
            f32x4 acc = (f32x4){0.f, 0.f, 0.f, 0.f};
            acc = mma_lds(bKD, ST, 16 * tdk, bUT, ST, 16 * tdv, 64, acc, c16, q4);
            QFR[((size_t)(ci * 8 + tdv) * 8 + tdk) * 64 + lane] = pack4(acc);
        }
        for (int x = 0; x < 4; ++x) {
            const int u = wv * 4 + x, tdv = u >> 2, ti = u & 3;
            f32x4 acc = (f32x4){0.f, 0.f, 0.f, 0.f};
            acc = mma_lds(bAQK, ST, 16 * ti, bUT, ST, 16 * tdv, 64, acc, c16, q4);
            OFR[((size_t)(ci * 8 + tdv) * 4 + ti) * 64 + lane] = pack4(acc);
        }
        }
        if (tid == 0) GL[ci] = gl;
    }
}

__device__ __forceinline__ void gs_load(uint4 (&d)[12], const unsigned char* pp, const unsigned char* rr, const unsigned char* qq, const unsigned char* oo, const int lt) {
#pragma unroll
    for (int i = 0; i < 6; ++i) { int c = lt + 384 * i; c = c < 2048 ? c : 2047; d[i] = *(const uint4*)(pp + c * 16); }
#pragma unroll
    for (int i = 0; i < 3; ++i) { int c = lt + 384 * i; c = c < 1024 ? c : 1023; d[6 + i] = *(const uint4*)(rr + c * 16); }
#pragma unroll
    for (int i = 0; i < 2; ++i) { int c = lt + 384 * i; c = c < 512 ? c : 511; d[9 + i] = *(const uint4*)(qq + c * 16); }
    { const int c = lt < 256 ? lt : 255; d[11] = *(const uint4*)(oo + c * 16); }
}
__device__ __forceinline__ void gs_store(const uint4 (&d)[12], unsigned char* sb, const int lt) {
#pragma unroll
    for (int i = 0; i < 6; ++i) { const int c = lt + 384 * i; if (c < 2048) *(uint4*)(sb + c * 16) = d[i]; }
#pragma unroll
    for (int i = 0; i < 3; ++i) { const int c = lt + 384 * i; if (c < 1024) *(uint4*)(sb + 32768 + c * 16) = d[6 + i]; }
#pragma unroll
    for (int i = 0; i < 2; ++i) { const int c = lt + 384 * i; if (c < 512) *(uint4*)(sb + 49152 + c * 16) = d[9 + i]; }
    if (lt < 256) *(uint4*)(sb + 57344 + lt * 16) = d[11];
}

#define SCAN_BODY                 bf16x8 Sb[4]; \
_Pragma("unroll") \
                for (int a = 0; a < 4; ++a) { union { uint4 u; bf16x8 v; } cv; const uint2 lo = pack4(S[2 * a]), hi = pack4(S[2 * a + 1]); cv.u.x = lo.x; cv.u.y = lo.y; cv.u.z = hi.x; cv.u.w = hi.y; Sb[a] = cv.v; } \
                const int t0 = b * 8192 + n * 64; \
                {   f32x4 oa[4]; \
_Pragma("unroll") \
                    for (int ti = 0; ti < 4; ++ti) oa[ti] = unpack4(*(const uint2*)(Of + ti * 512)); \
_Pragma("unroll") \
                    for (int a = 0; a < 4; ++a) \
_Pragma("unroll") \
                        for (int ti = 0; ti < 4; ++ti) oa[ti] = __builtin_amdgcn_mfma_f32_16x16x32_bf16(*(const bf16x8*)(Rf + (ti * 4 + a) * 1024), Sb[a], oa[ti], 0, 0, 0); \
_Pragma("unroll") \
                    for (int ti = 0; ti < 4; ++ti) { \
                        float* op = O + (size_t)(t0 + 16 * ti + 4 * q4) * 1024 + h * 128 + 16 * tdv + c16; \
                        op[0] = oa[ti][0]; op[1024] = oa[ti][1]; op[2048] = oa[ti][2]; op[3072] = oa[ti][3]; } \
                } \
                asm volatile("" ::: "memory"); \
_Pragma("unroll") \
                for (int g = 0; g < 2; ++g) { \
                    f32x4 sa[4]; \
_Pragma("unroll") \
                    for (int t = 0; t < 4; ++t) sa[t] = unpack4(*(const uint2*)(Qf + (g * 4 + t) * 512)); \
_Pragma("unroll") \
                    for (int a = 0; a < 4; ++a) \
_Pragma("unroll") \
                        for (int t = 0; t < 4; ++t) sa[t] = __builtin_amdgcn_mfma_f32_16x16x32_bf16(*(const bf16x8*)(Pf + ((g * 4 + t) * 4 + a) * 1024), Sb[a], sa[t], 0, 0, 0); \
_Pragma("unroll") \
                    for (int t = 0; t < 4; ++t) S[g * 4 + t] = sa[t]; \
                    asm volatile("" ::: "memory"); \
                }
PHASE_FN void ph_gdn_scan(const Params& p, float* smem) {
    unsigned char* ws_ = p.ws; asm volatile("" : "+s"(ws_));
    int tid_ = threadIdx.x; asm volatile("" : "+v"(tid_)); const int tid = tid_, lane = tid & 63, wv = __builtin_amdgcn_readfirstlane(tid >> 6), q4 = lane >> 4, c16 = lane & 15;
    int ldz_ = 0; asm volatile("" : "+s"(ldz_)); unsigned char* lds = g_smem + ldz_;
    constexpr int STG = 61440;
    const unsigned char* PFR = ws_ + OFF_PFR; const unsigned char* RFR = ws_ + OFF_RFR; const unsigned char* QFR = ws_ + OFF_QFR; const unsigned char* OFR = ws_ + OFF_OFR;
    float* O = (float*)(ws_ + OFF_O);
    for (int it = blockIdx.x; it < 32; it += gridDim.x) {
        const int bh = it >> 2, pair = it & 3, b = bh >> 2, h = bh & 3;
        __syncthreads();
        if (wv >= 2) {
            const int lt = tid - 128;
            const unsigned char* Pb = PFR + (size_t)bh * 128 * 32768;
            const unsigned char* Rb = RFR + (size_t)bh * 128 * 16384;
            const unsigned char* Qb = QFR + (size_t)bh * 128 * 32768 + pair * 8192;
            const unsigned char* Ob = OFR + (size_t)bh * 128 * 16384 + pair * 4096;
            uint4 ra0, ra1, ra2, ra3, ra4, ra5, ra6, ra7, ra8, ra9, ra10, ra11, rb0, rb1, rb2, rb3, rb4, rb5, rb6, rb7, rb8, rb9, rb10, rb11;
            uint4 rc0, rc1, rc2, rc3, rc4, rc5, rc6, rc7, rc8, rc9, rc10, rc11;
#define LDC(base_, c_, mx_) (*(const uint4*)((base_) + (size_t)(((c_) < (mx_)) ? (c_) : (mx_)) * 16))
#define GS_LOAD(X, n_) do { const unsigned char* pp_ = Pb + (size_t)(n_) * 32768; const unsigned char* rr_ = Rb + (size_t)(n_) * 16384; \
                const unsigned char* qq_ = Qb + (size_t)(n_) * 32768; const unsigned char* oo_ = Ob + (size_t)(n_) * 16384; \
                X##0 = LDC(pp_, lt, 2047); X##1 = LDC(pp_, lt + 384, 2047); X##2 = LDC(pp_, lt + 768, 2047); X##3 = LDC(pp_, lt + 1152, 2047); X##4 = LDC(pp_, lt + 1536, 2047); X##5 = LDC(pp_, lt + 1920, 2047); \
                X##6 = LDC(rr_, lt, 1023); X##7 = LDC(rr_, lt + 384, 1023); X##8 = LDC(rr_, lt + 768, 1023); \
                X##9 = LDC(qq_, lt, 511); X##10 = LDC(qq_, lt + 384, 511); X##11 = LDC(oo_, lt, 255); } while (0)
#define STC(off_, c_, lim_, v_) do { if ((c_) < (lim_)) *(uint4*)(sb_ + (off_) + (c_) * 16) = v_; } while (0)
#define GS_STORE(X, st_) do { unsigned char* sb_ = lds + (st_) * STG; \
                STC(0, lt, 2048, X##0); STC(0, lt + 384, 2048, X##1); STC(0, lt + 768, 2048, X##2); STC(0, lt + 1152, 2048, X##3); STC(0, lt + 1536, 2048, X##4); STC(0, lt + 1920, 2048, X##5); \
                STC(32768, lt, 1024, X##6); STC(32768, lt + 384, 1024, X##7); STC(32768, lt + 768, 1024, X##8); \
                STC(49152, lt, 512, X##9); STC(49152, lt + 384, 512, X##10); STC(57344, lt, 256, X##11); } while (0)
            GS_LOAD(ra, 0); GS_STORE(ra, 0);
            GS_LOAD(rb, 1); GS_LOAD(rc, 2); GS_LOAD(ra, 3);
            __syncthreads();
#define CLAMPN(x_) (((x_) < 128) ? (x_) : 127)
            for (int n = 0; n < 128; n += 3) {
                if (n + 1 < 128) GS_STORE(rb, (n + 1) & 1);
                GS_LOAD(rb, CLAMPN(n + 4)); __syncthreads();
                if (n + 1 < 128) { if (n + 2 < 128) GS_STORE(rc, (n + 2) & 1);
                    GS_LOAD(rc, CLAMPN(n + 5)); __syncthreads(); }
                if (n + 2 < 128) { if (n + 3 < 128) GS_STORE(ra, (n + 3) & 1);
                    GS_LOAD(ra, CLAMPN(n + 6)); __syncthreads(); }
            }
        } else {
            const int tdv = pair * 2 + wv;
            f32x4 S[8];
#pragma unroll
            for (int t = 0; t < 8; ++t) S[t] = (f32x4){0.f, 0.f, 0.f, 0.f};
            __syncthreads();
            for (int n = 0; n < 128; ++n) {
                const unsigned char* base = lds + (n & 1) * STG;
                const unsigned char* Pf = base + lane * 16, *Rf = base + 32768 + lane * 16;
                const unsigned char* Qf = base + 49152 + wv * 4096 + lane * 8, *Of = base + 57344 + wv * 2048 + lane * 8;
                SCAN_BODY
                __syncthreads();
            }
        }
    }
}

__device__ __forceinline__ void block_sum4(int (&v)[4], int* buf) {
    const int lane = threadIdx.x & 63, wv = threadIdx.x >> 6;
#pragma unroll
    for (int q = 0; q < 4; ++q) v[q] = wave_sum_i(v[q]);
    if (lane == 0) {
#pragma unroll
        for (int q = 0; q < 4; ++q) buf[wv * 4 + q] = v[q];
    }
    __syncthreads();
#pragma unroll
    for (int q = 0; q < 4; ++q) { int a = 0; for (int w = 0; w < 8; ++w) a += buf[w * 4 + q]; v[q] = a; }
}

PHASE_FN void ph_dsa_topk(const Params& p, int layer, float* smem) {
    unsigned char* ws_ = p.ws; asm volatile("" : "+s"(ws_));
    int tid_ = threadIdx.x; asm volatile("" : "+v"(tid_)); const int tid = tid_, lane = tid & 63, wv = __builtin_amdgcn_readfirstlane(tid >> 6), q4 = lane >> 4, c16 = lane & 15;
    int* sRed = (int*)g_smem;
    const bf16_t* QIb = (const bf16_t*)(ws_ + OFF_QIB); const bf16_t* KIb = (const bf16_t*)(ws_ + OFF_KIB); const float* WI = (const float*)(ws_ + OFF_WI);
    unsigned short* M16 = (unsigned short*)(ws_ + OFF_M16);
    int* qhead = (int*)(ws_ + OFF_QCTR) + layer * 16;
    int* sIt = (int*)(g_smem + 512);
    for (;;) {
        __syncthreads();
        if (tid == 0) *sIt = atomicAdd(qhead, 1);
        __syncthreads();
        const int it = *sIt;
        if (it >= 2048) break;
        const int b = it & 1, gp = 1023 - (it >> 1);
        const int s0 = gp * 8, t0 = b * 8192 + s0;
        const int ntiles = (s0 >> 4) + 1;
        const int nreg = (ntiles > wv) ? ((ntiles - wv + 7) >> 3) : 0;
        const bf16_t* qp = QIb + (size_t)(t0 + (c16 >> 2)) * 256 + (c16 & 3) * 64 + 8 * q4;
        const bf16x8 a0A = *(const bf16x8*)qp, a1A = *(const bf16x8*)(qp + 32), a0B = *(const bf16x8*)(qp + 4 * 256), a1B = *(const bf16x8*)(qp + 4 * 256 + 32);
        const float4 wqA = *(const float4*)(WI + (size_t)(t0 + q4) * 4), wqB = *(const float4*)(WI + (size_t)(t0 + 4 + q4) * 4);
        const int myqA = s0 + q4, myqB = s0 + 4 + q4;
        int c16s = c16; asm volatile("" : "+v"(c16s));
        int wvs = wv; asm volatile("" : "+s"(wvs));
        unsigned kA[64], kB[64];
#pragma unroll
        for (int i = 0; i < 64; ++i) { kA[i] = 0u; kB[i] = 0u; }
#pragma unroll
        for (int blk = 0; blk < 4; ++blk) if (nreg > blk * 16) {
#pragma unroll
            for (int ii = 0; ii < 16; ++ii) { const int i = blk * 16 + ii, tile = wvs + 8 * i;
                if (tile < ntiles) {
                    const bf16_t* kp = KIb + (size_t)(b * 8192 + tile * 16 + c16s) * 64 + 8 * q4;
                    const bf16x8 k0 = *(const bf16x8*)kp, k1 = *(const bf16x8*)(kp + 32);
                    f32x4 accA = (f32x4){0.f, 0.f, 0.f, 0.f}, accB = accA;
                    accA = __builtin_amdgcn_mfma_f32_16x16x32_bf16(a0A, k0, accA, 0, 0, 0);
                    accB = __builtin_amdgcn_mfma_f32_16x16x32_bf16(a0B, k0, accB, 0, 0, 0);
                    accA = __builtin_amdgcn_mfma_f32_16x16x32_bf16(a1A, k1, accA, 0, 0, 0);
                    accB = __builtin_amdgcn_mfma_f32_16x16x32_bf16(a1B, k1, accB, 0, 0, 0);
                    float sa = 0.f, sb = 0.f;
                    sa += wqA.x * fmaxf(accA[0], 0.f); sa += wqA.y * fmaxf(accA[1], 0.f); sa += wqA.z * fmaxf(accA[2], 0.f); sa += wqA.w * fmaxf(accA[3], 0.f);
                    sb += wqB.x * fmaxf(accB[0], 0.f); sb += wqB.y * fmaxf(accB[1], 0.f); sb += wqB.z * fmaxf(accB[2], 0.f); sb += wqB.w * fmaxf(accB[3], 0.f);
                    const int kidx = tile * 16 + c16s;
                    kA[i] = (kidx <= myqA) ? ordkey(sa) : 0u;
                    kB[i] = (kidx <= myqB) ? ordkey(sb) : 0u;
                }
                if ((ii & 3) == 3) asm volatile("" ::: "memory"); }
        }
        const int keffA = (myqA + 1 < 256) ? (myqA + 1) : 256, keffB = (myqB + 1 < 256) ? (myqB + 1) : 256;
        int par = 0;
        int mydone = 0, alldone = 0;
        int* sDone = sRed + 64;
        auto qsum = [&](int c) -> int {
            c += __shfl_xor(c, 1); c += __shfl_xor(c, 2); c += __shfl_xor(c, 4); c += __shfl_xor(c, 8);
            par ^= 1;
            if (c16 == 0) { sRed[par * 32 + wv * 4 + q4] = c; if (wv == 0) sDone[par * 4 + q4] = (mydone == 3) ? 1 : 0; }
            __syncthreads();
            int a = 0;
#pragma unroll
            for (int w = 0; w < 8; ++w) a += sRed[par * 32 + w * 4 + q4];
            alldone = sDone[par * 4] & sDone[par * 4 + 1] & sDone[par * 4 + 2] & sDone[par * 4 + 3];
            return a;
        };
        unsigned UA = 0u, UB = 0u;
        for (int bit = 31; bit >= 0; --bit) {
            const unsigned candA = UA | (1u << bit), candB = UB | (1u << bit);
            int ca = 0, cb = 0;
            if (!alldone) {
#pragma unroll
            for (int blk = 0; blk < 4; ++blk) if (nreg > blk * 16) {
#pragma unroll
                for (int ii = 0; ii < 16; ++ii) { ca += (kA[blk * 16 + ii] >= candA) ? 1 : 0; cb += (kB[blk * 16 + ii] >= candB) ? 1 : 0; }
            } }
            const int tot = qsum(ca | (cb << 16));
            if ((tot & 0xffff) >= keffA) { UA = candA; mydone = (mydone & 2) | (((tot & 0xffff) == keffA) ? 1 : 0); }
            if ((tot >> 16) >= keffB) { UB = candB; mydone = (mydone & 1) | (((tot >> 16) == keffB) ? 2 : 0); }
        }
        int cg = 0, ce = 0;
#pragma unroll
        for (int i = 0; i < 64; ++i) { cg += (kA[i] > UA) ? 1 : 0; ce += (kA[i] == UA) ? 1 : 0; cg += (kB[i] > UB) ? 65536 : 0; ce += (kB[i] == UB) ? 65536 : 0; }
        cg = qsum(cg); ce = qsum(ce);
        const int needA = keffA - (cg & 0xffff), needB = keffB - (cg >> 16);
        int JA = 8191, JB = 8191;
        par ^= 1;
        if (c16 == 0) sRed[par * 32 + wv * 4 + q4] = (((ce & 0xffff) > needA) || ((ce >> 16) > needB)) ? 1 : 0;
        __syncthreads();
        int anyov = 0;
#pragma unroll
        for (int w = 0; w < 32; ++w) anyov |= sRed[par * 32 + w];
        if (anyov) {
            JA = 0; JB = 0;
            int c16j = c16; asm volatile("" : "+v"(c16j));
            int wvj = wv; asm volatile("" : "+s"(wvj));
            for (int bit = 12; bit >= 0; --bit) {
                const int cjA = JA | (1 << bit), cjB = JB | (1 << bit);
                int c = 0;
#pragma unroll
                for (int i = 0; i < 64; ++i) { const int kidx = (wvj + 8 * i) * 16 + c16j; c += (kA[i] == UA && kidx < cjA) ? 1 : 0; c += (kB[i] == UB && kidx < cjB) ? 65536 : 0; }
                const int tot = qsum(c);
                if ((tot & 0xffff) <= needA - 1) JA = cjA;
                if ((tot >> 16) <= needB - 1) JB = cjB;
            }
        }
        unsigned short* sM = (unsigned short*)(g_smem + 1024);
        { unsigned z_ = 0u; asm volatile("" : "+v"(z_)); ((uint4*)sM)[tid] = make_uint4(z_, z_, z_, z_); }
        __syncthreads();
        int c16e = c16; asm volatile("" : "+v"(c16e));
        int wve = wv; asm volatile("" : "+s"(wve));
#pragma unroll
        for (int blk = 0; blk < 4; ++blk) if (nreg > blk * 16) {
#pragma unroll
            for (int ii = 0; ii < 16; ++ii) { const int i = blk * 16 + ii;
                const int tile = wve + 8 * i, kidx = tile * 16 + c16e;
                const bool selA = kA[i] > UA || (kA[i] == UA && kidx <= JA);
                const bool selB = kB[i] > UB || (kB[i] == UB && kidx <= JB);
                const unsigned long long balA = __ballot(selA), balB = __ballot(selB);
                if (c16 == 0) { sM[q4 * 512 + tile] = (unsigned short)((balA >> (16 * q4)) & 0xffffull);
                                sM[(4 + q4) * 512 + tile] = (unsigned short)((balB >> (16 * q4)) & 0xffffull); }
            }
        }
        __syncthreads();
        *(uint4*)(M16 + (size_t)(t0 + (tid >> 6)) * 512 + (tid & 63) * 8) = ((const uint4*)sM)[tid];
    }
}

PHASE_FN void ph_dsa_attn(const Params& p, float* smem) {
    unsigned char* ws_ = p.ws; asm volatile("" : "+s"(ws_));
    int tid_ = threadIdx.x; asm volatile("" : "+v"(tid_)); const int tid = tid_, lane = tid & 63, wv = tid >> 6, q4 = lane >> 4, c16 = lane & 15;
    int ldz_ = 0; asm volatile("" : "+s"(ldz_)); unsigned char* lds = g_smem + ldz_;
    const bf16_t* QBb = (const bf16_t*)(ws_ + OFF_QBB); const bf16_t* KBb = (const bf16_t*)(ws_ + OFF_KBB); const bf16_t* VT = (const bf16_t*)(ws_ + OFF_VT);
    const unsigned short* M16 = (const unsigned short*)(ws_ + OFF_M16);
    bf16_t* OB = (bf16_t*)(ws_ + OFF_OB);
    const float SC = SCALE128 * 1.4426950408889634f;
    for (int it = blockIdx.x; it < 256; it += gridDim.x) {
        const int bh = it & 7, jp = it >> 3, b = bh >> 2, h = bh & 3;
        for (int half = 0; half < 2; ++half) {
            const int jq = half ? jp : 63 - jp;
            const int qs = jq * 128, nkt = 2 * jq + 2;
            const int tq = b * 8192 + qs + wv * 16 + c16;
            bf16x8 qf[4];
#pragma unroll
            for (int a = 0; a < 4; ++a) qf[a] = *(const bf16x8*)(QBb + (size_t)tq * 512 + h * 128 + 8 * q4 + 32 * a);
            float m = -1e30f, lsum = 0.f;
            f32x4 oacc[8];
#pragma unroll
            for (int t = 0; t < 8; ++t) oacc[t] = (f32x4){0.f, 0.f, 0.f, 0.f};
            uint4 rk0, rk1, rv0, rv1;
            const int q0 = tid, q1 = tid + 512;
            const bf16_t* kg0 = KBb + (size_t)(b * 8192 + (q0 >> 4)) * 512 + h * 128 + (q0 & 15) * 8;
            const bf16_t* kg1 = KBb + (size_t)(b * 8192 + (q1 >> 4)) * 512 + h * 128 + (q1 & 15) * 8;
            const bf16_t* vg0 = VT + ((size_t)((b * 4 + h) * 128 + (q0 >> 3))) * 8192 + (q0 & 7) * 8;
            const bf16_t* vg1 = VT + ((size_t)((b * 4 + h) * 128 + (q1 >> 3))) * 8192 + (q1 & 7) * 8;
            const int lk0 = (q0 >> 4) * 256 + ((((q0 & 15)) ^ ((q0 >> 4) & 15)) << 4), lk1 = (q1 >> 4) * 256 + ((((q1 & 15)) ^ ((q1 >> 4) & 15)) << 4);
            const int lv0 = 16384 + (q0 >> 3) * 128 + ((((q0 & 7)) ^ ((q0 >> 3) & 7)) << 4), lv1 = 16384 + (q1 >> 3) * 128 + ((((q1 & 7)) ^ ((q1 >> 3) & 7)) << 4);
#define ATT_GLOAD(kt_) do { rk0 = *(const uint4*)(kg0 + (size_t)(kt_) * 64 * 512); rk1 = *(const uint4*)(kg1 + (size_t)(kt_) * 64 * 512); \
                            rv0 = *(const uint4*)(vg0 + (kt_) * 64); rv1 = *(const uint4*)(vg1 + (kt_) * 64); } while (0)
#define ATT_LSTORE(st_) do { unsigned char* base_ = lds + (st_) * 32768; *(uint4*)(base_ + lk0) = rk0; *(uint4*)(base_ + lk1) = rk1; *(uint4*)(base_ + lv0) = rv0; *(uint4*)(base_ + lv1) = rv1; } while (0)
            __syncthreads();
            ATT_GLOAD(0); ATT_LSTORE(0);
            __syncthreads();
            for (int kt = 0; kt < nkt; ++kt) {
                if (kt + 1 < nkt) ATT_GLOAD(kt + 1);
                const unsigned long long mbits = *(const unsigned long long*)(M16 + (size_t)tq * 512 + 4 * kt);
                const unsigned char* Kt = lds + (kt & 1) * 32768;
                const unsigned char* Vt = Kt + 16384;
                f32x4 sacc[4];
#pragma unroll
                for (int ti = 0; ti < 4; ++ti) { sacc[ti] = (f32x4){0.f, 0.f, 0.f, 0.f};
                    const int row = 16 * ti + c16;
#pragma unroll
                    for (int a = 0; a < 4; ++a) { const bf16x8 kf = *(const bf16x8*)(Kt + row * 256 + ((((q4 + 4 * a)) ^ (row & 15)) << 4));
                        sacc[ti] = __builtin_amdgcn_mfma_f32_16x16x32_bf16(kf, qf[a], sacc[ti], 0, 0, 0); } }
                float mx = m;
#pragma unroll
                for (int ti = 0; ti < 4; ++ti)
#pragma unroll
                    for (int r = 0; r < 4; ++r) { const bool valid = (mbits >> (16 * ti + 4 * q4 + r)) & 1ull; const float v = sacc[ti][r] * SC; sacc[ti][r] = v; mx = fmaxf(mx, valid ? v : -1e30f); }
                mx = fmaxf(mx, __shfl_xor(mx, 16)); mx = fmaxf(mx, __shfl_xor(mx, 32));
                const float alpha = __builtin_amdgcn_exp2f(m - mx); m = mx;
                float ps = 0.f;
#pragma unroll
                for (int ti = 0; ti < 4; ++ti)
#pragma unroll
                    for (int r = 0; r < 4; ++r) { const bool valid = (mbits >> (16 * ti + 4 * q4 + r)) & 1ull; const float pv = valid ? __builtin_amdgcn_exp2f(sacc[ti][r] - mx) : 0.f; sacc[ti][r] = pv; ps += pv; }
                lsum = lsum * alpha + ps;
#pragma unroll
                for (int t = 0; t < 8; ++t) oacc[t] = oacc[t] * alpha;
                bf16x8 pb[2];
#pragma unroll
                for (int a = 0; a < 2; ++a) {
                    union { uint4 u; bf16x8 v; } cv;
                    cv.u.x = cvt_pk_bf16(sacc[2 * a][0], sacc[2 * a][1]); cv.u.y = cvt_pk_bf16(sacc[2 * a][2], sacc[2 * a][3]);
                    cv.u.z = cvt_pk_bf16(sacc[2 * a + 1][0], sacc[2 * a + 1][1]); cv.u.w = cvt_pk_bf16(sacc[2 * a + 1][2], sacc[2 * a + 1][3]);
                    pb[a] = cv.v; }
#pragma unroll
                for (int t = 0; t < 8; ++t) { const int row = 16 * t + c16;
#pragma unroll
                    for (int a = 0; a < 2; ++a) {
                        union { uint2 h2[2]; bf16x8 v; } vf;
                        vf.h2[0] = *(const uint2*)(Vt + row * 128 + ((((4 * a + (q4 >> 1))) ^ (row & 7)) << 4) + 8 * (q4 & 1));
                        vf.h2[1] = *(const uint2*)(Vt + row * 128 + ((((4 * a + 2 + (q4 >> 1))) ^ (row & 7)) << 4) + 8 * (q4 & 1));
                        oacc[t] = __builtin_amdgcn_mfma_f32_16x16x32_bf16(vf.v, pb[a], oacc[t], 0, 0, 0); } }
                if (kt + 1 < nkt) ATT_LSTORE((kt + 1) & 1);
                __syncthreads();
            }
            lsum += __shfl_xor(lsum, 16); lsum += __shfl_xor(lsum, 32);
            const float inv = 1.f / lsum;
#pragma unroll
            for (int t = 0; t < 8; ++t) *(uint2*)(OB + (size_t)tq * 1024 + 512 + h * 128 + 16 * t + 4 * q4) = pack4(oacc[t] * inv);
        }
    }
}

PHASE_FN void ph_gdn_out(const Params& p, int layer) {
    unsigned char* ws_ = p.ws; asm volatile("" : "+s"(ws_));
    int tid_ = threadIdx.x; asm volatile("" : "+v"(tid_)); const int tid = tid_, lane = tid & 63, wv = tid >> 6;
    const float* O = (const float*)(ws_ + OFF_O); const bf16_t* P = (const bf16_t*)(ws_ + OFF_P); bf16_t* OB = (bf16_t*)(ws_ + OFF_OB);
    const float* onw = p.gdn_out_norm + (layer >> 1) * 128;
    for (int t = blockIdx.x * 8 + wv; t < NT; t += gridDim.x * 8) {
#pragma unroll
        for (int h = 0; h < 4; ++h) {
            const float* op = O + (size_t)t * 1024 + h * 128; bf16_t* ob = OB + (size_t)t * 1024 + h * 128;
            const float o0 = op[lane], o1 = op[64 + lane];
            const float ss = wave_sum(o0 * o0 + o1 * o1);
            const float r = rsqrtf(ss * (1.f / 128.f) + EPS);
            const float z0 = PBF(P, t, 1536 + h * 128 + lane), z1 = PBF(P, t, 1536 + h * 128 + 64 + lane);
            ob[lane] = f2bf(o0 * r * onw[lane] * siluf_(z0)); ob[64 + lane] = f2bf(o1 * r * onw[64 + lane] * siluf_(z1));
        }
    }
}

struct EpiOut {
    static constexpr bool PERM = false;
    const float* Xres; float* X; const float* gt0;
    __device__ __forceinline__ void operator()(const f32x4 (&acc)[2][2][4][2], const pg8::Unit& u, int wr, int wc, int fr, int fq) const {
        const int row0 = u.pm * 256 + wr * 64 + fr, col0 = u.pn * 256 + wc * 32 + 4 * fq;
        const float* gt = gt0 + (size_t)(row0 >> 13) * 6144 + col0;
        f32x4 gv[2][2];
#pragma unroll
        for (int bj = 0; bj < 2; ++bj)
#pragma unroll
            for (int n = 0; n < 2; ++n) gv[bj][n] = *(const f32x4*)(gt + bj * 128 + n * 16);
#pragma unroll
        for (int ai = 0; ai < 2; ++ai)
#pragma unroll
            for (int m = 0; m < 4; ++m) { const size_t off = (size_t)(row0 + ai * 128 + m * 16) * ND + col0;
#pragma unroll
                for (int bj = 0; bj < 2; ++bj)
#pragma unroll
                    for (int n = 0; n < 2; ++n) *(f32x4*)(X + off + bj * 128 + n * 16) = *(const f32x4*)(Xres + off + bj * 128 + n * 16) + gv[bj][n] * acc[ai][bj][m][n]; }
    }
};

PHASE_FN void ph_gemm_out(const Params& p, int layer, float* smem) {
    unsigned char* ws_ = p.ws; asm volatile("" : "+s"(ws_));
    int ldz_ = 0; asm volatile("" : "+s"(ldz_));
    const bf16_t* Wt = (const bf16_t*)(ws_ + OFF_WOUT) + (size_t)layer * 1024 * 1024;
    EpiOut E; E.Xres = (layer == 0) ? p.x : (const float*)p.X; E.X = p.X; E.gt0 = (const float*)(ws_ + OFF_MOD) + (size_t)(layer * 2) * 6144 + 2048;
    pg8::DenseOrder S; S.init(64, 4, gridDim.x, blockIdx.x, 1024);
    __syncthreads();
    pg8::gemm_phase<EpiOut, pg8::DenseOrder, false>((LAS unsigned char*)(g_smem + ldz_), (const bf16_t*)(ws_ + OFF_OB), Wt, 1024, S, E);
    __syncthreads();
}

PHASE_FN void ph_norm_ffn(const Params& p, int layer) {
    unsigned char* ws_ = p.ws; asm volatile("" : "+s"(ws_));
    int tid_ = threadIdx.x; asm volatile("" : "+v"(tid_)); const int tid = tid_, lane = tid & 63, wv = tid >> 6;
    const float* MOD = (const float*)(ws_ + OFF_MOD);
    bf16_t* H = (bf16_t*)(ws_ + OFF_H);
    int* CNT = (int*)(ws_ + OFF_CNT) + layer * 32 * CSTR;
    int* sCnt = (int*)g_smem; int* sBase = sCnt + 32; int* sE = sBase + 32; int* sR = sE + 256;
    const int nrb = (NT + (int)gridDim.x - 1) / (int)gridDim.x, row_lo = blockIdx.x * nrb, row_hi = (row_lo + nrb < NT) ? row_lo + nrb : NT;
    __syncthreads();
    if (tid < 32) sCnt[tid] = 0;
    __syncthreads();
    int* ASG = (int*)(ws_ + OFF_ASG); float* GATE = (float*)(ws_ + OFF_GATE); int* LIST = (int*)(ws_ + OFF_LIST);
    const float* nw = p.norm_ffn + layer * 1024;
    const float* wg = p.rg_w + (size_t)layer * 1024 * 4;
    for (int row = row_lo + wv; row < row_hi; row += 8) {
        const int b = row >> 13;
        const float* xr = p.X + (size_t)row * ND;
        const float* sh = MOD + (size_t)(layer * 2 + b) * 6144 + 3072;
        const float* sc = sh + 1024;
        float hv[16]; float ss = 0.f;
#pragma unroll
        for (int j = 0; j < 4; ++j) { const float4 v = *(const float4*)(xr + j * 256 + lane * 4); hv[4 * j] = v.x; hv[4 * j + 1] = v.y; hv[4 * j + 2] = v.z; hv[4 * j + 3] = v.w; }
#pragma unroll
        for (int j = 0; j < 16; ++j) ss += hv[j] * hv[j];
        ss = wave_sum(ss);
        const float rstd = rsqrtf(ss * (1.f / 1024.f) + EPS);
#pragma unroll
        for (int j = 0; j < 4; ++j) {
            const int col = j * 256 + lane * 4;
            const float4 w = *(const float4*)(nw + col), s4 = *(const float4*)(sc + col), h4 = *(const float4*)(sh + col);
            hv[4 * j] = hv[4 * j] * rstd * w.x * (1.f + s4.x) + h4.x; hv[4 * j + 1] = hv[4 * j + 1] * rstd * w.y * (1.f + s4.y) + h4.y;
            hv[4 * j + 2] = hv[4 * j + 2] * rstd * w.z * (1.f + s4.z) + h4.z; hv[4 * j + 3] = hv[4 * j + 3] * rstd * w.w * (1.f + s4.w) + h4.w;
            { f32x4 ov; ov[0] = hv[4 * j]; ov[1] = hv[4 * j + 1]; ov[2] = hv[4 * j + 2]; ov[3] = hv[4 * j + 3]; *(uint2*)(H + (size_t)row * ND + col) = pack4(ov); }
        }
        float gl[4] = {0.f, 0.f, 0.f, 0.f};
#pragma unroll
        for (int j = 0; j < 4; ++j)
#pragma unroll
            for (int e = 0; e < 4; ++e) { const int col = j * 256 + lane * 4 + e; const float4 w = *(const float4*)(wg + (size_t)col * 4); const float hh = hv[4 * j + e];
                gl[0] += hh * w.x; gl[1] += hh * w.y; gl[2] += hh * w.z; gl[3] += hh * w.w; }
#pragma unroll
        for (int g = 0; g < 4; ++g) gl[g] = wave_sum(gl[g]) + p.rg_b[layer * 4 + g];
        int gs = 0; float gm = gl[0];
#pragma unroll
        for (int g = 1; g < 4; ++g) if (gl[g] > gm) { gm = gl[g]; gs = g; }
        float gsum = 0.f;
#pragma unroll
        for (int g = 0; g < 4; ++g) gsum += expf(gl[g] - gm);
        const float ggate = 1.f / gsum;
        const float* we = p.re_w + ((size_t)(layer * 4 + gs) * 1024) * 8;
        float el[8] = {0.f, 0.f, 0.f, 0.f, 0.f, 0.f, 0.f, 0.f};
#pragma unroll
        for (int j = 0; j < 4; ++j)
#pragma unroll
            for (int e = 0; e < 4; ++e) { const int col = j * 256 + lane * 4 + e; const float4 w0 = *(const float4*)(we + (size_t)col * 8), w1 = *(const float4*)(we + (size_t)col * 8 + 4); const float hh = hv[4 * j + e];
                el[0] += hh * w0.x; el[1] += hh * w0.y; el[2] += hh * w0.z; el[3] += hh * w0.w; el[4] += hh * w1.x; el[5] += hh * w1.y; el[6] += hh * w1.z; el[7] += hh * w1.w; }
#pragma unroll
        for (int e = 0; e < 8; ++e) el[e] = wave_sum(el[e]) + p.re_b[(layer * 4 + gs) * 8 + e];
        int i1 = 0; float l1 = el[0];
#pragma unroll
        for (int e = 1; e < 8; ++e) if (el[e] > l1) { l1 = el[e]; i1 = e; }
        int i2 = -1; float l2 = -INFINITY;
#pragma unroll
        for (int e = 0; e < 8; ++e) if (e != i1 && el[e] > l2) { l2 = el[e]; i2 = e; }
        const float ex = expf(l2 - l1);
        const float p1 = 1.f / (1.f + ex), p2 = ex / (1.f + ex);
        if (lane == 0) {
            const int e1 = gs * 8 + i1, e2 = gs * 8 + i2, lr = row - row_lo;
            sE[lr * 2] = e1; sE[lr * 2 + 1] = e2;
            sR[lr * 2] = atomicAdd(&sCnt[e1], 1); sR[lr * 2 + 1] = atomicAdd(&sCnt[e2], 1);
            GATE[row * 2] = ggate * p1; GATE[row * 2 + 1] = ggate * p2;
        }
    }
    __syncthreads();
    if (tid < 32) sBase[tid] = (sCnt[tid] > 0) ? atomicAdd(&CNT[tid * CSTR], sCnt[tid]) : 0;
    __syncthreads();
    for (int a = tid; a < (row_hi - row_lo) * 2; a += NTHREADS) {
        const int row = row_lo + (a >> 1), e = sE[a], r = sBase[e] + sR[a];
        LIST[(size_t)e * LISTCAP + r] = row;
        ASG[row * 4 + (a & 1) * 2] = e; ASG[row * 4 + (a & 1) * 2 + 1] = r;
    }
}

struct MoeOrder {
    const int* sTs; const int* sPad; const int* CNT; const int* LIST; int G, c, which, K;
    __device__ __forceinline__ bool next(int i, pg8::Unit& u) const {
        const long L = (long)i * G + c; if (L >= (long)__builtin_amdgcn_readfirstlane(sTs[32]) * 4) return false;
        const int mt = (int)(L >> 2), nt = (int)(L & 3);
        int e = 0;
        for (int q = 1; q < 32; ++q) if (__builtin_amdgcn_readfirstlane(sTs[q]) <= mt) e = q;
        const int mi = mt - __builtin_amdgcn_readfirstlane(sTs[e]), cnt = __builtin_amdgcn_readfirstlane(CNT[e * CSTR]);
        u.pm = mt; u.pn = nt; u.e = e; u.mi = mi; u.mvalid = (cnt - mi * 256 < 256) ? (cnt - mi * 256) : 256; u.rowbase = __builtin_amdgcn_readfirstlane(sPad[e]) + mi * 256;
        u.boff = ((size_t)e * 1024 + nt * 256) * K * 2;
        u.aoff = which ? (size_t)u.rowbase * 512 * 2 : 0;
        return true;
    }
    __device__ __forceinline__ int row(const pg8::Unit& u, int r) const { const int rr = (r < u.mvalid) ? r : 0; return LIST[(size_t)u.e * LISTCAP + u.mi * 256 + rr]; }
};
struct EpiMoe1 {
    static constexpr bool PERM = false;
    bf16_t* HID;
    __device__ __forceinline__ void operator()(const f32x4 (&acc)[2][2][4][2], const pg8::Unit& u, int wr, int wc, int fr, int fq) const {
#pragma unroll
        for (int ai = 0; ai < 2; ++ai)
#pragma unroll
            for (int m = 0; m < 4; ++m) { const int rl = ai * 128 + wr * 64 + m * 16 + fr;
                if (rl < u.mvalid) {
#pragma unroll
                    for (int bj = 0; bj < 2; ++bj) { const f32x4 a1 = acc[ai][bj][m][0], a3 = acc[ai][bj][m][1]; f32x4 hv;
                        hv[0] = siluf_(a1[0]) * a3[0]; hv[1] = siluf_(a1[1]) * a3[1]; hv[2] = siluf_(a1[2]) * a3[2]; hv[3] = siluf_(a1[3]) * a3[3];
                        *(uint2*)(HID + (size_t)(u.rowbase + rl) * 512 + u.pn * 128 + bj * 64 + wc * 16 + 4 * fq) = pack4(hv); } } }
    }
};
struct EpiMoe2 {
    static constexpr bool PERM = true;
    bf16_t* YB;
    __device__ __forceinline__ void operator()(const f32x4 (&acc)[2][2][4][2], const pg8::Unit& u, int wr, int wc, int fr, int fq) const {
#pragma unroll
        for (int ai = 0; ai < 2; ++ai)
#pragma unroll
            for (int m = 0; m < 4; ++m) { const int rl = ai * 128 + wr * 64 + m * 16 + fr;
                if (rl < u.mvalid) {
#pragma unroll
                    for (int bj = 0; bj < 2; ++bj) { const uint2 lo = pack4(acc[ai][bj][m][0]), hi = pack4(acc[ai][bj][m][1]);
                        *(uint4*)(YB + (size_t)(u.rowbase + rl) * 1024 + u.pn * 256 + bj * 128 + wc * 32 + 8 * fq) = make_uint4(lo.x, lo.y, hi.x, hi.y); } } }
    }
};

PHASE_FN void ph_moe(const Params& p, int layer, int which, float* smem) {
    unsigned char* ws_ = p.ws; asm volatile("" : "+s"(ws_));
    int ldz_ = 0; asm volatile("" : "+s"(ldz_));
    int tid_ = threadIdx.x; asm volatile("" : "+v"(tid_)); const int tid = tid_;
    int* sPad = (int*)(g_smem + ldz_ + 131072); int* sTs = sPad + 40;
    const int* CNT = (const int*)(ws_ + OFF_CNT) + layer * 32 * CSTR;
    __syncthreads();
    if (tid == 0) { int a = 0, ts = 0; for (int e = 0; e < 32; ++e) { sPad[e] = a; sTs[e] = ts; a += ((CNT[e * CSTR] + 127) / 128) * 128; ts += (CNT[e * CSTR] + 255) / 256; } sTs[32] = ts; sPad[32] = a; }
    __syncthreads();
    MoeOrder S; S.sTs = sTs; S.sPad = sPad; S.CNT = CNT; S.LIST = (const int*)(ws_ + OFF_LIST); S.G = gridDim.x; S.which = which; S.K = which ? 512 : 1024;
    S.c = (((int)gridDim.x & 7) == 0) ? (((int)blockIdx.x & 7) * ((int)gridDim.x >> 3) + ((int)blockIdx.x >> 3)) : (int)blockIdx.x;
    if (which == 0) {
        EpiMoe1 E; E.HID = (bf16_t*)(ws_ + OFF_HID);
        pg8::gemm_phase<EpiMoe1, MoeOrder, true>((LAS unsigned char*)(g_smem + ldz_), (const bf16_t*)(ws_ + OFF_H), (const bf16_t*)(ws_ + OFF_W13), 1024, S, E);
    } else {
        EpiMoe2 E; E.YB = (bf16_t*)(ws_ + OFF_YB);
        pg8::gemm_phase<EpiMoe2, MoeOrder, false>((LAS unsigned char*)(g_smem + ldz_), (const bf16_t*)(ws_ + OFF_HID), (const bf16_t*)(ws_ + OFF_W2T), 512, S, E);
    }
    __syncthreads();
}

PHASE_FN void ph_conv_dense(const Params& p, float* smem) {
    unsigned char* ws_ = p.ws; asm volatile("" : "+s"(ws_));
    { int ldz_ = 0; asm volatile("" : "+s"(ldz_)); smem = (float*)(g_smem + ldz_); }
    auto dec = [&](int t, const float*& s0, const float*& s1, bf16_t*& dst, int& mode, int& K, int& N, int& ld, int& rt, int& kt) {
        s1 = nullptr; mode = 0; K = 1024;
        if (t >= 4672) t = 4671;
        if (t >= 4608) { const int v = t - 4608, l = v >> 5, u = v & 31; s0 = p.gla_w_in + (size_t)l * 1024 * 3088 + 3072; N = 16; ld = 3088; dst = (bf16_t*)(ws_ + OFF_WGL) + (size_t)l * 128 * 1024; rt = u >> 4; kt = u & 15; }
        else if (t < 2048) { const int l = t >> 10, u = t & 1023; s0 = p.even_w_in + (size_t)l * 1024 * 3916; N = 3916; ld = 3916; dst = (bf16_t*)(ws_ + OFF_WINE) + (size_t)l * 4096 * 1024; rt = u >> 4; kt = u & 15; }
        else if (t < 3584) { const int v = t - 2048, l = v / 768, u = v % 768; s0 = p.gla_w_in + (size_t)l * 1024 * 3088; N = 3072; ld = 3088; dst = (bf16_t*)(ws_ + OFF_WINO) + (size_t)l * 3072 * 1024; rt = u >> 4; kt = u & 15; }
        else { const int v = t - 3584, l = v >> 8, u = v & 255; s0 = ((l & 1) ? p.gla_w_out : p.even_w_out) + (size_t)(l >> 1) * 1024 * 1024; N = 1024; ld = 1024; dst = (bf16_t*)(ws_ + OFF_WOUT) + (size_t)l * 1024 * 1024; rt = u >> 4; kt = u & 15; }
    };
    for (int t = blockIdx.x * 4; t < 4672; t += gridDim.x * 4) convert_tiles4(dec, t, (4672 - t < 4) ? (4672 - t) : 4, smem);
}

PHASE_FN void ph_conv_exp(const Params& p, int layer, float* smem, int first_blk) {
    unsigned char* ws_ = p.ws; asm volatile("" : "+s"(ws_));
    { int ldz_ = 0; asm volatile("" : "+s"(ldz_)); smem = (float*)(g_smem + ldz_); }
    if ((int)blockIdx.x < first_blk) return;
    auto dec = [&](int t, const float*& s0, const float*& s1, bf16_t*& dst, int& mode, int& K, int& N, int& ld, int& rt, int& kt) {
        if (t >= 12288) t = 12287;
        if (t < 8192) { const int e = t >> 8, u = t & 255; s0 = p.w1 + (size_t)(layer * 32 + e) * 1024 * 512; s1 = p.w3 + (size_t)(layer * 32 + e) * 1024 * 512; mode = 1; K = 1024; N = 512; ld = 512;
            dst = (bf16_t*)(ws_ + OFF_W13) + (size_t)e * 1024 * 1024; rt = u >> 4; kt = u & 15; }
        else { const int v = t - 8192, e = v >> 7, u = v & 127; s0 = p.w2 + (size_t)(layer * 32 + e) * 512 * 1024; s1 = nullptr; mode = 0; K = 512; N = 1024; ld = 1024;
            dst = (bf16_t*)(ws_ + OFF_W2T) + (size_t)e * 1024 * 512; rt = u >> 3; kt = u & 7; }
    };
    const int nb = (int)gridDim.x - first_blk;
    for (int t = ((int)blockIdx.x - first_blk) * 4; t < 12288; t += nb * 4) convert_tiles4(dec, t, (12288 - t < 4) ? (12288 - t) : 4, smem);
}

PHASE_FN void ph_gla_tok(const Params& p, int layer) {
    unsigned char* ws_ = p.ws; asm volatile("" : "+s"(ws_));
    int tid_ = threadIdx.x; asm volatile("" : "+v"(tid_)); const int tid = tid_, lane = tid & 63, wv = tid >> 6, li = layer >> 1;
    const float* AUX = (const float*)(ws_ + OFF_AUX);
    float* LA = (float*)(ws_ + OFF_LA);
    const float* w2 = p.gla_w_gate2 + (size_t)li * 16 * 512; const float* b2 = p.gla_b_gate2 + li * 512;
    for (int t = blockIdx.x * 8 + wv; t < NT; t += gridDim.x * 8) {
        float glr[16];
#pragma unroll
        for (int r = 0; r < 16; ++r) glr[r] = AUX[(size_t)t * 16 + r];
#pragma unroll 1
        for (int i = 0; i < 8; ++i) {
            const int c = lane + 64 * i; float z = b2[c];
#pragma unroll
            for (int r = 0; r < 16; ++r) z += glr[r] * w2[r * 512 + c];
            LA[(size_t)t * 512 + c] = -softplusf_(-z) * (1.f / 16.f);
        }
    }
}

PHASE_FN void ph_gla_chunk(const Params& p, int layer, float* smem) {
    unsigned char* ws_ = p.ws; asm volatile("" : "+s"(ws_));
    int tid_ = threadIdx.x; asm volatile("" : "+v"(tid_)); const int tid = tid_, lane = tid & 63, wv = __builtin_amdgcn_readfirstlane(tid >> 6), q4 = lane >> 4, c16 = lane & 15;
    int ldz_ = 0; asm volatile("" : "+s"(ldz_)); unsigned char* lds = g_smem + ldz_;
    constexpr int SN = 272, ST = 144;
    float* sBc = (float*)lds;
    unsigned char* bQE = lds + 33024;
    unsigned char* bKE = lds + 50432;
    unsigned char* bKD = lds + 67840;
    unsigned char* bVT = lds + 86272;
    unsigned char* bATT = lds + 123136;
    const bf16_t* P = (const bf16_t*)(ws_ + OFF_P); const float* AUX = (const float*)(ws_ + OFF_AUX);
    const float* w2 = p.gla_w_gate2 + (size_t)(layer >> 1) * 16 * 512; const float* b2 = p.gla_b_gate2 + (layer >> 1) * 512;
    float* sGlr = (float*)(lds + 132352);
    uint4* QEF = (uint4*)(ws_ + OFF_GQE); uint2* OIF = (uint2*)(ws_ + OFF_GOI); uint2* HF = (uint2*)(ws_ + OFF_GH); float* EBL = (float*)(ws_ + OFF_GEBL);
    for (int ci = blockIdx.x; ci < 1024; ci += gridDim.x) {
        const int b = ci >> 9, h = (ci >> 7) & 3, n = ci & 127;
        const int t0 = b * 8192 + n * 64;
        __syncthreads();
        for (int e = tid; e < 1024; e += NTHREADS) sGlr[e] = AUX[(size_t)(t0 + (e >> 4)) * 16 + (e & 15)];
        __syncthreads();
        {
            const int d = tid & 127, c = h * 128 + d;
            float wg[16];
#pragma unroll
            for (int r = 0; r < 16; ++r) wg[r] = w2[r * 512 + c];
            const float bz = b2[c];
            for (int i = tid >> 7; i < 64; i += 4) {
                float z = bz;
#pragma unroll
                for (int r = 0; r < 16; ++r) z += sGlr[i * 16 + r] * wg[r];
                sBc[i * 129 + d] = -softplusf_(-z) * (1.f / 16.f);
            }
        }
        for (int e = tid; e < 64 * 36; e += NTHREADS) ((unsigned*)bATT)[e] = 0u;
        __syncthreads();
        if (tid < 128) { float a = 0.f; for (int i = 0; i < 64; ++i) { a += sBc[i * 129 + tid]; sBc[i * 129 + tid] = a; } }
        __syncthreads();
        {
            const int d = tid & 127, ig = tid >> 7;
            const float bl = sBc[63 * 129 + d];
#pragma unroll
            for (int gg = 0; gg < 2; ++gg) { const int g = ig + 4 * gg;
                float kd8[8];
#pragma unroll
                for (int r = 0; r < 8; ++r) { const int i = g * 8 + r;
                    const float bb = sBc[i * 129 + d];
                    const float qf = PBF(P, t0 + i, h * 128 + d), kf = PBF(P, t0 + i, 512 + h * 128 + d);
                    *(bf16_t*)(bQE + i * SN + d * 2) = f2bf(qf * SCALE128 * expf(bb));
                    *(bf16_t*)(bKE + i * SN + d * 2) = f2bf(kf * expf(-bb));
                    kd8[r] = kf * expf(bl - bb); }
                *(uint4*)(bKD + d * ST + g * 16) = make_uint4(cvt_pk_bf16(kd8[0], kd8[1]), cvt_pk_bf16(kd8[2], kd8[3]), cvt_pk_bf16(kd8[4], kd8[5]), cvt_pk_bf16(kd8[6], kd8[7]));
            }
            const int dv = tid & 255, hf = tid >> 8;
#pragma unroll
            for (int gg = 0; gg < 4; ++gg) { const int g = hf * 4 + gg;
                unsigned short v8[8];
#pragma unroll
                for (int r = 0; r < 8; ++r) v8[r] = P[(size_t)(t0 + g * 8 + r) * LDPB + 1024 + h * 256 + dv];
                *(uint4*)(bVT + dv * ST + g * 16) = make_uint4((unsigned)v8[0] | ((unsigned)v8[1] << 16), (unsigned)v8[2] | ((unsigned)v8[3] << 16), (unsigned)v8[4] | ((unsigned)v8[5] << 16), (unsigned)v8[6] | ((unsigned)v8[7] << 16));
            }
        }
        if (tid < 128) EBL[ci * 128 + tid] = expf(sBc[63 * 129 + tid]);
        __syncthreads();
        for (int u = wv; u < 10; u += 8) {
            const int ti = (u >= 6) ? 3 : (u >= 3) ? 2 : (u >= 1) ? 1 : 0, tj = u - ((ti * (ti + 1)) >> 1);
            f32x4 acc = (f32x4){0.f, 0.f, 0.f, 0.f};
            acc = mma_lds(bQE, SN, 16 * ti, bKE, SN, 16 * tj, 128, acc, c16, q4);
            const int j = 16 * tj + c16;
#pragma unroll
            for (int r = 0; r < 4; ++r) { const int i = 16 * ti + 4 * q4 + r; *(bf16_t*)(bATT + i * ST + j * 2) = f2bf((j <= i) ? acc[r] : 0.f); }
        }
        for (int x = 0; x < 2; ++x) {
            const int u = wv * 2 + x, ti = u >> 2, a = u & 3;
            const unsigned char* rp = bQE + (16 * ti + c16) * SN;
            const uint2 lo = *(const uint2*)(rp + (32 * a + 4 * q4) * 2), hi = *(const uint2*)(rp + (32 * a + 16 + 4 * q4) * 2);
            QEF[((size_t)(ci * 4 + ti) * 4 + a) * 64 + lane] = make_uint4(lo.x, lo.y, hi.x, hi.y);
        }
        __syncthreads();
        for (int x = 0; x < 8; ++x) {
            const int u = wv * 8 + x, tdv = u >> 2, ti = u & 3;
            f32x4 acc = (f32x4){0.f, 0.f, 0.f, 0.f};
            acc = mma_lds(bATT, ST, 16 * ti, bVT, ST, 16 * tdv, 64, acc, c16, q4);
            OIF[((size_t)(ci * 16 + tdv) * 4 + ti) * 64 + lane] = pack4(acc);
        }
        for (int x = 0; x < 16; ++x) {
            const int u = wv * 16 + x, tdv = u >> 3, tdk = u & 7;
            f32x4 acc = (f32x4){0.f, 0.f, 0.f, 0.f};
            acc = mma_lds(bKD, ST, 16 * tdk, bVT, ST, 16 * tdv, 64, acc, c16, q4);
            HF[((size_t)(ci * 16 + tdv) * 8 + tdk) * 64 + lane] = pack4(acc);
        }
    }
}

PHASE_FN void ph_gla_scan(const Params& p, float* smem) {
    unsigned char* ws_ = p.ws; asm volatile("" : "+s"(ws_));
    int tid_ = threadIdx.x; asm volatile("" : "+v"(tid_)); const int tid = tid_, lane = tid & 63, wv = __builtin_amdgcn_readfirstlane(tid >> 6), q4 = lane >> 4, c16 = lane & 15;
    int ldz_ = 0; asm volatile("" : "+s"(ldz_)); unsigned char* lds = g_smem + ldz_;
    constexpr int STG = 29184;
    const unsigned char* QEF = ws_ + OFF_GQE; const unsigned char* HF = ws_ + OFF_GH; const unsigned char* OIF = ws_ + OFF_GOI; const unsigned char* EBL = ws_ + OFF_GEBL;
    float* O = (float*)(ws_ + OFF_O);
    for (int it = blockIdx.x; it < 64; it += gridDim.x) {
        const int bh = it >> 3, pair = it & 7, b = bh >> 2, h = bh & 3;
        __syncthreads();
        if (wv >= 2) {
            const int lt = tid - 128;
            const unsigned char* Qb = QEF + (size_t)bh * 128 * 16384;
            const unsigned char* Hb = HF + (size_t)bh * 128 * 65536 + pair * 8192;
            const unsigned char* Ob = OIF + (size_t)bh * 128 * 32768 + pair * 4096;
            const unsigned char* Lb = EBL + (size_t)bh * 128 * 512;
            uint4 ra0, ra1, ra2, ra3, ra4, ra5, ra6, rb0, rb1, rb2, rb3, rb4, rb5, rb6, rc0, rc1, rc2, rc3, rc4, rc5, rc6, rd0, rd1, rd2, rd3, rd4, rd5, rd6;
#define GL_LOAD(X, n_) do { const unsigned char* q_ = Qb + (size_t)(n_) * 16384; const unsigned char* h_ = Hb + (size_t)(n_) * 65536; \
                const unsigned char* o_ = Ob + (size_t)(n_) * 32768; const unsigned char* l_ = Lb + (size_t)(n_) * 512; \
                X##0 = LDC(q_, lt, 1023); X##1 = LDC(q_, lt + 384, 1023); X##2 = LDC(q_, lt + 768, 1023); \
                X##3 = LDC(h_, lt, 511); X##4 = LDC(h_, lt + 384, 511); X##5 = LDC(o_, lt, 255); X##6 = LDC(l_, lt, 31); } while (0)
#define GL_STORE(X, st_) do { unsigned char* sb_ = lds + (st_) * STG; \
                STC(0, lt, 1024, X##0); STC(0, lt + 384, 1024, X##1); STC(0, lt + 768, 1024, X##2); \
                STC(16384, lt, 512, X##3); STC(16384, lt + 384, 512, X##4); STC(24576, lt, 256, X##5); STC(28672, lt, 32, X##6); } while (0)
            GL_LOAD(ra, 0); GL_STORE(ra, 0);
            GL_LOAD(rb, 1); GL_LOAD(rc, 2); GL_LOAD(rd, 3); GL_LOAD(ra, 4);
            __syncthreads();
            for (int n = 0; n < 128; n += 4) {
                GL_STORE(rb, 1); GL_LOAD(rb, CLAMPN(n + 5)); __syncthreads();
                GL_STORE(rc, 0); GL_LOAD(rc, CLAMPN(n + 6)); __syncthreads();
                GL_STORE(rd, 1); GL_LOAD(rd, CLAMPN(n + 7)); __syncthreads();
                if (n + 4 < 128) GL_STORE(ra, 0);
                GL_LOAD(ra, CLAMPN(n + 8)); __syncthreads();
            }
        } else {
            const int tdv = pair * 2 + wv;
            f32x4 S[8];
#pragma unroll
            for (int t = 0; t < 8; ++t) S[t] = (f32x4){0.f, 0.f, 0.f, 0.f};
            __syncthreads();
            for (int n = 0; n < 128; ++n) {
                const unsigned char* base = lds + (n & 1) * STG;
                const unsigned char* Qf = base + lane * 16, *Hf = base + 16384 + wv * 4096 + lane * 8, *Of = base + 24576 + wv * 2048 + lane * 8, *Lf = base + 28672 + q4 * 16;
                bf16x8 Sb[4];
#pragma unroll
                for (int a = 0; a < 4; ++a) { union { uint4 u; bf16x8 v; } cv; const uint2 lo = pack4(S[2 * a]), hi = pack4(S[2 * a + 1]); cv.u.x = lo.x; cv.u.y = lo.y; cv.u.z = hi.x; cv.u.w = hi.y; Sb[a] = cv.v; }
                const int t0 = b * 8192 + n * 64;
                f32x4 oa[4];
#pragma unroll
                for (int ti = 0; ti < 4; ++ti) oa[ti] = unpack4(*(const uint2*)(Of + ti * 512));
#pragma unroll
                for (int a = 0; a < 4; ++a)
#pragma unroll
                    for (int ti = 0; ti < 4; ++ti) oa[ti] = __builtin_amdgcn_mfma_f32_16x16x32_bf16(*(const bf16x8*)(Qf + (ti * 4 + a) * 1024), Sb[a], oa[ti], 0, 0, 0);
#pragma unroll
                for (int ti = 0; ti < 4; ++ti) {
                    float* op = O + (size_t)(t0 + 16 * ti + 4 * q4) * 1024 + h * 256 + 16 * tdv + c16;
                    op[0] = oa[ti][0]; op[1024] = oa[ti][1]; op[2048] = oa[ti][2]; op[3072] = oa[ti][3]; }
#pragma unroll
                for (int t = 0; t < 8; ++t) { const f32x4 lam = *(const f32x4*)(Lf + t * 64); S[t] = S[t] * lam + unpack4(*(const uint2*)(Hf + t * 512)); }
                __syncthreads();
            }
        }
    }
}

PHASE_FN void ph_gla_out(const Params& p, int layer) {
    unsigned char* ws_ = p.ws; asm volatile("" : "+s"(ws_));
    int tid_ = threadIdx.x; asm volatile("" : "+v"(tid_)); const int tid = tid_, lane = tid & 63, wv = tid >> 6;
    const float* O = (const float*)(ws_ + OFF_O); const bf16_t* P = (const bf16_t*)(ws_ + OFF_P); bf16_t* OB = (bf16_t*)(ws_ + OFF_OB);
    const float* onw = p.gla_out_norm + (layer >> 1) * 256;
    for (int t = blockIdx.x * 8 + wv; t < NT; t += gridDim.x * 8) {
#pragma unroll
        for (int h = 0; h < 4; ++h) {
            const float* op = O + (size_t)t * 1024 + h * 256;
            const float4 o = *(const float4*)(op + lane * 4);
            const float ss = wave_sum(o.x * o.x + o.y * o.y + o.z * o.z + o.w * o.w);
            const float r = rsqrtf(ss * (1.f / 256.f) + EPS);
            const f32x4 z = unpack4(*(const uint2*)(P + (size_t)t * LDPB + 2048 + h * 256 + lane * 4));
            const float4 w = *(const float4*)(onw + lane * 4);
            f32x4 ov; ov[0] = o.x * r * w.x * siluf_(z[0]); ov[1] = o.y * r * w.y * siluf_(z[1]); ov[2] = o.z * r * w.z * siluf_(z[2]); ov[3] = o.w * r * w.w * siluf_(z[3]);
            *(uint2*)(OB + (size_t)t * 1024 + h * 256 + lane * 4) = pack4(ov);
        }
    }
}

template <int PH>
__device__ __forceinline__ void run_phase(const Params& p, int layer, float* smem) {
    if (PH == PH_PROLOGUE) { ph_prologue(p, smem); ph_conv_dense(p, smem); }
    else if (PH == PH_NORM_MIX) ph_rows(p, layer, 0, smem);
    else if (PH == PH_GEMM_IN_EVEN) ph_gemm_in(p, layer, true, smem);
    else if (PH == PH_EVEN_TOK) { ph_even_tok(p, layer, smem); ph_gdn_chunk(p, layer, smem); if (DUP_MASK & 8192) ph_gdn_chunk(p, layer, smem); if (DUP_MASK & 16384) ph_even_tok(p, layer, smem); }
    else if (PH == PH_GDN_CHUNK) ph_gdn_chunk(p, layer, smem);
    else if (PH == PH_GDN_SCAN) { ph_gdn_scan(p, smem); ph_conv_exp(p, layer, smem, 32); ph_dsa_topk(p, layer, smem); }
    else if (PH == PH_DSA_TOPK) ph_dsa_topk(p, layer, smem);
    else if (PH == PH_DSA_ATTN) { ph_dsa_attn(p, smem); ph_gdn_out(p, layer); if (DUP_MASK & 32768) ph_dsa_attn(p, smem); }
    else if (PH == PH_GDN_OUT) ph_gdn_out(p, layer);
    else if (PH == PH_GEMM_OUT) ph_gemm_out(p, layer, smem);
    else if (PH == PH_NORM_FFN) ph_norm_ffn(p, layer);
    else if (PH == PH_MOE1) ph_moe(p, layer, 0, smem);
    else if (PH == PH_MOE2) ph_moe(p, layer, 1, smem);
    else if (PH == PH_GEMM_IN_ODD) ph_gemm_in(p, layer, false, smem);
    else if (PH == PH_GLA_TOK) ph_gla_tok(p, layer);
    else if (PH == PH_GLA_CHUNK) ph_gla_chunk(p, layer, smem);
    else if (PH == PH_GLA_SCAN) { ph_gla_scan(p, smem); ph_conv_exp(p, layer, smem, 64); }
    else if (PH == PH_GLA_OUT) ph_gla_out(p, layer);
    else if (PH == PH_FINAL) ph_rows(p, 0, 1, smem);
}

#if MK_MULTI
template <int PH>
__global__ void __launch_bounds__(NTHREADS, 2) k_phase(Params p, int layer) {
    run_phase<PH>(p, layer, (float*)g_smem);
}
#else
__global__ void __launch_bounds__(NTHREADS, 2) k_mega(Params p) {
    float* smem = (float*)g_smem;
    volatile LAS unsigned* xbw = (volatile LAS unsigned*)(LAS unsigned char*)(g_smem + LDS_BYTES - 16);
    if (threadIdx.x == 0) { xbw[0] = 0u; xbw[1] = 0u; xbw[2] = 0u; xbw[3] = 0u; }
    __syncthreads();
    XcdBarrier bar = xcd_barrier_post((unsigned*)(p.ws + OFF_BAR), xbw);
#define BAR() do { XcdBarrier bb_ = bar; asm volatile("" : "+s"(bb_.x)); asm volatile("" : "+s"(bb_.bar)); xcd_barrier(bb_); } while (0)
    run_phase<PH_PROLOGUE>(p, 0, smem); BAR(); if (DUP_MASK & 4096) { run_phase<PH_PROLOGUE>(p, 0, smem); BAR(); }
    for (int lp = 0; lp < 2; ++lp) {
        const int le = 2 * lp, lo = 2 * lp + 1;
        run_phase<PH_NORM_MIX>(p, le, smem); BAR();
        run_phase<PH_GEMM_IN_EVEN>(p, le, smem); BAR(); if (DUP_MASK & 1) { run_phase<PH_GEMM_IN_EVEN>(p, le, smem); BAR(); }
        run_phase<PH_EVEN_TOK>(p, le, smem); BAR(); if (DUP_MASK & 2) { run_phase<PH_EVEN_TOK>(p, le, smem); BAR(); }
        run_phase<PH_GDN_SCAN>(p, le, smem); BAR(); if (DUP_MASK & 8) { run_phase<PH_GDN_SCAN>(p, le, smem); BAR(); }
        run_phase<PH_DSA_ATTN>(p, le, smem); BAR(); if (DUP_MASK & 32) { run_phase<PH_DSA_ATTN>(p, le, smem); BAR(); }
        run_phase<PH_GEMM_OUT>(p, le, smem); BAR();
        run_phase<PH_NORM_FFN>(p, le, smem); BAR();
        run_phase<PH_MOE1>(p, le, smem); BAR(); if (DUP_MASK & 64) { run_phase<PH_MOE1>(p, le, smem); BAR(); }
        run_phase<PH_MOE2>(p, le, smem); BAR(); if (DUP_MASK & 128) { run_phase<PH_MOE2>(p, le, smem); BAR(); }
        run_phase<PH_NORM_MIX>(p, lo, smem); BAR();
        run_phase<PH_GEMM_IN_ODD>(p, lo, smem); BAR(); if (DUP_MASK & 256) { run_phase<PH_GEMM_IN_ODD>(p, lo, smem); BAR(); }
        run_phase<PH_GLA_CHUNK>(p, lo, smem); BAR(); if (DUP_MASK & 1024) { run_phase<PH_GLA_CHUNK>(p, lo, smem); BAR(); }
        run_phase<PH_GLA_SCAN>(p, lo, smem); BAR(); if (DUP_MASK & 2048) { run_phase<PH_GLA_SCAN>(p, lo, smem); BAR(); }
        run_phase<PH_GLA_OUT>(p, lo, smem); BAR();
        run_phase<PH_GEMM_OUT>(p, lo, smem); BAR();
        run_phase<PH_NORM_FFN>(p, lo, smem); BAR();
        run_phase<PH_MOE1>(p, lo, smem); BAR(); if (DUP_MASK & 64) { run_phase<PH_MOE1>(p, lo, smem); BAR(); }
        run_phase<PH_MOE2>(p, lo, smem); BAR(); if (DUP_MASK & 128) { run_phase<PH_MOE2>(p, lo, smem); BAR(); }
    }
    for (int xb = 0; xb < EXTRA_BARS; ++xb) BAR();
    run_phase<PH_FINAL>(p, 0, smem);
}
#endif

}

#if MK_MULTI
template <int PH>
static void launch_phase(const Params& p, int layer, hipStream_t stream) {
    static bool attr_set = false;
    if (!attr_set) { hipFuncSetAttribute((const void*)k_phase<PH>, hipFuncAttributeMaxDynamicSharedMemorySize, (int)LDS_BYTES); attr_set = true; }
    hipLaunchKernelGGL((k_phase<PH>), dim3(256), dim3(NTHREADS), LDS_BYTES, stream, p, layer);
}
#endif

extern "C" void kernel_launch(void* const* d_in, const int* in_sizes, int n_in, void* d_out, int out_size, void* d_ws, size_t ws_size, hipStream_t stream) {
    (void)in_sizes; (void)n_in; (void)out_size;
    if (ws_size < WS_NEEDED) { fprintf(stderr, "workspace too small: %zu < %zu\n", ws_size, (size_t)WS_NEEDED); return; }
    Params p{};
    p.x = (const float*)d_in[0]; p.c = (const float*)d_in[1]; p.pos = (const int*)d_in[2]; p.ada_w = (const float*)d_in[3]; p.ada_b = (const float*)d_in[4];
    p.norm_mix = (const float*)d_in[5]; p.norm_ffn = (const float*)d_in[6]; p.even_w_in = (const float*)d_in[7]; p.conv_w = (const float*)d_in[8];
    p.a_log = (const float*)d_in[9]; p.dt_bias = (const float*)d_in[10]; p.gdn_out_norm = (const float*)d_in[11]; p.even_w_out = (const float*)d_in[12];
    p.gla_w_in = (const float*)d_in[13]; p.gla_w_gate2 = (const float*)d_in[14]; p.gla_b_gate2 = (const float*)d_in[15]; p.gla_out_norm = (const float*)d_in[16]; p.gla_w_out = (const float*)d_in[17];
    p.rg_w = (const float*)d_in[18]; p.rg_b = (const float*)d_in[19]; p.re_w = (const float*)d_in[20]; p.re_b = (const float*)d_in[21];
    p.w1 = (const float*)d_in[22]; p.w3 = (const float*)d_in[23]; p.w2 = (const float*)d_in[24]; p.final_norm = (const float*)d_in[25];
    p.X = (float*)d_out; p.ws = (unsigned char*)d_ws;
    p.rA = pow(10000.0, -2.0 / 128.0); p.rI = pow(10000.0, -2.0 / 64.0);
    hipMemsetAsync(d_ws, 0, ZERO_BYTES, stream);
#if MK_MULTI
    launch_phase<PH_PROLOGUE>(p, 0, stream);
    for (int lp = 0; lp < 2; ++lp) {
        const int le = 2 * lp, lo = 2 * lp + 1;
        launch_phase<PH_NORM_MIX>(p, le, stream);
        launch_phase<PH_GEMM_IN_EVEN>(p, le, stream);
        launch_phase<PH_EVEN_TOK>(p, le, stream);
        launch_phase<PH_GDN_SCAN>(p, le, stream);
        launch_phase<PH_DSA_ATTN>(p, le, stream);
        launch_phase<PH_GEMM_OUT>(p, le, stream);
        launch_phase<PH_NORM_FFN>(p, le, stream);
        launch_phase<PH_MOE1>(p, le, stream);
        launch_phase<PH_MOE2>(p, le, stream);
        launch_phase<PH_NORM_MIX>(p, lo, stream);
        launch_phase<PH_GEMM_IN_ODD>(p, lo, stream);
        launch_phase<PH_GLA_CHUNK>(p, lo, stream);
        launch_phase<PH_GLA_SCAN>(p, lo, stream);
        launch_phase<PH_GLA_OUT>(p, lo, stream);
        launch_phase<PH_GEMM_OUT>(p, lo, stream);
        launch_phase<PH_NORM_FFN>(p, lo, stream);
        launch_phase<PH_MOE1>(p, lo, stream);
        launch_phase<PH_MOE2>(p, lo, stream);
    }
    launch_phase<PH_FINAL>(p, 0, stream);
#else
    static int grid = 0;
    if (!grid) {
        int dev = 0, cus = 0, per_cu = 0;
        hipGetDevice(&dev);
        hipDeviceGetAttribute(&cus, hipDeviceAttributeMultiprocessorCount, dev);
        hipFuncSetAttribute((const void*)k_mega, hipFuncAttributeMaxDynamicSharedMemorySize, (int)LDS_BYTES);
        hipOccupancyMaxActiveBlocksPerMultiprocessor(&per_cu, k_mega, NTHREADS, LDS_BYTES);
        if (cus <= 0) cus = 256;
        grid = cus * (per_cu < 1 ? 1 : 1);
    }
    hipLaunchKernelGGL(k_mega, dim3(grid), dim3(NTHREADS), LDS_BYTES, stream, p);
#endif
}
```

```cpp
#include <hip/hip_runtime.h>
#include <stdint.h>
#include <math.h>
#include <stdio.h>

#define EXTRA_BARS 0
#define REP_A 1
#define REP_B 1
#define REP_C 1
#ifndef DUP_MASK
#define DUP_MASK 0
#endif
#ifndef MK_MULTI
#define MK_MULTI 0
#endif

namespace {

constexpr int NT = 16384, ND = 1024, LDP = 3920, LDPB = 3968;
constexpr float EPS = 1e-6f;
constexpr int NTHREADS = 512;
constexpr size_t LDS_BYTES = 147456;
constexpr float SCALE128 = 0.08838834764831845f;
constexpr int LISTCAP = 32768;
constexpr int CSTR = 16;

constexpr size_t OFF_BAR  = 0;
constexpr size_t OFF_CNT  = 16384;
constexpr size_t ZERO_BYTES = 32768;
constexpr size_t OFF_QCTR = 28672;
constexpr size_t OFF_MOD  = 32768;
constexpr size_t OFF_COSA = OFF_MOD + 4 * 2 * 6144 * 4;
constexpr size_t OFF_SINA = OFF_COSA + (size_t)NT * 64 * 4;
constexpr size_t OFF_COSI = OFF_SINA + (size_t)NT * 64 * 4;
constexpr size_t OFF_SINI = OFF_COSI + (size_t)NT * 32 * 4;
constexpr size_t OFF_H    = OFF_SINI + (size_t)NT * 32 * 4;
constexpr size_t OFF_P    = OFF_H + (size_t)NT * 1024 * 4;
constexpr size_t OFF_HID  = OFF_P;
constexpr size_t OFF_YB   = OFF_HID + (size_t)36864 * 512 * 4;
constexpr size_t OFF_O    = OFF_P + (size_t)NT * LDP * 4;
constexpr size_t OFF_ASG  = OFF_O + (size_t)NT * 1024 * 4;
constexpr size_t OFF_GATE = OFF_ASG + (size_t)NT * 4 * 4;
constexpr size_t OFF_LIST = OFF_GATE + (size_t)NT * 2 * 4;
constexpr size_t OFF_R    = OFF_LIST + (size_t)32 * LISTCAP * 4;
constexpr size_t OFF_QN   = OFF_R;
constexpr size_t OFF_KN   = OFF_QN + (size_t)NT * 512 * 4;
constexpr size_t OFF_VC   = OFF_KN + (size_t)NT * 512 * 4;
constexpr size_t OFF_BETA = OFF_VC + (size_t)NT * 512 * 4;
constexpr size_t OFF_G    = OFF_BETA + (size_t)NT * 4 * 4;
constexpr size_t OFF_W    = OFF_G + (size_t)NT * 4 * 4;
constexpr size_t OFF_U    = OFF_W + (size_t)1024 * 8192 * 4;
constexpr size_t OFF_QG   = OFF_U + (size_t)1024 * 8192 * 4;
constexpr size_t OFF_KD   = OFF_QG + (size_t)1024 * 8192 * 4;
constexpr size_t OFF_AQK  = OFF_KD + (size_t)1024 * 8192 * 4;
constexpr size_t OFF_GL   = OFF_AQK + (size_t)1024 * 4096 * 4;
constexpr size_t OFF_QB   = OFF_GL + 4096;
constexpr size_t OFF_KB   = OFF_QB + (size_t)NT * 512 * 4;
constexpr size_t OFF_QI   = OFF_KB + (size_t)NT * 512 * 4;
constexpr size_t OFF_KI   = OFF_QI + (size_t)NT * 256 * 4;
constexpr size_t OFF_WI   = OFF_KI + (size_t)NT * 64 * 4;
constexpr size_t OFF_SEL  = OFF_WI + (size_t)NT * 4 * 4;
constexpr size_t OFF_EVEN_END = OFF_SEL + (size_t)NT * 256 * 4;
constexpr size_t OFF_PFR  = OFF_W;
constexpr size_t OFF_RFR  = OFF_PFR + (size_t)1024 * 32768;
constexpr size_t OFF_QFR  = OFF_RFR + (size_t)1024 * 16384;
constexpr size_t OFF_OFR  = OFF_QFR + (size_t)1024 * 32768;
static_assert(OFF_OFR + (size_t)1024 * 16384 <= OFF_GL, "gdn v2 buffers overflow");
constexpr size_t OFF_QBB  = OFF_QB;
constexpr size_t OFF_KBB  = OFF_QBB + (size_t)NT * 512 * 2;
constexpr size_t OFF_VT   = OFF_KBB + (size_t)NT * 512 * 2;
constexpr size_t OFF_QIB  = OFF_VT + (size_t)NT * 512 * 2;
constexpr size_t OFF_KIB  = OFF_QIB + (size_t)NT * 256 * 2;
constexpr size_t OFF_M16  = OFF_KIB + (size_t)NT * 64 * 2;
static_assert(OFF_M16 + (size_t)NT * 512 * 2 <= OFF_WI, "dsa v2 buffers overflow");
constexpr size_t OFF_LA   = OFF_R;
constexpr size_t OFF_ATT  = OFF_LA + (size_t)NT * 512 * 4;
constexpr size_t OFF_QE   = OFF_ATT + (size_t)1024 * 4096 * 4;
constexpr size_t OFF_GKD  = OFF_QE + (size_t)1024 * 8192 * 4;
constexpr size_t OFF_EBL  = OFF_GKD + (size_t)1024 * 8192 * 4;
constexpr size_t OFF_GQE  = OFF_LA + (size_t)NT * 512 * 4;
constexpr size_t OFF_GOI  = OFF_GQE + (size_t)1024 * 16384;
constexpr size_t OFF_GH   = OFF_GOI + (size_t)1024 * 32768;
constexpr size_t OFF_GEBL = OFF_GH + (size_t)1024 * 65536;
static_assert(OFF_GEBL + (size_t)1024 * 512 <= OFF_EVEN_END, "gla v2 buffers overflow");
constexpr size_t OFF_WINE = OFF_EVEN_END;
constexpr size_t OFF_WINO = OFF_WINE + (size_t)2 * 4096 * 1024 * 2;
constexpr size_t OFF_WOUT = OFF_WINO + (size_t)2 * 3200 * 1024 * 2;
constexpr size_t OFF_W13  = OFF_WOUT + (size_t)4 * 1024 * 1024 * 2;
constexpr size_t OFF_W2T  = OFF_W13 + (size_t)32 * 1024 * 1024 * 2;
constexpr size_t OFF_OB   = OFF_W2T + (size_t)32 * 1024 * 512 * 2;
constexpr size_t OFF_AUX  = OFF_OB + (size_t)NT * 1024 * 2;
constexpr size_t OFF_WGL  = OFF_AUX + (size_t)NT * 16 * 4;
constexpr size_t WS_NEEDED = OFF_WGL + (size_t)2 * 128 * 1024 * 2;

struct Params {
    const float* x; const float* c; const int* pos; const float* ada_w; const float* ada_b;
    const float* norm_mix; const float* norm_ffn; const float* even_w_in; const float* conv_w;
    const float* a_log; const float* dt_bias; const float* gdn_out_norm; const float* even_w_out;
    const float* gla_w_in; const float* gla_w_gate2; const float* gla_b_gate2; const float* gla_out_norm; const float* gla_w_out;
    const float* rg_w; const float* rg_b; const float* re_w; const float* re_b;
    const float* w1; const float* w3; const float* w2; const float* final_norm;
    float* X;
    unsigned char* ws;
    double rA, rI;
};

#define XB_TMO      128
#define XB_XCNT(j)  (256  + 64 * (j))
#define XB_XSUB(j)  (1280 + 64 * (j))
#define XB_XGEN(j)  (2304 + 64 * (j))
#define XB_TOP      3328
#define XB_TOPGEN   3392
#define XCD_BAR_WORDS 3456
#define XB_SPIN_CAP (1u << 18)
#define LAS __attribute__((address_space(3)))

__device__ __forceinline__ unsigned xb_ld(unsigned* p)              { return __hip_atomic_load(p, __ATOMIC_RELAXED, __HIP_MEMORY_SCOPE_AGENT); }
__device__ __forceinline__ unsigned xb_add(unsigned* p, unsigned v) { return __hip_atomic_fetch_add(p, v, __ATOMIC_RELAXED, __HIP_MEMORY_SCOPE_AGENT); }
__device__ __forceinline__ unsigned xb_xcc_id() { return (unsigned)__builtin_amdgcn_s_getreg((3 << 11) | 20) & 0xFu; }
#define XB_SPIN(cond, bar) do { unsigned _sp = 0; while (cond) { __builtin_amdgcn_s_sleep(1); \
    if ((++_sp & 255u) == 0u) { if (xb_ld(&(bar)[XB_TMO])) break; if (_sp > XB_SPIN_CAP) { atomicAdd(&(bar)[XB_TMO], 1u); break; } } } } while (0)

struct XcdBarrier { unsigned* bar; unsigned x; volatile LAS unsigned* st; };

__device__ __forceinline__ XcdBarrier xcd_barrier_post(unsigned* bar, volatile LAS unsigned* st) {
    XcdBarrier b; b.bar = bar; b.x = xb_xcc_id(); b.st = st;
    if (threadIdx.x == 0) (void)xb_add(&bar[XB_XCNT(b.x)], 1u);
    return b;
}
__device__ __forceinline__ void xcd_barrier_complete(unsigned* bar, unsigned x, unsigned& nloc, unsigned& nx) {
    const unsigned G = gridDim.x * gridDim.y * gridDim.z;
    unsigned sum, cnt, mine, sp = 0u;
    for (;;) {
        sum = 0u; cnt = 0u; mine = 0u;
#pragma unroll
        for (unsigned j = 0; j < 16; ++j) { const unsigned c = xb_ld(&bar[XB_XCNT(j)]); sum += c; cnt += (c > 0u) ? 1u : 0u; mine = (j == x) ? c : mine; }
        if (sum == G) break;
        __builtin_amdgcn_s_sleep(1);
        if ((++sp & 255u) == 0u) { if (xb_ld(&bar[XB_TMO])) break; if (sp > XB_SPIN_CAP) { atomicAdd(&bar[XB_TMO], 1u); break; } }
    }
    nloc = mine > 0u ? mine : 1u; nx = cnt > 0u ? cnt : 1u;
}
__device__ __forceinline__ void xcd_barrier(const XcdBarrier& b) {
    asm volatile("s_waitcnt vmcnt(0)" ::: "memory");
    __syncthreads();
    if (threadIdx.x == 0) {
        unsigned* bar = b.bar;
        __builtin_amdgcn_s_waitcnt(0);
        unsigned nloc = b.st[0], nx = b.st[1];
        if (nloc == 0u) { xcd_barrier_complete(bar, b.x, nloc, nx); b.st[0] = nloc; b.st[1] = nx; }
        const unsigned old = xb_add(&bar[XB_XSUB(b.x)], 1u);
        const unsigned gen = old / nloc;
        if (old + 1u == (gen + 1u) * nloc) {
            __builtin_amdgcn_fence(__ATOMIC_RELEASE, "agent");
            asm volatile("s_waitcnt vmcnt(0)" ::: "memory");
            const unsigned og = xb_add(&bar[XB_TOP], 1u);
            const unsigned tg = og / nx;
            if (og + 1u == (tg + 1u) * nx) xb_add(&bar[XB_TOPGEN], 1u);
            else XB_SPIN(xb_ld(&bar[XB_TOPGEN]) == tg, bar);
            __builtin_amdgcn_fence(__ATOMIC_ACQUIRE, "agent");
            xb_add(&bar[XB_XGEN(b.x)], 1u);
            asm volatile("s_waitcnt vmcnt(0)" ::: "memory");
        } else {
            XB_SPIN(xb_ld(&bar[XB_XGEN(b.x)]) == gen, bar);
            __builtin_amdgcn_fence(__ATOMIC_ACQUIRE, "agent");
            asm volatile("s_waitcnt vmcnt(0)" ::: "memory");
        }
    }
    __syncthreads();
}

template <class T> __device__ __forceinline__ T* as_global(T* p) { return (T*)(__attribute__((address_space(1))) T*)p; }
typedef __attribute__((address_space(1))) unsigned char GU8;
#if defined(__HIP_DEVICE_COMPILE__)
#define ASSUME_GLOBAL(p_) do { __builtin_assume(!__builtin_amdgcn_is_shared((const void*)(p_))); __builtin_assume(!__builtin_amdgcn_is_private((const void*)(p_))); } while (0)
#else
#define ASSUME_GLOBAL(p_) do { } while (0)
#endif
#define LBAR() do { asm volatile("s_waitcnt lgkmcnt(0)" ::: "memory"); __builtin_amdgcn_s_barrier(); asm volatile("" ::: "memory"); } while (0)
typedef const Params __attribute__((address_space(4))) KParams;
__device__ __forceinline__ KParams* kparams() { KParams* q = (KParams*)__builtin_amdgcn_kernarg_segment_ptr(); asm volatile("" : "+s"(q)); return q; }
__device__ __forceinline__ float wave_sum(float v) {
#pragma unroll
    for (int o = 32; o > 0; o >>= 1) v += __shfl_xor(v, o);
    return v;
}
__device__ __forceinline__ int wave_sum_i(int v) {
#pragma unroll
    for (int o = 32; o > 0; o >>= 1) v += __shfl_xor(v, o);
    return v;
}
__device__ __forceinline__ float wave_max(float v) {
#pragma unroll
    for (int o = 32; o > 0; o >>= 1) v = fmaxf(v, __shfl_xor(v, o));
    return v;
}
__device__ __forceinline__ float sigmoidf_(float x) { return 1.f / (1.f + expf(-x)); }
__device__ __forceinline__ float siluf_(float x) { return x / (1.f + expf(-x)); }
__device__ __forceinline__ float silu_fast(float x) { return x * __builtin_amdgcn_rcpf(1.f + __expf(-x)); }
__device__ __forceinline__ float softplusf_(float x) { return fmaxf(x, 0.f) + log1pf(expf(-fabsf(x))); }
__device__ __forceinline__ unsigned ordkey(float f) { const unsigned u = __float_as_uint(f); return (u & 0x80000000u) ? ~u : (u | 0x80000000u); }

__device__ __forceinline__ void sincos_d(double a, double& s, double& c) {
    const double kq = rint(a * 0.63661977236758134308);
    double r = fma(-kq, 1.57079632673412561417e+00, a);
    r = fma(-kq, 6.07710050650619224932e-11, r);
    const int q = (int)((long long)kq & 3);
    const double r2 = r * r;
    const double sp = r * (1.0 + r2 * (-1.0 / 6 + r2 * (1.0 / 120 + r2 * (-1.0 / 5040 + r2 * (1.0 / 362880 + r2 * (-1.0 / 39916800 + r2 * (1.0 / 6227020800.0)))))));
    const double cp = 1.0 + r2 * (-0.5 + r2 * (1.0 / 24 + r2 * (-1.0 / 720 + r2 * (1.0 / 40320 + r2 * (-1.0 / 3628800 + r2 * (1.0 / 479001600.0 + r2 * (-1.0 / 87178291200.0)))))));
    if (q == 0) { s = sp; c = cp; } else if (q == 1) { s = cp; c = -sp; } else if (q == 2) { s = -sp; c = -cp; } else { s = -cp; c = sp; }
}
__device__ __forceinline__ double ipow_d(double b, int e) { double v = 1.0; while (e) { if (e & 1) v *= b; b *= b; e >>= 1; } return v; }

struct GemmArgs { const float* A; int lda; const int* rows; int m0; int mvalid; const float* B; int ldb; int n0; int N; int K; };

template <class Epi>
__device__ __forceinline__ void gemm128(const GemmArgs& g, float* smem, Epi epi) {
    float* As = smem;
    float* Bs = smem + 16 * 132;
    int tid_ = threadIdx.x; asm volatile("" : "+v"(tid_)); const int tid = tid_, ty = tid >> 4, tx = tid & 15;
    const int arow = tid >> 2, kq = (tid & 3) * 4;
    const int bk = tid >> 5, bn = (tid & 31) * 4;
    long asrc = -1;
    if (arow < g.mvalid) { const int r = g.rows ? g.rows[arow] : (g.m0 + arow); if (r >= 0) asrc = (long)r * g.lda; }
    const bool bval = (g.n0 + bn) < g.N;
    float acc[4][8];
#pragma unroll
    for (int i = 0; i < 4; ++i)
#pragma unroll
        for (int j = 0; j < 8; ++j) acc[i][j] = 0.f;
    for (int k0 = 0; k0 < g.K; k0 += 16) {
        float4 av = make_float4(0.f, 0.f, 0.f, 0.f), bv = make_float4(0.f, 0.f, 0.f, 0.f);
        if (asrc >= 0) av = *(const float4*)(g.A + asrc + k0 + kq);
        if (bval) bv = *(const float4*)(g.B + (size_t)(k0 + bk) * g.ldb + g.n0 + bn);
        __syncthreads();
        As[(kq + 0) * 132 + arow] = av.x; As[(kq + 1) * 132 + arow] = av.y; As[(kq + 2) * 132 + arow] = av.z; As[(kq + 3) * 132 + arow] = av.w;
        *(float4*)&Bs[bk * 132 + bn] = bv;
        __syncthreads();
#pragma unroll
        for (int kk = 0; kk < 16; ++kk) {
            const float4 a = *(const float4*)&As[kk * 132 + ty * 4];
            const float4 b0 = *(const float4*)&Bs[kk * 132 + tx * 8];
            const float4 b1 = *(const float4*)&Bs[kk * 132 + tx * 8 + 4];
            const float aa[4] = {a.x, a.y, a.z, a.w};
            const float bb[8] = {b0.x, b0.y, b0.z, b0.w, b1.x, b1.y, b1.z, b1.w};
#pragma unroll
            for (int i = 0; i < 4; ++i)
#pragma unroll
                for (int j = 0; j < 8; ++j) acc[i][j] += aa[i] * bb[j];
        }
    }
#pragma unroll
    for (int i = 0; i < 4; ++i) {
        const int r = ty * 4 + i;
        if (r < g.mvalid) {
#pragma unroll
            for (int j = 0; j < 8; ++j) { const int n = g.n0 + tx * 8 + j; if (n < g.N) epi(r, n, acc[i][j]); }
        }
    }
}


typedef short bf16x8 __attribute__((ext_vector_type(8)));
typedef float f32x4 __attribute__((ext_vector_type(4)));
typedef unsigned short bf16_t;
typedef __bf16 bf16x2_t __attribute__((ext_vector_type(2)));
typedef float f32x2_t __attribute__((ext_vector_type(2)));
__device__ __forceinline__ unsigned cvt_pk_bf16(float lo, float hi) { const f32x2_t v = {lo, hi}; const bf16x2_t r = __builtin_convertvector(v, bf16x2_t); return __builtin_bit_cast(unsigned, r); }
__device__ __forceinline__ bf16_t f2bf(float f) { return (bf16_t)(cvt_pk_bf16(f, 0.f) & 0xffffu); }
__device__ __forceinline__ float bf16_to_f32(bf16_t v) { return __uint_as_float(((unsigned)v) << 16); }
__device__ __forceinline__ uint2 pack4(const f32x4 v) { uint2 r; r.x = cvt_pk_bf16(v[0], v[1]); r.y = cvt_pk_bf16(v[2], v[3]); return r; }
__device__ __forceinline__ f32x4 unpack4(const uint2 u) { f32x4 r; r[0] = __uint_as_float(u.x << 16); r[1] = __uint_as_float(u.x & 0xffff0000u); r[2] = __uint_as_float(u.y << 16); r[3] = __uint_as_float(u.y & 0xffff0000u); return r; }
#define PBF(Pb_, t_, c_) bf16_to_f32((Pb_)[(size_t)(t_) * LDPB + (c_)])
__device__ __forceinline__ uint4 pack8(const float4 a, const float4 b) { uint4 r; r.x = cvt_pk_bf16(a.x, a.y); r.y = cvt_pk_bf16(a.z, a.w); r.z = cvt_pk_bf16(b.x, b.y); r.w = cvt_pk_bf16(b.z, b.w); return r; }
__device__ __forceinline__ int lds_off(int r, int c) { return r * 128 + ((c ^ (r & 7)) << 4); }

template <class ALoad, class BLoad, class Epi>
__device__ __forceinline__ void gemm_tile_bf16(const int K, unsigned char* lds, ALoad aload, BLoad bload, Epi epi, const int mrows = 256) {
    int tid_ = threadIdx.x; asm volatile("" : "+v"(tid_)); const int tid = tid_, lane = tid & 63, wid = tid >> 6, wm = wid >> 1, wn = wid & 1;
    f32x4 acc[4][4];
#pragma unroll
    for (int mi = 0; mi < 4; ++mi)
#pragma unroll
        for (int ni = 0; ni < 4; ++ni) acc[mi][ni] = (f32x4){0.f, 0.f, 0.f, 0.f};
    uint4 ra[4], rb[2];
    const int nk = K >> 6;
#pragma unroll
    for (int i = 0; i < 4; ++i) { const int q = tid + 512 * i; ra[i] = aload(i, q >> 3, (q & 7) * 8); }
#pragma unroll
    for (int i = 0; i < 2; ++i) { const int q = tid + 512 * i; rb[i] = bload(i, q >> 3, (q & 7) * 8); }
    __syncthreads();
#pragma unroll
    for (int i = 0; i < 4; ++i) { const int q = tid + 512 * i; *(uint4*)(lds + lds_off(q >> 3, q & 7)) = ra[i]; }
#pragma unroll
    for (int i = 0; i < 2; ++i) { const int q = tid + 512 * i; *(uint4*)(lds + 32768 + lds_off(q >> 3, q & 7)) = rb[i]; }
    __syncthreads();
    for (int kt = 0; kt < nk; ++kt) {
        if (kt + 1 < nk) {
#pragma unroll
            for (int i = 0; i < 4; ++i) { const int q = tid + 512 * i; ra[i] = aload(i, q >> 3, (kt + 1) * 64 + (q & 7) * 8); }
#pragma unroll
            for (int i = 0; i < 2; ++i) { const int q = tid + 512 * i; rb[i] = bload(i, q >> 3, (kt + 1) * 64 + (q & 7) * 8); }
        }
        const unsigned char* At = lds + (kt & 1) * 49152;
        const unsigned char* Bt = At + 32768;
        if (__builtin_amdgcn_readfirstlane(wm) * 64 < mrows) {
#pragma unroll
        for (int ks = 0; ks < 2; ++ks) {
            bf16x8 af[4], bfr[4];
            const int c = ks * 4 + (lane >> 4);
#pragma unroll
            for (int mi = 0; mi < 4; ++mi) af[mi] = *(const bf16x8*)(At + lds_off(wm * 64 + mi * 16 + (lane & 15), c));
#pragma unroll
            for (int ni = 0; ni < 4; ++ni) bfr[ni] = *(const bf16x8*)(Bt + lds_off(wn * 64 + ni * 16 + (lane & 15), c));
            __builtin_amdgcn_s_setprio(1);
#pragma unroll
            for (int mi = 0; mi < 4; ++mi)
#pragma unroll
                for (int ni = 0; ni < 4; ++ni) acc[mi][ni] = __builtin_amdgcn_mfma_f32_16x16x32_bf16(bfr[ni], af[mi], acc[mi][ni], 0, 0, 0);
            __builtin_amdgcn_s_setprio(0);
        }
        }
        if (kt + 1 < nk) {
            unsigned char* An = lds + ((kt + 1) & 1) * 49152;
#pragma unroll
            for (int i = 0; i < 4; ++i) { const int q = tid + 512 * i; *(uint4*)(An + lds_off(q >> 3, q & 7)) = ra[i]; }
#pragma unroll
            for (int i = 0; i < 2; ++i) { const int q = tid + 512 * i; *(uint4*)(An + 32768 + lds_off(q >> 3, q & 7)) = rb[i]; }
        }
        __syncthreads();
    }
    epi(acc, wm, wn, lane);
}

__device__ __forceinline__ void convert_tile(const float* src0, const float* src1, int mode, int K, int N, int ld, bf16_t* dst, int rt, int kt, float* smem) {
    int tid_ = threadIdx.x; asm volatile("" : "+v"(tid_)); const int tid = tid_;
    __syncthreads();
    { const int k = tid >> 3, R0 = rt * 64 + (tid & 7) * 8;
      const float* sp; int col;
      if (mode == 0) { sp = src0; col = R0; } else { sp = (R0 & 32) ? src1 : src0; col = (R0 >> 6) * 32 + (R0 & 31); }
      float4 a = make_float4(0.f, 0.f, 0.f, 0.f), b = a;
      const float* rp = sp + (size_t)(kt * 64 + k) * ld + col;
      if (col < N) a = *(const float4*)rp;
      if (col + 4 < N) b = *(const float4*)(rp + 4);
      float* d = smem + k * 65 + (tid & 7) * 8;
      d[0] = a.x; d[1] = a.y; d[2] = a.z; d[3] = a.w; d[4] = b.x; d[5] = b.y; d[6] = b.z; d[7] = b.w; }
    __syncthreads();
    { const int R = tid >> 3, kc = (tid & 7) * 8;
      float v[8];
#pragma unroll
      for (int j = 0; j < 8; ++j) v[j] = smem[(kc + j) * 65 + R];
      uint4 o; o.x = cvt_pk_bf16(v[0], v[1]); o.y = cvt_pk_bf16(v[2], v[3]); o.z = cvt_pk_bf16(v[4], v[5]); o.w = cvt_pk_bf16(v[6], v[7]);
      *(uint4*)(dst + (size_t)(rt * 64 + R) * K + kt * 64 + kc) = o; }
}

#define CT_LOAD(S0, S1, MODE, NN, LD, RT, KT, A, B) do { const int k_ = tid >> 3, R0_ = (RT) * 64 + (tid & 7) * 8; const float* sp_; int col_; \
        if ((MODE) == 0) { sp_ = (S0); col_ = R0_; } else { sp_ = (R0_ & 16) ? (S1) : (S0); col_ = (R0_ >> 5) * 16 + (R0_ & 15); } \
        A = make_float4(0.f, 0.f, 0.f, 0.f); B = A; const float* rp_ = sp_ + (size_t)((KT) * 64 + k_) * (LD) + col_; \
        if (col_ < (NN)) A = *(const float4*)rp_; if (col_ + 4 < (NN)) B = *(const float4*)(rp_ + 4); } while (0)
#define CT_WRITE(BUF, A, B) do { float* d_ = smem + (BUF) * 4160 + (tid >> 3) * 65 + (tid & 7) * 8; \
        d_[0] = A.x; d_[1] = A.y; d_[2] = A.z; d_[3] = A.w; d_[4] = B.x; d_[5] = B.y; d_[6] = B.z; d_[7] = B.w; } while (0)
#define CT_STORE(DST, KK, RT, KT, BUF) do { const int R_ = tid >> 3, kc_ = (tid & 7) * 8; const float* sb_ = smem + (BUF) * 4160; \
        uint4 o_; o_.x = cvt_pk_bf16(sb_[(kc_ + 0) * 65 + R_], sb_[(kc_ + 1) * 65 + R_]); o_.y = cvt_pk_bf16(sb_[(kc_ + 2) * 65 + R_], sb_[(kc_ + 3) * 65 + R_]); \
        o_.z = cvt_pk_bf16(sb_[(kc_ + 4) * 65 + R_], sb_[(kc_ + 5) * 65 + R_]); o_.w = cvt_pk_bf16(sb_[(kc_ + 6) * 65 + R_], sb_[(kc_ + 7) * 65 + R_]); \
        *(uint4*)((DST) + (size_t)((RT) * 64 + R_) * (KK) + (KT) * 64 + kc_) = o_; } while (0)
#define CT_DECL(I) const float* s0_##I; const float* s1_##I; bf16_t* d_##I; int md_##I, K_##I, N_##I, ld_##I, rt_##I, kt_##I
#define CT_ARGS(I) s0_##I, s1_##I, d_##I, md_##I, K_##I, N_##I, ld_##I, rt_##I, kt_##I
template <class Dec>
__device__ __forceinline__ void convert_tiles4(const Dec& dec, int t, int nj, float* smem) {
    int tid_ = threadIdx.x; asm volatile("" : "+v"(tid_)); const int tid = tid_;
    CT_DECL(0); CT_DECL(1); CT_DECL(2); CT_DECL(3);
    dec(t, CT_ARGS(0)); dec(t + 1, CT_ARGS(1)); dec(t + 2, CT_ARGS(2)); dec(t + 3, CT_ARGS(3));
    float4 a0, b0, a1, b1, a2, b2, a3, b3;
    a1 = b1 = a2 = b2 = a3 = b3 = make_float4(0.f, 0.f, 0.f, 0.f);
    CT_LOAD(s0_0, s1_0, md_0, N_0, ld_0, rt_0, kt_0, a0, b0);
    if (nj > 1) CT_LOAD(s0_1, s1_1, md_1, N_1, ld_1, rt_1, kt_1, a1, b1);
    if (nj > 2) CT_LOAD(s0_2, s1_2, md_2, N_2, ld_2, rt_2, kt_2, a2, b2);
    if (nj > 3) CT_LOAD(s0_3, s1_3, md_3, N_3, ld_3, rt_3, kt_3, a3, b3);
    __syncthreads();
    CT_WRITE(0, a0, b0); CT_WRITE(1, a1, b1); CT_WRITE(2, a2, b2); CT_WRITE(3, a3, b3);
    __syncthreads();
    CT_STORE(d_0, K_0, rt_0, kt_0, 0);
    if (nj > 1) CT_STORE(d_1, K_1, rt_1, kt_1, 1);
    if (nj > 2) CT_STORE(d_2, K_2, rt_2, kt_2, 2);
    if (nj > 3) CT_STORE(d_3, K_3, rt_3, kt_3, 3);
}


namespace pg8 {
constexpr int BM = 256, BK = 64, HALF = 128, HTB = HALF * BK * 2, STAGE_BYTES = 8 * HTB;
__host__ __device__ __forceinline__ int lds_byte(int r, int c) { const int st = (r >> 4) * 2 + (c >> 5), rr = r & 15, cc = c & 31, ob = rr * 64 + cc * 2; return st * 1024 + (ob ^ (((ob >> 9) & 1) << 5)); }
__host__ __device__ __forceinline__ void stage_rc(int b, int& R, int& C) { const int st = b / 1024, sb = b % 1024, swz = sb ^ (((sb >> 9) & 1) << 5); R = (st >> 1) * 16 + swz / 64; C = (st & 1) * 32 + (swz % 64) / 2; }
__host__ __device__ __forceinline__ int perm32(int rho) { const int n = rho >> 4, i = rho & 15; return 8 * (i >> 2) + 4 * n + (i & 3); }

struct Unit { size_t aoff, boff; int pm, pn, e, mvalid, rowbase, mi; };
template <class Epi, class Sched, bool GATHER>
__device__ __forceinline__ void gemm_phase(LAS unsigned char* lds, const bf16_t* Abase, const bf16_t* Bbase, const int K, const Sched& S, const Epi& E) {
    int tid_ = threadIdx.x; asm volatile("" : "+v"(tid_));
    const int tid = tid_, wid = __builtin_amdgcn_readfirstlane(tid >> 6), lane = tid & 63, wr = wid >> 2, wc = wid & 3, fr = lane & 15, fq = lane >> 4;
    const int nt = K / BK;
    unsigned voffB[2];
#pragma unroll
    for (int i = 0; i < 2; ++i) { int R, C; stage_rc(tid * 16 + i * 8192, R, C); const int Rb = Epi::PERM ? ((R & ~31) + perm32(R & 31)) : R; voffB[i] = (unsigned)(Rb * K + C) * 2u; }
    const size_t kstep = (size_t)(BK * 2);
    const size_t hstep = (size_t)HALF * K * 2;
    const unsigned ldsw = (unsigned)wid * 1024u;
    const int aoff = lds_byte(wr * 64 + fr, fq * 8), boff = lds_byte(wc * 32 + fr, fq * 8);
#define PG8_SA(b, h) (((b) * 2 + (h)) * HTB)
#define PG8_SB(b, h) ((4 + (b) * 2 + (h)) * HTB)
#define PG8_STAGE(bufoff, gbase, voff) do { _Pragma("unroll") for (int _i = 0; _i < 2; ++_i) \
        __builtin_amdgcn_global_load_lds((const unsigned*)((const char*)(gbase) + (voff)[_i]), (LAS unsigned*)(lds + (bufoff) + ldsw + _i * 8192), 16, 0, 0); } while (0)
#define PG8_LDA(dst, b, h) do { _Pragma("unroll") for (int m = 0; m < 4; ++m) _Pragma("unroll") for (int k = 0; k < 2; ++k) dst[m][k] = *(const LAS bf16x8*)(lds + PG8_SA(b, h) + aoff + m * 2048 + k * 1024); } while (0)
#define PG8_LDB(dst, b, h) do { _Pragma("unroll") for (int n = 0; n < 2; ++n) _Pragma("unroll") for (int k = 0; k < 2; ++k) dst[n][k] = *(const LAS bf16x8*)(lds + PG8_SB(b, h) + boff + n * 2048 + k * 1024); } while (0)
#define PG8_MMA(ai, bj, At, Bt) do { __builtin_amdgcn_s_setprio(1); _Pragma("unroll") for (int m = 0; m < 4; ++m) _Pragma("unroll") for (int n = 0; n < 2; ++n) _Pragma("unroll") for (int k = 0; k < 2; ++k) \
        acc[ai][bj][m][n] = __builtin_amdgcn_mfma_f32_16x16x32_bf16(Bt[n][k], At[m][k], acc[ai][bj][m][n], 0, 0, 0); __builtin_amdgcn_s_setprio(0); } while (0)
#define PG8_WAIT_V(n) asm volatile("s_waitcnt vmcnt(" #n ")" ::: "memory")
#define PG8_WAIT_L(n) asm volatile("s_waitcnt lgkmcnt(" #n ")" ::: "memory")
#define PG8_BAR __builtin_amdgcn_s_barrier()
#define PG8_SCHED __builtin_amdgcn_sched_barrier(0)
#define PG8_AVOFF(U, V0, V1) do { _Pragma("unroll") for (int _i = 0; _i < 2; ++_i) { int R_, C_; stage_rc(tid * 16 + _i * 8192, R_, C_); \
        if (GATHER) { V0[_i] = (unsigned)((size_t)S.row(U, R_) * K + C_) * 2u; V1[_i] = (unsigned)((size_t)S.row(U, 128 + R_) * K + C_) * 2u; } \
        else { V0[_i] = (unsigned)(R_ * K + C_) * 2u; V1[_i] = V0[_i] + (unsigned)hstep; } } } while (0)
    Unit cur, nxt; int ui = 0;
    if (!S.next(0, cur)) return;
    f32x4 acc[2][2][4][2];
#pragma unroll
    for (int a = 0; a < 2; ++a)
#pragma unroll
        for (int b = 0; b < 2; ++b)
#pragma unroll
            for (int m = 0; m < 4; ++m)
#pragma unroll
                for (int n = 0; n < 2; ++n) acc[a][b][m][n] = (f32x4){0.f, 0.f, 0.f, 0.f};
    bf16x8 At[4][2], B0[2][2], B1[2][2];
    unsigned cv0[2], cv1[2];
    PG8_AVOFF(cur, cv0, cv1);
    const char* cA = (const char*)Abase + cur.aoff; const char* cB = (const char*)Bbase + cur.boff;
    PG8_STAGE(PG8_SB(0, 0), cB, voffB); PG8_STAGE(PG8_SA(0, 0), cA, cv0); PG8_STAGE(PG8_SB(0, 1), cB + hstep, voffB); PG8_STAGE(PG8_SA(0, 1), cA, cv1);
    if (wr == 1) PG8_BAR;
    PG8_WAIT_V(4); PG8_BAR;
    PG8_STAGE(PG8_SB(1, 0), cB + kstep, voffB); PG8_STAGE(PG8_SA(1, 0), cA + kstep, cv0); PG8_STAGE(PG8_SB(1, 1), cB + hstep + kstep, voffB);
    PG8_WAIT_V(6); PG8_BAR;
    for (;;) {
        const bool has_next = S.next(ui + 1, nxt);
        const char* nA = has_next ? (const char*)Abase + nxt.aoff : cA; const char* nB = has_next ? (const char*)Bbase + nxt.boff : cB;
        for (int t = 0; t < nt; t += 2) {
            const bool last = (t == nt - 2);
            const char* a1 = cA + (size_t)(t + 1) * kstep;
            const char* a2 = last ? nA : cA + (size_t)(t + 2) * kstep; const char* b2 = last ? nB : cB + (size_t)(t + 2) * kstep;
            const char* a3 = a2 + kstep; const char* b3 = b2 + kstep;
            PG8_LDB(B0, 0, 0); PG8_SCHED; PG8_LDA(At, 0, 0); PG8_STAGE(PG8_SA(1, 1), a1, cv1);
            if (last && has_next) { PG8_AVOFF(nxt, cv0, cv1); }
            PG8_WAIT_L(8); PG8_BAR; PG8_WAIT_L(0); PG8_MMA(0, 0, At, B0); PG8_BAR; PG8_SCHED;
            PG8_LDB(B1, 0, 1); PG8_STAGE(PG8_SB(0, 0), b2, voffB);
            PG8_BAR; PG8_WAIT_L(0); PG8_MMA(0, 1, At, B1); PG8_BAR;
            PG8_LDA(At, 0, 1); PG8_STAGE(PG8_SA(0, 0), a2, cv0);
            PG8_BAR; PG8_WAIT_L(0); PG8_MMA(1, 0, At, B0); PG8_BAR; PG8_SCHED;
            PG8_STAGE(PG8_SB(0, 1), b2 + hstep, voffB);
            PG8_WAIT_V(6); PG8_BAR; PG8_MMA(1, 1, At, B1); PG8_BAR;
            PG8_LDB(B0, 1, 0); PG8_SCHED; PG8_LDA(At, 1, 0); PG8_STAGE(PG8_SA(0, 1), a2, cv1);
            PG8_WAIT_L(8); PG8_BAR; PG8_WAIT_L(0); PG8_MMA(0, 0, At, B0); PG8_BAR; PG8_SCHED;
            PG8_LDB(B1, 1, 1); PG8_STAGE(PG8_SB(1, 0), b3, voffB);
            PG8_BAR; PG8_WAIT_L(0); PG8_MMA(0, 1, At, B1); PG8_BAR;
            PG8_LDA(At, 1, 1); PG8_STAGE(PG8_SA(1, 0), a3, cv0);
            PG8_BAR; PG8_WAIT_L(0); PG8_MMA(1, 0, At, B0); PG8_BAR; PG8_SCHED;
            PG8_STAGE(PG8_SB(1, 1), b3 + hstep, voffB);
            PG8_WAIT_V(6); PG8_BAR; PG8_MMA(1, 1, At, B1); PG8_BAR;
        }
        E(acc, cur, wr, wc, fr, fq);
        if (!has_next) break;
#pragma unroll
        for (int a = 0; a < 2; ++a)
#pragma unroll
            for (int b = 0; b < 2; ++b)
#pragma unroll
                for (int m = 0; m < 4; ++m)
#pragma unroll
                    for (int n = 0; n < 2; ++n) acc[a][b][m][n] = (f32x4){0.f, 0.f, 0.f, 0.f};
        cur = nxt; cA = nA; cB = nB; ++ui;
    }
    PG8_WAIT_V(0);
    if (wr == 0) PG8_BAR;
    PG8_BAR;
#undef PG8_SA
#undef PG8_SB
#undef PG8_STAGE
#undef PG8_LDA
#undef PG8_LDB
#undef PG8_MMA
#undef PG8_WAIT_V
#undef PG8_WAIT_L
#undef PG8_BAR
#undef PG8_SCHED
#undef PG8_AVOFF
}
struct DenseOrder {
    int nM, nN, nwg, G, c, K;
    __device__ __forceinline__ void init(int nM_, int nN_, int G_, int c_, int K_) { nM = nM_; nN = nN_; nwg = nM * nN; G = G_; c = c_; K = K_; }
    __device__ __forceinline__ bool next(int i, Unit& u) const {
        const long L = (long)i * G + c; if (L >= nwg) return false;
        int wgid = (int)L; { const int q = nwg / 8, r = nwg % 8, xcd = wgid % 8, off = wgid / 8; wgid = (xcd < r ? xcd * (q + 1) : r * (q + 1) + (xcd - r) * q) + off; }
        const int nig = 8 * nN, gid = wgid / nig, fm = gid * 8, gsz = (nM - fm) < 8 ? (nM - fm) : 8;
        u.pm = fm + ((wgid % nig) % gsz); u.pn = (wgid % nig) / gsz;
        u.aoff = (size_t)u.pm * 256 * K * 2; u.boff = (size_t)u.pn * 256 * K * 2; u.e = 0; u.mvalid = 256; u.rowbase = u.pm * 256; u.mi = 0;
        return true;
    }
    __device__ __forceinline__ int row(const Unit&, int r) const { return r; }
};
}

extern __shared__ __attribute__((aligned(16))) unsigned char g_smem[];
#define PHASE_FN __device__ __forceinline__
enum { PH_PROLOGUE = 0, PH_NORM_MIX, PH_GEMM_IN_EVEN, PH_EVEN_TOK, PH_GDN_CHUNK, PH_GDN_SCAN, PH_DSA_TOPK, PH_DSA_ATTN, PH_GDN_OUT,
       PH_GEMM_OUT, PH_NORM_FFN, PH_MOE1, PH_MOE2, PH_GEMM_IN_ODD, PH_GLA_TOK, PH_GLA_CHUNK, PH_GLA_SCAN, PH_GLA_OUT, PH_FINAL };

PHASE_FN void ph_prologue(const Params& p, float* smem) {
    KParams* pp = kparams();
    GU8* wsg_ = (GU8*)pp->ws; asm volatile("" : "+s"(wsg_)); unsigned char* ws_ = (unsigned char*)wsg_;
    { int ldz_ = 0; asm volatile("" : "+s"(ldz_)); smem = (float*)(g_smem + ldz_); }
    int tid_ = threadIdx.x; asm volatile("" : "+v"(tid_)); const int tid = tid_, nthr = gridDim.x * NTHREADS, gid = blockIdx.x * NTHREADS + tid;
    for (int i = tid; i < 2 * ND; i += NTHREADS) smem[i] = siluf_(as_global(pp->c)[i]);
    __syncthreads();
    float* MOD = (float*)(ws_ + OFF_MOD);
    { float* red = smem + 2048;
      const int lane = tid & 63, wv = tid >> 6;
      for (int item = blockIdx.x; item < 4 * 96; item += gridDim.x) {
          const int l = item / 96, n = (item % 96) * 64 + lane;
          const float* w = as_global(pp->ada_w) + (size_t)l * ND * 6144 + n;
          float a0 = 0.f, a1 = 0.f;
#pragma unroll 8
          for (int k = wv * 128; k < wv * 128 + 128; ++k) { const float wv_ = w[(size_t)k * 6144]; a0 += smem[k] * wv_; a1 += smem[ND + k] * wv_; }
          __syncthreads();
          red[(wv * 64 + lane) * 2] = a0; red[(wv * 64 + lane) * 2 + 1] = a1;
          __syncthreads();
          if (tid < 128) { const int c = tid >> 1, bb = tid & 1; float a = 0.f; for (int w8 = 0; w8 < 8; ++w8) a += red[(w8 * 64 + c) * 2 + bb];
              MOD[(l * 2 + bb) * 6144 + (item % 96) * 64 + c] = a + as_global(pp->ada_b)[l * 6144 + (item % 96) * 64 + c]; }
      }
      __syncthreads(); }
    float* COSA = (float*)(ws_ + OFF_COSA); float* SINA = (float*)(ws_ + OFF_SINA);
    float* COSI = (float*)(ws_ + OFF_COSI); float* SINI = (float*)(ws_ + OFF_SINI);
    for (size_t i = gid; i < (size_t)NT * 64; i += nthr) {
        const int t = (int)(i >> 6), j = (int)(i & 63);
        double s, c; sincos_d((double)as_global(pp->pos)[t] * ipow_d(pp->rA, j), s, c);
        COSA[i] = (float)c; SINA[i] = (float)s;
    }
    for (size_t i = gid; i < (size_t)NT * 32; i += nthr) {
        const int t = (int)(i >> 5), j = (int)(i & 31);
        double s, c; sincos_d((double)as_global(pp->pos)[t] * ipow_d(pp->rI, j), s, c);
        COSI[i] = (float)c; SINI[i] = (float)s;
    }
}

PHASE_FN void ph_rows(const Params& p, int layer, int mode, float* smem) {
    KParams* pp = kparams();
    GU8* wsg_ = (GU8*)pp->ws; asm volatile("" : "+s"(wsg_)); unsigned char* ws_ = (unsigned char*)wsg_;
    { int ldz_ = 0; asm volatile("" : "+s"(ldz_)); smem = (float*)(g_smem + ldz_); }
    int tid_ = threadIdx.x; asm volatile("" : "+v"(tid_)); const int tid = tid_, lane = tid & 63, wv = tid >> 6;
    int* pad = (int*)smem;
    const int moe_layer = (mode == 1) ? 3 : layer - 1;
    if (moe_layer >= 0) {
        if (tid == 0) { const int* cnt = (const int*)(ws_ + OFF_CNT) + moe_layer * 32 * CSTR; int a = 0; for (int e = 0; e < 32; ++e) { pad[e] = a; a += ((cnt[e * CSTR] + 127) / 128) * 128; } }
        __syncthreads();
    }
    const float* MOD = (const float*)(ws_ + OFF_MOD);
    bf16_t* H = (bf16_t*)(ws_ + OFF_H);
    const bf16_t* YB = (const bf16_t*)(ws_ + OFF_YB);
    const int* ASG = (const int*)(ws_ + OFF_ASG);
    const float* GATE = (const float*)(ws_ + OFF_GATE);
    auto load_x = [&](int row, float (&xv)[16]) {
        const float* xin = (mode == 0 && layer == 0) ? (as_global(pp->x) + (size_t)row * ND) : (as_global(pp->X) + (size_t)row * ND);
#pragma unroll
        for (int j = 0; j < 4; ++j) { const float4 v = *(const float4*)(xin + j * 256 + lane * 4); xv[4 * j] = v.x; xv[4 * j + 1] = v.y; xv[4 * j + 2] = v.z; xv[4 * j + 3] = v.w; }
    };
    auto load_y = [&](int row, uint2 (&ya)[4], uint2 (&yb)[4], float& g0, float& g1) {
        const int4 as = *(const int4*)(ASG + row * 4);
        g0 = GATE[row * 2]; g1 = GATE[row * 2 + 1];
        const bf16_t* y0 = YB + (size_t)(pad[as.x] + as.y) * ND;
        const bf16_t* y1 = YB + (size_t)(pad[as.z] + as.w) * ND;
#pragma unroll
        for (int j = 0; j < 4; ++j) { ya[j] = *(const uint2*)(y0 + j * 256 + lane * 4); yb[j] = *(const uint2*)(y1 + j * 256 + lane * 4); }
    };
    auto finish = [&](int row, float (&xv)[16], const uint2 (&ya)[4], const uint2 (&yb)[4], float g0, float g1) {
        const int b = row >> 13;
        float* xr = as_global(pp->X) + (size_t)row * ND;
        if (moe_layer >= 0) {
            const float* gt = MOD + (size_t)(moe_layer * 2 + b) * 6144 + 5 * 1024;
#pragma unroll
            for (int j = 0; j < 4; ++j) {
                const int col = j * 256 + lane * 4;
                const f32x4 a = unpack4(ya[j]), bq = unpack4(yb[j]); const float4 g = *(const float4*)(gt + col);
                xv[4 * j] += g.x * (g0 * a[0] + g1 * bq[0]); xv[4 * j + 1] += g.y * (g0 * a[1] + g1 * bq[1]);
                xv[4 * j + 2] += g.z * (g0 * a[2] + g1 * bq[2]); xv[4 * j + 3] += g.w * (g0 * a[3] + g1 * bq[3]);
                if (mode == 0) *(float4*)(xr + col) = make_float4(xv[4 * j], xv[4 * j + 1], xv[4 * j + 2], xv[4 * j + 3]);
            }
        }
        float ss = 0.f;
#pragma unroll
        for (int j = 0; j < 16; ++j) ss += xv[j] * xv[j];
        ss = wave_sum(ss);
        const float rstd = rsqrtf(ss * (1.f / 1024.f) + EPS);
        if (mode == 0) {
            const float* nw = as_global(pp->norm_mix) + layer * 1024;
            const float* sh = MOD + (size_t)(layer * 2 + b) * 6144;
            const float* sc = sh + 1024;
#pragma unroll
            for (int j = 0; j < 4; ++j) {
                const int col = j * 256 + lane * 4;
                const float4 w = *(const float4*)(nw + col), s4 = *(const float4*)(sc + col), h4 = *(const float4*)(sh + col);
                f32x4 ov;
                ov[0] = xv[4 * j] * rstd * w.x * (1.f + s4.x) + h4.x; ov[1] = xv[4 * j + 1] * rstd * w.y * (1.f + s4.y) + h4.y;
                ov[2] = xv[4 * j + 2] * rstd * w.z * (1.f + s4.z) + h4.z; ov[3] = xv[4 * j + 3] * rstd * w.w * (1.f + s4.w) + h4.w;
                *(uint2*)(H + (size_t)row * ND + col) = pack4(ov);
            }
        } else {
#pragma unroll
            for (int j = 0; j < 4; ++j) {
                const int col = j * 256 + lane * 4;
                const float4 w = *(const float4*)(as_global(pp->final_norm) + col);
                *(float4*)(xr + col) = make_float4(xv[4 * j] * rstd * w.x, xv[4 * j + 1] * rstd * w.y, xv[4 * j + 2] * rstd * w.z, xv[4 * j + 3] * rstd * w.w);
            }
        }
    };
    const int stride = gridDim.x * 8;
    for (int row = blockIdx.x * 8 + wv; row < NT; row += 2 * stride) {
        const int rowB = row + stride; const bool hasB = rowB < NT; const int rB = hasB ? rowB : row;
        float xa[16], xb[16]; uint2 yaa[4], yab[4], yba[4], ybb[4]; float ga0 = 0.f, ga1 = 0.f, gb0 = 0.f, gb1 = 0.f;
        load_x(row, xa); load_x(rB, xb);
        if (moe_layer >= 0) { load_y(row, yaa, yab, ga0, ga1); load_y(rB, yba, ybb, gb0, gb1); }
        finish(row, xa, yaa, yab, ga0, ga1);
        if (hasB) finish(rowB, xb, yba, ybb, gb0, gb1);
    }
}

struct EpiIn {
    static constexpr bool PERM = true;
    bf16_t* P; float* AUX; int ncols; int even;
    __device__ __forceinline__ void operator()(const f32x4 (&acc)[2][2][4][2], const pg8::Unit& u, int wr, int wc, int fr, int fq) const {
        const int row0 = u.pm * 256 + wr * 64 + fr, col0 = u.pn * 256 + wc * 32 + 8 * fq;
#pragma unroll
        for (int ai = 0; ai < 2; ++ai)
#pragma unroll
            for (int m = 0; m < 4; ++m) { const int r = row0 + ai * 128 + m * 16;
#pragma unroll
                for (int bj = 0; bj < 2; ++bj) { const int c = col0 + bj * 128;
                    if (c < ncols) { const uint2 lo = pack4(acc[ai][bj][m][0]), hi = pack4(acc[ai][bj][m][1]); *(uint4*)(P + (size_t)r * LDPB + c) = make_uint4(lo.x, lo.y, hi.x, hi.y); }
                    if (even) {
                        if (c == 2048) { *(f32x4*)(AUX + (size_t)r * 16) = acc[ai][bj][m][0]; *(f32x4*)(AUX + (size_t)r * 16 + 4) = acc[ai][bj][m][1]; }
                        if (c == 3912) *(f32x4*)(AUX + (size_t)r * 16 + 8) = acc[ai][bj][m][0];
                    } } }
    }
};

PHASE_FN void ph_gemm_in(const Params& p, int layer, bool even, float* smem) {
    KParams* pp = kparams();
    GU8* wsg_ = (GU8*)pp->ws; asm volatile("" : "+s"(wsg_)); unsigned char* ws_ = (unsigned char*)wsg_;
    int ldz_ = 0; asm volatile("" : "+s"(ldz_));
    const bf16_t* Wt = even ? (const bf16_t*)(ws_ + OFF_WINE) + (size_t)(layer >> 1) * 4096 * 1024 : (const bf16_t*)(ws_ + OFF_WINO) + (size_t)(layer >> 1) * 3072 * 1024;
    EpiIn E; E.P = (bf16_t*)(ws_ + OFF_P); E.AUX = (float*)(ws_ + OFF_AUX); E.ncols = even ? 3920 : 3072; E.even = even ? 1 : 0;
    pg8::DenseOrder S; S.init(64, even ? 16 : 12, gridDim.x, blockIdx.x, 1024);
    __syncthreads();
    pg8::gemm_phase<EpiIn, pg8::DenseOrder, false>((LAS unsigned char*)(g_smem + ldz_), (const bf16_t*)(ws_ + OFF_H), Wt, 1024, S, E);
    __syncthreads();
    if (!even) {
        const bf16_t* H = (const bf16_t*)(ws_ + OFF_H);
        const bf16_t* Wg = (const bf16_t*)(ws_ + OFF_WGL) + (size_t)(layer >> 1) * 128 * 1024;
        float* AUX = (float*)(ws_ + OFF_AUX);
        for (int mt = blockIdx.x; mt < 64; mt += gridDim.x) {
            const bf16_t* Ab = H + (size_t)mt * 256 * 1024;
            float* At = AUX + (size_t)mt * 256 * 16;
            gemm_tile_bf16(1024, g_smem + ldz_,
                [=](int i, int r, int k) -> uint4 { return *(const uint4*)(Ab + (size_t)r * 1024 + k); },
                [=](int i, int r, int k) -> uint4 { return *(const uint4*)(Wg + (size_t)r * 1024 + k); },
                [=](const f32x4 (&acc)[4][4], int wm, int wn, int lane) {
                    if (wn == 0 && (lane >> 4) < 4) {
#pragma unroll
                        for (int mi = 0; mi < 4; ++mi) { const int m = wm * 64 + mi * 16 + (lane & 15); *(f32x4*)(At + (size_t)m * 16 + 4 * (lane >> 4)) = acc[mi][0]; }
                    }
                });
        }
        __syncthreads();
    }
}

PHASE_FN void ph_even_tok(const Params& p, int layer, float* smem) {
    KParams* pp = kparams();
    GU8* wsg_ = (GU8*)pp->ws; asm volatile("" : "+s"(wsg_)); unsigned char* ws_ = (unsigned char*)wsg_;
    { int ldz_ = 0; asm volatile("" : "+s"(ldz_)); smem = (float*)(g_smem + ldz_); }
    int tid_ = threadIdx.x; asm volatile("" : "+v"(tid_)); const int tid = tid_, lane = tid & 63, wv = tid >> 6, li = layer >> 1;
    const bf16_t* P = (const bf16_t*)(ws_ + OFF_P); const float* AUX = (const float*)(ws_ + OFF_AUX);
    bf16_t* QB = (bf16_t*)(ws_ + OFF_QBB); bf16_t* KB = (bf16_t*)(ws_ + OFF_KBB); bf16_t* QI = (bf16_t*)(ws_ + OFF_QIB); bf16_t* KI = (bf16_t*)(ws_ + OFF_KIB); float* WI = (float*)(ws_ + OFF_WI);
    const float* COSA = (const float*)(ws_ + OFF_COSA); const float* SINA = (const float*)(ws_ + OFF_SINA);
    const float* COSI = (const float*)(ws_ + OFF_COSI); const float* SINI = (const float*)(ws_ + OFF_SINI);
    for (int t = blockIdx.x * 8 + wv; t < NT; t += gridDim.x * 8) {
        const bf16_t* Pt = P + (size_t)t * LDPB;
        if (lane < 4) {
            WI[t * 4 + lane] = AUX[(size_t)t * 16 + 8 + lane] * 0.0625f;
        }
        { const float c = COSA[(size_t)t * 64 + lane], sn = SINA[(size_t)t * 64 + lane];
#pragma unroll
          for (int h = 0; h < 4; ++h) {
              float t1 = bf16_to_f32(Pt[2056 + h * 128 + lane]), t2 = bf16_to_f32(Pt[2056 + h * 128 + 64 + lane]);
              QB[(size_t)t * 512 + h * 128 + lane] = f2bf(t1 * c - t2 * sn); QB[(size_t)t * 512 + h * 128 + 64 + lane] = f2bf(t2 * c + t1 * sn);
              t1 = bf16_to_f32(Pt[2568 + h * 128 + lane]); t2 = bf16_to_f32(Pt[2568 + h * 128 + 64 + lane]);
              KB[(size_t)t * 512 + h * 128 + lane] = f2bf(t1 * c - t2 * sn); KB[(size_t)t * 512 + h * 128 + 64 + lane] = f2bf(t2 * c + t1 * sn);
          } }
#pragma unroll
        for (int r = 0; r < 2; ++r) {
            const int item = lane + 64 * r, hh = item >> 5, ii = item & 31;
            const float c = COSI[(size_t)t * 32 + ii], sn = SINI[(size_t)t * 32 + ii];
            const float t1 = bf16_to_f32(Pt[3592 + hh * 64 + ii]), t2 = bf16_to_f32(Pt[3592 + hh * 64 + 32 + ii]);
            QI[(size_t)t * 256 + hh * 64 + ii] = f2bf(t1 * c - t2 * sn); QI[(size_t)t * 256 + hh * 64 + 32 + ii] = f2bf(t2 * c + t1 * sn);
        }
        if (lane < 32) {
            const float c = COSI[(size_t)t * 32 + lane], sn = SINI[(size_t)t * 32 + lane];
            const float t1 = bf16_to_f32(Pt[3848 + lane]), t2 = bf16_to_f32(Pt[3848 + 32 + lane]);
            KI[(size_t)t * 64 + lane] = f2bf(t1 * c - t2 * sn); KI[(size_t)t * 64 + 32 + lane] = f2bf(t2 * c + t1 * sn);
        }
    }
    { bf16_t* VT = (bf16_t*)(ws_ + OFF_VT);
      bf16_t* sv = (bf16_t*)g_smem;
      for (int item = blockIdx.x; item < 2 * 128 * 4; item += gridDim.x) {
          const int h = item & 3, tt = item >> 2, b = tt >> 7, s0 = (tt & 127) * 64;
          __syncthreads();
          for (int e = tid; e < 64 * 128; e += NTHREADS) { const int i = e >> 7, d = e & 127; sv[d * 72 + i] = P[(size_t)(b * 8192 + s0 + i) * LDPB + 3080 + h * 128 + d]; }
          __syncthreads();
          for (int e = tid; e < 128 * 8; e += NTHREADS) { const int d = e >> 3, c = e & 7;
              *(uint4*)(VT + ((size_t)((b * 4 + h) * 128 + d)) * 8192 + s0 + c * 8) = *(const uint4*)(sv + d * 72 + c * 8); }
      } }
}

__device__ __forceinline__ f32x4 mma_lds(const unsigned char* A, int sa, int a0, const unsigned char* B, int sb, int b0, int K, f32x4 acc, int c16, int q4) {
    const unsigned char* ap = A + (a0 + c16) * sa + q4 * 16;
    const unsigned char* bp = B + (b0 + c16) * sb + q4 * 16;
#pragma unroll
    for (int kk = 0; kk < K; kk += 32) { acc = __builtin_amdgcn_mfma_f32_16x16x32_bf16(*(const bf16x8*)(ap + kk * 2), *(const bf16x8*)(bp + kk * 2), acc, 0, 0, 0); }
    return acc;
}

PHASE_FN void ph_gdn_chunk(const Params& p, int layer, float* smem) {
    KParams* pp = kparams();
    GU8* wsg_ = (GU8*)pp->ws; asm volatile("" : "+s"(wsg_)); unsigned char* ws_ = (unsigned char*)wsg_;
    int tid_ = threadIdx.x; asm volatile("" : "+v"(tid_)); const int tid = tid_, lane = tid & 63, wv = __builtin_amdgcn_readfirstlane(tid >> 6), q4 = lane >> 4, c16 = lane & 15;
    int ldz_ = 0; asm volatile("" : "+s"(ldz_)); unsigned char* lds = g_smem + ldz_;
    constexpr int SN = 272, ST = 144;
    unsigned char* bKN = lds;
    unsigned char* bQN = lds + 18432;
    unsigned char* bKBG = lds + 35840;
    unsigned char* bVB = lds + 54272;
    unsigned char* bKD = lds + 72704;
    unsigned char* bUT = lds + 91136;
    float* sL = (float*)(lds + 109568);
    unsigned char* bAQK = lds + 126976;
    unsigned char* bTB = lds + 136192;
    float* sG = (float*)(lds + 145408); float* sB = sG + 64; float* sEg = sB + 64;
    const int li = layer >> 1;
    const bf16_t* P = (const bf16_t*)(ws_ + OFF_P); const float* AUX = (const float*)(ws_ + OFF_AUX);
    const float* cw = as_global(pp->conv_w) + (size_t)li * 4 * 1536;
    uint4* PFR = (uint4*)(ws_ + OFF_PFR); uint4* RFR = (uint4*)(ws_ + OFF_RFR); uint2* QFR = (uint2*)(ws_ + OFF_QFR); uint2* OFR = (uint2*)(ws_ + OFF_OFR);
    float* GL = (float*)(ws_ + OFF_GL);
    for (int ci = blockIdx.x; ci < 1024; ci += gridDim.x) {
        const int b = ci >> 9, h = (ci >> 7) & 3, n = ci & 127;
        const int t0 = b * 8192 + n * 64;
        __syncthreads();
        if (tid < 64) { float g = -expf(as_global(pp->a_log)[li * 4 + h]) * softplusf_(AUX[(size_t)(t0 + tid) * 16 + 4 + h] + as_global(pp->dt_bias)[li * 4 + h]);
#pragma unroll
            for (int o = 1; o < 64; o <<= 1) { const float nb = __shfl_up(g, o); if (lane >= o) g += nb; }
            sG[tid] = g; sB[tid] = sigmoidf_(AUX[(size_t)(t0 + tid) * 16 + h]); sEg[tid] = expf(g); }
        for (int e = tid; e < 64 * 36; e += NTHREADS) ((unsigned*)bAQK)[e] = 0u;
        __syncthreads();
        const float gl = sG[63];
        for (int rep_a = 0; rep_a < REP_A; ++rep_a)
        {
            const int d0 = 2 * lane, cb = h * 128 + d0, s00 = n * 64;
            float wq[4][2], wk[4][2], wvv[4][2];
#pragma unroll
            for (int jj = 0; jj < 4; ++jj) { wq[jj][0] = cw[jj * 1536 + cb]; wq[jj][1] = cw[jj * 1536 + cb + 1]; wk[jj][0] = cw[jj * 1536 + 512 + cb]; wk[jj][1] = cw[jj * 1536 + 512 + cb + 1];
                                            wvv[jj][0] = cw[jj * 1536 + 1024 + cb]; wvv[jj][1] = cw[jj * 1536 + 1024 + cb + 1]; }
            float tk0[8], tk1[8], tv0[8], tv1[8], td0[8], td1[8];
#pragma unroll
            for (int r = 0; r < 8; ++r) {
                const int i = wv * 8 + r;
                float aq0 = 0.f, aq1 = 0.f, ak0 = 0.f, ak1 = 0.f, av0 = 0.f, av1 = 0.f;
#pragma unroll
                for (int jj = 0; jj < 4; ++jj) {
                    if (s00 + i - 3 + jj >= 0) {
                        const bf16_t* rp = P + (size_t)(t0 + i - 3 + jj) * LDPB + cb;
                        const unsigned uq = *(const unsigned*)rp, uk = *(const unsigned*)(rp + 512), uv = *(const unsigned*)(rp + 1024);
                        aq0 += wq[jj][0] * __uint_as_float(uq << 16); aq1 += wq[jj][1] * __uint_as_float(uq & 0xffff0000u);
                        ak0 += wk[jj][0] * __uint_as_float(uk << 16); ak1 += wk[jj][1] * __uint_as_float(uk & 0xffff0000u);
                        av0 += wvv[jj][0] * __uint_as_float(uv << 16); av1 += wvv[jj][1] * __uint_as_float(uv & 0xffff0000u);
                    }
                }
                aq0 = siluf_(aq0); aq1 = siluf_(aq1); ak0 = siluf_(ak0); ak1 = siluf_(ak1); av0 = siluf_(av0); av1 = siluf_(av1);
                const float rq = rsqrtf(wave_sum(aq0 * aq0 + aq1 * aq1) + EPS), rk = rsqrtf(wave_sum(ak0 * ak0 + ak1 * ak1) + EPS);
                aq0 *= rq; aq1 *= rq; ak0 *= rk; ak1 *= rk;
                const float be = sB[i], eg_i = sEg[i], ekd = expf(gl - sG[i]);
                *(unsigned*)(bKN + i * SN + d0 * 2) = cvt_pk_bf16(ak0, ak1);
                *(unsigned*)(bQN + i * SN + d0 * 2) = cvt_pk_bf16(aq0, aq1);
                tk0[r] = ak0 * be * eg_i; tk1[r] = ak1 * be * eg_i; tv0[r] = av0 * be; tv1[r] = av1 * be; td0[r] = ak0 * ekd; td1[r] = ak1 * ekd;
                if ((r & 1) == 1) asm volatile("" ::: "memory");
            }
#define PK8(T) make_uint4(cvt_pk_bf16(T[0], T[1]), cvt_pk_bf16(T[2], T[3]), cvt_pk_bf16(T[4], T[5]), cvt_pk_bf16(T[6], T[7]))
            *(uint4*)(bKBG + d0 * ST + wv * 16) = PK8(tk0); *(uint4*)(bKBG + (d0 + 1) * ST + wv * 16) = PK8(tk1);
            *(uint4*)(bVB + d0 * ST + wv * 16) = PK8(tv0); *(uint4*)(bVB + (d0 + 1) * ST + wv * 16) = PK8(tv1);
            *(uint4*)(bKD + d0 * ST + wv * 16) = PK8(td0); *(uint4*)(bKD + (d0 + 1) * ST + wv * 16) = PK8(td1);
        }
        __syncthreads();
        for (int u = wv; u < 20; u += 8) {
            const int kind = (u >= 10) ? 1 : 0, idx = u - kind * 10;
            const int ti = (idx >= 6) ? 3 : (idx >= 3) ? 2 : (idx >= 1) ? 1 : 0, tj = idx - ((ti * (ti + 1)) >> 1);
            f32x4 acc = (f32x4){0.f, 0.f, 0.f, 0.f};
            acc = mma_lds(kind ? bQN : bKN, SN, 16 * ti, bKN, SN, 16 * tj, 128, acc, c16, q4);
            const int j = 16 * tj + c16;
#pragma unroll
            for (int r = 0; r < 4; ++r) { const int i = 16 * ti + 4 * q4 + r;
                const float dec = (j <= i) ? expf(sG[i] - sG[j]) : 0.f;
                if (kind == 0) sL[i * 68 + j] = (j < i) ? sB[i] * acc[r] * dec : 0.f;
                else *(bf16_t*)(bAQK + i * ST + j * 2) = f2bf(acc[r] * SCALE128 * dec); }
        }
        __syncthreads();
        for (int rep_b = 0; rep_b < REP_B; ++rep_b)
        if (wv == 0) {
            float t[64];
            int zz = 0; asm volatile("" : "+v"(zz)); const float* sLo = sL + zz;
#pragma clang loop unroll(full)
            for (int i = 0; i < 64; ++i) { float a0 = (i == lane) ? 1.f : 0.f, a1 = 0.f, a2 = 0.f, a3 = 0.f;
#define LQ(q) float4 lv##q = make_float4(0.f, 0.f, 0.f, 0.f); if (4 * q < i) lv##q = *(const float4*)(sLo + i * 68 + 4 * q);
#define FQ(q) if (4 * q < i) { a0 -= lv##q.x * t[4 * q]; if (4 * q + 1 < i) a1 -= lv##q.y * t[4 * q + 1]; if (4 * q + 2 < i) a2 -= lv##q.z * t[4 * q + 2]; if (4 * q + 3 < i) a3 -= lv##q.w * t[4 * q + 3]; }
                { LQ(0) LQ(1) LQ(2) LQ(3) LQ(4) LQ(5) LQ(6) LQ(7)
                  FQ(0) FQ(1) FQ(2) FQ(3) FQ(4) FQ(5) FQ(6) FQ(7) }
                if (i > 32) { asm volatile("" ::: "memory");
                  LQ(8) LQ(9) LQ(10) LQ(11) LQ(12) LQ(13) LQ(14) LQ(15)
                  FQ(8) FQ(9) FQ(10) FQ(11) FQ(12) FQ(13) FQ(14) FQ(15) }
                t[i] = (a0 + a1) + (a2 + a3); asm volatile("" ::: "memory"); }
#pragma unroll
            for (int i = 0; i < 64; ++i) *(bf16_t*)(bTB + i * ST + lane * 2) = f2bf(t[i]);
        }
        __syncthreads();
#pragma unroll 4
        for (int x = 0; x < 8; ++x) {
            const int u = wv * 8 + x, kind = u >> 5, ti = (u >> 3) & 3, td = u & 7;
            f32x4 acc = (f32x4){0.f, 0.f, 0.f, 0.f};
            acc = mma_lds(bTB, ST, 16 * ti, kind ? bVB : bKBG, ST, 16 * td, 64, acc, c16, q4);
            *(uint2*)((kind ? bUT : bKN) + (16 * td + c16) * ST + (16 * ti + 4 * q4) * 2) = pack4(acc);
        }
        __syncthreads();
        unsigned char* bWT = bKN;
        const float eg = expf(gl);
        for (int rep_c = 0; rep_c < REP_C; ++rep_c) {
        for (int x = 0; x < 4; ++x) {
            const int u = wv * 4 + x, ti = u >> 2, a = u & 3;
            uint4 fr;
#pragma unroll
            for (int hf = 0; hf < 2; ++hf) { const int tk = 2 * a + hf;
                f32x4 acc = (f32x4){0.f, 0.f, 0.f, 0.f};
                acc = mma_lds(bWT, ST, 16 * tk, bKD, ST, 16 * ti, 64, acc, c16, q4);
                f32x4 v;
#pragma unroll
                for (int r = 0; r < 4; ++r) v[r] = ((16 * tk + 4 * q4 + r) == (16 * ti + c16) ? eg : 0.f) - acc[r];
                const uint2 pk = pack4(v);
                if (hf == 0) { fr.x = pk.x; fr.y = pk.y; } else { fr.z = pk.x; fr.w = pk.y; } }
            PFR[((size_t)(ci * 8 + ti) * 4 + a) * 64 + lane] = fr;
        }
        for (int x = 0; x < 2; ++x) {
            const int u = wv * 2 + x, ti = u >> 2, a = u & 3;
            uint4 fr;
            const int i = 16 * ti + c16;
            const float qs = SCALE128 * sEg[i];
#pragma unroll
            for (int hf = 0; hf < 2; ++hf) { const int tk = 2 * a + hf;
                f32x4 acc = (f32x4){0.f, 0.f, 0.f, 0.f};
                acc = mma_lds(bWT, ST, 16 * tk, bAQK, ST, 16 * ti, 64, acc, c16, q4);
                const f32x4 qv = unpack4(*(const uint2*)(bQN + i * SN + (16 * tk + 4 * q4) * 2));
                const uint2 pk = pack4(qv * qs - acc);
                if (hf == 0) { fr.x = pk.x; fr.y = pk.y; } else { fr.z = pk.x; fr.w = pk.y; } }
            RFR[((size_t)(ci * 4 + ti) * 4 + a) * 64 + lane] = fr;
        }
#pragma unroll 4
        for (int x = 0; x < 8; ++x) {
            const int u = wv * 8 + x, tdv = u >> 3, tdk = u & 7;
            f32x4 acc = (f32x4){0.f, 0.f, 0.f, 0.f};
            acc = mma_lds(bKD, ST, 16 * tdk, bUT, ST, 16 * tdv, 64, acc, c16, q4);
            QFR[((size_t)(ci * 8 + tdv) * 8 + tdk) * 64 + lane] = pack4(acc);
        }
#pragma unroll
        for (int x = 0; x < 4; ++x) {
            const int u = wv * 4 + x, tdv = u >> 2, ti = u & 3;
            f32x4 acc = (f32x4){0.f, 0.f, 0.f, 0.f};
            acc = mma_lds(bAQK, ST, 16 * ti, bUT, ST, 16 * tdv, 64, acc, c16, q4);
            OFR[((size_t)(ci * 8 + tdv) * 4 + ti) * 64 + lane] = pack4(acc);
        }
        }
        if (tid == 0) GL[ci] = gl;
    }
}

__device__ __forceinline__ void gs_load(uint4 (&d)[12], const unsigned char* pp, const unsigned char* rr, const unsigned char* qq, const unsigned char* oo, const int lt) {
#pragma unroll
    for (int i = 0; i < 6; ++i) { int c = lt + 384 * i; c = c < 2048 ? c : 2047; d[i] = *(const uint4*)(pp + c * 16); }
#pragma unroll
    for (int i = 0; i < 3; ++i) { int c = lt + 384 * i; c = c < 1024 ? c : 1023; d[6 + i] = *(const uint4*)(rr + c * 16); }
#pragma unroll
    for (int i = 0; i < 2; ++i) { int c = lt + 384 * i; c = c < 512 ? c : 511; d[9 + i] = *(const uint4*)(qq + c * 16); }
    { const int c = lt < 256 ? lt : 255; d[11] = *(const uint4*)(oo + c * 16); }
}
__device__ __forceinline__ void gs_store(const uint4 (&d)[12], unsigned char* sb, const int lt) {
#pragma unroll
    for (int i = 0; i < 6; ++i) { const int c = lt + 384 * i; if (c < 2048) *(uint4*)(sb + c * 16) = d[i]; }
#pragma unroll
    for (int i = 0; i < 3; ++i) { const int c = lt + 384 * i; if (c < 1024) *(uint4*)(sb + 32768 + c * 16) = d[6 + i]; }
#pragma unroll
    for (int i = 0; i < 2; ++i) { const int c = lt + 384 * i; if (c < 512) *(uint4*)(sb + 49152 + c * 16) = d[9 + i]; }
    if (lt < 256) *(uint4*)(sb + 57344 + lt * 16) = d[11];
}

#define SCAN_BODY                 bf16x8 Sb[4]; \
_Pragma("unroll") \
                for (int a = 0; a < 4; ++a) { union { uint4 u; bf16x8 v; } cv; const uint2 lo = pack4(S[2 * a]), hi = pack4(S[2 * a + 1]); cv.u.x = lo.x; cv.u.y = lo.y; cv.u.z = hi.x; cv.u.w = hi.y; Sb[a] = cv.v; } \
                const int t0 = b * 8192 + n * 64; \
                {   f32x4 oa[4]; \
_Pragma("unroll") \
                    for (int ti = 0; ti < 4; ++ti) oa[ti] = unpack4(*(const uint2*)(Of + ti * 512)); \
_Pragma("unroll") \
                    for (int a = 0; a < 4; ++a) \
_Pragma("unroll") \
                        for (int ti = 0; ti < 4; ++ti) oa[ti] = __builtin_amdgcn_mfma_f32_16x16x32_bf16(*(const bf16x8*)(Rf + (ti * 4 + a) * 1024), Sb[a], oa[ti], 0, 0, 0); \
_Pragma("unroll") \
                    for (int ti = 0; ti < 4; ++ti) { \
                        float* op = O + (size_t)(t0 + 16 * ti + 4 * q4) * 1024 + h * 128 + 16 * tdv + c16; \
                        op[0] = oa[ti][0]; op[1024] = oa[ti][1]; op[2048] = oa[ti][2]; op[3072] = oa[ti][3]; } \
                } \
                asm volatile("" ::: "memory"); \
_Pragma("unroll") \
                for (int g = 0; g < 2; ++g) { \
                    f32x4 sa[4]; \
_Pragma("unroll") \
                    for (int t = 0; t < 4; ++t) sa[t] = unpack4(*(const uint2*)(Qf + (g * 4 + t) * 512)); \
_Pragma("unroll") \
                    for (int a = 0; a < 4; ++a) \
_Pragma("unroll") \
                        for (int t = 0; t < 4; ++t) sa[t] = __builtin_amdgcn_mfma_f32_16x16x32_bf16(*(const bf16x8*)(Pf + ((g * 4 + t) * 4 + a) * 1024), Sb[a], sa[t], 0, 0, 0); \
_Pragma("unroll") \
                    for (int t = 0; t < 4; ++t) S[g * 4 + t] = sa[t]; \
                    asm volatile("" ::: "memory"); \
                }
PHASE_FN void ph_gdn_scan(const Params& p, float* smem) {
    KParams* pp = kparams();
    GU8* wsg_ = (GU8*)pp->ws; asm volatile("" : "+s"(wsg_)); unsigned char* ws_ = (unsigned char*)wsg_;
    int tid_ = threadIdx.x; asm volatile("" : "+v"(tid_)); const int tid = tid_, lane = tid & 63, wv = __builtin_amdgcn_readfirstlane(tid >> 6), q4 = lane >> 4, c16 = lane & 15;
    int ldz_ = 0; asm volatile("" : "+s"(ldz_)); unsigned char* lds = g_smem + ldz_;
    constexpr int STG = 61440;
    const unsigned char* PFR = ws_ + OFF_PFR; const unsigned char* RFR = ws_ + OFF_RFR; const unsigned char* QFR = ws_ + OFF_QFR; const unsigned char* OFR = ws_ + OFF_OFR;
    float* O = (float*)(ws_ + OFF_O);
    for (int it = blockIdx.x; it < 32; it += gridDim.x) {
        const int bh = it >> 2, pair = it & 3, b = bh >> 2, h = bh & 3;
        __syncthreads();
        if (wv >= 2) {
            const int lt = tid - 128;
            const unsigned char* Pb = PFR + (size_t)bh * 128 * 32768;
            const unsigned char* Rb = RFR + (size_t)bh * 128 * 16384;
            const unsigned char* Qb = QFR + (size_t)bh * 128 * 32768 + pair * 8192;
            const unsigned char* Ob = OFR + (size_t)bh * 128 * 16384 + pair * 4096;
            uint4 ra0, ra1, ra2, ra3, ra4, ra5, ra6, ra7, ra8, ra9, ra10, ra11, rb0, rb1, rb2, rb3, rb4, rb5, rb6, rb7, rb8, rb9, rb10, rb11;
            uint4 rc0, rc1, rc2, rc3, rc4, rc5, rc6, rc7, rc8, rc9, rc10, rc11;
#define LDC(base_, c_, mx_) (*(const uint4*)((base_) + (size_t)(((c_) < (mx_)) ? (c_) : (mx_)) * 16))
#define GS_LOAD(X, n_) do { const unsigned char* pp_ = Pb + (size_t)(n_) * 32768; const unsigned char* rr_ = Rb + (size_t)(n_) * 16384; \
                const unsigned char* qq_ = Qb + (size_t)(n_) * 32768; const unsigned char* oo_ = Ob + (size_t)(n_) * 16384; \
                X##0 = LDC(pp_, lt, 2047); X##1 = LDC(pp_, lt + 384, 2047); X##2 = LDC(pp_, lt + 768, 2047); X##3 = LDC(pp_, lt + 1152, 2047); X##4 = LDC(pp_, lt + 1536, 2047); X##5 = LDC(pp_, lt + 1920, 2047); \
                X##6 = LDC(rr_, lt, 1023); X##7 = LDC(rr_, lt + 384, 1023); X##8 = LDC(rr_, lt + 768, 1023); \
                X##9 = LDC(qq_, lt, 511); X##10 = LDC(qq_, lt + 384, 511); X##11 = LDC(oo_, lt, 255); } while (0)
#define STC(off_, c_, lim_, v_) do { if ((c_) < (lim_)) *(uint4*)(sb_ + (off_) + (c_) * 16) = v_; } while (0)
#define GS_STORE(X, st_) do { unsigned char* sb_ = lds + (st_) * STG; \
                STC(0, lt, 2048, X##0); STC(0, lt + 384, 2048, X##1); STC(0, lt + 768, 2048, X##2); STC(0, lt + 1152, 2048, X##3); STC(0, lt + 1536, 2048, X##4); STC(0, lt + 1920, 2048, X##5); \
                STC(32768, lt, 1024, X##6); STC(32768, lt + 384, 1024, X##7); STC(32768, lt + 768, 1024, X##8); \
                STC(49152, lt, 512, X##9); STC(49152, lt + 384, 512, X##10); STC(57344, lt, 256, X##11); } while (0)
            GS_LOAD(ra, 0); GS_STORE(ra, 0);
            GS_LOAD(rb, 1); GS_LOAD(rc, 2); GS_LOAD(ra, 3);
            __syncthreads();
#define CLAMPN(x_) (((x_) < 128) ? (x_) : 127)
            for (int n = 0; n < 128; n += 3) {
                if (n + 1 < 128) GS_STORE(rb, (n + 1) & 1);
                GS_LOAD(rb, CLAMPN(n + 4)); LBAR();
                if (n + 1 < 128) { if (n + 2 < 128) GS_STORE(rc, (n + 2) & 1);
                    GS_LOAD(rc, CLAMPN(n + 5)); LBAR(); }
                if (n + 2 < 128) { if (n + 3 < 128) GS_STORE(ra, (n + 3) & 1);
                    GS_LOAD(ra, CLAMPN(n + 6)); LBAR(); }
            }
        } else {
            const int tdv = pair * 2 + wv;
            f32x4 S[8];
#pragma unroll
            for (int t = 0; t < 8; ++t) S[t] = (f32x4){0.f, 0.f, 0.f, 0.f};
            __syncthreads();
            for (int n = 0; n < 128; ++n) {
                const unsigned char* base = lds + (n & 1) * STG;
                const unsigned char* Pf = base + lane * 16, *Rf = base + 32768 + lane * 16;
                const unsigned char* Qf = base + 49152 + wv * 4096 + lane * 8, *Of = base + 57344 + wv * 2048 + lane * 8;
                SCAN_BODY
                LBAR();
            }
        }
    }
}

__device__ __forceinline__ void block_sum4(int (&v)[4], int* buf) {
    const int lane = threadIdx.x & 63, wv = threadIdx.x >> 6;
#pragma unroll
    for (int q = 0; q < 4; ++q) v[q] = wave_sum_i(v[q]);
    if (lane == 0) {
#pragma unroll
        for (int q = 0; q < 4; ++q) buf[wv * 4 + q] = v[q];
    }
    __syncthreads();
#pragma unroll
    for (int q = 0; q < 4; ++q) { int a = 0; for (int w = 0; w < 8; ++w) a += buf[w * 4 + q]; v[q] = a; }
}

PHASE_FN void ph_dsa_topk(const Params& p, int layer, float* smem) {
    KParams* pp = kparams();
    GU8* wsg_ = (GU8*)pp->ws; asm volatile("" : "+s"(wsg_)); unsigned char* ws_ = (unsigned char*)wsg_;
    int tid_ = threadIdx.x; asm volatile("" : "+v"(tid_)); const int tid = tid_, lane = tid & 63, wv = __builtin_amdgcn_readfirstlane(tid >> 6), q4 = lane >> 4, c16 = lane & 15;
    int* sRed = (int*)g_smem;
    const bf16_t* QIb = (const bf16_t*)(ws_ + OFF_QIB); const bf16_t* KIb = (const bf16_t*)(ws_ + OFF_KIB); const float* WI = (const float*)(ws_ + OFF_WI);
    unsigned short* M16 = (unsigned short*)(ws_ + OFF_M16);
    int* qhead = (int*)(ws_ + OFF_QCTR) + layer * 16;
    int* sIt = (int*)(g_smem + 512);
    for (;;) {
        __syncthreads();
        if (tid == 0) *sIt = atomicAdd(qhead, 1);
        __syncthreads();
        const int it = *sIt;
        if (it >= 2048) break;
        const int b = it & 1, gp = 1023 - (it >> 1);
        const int s0 = gp * 8, t0 = b * 8192 + s0;
        const int ntiles = (s0 >> 4) + 1;
        const int nreg = (ntiles > wv) ? ((ntiles - wv + 7) >> 3) : 0;
        const bf16_t* qp = QIb + (size_t)(t0 + (c16 >> 2)) * 256 + (c16 & 3) * 64 + 8 * q4;
        const bf16x8 a0A = *(const bf16x8*)qp, a1A = *(const bf16x8*)(qp + 32), a0B = *(const bf16x8*)(qp + 4 * 256), a1B = *(const bf16x8*)(qp + 4 * 256 + 32);
        const float4 wqA = *(const float4*)(WI + (size_t)(t0 + q4) * 4), wqB = *(const float4*)(WI + (size_t)(t0 + 4 + q4) * 4);
        const int myqA = s0 + q4, myqB = s0 + 4 + q4;
        int c16s = c16; asm volatile("" : "+v"(c16s));
        int wvs = wv; asm volatile("" : "+s"(wvs));
        unsigned kA[64], kB[64];
#pragma unroll
        for (int i = 0; i < 64; ++i) { kA[i] = 0u; kB[i] = 0u; }
#pragma unroll
        for (int blk = 0; blk < 4; ++blk) if (nreg > blk * 16) {
#pragma unroll
            for (int ii = 0; ii < 16; ++ii) { const int i = blk * 16 + ii, tile = wvs + 8 * i;
                if (tile < ntiles) {
                    const bf16_t* kp = KIb + (size_t)(b * 8192 + tile * 16 + c16s) * 64 + 8 * q4;
                    const bf16x8 k0 = *(const bf16x8*)kp, k1 = *(const bf16x8*)(kp + 32);
                    f32x4 accA = (f32x4){0.f, 0.f, 0.f, 0.f}, accB = accA;
                    accA = __builtin_amdgcn_mfma_f32_16x16x32_bf16(a0A, k0, accA, 0, 0, 0);
                    accB = __builtin_amdgcn_mfma_f32_16x16x32_bf16(a0B, k0, accB, 0, 0, 0);
                    accA = __builtin_amdgcn_mfma_f32_16x16x32_bf16(a1A, k1, accA, 0, 0, 0);
                    accB = __builtin_amdgcn_mfma_f32_16x16x32_bf16(a1B, k1, accB, 0, 0, 0);
                    float sa = 0.f, sb = 0.f;
                    sa += wqA.x * fmaxf(accA[0], 0.f); sa += wqA.y * fmaxf(accA[1], 0.f); sa += wqA.z * fmaxf(accA[2], 0.f); sa += wqA.w * fmaxf(accA[3], 0.f);
                    sb += wqB.x * fmaxf(accB[0], 0.f); sb += wqB.y * fmaxf(accB[1], 0.f); sb += wqB.z * fmaxf(accB[2], 0.f); sb += wqB.w * fmaxf(accB[3], 0.f);
                    const int kidx = tile * 16 + c16s;
                    kA[i] = (kidx <= myqA) ? ordkey(sa) : 0u;
                    kB[i] = (kidx <= myqB) ? ordkey(sb) : 0u;
                }
                if ((ii & 3) == 3) asm volatile("" ::: "memory"); }
        }
        const int keffA = (myqA + 1 < 256) ? (myqA + 1) : 256, keffB = (myqB + 1 < 256) ? (myqB + 1) : 256;
        int par = 0;
        int mydone = 0, alldone = 0;
        int* sDone = sRed + 64;
        auto qsum = [&](int c) -> int {
            c += __shfl_xor(c, 1); c += __shfl_xor(c, 2); c += __shfl_xor(c, 4); c += __shfl_xor(c, 8);
            par ^= 1;
            if (c16 == 0) { sRed[par * 32 + wv * 4 + q4] = c; if (wv == 0) sDone[par * 4 + q4] = (mydone == 3) ? 1 : 0; }
            __syncthreads();
            int a = 0;
#pragma unroll
            for (int w = 0; w < 8; ++w) a += sRed[par * 32 + w * 4 + q4];
            alldone = sDone[par * 4] & sDone[par * 4 + 1] & sDone[par * 4 + 2] & sDone[par * 4 + 3];
            return a;
        };
        unsigned UA = 0u, UB = 0u;
        for (int bit = 31; bit >= 0; --bit) {
            const unsigned candA = UA | (1u << bit), candB = UB | (1u << bit);
            int ca = 0, cb = 0;
            if (!alldone) {
#pragma unroll
            for (int blk = 0; blk < 4; ++blk) if (nreg > blk * 16) {
#pragma unroll
                for (int ii = 0; ii < 16; ++ii) { ca += (kA[blk * 16 + ii] >= candA) ? 1 : 0; cb += (kB[blk * 16 + ii] >= candB) ? 1 : 0; }
            } }
            const int tot = qsum(ca | (cb << 16));
            if ((tot & 0xffff) >= keffA) { UA = candA; mydone = (mydone & 2) | (((tot & 0xffff) == keffA) ? 1 : 0); }
            if ((tot >> 16) >= keffB) { UB = candB; mydone = (mydone & 1) | (((tot >> 16) == keffB) ? 2 : 0); }
        }
        int cg = 0, ce = 0;
#pragma unroll
        for (int i = 0; i < 64; ++i) { cg += (kA[i] > UA) ? 1 : 0; ce += (kA[i] == UA) ? 1 : 0; cg += (kB[i] > UB) ? 65536 : 0; ce += (kB[i] == UB) ? 65536 : 0; }
        cg = qsum(cg); ce = qsum(ce);
        const int needA = keffA - (cg & 0xffff), needB = keffB - (cg >> 16);
        int JA = 8191, JB = 8191;
        par ^= 1;
        if (c16 == 0) sRed[par * 32 + wv * 4 + q4] = (((ce & 0xffff) > needA) || ((ce >> 16) > needB)) ? 1 : 0;
        __syncthreads();
        int anyov = 0;
#pragma unroll
        for (int w = 0; w < 32; ++w) anyov |= sRed[par * 32 + w];
        if (anyov) {
            JA = 0; JB = 0;
            int c16j = c16; asm volatile("" : "+v"(c16j));
            int wvj = wv; asm volatile("" : "+s"(wvj));
            for (int bit = 12; bit >= 0; --bit) {
                const int cjA = JA | (1 << bit), cjB = JB | (1 << bit);
                int c = 0;
#pragma unroll
                for (int i = 0; i < 64; ++i) { const int kidx = (wvj + 8 * i) * 16 + c16j; c += (kA[i] == UA && kidx < cjA) ? 1 : 0; c += (kB[i] == UB && kidx < cjB) ? 65536 : 0; }
                const int tot = qsum(c);
                if ((tot & 0xffff) <= needA - 1) JA = cjA;
                if ((tot >> 16) <= needB - 1) JB = cjB;
            }
        }
        unsigned short* sM = (unsigned short*)(g_smem + 1024);
        { unsigned z_ = 0u; asm volatile("" : "+v"(z_)); ((uint4*)sM)[tid] = make_uint4(z_, z_, z_, z_); }
        __syncthreads();
        int c16e = c16; asm volatile("" : "+v"(c16e));
        int wve = wv; asm volatile("" : "+s"(wve));
#pragma unroll
        for (int blk = 0; blk < 4; ++blk) if (nreg > blk * 16) {
#pragma unroll
            for (int ii = 0; ii < 16; ++ii) { const int i = blk * 16 + ii;
                const int tile = wve + 8 * i, kidx = tile * 16 + c16e;
                const bool selA = kA[i] > UA || (kA[i] == UA && kidx <= JA);
                const bool selB = kB[i] > UB || (kB[i] == UB && kidx <= JB);
                const unsigned long long balA = __ballot(selA), balB = __ballot(selB);
                if (c16 == 0) { sM[q4 * 512 + tile] = (unsigned short)((balA >> (16 * q4)) & 0xffffull);
                                sM[(4 + q4) * 512 + tile] = (unsigned short)((balB >> (16 * q4)) & 0xffffull); }
            }
        }
        __syncthreads();
        *(uint4*)(M16 + (size_t)(t0 + (tid >> 6)) * 512 + (tid & 63) * 8) = ((const uint4*)sM)[tid];
    }
}

PHASE_FN void ph_dsa_attn(const Params& p, float* smem) {
    KParams* pp = kparams();
    GU8* wsg_ = (GU8*)pp->ws; asm volatile("" : "+s"(wsg_)); unsigned char* ws_ = (unsigned char*)wsg_;
    int tid_ = threadIdx.x; asm volatile("" : "+v"(tid_)); const int tid = tid_, lane = tid & 63, wv = tid >> 6, q4 = lane >> 4, c16 = lane & 15;
    int ldz_ = 0; asm volatile("" : "+s"(ldz_)); unsigned char* lds = g_smem + ldz_;
    const bf16_t* QBb = (const bf16_t*)(ws_ + OFF_QBB); const bf16_t* KBb = (const bf16_t*)(ws_ + OFF_KBB); const bf16_t* VT = (const bf16_t*)(ws_ + OFF_VT);
    const unsigned short* M16 = (const unsigned short*)(ws_ + OFF_M16);
    bf16_t* OB = (bf16_t*)(ws_ + OFF_OB);
    const float SC = SCALE128 * 1.4426950408889634f;
    for (int it = blockIdx.x; it < 256; it += gridDim.x) {
        const int bh = it & 7, jp = it >> 3, b = bh >> 2, h = bh & 3;
        for (int half = 0; half < 2; ++half) {
            const int jq = half ? jp : 63 - jp;
            const int qs = jq * 128, nkt = 2 * jq + 2;
            const int tq = b * 8192 + qs + wv * 16 + c16;
            bf16x8 qf[4];
#pragma unroll
            for (int a = 0; a < 4; ++a) qf[a] = *(const bf16x8*)(QBb + (size_t)tq * 512 + h * 128 + 8 * q4 + 32 * a);
            float m = -1e30f, lsum = 0.f;
            f32x4 oacc[8];
#pragma unroll
            for (int t = 0; t < 8; ++t) oacc[t] = (f32x4){0.f, 0.f, 0.f, 0.f};
            uint4 rk0, rk1, rv0, rv1;
            const int q0 = tid, q1 = tid + 512;
            const bf16_t* kg0 = KBb + (size_t)(b * 8192 + (q0 >> 4)) * 512 + h * 128 + (q0 & 15) * 8;
            const bf16_t* kg1 = KBb + (size_t)(b * 8192 + (q1 >> 4)) * 512 + h * 128 + (q1 & 15) * 8;
            const bf16_t* vg0 = VT + ((size_t)((b * 4 + h) * 128 + (q0 >> 3))) * 8192 + (q0 & 7) * 8;
            const bf16_t* vg1 = VT + ((size_t)((b * 4 + h) * 128 + (q1 >> 3))) * 8192 + (q1 & 7) * 8;
            const int lk0 = (q0 >> 4) * 256 + ((((q0 & 15)) ^ ((q0 >> 4) & 15)) << 4), lk1 = (q1 >> 4) * 256 + ((((q1 & 15)) ^ ((q1 >> 4) & 15)) << 4);
            const int lv0 = 16384 + (q0 >> 3) * 128 + ((((q0 & 7)) ^ ((q0 >> 3) & 7)) << 4), lv1 = 16384 + (q1 >> 3) * 128 + ((((q1 & 7)) ^ ((q1 >> 3) & 7)) << 4);
#define ATT_GLOAD(kt_) do { rk0 = *(const uint4*)(kg0 + (size_t)(kt_) * 64 * 512); rk1 = *(const uint4*)(kg1 + (size_t)(kt_) * 64 * 512); \
                            rv0 = *(const uint4*)(vg0 + (kt_) * 64); rv1 = *(const uint4*)(vg1 + (kt_) * 64); } while (0)
#define ATT_LSTORE(st_) do { unsigned char* base_ = lds + (st_) * 32768; *(uint4*)(base_ + lk0) = rk0; *(uint4*)(base_ + lk1) = rk1; *(uint4*)(base_ + lv0) = rv0; *(uint4*)(base_ + lv1) = rv1; } while (0)
            __syncthreads();
            ATT_GLOAD(0); ATT_LSTORE(0);
            __syncthreads();
            for (int kt = 0; kt < nkt; ++kt) {
                if (kt + 1 < nkt) ATT_GLOAD(kt + 1);
                const unsigned long long mbits = *(const unsigned long long*)(M16 + (size_t)tq * 512 + 4 * kt);
                const unsigned char* Kt = lds + (kt & 1) * 32768;
                const unsigned char* Vt = Kt + 16384;
                f32x4 sacc[4];
#pragma unroll
                for (int th = 0; th < 2; ++th) {
                    bf16x8 kf[8];
#pragma unroll
                    for (int tt = 0; tt < 2; ++tt) { const int row = 16 * (th * 2 + tt) + c16;
#pragma unroll
                        for (int a = 0; a < 4; ++a) kf[tt * 4 + a] = *(const bf16x8*)(Kt + row * 256 + ((((q4 + 4 * a)) ^ (row & 15)) << 4)); }
                    asm volatile("" : "+v"(kf[0]), "+v"(kf[1]), "+v"(kf[2]), "+v"(kf[3]), "+v"(kf[4]), "+v"(kf[5]), "+v"(kf[6]), "+v"(kf[7]));
                    sacc[th * 2] = (f32x4){0.f, 0.f, 0.f, 0.f}; sacc[th * 2 + 1] = (f32x4){0.f, 0.f, 0.f, 0.f};
#pragma unroll
                    for (int a = 0; a < 4; ++a)
#pragma unroll
                        for (int tt = 0; tt < 2; ++tt) sacc[th * 2 + tt] = __builtin_amdgcn_mfma_f32_16x16x32_bf16(kf[tt * 4 + a], qf[a], sacc[th * 2 + tt], 0, 0, 0);
                }
                float mx = m;
#pragma unroll
                for (int ti = 0; ti < 4; ++ti)
#pragma unroll
                    for (int r = 0; r < 4; ++r) { const bool valid = (mbits >> (16 * ti + 4 * q4 + r)) & 1ull; const float v = sacc[ti][r] * SC; sacc[ti][r] = v; mx = fmaxf(mx, valid ? v : -1e30f); }
                mx = fmaxf(mx, __shfl_xor(mx, 16)); mx = fmaxf(mx, __shfl_xor(mx, 32));
                const float alpha = __builtin_amdgcn_exp2f(m - mx); m = mx;
                float ps = 0.f;
#pragma unroll
                for (int ti = 0; ti < 4; ++ti)
#pragma unroll
                    for (int r = 0; r < 4; ++r) { const bool valid = (mbits >> (16 * ti + 4 * q4 + r)) & 1ull; const float pv = valid ? __builtin_amdgcn_exp2f(sacc[ti][r] - mx) : 0.f; sacc[ti][r] = pv; ps += pv; }
                lsum = lsum * alpha + ps;
                if (!__all(alpha == 1.f)) {
#pragma unroll
                for (int t = 0; t < 8; ++t) oacc[t] = oacc[t] * alpha; }
                bf16x8 pb[2];
#pragma unroll
                for (int a = 0; a < 2; ++a) {
                    union { uint4 u; bf16x8 v; } cv;
                    cv.u.x = cvt_pk_bf16(sacc[2 * a][0], sacc[2 * a][1]); cv.u.y = cvt_pk_bf16(sacc[2 * a][2], sacc[2 * a][3]);
                    cv.u.z = cvt_pk_bf16(sacc[2 * a + 1][0], sacc[2 * a + 1][1]); cv.u.w = cvt_pk_bf16(sacc[2 * a + 1][2], sacc[2 * a + 1][3]);
                    pb[a] = cv.v; }
#pragma unroll
                for (int tg = 0; tg < 2; ++tg) {
                    bf16x8 vfr[8];
#pragma unroll
                    for (int tt = 0; tt < 4; ++tt) { const int row = 16 * (tg * 4 + tt) + c16;
#pragma unroll
                        for (int a = 0; a < 2; ++a) {
                            union { uint2 h2[2]; bf16x8 v; } vf;
                            vf.h2[0] = *(const uint2*)(Vt + row * 128 + ((((4 * a + (q4 >> 1))) ^ (row & 7)) << 4) + 8 * (q4 & 1));
                            vf.h2[1] = *(const uint2*)(Vt + row * 128 + ((((4 * a + 2 + (q4 >> 1))) ^ (row & 7)) << 4) + 8 * (q4 & 1));
                            vfr[tt * 2 + a] = vf.v; } }
                    asm volatile("" : "+v"(vfr[0]), "+v"(vfr[1]), "+v"(vfr[2]), "+v"(vfr[3]), "+v"(vfr[4]), "+v"(vfr[5]), "+v"(vfr[6]), "+v"(vfr[7]));
#pragma unroll
                    for (int a = 0; a < 2; ++a)
#pragma unroll
                        for (int tt = 0; tt < 4; ++tt) oacc[tg * 4 + tt] = __builtin_amdgcn_mfma_f32_16x16x32_bf16(vfr[tt * 2 + a], pb[a], oacc[tg * 4 + tt], 0, 0, 0);
                }
                if (kt + 1 < nkt) ATT_LSTORE((kt + 1) & 1);
                __syncthreads();
            }
            lsum += __shfl_xor(lsum, 16); lsum += __shfl_xor(lsum, 32);
            const float inv = 1.f / lsum;
#pragma unroll
            for (int t = 0; t < 8; ++t) *(uint2*)(OB + (size_t)tq * 1024 + 512 + h * 128 + 16 * t + 4 * q4) = pack4(oacc[t] * inv);
        }
    }
}

PHASE_FN void ph_gdn_out(const Params& p, int layer) {
    KParams* pp = kparams();
    GU8* wsg_ = (GU8*)pp->ws; asm volatile("" : "+s"(wsg_)); unsigned char* ws_ = (unsigned char*)wsg_;
    int tid_ = threadIdx.x; asm volatile("" : "+v"(tid_)); const int tid = tid_, lane = tid & 63, wv = tid >> 6;
    const float* O = (const float*)(ws_ + OFF_O); const bf16_t* P = (const bf16_t*)(ws_ + OFF_P); bf16_t* OB = (bf16_t*)(ws_ + OFF_OB);
    const float* onw = as_global(pp->gdn_out_norm) + (layer >> 1) * 128;
    for (int t = blockIdx.x * 8 + wv; t < NT; t += gridDim.x * 8) {
#pragma unroll
        for (int h = 0; h < 4; ++h) {
            const float* op = O + (size_t)t * 1024 + h * 128; bf16_t* ob = OB + (size_t)t * 1024 + h * 128;
            const float o0 = op[lane], o1 = op[64 + lane];
            const float ss = wave_sum(o0 * o0 + o1 * o1);
            const float r = rsqrtf(ss * (1.f / 128.f) + EPS);
            const float z0 = PBF(P, t, 1536 + h * 128 + lane), z1 = PBF(P, t, 1536 + h * 128 + 64 + lane);
            ob[lane] = f2bf(o0 * r * onw[lane] * siluf_(z0)); ob[64 + lane] = f2bf(o1 * r * onw[64 + lane] * siluf_(z1));
        }
    }
}

struct EpiOut {
    static constexpr bool PERM = false;
    const float* Xres; float* X; const float* gt0;
    __device__ __forceinline__ void operator()(const f32x4 (&acc)[2][2][4][2], const pg8::Unit& u, int wr, int wc, int fr, int fq) const {
        const int row0 = u.pm * 256 + wr * 64 + fr, col0 = u.pn * 256 + wc * 32 + 4 * fq;
        const float* gt = gt0 + (size_t)(row0 >> 13) * 6144 + col0;
        f32x4 gv[2][2];
#pragma unroll
        for (int bj = 0; bj < 2; ++bj)
#pragma unroll
            for (int n = 0; n < 2; ++n) gv[bj][n] = *(const f32x4*)(gt + bj * 128 + n * 16);
#pragma unroll
        for (int ai = 0; ai < 2; ++ai)
#pragma unroll
            for (int m = 0; m < 4; ++m) { const size_t off = (size_t)(row0 + ai * 128 + m * 16) * ND + col0;
#pragma unroll
                for (int bj = 0; bj < 2; ++bj)
#pragma unroll
                    for (int n = 0; n < 2; ++n) *(f32x4*)(X + off + bj * 128 + n * 16) = *(const f32x4*)(Xres + off + bj * 128 + n * 16) + gv[bj][n] * acc[ai][bj][m][n]; }
    }
};

PHASE_FN void ph_gemm_out(const Params& p, int layer, float* smem) {
    KParams* pp = kparams();
    GU8* wsg_ = (GU8*)pp->ws; asm volatile("" : "+s"(wsg_)); unsigned char* ws_ = (unsigned char*)wsg_;
    int ldz_ = 0; asm volatile("" : "+s"(ldz_));
    const bf16_t* Wt = (const bf16_t*)(ws_ + OFF_WOUT) + (size_t)layer * 1024 * 1024;
    EpiOut E; E.Xres = (layer == 0) ? as_global(pp->x) : (const float*)as_global(pp->X); E.X = as_global(pp->X); E.gt0 = (const float*)(ws_ + OFF_MOD) + (size_t)(layer * 2) * 6144 + 2048;
    pg8::DenseOrder S; S.init(64, 4, gridDim.x, blockIdx.x, 1024);
    __syncthreads();
    pg8::gemm_phase<EpiOut, pg8::DenseOrder, false>((LAS unsigned char*)(g_smem + ldz_), (const bf16_t*)(ws_ + OFF_OB), Wt, 1024, S, E);
    __syncthreads();
}

PHASE_FN void ph_norm_ffn(const Params& p, int layer) {
    KParams* pp = kparams();
    GU8* wsg_ = (GU8*)pp->ws; asm volatile("" : "+s"(wsg_)); unsigned char* ws_ = (unsigned char*)wsg_;
    int tid_ = threadIdx.x; asm volatile("" : "+v"(tid_)); const int tid = tid_, lane = tid & 63, wv = tid >> 6;
    const float* MOD = (const float*)(ws_ + OFF_MOD);
    bf16_t* H = (bf16_t*)(ws_ + OFF_H);
    int* CNT = (int*)(ws_ + OFF_CNT) + layer * 32 * CSTR;
    int* sCnt = (int*)g_smem; int* sBase = sCnt + 32; int* sE = sBase + 32; int* sR = sE + 256;
    const int nrb = (NT + (int)gridDim.x - 1) / (int)gridDim.x, row_lo = blockIdx.x * nrb, row_hi = (row_lo + nrb < NT) ? row_lo + nrb : NT;
    __syncthreads();
    if (tid < 32) sCnt[tid] = 0;
    __syncthreads();
    int* ASG = (int*)(ws_ + OFF_ASG); float* GATE = (float*)(ws_ + OFF_GATE); int* LIST = (int*)(ws_ + OFF_LIST);
    const float* nw = as_global(pp->norm_ffn) + layer * 1024;
    const float* wg = as_global(pp->rg_w) + (size_t)layer * 1024 * 4;
    for (int row = row_lo + wv; row < row_hi; row += 8) {
        const int b = row >> 13;
        const float* xr = as_global(pp->X) + (size_t)row * ND;
        const float* sh = MOD + (size_t)(layer * 2 + b) * 6144 + 3072;
        const float* sc = sh + 1024;
        float hv[16]; float ss = 0.f;
#pragma unroll
        for (int j = 0; j < 4; ++j) { const float4 v = *(const float4*)(xr + j * 256 + lane * 4); hv[4 * j] = v.x; hv[4 * j + 1] = v.y; hv[4 * j + 2] = v.z; hv[4 * j + 3] = v.w; }
#pragma unroll
        for (int j = 0; j < 16; ++j) ss += hv[j] * hv[j];
        ss = wave_sum(ss);
        const float rstd = rsqrtf(ss * (1.f / 1024.f) + EPS);
#pragma unroll
        for (int j = 0; j < 4; ++j) {
            const int col = j * 256 + lane * 4;
            const float4 w = *(const float4*)(nw + col), s4 = *(const float4*)(sc + col), h4 = *(const float4*)(sh + col);
            hv[4 * j] = hv[4 * j] * rstd * w.x * (1.f + s4.x) + h4.x; hv[4 * j + 1] = hv[4 * j + 1] * rstd * w.y * (1.f + s4.y) + h4.y;
            hv[4 * j + 2] = hv[4 * j + 2] * rstd * w.z * (1.f + s4.z) + h4.z; hv[4 * j + 3] = hv[4 * j + 3] * rstd * w.w * (1.f + s4.w) + h4.w;
            { f32x4 ov; ov[0] = hv[4 * j]; ov[1] = hv[4 * j + 1]; ov[2] = hv[4 * j + 2]; ov[3] = hv[4 * j + 3]; *(uint2*)(H + (size_t)row * ND + col) = pack4(ov); }
        }
        float gl[4] = {0.f, 0.f, 0.f, 0.f};
#pragma unroll
        for (int j = 0; j < 4; ++j)
#pragma unroll
            for (int e = 0; e < 4; ++e) { const int col = j * 256 + lane * 4 + e; const float4 w = *(const float4*)(wg + (size_t)col * 4); const float hh = hv[4 * j + e];
                gl[0] += hh * w.x; gl[1] += hh * w.y; gl[2] += hh * w.z; gl[3] += hh * w.w; }
#pragma unroll
        for (int g = 0; g < 4; ++g) gl[g] = wave_sum(gl[g]) + as_global(pp->rg_b)[layer * 4 + g];
        int gs = 0; float gm = gl[0];
#pragma unroll
        for (int g = 1; g < 4; ++g) if (gl[g] > gm) { gm = gl[g]; gs = g; }
        float gsum = 0.f;
#pragma unroll
        for (int g = 0; g < 4; ++g) gsum += expf(gl[g] - gm);
        const float ggate = 1.f / gsum;
        const float* we = as_global(pp->re_w) + ((size_t)(layer * 4 + gs) * 1024) * 8;
        float el[8] = {0.f, 0.f, 0.f, 0.f, 0.f, 0.f, 0.f, 0.f};
#pragma unroll
        for (int j = 0; j < 4; ++j)
#pragma unroll
            for (int e = 0; e < 4; ++e) { const int col = j * 256 + lane * 4 + e; const float4 w0 = *(const float4*)(we + (size_t)col * 8), w1 = *(const float4*)(we + (size_t)col * 8 + 4); const float hh = hv[4 * j + e];
                el[0] += hh * w0.x; el[1] += hh * w0.y; el[2] += hh * w0.z; el[3] += hh * w0.w; el[4] += hh * w1.x; el[5] += hh * w1.y; el[6] += hh * w1.z; el[7] += hh * w1.w; }
#pragma unroll
        for (int e = 0; e < 8; ++e) el[e] = wave_sum(el[e]) + as_global(pp->re_b)[(layer * 4 + gs) * 8 + e];
        int i1 = 0; float l1 = el[0];
#pragma unroll
        for (int e = 1; e < 8; ++e) if (el[e] > l1) { l1 = el[e]; i1 = e; }
        int i2 = -1; float l2 = -INFINITY;
#pragma unroll
        for (int e = 0; e < 8; ++e) if (e != i1 && el[e] > l2) { l2 = el[e]; i2 = e; }
        const float ex = expf(l2 - l1);
        const float p1 = 1.f / (1.f + ex), p2 = ex / (1.f + ex);
        if (lane == 0) {
            const int e1 = gs * 8 + i1, e2 = gs * 8 + i2, lr = row - row_lo;
            sE[lr * 2] = e1; sE[lr * 2 + 1] = e2;
            sR[lr * 2] = atomicAdd(&sCnt[e1], 1); sR[lr * 2 + 1] = atomicAdd(&sCnt[e2], 1);
            GATE[row * 2] = ggate * p1; GATE[row * 2 + 1] = ggate * p2;
        }
    }
    __syncthreads();
    if (tid < 32) sBase[tid] = (sCnt[tid] > 0) ? atomicAdd(&CNT[tid * CSTR], sCnt[tid]) : 0;
    __syncthreads();
    for (int a = tid; a < (row_hi - row_lo) * 2; a += NTHREADS) {
        const int row = row_lo + (a >> 1), e = sE[a], r = sBase[e] + sR[a];
        LIST[(size_t)e * LISTCAP + r] = row;
        ASG[row * 4 + (a & 1) * 2] = e; ASG[row * 4 + (a & 1) * 2 + 1] = r;
    }
}

struct MoeOrder {
    const int* sTs; const int* sPad; const int* CNT; const int* LIST; int G, c, which, K;
    __device__ __forceinline__ bool next(int i, pg8::Unit& u) const {
        const long L = (long)i * G + c; if (L >= (long)__builtin_amdgcn_readfirstlane(sTs[32]) * 4) return false;
        const int mt = (int)(L >> 2), nt = (int)(L & 3);
        int e = 0;
        for (int q = 1; q < 32; ++q) if (__builtin_amdgcn_readfirstlane(sTs[q]) <= mt) e = q;
        const int mi = mt - __builtin_amdgcn_readfirstlane(sTs[e]), cnt = __builtin_amdgcn_readfirstlane(CNT[e * CSTR]);
        u.pm = mt; u.pn = nt; u.e = e; u.mi = mi; u.mvalid = (cnt - mi * 256 < 256) ? (cnt - mi * 256) : 256; u.rowbase = __builtin_amdgcn_readfirstlane(sPad[e]) + mi * 256;
        u.boff = ((size_t)e * 1024 + nt * 256) * K * 2;
        u.aoff = which ? (size_t)u.rowbase * 512 * 2 : 0;
        return true;
    }
    __device__ __forceinline__ int row(const pg8::Unit& u, int r) const { const int rr = (r < u.mvalid) ? r : 0; return LIST[(size_t)u.e * LISTCAP + u.mi * 256 + rr]; }
};
struct EpiMoe1 {
    static constexpr bool PERM = false;
    bf16_t* HID;
    __device__ __forceinline__ void operator()(const f32x4 (&acc)[2][2][4][2], const pg8::Unit& u, int wr, int wc, int fr, int fq) const {
#pragma unroll
        for (int ai = 0; ai < 2; ++ai)
#pragma unroll
            for (int m = 0; m < 4; ++m) { const int rl = ai * 128 + wr * 64 + m * 16 + fr;
                if (rl < u.mvalid) {
#pragma unroll
                    for (int bj = 0; bj < 2; ++bj) { const f32x4 a1 = acc[ai][bj][m][0], a3 = acc[ai][bj][m][1]; f32x4 hv;
                        hv[0] = silu_fast(a1[0]) * a3[0]; hv[1] = silu_fast(a1[1]) * a3[1]; hv[2] = silu_fast(a1[2]) * a3[2]; hv[3] = silu_fast(a1[3]) * a3[3];
                        *(uint2*)(HID + (size_t)(u.rowbase + rl) * 512 + u.pn * 128 + bj * 64 + wc * 16 + 4 * fq) = pack4(hv); } } }
    }
};
struct EpiMoe2 {
    static constexpr bool PERM = true;
    bf16_t* YB;
    __device__ __forceinline__ void operator()(const f32x4 (&acc)[2][2][4][2], const pg8::Unit& u, int wr, int wc, int fr, int fq) const {
#pragma unroll
        for (int ai = 0; ai < 2; ++ai)
#pragma unroll
            for (int m = 0; m < 4; ++m) { const int rl = ai * 128 + wr * 64 + m * 16 + fr;
                if (rl < u.mvalid) {
#pragma unroll
                    for (int bj = 0; bj < 2; ++bj) { const uint2 lo = pack4(acc[ai][bj][m][0]), hi = pack4(acc[ai][bj][m][1]);
                        *(uint4*)(YB + (size_t)(u.rowbase + rl) * 1024 + u.pn * 256 + bj * 128 + wc * 32 + 8 * fq) = make_uint4(lo.x, lo.y, hi.x, hi.y); } } }
    }
};

PHASE_FN void ph_moe(const Params& p, int layer, int which, float* smem) {
    KParams* pp = kparams();
    GU8* wsg_ = (GU8*)pp->ws; asm volatile("" : "+s"(wsg_)); unsigned char* ws_ = (unsigned char*)wsg_;
    int ldz_ = 0; asm volatile("" : "+s"(ldz_));
    int tid_ = threadIdx.x; asm volatile("" : "+v"(tid_)); const int tid = tid_;
    int* sPad = (int*)(g_smem + ldz_ + 131072); int* sTs = sPad + 40;
    const int* CNT = (const int*)(ws_ + OFF_CNT) + layer * 32 * CSTR;
    __syncthreads();
    if (tid == 0) { int a = 0, ts = 0; for (int e = 0; e < 32; ++e) { sPad[e] = a; sTs[e] = ts; a += ((CNT[e * CSTR] + 127) / 128) * 128; ts += (CNT[e * CSTR] + 255) / 256; } sTs[32] = ts; sPad[32] = a; }
    __syncthreads();
    MoeOrder S; S.sTs = sTs; S.sPad = sPad; S.CNT = CNT; S.LIST = (const int*)(ws_ + OFF_LIST); S.G = gridDim.x; S.which = which; S.K = which ? 512 : 1024;
    S.c = (((int)gridDim.x & 7) == 0) ? (((int)blockIdx.x & 7) * ((int)gridDim.x >> 3) + ((int)blockIdx.x >> 3)) : (int)blockIdx.x;
    if (which == 0) {
        EpiMoe1 E; E.HID = (bf16_t*)(ws_ + OFF_HID);
        pg8::gemm_phase<EpiMoe1, MoeOrder, true>((LAS unsigned char*)(g_smem + ldz_), (const bf16_t*)(ws_ + OFF_H), (const bf16_t*)(ws_ + OFF_W13), 1024, S, E);
    } else {
        EpiMoe2 E; E.YB = (bf16_t*)(ws_ + OFF_YB);
        pg8::gemm_phase<EpiMoe2, MoeOrder, false>((LAS unsigned char*)(g_smem + ldz_), (const bf16_t*)(ws_ + OFF_HID), (const bf16_t*)(ws_ + OFF_W2T), 512, S, E);
    }
    __syncthreads();
}

PHASE_FN void ph_conv_dense(const Params& p, float* smem) {
    KParams* pp = kparams();
    GU8* wsg_ = (GU8*)pp->ws; asm volatile("" : "+s"(wsg_)); unsigned char* ws_ = (unsigned char*)wsg_;
    { int ldz_ = 0; asm volatile("" : "+s"(ldz_)); smem = (float*)(g_smem + ldz_); }
    auto dec = [&](int t, const float*& s0, const float*& s1, bf16_t*& dst, int& mode, int& K, int& N, int& ld, int& rt, int& kt) {
        s1 = nullptr; mode = 0; K = 1024;
        if (t >= 4672) t = 4671;
        if (t >= 4608) { const int v = t - 4608, l = v >> 5, u = v & 31; s0 = as_global(pp->gla_w_in) + (size_t)l * 1024 * 3088 + 3072; N = 16; ld = 3088; dst = (bf16_t*)(ws_ + OFF_WGL) + (size_t)l * 128 * 1024; rt = u >> 4; kt = u & 15; }
        else if (t < 2048) { const int l = t >> 10, u = t & 1023; s0 = as_global(pp->even_w_in) + (size_t)l * 1024 * 3916; N = 3916; ld = 3916; dst = (bf16_t*)(ws_ + OFF_WINE) + (size_t)l * 4096 * 1024; rt = u >> 4; kt = u & 15; }
        else if (t < 3584) { const int v = t - 2048, l = v / 768, u = v % 768; s0 = as_global(pp->gla_w_in) + (size_t)l * 1024 * 3088; N = 3072; ld = 3088; dst = (bf16_t*)(ws_ + OFF_WINO) + (size_t)l * 3072 * 1024; rt = u >> 4; kt = u & 15; }
        else { const int v = t - 3584, l = v >> 8, u = v & 255; s0 = ((l & 1) ? as_global(pp->gla_w_out) : as_global(pp->even_w_out)) + (size_t)(l >> 1) * 1024 * 1024; N = 1024; ld = 1024; dst = (bf16_t*)(ws_ + OFF_WOUT) + (size_t)l * 1024 * 1024; rt = u >> 4; kt = u & 15; }
    };
    for (int t = blockIdx.x * 4; t < 4672; t += gridDim.x * 4) convert_tiles4(dec, t, (4672 - t < 4) ? (4672 - t) : 4, smem);
}

PHASE_FN void ph_conv_exp(const Params& p, int layer, float* smem, int first_blk) {
    KParams* pp = kparams();
    GU8* wsg_ = (GU8*)pp->ws; asm volatile("" : "+s"(wsg_)); unsigned char* ws_ = (unsigned char*)wsg_;
    { int ldz_ = 0; asm volatile("" : "+s"(ldz_)); smem = (float*)(g_smem + ldz_); }
    if ((int)blockIdx.x < first_blk) return;
    auto dec = [&](int t, const float*& s0, const float*& s1, bf16_t*& dst, int& mode, int& K, int& N, int& ld, int& rt, int& kt) {
        if (t >= 12288) t = 12287;
        if (t < 8192) { const int e = t >> 8, u = t & 255; s0 = as_global(pp->w1) + (size_t)(layer * 32 + e) * 1024 * 512; s1 = as_global(pp->w3) + (size_t)(layer * 32 + e) * 1024 * 512; mode = 1; K = 1024; N = 512; ld = 512;
            dst = (bf16_t*)(ws_ + OFF_W13) + (size_t)e * 1024 * 1024; rt = u >> 4; kt = u & 15; }
        else { const int v = t - 8192, e = v >> 7, u = v & 127; s0 = as_global(pp->w2) + (size_t)(layer * 32 + e) * 512 * 1024; s1 = nullptr; mode = 0; K = 512; N = 1024; ld = 1024;
            dst = (bf16_t*)(ws_ + OFF_W2T) + (size_t)e * 1024 * 512; rt = u >> 3; kt = u & 7; }
    };
    const int nb = (int)gridDim.x - first_blk;
    for (int t = ((int)blockIdx.x - first_blk) * 4; t < 12288; t += nb * 4) convert_tiles4(dec, t, (12288 - t < 4) ? (12288 - t) : 4, smem);
}

PHASE_FN void ph_gla_tok(const Params& p, int layer) {
    KParams* pp = kparams();
    GU8* wsg_ = (GU8*)pp->ws; asm volatile("" : "+s"(wsg_)); unsigned char* ws_ = (unsigned char*)wsg_;
    int tid_ = threadIdx.x; asm volatile("" : "+v"(tid_)); const int tid = tid_, lane = tid & 63, wv = tid >> 6, li = layer >> 1;
    const float* AUX = (const float*)(ws_ + OFF_AUX);
    float* LA = (float*)(ws_ + OFF_LA);
    const float* w2 = as_global(pp->gla_w_gate2) + (size_t)li * 16 * 512; const float* b2 = as_global(pp->gla_b_gate2) + li * 512;
    for (int t = blockIdx.x * 8 + wv; t < NT; t += gridDim.x * 8) {
        float glr[16];
#pragma unroll
        for (int r = 0; r < 16; ++r) glr[r] = AUX[(size_t)t * 16 + r];
#pragma unroll 1
        for (int i = 0; i < 8; ++i) {
            const int c = lane + 64 * i; float z = b2[c];
#pragma unroll
            for (int r = 0; r < 16; ++r) z += glr[r] * w2[r * 512 + c];
            LA[(size_t)t * 512 + c] = -softplusf_(-z) * (1.f / 16.f);
        }
    }
}

PHASE_FN void ph_gla_chunk(const Params& p, int layer, float* smem) {
    KParams* pp = kparams();
    GU8* wsg_ = (GU8*)pp->ws; asm volatile("" : "+s"(wsg_)); unsigned char* ws_ = (unsigned char*)wsg_;
    int tid_ = threadIdx.x; asm volatile("" : "+v"(tid_)); const int tid = tid_, lane = tid & 63, wv = __builtin_amdgcn_readfirstlane(tid >> 6), q4 = lane >> 4, c16 = lane & 15;
    int ldz_ = 0; asm volatile("" : "+s"(ldz_)); unsigned char* lds = g_smem + ldz_;
    constexpr int SN = 272, ST = 144;
    float* sBc = (float*)lds;
    unsigned char* bQE = lds + 33024;
    unsigned char* bKE = lds + 50432;
    unsigned char* bKD = lds + 67840;
    unsigned char* bVT = lds + 86272;
    unsigned char* bATT = lds + 123136;
    const bf16_t* P = (const bf16_t*)(ws_ + OFF_P); const float* AUX = (const float*)(ws_ + OFF_AUX);
    const float* w2 = as_global(pp->gla_w_gate2) + (size_t)(layer >> 1) * 16 * 512; const float* b2 = as_global(pp->gla_b_gate2) + (layer >> 1) * 512;
    float* sGlr = (float*)(lds + 132352);
    uint4* QEF = (uint4*)(ws_ + OFF_GQE); uint2* OIF = (uint2*)(ws_ + OFF_GOI); uint2* HF = (uint2*)(ws_ + OFF_GH); float* EBL = (float*)(ws_ + OFF_GEBL);
    for (int ci = blockIdx.x; ci < 1024; ci += gridDim.x) {
        const int b = ci >> 9, h = (ci >> 7) & 3, n = ci & 127;
        const int t0 = b * 8192 + n * 64;
        __syncthreads();
        for (int e = tid; e < 1024; e += NTHREADS) sGlr[e] = AUX[(size_t)(t0 + (e >> 4)) * 16 + (e & 15)];
        __syncthreads();
        {
            const int d = tid & 127, c = h * 128 + d;
            float wg[16];
#pragma unroll
            for (int r = 0; r < 16; ++r) wg[r] = w2[r * 512 + c];
            const float bz = b2[c];
            for (int i = tid >> 7; i < 64; i += 4) {
                float z = bz;
#pragma unroll
                for (int r = 0; r < 16; ++r) z += sGlr[i * 16 + r] * wg[r];
                sBc[i * 129 + d] = -softplusf_(-z) * (1.f / 16.f);
            }
        }
        for (int e = tid; e < 64 * 36; e += NTHREADS) ((unsigned*)bATT)[e] = 0u;
        __syncthreads();
        if (tid < 128) { float a = 0.f; for (int i = 0; i < 64; ++i) { a += sBc[i * 129 + tid]; sBc[i * 129 + tid] = a; } }
        __syncthreads();
        {
            const int d = tid & 127, ig = tid >> 7;
            const float bl = sBc[63 * 129 + d];
#pragma unroll
            for (int gg = 0; gg < 2; ++gg) { const int g = ig + 4 * gg;
                float kd8[8];
#pragma unroll
                for (int r = 0; r < 8; ++r) { const int i = g * 8 + r;
                    const float bb = sBc[i * 129 + d];
                    const float qf = PBF(P, t0 + i, h * 128 + d), kf = PBF(P, t0 + i, 512 + h * 128 + d);
                    *(bf16_t*)(bQE + i * SN + d * 2) = f2bf(qf * SCALE128 * expf(bb));
                    *(bf16_t*)(bKE + i * SN + d * 2) = f2bf(kf * expf(-bb));
                    kd8[r] = kf * expf(bl - bb); }
                *(uint4*)(bKD + d * ST + g * 16) = make_uint4(cvt_pk_bf16(kd8[0], kd8[1]), cvt_pk_bf16(kd8[2], kd8[3]), cvt_pk_bf16(kd8[4], kd8[5]), cvt_pk_bf16(kd8[6], kd8[7]));
            }
            const int dv = tid & 255, hf = tid >> 8;
#pragma unroll
            for (int gg = 0; gg < 4; ++gg) { const int g = hf * 4 + gg;
                unsigned short v8[8];
#pragma unroll
                for (int r = 0; r < 8; ++r) v8[r] = P[(size_t)(t0 + g * 8 + r) * LDPB + 1024 + h * 256 + dv];
                *(uint4*)(bVT + dv * ST + g * 16) = make_uint4((unsigned)v8[0] | ((unsigned)v8[1] << 16), (unsigned)v8[2] | ((unsigned)v8[3] << 16), (unsigned)v8[4] | ((unsigned)v8[5] << 16), (unsigned)v8[6] | ((unsigned)v8[7] << 16));
            }
        }
        if (tid < 128) EBL[ci * 128 + tid] = expf(sBc[63 * 129 + tid]);
        __syncthreads();
        for (int u = wv; u < 10; u += 8) {
            const int ti = (u >= 6) ? 3 : (u >= 3) ? 2 : (u >= 1) ? 1 : 0, tj = u - ((ti * (ti + 1)) >> 1);
            f32x4 acc = (f32x4){0.f, 0.f, 0.f, 0.f};
            acc = mma_lds(bQE, SN, 16 * ti, bKE, SN, 16 * tj, 128, acc, c16, q4);
            const int j = 16 * tj + c16;
#pragma unroll
            for (int r = 0; r < 4; ++r) { const int i = 16 * ti + 4 * q4 + r; *(bf16_t*)(bATT + i * ST + j * 2) = f2bf((j <= i) ? acc[r] : 0.f); }
        }
        for (int x = 0; x < 2; ++x) {
            const int u = wv * 2 + x, ti = u >> 2, a = u & 3;
            const unsigned char* rp = bQE + (16 * ti + c16) * SN;
            const uint2 lo = *(const uint2*)(rp + (32 * a + 4 * q4) * 2), hi = *(const uint2*)(rp + (32 * a + 16 + 4 * q4) * 2);
            QEF[((size_t)(ci * 4 + ti) * 4 + a) * 64 + lane] = make_uint4(lo.x, lo.y, hi.x, hi.y);
        }
        __syncthreads();
#pragma unroll 4
        for (int x = 0; x < 8; ++x) {
            const int u = wv * 8 + x, tdv = u >> 2, ti = u & 3;
            f32x4 acc = (f32x4){0.f, 0.f, 0.f, 0.f};
            acc = mma_lds(bATT, ST, 16 * ti, bVT, ST, 16 * tdv, 64, acc, c16, q4);
            OIF[((size_t)(ci * 16 + tdv) * 4 + ti) * 64 + lane] = pack4(acc);
        }
#pragma unroll 4
        for (int x = 0; x < 16; ++x) {
            const int u = wv * 16 + x, tdv = u >> 3, tdk = u & 7;
            f32x4 acc = (f32x4){0.f, 0.f, 0.f, 0.f};
            acc = mma_lds(bKD, ST, 16 * tdk, bVT, ST, 16 * tdv, 64, acc, c16, q4);
            HF[((size_t)(ci * 16 + tdv) * 8 + tdk) * 64 + lane] = pack4(acc);
        }
    }
}

PHASE_FN void ph_gla_scan(const Params& p, float* smem) {
    KParams* pp = kparams();
    GU8* wsg_ = (GU8*)pp->ws; asm volatile("" : "+s"(wsg_)); unsigned char* ws_ = (unsigned char*)wsg_;
    int tid_ = threadIdx.x; asm volatile("" : "+v"(tid_)); const int tid = tid_, lane = tid & 63, wv = __builtin_amdgcn_readfirstlane(tid >> 6), q4 = lane >> 4, c16 = lane & 15;
    int ldz_ = 0; asm volatile("" : "+s"(ldz_)); unsigned char* lds = g_smem + ldz_;
    constexpr int STG = 29184;
    const unsigned char* QEF = ws_ + OFF_GQE; const unsigned char* HF = ws_ + OFF_GH; const unsigned char* OIF = ws_ + OFF_GOI; const unsigned char* EBL = ws_ + OFF_GEBL;
    float* O = (float*)(ws_ + OFF_O);
    for (int it = blockIdx.x; it < 64; it += gridDim.x) {
        const int bh = it >> 3, pair = it & 7, b = bh >> 2, h = bh & 3;
        __syncthreads();
        if (wv >= 2) {
            const int lt = tid - 128;
            const unsigned char* Qb = QEF + (size_t)bh * 128 * 16384;
            const unsigned char* Hb = HF + (size_t)bh * 128 * 65536 + pair * 8192;
            const unsigned char* Ob = OIF + (size_t)bh * 128 * 32768 + pair * 4096;
            const unsigned char* Lb = EBL + (size_t)bh * 128 * 512;
            uint4 ra0, ra1, ra2, ra3, ra4, ra5, ra6, rb0, rb1, rb2, rb3, rb4, rb5, rb6, rc0, rc1, rc2, rc3, rc4, rc5, rc6, rd0, rd1, rd2, rd3, rd4, rd5, rd6;
#define GL_LOAD(X, n_) do { const unsigned char* q_ = Qb + (size_t)(n_) * 16384; const unsigned char* h_ = Hb + (size_t)(n_) * 65536; \
                const unsigned char* o_ = Ob + (size_t)(n_) * 32768; const unsigned char* l_ = Lb + (size_t)(n_) * 512; \
                X##0 = LDC(q_, lt, 1023); X##1 = LDC(q_, lt + 384, 1023); X##2 = LDC(q_, lt + 768, 1023); \
                X##3 = LDC(h_, lt, 511); X##4 = LDC(h_, lt + 384, 511); X##5 = LDC(o_, lt, 255); X##6 = LDC(l_, lt, 31); } while (0)
#define GL_STORE(X, st_) do { unsigned char* sb_ = lds + (st_) * STG; \
                STC(0, lt, 1024, X##0); STC(0, lt + 384, 1024, X##1); STC(0, lt + 768, 1024, X##2); \
                STC(16384, lt, 512, X##3); STC(16384, lt + 384, 512, X##4); STC(24576, lt, 256, X##5); STC(28672, lt, 32, X##6); } while (0)
            GL_LOAD(ra, 0); GL_STORE(ra, 0);
            GL_LOAD(rb, 1); GL_LOAD(rc, 2); GL_LOAD(rd, 3); GL_LOAD(ra, 4);
            __syncthreads();
            for (int n = 0; n < 128; n += 4) {
                GL_STORE(rb, 1); GL_LOAD(rb, CLAMPN(n + 5)); LBAR();
                GL_STORE(rc, 0); GL_LOAD(rc, CLAMPN(n + 6)); LBAR();
                GL_STORE(rd, 1); GL_LOAD(rd, CLAMPN(n + 7)); LBAR();
                if (n + 4 < 128) GL_STORE(ra, 0);
                GL_LOAD(ra, CLAMPN(n + 8)); LBAR();
            }
        } else {
            const int tdv = pair * 2 + wv;
            f32x4 S[8];
#pragma unroll
            for (int t = 0; t < 8; ++t) S[t] = (f32x4){0.f, 0.f, 0.f, 0.f};
            __syncthreads();
            for (int n = 0; n < 128; ++n) {
                const unsigned char* base = lds + (n & 1) * STG;
                const unsigned char* Qf = base + lane * 16, *Hf = base + 16384 + wv * 4096 + lane * 8, *Of = base + 24576 + wv * 2048 + lane * 8, *Lf = base + 28672 + q4 * 16;
                bf16x8 Sb[4];
#pragma unroll
                for (int a = 0; a < 4; ++a) { union { uint4 u; bf16x8 v; } cv; const uint2 lo = pack4(S[2 * a]), hi = pack4(S[2 * a + 1]); cv.u.x = lo.x; cv.u.y = lo.y; cv.u.z = hi.x; cv.u.w = hi.y; Sb[a] = cv.v; }
                const int t0 = b * 8192 + n * 64;
                f32x4 oa[4];
#pragma unroll
                for (int ti = 0; ti < 4; ++ti) oa[ti] = unpack4(*(const uint2*)(Of + ti * 512));
#pragma unroll
                for (int a = 0; a < 4; ++a)
#pragma unroll
                    for (int ti = 0; ti < 4; ++ti) oa[ti] = __builtin_amdgcn_mfma_f32_16x16x32_bf16(*(const bf16x8*)(Qf + (ti * 4 + a) * 1024), Sb[a], oa[ti], 0, 0, 0);
#pragma unroll
                for (int ti = 0; ti < 4; ++ti) {
                    float* op = O + (size_t)(t0 + 16 * ti + 4 * q4) * 1024 + h * 256 + 16 * tdv + c16;
                    op[0] = oa[ti][0]; op[1024] = oa[ti][1]; op[2048] = oa[ti][2]; op[3072] = oa[ti][3]; }
#pragma unroll
                for (int t = 0; t < 8; ++t) { const f32x4 lam = *(const f32x4*)(Lf + t * 64); S[t] = S[t] * lam + unpack4(*(const uint2*)(Hf + t * 512)); }
                LBAR();
            }
        }
    }
}

PHASE_FN void ph_gla_out(const Params& p, int layer) {
    KParams* pp = kparams();
    GU8* wsg_ = (GU8*)pp->ws; asm volatile("" : "+s"(wsg_)); unsigned char* ws_ = (unsigned char*)wsg_;
    int tid_ = threadIdx.x; asm volatile("" : "+v"(tid_)); const int tid = tid_, lane = tid & 63, wv = tid >> 6;
    const float* O = (const float*)(ws_ + OFF_O); const bf16_t* P = (const bf16_t*)(ws_ + OFF_P); bf16_t* OB = (bf16_t*)(ws_ + OFF_OB);
    const float* onw = as_global(pp->gla_out_norm) + (layer >> 1) * 256;
    for (int t = blockIdx.x * 8 + wv; t < NT; t += gridDim.x * 8) {
#pragma unroll
        for (int h = 0; h < 4; ++h) {
            const float* op = O + (size_t)t * 1024 + h * 256;
            const float4 o = *(const float4*)(op + lane * 4);
            const float ss = wave_sum(o.x * o.x + o.y * o.y + o.z * o.z + o.w * o.w);
            const float r = rsqrtf(ss * (1.f / 256.f) + EPS);
            const f32x4 z = unpack4(*(const uint2*)(P + (size_t)t * LDPB + 2048 + h * 256 + lane * 4));
            const float4 w = *(const float4*)(onw + lane * 4);
            f32x4 ov; ov[0] = o.x * r * w.x * siluf_(z[0]); ov[1] = o.y * r * w.y * siluf_(z[1]); ov[2] = o.z * r * w.z * siluf_(z[2]); ov[3] = o.w * r * w.w * siluf_(z[3]);
            *(uint2*)(OB + (size_t)t * 1024 + h * 256 + lane * 4) = pack4(ov);
        }
    }
}

template <int PH>
__device__ __forceinline__ void run_phase(const Params& p, int layer, float* smem) {
    if (PH == PH_PROLOGUE) { ph_prologue(p, smem); ph_conv_dense(p, smem); }
    else if (PH == PH_NORM_MIX) ph_rows(p, layer, 0, smem);
    else if (PH == PH_GEMM_IN_EVEN) ph_gemm_in(p, layer, true, smem);
    else if (PH == PH_EVEN_TOK) { ph_even_tok(p, layer, smem); ph_gdn_chunk(p, layer, smem); if (DUP_MASK & 8192) ph_gdn_chunk(p, layer, smem); if (DUP_MASK & 16384) ph_even_tok(p, layer, smem); }
    else if (PH == PH_GDN_CHUNK) ph_gdn_chunk(p, layer, smem);
    else if (PH == PH_GDN_SCAN) { ph_gdn_scan(p, smem); ph_conv_exp(p, layer, smem, 32); ph_dsa_topk(p, layer, smem); }
    else if (PH == PH_DSA_TOPK) ph_dsa_topk(p, layer, smem);
    else if (PH == PH_DSA_ATTN) { ph_dsa_attn(p, smem); ph_gdn_out(p, layer); if (DUP_MASK & 32768) ph_dsa_attn(p, smem); }
    else if (PH == PH_GDN_OUT) ph_gdn_out(p, layer);
    else if (PH == PH_GEMM_OUT) ph_gemm_out(p, layer, smem);
    else if (PH == PH_NORM_FFN) ph_norm_ffn(p, layer);
    else if (PH == PH_MOE1) ph_moe(p, layer, 0, smem);
    else if (PH == PH_MOE2) ph_moe(p, layer, 1, smem);
    else if (PH == PH_GEMM_IN_ODD) ph_gemm_in(p, layer, false, smem);
    else if (PH == PH_GLA_TOK) ph_gla_tok(p, layer);
    else if (PH == PH_GLA_CHUNK) ph_gla_chunk(p, layer, smem);
    else if (PH == PH_GLA_SCAN) { ph_gla_scan(p, smem); ph_conv_exp(p, layer, smem, 64); }
    else if (PH == PH_GLA_OUT) ph_gla_out(p, layer);
    else if (PH == PH_FINAL) ph_rows(p, 0, 1, smem);
}

#if MK_MULTI
template <int PH>
__global__ void __launch_bounds__(NTHREADS, 2) k_phase(Params p, int layer) {
    run_phase<PH>(p, layer, (float*)g_smem);
}
#else
__global__ void __launch_bounds__(NTHREADS, 2) k_mega(Params p) {
    float* smem = (float*)g_smem;
    volatile LAS unsigned* xbw = (volatile LAS unsigned*)(LAS unsigned char*)(g_smem + LDS_BYTES - 16);
    if (threadIdx.x == 0) { xbw[0] = 0u; xbw[1] = 0u; xbw[2] = 0u; xbw[3] = 0u; }
    __syncthreads();
    XcdBarrier bar = xcd_barrier_post((unsigned*)(p.ws + OFF_BAR), xbw);
#define BAR() do { XcdBarrier bb_ = bar; asm volatile("" : "+s"(bb_.x)); { __attribute__((address_space(1))) unsigned* gb_ = (__attribute__((address_space(1))) unsigned*)bb_.bar; asm volatile("" : "+s"(gb_)); bb_.bar = (unsigned*)gb_; } xcd_barrier(bb_); } while (0)
    run_phase<PH_PROLOGUE>(p, 0, smem); BAR(); if (DUP_MASK & 4096) { run_phase<PH_PROLOGUE>(p, 0, smem); BAR(); }
    for (int lp = 0; lp < 2; ++lp) {
        const int le = 2 * lp, lo = 2 * lp + 1;
        run_phase<PH_NORM_MIX>(p, le, smem); BAR();
        run_phase<PH_GEMM_IN_EVEN>(p, le, smem); BAR(); if (DUP_MASK & 1) { run_phase<PH_GEMM_IN_EVEN>(p, le, smem); BAR(); }
        run_phase<PH_EVEN_TOK>(p, le, smem); BAR(); if (DUP_MASK & 2) { run_phase<PH_EVEN_TOK>(p, le, smem); BAR(); }
        run_phase<PH_GDN_SCAN>(p, le, smem); BAR(); if (DUP_MASK & 8) { run_phase<PH_GDN_SCAN>(p, le, smem); BAR(); }
        run_phase<PH_DSA_ATTN>(p, le, smem); BAR(); if (DUP_MASK & 32) { run_phase<PH_DSA_ATTN>(p, le, smem); BAR(); }
        run_phase<PH_GEMM_OUT>(p, le, smem); BAR();
        run_phase<PH_NORM_FFN>(p, le, smem); BAR();
        run_phase<PH_MOE1>(p, le, smem); BAR(); if (DUP_MASK & 64) { run_phase<PH_MOE1>(p, le, smem); BAR(); }
        run_phase<PH_MOE2>(p, le, smem); BAR(); if (DUP_MASK & 128) { run_phase<PH_MOE2>(p, le, smem); BAR(); }
        run_phase<PH_NORM_MIX>(p, lo, smem); BAR();
        run_phase<PH_GEMM_IN_ODD>(p, lo, smem); BAR(); if (DUP_MASK & 256) { run_phase<PH_GEMM_IN_ODD>(p, lo, smem); BAR(); }
        run_phase<PH_GLA_CHUNK>(p, lo, smem); BAR(); if (DUP_MASK & 1024) { run_phase<PH_GLA_CHUNK>(p, lo, smem); BAR(); }
        run_phase<PH_GLA_SCAN>(p, lo, smem); BAR(); if (DUP_MASK & 2048) { run_phase<PH_GLA_SCAN>(p, lo, smem); BAR(); }
        run_phase<PH_GLA_OUT>(p, lo, smem); BAR();
        run_phase<PH_GEMM_OUT>(p, lo, smem); BAR();
        run_phase<PH_NORM_FFN>(p, lo, smem); BAR();
        run_phase<PH_MOE1>(p, lo, smem); BAR(); if (DUP_MASK & 64) { run_phase<PH_MOE1>(p, lo, smem); BAR(); }
        run_phase<PH_MOE2>(p, lo, smem); BAR(); if (DUP_MASK & 128) { run_phase<PH_MOE2>(p, lo, smem); BAR(); }
    }
    for (int xb = 0; xb < EXTRA_BARS; ++xb) BAR();
    run_phase<PH_FINAL>(p, 0, smem);
}
#endif

}

#if MK_MULTI
template <int PH>
static void launch_phase(const Params& p, int layer, hipStream_t stream) {
    static bool attr_set = false;
    if (!attr_set) { hipFuncSetAttribute((const void*)k_phase<PH>, hipFuncAttributeMaxDynamicSharedMemorySize, (int)LDS_BYTES); attr_set = true; }
    hipLaunchKernelGGL((k_phase<PH>), dim3(256), dim3(NTHREADS), LDS_BYTES, stream, p, layer);
}
#endif

extern "C" void kernel_launch(void* const* d_in, const int* in_sizes, int n_in, void* d_out, int out_size, void* d_ws, size_t ws_size, hipStream_t stream) {
    (void)in_sizes; (void)n_in; (void)out_size;
    if (ws_size < WS_NEEDED) { fprintf(stderr, "workspace too small: %zu < %zu\n", ws_size, (size_t)WS_NEEDED); return; }
    Params p{};
    p.x = (const float*)d_in[0]; p.c = (const float*)d_in[1]; p.pos = (const int*)d_in[2]; p.ada_w = (const float*)d_in[3]; p.ada_b = (const float*)d_in[4];
    p.norm_mix = (const float*)d_in[5]; p.norm_ffn = (const float*)d_in[6]; p.even_w_in = (const float*)d_in[7]; p.conv_w = (const float*)d_in[8];
    p.a_log = (const float*)d_in[9]; p.dt_bias = (const float*)d_in[10]; p.gdn_out_norm = (const float*)d_in[11]; p.even_w_out = (const float*)d_in[12];
    p.gla_w_in = (const float*)d_in[13]; p.gla_w_gate2 = (const float*)d_in[14]; p.gla_b_gate2 = (const float*)d_in[15]; p.gla_out_norm = (const float*)d_in[16]; p.gla_w_out = (const float*)d_in[17];
    p.rg_w = (const float*)d_in[18]; p.rg_b = (const float*)d_in[19]; p.re_w = (const float*)d_in[20]; p.re_b = (const float*)d_in[21];
    p.w1 = (const float*)d_in[22]; p.w3 = (const float*)d_in[23]; p.w2 = (const float*)d_in[24]; p.final_norm = (const float*)d_in[25];
    p.X = (float*)d_out; p.ws = (unsigned char*)d_ws;
    p.rA = pow(10000.0, -2.0 / 128.0); p.rI = pow(10000.0, -2.0 / 64.0);
    hipMemsetAsync(d_ws, 0, ZERO_BYTES, stream);
#if MK_MULTI
    launch_phase<PH_PROLOGUE>(p, 0, stream);
    for (int lp = 0; lp < 2; ++lp) {
        const int le = 2 * lp, lo = 2 * lp + 1;
        launch_phase<PH_NORM_MIX>(p, le, stream);
        launch_phase<PH_GEMM_IN_EVEN>(p, le, stream);
        launch_phase<PH_EVEN_TOK>(p, le, stream);
        launch_phase<PH_GDN_SCAN>(p, le, stream);
        launch_phase<PH_DSA_ATTN>(p, le, stream);
        launch_phase<PH_GEMM_OUT>(p, le, stream);
        launch_phase<PH_NORM_FFN>(p, le, stream);
        launch_phase<PH_MOE1>(p, le, stream);
        launch_phase<PH_MOE2>(p, le, stream);
        launch_phase<PH_NORM_MIX>(p, lo, stream);
        launch_phase<PH_GEMM_IN_ODD>(p, lo, stream);
        launch_phase<PH_GLA_CHUNK>(p, lo, stream);
        launch_phase<PH_GLA_SCAN>(p, lo, stream);
        launch_phase<PH_GLA_OUT>(p, lo, stream);
        launch_phase<PH_GEMM_OUT>(p, lo, stream);
        launch_phase<PH_NORM_FFN>(p, lo, stream);
        launch_phase<PH_MOE1>(p, lo, stream);
        launch_phase<PH_MOE2>(p, lo, stream);
    }
    launch_phase<PH_FINAL>(p, 0, stream);
#else
    static int grid = 0;
    if (!grid) {
        int dev = 0, cus = 0, per_cu = 0;
        hipGetDevice(&dev);
        hipDeviceGetAttribute(&cus, hipDeviceAttributeMultiprocessorCount, dev);
        hipFuncSetAttribute((const void*)k_mega, hipFuncAttributeMaxDynamicSharedMemorySize, (int)LDS_BYTES);
        hipOccupancyMaxActiveBlocksPerMultiprocessor(&per_cu, k_mega, NTHREADS, LDS_BYTES);
        if (cus <= 0) cus = 256;
        grid = cus * (per_cu < 1 ? 1 : 1);
    }
    hipLaunchKernelGGL(k_mega, dim3(grid), dim3(NTHREADS), LDS_BYTES, stream, p);
#endif
}
```

```cpp
#include <hip/hip_runtime.h>
#include <stdint.h>
#include <math.h>
#include <stdio.h>

#define EXTRA_BARS 0
#define REP_A 1
#define REP_B 1
#define REP_C 1
#ifndef DUP_MASK
#define DUP_MASK 0
#endif
#ifndef MK_MULTI
#define MK_MULTI 0
#endif

namespace {

constexpr int NT = 16384, ND = 1024, LDP = 3920, LDPB = 3968;
constexpr float EPS = 1e-6f;
constexpr int NTHREADS = 512;
constexpr size_t LDS_BYTES = 147456;
constexpr float SCALE128 = 0.08838834764831845f;
constexpr int LISTCAP = 32768;
constexpr int CSTR = 16;

constexpr size_t OFF_BAR  = 0;
constexpr size_t OFF_CNT  = 16384;
constexpr size_t ZERO_BYTES = 32768;
constexpr size_t OFF_QCTR = 28672;
constexpr size_t OFF_MOD  = 32768;
constexpr size_t OFF_COSA = OFF_MOD + 4 * 2 * 6144 * 4;
constexpr size_t OFF_SINA = OFF_COSA + (size_t)NT * 64 * 4;
constexpr size_t OFF_COSI = OFF_SINA + (size_t)NT * 64 * 4;
constexpr size_t OFF_SINI = OFF_COSI + (size_t)NT * 32 * 4;
constexpr size_t OFF_H    = OFF_SINI + (size_t)NT * 32 * 4;
constexpr size_t OFF_P    = OFF_H + (size_t)NT * 1024 * 4;
constexpr size_t OFF_HID  = OFF_P;
constexpr size_t OFF_YB   = OFF_HID + (size_t)36864 * 512 * 4;
constexpr size_t OFF_O    = OFF_P + (size_t)NT * LDP * 4;
constexpr size_t OFF_ASG  = OFF_O + (size_t)NT * 1024 * 4;
constexpr size_t OFF_GATE = OFF_ASG + (size_t)NT * 4 * 4;
constexpr size_t OFF_LIST = OFF_GATE + (size_t)NT * 2 * 4;
constexpr size_t OFF_R    = OFF_LIST + (size_t)32 * LISTCAP * 4;
constexpr size_t OFF_QN   = OFF_R;
constexpr size_t OFF_KN   = OFF_QN + (size_t)NT * 512 * 4;
constexpr size_t OFF_VC   = OFF_KN + (size_t)NT * 512 * 4;
constexpr size_t OFF_BETA = OFF_VC + (size_t)NT * 512 * 4;
constexpr size_t OFF_G    = OFF_BETA + (size_t)NT * 4 * 4;
constexpr size_t OFF_W    = OFF_G + (size_t)NT * 4 * 4;
constexpr size_t OFF_U    = OFF_W + (size_t)1024 * 8192 * 4;
constexpr size_t OFF_QG   = OFF_U + (size_t)1024 * 8192 * 4;
constexpr size_t OFF_KD   = OFF_QG + (size_t)1024 * 8192 * 4;
constexpr size_t OFF_AQK  = OFF_KD + (size_t)1024 * 8192 * 4;
constexpr size_t OFF_GL   = OFF_AQK + (size_t)1024 * 4096 * 4;
constexpr size_t OFF_QB   = OFF_GL + 4096;
constexpr size_t OFF_KB   = OFF_QB + (size_t)NT * 512 * 4;
constexpr size_t OFF_QI   = OFF_KB + (size_t)NT * 512 * 4;
constexpr size_t OFF_KI   = OFF_QI + (size_t)NT * 256 * 4;
constexpr size_t OFF_WI   = OFF_KI + (size_t)NT * 64 * 4;
constexpr size_t OFF_SEL  = OFF_WI + (size_t)NT * 4 * 4;
constexpr size_t OFF_EVEN_END = OFF_SEL + (size_t)NT * 256 * 4;
constexpr size_t OFF_PFR  = OFF_W;
constexpr size_t OFF_RFR  = OFF_PFR + (size_t)1024 * 32768;
constexpr size_t OFF_QFR  = OFF_RFR + (size_t)1024 * 16384;
constexpr size_t OFF_OFR  = OFF_QFR + (size_t)1024 * 32768;
static_assert(OFF_OFR + (size_t)1024 * 16384 <= OFF_GL, "gdn v2 buffers overflow");
constexpr size_t OFF_QBB  = OFF_QB;
constexpr size_t OFF_KBB  = OFF_QBB + (size_t)NT * 512 * 2;
constexpr size_t OFF_VT   = OFF_KBB + (size_t)NT * 512 * 2;
constexpr size_t OFF_QIB  = OFF_VT + (size_t)NT * 512 * 2;
constexpr size_t OFF_KIB  = OFF_QIB + (size_t)NT * 256 * 2;
constexpr size_t OFF_M16  = OFF_KIB + (size_t)NT * 64 * 2;
static_assert(OFF_M16 + (size_t)NT * 512 * 2 <= OFF_WI, "dsa v2 buffers overflow");
constexpr size_t OFF_LA   = OFF_R;
constexpr size_t OFF_ATT  = OFF_LA + (size_t)NT * 512 * 4;
constexpr size_t OFF_QE   = OFF_ATT + (size_t)1024 * 4096 * 4;
constexpr size_t OFF_GKD  = OFF_QE + (size_t)1024 * 8192 * 4;
constexpr size_t OFF_EBL  = OFF_GKD + (size_t)1024 * 8192 * 4;
constexpr size_t OFF_GQE  = OFF_LA + (size_t)NT * 512 * 4;
constexpr size_t OFF_GOI  = OFF_GQE + (size_t)1024 * 16384;
constexpr size_t OFF_GH   = OFF_GOI + (size_t)1024 * 32768;
constexpr size_t OFF_GEBL = OFF_GH + (size_t)1024 * 65536;
static_assert(OFF_GEBL + (size_t)1024 * 512 <= OFF_EVEN_END, "gla v2 buffers overflow");
constexpr size_t OFF_WINE = OFF_EVEN_END;
constexpr size_t OFF_WINO = OFF_WINE + (size_t)2 * 4096 * 1024 * 2;
constexpr size_t OFF_WOUT = OFF_WINO + (size_t)2 * 3200 * 1024 * 2;
constexpr size_t OFF_W13  = OFF_WOUT + (size_t)4 * 1024 * 1024 * 2;
constexpr size_t OFF_W2T  = OFF_W13 + (size_t)32 * 1024 * 1024 * 2;
constexpr size_t OFF_OB   = OFF_W2T + (size_t)32 * 1024 * 512 * 2;
constexpr size_t OFF_AUX  = OFF_OB + (size_t)NT * 1024 * 2;
constexpr size_t OFF_WGL  = OFF_AUX + (size_t)NT * 16 * 4;
constexpr size_t WS_NEEDED = OFF_WGL + (size_t)2 * 128 * 1024 * 2;

struct Params {
    const float* x; const float* c; const int* pos; const float* ada_w; const float* ada_b;
    const float* norm_mix; const float* norm_ffn; const float* even_w_in; const float* conv_w;
    const float* a_log; const float* dt_bias; const float* gdn_out_norm; const float* even_w_out;
    const float* gla_w_in; const float* gla_w_gate2; const float* gla_b_gate2; const float* gla_out_norm; const float* gla_w_out;
    const float* rg_w; const float* rg_b; const float* re_w; const float* re_b;
    const float* w1; const float* w3; const float* w2; const float* final_norm;
    float* X;
    unsigned char* ws;
    double rA, rI;
};

#define XB_TMO      128
#define XB_XCNT(j)  (256  + 64 * (j))
#define XB_XSUB(j)  (1280 + 64 * (j))
#define XB_XGEN(j)  (2304 + 64 * (j))
#define XB_TOP      3328
#define XB_TOPGEN   3392
#define XCD_BAR_WORDS 3456
#define XB_SPIN_CAP (1u << 18)
#define LAS __attribute__((address_space(3)))

__device__ __forceinline__ unsigned xb_ld(unsigned* p)              { return __hip_atomic_load(p, __ATOMIC_RELAXED, __HIP_MEMORY_SCOPE_AGENT); }
__device__ __forceinline__ unsigned xb_add(unsigned* p, unsigned v) { return __hip_atomic_fetch_add(p, v, __ATOMIC_RELAXED, __HIP_MEMORY_SCOPE_AGENT); }
__device__ __forceinline__ unsigned xb_xcc_id() { return (unsigned)__builtin_amdgcn_s_getreg((3 << 11) | 20) & 0xFu; }
#define XB_SPIN(cond, bar) do { unsigned _sp = 0; while (cond) { __builtin_amdgcn_s_sleep(1); \
    if ((++_sp & 255u) == 0u) { if (xb_ld(&(bar)[XB_TMO])) break; if (_sp > XB_SPIN_CAP) { atomicAdd(&(bar)[XB_TMO], 1u); break; } } } } while (0)

struct XcdBarrier { unsigned* bar; unsigned x; volatile LAS unsigned* st; };

__device__ __forceinline__ XcdBarrier xcd_barrier_post(unsigned* bar, volatile LAS unsigned* st) {
    XcdBarrier b; b.bar = bar; b.x = xb_xcc_id(); b.st = st;
    if (threadIdx.x == 0) (void)xb_add(&bar[XB_XCNT(b.x)], 1u);
    return b;
}
__device__ __forceinline__ void xcd_barrier_complete(unsigned* bar, unsigned x, unsigned& nloc, unsigned& nx) {
    const unsigned G = gridDim.x * gridDim.y * gridDim.z;
    unsigned sum, cnt, mine, sp = 0u;
    for (;;) {
        sum = 0u; cnt = 0u; mine = 0u;
#pragma unroll
        for (unsigned j = 0; j < 16; ++j) { const unsigned c = xb_ld(&bar[XB_XCNT(j)]); sum += c; cnt += (c > 0u) ? 1u : 0u; mine = (j == x) ? c : mine; }
        if (sum == G) break;
        __builtin_amdgcn_s_sleep(1);
        if ((++sp & 255u) == 0u) { if (xb_ld(&bar[XB_TMO])) break; if (sp > XB_SPIN_CAP) { atomicAdd(&bar[XB_TMO], 1u); break; } }
    }
    nloc = mine > 0u ? mine : 1u; nx = cnt > 0u ? cnt : 1u;
}
__device__ __forceinline__ void xcd_barrier(const XcdBarrier& b) {
    asm volatile("s_waitcnt vmcnt(0)" ::: "memory");
    __syncthreads();
    if (threadIdx.x == 0) {
        unsigned* bar = b.bar;
        __builtin_amdgcn_s_waitcnt(0);
        unsigned nloc = b.st[0], nx = b.st[1];
        if (nloc == 0u) { xcd_barrier_complete(bar, b.x, nloc, nx); b.st[0] = nloc; b.st[1] = nx; }
        const unsigned old = xb_add(&bar[XB_XSUB(b.x)], 1u);
        const unsigned gen = old / nloc;
        if (old + 1u == (gen + 1u) * nloc) {
            __builtin_amdgcn_fence(__ATOMIC_RELEASE, "agent");
            asm volatile("s_waitcnt vmcnt(0)" ::: "memory");
            const unsigned og = xb_add(&bar[XB_TOP], 1u);
            const unsigned tg = og / nx;
            if (og + 1u == (tg + 1u) * nx) xb_add(&bar[XB_TOPGEN], 1u);
            else XB_SPIN(xb_ld(&bar[XB_TOPGEN]) == tg, bar);
            __builtin_amdgcn_fence(__ATOMIC_ACQUIRE, "agent");
            xb_add(&bar[XB_XGEN(b.x)], 1u);
            asm volatile("s_waitcnt vmcnt(0)" ::: "memory");
        } else {
            XB_SPIN(xb_ld(&bar[XB_XGEN(b.x)]) == gen, bar);
            __builtin_amdgcn_fence(__ATOMIC_ACQUIRE, "agent");
            asm volatile("s_waitcnt vmcnt(0)" ::: "memory");
        }
    }
    __syncthreads();
}

template <class T> __device__ __forceinline__ T* as_global(T* p) { return (T*)(__attribute__((address_space(1))) T*)p; }
typedef __attribute__((address_space(1))) unsigned char GU8;
#if defined(__HIP_DEVICE_COMPILE__)
#define ASSUME_GLOBAL(p_) do { __builtin_assume(!__builtin_amdgcn_is_shared((const void*)(p_))); __builtin_assume(!__builtin_amdgcn_is_private((const void*)(p_))); } while (0)
#else
#define ASSUME_GLOBAL(p_) do { } while (0)
#endif
#define LBAR() do { asm volatile("s_waitcnt lgkmcnt(0)" ::: "memory"); __builtin_amdgcn_s_barrier(); asm volatile("" ::: "memory"); } while (0)
typedef const Params __attribute__((address_space(4))) KParams;
__device__ __forceinline__ KParams* kparams() { KParams* q = (KParams*)__builtin_amdgcn_kernarg_segment_ptr(); asm volatile("" : "+s"(q)); return q; }
__device__ __forceinline__ float wave_sum(float v) {
#pragma unroll
    for (int o = 32; o > 0; o >>= 1) v += __shfl_xor(v, o);
    return v;
}
__device__ __forceinline__ int wave_sum_i(int v) {
#pragma unroll
    for (int o = 32; o > 0; o >>= 1) v += __shfl_xor(v, o);
    return v;
}
__device__ __forceinline__ float wave_max(float v) {
#pragma unroll
    for (int o = 32; o > 0; o >>= 1) v = fmaxf(v, __shfl_xor(v, o));
    return v;
}
__device__ __forceinline__ float sigmoidf_(float x) { return 1.f / (1.f + expf(-x)); }
__device__ __forceinline__ float siluf_(float x) { return x / (1.f + expf(-x)); }
__device__ __forceinline__ float silu_fast(float x) { return x * __builtin_amdgcn_rcpf(1.f + __expf(-x)); }
__device__ __forceinline__ float softplusf_(float x) { return fmaxf(x, 0.f) + log1pf(expf(-fabsf(x))); }
__device__ __forceinline__ unsigned ordkey(float f) { const unsigned u = __float_as_uint(f); return (u & 0x80000000u) ? ~u : (u | 0x80000000u); }

__device__ __forceinline__ void sincos_d(double a, double& s, double& c) {
    const double kq = rint(a * 0.63661977236758134308);
    double r = fma(-kq, 1.57079632673412561417e+00, a);
    r = fma(-kq, 6.07710050650619224932e-11, r);
    const int q = (int)((long long)kq & 3);
    const double r2 = r * r;
    const double sp = r * (1.0 + r2 * (-1.0 / 6 + r2 * (1.0 / 120 + r2 * (-1.0 / 5040 + r2 * (1.0 / 362880 + r2 * (-1.0 / 39916800 + r2 * (1.0 / 6227020800.0)))))));
    const double cp = 1.0 + r2 * (-0.5 + r2 * (1.0 / 24 + r2 * (-1.0 / 720 + r2 * (1.0 / 40320 + r2 * (-1.0 / 3628800 + r2 * (1.0 / 479001600.0 + r2 * (-1.0 / 87178291200.0)))))));
    if (q == 0) { s = sp; c = cp; } else if (q == 1) { s = cp; c = -sp; } else if (q == 2) { s = -sp; c = -cp; } else { s = -cp; c = sp; }
}
__device__ __forceinline__ double ipow_d(double b, int e) { double v = 1.0; while (e) { if (e & 1) v *= b; b *= b; e >>= 1; } return v; }

struct GemmArgs { const float* A; int lda; const int* rows; int m0; int mvalid; const float* B; int ldb; int n0; int N; int K; };

template <class Epi>
__device__ __forceinline__ void gemm128(const GemmArgs& g, float* smem, Epi epi) {
    float* As = smem;
    float* Bs = smem + 16 * 132;
    int tid_ = threadIdx.x; asm volatile("" : "+v"(tid_)); const int tid = tid_, ty = tid >> 4, tx = tid & 15;
    const int arow = tid >> 2, kq = (tid & 3) * 4;
    const int bk = tid >> 5, bn = (tid & 31) * 4;
    long asrc = -1;
    if (arow < g.mvalid) { const int r = g.rows ? g.rows[arow] : (g.m0 + arow); if (r >= 0) asrc = (long)r * g.lda; }
    const bool bval = (g.n0 + bn) < g.N;
    float acc[4][8];
#pragma unroll
    for (int i = 0; i < 4; ++i)
#pragma unroll
        for (int j = 0; j < 8; ++j) acc[i][j] = 0.f;
    for (int k0 = 0; k0 < g.K; k0 += 16) {
        float4 av = make_float4(0.f, 0.f, 0.f, 0.f), bv = make_float4(0.f, 0.f, 0.f, 0.f);
        if (asrc >= 0) av = *(const float4*)(g.A + asrc + k0 + kq);
        if (bval) bv = *(const float4*)(g.B + (size_t)(k0 + bk) * g.ldb + g.n0 + bn);
        __syncthreads();
        As[(kq + 0) * 132 + arow] = av.x; As[(kq + 1) * 132 + arow] = av.y; As[(kq + 2) * 132 + arow] = av.z; As[(kq + 3) * 132 + arow] = av.w;
        *(float4*)&Bs[bk * 132 + bn] = bv;
        __syncthreads();
#pragma unroll
        for (int kk = 0; kk < 16; ++kk) {
            const float4 a = *(const float4*)&As[kk * 132 + ty * 4];
            const float4 b0 = *(const float4*)&Bs[kk * 132 + tx * 8];
            const float4 b1 = *(const float4*)&Bs[kk * 132 + tx * 8 + 4];
            const float aa[4] = {a.x, a.y, a.z, a.w};
            const float bb[8] = {b0.x, b0.y, b0.z, b0.w, b1.x, b1.y, b1.z, b1.w};
#pragma unroll
            for (int i = 0; i < 4; ++i)
#pragma unroll
                for (int j = 0; j < 8; ++j) acc[i][j] += aa[i] * bb[j];
        }
    }
#pragma unroll
    for (int i = 0; i < 4; ++i) {
        const int r = ty * 4 + i;
        if (r < g.mvalid) {
#pragma unroll
            for (int j = 0; j < 8; ++j) { const int n = g.n0 + tx * 8 + j; if (n < g.N) epi(r, n, acc[i][j]); }
        }
    }
}


typedef short bf16x8 __attribute__((ext_vector_type(8)));
typedef float f32x4 __attribute__((ext_vector_type(4)));
typedef unsigned short bf16_t;
typedef __bf16 bf16x2_t __attribute__((ext_vector_type(2)));
typedef float f32x2_t __attribute__((ext_vector_type(2)));
__device__ __forceinline__ unsigned cvt_pk_bf16(float lo, float hi) { const f32x2_t v = {lo, hi}; const bf16x2_t r = __builtin_convertvector(v, bf16x2_t); return __builtin_bit_cast(unsigned, r); }
__device__ __forceinline__ bf16_t f2bf(float f) { return (bf16_t)(cvt_pk_bf16(f, 0.f) & 0xffffu); }
__device__ __forceinline__ float bf16_to_f32(bf16_t v) { return __uint_as_float(((unsigned)v) << 16); }
__device__ __forceinline__ uint2 pack4(const f32x4 v) { uint2 r; r.x = cvt_pk_bf16(v[0], v[1]); r.y = cvt_pk_bf16(v[2], v[3]); return r; }
__device__ __forceinline__ f32x4 unpack4(const uint2 u) { f32x4 r; r[0] = __uint_as_float(u.x << 16); r[1] = __uint_as_float(u.x & 0xffff0000u); r[2] = __uint_as_float(u.y << 16); r[3] = __uint_as_float(u.y & 0xffff0000u); return r; }
#define PBF(Pb_, t_, c_) bf16_to_f32((Pb_)[(size_t)(t_) * LDPB + (c_)])
__device__ __forceinline__ uint4 pack8(const float4 a, const float4 b) { uint4 r; r.x = cvt_pk_bf16(a.x, a.y); r.y = cvt_pk_bf16(a.z, a.w); r.z = cvt_pk_bf16(b.x, b.y); r.w = cvt_pk_bf16(b.z, b.w); return r; }
__device__ __forceinline__ int lds_off(int r, int c) { return r * 128 + ((c ^ (r & 7)) << 4); }

template <class ALoad, class BLoad, class Epi>
__device__ __forceinline__ void gemm_tile_bf16(const int K, unsigned char* lds, ALoad aload, BLoad bload, Epi epi, const int mrows = 256) {
    int tid_ = threadIdx.x; asm volatile("" : "+v"(tid_)); const int tid = tid_, lane = tid & 63, wid = tid >> 6, wm = wid >> 1, wn = wid & 1;
    f32x4 acc[4][4];
#pragma unroll
    for (int mi = 0; mi < 4; ++mi)
#pragma unroll
        for (int ni = 0; ni < 4; ++ni) acc[mi][ni] = (f32x4){0.f, 0.f, 0.f, 0.f};
    uint4 ra[4], rb[2];
    const int nk = K >> 6;
#pragma unroll
    for (int i = 0; i < 4; ++i) { const int q = tid + 512 * i; ra[i] = aload(i, q >> 3, (q & 7) * 8); }
#pragma unroll
    for (int i = 0; i < 2; ++i) { const int q = tid + 512 * i; rb[i] = bload(i, q >> 3, (q & 7) * 8); }
    __syncthreads();
#pragma unroll
    for (int i = 0; i < 4; ++i) { const int q = tid + 512 * i; *(uint4*)(lds + lds_off(q >> 3, q & 7)) = ra[i]; }
#pragma unroll
    for (int i = 0; i < 2; ++i) { const int q = tid + 512 * i; *(uint4*)(lds + 32768 + lds_off(q >> 3, q & 7)) = rb[i]; }
    __syncthreads();
    for (int kt = 0; kt < nk; ++kt) {
        if (kt + 1 < nk) {
#pragma unroll
            for (int i = 0; i < 4; ++i) { const int q = tid + 512 * i; ra[i] = aload(i, q >> 3, (kt + 1) * 64 + (q & 7) * 8); }
#pragma unroll
            for (int i = 0; i < 2; ++i) { const int q = tid + 512 * i; rb[i] = bload(i, q >> 3, (kt + 1) * 64 + (q & 7) * 8); }
        }
        const unsigned char* At = lds + (kt & 1) * 49152;
        const unsigned char* Bt = At + 32768;
        if (__builtin_amdgcn_readfirstlane(wm) * 64 < mrows) {
#pragma unroll
        for (int ks = 0; ks < 2; ++ks) {
            bf16x8 af[4], bfr[4];
            const int c = ks * 4 + (lane >> 4);
#pragma unroll
            for (int mi = 0; mi < 4; ++mi) af[mi] = *(const bf16x8*)(At + lds_off(wm * 64 + mi * 16 + (lane & 15), c));
#pragma unroll
            for (int ni = 0; ni < 4; ++ni) bfr[ni] = *(const bf16x8*)(Bt + lds_off(wn * 64 + ni * 16 + (lane & 15), c));
            __builtin_amdgcn_s_setprio(1);
#pragma unroll
            for (int mi = 0; mi < 4; ++mi)
#pragma unroll
                for (int ni = 0; ni < 4; ++ni) acc[mi][ni] = __builtin_amdgcn_mfma_f32_16x16x32_bf16(bfr[ni], af[mi], acc[mi][ni], 0, 0, 0);
            __builtin_amdgcn_s_setprio(0);
        }
        }
        if (kt + 1 < nk) {
            unsigned char* An = lds + ((kt + 1) & 1) * 49152;
#pragma unroll
            for (int i = 0; i < 4; ++i) { const int q = tid + 512 * i; *(uint4*)(An + lds_off(q >> 3, q & 7)) = ra[i]; }
#pragma unroll
            for (int i = 0; i < 2; ++i) { const int q = tid + 512 * i; *(uint4*)(An + 32768 + lds_off(q >> 3, q & 7)) = rb[i]; }
        }
        __syncthreads();
    }
    epi(acc, wm, wn, lane);
}

__device__ __forceinline__ void convert_tile(const float* src0, const float* src1, int mode, int K, int N, int ld, bf16_t* dst, int rt, int kt, float* smem) {
    int tid_ = threadIdx.x; asm volatile("" : "+v"(tid_)); const int tid = tid_;
    __syncthreads();
    { const int k = tid >> 3, R0 = rt * 64 + (tid & 7) * 8;
      const float* sp; int col;
      if (mode == 0) { sp = src0; col = R0; } else { sp = (R0 & 32) ? src1 : src0; col = (R0 >> 6) * 32 + (R0 & 31); }
      float4 a = make_float4(0.f, 0.f, 0.f, 0.f), b = a;
      const float* rp = sp + (size_t)(kt * 64 + k) * ld + col;
      if (col < N) a = *(const float4*)rp;
      if (col + 4 < N) b = *(const float4*)(rp + 4);
      float* d = smem + k * 65 + (tid & 7) * 8;
      d[0] = a.x; d[1] = a.y; d[2] = a.z; d[3] = a.w; d[4] = b.x; d[5] = b.y; d[6] = b.z; d[7] = b.w; }
    __syncthreads();
    { const int R = tid >> 3, kc = (tid & 7) * 8;
      float v[8];
#pragma unroll
      for (int j = 0; j < 8; ++j) v[j] = smem[(kc + j) * 65 + R];
      uint4 o; o.x = cvt_pk_bf16(v[0], v[1]); o.y = cvt_pk_bf16(v[2], v[3]); o.z = cvt_pk_bf16(v[4], v[5]); o.w = cvt_pk_bf16(v[6], v[7]);
      *(uint4*)(dst + (size_t)(rt * 64 + R) * K + kt * 64 + kc) = o; }
}

#define CT_LOAD(S0, S1, MODE, NN, LD, RT, KT, A, B) do { const int k_ = tid >> 3, R0_ = (RT) * 64 + (tid & 7) * 8; const float* sp_; int col_; \
        if ((MODE) == 0) { sp_ = (S0); col_ = R0_; } else { sp_ = (R0_ & 16) ? (S1) : (S0); col_ = (R0_ >> 5) * 16 + (R0_ & 15); } \
        A = make_float4(0.f, 0.f, 0.f, 0.f); B = A; const float* rp_ = sp_ + (size_t)((KT) * 64 + k_) * (LD) + col_; \
        if (col_ < (NN)) A = *(const float4*)rp_; if (col_ + 4 < (NN)) B = *(const float4*)(rp_ + 4); } while (0)
#define CT_WRITE(BUF, A, B) do { float* d_ = smem + (BUF) * 4160 + (tid >> 3) * 65 + (tid & 7) * 8; \
        d_[0] = A.x; d_[1] = A.y; d_[2] = A.z; d_[3] = A.w; d_[4] = B.x; d_[5] = B.y; d_[6] = B.z; d_[7] = B.w; } while (0)
#define CT_STORE(DST, KK, RT, KT, BUF) do { const int R_ = tid >> 3, kc_ = (tid & 7) * 8; const float* sb_ = smem + (BUF) * 4160; \
        uint4 o_; o_.x = cvt_pk_bf16(sb_[(kc_ + 0) * 65 + R_], sb_[(kc_ + 1) * 65 + R_]); o_.y = cvt_pk_bf16(sb_[(kc_ + 2) * 65 + R_], sb_[(kc_ + 3) * 65 + R_]); \
        o_.z = cvt_pk_bf16(sb_[(kc_ + 4) * 65 + R_], sb_[(kc_ + 5) * 65 + R_]); o_.w = cvt_pk_bf16(sb_[(kc_ + 6) * 65 + R_], sb_[(kc_ + 7) * 65 + R_]); \
        *(uint4*)((DST) + (size_t)((RT) * 64 + R_) * (KK) + (KT) * 64 + kc_) = o_; } while (0)
#define CT_DECL(I) const float* s0_##I; const float* s1_##I; bf16_t* d_##I; int md_##I, K_##I, N_##I, ld_##I, rt_##I, kt_##I
#define CT_ARGS(I) s0_##I, s1_##I, d_##I, md_##I, K_##I, N_##I, ld_##I, rt_##I, kt_##I
#define CT_LOADSET(X, T) do { const int nj_ = (total - (T) < 4) ? (total - (T)) : 4; \
        { CT_DECL(0); dec((T), CT_ARGS(0)); CT_LOAD(s0_0, s1_0, md_0, N_0, ld_0, rt_0, kt_0, X##a0, X##b0); } \
        if (nj_ > 1) { CT_DECL(1); dec((T) + 1, CT_ARGS(1)); CT_LOAD(s0_1, s1_1, md_1, N_1, ld_1, rt_1, kt_1, X##a1, X##b1); } \
        if (nj_ > 2) { CT_DECL(2); dec((T) + 2, CT_ARGS(2)); CT_LOAD(s0_2, s1_2, md_2, N_2, ld_2, rt_2, kt_2, X##a2, X##b2); } \
        if (nj_ > 3) { CT_DECL(3); dec((T) + 3, CT_ARGS(3)); CT_LOAD(s0_3, s1_3, md_3, N_3, ld_3, rt_3, kt_3, X##a3, X##b3); } } while (0)
#define CT_PROCESS(X, T) do { const int nj_ = (total - (T) < 4) ? (total - (T)) : 4; \
        __syncthreads(); \
        CT_WRITE(0, X##a0, X##b0); CT_WRITE(1, X##a1, X##b1); CT_WRITE(2, X##a2, X##b2); CT_WRITE(3, X##a3, X##b3); \
        __syncthreads(); \
        { CT_DECL(0); dec((T), CT_ARGS(0)); CT_STORE(d_0, K_0, rt_0, kt_0, 0); } \
        if (nj_ > 1) { CT_DECL(1); dec((T) + 1, CT_ARGS(1)); CT_STORE(d_1, K_1, rt_1, kt_1, 1); } \
        if (nj_ > 2) { CT_DECL(2); dec((T) + 2, CT_ARGS(2)); CT_STORE(d_2, K_2, rt_2, kt_2, 2); } \
        if (nj_ > 3) { CT_DECL(3); dec((T) + 3, CT_ARGS(3)); CT_STORE(d_3, K_3, rt_3, kt_3, 3); } } while (0)
template <class Dec>
__device__ __forceinline__ void convert_stream(const Dec& dec, int t0, int tstep, int total, float* smem) {
    int tid_ = threadIdx.x; asm volatile("" : "+v"(tid_)); const int tid = tid_;
    if (t0 >= total) return;
    const float4 z4 = make_float4(0.f, 0.f, 0.f, 0.f);
    float4 Aa0 = z4, Ab0 = z4, Aa1 = z4, Ab1 = z4, Aa2 = z4, Ab2 = z4, Aa3 = z4, Ab3 = z4, Ba0 = z4, Bb0 = z4, Ba1 = z4, Bb1 = z4, Ba2 = z4, Bb2 = z4, Ba3 = z4, Bb3 = z4;
    CT_LOADSET(A, t0);
    for (int t = t0; t < total; t += 2 * tstep) {
        if (t + tstep < total) CT_LOADSET(B, t + tstep);
        CT_PROCESS(A, t);
        if (t + tstep >= total) break;
        if (t + 2 * tstep < total) CT_LOADSET(A, t + 2 * tstep);
        CT_PROCESS(B, t + tstep);
    }
}


namespace pg8 {
constexpr int BM = 256, BK = 64, HALF = 128, HTB = HALF * BK * 2, STAGE_BYTES = 8 * HTB;
__host__ __device__ __forceinline__ int lds_byte(int r, int c) { const int st = (r >> 4) * 2 + (c >> 5), rr = r & 15, cc = c & 31, ob = rr * 64 + cc * 2; return st * 1024 + (ob ^ (((ob >> 9) & 1) << 5)); }
__host__ __device__ __forceinline__ void stage_rc(int b, int& R, int& C) { const int st = b / 1024, sb = b % 1024, swz = sb ^ (((sb >> 9) & 1) << 5); R = (st >> 1) * 16 + swz / 64; C = (st & 1) * 32 + (swz % 64) / 2; }
__host__ __device__ __forceinline__ int perm32(int rho) { const int n = rho >> 4, i = rho & 15; return 8 * (i >> 2) + 4 * n + (i & 3); }

struct Unit { size_t aoff, boff; int pm, pn, e, mvalid, rowbase, mi; };
template <class Epi, class Sched, bool GATHER>
__device__ __forceinline__ void gemm_phase(LAS unsigned char* lds, const bf16_t* Abase, const bf16_t* Bbase, const int K, const Sched& S, const Epi& E) {
    int tid_ = threadIdx.x; asm volatile("" : "+v"(tid_));
    const int tid = tid_, wid = __builtin_amdgcn_readfirstlane(tid >> 6), lane = tid & 63, wr = wid >> 2, wc = wid & 3, fr = lane & 15, fq = lane >> 4;
    const int nt = K / BK;
    unsigned voffB[2];
#pragma unroll
    for (int i = 0; i < 2; ++i) { int R, C; stage_rc(tid * 16 + i * 8192, R, C); const int Rb = Epi::PERM ? ((R & ~31) + perm32(R & 31)) : R; voffB[i] = (unsigned)(Rb * K + C) * 2u; }
    const size_t kstep = (size_t)(BK * 2);
    const size_t hstep = (size_t)HALF * K * 2;
    const unsigned ldsw = (unsigned)wid * 1024u;
    const int aoff = lds_byte(wr * 64 + fr, fq * 8), boff = lds_byte(wc * 32 + fr, fq * 8);
#define PG8_SA(b, h) (((b) * 2 + (h)) * HTB)
#define PG8_SB(b, h) ((4 + (b) * 2 + (h)) * HTB)
#define PG8_STAGE(bufoff, gbase, voff) do { _Pragma("unroll") for (int _i = 0; _i < 2; ++_i) \
        __builtin_amdgcn_global_load_lds((const unsigned*)((const char*)(gbase) + (voff)[_i]), (LAS unsigned*)(lds + (bufoff) + ldsw + _i * 8192), 16, 0, 0); } while (0)
#define PG8_LDA(dst, b, h) do { _Pragma("unroll") for (int m = 0; m < 4; ++m) _Pragma("unroll") for (int k = 0; k < 2; ++k) dst[m][k] = *(const LAS bf16x8*)(lds + PG8_SA(b, h) + aoff + m * 2048 + k * 1024); } while (0)
#define PG8_LDB(dst, b, h) do { _Pragma("unroll") for (int n = 0; n < 2; ++n) _Pragma("unroll") for (int k = 0; k < 2; ++k) dst[n][k] = *(const LAS bf16x8*)(lds + PG8_SB(b, h) + boff + n * 2048 + k * 1024); } while (0)
#define PG8_MMA(ai, bj, At, Bt) do { __builtin_amdgcn_s_setprio(1); _Pragma("unroll") for (int m = 0; m < 4; ++m) _Pragma("unroll") for (int n = 0; n < 2; ++n) _Pragma("unroll") for (int k = 0; k < 2; ++k) \
        acc[ai][bj][m][n] = __builtin_amdgcn_mfma_f32_16x16x32_bf16(Bt[n][k], At[m][k], acc[ai][bj][m][n], 0, 0, 0); __builtin_amdgcn_s_setprio(0); } while (0)
#define PG8_WAIT_V(n) asm volatile("s_waitcnt vmcnt(" #n ")" ::: "memory")
#define PG8_WAIT_L(n) asm volatile("s_waitcnt lgkmcnt(" #n ")" ::: "memory")
#define PG8_BAR __builtin_amdgcn_s_barrier()
#define PG8_SCHED __builtin_amdgcn_sched_barrier(0)
#define PG8_AVOFF(U, V0, V1) do { _Pragma("unroll") for (int _i = 0; _i < 2; ++_i) { int R_, C_; stage_rc(tid * 16 + _i * 8192, R_, C_); \
        if (GATHER) { V0[_i] = (unsigned)((size_t)S.row(U, R_) * K + C_) * 2u; V1[_i] = (unsigned)((size_t)S.row(U, 128 + R_) * K + C_) * 2u; } \
        else { V0[_i] = (unsigned)(R_ * K + C_) * 2u; V1[_i] = V0[_i] + (unsigned)hstep; } } } while (0)
    Unit cur, nxt; int ui = 0;
    if (!S.next(0, cur)) return;
    f32x4 acc[2][2][4][2];
#pragma unroll
    for (int a = 0; a < 2; ++a)
#pragma unroll
        for (int b = 0; b < 2; ++b)
#pragma unroll
            for (int m = 0; m < 4; ++m)
#pragma unroll
                for (int n = 0; n < 2; ++n) acc[a][b][m][n] = (f32x4){0.f, 0.f, 0.f, 0.f};
    bf16x8 At[4][2], B0[2][2], B1[2][2];
    unsigned cv0[2], cv1[2];
    PG8_AVOFF(cur, cv0, cv1);
    const char* cA = (const char*)Abase + cur.aoff; const char* cB = (const char*)Bbase + cur.boff;
    PG8_STAGE(PG8_SB(0, 0), cB, voffB); PG8_STAGE(PG8_SA(0, 0), cA, cv0); PG8_STAGE(PG8_SB(0, 1), cB + hstep, voffB); PG8_STAGE(PG8_SA(0, 1), cA, cv1);
    if (wr == 1) PG8_BAR;
    PG8_WAIT_V(4); PG8_BAR;
    PG8_STAGE(PG8_SB(1, 0), cB + kstep, voffB); PG8_STAGE(PG8_SA(1, 0), cA + kstep, cv0); PG8_STAGE(PG8_SB(1, 1), cB + hstep + kstep, voffB);
    PG8_WAIT_V(6); PG8_BAR;
    for (;;) {
        const bool has_next = S.next(ui + 1, nxt);
        const char* nA = has_next ? (const char*)Abase + nxt.aoff : cA; const char* nB = has_next ? (const char*)Bbase + nxt.boff : cB;
        for (int t = 0; t < nt; t += 2) {
            const bool last = (t == nt - 2);
            const char* a1 = cA + (size_t)(t + 1) * kstep;
            const char* a2 = last ? nA : cA + (size_t)(t + 2) * kstep; const char* b2 = last ? nB : cB + (size_t)(t + 2) * kstep;
            const char* a3 = a2 + kstep; const char* b3 = b2 + kstep;
            PG8_LDB(B0, 0, 0); PG8_SCHED; PG8_LDA(At, 0, 0); PG8_STAGE(PG8_SA(1, 1), a1, cv1);
            if (last && has_next) { PG8_AVOFF(nxt, cv0, cv1); }
            PG8_WAIT_L(8); PG8_BAR; PG8_WAIT_L(0); PG8_MMA(0, 0, At, B0); PG8_BAR; PG8_SCHED;
            PG8_LDB(B1, 0, 1); PG8_STAGE(PG8_SB(0, 0), b2, voffB);
            PG8_BAR; PG8_WAIT_L(0); PG8_MMA(0, 1, At, B1); PG8_BAR;
            PG8_LDA(At, 0, 1); PG8_STAGE(PG8_SA(0, 0), a2, cv0);
            PG8_BAR; PG8_WAIT_L(0); PG8_MMA(1, 0, At, B0); PG8_BAR; PG8_SCHED;
            PG8_STAGE(PG8_SB(0, 1), b2 + hstep, voffB);
            PG8_WAIT_V(6); PG8_BAR; PG8_MMA(1, 1, At, B1); PG8_BAR;
            PG8_LDB(B0, 1, 0); PG8_SCHED; PG8_LDA(At, 1, 0); PG8_STAGE(PG8_SA(0, 1), a2, cv1);
            PG8_WAIT_L(8); PG8_BAR; PG8_WAIT_L(0); PG8_MMA(0, 0, At, B0); PG8_BAR; PG8_SCHED;
            PG8_LDB(B1, 1, 1); PG8_STAGE(PG8_SB(1, 0), b3, voffB);
            PG8_BAR; PG8_WAIT_L(0); PG8_MMA(0, 1, At, B1); PG8_BAR;
            PG8_LDA(At, 1, 1); PG8_STAGE(PG8_SA(1, 0), a3, cv0);
            PG8_BAR; PG8_WAIT_L(0); PG8_MMA(1, 0, At, B0); PG8_BAR; PG8_SCHED;
            PG8_STAGE(PG8_SB(1, 1), b3 + hstep, voffB);
            PG8_WAIT_V(6); PG8_BAR; PG8_MMA(1, 1, At, B1); PG8_BAR;
        }
        E(acc, cur, wr, wc, fr, fq);
        if (!has_next) break;
#pragma unroll
        for (int a = 0; a < 2; ++a)
#pragma unroll
            for (int b = 0; b < 2; ++b)
#pragma unroll
                for (int m = 0; m < 4; ++m)
#pragma unroll
                    for (int n = 0; n < 2; ++n) acc[a][b][m][n] = (f32x4){0.f, 0.f, 0.f, 0.f};
        cur = nxt; cA = nA; cB = nB; ++ui;
    }
    PG8_WAIT_V(0);
    if (wr == 0) PG8_BAR;
    PG8_BAR;
#undef PG8_SA
#undef PG8_SB
#undef PG8_STAGE
#undef PG8_LDA
#undef PG8_LDB
#undef PG8_MMA
#undef PG8_WAIT_V
#undef PG8_WAIT_L
#undef PG8_BAR
#undef PG8_SCHED
#undef PG8_AVOFF
}
struct DenseOrder {
    int nM, nN, nwg, G, c, K;
    __device__ __forceinline__ void init(int nM_, int nN_, int G_, int c_, int K_) { nM = nM_; nN = nN_; nwg = nM * nN; G = G_; c = c_; K = K_; }
    __device__ __forceinline__ bool next(int i, Unit& u) const {
        const long L = (long)i * G + c; if (L >= nwg) return false;
        int wgid = (int)L; { const int q = nwg / 8, r = nwg % 8, xcd = wgid % 8, off = wgid / 8; wgid = (xcd < r ? xcd * (q + 1) : r * (q + 1) + (xcd - r) * q) + off; }
        const int nig = 8 * nN, gid = wgid / nig, fm = gid * 8, gsz = (nM - fm) < 8 ? (nM - fm) : 8;
        u.pm = fm + ((wgid % nig) % gsz); u.pn = (wgid % nig) / gsz;
        u.aoff = (size_t)u.pm * 256 * K * 2; u.boff = (size_t)u.pn * 256 * K * 2; u.e = 0; u.mvalid = 256; u.rowbase = u.pm * 256; u.mi = 0;
        return true;
    }
    __device__ __forceinline__ int row(const Unit&, int r) const { return r; }
};
}

extern __shared__ __attribute__((aligned(16))) unsigned char g_smem[];
#define PHASE_FN __device__ __forceinline__
enum { PH_PROLOGUE = 0, PH_NORM_MIX, PH_GEMM_IN_EVEN, PH_EVEN_TOK, PH_GDN_CHUNK, PH_GDN_SCAN, PH_DSA_TOPK, PH_DSA_ATTN, PH_GDN_OUT,
       PH_GEMM_OUT, PH_NORM_FFN, PH_MOE1, PH_MOE2, PH_GEMM_IN_ODD, PH_GLA_TOK, PH_GLA_CHUNK, PH_GLA_SCAN, PH_GLA_OUT, PH_FINAL };

PHASE_FN void ph_prologue(const Params& p, float* smem) {
    KParams* pp = kparams();
    GU8* wsg_ = (GU8*)pp->ws; asm volatile("" : "+s"(wsg_)); unsigned char* ws_ = (unsigned char*)wsg_;
    { int ldz_ = 0; asm volatile("" : "+s"(ldz_)); smem = (float*)(g_smem + ldz_); }
    int tid_ = threadIdx.x; asm volatile("" : "+v"(tid_)); const int tid = tid_, nthr = gridDim.x * NTHREADS, gid = blockIdx.x * NTHREADS + tid;
    for (int i = tid; i < 2 * ND; i += NTHREADS) smem[i] = siluf_(as_global(pp->c)[i]);
    __syncthreads();
    float* MOD = (float*)(ws_ + OFF_MOD);
    { float* red = smem + 2048;
      const int lane = tid & 63, wv = tid >> 6;
      for (int item = blockIdx.x; item < 4 * 96; item += gridDim.x) {
          const int l = item / 96, n = (item % 96) * 64 + lane;
          const float* w = as_global(pp->ada_w) + (size_t)l * ND * 6144 + n;
          float a0 = 0.f, a1 = 0.f;
#pragma unroll 8
          for (int k = wv * 128; k < wv * 128 + 128; ++k) { const float wv_ = w[(size_t)k * 6144]; a0 += smem[k] * wv_; a1 += smem[ND + k] * wv_; }
          __syncthreads();
          red[(wv * 64 + lane) * 2] = a0; red[(wv * 64 + lane) * 2 + 1] = a1;
          __syncthreads();
          if (tid < 128) { const int c = tid >> 1, bb = tid & 1; float a = 0.f; for (int w8 = 0; w8 < 8; ++w8) a += red[(w8 * 64 + c) * 2 + bb];
              MOD[(l * 2 + bb) * 6144 + (item % 96) * 64 + c] = a + as_global(pp->ada_b)[l * 6144 + (item % 96) * 64 + c]; }
      }
      __syncthreads(); }
    float* COSA = (float*)(ws_ + OFF_COSA); float* SINA = (float*)(ws_ + OFF_SINA);
    float* COSI = (float*)(ws_ + OFF_COSI); float* SINI = (float*)(ws_ + OFF_SINI);
    for (size_t i = gid; i < (size_t)NT * 64; i += nthr) {
        const int t = (int)(i >> 6), j = (int)(i & 63);
        double s, c; sincos_d((double)as_global(pp->pos)[t] * ipow_d(pp->rA, j), s, c);
        COSA[i] = (float)c; SINA[i] = (float)s;
    }
    for (size_t i = gid; i < (size_t)NT * 32; i += nthr) {
        const int t = (int)(i >> 5), j = (int)(i & 31);
        double s, c; sincos_d((double)as_global(pp->pos)[t] * ipow_d(pp->rI, j), s, c);
        COSI[i] = (float)c; SINI[i] = (float)s;
    }
}

PHASE_FN void ph_rows(const Params& p, int layer, int mode, float* smem) {
    KParams* pp = kparams();
    GU8* wsg_ = (GU8*)pp->ws; asm volatile("" : "+s"(wsg_)); unsigned char* ws_ = (unsigned char*)wsg_;
    { int ldz_ = 0; asm volatile("" : "+s"(ldz_)); smem = (float*)(g_smem + ldz_); }
    int tid_ = threadIdx.x; asm volatile("" : "+v"(tid_)); const int tid = tid_, lane = tid & 63, wv = tid >> 6;
    int* pad = (int*)smem;
    const int moe_layer = (mode == 1) ? 3 : layer - 1;
    if (moe_layer >= 0) {
        if (tid == 0) { const int* cnt = (const int*)(ws_ + OFF_CNT) + moe_layer * 32 * CSTR; int a = 0; for (int e = 0; e < 32; ++e) { pad[e] = a; a += ((cnt[e * CSTR] + 127) / 128) * 128; } }
        __syncthreads();
    }
    const float* MOD = (const float*)(ws_ + OFF_MOD);
    bf16_t* H = (bf16_t*)(ws_ + OFF_H);
    const bf16_t* YB = (const bf16_t*)(ws_ + OFF_YB);
    const int* ASG = (const int*)(ws_ + OFF_ASG);
    const float* GATE = (const float*)(ws_ + OFF_GATE);
    auto load_x = [&](int row, float (&xv)[16]) {
        const float* xin = (mode == 0 && layer == 0) ? (as_global(pp->x) + (size_t)row * ND) : (as_global(pp->X) + (size_t)row * ND);
#pragma unroll
        for (int j = 0; j < 4; ++j) { const float4 v = *(const float4*)(xin + j * 256 + lane * 4); xv[4 * j] = v.x; xv[4 * j + 1] = v.y; xv[4 * j + 2] = v.z; xv[4 * j + 3] = v.w; }
    };
    auto load_y = [&](int row, uint2 (&ya)[4], uint2 (&yb)[4], float& g0, float& g1) {
        const int4 as = *(const int4*)(ASG + row * 4);
        g0 = GATE[row * 2]; g1 = GATE[row * 2 + 1];
        const bf16_t* y0 = YB + (size_t)(pad[as.x] + as.y) * ND;
        const bf16_t* y1 = YB + (size_t)(pad[as.z] + as.w) * ND;
#pragma unroll
        for (int j = 0; j < 4; ++j) { ya[j] = *(const uint2*)(y0 + j * 256 + lane * 4); yb[j] = *(const uint2*)(y1 + j * 256 + lane * 4); }
    };
    auto finish = [&](int row, float (&xv)[16], const uint2 (&ya)[4], const uint2 (&yb)[4], float g0, float g1) {
        const int b = row >> 13;
        float* xr = as_global(pp->X) + (size_t)row * ND;
        if (moe_layer >= 0) {
            const float* gt = MOD + (size_t)(moe_layer * 2 + b) * 6144 + 5 * 1024;
#pragma unroll
            for (int j = 0; j < 4; ++j) {
                const int col = j * 256 + lane * 4;
                const f32x4 a = unpack4(ya[j]), bq = unpack4(yb[j]); const float4 g = *(const float4*)(gt + col);
                xv[4 * j] += g.x * (g0 * a[0] + g1 * bq[0]); xv[4 * j + 1] += g.y * (g0 * a[1] + g1 * bq[1]);
                xv[4 * j + 2] += g.z * (g0 * a[2] + g1 * bq[2]); xv[4 * j + 3] += g.w * (g0 * a[3] + g1 * bq[3]);
                if (mode == 0) *(float4*)(xr + col) = make_float4(xv[4 * j], xv[4 * j + 1], xv[4 * j + 2], xv[4 * j + 3]);
            }
        }
        float ss = 0.f;
#pragma unroll
        for (int j = 0; j < 16; ++j) ss += xv[j] * xv[j];
        ss = wave_sum(ss);
        const float rstd = rsqrtf(ss * (1.f / 1024.f) + EPS);
        if (mode == 0) {
            const float* nw = as_global(pp->norm_mix) + layer * 1024;
            const float* sh = MOD + (size_t)(layer * 2 + b) * 6144;
            const float* sc = sh + 1024;
#pragma unroll
            for (int j = 0; j < 4; ++j) {
                const int col = j * 256 + lane * 4;
                const float4 w = *(const float4*)(nw + col), s4 = *(const float4*)(sc + col), h4 = *(const float4*)(sh + col);
                f32x4 ov;
                ov[0] = xv[4 * j] * rstd * w.x * (1.f + s4.x) + h4.x; ov[1] = xv[4 * j + 1] * rstd * w.y * (1.f + s4.y) + h4.y;
                ov[2] = xv[4 * j + 2] * rstd * w.z * (1.f + s4.z) + h4.z; ov[3] = xv[4 * j + 3] * rstd * w.w * (1.f + s4.w) + h4.w;
                *(uint2*)(H + (size_t)row * ND + col) = pack4(ov);
            }
        } else {
#pragma unroll
            for (int j = 0; j < 4; ++j) {
                const int col = j * 256 + lane * 4;
                const float4 w = *(const float4*)(as_global(pp->final_norm) + col);
                *(float4*)(xr + col) = make_float4(xv[4 * j] * rstd * w.x, xv[4 * j + 1] * rstd * w.y, xv[4 * j + 2] * rstd * w.z, xv[4 * j + 3] * rstd * w.w);
            }
        }
    };
    const int stride = gridDim.x * 8;
    for (int row = blockIdx.x * 8 + wv; row < NT; row += 2 * stride) {
        const int rowB = row + stride; const bool hasB = rowB < NT; const int rB = hasB ? rowB : row;
        float xa[16], xb[16]; uint2 yaa[4], yab[4], yba[4], ybb[4]; float ga0 = 0.f, ga1 = 0.f, gb0 = 0.f, gb1 = 0.f;
        load_x(row, xa); load_x(rB, xb);
        if (moe_layer >= 0) { load_y(row, yaa, yab, ga0, ga1); load_y(rB, yba, ybb, gb0, gb1); }
        finish(row, xa, yaa, yab, ga0, ga1);
        if (hasB) finish(rowB, xb, yba, ybb, gb0, gb1);
    }
}

struct EpiIn {
    static constexpr bool PERM = true;
    bf16_t* P; float* AUX; int ncols; int even;
    __device__ __forceinline__ void operator()(const f32x4 (&acc)[2][2][4][2], const pg8::Unit& u, int wr, int wc, int fr, int fq) const {
        const int row0 = u.pm * 256 + wr * 64 + fr, col0 = u.pn * 256 + wc * 32 + 8 * fq;
#pragma unroll
        for (int ai = 0; ai < 2; ++ai)
#pragma unroll
            for (int m = 0; m < 4; ++m) { const int r = row0 + ai * 128 + m * 16;
#pragma unroll
                for (int bj = 0; bj < 2; ++bj) { const int c = col0 + bj * 128;
                    if (c < ncols) { const uint2 lo = pack4(acc[ai][bj][m][0]), hi = pack4(acc[ai][bj][m][1]); *(uint4*)(P + (size_t)r * LDPB + c) = make_uint4(lo.x, lo.y, hi.x, hi.y); }
                    if (even) {
                        if (c == 2048) { *(f32x4*)(AUX + (size_t)r * 16) = acc[ai][bj][m][0]; *(f32x4*)(AUX + (size_t)r * 16 + 4) = acc[ai][bj][m][1]; }
                        if (c == 3912) *(f32x4*)(AUX + (size_t)r * 16 + 8) = acc[ai][bj][m][0];
                    } } }
    }
};

PHASE_FN void ph_gemm_in(const Params& p, int layer, bool even, float* smem) {
    KParams* pp = kparams();
    GU8* wsg_ = (GU8*)pp->ws; asm volatile("" : "+s"(wsg_)); unsigned char* ws_ = (unsigned char*)wsg_;
    int ldz_ = 0; asm volatile("" : "+s"(ldz_));
    const bf16_t* Wt = even ? (const bf16_t*)(ws_ + OFF_WINE) + (size_t)(layer >> 1) * 4096 * 1024 : (const bf16_t*)(ws_ + OFF_WINO) + (size_t)(layer >> 1) * 3072 * 1024;
    EpiIn E; E.P = (bf16_t*)(ws_ + OFF_P); E.AUX = (float*)(ws_ + OFF_AUX); E.ncols = even ? 3920 : 3072; E.even = even ? 1 : 0;
    pg8::DenseOrder S; S.init(64, even ? 16 : 12, gridDim.x, blockIdx.x, 1024);
    __syncthreads();
    pg8::gemm_phase<EpiIn, pg8::DenseOrder, false>((LAS unsigned char*)(g_smem + ldz_), (const bf16_t*)(ws_ + OFF_H), Wt, 1024, S, E);
    __syncthreads();
    if (!even) {
        const bf16_t* H = (const bf16_t*)(ws_ + OFF_H);
        const bf16_t* Wg = (const bf16_t*)(ws_ + OFF_WGL) + (size_t)(layer >> 1) * 128 * 1024;
        float* AUX = (float*)(ws_ + OFF_AUX);
        for (int mt = blockIdx.x; mt < 64; mt += gridDim.x) {
            const bf16_t* Ab = H + (size_t)mt * 256 * 1024;
            float* At = AUX + (size_t)mt * 256 * 16;
            gemm_tile_bf16(1024, g_smem + ldz_,
                [=](int i, int r, int k) -> uint4 { return *(const uint4*)(Ab + (size_t)r * 1024 + k); },
                [=](int i, int r, int k) -> uint4 { return *(const uint4*)(Wg + (size_t)r * 1024 + k); },
                [=](const f32x4 (&acc)[4][4], int wm, int wn, int lane) {
                    if (wn == 0 && (lane >> 4) < 4) {
#pragma unroll
                        for (int mi = 0; mi < 4; ++mi) { const int m = wm * 64 + mi * 16 + (lane & 15); *(f32x4*)(At + (size_t)m * 16 + 4 * (lane >> 4)) = acc[mi][0]; }
                    }
                });
        }
        __syncthreads();
    }
}

PHASE_FN void ph_even_tok(const Params& p, int layer, float* smem) {
    KParams* pp = kparams();
    GU8* wsg_ = (GU8*)pp->ws; asm volatile("" : "+s"(wsg_)); unsigned char* ws_ = (unsigned char*)wsg_;
    { int ldz_ = 0; asm volatile("" : "+s"(ldz_)); smem = (float*)(g_smem + ldz_); }
    int tid_ = threadIdx.x; asm volatile("" : "+v"(tid_)); const int tid = tid_, lane = tid & 63, wv = tid >> 6, li = layer >> 1;
    const bf16_t* P = (const bf16_t*)(ws_ + OFF_P); const float* AUX = (const float*)(ws_ + OFF_AUX);
    bf16_t* QB = (bf16_t*)(ws_ + OFF_QBB); bf16_t* KB = (bf16_t*)(ws_ + OFF_KBB); bf16_t* QI = (bf16_t*)(ws_ + OFF_QIB); bf16_t* KI = (bf16_t*)(ws_ + OFF_KIB); float* WI = (float*)(ws_ + OFF_WI);
    const float* COSA = (const float*)(ws_ + OFF_COSA); const float* SINA = (const float*)(ws_ + OFF_SINA);
    const float* COSI = (const float*)(ws_ + OFF_COSI); const float* SINI = (const float*)(ws_ + OFF_SINI);
    for (int t = blockIdx.x * 8 + wv; t < NT; t += gridDim.x * 8) {
        const bf16_t* Pt = P + (size_t)t * LDPB;
        if (lane < 4) {
            WI[t * 4 + lane] = AUX[(size_t)t * 16 + 8 + lane] * 0.0625f;
        }
        { const float c = COSA[(size_t)t * 64 + lane], sn = SINA[(size_t)t * 64 + lane];
#pragma unroll
          for (int h = 0; h < 4; ++h) {
              float t1 = bf16_to_f32(Pt[2056 + h * 128 + lane]), t2 = bf16_to_f32(Pt[2056 + h * 128 + 64 + lane]);
              QB[(size_t)t * 512 + h * 128 + lane] = f2bf(t1 * c - t2 * sn); QB[(size_t)t * 512 + h * 128 + 64 + lane] = f2bf(t2 * c + t1 * sn);
              t1 = bf16_to_f32(Pt[2568 + h * 128 + lane]); t2 = bf16_to_f32(Pt[2568 + h * 128 + 64 + lane]);
              KB[(size_t)t * 512 + h * 128 + lane] = f2bf(t1 * c - t2 * sn); KB[(size_t)t * 512 + h * 128 + 64 + lane] = f2bf(t2 * c + t1 * sn);
          } }
#pragma unroll
        for (int r = 0; r < 2; ++r) {
            const int item = lane + 64 * r, hh = item >> 5, ii = item & 31;
            const float c = COSI[(size_t)t * 32 + ii], sn = SINI[(size_t)t * 32 + ii];
            const float t1 = bf16_to_f32(Pt[3592 + hh * 64 + ii]), t2 = bf16_to_f32(Pt[3592 + hh * 64 + 32 + ii]);
            QI[(size_t)t * 256 + hh * 64 + ii] = f2bf(t1 * c - t2 * sn); QI[(size_t)t * 256 + hh * 64 + 32 + ii] = f2bf(t2 * c + t1 * sn);
        }
        if (lane < 32) {
            const float c = COSI[(size_t)t * 32 + lane], sn = SINI[(size_t)t * 32 + lane];
            const float t1 = bf16_to_f32(Pt[3848 + lane]), t2 = bf16_to_f32(Pt[3848 + 32 + lane]);
            KI[(size_t)t * 64 + lane] = f2bf(t1 * c - t2 * sn); KI[(size_t)t * 64 + 32 + lane] = f2bf(t2 * c + t1 * sn);
        }
    }
    { bf16_t* VT = (bf16_t*)(ws_ + OFF_VT);
      bf16_t* sv = (bf16_t*)g_smem;
      for (int item = blockIdx.x; item < 2 * 128 * 4; item += gridDim.x) {
          const int h = item & 3, tt = item >> 2, b = tt >> 7, s0 = (tt & 127) * 64;
          __syncthreads();
          for (int e = tid; e < 64 * 128; e += NTHREADS) { const int i = e >> 7, d = e & 127; sv[d * 72 + i] = P[(size_t)(b * 8192 + s0 + i) * LDPB + 3080 + h * 128 + d]; }
          __syncthreads();
          for (int e = tid; e < 128 * 8; e += NTHREADS) { const int d = e >> 3, c = e & 7;
              *(uint4*)(VT + ((size_t)((b * 4 + h) * 128 + d)) * 8192 + s0 + c * 8) = *(const uint4*)(sv + d * 72 + c * 8); }
      } }
}

__device__ __forceinline__ f32x4 mma_lds(const unsigned char* A, int sa, int a0, const unsigned char* B, int sb, int b0, int K, f32x4 acc, int c16, int q4) {
    const unsigned char* ap = A + (a0 + c16) * sa + q4 * 16;
    const unsigned char* bp = B + (b0 + c16) * sb + q4 * 16;
#pragma unroll
    for (int kk = 0; kk < K; kk += 32) { acc = __builtin_amdgcn_mfma_f32_16x16x32_bf16(*(const bf16x8*)(ap + kk * 2), *(const bf16x8*)(bp + kk * 2), acc, 0, 0, 0); }
    return acc;
}

PHASE_FN void ph_gdn_chunk(const Params& p, int layer, float* smem) {
    KParams* pp = kparams();
    GU8* wsg_ = (GU8*)pp->ws; asm volatile("" : "+s"(wsg_)); unsigned char* ws_ = (unsigned char*)wsg_;
    int tid_ = threadIdx.x; asm volatile("" : "+v"(tid_)); const int tid = tid_, lane = tid & 63, wv = __builtin_amdgcn_readfirstlane(tid >> 6), q4 = lane >> 4, c16 = lane & 15;
    int ldz_ = 0; asm volatile("" : "+s"(ldz_)); unsigned char* lds = g_smem + ldz_;
    constexpr int SN = 272, ST = 144;
    unsigned char* bKN = lds;
    unsigned char* bQN = lds + 18432;
    unsigned char* bKBG = lds + 35840;
    unsigned char* bVB = lds + 54272;
    unsigned char* bKD = lds + 72704;
    unsigned char* bUT = lds + 91136;
    float* sL = (float*)(lds + 109568);
    unsigned char* bAQK = lds + 126976;
    unsigned char* bTB = lds + 136192;
    float* sG = (float*)(lds + 145408); float* sB = sG + 64; float* sEg = sB + 64;
    const int li = layer >> 1;
    const bf16_t* P = (const bf16_t*)(ws_ + OFF_P); const float* AUX = (const float*)(ws_ + OFF_AUX);
    const float* cw = as_global(pp->conv_w) + (size_t)li * 4 * 1536;
    uint4* PFR = (uint4*)(ws_ + OFF_PFR); uint4* RFR = (uint4*)(ws_ + OFF_RFR); uint2* QFR = (uint2*)(ws_ + OFF_QFR); uint2* OFR = (uint2*)(ws_ + OFF_OFR);
    float* GL = (float*)(ws_ + OFF_GL);
    for (int ci = blockIdx.x; ci < 1024; ci += gridDim.x) {
        const int b = ci >> 9, h = (ci >> 7) & 3, n = ci & 127;
        const int t0 = b * 8192 + n * 64;
        __syncthreads();
        if (tid < 64) { float g = -expf(as_global(pp->a_log)[li * 4 + h]) * softplusf_(AUX[(size_t)(t0 + tid) * 16 + 4 + h] + as_global(pp->dt_bias)[li * 4 + h]);
#pragma unroll
            for (int o = 1; o < 64; o <<= 1) { const float nb = __shfl_up(g, o); if (lane >= o) g += nb; }
            sG[tid] = g; sB[tid] = sigmoidf_(AUX[(size_t)(t0 + tid) * 16 + h]); sEg[tid] = expf(g); }
        for (int e = tid; e < 64 * 36; e += NTHREADS) ((unsigned*)bAQK)[e] = 0u;
        __syncthreads();
        const float gl = sG[63];
        for (int rep_a = 0; rep_a < REP_A; ++rep_a)
        {
            const int d0 = 2 * lane, cb = h * 128 + d0, s00 = n * 64;
            float wq[4][2], wk[4][2], wvv[4][2];
#pragma unroll
            for (int jj = 0; jj < 4; ++jj) { wq[jj][0] = cw[jj * 1536 + cb]; wq[jj][1] = cw[jj * 1536 + cb + 1]; wk[jj][0] = cw[jj * 1536 + 512 + cb]; wk[jj][1] = cw[jj * 1536 + 512 + cb + 1];
                                            wvv[jj][0] = cw[jj * 1536 + 1024 + cb]; wvv[jj][1] = cw[jj * 1536 + 1024 + cb + 1]; }
            float tk0[8], tk1[8], tv0[8], tv1[8], td0[8], td1[8];
#pragma unroll
            for (int r = 0; r < 8; ++r) {
                const int i = wv * 8 + r;
                float aq0 = 0.f, aq1 = 0.f, ak0 = 0.f, ak1 = 0.f, av0 = 0.f, av1 = 0.f;
#pragma unroll
                for (int jj = 0; jj < 4; ++jj) {
                    if (s00 + i - 3 + jj >= 0) {
                        const bf16_t* rp = P + (size_t)(t0 + i - 3 + jj) * LDPB + cb;
                        const unsigned uq = *(const unsigned*)rp, uk = *(const unsigned*)(rp + 512), uv = *(const unsigned*)(rp + 1024);
                        aq0 += wq[jj][0] * __uint_as_float(uq << 16); aq1 += wq[jj][1] * __uint_as_float(uq & 0xffff0000u);
                        ak0 += wk[jj][0] * __uint_as_float(uk << 16); ak1 += wk[jj][1] * __uint_as_float(uk & 0xffff0000u);
                        av0 += wvv[jj][0] * __uint_as_float(uv << 16); av1 += wvv[jj][1] * __uint_as_float(uv & 0xffff0000u);
                    }
                }
                aq0 = siluf_(aq0); aq1 = siluf_(aq1); ak0 = siluf_(ak0); ak1 = siluf_(ak1); av0 = siluf_(av0); av1 = siluf_(av1);
                const float rq = rsqrtf(wave_sum(aq0 * aq0 + aq1 * aq1) + EPS), rk = rsqrtf(wave_sum(ak0 * ak0 + ak1 * ak1) + EPS);
                aq0 *= rq; aq1 *= rq; ak0 *= rk; ak1 *= rk;
                const float be = sB[i], eg_i = sEg[i], ekd = expf(gl - sG[i]);
                *(unsigned*)(bKN + i * SN + d0 * 2) = cvt_pk_bf16(ak0, ak1);
                *(unsigned*)(bQN + i * SN + d0 * 2) = cvt_pk_bf16(aq0, aq1);
                tk0[r] = ak0 * be * eg_i; tk1[r] = ak1 * be * eg_i; tv0[r] = av0 * be; tv1[r] = av1 * be; td0[r] = ak0 * ekd; td1[r] = ak1 * ekd;
                if ((r & 1) == 1) asm volatile("" ::: "memory");
            }
#define PK8(T) make_uint4(cvt_pk_bf16(T[0], T[1]), cvt_pk_bf16(T[2], T[3]), cvt_pk_bf16(T[4], T[5]), cvt_pk_bf16(T[6], T[7]))
            *(uint4*)(bKBG + d0 * ST + wv * 16) = PK8(tk0); *(uint4*)(bKBG + (d0 + 1) * ST + wv * 16) = PK8(tk1);
            *(uint4*)(bVB + d0 * ST + wv * 16) = PK8(tv0); *(uint4*)(bVB + (d0 + 1) * ST + wv * 16) = PK8(tv1);
            *(uint4*)(bKD + d0 * ST + wv * 16) = PK8(td0); *(uint4*)(bKD + (d0 + 1) * ST + wv * 16) = PK8(td1);
        }
        __syncthreads();
        for (int u = wv; u < 20; u += 8) {
            const int kind = (u >= 10) ? 1 : 0, idx = u - kind * 10;
            const int ti = (idx >= 6) ? 3 : (idx >= 3) ? 2 : (idx >= 1) ? 1 : 0, tj = idx - ((ti * (ti + 1)) >> 1);
            f32x4 acc = (f32x4){0.f, 0.f, 0.f, 0.f};
            acc = mma_lds(kind ? bQN : bKN, SN, 16 * ti, bKN, SN, 16 * tj, 128, acc, c16, q4);
            const int j = 16 * tj + c16;
#pragma unroll
            for (int r = 0; r < 4; ++r) { const int i = 16 * ti + 4 * q4 + r;
                const float dec = (j <= i) ? expf(sG[i] - sG[j]) : 0.f;
                if (kind == 0) sL[i * 68 + j] = (j < i) ? sB[i] * acc[r] * dec : 0.f;
                else *(bf16_t*)(bAQK + i * ST + j * 2) = f2bf(acc[r] * SCALE128 * dec); }
        }
        __syncthreads();
        for (int rep_b = 0; rep_b < REP_B; ++rep_b)
        if (wv == 0) {
            float t[64];
            int zz = 0; asm volatile("" : "+v"(zz)); const float* sLo = sL + zz;
#pragma clang loop unroll(full)
            for (int i = 0; i < 64; ++i) { float a0 = (i == lane) ? 1.f : 0.f, a1 = 0.f, a2 = 0.f, a3 = 0.f;
#define LQ(q) float4 lv##q = make_float4(0.f, 0.f, 0.f, 0.f); if (4 * q < i) lv##q = *(const float4*)(sLo + i * 68 + 4 * q);
#define FQ(q) if (4 * q < i) { a0 -= lv##q.x * t[4 * q]; if (4 * q + 1 < i) a1 -= lv##q.y * t[4 * q + 1]; if (4 * q + 2 < i) a2 -= lv##q.z * t[4 * q + 2]; if (4 * q + 3 < i) a3 -= lv##q.w * t[4 * q + 3]; }
                { LQ(0) LQ(1) LQ(2) LQ(3) LQ(4) LQ(5) LQ(6) LQ(7)
                  FQ(0) FQ(1) FQ(2) FQ(3) FQ(4) FQ(5) FQ(6) FQ(7) }
                if (i > 32) { asm volatile("" ::: "memory");
                  LQ(8) LQ(9) LQ(10) LQ(11) LQ(12) LQ(13) LQ(14) LQ(15)
                  FQ(8) FQ(9) FQ(10) FQ(11) FQ(12) FQ(13) FQ(14) FQ(15) }
                t[i] = (a0 + a1) + (a2 + a3); asm volatile("" ::: "memory"); }
#pragma unroll
            for (int i = 0; i < 64; ++i) *(bf16_t*)(bTB + i * ST + lane * 2) = f2bf(t[i]);
        }
        __syncthreads();
#pragma unroll 4
        for (int x = 0; x < 8; ++x) {
            const int u = wv * 8 + x, kind = u >> 5, ti = (u >> 3) & 3, td = u & 7;
            f32x4 acc = (f32x4){0.f, 0.f, 0.f, 0.f};
            acc = mma_lds(bTB, ST, 16 * ti, kind ? bVB : bKBG, ST, 16 * td, 64, acc, c16, q4);
            *(uint2*)((kind ? bUT : bKN) + (16 * td + c16) * ST + (16 * ti + 4 * q4) * 2) = pack4(acc);
        }
        __syncthreads();
        unsigned char* bWT = bKN;
        const float eg = expf(gl);
        for (int rep_c = 0; rep_c < REP_C; ++rep_c) {
        for (int x = 0; x < 4; ++x) {
            const int u = wv * 4 + x, ti = u >> 2, a = u & 3;
            uint4 fr;
#pragma unroll
            for (int hf = 0; hf < 2; ++hf) { const int tk = 2 * a + hf;
                f32x4 acc = (f32x4){0.f, 0.f, 0.f, 0.f};
                acc = mma_lds(bWT, ST, 16 * tk, bKD, ST, 16 * ti, 64, acc, c16, q4);
                f32x4 v;
#pragma unroll
                for (int r = 0; r < 4; ++r) v[r] = ((16 * tk + 4 * q4 + r) == (16 * ti + c16) ? eg : 0.f) - acc[r];
                const uint2 pk = pack4(v);
                if (hf == 0) { fr.x = pk.x; fr.y = pk.y; } else { fr.z = pk.x; fr.w = pk.y; } }
            PFR[((size_t)(ci * 8 + ti) * 4 + a) * 64 + lane] = fr;
        }
        for (int x = 0; x < 2; ++x) {
            const int u = wv * 2 + x, ti = u >> 2, a = u & 3;
            uint4 fr;
            const int i = 16 * ti + c16;
            const float qs = SCALE128 * sEg[i];
#pragma unroll
            for (int hf = 0; hf < 2; ++hf) { const int tk = 2 * a + hf;
                f32x4 acc = (f32x4){0.f, 0.f, 0.f, 0.f};
                acc = mma_lds(bWT, ST, 16 * tk, bAQK, ST, 16 * ti, 64, acc, c16, q4);
                const f32x4 qv = unpack4(*(const uint2*)(bQN + i * SN + (16 * tk + 4 * q4) * 2));
                const uint2 pk = pack4(qv * qs - acc);
                if (hf == 0) { fr.x = pk.x; fr.y = pk.y; } else { fr.z = pk.x; fr.w = pk.y; } }
            RFR[((size_t)(ci * 4 + ti) * 4 + a) * 64 + lane] = fr;
        }
#pragma unroll 4
        for (int x = 0; x < 8; ++x) {
            const int u = wv * 8 + x, tdv = u >> 3, tdk = u & 7;
            f32x4 acc = (f32x4){0.f, 0.f, 0.f, 0.f};
            acc = mma_lds(bKD, ST, 16 * tdk, bUT, ST, 16 * tdv, 64, acc, c16, q4);
            QFR[((size_t)(ci * 8 + tdv) * 8 + tdk) * 64 + lane] = pack4(acc);
        }
#pragma unroll
        for (int x = 0; x < 4; ++x) {
            const int u = wv * 4 + x, tdv = u >> 2, ti = u & 3;
            f32x4 acc = (f32x4){0.f, 0.f, 0.f, 0.f};
            acc = mma_lds(bAQK, ST, 16 * ti, bUT, ST, 16 * tdv, 64, acc, c16, q4);
            OFR[((size_t)(ci * 8 + tdv) * 4 + ti) * 64 + lane] = pack4(acc);
        }
        }
        if (tid == 0) GL[ci] = gl;
    }
}

__device__ __forceinline__ void gs_load(uint4 (&d)[12], const unsigned char* pp, const unsigned char* rr, const unsigned char* qq, const unsigned char* oo, const int lt) {
#pragma unroll
    for (int i = 0; i < 6; ++i) { int c = lt + 384 * i; c = c < 2048 ? c : 2047; d[i] = *(const uint4*)(pp + c * 16); }
#pragma unroll
    for (int i = 0; i < 3; ++i) { int c = lt + 384 * i; c = c < 1024 ? c : 1023; d[6 + i] = *(const uint4*)(rr + c * 16); }
#pragma unroll
    for (int i = 0; i < 2; ++i) { int c = lt + 384 * i; c = c < 512 ? c : 511; d[9 + i] = *(const uint4*)(qq + c * 16); }
    { const int c = lt < 256 ? lt : 255; d[11] = *(const uint4*)(oo + c * 16); }
}
__device__ __forceinline__ void gs_store(const uint4 (&d)[12], unsigned char* sb, const int lt) {
#pragma unroll
    for (int i = 0; i < 6; ++i) { const int c = lt + 384 * i; if (c < 2048) *(uint4*)(sb + c * 16) = d[i]; }
#pragma unroll
    for (int i = 0; i < 3; ++i) { const int c = lt + 384 * i; if (c < 1024) *(uint4*)(sb + 32768 + c * 16) = d[6 + i]; }
#pragma unroll
    for (int i = 0; i < 2; ++i) { const int c = lt + 384 * i; if (c < 512) *(uint4*)(sb + 49152 + c * 16) = d[9 + i]; }
    if (lt < 256) *(uint4*)(sb + 57344 + lt * 16) = d[11];
}

#define SCAN_BODY                 bf16x8 Sb[4]; \
_Pragma("unroll") \
                for (int a = 0; a < 4; ++a) { union { uint4 u; bf16x8 v; } cv; const uint2 lo = pack4(S[2 * a]), hi = pack4(S[2 * a + 1]); cv.u.x = lo.x; cv.u.y = lo.y; cv.u.z = hi.x; cv.u.w = hi.y; Sb[a] = cv.v; } \
                const int t0 = b * 8192 + n * 64; \
                {   f32x4 oa[4]; \
_Pragma("unroll") \
                    for (int ti = 0; ti < 4; ++ti) oa[ti] = unpack4(*(const uint2*)(Of + ti * 512)); \
_Pragma("unroll") \
                    for (int a = 0; a < 4; ++a) \
_Pragma("unroll") \
                        for (int ti = 0; ti < 4; ++ti) oa[ti] = __builtin_amdgcn_mfma_f32_16x16x32_bf16(*(const bf16x8*)(Rf + (ti * 4 + a) * 1024), Sb[a], oa[ti], 0, 0, 0); \
_Pragma("unroll") \
                    for (int ti = 0; ti < 4; ++ti) { \
                        float* op = O + (size_t)(t0 + 16 * ti + 4 * q4) * 1024 + h * 128 + 16 * tdv + c16; \
                        op[0] = oa[ti][0]; op[1024] = oa[ti][1]; op[2048] = oa[ti][2]; op[3072] = oa[ti][3]; } \
                } \
                asm volatile("" ::: "memory"); \
_Pragma("unroll") \
                for (int g = 0; g < 2; ++g) { \
                    f32x4 sa[4]; \
_Pragma("unroll") \
                    for (int t = 0; t < 4; ++t) sa[t] = unpack4(*(const uint2*)(Qf + (g * 4 + t) * 512)); \
_Pragma("unroll") \
                    for (int a = 0; a < 4; ++a) \
_Pragma("unroll") \
                        for (int t = 0; t < 4; ++t) sa[t] = __builtin_amdgcn_mfma_f32_16x16x32_bf16(*(const bf16x8*)(Pf + ((g * 4 + t) * 4 + a) * 1024), Sb[a], sa[t], 0, 0, 0); \
_Pragma("unroll") \
                    for (int t = 0; t < 4; ++t) S[g * 4 + t] = sa[t]; \
                    asm volatile("" ::: "memory"); \
                }
PHASE_FN void ph_gdn_scan(const Params& p, float* smem) {
    KParams* pp = kparams();
    GU8* wsg_ = (GU8*)pp->ws; asm volatile("" : "+s"(wsg_)); unsigned char* ws_ = (unsigned char*)wsg_;
    int tid_ = threadIdx.x; asm volatile("" : "+v"(tid_)); const int tid = tid_, lane = tid & 63, wv = __builtin_amdgcn_readfirstlane(tid >> 6), q4 = lane >> 4, c16 = lane & 15;
    int ldz_ = 0; asm volatile("" : "+s"(ldz_)); unsigned char* lds = g_smem + ldz_;
    constexpr int STG = 61440;
    const unsigned char* PFR = ws_ + OFF_PFR; const unsigned char* RFR = ws_ + OFF_RFR; const unsigned char* QFR = ws_ + OFF_QFR; const unsigned char* OFR = ws_ + OFF_OFR;
    float* O = (float*)(ws_ + OFF_O);
    for (int it = blockIdx.x; it < 32; it += gridDim.x) {
        const int bh = it >> 2, pair = it & 3, b = bh >> 2, h = bh & 3;
        __syncthreads();
        if (wv >= 2) {
            const int lt = tid - 128;
            const unsigned char* Pb = PFR + (size_t)bh * 128 * 32768;
            const unsigned char* Rb = RFR + (size_t)bh * 128 * 16384;
            const unsigned char* Qb = QFR + (size_t)bh * 128 * 32768 + pair * 8192;
            const unsigned char* Ob = OFR + (size_t)bh * 128 * 16384 + pair * 4096;
            uint4 ra0, ra1, ra2, ra3, ra4, ra5, ra6, ra7, ra8, ra9, ra10, ra11, rb0, rb1, rb2, rb3, rb4, rb5, rb6, rb7, rb8, rb9, rb10, rb11;
            uint4 rc0, rc1, rc2, rc3, rc4, rc5, rc6, rc7, rc8, rc9, rc10, rc11;
#define LDC(base_, c_, mx_) (*(const uint4*)((base_) + (size_t)(((c_) < (mx_)) ? (c_) : (mx_)) * 16))
#define GS_LOAD(X, n_) do { const unsigned char* pp_ = Pb + (size_t)(n_) * 32768; const unsigned char* rr_ = Rb + (size_t)(n_) * 16384; \
                const unsigned char* qq_ = Qb + (size_t)(n_) * 32768; const unsigned char* oo_ = Ob + (size_t)(n_) * 16384; \
                X##0 = LDC(pp_, lt, 2047); X##1 = LDC(pp_, lt + 384, 2047); X##2 = LDC(pp_, lt + 768, 2047); X##3 = LDC(pp_, lt + 1152, 2047); X##4 = LDC(pp_, lt + 1536, 2047); X##5 = LDC(pp_, lt + 1920, 2047); \
                X##6 = LDC(rr_, lt, 1023); X##7 = LDC(rr_, lt + 384, 1023); X##8 = LDC(rr_, lt + 768, 1023); \
                X##9 = LDC(qq_, lt, 511); X##10 = LDC(qq_, lt + 384, 511); X##11 = LDC(oo_, lt, 255); } while (0)
#define STC(off_, c_, lim_, v_) do { if ((c_) < (lim_)) *(uint4*)(sb_ + (off_) + (c_) * 16) = v_; } while (0)
#define GS_STORE(X, st_) do { unsigned char* sb_ = lds + (st_) * STG; \
                STC(0, lt, 2048, X##0); STC(0, lt + 384, 2048, X##1); STC(0, lt + 768, 2048, X##2); STC(0, lt + 1152, 2048, X##3); STC(0, lt + 1536, 2048, X##4); STC(0, lt + 1920, 2048, X##5); \
                STC(32768, lt, 1024, X##6); STC(32768, lt + 384, 1024, X##7); STC(32768, lt + 768, 1024, X##8); \
                STC(49152, lt, 512, X##9); STC(49152, lt + 384, 512, X##10); STC(57344, lt, 256, X##11); } while (0)
            GS_LOAD(ra, 0); GS_STORE(ra, 0);
            GS_LOAD(rb, 1); GS_LOAD(rc, 2); GS_LOAD(ra, 3);
            __syncthreads();
#define CLAMPN(x_) (((x_) < 128) ? (x_) : 127)
            for (int n = 0; n < 128; n += 3) {
                if (n + 1 < 128) GS_STORE(rb, (n + 1) & 1);
                GS_LOAD(rb, CLAMPN(n + 4)); LBAR();
                if (n + 1 < 128) { if (n + 2 < 128) GS_STORE(rc, (n + 2) & 1);
                    GS_LOAD(rc, CLAMPN(n + 5)); LBAR(); }
                if (n + 2 < 128) { if (n + 3 < 128) GS_STORE(ra, (n + 3) & 1);
                    GS_LOAD(ra, CLAMPN(n + 6)); LBAR(); }
            }
        } else {
            const int tdv = pair * 2 + wv;
            f32x4 S[8];
#pragma unroll
            for (int t = 0; t < 8; ++t) S[t] = (f32x4){0.f, 0.f, 0.f, 0.f};
            __syncthreads();
            for (int n = 0; n < 128; ++n) {
                const unsigned char* base = lds + (n & 1) * STG;
                const unsigned char* Pf = base + lane * 16, *Rf = base + 32768 + lane * 16;
                const unsigned char* Qf = base + 49152 + wv * 4096 + lane * 8, *Of = base + 57344 + wv * 2048 + lane * 8;
                SCAN_BODY
                LBAR();
            }
        }
    }
}

__device__ __forceinline__ void block_sum4(int (&v)[4], int* buf) {
    const int lane = threadIdx.x & 63, wv = threadIdx.x >> 6;
#pragma unroll
    for (int q = 0; q < 4; ++q) v[q] = wave_sum_i(v[q]);
    if (lane == 0) {
#pragma unroll
        for (int q = 0; q < 4; ++q) buf[wv * 4 + q] = v[q];
    }
    __syncthreads();
#pragma unroll
    for (int q = 0; q < 4; ++q) { int a = 0; for (int w = 0; w < 8; ++w) a += buf[w * 4 + q]; v[q] = a; }
}

PHASE_FN void ph_dsa_topk(const Params& p, int layer, float* smem) {
    KParams* pp = kparams();
    GU8* wsg_ = (GU8*)pp->ws; asm volatile("" : "+s"(wsg_)); unsigned char* ws_ = (unsigned char*)wsg_;
    int tid_ = threadIdx.x; asm volatile("" : "+v"(tid_)); const int tid = tid_, lane = tid & 63, wv = __builtin_amdgcn_readfirstlane(tid >> 6), q4 = lane >> 4, c16 = lane & 15;
    int* sRed = (int*)g_smem;
    const bf16_t* QIb = (const bf16_t*)(ws_ + OFF_QIB); const bf16_t* KIb = (const bf16_t*)(ws_ + OFF_KIB); const float* WI = (const float*)(ws_ + OFF_WI);
    unsigned short* M16 = (unsigned short*)(ws_ + OFF_M16);
    int* qhead = (int*)(ws_ + OFF_QCTR) + layer * 16;
    int* sIt = (int*)(g_smem + 512);
    for (;;) {
        __syncthreads();
        if (tid == 0) *sIt = atomicAdd(qhead, 1);
        __syncthreads();
        const int it = *sIt;
        if (it >= 2048) break;
        const int b = it & 1, gp = 1023 - (it >> 1);
        const int s0 = gp * 8, t0 = b * 8192 + s0;
        const int ntiles = (s0 >> 4) + 1;
        const int nreg = (ntiles > wv) ? ((ntiles - wv + 7) >> 3) : 0;
        const bf16_t* qp = QIb + (size_t)(t0 + (c16 >> 2)) * 256 + (c16 & 3) * 64 + 8 * q4;
        const bf16x8 a0A = *(const bf16x8*)qp, a1A = *(const bf16x8*)(qp + 32), a0B = *(const bf16x8*)(qp + 4 * 256), a1B = *(const bf16x8*)(qp + 4 * 256 + 32);
        const float4 wqA = *(const float4*)(WI + (size_t)(t0 + q4) * 4), wqB = *(const float4*)(WI + (size_t)(t0 + 4 + q4) * 4);
        const int myqA = s0 + q4, myqB = s0 + 4 + q4;
        int c16s = c16; asm volatile("" : "+v"(c16s));
        int wvs = wv; asm volatile("" : "+s"(wvs));
        unsigned kA[64], kB[64];
#pragma unroll
        for (int i = 0; i < 64; ++i) { kA[i] = 0u; kB[i] = 0u; }
#pragma unroll
        for (int blk = 0; blk < 4; ++blk) if (nreg > blk * 16) {
#pragma unroll
            for (int ii = 0; ii < 16; ++ii) { const int i = blk * 16 + ii, tile = wvs + 8 * i;
                if (tile < ntiles) {
                    const bf16_t* kp = KIb + (size_t)(b * 8192 + tile * 16 + c16s) * 64 + 8 * q4;
                    const bf16x8 k0 = *(const bf16x8*)kp, k1 = *(const bf16x8*)(kp + 32);
                    f32x4 accA = (f32x4){0.f, 0.f, 0.f, 0.f}, accB = accA;
                    accA = __builtin_amdgcn_mfma_f32_16x16x32_bf16(a0A, k0, accA, 0, 0, 0);
                    accB = __builtin_amdgcn_mfma_f32_16x16x32_bf16(a0B, k0, accB, 0, 0, 0);
                    accA = __builtin_amdgcn_mfma_f32_16x16x32_bf16(a1A, k1, accA, 0, 0, 0);
                    accB = __builtin_amdgcn_mfma_f32_16x16x32_bf16(a1B, k1, accB, 0, 0, 0);
                    float sa = 0.f, sb = 0.f;
                    sa += wqA.x * fmaxf(accA[0], 0.f); sa += wqA.y * fmaxf(accA[1], 0.f); sa += wqA.z * fmaxf(accA[2], 0.f); sa += wqA.w * fmaxf(accA[3], 0.f);
                    sb += wqB.x * fmaxf(accB[0], 0.f); sb += wqB.y * fmaxf(accB[1], 0.f); sb += wqB.z * fmaxf(accB[2], 0.f); sb += wqB.w * fmaxf(accB[3], 0.f);
                    const int kidx = tile * 16 + c16s;
                    kA[i] = (kidx <= myqA) ? ordkey(sa) : 0u;
                    kB[i] = (kidx <= myqB) ? ordkey(sb) : 0u;
                }
                if ((ii & 3) == 3) asm volatile("" ::: "memory"); }
        }
        const int keffA = (myqA + 1 < 256) ? (myqA + 1) : 256, keffB = (myqB + 1 < 256) ? (myqB + 1) : 256;
        int par = 0;
        int mydone = 0, alldone = 0;
        int* sDone = sRed + 64;
        auto qsum = [&](int c) -> int {
            c += __shfl_xor(c, 1); c += __shfl_xor(c, 2); c += __shfl_xor(c, 4); c += __shfl_xor(c, 8);
            par ^= 1;
            if (c16 == 0) { sRed[par * 32 + wv * 4 + q4] = c; if (wv == 0) sDone[par * 4 + q4] = (mydone == 3) ? 1 : 0; }
            __syncthreads();
            int a = 0;
#pragma unroll
            for (int w = 0; w < 8; ++w) a += sRed[par * 32 + w * 4 + q4];
            alldone = sDone[par * 4] & sDone[par * 4 + 1] & sDone[par * 4 + 2] & sDone[par * 4 + 3];
            return a;
        };
        unsigned UA = 0u, UB = 0u;
        for (int bit = 31; bit >= 0; --bit) {
            const unsigned candA = UA | (1u << bit), candB = UB | (1u << bit);
            int ca = 0, cb = 0;
            if (!alldone) {
#pragma unroll
            for (int blk = 0; blk < 4; ++blk) if (nreg > blk * 16) {
#pragma unroll
                for (int ii = 0; ii < 16; ++ii) { ca += (kA[blk * 16 + ii] >= candA) ? 1 : 0; cb += (kB[blk * 16 + ii] >= candB) ? 1 : 0; }
            } }
            const int tot = qsum(ca | (cb << 16));
            if ((tot & 0xffff) >= keffA) { UA = candA; mydone = (mydone & 2) | (((tot & 0xffff) == keffA) ? 1 : 0); }
            if ((tot >> 16) >= keffB) { UB = candB; mydone = (mydone & 1) | (((tot >> 16) == keffB) ? 2 : 0); }
        }
        int cg = 0, ce = 0;
#pragma unroll
        for (int i = 0; i < 64; ++i) { cg += (kA[i] > UA) ? 1 : 0; ce += (kA[i] == UA) ? 1 : 0; cg += (kB[i] > UB) ? 65536 : 0; ce += (kB[i] == UB) ? 65536 : 0; }
        cg = qsum(cg); ce = qsum(ce);
        const int needA = keffA - (cg & 0xffff), needB = keffB - (cg >> 16);
        int JA = 8191, JB = 8191;
        par ^= 1;
        if (c16 == 0) sRed[par * 32 + wv * 4 + q4] = (((ce & 0xffff) > needA) || ((ce >> 16) > needB)) ? 1 : 0;
        __syncthreads();
        int anyov = 0;
#pragma unroll
        for (int w = 0; w < 32; ++w) anyov |= sRed[par * 32 + w];
        if (anyov) {
            JA = 0; JB = 0;
            int c16j = c16; asm volatile("" : "+v"(c16j));
            int wvj = wv; asm volatile("" : "+s"(wvj));
            for (int bit = 12; bit >= 0; --bit) {
                const int cjA = JA | (1 << bit), cjB = JB | (1 << bit);
                int c = 0;
#pragma unroll
                for (int i = 0; i < 64; ++i) { const int kidx = (wvj + 8 * i) * 16 + c16j; c += (kA[i] == UA && kidx < cjA) ? 1 : 0; c += (kB[i] == UB && kidx < cjB) ? 65536 : 0; }
                const int tot = qsum(c);
                if ((tot & 0xffff) <= needA - 1) JA = cjA;
                if ((tot >> 16) <= needB - 1) JB = cjB;
            }
        }
        unsigned short* sM = (unsigned short*)(g_smem + 1024);
        { unsigned z_ = 0u; asm volatile("" : "+v"(z_)); ((uint4*)sM)[tid] = make_uint4(z_, z_, z_, z_); }
        __syncthreads();
        const unsigned UA1 = UA + 1u, UB1 = UB + 1u;
        int c16e = c16; asm volatile("" : "+v"(c16e));
        int wve = wv; asm volatile("" : "+s"(wve));
#pragma unroll
        for (int blk = 0; blk < 4; ++blk) if (nreg > blk * 16) {
#pragma unroll
            for (int ii = 0; ii < 16; ++ii) { const int i = blk * 16 + ii;
                const int tile = wve + 8 * i, kidx = tile * 16 + c16e;
                const bool selA = kA[i] >= UA1 || (kA[i] == UA && kidx <= JA);
                const bool selB = kB[i] >= UB1 || (kB[i] == UB && kidx <= JB);
                const unsigned long long balA = __ballot(selA), balB = __ballot(selB);
                if (c16 == 0) { sM[q4 * 512 + tile] = (unsigned short)((balA >> (16 * q4)) & 0xffffull);
                                sM[(4 + q4) * 512 + tile] = (unsigned short)((balB >> (16 * q4)) & 0xffffull); }
            }
        }
        __syncthreads();
        *(uint4*)(M16 + (size_t)(t0 + (tid >> 6)) * 512 + (tid & 63) * 8) = ((const uint4*)sM)[tid];
    }
}

PHASE_FN void ph_dsa_attn(const Params& p, float* smem) {
    KParams* pp = kparams();
    GU8* wsg_ = (GU8*)pp->ws; asm volatile("" : "+s"(wsg_)); unsigned char* ws_ = (unsigned char*)wsg_;
    int tid_ = threadIdx.x; asm volatile("" : "+v"(tid_)); const int tid = tid_, lane = tid & 63, wv = tid >> 6, q4 = lane >> 4, c16 = lane & 15;
    int ldz_ = 0; asm volatile("" : "+s"(ldz_)); unsigned char* lds = g_smem + ldz_;
    const bf16_t* QBb = (const bf16_t*)(ws_ + OFF_QBB); const bf16_t* KBb = (const bf16_t*)(ws_ + OFF_KBB); const bf16_t* VT = (const bf16_t*)(ws_ + OFF_VT);
    const unsigned short* M16 = (const unsigned short*)(ws_ + OFF_M16);
    bf16_t* OB = (bf16_t*)(ws_ + OFF_OB);
    const float SC = SCALE128 * 1.4426950408889634f;
    for (int it = blockIdx.x; it < 256; it += gridDim.x) {
        const int bh = it & 7, jp = it >> 3, b = bh >> 2, h = bh & 3;
        for (int half = 0; half < 2; ++half) {
            const int jq = half ? jp : 63 - jp;
            const int qs = jq * 128, nkt = 2 * jq + 2;
            const int tq = b * 8192 + qs + wv * 16 + c16;
            bf16x8 qf[4];
#pragma unroll
            for (int a = 0; a < 4; ++a) qf[a] = *(const bf16x8*)(QBb + (size_t)tq * 512 + h * 128 + 8 * q4 + 32 * a);
            float m = -1e30f, lsum = 0.f;
            f32x4 oacc[8];
#pragma unroll
            for (int t = 0; t < 8; ++t) oacc[t] = (f32x4){0.f, 0.f, 0.f, 0.f};
            uint4 rk0, rk1, rv0, rv1;
            const int q0 = tid, q1 = tid + 512;
            const bf16_t* kg0 = KBb + (size_t)(b * 8192 + (q0 >> 4)) * 512 + h * 128 + (q0 & 15) * 8;
            const bf16_t* kg1 = KBb + (size_t)(b * 8192 + (q1 >> 4)) * 512 + h * 128 + (q1 & 15) * 8;
            const bf16_t* vg0 = VT + ((size_t)((b * 4 + h) * 128 + (q0 >> 3))) * 8192 + (q0 & 7) * 8;
            const bf16_t* vg1 = VT + ((size_t)((b * 4 + h) * 128 + (q1 >> 3))) * 8192 + (q1 & 7) * 8;
            const int lk0 = (q0 >> 4) * 256 + ((((q0 & 15)) ^ ((q0 >> 4) & 15)) << 4), lk1 = (q1 >> 4) * 256 + ((((q1 & 15)) ^ ((q1 >> 4) & 15)) << 4);
            const int lv0 = 16384 + (q0 >> 3) * 128 + ((((q0 & 7)) ^ ((q0 >> 3) & 7)) << 4), lv1 = 16384 + (q1 >> 3) * 128 + ((((q1 & 7)) ^ ((q1 >> 3) & 7)) << 4);
#define ATT_GLOAD(kt_) do { rk0 = *(const uint4*)(kg0 + (size_t)(kt_) * 64 * 512); rk1 = *(const uint4*)(kg1 + (size_t)(kt_) * 64 * 512); \
                            rv0 = *(const uint4*)(vg0 + (kt_) * 64); rv1 = *(const uint4*)(vg1 + (kt_) * 64); } while (0)
#define ATT_LSTORE(st_) do { unsigned char* base_ = lds + (st_) * 32768; *(uint4*)(base_ + lk0) = rk0; *(uint4*)(base_ + lk1) = rk1; *(uint4*)(base_ + lv0) = rv0; *(uint4*)(base_ + lv1) = rv1; } while (0)
            __syncthreads();
            ATT_GLOAD(0); ATT_LSTORE(0);
            __syncthreads();
            for (int kt = 0; kt < nkt; ++kt) {
                if (kt + 1 < nkt) ATT_GLOAD(kt + 1);
                const unsigned long long mbits = *(const unsigned long long*)(M16 + (size_t)tq * 512 + 4 * kt);
                const unsigned char* Kt = lds + (kt & 1) * 32768;
                const unsigned char* Vt = Kt + 16384;
                f32x4 sacc[4];
#pragma unroll
                for (int th = 0; th < 2; ++th) {
                    bf16x8 kf[8];
#pragma unroll
                    for (int tt = 0; tt < 2; ++tt) { const int row = 16 * (th * 2 + tt) + c16;
#pragma unroll
                        for (int a = 0; a < 4; ++a) kf[tt * 4 + a] = *(const bf16x8*)(Kt + row * 256 + ((((q4 + 4 * a)) ^ (row & 15)) << 4)); }
                    asm volatile("" : "+v"(kf[0]), "+v"(kf[1]), "+v"(kf[2]), "+v"(kf[3]), "+v"(kf[4]), "+v"(kf[5]), "+v"(kf[6]), "+v"(kf[7]));
                    sacc[th * 2] = (f32x4){0.f, 0.f, 0.f, 0.f}; sacc[th * 2 + 1] = (f32x4){0.f, 0.f, 0.f, 0.f};
#pragma unroll
                    for (int a = 0; a < 4; ++a)
#pragma unroll
                        for (int tt = 0; tt < 2; ++tt) sacc[th * 2 + tt] = __builtin_amdgcn_mfma_f32_16x16x32_bf16(kf[tt * 4 + a], qf[a], sacc[th * 2 + tt], 0, 0, 0);
                }
                float mx = m;
#pragma unroll
                for (int ti = 0; ti < 4; ++ti)
#pragma unroll
                    for (int r = 0; r < 4; ++r) { const bool valid = (mbits >> (16 * ti + 4 * q4 + r)) & 1ull; const float v = sacc[ti][r] * SC; sacc[ti][r] = v; mx = fmaxf(mx, valid ? v : -1e30f); }
                mx = fmaxf(mx, __shfl_xor(mx, 16)); mx = fmaxf(mx, __shfl_xor(mx, 32));
                const float alpha = __builtin_amdgcn_exp2f(m - mx); m = mx;
                float ps = 0.f;
#pragma unroll
                for (int ti = 0; ti < 4; ++ti)
#pragma unroll
                    for (int r = 0; r < 4; ++r) { const bool valid = (mbits >> (16 * ti + 4 * q4 + r)) & 1ull; const float pv = valid ? __builtin_amdgcn_exp2f(sacc[ti][r] - mx) : 0.f; sacc[ti][r] = pv; ps += pv; }
                lsum = lsum * alpha + ps;
                if (!__all(alpha == 1.f)) {
#pragma unroll
                for (int t = 0; t < 8; ++t) oacc[t] = oacc[t] * alpha; }
                bf16x8 pb[2];
#pragma unroll
                for (int a = 0; a < 2; ++a) {
                    union { uint4 u; bf16x8 v; } cv;
                    cv.u.x = cvt_pk_bf16(sacc[2 * a][0], sacc[2 * a][1]); cv.u.y = cvt_pk_bf16(sacc[2 * a][2], sacc[2 * a][3]);
                    cv.u.z = cvt_pk_bf16(sacc[2 * a + 1][0], sacc[2 * a + 1][1]); cv.u.w = cvt_pk_bf16(sacc[2 * a + 1][2], sacc[2 * a + 1][3]);
                    pb[a] = cv.v; }
#pragma unroll
                for (int tg = 0; tg < 2; ++tg) {
                    bf16x8 vfr[8];
#pragma unroll
                    for (int tt = 0; tt < 4; ++tt) { const int row = 16 * (tg * 4 + tt) + c16;
#pragma unroll
                        for (int a = 0; a < 2; ++a) {
                            union { uint2 h2[2]; bf16x8 v; } vf;
                            vf.h2[0] = *(const uint2*)(Vt + row * 128 + ((((4 * a + (q4 >> 1))) ^ (row & 7)) << 4) + 8 * (q4 & 1));
                            vf.h2[1] = *(const uint2*)(Vt + row * 128 + ((((4 * a + 2 + (q4 >> 1))) ^ (row & 7)) << 4) + 8 * (q4 & 1));
                            vfr[tt * 2 + a] = vf.v; } }
                    asm volatile("" : "+v"(vfr[0]), "+v"(vfr[1]), "+v"(vfr[2]), "+v"(vfr[3]), "+v"(vfr[4]), "+v"(vfr[5]), "+v"(vfr[6]), "+v"(vfr[7]));
#pragma unroll
                    for (int a = 0; a < 2; ++a)
#pragma unroll
                        for (int tt = 0; tt < 4; ++tt) oacc[tg * 4 + tt] = __builtin_amdgcn_mfma_f32_16x16x32_bf16(vfr[tt * 2 + a], pb[a], oacc[tg * 4 + tt], 0, 0, 0);
                }
                if (kt + 1 < nkt) ATT_LSTORE((kt + 1) & 1);
                __syncthreads();
            }
            lsum += __shfl_xor(lsum, 16); lsum += __shfl_xor(lsum, 32);
            const float inv = 1.f / lsum;
#pragma unroll
            for (int t = 0; t < 8; ++t) *(uint2*)(OB + (size_t)tq * 1024 + 512 + h * 128 + 16 * t + 4 * q4) = pack4(oacc[t] * inv);
        }
    }
}

PHASE_FN void ph_gdn_out(const Params& p, int layer) {
    KParams* pp = kparams();
    GU8* wsg_ = (GU8*)pp->ws; asm volatile("" : "+s"(wsg_)); unsigned char* ws_ = (unsigned char*)wsg_;
    int tid_ = threadIdx.x; asm volatile("" : "+v"(tid_)); const int tid = tid_, lane = tid & 63, wv = tid >> 6;
    const float* O = (const float*)(ws_ + OFF_O); const bf16_t* P = (const bf16_t*)(ws_ + OFF_P); bf16_t* OB = (bf16_t*)(ws_ + OFF_OB);
    const float* onw = as_global(pp->gdn_out_norm) + (layer >> 1) * 128;
    for (int t = blockIdx.x * 8 + wv; t < NT; t += gridDim.x * 8) {
#pragma unroll
        for (int h = 0; h < 4; ++h) {
            const float* op = O + (size_t)t * 1024 + h * 128; bf16_t* ob = OB + (size_t)t * 1024 + h * 128;
            const float o0 = op[lane], o1 = op[64 + lane];
            const float ss = wave_sum(o0 * o0 + o1 * o1);
            const float r = rsqrtf(ss * (1.f / 128.f) + EPS);
            const float z0 = PBF(P, t, 1536 + h * 128 + lane), z1 = PBF(P, t, 1536 + h * 128 + 64 + lane);
            ob[lane] = f2bf(o0 * r * onw[lane] * siluf_(z0)); ob[64 + lane] = f2bf(o1 * r * onw[64 + lane] * siluf_(z1));
        }
    }
}

struct EpiOut {
    static constexpr bool PERM = false;
    const float* Xres; float* X; const float* gt0;
    __device__ __forceinline__ void operator()(const f32x4 (&acc)[2][2][4][2], const pg8::Unit& u, int wr, int wc, int fr, int fq) const {
        const int row0 = u.pm * 256 + wr * 64 + fr, col0 = u.pn * 256 + wc * 32 + 4 * fq;
        const float* gt = gt0 + (size_t)(row0 >> 13) * 6144 + col0;
        f32x4 gv[2][2];
#pragma unroll
        for (int bj = 0; bj < 2; ++bj)
#pragma unroll
            for (int n = 0; n < 2; ++n) gv[bj][n] = *(const f32x4*)(gt + bj * 128 + n * 16);
#pragma unroll
        for (int ai = 0; ai < 2; ++ai)
#pragma unroll
            for (int m = 0; m < 4; ++m) { const size_t off = (size_t)(row0 + ai * 128 + m * 16) * ND + col0;
#pragma unroll
                for (int bj = 0; bj < 2; ++bj)
#pragma unroll
                    for (int n = 0; n < 2; ++n) *(f32x4*)(X + off + bj * 128 + n * 16) = *(const f32x4*)(Xres + off + bj * 128 + n * 16) + gv[bj][n] * acc[ai][bj][m][n]; }
    }
};

PHASE_FN void ph_gemm_out(const Params& p, int layer, float* smem) {
    KParams* pp = kparams();
    GU8* wsg_ = (GU8*)pp->ws; asm volatile("" : "+s"(wsg_)); unsigned char* ws_ = (unsigned char*)wsg_;
    int ldz_ = 0; asm volatile("" : "+s"(ldz_));
    const bf16_t* Wt = (const bf16_t*)(ws_ + OFF_WOUT) + (size_t)layer * 1024 * 1024;
    EpiOut E; E.Xres = (layer == 0) ? as_global(pp->x) : (const float*)as_global(pp->X); E.X = as_global(pp->X); E.gt0 = (const float*)(ws_ + OFF_MOD) + (size_t)(layer * 2) * 6144 + 2048;
    pg8::DenseOrder S; S.init(64, 4, gridDim.x, blockIdx.x, 1024);
    __syncthreads();
    pg8::gemm_phase<EpiOut, pg8::DenseOrder, false>((LAS unsigned char*)(g_smem + ldz_), (const bf16_t*)(ws_ + OFF_OB), Wt, 1024, S, E);
    __syncthreads();
}

PHASE_FN void ph_norm_ffn(const Params& p, int layer) {
    KParams* pp = kparams();
    GU8* wsg_ = (GU8*)pp->ws; asm volatile("" : "+s"(wsg_)); unsigned char* ws_ = (unsigned char*)wsg_;
    int tid_ = threadIdx.x; asm volatile("" : "+v"(tid_)); const int tid = tid_, lane = tid & 63, wv = tid >> 6;
    const float* MOD = (const float*)(ws_ + OFF_MOD);
    bf16_t* H = (bf16_t*)(ws_ + OFF_H);
    int* CNT = (int*)(ws_ + OFF_CNT) + layer * 32 * CSTR;
    int* sCnt = (int*)g_smem; int* sBase = sCnt + 32; int* sE = sBase + 32; int* sR = sE + 256;
    const int nrb = (NT + (int)gridDim.x - 1) / (int)gridDim.x, row_lo = blockIdx.x * nrb, row_hi = (row_lo + nrb < NT) ? row_lo + nrb : NT;
    __syncthreads();
    if (tid < 32) sCnt[tid] = 0;
    __syncthreads();
    int* ASG = (int*)(ws_ + OFF_ASG); float* GATE = (float*)(ws_ + OFF_GATE); int* LIST = (int*)(ws_ + OFF_LIST);
    const float* nw = as_global(pp->norm_ffn) + layer * 1024;
    const float* wg = as_global(pp->rg_w) + (size_t)layer * 1024 * 4;
    for (int row = row_lo + wv; row < row_hi; row += 8) {
        const int b = row >> 13;
        const float* xr = as_global(pp->X) + (size_t)row * ND;
        const float* sh = MOD + (size_t)(layer * 2 + b) * 6144 + 3072;
        const float* sc = sh + 1024;
        float hv[16]; float ss = 0.f;
#pragma unroll
        for (int j = 0; j < 4; ++j) { const float4 v = *(const float4*)(xr + j * 256 + lane * 4); hv[4 * j] = v.x; hv[4 * j + 1] = v.y; hv[4 * j + 2] = v.z; hv[4 * j + 3] = v.w; }
#pragma unroll
        for (int j = 0; j < 16; ++j) ss += hv[j] * hv[j];
        ss = wave_sum(ss);
        const float rstd = rsqrtf(ss * (1.f / 1024.f) + EPS);
#pragma unroll
        for (int j = 0; j < 4; ++j) {
            const int col = j * 256 + lane * 4;
            const float4 w = *(const float4*)(nw + col), s4 = *(const float4*)(sc + col), h4 = *(const float4*)(sh + col);
            hv[4 * j] = hv[4 * j] * rstd * w.x * (1.f + s4.x) + h4.x; hv[4 * j + 1] = hv[4 * j + 1] * rstd * w.y * (1.f + s4.y) + h4.y;
            hv[4 * j + 2] = hv[4 * j + 2] * rstd * w.z * (1.f + s4.z) + h4.z; hv[4 * j + 3] = hv[4 * j + 3] * rstd * w.w * (1.f + s4.w) + h4.w;
            { f32x4 ov; ov[0] = hv[4 * j]; ov[1] = hv[4 * j + 1]; ov[2] = hv[4 * j + 2]; ov[3] = hv[4 * j + 3]; *(uint2*)(H + (size_t)row * ND + col) = pack4(ov); }
        }
        float gl[4] = {0.f, 0.f, 0.f, 0.f};
#pragma unroll
        for (int j = 0; j < 4; ++j)
#pragma unroll
            for (int e = 0; e < 4; ++e) { const int col = j * 256 + lane * 4 + e; const float4 w = *(const float4*)(wg + (size_t)col * 4); const float hh = hv[4 * j + e];
                gl[0] += hh * w.x; gl[1] += hh * w.y; gl[2] += hh * w.z; gl[3] += hh * w.w; }
#pragma unroll
        for (int g = 0; g < 4; ++g) gl[g] = wave_sum(gl[g]) + as_global(pp->rg_b)[layer * 4 + g];
        int gs = 0; float gm = gl[0];
#pragma unroll
        for (int g = 1; g < 4; ++g) if (gl[g] > gm) { gm = gl[g]; gs = g; }
        float gsum = 0.f;
#pragma unroll
        for (int g = 0; g < 4; ++g) gsum += expf(gl[g] - gm);
        const float ggate = 1.f / gsum;
        const float* we = as_global(pp->re_w) + ((size_t)(layer * 4 + gs) * 1024) * 8;
        float el[8] = {0.f, 0.f, 0.f, 0.f, 0.f, 0.f, 0.f, 0.f};
#pragma unroll
        for (int j = 0; j < 4; ++j)
#pragma unroll
            for (int e = 0; e < 4; ++e) { const int col = j * 256 + lane * 4 + e; const float4 w0 = *(const float4*)(we + (size_t)col * 8), w1 = *(const float4*)(we + (size_t)col * 8 + 4); const float hh = hv[4 * j + e];
                el[0] += hh * w0.x; el[1] += hh * w0.y; el[2] += hh * w0.z; el[3] += hh * w0.w; el[4] += hh * w1.x; el[5] += hh * w1.y; el[6] += hh * w1.z; el[7] += hh * w1.w; }
#pragma unroll
        for (int e = 0; e < 8; ++e) el[e] = wave_sum(el[e]) + as_global(pp->re_b)[(layer * 4 + gs) * 8 + e];
        int i1 = 0; float l1 = el[0];
#pragma unroll
        for (int e = 1; e < 8; ++e) if (el[e] > l1) { l1 = el[e]; i1 = e; }
        int i2 = -1; float l2 = -INFINITY;
#pragma unroll
        for (int e = 0; e < 8; ++e) if (e != i1 && el[e] > l2) { l2 = el[e]; i2 = e; }
        const float ex = expf(l2 - l1);
        const float p1 = 1.f / (1.f + ex), p2 = ex / (1.f + ex);
        if (lane == 0) {
            const int e1 = gs * 8 + i1, e2 = gs * 8 + i2, lr = row - row_lo;
            sE[lr * 2] = e1; sE[lr * 2 + 1] = e2;
            sR[lr * 2] = atomicAdd(&sCnt[e1], 1); sR[lr * 2 + 1] = atomicAdd(&sCnt[e2], 1);
            GATE[row * 2] = ggate * p1; GATE[row * 2 + 1] = ggate * p2;
        }
    }
    __syncthreads();
    if (tid < 32) sBase[tid] = (sCnt[tid] > 0) ? atomicAdd(&CNT[tid * CSTR], sCnt[tid]) : 0;
    __syncthreads();
    for (int a = tid; a < (row_hi - row_lo) * 2; a += NTHREADS) {
        const int row = row_lo + (a >> 1), e = sE[a], r = sBase[e] + sR[a];
        LIST[(size_t)e * LISTCAP + r] = row;
        ASG[row * 4 + (a & 1) * 2] = e; ASG[row * 4 + (a & 1) * 2 + 1] = r;
    }
}

struct MoeOrder {
    const int* sTs; const int* sPad; const int* CNT; const int* LIST; int G, c, which, K;
    __device__ __forceinline__ bool next(int i, pg8::Unit& u) const {
        const long L = (long)i * G + c; if (L >= (long)__builtin_amdgcn_readfirstlane(sTs[32]) * 4) return false;
        const int mt = (int)(L >> 2), nt = (int)(L & 3);
        int e = 0;
        for (int q = 1; q < 32; ++q) if (__builtin_amdgcn_readfirstlane(sTs[q]) <= mt) e = q;
        const int mi = mt - __builtin_amdgcn_readfirstlane(sTs[e]), cnt = __builtin_amdgcn_readfirstlane(CNT[e * CSTR]);
        u.pm = mt; u.pn = nt; u.e = e; u.mi = mi; u.mvalid = (cnt - mi * 256 < 256) ? (cnt - mi * 256) : 256; u.rowbase = __builtin_amdgcn_readfirstlane(sPad[e]) + mi * 256;
        u.boff = ((size_t)e * 1024 + nt * 256) * K * 2;
        u.aoff = which ? (size_t)u.rowbase * 512 * 2 : 0;
        return true;
    }
    __device__ __forceinline__ int row(const pg8::Unit& u, int r) const { const int rr = (r < u.mvalid) ? r : 0; return LIST[(size_t)u.e * LISTCAP + u.mi * 256 + rr]; }
};
struct EpiMoe1 {
    static constexpr bool PERM = false;
    bf16_t* HID;
    __device__ __forceinline__ void operator()(const f32x4 (&acc)[2][2][4][2], const pg8::Unit& u, int wr, int wc, int fr, int fq) const {
#pragma unroll
        for (int ai = 0; ai < 2; ++ai)
#pragma unroll
            for (int m = 0; m < 4; ++m) { const int rl = ai * 128 + wr * 64 + m * 16 + fr;
                if (rl < u.mvalid) {
#pragma unroll
                    for (int bj = 0; bj < 2; ++bj) { const f32x4 a1 = acc[ai][bj][m][0], a3 = acc[ai][bj][m][1]; f32x4 hv;
                        hv[0] = silu_fast(a1[0]) * a3[0]; hv[1] = silu_fast(a1[1]) * a3[1]; hv[2] = silu_fast(a1[2]) * a3[2]; hv[3] = silu_fast(a1[3]) * a3[3];
                        *(uint2*)(HID + (size_t)(u.rowbase + rl) * 512 + u.pn * 128 + bj * 64 + wc * 16 + 4 * fq) = pack4(hv); } } }
    }
};
struct EpiMoe2 {
    static constexpr bool PERM = true;
    bf16_t* YB;
    __device__ __forceinline__ void operator()(const f32x4 (&acc)[2][2][4][2], const pg8::Unit& u, int wr, int wc, int fr, int fq) const {
#pragma unroll
        for (int ai = 0; ai < 2; ++ai)
#pragma unroll
            for (int m = 0; m < 4; ++m) { const int rl = ai * 128 + wr * 64 + m * 16 + fr;
                if (rl < u.mvalid) {
#pragma unroll
                    for (int bj = 0; bj < 2; ++bj) { const uint2 lo = pack4(acc[ai][bj][m][0]), hi = pack4(acc[ai][bj][m][1]);
                        *(uint4*)(YB + (size_t)(u.rowbase + rl) * 1024 + u.pn * 256 + bj * 128 + wc * 32 + 8 * fq) = make_uint4(lo.x, lo.y, hi.x, hi.y); } } }
    }
};

PHASE_FN void ph_moe(const Params& p, int layer, int which, float* smem) {
    KParams* pp = kparams();
    GU8* wsg_ = (GU8*)pp->ws; asm volatile("" : "+s"(wsg_)); unsigned char* ws_ = (unsigned char*)wsg_;
    int ldz_ = 0; asm volatile("" : "+s"(ldz_));
    int tid_ = threadIdx.x; asm volatile("" : "+v"(tid_)); const int tid = tid_;
    int* sPad = (int*)(g_smem + ldz_ + 131072); int* sTs = sPad + 40;
    const int* CNT = (const int*)(ws_ + OFF_CNT) + layer * 32 * CSTR;
    __syncthreads();
    if (tid == 0) { int a = 0, ts = 0; for (int e = 0; e < 32; ++e) { sPad[e] = a; sTs[e] = ts; a += ((CNT[e * CSTR] + 127) / 128) * 128; ts += (CNT[e * CSTR] + 255) / 256; } sTs[32] = ts; sPad[32] = a; }
    __syncthreads();
    MoeOrder S; S.sTs = sTs; S.sPad = sPad; S.CNT = CNT; S.LIST = (const int*)(ws_ + OFF_LIST); S.G = gridDim.x; S.which = which; S.K = which ? 512 : 1024;
    S.c = (((int)gridDim.x & 7) == 0) ? (((int)blockIdx.x & 7) * ((int)gridDim.x >> 3) + ((int)blockIdx.x >> 3)) : (int)blockIdx.x;
    if (which == 0) {
        EpiMoe1 E; E.HID = (bf16_t*)(ws_ + OFF_HID);
        pg8::gemm_phase<EpiMoe1, MoeOrder, true>((LAS unsigned char*)(g_smem + ldz_), (const bf16_t*)(ws_ + OFF_H), (const bf16_t*)(ws_ + OFF_W13), 1024, S, E);
    } else {
        EpiMoe2 E; E.YB = (bf16_t*)(ws_ + OFF_YB);
        pg8::gemm_phase<EpiMoe2, MoeOrder, false>((LAS unsigned char*)(g_smem + ldz_), (const bf16_t*)(ws_ + OFF_HID), (const bf16_t*)(ws_ + OFF_W2T), 512, S, E);
    }
    __syncthreads();
}

PHASE_FN void ph_conv_dense(const Params& p, float* smem) {
    KParams* pp = kparams();
    GU8* wsg_ = (GU8*)pp->ws; asm volatile("" : "+s"(wsg_)); unsigned char* ws_ = (unsigned char*)wsg_;
    { int ldz_ = 0; asm volatile("" : "+s"(ldz_)); smem = (float*)(g_smem + ldz_); }
    auto dec = [&](int t, const float*& s0, const float*& s1, bf16_t*& dst, int& mode, int& K, int& N, int& ld, int& rt, int& kt) {
        s1 = nullptr; mode = 0; K = 1024;
        if (t >= 4672) t = 4671;
        if (t >= 4608) { const int v = t - 4608, l = v >> 5, u = v & 31; s0 = as_global(pp->gla_w_in) + (size_t)l * 1024 * 3088 + 3072; N = 16; ld = 3088; dst = (bf16_t*)(ws_ + OFF_WGL) + (size_t)l * 128 * 1024; rt = u >> 4; kt = u & 15; }
        else if (t < 2048) { const int l = t >> 10, u = t & 1023; s0 = as_global(pp->even_w_in) + (size_t)l * 1024 * 3916; N = 3916; ld = 3916; dst = (bf16_t*)(ws_ + OFF_WINE) + (size_t)l * 4096 * 1024; rt = u >> 4; kt = u & 15; }
        else if (t < 3584) { const int v = t - 2048, l = v / 768, u = v % 768; s0 = as_global(pp->gla_w_in) + (size_t)l * 1024 * 3088; N = 3072; ld = 3088; dst = (bf16_t*)(ws_ + OFF_WINO) + (size_t)l * 3072 * 1024; rt = u >> 4; kt = u & 15; }
        else { const int v = t - 3584, l = v >> 8, u = v & 255; s0 = ((l & 1) ? as_global(pp->gla_w_out) : as_global(pp->even_w_out)) + (size_t)(l >> 1) * 1024 * 1024; N = 1024; ld = 1024; dst = (bf16_t*)(ws_ + OFF_WOUT) + (size_t)l * 1024 * 1024; rt = u >> 4; kt = u & 15; }
    };
    convert_stream(dec, blockIdx.x * 4, gridDim.x * 4, 4672, smem);
}

PHASE_FN void ph_conv_exp(const Params& p, int layer, float* smem, int first_blk) {
    KParams* pp = kparams();
    GU8* wsg_ = (GU8*)pp->ws; asm volatile("" : "+s"(wsg_)); unsigned char* ws_ = (unsigned char*)wsg_;
    { int ldz_ = 0; asm volatile("" : "+s"(ldz_)); smem = (float*)(g_smem + ldz_); }
    if ((int)blockIdx.x < first_blk) return;
    auto dec = [&](int t, const float*& s0, const float*& s1, bf16_t*& dst, int& mode, int& K, int& N, int& ld, int& rt, int& kt) {
        if (t >= 12288) t = 12287;
        if (t < 8192) { const int e = t >> 8, u = t & 255; s0 = as_global(pp->w1) + (size_t)(layer * 32 + e) * 1024 * 512; s1 = as_global(pp->w3) + (size_t)(layer * 32 + e) * 1024 * 512; mode = 1; K = 1024; N = 512; ld = 512;
            dst = (bf16_t*)(ws_ + OFF_W13) + (size_t)e * 1024 * 1024; rt = u >> 4; kt = u & 15; }
        else { const int v = t - 8192, e = v >> 7, u = v & 127; s0 = as_global(pp->w2) + (size_t)(layer * 32 + e) * 512 * 1024; s1 = nullptr; mode = 0; K = 512; N = 1024; ld = 1024;
            dst = (bf16_t*)(ws_ + OFF_W2T) + (size_t)e * 1024 * 512; rt = u >> 3; kt = u & 7; }
    };
    convert_stream(dec, ((int)blockIdx.x - first_blk) * 4, ((int)gridDim.x - first_blk) * 4, 12288, smem);
}

PHASE_FN void ph_gla_tok(const Params& p, int layer) {
    KParams* pp = kparams();
    GU8* wsg_ = (GU8*)pp->ws; asm volatile("" : "+s"(wsg_)); unsigned char* ws_ = (unsigned char*)wsg_;
    int tid_ = threadIdx.x; asm volatile("" : "+v"(tid_)); const int tid = tid_, lane = tid & 63, wv = tid >> 6, li = layer >> 1;
    const float* AUX = (const float*)(ws_ + OFF_AUX);
    float* LA = (float*)(ws_ + OFF_LA);
    const float* w2 = as_global(pp->gla_w_gate2) + (size_t)li * 16 * 512; const float* b2 = as_global(pp->gla_b_gate2) + li * 512;
    for (int t = blockIdx.x * 8 + wv; t < NT; t += gridDim.x * 8) {
        float glr[16];
#pragma unroll
        for (int r = 0; r < 16; ++r) glr[r] = AUX[(size_t)t * 16 + r];
#pragma unroll 1
        for (int i = 0; i < 8; ++i) {
            const int c = lane + 64 * i; float z = b2[c];
#pragma unroll
            for (int r = 0; r < 16; ++r) z += glr[r] * w2[r * 512 + c];
            LA[(size_t)t * 512 + c] = -softplusf_(-z) * (1.f / 16.f);
        }
    }
}

PHASE_FN void ph_gla_chunk(const Params& p, int layer, float* smem) {
    KParams* pp = kparams();
    GU8* wsg_ = (GU8*)pp->ws; asm volatile("" : "+s"(wsg_)); unsigned char* ws_ = (unsigned char*)wsg_;
    int tid_ = threadIdx.x; asm volatile("" : "+v"(tid_)); const int tid = tid_, lane = tid & 63, wv = __builtin_amdgcn_readfirstlane(tid >> 6), q4 = lane >> 4, c16 = lane & 15;
    int ldz_ = 0; asm volatile("" : "+s"(ldz_)); unsigned char* lds = g_smem + ldz_;
    constexpr int SN = 272, ST = 144;
    float* sBc = (float*)lds;
    unsigned char* bQE = lds + 33024;
    unsigned char* bKE = lds + 50432;
    unsigned char* bKD = lds + 67840;
    unsigned char* bVT = lds + 86272;
    unsigned char* bATT = lds + 123136;
    const bf16_t* P = (const bf16_t*)(ws_ + OFF_P); const float* AUX = (const float*)(ws_ + OFF_AUX);
    const float* w2 = as_global(pp->gla_w_gate2) + (size_t)(layer >> 1) * 16 * 512; const float* b2 = as_global(pp->gla_b_gate2) + (layer >> 1) * 512;
    float* sGlr = (float*)(lds + 132352);
    uint4* QEF = (uint4*)(ws_ + OFF_GQE); uint2* OIF = (uint2*)(ws_ + OFF_GOI); uint2* HF = (uint2*)(ws_ + OFF_GH); float* EBL = (float*)(ws_ + OFF_GEBL);
    for (int ci = blockIdx.x; ci < 1024; ci += gridDim.x) {
        const int b = ci >> 9, h = (ci >> 7) & 3, n = ci & 127;
        const int t0 = b * 8192 + n * 64;
        __syncthreads();
        for (int e = tid; e < 1024; e += NTHREADS) sGlr[e] = AUX[(size_t)(t0 + (e >> 4)) * 16 + (e & 15)];
        __syncthreads();
        {
            const int d = tid & 127, c = h * 128 + d;
            float wg[16];
#pragma unroll
            for (int r = 0; r < 16; ++r) wg[r] = w2[r * 512 + c];
            const float bz = b2[c];
            for (int i = tid >> 7; i < 64; i += 4) {
                float z = bz;
#pragma unroll
                for (int r = 0; r < 16; ++r) z += sGlr[i * 16 + r] * wg[r];
                sBc[i * 129 + d] = -softplusf_(-z) * (1.f / 16.f);
            }
        }
        for (int e = tid; e < 64 * 36; e += NTHREADS) ((unsigned*)bATT)[e] = 0u;
        __syncthreads();
        if (tid < 128) { float a = 0.f; for (int i = 0; i < 64; ++i) { a += sBc[i * 129 + tid]; sBc[i * 129 + tid] = a; } }
        __syncthreads();
        {
            const int d = tid & 127, ig = tid >> 7;
            const float bl = sBc[63 * 129 + d];
#pragma unroll
            for (int gg = 0; gg < 2; ++gg) { const int g = ig + 4 * gg;
                float kd8[8];
#pragma unroll
                for (int r = 0; r < 8; ++r) { const int i = g * 8 + r;
                    const float bb = sBc[i * 129 + d];
                    const float qf = PBF(P, t0 + i, h * 128 + d), kf = PBF(P, t0 + i, 512 + h * 128 + d);
                    *(bf16_t*)(bQE + i * SN + d * 2) = f2bf(qf * SCALE128 * expf(bb));
                    *(bf16_t*)(bKE + i * SN + d * 2) = f2bf(kf * expf(-bb));
                    kd8[r] = kf * expf(bl - bb); }
                *(uint4*)(bKD + d * ST + g * 16) = make_uint4(cvt_pk_bf16(kd8[0], kd8[1]), cvt_pk_bf16(kd8[2], kd8[3]), cvt_pk_bf16(kd8[4], kd8[5]), cvt_pk_bf16(kd8[6], kd8[7]));
            }
            const int dv = tid & 255, hf = tid >> 8;
#pragma unroll
            for (int gg = 0; gg < 4; ++gg) { const int g = hf * 4 + gg;
                unsigned short v8[8];
#pragma unroll
                for (int r = 0; r < 8; ++r) v8[r] = P[(size_t)(t0 + g * 8 + r) * LDPB + 1024 + h * 256 + dv];
                *(uint4*)(bVT + dv * ST + g * 16) = make_uint4((unsigned)v8[0] | ((unsigned)v8[1] << 16), (unsigned)v8[2] | ((unsigned)v8[3] << 16), (unsigned)v8[4] | ((unsigned)v8[5] << 16), (unsigned)v8[6] | ((unsigned)v8[7] << 16));
            }
        }
        if (tid < 128) EBL[ci * 128 + tid] = expf(sBc[63 * 129 + tid]);
        __syncthreads();
        for (int u = wv; u < 10; u += 8) {
            const int ti = (u >= 6) ? 3 : (u >= 3) ? 2 : (u >= 1) ? 1 : 0, tj = u - ((ti * (ti + 1)) >> 1);
            f32x4 acc = (f32x4){0.f, 0.f, 0.f, 0.f};
            acc = mma_lds(bQE, SN, 16 * ti, bKE, SN, 16 * tj, 128, acc, c16, q4);
            const int j = 16 * tj + c16;
#pragma unroll
            for (int r = 0; r < 4; ++r) { const int i = 16 * ti + 4 * q4 + r; *(bf16_t*)(bATT + i * ST + j * 2) = f2bf((j <= i) ? acc[r] : 0.f); }
        }
        for (int x = 0; x < 2; ++x) {
            const int u = wv * 2 + x, ti = u >> 2, a = u & 3;
            const unsigned char* rp = bQE + (16 * ti + c16) * SN;
            const uint2 lo = *(const uint2*)(rp + (32 * a + 4 * q4) * 2), hi = *(const uint2*)(rp + (32 * a + 16 + 4 * q4) * 2);
            QEF[((size_t)(ci * 4 + ti) * 4 + a) * 64 + lane] = make_uint4(lo.x, lo.y, hi.x, hi.y);
        }
        __syncthreads();
#pragma unroll 4
        for (int x = 0; x < 8; ++x) {
            const int u = wv * 8 + x, tdv = u >> 2, ti = u & 3;
            f32x4 acc = (f32x4){0.f, 0.f, 0.f, 0.f};
            acc = mma_lds(bATT, ST, 16 * ti, bVT, ST, 16 * tdv, 64, acc, c16, q4);
            OIF[((size_t)(ci * 16 + tdv) * 4 + ti) * 64 + lane] = pack4(acc);
        }
#pragma unroll 4
        for (int x = 0; x < 16; ++x) {
            const int u = wv * 16 + x, tdv = u >> 3, tdk = u & 7;
            f32x4 acc = (f32x4){0.f, 0.f, 0.f, 0.f};
            acc = mma_lds(bKD, ST, 16 * tdk, bVT, ST, 16 * tdv, 64, acc, c16, q4);
            HF[((size_t)(ci * 16 + tdv) * 8 + tdk) * 64 + lane] = pack4(acc);
        }
    }
}

PHASE_FN void ph_gla_scan(const Params& p, float* smem) {
    KParams* pp = kparams();
    GU8* wsg_ = (GU8*)pp->ws; asm volatile("" : "+s"(wsg_)); unsigned char* ws_ = (unsigned char*)wsg_;
    int tid_ = threadIdx.x; asm volatile("" : "+v"(tid_)); const int tid = tid_, lane = tid & 63, wv = __builtin_amdgcn_readfirstlane(tid >> 6), q4 = lane >> 4, c16 = lane & 15;
    int ldz_ = 0; asm volatile("" : "+s"(ldz_)); unsigned char* lds = g_smem + ldz_;
    constexpr int STG = 29184;
    const unsigned char* QEF = ws_ + OFF_GQE; const unsigned char* HF = ws_ + OFF_GH; const unsigned char* OIF = ws_ + OFF_GOI; const unsigned char* EBL = ws_ + OFF_GEBL;
    float* O = (float*)(ws_ + OFF_O);
    for (int it = blockIdx.x; it < 64; it += gridDim.x) {
        const int bh = it >> 3, pair = it & 7, b = bh >> 2, h = bh & 3;
        __syncthreads();
        if (wv >= 2) {
            const int lt = tid - 128;
            const unsigned char* Qb = QEF + (size_t)bh * 128 * 16384;
            const unsigned char* Hb = HF + (size_t)bh * 128 * 65536 + pair * 8192;
            const unsigned char* Ob = OIF + (size_t)bh * 128 * 32768 + pair * 4096;
            const unsigned char* Lb = EBL + (size_t)bh * 128 * 512;
            uint4 ra0, ra1, ra2, ra3, ra4, ra5, ra6, rb0, rb1, rb2, rb3, rb4, rb5, rb6, rc0, rc1, rc2, rc3, rc4, rc5, rc6, rd0, rd1, rd2, rd3, rd4, rd5, rd6;
#define GL_LOAD(X, n_) do { const unsigned char* q_ = Qb + (size_t)(n_) * 16384; const unsigned char* h_ = Hb + (size_t)(n_) * 65536; \
                const unsigned char* o_ = Ob + (size_t)(n_) * 32768; const unsigned char* l_ = Lb + (size_t)(n_) * 512; \
                X##0 = LDC(q_, lt, 1023); X##1 = LDC(q_, lt + 384, 1023); X##2 = LDC(q_, lt + 768, 1023); \
                X##3 = LDC(h_, lt, 511); X##4 = LDC(h_, lt + 384, 511); X##5 = LDC(o_, lt, 255); X##6 = LDC(l_, lt, 31); } while (0)
#define GL_STORE(X, st_) do { unsigned char* sb_ = lds + (st_) * STG; \
                STC(0, lt, 1024, X##0); STC(0, lt + 384, 1024, X##1); STC(0, lt + 768, 1024, X##2); \
                STC(16384, lt, 512, X##3); STC(16384, lt + 384, 512, X##4); STC(24576, lt, 256, X##5); STC(28672, lt, 32, X##6); } while (0)
            GL_LOAD(ra, 0); GL_STORE(ra, 0);
            GL_LOAD(rb, 1); GL_LOAD(rc, 2); GL_LOAD(rd, 3); GL_LOAD(ra, 4);
            __syncthreads();
            for (int n = 0; n < 128; n += 4) {
                GL_STORE(rb, 1); GL_LOAD(rb, CLAMPN(n + 5)); LBAR();
                GL_STORE(rc, 0); GL_LOAD(rc, CLAMPN(n + 6)); LBAR();
                GL_STORE(rd, 1); GL_LOAD(rd, CLAMPN(n + 7)); LBAR();
                if (n + 4 < 128) GL_STORE(ra, 0);
                GL_LOAD(ra, CLAMPN(n + 8)); LBAR();
            }
        } else {
            const int tdv = pair * 2 + wv;
            f32x4 S[8];
#pragma unroll
            for (int t = 0; t < 8; ++t) S[t] = (f32x4){0.f, 0.f, 0.f, 0.f};
            __syncthreads();
            for (int n = 0; n < 128; ++n) {
                const unsigned char* base = lds + (n & 1) * STG;
                const unsigned char* Qf = base + lane * 16, *Hf = base + 16384 + wv * 4096 + lane * 8, *Of = base + 24576 + wv * 2048 + lane * 8, *Lf = base + 28672 + q4 * 16;
                bf16x8 Sb[4];
#pragma unroll
                for (int a = 0; a < 4; ++a) { union { uint4 u; bf16x8 v; } cv; const uint2 lo = pack4(S[2 * a]), hi = pack4(S[2 * a + 1]); cv.u.x = lo.x; cv.u.y = lo.y; cv.u.z = hi.x; cv.u.w = hi.y; Sb[a] = cv.v; }
                const int t0 = b * 8192 + n * 64;
                f32x4 oa[4];
                uint2 o4[4];
#pragma unroll
                for (int ti = 0; ti < 4; ++ti) o4[ti] = *(const uint2*)(Of + ti * 512);
#pragma unroll
                for (int hf = 0; hf < 2; ++hf) {
                    bf16x8 qf[8];
#pragma unroll
                    for (int tt = 0; tt < 2; ++tt)
#pragma unroll
                        for (int a = 0; a < 4; ++a) qf[tt * 4 + a] = *(const bf16x8*)(Qf + ((hf * 2 + tt) * 4 + a) * 1024);
                    asm volatile("" : "+v"(qf[0]), "+v"(qf[1]), "+v"(qf[2]), "+v"(qf[3]), "+v"(qf[4]), "+v"(qf[5]), "+v"(qf[6]), "+v"(qf[7]));
                    oa[hf * 2] = unpack4(o4[hf * 2]); oa[hf * 2 + 1] = unpack4(o4[hf * 2 + 1]);
#pragma unroll
                    for (int a = 0; a < 4; ++a)
#pragma unroll
                        for (int tt = 0; tt < 2; ++tt) oa[hf * 2 + tt] = __builtin_amdgcn_mfma_f32_16x16x32_bf16(qf[tt * 4 + a], Sb[a], oa[hf * 2 + tt], 0, 0, 0);
                }
                {
                    f32x4 lam[8]; uint2 h8[8];
#pragma unroll
                    for (int t = 0; t < 8; ++t) { lam[t] = *(const f32x4*)(Lf + t * 64); h8[t] = *(const uint2*)(Hf + t * 512); }
                    asm volatile("" : "+v"(lam[0]), "+v"(lam[1]), "+v"(lam[2]), "+v"(lam[3]), "+v"(lam[4]), "+v"(lam[5]), "+v"(lam[6]), "+v"(lam[7]));
#pragma unroll
                    for (int ti = 0; ti < 4; ++ti) {
                        float* op = O + (size_t)(t0 + 16 * ti + 4 * q4) * 1024 + h * 256 + 16 * tdv + c16;
                        op[0] = oa[ti][0]; op[1024] = oa[ti][1]; op[2048] = oa[ti][2]; op[3072] = oa[ti][3]; }
#pragma unroll
                    for (int t = 0; t < 8; ++t) S[t] = S[t] * lam[t] + unpack4(h8[t]);
                }
                LBAR();
            }
        }
    }
}

PHASE_FN void ph_gla_out(const Params& p, int layer) {
    KParams* pp = kparams();
    GU8* wsg_ = (GU8*)pp->ws; asm volatile("" : "+s"(wsg_)); unsigned char* ws_ = (unsigned char*)wsg_;
    int tid_ = threadIdx.x; asm volatile("" : "+v"(tid_)); const int tid = tid_, lane = tid & 63, wv = tid >> 6;
    const float* O = (const float*)(ws_ + OFF_O); const bf16_t* P = (const bf16_t*)(ws_ + OFF_P); bf16_t* OB = (bf16_t*)(ws_ + OFF_OB);
    const float* onw = as_global(pp->gla_out_norm) + (layer >> 1) * 256;
    for (int t = blockIdx.x * 8 + wv; t < NT; t += gridDim.x * 8) {
#pragma unroll
        for (int h = 0; h < 4; ++h) {
            const float* op = O + (size_t)t * 1024 + h * 256;
            const float4 o = *(const float4*)(op + lane * 4);
            const float ss = wave_sum(o.x * o.x + o.y * o.y + o.z * o.z + o.w * o.w);
            const float r = rsqrtf(ss * (1.f / 256.f) + EPS);
            const f32x4 z = unpack4(*(const uint2*)(P + (size_t)t * LDPB + 2048 + h * 256 + lane * 4));
            const float4 w = *(const float4*)(onw + lane * 4);
            f32x4 ov; ov[0] = o.x * r * w.x * siluf_(z[0]); ov[1] = o.y * r * w.y * siluf_(z[1]); ov[2] = o.z * r * w.z * siluf_(z[2]); ov[3] = o.w * r * w.w * siluf_(z[3]);
            *(uint2*)(OB + (size_t)t * 1024 + h * 256 + lane * 4) = pack4(ov);
        }
    }
}

template <int PH>
__device__ __forceinline__ void run_phase(const Params& p, int layer, float* smem) {
    if (PH == PH_PROLOGUE) { ph_prologue(p, smem); ph_conv_dense(p, smem); }
    else if (PH == PH_NORM_MIX) ph_rows(p, layer, 0, smem);
    else if (PH == PH_GEMM_IN_EVEN) ph_gemm_in(p, layer, true, smem);
    else if (PH == PH_EVEN_TOK) { ph_even_tok(p, layer, smem); ph_gdn_chunk(p, layer, smem); if (DUP_MASK & 8192) ph_gdn_chunk(p, layer, smem); if (DUP_MASK & 16384) ph_even_tok(p, layer, smem); }
    else if (PH == PH_GDN_CHUNK) ph_gdn_chunk(p, layer, smem);
    else if (PH == PH_GDN_SCAN) { ph_gdn_scan(p, smem); ph_conv_exp(p, layer, smem, 32); ph_dsa_topk(p, layer, smem); }
    else if (PH == PH_DSA_TOPK) ph_dsa_topk(p, layer, smem);
    else if (PH == PH_DSA_ATTN) { ph_dsa_attn(p, smem); ph_gdn_out(p, layer); if (DUP_MASK & 32768) ph_dsa_attn(p, smem); }
    else if (PH == PH_GDN_OUT) ph_gdn_out(p, layer);
    else if (PH == PH_GEMM_OUT) ph_gemm_out(p, layer, smem);
    else if (PH == PH_NORM_FFN) ph_norm_ffn(p, layer);
    else if (PH == PH_MOE1) ph_moe(p, layer, 0, smem);
    else if (PH == PH_MOE2) ph_moe(p, layer, 1, smem);
    else if (PH == PH_GEMM_IN_ODD) ph_gemm_in(p, layer, false, smem);
    else if (PH == PH_GLA_TOK) ph_gla_tok(p, layer);
    else if (PH == PH_GLA_CHUNK) ph_gla_chunk(p, layer, smem);
    else if (PH == PH_GLA_SCAN) { ph_gla_scan(p, smem); ph_conv_exp(p, layer, smem, 64); if (DUP_MASK & 65536) ph_gla_scan(p, smem); if (DUP_MASK & 131072) ph_conv_exp(p, layer, smem, 64); }
    else if (PH == PH_GLA_OUT) ph_gla_out(p, layer);
    else if (PH == PH_FINAL) ph_rows(p, 0, 1, smem);
}

#if MK_MULTI
template <int PH>
__global__ void __launch_bounds__(NTHREADS, 2) k_phase(Params p, int layer) {
    run_phase<PH>(p, layer, (float*)g_smem);
}
#else
__global__ void __launch_bounds__(NTHREADS, 2) k_mega(Params p) {
    float* smem = (float*)g_smem;
    volatile LAS unsigned* xbw = (volatile LAS unsigned*)(LAS unsigned char*)(g_smem + LDS_BYTES - 16);
    if (threadIdx.x == 0) { xbw[0] = 0u; xbw[1] = 0u; xbw[2] = 0u; xbw[3] = 0u; }
    __syncthreads();
    XcdBarrier bar = xcd_barrier_post((unsigned*)(p.ws + OFF_BAR), xbw);
#define BAR() do { XcdBarrier bb_ = bar; asm volatile("" : "+s"(bb_.x)); { __attribute__((address_space(1))) unsigned* gb_ = (__attribute__((address_space(1))) unsigned*)bb_.bar; asm volatile("" : "+s"(gb_)); bb_.bar = (unsigned*)gb_; } xcd_barrier(bb_); } while (0)
    run_phase<PH_PROLOGUE>(p, 0, smem); BAR(); if (DUP_MASK & 4096) { run_phase<PH_PROLOGUE>(p, 0, smem); BAR(); }
    for (int lp = 0; lp < 2; ++lp) {
        const int le = 2 * lp, lo = 2 * lp + 1;
        run_phase<PH_NORM_MIX>(p, le, smem); BAR();
        run_phase<PH_GEMM_IN_EVEN>(p, le, smem); BAR(); if (DUP_MASK & 1) { run_phase<PH_GEMM_IN_EVEN>(p, le, smem); BAR(); }
        run_phase<PH_EVEN_TOK>(p, le, smem); BAR(); if (DUP_MASK & 2) { run_phase<PH_EVEN_TOK>(p, le, smem); BAR(); }
        run_phase<PH_GDN_SCAN>(p, le, smem); BAR(); if (DUP_MASK & 8) { run_phase<PH_GDN_SCAN>(p, le, smem); BAR(); }
        run_phase<PH_DSA_ATTN>(p, le, smem); BAR(); if (DUP_MASK & 32) { run_phase<PH_DSA_ATTN>(p, le, smem); BAR(); }
        run_phase<PH_GEMM_OUT>(p, le, smem); BAR();
        run_phase<PH_NORM_FFN>(p, le, smem); BAR();
        run_phase<PH_MOE1>(p, le, smem); BAR(); if (DUP_MASK & 64) { run_phase<PH_MOE1>(p, le, smem); BAR(); }
        run_phase<PH_MOE2>(p, le, smem); BAR(); if (DUP_MASK & 128) { run_phase<PH_MOE2>(p, le, smem); BAR(); }
        run_phase<PH_NORM_MIX>(p, lo, smem); BAR();
        run_phase<PH_GEMM_IN_ODD>(p, lo, smem); BAR(); if (DUP_MASK & 256) { run_phase<PH_GEMM_IN_ODD>(p, lo, smem); BAR(); }
        run_phase<PH_GLA_CHUNK>(p, lo, smem); BAR(); if (DUP_MASK & 1024) { run_phase<PH_GLA_CHUNK>(p, lo, smem); BAR(); }
        run_phase<PH_GLA_SCAN>(p, lo, smem); BAR(); if (DUP_MASK & 2048) { run_phase<PH_GLA_SCAN>(p, lo, smem); BAR(); }
        run_phase<PH_GLA_OUT>(p, lo, smem); BAR();
        run_phase<PH_GEMM_OUT>(p, lo, smem); BAR();
        run_phase<PH_NORM_FFN>(p, lo, smem); BAR();
        run_phase<PH_MOE1>(p, lo, smem); BAR(); if (DUP_MASK & 64) { run_phase<PH_MOE1>(p, lo, smem); BAR(); }
        run_phase<PH_MOE2>(p, lo, smem); BAR(); if (DUP_MASK & 128) { run_phase<PH_MOE2>(p, lo, smem); BAR(); }
    }
    for (int xb = 0; xb < EXTRA_BARS; ++xb) BAR();
    run_phase<PH_FINAL>(p, 0, smem);
}
#endif

}

#if MK_MULTI
template <int PH>
static void launch_phase(const Params& p, int layer, hipStream_t stream) {
    static bool attr_set = false;
    if (!attr_set) { hipFuncSetAttribute((const void*)k_phase<PH>, hipFuncAttributeMaxDynamicSharedMemorySize, (int)LDS_BYTES); attr_set = true; }
    hipLaunchKernelGGL((k_phase<PH>), dim3(256), dim3(NTHREADS), LDS_BYTES, stream, p, layer);
}
#endif

extern "C" void kernel_launch(void* const* d_in, const int* in_sizes, int n_in, void* d_out, int out_size, void* d_ws, size_t ws_size, hipStream_t stream) {
    (void)in_sizes; (void)n_in; (void)out_size;
    if (ws_size < WS_NEEDED) { fprintf(stderr, "workspace too small: %zu < %zu\n", ws_size, (size_t)WS_NEEDED); return; }
    Params p{};
    p.x = (const float*)d_in[0]; p.c = (const float*)d_in[1]; p.pos = (const int*)d_in[2]; p.ada_w = (const float*)d_in[3]; p.ada_b = (const float*)d_in[4];
    p.norm_mix = (const float*)d_in[5]; p.norm_ffn = (const float*)d_in[6]; p.even_w_in = (const float*)d_in[7]; p.conv_w = (const float*)d_in[8];
    p.a_log = (const float*)d_in[9]; p.dt_bias = (const float*)d_in[10]; p.gdn_out_norm = (const float*)d_in[11]; p.even_w_out = (const float*)d_in[12];
    p.gla_w_in = (const float*)d_in[13]; p.gla_w_gate2 = (const float*)d_in[14]; p.gla_b_gate2 = (const float*)d_in[15]; p.gla_out_norm = (const float*)d_in[16]; p.gla_w_out = (const float*)d_in[17];
    p.rg_w = (const float*)d_in[18]; p.rg_b = (const float*)d_in[19]; p.re_w = (const float*)d_in[20]; p.re_b = (const float*)d_in[21];
    p.w1 = (const float*)d_in[22]; p.w3 = (const float*)d_in[23]; p.w2 = (const float*)d_in[24]; p.final_norm = (const float*)d_in[25];
    p.X = (float*)d_out; p.ws = (unsigned char*)d_ws;
    p.rA = pow(10000.0, -2.0 / 128.0); p.rI = pow(10000.0, -2.0 / 64.0);
    hipMemsetAsync(d_ws, 0, ZERO_BYTES, stream);
#if MK_MULTI
    launch_phase<PH_PROLOGUE>(p, 0, stream);
    for (int lp = 0; lp < 2; ++lp) {
        const int le = 2 * lp, lo = 2 * lp + 1;
        launch_phase<PH_NORM_MIX>(p, le, stream);
        launch_phase<PH_GEMM_IN_EVEN>(p, le, stream);
        launch_phase<PH_EVEN_TOK>(p, le, stream);
        launch_phase<PH_GDN_SCAN>(p, le, stream);
        launch_phase<PH_DSA_ATTN>(p, le, stream);
        launch_phase<PH_GEMM_OUT>(p, le, stream);
        launch_phase<PH_NORM_FFN>(p, le, stream);
        launch_phase<PH_MOE1>(p, le, stream);
        launch_phase<PH_MOE2>(p, le, stream);
        launch_phase<PH_NORM_MIX>(p, lo, stream);
        launch_phase<PH_GEMM_IN_ODD>(p, lo, stream);
        launch_phase<PH_GLA_CHUNK>(p, lo, stream);
        launch_phase<PH_GLA_SCAN>(p, lo, stream);
        launch_phase<PH_GLA_OUT>(p, lo, stream);
        launch_phase<PH_GEMM_OUT>(p, lo, stream);
        launch_phase<PH_NORM_FFN>(p, lo, stream);
        launch_phase<PH_MOE1>(p, lo, stream);
        launch_phase<PH_MOE2>(p, lo, stream);
    }
    launch_phase<PH_FINAL>(p, 0, stream);
#else
    static int grid = 0;
    if (!grid) {
        int dev = 0, cus = 0, per_cu = 0;
        hipGetDevice(&dev);
        hipDeviceGetAttribute(&cus, hipDeviceAttributeMultiprocessorCount, dev);
        hipFuncSetAttribute((const void*)k_mega, hipFuncAttributeMaxDynamicSharedMemorySize, (int)LDS_BYTES);
        hipOccupancyMaxActiveBlocksPerMultiprocessor(&per_cu, k_mega, NTHREADS, LDS_BYTES);
        if (cus <= 0) cus = 256;
        grid = cus * (per_cu < 1 ? 1 : 1);
    }
    hipLaunchKernelGGL(k_mega, dim3(grid), dim3(NTHREADS), LDS_BYTES, stream, p);
#endif
}
```

```cpp
#include <hip/hip_runtime.h>
#include <stdint.h>
#include <math.h>
#include <stdio.h>

#define EXTRA_BARS 0
#define REP_A 1
#ifndef REP_Q
#define REP_Q 1
#endif
#ifndef REP_S
#define REP_S 1
#endif
#ifndef REP_T
#define REP_T 1
#endif
#ifndef REP_E
#define REP_E 1
#endif
#define REP_B 1
#define REP_C 1
#ifndef DUP_MASK
#define DUP_MASK 0
#endif
#ifndef MK_MULTI
#define MK_MULTI 0
#endif

namespace {

constexpr int NT = 16384, ND = 1024, LDP = 3920, LDPB = 3968;
constexpr float EPS = 1e-6f;
constexpr int NTHREADS = 512;
constexpr size_t LDS_BYTES = 147456;
constexpr float SCALE128 = 0.08838834764831845f;
constexpr int LISTCAP = 32768;
constexpr int CSTR = 16;

constexpr size_t OFF_BAR  = 0;
constexpr size_t OFF_CNT  = 16384;
constexpr size_t ZERO_BYTES = 32768;
constexpr size_t OFF_QCTR = 28672;
constexpr size_t OFF_MOD  = 32768;
constexpr size_t OFF_COSA = OFF_MOD + 4 * 2 * 6144 * 4;
constexpr size_t OFF_SINA = OFF_COSA + (size_t)NT * 64 * 4;
constexpr size_t OFF_COSI = OFF_SINA + (size_t)NT * 64 * 4;
constexpr size_t OFF_SINI = OFF_COSI + (size_t)NT * 32 * 4;
constexpr size_t OFF_H    = OFF_SINI + (size_t)NT * 32 * 4;
constexpr size_t OFF_P    = OFF_H + (size_t)NT * 1024 * 4;
constexpr size_t OFF_HID  = OFF_P;
constexpr size_t OFF_YB   = OFF_HID + (size_t)36864 * 512 * 4;
constexpr size_t OFF_O    = OFF_P + (size_t)NT * LDP * 4;
constexpr size_t OFF_ASG  = OFF_O + (size_t)NT * 1024 * 4;
constexpr size_t OFF_GATE = OFF_ASG + (size_t)NT * 4 * 4;
constexpr size_t OFF_LIST = OFF_GATE + (size_t)NT * 2 * 4;
constexpr size_t OFF_R    = OFF_LIST + (size_t)32 * LISTCAP * 4;
constexpr size_t OFF_QN   = OFF_R;
constexpr size_t OFF_KN   = OFF_QN + (size_t)NT * 512 * 4;
constexpr size_t OFF_VC   = OFF_KN + (size_t)NT * 512 * 4;
constexpr size_t OFF_BETA = OFF_VC + (size_t)NT * 512 * 4;
constexpr size_t OFF_G    = OFF_BETA + (size_t)NT * 4 * 4;
constexpr size_t OFF_W    = OFF_G + (size_t)NT * 4 * 4;
constexpr size_t OFF_U    = OFF_W + (size_t)1024 * 8192 * 4;
constexpr size_t OFF_QG   = OFF_U + (size_t)1024 * 8192 * 4;
constexpr size_t OFF_KD   = OFF_QG + (size_t)1024 * 8192 * 4;
constexpr size_t OFF_AQK  = OFF_KD + (size_t)1024 * 8192 * 4;
constexpr size_t OFF_GL   = OFF_AQK + (size_t)1024 * 4096 * 4;
constexpr size_t OFF_QB   = OFF_GL + 4096;
constexpr size_t OFF_KB   = OFF_QB + (size_t)NT * 512 * 4;
constexpr size_t OFF_QI   = OFF_KB + (size_t)NT * 512 * 4;
constexpr size_t OFF_KI   = OFF_QI + (size_t)NT * 256 * 4;
constexpr size_t OFF_WI   = OFF_KI + (size_t)NT * 64 * 4;
constexpr size_t OFF_SEL  = OFF_WI + (size_t)NT * 4 * 4;
constexpr size_t OFF_EVEN_END = OFF_SEL + (size_t)NT * 256 * 4;
constexpr size_t OFF_PFR  = OFF_W;
constexpr size_t OFF_RFR  = OFF_PFR + (size_t)1024 * 32768;
constexpr size_t OFF_QFR  = OFF_RFR + (size_t)1024 * 16384;
constexpr size_t OFF_OFR  = OFF_QFR + (size_t)1024 * 32768;
static_assert(OFF_OFR + (size_t)1024 * 16384 <= OFF_GL, "gdn v2 buffers overflow");
constexpr size_t OFF_QBB  = OFF_QB;
constexpr size_t OFF_KBB  = OFF_QBB + (size_t)NT * 512 * 2;
constexpr size_t OFF_VT   = OFF_KBB + (size_t)NT * 512 * 2;
constexpr size_t OFF_QIB  = OFF_VT + (size_t)NT * 512 * 2;
constexpr size_t OFF_KIB  = OFF_QIB + (size_t)NT * 256 * 2;
constexpr size_t OFF_M16  = OFF_KIB + (size_t)NT * 64 * 2;
static_assert(OFF_M16 + (size_t)NT * 512 * 2 <= OFF_WI, "dsa v2 buffers overflow");
constexpr size_t OFF_LA   = OFF_R;
constexpr size_t OFF_ATT  = OFF_LA + (size_t)NT * 512 * 4;
constexpr size_t OFF_QE   = OFF_ATT + (size_t)1024 * 4096 * 4;
constexpr size_t OFF_GKD  = OFF_QE + (size_t)1024 * 8192 * 4;
constexpr size_t OFF_EBL  = OFF_GKD + (size_t)1024 * 8192 * 4;
constexpr size_t OFF_GQE  = OFF_LA + (size_t)NT * 512 * 4;
constexpr size_t OFF_GOI  = OFF_GQE + (size_t)1024 * 16384;
constexpr size_t OFF_GH   = OFF_GOI + (size_t)1024 * 32768;
constexpr size_t OFF_GEBL = OFF_GH + (size_t)1024 * 65536;
static_assert(OFF_GEBL + (size_t)1024 * 512 <= OFF_EVEN_END, "gla v2 buffers overflow");
constexpr size_t OFF_WINE = OFF_EVEN_END;
constexpr size_t OFF_WINO = OFF_WINE + (size_t)2 * 4096 * 1024 * 2;
constexpr size_t OFF_WOUT = OFF_WINO + (size_t)2 * 3200 * 1024 * 2;
constexpr size_t OFF_W13  = OFF_WOUT + (size_t)4 * 1024 * 1024 * 2;
constexpr size_t OFF_W2T  = OFF_W13 + (size_t)32 * 1024 * 1024 * 2;
constexpr size_t OFF_OB   = OFF_W2T + (size_t)32 * 1024 * 512 * 2;
constexpr size_t OFF_AUX  = OFF_OB + (size_t)NT * 1024 * 2;
constexpr size_t OFF_WGL  = OFF_AUX + (size_t)NT * 16 * 4;
constexpr size_t WS_NEEDED = OFF_WGL + (size_t)2 * 128 * 1024 * 2;

struct Params {
    const float* x; const float* c; const int* pos; const float* ada_w; const float* ada_b;
    const float* norm_mix; const float* norm_ffn; const float* even_w_in; const float* conv_w;
    const float* a_log; const float* dt_bias; const float* gdn_out_norm; const float* even_w_out;
    const float* gla_w_in; const float* gla_w_gate2; const float* gla_b_gate2; const float* gla_out_norm; const float* gla_w_out;
    const float* rg_w; const float* rg_b; const float* re_w; const float* re_b;
    const float* w1; const float* w3; const float* w2; const float* final_norm;
    float* X;
    unsigned char* ws;
    double rA, rI;
};

#define XB_TMO      128
#define XB_XCNT(j)  (256  + 64 * (j))
#define XB_XSUB(j)  (1280 + 64 * (j))
#define XB_XGEN(j)  (2304 + 64 * (j))
#define XB_TOP      3328
#define XB_TOPGEN   3392
#define XCD_BAR_WORDS 3456
#define XB_SPIN_CAP (1u << 18)
#define LAS __attribute__((address_space(3)))

__device__ __forceinline__ unsigned xb_ld(unsigned* p)              { return __hip_atomic_load(p, __ATOMIC_RELAXED, __HIP_MEMORY_SCOPE_AGENT); }
__device__ __forceinline__ unsigned xb_add(unsigned* p, unsigned v) { return __hip_atomic_fetch_add(p, v, __ATOMIC_RELAXED, __HIP_MEMORY_SCOPE_AGENT); }
__device__ __forceinline__ unsigned xb_xcc_id() { return (unsigned)__builtin_amdgcn_s_getreg((3 << 11) | 20) & 0xFu; }
#define XB_SPIN(cond, bar) do { unsigned _sp = 0; while (cond) { __builtin_amdgcn_s_sleep(1); \
    if ((++_sp & 255u) == 0u) { if (xb_ld(&(bar)[XB_TMO])) break; if (_sp > XB_SPIN_CAP) { atomicAdd(&(bar)[XB_TMO], 1u); break; } } } } while (0)

struct XcdBarrier { unsigned* bar; unsigned x; volatile LAS unsigned* st; };

__device__ __forceinline__ XcdBarrier xcd_barrier_post(unsigned* bar, volatile LAS unsigned* st) {
    XcdBarrier b; b.bar = bar; b.x = xb_xcc_id(); b.st = st;
    if (threadIdx.x == 0) (void)xb_add(&bar[XB_XCNT(b.x)], 1u);
    return b;
}
__device__ __forceinline__ void xcd_barrier_complete(unsigned* bar, unsigned x, unsigned& nloc, unsigned& nx) {
    const unsigned G = gridDim.x * gridDim.y * gridDim.z;
    unsigned sum, cnt, mine, sp = 0u;
    for (;;) {
        sum = 0u; cnt = 0u; mine = 0u;
#pragma unroll
        for (unsigned j = 0; j < 16; ++j) { const unsigned c = xb_ld(&bar[XB_XCNT(j)]); sum += c; cnt += (c > 0u) ? 1u : 0u; mine = (j == x) ? c : mine; }
        if (sum == G) break;
        __builtin_amdgcn_s_sleep(1);
        if ((++sp & 255u) == 0u) { if (xb_ld(&bar[XB_TMO])) break; if (sp > XB_SPIN_CAP) { atomicAdd(&bar[XB_TMO], 1u); break; } }
    }
    nloc = mine > 0u ? mine : 1u; nx = cnt > 0u ? cnt : 1u;
}
__device__ __forceinline__ void xcd_barrier(const XcdBarrier& b) {
    asm volatile("s_waitcnt vmcnt(0)" ::: "memory");
    __syncthreads();
    if (threadIdx.x == 0) {
        unsigned* bar = b.bar;
        __builtin_amdgcn_s_waitcnt(0);
        unsigned nloc = b.st[0], nx = b.st[1];
        if (nloc == 0u) { xcd_barrier_complete(bar, b.x, nloc, nx); b.st[0] = nloc; b.st[1] = nx; }
        const unsigned old = xb_add(&bar[XB_XSUB(b.x)], 1u);
        const unsigned gen = old / nloc;
        if (old + 1u == (gen + 1u) * nloc) {
            __builtin_amdgcn_fence(__ATOMIC_RELEASE, "agent");
            asm volatile("s_waitcnt vmcnt(0)" ::: "memory");
            const unsigned og = xb_add(&bar[XB_TOP], 1u);
            const unsigned tg = og / nx;
            if (og + 1u == (tg + 1u) * nx) xb_add(&bar[XB_TOPGEN], 1u);
            else XB_SPIN(xb_ld(&bar[XB_TOPGEN]) == tg, bar);
            __builtin_amdgcn_fence(__ATOMIC_ACQUIRE, "agent");
            xb_add(&bar[XB_XGEN(b.x)], 1u);
            asm volatile("s_waitcnt vmcnt(0)" ::: "memory");
        } else {
            XB_SPIN(xb_ld(&bar[XB_XGEN(b.x)]) == gen, bar);
            __builtin_amdgcn_fence(__ATOMIC_ACQUIRE, "agent");
            asm volatile("s_waitcnt vmcnt(0)" ::: "memory");
        }
    }
    __syncthreads();
}

template <class T> __device__ __forceinline__ T* as_global(T* p) { return (T*)(__attribute__((address_space(1))) T*)p; }
typedef __attribute__((address_space(1))) unsigned char GU8;
#if defined(__HIP_DEVICE_COMPILE__)
#define ASSUME_GLOBAL(p_) do { __builtin_assume(!__builtin_amdgcn_is_shared((const void*)(p_))); __builtin_assume(!__builtin_amdgcn_is_private((const void*)(p_))); } while (0)
#else
#define ASSUME_GLOBAL(p_) do { } while (0)
#endif
#define LBAR() do { asm volatile("s_waitcnt lgkmcnt(0)" ::: "memory"); __builtin_amdgcn_s_barrier(); asm volatile("" ::: "memory"); } while (0)
typedef const Params __attribute__((address_space(4))) KParams;
__device__ __forceinline__ KParams* kparams() { KParams* q = (KParams*)__builtin_amdgcn_kernarg_segment_ptr(); asm volatile("" : "+s"(q)); return q; }
__device__ __forceinline__ float wave_sum(float v) {
#pragma unroll
    for (int o = 32; o > 0; o >>= 1) v += __shfl_xor(v, o);
    return v;
}
__device__ __forceinline__ int wave_sum_i(int v) {
#pragma unroll
    for (int o = 32; o > 0; o >>= 1) v += __shfl_xor(v, o);
    return v;
}
__device__ __forceinline__ float wave_max(float v) {
#pragma unroll
    for (int o = 32; o > 0; o >>= 1) v = fmaxf(v, __shfl_xor(v, o));
    return v;
}
__device__ __forceinline__ float sigmoidf_(float x) { return 1.f / (1.f + expf(-x)); }
__device__ __forceinline__ float siluf_(float x) { return x / (1.f + expf(-x)); }
__device__ __forceinline__ float silu_fast(float x) { return x * __builtin_amdgcn_rcpf(1.f + __expf(-x)); }
__device__ __forceinline__ float softplusf_(float x) { return fmaxf(x, 0.f) + log1pf(expf(-fabsf(x))); }
__device__ __forceinline__ unsigned ordkey(float f) { const unsigned u = __float_as_uint(f); return (u & 0x80000000u) ? ~u : (u | 0x80000000u); }

__device__ __forceinline__ void sincos_d(double a, double& s, double& c) {
    const double kq = rint(a * 0.63661977236758134308);
    double r = fma(-kq, 1.57079632673412561417e+00, a);
    r = fma(-kq, 6.07710050650619224932e-11, r);
    const int q = (int)((long long)kq & 3);
    const double r2 = r * r;
    const double sp = r * (1.0 + r2 * (-1.0 / 6 + r2 * (1.0 / 120 + r2 * (-1.0 / 5040 + r2 * (1.0 / 362880 + r2 * (-1.0 / 39916800 + r2 * (1.0 / 6227020800.0)))))));
    const double cp = 1.0 + r2 * (-0.5 + r2 * (1.0 / 24 + r2 * (-1.0 / 720 + r2 * (1.0 / 40320 + r2 * (-1.0 / 3628800 + r2 * (1.0 / 479001600.0 + r2 * (-1.0 / 87178291200.0)))))));
    if (q == 0) { s = sp; c = cp; } else if (q == 1) { s = cp; c = -sp; } else if (q == 2) { s = -sp; c = -cp; } else { s = -cp; c = sp; }
}
__device__ __forceinline__ double ipow_d(double b, int e) { double v = 1.0; while (e) { if (e & 1) v *= b; b *= b; e >>= 1; } return v; }

struct GemmArgs { const float* A; int lda; const int* rows; int m0; int mvalid; const float* B; int ldb; int n0; int N; int K; };

template <class Epi>
__device__ __forceinline__ void gemm128(const GemmArgs& g, float* smem, Epi epi) {
    float* As = smem;
    float* Bs = smem + 16 * 132;
    int tid_ = threadIdx.x; asm volatile("" : "+v"(tid_)); const int tid = tid_, ty = tid >> 4, tx = tid & 15;
    const int arow = tid >> 2, kq = (tid & 3) * 4;
    const int bk = tid >> 5, bn = (tid & 31) * 4;
    long asrc = -1;
    if (arow < g.mvalid) { const int r = g.rows ? g.rows[arow] : (g.m0 + arow); if (r >= 0) asrc = (long)r * g.lda; }
    const bool bval = (g.n0 + bn) < g.N;
    float acc[4][8];
#pragma unroll
    for (int i = 0; i < 4; ++i)
#pragma unroll
        for (int j = 0; j < 8; ++j) acc[i][j] = 0.f;
    for (int k0 = 0; k0 < g.K; k0 += 16) {
        float4 av = make_float4(0.f, 0.f, 0.f, 0.f), bv = make_float4(0.f, 0.f, 0.f, 0.f);
        if (asrc >= 0) av = *(const float4*)(g.A + asrc + k0 + kq);
        if (bval) bv = *(const float4*)(g.B + (size_t)(k0 + bk) * g.ldb + g.n0 + bn);
        __syncthreads();
        As[(kq + 0) * 132 + arow] = av.x; As[(kq + 1) * 132 + arow] = av.y; As[(kq + 2) * 132 + arow] = av.z; As[(kq + 3) * 132 + arow] = av.w;
        *(float4*)&Bs[bk * 132 + bn] = bv;
        __syncthreads();
#pragma unroll
        for (int kk = 0; kk < 16; ++kk) {
            const float4 a = *(const float4*)&As[kk * 132 + ty * 4];
            const float4 b0 = *(const float4*)&Bs[kk * 132 + tx * 8];
            const float4 b1 = *(const float4*)&Bs[kk * 132 + tx * 8 + 4];
            const float aa[4] = {a.x, a.y, a.z, a.w};
            const float bb[8] = {b0.x, b0.y, b0.z, b0.w, b1.x, b1.y, b1.z, b1.w};
#pragma unroll
            for (int i = 0; i < 4; ++i)
#pragma unroll
                for (int j = 0; j < 8; ++j) acc[i][j] += aa[i] * bb[j];
        }
    }
#pragma unroll
    for (int i = 0; i < 4; ++i) {
        const int r = ty * 4 + i;
        if (r < g.mvalid) {
#pragma unroll
            for (int j = 0; j < 8; ++j) { const int n = g.n0 + tx * 8 + j; if (n < g.N) epi(r, n, acc[i][j]); }
        }
    }
}


typedef short bf16x8 __attribute__((ext_vector_type(8)));
typedef float f32x4 __attribute__((ext_vector_type(4)));
typedef unsigned short bf16_t;
typedef __bf16 bf16x2_t __attribute__((ext_vector_type(2)));
typedef float f32x2_t __attribute__((ext_vector_type(2)));
__device__ __forceinline__ unsigned cvt_pk_bf16(float lo, float hi) { const f32x2_t v = {lo, hi}; const bf16x2_t r = __builtin_convertvector(v, bf16x2_t); return __builtin_bit_cast(unsigned, r); }
__device__ __forceinline__ bf16_t f2bf(float f) { return (bf16_t)(cvt_pk_bf16(f, 0.f) & 0xffffu); }
__device__ __forceinline__ float bf16_to_f32(bf16_t v) { return __uint_as_float(((unsigned)v) << 16); }
__device__ __forceinline__ uint2 pack4(const f32x4 v) { uint2 r; r.x = cvt_pk_bf16(v[0], v[1]); r.y = cvt_pk_bf16(v[2], v[3]); return r; }
__device__ __forceinline__ f32x4 unpack4(const uint2 u) { f32x4 r; r[0] = __uint_as_float(u.x << 16); r[1] = __uint_as_float(u.x & 0xffff0000u); r[2] = __uint_as_float(u.y << 16); r[3] = __uint_as_float(u.y & 0xffff0000u); return r; }
#define PBF(Pb_, t_, c_) bf16_to_f32((Pb_)[(size_t)(t_) * LDPB + (c_)])
__device__ __forceinline__ uint4 pack8(const float4 a, const float4 b) { uint4 r; r.x = cvt_pk_bf16(a.x, a.y); r.y = cvt_pk_bf16(a.z, a.w); r.z = cvt_pk_bf16(b.x, b.y); r.w = cvt_pk_bf16(b.z, b.w); return r; }
__device__ __forceinline__ int lds_off(int r, int c) { return r * 128 + ((c ^ (r & 7)) << 4); }

template <class ALoad, class BLoad, class Epi>
__device__ __forceinline__ void gemm_tile_bf16(const int K, unsigned char* lds, ALoad aload, BLoad bload, Epi epi, const int mrows = 256) {
    int tid_ = threadIdx.x; asm volatile("" : "+v"(tid_)); const int tid = tid_, lane = tid & 63, wid = tid >> 6, wm = wid >> 1, wn = wid & 1;
    f32x4 acc[4][4];
#pragma unroll
    for (int mi = 0; mi < 4; ++mi)
#pragma unroll
        for (int ni = 0; ni < 4; ++ni) acc[mi][ni] = (f32x4){0.f, 0.f, 0.f, 0.f};
    uint4 ra[4], rb[2];
    const int nk = K >> 6;
#pragma unroll
    for (int i = 0; i < 4; ++i) { const int q = tid + 512 * i; ra[i] = aload(i, q >> 3, (q & 7) * 8); }
#pragma unroll
    for (int i = 0; i < 2; ++i) { const int q = tid + 512 * i; rb[i] = bload(i, q >> 3, (q & 7) * 8); }
    __syncthreads();
#pragma unroll
    for (int i = 0; i < 4; ++i) { const int q = tid + 512 * i; *(uint4*)(lds + lds_off(q >> 3, q & 7)) = ra[i]; }
#pragma unroll
    for (int i = 0; i < 2; ++i) { const int q = tid + 512 * i; *(uint4*)(lds + 32768 + lds_off(q >> 3, q & 7)) = rb[i]; }
    __syncthreads();
    for (int kt = 0; kt < nk; ++kt) {
        if (kt + 1 < nk) {
#pragma unroll
            for (int i = 0; i < 4; ++i) { const int q = tid + 512 * i; ra[i] = aload(i, q >> 3, (kt + 1) * 64 + (q & 7) * 8); }
#pragma unroll
            for (int i = 0; i < 2; ++i) { const int q = tid + 512 * i; rb[i] = bload(i, q >> 3, (kt + 1) * 64 + (q & 7) * 8); }
        }
        const unsigned char* At = lds + (kt & 1) * 49152;
        const unsigned char* Bt = At + 32768;
        if (__builtin_amdgcn_readfirstlane(wm) * 64 < mrows) {
#pragma unroll
        for (int ks = 0; ks < 2; ++ks) {
            bf16x8 af[4], bfr[4];
            const int c = ks * 4 + (lane >> 4);
#pragma unroll
            for (int mi = 0; mi < 4; ++mi) af[mi] = *(const bf16x8*)(At + lds_off(wm * 64 + mi * 16 + (lane & 15), c));
#pragma unroll
            for (int ni = 0; ni < 4; ++ni) bfr[ni] = *(const bf16x8*)(Bt + lds_off(wn * 64 + ni * 16 + (lane & 15), c));
            __builtin_amdgcn_s_setprio(1);
#pragma unroll
            for (int mi = 0; mi < 4; ++mi)
#pragma unroll
                for (int ni = 0; ni < 4; ++ni) acc[mi][ni] = __builtin_amdgcn_mfma_f32_16x16x32_bf16(bfr[ni], af[mi], acc[mi][ni], 0, 0, 0);
            __builtin_amdgcn_s_setprio(0);
        }
        }
        if (kt + 1 < nk) {
            unsigned char* An = lds + ((kt + 1) & 1) * 49152;
#pragma unroll
            for (int i = 0; i < 4; ++i) { const int q = tid + 512 * i; *(uint4*)(An + lds_off(q >> 3, q & 7)) = ra[i]; }
#pragma unroll
            for (int i = 0; i < 2; ++i) { const int q = tid + 512 * i; *(uint4*)(An + 32768 + lds_off(q >> 3, q & 7)) = rb[i]; }
        }
        __syncthreads();
    }
    epi(acc, wm, wn, lane);
}

__device__ __forceinline__ void convert_tile(const float* src0, const float* src1, int mode, int K, int N, int ld, bf16_t* dst, int rt, int kt, float* smem) {
    int tid_ = threadIdx.x; asm volatile("" : "+v"(tid_)); const int tid = tid_;
    __syncthreads();
    { const int k = tid >> 3, R0 = rt * 64 + (tid & 7) * 8;
      const float* sp; int col;
      if (mode == 0) { sp = src0; col = R0; } else { sp = (R0 & 32) ? src1 : src0; col = (R0 >> 6) * 32 + (R0 & 31); }
      float4 a = make_float4(0.f, 0.f, 0.f, 0.f), b = a;
      const float* rp = sp + (size_t)(kt * 64 + k) * ld + col;
      if (col < N) a = *(const float4*)rp;
      if (col + 4 < N) b = *(const float4*)(rp + 4);
      float* d = smem + k * 65 + (tid & 7) * 8;
      d[0] = a.x; d[1] = a.y; d[2] = a.z; d[3] = a.w; d[4] = b.x; d[5] = b.y; d[6] = b.z; d[7] = b.w; }
    __syncthreads();
    { const int R = tid >> 3, kc = (tid & 7) * 8;
      float v[8];
#pragma unroll
      for (int j = 0; j < 8; ++j) v[j] = smem[(kc + j) * 65 + R];
      uint4 o; o.x = cvt_pk_bf16(v[0], v[1]); o.y = cvt_pk_bf16(v[2], v[3]); o.z = cvt_pk_bf16(v[4], v[5]); o.w = cvt_pk_bf16(v[6], v[7]);
      *(uint4*)(dst + (size_t)(rt * 64 + R) * K + kt * 64 + kc) = o; }
}

#define CT_LOAD(S0, S1, MODE, NN, LD, RT, KT, A, B) do { const int k_ = tid >> 3, R0_ = (RT) * 64 + (tid & 7) * 8; const float* sp_; int col_; \
        if ((MODE) == 0) { sp_ = (S0); col_ = R0_; } else { sp_ = (R0_ & 16) ? (S1) : (S0); col_ = (R0_ >> 5) * 16 + (R0_ & 15); } \
        A = make_float4(0.f, 0.f, 0.f, 0.f); B = A; const float* rp_ = sp_ + (size_t)((KT) * 64 + k_) * (LD) + col_; \
        if (col_ < (NN)) A = *(const float4*)rp_; if (col_ + 4 < (NN)) B = *(const float4*)(rp_ + 4); } while (0)
#define CT_WRITE(BUF, A, B) do { float* d_ = smem + (BUF) * 4160 + (tid >> 3) * 65 + (tid & 7) * 8; \
        d_[0] = A.x; d_[1] = A.y; d_[2] = A.z; d_[3] = A.w; d_[4] = B.x; d_[5] = B.y; d_[6] = B.z; d_[7] = B.w; } while (0)
#define CT_STORE(DST, KK, RT, KT, BUF) do { const int R_ = tid >> 3, kc_ = (tid & 7) * 8; const float* sb_ = smem + (BUF) * 4160; \
        uint4 o_; o_.x = cvt_pk_bf16(sb_[(kc_ + 0) * 65 + R_], sb_[(kc_ + 1) * 65 + R_]); o_.y = cvt_pk_bf16(sb_[(kc_ + 2) * 65 + R_], sb_[(kc_ + 3) * 65 + R_]); \
        o_.z = cvt_pk_bf16(sb_[(kc_ + 4) * 65 + R_], sb_[(kc_ + 5) * 65 + R_]); o_.w = cvt_pk_bf16(sb_[(kc_ + 6) * 65 + R_], sb_[(kc_ + 7) * 65 + R_]); \
        *(uint4*)((DST) + (size_t)((RT) * 64 + R_) * (KK) + (KT) * 64 + kc_) = o_; } while (0)
#define CT_DECL(I) const float* s0_##I; const float* s1_##I; bf16_t* d_##I; int md_##I, K_##I, N_##I, ld_##I, rt_##I, kt_##I
#define CT_ARGS(I) s0_##I, s1_##I, d_##I, md_##I, K_##I, N_##I, ld_##I, rt_##I, kt_##I
#define CT_LOADSET(X, T) do { const int nj_ = (total - (T) < 4) ? (total - (T)) : 4; \
        { CT_DECL(0); dec((T), CT_ARGS(0)); CT_LOAD(s0_0, s1_0, md_0, N_0, ld_0, rt_0, kt_0, X##a0, X##b0); } \
        if (nj_ > 1) { CT_DECL(1); dec((T) + 1, CT_ARGS(1)); CT_LOAD(s0_1, s1_1, md_1, N_1, ld_1, rt_1, kt_1, X##a1, X##b1); } \
        if (nj_ > 2) { CT_DECL(2); dec((T) + 2, CT_ARGS(2)); CT_LOAD(s0_2, s1_2, md_2, N_2, ld_2, rt_2, kt_2, X##a2, X##b2); } \
        if (nj_ > 3) { CT_DECL(3); dec((T) + 3, CT_ARGS(3)); CT_LOAD(s0_3, s1_3, md_3, N_3, ld_3, rt_3, kt_3, X##a3, X##b3); } } while (0)
#define CT_PROCESS(X, T) do { const int nj_ = (total - (T) < 4) ? (total - (T)) : 4; \
        __syncthreads(); \
        CT_WRITE(0, X##a0, X##b0); CT_WRITE(1, X##a1, X##b1); CT_WRITE(2, X##a2, X##b2); CT_WRITE(3, X##a3, X##b3); \
        __syncthreads(); \
        { CT_DECL(0); dec((T), CT_ARGS(0)); CT_STORE(d_0, K_0, rt_0, kt_0, 0); } \
        if (nj_ > 1) { CT_DECL(1); dec((T) + 1, CT_ARGS(1)); CT_STORE(d_1, K_1, rt_1, kt_1, 1); } \
        if (nj_ > 2) { CT_DECL(2); dec((T) + 2, CT_ARGS(2)); CT_STORE(d_2, K_2, rt_2, kt_2, 2); } \
        if (nj_ > 3) { CT_DECL(3); dec((T) + 3, CT_ARGS(3)); CT_STORE(d_3, K_3, rt_3, kt_3, 3); } } while (0)
template <class Dec>
__device__ __forceinline__ void convert_stream(const Dec& dec, int t0, int tstep, int total, float* smem) {
    int tid_ = threadIdx.x; asm volatile("" : "+v"(tid_)); const int tid = tid_;
    if (t0 >= total) return;
    const float4 z4 = make_float4(0.f, 0.f, 0.f, 0.f);
    float4 Aa0 = z4, Ab0 = z4, Aa1 = z4, Ab1 = z4, Aa2 = z4, Ab2 = z4, Aa3 = z4, Ab3 = z4, Ba0 = z4, Bb0 = z4, Ba1 = z4, Bb1 = z4, Ba2 = z4, Bb2 = z4, Ba3 = z4, Bb3 = z4;
    CT_LOADSET(A, t0);
    for (int t = t0; t < total; t += 2 * tstep) {
        if (t + tstep < total) CT_LOADSET(B, t + tstep);
        CT_PROCESS(A, t);
        if (t + tstep >= total) break;
        if (t + 2 * tstep < total) CT_LOADSET(A, t + 2 * tstep);
        CT_PROCESS(B, t + tstep);
    }
}


namespace pg8 {
constexpr int BM = 256, BK = 64, HALF = 128, HTB = HALF * BK * 2, STAGE_BYTES = 8 * HTB;
__host__ __device__ __forceinline__ int lds_byte(int r, int c) { const int st = (r >> 4) * 2 + (c >> 5), rr = r & 15, cc = c & 31, ob = rr * 64 + cc * 2; return st * 1024 + (ob ^ (((ob >> 9) & 1) << 5)); }
__host__ __device__ __forceinline__ void stage_rc(int b, int& R, int& C) { const int st = b / 1024, sb = b % 1024, swz = sb ^ (((sb >> 9) & 1) << 5); R = (st >> 1) * 16 + swz / 64; C = (st & 1) * 32 + (swz % 64) / 2; }
__host__ __device__ __forceinline__ int perm32(int rho) { const int n = rho >> 4, i = rho & 15; return 8 * (i >> 2) + 4 * n + (i & 3); }

struct Unit { size_t aoff, boff; int pm, pn, e, mvalid, rowbase, mi; };
template <class Epi, class Sched, bool GATHER>
__device__ __forceinline__ void gemm_phase(LAS unsigned char* lds, const bf16_t* Abase, const bf16_t* Bbase, const int K, const Sched& S, const Epi& E) {
    int tid_ = threadIdx.x; asm volatile("" : "+v"(tid_));
    const int tid = tid_, wid = __builtin_amdgcn_readfirstlane(tid >> 6), lane = tid & 63, wr = wid >> 2, wc = wid & 3, fr = lane & 15, fq = lane >> 4;
    const int nt = K / BK;
    unsigned voffB[2];
#pragma unroll
    for (int i = 0; i < 2; ++i) { int R, C; stage_rc(tid * 16 + i * 8192, R, C); const int Rb = Epi::PERM ? ((R & ~31) + perm32(R & 31)) : R; voffB[i] = (unsigned)(Rb * K + C) * 2u; }
    const size_t kstep = (size_t)(BK * 2);
    const size_t hstep = (size_t)HALF * K * 2;
    const unsigned ldsw = (unsigned)wid * 1024u;
    const int aoff = lds_byte(wr * 64 + fr, fq * 8), boff = lds_byte(wc * 32 + fr, fq * 8);
#define PG8_SA(b, h) (((b) * 2 + (h)) * HTB)
#define PG8_SB(b, h) ((4 + (b) * 2 + (h)) * HTB)
#define PG8_STAGE(bufoff, gbase, voff) do { _Pragma("unroll") for (int _i = 0; _i < 2; ++_i) \
        __builtin_amdgcn_global_load_lds((const unsigned*)((const char*)(gbase) + (voff)[_i]), (LAS unsigned*)(lds + (bufoff) + ldsw + _i * 8192), 16, 0, 0); } while (0)
#define PG8_LDA(dst, b, h) do { _Pragma("unroll") for (int m = 0; m < 4; ++m) _Pragma("unroll") for (int k = 0; k < 2; ++k) dst[m][k] = *(const LAS bf16x8*)(lds + PG8_SA(b, h) + aoff + m * 2048 + k * 1024); } while (0)
#define PG8_LDB(dst, b, h) do { _Pragma("unroll") for (int n = 0; n < 2; ++n) _Pragma("unroll") for (int k = 0; k < 2; ++k) dst[n][k] = *(const LAS bf16x8*)(lds + PG8_SB(b, h) + boff + n * 2048 + k * 1024); } while (0)
#define PG8_MMA(ai, bj, At, Bt) do { __builtin_amdgcn_s_setprio(1); _Pragma("unroll") for (int m = 0; m < 4; ++m) _Pragma("unroll") for (int n = 0; n < 2; ++n) _Pragma("unroll") for (int k = 0; k < 2; ++k) \
        acc[ai][bj][m][n] = __builtin_amdgcn_mfma_f32_16x16x32_bf16(Bt[n][k], At[m][k], acc[ai][bj][m][n], 0, 0, 0); __builtin_amdgcn_s_setprio(0); } while (0)
#define PG8_WAIT_V(n) asm volatile("s_waitcnt vmcnt(" #n ")" ::: "memory")
#define PG8_WAIT_L(n) asm volatile("s_waitcnt lgkmcnt(" #n ")" ::: "memory")
#define PG8_BAR __builtin_amdgcn_s_barrier()
#define PG8_SCHED __builtin_amdgcn_sched_barrier(0)
#define PG8_AVOFF(U, V0, V1) do { _Pragma("unroll") for (int _i = 0; _i < 2; ++_i) { int R_, C_; stage_rc(tid * 16 + _i * 8192, R_, C_); \
        if (GATHER) { V0[_i] = (unsigned)((size_t)S.row(U, R_) * K + C_) * 2u; V1[_i] = (unsigned)((size_t)S.row(U, 128 + R_) * K + C_) * 2u; } \
        else { V0[_i] = (unsigned)(R_ * K + C_) * 2u; V1[_i] = V0[_i] + (unsigned)hstep; } } } while (0)
    Unit cur, nxt; int ui = 0;
    if (!S.next(0, cur)) return;
    f32x4 acc[2][2][4][2];
#pragma unroll
    for (int a = 0; a < 2; ++a)
#pragma unroll
        for (int b = 0; b < 2; ++b)
#pragma unroll
            for (int m = 0; m < 4; ++m)
#pragma unroll
                for (int n = 0; n < 2; ++n) acc[a][b][m][n] = (f32x4){0.f, 0.f, 0.f, 0.f};
    bf16x8 At[4][2], B0[2][2], B1[2][2];
    unsigned cv0[2], cv1[2];
    PG8_AVOFF(cur, cv0, cv1);
    const char* cA = (const char*)Abase + cur.aoff; const char* cB = (const char*)Bbase + cur.boff;
    PG8_STAGE(PG8_SB(0, 0), cB, voffB); PG8_STAGE(PG8_SA(0, 0), cA, cv0); PG8_STAGE(PG8_SB(0, 1), cB + hstep, voffB); PG8_STAGE(PG8_SA(0, 1), cA, cv1);
    if (wr == 1) PG8_BAR;
    PG8_WAIT_V(4); PG8_BAR;
    PG8_STAGE(PG8_SB(1, 0), cB + kstep, voffB); PG8_STAGE(PG8_SA(1, 0), cA + kstep, cv0); PG8_STAGE(PG8_SB(1, 1), cB + hstep + kstep, voffB);
    PG8_WAIT_V(6); PG8_BAR;
    for (;;) {
        const bool has_next = S.next(ui + 1, nxt);
        const char* nA = has_next ? (const char*)Abase + nxt.aoff : cA; const char* nB = has_next ? (const char*)Bbase + nxt.boff : cB;
        for (int t = 0; t < nt; t += 2) {
            const bool last = (t == nt - 2);
            const char* a1 = cA + (size_t)(t + 1) * kstep;
            const char* a2 = last ? nA : cA + (size_t)(t + 2) * kstep; const char* b2 = last ? nB : cB + (size_t)(t + 2) * kstep;
            const char* a3 = a2 + kstep; const char* b3 = b2 + kstep;
            PG8_LDB(B0, 0, 0); PG8_SCHED; PG8_LDA(At, 0, 0); PG8_STAGE(PG8_SA(1, 1), a1, cv1);
            if (last && has_next) { PG8_AVOFF(nxt, cv0, cv1); }
            PG8_WAIT_L(8); PG8_BAR; PG8_WAIT_L(0); PG8_MMA(0, 0, At, B0); PG8_BAR; PG8_SCHED;
            PG8_LDB(B1, 0, 1); PG8_STAGE(PG8_SB(0, 0), b2, voffB);
            PG8_BAR; PG8_WAIT_L(0); PG8_MMA(0, 1, At, B1); PG8_BAR;
            PG8_LDA(At, 0, 1); PG8_STAGE(PG8_SA(0, 0), a2, cv0);
            PG8_BAR; PG8_WAIT_L(0); PG8_MMA(1, 0, At, B0); PG8_BAR; PG8_SCHED;
            PG8_STAGE(PG8_SB(0, 1), b2 + hstep, voffB);
            PG8_WAIT_V(6); PG8_BAR; PG8_MMA(1, 1, At, B1); PG8_BAR;
            PG8_LDB(B0, 1, 0); PG8_SCHED; PG8_LDA(At, 1, 0); PG8_STAGE(PG8_SA(0, 1), a2, cv1);
            PG8_WAIT_L(8); PG8_BAR; PG8_WAIT_L(0); PG8_MMA(0, 0, At, B0); PG8_BAR; PG8_SCHED;
            PG8_LDB(B1, 1, 1); PG8_STAGE(PG8_SB(1, 0), b3, voffB);
            PG8_BAR; PG8_WAIT_L(0); PG8_MMA(0, 1, At, B1); PG8_BAR;
            PG8_LDA(At, 1, 1); PG8_STAGE(PG8_SA(1, 0), a3, cv0);
            PG8_BAR; PG8_WAIT_L(0); PG8_MMA(1, 0, At, B0); PG8_BAR; PG8_SCHED;
            PG8_STAGE(PG8_SB(1, 1), b3 + hstep, voffB);
            PG8_WAIT_V(6); PG8_BAR; PG8_MMA(1, 1, At, B1); PG8_BAR;
        }
        E(acc, cur, wr, wc, fr, fq);
        if (!has_next) break;
#pragma unroll
        for (int a = 0; a < 2; ++a)
#pragma unroll
            for (int b = 0; b < 2; ++b)
#pragma unroll
                for (int m = 0; m < 4; ++m)
#pragma unroll
                    for (int n = 0; n < 2; ++n) acc[a][b][m][n] = (f32x4){0.f, 0.f, 0.f, 0.f};
        cur = nxt; cA = nA; cB = nB; ++ui;
    }
    PG8_WAIT_V(0);
    if (wr == 0) PG8_BAR;
    PG8_BAR;
#undef PG8_SA
#undef PG8_SB
#undef PG8_STAGE
#undef PG8_LDA
#undef PG8_LDB
#undef PG8_MMA
#undef PG8_WAIT_V
#undef PG8_WAIT_L
#undef PG8_BAR
#undef PG8_SCHED
#undef PG8_AVOFF
}
struct DenseOrder {
    int nM, nN, nwg, G, c, K;
    __device__ __forceinline__ void init(int nM_, int nN_, int G_, int c_, int K_) { nM = nM_; nN = nN_; nwg = nM * nN; G = G_; c = c_; K = K_; }
    __device__ __forceinline__ bool next(int i, Unit& u) const {
        const long L = (long)i * G + c; if (L >= nwg) return false;
        int wgid = (int)L; { const int q = nwg / 8, r = nwg % 8, xcd = wgid % 8, off = wgid / 8; wgid = (xcd < r ? xcd * (q + 1) : r * (q + 1) + (xcd - r) * q) + off; }
        const int nig = 8 * nN, gid = wgid / nig, fm = gid * 8, gsz = (nM - fm) < 8 ? (nM - fm) : 8;
        u.pm = fm + ((wgid % nig) % gsz); u.pn = (wgid % nig) / gsz;
        u.aoff = (size_t)u.pm * 256 * K * 2; u.boff = (size_t)u.pn * 256 * K * 2; u.e = 0; u.mvalid = 256; u.rowbase = u.pm * 256; u.mi = 0;
        return true;
    }
    __device__ __forceinline__ int row(const Unit&, int r) const { return r; }
};
}

extern __shared__ __attribute__((aligned(16))) unsigned char g_smem[];
#define PHASE_FN __device__ __forceinline__
enum { PH_PROLOGUE = 0, PH_NORM_MIX, PH_GEMM_IN_EVEN, PH_EVEN_TOK, PH_GDN_CHUNK, PH_GDN_SCAN, PH_DSA_TOPK, PH_DSA_ATTN, PH_GDN_OUT,
       PH_GEMM_OUT, PH_NORM_FFN, PH_MOE1, PH_MOE2, PH_GEMM_IN_ODD, PH_GLA_TOK, PH_GLA_CHUNK, PH_GLA_SCAN, PH_GLA_OUT, PH_FINAL };

PHASE_FN void ph_prologue(const Params& p, float* smem) {
    KParams* pp = kparams();
    GU8* wsg_ = (GU8*)pp->ws; asm volatile("" : "+s"(wsg_)); unsigned char* ws_ = (unsigned char*)wsg_;
    { int ldz_ = 0; asm volatile("" : "+s"(ldz_)); smem = (float*)(g_smem + ldz_); }
    int tid_ = threadIdx.x; asm volatile("" : "+v"(tid_)); const int tid = tid_, nthr = gridDim.x * NTHREADS, gid = blockIdx.x * NTHREADS + tid;
    for (int i = tid; i < 2 * ND; i += NTHREADS) smem[i] = siluf_(as_global(pp->c)[i]);
    __syncthreads();
    float* MOD = (float*)(ws_ + OFF_MOD);
    { float* red = smem + 2048;
      const int lane = tid & 63, wv = tid >> 6;
      for (int item = blockIdx.x; item < 4 * 96; item += gridDim.x) {
          const int l = item / 96, n = (item % 96) * 64 + lane;
          const float* w = as_global(pp->ada_w) + (size_t)l * ND * 6144 + n;
          float a0 = 0.f, a1 = 0.f;
#pragma unroll 8
          for (int k = wv * 128; k < wv * 128 + 128; ++k) { const float wv_ = w[(size_t)k * 6144]; a0 += smem[k] * wv_; a1 += smem[ND + k] * wv_; }
          __syncthreads();
          red[(wv * 64 + lane) * 2] = a0; red[(wv * 64 + lane) * 2 + 1] = a1;
          __syncthreads();
          if (tid < 128) { const int c = tid >> 1, bb = tid & 1; float a = 0.f; for (int w8 = 0; w8 < 8; ++w8) a += red[(w8 * 64 + c) * 2 + bb];
              MOD[(l * 2 + bb) * 6144 + (item % 96) * 64 + c] = a + as_global(pp->ada_b)[l * 6144 + (item % 96) * 64 + c]; }
      }
      __syncthreads(); }
    float* COSA = (float*)(ws_ + OFF_COSA); float* SINA = (float*)(ws_ + OFF_SINA);
    float* COSI = (float*)(ws_ + OFF_COSI); float* SINI = (float*)(ws_ + OFF_SINI);
    for (size_t i = gid; i < (size_t)NT * 64; i += nthr) {
        const int t = (int)(i >> 6), j = (int)(i & 63);
        double s, c; sincos_d((double)as_global(pp->pos)[t] * ipow_d(pp->rA, j), s, c);
        COSA[i] = (float)c; SINA[i] = (float)s;
    }
    for (size_t i = gid; i < (size_t)NT * 32; i += nthr) {
        const int t = (int)(i >> 5), j = (int)(i & 31);
        double s, c; sincos_d((double)as_global(pp->pos)[t] * ipow_d(pp->rI, j), s, c);
        COSI[i] = (float)c; SINI[i] = (float)s;
    }
}

PHASE_FN void ph_rows(const Params& p, int layer, int mode, float* smem) {
    KParams* pp = kparams();
    GU8* wsg_ = (GU8*)pp->ws; asm volatile("" : "+s"(wsg_)); unsigned char* ws_ = (unsigned char*)wsg_;
    { int ldz_ = 0; asm volatile("" : "+s"(ldz_)); smem = (float*)(g_smem + ldz_); }
    int tid_ = threadIdx.x; asm volatile("" : "+v"(tid_)); const int tid = tid_, lane = tid & 63, wv = tid >> 6;
    int* pad = (int*)smem;
    const int moe_layer = (mode == 1) ? 3 : layer - 1;
    if (moe_layer >= 0) {
        if (tid == 0) { const int* cnt = (const int*)(ws_ + OFF_CNT) + moe_layer * 32 * CSTR; int a = 0; for (int e = 0; e < 32; ++e) { pad[e] = a; a += ((cnt[e * CSTR] + 127) / 128) * 128; } }
        __syncthreads();
    }
    const float* MOD = (const float*)(ws_ + OFF_MOD);
    bf16_t* H = (bf16_t*)(ws_ + OFF_H);
    const bf16_t* YB = (const bf16_t*)(ws_ + OFF_YB);
    const int* ASG = (const int*)(ws_ + OFF_ASG);
    const float* GATE = (const float*)(ws_ + OFF_GATE);
    auto load_x = [&](int row, float (&xv)[16]) {
        const float* xin = (mode == 0 && layer == 0) ? (as_global(pp->x) + (size_t)row * ND) : (as_global(pp->X) + (size_t)row * ND);
#pragma unroll
        for (int j = 0; j < 4; ++j) { const float4 v = *(const float4*)(xin + j * 256 + lane * 4); xv[4 * j] = v.x; xv[4 * j + 1] = v.y; xv[4 * j + 2] = v.z; xv[4 * j + 3] = v.w; }
    };
    auto load_y = [&](int row, uint2 (&ya)[4], uint2 (&yb)[4], float& g0, float& g1) {
        const int4 as = *(const int4*)(ASG + row * 4);
        g0 = GATE[row * 2]; g1 = GATE[row * 2 + 1];
        const bf16_t* y0 = YB + (size_t)(pad[as.x] + as.y) * ND;
        const bf16_t* y1 = YB + (size_t)(pad[as.z] + as.w) * ND;
#pragma unroll
        for (int j = 0; j < 4; ++j) { ya[j] = *(const uint2*)(y0 + j * 256 + lane * 4); yb[j] = *(const uint2*)(y1 + j * 256 + lane * 4); }
    };
    auto finish = [&](int row, float (&xv)[16], const uint2 (&ya)[4], const uint2 (&yb)[4], float g0, float g1) {
        const int b = row >> 13;
        float* xr = as_global(pp->X) + (size_t)row * ND;
        if (moe_layer >= 0) {
            const float* gt = MOD + (size_t)(moe_layer * 2 + b) * 6144 + 5 * 1024;
#pragma unroll
            for (int j = 0; j < 4; ++j) {
                const int col = j * 256 + lane * 4;
                const f32x4 a = unpack4(ya[j]), bq = unpack4(yb[j]); const float4 g = *(const float4*)(gt + col);
                xv[4 * j] += g.x * (g0 * a[0] + g1 * bq[0]); xv[4 * j + 1] += g.y * (g0 * a[1] + g1 * bq[1]);
                xv[4 * j + 2] += g.z * (g0 * a[2] + g1 * bq[2]); xv[4 * j + 3] += g.w * (g0 * a[3] + g1 * bq[3]);
                if (mode == 0) *(float4*)(xr + col) = make_float4(xv[4 * j], xv[4 * j + 1], xv[4 * j + 2], xv[4 * j + 3]);
            }
        }
        float ss = 0.f;
#pragma unroll
        for (int j = 0; j < 16; ++j) ss += xv[j] * xv[j];
        ss = wave_sum(ss);
        const float rstd = rsqrtf(ss * (1.f / 1024.f) + EPS);
        if (mode == 0) {
            const float* nw = as_global(pp->norm_mix) + layer * 1024;
            const float* sh = MOD + (size_t)(layer * 2 + b) * 6144;
            const float* sc = sh + 1024;
#pragma unroll
            for (int j = 0; j < 4; ++j) {
                const int col = j * 256 + lane * 4;
                const float4 w = *(const float4*)(nw + col), s4 = *(const float4*)(sc + col), h4 = *(const float4*)(sh + col);
                f32x4 ov;
                ov[0] = xv[4 * j] * rstd * w.x * (1.f + s4.x) + h4.x; ov[1] = xv[4 * j + 1] * rstd * w.y * (1.f + s4.y) + h4.y;
                ov[2] = xv[4 * j + 2] * rstd * w.z * (1.f + s4.z) + h4.z; ov[3] = xv[4 * j + 3] * rstd * w.w * (1.f + s4.w) + h4.w;
                *(uint2*)(H + (size_t)row * ND + col) = pack4(ov);
            }
        } else {
#pragma unroll
            for (int j = 0; j < 4; ++j) {
                const int col = j * 256 + lane * 4;
                const float4 w = *(const float4*)(as_global(pp->final_norm) + col);
                *(float4*)(xr + col) = make_float4(xv[4 * j] * rstd * w.x, xv[4 * j + 1] * rstd * w.y, xv[4 * j + 2] * rstd * w.z, xv[4 * j + 3] * rstd * w.w);
            }
        }
    };
    const int stride = gridDim.x * 8;
    for (int row = blockIdx.x * 8 + wv; row < NT; row += 2 * stride) {
        const int rowB = row + stride; const bool hasB = rowB < NT; const int rB = hasB ? rowB : row;
        float xa[16], xb[16]; uint2 yaa[4], yab[4], yba[4], ybb[4]; float ga0 = 0.f, ga1 = 0.f, gb0 = 0.f, gb1 = 0.f;
        load_x(row, xa); load_x(rB, xb);
        if (moe_layer >= 0) { load_y(row, yaa, yab, ga0, ga1); load_y(rB, yba, ybb, gb0, gb1); }
        finish(row, xa, yaa, yab, ga0, ga1);
        if (hasB) finish(rowB, xb, yba, ybb, gb0, gb1);
    }
}

struct EpiIn {
    static constexpr bool PERM = true;
    bf16_t* P; float* AUX; int ncols; int even;
    __device__ __forceinline__ void operator()(const f32x4 (&acc)[2][2][4][2], const pg8::Unit& u, int wr, int wc, int fr, int fq) const {
        const int row0 = u.pm * 256 + wr * 64 + fr, col0 = u.pn * 256 + wc * 32 + 8 * fq;
#pragma unroll
        for (int ai = 0; ai < 2; ++ai)
#pragma unroll
            for (int m = 0; m < 4; ++m) { const int r = row0 + ai * 128 + m * 16;
#pragma unroll
                for (int bj = 0; bj < 2; ++bj) { const int c = col0 + bj * 128;
                    if (c < ncols) { const uint2 lo = pack4(acc[ai][bj][m][0]), hi = pack4(acc[ai][bj][m][1]); *(uint4*)(P + (size_t)r * LDPB + c) = make_uint4(lo.x, lo.y, hi.x, hi.y); }
                    if (even) {
                        if (c == 2048) { *(f32x4*)(AUX + (size_t)r * 16) = acc[ai][bj][m][0]; *(f32x4*)(AUX + (size_t)r * 16 + 4) = acc[ai][bj][m][1]; }
                        if (c == 3912) *(f32x4*)(AUX + (size_t)r * 16 + 8) = acc[ai][bj][m][0];
                    } } }
    }
};

PHASE_FN void ph_gemm_in(const Params& p, int layer, bool even, float* smem) {
    KParams* pp = kparams();
    GU8* wsg_ = (GU8*)pp->ws; asm volatile("" : "+s"(wsg_)); unsigned char* ws_ = (unsigned char*)wsg_;
    int ldz_ = 0; asm volatile("" : "+s"(ldz_));
    const bf16_t* Wt = even ? (const bf16_t*)(ws_ + OFF_WINE) + (size_t)(layer >> 1) * 4096 * 1024 : (const bf16_t*)(ws_ + OFF_WINO) + (size_t)(layer >> 1) * 3072 * 1024;
    EpiIn E; E.P = (bf16_t*)(ws_ + OFF_P); E.AUX = (float*)(ws_ + OFF_AUX); E.ncols = even ? 3920 : 3072; E.even = even ? 1 : 0;
    pg8::DenseOrder S; S.init(64, even ? 16 : 12, gridDim.x, blockIdx.x, 1024);
    __syncthreads();
    pg8::gemm_phase<EpiIn, pg8::DenseOrder, false>((LAS unsigned char*)(g_smem + ldz_), (const bf16_t*)(ws_ + OFF_H), Wt, 1024, S, E);
    __syncthreads();
    if (!even) {
        const bf16_t* H = (const bf16_t*)(ws_ + OFF_H);
        const bf16_t* Wg = (const bf16_t*)(ws_ + OFF_WGL) + (size_t)(layer >> 1) * 128 * 1024;
        float* AUX = (float*)(ws_ + OFF_AUX);
        for (int mt = blockIdx.x; mt < 64; mt += gridDim.x) {
            const bf16_t* Ab = H + (size_t)mt * 256 * 1024;
            float* At = AUX + (size_t)mt * 256 * 16;
            gemm_tile_bf16(1024, g_smem + ldz_,
                [=](int i, int r, int k) -> uint4 { return *(const uint4*)(Ab + (size_t)r * 1024 + k); },
                [=](int i, int r, int k) -> uint4 { return *(const uint4*)(Wg + (size_t)r * 1024 + k); },
                [=](const f32x4 (&acc)[4][4], int wm, int wn, int lane) {
                    if (wn == 0 && (lane >> 4) < 4) {
#pragma unroll
                        for (int mi = 0; mi < 4; ++mi) { const int m = wm * 64 + mi * 16 + (lane & 15); *(f32x4*)(At + (size_t)m * 16 + 4 * (lane >> 4)) = acc[mi][0]; }
                    }
                });
        }
        __syncthreads();
    }
}

PHASE_FN void ph_even_tok(const Params& p, int layer, float* smem) {
    KParams* pp = kparams();
    GU8* wsg_ = (GU8*)pp->ws; asm volatile("" : "+s"(wsg_)); unsigned char* ws_ = (unsigned char*)wsg_;
    { int ldz_ = 0; asm volatile("" : "+s"(ldz_)); smem = (float*)(g_smem + ldz_); }
    int tid_ = threadIdx.x; asm volatile("" : "+v"(tid_)); const int tid = tid_, lane = tid & 63, wv = tid >> 6, li = layer >> 1;
    const bf16_t* P = (const bf16_t*)(ws_ + OFF_P); const float* AUX = (const float*)(ws_ + OFF_AUX);
    bf16_t* QB = (bf16_t*)(ws_ + OFF_QBB); bf16_t* KB = (bf16_t*)(ws_ + OFF_KBB); bf16_t* QI = (bf16_t*)(ws_ + OFF_QIB); bf16_t* KI = (bf16_t*)(ws_ + OFF_KIB); float* WI = (float*)(ws_ + OFF_WI);
    const float* COSA = (const float*)(ws_ + OFF_COSA); const float* SINA = (const float*)(ws_ + OFF_SINA);
    const float* COSI = (const float*)(ws_ + OFF_COSI); const float* SINI = (const float*)(ws_ + OFF_SINI);
    for (int t = blockIdx.x * 8 + wv; t < NT; t += gridDim.x * 8) {
        const bf16_t* Pt = P + (size_t)t * LDPB;
        if (lane < 4) {
            WI[t * 4 + lane] = AUX[(size_t)t * 16 + 8 + lane] * 0.0625f;
        }
        { const float c = COSA[(size_t)t * 64 + lane], sn = SINA[(size_t)t * 64 + lane];
#pragma unroll
          for (int h = 0; h < 4; ++h) {
              float t1 = bf16_to_f32(Pt[2056 + h * 128 + lane]), t2 = bf16_to_f32(Pt[2056 + h * 128 + 64 + lane]);
              QB[(size_t)t * 512 + h * 128 + lane] = f2bf(t1 * c - t2 * sn); QB[(size_t)t * 512 + h * 128 + 64 + lane] = f2bf(t2 * c + t1 * sn);
              t1 = bf16_to_f32(Pt[2568 + h * 128 + lane]); t2 = bf16_to_f32(Pt[2568 + h * 128 + 64 + lane]);
              KB[(size_t)t * 512 + h * 128 + lane] = f2bf(t1 * c - t2 * sn); KB[(size_t)t * 512 + h * 128 + 64 + lane] = f2bf(t2 * c + t1 * sn);
          } }
#pragma unroll
        for (int r = 0; r < 2; ++r) {
            const int item = lane + 64 * r, hh = item >> 5, ii = item & 31;
            const float c = COSI[(size_t)t * 32 + ii], sn = SINI[(size_t)t * 32 + ii];
            const float t1 = bf16_to_f32(Pt[3592 + hh * 64 + ii]), t2 = bf16_to_f32(Pt[3592 + hh * 64 + 32 + ii]);
            QI[(size_t)t * 256 + hh * 64 + ii] = f2bf(t1 * c - t2 * sn); QI[(size_t)t * 256 + hh * 64 + 32 + ii] = f2bf(t2 * c + t1 * sn);
        }
        if (lane < 32) {
            const float c = COSI[(size_t)t * 32 + lane], sn = SINI[(size_t)t * 32 + lane];
            const float t1 = bf16_to_f32(Pt[3848 + lane]), t2 = bf16_to_f32(Pt[3848 + 32 + lane]);
            bf16_t* kd = KI + (size_t)(t >> 4) * 1024 + ((lane >> 3) * 16 + (t & 15)) * 8 + (lane & 7);
            kd[0] = f2bf(t1 * c - t2 * sn); kd[512] = f2bf(t2 * c + t1 * sn);
        }
    }
    { bf16_t* VT = (bf16_t*)(ws_ + OFF_VT);
      bf16_t* sv = (bf16_t*)g_smem;
      for (int item = blockIdx.x; item < 2 * 128 * 4; item += gridDim.x) {
          const int h = item & 3, tt = item >> 2, b = tt >> 7, s0 = (tt & 127) * 64;
          __syncthreads();
          for (int e = tid; e < 64 * 128; e += NTHREADS) { const int i = e >> 7, d = e & 127; sv[d * 72 + i] = P[(size_t)(b * 8192 + s0 + i) * LDPB + 3080 + h * 128 + d]; }
          __syncthreads();
          for (int e = tid; e < 128 * 8; e += NTHREADS) { const int d = e >> 3, c = e & 7;
              *(uint4*)(VT + ((size_t)((b * 4 + h) * 128 + d)) * 8192 + s0 + c * 8) = *(const uint4*)(sv + d * 72 + c * 8); }
      } }
}

__device__ __forceinline__ f32x4 mma_lds(const unsigned char* A, int sa, int a0, const unsigned char* B, int sb, int b0, int K, f32x4 acc, int c16, int q4) {
    const unsigned char* ap = A + (a0 + c16) * sa + q4 * 16;
    const unsigned char* bp = B + (b0 + c16) * sb + q4 * 16;
#pragma unroll
    for (int kk = 0; kk < K; kk += 32) { acc = __builtin_amdgcn_mfma_f32_16x16x32_bf16(*(const bf16x8*)(ap + kk * 2), *(const bf16x8*)(bp + kk * 2), acc, 0, 0, 0); }
    return acc;
}

PHASE_FN void ph_gdn_chunk(const Params& p, int layer, float* smem) {
    KParams* pp = kparams();
    GU8* wsg_ = (GU8*)pp->ws; asm volatile("" : "+s"(wsg_)); unsigned char* ws_ = (unsigned char*)wsg_;
    int tid_ = threadIdx.x; asm volatile("" : "+v"(tid_)); const int tid = tid_, lane = tid & 63, wv = __builtin_amdgcn_readfirstlane(tid >> 6), q4 = lane >> 4, c16 = lane & 15;
    int ldz_ = 0; asm volatile("" : "+s"(ldz_)); unsigned char* lds = g_smem + ldz_;
    constexpr int SN = 272, ST = 144;
    unsigned char* bKN = lds;
    unsigned char* bQN = lds + 18432;
    unsigned char* bKBG = lds + 35840;
    unsigned char* bVB = lds + 54272;
    unsigned char* bKD = lds + 72704;
    unsigned char* bUT = lds + 91136;
    float* sL = (float*)(lds + 109568);
    unsigned char* bAQK = lds + 126976;
    unsigned char* bTB = lds + 136192;
    float* sG = (float*)(lds + 145408); float* sB = sG + 64; float* sEg = sB + 64;
    const int li = layer >> 1;
    const bf16_t* P = (const bf16_t*)(ws_ + OFF_P); const float* AUX = (const float*)(ws_ + OFF_AUX);
    const float* cw = as_global(pp->conv_w) + (size_t)li * 4 * 1536;
    uint4* PFR = (uint4*)(ws_ + OFF_PFR); uint4* RFR = (uint4*)(ws_ + OFF_RFR); uint2* QFR = (uint2*)(ws_ + OFF_QFR); uint2* OFR = (uint2*)(ws_ + OFF_OFR);
    float* GL = (float*)(ws_ + OFF_GL);
    for (int ci = blockIdx.x; ci < 1024; ci += gridDim.x) {
        const int b = ci >> 9, h = (ci >> 7) & 3, n = ci & 127;
        const int t0 = b * 8192 + n * 64;
        __syncthreads();
        if (tid < 64) { float g = -expf(as_global(pp->a_log)[li * 4 + h]) * softplusf_(AUX[(size_t)(t0 + tid) * 16 + 4 + h] + as_global(pp->dt_bias)[li * 4 + h]);
#pragma unroll
            for (int o = 1; o < 64; o <<= 1) { const float nb = __shfl_up(g, o); if (lane >= o) g += nb; }
            sG[tid] = g; sB[tid] = sigmoidf_(AUX[(size_t)(t0 + tid) * 16 + h]); sEg[tid] = expf(g); }
        for (int e = tid; e < 64 * 36; e += NTHREADS) ((unsigned*)bAQK)[e] = 0u;
        __syncthreads();
        const float gl = sG[63];
        for (int rep_a = 0; rep_a < REP_A; ++rep_a)
        {
            const int d0 = 2 * lane, cb = h * 128 + d0, s00 = n * 64;
            float wq[4][2], wk[4][2], wvv[4][2];
#pragma unroll
            for (int jj = 0; jj < 4; ++jj) { wq[jj][0] = cw[jj * 1536 + cb]; wq[jj][1] = cw[jj * 1536 + cb + 1]; wk[jj][0] = cw[jj * 1536 + 512 + cb]; wk[jj][1] = cw[jj * 1536 + 512 + cb + 1];
                                            wvv[jj][0] = cw[jj * 1536 + 1024 + cb]; wvv[jj][1] = cw[jj * 1536 + 1024 + cb + 1]; }
            float tk0[8], tk1[8], tv0[8], tv1[8], td0[8], td1[8];
#pragma unroll
            for (int r = 0; r < 8; ++r) {
                const int i = wv * 8 + r;
                float aq0 = 0.f, aq1 = 0.f, ak0 = 0.f, ak1 = 0.f, av0 = 0.f, av1 = 0.f;
#pragma unroll
                for (int jj = 0; jj < 4; ++jj) {
                    if (s00 + i - 3 + jj >= 0) {
                        const bf16_t* rp = P + (size_t)(t0 + i - 3 + jj) * LDPB + cb;
                        const unsigned uq = *(const unsigned*)rp, uk = *(const unsigned*)(rp + 512), uv = *(const unsigned*)(rp + 1024);
                        aq0 += wq[jj][0] * __uint_as_float(uq << 16); aq1 += wq[jj][1] * __uint_as_float(uq & 0xffff0000u);
                        ak0 += wk[jj][0] * __uint_as_float(uk << 16); ak1 += wk[jj][1] * __uint_as_float(uk & 0xffff0000u);
                        av0 += wvv[jj][0] * __uint_as_float(uv << 16); av1 += wvv[jj][1] * __uint_as_float(uv & 0xffff0000u);
                    }
                }
                aq0 = siluf_(aq0); aq1 = siluf_(aq1); ak0 = siluf_(ak0); ak1 = siluf_(ak1); av0 = siluf_(av0); av1 = siluf_(av1);
                const float rq = rsqrtf(wave_sum(aq0 * aq0 + aq1 * aq1) + EPS), rk = rsqrtf(wave_sum(ak0 * ak0 + ak1 * ak1) + EPS);
                aq0 *= rq; aq1 *= rq; ak0 *= rk; ak1 *= rk;
                const float be = sB[i], eg_i = sEg[i], ekd = expf(gl - sG[i]);
                *(unsigned*)(bKN + i * SN + d0 * 2) = cvt_pk_bf16(ak0, ak1);
                *(unsigned*)(bQN + i * SN + d0 * 2) = cvt_pk_bf16(aq0, aq1);
                tk0[r] = ak0 * be * eg_i; tk1[r] = ak1 * be * eg_i; tv0[r] = av0 * be; tv1[r] = av1 * be; td0[r] = ak0 * ekd; td1[r] = ak1 * ekd;
                if ((r & 1) == 1) asm volatile("" ::: "memory");
            }
#define PK8(T) make_uint4(cvt_pk_bf16(T[0], T[1]), cvt_pk_bf16(T[2], T[3]), cvt_pk_bf16(T[4], T[5]), cvt_pk_bf16(T[6], T[7]))
            *(uint4*)(bKBG + d0 * ST + wv * 16) = PK8(tk0); *(uint4*)(bKBG + (d0 + 1) * ST + wv * 16) = PK8(tk1);
            *(uint4*)(bVB + d0 * ST + wv * 16) = PK8(tv0); *(uint4*)(bVB + (d0 + 1) * ST + wv * 16) = PK8(tv1);
            *(uint4*)(bKD + d0 * ST + wv * 16) = PK8(td0); *(uint4*)(bKD + (d0 + 1) * ST + wv * 16) = PK8(td1);
        }
        __syncthreads();
        for (int u = wv; u < 20; u += 8) {
            const int kind = (u >= 10) ? 1 : 0, idx = u - kind * 10;
            const int ti = (idx >= 6) ? 3 : (idx >= 3) ? 2 : (idx >= 1) ? 1 : 0, tj = idx - ((ti * (ti + 1)) >> 1);
            f32x4 acc = (f32x4){0.f, 0.f, 0.f, 0.f};
            acc = mma_lds(kind ? bQN : bKN, SN, 16 * ti, bKN, SN, 16 * tj, 128, acc, c16, q4);
            const int j = 16 * tj + c16;
#pragma unroll
            for (int r = 0; r < 4; ++r) { const int i = 16 * ti + 4 * q4 + r;
                const float dec = (j <= i) ? expf(sG[i] - sG[j]) : 0.f;
                if (kind == 0) sL[i * 68 + j] = (j < i) ? sB[i] * acc[r] * dec : 0.f;
                else *(bf16_t*)(bAQK + i * ST + j * 2) = f2bf(acc[r] * SCALE128 * dec); }
        }
        __syncthreads();
        for (int rep_b = 0; rep_b < REP_B; ++rep_b)
        if (wv == 0) {
            float t[64];
            int zz = 0; asm volatile("" : "+v"(zz)); const float* sLo = sL + zz;
#pragma clang loop unroll(full)
            for (int i = 0; i < 64; ++i) { float a0 = (i == lane) ? 1.f : 0.f, a1 = 0.f, a2 = 0.f, a3 = 0.f;
#define LQ(q) float4 lv##q = make_float4(0.f, 0.f, 0.f, 0.f); if (4 * q < i) lv##q = *(const float4*)(sLo + i * 68 + 4 * q);
#define FQ(q) if (4 * q < i) { a0 -= lv##q.x * t[4 * q]; if (4 * q + 1 < i) a1 -= lv##q.y * t[4 * q + 1]; if (4 * q + 2 < i) a2 -= lv##q.z * t[4 * q + 2]; if (4 * q + 3 < i) a3 -= lv##q.w * t[4 * q + 3]; }
                { LQ(0) LQ(1) LQ(2) LQ(3) LQ(4) LQ(5) LQ(6) LQ(7)
                  FQ(0) FQ(1) FQ(2) FQ(3) FQ(4) FQ(5) FQ(6) FQ(7) }
                if (i > 32) { asm volatile("" ::: "memory");
                  LQ(8) LQ(9) LQ(10) LQ(11) LQ(12) LQ(13) LQ(14) LQ(15)
                  FQ(8) FQ(9) FQ(10) FQ(11) FQ(12) FQ(13) FQ(14) FQ(15) }
                t[i] = (a0 + a1) + (a2 + a3); asm volatile("" ::: "memory"); }
#pragma unroll
            for (int i = 0; i < 64; ++i) *(bf16_t*)(bTB + i * ST + lane * 2) = f2bf(t[i]);
        }
        __syncthreads();
#pragma unroll 4
        for (int x = 0; x < 8; ++x) {
            const int u = wv * 8 + x, kind = u >> 5, ti = (u >> 3) & 3, td = u & 7;
            f32x4 acc = (f32x4){0.f, 0.f, 0.f, 0.f};
            acc = mma_lds(bTB, ST, 16 * ti, kind ? bVB : bKBG, ST, 16 * td, 64, acc, c16, q4);
            *(uint2*)((kind ? bUT : bKN) + (16 * td + c16) * ST + (16 * ti + 4 * q4) * 2) = pack4(acc);
        }
        __syncthreads();
        unsigned char* bWT = bKN;
        const float eg = expf(gl);
        for (int rep_c = 0; rep_c < REP_C; ++rep_c) {
        for (int x = 0; x < 4; ++x) {
            const int u = wv * 4 + x, ti = u >> 2, a = u & 3;
            uint4 fr;
#pragma unroll
            for (int hf = 0; hf < 2; ++hf) { const int tk = 2 * a + hf;
                f32x4 acc = (f32x4){0.f, 0.f, 0.f, 0.f};
                acc = mma_lds(bWT, ST, 16 * tk, bKD, ST, 16 * ti, 64, acc, c16, q4);
                f32x4 v;
#pragma unroll
                for (int r = 0; r < 4; ++r) v[r] = ((16 * tk + 4 * q4 + r) == (16 * ti + c16) ? eg : 0.f) - acc[r];
                const uint2 pk = pack4(v);
                if (hf == 0) { fr.x = pk.x; fr.y = pk.y; } else { fr.z = pk.x; fr.w = pk.y; } }
            PFR[((size_t)(ci * 8 + ti) * 4 + a) * 64 + lane] = fr;
        }
        for (int x = 0; x < 2; ++x) {
            const int u = wv * 2 + x, ti = u >> 2, a = u & 3;
            uint4 fr;
            const int i = 16 * ti + c16;
            const float qs = SCALE128 * sEg[i];
#pragma unroll
            for (int hf = 0; hf < 2; ++hf) { const int tk = 2 * a + hf;
                f32x4 acc = (f32x4){0.f, 0.f, 0.f, 0.f};
                acc = mma_lds(bWT, ST, 16 * tk, bAQK, ST, 16 * ti, 64, acc, c16, q4);
                const f32x4 qv = unpack4(*(const uint2*)(bQN + i * SN + (16 * tk + 4 * q4) * 2));
                const uint2 pk = pack4(qv * qs - acc);
                if (hf == 0) { fr.x = pk.x; fr.y = pk.y; } else { fr.z = pk.x; fr.w = pk.y; } }
            RFR[((size_t)(ci * 4 + ti) * 4 + a) * 64 + lane] = fr;
        }
#pragma unroll 4
        for (int x = 0; x < 8; ++x) {
            const int u = wv * 8 + x, tdv = u >> 3, tdk = u & 7;
            f32x4 acc = (f32x4){0.f, 0.f, 0.f, 0.f};
            acc = mma_lds(bKD, ST, 16 * tdk, bUT, ST, 16 * tdv, 64, acc, c16, q4);
            QFR[((size_t)(ci * 8 + tdv) * 8 + tdk) * 64 + lane] = pack4(acc);
        }
#pragma unroll
        for (int x = 0; x < 4; ++x) {
            const int u = wv * 4 + x, tdv = u >> 2, ti = u & 3;
            f32x4 acc = (f32x4){0.f, 0.f, 0.f, 0.f};
            acc = mma_lds(bAQK, ST, 16 * ti, bUT, ST, 16 * tdv, 64, acc, c16, q4);
            OFR[((size_t)(ci * 8 + tdv) * 4 + ti) * 64 + lane] = pack4(acc);
        }
        }
        if (tid == 0) GL[ci] = gl;
    }
}

__device__ __forceinline__ void gs_load(uint4 (&d)[12], const unsigned char* pp, const unsigned char* rr, const unsigned char* qq, const unsigned char* oo, const int lt) {
#pragma unroll
    for (int i = 0; i < 6; ++i) { int c = lt + 384 * i; c = c < 2048 ? c : 2047; d[i] = *(const uint4*)(pp + c * 16); }
#pragma unroll
    for (int i = 0; i < 3; ++i) { int c = lt + 384 * i; c = c < 1024 ? c : 1023; d[6 + i] = *(const uint4*)(rr + c * 16); }
#pragma unroll
    for (int i = 0; i < 2; ++i) { int c = lt + 384 * i; c = c < 512 ? c : 511; d[9 + i] = *(const uint4*)(qq + c * 16); }
    { const int c = lt < 256 ? lt : 255; d[11] = *(const uint4*)(oo + c * 16); }
}
__device__ __forceinline__ void gs_store(const uint4 (&d)[12], unsigned char* sb, const int lt) {
#pragma unroll
    for (int i = 0; i < 6; ++i) { const int c = lt + 384 * i; if (c < 2048) *(uint4*)(sb + c * 16) = d[i]; }
#pragma unroll
    for (int i = 0; i < 3; ++i) { const int c = lt + 384 * i; if (c < 1024) *(uint4*)(sb + 32768 + c * 16) = d[6 + i]; }
#pragma unroll
    for (int i = 0; i < 2; ++i) { const int c = lt + 384 * i; if (c < 512) *(uint4*)(sb + 49152 + c * 16) = d[9 + i]; }
    if (lt < 256) *(uint4*)(sb + 57344 + lt * 16) = d[11];
}

#define SCAN_BODY                 bf16x8 Sb[4]; \
_Pragma("unroll") \
                for (int a = 0; a < 4; ++a) { union { uint4 u; bf16x8 v; } cv; const uint2 lo = pack4(S[2 * a]), hi = pack4(S[2 * a + 1]); cv.u.x = lo.x; cv.u.y = lo.y; cv.u.z = hi.x; cv.u.w = hi.y; Sb[a] = cv.v; } \
                const int t0 = b * 8192 + n * 64; \
                {   f32x4 oa[4]; \
_Pragma("unroll") \
                    for (int ti = 0; ti < 4; ++ti) oa[ti] = unpack4(*(const uint2*)(Of + ti * 512)); \
_Pragma("unroll") \
                    for (int a = 0; a < 4; ++a) \
_Pragma("unroll") \
                        for (int ti = 0; ti < 4; ++ti) oa[ti] = __builtin_amdgcn_mfma_f32_16x16x32_bf16(*(const bf16x8*)(Rf + (ti * 4 + a) * 1024), Sb[a], oa[ti], 0, 0, 0); \
_Pragma("unroll") \
                    for (int ti = 0; ti < 4; ++ti) { \
                        float* op = O + (size_t)(t0 + 16 * ti + 4 * q4) * 1024 + h * 128 + 16 * tdv + c16; \
                        op[0] = oa[ti][0]; op[1024] = oa[ti][1]; op[2048] = oa[ti][2]; op[3072] = oa[ti][3]; } \
                } \
                asm volatile("" ::: "memory"); \
_Pragma("unroll") \
                for (int g = 0; g < 2; ++g) { \
                    f32x4 sa[4]; \
_Pragma("unroll") \
                    for (int t = 0; t < 4; ++t) sa[t] = unpack4(*(const uint2*)(Qf + (g * 4 + t) * 512)); \
_Pragma("unroll") \
                    for (int a = 0; a < 4; ++a) \
_Pragma("unroll") \
                        for (int t = 0; t < 4; ++t) sa[t] = __builtin_amdgcn_mfma_f32_16x16x32_bf16(*(const bf16x8*)(Pf + ((g * 4 + t) * 4 + a) * 1024), Sb[a], sa[t], 0, 0, 0); \
_Pragma("unroll") \
                    for (int t = 0; t < 4; ++t) S[g * 4 + t] = sa[t]; \
                    asm volatile("" ::: "memory"); \
                }
PHASE_FN void ph_gdn_scan(const Params& p, float* smem) {
    KParams* pp = kparams();
    GU8* wsg_ = (GU8*)pp->ws; asm volatile("" : "+s"(wsg_)); unsigned char* ws_ = (unsigned char*)wsg_;
    int tid_ = threadIdx.x; asm volatile("" : "+v"(tid_)); const int tid = tid_, lane = tid & 63, wv = __builtin_amdgcn_readfirstlane(tid >> 6), q4 = lane >> 4, c16 = lane & 15;
    int ldz_ = 0; asm volatile("" : "+s"(ldz_)); unsigned char* lds = g_smem + ldz_;
    constexpr int STG = 61440;
    const unsigned char* PFR = ws_ + OFF_PFR; const unsigned char* RFR = ws_ + OFF_RFR; const unsigned char* QFR = ws_ + OFF_QFR; const unsigned char* OFR = ws_ + OFF_OFR;
    float* O = (float*)(ws_ + OFF_O);
    for (int it = blockIdx.x; it < 32; it += gridDim.x) {
        const int bh = it >> 2, pair = it & 3, b = bh >> 2, h = bh & 3;
        __syncthreads();
        if (wv >= 2) {
            const int lt = tid - 128;
            const unsigned char* Pb = PFR + (size_t)bh * 128 * 32768;
            const unsigned char* Rb = RFR + (size_t)bh * 128 * 16384;
            const unsigned char* Qb = QFR + (size_t)bh * 128 * 32768 + pair * 8192;
            const unsigned char* Ob = OFR + (size_t)bh * 128 * 16384 + pair * 4096;
            uint4 ra0, ra1, ra2, ra3, ra4, ra5, ra6, ra7, ra8, ra9, ra10, ra11, rb0, rb1, rb2, rb3, rb4, rb5, rb6, rb7, rb8, rb9, rb10, rb11;
            uint4 rc0, rc1, rc2, rc3, rc4, rc5, rc6, rc7, rc8, rc9, rc10, rc11;
#define LDC(base_, c_, mx_) (*(const uint4*)((base_) + (size_t)(((c_) < (mx_)) ? (c_) : (mx_)) * 16))
#define GS_LOAD(X, n_) do { const unsigned char* pp_ = Pb + (size_t)(n_) * 32768; const unsigned char* rr_ = Rb + (size_t)(n_) * 16384; \
                const unsigned char* qq_ = Qb + (size_t)(n_) * 32768; const unsigned char* oo_ = Ob + (size_t)(n_) * 16384; \
                X##0 = LDC(pp_, lt, 2047); X##1 = LDC(pp_, lt + 384, 2047); X##2 = LDC(pp_, lt + 768, 2047); X##3 = LDC(pp_, lt + 1152, 2047); X##4 = LDC(pp_, lt + 1536, 2047); X##5 = LDC(pp_, lt + 1920, 2047); \
                X##6 = LDC(rr_, lt, 1023); X##7 = LDC(rr_, lt + 384, 1023); X##8 = LDC(rr_, lt + 768, 1023); \
                X##9 = LDC(qq_, lt, 511); X##10 = LDC(qq_, lt + 384, 511); X##11 = LDC(oo_, lt, 255); } while (0)
#define STC(off_, c_, lim_, v_) do { if ((c_) < (lim_)) *(uint4*)(sb_ + (off_) + (c_) * 16) = v_; } while (0)
#define GS_STORE(X, st_) do { unsigned char* sb_ = lds + (st_) * STG; \
                STC(0, lt, 2048, X##0); STC(0, lt + 384, 2048, X##1); STC(0, lt + 768, 2048, X##2); STC(0, lt + 1152, 2048, X##3); STC(0, lt + 1536, 2048, X##4); STC(0, lt + 1920, 2048, X##5); \
                STC(32768, lt, 1024, X##6); STC(32768, lt + 384, 1024, X##7); STC(32768, lt + 768, 1024, X##8); \
                STC(49152, lt, 512, X##9); STC(49152, lt + 384, 512, X##10); STC(57344, lt, 256, X##11); } while (0)
            GS_LOAD(ra, 0); GS_STORE(ra, 0);
            GS_LOAD(rb, 1); GS_LOAD(rc, 2); GS_LOAD(ra, 3);
            __syncthreads();
#define CLAMPN(x_) (((x_) < 128) ? (x_) : 127)
            for (int n = 0; n < 128; n += 3) {
                if (n + 1 < 128) GS_STORE(rb, (n + 1) & 1);
                GS_LOAD(rb, CLAMPN(n + 4)); LBAR();
                if (n + 1 < 128) { if (n + 2 < 128) GS_STORE(rc, (n + 2) & 1);
                    GS_LOAD(rc, CLAMPN(n + 5)); LBAR(); }
                if (n + 2 < 128) { if (n + 3 < 128) GS_STORE(ra, (n + 3) & 1);
                    GS_LOAD(ra, CLAMPN(n + 6)); LBAR(); }
            }
        } else {
            const int tdv = pair * 2 + wv;
            f32x4 S[8];
#pragma unroll
            for (int t = 0; t < 8; ++t) S[t] = (f32x4){0.f, 0.f, 0.f, 0.f};
            __syncthreads();
            for (int n = 0; n < 128; ++n) {
                const unsigned char* base = lds + (n & 1) * STG;
                const unsigned char* Pf = base + lane * 16, *Rf = base + 32768 + lane * 16;
                const unsigned char* Qf = base + 49152 + wv * 4096 + lane * 8, *Of = base + 57344 + wv * 2048 + lane * 8;
                SCAN_BODY
                LBAR();
            }
        }
    }
}

__device__ __forceinline__ void block_sum4(int (&v)[4], int* buf) {
    const int lane = threadIdx.x & 63, wv = threadIdx.x >> 6;
#pragma unroll
    for (int q = 0; q < 4; ++q) v[q] = wave_sum_i(v[q]);
    if (lane == 0) {
#pragma unroll
        for (int q = 0; q < 4; ++q) buf[wv * 4 + q] = v[q];
    }
    __syncthreads();
#pragma unroll
    for (int q = 0; q < 4; ++q) { int a = 0; for (int w = 0; w < 8; ++w) a += buf[w * 4 + q]; v[q] = a; }
}

PHASE_FN void ph_dsa_topk(const Params& p, int layer, float* smem) {
    KParams* pp = kparams();
    GU8* wsg_ = (GU8*)pp->ws; asm volatile("" : "+s"(wsg_)); unsigned char* ws_ = (unsigned char*)wsg_;
    int tid_ = threadIdx.x; asm volatile("" : "+v"(tid_)); const int tid = tid_, lane = tid & 63, wv = __builtin_amdgcn_readfirstlane(tid >> 6), q4 = lane >> 4, c16 = lane & 15;
    int* sRed = (int*)g_smem;
    const bf16_t* QIb = (const bf16_t*)(ws_ + OFF_QIB); const bf16_t* KIb = (const bf16_t*)(ws_ + OFF_KIB); const float* WI = (const float*)(ws_ + OFF_WI);
    unsigned short* M16 = (unsigned short*)(ws_ + OFF_M16);
    int* qhead = (int*)(ws_ + OFF_QCTR) + layer * 16;
    int* sIt = (int*)(g_smem + 512);
    __syncthreads();
    if (tid == 0) *sIt = atomicAdd(qhead, 1);
    __syncthreads();
    int it = *sIt;
    while (it < 2048) {
        int nxt = 0;
        const int b = it & 1, gp = 1023 - (it >> 1);
        const int s0 = gp * 8, t0 = b * 8192 + s0;
        const int ntiles = (s0 >> 4) + 1;
        const int nreg = (ntiles > wv) ? ((ntiles - wv + 7) >> 3) : 0;
        const bf16_t* qp = QIb + (size_t)(t0 + (c16 >> 2)) * 256 + (c16 & 3) * 64 + 8 * q4;
        const bf16x8 a0A = *(const bf16x8*)qp, a1A = *(const bf16x8*)(qp + 32), a0B = *(const bf16x8*)(qp + 4 * 256), a1B = *(const bf16x8*)(qp + 4 * 256 + 32);
        const float4 wqA = *(const float4*)(WI + (size_t)(t0 + q4) * 4), wqB = *(const float4*)(WI + (size_t)(t0 + 4 + q4) * 4);
        const int myqA = s0 + q4, myqB = s0 + 4 + q4;
        int c16s = c16; asm volatile("" : "+v"(c16s));
        int lanes = lane; asm volatile("" : "+v"(lanes));
        int wvs = wv; asm volatile("" : "+s"(wvs));
        unsigned kA[64], kB[64];
#pragma unroll
        for (int i = 0; i < 64; ++i) { kA[i] = 0u; kB[i] = 0u; }
#define SC_TILE(il_, tile_, k0_, k1_) { \
                    f32x4 accA = (f32x4){0.f, 0.f, 0.f, 0.f}, accB = accA; \
                    accA = __builtin_amdgcn_mfma_f32_16x16x32_bf16(a0A, k0_, accA, 0, 0, 0); \
                    accB = __builtin_amdgcn_mfma_f32_16x16x32_bf16(a0B, k0_, accB, 0, 0, 0); \
                    accA = __builtin_amdgcn_mfma_f32_16x16x32_bf16(a1A, k1_, accA, 0, 0, 0); \
                    accB = __builtin_amdgcn_mfma_f32_16x16x32_bf16(a1B, k1_, accB, 0, 0, 0); \
                    float sa = 0.f, sb = 0.f; \
                    sa += wqA.x * fmaxf(accA[0], 0.f); sa += wqA.y * fmaxf(accA[1], 0.f); sa += wqA.z * fmaxf(accA[2], 0.f); sa += wqA.w * fmaxf(accA[3], 0.f); \
                    sb += wqB.x * fmaxf(accB[0], 0.f); sb += wqB.y * fmaxf(accB[1], 0.f); sb += wqB.z * fmaxf(accB[2], 0.f); sb += wqB.w * fmaxf(accB[3], 0.f); \
                    const int kidx = (tile_) * 16 + c16s; \
                    kA[il_] = (kidx <= myqA) ? ordkey(sa) : 0u; \
                    kB[il_] = (kidx <= myqB) ? ordkey(sb) : 0u; }
        const int nblk = (nreg + 15) >> 4;
        for (int rep_s = 0; rep_s < REP_S; ++rep_s) {
        if (rep_s > 0) {
#pragma unroll
            for (int i = 0; i < 64; ++i) { kA[i] = 0u; kB[i] = 0u; } }
#pragma nounroll
        for (int blk = nblk - 1; blk >= 0; --blk) {
#pragma unroll
            for (int i = 63; i >= 16; --i) { kA[i] = kA[i - 16]; kB[i] = kB[i - 16]; }
#pragma unroll
            for (int i = 0; i < 16; ++i) { kA[i] = 0u; kB[i] = 0u; }
            const int tb = wvs + 128 * blk;
#pragma unroll
            for (int g = 0; g < 4; ++g) { const int tg = tb + 32 * g;
                if (tg < ntiles) {
                    const bf16_t* kp = KIb + (size_t)(b * 512 + tg) * 1024 + lanes * 8;
                    const bf16x8 k00 = *(const bf16x8*)kp, k01 = *(const bf16x8*)(kp + 512);
                    const bf16x8 k10 = *(const bf16x8*)(kp + 8 * 1024), k11 = *(const bf16x8*)(kp + 8 * 1024 + 512);
                    const bf16x8 k20 = *(const bf16x8*)(kp + 16 * 1024), k21 = *(const bf16x8*)(kp + 16 * 1024 + 512);
                    const bf16x8 k30 = *(const bf16x8*)(kp + 24 * 1024), k31 = *(const bf16x8*)(kp + 24 * 1024 + 512);
                    SC_TILE(g * 4, tg, k00, k01) SC_TILE(g * 4 + 1, tg + 8, k10, k11) SC_TILE(g * 4 + 2, tg + 16, k20, k21) SC_TILE(g * 4 + 3, tg + 24, k30, k31)
                }
                asm volatile("" ::: "memory"); }
        }
        }
        if (tid == 0) nxt = atomicAdd(qhead, 1);
        const int keffA = (myqA + 1 < 256) ? (myqA + 1) : 256, keffB = (myqB + 1 < 256) ? (myqB + 1) : 256;
        int par = 0;
        int mydone = 0, alldone = 0;
        auto qsum = [&](int c) -> int {
            c += __builtin_amdgcn_update_dpp(0, c, 0xB1, 0xf, 0xf, true);
            c += __builtin_amdgcn_update_dpp(0, c, 0x4E, 0xf, 0xf, true);
            c += __builtin_amdgcn_update_dpp(0, c, 0x124, 0xf, 0xf, true);
            c += __builtin_amdgcn_update_dpp(0, c, 0x128, 0xf, 0xf, true);
            par ^= 1;
            sRed[par * 32 + q4 * 8 + wv] = c;
            LBAR();
            const int4 r0 = *(const int4*)(sRed + par * 32 + q4 * 8), r1 = *(const int4*)(sRed + par * 32 + q4 * 8 + 4);
            return r0.x + r0.y + r0.z + r0.w + r1.x + r1.y + r1.z + r1.w;
        };
        const bool has1 = nreg > 32;
#define TR_STEP(a, base, J_, M_) { _Pragma("unroll") for (int k_ = 0; k_ < 32; ++k_) if ((k_ & (J_)) == 0) { \
                const unsigned lo_ = a[(base) + k_], hi_ = a[(base) + k_ + (J_)]; \
                a[(base) + k_] = ((M_) & lo_) | (~(M_) & (hi_ << (J_))); \
                a[(base) + k_ + (J_)] = ((M_) & (lo_ >> (J_))) | (~(M_) & hi_); } }
#define TR32(a, base) { TR_STEP(a, base, 16, 0x0000FFFFu) TR_STEP(a, base, 8, 0x00FF00FFu) TR_STEP(a, base, 4, 0x0F0F0F0Fu) TR_STEP(a, base, 2, 0x33333333u) TR_STEP(a, base, 1, 0x55555555u) }
        for (int rep_t = 0; rep_t < REP_T; ++rep_t) {
        TR32(kA, 0) TR32(kB, 0)
        if (has1) { TR32(kA, 32) TR32(kB, 32) } }
        unsigned alA0, alA1, alB0, alB1, gmA0, gmA1, gmB0, gmB1;
        int GA, GB;
        for (int rep_q = 0; rep_q < REP_Q; ++rep_q) {
        alA0 = ~0u; alA1 = has1 ? ~0u : 0u; alB0 = ~0u; alB1 = alA1; gmA0 = 0u; gmA1 = 0u; gmB0 = 0u; gmB1 = 0u; GA = 0; GB = 0; mydone = 0; alldone = 0;
#pragma unroll
        for (int bit = 31; bit >= 0; --bit) {
            if (alldone) continue;
            const unsigned mA0 = alA0 & kA[bit], mA1 = alA1 & kA[32 + bit], mB0 = alB0 & kB[bit], mB1 = alB1 & kB[32 + bit];
            const int ca = __builtin_popcount(mA0) + __builtin_popcount(mA1), cb = __builtin_popcount(mB0) + __builtin_popcount(mB1);
            const int tot = qsum(ca | (cb << 16));
            const int tA = GA + (tot & 0xffff), tB = GB + (tot >> 16);
            if (tA >= keffA) { alA0 = mA0; alA1 = mA1; mydone = (mydone & 2) | ((tA == keffA) ? 1 : 0); }
            else { GA = tA; gmA0 |= mA0; gmA1 |= mA1; alA0 ^= mA0; alA1 ^= mA1; }
            if (tB >= keffB) { alB0 = mB0; alB1 = mB1; mydone = (mydone & 1) | ((tB == keffB) ? 2 : 0); }
            else { GB = tB; gmB0 |= mB0; gmB1 |= mB1; alB0 ^= mB0; alB1 ^= mB1; }
            alldone = (__ballot(mydone == 3) == ~0ull) ? 1 : 0;
        }
        }
        const int ce = qsum((__builtin_popcount(alA0) + __builtin_popcount(alA1)) | ((__builtin_popcount(alB0) + __builtin_popcount(alB1)) << 16));
        const int needA = keffA - GA, needB = keffB - GB;
        par ^= 1;
        sRed[par * 32 + q4 * 8 + wv] = (((ce & 0xffff) > needA) || ((ce >> 16) > needB)) ? 1 : 0;
        LBAR();
        int anyov = 0;
#pragma unroll
        for (int w = 0; w < 32; ++w) anyov |= sRed[par * 32 + w];
        if (anyov) {
            int JA = 0, JB = 0;
            int c16j = c16; asm volatile("" : "+v"(c16j));
            int wvj = wv; asm volatile("" : "+s"(wvj));
            for (int bit = 12; bit >= 0; --bit) {
                const int cjA = JA | (1 << bit), cjB = JB | (1 << bit);
                int c = 0;
#pragma unroll
                for (int i = 0; i < 64; ++i) { const int kidx = (wvj + 8 * i) * 16 + c16j;
                    const unsigned ba = ((i < 32 ? alA0 : alA1) >> (i & 31)) & 1u, bb = ((i < 32 ? alB0 : alB1) >> (i & 31)) & 1u;
                    c += (ba && kidx < cjA) ? 1 : 0; c += (bb && kidx < cjB) ? 65536 : 0; }
                const int tot = qsum(c);
                if ((tot & 0xffff) <= needA - 1) JA = cjA;
                if ((tot >> 16) <= needB - 1) JB = cjB;
            }
            unsigned kpA0 = 0u, kpA1 = 0u, kpB0 = 0u, kpB1 = 0u;
#pragma unroll
            for (int i = 0; i < 32; ++i) { const int k0 = (wvj + 8 * i) * 16 + c16j, k1 = k0 + 4096;
                kpA0 |= (k0 <= JA) ? (1u << i) : 0u; kpA1 |= (k1 <= JA) ? (1u << i) : 0u; kpB0 |= (k0 <= JB) ? (1u << i) : 0u; kpB1 |= (k1 <= JB) ? (1u << i) : 0u; }
            alA0 &= kpA0; alA1 &= kpA1; alB0 &= kpB0; alB1 &= kpB1;
        }
        const unsigned selA0 = gmA0 | alA0, selA1 = gmA1 | alA1, selB0 = gmB0 | alB0, selB1 = gmB1 | alB1;
        unsigned short* sM = (unsigned short*)(g_smem + 1024);
        { unsigned z_ = 0u; asm volatile("" : "+v"(z_)); ((uint4*)sM)[tid] = make_uint4(z_, z_, z_, z_); }
        LBAR();
        int wve = wv; asm volatile("" : "+s"(wve));
        for (int rep_e = 0; rep_e < REP_E; ++rep_e)
#pragma nounroll
        for (int i = 0; i < nreg; ++i) {
            const int tile = wve + 8 * i;
            const unsigned wA = (i < 32) ? selA0 : selA1, wB = (i < 32) ? selB0 : selB1;
            const bool selA = ((wA >> (i & 31)) & 1u) != 0u, selB = ((wB >> (i & 31)) & 1u) != 0u;
            const unsigned long long balA = __ballot(selA), balB = __ballot(selB);
            if (c16 == 0) { sM[q4 * 512 + tile] = (unsigned short)((balA >> (16 * q4)) & 0xffffull);
                            sM[(4 + q4) * 512 + tile] = (unsigned short)((balB >> (16 * q4)) & 0xffffull); }
        }
        if (tid == 0) *sIt = nxt;
        __syncthreads();
        *(uint4*)(M16 + (size_t)(t0 + (tid >> 6)) * 512 + (tid & 63) * 8) = ((const uint4*)sM)[tid];
        it = *sIt;
    }
}

PHASE_FN void ph_dsa_attn(const Params& p, float* smem) {
    KParams* pp = kparams();
    GU8* wsg_ = (GU8*)pp->ws; asm volatile("" : "+s"(wsg_)); unsigned char* ws_ = (unsigned char*)wsg_;
    int tid_ = threadIdx.x; asm volatile("" : "+v"(tid_)); const int tid = tid_, lane = tid & 63, wv = tid >> 6, q4 = lane >> 4, c16 = lane & 15;
    int ldz_ = 0; asm volatile("" : "+s"(ldz_)); unsigned char* lds = g_smem + ldz_;
    const bf16_t* QBb = (const bf16_t*)(ws_ + OFF_QBB); const bf16_t* KBb = (const bf16_t*)(ws_ + OFF_KBB); const bf16_t* VT = (const bf16_t*)(ws_ + OFF_VT);
    const unsigned short* M16 = (const unsigned short*)(ws_ + OFF_M16);
    bf16_t* OB = (bf16_t*)(ws_ + OFF_OB);
    const float SC = SCALE128 * 1.4426950408889634f;
    for (int it = blockIdx.x; it < 256; it += gridDim.x) {
        const int bh = it & 7, jp = it >> 3, b = bh >> 2, h = bh & 3;
        for (int half = 0; half < 2; ++half) {
            const int jq = half ? jp : 63 - jp;
            const int qs = jq * 128, nkt = 2 * jq + 2;
            const int tq = b * 8192 + qs + wv * 16 + c16;
            bf16x8 qf[4];
#pragma unroll
            for (int a = 0; a < 4; ++a) qf[a] = *(const bf16x8*)(QBb + (size_t)tq * 512 + h * 128 + 8 * q4 + 32 * a);
            float m = -1e30f, lsum = 0.f;
            f32x4 oacc[8];
#pragma unroll
            for (int t = 0; t < 8; ++t) oacc[t] = (f32x4){0.f, 0.f, 0.f, 0.f};
            uint4 rk0, rk1, rv0, rv1;
            const int q0 = tid, q1 = tid + 512;
            const bf16_t* kg0 = KBb + (size_t)(b * 8192 + (q0 >> 4)) * 512 + h * 128 + (q0 & 15) * 8;
            const bf16_t* kg1 = KBb + (size_t)(b * 8192 + (q1 >> 4)) * 512 + h * 128 + (q1 & 15) * 8;
            const bf16_t* vg0 = VT + ((size_t)((b * 4 + h) * 128 + (q0 >> 3))) * 8192 + (q0 & 7) * 8;
            const bf16_t* vg1 = VT + ((size_t)((b * 4 + h) * 128 + (q1 >> 3))) * 8192 + (q1 & 7) * 8;
            const int lk0 = (q0 >> 4) * 256 + ((((q0 & 15)) ^ ((q0 >> 4) & 15)) << 4), lk1 = (q1 >> 4) * 256 + ((((q1 & 15)) ^ ((q1 >> 4) & 15)) << 4);
            const int lv0 = 16384 + (q0 >> 3) * 128 + ((((q0 & 7)) ^ ((q0 >> 3) & 7)) << 4), lv1 = 16384 + (q1 >> 3) * 128 + ((((q1 & 7)) ^ ((q1 >> 3) & 7)) << 4);
#define ATT_GLOAD(kt_) do { rk0 = *(const uint4*)(kg0 + (size_t)(kt_) * 64 * 512); rk1 = *(const uint4*)(kg1 + (size_t)(kt_) * 64 * 512); \
                            rv0 = *(const uint4*)(vg0 + (kt_) * 64); rv1 = *(const uint4*)(vg1 + (kt_) * 64); } while (0)
#define ATT_LSTORE(st_) do { unsigned char* base_ = lds + (st_) * 32768; *(uint4*)(base_ + lk0) = rk0; *(uint4*)(base_ + lk1) = rk1; *(uint4*)(base_ + lv0) = rv0; *(uint4*)(base_ + lv1) = rv1; } while (0)
            __syncthreads();
            ATT_GLOAD(0); ATT_LSTORE(0);
            __syncthreads();
            for (int kt = 0; kt < nkt; ++kt) {
                if (kt + 1 < nkt) ATT_GLOAD(kt + 1);
                const unsigned long long mbits = *(const unsigned long long*)(M16 + (size_t)tq * 512 + 4 * kt);
                const unsigned char* Kt = lds + (kt & 1) * 32768;
                const unsigned char* Vt = Kt + 16384;
                f32x4 sacc[4];
#pragma unroll
                for (int th = 0; th < 2; ++th) {
                    bf16x8 kf[8];
#pragma unroll
                    for (int tt = 0; tt < 2; ++tt) { const int row = 16 * (th * 2 + tt) + c16;
#pragma unroll
                        for (int a = 0; a < 4; ++a) kf[tt * 4 + a] = *(const bf16x8*)(Kt + row * 256 + ((((q4 + 4 * a)) ^ (row & 15)) << 4)); }
                    asm volatile("" : "+v"(kf[0]), "+v"(kf[1]), "+v"(kf[2]), "+v"(kf[3]), "+v"(kf[4]), "+v"(kf[5]), "+v"(kf[6]), "+v"(kf[7]));
                    sacc[th * 2] = (f32x4){0.f, 0.f, 0.f, 0.f}; sacc[th * 2 + 1] = (f32x4){0.f, 0.f, 0.f, 0.f};
#pragma unroll
                    for (int a = 0; a < 4; ++a)
#pragma unroll
                        for (int tt = 0; tt < 2; ++tt) sacc[th * 2 + tt] = __builtin_amdgcn_mfma_f32_16x16x32_bf16(kf[tt * 4 + a], qf[a], sacc[th * 2 + tt], 0, 0, 0);
                }
                float mx = m;
#pragma unroll
                for (int ti = 0; ti < 4; ++ti)
#pragma unroll
                    for (int r = 0; r < 4; ++r) { const bool valid = (mbits >> (16 * ti + 4 * q4 + r)) & 1ull; const float v = sacc[ti][r] * SC; sacc[ti][r] = v; mx = fmaxf(mx, valid ? v : -1e30f); }
                mx = fmaxf(mx, __shfl_xor(mx, 16)); mx = fmaxf(mx, __shfl_xor(mx, 32));
                const float alpha = __builtin_amdgcn_exp2f(m - mx); m = mx;
                float ps = 0.f;
#pragma unroll
                for (int ti = 0; ti < 4; ++ti)
#pragma unroll
                    for (int r = 0; r < 4; ++r) { const bool valid = (mbits >> (16 * ti + 4 * q4 + r)) & 1ull; const float pv = valid ? __builtin_amdgcn_exp2f(sacc[ti][r] - mx) : 0.f; sacc[ti][r] = pv; ps += pv; }
                lsum = lsum * alpha + ps;
                if (!__all(alpha == 1.f)) {
#pragma unroll
                for (int t = 0; t < 8; ++t) oacc[t] = oacc[t] * alpha; }
                bf16x8 pb[2];
#pragma unroll
                for (int a = 0; a < 2; ++a) {
                    union { uint4 u; bf16x8 v; } cv;
                    cv.u.x = cvt_pk_bf16(sacc[2 * a][0], sacc[2 * a][1]); cv.u.y = cvt_pk_bf16(sacc[2 * a][2], sacc[2 * a][3]);
                    cv.u.z = cvt_pk_bf16(sacc[2 * a + 1][0], sacc[2 * a + 1][1]); cv.u.w = cvt_pk_bf16(sacc[2 * a + 1][2], sacc[2 * a + 1][3]);
                    pb[a] = cv.v; }
#pragma unroll
                for (int tg = 0; tg < 2; ++tg) {
                    bf16x8 vfr[8];
#pragma unroll
                    for (int tt = 0; tt < 4; ++tt) { const int row = 16 * (tg * 4 + tt) + c16;
#pragma unroll
                        for (int a = 0; a < 2; ++a) {
                            union { uint2 h2[2]; bf16x8 v; } vf;
                            vf.h2[0] = *(const uint2*)(Vt + row * 128 + ((((4 * a + (q4 >> 1))) ^ (row & 7)) << 4) + 8 * (q4 & 1));
                            vf.h2[1] = *(const uint2*)(Vt + row * 128 + ((((4 * a + 2 + (q4 >> 1))) ^ (row & 7)) << 4) + 8 * (q4 & 1));
                            vfr[tt * 2 + a] = vf.v; } }
                    asm volatile("" : "+v"(vfr[0]), "+v"(vfr[1]), "+v"(vfr[2]), "+v"(vfr[3]), "+v"(vfr[4]), "+v"(vfr[5]), "+v"(vfr[6]), "+v"(vfr[7]));
#pragma unroll
                    for (int a = 0; a < 2; ++a)
#pragma unroll
                        for (int tt = 0; tt < 4; ++tt) oacc[tg * 4 + tt] = __builtin_amdgcn_mfma_f32_16x16x32_bf16(vfr[tt * 2 + a], pb[a], oacc[tg * 4 + tt], 0, 0, 0);
                }
                if (kt + 1 < nkt) ATT_LSTORE((kt + 1) & 1);
                __syncthreads();
            }
            lsum += __shfl_xor(lsum, 16); lsum += __shfl_xor(lsum, 32);
            const float inv = 1.f / lsum;
#pragma unroll
            for (int t = 0; t < 8; ++t) *(uint2*)(OB + (size_t)tq * 1024 + 512 + h * 128 + 16 * t + 4 * q4) = pack4(oacc[t] * inv);
        }
    }
}

PHASE_FN void ph_gdn_out(const Params& p, int layer) {
    KParams* pp = kparams();
    GU8* wsg_ = (GU8*)pp->ws; asm volatile("" : "+s"(wsg_)); unsigned char* ws_ = (unsigned char*)wsg_;
    int tid_ = threadIdx.x; asm volatile("" : "+v"(tid_)); const int tid = tid_, lane = tid & 63, wv = tid >> 6;
    const float* O = (const float*)(ws_ + OFF_O); const bf16_t* P = (const bf16_t*)(ws_ + OFF_P); bf16_t* OB = (bf16_t*)(ws_ + OFF_OB);
    const float* onw = as_global(pp->gdn_out_norm) + (layer >> 1) * 128;
    for (int t = blockIdx.x * 8 + wv; t < NT; t += gridDim.x * 8) {
#pragma unroll
        for (int h = 0; h < 4; ++h) {
            const float* op = O + (size_t)t * 1024 + h * 128; bf16_t* ob = OB + (size_t)t * 1024 + h * 128;
            const float o0 = op[lane], o1 = op[64 + lane];
            const float ss = wave_sum(o0 * o0 + o1 * o1);
            const float r = rsqrtf(ss * (1.f / 128.f) + EPS);
            const float z0 = PBF(P, t, 1536 + h * 128 + lane), z1 = PBF(P, t, 1536 + h * 128 + 64 + lane);
            ob[lane] = f2bf(o0 * r * onw[lane] * siluf_(z0)); ob[64 + lane] = f2bf(o1 * r * onw[64 + lane] * siluf_(z1));
        }
    }
}

struct EpiOut {
    static constexpr bool PERM = false;
    const float* Xres; float* X; const float* gt0;
    __device__ __forceinline__ void operator()(const f32x4 (&acc)[2][2][4][2], const pg8::Unit& u, int wr, int wc, int fr, int fq) const {
        const int row0 = u.pm * 256 + wr * 64 + fr, col0 = u.pn * 256 + wc * 32 + 4 * fq;
        const float* gt = gt0 + (size_t)(row0 >> 13) * 6144 + col0;
        f32x4 gv[2][2];
#pragma unroll
        for (int bj = 0; bj < 2; ++bj)
#pragma unroll
            for (int n = 0; n < 2; ++n) gv[bj][n] = *(const f32x4*)(gt + bj * 128 + n * 16);
#pragma unroll
        for (int ai = 0; ai < 2; ++ai)
#pragma unroll
            for (int m = 0; m < 4; ++m) { const size_t off = (size_t)(row0 + ai * 128 + m * 16) * ND + col0;
#pragma unroll
                for (int bj = 0; bj < 2; ++bj)
#pragma unroll
                    for (int n = 0; n < 2; ++n) *(f32x4*)(X + off + bj * 128 + n * 16) = *(const f32x4*)(Xres + off + bj * 128 + n * 16) + gv[bj][n] * acc[ai][bj][m][n]; }
    }
};

PHASE_FN void ph_gemm_out(const Params& p, int layer, float* smem) {
    KParams* pp = kparams();
    GU8* wsg_ = (GU8*)pp->ws; asm volatile("" : "+s"(wsg_)); unsigned char* ws_ = (unsigned char*)wsg_;
    int ldz_ = 0; asm volatile("" : "+s"(ldz_));
    const bf16_t* Wt = (const bf16_t*)(ws_ + OFF_WOUT) + (size_t)layer * 1024 * 1024;
    EpiOut E; E.Xres = (layer == 0) ? as_global(pp->x) : (const float*)as_global(pp->X); E.X = as_global(pp->X); E.gt0 = (const float*)(ws_ + OFF_MOD) + (size_t)(layer * 2) * 6144 + 2048;
    pg8::DenseOrder S; S.init(64, 4, gridDim.x, blockIdx.x, 1024);
    __syncthreads();
    pg8::gemm_phase<EpiOut, pg8::DenseOrder, false>((LAS unsigned char*)(g_smem + ldz_), (const bf16_t*)(ws_ + OFF_OB), Wt, 1024, S, E);
    __syncthreads();
}

PHASE_FN void ph_norm_ffn(const Params& p, int layer) {
    KParams* pp = kparams();
    GU8* wsg_ = (GU8*)pp->ws; asm volatile("" : "+s"(wsg_)); unsigned char* ws_ = (unsigned char*)wsg_;
    int tid_ = threadIdx.x; asm volatile("" : "+v"(tid_)); const int tid = tid_, lane = tid & 63, wv = tid >> 6;
    const float* MOD = (const float*)(ws_ + OFF_MOD);
    bf16_t* H = (bf16_t*)(ws_ + OFF_H);
    int* CNT = (int*)(ws_ + OFF_CNT) + layer * 32 * CSTR;
    int* sCnt = (int*)g_smem; int* sBase = sCnt + 32; int* sE = sBase + 32; int* sR = sE + 256;
    const int nrb = (NT + (int)gridDim.x - 1) / (int)gridDim.x, row_lo = blockIdx.x * nrb, row_hi = (row_lo + nrb < NT) ? row_lo + nrb : NT;
    __syncthreads();
    if (tid < 32) sCnt[tid] = 0;
    __syncthreads();
    int* ASG = (int*)(ws_ + OFF_ASG); float* GATE = (float*)(ws_ + OFF_GATE); int* LIST = (int*)(ws_ + OFF_LIST);
    const float* nw = as_global(pp->norm_ffn) + layer * 1024;
    const float* wg = as_global(pp->rg_w) + (size_t)layer * 1024 * 4;
    for (int row = row_lo + wv; row < row_hi; row += 8) {
        const int b = row >> 13;
        const float* xr = as_global(pp->X) + (size_t)row * ND;
        const float* sh = MOD + (size_t)(layer * 2 + b) * 6144 + 3072;
        const float* sc = sh + 1024;
        float hv[16]; float ss = 0.f;
#pragma unroll
        for (int j = 0; j < 4; ++j) { const float4 v = *(const float4*)(xr + j * 256 + lane * 4); hv[4 * j] = v.x; hv[4 * j + 1] = v.y; hv[4 * j + 2] = v.z; hv[4 * j + 3] = v.w; }
#pragma unroll
        for (int j = 0; j < 16; ++j) ss += hv[j] * hv[j];
        ss = wave_sum(ss);
        const float rstd = rsqrtf(ss * (1.f / 1024.f) + EPS);
#pragma unroll
        for (int j = 0; j < 4; ++j) {
            const int col = j * 256 + lane * 4;
            const float4 w = *(const float4*)(nw + col), s4 = *(const float4*)(sc + col), h4 = *(const float4*)(sh + col);
            hv[4 * j] = hv[4 * j] * rstd * w.x * (1.f + s4.x) + h4.x; hv[4 * j + 1] = hv[4 * j + 1] * rstd * w.y * (1.f + s4.y) + h4.y;
            hv[4 * j + 2] = hv[4 * j + 2] * rstd * w.z * (1.f + s4.z) + h4.z; hv[4 * j + 3] = hv[4 * j + 3] * rstd * w.w * (1.f + s4.w) + h4.w;
            { f32x4 ov; ov[0] = hv[4 * j]; ov[1] = hv[4 * j + 1]; ov[2] = hv[4 * j + 2]; ov[3] = hv[4 * j + 3]; *(uint2*)(H + (size_t)row * ND + col) = pack4(ov); }
        }
        float gl[4] = {0.f, 0.f, 0.f, 0.f};
#pragma unroll
        for (int j = 0; j < 4; ++j)
#pragma unroll
            for (int e = 0; e < 4; ++e) { const int col = j * 256 + lane * 4 + e; const float4 w = *(const float4*)(wg + (size_t)col * 4); const float hh = hv[4 * j + e];
                gl[0] += hh * w.x; gl[1] += hh * w.y; gl[2] += hh * w.z; gl[3] += hh * w.w; }
#pragma unroll
        for (int g = 0; g < 4; ++g) gl[g] = wave_sum(gl[g]) + as_global(pp->rg_b)[layer * 4 + g];
        int gs = 0; float gm = gl[0];
#pragma unroll
        for (int g = 1; g < 4; ++g) if (gl[g] > gm) { gm = gl[g]; gs = g; }
        float gsum = 0.f;
#pragma unroll
        for (int g = 0; g < 4; ++g) gsum += expf(gl[g] - gm);
        const float ggate = 1.f / gsum;
        const float* we = as_global(pp->re_w) + ((size_t)(layer * 4 + gs) * 1024) * 8;
        float el[8] = {0.f, 0.f, 0.f, 0.f, 0.f, 0.f, 0.f, 0.f};
#pragma unroll
        for (int j = 0; j < 4; ++j)
#pragma unroll
            for (int e = 0; e < 4; ++e) { const int col = j * 256 + lane * 4 + e; const float4 w0 = *(const float4*)(we + (size_t)col * 8), w1 = *(const float4*)(we + (size_t)col * 8 + 4); const float hh = hv[4 * j + e];
                el[0] += hh * w0.x; el[1] += hh * w0.y; el[2] += hh * w0.z; el[3] += hh * w0.w; el[4] += hh * w1.x; el[5] += hh * w1.y; el[6] += hh * w1.z; el[7] += hh * w1.w; }
#pragma unroll
        for (int e = 0; e < 8; ++e) el[e] = wave_sum(el[e]) + as_global(pp->re_b)[(layer * 4 + gs) * 8 + e];
        int i1 = 0; float l1 = el[0];
#pragma unroll
        for (int e = 1; e < 8; ++e) if (el[e] > l1) { l1 = el[e]; i1 = e; }
        int i2 = -1; float l2 = -INFINITY;
#pragma unroll
        for (int e = 0; e < 8; ++e) if (e != i1 && el[e] > l2) { l2 = el[e]; i2 = e; }
        const float ex = expf(l2 - l1);
        const float p1 = 1.f / (1.f + ex), p2 = ex / (1.f + ex);
        if (lane == 0) {
            const int e1 = gs * 8 + i1, e2 = gs * 8 + i2, lr = row - row_lo;
            sE[lr * 2] = e1; sE[lr * 2 + 1] = e2;
            sR[lr * 2] = atomicAdd(&sCnt[e1], 1); sR[lr * 2 + 1] = atomicAdd(&sCnt[e2], 1);
            GATE[row * 2] = ggate * p1; GATE[row * 2 + 1] = ggate * p2;
        }
    }
    __syncthreads();
    if (tid < 32) sBase[tid] = (sCnt[tid] > 0) ? atomicAdd(&CNT[tid * CSTR], sCnt[tid]) : 0;
    __syncthreads();
    for (int a = tid; a < (row_hi - row_lo) * 2; a += NTHREADS) {
        const int row = row_lo + (a >> 1), e = sE[a], r = sBase[e] + sR[a];
        LIST[(size_t)e * LISTCAP + r] = row;
        ASG[row * 4 + (a & 1) * 2] = e; ASG[row * 4 + (a & 1) * 2 + 1] = r;
    }
}

struct MoeOrder {
    const int* sTs; const int* sPad; const int* CNT; const int* LIST; int G, c, which, K;
    __device__ __forceinline__ bool next(int i, pg8::Unit& u) const {
        const long L = (long)i * G + c; if (L >= (long)__builtin_amdgcn_readfirstlane(sTs[32]) * 4) return false;
        const int mt = (int)(L >> 2), nt = (int)(L & 3);
        int e = 0;
        for (int q = 1; q < 32; ++q) if (__builtin_amdgcn_readfirstlane(sTs[q]) <= mt) e = q;
        const int mi = mt - __builtin_amdgcn_readfirstlane(sTs[e]), cnt = __builtin_amdgcn_readfirstlane(CNT[e * CSTR]);
        u.pm = mt; u.pn = nt; u.e = e; u.mi = mi; u.mvalid = (cnt - mi * 256 < 256) ? (cnt - mi * 256) : 256; u.rowbase = __builtin_amdgcn_readfirstlane(sPad[e]) + mi * 256;
        u.boff = ((size_t)e * 1024 + nt * 256) * K * 2;
        u.aoff = which ? (size_t)u.rowbase * 512 * 2 : 0;
        return true;
    }
    __device__ __forceinline__ int row(const pg8::Unit& u, int r) const { const int rr = (r < u.mvalid) ? r : 0; return LIST[(size_t)u.e * LISTCAP + u.mi * 256 + rr]; }
};
struct EpiMoe1 {
    static constexpr bool PERM = false;
    bf16_t* HID;
    __device__ __forceinline__ void operator()(const f32x4 (&acc)[2][2][4][2], const pg8::Unit& u, int wr, int wc, int fr, int fq) const {
#pragma unroll
        for (int ai = 0; ai < 2; ++ai)
#pragma unroll
            for (int m = 0; m < 4; ++m) { const int rl = ai * 128 + wr * 64 + m * 16 + fr;
                if (rl < u.mvalid) {
#pragma unroll
                    for (int bj = 0; bj < 2; ++bj) { const f32x4 a1 = acc[ai][bj][m][0], a3 = acc[ai][bj][m][1]; f32x4 hv;
                        hv[0] = silu_fast(a1[0]) * a3[0]; hv[1] = silu_fast(a1[1]) * a3[1]; hv[2] = silu_fast(a1[2]) * a3[2]; hv[3] = silu_fast(a1[3]) * a3[3];
                        *(uint2*)(HID + (size_t)(u.rowbase + rl) * 512 + u.pn * 128 + bj * 64 + wc * 16 + 4 * fq) = pack4(hv); } } }
    }
};
struct EpiMoe2 {
    static constexpr bool PERM = true;
    bf16_t* YB;
    __device__ __forceinline__ void operator()(const f32x4 (&acc)[2][2][4][2], const pg8::Unit& u, int wr, int wc, int fr, int fq) const {
#pragma unroll
        for (int ai = 0; ai < 2; ++ai)
#pragma unroll
            for (int m = 0; m < 4; ++m) { const int rl = ai * 128 + wr * 64 + m * 16 + fr;
                if (rl < u.mvalid) {
#pragma unroll
                    for (int bj = 0; bj < 2; ++bj) { const uint2 lo = pack4(acc[ai][bj][m][0]), hi = pack4(acc[ai][bj][m][1]);
                        *(uint4*)(YB + (size_t)(u.rowbase + rl) * 1024 + u.pn * 256 + bj * 128 + wc * 32 + 8 * fq) = make_uint4(lo.x, lo.y, hi.x, hi.y); } } }
    }
};

PHASE_FN void ph_moe(const Params& p, int layer, int which, float* smem) {
    KParams* pp = kparams();
    GU8* wsg_ = (GU8*)pp->ws; asm volatile("" : "+s"(wsg_)); unsigned char* ws_ = (unsigned char*)wsg_;
    int ldz_ = 0; asm volatile("" : "+s"(ldz_));
    int tid_ = threadIdx.x; asm volatile("" : "+v"(tid_)); const int tid = tid_;
    int* sPad = (int*)(g_smem + ldz_ + 131072); int* sTs = sPad + 40;
    const int* CNT = (const int*)(ws_ + OFF_CNT) + layer * 32 * CSTR;
    __syncthreads();
    if (tid == 0) { int a = 0, ts = 0; for (int e = 0; e < 32; ++e) { sPad[e] = a; sTs[e] = ts; a += ((CNT[e * CSTR] + 127) / 128) * 128; ts += (CNT[e * CSTR] + 255) / 256; } sTs[32] = ts; sPad[32] = a; }
    __syncthreads();
    MoeOrder S; S.sTs = sTs; S.sPad = sPad; S.CNT = CNT; S.LIST = (const int*)(ws_ + OFF_LIST); S.G = gridDim.x; S.which = which; S.K = which ? 512 : 1024;
    S.c = (((int)gridDim.x & 7) == 0) ? (((int)blockIdx.x & 7) * ((int)gridDim.x >> 3) + ((int)blockIdx.x >> 3)) : (int)blockIdx.x;
    if (which == 0) {
        EpiMoe1 E; E.HID = (bf16_t*)(ws_ + OFF_HID);
        pg8::gemm_phase<EpiMoe1, MoeOrder, true>((LAS unsigned char*)(g_smem + ldz_), (const bf16_t*)(ws_ + OFF_H), (const bf16_t*)(ws_ + OFF_W13), 1024, S, E);
    } else {
        EpiMoe2 E; E.YB = (bf16_t*)(ws_ + OFF_YB);
        pg8::gemm_phase<EpiMoe2, MoeOrder, false>((LAS unsigned char*)(g_smem + ldz_), (const bf16_t*)(ws_ + OFF_HID), (const bf16_t*)(ws_ + OFF_W2T), 512, S, E);
    }
    __syncthreads();
}

PHASE_FN void ph_conv_dense(const Params& p, float* smem) {
    KParams* pp = kparams();
    GU8* wsg_ = (GU8*)pp->ws; asm volatile("" : "+s"(wsg_)); unsigned char* ws_ = (unsigned char*)wsg_;
    { int ldz_ = 0; asm volatile("" : "+s"(ldz_)); smem = (float*)(g_smem + ldz_); }
    auto dec = [&](int t, const float*& s0, const float*& s1, bf16_t*& dst, int& mode, int& K, int& N, int& ld, int& rt, int& kt) {
        s1 = nullptr; mode = 0; K = 1024;
        if (t >= 4672) t = 4671;
        if (t >= 4608) { const int v = t - 4608, l = v >> 5, u = v & 31; s0 = as_global(pp->gla_w_in) + (size_t)l * 1024 * 3088 + 3072; N = 16; ld = 3088; dst = (bf16_t*)(ws_ + OFF_WGL) + (size_t)l * 128 * 1024; rt = u >> 4; kt = u & 15; }
        else if (t < 2048) { const int l = t >> 10, u = t & 1023; s0 = as_global(pp->even_w_in) + (size_t)l * 1024 * 3916; N = 3916; ld = 3916; dst = (bf16_t*)(ws_ + OFF_WINE) + (size_t)l * 4096 * 1024; rt = u >> 4; kt = u & 15; }
        else if (t < 3584) { const int v = t - 2048, l = v / 768, u = v % 768; s0 = as_global(pp->gla_w_in) + (size_t)l * 1024 * 3088; N = 3072; ld = 3088; dst = (bf16_t*)(ws_ + OFF_WINO) + (size_t)l * 3072 * 1024; rt = u >> 4; kt = u & 15; }
        else { const int v = t - 3584, l = v >> 8, u = v & 255; s0 = ((l & 1) ? as_global(pp->gla_w_out) : as_global(pp->even_w_out)) + (size_t)(l >> 1) * 1024 * 1024; N = 1024; ld = 1024; dst = (bf16_t*)(ws_ + OFF_WOUT) + (size_t)l * 1024 * 1024; rt = u >> 4; kt = u & 15; }
    };
    convert_stream(dec, blockIdx.x * 4, gridDim.x * 4, 4672, smem);
}

PHASE_FN void ph_conv_exp(const Params& p, int layer, float* smem, int first_blk) {
    KParams* pp = kparams();
    GU8* wsg_ = (GU8*)pp->ws; asm volatile("" : "+s"(wsg_)); unsigned char* ws_ = (unsigned char*)wsg_;
    { int ldz_ = 0; asm volatile("" : "+s"(ldz_)); smem = (float*)(g_smem + ldz_); }
    if ((int)blockIdx.x < first_blk) return;
    auto dec = [&](int t, const float*& s0, const float*& s1, bf16_t*& dst, int& mode, int& K, int& N, int& ld, int& rt, int& kt) {
        if (t >= 12288) t = 12287;
        if (t < 8192) { const int e = t >> 8, u = t & 255; s0 = as_global(pp->w1) + (size_t)(layer * 32 + e) * 1024 * 512; s1 = as_global(pp->w3) + (size_t)(layer * 32 + e) * 1024 * 512; mode = 1; K = 1024; N = 512; ld = 512;
            dst = (bf16_t*)(ws_ + OFF_W13) + (size_t)e * 1024 * 1024; rt = u >> 4; kt = u & 15; }
        else { const int v = t - 8192, e = v >> 7, u = v & 127; s0 = as_global(pp->w2) + (size_t)(layer * 32 + e) * 512 * 1024; s1 = nullptr; mode = 0; K = 512; N = 1024; ld = 1024;
            dst = (bf16_t*)(ws_ + OFF_W2T) + (size_t)e * 1024 * 512; rt = u >> 3; kt = u & 7; }
    };
    convert_stream(dec, ((int)blockIdx.x - first_blk) * 4, ((int)gridDim.x - first_blk) * 4, 12288, smem);
}

PHASE_FN void ph_gla_tok(const Params& p, int layer) {
    KParams* pp = kparams();
    GU8* wsg_ = (GU8*)pp->ws; asm volatile("" : "+s"(wsg_)); unsigned char* ws_ = (unsigned char*)wsg_;
    int tid_ = threadIdx.x; asm volatile("" : "+v"(tid_)); const int tid = tid_, lane = tid & 63, wv = tid >> 6, li = layer >> 1;
    const float* AUX = (const float*)(ws_ + OFF_AUX);
    float* LA = (float*)(ws_ + OFF_LA);
    const float* w2 = as_global(pp->gla_w_gate2) + (size_t)li * 16 * 512; const float* b2 = as_global(pp->gla_b_gate2) + li * 512;
    for (int t = blockIdx.x * 8 + wv; t < NT; t += gridDim.x * 8) {
        float glr[16];
#pragma unroll
        for (int r = 0; r < 16; ++r) glr[r] = AUX[(size_t)t * 16 + r];
#pragma unroll 1
        for (int i = 0; i < 8; ++i) {
            const int c = lane + 64 * i; float z = b2[c];
#pragma unroll
            for (int r = 0; r < 16; ++r) z += glr[r] * w2[r * 512 + c];
            LA[(size_t)t * 512 + c] = -softplusf_(-z) * (1.f / 16.f);
        }
    }
}

PHASE_FN void ph_gla_chunk(const Params& p, int layer, float* smem) {
    KParams* pp = kparams();
    GU8* wsg_ = (GU8*)pp->ws; asm volatile("" : "+s"(wsg_)); unsigned char* ws_ = (unsigned char*)wsg_;
    int tid_ = threadIdx.x; asm volatile("" : "+v"(tid_)); const int tid = tid_, lane = tid & 63, wv = __builtin_amdgcn_readfirstlane(tid >> 6), q4 = lane >> 4, c16 = lane & 15;
    int ldz_ = 0; asm volatile("" : "+s"(ldz_)); unsigned char* lds = g_smem + ldz_;
    constexpr int SN = 272, ST = 144;
    float* sBc = (float*)lds;
    unsigned char* bQE = lds + 33024;
    unsigned char* bKE = lds + 50432;
    unsigned char* bKD = lds + 67840;
    unsigned char* bVT = lds + 86272;
    unsigned char* bATT = lds + 123136;
    const bf16_t* P = (const bf16_t*)(ws_ + OFF_P); const float* AUX = (const float*)(ws_ + OFF_AUX);
    const float* w2 = as_global(pp->gla_w_gate2) + (size_t)(layer >> 1) * 16 * 512; const float* b2 = as_global(pp->gla_b_gate2) + (layer >> 1) * 512;
    float* sGlr = (float*)(lds + 132352);
    uint4* QEF = (uint4*)(ws_ + OFF_GQE); uint2* OIF = (uint2*)(ws_ + OFF_GOI); uint2* HF = (uint2*)(ws_ + OFF_GH); float* EBL = (float*)(ws_ + OFF_GEBL);
    for (int ci = blockIdx.x; ci < 1024; ci += gridDim.x) {
        const int b = ci >> 9, h = (ci >> 7) & 3, n = ci & 127;
        const int t0 = b * 8192 + n * 64;
        __syncthreads();
        for (int e = tid; e < 1024; e += NTHREADS) sGlr[e] = AUX[(size_t)(t0 + (e >> 4)) * 16 + (e & 15)];
        __syncthreads();
        {
            const int d = tid & 127, c = h * 128 + d;
            float wg[16];
#pragma unroll
            for (int r = 0; r < 16; ++r) wg[r] = w2[r * 512 + c];
            const float bz = b2[c];
            for (int i = tid >> 7; i < 64; i += 4) {
                float z = bz;
#pragma unroll
                for (int r = 0; r < 16; ++r) z += sGlr[i * 16 + r] * wg[r];
                sBc[i * 129 + d] = -softplusf_(-z) * (1.f / 16.f);
            }
        }
        for (int e = tid; e < 64 * 36; e += NTHREADS) ((unsigned*)bATT)[e] = 0u;
        __syncthreads();
        if (tid < 128) { float a = 0.f; for (int i = 0; i < 64; ++i) { a += sBc[i * 129 + tid]; sBc[i * 129 + tid] = a; } }
        __syncthreads();
        {
            const int d = tid & 127, ig = tid >> 7;
            const float bl = sBc[63 * 129 + d];
#pragma unroll
            for (int gg = 0; gg < 2; ++gg) { const int g = ig + 4 * gg;
                float kd8[8];
#pragma unroll
                for (int r = 0; r < 8; ++r) { const int i = g * 8 + r;
                    const float bb = sBc[i * 129 + d];
                    const float qf = PBF(P, t0 + i, h * 128 + d), kf = PBF(P, t0 + i, 512 + h * 128 + d);
                    *(bf16_t*)(bQE + i * SN + d * 2) = f2bf(qf * SCALE128 * expf(bb));
                    *(bf16_t*)(bKE + i * SN + d * 2) = f2bf(kf * expf(-bb));
                    kd8[r] = kf * expf(bl - bb); }
                *(uint4*)(bKD + d * ST + g * 16) = make_uint4(cvt_pk_bf16(kd8[0], kd8[1]), cvt_pk_bf16(kd8[2], kd8[3]), cvt_pk_bf16(kd8[4], kd8[5]), cvt_pk_bf16(kd8[6], kd8[7]));
            }
            const int dv = tid & 255, hf = tid >> 8;
#pragma unroll
            for (int gg = 0; gg < 4; ++gg) { const int g = hf * 4 + gg;
                unsigned short v8[8];
#pragma unroll
                for (int r = 0; r < 8; ++r) v8[r] = P[(size_t)(t0 + g * 8 + r) * LDPB + 1024 + h * 256 + dv];
                *(uint4*)(bVT + dv * ST + g * 16) = make_uint4((unsigned)v8[0] | ((unsigned)v8[1] << 16), (unsigned)v8[2] | ((unsigned)v8[3] << 16), (unsigned)v8[4] | ((unsigned)v8[5] << 16), (unsigned)v8[6] | ((unsigned)v8[7] << 16));
            }
        }
        if (tid < 128) EBL[ci * 128 + tid] = expf(sBc[63 * 129 + tid]);
        __syncthreads();
        for (int u = wv; u < 10; u += 8) {
            const int ti = (u >= 6) ? 3 : (u >= 3) ? 2 : (u >= 1) ? 1 : 0, tj = u - ((ti * (ti + 1)) >> 1);
            f32x4 acc = (f32x4){0.f, 0.f, 0.f, 0.f};
            acc = mma_lds(bQE, SN, 16 * ti, bKE, SN, 16 * tj, 128, acc, c16, q4);
            const int j = 16 * tj + c16;
#pragma unroll
            for (int r = 0; r < 4; ++r) { const int i = 16 * ti + 4 * q4 + r; *(bf16_t*)(bATT + i * ST + j * 2) = f2bf((j <= i) ? acc[r] : 0.f); }
        }
        for (int x = 0; x < 2; ++x) {
            const int u = wv * 2 + x, ti = u >> 2, a = u & 3;
            const unsigned char* rp = bQE + (16 * ti + c16) * SN;
            const uint2 lo = *(const uint2*)(rp + (32 * a + 4 * q4) * 2), hi = *(const uint2*)(rp + (32 * a + 16 + 4 * q4) * 2);
            QEF[((size_t)(ci * 4 + ti) * 4 + a) * 64 + lane] = make_uint4(lo.x, lo.y, hi.x, hi.y);
        }
        __syncthreads();
#pragma unroll 4
        for (int x = 0; x < 8; ++x) {
            const int u = wv * 8 + x, tdv = u >> 2, ti = u & 3;
            f32x4 acc = (f32x4){0.f, 0.f, 0.f, 0.f};
            acc = mma_lds(bATT, ST, 16 * ti, bVT, ST, 16 * tdv, 64, acc, c16, q4);
            OIF[((size_t)(ci * 16 + tdv) * 4 + ti) * 64 + lane] = pack4(acc);
        }
#pragma unroll 4
        for (int x = 0; x < 16; ++x) {
            const int u = wv * 16 + x, tdv = u >> 3, tdk = u & 7;
            f32x4 acc = (f32x4){0.f, 0.f, 0.f, 0.f};
            acc = mma_lds(bKD, ST, 16 * tdk, bVT, ST, 16 * tdv, 64, acc, c16, q4);
            HF[((size_t)(ci * 16 + tdv) * 8 + tdk) * 64 + lane] = pack4(acc);
        }
    }
}

PHASE_FN void ph_gla_scan(const Params& p, float* smem) {
    KParams* pp = kparams();
    GU8* wsg_ = (GU8*)pp->ws; asm volatile("" : "+s"(wsg_)); unsigned char* ws_ = (unsigned char*)wsg_;
    int tid_ = threadIdx.x; asm volatile("" : "+v"(tid_)); const int tid = tid_, lane = tid & 63, wv = __builtin_amdgcn_readfirstlane(tid >> 6), q4 = lane >> 4, c16 = lane & 15;
    int ldz_ = 0; asm volatile("" : "+s"(ldz_)); unsigned char* lds = g_smem + ldz_;
    constexpr int STG = 29184;
    const unsigned char* QEF = ws_ + OFF_GQE; const unsigned char* HF = ws_ + OFF_GH; const unsigned char* OIF = ws_ + OFF_GOI; const unsigned char* EBL = ws_ + OFF_GEBL;
    float* O = (float*)(ws_ + OFF_O);
    for (int it = blockIdx.x; it < 64; it += gridDim.x) {
        const int bh = it >> 3, pair = it & 7, b = bh >> 2, h = bh & 3;
        __syncthreads();
        if (wv >= 2) {
            const int lt = tid - 128;
            const unsigned char* Qb = QEF + (size_t)bh * 128 * 16384;
            const unsigned char* Hb = HF + (size_t)bh * 128 * 65536 + pair * 8192;
            const unsigned char* Ob = OIF + (size_t)bh * 128 * 32768 + pair * 4096;
            const unsigned char* Lb = EBL + (size_t)bh * 128 * 512;
            uint4 ra0, ra1, ra2, ra3, ra4, ra5, ra6, rb0, rb1, rb2, rb3, rb4, rb5, rb6, rc0, rc1, rc2, rc3, rc4, rc5, rc6, rd0, rd1, rd2, rd3, rd4, rd5, rd6;
#define GL_LOAD(X, n_) do { const unsigned char* q_ = Qb + (size_t)(n_) * 16384; const unsigned char* h_ = Hb + (size_t)(n_) * 65536; \
                const unsigned char* o_ = Ob + (size_t)(n_) * 32768; const unsigned char* l_ = Lb + (size_t)(n_) * 512; \
                X##0 = LDC(q_, lt, 1023); X##1 = LDC(q_, lt + 384, 1023); X##2 = LDC(q_, lt + 768, 1023); \
                X##3 = LDC(h_, lt, 511); X##4 = LDC(h_, lt + 384, 511); X##5 = LDC(o_, lt, 255); X##6 = LDC(l_, lt, 31); } while (0)
#define GL_STORE(X, st_) do { unsigned char* sb_ = lds + (st_) * STG; \
                STC(0, lt, 1024, X##0); STC(0, lt + 384, 1024, X##1); STC(0, lt + 768, 1024, X##2); \
                STC(16384, lt, 512, X##3); STC(16384, lt + 384, 512, X##4); STC(24576, lt, 256, X##5); STC(28672, lt, 32, X##6); } while (0)
            GL_LOAD(ra, 0); GL_STORE(ra, 0);
            GL_LOAD(rb, 1); GL_LOAD(rc, 2); GL_LOAD(rd, 3); GL_LOAD(ra, 4);
            __syncthreads();
            for (int n = 0; n < 128; n += 4) {
                GL_STORE(rb, 1); GL_LOAD(rb, CLAMPN(n + 5)); LBAR();
                GL_STORE(rc, 0); GL_LOAD(rc, CLAMPN(n + 6)); LBAR();
                GL_STORE(rd, 1); GL_LOAD(rd, CLAMPN(n + 7)); LBAR();
                if (n + 4 < 128) GL_STORE(ra, 0);
                GL_LOAD(ra, CLAMPN(n + 8)); LBAR();
            }
        } else {
            const int tdv = pair * 2 + wv;
            f32x4 S[8];
#pragma unroll
            for (int t = 0; t < 8; ++t) S[t] = (f32x4){0.f, 0.f, 0.f, 0.f};
            __syncthreads();
            for (int n = 0; n < 128; ++n) {
                const unsigned char* base = lds + (n & 1) * STG;
                const unsigned char* Qf = base + lane * 16, *Hf = base + 16384 + wv * 4096 + lane * 8, *Of = base + 24576 + wv * 2048 + lane * 8, *Lf = base + 28672 + q4 * 16;
                bf16x8 Sb[4];
#pragma unroll
                for (int a = 0; a < 4; ++a) { union { uint4 u; bf16x8 v; } cv; const uint2 lo = pack4(S[2 * a]), hi = pack4(S[2 * a + 1]); cv.u.x = lo.x; cv.u.y = lo.y; cv.u.z = hi.x; cv.u.w = hi.y; Sb[a] = cv.v; }
                const int t0 = b * 8192 + n * 64;
                f32x4 oa[4];
                uint2 o4[4];
#pragma unroll
                for (int ti = 0; ti < 4; ++ti) o4[ti] = *(const uint2*)(Of + ti * 512);
#pragma unroll
                for (int hf = 0; hf < 2; ++hf) {
                    bf16x8 qf[8];
#pragma unroll
                    for (int tt = 0; tt < 2; ++tt)
#pragma unroll
                        for (int a = 0; a < 4; ++a) qf[tt * 4 + a] = *(const bf16x8*)(Qf + ((hf * 2 + tt) * 4 + a) * 1024);
                    asm volatile("" : "+v"(qf[0]), "+v"(qf[1]), "+v"(qf[2]), "+v"(qf[3]), "+v"(qf[4]), "+v"(qf[5]), "+v"(qf[6]), "+v"(qf[7]));
                    oa[hf * 2] = unpack4(o4[hf * 2]); oa[hf * 2 + 1] = unpack4(o4[hf * 2 + 1]);
#pragma unroll
                    for (int a = 0; a < 4; ++a)
#pragma unroll
                        for (int tt = 0; tt < 2; ++tt) oa[hf * 2 + tt] = __builtin_amdgcn_mfma_f32_16x16x32_bf16(qf[tt * 4 + a], Sb[a], oa[hf * 2 + tt], 0, 0, 0);
                }
                {
                    f32x4 lam[8]; uint2 h8[8];
#pragma unroll
                    for (int t = 0; t < 8; ++t) { lam[t] = *(const f32x4*)(Lf + t * 64); h8[t] = *(const uint2*)(Hf + t * 512); }
                    asm volatile("" : "+v"(lam[0]), "+v"(lam[1]), "+v"(lam[2]), "+v"(lam[3]), "+v"(lam[4]), "+v"(lam[5]), "+v"(lam[6]), "+v"(lam[7]));
#pragma unroll
                    for (int ti = 0; ti < 4; ++ti) {
                        float* op = O + (size_t)(t0 + 16 * ti + 4 * q4) * 1024 + h * 256 + 16 * tdv + c16;
                        op[0] = oa[ti][0]; op[1024] = oa[ti][1]; op[2048] = oa[ti][2]; op[3072] = oa[ti][3]; }
#pragma unroll
                    for (int t = 0; t < 8; ++t) S[t] = S[t] * lam[t] + unpack4(h8[t]);
                }
                LBAR();
            }
        }
    }
}

PHASE_FN void ph_gla_out(const Params& p, int layer) {
    KParams* pp = kparams();
    GU8* wsg_ = (GU8*)pp->ws; asm volatile("" : "+s"(wsg_)); unsigned char* ws_ = (unsigned char*)wsg_;
    int tid_ = threadIdx.x; asm volatile("" : "+v"(tid_)); const int tid = tid_, lane = tid & 63, wv = tid >> 6;
    const float* O = (const float*)(ws_ + OFF_O); const bf16_t* P = (const bf16_t*)(ws_ + OFF_P); bf16_t* OB = (bf16_t*)(ws_ + OFF_OB);
    const float* onw = as_global(pp->gla_out_norm) + (layer >> 1) * 256;
    for (int t = blockIdx.x * 8 + wv; t < NT; t += gridDim.x * 8) {
#pragma unroll
        for (int h = 0; h < 4; ++h) {
            const float* op = O + (size_t)t * 1024 + h * 256;
            const float4 o = *(const float4*)(op + lane * 4);
            const float ss = wave_sum(o.x * o.x + o.y * o.y + o.z * o.z + o.w * o.w);
            const float r = rsqrtf(ss * (1.f / 256.f) + EPS);
            const f32x4 z = unpack4(*(const uint2*)(P + (size_t)t * LDPB + 2048 + h * 256 + lane * 4));
            const float4 w = *(const float4*)(onw + lane * 4);
            f32x4 ov; ov[0] = o.x * r * w.x * siluf_(z[0]); ov[1] = o.y * r * w.y * siluf_(z[1]); ov[2] = o.z * r * w.z * siluf_(z[2]); ov[3] = o.w * r * w.w * siluf_(z[3]);
            *(uint2*)(OB + (size_t)t * 1024 + h * 256 + lane * 4) = pack4(ov);
        }
    }
}

template <int PH>
__device__ __forceinline__ void run_phase(const Params& p, int layer, float* smem) {
    if (PH == PH_PROLOGUE) { ph_prologue(p, smem); ph_conv_dense(p, smem); }
    else if (PH == PH_NORM_MIX) ph_rows(p, layer, 0, smem);
    else if (PH == PH_GEMM_IN_EVEN) ph_gemm_in(p, layer, true, smem);
    else if (PH == PH_EVEN_TOK) { ph_even_tok(p, layer, smem); ph_gdn_chunk(p, layer, smem); if (DUP_MASK & 8192) ph_gdn_chunk(p, layer, smem); if (DUP_MASK & 16384) ph_even_tok(p, layer, smem); }
    else if (PH == PH_GDN_CHUNK) ph_gdn_chunk(p, layer, smem);
    else if (PH == PH_GDN_SCAN) { ph_gdn_scan(p, smem); ph_conv_exp(p, layer, smem, 32); ph_dsa_topk(p, layer, smem); }
    else if (PH == PH_DSA_TOPK) ph_dsa_topk(p, layer, smem);
    else if (PH == PH_DSA_ATTN) { ph_dsa_attn(p, smem); ph_gdn_out(p, layer); if (DUP_MASK & 32768) ph_dsa_attn(p, smem); }
    else if (PH == PH_GDN_OUT) ph_gdn_out(p, layer);
    else if (PH == PH_GEMM_OUT) ph_gemm_out(p, layer, smem);
    else if (PH == PH_NORM_FFN) ph_norm_ffn(p, layer);
    else if (PH == PH_MOE1) ph_moe(p, layer, 0, smem);
    else if (PH == PH_MOE2) ph_moe(p, layer, 1, smem);
    else if (PH == PH_GEMM_IN_ODD) ph_gemm_in(p, layer, false, smem);
    else if (PH == PH_GLA_TOK) ph_gla_tok(p, layer);
    else if (PH == PH_GLA_CHUNK) ph_gla_chunk(p, layer, smem);
    else if (PH == PH_GLA_SCAN) { ph_gla_scan(p, smem); ph_conv_exp(p, layer, smem, 64); if (DUP_MASK & 65536) ph_gla_scan(p, smem); if (DUP_MASK & 131072) ph_conv_exp(p, layer, smem, 64); }
    else if (PH == PH_GLA_OUT) ph_gla_out(p, layer);
    else if (PH == PH_FINAL) ph_rows(p, 0, 1, smem);
}

#if MK_MULTI
template <int PH>
__global__ void __launch_bounds__(NTHREADS, 2) k_phase(Params p, int layer) {
    run_phase<PH>(p, layer, (float*)g_smem);
}
#else
__global__ void __launch_bounds__(NTHREADS, 2) k_mega(Params p) {
    float* smem = (float*)g_smem;
    volatile LAS unsigned* xbw = (volatile LAS unsigned*)(LAS unsigned char*)(g_smem + LDS_BYTES - 16);
    if (threadIdx.x == 0) { xbw[0] = 0u; xbw[1] = 0u; xbw[2] = 0u; xbw[3] = 0u; }
    __syncthreads();
    XcdBarrier bar = xcd_barrier_post((unsigned*)(p.ws + OFF_BAR), xbw);
#define BAR() do { XcdBarrier bb_ = bar; asm volatile("" : "+s"(bb_.x)); { __attribute__((address_space(1))) unsigned* gb_ = (__attribute__((address_space(1))) unsigned*)bb_.bar; asm volatile("" : "+s"(gb_)); bb_.bar = (unsigned*)gb_; } xcd_barrier(bb_); } while (0)
    run_phase<PH_PROLOGUE>(p, 0, smem); BAR(); if (DUP_MASK & 4096) { run_phase<PH_PROLOGUE>(p, 0, smem); BAR(); }
    for (int lp = 0; lp < 2; ++lp) {
        const int le = 2 * lp, lo = 2 * lp + 1;
        run_phase<PH_NORM_MIX>(p, le, smem); BAR();
        run_phase<PH_GEMM_IN_EVEN>(p, le, smem); BAR(); if (DUP_MASK & 1) { run_phase<PH_GEMM_IN_EVEN>(p, le, smem); BAR(); }
        run_phase<PH_EVEN_TOK>(p, le, smem); BAR(); if (DUP_MASK & 2) { run_phase<PH_EVEN_TOK>(p, le, smem); BAR(); }
        run_phase<PH_GDN_SCAN>(p, le, smem); BAR(); if (DUP_MASK & 8) { run_phase<PH_GDN_SCAN>(p, le, smem); BAR(); } if (DUP_MASK & 262144) { run_phase<PH_DSA_TOPK>(p, le + 1, smem); BAR(); }
        run_phase<PH_DSA_ATTN>(p, le, smem); BAR(); if (DUP_MASK & 32) { run_phase<PH_DSA_ATTN>(p, le, smem); BAR(); }
        run_phase<PH_GEMM_OUT>(p, le, smem); BAR();
        run_phase<PH_NORM_FFN>(p, le, smem); BAR();
        run_phase<PH_MOE1>(p, le, smem); BAR(); if (DUP_MASK & 64) { run_phase<PH_MOE1>(p, le, smem); BAR(); }
        run_phase<PH_MOE2>(p, le, smem); BAR(); if (DUP_MASK & 128) { run_phase<PH_MOE2>(p, le, smem); BAR(); }
        run_phase<PH_NORM_MIX>(p, lo, smem); BAR();
        run_phase<PH_GEMM_IN_ODD>(p, lo, smem); BAR(); if (DUP_MASK & 256) { run_phase<PH_GEMM_IN_ODD>(p, lo, smem); BAR(); }
        run_phase<PH_GLA_CHUNK>(p, lo, smem); BAR(); if (DUP_MASK & 1024) { run_phase<PH_GLA_CHUNK>(p, lo, smem); BAR(); }
        run_phase<PH_GLA_SCAN>(p, lo, smem); BAR(); if (DUP_MASK & 2048) { run_phase<PH_GLA_SCAN>(p, lo, smem); BAR(); }
        run_phase<PH_GLA_OUT>(p, lo, smem); BAR();
        run_phase<PH_GEMM_OUT>(p, lo, smem); BAR();
        run_phase<PH_NORM_FFN>(p, lo, smem); BAR();
        run_phase<PH_MOE1>(p, lo, smem); BAR(); if (DUP_MASK & 64) { run_phase<PH_MOE1>(p, lo, smem); BAR(); }
        run_phase<PH_MOE2>(p, lo, smem); BAR(); if (DUP_MASK & 128) { run_phase<PH_MOE2>(p, lo, smem); BAR(); }
    }
    for (int xb = 0; xb < EXTRA_BARS; ++xb) BAR();
    run_phase<PH_FINAL>(p, 0, smem);
}
#endif

}

#if MK_MULTI
template <int PH>
static void launch_phase(const Params& p, int layer, hipStream_t stream) {
    static bool attr_set = false;
    if (!attr_set) { hipFuncSetAttribute((const void*)k_phase<PH>, hipFuncAttributeMaxDynamicSharedMemorySize, (int)LDS_BYTES); attr_set = true; }
    hipLaunchKernelGGL((k_phase<PH>), dim3(256), dim3(NTHREADS), LDS_BYTES, stream, p, layer);
}
#endif

extern "C" void kernel_launch(void* const* d_in, const int* in_sizes, int n_in, void* d_out, int out_size, void* d_ws, size_t ws_size, hipStream_t stream) {
    (void)in_sizes; (void)n_in; (void)out_size;
    if (ws_size < WS_NEEDED) { fprintf(stderr, "workspace too small: %zu < %zu\n", ws_size, (size_t)WS_NEEDED); return; }
    Params p{};
    p.x = (const float*)d_in[0]; p.c = (const float*)d_in[1]; p.pos = (const int*)d_in[2]; p.ada_w = (const float*)d_in[3]; p.ada_b = (const float*)d_in[4];
    p.norm_mix = (const float*)d_in[5]; p.norm_ffn = (const float*)d_in[6]; p.even_w_in = (const float*)d_in[7]; p.conv_w = (const float*)d_in[8];
    p.a_log = (const float*)d_in[9]; p.dt_bias = (const float*)d_in[10]; p.gdn_out_norm = (const float*)d_in[11]; p.even_w_out = (const float*)d_in[12];
    p.gla_w_in = (const float*)d_in[13]; p.gla_w_gate2 = (const float*)d_in[14]; p.gla_b_gate2 = (const float*)d_in[15]; p.gla_out_norm = (const float*)d_in[16]; p.gla_w_out = (const float*)d_in[17];
    p.rg_w = (const float*)d_in[18]; p.rg_b = (const float*)d_in[19]; p.re_w = (const float*)d_in[20]; p.re_b = (const float*)d_in[21];
    p.w1 = (const float*)d_in[22]; p.w3 = (const float*)d_in[23]; p.w2 = (const float*)d_in[24]; p.final_norm = (const float*)d_in[25];
    p.X = (float*)d_out; p.ws = (unsigned char*)d_ws;
    p.rA = pow(10000.0, -2.0 / 128.0); p.rI = pow(10000.0, -2.0 / 64.0);
    hipMemsetAsync(d_ws, 0, ZERO_BYTES, stream);
#if MK_MULTI
    launch_phase<PH_PROLOGUE>(p, 0, stream);
    for (int lp = 0; lp < 2; ++lp) {
        const int le = 2 * lp, lo = 2 * lp + 1;
        launch_phase<PH_NORM_MIX>(p, le, stream);
        launch_phase<PH_GEMM_IN_EVEN>(p, le, stream);
        launch_phase<PH_EVEN_TOK>(p, le, stream);
        launch_phase<PH_GDN_SCAN>(p, le, stream);
        launch_phase<PH_DSA_ATTN>(p, le, stream);
        launch_phase<PH_GEMM_OUT>(p, le, stream);
        launch_phase<PH_NORM_FFN>(p, le, stream);
        launch_phase<PH_MOE1>(p, le, stream);
        launch_phase<PH_MOE2>(p, le, stream);
        launch_phase<PH_NORM_MIX>(p, lo, stream);
        launch_phase<PH_GEMM_IN_ODD>(p, lo, stream);
        launch_phase<PH_GLA_CHUNK>(p, lo, stream);
        launch_phase<PH_GLA_SCAN>(p, lo, stream);
        launch_phase<PH_GLA_OUT>(p, lo, stream);
        launch_phase<PH_GEMM_OUT>(p, lo, stream);
        launch_phase<PH_NORM_FFN>(p, lo, stream);
        launch_phase<PH_MOE1>(p, lo, stream);
        launch_phase<PH_MOE2>(p, lo, stream);
    }
    launch_phase<PH_FINAL>(p, 0, stream);
#else
    static int grid = 0;
    if (!grid) {
        int dev = 0, cus = 0, per_cu = 0;
        hipGetDevice(&dev);
        hipDeviceGetAttribute(&cus, hipDeviceAttributeMultiprocessorCount, dev);
        hipFuncSetAttribute((const void*)k_mega, hipFuncAttributeMaxDynamicSharedMemorySize, (int)LDS_BYTES);
        hipOccupancyMaxActiveBlocksPerMultiprocessor(&per_cu, k_mega, NTHREADS, LDS_BYTES);
        if (cus <= 0) cus = 256;
        grid = cus * (per_cu < 1 ? 1 : 1);
    }
    hipLaunchKernelGGL(k_mega, dim3(grid), dim3(NTHREADS), LDS_BYTES, stream, p);
#endif
}
```

```cpp
#include <hip/hip_runtime.h>
#include <stdint.h>
#include <math.h>
#include <stdio.h>

#define EXTRA_BARS 0
#define REP_A 1
#ifndef REP_Q
#define REP_Q 1
#endif
#ifndef REP_S
#define REP_S 1
#endif
#ifndef REP_T
#define REP_T 1
#endif
#ifndef REP_E
#define REP_E 1
#endif
#define REP_B 1
#define REP_C 1
#ifndef DUP_MASK
#define DUP_MASK 0
#endif
#ifndef MK_MULTI
#define MK_MULTI 0
#endif

namespace {

constexpr int NT = 16384, ND = 1024, LDP = 3920, LDPB = 3968;
constexpr float EPS = 1e-6f;
constexpr int NTHREADS = 512;
constexpr size_t LDS_BYTES = 163840;
constexpr float SCALE128 = 0.08838834764831845f;
constexpr int LISTCAP = 32768;
constexpr int CSTR = 16;

constexpr size_t OFF_BAR  = 0;
constexpr size_t OFF_CNT  = 16384;
constexpr size_t ZERO_BYTES = 32768;
constexpr size_t OFF_QCTR = 28672;
constexpr size_t OFF_MOD  = 32768;
constexpr size_t OFF_COSA = OFF_MOD + 4 * 2 * 6144 * 4;
constexpr size_t OFF_SINA = OFF_COSA + (size_t)NT * 64 * 4;
constexpr size_t OFF_COSI = OFF_SINA + (size_t)NT * 64 * 4;
constexpr size_t OFF_SINI = OFF_COSI + (size_t)NT * 32 * 4;
constexpr size_t OFF_H    = OFF_SINI + (size_t)NT * 32 * 4;
constexpr size_t OFF_P    = OFF_H + (size_t)NT * 1024 * 4;
constexpr size_t OFF_HID  = OFF_P;
constexpr size_t OFF_YB   = OFF_HID + (size_t)36864 * 512 * 4;
constexpr size_t OFF_O    = OFF_P + (size_t)NT * LDP * 4;
constexpr size_t OFF_ASG  = OFF_O + (size_t)NT * 1024 * 4;
constexpr size_t OFF_GATE = OFF_ASG + (size_t)NT * 4 * 4;
constexpr size_t OFF_LIST = OFF_GATE + (size_t)NT * 2 * 4;
constexpr size_t OFF_R    = OFF_LIST + (size_t)32 * LISTCAP * 4;
constexpr size_t OFF_QN   = OFF_R;
constexpr size_t OFF_KN   = OFF_QN + (size_t)NT * 512 * 4;
constexpr size_t OFF_VC   = OFF_KN + (size_t)NT * 512 * 4;
constexpr size_t OFF_BETA = OFF_VC + (size_t)NT * 512 * 4;
constexpr size_t OFF_G    = OFF_BETA + (size_t)NT * 4 * 4;
constexpr size_t OFF_W    = OFF_G + (size_t)NT * 4 * 4;
constexpr size_t OFF_U    = OFF_W + (size_t)1024 * 8192 * 4;
constexpr size_t OFF_QG   = OFF_U + (size_t)1024 * 8192 * 4;
constexpr size_t OFF_KD   = OFF_QG + (size_t)1024 * 8192 * 4;
constexpr size_t OFF_AQK  = OFF_KD + (size_t)1024 * 8192 * 4;
constexpr size_t OFF_GL   = OFF_AQK + (size_t)1024 * 4096 * 4;
constexpr size_t OFF_QB   = OFF_GL + 4096;
constexpr size_t OFF_KB   = OFF_QB + (size_t)NT * 512 * 4;
constexpr size_t OFF_QI   = OFF_KB + (size_t)NT * 512 * 4;
constexpr size_t OFF_KI   = OFF_QI + (size_t)NT * 256 * 4;
constexpr size_t OFF_WI   = OFF_KI + (size_t)NT * 64 * 4;
constexpr size_t OFF_SEL  = OFF_WI + (size_t)NT * 4 * 4;
constexpr size_t OFF_EVEN_END = OFF_SEL + (size_t)NT * 256 * 4;
constexpr size_t OFF_PFR  = OFF_W;
constexpr size_t OFF_RFR  = OFF_PFR + (size_t)1024 * 32768;
constexpr size_t OFF_QFR  = OFF_RFR + (size_t)1024 * 16384;
constexpr size_t OFF_OFR  = OFF_QFR + (size_t)1024 * 32768;
static_assert(OFF_OFR + (size_t)1024 * 16384 <= OFF_GL, "gdn v2 buffers overflow");
constexpr size_t OFF_QBB  = OFF_QB;
constexpr size_t OFF_KBB  = OFF_QBB + (size_t)NT * 512 * 2;
constexpr size_t OFF_VT   = OFF_KBB + (size_t)NT * 512 * 2;
constexpr size_t OFF_QIB  = OFF_VT + (size_t)NT * 512 * 2;
constexpr size_t OFF_KIB  = OFF_QIB + (size_t)NT * 256 * 2;
constexpr size_t OFF_M16  = OFF_KIB + (size_t)NT * 64 * 2;
static_assert(OFF_M16 + (size_t)NT * 512 * 2 <= OFF_WI, "dsa v2 buffers overflow");
constexpr size_t OFF_LA   = OFF_R;
constexpr size_t OFF_ATT  = OFF_LA + (size_t)NT * 512 * 4;
constexpr size_t OFF_QE   = OFF_ATT + (size_t)1024 * 4096 * 4;
constexpr size_t OFF_GKD  = OFF_QE + (size_t)1024 * 8192 * 4;
constexpr size_t OFF_EBL  = OFF_GKD + (size_t)1024 * 8192 * 4;
constexpr size_t OFF_GQE  = OFF_LA + (size_t)NT * 512 * 4;
constexpr size_t OFF_GOI  = OFF_GQE + (size_t)1024 * 16384;
constexpr size_t OFF_GH   = OFF_GOI + (size_t)1024 * 32768;
constexpr size_t OFF_GEBL = OFF_GH + (size_t)1024 * 65536;
static_assert(OFF_GEBL + (size_t)1024 * 512 <= OFF_EVEN_END, "gla v2 buffers overflow");
constexpr size_t OFF_WINE = OFF_EVEN_END;
constexpr size_t OFF_WINO = OFF_WINE + (size_t)2 * 4096 * 1024 * 2;
constexpr size_t OFF_WOUT = OFF_WINO + (size_t)2 * 3200 * 1024 * 2;
constexpr size_t OFF_W13  = OFF_WOUT + (size_t)4 * 1024 * 1024 * 2;
constexpr size_t OFF_W2T  = OFF_W13 + (size_t)32 * 1024 * 1024 * 2;
constexpr size_t OFF_OB   = OFF_W2T + (size_t)32 * 1024 * 512 * 2;
constexpr size_t OFF_AUX  = OFF_OB + (size_t)NT * 1024 * 2;
constexpr size_t OFF_WGL  = OFF_AUX + (size_t)NT * 16 * 4;
constexpr size_t WS_NEEDED = OFF_WGL + (size_t)2 * 128 * 1024 * 2;

struct Params {
    const float* x; const float* c; const int* pos; const float* ada_w; const float* ada_b;
    const float* norm_mix; const float* norm_ffn; const float* even_w_in; const float* conv_w;
    const float* a_log; const float* dt_bias; const float* gdn_out_norm; const float* even_w_out;
    const float* gla_w_in; const float* gla_w_gate2; const float* gla_b_gate2; const float* gla_out_norm; const float* gla_w_out;
    const float* rg_w; const float* rg_b; const float* re_w; const float* re_b;
    const float* w1; const float* w3; const float* w2; const float* final_norm;
    float* X;
    unsigned char* ws;
    double rA, rI;
};

#define XB_TMO      128
#define XB_XCNT(j)  (256  + 64 * (j))
#define XB_XSUB(j)  (1280 + 64 * (j))
#define XB_XGEN(j)  (2304 + 64 * (j))
#define XB_TOP      3328
#define XB_TOPGEN   3392
#define XCD_BAR_WORDS 3456
#define XB_SPIN_CAP (1u << 18)
#define LAS __attribute__((address_space(3)))

__device__ __forceinline__ unsigned xb_ld(unsigned* p)              { return __hip_atomic_load(p, __ATOMIC_RELAXED, __HIP_MEMORY_SCOPE_AGENT); }
__device__ __forceinline__ unsigned xb_add(unsigned* p, unsigned v) { return __hip_atomic_fetch_add(p, v, __ATOMIC_RELAXED, __HIP_MEMORY_SCOPE_AGENT); }
__device__ __forceinline__ unsigned xb_xcc_id() { return (unsigned)__builtin_amdgcn_s_getreg((3 << 11) | 20) & 0xFu; }
#define XB_SPIN(cond, bar) do { unsigned _sp = 0; while (cond) { __builtin_amdgcn_s_sleep(1); \
    if ((++_sp & 255u) == 0u) { if (xb_ld(&(bar)[XB_TMO])) break; if (_sp > XB_SPIN_CAP) { atomicAdd(&(bar)[XB_TMO], 1u); break; } } } } while (0)

struct XcdBarrier { unsigned* bar; unsigned x; volatile LAS unsigned* st; };

__device__ __forceinline__ XcdBarrier xcd_barrier_post(unsigned* bar, volatile LAS unsigned* st) {
    XcdBarrier b; b.bar = bar; b.x = xb_xcc_id(); b.st = st;
    if (threadIdx.x == 0) (void)xb_add(&bar[XB_XCNT(b.x)], 1u);
    return b;
}
__device__ __forceinline__ void xcd_barrier_complete(unsigned* bar, unsigned x, unsigned& nloc, unsigned& nx) {
    const unsigned G = gridDim.x * gridDim.y * gridDim.z;
    unsigned sum, cnt, mine, sp = 0u;
    for (;;) {
        sum = 0u; cnt = 0u; mine = 0u;
#pragma unroll
        for (unsigned j = 0; j < 16; ++j) { const unsigned c = xb_ld(&bar[XB_XCNT(j)]); sum += c; cnt += (c > 0u) ? 1u : 0u; mine = (j == x) ? c : mine; }
        if (sum == G) break;
        __builtin_amdgcn_s_sleep(1);
        if ((++sp & 255u) == 0u) { if (xb_ld(&bar[XB_TMO])) break; if (sp > XB_SPIN_CAP) { atomicAdd(&bar[XB_TMO], 1u); break; } }
    }
    nloc = mine > 0u ? mine : 1u; nx = cnt > 0u ? cnt : 1u;
}
__device__ __forceinline__ void xcd_barrier(const XcdBarrier& b) {
    asm volatile("s_waitcnt vmcnt(0)" ::: "memory");
    __syncthreads();
    if (threadIdx.x == 0) {
        unsigned* bar = b.bar;
        __builtin_amdgcn_s_waitcnt(0);
        unsigned nloc = b.st[0], nx = b.st[1];
        if (nloc == 0u) { xcd_barrier_complete(bar, b.x, nloc, nx); b.st[0] = nloc; b.st[1] = nx; }
        const unsigned old = xb_add(&bar[XB_XSUB(b.x)], 1u);
        const unsigned gen = old / nloc;
        if (old + 1u == (gen + 1u) * nloc) {
            __builtin_amdgcn_fence(__ATOMIC_RELEASE, "agent");
            asm volatile("s_waitcnt vmcnt(0)" ::: "memory");
            const unsigned og = xb_add(&bar[XB_TOP], 1u);
            const unsigned tg = og / nx;
            if (og + 1u == (tg + 1u) * nx) xb_add(&bar[XB_TOPGEN], 1u);
            else XB_SPIN(xb_ld(&bar[XB_TOPGEN]) == tg, bar);
            __builtin_amdgcn_fence(__ATOMIC_ACQUIRE, "agent");
            xb_add(&bar[XB_XGEN(b.x)], 1u);
            asm volatile("s_waitcnt vmcnt(0)" ::: "memory");
        } else {
            XB_SPIN(xb_ld(&bar[XB_XGEN(b.x)]) == gen, bar);
            __builtin_amdgcn_fence(__ATOMIC_ACQUIRE, "agent");
            asm volatile("s_waitcnt vmcnt(0)" ::: "memory");
        }
    }
    __syncthreads();
}

template <class T> __device__ __forceinline__ T* as_global(T* p) { return (T*)(__attribute__((address_space(1))) T*)p; }
typedef __attribute__((address_space(1))) unsigned char GU8;
#if defined(__HIP_DEVICE_COMPILE__)
#define ASSUME_GLOBAL(p_) do { __builtin_assume(!__builtin_amdgcn_is_shared((const void*)(p_))); __builtin_assume(!__builtin_amdgcn_is_private((const void*)(p_))); } while (0)
#else
#define ASSUME_GLOBAL(p_) do { } while (0)
#endif
#define LBAR() do { asm volatile("s_waitcnt lgkmcnt(0)" ::: "memory"); __builtin_amdgcn_s_barrier(); asm volatile("" ::: "memory"); } while (0)
typedef const Params __attribute__((address_space(4))) KParams;
__device__ __forceinline__ KParams* kparams() { KParams* q = (KParams*)__builtin_amdgcn_kernarg_segment_ptr(); asm volatile("" : "+s"(q)); return q; }
#if defined(__HIP_DEVICE_COMPILE__)
#define DPPI_(v_, c_) __builtin_amdgcn_update_dpp(0, (v_), (c_), 0xf, 0xf, true)
#define DPPF_(v_, c_) __int_as_float(__builtin_amdgcn_update_dpp(0, __float_as_int(v_), (c_), 0xf, 0xf, true))
__device__ __forceinline__ float xor16_sum(float v) { const auto r = __builtin_amdgcn_permlane16_swap(__float_as_int(v), __float_as_int(v), false, false); return __int_as_float(r[0]) + __int_as_float(r[1]); }
__device__ __forceinline__ float xor32_sum(float v) { const auto r = __builtin_amdgcn_permlane32_swap(__float_as_int(v), __float_as_int(v), false, false); return __int_as_float(r[0]) + __int_as_float(r[1]); }
__device__ __forceinline__ float xor16_max(float v) { const auto r = __builtin_amdgcn_permlane16_swap(__float_as_int(v), __float_as_int(v), false, false); return fmaxf(__int_as_float(r[0]), __int_as_float(r[1])); }
__device__ __forceinline__ float xor32_max(float v) { const auto r = __builtin_amdgcn_permlane32_swap(__float_as_int(v), __float_as_int(v), false, false); return fmaxf(__int_as_float(r[0]), __int_as_float(r[1])); }
__device__ __forceinline__ float wave_sum(float v) {
    v += DPPF_(v, 0xB1); v += DPPF_(v, 0x4E); v += DPPF_(v, 0x141); v += DPPF_(v, 0x140);
    return xor32_sum(xor16_sum(v));
}
__device__ __forceinline__ int wave_sum_i(int v) {
    v += DPPI_(v, 0xB1); v += DPPI_(v, 0x4E); v += DPPI_(v, 0x141); v += DPPI_(v, 0x140);
    { const auto r = __builtin_amdgcn_permlane16_swap(v, v, false, false); v = (int)r[0] + (int)r[1]; }
    { const auto r = __builtin_amdgcn_permlane32_swap(v, v, false, false); v = (int)r[0] + (int)r[1]; }
    return v;
}
__device__ __forceinline__ float wave_max(float v) {
    v = fmaxf(v, DPPF_(v, 0xB1)); v = fmaxf(v, DPPF_(v, 0x4E)); v = fmaxf(v, DPPF_(v, 0x141)); v = fmaxf(v, DPPF_(v, 0x140));
    return xor32_max(xor16_max(v));
}
#else
__device__ __forceinline__ float xor16_sum(float v) { return v; }
__device__ __forceinline__ float xor32_sum(float v) { return v; }
__device__ __forceinline__ float xor16_max(float v) { return v; }
__device__ __forceinline__ float xor32_max(float v) { return v; }
__device__ __forceinline__ float wave_sum(float v) { return v; }
__device__ __forceinline__ int wave_sum_i(int v) { return v; }
__device__ __forceinline__ float wave_max(float v) { return v; }
#endif
__device__ __forceinline__ float sigmoidf_(float x) { return 1.f / (1.f + expf(-x)); }
__device__ __forceinline__ float siluf_(float x) { return x / (1.f + expf(-x)); }
__device__ __forceinline__ float silu_fast(float x) { return x * __builtin_amdgcn_rcpf(1.f + __expf(-x)); }
__device__ __forceinline__ float softplusf_(float x) { return fmaxf(x, 0.f) + log1pf(expf(-fabsf(x))); }
__device__ __forceinline__ unsigned ordkey(float f) { const unsigned u = __float_as_uint(f); return u ^ ((unsigned)((int)u >> 31) | 0x80000000u); }

__device__ __forceinline__ void sincos_d(double a, double& s, double& c) {
    const double kq = rint(a * 0.63661977236758134308);
    double r = fma(-kq, 1.57079632673412561417e+00, a);
    r = fma(-kq, 6.07710050650619224932e-11, r);
    const int q = (int)((long long)kq & 3);
    const double r2 = r * r;
    const double sp = r * (1.0 + r2 * (-1.0 / 6 + r2 * (1.0 / 120 + r2 * (-1.0 / 5040 + r2 * (1.0 / 362880 + r2 * (-1.0 / 39916800 + r2 * (1.0 / 6227020800.0)))))));
    const double cp = 1.0 + r2 * (-0.5 + r2 * (1.0 / 24 + r2 * (-1.0 / 720 + r2 * (1.0 / 40320 + r2 * (-1.0 / 3628800 + r2 * (1.0 / 479001600.0 + r2 * (-1.0 / 87178291200.0)))))));
    if (q == 0) { s = sp; c = cp; } else if (q == 1) { s = cp; c = -sp; } else if (q == 2) { s = -sp; c = -cp; } else { s = -cp; c = sp; }
}
__device__ __forceinline__ double ipow_d(double b, int e) { double v = 1.0; while (e) { if (e & 1) v *= b; b *= b; e >>= 1; } return v; }

struct GemmArgs { const float* A; int lda; const int* rows; int m0; int mvalid; const float* B; int ldb; int n0; int N; int K; };

template <class Epi>
__device__ __forceinline__ void gemm128(const GemmArgs& g, float* smem, Epi epi) {
    float* As = smem;
    float* Bs = smem + 16 * 132;
    int tid_ = threadIdx.x; asm volatile("" : "+v"(tid_)); const int tid = tid_, ty = tid >> 4, tx = tid & 15;
    const int arow = tid >> 2, kq = (tid & 3) * 4;
    const int bk = tid >> 5, bn = (tid & 31) * 4;
    long asrc = -1;
    if (arow < g.mvalid) { const int r = g.rows ? g.rows[arow] : (g.m0 + arow); if (r >= 0) asrc = (long)r * g.lda; }
    const bool bval = (g.n0 + bn) < g.N;
    float acc[4][8];
#pragma unroll
    for (int i = 0; i < 4; ++i)
#pragma unroll
        for (int j = 0; j < 8; ++j) acc[i][j] = 0.f;
    for (int k0 = 0; k0 < g.K; k0 += 16) {
        float4 av = make_float4(0.f, 0.f, 0.f, 0.f), bv = make_float4(0.f, 0.f, 0.f, 0.f);
        if (asrc >= 0) av = *(const float4*)(g.A + asrc + k0 + kq);
        if (bval) bv = *(const float4*)(g.B + (size_t)(k0 + bk) * g.ldb + g.n0 + bn);
        __syncthreads();
        As[(kq + 0) * 132 + arow] = av.x; As[(kq + 1) * 132 + arow] = av.y; As[(kq + 2) * 132 + arow] = av.z; As[(kq + 3) * 132 + arow] = av.w;
        *(float4*)&Bs[bk * 132 + bn] = bv;
        __syncthreads();
#pragma unroll
        for (int kk = 0; kk < 16; ++kk) {
            const float4 a = *(const float4*)&As[kk * 132 + ty * 4];
            const float4 b0 = *(const float4*)&Bs[kk * 132 + tx * 8];
            const float4 b1 = *(const float4*)&Bs[kk * 132 + tx * 8 + 4];
            const float aa[4] = {a.x, a.y, a.z, a.w};
            const float bb[8] = {b0.x, b0.y, b0.z, b0.w, b1.x, b1.y, b1.z, b1.w};
#pragma unroll
            for (int i = 0; i < 4; ++i)
#pragma unroll
                for (int j = 0; j < 8; ++j) acc[i][j] += aa[i] * bb[j];
        }
    }
#pragma unroll
    for (int i = 0; i < 4; ++i) {
        const int r = ty * 4 + i;
        if (r < g.mvalid) {
#pragma unroll
            for (int j = 0; j < 8; ++j) { const int n = g.n0 + tx * 8 + j; if (n < g.N) epi(r, n, acc[i][j]); }
        }
    }
}


typedef short bf16x8 __attribute__((ext_vector_type(8)));
typedef float f32x4 __attribute__((ext_vector_type(4)));
typedef unsigned short bf16_t;
typedef __bf16 bf16x2_t __attribute__((ext_vector_type(2)));
typedef float f32x2_t __attribute__((ext_vector_type(2)));
__device__ __forceinline__ unsigned cvt_pk_bf16(float lo, float hi) { const f32x2_t v = {lo, hi}; const bf16x2_t r = __builtin_convertvector(v, bf16x2_t); return __builtin_bit_cast(unsigned, r); }
__device__ __forceinline__ bf16_t f2bf(float f) { return (bf16_t)(cvt_pk_bf16(f, 0.f) & 0xffffu); }
__device__ __forceinline__ float bf16_to_f32(bf16_t v) { return __uint_as_float(((unsigned)v) << 16); }
__device__ __forceinline__ uint2 pack4(const f32x4 v) { uint2 r; r.x = cvt_pk_bf16(v[0], v[1]); r.y = cvt_pk_bf16(v[2], v[3]); return r; }
__device__ __forceinline__ f32x4 unpack4(const uint2 u) { f32x4 r; r[0] = __uint_as_float(u.x << 16); r[1] = __uint_as_float(u.x & 0xffff0000u); r[2] = __uint_as_float(u.y << 16); r[3] = __uint_as_float(u.y & 0xffff0000u); return r; }
#define PBF(Pb_, t_, c_) bf16_to_f32((Pb_)[(size_t)(t_) * LDPB + (c_)])
__device__ __forceinline__ uint4 pack8(const float4 a, const float4 b) { uint4 r; r.x = cvt_pk_bf16(a.x, a.y); r.y = cvt_pk_bf16(a.z, a.w); r.z = cvt_pk_bf16(b.x, b.y); r.w = cvt_pk_bf16(b.z, b.w); return r; }
__device__ __forceinline__ int lds_off(int r, int c) { return r * 128 + ((c ^ (r & 7)) << 4); }

template <class ALoad, class BLoad, class Epi>
__device__ __forceinline__ void gemm_tile_bf16(const int K, unsigned char* lds, ALoad aload, BLoad bload, Epi epi, const int mrows = 256) {
    int tid_ = threadIdx.x; asm volatile("" : "+v"(tid_)); const int tid = tid_, lane = tid & 63, wid = tid >> 6, wm = wid >> 1, wn = wid & 1;
    f32x4 acc[4][4];
#pragma unroll
    for (int mi = 0; mi < 4; ++mi)
#pragma unroll
        for (int ni = 0; ni < 4; ++ni) acc[mi][ni] = (f32x4){0.f, 0.f, 0.f, 0.f};
    uint4 ra[4], rb[2];
    const int nk = K >> 6;
#pragma unroll
    for (int i = 0; i < 4; ++i) { const int q = tid + 512 * i; ra[i] = aload(i, q >> 3, (q & 7) * 8); }
#pragma unroll
    for (int i = 0; i < 2; ++i) { const int q = tid + 512 * i; rb[i] = bload(i, q >> 3, (q & 7) * 8); }
    __syncthreads();
#pragma unroll
    for (int i = 0; i < 4; ++i) { const int q = tid + 512 * i; *(uint4*)(lds + lds_off(q >> 3, q & 7)) = ra[i]; }
#pragma unroll
    for (int i = 0; i < 2; ++i) { const int q = tid + 512 * i; *(uint4*)(lds + 32768 + lds_off(q >> 3, q & 7)) = rb[i]; }
    __syncthreads();
    for (int kt = 0; kt < nk; ++kt) {
        if (kt + 1 < nk) {
#pragma unroll
            for (int i = 0; i < 4; ++i) { const int q = tid + 512 * i; ra[i] = aload(i, q >> 3, (kt + 1) * 64 + (q & 7) * 8); }
#pragma unroll
            for (int i = 0; i < 2; ++i) { const int q = tid + 512 * i; rb[i] = bload(i, q >> 3, (kt + 1) * 64 + (q & 7) * 8); }
        }
        const unsigned char* At = lds + (kt & 1) * 49152;
        const unsigned char* Bt = At + 32768;
        if (__builtin_amdgcn_readfirstlane(wm) * 64 < mrows) {
#pragma unroll
        for (int ks = 0; ks < 2; ++ks) {
            bf16x8 af[4], bfr[4];
            const int c = ks * 4 + (lane >> 4);
#pragma unroll
            for (int mi = 0; mi < 4; ++mi) af[mi] = *(const bf16x8*)(At + lds_off(wm * 64 + mi * 16 + (lane & 15), c));
#pragma unroll
            for (int ni = 0; ni < 4; ++ni) bfr[ni] = *(const bf16x8*)(Bt + lds_off(wn * 64 + ni * 16 + (lane & 15), c));
            __builtin_amdgcn_s_setprio(1);
#pragma unroll
            for (int mi = 0; mi < 4; ++mi)
#pragma unroll
                for (int ni = 0; ni < 4; ++ni) acc[mi][ni] = __builtin_amdgcn_mfma_f32_16x16x32_bf16(bfr[ni], af[mi], acc[mi][ni], 0, 0, 0);
            __builtin_amdgcn_s_setprio(0);
        }
        }
        if (kt + 1 < nk) {
            unsigned char* An = lds + ((kt + 1) & 1) * 49152;
#pragma unroll
            for (int i = 0; i < 4; ++i) { const int q = tid + 512 * i; *(uint4*)(An + lds_off(q >> 3, q & 7)) = ra[i]; }
#pragma unroll
            for (int i = 0; i < 2; ++i) { const int q = tid + 512 * i; *(uint4*)(An + 32768 + lds_off(q >> 3, q & 7)) = rb[i]; }
        }
        __syncthreads();
    }
    epi(acc, wm, wn, lane);
}

__device__ __forceinline__ void convert_tile(const float* src0, const float* src1, int mode, int K, int N, int ld, bf16_t* dst, int rt, int kt, float* smem) {
    int tid_ = threadIdx.x; asm volatile("" : "+v"(tid_)); const int tid = tid_;
    __syncthreads();
    { const int k = tid >> 3, R0 = rt * 64 + (tid & 7) * 8;
      const float* sp; int col;
      if (mode == 0) { sp = src0; col = R0; } else { sp = (R0 & 32) ? src1 : src0; col = (R0 >> 6) * 32 + (R0 & 31); }
      float4 a = make_float4(0.f, 0.f, 0.f, 0.f), b = a;
      const float* rp = sp + (size_t)(kt * 64 + k) * ld + col;
      if (col < N) a = *(const float4*)rp;
      if (col + 4 < N) b = *(const float4*)(rp + 4);
      float* d = smem + k * 65 + (tid & 7) * 8;
      d[0] = a.x; d[1] = a.y; d[2] = a.z; d[3] = a.w; d[4] = b.x; d[5] = b.y; d[6] = b.z; d[7] = b.w; }
    __syncthreads();
    { const int R = tid >> 3, kc = (tid & 7) * 8;
      float v[8];
#pragma unroll
      for (int j = 0; j < 8; ++j) v[j] = smem[(kc + j) * 65 + R];
      uint4 o; o.x = cvt_pk_bf16(v[0], v[1]); o.y = cvt_pk_bf16(v[2], v[3]); o.z = cvt_pk_bf16(v[4], v[5]); o.w = cvt_pk_bf16(v[6], v[7]);
      *(uint4*)(dst + (size_t)(rt * 64 + R) * K + kt * 64 + kc) = o; }
}

#define CT_LOAD(S0, S1, MODE, NN, LD, RT, KT, A, B) do { const int k_ = tid >> 3, R0_ = (RT) * 64 + (tid & 7) * 8; const float* sp_; int col_; \
        if ((MODE) == 0) { sp_ = (S0); col_ = R0_; } else { sp_ = (R0_ & 16) ? (S1) : (S0); col_ = (R0_ >> 5) * 16 + (R0_ & 15); } \
        const bool oka_ = col_ < (NN), okb_ = col_ + 4 < (NN); const float* rp_ = sp_ + (size_t)((KT) * 64 + k_) * (LD) + (oka_ ? col_ : 0); \
        A = *(const float4*)rp_; B = *(const float4*)(rp_ + (okb_ ? 4 : 0));        \
        if (!oka_) A = make_float4(0.f, 0.f, 0.f, 0.f); if (!okb_) B = make_float4(0.f, 0.f, 0.f, 0.f); } while (0)
#define CT_WRITE(BUF, A, B) do { float* d_ = smem + (BUF) * 4160 + (tid >> 3) * 65 + (tid & 7) * 8; \
        d_[0] = A.x; d_[1] = A.y; d_[2] = A.z; d_[3] = A.w; d_[4] = B.x; d_[5] = B.y; d_[6] = B.z; d_[7] = B.w; } while (0)
#define CT_STORE(DST, KK, RT, KT, BUF) do { const int R_ = tid >> 3, kc_ = (tid & 7) * 8; const float* sb_ = smem + (BUF) * 4160; \
        uint4 o_; o_.x = cvt_pk_bf16(sb_[(kc_ + 0) * 65 + R_], sb_[(kc_ + 1) * 65 + R_]); o_.y = cvt_pk_bf16(sb_[(kc_ + 2) * 65 + R_], sb_[(kc_ + 3) * 65 + R_]); \
        o_.z = cvt_pk_bf16(sb_[(kc_ + 4) * 65 + R_], sb_[(kc_ + 5) * 65 + R_]); o_.w = cvt_pk_bf16(sb_[(kc_ + 6) * 65 + R_], sb_[(kc_ + 7) * 65 + R_]); \
        *(uint4*)((DST) + (size_t)((RT) * 64 + R_) * (KK) + (KT) * 64 + kc_) = o_; } while (0)
#define CT_DECL(I) const float* s0_##I; const float* s1_##I; bf16_t* d_##I; int md_##I, K_##I, N_##I, ld_##I, rt_##I, kt_##I
#define CT_ARGS(I) s0_##I, s1_##I, d_##I, md_##I, K_##I, N_##I, ld_##I, rt_##I, kt_##I
#define CT_LOADSET(X, T) do {   \
        { CT_DECL(0); dec((T), CT_ARGS(0)); CT_LOAD(s0_0, s1_0, md_0, N_0, ld_0, rt_0, kt_0, X##a0, X##b0); } \
        { CT_DECL(1); dec((T) + 1, CT_ARGS(1)); CT_LOAD(s0_1, s1_1, md_1, N_1, ld_1, rt_1, kt_1, X##a1, X##b1); } \
        { CT_DECL(2); dec((T) + 2, CT_ARGS(2)); CT_LOAD(s0_2, s1_2, md_2, N_2, ld_2, rt_2, kt_2, X##a2, X##b2); } \
        { CT_DECL(3); dec((T) + 3, CT_ARGS(3)); CT_LOAD(s0_3, s1_3, md_3, N_3, ld_3, rt_3, kt_3, X##a3, X##b3); } } while (0)
#define CT_PROCESS(X, T) do { \
        LBAR();   \
        CT_WRITE(0, X##a0, X##b0); CT_WRITE(1, X##a1, X##b1); CT_WRITE(2, X##a2, X##b2); CT_WRITE(3, X##a3, X##b3); \
        LBAR(); \
        { CT_DECL(0); dec((T), CT_ARGS(0)); CT_STORE(d_0, K_0, rt_0, kt_0, 0); } \
        { CT_DECL(1); dec((T) + 1, CT_ARGS(1)); CT_STORE(d_1, K_1, rt_1, kt_1, 1); } \
        { CT_DECL(2); dec((T) + 2, CT_ARGS(2)); CT_STORE(d_2, K_2, rt_2, kt_2, 2); } \
        { CT_DECL(3); dec((T) + 3, CT_ARGS(3)); CT_STORE(d_3, K_3, rt_3, kt_3, 3); } } while (0)
template <class Dec>
__device__ __forceinline__ void convert_stream(const Dec& dec, int t0, int tstep, int total, float* smem) {
    int tid_ = threadIdx.x; asm volatile("" : "+v"(tid_)); const int tid = tid_;
    if (t0 >= total) return;
    const float4 z4 = make_float4(0.f, 0.f, 0.f, 0.f);
    float4 Aa0 = z4, Ab0 = z4, Aa1 = z4, Ab1 = z4, Aa2 = z4, Ab2 = z4, Aa3 = z4, Ab3 = z4, Ba0 = z4, Bb0 = z4, Ba1 = z4, Bb1 = z4, Ba2 = z4, Bb2 = z4, Ba3 = z4, Bb3 = z4;
    CT_LOADSET(A, t0);
    for (int t = t0; t < total; t += 2 * tstep) {
        if (t + tstep < total) CT_LOADSET(B, t + tstep);
        CT_PROCESS(A, t);
        if (t + tstep >= total) break;
        if (t + 2 * tstep < total) CT_LOADSET(A, t + 2 * tstep);
        CT_PROCESS(B, t + tstep);
    }
}


namespace pg8 {
constexpr int BM = 256, BK = 64, HALF = 128, HTB = HALF * BK * 2, STAGE_BYTES = 8 * HTB;
__host__ __device__ __forceinline__ int lds_byte(int r, int c) { const int st = (r >> 4) * 2 + (c >> 5), rr = r & 15, cc = c & 31, ob = rr * 64 + cc * 2; return st * 1024 + (ob ^ (((ob >> 9) & 1) << 5)); }
__host__ __device__ __forceinline__ void stage_rc(int b, int& R, int& C) { const int st = b / 1024, sb = b % 1024, swz = sb ^ (((sb >> 9) & 1) << 5); R = (st >> 1) * 16 + swz / 64; C = (st & 1) * 32 + (swz % 64) / 2; }
__host__ __device__ __forceinline__ int perm32(int rho) { const int n = rho >> 4, i = rho & 15; return 8 * (i >> 2) + 4 * n + (i & 3); }

struct Unit { size_t aoff, boff; int pm, pn, e, mvalid, rowbase, mi; };
template <class Epi, class Sched, bool GATHER>
__device__ __forceinline__ void gemm_phase(LAS unsigned char* lds, const bf16_t* Abase, const bf16_t* Bbase, const int K, const Sched& S, const Epi& E) {
    int tid_ = threadIdx.x; asm volatile("" : "+v"(tid_));
    const int tid = tid_, wid = __builtin_amdgcn_readfirstlane(tid >> 6), lane = tid & 63, wr = wid >> 2, wc = wid & 3, fr = lane & 15, fq = lane >> 4;
    const int nt = K / BK;
    unsigned voffB[2];
#pragma unroll
    for (int i = 0; i < 2; ++i) { int R, C; stage_rc(tid * 16 + i * 8192, R, C); const int Rb = Epi::PERM ? ((R & ~31) + perm32(R & 31)) : R; voffB[i] = (unsigned)(Rb * K + C) * 2u; }
    const size_t kstep = (size_t)(BK * 2);
    const size_t hstep = (size_t)HALF * K * 2;
    const unsigned ldsw = (unsigned)wid * 1024u;
    const int aoff = lds_byte(wr * 64 + fr, fq * 8), boff = lds_byte(wc * 32 + fr, fq * 8);
#define PG8_SA(b, h) (((b) * 2 + (h)) * HTB)
#define PG8_SB(b, h) ((4 + (b) * 2 + (h)) * HTB)
#define PG8_STAGE(bufoff, gbase, voff) do { _Pragma("unroll") for (int _i = 0; _i < 2; ++_i) \
        __builtin_amdgcn_global_load_lds((const unsigned*)((const char*)(gbase) + (voff)[_i]), (LAS unsigned*)(lds + (bufoff) + ldsw + _i * 8192), 16, 0, 0); } while (0)
#define PG8_LDA(dst, b, h) do { _Pragma("unroll") for (int m = 0; m < 4; ++m) _Pragma("unroll") for (int k = 0; k < 2; ++k) dst[m][k] = *(const LAS bf16x8*)(lds + PG8_SA(b, h) + aoff + m * 2048 + k * 1024); } while (0)
#define PG8_LDB(dst, b, h) do { _Pragma("unroll") for (int n = 0; n < 2; ++n) _Pragma("unroll") for (int k = 0; k < 2; ++k) dst[n][k] = *(const LAS bf16x8*)(lds + PG8_SB(b, h) + boff + n * 2048 + k * 1024); } while (0)
#define PG8_MMA(ai, bj, At, Bt) do { __builtin_amdgcn_s_setprio(1); _Pragma("unroll") for (int m = 0; m < 4; ++m) _Pragma("unroll") for (int n = 0; n < 2; ++n) _Pragma("unroll") for (int k = 0; k < 2; ++k) \
        acc[ai][bj][m][n] = __builtin_amdgcn_mfma_f32_16x16x32_bf16(Bt[n][k], At[m][k], acc[ai][bj][m][n], 0, 0, 0); __builtin_amdgcn_s_setprio(0); } while (0)
#define PG8_WAIT_V(n) asm volatile("s_waitcnt vmcnt(" #n ")" ::: "memory")
#define PG8_WAIT_L(n) asm volatile("s_waitcnt lgkmcnt(" #n ")" ::: "memory")
#define PG8_BAR __builtin_amdgcn_s_barrier()
#define PG8_SCHED __builtin_amdgcn_sched_barrier(0)
#define PG8_AVOFF(U, V0, V1) do { _Pragma("unroll") for (int _i = 0; _i < 2; ++_i) { int R_, C_; stage_rc(tid * 16 + _i * 8192, R_, C_); \
        if (GATHER) { V0[_i] = (unsigned)((size_t)S.row(U, R_) * K + C_) * 2u; V1[_i] = (unsigned)((size_t)S.row(U, 128 + R_) * K + C_) * 2u; } \
        else { V0[_i] = (unsigned)(R_ * K + C_) * 2u; V1[_i] = V0[_i] + (unsigned)hstep; } } } while (0)
    Unit cur, nxt; int ui = 0;
    if (!S.next(0, cur)) return;
    f32x4 acc[2][2][4][2];
#pragma unroll
    for (int a = 0; a < 2; ++a)
#pragma unroll
        for (int b = 0; b < 2; ++b)
#pragma unroll
            for (int m = 0; m < 4; ++m)
#pragma unroll
                for (int n = 0; n < 2; ++n) acc[a][b][m][n] = (f32x4){0.f, 0.f, 0.f, 0.f};
    bf16x8 At[4][2], B0[2][2], B1[2][2];
    unsigned cv0[2], cv1[2];
    PG8_AVOFF(cur, cv0, cv1);
    const char* cA = (const char*)Abase + cur.aoff; const char* cB = (const char*)Bbase + cur.boff;
    PG8_STAGE(PG8_SB(0, 0), cB, voffB); PG8_STAGE(PG8_SA(0, 0), cA, cv0); PG8_STAGE(PG8_SB(0, 1), cB + hstep, voffB); PG8_STAGE(PG8_SA(0, 1), cA, cv1);
    if (wr == 1) PG8_BAR;
    PG8_WAIT_V(4); PG8_BAR;
    PG8_STAGE(PG8_SB(1, 0), cB + kstep, voffB); PG8_STAGE(PG8_SA(1, 0), cA + kstep, cv0); PG8_STAGE(PG8_SB(1, 1), cB + hstep + kstep, voffB);
    PG8_WAIT_V(6); PG8_BAR;
    for (;;) {
        const bool has_next = S.next(ui + 1, nxt);
        const char* nA = has_next ? (const char*)Abase + nxt.aoff : cA; const char* nB = has_next ? (const char*)Bbase + nxt.boff : cB;
        for (int t = 0; t < nt; t += 2) {
            const bool last = (t == nt - 2);
            const char* a1 = cA + (size_t)(t + 1) * kstep;
            const char* a2 = last ? nA : cA + (size_t)(t + 2) * kstep; const char* b2 = last ? nB : cB + (size_t)(t + 2) * kstep;
            const char* a3 = a2 + kstep; const char* b3 = b2 + kstep;
            PG8_LDB(B0, 0, 0); PG8_SCHED; PG8_LDA(At, 0, 0); PG8_STAGE(PG8_SA(1, 1), a1, cv1);
            if (last && has_next) { PG8_AVOFF(nxt, cv0, cv1); }
            PG8_WAIT_L(8); PG8_BAR; PG8_WAIT_L(0); PG8_MMA(0, 0, At, B0); PG8_BAR; PG8_SCHED;
            PG8_LDB(B1, 0, 1); PG8_STAGE(PG8_SB(0, 0), b2, voffB);
            PG8_BAR; PG8_WAIT_L(0); PG8_MMA(0, 1, At, B1); PG8_BAR;
            PG8_LDA(At, 0, 1); PG8_STAGE(PG8_SA(0, 0), a2, cv0);
            PG8_BAR; PG8_WAIT_L(0); PG8_MMA(1, 0, At, B0); PG8_BAR; PG8_SCHED;
            PG8_STAGE(PG8_SB(0, 1), b2 + hstep, voffB);
            PG8_WAIT_V(6); PG8_BAR; PG8_MMA(1, 1, At, B1); PG8_BAR;
            PG8_LDB(B0, 1, 0); PG8_SCHED; PG8_LDA(At, 1, 0); PG8_STAGE(PG8_SA(0, 1), a2, cv1);
            PG8_WAIT_L(8); PG8_BAR; PG8_WAIT_L(0); PG8_MMA(0, 0, At, B0); PG8_BAR; PG8_SCHED;
            PG8_LDB(B1, 1, 1); PG8_STAGE(PG8_SB(1, 0), b3, voffB);
            PG8_BAR; PG8_WAIT_L(0); PG8_MMA(0, 1, At, B1); PG8_BAR;
            PG8_LDA(At, 1, 1); PG8_STAGE(PG8_SA(1, 0), a3, cv0);
            PG8_BAR; PG8_WAIT_L(0); PG8_MMA(1, 0, At, B0); PG8_BAR; PG8_SCHED;
            PG8_STAGE(PG8_SB(1, 1), b3 + hstep, voffB);
            PG8_WAIT_V(6); PG8_BAR; PG8_MMA(1, 1, At, B1); PG8_BAR;
        }
        E(acc, cur, wr, wc, fr, fq);
        if (!has_next) break;
#pragma unroll
        for (int a = 0; a < 2; ++a)
#pragma unroll
            for (int b = 0; b < 2; ++b)
#pragma unroll
                for (int m = 0; m < 4; ++m)
#pragma unroll
                    for (int n = 0; n < 2; ++n) acc[a][b][m][n] = (f32x4){0.f, 0.f, 0.f, 0.f};
        cur = nxt; cA = nA; cB = nB; ++ui;
    }
    PG8_WAIT_V(0);
    if (wr == 0) PG8_BAR;
    PG8_BAR;
#undef PG8_SA
#undef PG8_SB
#undef PG8_STAGE
#undef PG8_LDA
#undef PG8_LDB
#undef PG8_MMA
#undef PG8_WAIT_V
#undef PG8_WAIT_L
#undef PG8_BAR
#undef PG8_SCHED
#undef PG8_AVOFF
}
struct DenseOrder {
    int nM, nN, nwg, G, c, K;
    __device__ __forceinline__ void init(int nM_, int nN_, int G_, int c_, int K_) { nM = nM_; nN = nN_; nwg = nM * nN; G = G_; c = c_; K = K_; }
    __device__ __forceinline__ bool next(int i, Unit& u) const {
        const long L = (long)i * G + c; if (L >= nwg) return false;
        int wgid = (int)L; { const int q = nwg / 8, r = nwg % 8, xcd = wgid % 8, off = wgid / 8; wgid = (xcd < r ? xcd * (q + 1) : r * (q + 1) + (xcd - r) * q) + off; }
        const int nig = 8 * nN, gid = wgid / nig, fm = gid * 8, gsz = (nM - fm) < 8 ? (nM - fm) : 8;
        u.pm = fm + ((wgid % nig) % gsz); u.pn = (wgid % nig) / gsz;
        u.aoff = (size_t)u.pm * 256 * K * 2; u.boff = (size_t)u.pn * 256 * K * 2; u.e = 0; u.mvalid = 256; u.rowbase = u.pm * 256; u.mi = 0;
        return true;
    }
    __device__ __forceinline__ int row(const Unit&, int r) const { return r; }
};
}

extern __shared__ __attribute__((aligned(16))) unsigned char g_smem[];
#define PHASE_FN __device__ __forceinline__
enum { PH_PROLOGUE = 0, PH_NORM_MIX, PH_GEMM_IN_EVEN, PH_EVEN_TOK, PH_GDN_CHUNK, PH_GDN_SCAN, PH_DSA_TOPK, PH_DSA_ATTN, PH_GDN_OUT,
       PH_GEMM_OUT, PH_NORM_FFN, PH_MOE1, PH_MOE2, PH_GEMM_IN_ODD, PH_GLA_TOK, PH_GLA_CHUNK, PH_GLA_SCAN, PH_GLA_OUT, PH_FINAL };

PHASE_FN void ph_prologue(const Params& p, float* smem) {
    KParams* pp = kparams();
    GU8* wsg_ = (GU8*)pp->ws; asm volatile("" : "+s"(wsg_)); unsigned char* ws_ = (unsigned char*)wsg_;
    { int ldz_ = 0; asm volatile("" : "+s"(ldz_)); smem = (float*)(g_smem + ldz_); }
    int tid_ = threadIdx.x; asm volatile("" : "+v"(tid_)); const int tid = tid_, nthr = gridDim.x * NTHREADS, gid = blockIdx.x * NTHREADS + tid;
    for (int i = tid; i < 2 * ND; i += NTHREADS) smem[i] = siluf_(as_global(pp->c)[i]);
    __syncthreads();
    float* MOD = (float*)(ws_ + OFF_MOD);
    { float* red = smem + 2048;
      const int lane = tid & 63, wv = tid >> 6;
      for (int item = blockIdx.x; item < 4 * 96; item += gridDim.x) {
          const int l = item / 96, n = (item % 96) * 64 + lane;
          const float* w = as_global(pp->ada_w) + (size_t)l * ND * 6144 + n;
          float a0 = 0.f, a1 = 0.f;
#pragma unroll 8
          for (int k = wv * 128; k < wv * 128 + 128; ++k) { const float wv_ = w[(size_t)k * 6144]; a0 += smem[k] * wv_; a1 += smem[ND + k] * wv_; }
          __syncthreads();
          red[(wv * 64 + lane) * 2] = a0; red[(wv * 64 + lane) * 2 + 1] = a1;
          __syncthreads();
          if (tid < 128) { const int c = tid >> 1, bb = tid & 1; float a = 0.f; for (int w8 = 0; w8 < 8; ++w8) a += red[(w8 * 64 + c) * 2 + bb];
              MOD[(l * 2 + bb) * 6144 + (item % 96) * 64 + c] = a + as_global(pp->ada_b)[l * 6144 + (item % 96) * 64 + c]; }
      }
      __syncthreads(); }
    float* COSA = (float*)(ws_ + OFF_COSA); float* SINA = (float*)(ws_ + OFF_SINA);
    float* COSI = (float*)(ws_ + OFF_COSI); float* SINI = (float*)(ws_ + OFF_SINI);
    for (size_t i = gid; i < (size_t)NT * 64; i += nthr) {
        const int t = (int)(i >> 6), j = (int)(i & 63);
        double s, c; sincos_d((double)as_global(pp->pos)[t] * ipow_d(pp->rA, j), s, c);
        COSA[i] = (float)c; SINA[i] = (float)s;
    }
    for (size_t i = gid; i < (size_t)NT * 32; i += nthr) {
        const int t = (int)(i >> 5), j = (int)(i & 31);
        double s, c; sincos_d((double)as_global(pp->pos)[t] * ipow_d(pp->rI, j), s, c);
        COSI[i] = (float)c; SINI[i] = (float)s;
    }
}

PHASE_FN void ph_rows(const Params& p, int layer, int mode, float* smem) {
    KParams* pp = kparams();
    GU8* wsg_ = (GU8*)pp->ws; asm volatile("" : "+s"(wsg_)); unsigned char* ws_ = (unsigned char*)wsg_;
    { int ldz_ = 0; asm volatile("" : "+s"(ldz_)); smem = (float*)(g_smem + ldz_); }
    int tid_ = threadIdx.x; asm volatile("" : "+v"(tid_)); const int tid = tid_, lane = tid & 63, wv = tid >> 6;
    int* pad = (int*)smem;
    const int moe_layer = (mode == 1) ? 3 : layer - 1;
    if (moe_layer >= 0) {
        if (tid == 0) { const int* cnt = (const int*)(ws_ + OFF_CNT) + moe_layer * 32 * CSTR; int a = 0; for (int e = 0; e < 32; ++e) { pad[e] = a; a += ((cnt[e * CSTR] + 127) / 128) * 128; } }
        __syncthreads();
    }
    const float* MOD = (const float*)(ws_ + OFF_MOD);
    bf16_t* H = (bf16_t*)(ws_ + OFF_H);
    const bf16_t* YB = (const bf16_t*)(ws_ + OFF_YB);
    const int* ASG = (const int*)(ws_ + OFF_ASG);
    const float* GATE = (const float*)(ws_ + OFF_GATE);
    auto load_x = [&](int row, float (&xv)[16]) {
        const float* xin = (mode == 0 && layer == 0) ? (as_global(pp->x) + (size_t)row * ND) : (as_global(pp->X) + (size_t)row * ND);
#pragma unroll
        for (int j = 0; j < 4; ++j) { const float4 v = *(const float4*)(xin + j * 256 + lane * 4); xv[4 * j] = v.x; xv[4 * j + 1] = v.y; xv[4 * j + 2] = v.z; xv[4 * j + 3] = v.w; }
    };
    auto load_y = [&](int row, uint2 (&ya)[4], uint2 (&yb)[4], float& g0, float& g1) {
        const int4 as = *(const int4*)(ASG + row * 4);
        g0 = GATE[row * 2]; g1 = GATE[row * 2 + 1];
        const bf16_t* y0 = YB + (size_t)(pad[as.x] + as.y) * ND;
        const bf16_t* y1 = YB + (size_t)(pad[as.z] + as.w) * ND;
#pragma unroll
        for (int j = 0; j < 4; ++j) { ya[j] = *(const uint2*)(y0 + j * 256 + lane * 4); yb[j] = *(const uint2*)(y1 + j * 256 + lane * 4); }
    };
    auto finish = [&](int row, float (&xv)[16], const uint2 (&ya)[4], const uint2 (&yb)[4], float g0, float g1) {
        const int b = row >> 13;
        float* xr = as_global(pp->X) + (size_t)row * ND;
        if (moe_layer >= 0) {
            const float* gt = MOD + (size_t)(moe_layer * 2 + b) * 6144 + 5 * 1024;
#pragma unroll
            for (int j = 0; j < 4; ++j) {
                const int col = j * 256 + lane * 4;
                const f32x4 a = unpack4(ya[j]), bq = unpack4(yb[j]); const float4 g = *(const float4*)(gt + col);
                xv[4 * j] += g.x * (g0 * a[0] + g1 * bq[0]); xv[4 * j + 1] += g.y * (g0 * a[1] + g1 * bq[1]);
                xv[4 * j + 2] += g.z * (g0 * a[2] + g1 * bq[2]); xv[4 * j + 3] += g.w * (g0 * a[3] + g1 * bq[3]);
                if (mode == 0) *(float4*)(xr + col) = make_float4(xv[4 * j], xv[4 * j + 1], xv[4 * j + 2], xv[4 * j + 3]);
            }
        }
        float ss = 0.f;
#pragma unroll
        for (int j = 0; j < 16; ++j) ss += xv[j] * xv[j];
        ss = wave_sum(ss);
        const float rstd = rsqrtf(ss * (1.f / 1024.f) + EPS);
        if (mode == 0) {
            const float* nw = as_global(pp->norm_mix) + layer * 1024;
            const float* sh = MOD + (size_t)(layer * 2 + b) * 6144;
            const float* sc = sh + 1024;
#pragma unroll
            for (int j = 0; j < 4; ++j) {
                const int col = j * 256 + lane * 4;
                const float4 w = *(const float4*)(nw + col), s4 = *(const float4*)(sc + col), h4 = *(const float4*)(sh + col);
                f32x4 ov;
                ov[0] = xv[4 * j] * rstd * w.x * (1.f + s4.x) + h4.x; ov[1] = xv[4 * j + 1] * rstd * w.y * (1.f + s4.y) + h4.y;
                ov[2] = xv[4 * j + 2] * rstd * w.z * (1.f + s4.z) + h4.z; ov[3] = xv[4 * j + 3] * rstd * w.w * (1.f + s4.w) + h4.w;
                *(uint2*)(H + (size_t)row * ND + col) = pack4(ov);
            }
        } else {
#pragma unroll
            for (int j = 0; j < 4; ++j) {
                const int col = j * 256 + lane * 4;
                const float4 w = *(const float4*)(as_global(pp->final_norm) + col);
                *(float4*)(xr + col) = make_float4(xv[4 * j] * rstd * w.x, xv[4 * j + 1] * rstd * w.y, xv[4 * j + 2] * rstd * w.z, xv[4 * j + 3] * rstd * w.w);
            }
        }
    };
    const int stride = gridDim.x * 8;
    for (int row = blockIdx.x * 8 + wv; row < NT; row += 2 * stride) {
        const int rowB = row + stride; const bool hasB = rowB < NT; const int rB = hasB ? rowB : row;
        float xa[16], xb[16]; uint2 yaa[4], yab[4], yba[4], ybb[4]; float ga0 = 0.f, ga1 = 0.f, gb0 = 0.f, gb1 = 0.f;
        load_x(row, xa); load_x(rB, xb);
        if (moe_layer >= 0) { load_y(row, yaa, yab, ga0, ga1); load_y(rB, yba, ybb, gb0, gb1); }
        finish(row, xa, yaa, yab, ga0, ga1);
        if (hasB) finish(rowB, xb, yba, ybb, gb0, gb1);
    }
}

struct EpiIn {
    static constexpr bool PERM = true;
    bf16_t* P; float* AUX; int ncols; int even;
    __device__ __forceinline__ void operator()(const f32x4 (&acc)[2][2][4][2], const pg8::Unit& u, int wr, int wc, int fr, int fq) const {
        const int row0 = u.pm * 256 + wr * 64 + fr, col0 = u.pn * 256 + wc * 32 + 8 * fq;
#pragma unroll
        for (int ai = 0; ai < 2; ++ai)
#pragma unroll
            for (int m = 0; m < 4; ++m) { const int r = row0 + ai * 128 + m * 16;
#pragma unroll
                for (int bj = 0; bj < 2; ++bj) { const int c = col0 + bj * 128;
                    if (c < ncols) { const uint2 lo = pack4(acc[ai][bj][m][0]), hi = pack4(acc[ai][bj][m][1]); *(uint4*)(P + (size_t)r * LDPB + c) = make_uint4(lo.x, lo.y, hi.x, hi.y); }
                    if (even) {
                        if (c == 2048) { *(f32x4*)(AUX + (size_t)r * 16) = acc[ai][bj][m][0]; *(f32x4*)(AUX + (size_t)r * 16 + 4) = acc[ai][bj][m][1]; }
                        if (c == 3912) *(f32x4*)(AUX + (size_t)r * 16 + 8) = acc[ai][bj][m][0];
                    } } }
    }
};

PHASE_FN void ph_gemm_in(const Params& p, int layer, bool even, float* smem) {
    KParams* pp = kparams();
    GU8* wsg_ = (GU8*)pp->ws; asm volatile("" : "+s"(wsg_)); unsigned char* ws_ = (unsigned char*)wsg_;
    int ldz_ = 0; asm volatile("" : "+s"(ldz_));
    const bf16_t* Wt = even ? (const bf16_t*)(ws_ + OFF_WINE) + (size_t)(layer >> 1) * 4096 * 1024 : (const bf16_t*)(ws_ + OFF_WINO) + (size_t)(layer >> 1) * 3072 * 1024;
    EpiIn E; E.P = (bf16_t*)(ws_ + OFF_P); E.AUX = (float*)(ws_ + OFF_AUX); E.ncols = even ? 3920 : 3072; E.even = even ? 1 : 0;
    pg8::DenseOrder S; S.init(64, even ? 16 : 12, gridDim.x, blockIdx.x, 1024);
    __syncthreads();
    pg8::gemm_phase<EpiIn, pg8::DenseOrder, false>((LAS unsigned char*)(g_smem + ldz_), (const bf16_t*)(ws_ + OFF_H), Wt, 1024, S, E);
    __syncthreads();
    if (!even) {
        const bf16_t* H = (const bf16_t*)(ws_ + OFF_H);
        const bf16_t* Wg = (const bf16_t*)(ws_ + OFF_WGL) + (size_t)(layer >> 1) * 128 * 1024;
        float* AUX = (float*)(ws_ + OFF_AUX);
        for (int mt = blockIdx.x; mt < 64; mt += gridDim.x) {
            const bf16_t* Ab = H + (size_t)mt * 256 * 1024;
            float* At = AUX + (size_t)mt * 256 * 16;
            gemm_tile_bf16(1024, g_smem + ldz_,
                [=](int i, int r, int k) -> uint4 { return *(const uint4*)(Ab + (size_t)r * 1024 + k); },
                [=](int i, int r, int k) -> uint4 { return *(const uint4*)(Wg + (size_t)r * 1024 + k); },
                [=](const f32x4 (&acc)[4][4], int wm, int wn, int lane) {
                    if (wn == 0 && (lane >> 4) < 4) {
#pragma unroll
                        for (int mi = 0; mi < 4; ++mi) { const int m = wm * 64 + mi * 16 + (lane & 15); *(f32x4*)(At + (size_t)m * 16 + 4 * (lane >> 4)) = acc[mi][0]; }
                    }
                });
        }
        __syncthreads();
    }
}

PHASE_FN void ph_even_tok(const Params& p, int layer, float* smem) {
    KParams* pp = kparams();
    GU8* wsg_ = (GU8*)pp->ws; asm volatile("" : "+s"(wsg_)); unsigned char* ws_ = (unsigned char*)wsg_;
    { int ldz_ = 0; asm volatile("" : "+s"(ldz_)); smem = (float*)(g_smem + ldz_); }
    int tid_ = threadIdx.x; asm volatile("" : "+v"(tid_)); const int tid = tid_, lane = tid & 63, wv = tid >> 6, li = layer >> 1;
    const bf16_t* P = (const bf16_t*)(ws_ + OFF_P); const float* AUX = (const float*)(ws_ + OFF_AUX);
    bf16_t* QB = (bf16_t*)(ws_ + OFF_QBB); bf16_t* KB = (bf16_t*)(ws_ + OFF_KBB); bf16_t* QI = (bf16_t*)(ws_ + OFF_QIB); bf16_t* KI = (bf16_t*)(ws_ + OFF_KIB); float* WI = (float*)(ws_ + OFF_WI);
    const float* COSA = (const float*)(ws_ + OFF_COSA); const float* SINA = (const float*)(ws_ + OFF_SINA);
    const float* COSI = (const float*)(ws_ + OFF_COSI); const float* SINI = (const float*)(ws_ + OFF_SINI);
    for (int t = blockIdx.x * 8 + wv; t < NT; t += gridDim.x * 8) {
        const bf16_t* Pt = P + (size_t)t * LDPB;
        if (lane < 4) {
            WI[t * 4 + lane] = AUX[(size_t)t * 16 + 8 + lane] * 0.0625f;
        }
        { const float c = COSA[(size_t)t * 64 + lane], sn = SINA[(size_t)t * 64 + lane];
#pragma unroll
          for (int h = 0; h < 4; ++h) {
              float t1 = bf16_to_f32(Pt[2056 + h * 128 + lane]), t2 = bf16_to_f32(Pt[2056 + h * 128 + 64 + lane]);
              QB[(size_t)t * 512 + h * 128 + lane] = f2bf(t1 * c - t2 * sn); QB[(size_t)t * 512 + h * 128 + 64 + lane] = f2bf(t2 * c + t1 * sn);
              t1 = bf16_to_f32(Pt[2568 + h * 128 + lane]); t2 = bf16_to_f32(Pt[2568 + h * 128 + 64 + lane]);
              KB[(size_t)t * 512 + h * 128 + lane] = f2bf(t1 * c - t2 * sn); KB[(size_t)t * 512 + h * 128 + 64 + lane] = f2bf(t2 * c + t1 * sn);
          } }
#pragma unroll
        for (int r = 0; r < 2; ++r) {
            const int item = lane + 64 * r, hh = item >> 5, ii = item & 31;
            const float c = COSI[(size_t)t * 32 + ii], sn = SINI[(size_t)t * 32 + ii];
            const float t1 = bf16_to_f32(Pt[3592 + hh * 64 + ii]), t2 = bf16_to_f32(Pt[3592 + hh * 64 + 32 + ii]);
            QI[(size_t)t * 256 + hh * 64 + ii] = f2bf(t1 * c - t2 * sn); QI[(size_t)t * 256 + hh * 64 + 32 + ii] = f2bf(t2 * c + t1 * sn);
        }
        if (lane < 32) {
            const float c = COSI[(size_t)t * 32 + lane], sn = SINI[(size_t)t * 32 + lane];
            const float t1 = bf16_to_f32(Pt[3848 + lane]), t2 = bf16_to_f32(Pt[3848 + 32 + lane]);
            bf16_t* kd = KI + (size_t)(t >> 4) * 1024 + ((lane >> 3) * 16 + (t & 15)) * 8 + (lane & 7);
            kd[0] = f2bf(t1 * c - t2 * sn); kd[512] = f2bf(t2 * c + t1 * sn);
        }
    }
    { bf16_t* VT = (bf16_t*)(ws_ + OFF_VT);
      bf16_t* sv = (bf16_t*)g_smem;
      for (int item = blockIdx.x; item < 2 * 128 * 4; item += gridDim.x) {
          const int h = item & 3, tt = item >> 2, b = tt >> 7, s0 = (tt & 127) * 64;
          __syncthreads();
          for (int e = tid; e < 64 * 128; e += NTHREADS) { const int i = e >> 7, d = e & 127; sv[d * 72 + i] = P[(size_t)(b * 8192 + s0 + i) * LDPB + 3080 + h * 128 + d]; }
          __syncthreads();
          for (int e = tid; e < 128 * 8; e += NTHREADS) { const int d = e >> 3, c = e & 7;
              *(uint4*)(VT + ((size_t)((b * 4 + h) * 128 + d)) * 8192 + s0 + c * 8) = *(const uint4*)(sv + d * 72 + c * 8); }
      } }
}

__device__ __forceinline__ f32x4 mma_lds(const unsigned char* A, int sa, int a0, const unsigned char* B, int sb, int b0, int K, f32x4 acc, int c16, int q4) {
    const unsigned char* ap = A + (a0 + c16) * sa + q4 * 16;
    const unsigned char* bp = B + (b0 + c16) * sb + q4 * 16;
#pragma unroll
    for (int kk = 0; kk < K; kk += 32) { acc = __builtin_amdgcn_mfma_f32_16x16x32_bf16(*(const bf16x8*)(ap + kk * 2), *(const bf16x8*)(bp + kk * 2), acc, 0, 0, 0); }
    return acc;
}

PHASE_FN void ph_gdn_chunk(const Params& p, int layer, float* smem) {
    KParams* pp = kparams();
    GU8* wsg_ = (GU8*)pp->ws; asm volatile("" : "+s"(wsg_)); unsigned char* ws_ = (unsigned char*)wsg_;
    int tid_ = threadIdx.x; asm volatile("" : "+v"(tid_)); const int tid = tid_, lane = tid & 63, wv = __builtin_amdgcn_readfirstlane(tid >> 6), q4 = lane >> 4, c16 = lane & 15;
    int ldz_ = 0; asm volatile("" : "+s"(ldz_)); unsigned char* lds = g_smem + ldz_;
    constexpr int SN = 272, ST = 144;
    unsigned char* bKN = lds;
    unsigned char* bQN = lds + 18432;
    unsigned char* bKBG = lds + 35840;
    unsigned char* bVB = lds + 54272;
    unsigned char* bKD = lds + 72704;
    unsigned char* bUT = lds + 91136;
    float* sL = (float*)(lds + 109568);
    unsigned char* bAQK = lds + 126976;
    unsigned char* bTB = lds + 136192;
    float* sG = (float*)(lds + 145408); float* sB = sG + 64; float* sEg = sB + 64;
    const int li = layer >> 1;
    const bf16_t* P = (const bf16_t*)(ws_ + OFF_P); const float* AUX = (const float*)(ws_ + OFF_AUX);
    const float* cw = as_global(pp->conv_w) + (size_t)li * 4 * 1536;
    uint4* PFR = (uint4*)(ws_ + OFF_PFR); uint4* RFR = (uint4*)(ws_ + OFF_RFR); uint2* QFR = (uint2*)(ws_ + OFF_QFR); uint2* OFR = (uint2*)(ws_ + OFF_OFR);
    float* GL = (float*)(ws_ + OFF_GL);
    for (int ci = blockIdx.x; ci < 1024; ci += gridDim.x) {
        const int b = ci >> 9, h = (ci >> 7) & 3, n = ci & 127;
        const int t0 = b * 8192 + n * 64;
        __syncthreads();
        if (tid < 64) { float g = -expf(as_global(pp->a_log)[li * 4 + h]) * softplusf_(AUX[(size_t)(t0 + tid) * 16 + 4 + h] + as_global(pp->dt_bias)[li * 4 + h]);
#pragma unroll
            for (int o = 1; o < 64; o <<= 1) { const float nb = __shfl_up(g, o); if (lane >= o) g += nb; }
            sG[tid] = g; sB[tid] = sigmoidf_(AUX[(size_t)(t0 + tid) * 16 + h]); sEg[tid] = expf(g); }
        for (int e = tid; e < 64 * 36; e += NTHREADS) ((unsigned*)bAQK)[e] = 0u;
        __syncthreads();
        const float gl = sG[63];
        for (int rep_a = 0; rep_a < REP_A; ++rep_a)
        {
            const int d0 = 2 * lane, cb = h * 128 + d0, s00 = n * 64;
            float wq[4][2], wk[4][2], wvv[4][2];
#pragma unroll
            for (int jj = 0; jj < 4; ++jj) { wq[jj][0] = cw[jj * 1536 + cb]; wq[jj][1] = cw[jj * 1536 + cb + 1]; wk[jj][0] = cw[jj * 1536 + 512 + cb]; wk[jj][1] = cw[jj * 1536 + 512 + cb + 1];
                                            wvv[jj][0] = cw[jj * 1536 + 1024 + cb]; wvv[jj][1] = cw[jj * 1536 + 1024 + cb + 1]; }
            float tk0[8], tk1[8], tv0[8], tv1[8], td0[8], td1[8];
#pragma unroll
            for (int r = 0; r < 8; ++r) {
                const int i = wv * 8 + r;
                float aq0 = 0.f, aq1 = 0.f, ak0 = 0.f, ak1 = 0.f, av0 = 0.f, av1 = 0.f;
#pragma unroll
                for (int jj = 0; jj < 4; ++jj) {
                    if (s00 + i - 3 + jj >= 0) {
                        const bf16_t* rp = P + (size_t)(t0 + i - 3 + jj) * LDPB + cb;
                        const unsigned uq = *(const unsigned*)rp, uk = *(const unsigned*)(rp + 512), uv = *(const unsigned*)(rp + 1024);
                        aq0 += wq[jj][0] * __uint_as_float(uq << 16); aq1 += wq[jj][1] * __uint_as_float(uq & 0xffff0000u);
                        ak0 += wk[jj][0] * __uint_as_float(uk << 16); ak1 += wk[jj][1] * __uint_as_float(uk & 0xffff0000u);
                        av0 += wvv[jj][0] * __uint_as_float(uv << 16); av1 += wvv[jj][1] * __uint_as_float(uv & 0xffff0000u);
                    }
                }
                aq0 = siluf_(aq0); aq1 = siluf_(aq1); ak0 = siluf_(ak0); ak1 = siluf_(ak1); av0 = siluf_(av0); av1 = siluf_(av1);
                const float rq = rsqrtf(wave_sum(aq0 * aq0 + aq1 * aq1) + EPS), rk = rsqrtf(wave_sum(ak0 * ak0 + ak1 * ak1) + EPS);
                aq0 *= rq; aq1 *= rq; ak0 *= rk; ak1 *= rk;
                const float be = sB[i], eg_i = sEg[i], ekd = expf(gl - sG[i]);
                *(unsigned*)(bKN + i * SN + d0 * 2) = cvt_pk_bf16(ak0, ak1);
                *(unsigned*)(bQN + i * SN + d0 * 2) = cvt_pk_bf16(aq0, aq1);
                tk0[r] = ak0 * be * eg_i; tk1[r] = ak1 * be * eg_i; tv0[r] = av0 * be; tv1[r] = av1 * be; td0[r] = ak0 * ekd; td1[r] = ak1 * ekd;
                if ((r & 1) == 1) asm volatile("" ::: "memory");
            }
#define PK8(T) make_uint4(cvt_pk_bf16(T[0], T[1]), cvt_pk_bf16(T[2], T[3]), cvt_pk_bf16(T[4], T[5]), cvt_pk_bf16(T[6], T[7]))
            *(uint4*)(bKBG + d0 * ST + wv * 16) = PK8(tk0); *(uint4*)(bKBG + (d0 + 1) * ST + wv * 16) = PK8(tk1);
            *(uint4*)(bVB + d0 * ST + wv * 16) = PK8(tv0); *(uint4*)(bVB + (d0 + 1) * ST + wv * 16) = PK8(tv1);
            *(uint4*)(bKD + d0 * ST + wv * 16) = PK8(td0); *(uint4*)(bKD + (d0 + 1) * ST + wv * 16) = PK8(td1);
        }
        __syncthreads();
        for (int u = wv; u < 20; u += 8) {
            const int kind = (u >= 10) ? 1 : 0, idx = u - kind * 10;
            const int ti = (idx >= 6) ? 3 : (idx >= 3) ? 2 : (idx >= 1) ? 1 : 0, tj = idx - ((ti * (ti + 1)) >> 1);
            f32x4 acc = (f32x4){0.f, 0.f, 0.f, 0.f};
            acc = mma_lds(kind ? bQN : bKN, SN, 16 * ti, bKN, SN, 16 * tj, 128, acc, c16, q4);
            const int j = 16 * tj + c16;
#pragma unroll
            for (int r = 0; r < 4; ++r) { const int i = 16 * ti + 4 * q4 + r;
                const float dec = (j <= i) ? expf(sG[i] - sG[j]) : 0.f;
                if (kind == 0) sL[i * 68 + j] = (j < i) ? sB[i] * acc[r] * dec : 0.f;
                else *(bf16_t*)(bAQK + i * ST + j * 2) = f2bf(acc[r] * SCALE128 * dec); }
        }
        __syncthreads();
        for (int rep_b = 0; rep_b < REP_B; ++rep_b)
        if (wv == 0) {
            float t[64];
            int zz = 0; asm volatile("" : "+v"(zz)); const float* sLo = sL + zz;
#pragma clang loop unroll(full)
            for (int i = 0; i < 64; ++i) { float a0 = (i == lane) ? 1.f : 0.f, a1 = 0.f, a2 = 0.f, a3 = 0.f;
#define LQ(q) float4 lv##q = make_float4(0.f, 0.f, 0.f, 0.f); if (4 * q < i) lv##q = *(const float4*)(sLo + i * 68 + 4 * q);
#define FQ(q) if (4 * q < i) { a0 -= lv##q.x * t[4 * q]; if (4 * q + 1 < i) a1 -= lv##q.y * t[4 * q + 1]; if (4 * q + 2 < i) a2 -= lv##q.z * t[4 * q + 2]; if (4 * q + 3 < i) a3 -= lv##q.w * t[4 * q + 3]; }
                { LQ(0) LQ(1) LQ(2) LQ(3) LQ(4) LQ(5) LQ(6) LQ(7)
                  FQ(0) FQ(1) FQ(2) FQ(3) FQ(4) FQ(5) FQ(6) FQ(7) }
                if (i > 32) { asm volatile("" ::: "memory");
                  LQ(8) LQ(9) LQ(10) LQ(11) LQ(12) LQ(13) LQ(14) LQ(15)
                  FQ(8) FQ(9) FQ(10) FQ(11) FQ(12) FQ(13) FQ(14) FQ(15) }
                t[i] = (a0 + a1) + (a2 + a3); asm volatile("" ::: "memory"); }
#pragma unroll
            for (int i = 0; i < 64; ++i) *(bf16_t*)(bTB + i * ST + lane * 2) = f2bf(t[i]);
        }
        __syncthreads();
#pragma unroll 4
        for (int x = 0; x < 8; ++x) {
            const int u = wv * 8 + x, kind = u >> 5, ti = (u >> 3) & 3, td = u & 7;
            f32x4 acc = (f32x4){0.f, 0.f, 0.f, 0.f};
            acc = mma_lds(bTB, ST, 16 * ti, kind ? bVB : bKBG, ST, 16 * td, 64, acc, c16, q4);
            *(uint2*)((kind ? bUT : bKN) + (16 * td + c16) * ST + (16 * ti + 4 * q4) * 2) = pack4(acc);
        }
        __syncthreads();
        unsigned char* bWT = bKN;
        const float eg = expf(gl);
        for (int rep_c = 0; rep_c < REP_C; ++rep_c) {
        for (int x = 0; x < 4; ++x) {
            const int u = wv * 4 + x, ti = u >> 2, a = u & 3;
            uint4 fr;
#pragma unroll
            for (int hf = 0; hf < 2; ++hf) { const int tk = 2 * a + hf;
                f32x4 acc = (f32x4){0.f, 0.f, 0.f, 0.f};
                acc = mma_lds(bWT, ST, 16 * tk, bKD, ST, 16 * ti, 64, acc, c16, q4);
                f32x4 v;
#pragma unroll
                for (int r = 0; r < 4; ++r) v[r] = ((16 * tk + 4 * q4 + r) == (16 * ti + c16) ? eg : 0.f) - acc[r];
                const uint2 pk = pack4(v);
                if (hf == 0) { fr.x = pk.x; fr.y = pk.y; } else { fr.z = pk.x; fr.w = pk.y; } }
            PFR[((size_t)(ci * 8 + ti) * 4 + a) * 64 + lane] = fr;
        }
        for (int x = 0; x < 2; ++x) {
            const int u = wv * 2 + x, ti = u >> 2, a = u & 3;
            uint4 fr;
            const int i = 16 * ti + c16;
            const float qs = SCALE128 * sEg[i];
#pragma unroll
            for (int hf = 0; hf < 2; ++hf) { const int tk = 2 * a + hf;
                f32x4 acc = (f32x4){0.f, 0.f, 0.f, 0.f};
                acc = mma_lds(bWT, ST, 16 * tk, bAQK, ST, 16 * ti, 64, acc, c16, q4);
                const f32x4 qv = unpack4(*(const uint2*)(bQN + i * SN + (16 * tk + 4 * q4) * 2));
                const uint2 pk = pack4(qv * qs - acc);
                if (hf == 0) { fr.x = pk.x; fr.y = pk.y; } else { fr.z = pk.x; fr.w = pk.y; } }
            RFR[((size_t)(ci * 4 + ti) * 4 + a) * 64 + lane] = fr;
        }
#pragma unroll 4
        for (int x = 0; x < 8; ++x) {
            const int u = wv * 8 + x, tdv = u >> 3, tdk = u & 7;
            f32x4 acc = (f32x4){0.f, 0.f, 0.f, 0.f};
            acc = mma_lds(bKD, ST, 16 * tdk, bUT, ST, 16 * tdv, 64, acc, c16, q4);
            QFR[((size_t)(ci * 8 + tdv) * 8 + tdk) * 64 + lane] = pack4(acc);
        }
#pragma unroll
        for (int x = 0; x < 4; ++x) {
            const int u = wv * 4 + x, tdv = u >> 2, ti = u & 3;
            f32x4 acc = (f32x4){0.f, 0.f, 0.f, 0.f};
            acc = mma_lds(bAQK, ST, 16 * ti, bUT, ST, 16 * tdv, 64, acc, c16, q4);
            OFR[((size_t)(ci * 8 + tdv) * 4 + ti) * 64 + lane] = pack4(acc);
        }
        }
        if (tid == 0) GL[ci] = gl;
    }
}

__device__ __forceinline__ void gs_load(uint4 (&d)[12], const unsigned char* pp, const unsigned char* rr, const unsigned char* qq, const unsigned char* oo, const int lt) {
#pragma unroll
    for (int i = 0; i < 6; ++i) { int c = lt + 384 * i; c = c < 2048 ? c : 2047; d[i] = *(const uint4*)(pp + c * 16); }
#pragma unroll
    for (int i = 0; i < 3; ++i) { int c = lt + 384 * i; c = c < 1024 ? c : 1023; d[6 + i] = *(const uint4*)(rr + c * 16); }
#pragma unroll
    for (int i = 0; i < 2; ++i) { int c = lt + 384 * i; c = c < 512 ? c : 511; d[9 + i] = *(const uint4*)(qq + c * 16); }
    { const int c = lt < 256 ? lt : 255; d[11] = *(const uint4*)(oo + c * 16); }
}
__device__ __forceinline__ void gs_store(const uint4 (&d)[12], unsigned char* sb, const int lt) {
#pragma unroll
    for (int i = 0; i < 6; ++i) { const int c = lt + 384 * i; if (c < 2048) *(uint4*)(sb + c * 16) = d[i]; }
#pragma unroll
    for (int i = 0; i < 3; ++i) { const int c = lt + 384 * i; if (c < 1024) *(uint4*)(sb + 32768 + c * 16) = d[6 + i]; }
#pragma unroll
    for (int i = 0; i < 2; ++i) { const int c = lt + 384 * i; if (c < 512) *(uint4*)(sb + 49152 + c * 16) = d[9 + i]; }
    if (lt < 256) *(uint4*)(sb + 57344 + lt * 16) = d[11];
}

#define SCAN_BODY                 bf16x8 Sb[4]; \
_Pragma("unroll") \
                for (int a = 0; a < 4; ++a) { union { uint4 u; bf16x8 v; } cv; const uint2 lo = pack4(S[2 * a]), hi = pack4(S[2 * a + 1]); cv.u.x = lo.x; cv.u.y = lo.y; cv.u.z = hi.x; cv.u.w = hi.y; Sb[a] = cv.v; } \
                const int t0 = b * 8192 + n * 64; \
                {   f32x4 oa[4]; \
_Pragma("unroll") \
                    for (int ti = 0; ti < 4; ++ti) oa[ti] = unpack4(*(const uint2*)(Of + ti * 512)); \
_Pragma("unroll") \
                    for (int a = 0; a < 4; ++a) \
_Pragma("unroll") \
                        for (int ti = 0; ti < 4; ++ti) oa[ti] = __builtin_amdgcn_mfma_f32_16x16x32_bf16(*(const bf16x8*)(Rf + (ti * 4 + a) * 1024), Sb[a], oa[ti], 0, 0, 0); \
_Pragma("unroll") \
                    for (int ti = 0; ti < 4; ++ti) { \
                        float* op = O + (size_t)(t0 + 16 * ti + 4 * q4) * 1024 + h * 128 + 16 * tdv + c16; \
                        op[0] = oa[ti][0]; op[1024] = oa[ti][1]; op[2048] = oa[ti][2]; op[3072] = oa[ti][3]; } \
                } \
                asm volatile("" ::: "memory"); \
_Pragma("unroll") \
                for (int g = 0; g < 2; ++g) { \
                    f32x4 sa[4]; \
_Pragma("unroll") \
                    for (int t = 0; t < 4; ++t) sa[t] = unpack4(*(const uint2*)(Qf + (g * 4 + t) * 512)); \
_Pragma("unroll") \
                    for (int a = 0; a < 4; ++a) \
_Pragma("unroll") \
                        for (int t = 0; t < 4; ++t) sa[t] = __builtin_amdgcn_mfma_f32_16x16x32_bf16(*(const bf16x8*)(Pf + ((g * 4 + t) * 4 + a) * 1024), Sb[a], sa[t], 0, 0, 0); \
_Pragma("unroll") \
                    for (int t = 0; t < 4; ++t) S[g * 4 + t] = sa[t]; \
                    asm volatile("" ::: "memory"); \
                }
PHASE_FN void ph_gdn_scan(const Params& p, float* smem) {
    KParams* pp = kparams();
    GU8* wsg_ = (GU8*)pp->ws; asm volatile("" : "+s"(wsg_)); unsigned char* ws_ = (unsigned char*)wsg_;
    int tid_ = threadIdx.x; asm volatile("" : "+v"(tid_)); const int tid = tid_, lane = tid & 63, wv = __builtin_amdgcn_readfirstlane(tid >> 6), q4 = lane >> 4, c16 = lane & 15;
    int ldz_ = 0; asm volatile("" : "+s"(ldz_)); unsigned char* lds = g_smem + ldz_;
    constexpr int STG = 61440;
    const unsigned char* PFR = ws_ + OFF_PFR; const unsigned char* RFR = ws_ + OFF_RFR; const unsigned char* QFR = ws_ + OFF_QFR; const unsigned char* OFR = ws_ + OFF_OFR;
    float* O = (float*)(ws_ + OFF_O);
    for (int it = blockIdx.x; it < 32; it += gridDim.x) {
        const int bh = it >> 2, pair = it & 3, b = bh >> 2, h = bh & 3;
        __syncthreads();
        if (wv >= 2) {
            const int lt = tid - 128;
            const unsigned char* Pb = PFR + (size_t)bh * 128 * 32768;
            const unsigned char* Rb = RFR + (size_t)bh * 128 * 16384;
            const unsigned char* Qb = QFR + (size_t)bh * 128 * 32768 + pair * 8192;
            const unsigned char* Ob = OFR + (size_t)bh * 128 * 16384 + pair * 4096;
            uint4 ra0, ra1, ra2, ra3, ra4, ra5, ra6, ra7, ra8, ra9, ra10, ra11, rb0, rb1, rb2, rb3, rb4, rb5, rb6, rb7, rb8, rb9, rb10, rb11;
            uint4 rc0, rc1, rc2, rc3, rc4, rc5, rc6, rc7, rc8, rc9, rc10, rc11;
#define LDC(base_, c_, mx_) (*(const uint4*)((base_) + (size_t)(((c_) < (mx_)) ? (c_) : (mx_)) * 16))
#define GS_LOAD(X, n_) do { const unsigned char* pp_ = Pb + (size_t)(n_) * 32768; const unsigned char* rr_ = Rb + (size_t)(n_) * 16384; \
                const unsigned char* qq_ = Qb + (size_t)(n_) * 32768; const unsigned char* oo_ = Ob + (size_t)(n_) * 16384; \
                X##0 = LDC(pp_, lt, 2047); X##1 = LDC(pp_, lt + 384, 2047); X##2 = LDC(pp_, lt + 768, 2047); X##3 = LDC(pp_, lt + 1152, 2047); X##4 = LDC(pp_, lt + 1536, 2047); X##5 = LDC(pp_, lt + 1920, 2047); \
                X##6 = LDC(rr_, lt, 1023); X##7 = LDC(rr_, lt + 384, 1023); X##8 = LDC(rr_, lt + 768, 1023); \
                X##9 = LDC(qq_, lt, 511); X##10 = LDC(qq_, lt + 384, 511); X##11 = LDC(oo_, lt, 255); } while (0)
#define STC(off_, c_, lim_, v_) do { if ((c_) < (lim_)) *(uint4*)(sb_ + (off_) + (c_) * 16) = v_; } while (0)
#define GS_STORE(X, st_) do { unsigned char* sb_ = lds + (st_) * STG; \
                STC(0, lt, 2048, X##0); STC(0, lt + 384, 2048, X##1); STC(0, lt + 768, 2048, X##2); STC(0, lt + 1152, 2048, X##3); STC(0, lt + 1536, 2048, X##4); STC(0, lt + 1920, 2048, X##5); \
                STC(32768, lt, 1024, X##6); STC(32768, lt + 384, 1024, X##7); STC(32768, lt + 768, 1024, X##8); \
                STC(49152, lt, 512, X##9); STC(49152, lt + 384, 512, X##10); STC(57344, lt, 256, X##11); } while (0)
            GS_LOAD(ra, 0); GS_STORE(ra, 0);
            GS_LOAD(rb, 1); GS_LOAD(rc, 2); GS_LOAD(ra, 3);
            __syncthreads();
#define CLAMPN(x_) (((x_) < 128) ? (x_) : 127)
            for (int n = 0; n < 128; n += 3) {
                if (n + 1 < 128) GS_STORE(rb, (n + 1) & 1);
                GS_LOAD(rb, CLAMPN(n + 4)); LBAR();
                if (n + 1 < 128) { if (n + 2 < 128) GS_STORE(rc, (n + 2) & 1);
                    GS_LOAD(rc, CLAMPN(n + 5)); LBAR(); }
                if (n + 2 < 128) { if (n + 3 < 128) GS_STORE(ra, (n + 3) & 1);
                    GS_LOAD(ra, CLAMPN(n + 6)); LBAR(); }
            }
        } else {
            const int tdv = pair * 2 + wv;
            f32x4 S[8];
#pragma unroll
            for (int t = 0; t < 8; ++t) S[t] = (f32x4){0.f, 0.f, 0.f, 0.f};
            __syncthreads();
            for (int n = 0; n < 128; ++n) {
                const unsigned char* base = lds + (n & 1) * STG;
                const unsigned char* Pf = base + lane * 16, *Rf = base + 32768 + lane * 16;
                const unsigned char* Qf = base + 49152 + wv * 4096 + lane * 8, *Of = base + 57344 + wv * 2048 + lane * 8;
                SCAN_BODY
                LBAR();
            }
        }
    }
}

__device__ __forceinline__ void block_sum4(int (&v)[4], int* buf) {
    const int lane = threadIdx.x & 63, wv = threadIdx.x >> 6;
#pragma unroll
    for (int q = 0; q < 4; ++q) v[q] = wave_sum_i(v[q]);
    if (lane == 0) {
#pragma unroll
        for (int q = 0; q < 4; ++q) buf[wv * 4 + q] = v[q];
    }
    __syncthreads();
#pragma unroll
    for (int q = 0; q < 4; ++q) { int a = 0; for (int w = 0; w < 8; ++w) a += buf[w * 4 + q]; v[q] = a; }
}

PHASE_FN void ph_dsa_topk(const Params& p, int layer, float* smem) {
    KParams* pp = kparams();
    GU8* wsg_ = (GU8*)pp->ws; asm volatile("" : "+s"(wsg_)); unsigned char* ws_ = (unsigned char*)wsg_;
    int tid_ = threadIdx.x; asm volatile("" : "+v"(tid_)); const int tid = tid_, lane = tid & 63, wv = __builtin_amdgcn_readfirstlane(tid >> 6), q4 = lane >> 4, c16 = lane & 15;
    int* sRed = (int*)g_smem;
    const bf16_t* QIb = (const bf16_t*)(ws_ + OFF_QIB); const bf16_t* KIb = (const bf16_t*)(ws_ + OFF_KIB); const float* WI = (const float*)(ws_ + OFF_WI);
    unsigned short* M16 = (unsigned short*)(ws_ + OFF_M16);
    int* qhead = (int*)(ws_ + OFF_QCTR) + layer * 16;
    int* sIt = (int*)(g_smem + 512);
    __syncthreads();
    if (tid == 0) *sIt = atomicAdd(qhead, 1);
    __syncthreads();
    int it = *sIt;
    while (it < 2048) {
        int nxt = 0;
        const int b = it & 1, gp = 1023 - (it >> 1);
        const int s0 = gp * 8, t0 = b * 8192 + s0;
        const int ntiles = (s0 >> 4) + 1;
        const int nreg = (ntiles > wv) ? ((ntiles - wv + 7) >> 3) : 0;
        const bf16_t* qp = QIb + (size_t)(t0 + (c16 >> 2)) * 256 + (c16 & 3) * 64 + 8 * q4;
        const bf16x8 a0A = *(const bf16x8*)qp, a1A = *(const bf16x8*)(qp + 32), a0B = *(const bf16x8*)(qp + 4 * 256), a1B = *(const bf16x8*)(qp + 4 * 256 + 32);
        const float4 wqA = *(const float4*)(WI + (size_t)(t0 + q4) * 4), wqB = *(const float4*)(WI + (size_t)(t0 + 4 + q4) * 4);
        const int myqA = s0 + q4, myqB = s0 + 4 + q4;
        int c16s = c16; asm volatile("" : "+v"(c16s));
        int lanes = lane; asm volatile("" : "+v"(lanes));
        int wvs = wv; asm volatile("" : "+s"(wvs));
        unsigned kA[64], kB[64];
#pragma unroll
        for (int i = 0; i < 64; ++i) { kA[i] = 0u; kB[i] = 0u; }
#define RELU_(x_) __builtin_amdgcn_fmed3f((x_), 0.f, __builtin_inff())
#define SC_TILE(il_, tile_, k0_, k1_) { \
                    f32x4 accA = (f32x4){0.f, 0.f, 0.f, 0.f}, accB = accA; \
                    accA = __builtin_amdgcn_mfma_f32_16x16x32_bf16(a0A, k0_, accA, 0, 0, 0); \
                    accB = __builtin_amdgcn_mfma_f32_16x16x32_bf16(a0B, k0_, accB, 0, 0, 0); \
                    accA = __builtin_amdgcn_mfma_f32_16x16x32_bf16(a1A, k1_, accA, 0, 0, 0); \
                    accB = __builtin_amdgcn_mfma_f32_16x16x32_bf16(a1B, k1_, accB, 0, 0, 0); \
                    const float sa = fmaf(wqA.w, RELU_(accA[3]), fmaf(wqA.z, RELU_(accA[2]), fmaf(wqA.y, RELU_(accA[1]), wqA.x * RELU_(accA[0])))); \
                    const float sb = fmaf(wqB.w, RELU_(accB[3]), fmaf(wqB.z, RELU_(accB[2]), fmaf(wqB.y, RELU_(accB[1]), wqB.x * RELU_(accB[0])))); \
                    const int kidx = (tile_) * 16 + c16s; \
                    kA[il_] = (kidx <= myqA) ? ordkey(sa) : 0u; \
                    kB[il_] = (kidx <= myqB) ? ordkey(sb) : 0u; }
        const int nblk = (nreg + 15) >> 4;
        for (int rep_s = 0; rep_s < REP_S; ++rep_s) {
        if (rep_s > 0) {
#pragma unroll
            for (int i = 0; i < 64; ++i) { kA[i] = 0u; kB[i] = 0u; } }
#pragma nounroll
        for (int blk = nblk - 1; blk >= 0; --blk) {
#pragma unroll
            for (int i = 63; i >= 16; --i) { kA[i] = kA[i - 16]; kB[i] = kB[i - 16]; }
#pragma unroll
            for (int i = 0; i < 16; ++i) { kA[i] = 0u; kB[i] = 0u; }
            const int tb = wvs + 128 * blk;
#pragma unroll
            for (int g = 0; g < 4; ++g) { const int tg = tb + 32 * g;
                if (tg < ntiles) {
                    const bf16_t* kp = KIb + (size_t)(b * 512 + tg) * 1024 + lanes * 8;
                    const bf16x8 k00 = *(const bf16x8*)kp, k01 = *(const bf16x8*)(kp + 512);
                    const bf16x8 k10 = *(const bf16x8*)(kp + 8 * 1024), k11 = *(const bf16x8*)(kp + 8 * 1024 + 512);
                    const bf16x8 k20 = *(const bf16x8*)(kp + 16 * 1024), k21 = *(const bf16x8*)(kp + 16 * 1024 + 512);
                    const bf16x8 k30 = *(const bf16x8*)(kp + 24 * 1024), k31 = *(const bf16x8*)(kp + 24 * 1024 + 512);
                    SC_TILE(g * 4, tg, k00, k01) SC_TILE(g * 4 + 1, tg + 8, k10, k11) SC_TILE(g * 4 + 2, tg + 16, k20, k21) SC_TILE(g * 4 + 3, tg + 24, k30, k31)
                }
                asm volatile("" ::: "memory"); }
        }
        }
        if (tid == 0) nxt = atomicAdd(qhead, 1);
        const int keffA = (myqA + 1 < 256) ? (myqA + 1) : 256, keffB = (myqB + 1 < 256) ? (myqB + 1) : 256;
        int par = 0;
        int mydone = 0, alldone = 0;
        auto qsum = [&](int c) -> int {
            c += __builtin_amdgcn_update_dpp(0, c, 0xB1, 0xf, 0xf, true);
            c += __builtin_amdgcn_update_dpp(0, c, 0x4E, 0xf, 0xf, true);
            c += __builtin_amdgcn_update_dpp(0, c, 0x124, 0xf, 0xf, true);
            c += __builtin_amdgcn_update_dpp(0, c, 0x128, 0xf, 0xf, true);
            par ^= 1;
            sRed[par * 32 + q4 * 8 + wv] = c;
            LBAR();
            const int4 r0 = *(const int4*)(sRed + par * 32 + q4 * 8), r1 = *(const int4*)(sRed + par * 32 + q4 * 8 + 4);
            return r0.x + r0.y + r0.z + r0.w + r1.x + r1.y + r1.z + r1.w;
        };
        const bool has1 = nreg > 32;
#define TR_STEP(a, base, J_, M_) { _Pragma("unroll") for (int k_ = 0; k_ < 32; ++k_) if ((k_ & (J_)) == 0) { \
                const unsigned lo_ = a[(base) + k_], hi_ = a[(base) + k_ + (J_)]; \
                a[(base) + k_] = ((M_) & lo_) | (~(M_) & (hi_ << (J_))); \
                a[(base) + k_ + (J_)] = ((M_) & (lo_ >> (J_))) | (~(M_) & hi_); } }
#define TR32(a, base) { TR_STEP(a, base, 16, 0x0000FFFFu) TR_STEP(a, base, 8, 0x00FF00FFu) TR_STEP(a, base, 4, 0x0F0F0F0Fu) TR_STEP(a, base, 2, 0x33333333u) TR_STEP(a, base, 1, 0x55555555u) }
        for (int rep_t = 0; rep_t < REP_T; ++rep_t) {
        TR32(kA, 0) TR32(kB, 0)
        if (has1) { TR32(kA, 32) TR32(kB, 32) } }
        unsigned alA0, alA1, alB0, alB1, gmA0, gmA1, gmB0, gmB1;
        int GA, GB;
        for (int rep_q = 0; rep_q < REP_Q; ++rep_q) {
        alA0 = ~0u; alA1 = has1 ? ~0u : 0u; alB0 = ~0u; alB1 = alA1; gmA0 = 0u; gmA1 = 0u; gmB0 = 0u; gmB1 = 0u; GA = 0; GB = 0; mydone = 0; alldone = 0;
#pragma unroll
        for (int bit = 31; bit >= 0; --bit) {
            if (alldone) continue;
            const unsigned mA0 = alA0 & kA[bit], mA1 = alA1 & kA[32 + bit], mB0 = alB0 & kB[bit], mB1 = alB1 & kB[32 + bit];
            const int ca = __builtin_popcount(mA0) + __builtin_popcount(mA1), cb = __builtin_popcount(mB0) + __builtin_popcount(mB1);
            const int tot = qsum(ca | (cb << 16));
            const int tA = GA + (tot & 0xffff), tB = GB + (tot >> 16);
            if (tA >= keffA) { alA0 = mA0; alA1 = mA1; mydone = (mydone & 2) | ((tA == keffA) ? 1 : 0); }
            else { GA = tA; gmA0 |= mA0; gmA1 |= mA1; alA0 ^= mA0; alA1 ^= mA1; }
            if (tB >= keffB) { alB0 = mB0; alB1 = mB1; mydone = (mydone & 1) | ((tB == keffB) ? 2 : 0); }
            else { GB = tB; gmB0 |= mB0; gmB1 |= mB1; alB0 ^= mB0; alB1 ^= mB1; }
            alldone = (__ballot(mydone == 3) == ~0ull) ? 1 : 0;
        }
        }
        const int ce = qsum((__builtin_popcount(alA0) + __builtin_popcount(alA1)) | ((__builtin_popcount(alB0) + __builtin_popcount(alB1)) << 16));
        const int needA = keffA - GA, needB = keffB - GB;
        par ^= 1;
        sRed[par * 32 + q4 * 8 + wv] = (((ce & 0xffff) > needA) || ((ce >> 16) > needB)) ? 1 : 0;
        LBAR();
        int anyov = 0;
#pragma unroll
        for (int w = 0; w < 32; ++w) anyov |= sRed[par * 32 + w];
        if (anyov) {
            int JA = 0, JB = 0;
            int c16j = c16; asm volatile("" : "+v"(c16j));
            int wvj = wv; asm volatile("" : "+s"(wvj));
            for (int bit = 12; bit >= 0; --bit) {
                const int cjA = JA | (1 << bit), cjB = JB | (1 << bit);
                int c = 0;
#pragma unroll
                for (int i = 0; i < 64; ++i) { const int kidx = (wvj + 8 * i) * 16 + c16j;
                    const unsigned ba = ((i < 32 ? alA0 : alA1) >> (i & 31)) & 1u, bb = ((i < 32 ? alB0 : alB1) >> (i & 31)) & 1u;
                    c += (ba && kidx < cjA) ? 1 : 0; c += (bb && kidx < cjB) ? 65536 : 0; }
                const int tot = qsum(c);
                if ((tot & 0xffff) <= needA - 1) JA = cjA;
                if ((tot >> 16) <= needB - 1) JB = cjB;
            }
            unsigned kpA0 = 0u, kpA1 = 0u, kpB0 = 0u, kpB1 = 0u;
#pragma unroll
            for (int i = 0; i < 32; ++i) { const int k0 = (wvj + 8 * i) * 16 + c16j, k1 = k0 + 4096;
                kpA0 |= (k0 <= JA) ? (1u << i) : 0u; kpA1 |= (k1 <= JA) ? (1u << i) : 0u; kpB0 |= (k0 <= JB) ? (1u << i) : 0u; kpB1 |= (k1 <= JB) ? (1u << i) : 0u; }
            alA0 &= kpA0; alA1 &= kpA1; alB0 &= kpB0; alB1 &= kpB1;
        }
        const unsigned selA0 = gmA0 | alA0, selA1 = gmA1 | alA1, selB0 = gmB0 | alB0, selB1 = gmB1 | alB1;
        unsigned short* sM = (unsigned short*)(g_smem + 1024);
        { unsigned z_ = 0u; asm volatile("" : "+v"(z_)); ((uint4*)sM)[tid] = make_uint4(z_, z_, z_, z_); }
        LBAR();
        int wve = wv; asm volatile("" : "+s"(wve));
        for (int rep_e = 0; rep_e < REP_E; ++rep_e)
#pragma nounroll
        for (int i = 0; i < nreg; ++i) {
            const int tile = wve + 8 * i;
            const unsigned wA = (i < 32) ? selA0 : selA1, wB = (i < 32) ? selB0 : selB1;
            const bool selA = ((wA >> (i & 31)) & 1u) != 0u, selB = ((wB >> (i & 31)) & 1u) != 0u;
            const unsigned long long balA = __ballot(selA), balB = __ballot(selB);
            if (c16 == 0) { sM[q4 * 512 + tile] = (unsigned short)((balA >> (16 * q4)) & 0xffffull);
                            sM[(4 + q4) * 512 + tile] = (unsigned short)((balB >> (16 * q4)) & 0xffffull); }
        }
        if (tid == 0) *sIt = nxt;
        __syncthreads();
        *(uint4*)(M16 + (size_t)(t0 + (tid >> 6)) * 512 + (tid & 63) * 8) = ((const uint4*)sM)[tid];
        it = *sIt;
    }
}

PHASE_FN void ph_dsa_attn(const Params& p, float* smem) {
    KParams* pp = kparams();
    GU8* wsg_ = (GU8*)pp->ws; asm volatile("" : "+s"(wsg_)); unsigned char* ws_ = (unsigned char*)wsg_;
    int tid_ = threadIdx.x; asm volatile("" : "+v"(tid_)); const int tid = tid_, lane = tid & 63, wv = tid >> 6, q4 = lane >> 4, c16 = lane & 15;
    int ldz_ = 0; asm volatile("" : "+s"(ldz_)); unsigned char* lds = g_smem + ldz_;
    const bf16_t* QBb = (const bf16_t*)(ws_ + OFF_QBB); const bf16_t* KBb = (const bf16_t*)(ws_ + OFF_KBB); const bf16_t* VT = (const bf16_t*)(ws_ + OFF_VT);
    const unsigned short* M16 = (const unsigned short*)(ws_ + OFF_M16);
    bf16_t* OB = (bf16_t*)(ws_ + OFF_OB);
    const float SC = SCALE128 * 1.4426950408889634f;
    for (int it = blockIdx.x; it < 256; it += gridDim.x) {
        const int bh = it & 7, jp = it >> 3, b = bh >> 2, h = bh & 3;
        for (int half = 0; half < 2; ++half) {
            const int jq = half ? jp : 63 - jp;
            const int qs = jq * 128, nkt = 2 * jq + 2;
            const int tq = b * 8192 + qs + wv * 16 + c16;
            bf16x8 qf[4];
#pragma unroll
            for (int a = 0; a < 4; ++a) qf[a] = *(const bf16x8*)(QBb + (size_t)tq * 512 + h * 128 + 8 * q4 + 32 * a);
            float m = -1e30f, lsum = 0.f;
            f32x4 oacc[8];
#pragma unroll
            for (int t = 0; t < 8; ++t) oacc[t] = (f32x4){0.f, 0.f, 0.f, 0.f};
            uint4 rk0, rk1, rv0, rv1;
            const int q0 = tid, q1 = tid + 512;
            const bf16_t* kg0 = KBb + (size_t)(b * 8192 + (q0 >> 4)) * 512 + h * 128 + (q0 & 15) * 8;
            const bf16_t* kg1 = KBb + (size_t)(b * 8192 + (q1 >> 4)) * 512 + h * 128 + (q1 & 15) * 8;
            const bf16_t* vg0 = VT + ((size_t)((b * 4 + h) * 128 + (q0 >> 3))) * 8192 + (q0 & 7) * 8;
            const bf16_t* vg1 = VT + ((size_t)((b * 4 + h) * 128 + (q1 >> 3))) * 8192 + (q1 & 7) * 8;
            const int lk0 = (q0 >> 4) * 256 + ((((q0 & 15)) ^ ((q0 >> 4) & 15)) << 4), lk1 = (q1 >> 4) * 256 + ((((q1 & 15)) ^ ((q1 >> 4) & 15)) << 4);
            const int lv0 = 16384 + (q0 >> 3) * 128 + ((((q0 & 7)) ^ ((q0 >> 3) & 7)) << 4), lv1 = 16384 + (q1 >> 3) * 128 + ((((q1 & 7)) ^ ((q1 >> 3) & 7)) << 4);
#define ATT_GLOAD(kt_) do { rk0 = *(const uint4*)(kg0 + (size_t)(kt_) * 64 * 512); rk1 = *(const uint4*)(kg1 + (size_t)(kt_) * 64 * 512); \
                            rv0 = *(const uint4*)(vg0 + (kt_) * 64); rv1 = *(const uint4*)(vg1 + (kt_) * 64); } while (0)
#define ATT_LSTORE(st_) do { unsigned char* base_ = lds + (st_) * 32768; *(uint4*)(base_ + lk0) = rk0; *(uint4*)(base_ + lk1) = rk1; *(uint4*)(base_ + lv0) = rv0; *(uint4*)(base_ + lv1) = rv1; } while (0)
            __syncthreads();
            ATT_GLOAD(0); ATT_LSTORE(0);
            __syncthreads();
            for (int kt = 0; kt < nkt; ++kt) {
                if (kt + 1 < nkt) ATT_GLOAD(kt + 1);
                const unsigned long long mbits = *(const unsigned long long*)(M16 + (size_t)tq * 512 + 4 * kt);
                const unsigned char* Kt = lds + (kt & 1) * 32768;
                const unsigned char* Vt = Kt + 16384;
                f32x4 sacc[4];
#pragma unroll
                for (int th = 0; th < 2; ++th) {
                    bf16x8 kf[8];
#pragma unroll
                    for (int tt = 0; tt < 2; ++tt) { const int row = 16 * (th * 2 + tt) + c16;
#pragma unroll
                        for (int a = 0; a < 4; ++a) kf[tt * 4 + a] = *(const bf16x8*)(Kt + row * 256 + ((((q4 + 4 * a)) ^ (row & 15)) << 4)); }
                    asm volatile("" : "+v"(kf[0]), "+v"(kf[1]), "+v"(kf[2]), "+v"(kf[3]), "+v"(kf[4]), "+v"(kf[5]), "+v"(kf[6]), "+v"(kf[7]));
                    sacc[th * 2] = (f32x4){0.f, 0.f, 0.f, 0.f}; sacc[th * 2 + 1] = (f32x4){0.f, 0.f, 0.f, 0.f};
#pragma unroll
                    for (int a = 0; a < 4; ++a)
#pragma unroll
                        for (int tt = 0; tt < 2; ++tt) sacc[th * 2 + tt] = __builtin_amdgcn_mfma_f32_16x16x32_bf16(kf[tt * 4 + a], qf[a], sacc[th * 2 + tt], 0, 0, 0);
                }
                float mx = m;
                const unsigned mlo = (unsigned)mbits >> (4 * q4), mhi = (unsigned)(mbits >> 32) >> (4 * q4);
                int vm[4][4];
#pragma unroll
                for (int ti = 0; ti < 4; ++ti)
#pragma unroll
                    for (int r = 0; r < 4; ++r) { vm[ti][r] = __builtin_amdgcn_sbfe((int)((ti < 2) ? mlo : mhi), 16 * (ti & 1) + r, 1);
                        const float v = sacc[ti][r] * SC; sacc[ti][r] = v;
                        mx = fmaxf(mx, __int_as_float((vm[ti][r] & __float_as_int(v)) | (~vm[ti][r] & (int)0xF149F2CAu))); }
                mx = xor32_max(xor16_max(mx));
                const float alpha = __builtin_amdgcn_exp2f(m - mx); m = mx;
                float ps = 0.f;
#pragma unroll
                for (int ti = 0; ti < 4; ++ti)
#pragma unroll
                    for (int r = 0; r < 4; ++r) { const float pv = __int_as_float(__float_as_int(__builtin_amdgcn_exp2f(sacc[ti][r] - mx)) & vm[ti][r]); sacc[ti][r] = pv; ps += pv; }
                lsum = lsum * alpha + ps;
                if (!__all(alpha == 1.f)) {
#pragma unroll
                for (int t = 0; t < 8; ++t) oacc[t] = oacc[t] * alpha; }
                bf16x8 pb[2];
#pragma unroll
                for (int a = 0; a < 2; ++a) {
                    union { uint4 u; bf16x8 v; } cv;
                    cv.u.x = cvt_pk_bf16(sacc[2 * a][0], sacc[2 * a][1]); cv.u.y = cvt_pk_bf16(sacc[2 * a][2], sacc[2 * a][3]);
                    cv.u.z = cvt_pk_bf16(sacc[2 * a + 1][0], sacc[2 * a + 1][1]); cv.u.w = cvt_pk_bf16(sacc[2 * a + 1][2], sacc[2 * a + 1][3]);
                    pb[a] = cv.v; }
#pragma unroll
                for (int tg = 0; tg < 2; ++tg) {
                    bf16x8 vfr[8];
#pragma unroll
                    for (int tt = 0; tt < 4; ++tt) { const int row = 16 * (tg * 4 + tt) + c16;
#pragma unroll
                        for (int a = 0; a < 2; ++a) {
                            union { uint2 h2[2]; bf16x8 v; } vf;
                            vf.h2[0] = *(const uint2*)(Vt + row * 128 + ((((4 * a + (q4 >> 1))) ^ (row & 7)) << 4) + 8 * (q4 & 1));
                            vf.h2[1] = *(const uint2*)(Vt + row * 128 + ((((4 * a + 2 + (q4 >> 1))) ^ (row & 7)) << 4) + 8 * (q4 & 1));
                            vfr[tt * 2 + a] = vf.v; } }
                    asm volatile("" : "+v"(vfr[0]), "+v"(vfr[1]), "+v"(vfr[2]), "+v"(vfr[3]), "+v"(vfr[4]), "+v"(vfr[5]), "+v"(vfr[6]), "+v"(vfr[7]));
#pragma unroll
                    for (int a = 0; a < 2; ++a)
#pragma unroll
                        for (int tt = 0; tt < 4; ++tt) oacc[tg * 4 + tt] = __builtin_amdgcn_mfma_f32_16x16x32_bf16(vfr[tt * 2 + a], pb[a], oacc[tg * 4 + tt], 0, 0, 0);
                }
                if (kt + 1 < nkt) ATT_LSTORE((kt + 1) & 1);
                __syncthreads();
            }
            lsum = xor32_sum(xor16_sum(lsum));
            const float inv = 1.f / lsum;
#pragma unroll
            for (int t = 0; t < 8; ++t) *(uint2*)(OB + (size_t)tq * 1024 + 512 + h * 128 + 16 * t + 4 * q4) = pack4(oacc[t] * inv);
        }
    }
}

PHASE_FN void ph_gdn_out(const Params& p, int layer) {
    KParams* pp = kparams();
    GU8* wsg_ = (GU8*)pp->ws; asm volatile("" : "+s"(wsg_)); unsigned char* ws_ = (unsigned char*)wsg_;
    int tid_ = threadIdx.x; asm volatile("" : "+v"(tid_)); const int tid = tid_, lane = tid & 63, wv = tid >> 6;
    const float* O = (const float*)(ws_ + OFF_O); const bf16_t* P = (const bf16_t*)(ws_ + OFF_P); bf16_t* OB = (bf16_t*)(ws_ + OFF_OB);
    const float* onw = as_global(pp->gdn_out_norm) + (layer >> 1) * 128;
    for (int t = blockIdx.x * 8 + wv; t < NT; t += gridDim.x * 8) {
#pragma unroll
        for (int h = 0; h < 4; ++h) {
            const float* op = O + (size_t)t * 1024 + h * 128; bf16_t* ob = OB + (size_t)t * 1024 + h * 128;
            const float o0 = op[lane], o1 = op[64 + lane];
            const float ss = wave_sum(o0 * o0 + o1 * o1);
            const float r = rsqrtf(ss * (1.f / 128.f) + EPS);
            const float z0 = PBF(P, t, 1536 + h * 128 + lane), z1 = PBF(P, t, 1536 + h * 128 + 64 + lane);
            ob[lane] = f2bf(o0 * r * onw[lane] * siluf_(z0)); ob[64 + lane] = f2bf(o1 * r * onw[64 + lane] * siluf_(z1));
        }
    }
}

struct EpiOut {
    static constexpr bool PERM = false;
    const float* Xres; float* X; const float* gt0;
    __device__ __forceinline__ void operator()(const f32x4 (&acc)[2][2][4][2], const pg8::Unit& u, int wr, int wc, int fr, int fq) const {
        const int row0 = u.pm * 256 + wr * 64 + fr, col0 = u.pn * 256 + wc * 32 + 4 * fq;
        const float* gt = gt0 + (size_t)(row0 >> 13) * 6144 + col0;
        f32x4 gv[2][2];
#pragma unroll
        for (int bj = 0; bj < 2; ++bj)
#pragma unroll
            for (int n = 0; n < 2; ++n) gv[bj][n] = *(const f32x4*)(gt + bj * 128 + n * 16);
#pragma unroll
        for (int ai = 0; ai < 2; ++ai)
#pragma unroll
            for (int m = 0; m < 4; ++m) { const size_t off = (size_t)(row0 + ai * 128 + m * 16) * ND + col0;
#pragma unroll
                for (int bj = 0; bj < 2; ++bj)
#pragma unroll
                    for (int n = 0; n < 2; ++n) *(f32x4*)(X + off + bj * 128 + n * 16) = *(const f32x4*)(Xres + off + bj * 128 + n * 16) + gv[bj][n] * acc[ai][bj][m][n]; }
    }
};

PHASE_FN void ph_gemm_out(const Params& p, int layer, float* smem) {
    KParams* pp = kparams();
    GU8* wsg_ = (GU8*)pp->ws; asm volatile("" : "+s"(wsg_)); unsigned char* ws_ = (unsigned char*)wsg_;
    int ldz_ = 0; asm volatile("" : "+s"(ldz_));
    const bf16_t* Wt = (const bf16_t*)(ws_ + OFF_WOUT) + (size_t)layer * 1024 * 1024;
    EpiOut E; E.Xres = (layer == 0) ? as_global(pp->x) : (const float*)as_global(pp->X); E.X = as_global(pp->X); E.gt0 = (const float*)(ws_ + OFF_MOD) + (size_t)(layer * 2) * 6144 + 2048;
    pg8::DenseOrder S; S.init(64, 4, gridDim.x, blockIdx.x, 1024);
    __syncthreads();
    pg8::gemm_phase<EpiOut, pg8::DenseOrder, false>((LAS unsigned char*)(g_smem + ldz_), (const bf16_t*)(ws_ + OFF_OB), Wt, 1024, S, E);
    __syncthreads();
}

PHASE_FN void ph_norm_ffn(const Params& p, int layer) {
    KParams* pp = kparams();
    GU8* wsg_ = (GU8*)pp->ws; asm volatile("" : "+s"(wsg_)); unsigned char* ws_ = (unsigned char*)wsg_;
    int tid_ = threadIdx.x; asm volatile("" : "+v"(tid_)); const int tid = tid_, lane = tid & 63, wv = tid >> 6;
    const float* MOD = (const float*)(ws_ + OFF_MOD);
    bf16_t* H = (bf16_t*)(ws_ + OFF_H);
    int* CNT = (int*)(ws_ + OFF_CNT) + layer * 32 * CSTR;
    int* sCnt = (int*)g_smem; int* sBase = sCnt + 32; int* sE = sBase + 32; int* sR = sE + 256;
    const int nrb = (NT + (int)gridDim.x - 1) / (int)gridDim.x, row_lo = blockIdx.x * nrb, row_hi = (row_lo + nrb < NT) ? row_lo + nrb : NT;
    __syncthreads();
    if (tid < 32) sCnt[tid] = 0;
    __syncthreads();
    int* ASG = (int*)(ws_ + OFF_ASG); float* GATE = (float*)(ws_ + OFF_GATE); int* LIST = (int*)(ws_ + OFF_LIST);
    const float* nw = as_global(pp->norm_ffn) + layer * 1024;
    const float* wg = as_global(pp->rg_w) + (size_t)layer * 1024 * 4;
    float4* sW = (float4*)(g_smem + 4096);
    { const float* weL = as_global(pp->re_w) + (size_t)(layer * 4) * 1024 * 8;
      for (int idx = tid; idx < 144 * 64; idx += NTHREADS) { const int slot = idx >> 6, ln = idx & 63;
          if (slot < 16) { const int col = (slot >> 2) * 256 + ln * 4 + (slot & 3); sW[idx] = *(const float4*)(wg + (size_t)col * 4); }
          else { const int s2 = slot - 16, gx = s2 >> 5, r = s2 & 31, col = (r >> 3) * 256 + ln * 4 + ((r >> 1) & 3);
                 sW[idx] = *(const float4*)(weL + ((size_t)gx * 1024 + col) * 8 + (r & 1) * 4); } } }
    __syncthreads();
    for (int row = row_lo + wv; row < row_hi; row += 8) {
        const int b = row >> 13;
        const float* xr = as_global(pp->X) + (size_t)row * ND;
        const float* sh = MOD + (size_t)(layer * 2 + b) * 6144 + 3072;
        const float* sc = sh + 1024;
        float hv[16]; float ss = 0.f;
#pragma unroll
        for (int j = 0; j < 4; ++j) { const float4 v = *(const float4*)(xr + j * 256 + lane * 4); hv[4 * j] = v.x; hv[4 * j + 1] = v.y; hv[4 * j + 2] = v.z; hv[4 * j + 3] = v.w; }
#pragma unroll
        for (int j = 0; j < 16; ++j) ss += hv[j] * hv[j];
        ss = wave_sum(ss);
        const float rstd = rsqrtf(ss * (1.f / 1024.f) + EPS);
#pragma unroll
        for (int j = 0; j < 4; ++j) {
            const int col = j * 256 + lane * 4;
            const float4 w = *(const float4*)(nw + col), s4 = *(const float4*)(sc + col), h4 = *(const float4*)(sh + col);
            hv[4 * j] = hv[4 * j] * rstd * w.x * (1.f + s4.x) + h4.x; hv[4 * j + 1] = hv[4 * j + 1] * rstd * w.y * (1.f + s4.y) + h4.y;
            hv[4 * j + 2] = hv[4 * j + 2] * rstd * w.z * (1.f + s4.z) + h4.z; hv[4 * j + 3] = hv[4 * j + 3] * rstd * w.w * (1.f + s4.w) + h4.w;
            { f32x4 ov; ov[0] = hv[4 * j]; ov[1] = hv[4 * j + 1]; ov[2] = hv[4 * j + 2]; ov[3] = hv[4 * j + 3]; *(uint2*)(H + (size_t)row * ND + col) = pack4(ov); }
        }
        float gl[4] = {0.f, 0.f, 0.f, 0.f};
#pragma unroll
        for (int j = 0; j < 4; ++j)
#pragma unroll
            for (int e = 0; e < 4; ++e) { const float4 w = sW[(j * 4 + e) * 64 + lane]; const float hh = hv[4 * j + e];
                gl[0] += hh * w.x; gl[1] += hh * w.y; gl[2] += hh * w.z; gl[3] += hh * w.w; }
#pragma unroll
        for (int g = 0; g < 4; ++g) gl[g] = wave_sum(gl[g]) + as_global(pp->rg_b)[layer * 4 + g];
        int gs = 0; float gm = gl[0];
#pragma unroll
        for (int g = 1; g < 4; ++g) if (gl[g] > gm) { gm = gl[g]; gs = g; }
        float gsum = 0.f;
#pragma unroll
        for (int g = 0; g < 4; ++g) gsum += expf(gl[g] - gm);
        const float ggate = 1.f / gsum;
        const float4* we4 = sW + (16 + gs * 32) * 64 + lane;
        float el[8] = {0.f, 0.f, 0.f, 0.f, 0.f, 0.f, 0.f, 0.f};
#pragma unroll
        for (int j = 0; j < 4; ++j)
#pragma unroll
            for (int e = 0; e < 4; ++e) { const float4 w0 = we4[((j * 4 + e) * 2) * 64], w1 = we4[((j * 4 + e) * 2 + 1) * 64]; const float hh = hv[4 * j + e];
                el[0] += hh * w0.x; el[1] += hh * w0.y; el[2] += hh * w0.z; el[3] += hh * w0.w; el[4] += hh * w1.x; el[5] += hh * w1.y; el[6] += hh * w1.z; el[7] += hh * w1.w; }
#pragma unroll
        for (int e = 0; e < 8; ++e) el[e] = wave_sum(el[e]) + as_global(pp->re_b)[(layer * 4 + gs) * 8 + e];
        int i1 = 0; float l1 = el[0];
#pragma unroll
        for (int e = 1; e < 8; ++e) if (el[e] > l1) { l1 = el[e]; i1 = e; }
        int i2 = -1; float l2 = -INFINITY;
#pragma unroll
        for (int e = 0; e < 8; ++e) if (e != i1 && el[e] > l2) { l2 = el[e]; i2 = e; }
        const float ex = expf(l2 - l1);
        const float p1 = 1.f / (1.f + ex), p2 = ex / (1.f + ex);
        if (lane == 0) {
            const int e1 = gs * 8 + i1, e2 = gs * 8 + i2, lr = row - row_lo;
            sE[lr * 2] = e1; sE[lr * 2 + 1] = e2;
            sR[lr * 2] = atomicAdd(&sCnt[e1], 1); sR[lr * 2 + 1] = atomicAdd(&sCnt[e2], 1);
            GATE[row * 2] = ggate * p1; GATE[row * 2 + 1] = ggate * p2;
        }
    }
    __syncthreads();
    if (tid < 32) sBase[tid] = (sCnt[tid] > 0) ? atomicAdd(&CNT[tid * CSTR], sCnt[tid]) : 0;
    __syncthreads();
    for (int a = tid; a < (row_hi - row_lo) * 2; a += NTHREADS) {
        const int row = row_lo + (a >> 1), e = sE[a], r = sBase[e] + sR[a];
        LIST[(size_t)e * LISTCAP + r] = row;
        ASG[row * 4 + (a & 1) * 2] = e; ASG[row * 4 + (a & 1) * 2 + 1] = r;
    }
}

struct MoeOrder {
    const int* sTs; const int* sPad; const int* CNT; const int* LIST; int G, c, which, K;
    __device__ __forceinline__ bool next(int i, pg8::Unit& u) const {
        const long L = (long)i * G + c; if (L >= (long)__builtin_amdgcn_readfirstlane(sTs[32]) * 4) return false;
        const int mt = (int)(L >> 2), nt = (int)(L & 3);
        int e = 0;
        for (int q = 1; q < 32; ++q) if (__builtin_amdgcn_readfirstlane(sTs[q]) <= mt) e = q;
        const int mi = mt - __builtin_amdgcn_readfirstlane(sTs[e]), cnt = __builtin_amdgcn_readfirstlane(CNT[e * CSTR]);
        u.pm = mt; u.pn = nt; u.e = e; u.mi = mi; u.mvalid = (cnt - mi * 256 < 256) ? (cnt - mi * 256) : 256; u.rowbase = __builtin_amdgcn_readfirstlane(sPad[e]) + mi * 256;
        u.boff = ((size_t)e * 1024 + nt * 256) * K * 2;
        u.aoff = which ? (size_t)u.rowbase * 512 * 2 : 0;
        return true;
    }
    __device__ __forceinline__ int row(const pg8::Unit& u, int r) const { const int rr = (r < u.mvalid) ? r : 0; return LIST[(size_t)u.e * LISTCAP + u.mi * 256 + rr]; }
};
struct EpiMoe1 {
    static constexpr bool PERM = false;
    bf16_t* HID;
    __device__ __forceinline__ void operator()(const f32x4 (&acc)[2][2][4][2], const pg8::Unit& u, int wr, int wc, int fr, int fq) const {
#pragma unroll
        for (int ai = 0; ai < 2; ++ai)
#pragma unroll
            for (int m = 0; m < 4; ++m) { const int rl = ai * 128 + wr * 64 + m * 16 + fr;
                if (rl < u.mvalid) {
#pragma unroll
                    for (int bj = 0; bj < 2; ++bj) { const f32x4 a1 = acc[ai][bj][m][0], a3 = acc[ai][bj][m][1]; f32x4 hv;
                        hv[0] = silu_fast(a1[0]) * a3[0]; hv[1] = silu_fast(a1[1]) * a3[1]; hv[2] = silu_fast(a1[2]) * a3[2]; hv[3] = silu_fast(a1[3]) * a3[3];
                        *(uint2*)(HID + (size_t)(u.rowbase + rl) * 512 + u.pn * 128 + bj * 64 + wc * 16 + 4 * fq) = pack4(hv); } } }
    }
};
struct EpiMoe2 {
    static constexpr bool PERM = true;
    bf16_t* YB;
    __device__ __forceinline__ void operator()(const f32x4 (&acc)[2][2][4][2], const pg8::Unit& u, int wr, int wc, int fr, int fq) const {
#pragma unroll
        for (int ai = 0; ai < 2; ++ai)
#pragma unroll
            for (int m = 0; m < 4; ++m) { const int rl = ai * 128 + wr * 64 + m * 16 + fr;
                if (rl < u.mvalid) {
#pragma unroll
                    for (int bj = 0; bj < 2; ++bj) { const uint2 lo = pack4(acc[ai][bj][m][0]), hi = pack4(acc[ai][bj][m][1]);
                        *(uint4*)(YB + (size_t)(u.rowbase + rl) * 1024 + u.pn * 256 + bj * 128 + wc * 32 + 8 * fq) = make_uint4(lo.x, lo.y, hi.x, hi.y); } } }
    }
};

PHASE_FN void ph_moe(const Params& p, int layer, int which, float* smem) {
    KParams* pp = kparams();
    GU8* wsg_ = (GU8*)pp->ws; asm volatile("" : "+s"(wsg_)); unsigned char* ws_ = (unsigned char*)wsg_;
    int ldz_ = 0; asm volatile("" : "+s"(ldz_));
    int tid_ = threadIdx.x; asm volatile("" : "+v"(tid_)); const int tid = tid_;
    int* sPad = (int*)(g_smem + ldz_ + 131072); int* sTs = sPad + 40;
    const int* CNT = (const int*)(ws_ + OFF_CNT) + layer * 32 * CSTR;
    __syncthreads();
    if (tid == 0) { int a = 0, ts = 0; for (int e = 0; e < 32; ++e) { sPad[e] = a; sTs[e] = ts; a += ((CNT[e * CSTR] + 127) / 128) * 128; ts += (CNT[e * CSTR] + 255) / 256; } sTs[32] = ts; sPad[32] = a; }
    __syncthreads();
    MoeOrder S; S.sTs = sTs; S.sPad = sPad; S.CNT = CNT; S.LIST = (const int*)(ws_ + OFF_LIST); S.G = gridDim.x; S.which = which; S.K = which ? 512 : 1024;
    S.c = (((int)gridDim.x & 7) == 0) ? (((int)blockIdx.x & 7) * ((int)gridDim.x >> 3) + ((int)blockIdx.x >> 3)) : (int)blockIdx.x;
    if (which == 0) {
        EpiMoe1 E; E.HID = (bf16_t*)(ws_ + OFF_HID);
        pg8::gemm_phase<EpiMoe1, MoeOrder, true>((LAS unsigned char*)(g_smem + ldz_), (const bf16_t*)(ws_ + OFF_H), (const bf16_t*)(ws_ + OFF_W13), 1024, S, E);
    } else {
        EpiMoe2 E; E.YB = (bf16_t*)(ws_ + OFF_YB);
        pg8::gemm_phase<EpiMoe2, MoeOrder, false>((LAS unsigned char*)(g_smem + ldz_), (const bf16_t*)(ws_ + OFF_HID), (const bf16_t*)(ws_ + OFF_W2T), 512, S, E);
    }
    __syncthreads();
}

PHASE_FN void ph_conv_dense(const Params& p, float* smem) {
    KParams* pp = kparams();
    GU8* wsg_ = (GU8*)pp->ws; asm volatile("" : "+s"(wsg_)); unsigned char* ws_ = (unsigned char*)wsg_;
    { int ldz_ = 0; asm volatile("" : "+s"(ldz_)); smem = (float*)(g_smem + ldz_); }
    auto dec = [&](int t, const float*& s0, const float*& s1, bf16_t*& dst, int& mode, int& K, int& N, int& ld, int& rt, int& kt) {
        s1 = nullptr; mode = 0; K = 1024;
        if (t >= 4672) t = 4671;
        if (t >= 4608) { const int v = t - 4608, l = v >> 5, u = v & 31; s0 = as_global(pp->gla_w_in) + (size_t)l * 1024 * 3088 + 3072; N = 16; ld = 3088; dst = (bf16_t*)(ws_ + OFF_WGL) + (size_t)l * 128 * 1024; rt = u >> 4; kt = u & 15; }
        else if (t < 2048) { const int l = t >> 10, u = t & 1023; s0 = as_global(pp->even_w_in) + (size_t)l * 1024 * 3916; N = 3916; ld = 3916; dst = (bf16_t*)(ws_ + OFF_WINE) + (size_t)l * 4096 * 1024; rt = u >> 4; kt = u & 15; }
        else if (t < 3584) { const int v = t - 2048, l = v / 768, u = v % 768; s0 = as_global(pp->gla_w_in) + (size_t)l * 1024 * 3088; N = 3072; ld = 3088; dst = (bf16_t*)(ws_ + OFF_WINO) + (size_t)l * 3072 * 1024; rt = u >> 4; kt = u & 15; }
        else { const int v = t - 3584, l = v >> 8, u = v & 255; s0 = ((l & 1) ? as_global(pp->gla_w_out) : as_global(pp->even_w_out)) + (size_t)(l >> 1) * 1024 * 1024; N = 1024; ld = 1024; dst = (bf16_t*)(ws_ + OFF_WOUT) + (size_t)l * 1024 * 1024; rt = u >> 4; kt = u & 15; }
    };
    convert_stream(dec, blockIdx.x * 4, gridDim.x * 4, 4672, smem);
}

PHASE_FN void ph_conv_exp(const Params& p, int layer, float* smem, int first_blk) {
    KParams* pp = kparams();
    GU8* wsg_ = (GU8*)pp->ws; asm volatile("" : "+s"(wsg_)); unsigned char* ws_ = (unsigned char*)wsg_;
    { int ldz_ = 0; asm volatile("" : "+s"(ldz_)); smem = (float*)(g_smem + ldz_); }
    if ((int)blockIdx.x < first_blk) return;
    auto dec = [&](int t, const float*& s0, const float*& s1, bf16_t*& dst, int& mode, int& K, int& N, int& ld, int& rt, int& kt) {
        if (t >= 12288) t = 12287;
        if (t < 8192) { const int e = t >> 8, u = t & 255; s0 = as_global(pp->w1) + (size_t)(layer * 32 + e) * 1024 * 512; s1 = as_global(pp->w3) + (size_t)(layer * 32 + e) * 1024 * 512; mode = 1; K = 1024; N = 512; ld = 512;
            dst = (bf16_t*)(ws_ + OFF_W13) + (size_t)e * 1024 * 1024; rt = u >> 4; kt = u & 15; }
        else { const int v = t - 8192, e = v >> 7, u = v & 127; s0 = as_global(pp->w2) + (size_t)(layer * 32 + e) * 512 * 1024; s1 = nullptr; mode = 0; K = 512; N = 1024; ld = 1024;
            dst = (bf16_t*)(ws_ + OFF_W2T) + (size_t)e * 1024 * 512; rt = u >> 3; kt = u & 7; }
    };
    convert_stream(dec, ((int)blockIdx.x - first_blk) * 4, ((int)gridDim.x - first_blk) * 4, 12288, smem);
}

PHASE_FN void ph_gla_tok(const Params& p, int layer) {
    KParams* pp = kparams();
    GU8* wsg_ = (GU8*)pp->ws; asm volatile("" : "+s"(wsg_)); unsigned char* ws_ = (unsigned char*)wsg_;
    int tid_ = threadIdx.x; asm volatile("" : "+v"(tid_)); const int tid = tid_, lane = tid & 63, wv = tid >> 6, li = layer >> 1;
    const float* AUX = (const float*)(ws_ + OFF_AUX);
    float* LA = (float*)(ws_ + OFF_LA);
    const float* w2 = as_global(pp->gla_w_gate2) + (size_t)li * 16 * 512; const float* b2 = as_global(pp->gla_b_gate2) + li * 512;
    for (int t = blockIdx.x * 8 + wv; t < NT; t += gridDim.x * 8) {
        float glr[16];
#pragma unroll
        for (int r = 0; r < 16; ++r) glr[r] = AUX[(size_t)t * 16 + r];
#pragma unroll 1
        for (int i = 0; i < 8; ++i) {
            const int c = lane + 64 * i; float z = b2[c];
#pragma unroll
            for (int r = 0; r < 16; ++r) z += glr[r] * w2[r * 512 + c];
            LA[(size_t)t * 512 + c] = -softplusf_(-z) * (1.f / 16.f);
        }
    }
}

PHASE_FN void ph_gla_chunk(const Params& p, int layer, float* smem) {
    KParams* pp = kparams();
    GU8* wsg_ = (GU8*)pp->ws; asm volatile("" : "+s"(wsg_)); unsigned char* ws_ = (unsigned char*)wsg_;
    int tid_ = threadIdx.x; asm volatile("" : "+v"(tid_)); const int tid = tid_, lane = tid & 63, wv = __builtin_amdgcn_readfirstlane(tid >> 6), q4 = lane >> 4, c16 = lane & 15;
    int ldz_ = 0; asm volatile("" : "+s"(ldz_)); unsigned char* lds = g_smem + ldz_;
    constexpr int SN = 272, ST = 144;
    float* sBc = (float*)lds;
    unsigned char* bQE = lds + 33024;
    unsigned char* bKE = lds + 50432;
    unsigned char* bKD = lds + 67840;
    unsigned char* bVT = lds + 86272;
    unsigned char* bATT = lds + 123136;
    const bf16_t* P = (const bf16_t*)(ws_ + OFF_P); const float* AUX = (const float*)(ws_ + OFF_AUX);
    const float* w2 = as_global(pp->gla_w_gate2) + (size_t)(layer >> 1) * 16 * 512; const float* b2 = as_global(pp->gla_b_gate2) + (layer >> 1) * 512;
    float* sGlr = (float*)(lds + 132352);
    uint4* QEF = (uint4*)(ws_ + OFF_GQE); uint2* OIF = (uint2*)(ws_ + OFF_GOI); uint2* HF = (uint2*)(ws_ + OFF_GH); float* EBL = (float*)(ws_ + OFF_GEBL);
    for (int ci = blockIdx.x; ci < 1024; ci += gridDim.x) {
        const int b = ci >> 9, h = (ci >> 7) & 3, n = ci & 127;
        const int t0 = b * 8192 + n * 64;
        __syncthreads();
        for (int e = tid; e < 1024; e += NTHREADS) sGlr[e] = AUX[(size_t)(t0 + (e >> 4)) * 16 + (e & 15)];
        __syncthreads();
        {
            const int d = tid & 127, c = h * 128 + d;
            float wg[16];
#pragma unroll
            for (int r = 0; r < 16; ++r) wg[r] = w2[r * 512 + c];
            const float bz = b2[c];
            for (int i = tid >> 7; i < 64; i += 4) {
                float z = bz;
#pragma unroll
                for (int r = 0; r < 16; ++r) z += sGlr[i * 16 + r] * wg[r];
                sBc[i * 129 + d] = -softplusf_(-z) * (1.f / 16.f);
            }
        }
        for (int e = tid; e < 64 * 36; e += NTHREADS) ((unsigned*)bATT)[e] = 0u;
        __syncthreads();
        if (tid < 128) { float a = 0.f; for (int i = 0; i < 64; ++i) { a += sBc[i * 129 + tid]; sBc[i * 129 + tid] = a; } }
        __syncthreads();
        {
            const int d = tid & 127, ig = tid >> 7;
            const float bl = sBc[63 * 129 + d];
#pragma unroll
            for (int gg = 0; gg < 2; ++gg) { const int g = ig + 4 * gg;
                float kd8[8];
#pragma unroll
                for (int r = 0; r < 8; ++r) { const int i = g * 8 + r;
                    const float bb = sBc[i * 129 + d];
                    const float qf = PBF(P, t0 + i, h * 128 + d), kf = PBF(P, t0 + i, 512 + h * 128 + d);
                    *(bf16_t*)(bQE + i * SN + d * 2) = f2bf(qf * SCALE128 * expf(bb));
                    *(bf16_t*)(bKE + i * SN + d * 2) = f2bf(kf * expf(-bb));
                    kd8[r] = kf * expf(bl - bb); }
                *(uint4*)(bKD + d * ST + g * 16) = make_uint4(cvt_pk_bf16(kd8[0], kd8[1]), cvt_pk_bf16(kd8[2], kd8[3]), cvt_pk_bf16(kd8[4], kd8[5]), cvt_pk_bf16(kd8[6], kd8[7]));
            }
            const int dv = tid & 255, hf = tid >> 8;
#pragma unroll
            for (int gg = 0; gg < 4; ++gg) { const int g = hf * 4 + gg;
                unsigned short v8[8];
#pragma unroll
                for (int r = 0; r < 8; ++r) v8[r] = P[(size_t)(t0 + g * 8 + r) * LDPB + 1024 + h * 256 + dv];
                *(uint4*)(bVT + dv * ST + g * 16) = make_uint4((unsigned)v8[0] | ((unsigned)v8[1] << 16), (unsigned)v8[2] | ((unsigned)v8[3] << 16), (unsigned)v8[4] | ((unsigned)v8[5] << 16), (unsigned)v8[6] | ((unsigned)v8[7] << 16));
            }
        }
        if (tid < 128) EBL[ci * 128 + tid] = expf(sBc[63 * 129 + tid]);
        __syncthreads();
        for (int u = wv; u < 10; u += 8) {
            const int ti = (u >= 6) ? 3 : (u >= 3) ? 2 : (u >= 1) ? 1 : 0, tj = u - ((ti * (ti + 1)) >> 1);
            f32x4 acc = (f32x4){0.f, 0.f, 0.f, 0.f};
            acc = mma_lds(bQE, SN, 16 * ti, bKE, SN, 16 * tj, 128, acc, c16, q4);
            const int j = 16 * tj + c16;
#pragma unroll
            for (int r = 0; r < 4; ++r) { const int i = 16 * ti + 4 * q4 + r; *(bf16_t*)(bATT + i * ST + j * 2) = f2bf((j <= i) ? acc[r] : 0.f); }
        }
        for (int x = 0; x < 2; ++x) {
            const int u = wv * 2 + x, ti = u >> 2, a = u & 3;
            const unsigned char* rp = bQE + (16 * ti + c16) * SN;
            const uint2 lo = *(const uint2*)(rp + (32 * a + 4 * q4) * 2), hi = *(const uint2*)(rp + (32 * a + 16 + 4 * q4) * 2);
            QEF[((size_t)(ci * 4 + ti) * 4 + a) * 64 + lane] = make_uint4(lo.x, lo.y, hi.x, hi.y);
        }
        __syncthreads();
#pragma unroll 4
        for (int x = 0; x < 8; ++x) {
            const int u = wv * 8 + x, tdv = u >> 2, ti = u & 3;
            f32x4 acc = (f32x4){0.f, 0.f, 0.f, 0.f};
            acc = mma_lds(bATT, ST, 16 * ti, bVT, ST, 16 * tdv, 64, acc, c16, q4);
            OIF[((size_t)(ci * 16 + tdv) * 4 + ti) * 64 + lane] = pack4(acc);
        }
#pragma unroll 4
        for (int x = 0; x < 16; ++x) {
            const int u = wv * 16 + x, tdv = u >> 3, tdk = u & 7;
            f32x4 acc = (f32x4){0.f, 0.f, 0.f, 0.f};
            acc = mma_lds(bKD, ST, 16 * tdk, bVT, ST, 16 * tdv, 64, acc, c16, q4);
            HF[((size_t)(ci * 16 + tdv) * 8 + tdk) * 64 + lane] = pack4(acc);
        }
    }
}

PHASE_FN void ph_gla_scan(const Params& p, float* smem) {
    KParams* pp = kparams();
    GU8* wsg_ = (GU8*)pp->ws; asm volatile("" : "+s"(wsg_)); unsigned char* ws_ = (unsigned char*)wsg_;
    int tid_ = threadIdx.x; asm volatile("" : "+v"(tid_)); const int tid = tid_, lane = tid & 63, wv = __builtin_amdgcn_readfirstlane(tid >> 6), q4 = lane >> 4, c16 = lane & 15;
    int ldz_ = 0; asm volatile("" : "+s"(ldz_)); unsigned char* lds = g_smem + ldz_;
    constexpr int STG = 29184;
    const unsigned char* QEF = ws_ + OFF_GQE; const unsigned char* HF = ws_ + OFF_GH; const unsigned char* OIF = ws_ + OFF_GOI; const unsigned char* EBL = ws_ + OFF_GEBL;
    float* O = (float*)(ws_ + OFF_O);
    for (int it = blockIdx.x; it < 64; it += gridDim.x) {
        const int bh = it >> 3, pair = it & 7, b = bh >> 2, h = bh & 3;
        __syncthreads();
        if (wv >= 2) {
            const int lt = tid - 128;
            const unsigned char* Qb = QEF + (size_t)bh * 128 * 16384;
            const unsigned char* Hb = HF + (size_t)bh * 128 * 65536 + pair * 8192;
            const unsigned char* Ob = OIF + (size_t)bh * 128 * 32768 + pair * 4096;
            const unsigned char* Lb = EBL + (size_t)bh * 128 * 512;
            uint4 ra0, ra1, ra2, ra3, ra4, ra5, ra6, rb0, rb1, rb2, rb3, rb4, rb5, rb6, rc0, rc1, rc2, rc3, rc4, rc5, rc6, rd0, rd1, rd2, rd3, rd4, rd5, rd6;
#define GL_LOAD(X, n_) do { const unsigned char* q_ = Qb + (size_t)(n_) * 16384; const unsigned char* h_ = Hb + (size_t)(n_) * 65536; \
                const unsigned char* o_ = Ob + (size_t)(n_) * 32768; const unsigned char* l_ = Lb + (size_t)(n_) * 512; \
                X##0 = LDC(q_, lt, 1023); X##1 = LDC(q_, lt + 384, 1023); X##2 = LDC(q_, lt + 768, 1023); \
                X##3 = LDC(h_, lt, 511); X##4 = LDC(h_, lt + 384, 511); X##5 = LDC(o_, lt, 255); X##6 = LDC(l_, lt, 31); } while (0)
#define GL_STORE(X, st_) do { unsigned char* sb_ = lds + (st_) * STG; \
                STC(0, lt, 1024, X##0); STC(0, lt + 384, 1024, X##1); STC(0, lt + 768, 1024, X##2); \
                STC(16384, lt, 512, X##3); STC(16384, lt + 384, 512, X##4); STC(24576, lt, 256, X##5); STC(28672, lt, 32, X##6); } while (0)
            GL_LOAD(ra, 0); GL_STORE(ra, 0);
            GL_LOAD(rb, 1); GL_LOAD(rc, 2); GL_LOAD(rd, 3); GL_LOAD(ra, 4);
            __syncthreads();
            for (int n = 0; n < 128; n += 4) {
                GL_STORE(rb, 1); GL_LOAD(rb, CLAMPN(n + 5)); LBAR();
                GL_STORE(rc, 0); GL_LOAD(rc, CLAMPN(n + 6)); LBAR();
                GL_STORE(rd, 1); GL_LOAD(rd, CLAMPN(n + 7)); LBAR();
                if (n + 4 < 128) GL_STORE(ra, 0);
                GL_LOAD(ra, CLAMPN(n + 8)); LBAR();
            }
        } else {
            const int tdv = pair * 2 + wv;
            f32x4 S[8];
#pragma unroll
            for (int t = 0; t < 8; ++t) S[t] = (f32x4){0.f, 0.f, 0.f, 0.f};
            __syncthreads();
            for (int n = 0; n < 128; ++n) {
                const unsigned char* base = lds + (n & 1) * STG;
                const unsigned char* Qf = base + lane * 16, *Hf = base + 16384 + wv * 4096 + lane * 8, *Of = base + 24576 + wv * 2048 + lane * 8, *Lf = base + 28672 + q4 * 16;
                bf16x8 Sb[4];
#pragma unroll
                for (int a = 0; a < 4; ++a) { union { uint4 u; bf16x8 v; } cv; const uint2 lo = pack4(S[2 * a]), hi = pack4(S[2 * a + 1]); cv.u.x = lo.x; cv.u.y = lo.y; cv.u.z = hi.x; cv.u.w = hi.y; Sb[a] = cv.v; }
                const int t0 = b * 8192 + n * 64;
                f32x4 oa[4];
                uint2 o4[4];
#pragma unroll
                for (int ti = 0; ti < 4; ++ti) o4[ti] = *(const uint2*)(Of + ti * 512);
#pragma unroll
                for (int hf = 0; hf < 2; ++hf) {
                    bf16x8 qf[8];
#pragma unroll
                    for (int tt = 0; tt < 2; ++tt)
#pragma unroll
                        for (int a = 0; a < 4; ++a) qf[tt * 4 + a] = *(const bf16x8*)(Qf + ((hf * 2 + tt) * 4 + a) * 1024);
                    asm volatile("" : "+v"(qf[0]), "+v"(qf[1]), "+v"(qf[2]), "+v"(qf[3]), "+v"(qf[4]), "+v"(qf[5]), "+v"(qf[6]), "+v"(qf[7]));
                    oa[hf * 2] = unpack4(o4[hf * 2]); oa[hf * 2 + 1] = unpack4(o4[hf * 2 + 1]);
#pragma unroll
                    for (int a = 0; a < 4; ++a)
#pragma unroll
                        for (int tt = 0; tt < 2; ++tt) oa[hf * 2 + tt] = __builtin_amdgcn_mfma_f32_16x16x32_bf16(qf[tt * 4 + a], Sb[a], oa[hf * 2 + tt], 0, 0, 0);
                }
                {
                    f32x4 lam[8]; uint2 h8[8];
#pragma unroll
                    for (int t = 0; t < 8; ++t) { lam[t] = *(const f32x4*)(Lf + t * 64); h8[t] = *(const uint2*)(Hf + t * 512); }
                    asm volatile("" : "+v"(lam[0]), "+v"(lam[1]), "+v"(lam[2]), "+v"(lam[3]), "+v"(lam[4]), "+v"(lam[5]), "+v"(lam[6]), "+v"(lam[7]));
#pragma unroll
                    for (int ti = 0; ti < 4; ++ti) {
                        float* op = O + (size_t)(t0 + 16 * ti + 4 * q4) * 1024 + h * 256 + 16 * tdv + c16;
                        op[0] = oa[ti][0]; op[1024] = oa[ti][1]; op[2048] = oa[ti][2]; op[3072] = oa[ti][3]; }
#pragma unroll
                    for (int t = 0; t < 8; ++t) S[t] = S[t] * lam[t] + unpack4(h8[t]);
                }
                LBAR();
            }
        }
    }
}

PHASE_FN void ph_gla_out(const Params& p, int layer) {
    KParams* pp = kparams();
    GU8* wsg_ = (GU8*)pp->ws; asm volatile("" : "+s"(wsg_)); unsigned char* ws_ = (unsigned char*)wsg_;
    int tid_ = threadIdx.x; asm volatile("" : "+v"(tid_)); const int tid = tid_, lane = tid & 63, wv = tid >> 6;
    const float* O = (const float*)(ws_ + OFF_O); const bf16_t* P = (const bf16_t*)(ws_ + OFF_P); bf16_t* OB = (bf16_t*)(ws_ + OFF_OB);
    const float* onw = as_global(pp->gla_out_norm) + (layer >> 1) * 256;
    for (int t = blockIdx.x * 8 + wv; t < NT; t += gridDim.x * 8) {
#pragma unroll
        for (int h = 0; h < 4; ++h) {
            const float* op = O + (size_t)t * 1024 + h * 256;
            const float4 o = *(const float4*)(op + lane * 4);
            const float ss = wave_sum(o.x * o.x + o.y * o.y + o.z * o.z + o.w * o.w);
            const float r = rsqrtf(ss * (1.f / 256.f) + EPS);
            const f32x4 z = unpack4(*(const uint2*)(P + (size_t)t * LDPB + 2048 + h * 256 + lane * 4));
            const float4 w = *(const float4*)(onw + lane * 4);
            f32x4 ov; ov[0] = o.x * r * w.x * siluf_(z[0]); ov[1] = o.y * r * w.y * siluf_(z[1]); ov[2] = o.z * r * w.z * siluf_(z[2]); ov[3] = o.w * r * w.w * siluf_(z[3]);
            *(uint2*)(OB + (size_t)t * 1024 + h * 256 + lane * 4) = pack4(ov);
        }
    }
}

template <int PH>
__device__ __forceinline__ void run_phase(const Params& p, int layer, float* smem) {
    if (PH == PH_PROLOGUE) { ph_prologue(p, smem); ph_conv_dense(p, smem); }
    else if (PH == PH_NORM_MIX) ph_rows(p, layer, 0, smem);
    else if (PH == PH_GEMM_IN_EVEN) ph_gemm_in(p, layer, true, smem);
    else if (PH == PH_EVEN_TOK) { ph_even_tok(p, layer, smem); ph_gdn_chunk(p, layer, smem); if (DUP_MASK & 8192) ph_gdn_chunk(p, layer, smem); if (DUP_MASK & 16384) ph_even_tok(p, layer, smem); }
    else if (PH == PH_GDN_CHUNK) ph_gdn_chunk(p, layer, smem);
    else if (PH == PH_GDN_SCAN) { ph_gdn_scan(p, smem); ph_conv_exp(p, layer, smem, 32); ph_dsa_topk(p, layer, smem); }
    else if (PH == PH_DSA_TOPK) ph_dsa_topk(p, layer, smem);
    else if (PH == PH_DSA_ATTN) { ph_dsa_attn(p, smem); ph_gdn_out(p, layer); if (DUP_MASK & 32768) ph_dsa_attn(p, smem); }
    else if (PH == PH_GDN_OUT) ph_gdn_out(p, layer);
    else if (PH == PH_GEMM_OUT) ph_gemm_out(p, layer, smem);
    else if (PH == PH_NORM_FFN) ph_norm_ffn(p, layer);
    else if (PH == PH_MOE1) ph_moe(p, layer, 0, smem);
    else if (PH == PH_MOE2) ph_moe(p, layer, 1, smem);
    else if (PH == PH_GEMM_IN_ODD) ph_gemm_in(p, layer, false, smem);
    else if (PH == PH_GLA_TOK) ph_gla_tok(p, layer);
    else if (PH == PH_GLA_CHUNK) ph_gla_chunk(p, layer, smem);
    else if (PH == PH_GLA_SCAN) { ph_gla_scan(p, smem); ph_conv_exp(p, layer, smem, 64); if (DUP_MASK & 65536) ph_gla_scan(p, smem); if (DUP_MASK & 131072) ph_conv_exp(p, layer, smem, 64); }
    else if (PH == PH_GLA_OUT) ph_gla_out(p, layer);
    else if (PH == PH_FINAL) ph_rows(p, 0, 1, smem);
}

#if MK_MULTI
template <int PH>
__global__ void __launch_bounds__(NTHREADS, 2) k_phase(Params p, int layer) {
    run_phase<PH>(p, layer, (float*)g_smem);
}
#else
__global__ void __launch_bounds__(NTHREADS, 2) k_mega(Params p) {
    float* smem = (float*)g_smem;
    volatile LAS unsigned* xbw = (volatile LAS unsigned*)(LAS unsigned char*)(g_smem + LDS_BYTES - 16);
    if (threadIdx.x == 0) { xbw[0] = 0u; xbw[1] = 0u; xbw[2] = 0u; xbw[3] = 0u; }
    __syncthreads();
    XcdBarrier bar = xcd_barrier_post((unsigned*)(p.ws + OFF_BAR), xbw);
#define BAR() do { XcdBarrier bb_ = bar; asm volatile("" : "+s"(bb_.x)); { __attribute__((address_space(1))) unsigned* gb_ = (__attribute__((address_space(1))) unsigned*)bb_.bar; asm volatile("" : "+s"(gb_)); bb_.bar = (unsigned*)gb_; } xcd_barrier(bb_); } while (0)
    run_phase<PH_PROLOGUE>(p, 0, smem); BAR(); if (DUP_MASK & 4096) { run_phase<PH_PROLOGUE>(p, 0, smem); BAR(); }
    for (int lp = 0; lp < 2; ++lp) {
        const int le = 2 * lp, lo = 2 * lp + 1;
        run_phase<PH_NORM_MIX>(p, le, smem); BAR();
        run_phase<PH_GEMM_IN_EVEN>(p, le, smem); BAR(); if (DUP_MASK & 1) { run_phase<PH_GEMM_IN_EVEN>(p, le, smem); BAR(); }
        run_phase<PH_EVEN_TOK>(p, le, smem); BAR(); if (DUP_MASK & 2) { run_phase<PH_EVEN_TOK>(p, le, smem); BAR(); }
        run_phase<PH_GDN_SCAN>(p, le, smem); BAR(); if (DUP_MASK & 8) { run_phase<PH_GDN_SCAN>(p, le, smem); BAR(); } if (DUP_MASK & 262144) { run_phase<PH_DSA_TOPK>(p, le + 1, smem); BAR(); }
        run_phase<PH_DSA_ATTN>(p, le, smem); BAR(); if (DUP_MASK & 32) { run_phase<PH_DSA_ATTN>(p, le, smem); BAR(); }
        run_phase<PH_GEMM_OUT>(p, le, smem); BAR();
        run_phase<PH_NORM_FFN>(p, le, smem); BAR();
        run_phase<PH_MOE1>(p, le, smem); BAR(); if (DUP_MASK & 64) { run_phase<PH_MOE1>(p, le, smem); BAR(); }
        run_phase<PH_MOE2>(p, le, smem); BAR(); if (DUP_MASK & 128) { run_phase<PH_MOE2>(p, le, smem); BAR(); }
        run_phase<PH_NORM_MIX>(p, lo, smem); BAR();
        run_phase<PH_GEMM_IN_ODD>(p, lo, smem); BAR(); if (DUP_MASK & 256) { run_phase<PH_GEMM_IN_ODD>(p, lo, smem); BAR(); }
        run_phase<PH_GLA_CHUNK>(p, lo, smem); BAR(); if (DUP_MASK & 1024) { run_phase<PH_GLA_CHUNK>(p, lo, smem); BAR(); }
        run_phase<PH_GLA_SCAN>(p, lo, smem); BAR(); if (DUP_MASK & 2048) { run_phase<PH_GLA_SCAN>(p, lo, smem); BAR(); }
        run_phase<PH_GLA_OUT>(p, lo, smem); BAR();
        run_phase<PH_GEMM_OUT>(p, lo, smem); BAR();
        run_phase<PH_NORM_FFN>(p, lo, smem); BAR();
        run_phase<PH_MOE1>(p, lo, smem); BAR(); if (DUP_MASK & 64) { run_phase<PH_MOE1>(p, lo, smem); BAR(); }
        run_phase<PH_MOE2>(p, lo, smem); BAR(); if (DUP_MASK & 128) { run_phase<PH_MOE2>(p, lo, smem); BAR(); }
    }
    for (int xb = 0; xb < EXTRA_BARS; ++xb) BAR();
    run_phase<PH_FINAL>(p, 0, smem);
}
#endif

}

#if MK_MULTI
template <int PH>
static void launch_phase(const Params& p, int layer, hipStream_t stream) {
    static bool attr_set = false;
    if (!attr_set) { hipFuncSetAttribute((const void*)k_phase<PH>, hipFuncAttributeMaxDynamicSharedMemorySize, (int)LDS_BYTES); attr_set = true; }
    hipLaunchKernelGGL((k_phase<PH>), dim3(256), dim3(NTHREADS), LDS_BYTES, stream, p, layer);
}
#endif

extern "C" void kernel_launch(void* const* d_in, const int* in_sizes, int n_in, void* d_out, int out_size, void* d_ws, size_t ws_size, hipStream_t stream) {
    (void)in_sizes; (void)n_in; (void)out_size;
    if (ws_size < WS_NEEDED) { fprintf(stderr, "workspace too small: %zu < %zu\n", ws_size, (size_t)WS_NEEDED); return; }
    Params p{};
    p.x = (const float*)d_in[0]; p.c = (const float*)d_in[1]; p.pos = (const int*)d_in[2]; p.ada_w = (const float*)d_in[3]; p.ada_b = (const float*)d_in[4];
    p.norm_mix = (const float*)d_in[5]; p.norm_ffn = (const float*)d_in[6]; p.even_w_in = (const float*)d_in[7]; p.conv_w = (const float*)d_in[8];
    p.a_log = (const float*)d_in[9]; p.dt_bias = (const float*)d_in[10]; p.gdn_out_norm = (const float*)d_in[11]; p.even_w_out = (const float*)d_in[12];
    p.gla_w_in = (const float*)d_in[13]; p.gla_w_gate2 = (const float*)d_in[14]; p.gla_b_gate2 = (const float*)d_in[15]; p.gla_out_norm = (const float*)d_in[16]; p.gla_w_out = (const float*)d_in[17];
    p.rg_w = (const float*)d_in[18]; p.rg_b = (const float*)d_in[19]; p.re_w = (const float*)d_in[20]; p.re_b = (const float*)d_in[21];
    p.w1 = (const float*)d_in[22]; p.w3 = (const float*)d_in[23]; p.w2 = (const float*)d_in[24]; p.final_norm = (const float*)d_in[25];
    p.X = (float*)d_out; p.ws = (unsigned char*)d_ws;
    p.rA = pow(10000.0, -2.0 / 128.0); p.rI = pow(10000.0, -2.0 / 64.0);
    hipMemsetAsync(d_ws, 0, ZERO_BYTES, stream);
#if MK_MULTI
    launch_phase<PH_PROLOGUE>(p, 0, stream);
    for (int lp = 0; lp < 2; ++lp) {
        const int le = 2 * lp, lo = 2 * lp + 1;
        launch_phase<PH_NORM_MIX>(p, le, stream);
        launch_phase<PH_GEMM_IN_EVEN>(p, le, stream);
        launch_phase<PH_EVEN_TOK>(p, le, stream);
        launch_phase<PH_GDN_SCAN>(p, le, stream);
        launch_phase<PH_DSA_ATTN>(p, le, stream);
        launch_phase<PH_GEMM_OUT>(p, le, stream);
        launch_phase<PH_NORM_FFN>(p, le, stream);
        launch_phase<PH_MOE1>(p, le, stream);
        launch_phase<PH_MOE2>(p, le, stream);
        launch_phase<PH_NORM_MIX>(p, lo, stream);
        launch_phase<PH_GEMM_IN_ODD>(p, lo, stream);
        launch_phase<PH_GLA_CHUNK>(p, lo, stream);
        launch_phase<PH_GLA_SCAN>(p, lo, stream);
        launch_phase<PH_GLA_OUT>(p, lo, stream);
        launch_phase<PH_GEMM_OUT>(p, lo, stream);
        launch_phase<PH_NORM_FFN>(p, lo, stream);
        launch_phase<PH_MOE1>(p, lo, stream);
        launch_phase<PH_MOE2>(p, lo, stream);
    }
    launch_phase<PH_FINAL>(p, 0, stream);
#else
    static int grid = 0;
    if (!grid) {
        int dev = 0, cus = 0, per_cu = 0;
        hipGetDevice(&dev);
        hipDeviceGetAttribute(&cus, hipDeviceAttributeMultiprocessorCount, dev);
        hipFuncSetAttribute((const void*)k_mega, hipFuncAttributeMaxDynamicSharedMemorySize, (int)LDS_BYTES);
        hipOccupancyMaxActiveBlocksPerMultiprocessor(&per_cu, k_mega, NTHREADS, LDS_BYTES);
        if (cus <= 0) cus = 256;
        grid = cus * (per_cu < 1 ? 1 : 1);
    }
    hipLaunchKernelGGL(k_mega, dim3(grid), dim3(NTHREADS), LDS_BYTES, stream, p);
#endif
}
```

```cpp
#include <hip/hip_runtime.h>
#include <stdint.h>
#include <math.h>
#include <stdio.h>

#define EXTRA_BARS 0
#define REP_A 1
#ifndef REP_Q
#define REP_Q 1
#endif
#ifndef REP_S
#define REP_S 1
#endif
#ifndef REP_T
#define REP_T 1
#endif
#ifndef REP_E
#define REP_E 1
#endif
#define REP_B 1
#define REP_C 1
#ifndef DUP_MASK
#define DUP_MASK 0
#endif
#ifndef MK_MULTI
#define MK_MULTI 0
#endif

namespace {

constexpr int NT = 16384, ND = 1024, LDP = 3920, LDPB = 3968;
constexpr float EPS = 1e-6f;
constexpr int NTHREADS = 512;
constexpr size_t LDS_BYTES = 163840;
constexpr float SCALE128 = 0.08838834764831845f;
constexpr int LISTCAP = 32768;
constexpr int CSTR = 16;

constexpr size_t OFF_BAR  = 0;
constexpr size_t OFF_CNT  = 16384;
constexpr size_t ZERO_BYTES = 32768;
constexpr size_t OFF_QCTR = 28672;
constexpr size_t OFF_MOD  = 32768;
constexpr size_t OFF_COSA = OFF_MOD + 4 * 2 * 6144 * 4;
constexpr size_t OFF_SINA = OFF_COSA + (size_t)NT * 64 * 4;
constexpr size_t OFF_COSI = OFF_SINA + (size_t)NT * 64 * 4;
constexpr size_t OFF_SINI = OFF_COSI + (size_t)NT * 32 * 4;
constexpr size_t OFF_H    = OFF_SINI + (size_t)NT * 32 * 4;
constexpr size_t OFF_P    = OFF_H + (size_t)NT * 1024 * 4;
constexpr size_t OFF_HID  = OFF_P;
constexpr size_t OFF_YB   = OFF_HID + (size_t)36864 * 512 * 4;
constexpr size_t OFF_O    = OFF_P + (size_t)NT * LDP * 4;
constexpr size_t OFF_ASG  = OFF_O + (size_t)NT * 1024 * 4;
constexpr size_t OFF_GATE = OFF_ASG + (size_t)NT * 4 * 4;
constexpr size_t OFF_LIST = OFF_GATE + (size_t)NT * 2 * 4;
constexpr size_t OFF_R    = OFF_LIST + (size_t)32 * LISTCAP * 4;
constexpr size_t OFF_QN   = OFF_R;
constexpr size_t OFF_KN   = OFF_QN + (size_t)NT * 512 * 4;
constexpr size_t OFF_VC   = OFF_KN + (size_t)NT * 512 * 4;
constexpr size_t OFF_BETA = OFF_VC + (size_t)NT * 512 * 4;
constexpr size_t OFF_G    = OFF_BETA + (size_t)NT * 4 * 4;
constexpr size_t OFF_W    = OFF_G + (size_t)NT * 4 * 4;
constexpr size_t OFF_U    = OFF_W + (size_t)1024 * 8192 * 4;
constexpr size_t OFF_QG   = OFF_U + (size_t)1024 * 8192 * 4;
constexpr size_t OFF_KD   = OFF_QG + (size_t)1024 * 8192 * 4;
constexpr size_t OFF_AQK  = OFF_KD + (size_t)1024 * 8192 * 4;
constexpr size_t OFF_GL   = OFF_AQK + (size_t)1024 * 4096 * 4;
constexpr size_t OFF_QB   = OFF_GL + 4096;
constexpr size_t OFF_KB   = OFF_QB + (size_t)NT * 512 * 4;
constexpr size_t OFF_QI   = OFF_KB + (size_t)NT * 512 * 4;
constexpr size_t OFF_KI   = OFF_QI + (size_t)NT * 256 * 4;
constexpr size_t OFF_WI   = OFF_KI + (size_t)NT * 64 * 4;
constexpr size_t OFF_SEL  = OFF_WI + (size_t)NT * 4 * 4;
constexpr size_t OFF_EVEN_END = OFF_SEL + (size_t)NT * 256 * 4;
constexpr size_t OFF_PFR  = OFF_W;
constexpr size_t OFF_RFR  = OFF_PFR + (size_t)1024 * 32768;
constexpr size_t OFF_QFR  = OFF_RFR + (size_t)1024 * 16384;
constexpr size_t OFF_OFR  = OFF_QFR + (size_t)1024 * 32768;
static_assert(OFF_OFR + (size_t)1024 * 16384 <= OFF_GL, "gdn v2 buffers overflow");
constexpr size_t OFF_QBB  = OFF_QB;
constexpr size_t OFF_KBB  = OFF_QBB + (size_t)NT * 512 * 2;
constexpr size_t OFF_VT   = OFF_KBB + (size_t)NT * 512 * 2;
constexpr size_t OFF_QIB  = OFF_VT + (size_t)NT * 512 * 2;
constexpr size_t OFF_KIB  = OFF_QIB + (size_t)NT * 256 * 2;
constexpr size_t OFF_M16  = OFF_KIB + (size_t)NT * 64 * 2;
static_assert(OFF_M16 + (size_t)NT * 512 * 2 <= OFF_WI, "dsa v2 buffers overflow");
constexpr size_t OFF_LA   = OFF_R;
constexpr size_t OFF_ATT  = OFF_LA + (size_t)NT * 512 * 4;
constexpr size_t OFF_QE   = OFF_ATT + (size_t)1024 * 4096 * 4;
constexpr size_t OFF_GKD  = OFF_QE + (size_t)1024 * 8192 * 4;
constexpr size_t OFF_EBL  = OFF_GKD + (size_t)1024 * 8192 * 4;
constexpr size_t OFF_GQE  = OFF_LA + (size_t)NT * 512 * 4;
constexpr size_t OFF_GOI  = OFF_GQE + (size_t)1024 * 16384;
constexpr size_t OFF_GH   = OFF_GOI + (size_t)1024 * 32768;
constexpr size_t OFF_GEBL = OFF_GH + (size_t)1024 * 65536;
static_assert(OFF_GEBL + (size_t)1024 * 512 <= OFF_EVEN_END, "gla v2 buffers overflow");
constexpr size_t OFF_WINE = OFF_EVEN_END;
constexpr size_t OFF_WINO = OFF_WINE + (size_t)2 * 4096 * 1024 * 2;
constexpr size_t OFF_WOUT = OFF_WINO + (size_t)2 * 3200 * 1024 * 2;
constexpr size_t OFF_W13  = OFF_WOUT + (size_t)4 * 1024 * 1024 * 2;
constexpr size_t OFF_W2T  = OFF_W13 + (size_t)32 * 1024 * 1024 * 2;
constexpr size_t OFF_OB   = OFF_W2T + (size_t)32 * 1024 * 512 * 2;
constexpr size_t OFF_AUX  = OFF_OB + (size_t)NT * 1024 * 2;
constexpr size_t OFF_WGL  = OFF_AUX + (size_t)NT * 16 * 4;
constexpr size_t WS_NEEDED = OFF_WGL + (size_t)2 * 128 * 1024 * 2;

struct Params {
    const float* x; const float* c; const int* pos; const float* ada_w; const float* ada_b;
    const float* norm_mix; const float* norm_ffn; const float* even_w_in; const float* conv_w;
    const float* a_log; const float* dt_bias; const float* gdn_out_norm; const float* even_w_out;
    const float* gla_w_in; const float* gla_w_gate2; const float* gla_b_gate2; const float* gla_out_norm; const float* gla_w_out;
    const float* rg_w; const float* rg_b; const float* re_w; const float* re_b;
    const float* w1; const float* w3; const float* w2; const float* final_norm;
    float* X;
    unsigned char* ws;
    double rA, rI;
};

#define XB_TMO      128
#define XB_XCNT(j)  (256  + 64 * (j))
#define XB_XSUB(j)  (1280 + 64 * (j))
#define XB_XGEN(j)  (2304 + 64 * (j))
#define XB_TOP      3328
#define XB_TOPGEN   3392
#define XCD_BAR_WORDS 3456
#define XB_SPIN_CAP (1u << 18)
#define LAS __attribute__((address_space(3)))

__device__ __forceinline__ unsigned xb_ld(unsigned* p)              { return __hip_atomic_load(p, __ATOMIC_RELAXED, __HIP_MEMORY_SCOPE_AGENT); }
__device__ __forceinline__ unsigned xb_add(unsigned* p, unsigned v) { return __hip_atomic_fetch_add(p, v, __ATOMIC_RELAXED, __HIP_MEMORY_SCOPE_AGENT); }
__device__ __forceinline__ unsigned xb_xcc_id() { return (unsigned)__builtin_amdgcn_s_getreg((3 << 11) | 20) & 0xFu; }
#define XB_SPIN(cond, bar) do { unsigned _sp = 0; while (cond) { __builtin_amdgcn_s_sleep(1); \
    if ((++_sp & 255u) == 0u) { if (xb_ld(&(bar)[XB_TMO])) break; if (_sp > XB_SPIN_CAP) { atomicAdd(&(bar)[XB_TMO], 1u); break; } } } } while (0)

struct XcdBarrier { unsigned* bar; unsigned x; volatile LAS unsigned* st; };

__device__ __forceinline__ XcdBarrier xcd_barrier_post(unsigned* bar, volatile LAS unsigned* st) {
    XcdBarrier b; b.bar = bar; b.x = xb_xcc_id(); b.st = st;
    if (threadIdx.x == 0) (void)xb_add(&bar[XB_XCNT(b.x)], 1u);
    return b;
}
__device__ __forceinline__ void xcd_barrier_complete(unsigned* bar, unsigned x, unsigned& nloc, unsigned& nx) {
    const unsigned G = gridDim.x * gridDim.y * gridDim.z;
    unsigned sum, cnt, mine, sp = 0u;
    for (;;) {
        sum = 0u; cnt = 0u; mine = 0u;
#pragma unroll
        for (unsigned j = 0; j < 16; ++j) { const unsigned c = xb_ld(&bar[XB_XCNT(j)]); sum += c; cnt += (c > 0u) ? 1u : 0u; mine = (j == x) ? c : mine; }
        if (sum == G) break;
        __builtin_amdgcn_s_sleep(1);
        if ((++sp & 255u) == 0u) { if (xb_ld(&bar[XB_TMO])) break; if (sp > XB_SPIN_CAP) { atomicAdd(&bar[XB_TMO], 1u); break; } }
    }
    nloc = mine > 0u ? mine : 1u; nx = cnt > 0u ? cnt : 1u;
}
__device__ __forceinline__ void xcd_barrier(const XcdBarrier& b) {
    asm volatile("s_waitcnt vmcnt(0)" ::: "memory");
    __syncthreads();
    if (threadIdx.x == 0) {
        unsigned* bar = b.bar;
        __builtin_amdgcn_s_waitcnt(0);
        unsigned nloc = b.st[0], nx = b.st[1];
        if (nloc == 0u) { xcd_barrier_complete(bar, b.x, nloc, nx); b.st[0] = nloc; b.st[1] = nx; }
        const unsigned old = xb_add(&bar[XB_XSUB(b.x)], 1u);
        const unsigned gen = old / nloc;
        if (old + 1u == (gen + 1u) * nloc) {
            __builtin_amdgcn_fence(__ATOMIC_RELEASE, "agent");
            asm volatile("s_waitcnt vmcnt(0)" ::: "memory");
            const unsigned og = xb_add(&bar[XB_TOP], 1u);
            const unsigned tg = og / nx;
            if (og + 1u == (tg + 1u) * nx) xb_add(&bar[XB_TOPGEN], 1u);
            else XB_SPIN(xb_ld(&bar[XB_TOPGEN]) == tg, bar);
            __builtin_amdgcn_fence(__ATOMIC_ACQUIRE, "agent");
            xb_add(&bar[XB_XGEN(b.x)], 1u);
            asm volatile("s_waitcnt vmcnt(0)" ::: "memory");
        } else {
            XB_SPIN(xb_ld(&bar[XB_XGEN(b.x)]) == gen, bar);
            __builtin_amdgcn_fence(__ATOMIC_ACQUIRE, "agent");
            asm volatile("s_waitcnt vmcnt(0)" ::: "memory");
        }
    }
    __syncthreads();
}

template <class T> __device__ __forceinline__ T* as_global(T* p) { return (T*)(__attribute__((address_space(1))) T*)p; }
typedef __attribute__((address_space(1))) unsigned char GU8;
#if defined(__HIP_DEVICE_COMPILE__)
#define ASSUME_GLOBAL(p_) do { __builtin_assume(!__builtin_amdgcn_is_shared((const void*)(p_))); __builtin_assume(!__builtin_amdgcn_is_private((const void*)(p_))); } while (0)
#else
#define ASSUME_GLOBAL(p_) do { } while (0)
#endif
#define LBAR() do { asm volatile("s_waitcnt lgkmcnt(0)" ::: "memory"); __builtin_amdgcn_s_barrier(); asm volatile("" ::: "memory"); } while (0)
typedef const Params __attribute__((address_space(4))) KParams;
__device__ __forceinline__ KParams* kparams() { KParams* q = (KParams*)__builtin_amdgcn_kernarg_segment_ptr(); asm volatile("" : "+s"(q)); return q; }
#if defined(__HIP_DEVICE_COMPILE__)
#define DPPI_(v_, c_) __builtin_amdgcn_update_dpp(0, (v_), (c_), 0xf, 0xf, true)
#define DPPF_(v_, c_) __int_as_float(__builtin_amdgcn_update_dpp(0, __float_as_int(v_), (c_), 0xf, 0xf, true))
__device__ __forceinline__ float xor16_sum(float v) { const auto r = __builtin_amdgcn_permlane16_swap(__float_as_int(v), __float_as_int(v), false, false); return __int_as_float(r[0]) + __int_as_float(r[1]); }
__device__ __forceinline__ float xor32_sum(float v) { const auto r = __builtin_amdgcn_permlane32_swap(__float_as_int(v), __float_as_int(v), false, false); return __int_as_float(r[0]) + __int_as_float(r[1]); }
__device__ __forceinline__ float xor16_max(float v) { const auto r = __builtin_amdgcn_permlane16_swap(__float_as_int(v), __float_as_int(v), false, false); return fmaxf(__int_as_float(r[0]), __int_as_float(r[1])); }
__device__ __forceinline__ float xor32_max(float v) { const auto r = __builtin_amdgcn_permlane32_swap(__float_as_int(v), __float_as_int(v), false, false); return fmaxf(__int_as_float(r[0]), __int_as_float(r[1])); }
__device__ __forceinline__ float wave_sum(float v) {
    v += DPPF_(v, 0xB1); v += DPPF_(v, 0x4E); v += DPPF_(v, 0x141); v += DPPF_(v, 0x140);
    return xor32_sum(xor16_sum(v));
}
__device__ __forceinline__ int wave_sum_i(int v) {
    v += DPPI_(v, 0xB1); v += DPPI_(v, 0x4E); v += DPPI_(v, 0x141); v += DPPI_(v, 0x140);
    { const auto r = __builtin_amdgcn_permlane16_swap(v, v, false, false); v = (int)r[0] + (int)r[1]; }
    { const auto r = __builtin_amdgcn_permlane32_swap(v, v, false, false); v = (int)r[0] + (int)r[1]; }
    return v;
}
__device__ __forceinline__ float wave_max(float v) {
    v = fmaxf(v, DPPF_(v, 0xB1)); v = fmaxf(v, DPPF_(v, 0x4E)); v = fmaxf(v, DPPF_(v, 0x141)); v = fmaxf(v, DPPF_(v, 0x140));
    return xor32_max(xor16_max(v));
}
#else
__device__ __forceinline__ float xor16_sum(float v) { return v; }
__device__ __forceinline__ float xor32_sum(float v) { return v; }
__device__ __forceinline__ float xor16_max(float v) { return v; }
__device__ __forceinline__ float xor32_max(float v) { return v; }
__device__ __forceinline__ float wave_sum(float v) { return v; }
__device__ __forceinline__ int wave_sum_i(int v) { return v; }
__device__ __forceinline__ float wave_max(float v) { return v; }
#endif
__device__ __forceinline__ float sigmoidf_(float x) { return 1.f / (1.f + expf(-x)); }
__device__ __forceinline__ float siluf_(float x) { return x / (1.f + expf(-x)); }
__device__ __forceinline__ float silu_fast(float x) { return x * __builtin_amdgcn_rcpf(1.f + __expf(-x)); }
__device__ __forceinline__ float softplusf_(float x) { return fmaxf(x, 0.f) + log1pf(expf(-fabsf(x))); }
__device__ __forceinline__ unsigned ordkey(float f) { const unsigned u = __float_as_uint(f); return u ^ ((unsigned)((int)u >> 31) | 0x80000000u); }

__device__ __forceinline__ void sincos_d(double a, double& s, double& c) {
    const double kq = rint(a * 0.63661977236758134308);
    double r = fma(-kq, 1.57079632673412561417e+00, a);
    r = fma(-kq, 6.07710050650619224932e-11, r);
    const int q = (int)((long long)kq & 3);
    const double r2 = r * r;
    const double sp = r * (1.0 + r2 * (-1.0 / 6 + r2 * (1.0 / 120 + r2 * (-1.0 / 5040 + r2 * (1.0 / 362880 + r2 * (-1.0 / 39916800 + r2 * (1.0 / 6227020800.0)))))));
    const double cp = 1.0 + r2 * (-0.5 + r2 * (1.0 / 24 + r2 * (-1.0 / 720 + r2 * (1.0 / 40320 + r2 * (-1.0 / 3628800 + r2 * (1.0 / 479001600.0 + r2 * (-1.0 / 87178291200.0)))))));
    if (q == 0) { s = sp; c = cp; } else if (q == 1) { s = cp; c = -sp; } else if (q == 2) { s = -sp; c = -cp; } else { s = -cp; c = sp; }
}
__device__ __forceinline__ double ipow_d(double b, int e) { double v = 1.0; while (e) { if (e & 1) v *= b; b *= b; e >>= 1; } return v; }

struct GemmArgs { const float* A; int lda; const int* rows; int m0; int mvalid; const float* B; int ldb; int n0; int N; int K; };

template <class Epi>
__device__ __forceinline__ void gemm128(const GemmArgs& g, float* smem, Epi epi) {
    float* As = smem;
    float* Bs = smem + 16 * 132;
    int tid_ = threadIdx.x; asm volatile("" : "+v"(tid_)); const int tid = tid_, ty = tid >> 4, tx = tid & 15;
    const int arow = tid >> 2, kq = (tid & 3) * 4;
    const int bk = tid >> 5, bn = (tid & 31) * 4;
    long asrc = -1;
    if (arow < g.mvalid) { const int r = g.rows ? g.rows[arow] : (g.m0 + arow); if (r >= 0) asrc = (long)r * g.lda; }
    const bool bval = (g.n0 + bn) < g.N;
    float acc[4][8];
#pragma unroll
    for (int i = 0; i < 4; ++i)
#pragma unroll
        for (int j = 0; j < 8; ++j) acc[i][j] = 0.f;
    for (int k0 = 0; k0 < g.K; k0 += 16) {
        float4 av = make_float4(0.f, 0.f, 0.f, 0.f), bv = make_float4(0.f, 0.f, 0.f, 0.f);
        if (asrc >= 0) av = *(const float4*)(g.A + asrc + k0 + kq);
        if (bval) bv = *(const float4*)(g.B + (size_t)(k0 + bk) * g.ldb + g.n0 + bn);
        __syncthreads();
        As[(kq + 0) * 132 + arow] = av.x; As[(kq + 1) * 132 + arow] = av.y; As[(kq + 2) * 132 + arow] = av.z; As[(kq + 3) * 132 + arow] = av.w;
        *(float4*)&Bs[bk * 132 + bn] = bv;
        __syncthreads();
#pragma unroll
        for (int kk = 0; kk < 16; ++kk) {
            const float4 a = *(const float4*)&As[kk * 132 + ty * 4];
            const float4 b0 = *(const float4*)&Bs[kk * 132 + tx * 8];
            const float4 b1 = *(const float4*)&Bs[kk * 132 + tx * 8 + 4];
            const float aa[4] = {a.x, a.y, a.z, a.w};
            const float bb[8] = {b0.x, b0.y, b0.z, b0.w, b1.x, b1.y, b1.z, b1.w};
#pragma unroll
            for (int i = 0; i < 4; ++i)
#pragma unroll
                for (int j = 0; j < 8; ++j) acc[i][j] += aa[i] * bb[j];
        }
    }
#pragma unroll
    for (int i = 0; i < 4; ++i) {
        const int r = ty * 4 + i;
        if (r < g.mvalid) {
#pragma unroll
            for (int j = 0; j < 8; ++j) { const int n = g.n0 + tx * 8 + j; if (n < g.N) epi(r, n, acc[i][j]); }
        }
    }
}


typedef short bf16x8 __attribute__((ext_vector_type(8)));
typedef float f32x4 __attribute__((ext_vector_type(4)));
typedef unsigned short bf16_t;
typedef __bf16 bf16x2_t __attribute__((ext_vector_type(2)));
typedef float f32x2_t __attribute__((ext_vector_type(2)));
__device__ __forceinline__ unsigned cvt_pk_bf16(float lo, float hi) { const f32x2_t v = {lo, hi}; const bf16x2_t r = __builtin_convertvector(v, bf16x2_t); return __builtin_bit_cast(unsigned, r); }
__device__ __forceinline__ bf16_t f2bf(float f) { return (bf16_t)(cvt_pk_bf16(f, 0.f) & 0xffffu); }
__device__ __forceinline__ float bf16_to_f32(bf16_t v) { return __uint_as_float(((unsigned)v) << 16); }
__device__ __forceinline__ uint2 pack4(const f32x4 v) { uint2 r; r.x = cvt_pk_bf16(v[0], v[1]); r.y = cvt_pk_bf16(v[2], v[3]); return r; }
__device__ __forceinline__ f32x4 unpack4(const uint2 u) { f32x4 r; r[0] = __uint_as_float(u.x << 16); r[1] = __uint_as_float(u.x & 0xffff0000u); r[2] = __uint_as_float(u.y << 16); r[3] = __uint_as_float(u.y & 0xffff0000u); return r; }
#define PBF(Pb_, t_, c_) bf16_to_f32((Pb_)[(size_t)(t_) * LDPB + (c_)])
__device__ __forceinline__ uint4 pack8(const float4 a, const float4 b) { uint4 r; r.x = cvt_pk_bf16(a.x, a.y); r.y = cvt_pk_bf16(a.z, a.w); r.z = cvt_pk_bf16(b.x, b.y); r.w = cvt_pk_bf16(b.z, b.w); return r; }
__device__ __forceinline__ int lds_off(int r, int c) { return r * 128 + ((c ^ (r & 7)) << 4); }

template <class ALoad, class BLoad, class Epi>
__device__ __forceinline__ void gemm_tile_bf16(const int K, unsigned char* lds, ALoad aload, BLoad bload, Epi epi, const int mrows = 256) {
    int tid_ = threadIdx.x; asm volatile("" : "+v"(tid_)); const int tid = tid_, lane = tid & 63, wid = tid >> 6, wm = wid >> 1, wn = wid & 1;
    f32x4 acc[4][4];
#pragma unroll
    for (int mi = 0; mi < 4; ++mi)
#pragma unroll
        for (int ni = 0; ni < 4; ++ni) acc[mi][ni] = (f32x4){0.f, 0.f, 0.f, 0.f};
    uint4 ra[4], rb[2];
    const int nk = K >> 6;
#pragma unroll
    for (int i = 0; i < 4; ++i) { const int q = tid + 512 * i; ra[i] = aload(i, q >> 3, (q & 7) * 8); }
#pragma unroll
    for (int i = 0; i < 2; ++i) { const int q = tid + 512 * i; rb[i] = bload(i, q >> 3, (q & 7) * 8); }
    __syncthreads();
#pragma unroll
    for (int i = 0; i < 4; ++i) { const int q = tid + 512 * i; *(uint4*)(lds + lds_off(q >> 3, q & 7)) = ra[i]; }
#pragma unroll
    for (int i = 0; i < 2; ++i) { const int q = tid + 512 * i; *(uint4*)(lds + 32768 + lds_off(q >> 3, q & 7)) = rb[i]; }
    __syncthreads();
    for (int kt = 0; kt < nk; ++kt) {
        if (kt + 1 < nk) {
#pragma unroll
            for (int i = 0; i < 4; ++i) { const int q = tid + 512 * i; ra[i] = aload(i, q >> 3, (kt + 1) * 64 + (q & 7) * 8); }
#pragma unroll
            for (int i = 0; i < 2; ++i) { const int q = tid + 512 * i; rb[i] = bload(i, q >> 3, (kt + 1) * 64 + (q & 7) * 8); }
        }
        const unsigned char* At = lds + (kt & 1) * 49152;
        const unsigned char* Bt = At + 32768;
        if (__builtin_amdgcn_readfirstlane(wm) * 64 < mrows) {
#pragma unroll
        for (int ks = 0; ks < 2; ++ks) {
            bf16x8 af[4], bfr[4];
            const int c = ks * 4 + (lane >> 4);
#pragma unroll
            for (int mi = 0; mi < 4; ++mi) af[mi] = *(const bf16x8*)(At + lds_off(wm * 64 + mi * 16 + (lane & 15), c));
#pragma unroll
            for (int ni = 0; ni < 4; ++ni) bfr[ni] = *(const bf16x8*)(Bt + lds_off(wn * 64 + ni * 16 + (lane & 15), c));
            __builtin_amdgcn_s_setprio(1);
#pragma unroll
            for (int mi = 0; mi < 4; ++mi)
#pragma unroll
                for (int ni = 0; ni < 4; ++ni) acc[mi][ni] = __builtin_amdgcn_mfma_f32_16x16x32_bf16(bfr[ni], af[mi], acc[mi][ni], 0, 0, 0);
            __builtin_amdgcn_s_setprio(0);
        }
        }
        if (kt + 1 < nk) {
            unsigned char* An = lds + ((kt + 1) & 1) * 49152;
#pragma unroll
            for (int i = 0; i < 4; ++i) { const int q = tid + 512 * i; *(uint4*)(An + lds_off(q >> 3, q & 7)) = ra[i]; }
#pragma unroll
            for (int i = 0; i < 2; ++i) { const int q = tid + 512 * i; *(uint4*)(An + 32768 + lds_off(q >> 3, q & 7)) = rb[i]; }
        }
        __syncthreads();
    }
    epi(acc, wm, wn, lane);
}

__device__ __forceinline__ void convert_tile(const float* src0, const float* src1, int mode, int K, int N, int ld, bf16_t* dst, int rt, int kt, float* smem) {
    int tid_ = threadIdx.x; asm volatile("" : "+v"(tid_)); const int tid = tid_;
    __syncthreads();
    { const int k = tid >> 3, R0 = rt * 64 + (tid & 7) * 8;
      const float* sp; int col;
      if (mode == 0) { sp = src0; col = R0; } else { sp = (R0 & 32) ? src1 : src0; col = (R0 >> 6) * 32 + (R0 & 31); }
      float4 a = make_float4(0.f, 0.f, 0.f, 0.f), b = a;
      const float* rp = sp + (size_t)(kt * 64 + k) * ld + col;
      if (col < N) a = *(const float4*)rp;
      if (col + 4 < N) b = *(const float4*)(rp + 4);
      float* d = smem + k * 65 + (tid & 7) * 8;
      d[0] = a.x; d[1] = a.y; d[2] = a.z; d[3] = a.w; d[4] = b.x; d[5] = b.y; d[6] = b.z; d[7] = b.w; }
    __syncthreads();
    { const int R = tid >> 3, kc = (tid & 7) * 8;
      float v[8];
#pragma unroll
      for (int j = 0; j < 8; ++j) v[j] = smem[(kc + j) * 65 + R];
      uint4 o; o.x = cvt_pk_bf16(v[0], v[1]); o.y = cvt_pk_bf16(v[2], v[3]); o.z = cvt_pk_bf16(v[4], v[5]); o.w = cvt_pk_bf16(v[6], v[7]);
      *(uint4*)(dst + (size_t)(rt * 64 + R) * K + kt * 64 + kc) = o; }
}

#define CT_LOAD(S0, S1, MODE, NN, LD, RT, KT, A, B) do { const int k_ = tid >> 3, R0_ = (RT) * 64 + (tid & 7) * 8; const float* sp_; int col_; \
        if ((MODE) == 0) { sp_ = (S0); col_ = R0_; } else { sp_ = (R0_ & 16) ? (S1) : (S0); col_ = (R0_ >> 5) * 16 + (R0_ & 15); } \
        const bool oka_ = col_ < (NN), okb_ = col_ + 4 < (NN); const float* rp_ = sp_ + (size_t)((KT) * 64 + k_) * (LD) + (oka_ ? col_ : 0); \
        A = *(const float4*)rp_; B = *(const float4*)(rp_ + (okb_ ? 4 : 0));        \
        if (!oka_) A = make_float4(0.f, 0.f, 0.f, 0.f); if (!okb_) B = make_float4(0.f, 0.f, 0.f, 0.f); } while (0)
#define CT_WRITE(BUF, A, B) do { float* d_ = smem + (BUF) * 4160 + (tid >> 3) * 65 + (tid & 7) * 8; \
        d_[0] = A.x; d_[1] = A.y; d_[2] = A.z; d_[3] = A.w; d_[4] = B.x; d_[5] = B.y; d_[6] = B.z; d_[7] = B.w; } while (0)
#define CT_STORE(DST, KK, RT, KT, BUF) do { const int R_ = tid >> 3, kc_ = (tid & 7) * 8; const float* sb_ = smem + (BUF) * 4160; \
        uint4 o_; o_.x = cvt_pk_bf16(sb_[(kc_ + 0) * 65 + R_], sb_[(kc_ + 1) * 65 + R_]); o_.y = cvt_pk_bf16(sb_[(kc_ + 2) * 65 + R_], sb_[(kc_ + 3) * 65 + R_]); \
        o_.z = cvt_pk_bf16(sb_[(kc_ + 4) * 65 + R_], sb_[(kc_ + 5) * 65 + R_]); o_.w = cvt_pk_bf16(sb_[(kc_ + 6) * 65 + R_], sb_[(kc_ + 7) * 65 + R_]); \
        *(uint4*)((DST) + (size_t)((RT) * 64 + R_) * (KK) + (KT) * 64 + kc_) = o_; } while (0)
#define CT_DECL(I) const float* s0_##I; const float* s1_##I; bf16_t* d_##I; int md_##I, K_##I, N_##I, ld_##I, rt_##I, kt_##I
#define CT_ARGS(I) s0_##I, s1_##I, d_##I, md_##I, K_##I, N_##I, ld_##I, rt_##I, kt_##I
#define CT_LOADSET(X, T) do {   \
        { CT_DECL(0); dec((T), CT_ARGS(0)); CT_LOAD(s0_0, s1_0, md_0, N_0, ld_0, rt_0, kt_0, X##a0, X##b0); } \
        { CT_DECL(1); dec((T) + 1, CT_ARGS(1)); CT_LOAD(s0_1, s1_1, md_1, N_1, ld_1, rt_1, kt_1, X##a1, X##b1); } \
        { CT_DECL(2); dec((T) + 2, CT_ARGS(2)); CT_LOAD(s0_2, s1_2, md_2, N_2, ld_2, rt_2, kt_2, X##a2, X##b2); } \
        { CT_DECL(3); dec((T) + 3, CT_ARGS(3)); CT_LOAD(s0_3, s1_3, md_3, N_3, ld_3, rt_3, kt_3, X##a3, X##b3); } } while (0)
#define CT_PROCESS(X, T) do { \
        LBAR();   \
        CT_WRITE(0, X##a0, X##b0); CT_WRITE(1, X##a1, X##b1); CT_WRITE(2, X##a2, X##b2); CT_WRITE(3, X##a3, X##b3); \
        LBAR(); \
        { CT_DECL(0); dec((T), CT_ARGS(0)); CT_STORE(d_0, K_0, rt_0, kt_0, 0); } \
        { CT_DECL(1); dec((T) + 1, CT_ARGS(1)); CT_STORE(d_1, K_1, rt_1, kt_1, 1); } \
        { CT_DECL(2); dec((T) + 2, CT_ARGS(2)); CT_STORE(d_2, K_2, rt_2, kt_2, 2); } \
        { CT_DECL(3); dec((T) + 3, CT_ARGS(3)); CT_STORE(d_3, K_3, rt_3, kt_3, 3); } } while (0)
template <class Dec>
__device__ __forceinline__ void convert_stream(const Dec& dec, int t0, int tstep, int total, float* smem) {
    int tid_ = threadIdx.x; asm volatile("" : "+v"(tid_)); const int tid = tid_;
    if (t0 >= total) return;
    const float4 z4 = make_float4(0.f, 0.f, 0.f, 0.f);
    float4 Aa0 = z4, Ab0 = z4, Aa1 = z4, Ab1 = z4, Aa2 = z4, Ab2 = z4, Aa3 = z4, Ab3 = z4, Ba0 = z4, Bb0 = z4, Ba1 = z4, Bb1 = z4, Ba2 = z4, Bb2 = z4, Ba3 = z4, Bb3 = z4;
    CT_LOADSET(A, t0);
    for (int t = t0; t < total; t += 2 * tstep) {
        if (t + tstep < total) CT_LOADSET(B, t + tstep);
        CT_PROCESS(A, t);
        if (t + tstep >= total) break;
        if (t + 2 * tstep < total) CT_LOADSET(A, t + 2 * tstep);
        CT_PROCESS(B, t + tstep);
    }
}


namespace pg8 {
constexpr int BM = 256, BK = 64, HALF = 128, HTB = HALF * BK * 2, STAGE_BYTES = 8 * HTB;
__host__ __device__ __forceinline__ int lds_byte(int r, int c) { const int st = (r >> 4) * 2 + (c >> 5), rr = r & 15, cc = c & 31, ob = rr * 64 + cc * 2; return st * 1024 + (ob ^ (((ob >> 9) & 1) << 5)); }
__host__ __device__ __forceinline__ void stage_rc(int b, int& R, int& C) { const int st = b / 1024, sb = b % 1024, swz = sb ^ (((sb >> 9) & 1) << 5); R = (st >> 1) * 16 + swz / 64; C = (st & 1) * 32 + (swz % 64) / 2; }
__host__ __device__ __forceinline__ int perm32(int rho) { const int n = rho >> 4, i = rho & 15; return 8 * (i >> 2) + 4 * n + (i & 3); }

struct Unit { size_t aoff, boff; int pm, pn, e, mvalid, rowbase, mi; };
template <class Epi, class Sched, bool GATHER>
__device__ __forceinline__ void gemm_phase(LAS unsigned char* lds, const bf16_t* Abase, const bf16_t* Bbase, const int K, const Sched& S, const Epi& E) {
    int tid_ = threadIdx.x; asm volatile("" : "+v"(tid_));
    const int tid = tid_, wid = __builtin_amdgcn_readfirstlane(tid >> 6), lane = tid & 63, wr = wid >> 2, wc = wid & 3, fr = lane & 15, fq = lane >> 4;
    const int nt = K / BK;
    unsigned voffB[2];
#pragma unroll
    for (int i = 0; i < 2; ++i) { int R, C; stage_rc(tid * 16 + i * 8192, R, C); const int Rb = Epi::PERM ? ((R & ~31) + perm32(R & 31)) : R; voffB[i] = (unsigned)(Rb * K + C) * 2u; }
    const size_t kstep = (size_t)(BK * 2);
    const size_t hstep = (size_t)HALF * K * 2;
    const unsigned ldsw = (unsigned)wid * 1024u;
    const int aoff = lds_byte(wr * 64 + fr, fq * 8), boff = lds_byte(wc * 32 + fr, fq * 8);
#define PG8_SA(b, h) (((b) * 2 + (h)) * HTB)
#define PG8_SB(b, h) ((4 + (b) * 2 + (h)) * HTB)
#define PG8_STAGE(bufoff, gbase, voff) do { _Pragma("unroll") for (int _i = 0; _i < 2; ++_i) \
        __builtin_amdgcn_global_load_lds((const unsigned*)((const char*)(gbase) + (voff)[_i]), (LAS unsigned*)(lds + (bufoff) + ldsw + _i * 8192), 16, 0, 0); } while (0)
#define PG8_LDA(dst, b, h) do { _Pragma("unroll") for (int m = 0; m < 4; ++m) _Pragma("unroll") for (int k = 0; k < 2; ++k) dst[m][k] = *(const LAS bf16x8*)(lds + PG8_SA(b, h) + aoff + m * 2048 + k * 1024); } while (0)
#define PG8_LDB(dst, b, h) do { _Pragma("unroll") for (int n = 0; n < 2; ++n) _Pragma("unroll") for (int k = 0; k < 2; ++k) dst[n][k] = *(const LAS bf16x8*)(lds + PG8_SB(b, h) + boff + n * 2048 + k * 1024); } while (0)
#define PG8_MMA(ai, bj, At, Bt) do { __builtin_amdgcn_s_setprio(1); _Pragma("unroll") for (int m = 0; m < 4; ++m) _Pragma("unroll") for (int n = 0; n < 2; ++n) _Pragma("unroll") for (int k = 0; k < 2; ++k) \
        acc[ai][bj][m][n] = __builtin_amdgcn_mfma_f32_16x16x32_bf16(Bt[n][k], At[m][k], acc[ai][bj][m][n], 0, 0, 0); __builtin_amdgcn_s_setprio(0); } while (0)
#define PG8_WAIT_V(n) asm volatile("s_waitcnt vmcnt(" #n ")" ::: "memory")
#define PG8_WAIT_L(n) asm volatile("s_waitcnt lgkmcnt(" #n ")" ::: "memory")
#define PG8_BAR __builtin_amdgcn_s_barrier()
#define PG8_SCHED __builtin_amdgcn_sched_barrier(0)
#define PG8_AVOFF(U, V0, V1) do { _Pragma("unroll") for (int _i = 0; _i < 2; ++_i) { int R_, C_; stage_rc(tid * 16 + _i * 8192, R_, C_); \
        if (GATHER) { V0[_i] = (unsigned)((size_t)S.row(U, R_) * K + C_) * 2u; V1[_i] = (unsigned)((size_t)S.row(U, 128 + R_) * K + C_) * 2u; } \
        else { V0[_i] = (unsigned)(R_ * K + C_) * 2u; V1[_i] = V0[_i] + (unsigned)hstep; } } } while (0)
    Unit cur, nxt; int ui = 0;
    if (!S.next(0, cur)) return;
    f32x4 acc[2][2][4][2];
#pragma unroll
    for (int a = 0; a < 2; ++a)
#pragma unroll
        for (int b = 0; b < 2; ++b)
#pragma unroll
            for (int m = 0; m < 4; ++m)
#pragma unroll
                for (int n = 0; n < 2; ++n) acc[a][b][m][n] = (f32x4){0.f, 0.f, 0.f, 0.f};
    bf16x8 At[4][2], B0[2][2], B1[2][2];
    unsigned cv0[2], cv1[2];
    PG8_AVOFF(cur, cv0, cv1);
    const char* cA = (const char*)Abase + cur.aoff; const char* cB = (const char*)Bbase + cur.boff;
    PG8_STAGE(PG8_SB(0, 0), cB, voffB); PG8_STAGE(PG8_SA(0, 0), cA, cv0); PG8_STAGE(PG8_SB(0, 1), cB + hstep, voffB); PG8_STAGE(PG8_SA(0, 1), cA, cv1);
    if (wr == 1) PG8_BAR;
    PG8_WAIT_V(4); PG8_BAR;
    PG8_STAGE(PG8_SB(1, 0), cB + kstep, voffB); PG8_STAGE(PG8_SA(1, 0), cA + kstep, cv0); PG8_STAGE(PG8_SB(1, 1), cB + hstep + kstep, voffB);
    PG8_WAIT_V(6); PG8_BAR;
    for (;;) {
        const bool has_next = S.next(ui + 1, nxt);
        const char* nA = has_next ? (const char*)Abase + nxt.aoff : cA; const char* nB = has_next ? (const char*)Bbase + nxt.boff : cB;
        for (int t = 0; t < nt; t += 2) {
            const bool last = (t == nt - 2);
            const char* a1 = cA + (size_t)(t + 1) * kstep;
            const char* a2 = last ? nA : cA + (size_t)(t + 2) * kstep; const char* b2 = last ? nB : cB + (size_t)(t + 2) * kstep;
            const char* a3 = a2 + kstep; const char* b3 = b2 + kstep;
            PG8_LDB(B0, 0, 0); PG8_SCHED; PG8_LDA(At, 0, 0); PG8_STAGE(PG8_SA(1, 1), a1, cv1);
            if (last && has_next) { PG8_AVOFF(nxt, cv0, cv1); }
            PG8_WAIT_L(8); PG8_BAR; PG8_WAIT_L(0); PG8_MMA(0, 0, At, B0); PG8_BAR; PG8_SCHED;
            PG8_LDB(B1, 0, 1); PG8_STAGE(PG8_SB(0, 0), b2, voffB);
            PG8_BAR; PG8_WAIT_L(0); PG8_MMA(0, 1, At, B1); PG8_BAR;
            PG8_LDA(At, 0, 1); PG8_STAGE(PG8_SA(0, 0), a2, cv0);
            PG8_BAR; PG8_WAIT_L(0); PG8_MMA(1, 0, At, B0); PG8_BAR; PG8_SCHED;
            PG8_STAGE(PG8_SB(0, 1), b2 + hstep, voffB);
            PG8_WAIT_V(6); PG8_BAR; PG8_MMA(1, 1, At, B1); PG8_BAR;
            PG8_LDB(B0, 1, 0); PG8_SCHED; PG8_LDA(At, 1, 0); PG8_STAGE(PG8_SA(0, 1), a2, cv1);
            PG8_WAIT_L(8); PG8_BAR; PG8_WAIT_L(0); PG8_MMA(0, 0, At, B0); PG8_BAR; PG8_SCHED;
            PG8_LDB(B1, 1, 1); PG8_STAGE(PG8_SB(1, 0), b3, voffB);
            PG8_BAR; PG8_WAIT_L(0); PG8_MMA(0, 1, At, B1); PG8_BAR;
            PG8_LDA(At, 1, 1); PG8_STAGE(PG8_SA(1, 0), a3, cv0);
            PG8_BAR; PG8_WAIT_L(0); PG8_MMA(1, 0, At, B0); PG8_BAR; PG8_SCHED;
            PG8_STAGE(PG8_SB(1, 1), b3 + hstep, voffB);
            PG8_WAIT_V(6); PG8_BAR; PG8_MMA(1, 1, At, B1); PG8_BAR;
        }
        E(acc, cur, wr, wc, fr, fq);
        if (!has_next) break;
#pragma unroll
        for (int a = 0; a < 2; ++a)
#pragma unroll
            for (int b = 0; b < 2; ++b)
#pragma unroll
                for (int m = 0; m < 4; ++m)
#pragma unroll
                    for (int n = 0; n < 2; ++n) acc[a][b][m][n] = (f32x4){0.f, 0.f, 0.f, 0.f};
        cur = nxt; cA = nA; cB = nB; ++ui;
    }
    PG8_WAIT_V(0);
    if (wr == 0) PG8_BAR;
    PG8_BAR;
#undef PG8_SA
#undef PG8_SB
#undef PG8_STAGE
#undef PG8_LDA
#undef PG8_LDB
#undef PG8_MMA
#undef PG8_WAIT_V
#undef PG8_WAIT_L
#undef PG8_BAR
#undef PG8_SCHED
#undef PG8_AVOFF
}
struct DenseOrder {
    int nM, nN, nwg, G, c, K;
    __device__ __forceinline__ void init(int nM_, int nN_, int G_, int c_, int K_) { nM = nM_; nN = nN_; nwg = nM * nN; G = G_; c = c_; K = K_; }
    __device__ __forceinline__ bool next(int i, Unit& u) const {
        const long L = (long)i * G + c; if (L >= nwg) return false;
        int wgid = (int)L; { const int q = nwg / 8, r = nwg % 8, xcd = wgid % 8, off = wgid / 8; wgid = (xcd < r ? xcd * (q + 1) : r * (q + 1) + (xcd - r) * q) + off; }
        const int nig = 8 * nN, gid = wgid / nig, fm = gid * 8, gsz = (nM - fm) < 8 ? (nM - fm) : 8;
        u.pm = fm + ((wgid % nig) % gsz); u.pn = (wgid % nig) / gsz;
        u.aoff = (size_t)u.pm * 256 * K * 2; u.boff = (size_t)u.pn * 256 * K * 2; u.e = 0; u.mvalid = 256; u.rowbase = u.pm * 256; u.mi = 0;
        return true;
    }
    __device__ __forceinline__ int row(const Unit&, int r) const { return r; }
};
}

extern __shared__ __attribute__((aligned(16))) unsigned char g_smem[];
#define PHASE_FN __device__ __forceinline__
enum { PH_PROLOGUE = 0, PH_NORM_MIX, PH_GEMM_IN_EVEN, PH_EVEN_TOK, PH_GDN_CHUNK, PH_GDN_SCAN, PH_DSA_TOPK, PH_DSA_ATTN, PH_GDN_OUT,
       PH_GEMM_OUT, PH_NORM_FFN, PH_MOE1, PH_MOE2, PH_GEMM_IN_ODD, PH_GLA_TOK, PH_GLA_CHUNK, PH_GLA_SCAN, PH_GLA_OUT, PH_FINAL };

PHASE_FN void ph_prologue(const Params& p, float* smem) {
    KParams* pp = kparams();
    GU8* wsg_ = (GU8*)pp->ws; asm volatile("" : "+s"(wsg_)); unsigned char* ws_ = (unsigned char*)wsg_;
    { int ldz_ = 0; asm volatile("" : "+s"(ldz_)); smem = (float*)(g_smem + ldz_); }
    int tid_ = threadIdx.x; asm volatile("" : "+v"(tid_)); const int tid = tid_, nthr = gridDim.x * NTHREADS, gid = blockIdx.x * NTHREADS + tid;
    for (int i = tid; i < 2 * ND; i += NTHREADS) smem[i] = siluf_(as_global(pp->c)[i]);
    __syncthreads();
    float* MOD = (float*)(ws_ + OFF_MOD);
    { float* red = smem + 2048;
      const int lane = tid & 63, wv = tid >> 6;
      for (int item = blockIdx.x; item < 4 * 96; item += gridDim.x) {
          const int l = item / 96, n = (item % 96) * 64 + lane;
          const float* w = as_global(pp->ada_w) + (size_t)l * ND * 6144 + n;
          float a0 = 0.f, a1 = 0.f;
#pragma unroll 8
          for (int k = wv * 128; k < wv * 128 + 128; ++k) { const float wv_ = w[(size_t)k * 6144]; a0 += smem[k] * wv_; a1 += smem[ND + k] * wv_; }
          __syncthreads();
          red[(wv * 64 + lane) * 2] = a0; red[(wv * 64 + lane) * 2 + 1] = a1;
          __syncthreads();
          if (tid < 128) { const int c = tid >> 1, bb = tid & 1; float a = 0.f; for (int w8 = 0; w8 < 8; ++w8) a += red[(w8 * 64 + c) * 2 + bb];
              MOD[(l * 2 + bb) * 6144 + (item % 96) * 64 + c] = a + as_global(pp->ada_b)[l * 6144 + (item % 96) * 64 + c]; }
      }
      __syncthreads(); }
    float* COSA = (float*)(ws_ + OFF_COSA); float* SINA = (float*)(ws_ + OFF_SINA);
    float* COSI = (float*)(ws_ + OFF_COSI); float* SINI = (float*)(ws_ + OFF_SINI);
    for (size_t i = gid; i < (size_t)NT * 64; i += nthr) {
        const int t = (int)(i >> 6), j = (int)(i & 63);
        double s, c; sincos_d((double)as_global(pp->pos)[t] * ipow_d(pp->rA, j), s, c);
        COSA[i] = (float)c; SINA[i] = (float)s;
    }
    for (size_t i = gid; i < (size_t)NT * 32; i += nthr) {
        const int t = (int)(i >> 5), j = (int)(i & 31);
        double s, c; sincos_d((double)as_global(pp->pos)[t] * ipow_d(pp->rI, j), s, c);
        COSI[i] = (float)c; SINI[i] = (float)s;
    }
}

PHASE_FN void ph_rows(const Params& p, int layer, int mode, float* smem) {
    KParams* pp = kparams();
    GU8* wsg_ = (GU8*)pp->ws; asm volatile("" : "+s"(wsg_)); unsigned char* ws_ = (unsigned char*)wsg_;
    { int ldz_ = 0; asm volatile("" : "+s"(ldz_)); smem = (float*)(g_smem + ldz_); }
    int tid_ = threadIdx.x; asm volatile("" : "+v"(tid_)); const int tid = tid_, lane = tid & 63, wv = tid >> 6;
    int* pad = (int*)smem;
    const int moe_layer = (mode == 1) ? 3 : layer - 1;
    const float* MOD = (const float*)(ws_ + OFF_MOD);
    float4* sG = (float4*)(smem + 64); float4* sNA = sG + 512; float4* sNB = sNA + 512;
    __syncthreads();
    if (moe_layer >= 0 && tid == 0) { const int* cnt = (const int*)(ws_ + OFF_CNT) + moe_layer * 32 * CSTR; int a = 0; for (int e = 0; e < 32; ++e) { pad[e] = a; a += ((cnt[e * CSTR] + 127) / 128) * 128; } }
    { const int bsel = tid >> 8, col = ((tid >> 6) & 3) * 256 + lane * 4;
      if (moe_layer >= 0) sG[tid] = *(const float4*)(MOD + (size_t)(moe_layer * 2 + bsel) * 6144 + 5 * 1024 + col);
      if (mode == 0) { const float* sh = MOD + (size_t)(layer * 2 + bsel) * 6144; const float4 w = *(const float4*)(as_global(pp->norm_mix) + layer * 1024 + col), s4 = *(const float4*)(sh + 1024 + col);
          sNA[tid] = make_float4(w.x * (1.f + s4.x), w.y * (1.f + s4.y), w.z * (1.f + s4.z), w.w * (1.f + s4.w)); sNB[tid] = *(const float4*)(sh + col); }
      else sNA[tid] = *(const float4*)(as_global(pp->final_norm) + col); }
    __syncthreads();
    bf16_t* H = (bf16_t*)(ws_ + OFF_H);
    const bf16_t* YB = (const bf16_t*)(ws_ + OFF_YB);
    const int* ASG = (const int*)(ws_ + OFF_ASG);
    const float* GATE = (const float*)(ws_ + OFF_GATE);
    auto load_x = [&](int row, float (&xv)[16]) {
        const float* xin = (mode == 0 && layer == 0) ? (as_global(pp->x) + (size_t)row * ND) : (as_global(pp->X) + (size_t)row * ND);
#pragma unroll
        for (int j = 0; j < 4; ++j) { const float4 v = *(const float4*)(xin + j * 256 + lane * 4); xv[4 * j] = v.x; xv[4 * j + 1] = v.y; xv[4 * j + 2] = v.z; xv[4 * j + 3] = v.w; }
    };
    auto load_y = [&](const int4& as, uint2 (&ya)[4], uint2 (&yb)[4]) {
        const bf16_t* y0 = YB + (size_t)(pad[as.x] + as.y) * ND;
        const bf16_t* y1 = YB + (size_t)(pad[as.z] + as.w) * ND;
#pragma unroll
        for (int j = 0; j < 4; ++j) { ya[j] = *(const uint2*)(y0 + j * 256 + lane * 4); yb[j] = *(const uint2*)(y1 + j * 256 + lane * 4); }
    };
    auto finish = [&](int row, float (&xv)[16], const uint2 (&ya)[4], const uint2 (&yb)[4], float g0, float g1) {
        const int bo = (row >> 13) * 256 + lane;
        float* xr = as_global(pp->X) + (size_t)row * ND;
        if (moe_layer >= 0) {
#pragma unroll
            for (int j = 0; j < 4; ++j) {
                const int col = j * 256 + lane * 4;
                const f32x4 a = unpack4(ya[j]), bq = unpack4(yb[j]); const float4 g = sG[bo + j * 64];
                xv[4 * j] += g.x * (g0 * a[0] + g1 * bq[0]); xv[4 * j + 1] += g.y * (g0 * a[1] + g1 * bq[1]);
                xv[4 * j + 2] += g.z * (g0 * a[2] + g1 * bq[2]); xv[4 * j + 3] += g.w * (g0 * a[3] + g1 * bq[3]);
                if (mode == 0) *(float4*)(xr + col) = make_float4(xv[4 * j], xv[4 * j + 1], xv[4 * j + 2], xv[4 * j + 3]);
            }
        }
        float ss = 0.f;
#pragma unroll
        for (int j = 0; j < 16; ++j) ss += xv[j] * xv[j];
        ss = wave_sum(ss);
        const float rstd = rsqrtf(ss * (1.f / 1024.f) + EPS);
        if (mode == 0) {
#pragma unroll
            for (int j = 0; j < 4; ++j) {
                const int col = j * 256 + lane * 4;
                const float4 wa = sNA[bo + j * 64], h4 = sNB[bo + j * 64];
                f32x4 ov;
                ov[0] = xv[4 * j] * rstd * wa.x + h4.x; ov[1] = xv[4 * j + 1] * rstd * wa.y + h4.y;
                ov[2] = xv[4 * j + 2] * rstd * wa.z + h4.z; ov[3] = xv[4 * j + 3] * rstd * wa.w + h4.w;
                *(uint2*)(H + (size_t)row * ND + col) = pack4(ov);
            }
        } else {
#pragma unroll
            for (int j = 0; j < 4; ++j) {
                const int col = j * 256 + lane * 4;
                const float4 w = sNA[lane + j * 64];
                *(float4*)(xr + col) = make_float4(xv[4 * j] * rstd * w.x, xv[4 * j + 1] * rstd * w.y, xv[4 * j + 2] * rstd * w.z, xv[4 * j + 3] * rstd * w.w);
            }
        }
    };
    const int stride = gridDim.x * 8, step = 2 * stride;
    const int row0 = blockIdx.x * 8 + wv;
#define RCL(r_) (((r_) < NT) ? (r_) : (NT - 1))
    int4 asA = make_int4(0, 0, 0, 0), asB = asA, nsA = asA, nsB = asA; float2 gA = make_float2(0.f, 0.f), gB = gA, ngA = gA, ngB = gA;
    float xa[16], xb[16], nxa[16], nxb[16]; uint2 yaa[4], yab[4], yba[4], ybb[4], nyaa[4], nyab[4], nyba[4], nybb[4];
#pragma unroll
    for (int j = 0; j < 4; ++j) { yaa[j] = yab[j] = yba[j] = ybb[j] = nyaa[j] = nyab[j] = nyba[j] = nybb[j] = make_uint2(0u, 0u); }
    if (moe_layer >= 0) { asA = *(const int4*)(ASG + RCL(row0) * 4); gA = *(const float2*)(GATE + RCL(row0) * 2); asB = *(const int4*)(ASG + RCL(row0 + stride) * 4); gB = *(const float2*)(GATE + RCL(row0 + stride) * 2);
                          nsA = *(const int4*)(ASG + RCL(row0 + step) * 4); ngA = *(const float2*)(GATE + RCL(row0 + step) * 2); nsB = *(const int4*)(ASG + RCL(row0 + step + stride) * 4); ngB = *(const float2*)(GATE + RCL(row0 + step + stride) * 2); }
    load_x(RCL(row0), xa); load_x(RCL(row0 + stride), xb);
    if (moe_layer >= 0) { load_y(asA, yaa, yab); load_y(asB, yba, ybb); }
    for (int row = row0; row < NT; row += step) {
        const int rowB = row + stride, nrow = row + step;
        int4 fsA = make_int4(0, 0, 0, 0), fsB = fsA; float2 fgA = make_float2(0.f, 0.f), fgB = fgA;
        if (nrow < NT) {
            if (moe_layer >= 0) { fsA = *(const int4*)(ASG + RCL(nrow + step) * 4); fgA = *(const float2*)(GATE + RCL(nrow + step) * 2); fsB = *(const int4*)(ASG + RCL(nrow + step + stride) * 4); fgB = *(const float2*)(GATE + RCL(nrow + step + stride) * 2); }
            load_x(nrow, nxa); load_x(RCL(nrow + stride), nxb);
            if (moe_layer >= 0) { load_y(nsA, nyaa, nyab); load_y(nsB, nyba, nybb); }
        }
        finish(row, xa, yaa, yab, gA.x, gA.y);
        if (rowB < NT) finish(rowB, xb, yba, ybb, gB.x, gB.y);
#pragma unroll
        for (int j = 0; j < 16; ++j) { xa[j] = nxa[j]; xb[j] = nxb[j]; }
#pragma unroll
        for (int j = 0; j < 4; ++j) { yaa[j] = nyaa[j]; yab[j] = nyab[j]; yba[j] = nyba[j]; ybb[j] = nybb[j]; }
        asA = nsA; asB = nsB; gA = ngA; gB = ngB; nsA = fsA; nsB = fsB; ngA = fgA; ngB = fgB;
    }
#undef RCL
}

struct EpiIn {
    static constexpr bool PERM = true;
    bf16_t* P; float* AUX; int ncols; int even;
    __device__ __forceinline__ void operator()(const f32x4 (&acc)[2][2][4][2], const pg8::Unit& u, int wr, int wc, int fr, int fq) const {
        const int row0 = u.pm * 256 + wr * 64 + fr, col0 = u.pn * 256 + wc * 32 + 8 * fq;
#pragma unroll
        for (int ai = 0; ai < 2; ++ai)
#pragma unroll
            for (int m = 0; m < 4; ++m) { const int r = row0 + ai * 128 + m * 16;
#pragma unroll
                for (int bj = 0; bj < 2; ++bj) { const int c = col0 + bj * 128;
                    if (c < ncols) { const uint2 lo = pack4(acc[ai][bj][m][0]), hi = pack4(acc[ai][bj][m][1]); *(uint4*)(P + (size_t)r * LDPB + c) = make_uint4(lo.x, lo.y, hi.x, hi.y); }
                    if (even) {
                        if (c == 2048) { *(f32x4*)(AUX + (size_t)r * 16) = acc[ai][bj][m][0]; *(f32x4*)(AUX + (size_t)r * 16 + 4) = acc[ai][bj][m][1]; }
                        if (c == 3912) *(f32x4*)(AUX + (size_t)r * 16 + 8) = acc[ai][bj][m][0];
                    } } }
    }
};

PHASE_FN void ph_gemm_in(const Params& p, int layer, bool even, float* smem) {
    KParams* pp = kparams();
    GU8* wsg_ = (GU8*)pp->ws; asm volatile("" : "+s"(wsg_)); unsigned char* ws_ = (unsigned char*)wsg_;
    int ldz_ = 0; asm volatile("" : "+s"(ldz_));
    const bf16_t* Wt = even ? (const bf16_t*)(ws_ + OFF_WINE) + (size_t)(layer >> 1) * 4096 * 1024 : (const bf16_t*)(ws_ + OFF_WINO) + (size_t)(layer >> 1) * 3072 * 1024;
    EpiIn E; E.P = (bf16_t*)(ws_ + OFF_P); E.AUX = (float*)(ws_ + OFF_AUX); E.ncols = even ? 3920 : 3072; E.even = even ? 1 : 0;
    pg8::DenseOrder S; S.init(64, even ? 16 : 12, gridDim.x, blockIdx.x, 1024);
    __syncthreads();
    pg8::gemm_phase<EpiIn, pg8::DenseOrder, false>((LAS unsigned char*)(g_smem + ldz_), (const bf16_t*)(ws_ + OFF_H), Wt, 1024, S, E);
    __syncthreads();
    if (!even) {
        const bf16_t* H = (const bf16_t*)(ws_ + OFF_H);
        const bf16_t* Wg = (const bf16_t*)(ws_ + OFF_WGL) + (size_t)(layer >> 1) * 128 * 1024;
        float* AUX = (float*)(ws_ + OFF_AUX);
        for (int mt = blockIdx.x; mt < 64; mt += gridDim.x) {
            const bf16_t* Ab = H + (size_t)mt * 256 * 1024;
            float* At = AUX + (size_t)mt * 256 * 16;
            gemm_tile_bf16(1024, g_smem + ldz_,
                [=](int i, int r, int k) -> uint4 { return *(const uint4*)(Ab + (size_t)r * 1024 + k); },
                [=](int i, int r, int k) -> uint4 { return *(const uint4*)(Wg + (size_t)r * 1024 + k); },
                [=](const f32x4 (&acc)[4][4], int wm, int wn, int lane) {
                    if (wn == 0 && (lane >> 4) < 4) {
#pragma unroll
                        for (int mi = 0; mi < 4; ++mi) { const int m = wm * 64 + mi * 16 + (lane & 15); *(f32x4*)(At + (size_t)m * 16 + 4 * (lane >> 4)) = acc[mi][0]; }
                    }
                });
        }
        __syncthreads();
    }
}

PHASE_FN void ph_even_tok(const Params& p, int layer, float* smem) {
    KParams* pp = kparams();
    GU8* wsg_ = (GU8*)pp->ws; asm volatile("" : "+s"(wsg_)); unsigned char* ws_ = (unsigned char*)wsg_;
    { int ldz_ = 0; asm volatile("" : "+s"(ldz_)); smem = (float*)(g_smem + ldz_); }
    int tid_ = threadIdx.x; asm volatile("" : "+v"(tid_)); const int tid = tid_, lane = tid & 63, wv = tid >> 6, li = layer >> 1;
    const bf16_t* P = (const bf16_t*)(ws_ + OFF_P); const float* AUX = (const float*)(ws_ + OFF_AUX);
    bf16_t* QB = (bf16_t*)(ws_ + OFF_QBB); bf16_t* KB = (bf16_t*)(ws_ + OFF_KBB); bf16_t* QI = (bf16_t*)(ws_ + OFF_QIB); bf16_t* KI = (bf16_t*)(ws_ + OFF_KIB); float* WI = (float*)(ws_ + OFF_WI);
    const float* COSA = (const float*)(ws_ + OFF_COSA); const float* SINA = (const float*)(ws_ + OFF_SINA);
    const float* COSI = (const float*)(ws_ + OFF_COSI); const float* SINI = (const float*)(ws_ + OFF_SINI);
    for (int t = blockIdx.x * 8 + wv; t < NT; t += gridDim.x * 8) {
        const bf16_t* Pt = P + (size_t)t * LDPB;
        if (lane < 4) {
            WI[t * 4 + lane] = AUX[(size_t)t * 16 + 8 + lane] * 0.0625f;
        }
        { const float c = COSA[(size_t)t * 64 + lane], sn = SINA[(size_t)t * 64 + lane];
#pragma unroll
          for (int h = 0; h < 4; ++h) {
              float t1 = bf16_to_f32(Pt[2056 + h * 128 + lane]), t2 = bf16_to_f32(Pt[2056 + h * 128 + 64 + lane]);
              QB[(size_t)t * 512 + h * 128 + lane] = f2bf(t1 * c - t2 * sn); QB[(size_t)t * 512 + h * 128 + 64 + lane] = f2bf(t2 * c + t1 * sn);
              t1 = bf16_to_f32(Pt[2568 + h * 128 + lane]); t2 = bf16_to_f32(Pt[2568 + h * 128 + 64 + lane]);
              KB[(size_t)t * 512 + h * 128 + lane] = f2bf(t1 * c - t2 * sn); KB[(size_t)t * 512 + h * 128 + 64 + lane] = f2bf(t2 * c + t1 * sn);
          } }
#pragma unroll
        for (int r = 0; r < 2; ++r) {
            const int item = lane + 64 * r, hh = item >> 5, ii = item & 31;
            const float c = COSI[(size_t)t * 32 + ii], sn = SINI[(size_t)t * 32 + ii];
            const float t1 = bf16_to_f32(Pt[3592 + hh * 64 + ii]), t2 = bf16_to_f32(Pt[3592 + hh * 64 + 32 + ii]);
            QI[(size_t)t * 256 + hh * 64 + ii] = f2bf(t1 * c - t2 * sn); QI[(size_t)t * 256 + hh * 64 + 32 + ii] = f2bf(t2 * c + t1 * sn);
        }
        if (lane < 32) {
            const float c = COSI[(size_t)t * 32 + lane], sn = SINI[(size_t)t * 32 + lane];
            const float t1 = bf16_to_f32(Pt[3848 + lane]), t2 = bf16_to_f32(Pt[3848 + 32 + lane]);
            bf16_t* kd = KI + (size_t)(t >> 4) * 1024 + ((lane >> 3) * 16 + (t & 15)) * 8 + (lane & 7);
            kd[0] = f2bf(t1 * c - t2 * sn); kd[512] = f2bf(t2 * c + t1 * sn);
        }
    }
    { bf16_t* VT = (bf16_t*)(ws_ + OFF_VT);
      bf16_t* sv = (bf16_t*)g_smem;
      for (int item = blockIdx.x; item < 2 * 128 * 4; item += gridDim.x) {
          const int h = item & 3, tt = item >> 2, b = tt >> 7, s0 = (tt & 127) * 64;
          __syncthreads();
          for (int e = tid; e < 64 * 128; e += NTHREADS) { const int i = e >> 7, d = e & 127; sv[d * 72 + i] = P[(size_t)(b * 8192 + s0 + i) * LDPB + 3080 + h * 128 + d]; }
          __syncthreads();
          for (int e = tid; e < 128 * 8; e += NTHREADS) { const int d = e >> 3, c = e & 7;
              *(uint4*)(VT + ((size_t)((b * 4 + h) * 128 + d)) * 8192 + s0 + c * 8) = *(const uint4*)(sv + d * 72 + c * 8); }
      } }
}

__device__ __forceinline__ f32x4 mma_lds(const unsigned char* A, int sa, int a0, const unsigned char* B, int sb, int b0, int K, f32x4 acc, int c16, int q4) {
    const unsigned char* ap = A + (a0 + c16) * sa + q4 * 16;
    const unsigned char* bp = B + (b0 + c16) * sb + q4 * 16;
#pragma unroll
    for (int kk = 0; kk < K; kk += 32) { acc = __builtin_amdgcn_mfma_f32_16x16x32_bf16(*(const bf16x8*)(ap + kk * 2), *(const bf16x8*)(bp + kk * 2), acc, 0, 0, 0); }
    return acc;
}

PHASE_FN void ph_gdn_chunk(const Params& p, int layer, float* smem) {
    KParams* pp = kparams();
    GU8* wsg_ = (GU8*)pp->ws; asm volatile("" : "+s"(wsg_)); unsigned char* ws_ = (unsigned char*)wsg_;
    int tid_ = threadIdx.x; asm volatile("" : "+v"(tid_)); const int tid = tid_, lane = tid & 63, wv = __builtin_amdgcn_readfirstlane(tid >> 6), q4 = lane >> 4, c16 = lane & 15;
    int ldz_ = 0; asm volatile("" : "+s"(ldz_)); unsigned char* lds = g_smem + ldz_;
    constexpr int SN = 272, ST = 144;
    unsigned char* bKN = lds;
    unsigned char* bQN = lds + 18432;
    unsigned char* bKBG = lds + 35840;
    unsigned char* bVB = lds + 54272;
    unsigned char* bKD = lds + 72704;
    unsigned char* bUT = lds + 91136;
    float* sL = (float*)(lds + 109568);
    unsigned char* bAQK = lds + 126976;
    unsigned char* bTB = lds + 136192;
    float* sG = (float*)(lds + 145408); float* sB = sG + 64; float* sEg = sB + 64;
    const int li = layer >> 1;
    const bf16_t* P = (const bf16_t*)(ws_ + OFF_P); const float* AUX = (const float*)(ws_ + OFF_AUX);
    const float* cw = as_global(pp->conv_w) + (size_t)li * 4 * 1536;
    uint4* PFR = (uint4*)(ws_ + OFF_PFR); uint4* RFR = (uint4*)(ws_ + OFF_RFR); uint2* QFR = (uint2*)(ws_ + OFF_QFR); uint2* OFR = (uint2*)(ws_ + OFF_OFR);
    float* GL = (float*)(ws_ + OFF_GL);
    for (int ci = blockIdx.x; ci < 1024; ci += gridDim.x) {
        const int b = ci >> 9, h = (ci >> 7) & 3, n = ci & 127;
        const int t0 = b * 8192 + n * 64;
        __syncthreads();
        if (tid < 64) { float g = -expf(as_global(pp->a_log)[li * 4 + h]) * softplusf_(AUX[(size_t)(t0 + tid) * 16 + 4 + h] + as_global(pp->dt_bias)[li * 4 + h]);
#pragma unroll
            for (int o = 1; o < 64; o <<= 1) { const float nb = __shfl_up(g, o); if (lane >= o) g += nb; }
            sG[tid] = g; sB[tid] = sigmoidf_(AUX[(size_t)(t0 + tid) * 16 + h]); sEg[tid] = expf(g); }
        for (int e = tid; e < 64 * 36; e += NTHREADS) ((unsigned*)bAQK)[e] = 0u;
        __syncthreads();
        const float gl = sG[63];
        for (int rep_a = 0; rep_a < REP_A; ++rep_a)
        {
            const int d0 = 2 * lane, cb = h * 128 + d0, s00 = n * 64;
            float wq[4][2], wk[4][2], wvv[4][2];
#pragma unroll
            for (int jj = 0; jj < 4; ++jj) { wq[jj][0] = cw[jj * 1536 + cb]; wq[jj][1] = cw[jj * 1536 + cb + 1]; wk[jj][0] = cw[jj * 1536 + 512 + cb]; wk[jj][1] = cw[jj * 1536 + 512 + cb + 1];
                                            wvv[jj][0] = cw[jj * 1536 + 1024 + cb]; wvv[jj][1] = cw[jj * 1536 + 1024 + cb + 1]; }
            float tk0[8], tk1[8], tv0[8], tv1[8], td0[8], td1[8];
#pragma unroll
            for (int r = 0; r < 8; ++r) {
                const int i = wv * 8 + r;
                float aq0 = 0.f, aq1 = 0.f, ak0 = 0.f, ak1 = 0.f, av0 = 0.f, av1 = 0.f;
#pragma unroll
                for (int jj = 0; jj < 4; ++jj) {
                    if (s00 + i - 3 + jj >= 0) {
                        const bf16_t* rp = P + (size_t)(t0 + i - 3 + jj) * LDPB + cb;
                        const unsigned uq = *(const unsigned*)rp, uk = *(const unsigned*)(rp + 512), uv = *(const unsigned*)(rp + 1024);
                        aq0 += wq[jj][0] * __uint_as_float(uq << 16); aq1 += wq[jj][1] * __uint_as_float(uq & 0xffff0000u);
                        ak0 += wk[jj][0] * __uint_as_float(uk << 16); ak1 += wk[jj][1] * __uint_as_float(uk & 0xffff0000u);
                        av0 += wvv[jj][0] * __uint_as_float(uv << 16); av1 += wvv[jj][1] * __uint_as_float(uv & 0xffff0000u);
                    }
                }
                aq0 = siluf_(aq0); aq1 = siluf_(aq1); ak0 = siluf_(ak0); ak1 = siluf_(ak1); av0 = siluf_(av0); av1 = siluf_(av1);
                const float rq = rsqrtf(wave_sum(aq0 * aq0 + aq1 * aq1) + EPS), rk = rsqrtf(wave_sum(ak0 * ak0 + ak1 * ak1) + EPS);
                aq0 *= rq; aq1 *= rq; ak0 *= rk; ak1 *= rk;
                const float be = sB[i], eg_i = sEg[i], ekd = expf(gl - sG[i]);
                *(unsigned*)(bKN + i * SN + d0 * 2) = cvt_pk_bf16(ak0, ak1);
                *(unsigned*)(bQN + i * SN + d0 * 2) = cvt_pk_bf16(aq0, aq1);
                tk0[r] = ak0 * be * eg_i; tk1[r] = ak1 * be * eg_i; tv0[r] = av0 * be; tv1[r] = av1 * be; td0[r] = ak0 * ekd; td1[r] = ak1 * ekd;
                if ((r & 1) == 1) asm volatile("" ::: "memory");
            }
#define PK8(T) make_uint4(cvt_pk_bf16(T[0], T[1]), cvt_pk_bf16(T[2], T[3]), cvt_pk_bf16(T[4], T[5]), cvt_pk_bf16(T[6], T[7]))
            *(uint4*)(bKBG + d0 * ST + wv * 16) = PK8(tk0); *(uint4*)(bKBG + (d0 + 1) * ST + wv * 16) = PK8(tk1);
            *(uint4*)(bVB + d0 * ST + wv * 16) = PK8(tv0); *(uint4*)(bVB + (d0 + 1) * ST + wv * 16) = PK8(tv1);
            *(uint4*)(bKD + d0 * ST + wv * 16) = PK8(td0); *(uint4*)(bKD + (d0 + 1) * ST + wv * 16) = PK8(td1);
        }
        __syncthreads();
        for (int u = wv; u < 20; u += 8) {
            const int kind = (u >= 10) ? 1 : 0, idx = u - kind * 10;
            const int ti = (idx >= 6) ? 3 : (idx >= 3) ? 2 : (idx >= 1) ? 1 : 0, tj = idx - ((ti * (ti + 1)) >> 1);
            f32x4 acc = (f32x4){0.f, 0.f, 0.f, 0.f};
            acc = mma_lds(kind ? bQN : bKN, SN, 16 * ti, bKN, SN, 16 * tj, 128, acc, c16, q4);
            const int j = 16 * tj + c16;
#pragma unroll
            for (int r = 0; r < 4; ++r) { const int i = 16 * ti + 4 * q4 + r;
                const float dec = (j <= i) ? expf(sG[i] - sG[j]) : 0.f;
                if (kind == 0) sL[i * 68 + j] = (j < i) ? sB[i] * acc[r] * dec : 0.f;
                else *(bf16_t*)(bAQK + i * ST + j * 2) = f2bf(acc[r] * SCALE128 * dec); }
        }
        __syncthreads();
        for (int rep_b = 0; rep_b < REP_B; ++rep_b)
        if (wv == 0) {
            float t[64];
            int zz = 0; asm volatile("" : "+v"(zz)); const float* sLo = sL + zz;
#pragma clang loop unroll(full)
            for (int i = 0; i < 64; ++i) { float a0 = (i == lane) ? 1.f : 0.f, a1 = 0.f, a2 = 0.f, a3 = 0.f;
#define LQ(q) float4 lv##q = make_float4(0.f, 0.f, 0.f, 0.f); if (4 * q < i) lv##q = *(const float4*)(sLo + i * 68 + 4 * q);
#define FQ(q) if (4 * q < i) { a0 -= lv##q.x * t[4 * q]; if (4 * q + 1 < i) a1 -= lv##q.y * t[4 * q + 1]; if (4 * q + 2 < i) a2 -= lv##q.z * t[4 * q + 2]; if (4 * q + 3 < i) a3 -= lv##q.w * t[4 * q + 3]; }
                { LQ(0) LQ(1) LQ(2) LQ(3) LQ(4) LQ(5) LQ(6) LQ(7)
                  FQ(0) FQ(1) FQ(2) FQ(3) FQ(4) FQ(5) FQ(6) FQ(7) }
                if (i > 32) { asm volatile("" ::: "memory");
                  LQ(8) LQ(9) LQ(10) LQ(11) LQ(12) LQ(13) LQ(14) LQ(15)
                  FQ(8) FQ(9) FQ(10) FQ(11) FQ(12) FQ(13) FQ(14) FQ(15) }
                t[i] = (a0 + a1) + (a2 + a3); asm volatile("" ::: "memory"); }
#pragma unroll
            for (int i = 0; i < 64; ++i) *(bf16_t*)(bTB + i * ST + lane * 2) = f2bf(t[i]);
        }
        __syncthreads();
#pragma unroll 4
        for (int x = 0; x < 8; ++x) {
            const int u = wv * 8 + x, kind = u >> 5, ti = (u >> 3) & 3, td = u & 7;
            f32x4 acc = (f32x4){0.f, 0.f, 0.f, 0.f};
            acc = mma_lds(bTB, ST, 16 * ti, kind ? bVB : bKBG, ST, 16 * td, 64, acc, c16, q4);
            *(uint2*)((kind ? bUT : bKN) + (16 * td + c16) * ST + (16 * ti + 4 * q4) * 2) = pack4(acc);
        }
        __syncthreads();
        unsigned char* bWT = bKN;
        const float eg = expf(gl);
        for (int rep_c = 0; rep_c < REP_C; ++rep_c) {
        for (int x = 0; x < 4; ++x) {
            const int u = wv * 4 + x, ti = u >> 2, a = u & 3;
            uint4 fr;
#pragma unroll
            for (int hf = 0; hf < 2; ++hf) { const int tk = 2 * a + hf;
                f32x4 acc = (f32x4){0.f, 0.f, 0.f, 0.f};
                acc = mma_lds(bWT, ST, 16 * tk, bKD, ST, 16 * ti, 64, acc, c16, q4);
                f32x4 v;
#pragma unroll
                for (int r = 0; r < 4; ++r) v[r] = ((16 * tk + 4 * q4 + r) == (16 * ti + c16) ? eg : 0.f) - acc[r];
                const uint2 pk = pack4(v);
                if (hf == 0) { fr.x = pk.x; fr.y = pk.y; } else { fr.z = pk.x; fr.w = pk.y; } }
            PFR[((size_t)(ci * 8 + ti) * 4 + a) * 64 + lane] = fr;
        }
        for (int x = 0; x < 2; ++x) {
            const int u = wv * 2 + x, ti = u >> 2, a = u & 3;
            uint4 fr;
            const int i = 16 * ti + c16;
            const float qs = SCALE128 * sEg[i];
#pragma unroll
            for (int hf = 0; hf < 2; ++hf) { const int tk = 2 * a + hf;
                f32x4 acc = (f32x4){0.f, 0.f, 0.f, 0.f};
                acc = mma_lds(bWT, ST, 16 * tk, bAQK, ST, 16 * ti, 64, acc, c16, q4);
                const f32x4 qv = unpack4(*(const uint2*)(bQN + i * SN + (16 * tk + 4 * q4) * 2));
                const uint2 pk = pack4(qv * qs - acc);
                if (hf == 0) { fr.x = pk.x; fr.y = pk.y; } else { fr.z = pk.x; fr.w = pk.y; } }
            RFR[((size_t)(ci * 4 + ti) * 4 + a) * 64 + lane] = fr;
        }
#pragma unroll 4
        for (int x = 0; x < 8; ++x) {
            const int u = wv * 8 + x, tdv = u >> 3, tdk = u & 7;
            f32x4 acc = (f32x4){0.f, 0.f, 0.f, 0.f};
            acc = mma_lds(bKD, ST, 16 * tdk, bUT, ST, 16 * tdv, 64, acc, c16, q4);
            QFR[((size_t)(ci * 8 + tdv) * 8 + tdk) * 64 + lane] = pack4(acc);
        }
#pragma unroll
        for (int x = 0; x < 4; ++x) {
            const int u = wv * 4 + x, tdv = u >> 2, ti = u & 3;
            f32x4 acc = (f32x4){0.f, 0.f, 0.f, 0.f};
            acc = mma_lds(bAQK, ST, 16 * ti, bUT, ST, 16 * tdv, 64, acc, c16, q4);
            OFR[((size_t)(ci * 8 + tdv) * 4 + ti) * 64 + lane] = pack4(acc);
        }
        }
        if (tid == 0) GL[ci] = gl;
    }
}

__device__ __forceinline__ void gs_load(uint4 (&d)[12], const unsigned char* pp, const unsigned char* rr, const unsigned char* qq, const unsigned char* oo, const int lt) {
#pragma unroll
    for (int i = 0; i < 6; ++i) { int c = lt + 384 * i; c = c < 2048 ? c : 2047; d[i] = *(const uint4*)(pp + c * 16); }
#pragma unroll
    for (int i = 0; i < 3; ++i) { int c = lt + 384 * i; c = c < 1024 ? c : 1023; d[6 + i] = *(const uint4*)(rr + c * 16); }
#pragma unroll
    for (int i = 0; i < 2; ++i) { int c = lt + 384 * i; c = c < 512 ? c : 511; d[9 + i] = *(const uint4*)(qq + c * 16); }
    { const int c = lt < 256 ? lt : 255; d[11] = *(const uint4*)(oo + c * 16); }
}
__device__ __forceinline__ void gs_store(const uint4 (&d)[12], unsigned char* sb, const int lt) {
#pragma unroll
    for (int i = 0; i < 6; ++i) { const int c = lt + 384 * i; if (c < 2048) *(uint4*)(sb + c * 16) = d[i]; }
#pragma unroll
    for (int i = 0; i < 3; ++i) { const int c = lt + 384 * i; if (c < 1024) *(uint4*)(sb + 32768 + c * 16) = d[6 + i]; }
#pragma unroll
    for (int i = 0; i < 2; ++i) { const int c = lt + 384 * i; if (c < 512) *(uint4*)(sb + 49152 + c * 16) = d[9 + i]; }
    if (lt < 256) *(uint4*)(sb + 57344 + lt * 16) = d[11];
}

#define SCAN_BODY                 bf16x8 Sb[4]; \
_Pragma("unroll") \
                for (int a = 0; a < 4; ++a) { union { uint4 u; bf16x8 v; } cv; const uint2 lo = pack4(S[2 * a]), hi = pack4(S[2 * a + 1]); cv.u.x = lo.x; cv.u.y = lo.y; cv.u.z = hi.x; cv.u.w = hi.y; Sb[a] = cv.v; } \
                const int t0 = b * 8192 + n * 64; \
                {   f32x4 oa[4]; \
_Pragma("unroll") \
                    for (int ti = 0; ti < 4; ++ti) oa[ti] = unpack4(*(const uint2*)(Of + ti * 512)); \
_Pragma("unroll") \
                    for (int a = 0; a < 4; ++a) \
_Pragma("unroll") \
                        for (int ti = 0; ti < 4; ++ti) oa[ti] = __builtin_amdgcn_mfma_f32_16x16x32_bf16(*(const bf16x8*)(Rf + (ti * 4 + a) * 1024), Sb[a], oa[ti], 0, 0, 0); \
_Pragma("unroll") \
                    for (int ti = 0; ti < 4; ++ti) { \
                        float* op = O + (size_t)(t0 + 16 * ti + 4 * q4) * 1024 + h * 128 + 16 * tdv + c16; \
                        op[0] = oa[ti][0]; op[1024] = oa[ti][1]; op[2048] = oa[ti][2]; op[3072] = oa[ti][3]; } \
                } \
                asm volatile("" ::: "memory"); \
_Pragma("unroll") \
                for (int g = 0; g < 2; ++g) { \
                    f32x4 sa[4]; \
_Pragma("unroll") \
                    for (int t = 0; t < 4; ++t) sa[t] = unpack4(*(const uint2*)(Qf + (g * 4 + t) * 512)); \
_Pragma("unroll") \
                    for (int a = 0; a < 4; ++a) \
_Pragma("unroll") \
                        for (int t = 0; t < 4; ++t) sa[t] = __builtin_amdgcn_mfma_f32_16x16x32_bf16(*(const bf16x8*)(Pf + ((g * 4 + t) * 4 + a) * 1024), Sb[a], sa[t], 0, 0, 0); \
_Pragma("unroll") \
                    for (int t = 0; t < 4; ++t) S[g * 4 + t] = sa[t]; \
                    asm volatile("" ::: "memory"); \
                }
PHASE_FN void ph_gdn_scan(const Params& p, float* smem) {
    KParams* pp = kparams();
    GU8* wsg_ = (GU8*)pp->ws; asm volatile("" : "+s"(wsg_)); unsigned char* ws_ = (unsigned char*)wsg_;
    int tid_ = threadIdx.x; asm volatile("" : "+v"(tid_)); const int tid = tid_, lane = tid & 63, wv = __builtin_amdgcn_readfirstlane(tid >> 6), q4 = lane >> 4, c16 = lane & 15;
    int ldz_ = 0; asm volatile("" : "+s"(ldz_)); unsigned char* lds = g_smem + ldz_;
    constexpr int STG = 61440;
    const unsigned char* PFR = ws_ + OFF_PFR; const unsigned char* RFR = ws_ + OFF_RFR; const unsigned char* QFR = ws_ + OFF_QFR; const unsigned char* OFR = ws_ + OFF_OFR;
    float* O = (float*)(ws_ + OFF_O);
    for (int it = blockIdx.x; it < 32; it += gridDim.x) {
        const int bh = it >> 2, pair = it & 3, b = bh >> 2, h = bh & 3;
        __syncthreads();
        if (wv >= 2) {
            const int lt = tid - 128;
            const unsigned char* Pb = PFR + (size_t)bh * 128 * 32768;
            const unsigned char* Rb = RFR + (size_t)bh * 128 * 16384;
            const unsigned char* Qb = QFR + (size_t)bh * 128 * 32768 + pair * 8192;
            const unsigned char* Ob = OFR + (size_t)bh * 128 * 16384 + pair * 4096;
            uint4 ra0, ra1, ra2, ra3, ra4, ra5, ra6, ra7, ra8, ra9, ra10, ra11, rb0, rb1, rb2, rb3, rb4, rb5, rb6, rb7, rb8, rb9, rb10, rb11;
            uint4 rc0, rc1, rc2, rc3, rc4, rc5, rc6, rc7, rc8, rc9, rc10, rc11;
#define LDC(base_, c_, mx_) (*(const uint4*)((base_) + (size_t)(((c_) < (mx_)) ? (c_) : (mx_)) * 16))
#define GS_LOAD(X, n_) do { const unsigned char* pp_ = Pb + (size_t)(n_) * 32768; const unsigned char* rr_ = Rb + (size_t)(n_) * 16384; \
                const unsigned char* qq_ = Qb + (size_t)(n_) * 32768; const unsigned char* oo_ = Ob + (size_t)(n_) * 16384; \
                X##0 = LDC(pp_, lt, 2047); X##1 = LDC(pp_, lt + 384, 2047); X##2 = LDC(pp_, lt + 768, 2047); X##3 = LDC(pp_, lt + 1152, 2047); X##4 = LDC(pp_, lt + 1536, 2047); X##5 = LDC(pp_, lt + 1920, 2047); \
                X##6 = LDC(rr_, lt, 1023); X##7 = LDC(rr_, lt + 384, 1023); X##8 = LDC(rr_, lt + 768, 1023); \
                X##9 = LDC(qq_, lt, 511); X##10 = LDC(qq_, lt + 384, 511); X##11 = LDC(oo_, lt, 255); } while (0)
#define STC(off_, c_, lim_, v_) do { if ((c_) < (lim_)) *(uint4*)(sb_ + (off_) + (c_) * 16) = v_; } while (0)
#define GS_STORE(X, st_) do { unsigned char* sb_ = lds + (st_) * STG; \
                STC(0, lt, 2048, X##0); STC(0, lt + 384, 2048, X##1); STC(0, lt + 768, 2048, X##2); STC(0, lt + 1152, 2048, X##3); STC(0, lt + 1536, 2048, X##4); STC(0, lt + 1920, 2048, X##5); \
                STC(32768, lt, 1024, X##6); STC(32768, lt + 384, 1024, X##7); STC(32768, lt + 768, 1024, X##8); \
                STC(49152, lt, 512, X##9); STC(49152, lt + 384, 512, X##10); STC(57344, lt, 256, X##11); } while (0)
            GS_LOAD(ra, 0); GS_STORE(ra, 0);
            GS_LOAD(rb, 1); GS_LOAD(rc, 2); GS_LOAD(ra, 3);
            __syncthreads();
#define CLAMPN(x_) (((x_) < 128) ? (x_) : 127)
            for (int n = 0; n < 128; n += 3) {
                if (n + 1 < 128) GS_STORE(rb, (n + 1) & 1);
                GS_LOAD(rb, CLAMPN(n + 4)); LBAR();
                if (n + 1 < 128) { if (n + 2 < 128) GS_STORE(rc, (n + 2) & 1);
                    GS_LOAD(rc, CLAMPN(n + 5)); LBAR(); }
                if (n + 2 < 128) { if (n + 3 < 128) GS_STORE(ra, (n + 3) & 1);
                    GS_LOAD(ra, CLAMPN(n + 6)); LBAR(); }
            }
        } else {
            const int tdv = pair * 2 + wv;
            f32x4 S[8];
#pragma unroll
            for (int t = 0; t < 8; ++t) S[t] = (f32x4){0.f, 0.f, 0.f, 0.f};
            __syncthreads();
            for (int n = 0; n < 128; ++n) {
                const unsigned char* base = lds + (n & 1) * STG;
                const unsigned char* Pf = base + lane * 16, *Rf = base + 32768 + lane * 16;
                const unsigned char* Qf = base + 49152 + wv * 4096 + lane * 8, *Of = base + 57344 + wv * 2048 + lane * 8;
                SCAN_BODY
                LBAR();
            }
        }
    }
}

__device__ __forceinline__ void block_sum4(int (&v)[4], int* buf) {
    const int lane = threadIdx.x & 63, wv = threadIdx.x >> 6;
#pragma unroll
    for (int q = 0; q < 4; ++q) v[q] = wave_sum_i(v[q]);
    if (lane == 0) {
#pragma unroll
        for (int q = 0; q < 4; ++q) buf[wv * 4 + q] = v[q];
    }
    __syncthreads();
#pragma unroll
    for (int q = 0; q < 4; ++q) { int a = 0; for (int w = 0; w < 8; ++w) a += buf[w * 4 + q]; v[q] = a; }
}

PHASE_FN void ph_dsa_topk(const Params& p, int layer, float* smem) {
    KParams* pp = kparams();
    GU8* wsg_ = (GU8*)pp->ws; asm volatile("" : "+s"(wsg_)); unsigned char* ws_ = (unsigned char*)wsg_;
    int tid_ = threadIdx.x; asm volatile("" : "+v"(tid_)); const int tid = tid_, lane = tid & 63, wv = __builtin_amdgcn_readfirstlane(tid >> 6), q4 = lane >> 4, c16 = lane & 15;
    int* sRed = (int*)g_smem;
    const bf16_t* QIb = (const bf16_t*)(ws_ + OFF_QIB); const bf16_t* KIb = (const bf16_t*)(ws_ + OFF_KIB); const float* WI = (const float*)(ws_ + OFF_WI);
    unsigned short* M16 = (unsigned short*)(ws_ + OFF_M16);
    int* qhead = (int*)(ws_ + OFF_QCTR) + layer * 16;
    int* sIt = (int*)(g_smem + 512);
    __syncthreads();
    if (tid == 0) *sIt = atomicAdd(qhead, 1);
    __syncthreads();
    int it = *sIt;
    while (it < 2048) {
        int nxt = 0;
        const int b = it & 1, gp = 1023 - (it >> 1);
        const int s0 = gp * 8, t0 = b * 8192 + s0;
        const int ntiles = (s0 >> 4) + 1;
        const int nreg = (ntiles > wv) ? ((ntiles - wv + 7) >> 3) : 0;
        const bf16_t* qp = QIb + (size_t)(t0 + (c16 >> 2)) * 256 + (c16 & 3) * 64 + 8 * q4;
        const bf16x8 a0A = *(const bf16x8*)qp, a1A = *(const bf16x8*)(qp + 32), a0B = *(const bf16x8*)(qp + 4 * 256), a1B = *(const bf16x8*)(qp + 4 * 256 + 32);
        const float4 wqA = *(const float4*)(WI + (size_t)(t0 + q4) * 4), wqB = *(const float4*)(WI + (size_t)(t0 + 4 + q4) * 4);
        const int myqA = s0 + q4, myqB = s0 + 4 + q4;
        int c16s = c16; asm volatile("" : "+v"(c16s));
        int lanes = lane; asm volatile("" : "+v"(lanes));
        int wvs = wv; asm volatile("" : "+s"(wvs));
        unsigned kA[64], kB[64];
#pragma unroll
        for (int i = 0; i < 64; ++i) { kA[i] = 0u; kB[i] = 0u; }
#define RELU_(x_) __builtin_amdgcn_fmed3f((x_), 0.f, __builtin_inff())
#define SC_TILE(il_, tile_, k0_, k1_) { \
                    f32x4 accA = (f32x4){0.f, 0.f, 0.f, 0.f}, accB = accA; \
                    accA = __builtin_amdgcn_mfma_f32_16x16x32_bf16(a0A, k0_, accA, 0, 0, 0); \
                    accB = __builtin_amdgcn_mfma_f32_16x16x32_bf16(a0B, k0_, accB, 0, 0, 0); \
                    accA = __builtin_amdgcn_mfma_f32_16x16x32_bf16(a1A, k1_, accA, 0, 0, 0); \
                    accB = __builtin_amdgcn_mfma_f32_16x16x32_bf16(a1B, k1_, accB, 0, 0, 0); \
                    const float sa = fmaf(wqA.w, RELU_(accA[3]), fmaf(wqA.z, RELU_(accA[2]), fmaf(wqA.y, RELU_(accA[1]), wqA.x * RELU_(accA[0])))); \
                    const float sb = fmaf(wqB.w, RELU_(accB[3]), fmaf(wqB.z, RELU_(accB[2]), fmaf(wqB.y, RELU_(accB[1]), wqB.x * RELU_(accB[0])))); \
                    const int kidx = (tile_) * 16 + c16s; \
                    kA[il_] = (kidx <= myqA) ? ordkey(sa) : 0u; \
                    kB[il_] = (kidx <= myqB) ? ordkey(sb) : 0u; }
        const int nblk = (nreg + 15) >> 4;
        for (int rep_s = 0; rep_s < REP_S; ++rep_s) {
        if (rep_s > 0) {
#pragma unroll
            for (int i = 0; i < 64; ++i) { kA[i] = 0u; kB[i] = 0u; } }
#pragma nounroll
        for (int blk = nblk - 1; blk >= 0; --blk) {
#pragma unroll
            for (int i = 63; i >= 16; --i) { kA[i] = kA[i - 16]; kB[i] = kB[i - 16]; }
#pragma unroll
            for (int i = 0; i < 16; ++i) { kA[i] = 0u; kB[i] = 0u; }
            const int tb = wvs + 128 * blk;
#pragma unroll
            for (int g = 0; g < 4; ++g) { const int tg = tb + 32 * g;
                if (tg < ntiles) {
                    const bf16_t* kp = KIb + (size_t)(b * 512 + tg) * 1024 + lanes * 8;
                    const bf16x8 k00 = *(const bf16x8*)kp, k01 = *(const bf16x8*)(kp + 512);
                    const bf16x8 k10 = *(const bf16x8*)(kp + 8 * 1024), k11 = *(const bf16x8*)(kp + 8 * 1024 + 512);
                    const bf16x8 k20 = *(const bf16x8*)(kp + 16 * 1024), k21 = *(const bf16x8*)(kp + 16 * 1024 + 512);
                    const bf16x8 k30 = *(const bf16x8*)(kp + 24 * 1024), k31 = *(const bf16x8*)(kp + 24 * 1024 + 512);
                    SC_TILE(g * 4, tg, k00, k01) SC_TILE(g * 4 + 1, tg + 8, k10, k11) SC_TILE(g * 4 + 2, tg + 16, k20, k21) SC_TILE(g * 4 + 3, tg + 24, k30, k31)
                }
                asm volatile("" ::: "memory"); }
        }
        }
        if (tid == 0) nxt = atomicAdd(qhead, 1);
        const int keffA = (myqA + 1 < 256) ? (myqA + 1) : 256, keffB = (myqB + 1 < 256) ? (myqB + 1) : 256;
        int par = 0;
        int mydone = 0, alldone = 0;
        auto qsum = [&](int c) -> int {
            c += __builtin_amdgcn_update_dpp(0, c, 0xB1, 0xf, 0xf, true);
            c += __builtin_amdgcn_update_dpp(0, c, 0x4E, 0xf, 0xf, true);
            c += __builtin_amdgcn_update_dpp(0, c, 0x124, 0xf, 0xf, true);
            c += __builtin_amdgcn_update_dpp(0, c, 0x128, 0xf, 0xf, true);
            par ^= 1;
            sRed[par * 32 + q4 * 8 + wv] = c;
            LBAR();
            const int4 r0 = *(const int4*)(sRed + par * 32 + q4 * 8), r1 = *(const int4*)(sRed + par * 32 + q4 * 8 + 4);
            return r0.x + r0.y + r0.z + r0.w + r1.x + r1.y + r1.z + r1.w;
        };
        const bool has1 = nreg > 32;
#define TR_STEP(a, base, J_, M_) { _Pragma("unroll") for (int k_ = 0; k_ < 32; ++k_) if ((k_ & (J_)) == 0) { \
                const unsigned lo_ = a[(base) + k_], hi_ = a[(base) + k_ + (J_)]; \
                a[(base) + k_] = ((M_) & lo_) | (~(M_) & (hi_ << (J_))); \
                a[(base) + k_ + (J_)] = ((M_) & (lo_ >> (J_))) | (~(M_) & hi_); } }
#define TR32(a, base) { TR_STEP(a, base, 16, 0x0000FFFFu) TR_STEP(a, base, 8, 0x00FF00FFu) TR_STEP(a, base, 4, 0x0F0F0F0Fu) TR_STEP(a, base, 2, 0x33333333u) TR_STEP(a, base, 1, 0x55555555u) }
        for (int rep_t = 0; rep_t < REP_T; ++rep_t) {
        TR32(kA, 0) TR32(kB, 0)
        if (has1) { TR32(kA, 32) TR32(kB, 32) } }
        unsigned alA0, alA1, alB0, alB1, gmA0, gmA1, gmB0, gmB1;
        int GA, GB;
        for (int rep_q = 0; rep_q < REP_Q; ++rep_q) {
        alA0 = ~0u; alA1 = has1 ? ~0u : 0u; alB0 = ~0u; alB1 = alA1; gmA0 = 0u; gmA1 = 0u; gmB0 = 0u; gmB1 = 0u; GA = 0; GB = 0; mydone = 0; alldone = 0;
#pragma unroll
        for (int bit = 31; bit >= 0; --bit) {
            if (alldone) continue;
            const unsigned mA0 = alA0 & kA[bit], mA1 = alA1 & kA[32 + bit], mB0 = alB0 & kB[bit], mB1 = alB1 & kB[32 + bit];
            const int ca = __builtin_popcount(mA0) + __builtin_popcount(mA1), cb = __builtin_popcount(mB0) + __builtin_popcount(mB1);
            const int tot = qsum(ca | (cb << 16));
            const int tA = GA + (tot & 0xffff), tB = GB + (tot >> 16);
            if (tA >= keffA) { alA0 = mA0; alA1 = mA1; mydone = (mydone & 2) | ((tA == keffA) ? 1 : 0); }
            else { GA = tA; gmA0 |= mA0; gmA1 |= mA1; alA0 ^= mA0; alA1 ^= mA1; }
            if (tB >= keffB) { alB0 = mB0; alB1 = mB1; mydone = (mydone & 1) | ((tB == keffB) ? 2 : 0); }
            else { GB = tB; gmB0 |= mB0; gmB1 |= mB1; alB0 ^= mB0; alB1 ^= mB1; }
            alldone = (__ballot(mydone == 3) == ~0ull) ? 1 : 0;
        }
        }
        const int ce = qsum((__builtin_popcount(alA0) + __builtin_popcount(alA1)) | ((__builtin_popcount(alB0) + __builtin_popcount(alB1)) << 16));
        const int needA = keffA - GA, needB = keffB - GB;
        par ^= 1;
        sRed[par * 32 + q4 * 8 + wv] = (((ce & 0xffff) > needA) || ((ce >> 16) > needB)) ? 1 : 0;
        LBAR();
        int anyov = 0;
#pragma unroll
        for (int w = 0; w < 32; ++w) anyov |= sRed[par * 32 + w];
        if (anyov) {
            int JA = 0, JB = 0;
            int c16j = c16; asm volatile("" : "+v"(c16j));
            int wvj = wv; asm volatile("" : "+s"(wvj));
            for (int bit = 12; bit >= 0; --bit) {
                const int cjA = JA | (1 << bit), cjB = JB | (1 << bit);
                int c = 0;
#pragma unroll
                for (int i = 0; i < 64; ++i) { const int kidx = (wvj + 8 * i) * 16 + c16j;
                    const unsigned ba = ((i < 32 ? alA0 : alA1) >> (i & 31)) & 1u, bb = ((i < 32 ? alB0 : alB1) >> (i & 31)) & 1u;
                    c += (ba && kidx < cjA) ? 1 : 0; c += (bb && kidx < cjB) ? 65536 : 0; }
                const int tot = qsum(c);
                if ((tot & 0xffff) <= needA - 1) JA = cjA;
                if ((tot >> 16) <= needB - 1) JB = cjB;
            }
            unsigned kpA0 = 0u, kpA1 = 0u, kpB0 = 0u, kpB1 = 0u;
#pragma unroll
            for (int i = 0; i < 32; ++i) { const int k0 = (wvj + 8 * i) * 16 + c16j, k1 = k0 + 4096;
                kpA0 |= (k0 <= JA) ? (1u << i) : 0u; kpA1 |= (k1 <= JA) ? (1u << i) : 0u; kpB0 |= (k0 <= JB) ? (1u << i) : 0u; kpB1 |= (k1 <= JB) ? (1u << i) : 0u; }
            alA0 &= kpA0; alA1 &= kpA1; alB0 &= kpB0; alB1 &= kpB1;
        }
        const unsigned selA0 = gmA0 | alA0, selA1 = gmA1 | alA1, selB0 = gmB0 | alB0, selB1 = gmB1 | alB1;
        unsigned short* sM = (unsigned short*)(g_smem + 1024);
        {
            int c16e = c16; asm volatile("" : "+v"(c16e));
            unsigned wsel[4] = {selA0, selA1, selB0, selB1};
#pragma unroll
            for (int st = 0; st < 4; ++st) {
                const int d = 8 >> st;
                const unsigned m = (d == 8) ? 0x00FF00FFu : (d == 4) ? 0x0F0F0F0Fu : (d == 2) ? 0x33333333u : 0x55555555u;
                const bool lowr = (c16e & d) != 0;
                const unsigned km = lowr ? ~m : m, rr = lowr ? (unsigned)d : (unsigned)(32 - d);
#pragma unroll
                for (int w = 0; w < 4; ++w) {
                    int pw = (int)wsel[w];
                    if (d == 8) { pw = __builtin_amdgcn_update_dpp(0, pw, 0x128, 0xf, 0xf, true); }
                    else if (d == 4) { pw = __builtin_amdgcn_update_dpp(0, pw, 0x141, 0xf, 0xf, true); pw = __builtin_amdgcn_update_dpp(0, pw, 0x1B, 0xf, 0xf, true); }
                    else if (d == 2) { pw = __builtin_amdgcn_update_dpp(0, pw, 0x4E, 0xf, 0xf, true); }
                    else { pw = __builtin_amdgcn_update_dpp(0, pw, 0xB1, 0xf, 0xf, true); }
                    const unsigned q = __builtin_amdgcn_alignbit((unsigned)pw, (unsigned)pw, rr);
                    wsel[w] = (wsel[w] & km) | (q & ~km);
                }
            }
            const int wve = wv;
#pragma unroll
            for (int w = 0; w < 4; ++w) { const int qrow = (w >> 1) * 4 + q4, g = w & 1;
                sM[qrow * 512 + wve + 8 * (32 * g + c16e)] = (unsigned short)(wsel[w] & 0xffffu);
                sM[qrow * 512 + wve + 8 * (32 * g + 16 + c16e)] = (unsigned short)(wsel[w] >> 16); }
        }
        if (tid == 0) *sIt = nxt;
        __syncthreads();
        *(uint4*)(M16 + (size_t)(t0 + (tid >> 6)) * 512 + (tid & 63) * 8) = ((const uint4*)sM)[tid];
        it = *sIt;
    }
}

PHASE_FN void ph_dsa_attn(const Params& p, float* smem) {
    KParams* pp = kparams();
    GU8* wsg_ = (GU8*)pp->ws; asm volatile("" : "+s"(wsg_)); unsigned char* ws_ = (unsigned char*)wsg_;
    int tid_ = threadIdx.x; asm volatile("" : "+v"(tid_)); const int tid = tid_, lane = tid & 63, wv = tid >> 6, q4 = lane >> 4, c16 = lane & 15;
    int ldz_ = 0; asm volatile("" : "+s"(ldz_)); unsigned char* lds = g_smem + ldz_;
    const bf16_t* QBb = (const bf16_t*)(ws_ + OFF_QBB); const bf16_t* KBb = (const bf16_t*)(ws_ + OFF_KBB); const bf16_t* VT = (const bf16_t*)(ws_ + OFF_VT);
    const unsigned short* M16 = (const unsigned short*)(ws_ + OFF_M16);
    bf16_t* OB = (bf16_t*)(ws_ + OFF_OB);
    const float SC = SCALE128 * 1.4426950408889634f;
    for (int it = blockIdx.x; it < 256; it += gridDim.x) {
        const int bh = it & 7, jp = it >> 3, b = bh >> 2, h = bh & 3;
        for (int half = 0; half < 2; ++half) {
            const int jq = half ? jp : 63 - jp;
            const int qs = jq * 128, nkt = 2 * jq + 2;
            const int tq = b * 8192 + qs + wv * 16 + c16;
            bf16x8 qf[4];
#pragma unroll
            for (int a = 0; a < 4; ++a) qf[a] = *(const bf16x8*)(QBb + (size_t)tq * 512 + h * 128 + 8 * q4 + 32 * a);
            float m = -1e30f, lsum = 0.f;
            f32x4 oacc[8];
#pragma unroll
            for (int t = 0; t < 8; ++t) oacc[t] = (f32x4){0.f, 0.f, 0.f, 0.f};
            uint4 rk0, rk1, rv0, rv1;
            const int q0 = tid, q1 = tid + 512;
            const bf16_t* kg0 = KBb + (size_t)(b * 8192 + (q0 >> 4)) * 512 + h * 128 + (q0 & 15) * 8;
            const bf16_t* kg1 = KBb + (size_t)(b * 8192 + (q1 >> 4)) * 512 + h * 128 + (q1 & 15) * 8;
            const bf16_t* vg0 = VT + ((size_t)((b * 4 + h) * 128 + (q0 >> 3))) * 8192 + (q0 & 7) * 8;
            const bf16_t* vg1 = VT + ((size_t)((b * 4 + h) * 128 + (q1 >> 3))) * 8192 + (q1 & 7) * 8;
            const int lk0 = (q0 >> 4) * 256 + ((((q0 & 15)) ^ ((q0 >> 4) & 15)) << 4), lk1 = (q1 >> 4) * 256 + ((((q1 & 15)) ^ ((q1 >> 4) & 15)) << 4);
            const int lv0 = 16384 + (q0 >> 3) * 128 + ((((q0 & 7)) ^ ((q0 >> 3) & 7)) << 4), lv1 = 16384 + (q1 >> 3) * 128 + ((((q1 & 7)) ^ ((q1 >> 3) & 7)) << 4);
#define ATT_GLOAD(kt_) do { rk0 = *(const uint4*)(kg0 + (size_t)(kt_) * 64 * 512); rk1 = *(const uint4*)(kg1 + (size_t)(kt_) * 64 * 512); \
                            rv0 = *(const uint4*)(vg0 + (kt_) * 64); rv1 = *(const uint4*)(vg1 + (kt_) * 64); } while (0)
#define ATT_LSTORE(st_) do { unsigned char* base_ = lds + (st_) * 32768; *(uint4*)(base_ + lk0) = rk0; *(uint4*)(base_ + lk1) = rk1; *(uint4*)(base_ + lv0) = rv0; *(uint4*)(base_ + lv1) = rv1; } while (0)
            __syncthreads();
            ATT_GLOAD(0); ATT_LSTORE(0);
            __syncthreads();
            for (int kt = 0; kt < nkt; ++kt) {
                if (kt + 1 < nkt) ATT_GLOAD(kt + 1);
                const unsigned long long mbits = *(const unsigned long long*)(M16 + (size_t)tq * 512 + 4 * kt);
                const unsigned char* Kt = lds + (kt & 1) * 32768;
                const unsigned char* Vt = Kt + 16384;
                f32x4 sacc[4];
#pragma unroll
                for (int th = 0; th < 2; ++th) {
                    bf16x8 kf[8];
#pragma unroll
                    for (int tt = 0; tt < 2; ++tt) { const int row = 16 * (th * 2 + tt) + c16;
#pragma unroll
                        for (int a = 0; a < 4; ++a) kf[tt * 4 + a] = *(const bf16x8*)(Kt + row * 256 + ((((q4 + 4 * a)) ^ (row & 15)) << 4)); }
                    asm volatile("" : "+v"(kf[0]), "+v"(kf[1]), "+v"(kf[2]), "+v"(kf[3]), "+v"(kf[4]), "+v"(kf[5]), "+v"(kf[6]), "+v"(kf[7]));
                    sacc[th * 2] = (f32x4){0.f, 0.f, 0.f, 0.f}; sacc[th * 2 + 1] = (f32x4){0.f, 0.f, 0.f, 0.f};
#pragma unroll
                    for (int a = 0; a < 4; ++a)
#pragma unroll
                        for (int tt = 0; tt < 2; ++tt) sacc[th * 2 + tt] = __builtin_amdgcn_mfma_f32_16x16x32_bf16(kf[tt * 4 + a], qf[a], sacc[th * 2 + tt], 0, 0, 0);
                }
                float mx = m;
                const unsigned mlo = (unsigned)mbits >> (4 * q4), mhi = (unsigned)(mbits >> 32) >> (4 * q4);
                int vm[4][4];
#pragma unroll
                for (int ti = 0; ti < 4; ++ti)
#pragma unroll
                    for (int r = 0; r < 4; ++r) { vm[ti][r] = __builtin_amdgcn_sbfe((int)((ti < 2) ? mlo : mhi), 16 * (ti & 1) + r, 1);
                        const float v = sacc[ti][r] * SC; sacc[ti][r] = v;
                        mx = fmaxf(mx, __int_as_float((vm[ti][r] & __float_as_int(v)) | (~vm[ti][r] & (int)0xF149F2CAu))); }
                mx = xor32_max(xor16_max(mx));
                const float alpha = __builtin_amdgcn_exp2f(m - mx); m = mx;
                float ps = 0.f;
#pragma unroll
                for (int ti = 0; ti < 4; ++ti)
#pragma unroll
                    for (int r = 0; r < 4; ++r) { const float pv = __int_as_float(__float_as_int(__builtin_amdgcn_exp2f(sacc[ti][r] - mx)) & vm[ti][r]); sacc[ti][r] = pv; ps += pv; }
                lsum = lsum * alpha + ps;
                if (!__all(alpha == 1.f)) {
#pragma unroll
                for (int t = 0; t < 8; ++t) oacc[t] = oacc[t] * alpha; }
                bf16x8 pb[2];
#pragma unroll
                for (int a = 0; a < 2; ++a) {
                    union { uint4 u; bf16x8 v; } cv;
                    cv.u.x = cvt_pk_bf16(sacc[2 * a][0], sacc[2 * a][1]); cv.u.y = cvt_pk_bf16(sacc[2 * a][2], sacc[2 * a][3]);
                    cv.u.z = cvt_pk_bf16(sacc[2 * a + 1][0], sacc[2 * a + 1][1]); cv.u.w = cvt_pk_bf16(sacc[2 * a + 1][2], sacc[2 * a + 1][3]);
                    pb[a] = cv.v; }
#pragma unroll
                for (int tg = 0; tg < 2; ++tg) {
                    bf16x8 vfr[8];
#pragma unroll
                    for (int tt = 0; tt < 4; ++tt) { const int row = 16 * (tg * 4 + tt) + c16;
#pragma unroll
                        for (int a = 0; a < 2; ++a) {
                            union { uint2 h2[2]; bf16x8 v; } vf;
                            vf.h2[0] = *(const uint2*)(Vt + row * 128 + ((((4 * a + (q4 >> 1))) ^ (row & 7)) << 4) + 8 * (q4 & 1));
                            vf.h2[1] = *(const uint2*)(Vt + row * 128 + ((((4 * a + 2 + (q4 >> 1))) ^ (row & 7)) << 4) + 8 * (q4 & 1));
                            vfr[tt * 2 + a] = vf.v; } }
                    asm volatile("" : "+v"(vfr[0]), "+v"(vfr[1]), "+v"(vfr[2]), "+v"(vfr[3]), "+v"(vfr[4]), "+v"(vfr[5]), "+v"(vfr[6]), "+v"(vfr[7]));
#pragma unroll
                    for (int a = 0; a < 2; ++a)
#pragma unroll
                        for (int tt = 0; tt < 4; ++tt) oacc[tg * 4 + tt] = __builtin_amdgcn_mfma_f32_16x16x32_bf16(vfr[tt * 2 + a], pb[a], oacc[tg * 4 + tt], 0, 0, 0);
                }
                if (kt + 1 < nkt) ATT_LSTORE((kt + 1) & 1);
                __syncthreads();
            }
            lsum = xor32_sum(xor16_sum(lsum));
            const float inv = 1.f / lsum;
#pragma unroll
            for (int t = 0; t < 8; ++t) *(uint2*)(OB + (size_t)tq * 1024 + 512 + h * 128 + 16 * t + 4 * q4) = pack4(oacc[t] * inv);
        }
    }
}

PHASE_FN void ph_gdn_out(const Params& p, int layer) {
    KParams* pp = kparams();
    GU8* wsg_ = (GU8*)pp->ws; asm volatile("" : "+s"(wsg_)); unsigned char* ws_ = (unsigned char*)wsg_;
    int tid_ = threadIdx.x; asm volatile("" : "+v"(tid_)); const int tid = tid_, lane = tid & 63, wv = tid >> 6;
    const float* O = (const float*)(ws_ + OFF_O); const bf16_t* P = (const bf16_t*)(ws_ + OFF_P); bf16_t* OB = (bf16_t*)(ws_ + OFF_OB);
    const float* onw = as_global(pp->gdn_out_norm) + (layer >> 1) * 128;
    for (int t = blockIdx.x * 8 + wv; t < NT; t += gridDim.x * 8) {
#pragma unroll
        for (int h = 0; h < 4; ++h) {
            const float* op = O + (size_t)t * 1024 + h * 128; bf16_t* ob = OB + (size_t)t * 1024 + h * 128;
            const float o0 = op[lane], o1 = op[64 + lane];
            const float ss = wave_sum(o0 * o0 + o1 * o1);
            const float r = rsqrtf(ss * (1.f / 128.f) + EPS);
            const float z0 = PBF(P, t, 1536 + h * 128 + lane), z1 = PBF(P, t, 1536 + h * 128 + 64 + lane);
            ob[lane] = f2bf(o0 * r * onw[lane] * siluf_(z0)); ob[64 + lane] = f2bf(o1 * r * onw[64 + lane] * siluf_(z1));
        }
    }
}

struct EpiOut {
    static constexpr bool PERM = false;
    const float* Xres; float* X; const float* gt0;
    __device__ __forceinline__ void operator()(const f32x4 (&acc)[2][2][4][2], const pg8::Unit& u, int wr, int wc, int fr, int fq) const {
        const int row0 = u.pm * 256 + wr * 64 + fr, col0 = u.pn * 256 + wc * 32 + 4 * fq;
        const float* gt = gt0 + (size_t)(row0 >> 13) * 6144 + col0;
        f32x4 gv[2][2];
#pragma unroll
        for (int bj = 0; bj < 2; ++bj)
#pragma unroll
            for (int n = 0; n < 2; ++n) gv[bj][n] = *(const f32x4*)(gt + bj * 128 + n * 16);
#pragma unroll
        for (int ai = 0; ai < 2; ++ai)
#pragma unroll
            for (int m = 0; m < 4; ++m) { const size_t off = (size_t)(row0 + ai * 128 + m * 16) * ND + col0;
#pragma unroll
                for (int bj = 0; bj < 2; ++bj)
#pragma unroll
                    for (int n = 0; n < 2; ++n) *(f32x4*)(X + off + bj * 128 + n * 16) = *(const f32x4*)(Xres + off + bj * 128 + n * 16) + gv[bj][n] * acc[ai][bj][m][n]; }
    }
};

PHASE_FN void ph_gemm_out(const Params& p, int layer, float* smem) {
    KParams* pp = kparams();
    GU8* wsg_ = (GU8*)pp->ws; asm volatile("" : "+s"(wsg_)); unsigned char* ws_ = (unsigned char*)wsg_;
    int ldz_ = 0; asm volatile("" : "+s"(ldz_));
    const bf16_t* Wt = (const bf16_t*)(ws_ + OFF_WOUT) + (size_t)layer * 1024 * 1024;
    EpiOut E; E.Xres = (layer == 0) ? as_global(pp->x) : (const float*)as_global(pp->X); E.X = as_global(pp->X); E.gt0 = (const float*)(ws_ + OFF_MOD) + (size_t)(layer * 2) * 6144 + 2048;
    pg8::DenseOrder S; S.init(64, 4, gridDim.x, blockIdx.x, 1024);
    __syncthreads();
    pg8::gemm_phase<EpiOut, pg8::DenseOrder, false>((LAS unsigned char*)(g_smem + ldz_), (const bf16_t*)(ws_ + OFF_OB), Wt, 1024, S, E);
    __syncthreads();
}

PHASE_FN void ph_norm_ffn(const Params& p, int layer) {
    KParams* pp = kparams();
    GU8* wsg_ = (GU8*)pp->ws; asm volatile("" : "+s"(wsg_)); unsigned char* ws_ = (unsigned char*)wsg_;
    int tid_ = threadIdx.x; asm volatile("" : "+v"(tid_)); const int tid = tid_, lane = tid & 63, wv = tid >> 6;
    const float* MOD = (const float*)(ws_ + OFF_MOD);
    bf16_t* H = (bf16_t*)(ws_ + OFF_H);
    int* CNT = (int*)(ws_ + OFF_CNT) + layer * 32 * CSTR;
    int* sCnt = (int*)g_smem; int* sBase = sCnt + 32; int* sE = sBase + 32; int* sR = sE + 256;
    const int nrb = (NT + (int)gridDim.x - 1) / (int)gridDim.x, row_lo = blockIdx.x * nrb, row_hi = (row_lo + nrb < NT) ? row_lo + nrb : NT;
    __syncthreads();
    if (tid < 32) sCnt[tid] = 0;
    __syncthreads();
    int* ASG = (int*)(ws_ + OFF_ASG); float* GATE = (float*)(ws_ + OFF_GATE); int* LIST = (int*)(ws_ + OFF_LIST);
    const float* nw = as_global(pp->norm_ffn) + layer * 1024;
    const float* wg = as_global(pp->rg_w) + (size_t)layer * 1024 * 4;
    float4* sW = (float4*)(g_smem + 2560);
    float4* sNA = (float4*)(g_smem + 2560 + 147456); float4* sNB = sNA + 256;
    float* sBias = (float*)(sNB + 256);
    { const float* weL = as_global(pp->re_w) + (size_t)(layer * 4) * 1024 * 8;
      for (int idx = tid; idx < 144 * 64; idx += NTHREADS) { const int slot = idx >> 6, ln = idx & 63;
          if (slot < 16) { const int col = (slot >> 2) * 256 + ln * 4 + (slot & 3); sW[idx] = *(const float4*)(wg + (size_t)col * 4); }
          else { const int s2 = slot - 16, gx = s2 >> 5, r = s2 & 31, col = (r >> 3) * 256 + ln * 4 + ((r >> 1) & 3);
                 sW[idx] = *(const float4*)(weL + ((size_t)gx * 1024 + col) * 8 + (r & 1) * 4); } } }
    { const int b0 = row_lo >> 13;
      const float* sh0 = MOD + (size_t)(layer * 2 + b0) * 6144 + 3072; const float* sc0 = sh0 + 1024;
      if (tid < 256) { const int col = (tid >> 6) * 256 + (tid & 63) * 4;
          const float4 w = *(const float4*)(nw + col), s4 = *(const float4*)(sc0 + col);
          sNA[tid] = make_float4(w.x * (1.f + s4.x), w.y * (1.f + s4.y), w.z * (1.f + s4.z), w.w * (1.f + s4.w)); sNB[tid] = *(const float4*)(sh0 + col); }
      if (tid < 4) sBias[tid] = as_global(pp->rg_b)[layer * 4 + tid];
      if (tid >= 64 && tid < 96) sBias[4 + tid - 64] = as_global(pp->re_b)[layer * 32 + tid - 64]; }
    __syncthreads();
    float4 nx0 = make_float4(0.f, 0.f, 0.f, 0.f), nx1 = nx0, nx2 = nx0, nx3 = nx0;
    if (row_lo + wv < row_hi) { const float* xr = as_global(pp->X) + (size_t)(row_lo + wv) * ND + lane * 4;
        nx0 = *(const float4*)xr; nx1 = *(const float4*)(xr + 256); nx2 = *(const float4*)(xr + 512); nx3 = *(const float4*)(xr + 768); }
    for (int row = row_lo + wv; row < row_hi; row += 8) {
        float hv[16]; float ss = 0.f;
        hv[0] = nx0.x; hv[1] = nx0.y; hv[2] = nx0.z; hv[3] = nx0.w; hv[4] = nx1.x; hv[5] = nx1.y; hv[6] = nx1.z; hv[7] = nx1.w;
        hv[8] = nx2.x; hv[9] = nx2.y; hv[10] = nx2.z; hv[11] = nx2.w; hv[12] = nx3.x; hv[13] = nx3.y; hv[14] = nx3.z; hv[15] = nx3.w;
        if (row + 8 < row_hi) { const float* xr = as_global(pp->X) + (size_t)(row + 8) * ND + lane * 4;
            nx0 = *(const float4*)xr; nx1 = *(const float4*)(xr + 256); nx2 = *(const float4*)(xr + 512); nx3 = *(const float4*)(xr + 768); }
#pragma unroll
        for (int j = 0; j < 16; ++j) ss += hv[j] * hv[j];
        ss = wave_sum(ss);
        const float rstd = rsqrtf(ss * (1.f / 1024.f) + EPS);
#pragma unroll
        for (int j = 0; j < 4; ++j) {
            const int col = j * 256 + lane * 4;
            const float4 wa = sNA[j * 64 + lane], h4 = sNB[j * 64 + lane];
            hv[4 * j] = hv[4 * j] * rstd * wa.x + h4.x; hv[4 * j + 1] = hv[4 * j + 1] * rstd * wa.y + h4.y;
            hv[4 * j + 2] = hv[4 * j + 2] * rstd * wa.z + h4.z; hv[4 * j + 3] = hv[4 * j + 3] * rstd * wa.w + h4.w;
            { f32x4 ov; ov[0] = hv[4 * j]; ov[1] = hv[4 * j + 1]; ov[2] = hv[4 * j + 2]; ov[3] = hv[4 * j + 3]; *(uint2*)(H + (size_t)row * ND + col) = pack4(ov); }
        }
        float gl[4] = {0.f, 0.f, 0.f, 0.f};
#pragma unroll
        for (int j = 0; j < 4; ++j)
#pragma unroll
            for (int e = 0; e < 4; ++e) { const float4 w = sW[(j * 4 + e) * 64 + lane]; const float hh = hv[4 * j + e];
                gl[0] += hh * w.x; gl[1] += hh * w.y; gl[2] += hh * w.z; gl[3] += hh * w.w; }
#pragma unroll
        for (int g = 0; g < 4; ++g) gl[g] = wave_sum(gl[g]) + sBias[g];
        int gs = 0; float gm = gl[0];
#pragma unroll
        for (int g = 1; g < 4; ++g) if (gl[g] > gm) { gm = gl[g]; gs = g; }
        float gsum = 0.f;
#pragma unroll
        for (int g = 0; g < 4; ++g) gsum += expf(gl[g] - gm);
        const float ggate = 1.f / gsum;
        const float4* we4 = sW + (16 + gs * 32) * 64 + lane;
        float el[8] = {0.f, 0.f, 0.f, 0.f, 0.f, 0.f, 0.f, 0.f};
#pragma unroll
        for (int j = 0; j < 4; ++j)
#pragma unroll
            for (int e = 0; e < 4; ++e) { const float4 w0 = we4[((j * 4 + e) * 2) * 64], w1 = we4[((j * 4 + e) * 2 + 1) * 64]; const float hh = hv[4 * j + e];
                el[0] += hh * w0.x; el[1] += hh * w0.y; el[2] += hh * w0.z; el[3] += hh * w0.w; el[4] += hh * w1.x; el[5] += hh * w1.y; el[6] += hh * w1.z; el[7] += hh * w1.w; }
#pragma unroll
        for (int e = 0; e < 8; ++e) el[e] = wave_sum(el[e]) + sBias[4 + gs * 8 + e];
        int i1 = 0; float l1 = el[0];
#pragma unroll
        for (int e = 1; e < 8; ++e) if (el[e] > l1) { l1 = el[e]; i1 = e; }
        int i2 = -1; float l2 = -INFINITY;
#pragma unroll
        for (int e = 0; e < 8; ++e) if (e != i1 && el[e] > l2) { l2 = el[e]; i2 = e; }
        const float ex = expf(l2 - l1);
        const float p1 = 1.f / (1.f + ex), p2 = ex / (1.f + ex);
        if (lane == 0) {
            const int e1 = gs * 8 + i1, e2 = gs * 8 + i2, lr = row - row_lo;
            sE[lr * 2] = e1; sE[lr * 2 + 1] = e2;
            sR[lr * 2] = atomicAdd(&sCnt[e1], 1); sR[lr * 2 + 1] = atomicAdd(&sCnt[e2], 1);
            GATE[row * 2] = ggate * p1; GATE[row * 2 + 1] = ggate * p2;
        }
    }
    __syncthreads();
    if (tid < 32) sBase[tid] = (sCnt[tid] > 0) ? atomicAdd(&CNT[tid * CSTR], sCnt[tid]) : 0;
    __syncthreads();
    for (int a = tid; a < (row_hi - row_lo) * 2; a += NTHREADS) {
        const int row = row_lo + (a >> 1), e = sE[a], r = sBase[e] + sR[a];
        LIST[(size_t)e * LISTCAP + r] = row;
        ASG[row * 4 + (a & 1) * 2] = e; ASG[row * 4 + (a & 1) * 2 + 1] = r;
    }
}

struct MoeOrder {
    const int* sTs; const int* sPad; const int* CNT; const int* LIST; int G, c, which, K;
    __device__ __forceinline__ bool next(int i, pg8::Unit& u) const {
        const long L = (long)i * G + c; if (L >= (long)__builtin_amdgcn_readfirstlane(sTs[32]) * 4) return false;
        const int mt = (int)(L >> 2), nt = (int)(L & 3);
        int e = 0;
        for (int q = 1; q < 32; ++q) if (__builtin_amdgcn_readfirstlane(sTs[q]) <= mt) e = q;
        const int mi = mt - __builtin_amdgcn_readfirstlane(sTs[e]), cnt = __builtin_amdgcn_readfirstlane(CNT[e * CSTR]);
        u.pm = mt; u.pn = nt; u.e = e; u.mi = mi; u.mvalid = (cnt - mi * 256 < 256) ? (cnt - mi * 256) : 256; u.rowbase = __builtin_amdgcn_readfirstlane(sPad[e]) + mi * 256;
        u.boff = ((size_t)e * 1024 + nt * 256) * K * 2;
        u.aoff = which ? (size_t)u.rowbase * 512 * 2 : 0;
        return true;
    }
    __device__ __forceinline__ int row(const pg8::Unit& u, int r) const { const int rr = (r < u.mvalid) ? r : 0; return LIST[(size_t)u.e * LISTCAP + u.mi * 256 + rr]; }
};
struct EpiMoe1 {
    static constexpr bool PERM = false;
    bf16_t* HID;
    __device__ __forceinline__ void operator()(const f32x4 (&acc)[2][2][4][2], const pg8::Unit& u, int wr, int wc, int fr, int fq) const {
#pragma unroll
        for (int ai = 0; ai < 2; ++ai)
#pragma unroll
            for (int m = 0; m < 4; ++m) { const int rl = ai * 128 + wr * 64 + m * 16 + fr;
                if (rl < u.mvalid) {
#pragma unroll
                    for (int bj = 0; bj < 2; ++bj) { const f32x4 a1 = acc[ai][bj][m][0], a3 = acc[ai][bj][m][1]; f32x4 hv;
                        hv[0] = silu_fast(a1[0]) * a3[0]; hv[1] = silu_fast(a1[1]) * a3[1]; hv[2] = silu_fast(a1[2]) * a3[2]; hv[3] = silu_fast(a1[3]) * a3[3];
                        *(uint2*)(HID + (size_t)(u.rowbase + rl) * 512 + u.pn * 128 + bj * 64 + wc * 16 + 4 * fq) = pack4(hv); } } }
    }
};
struct EpiMoe2 {
    static constexpr bool PERM = true;
    bf16_t* YB;
    __device__ __forceinline__ void operator()(const f32x4 (&acc)[2][2][4][2], const pg8::Unit& u, int wr, int wc, int fr, int fq) const {
#pragma unroll
        for (int ai = 0; ai < 2; ++ai)
#pragma unroll
            for (int m = 0; m < 4; ++m) { const int rl = ai * 128 + wr * 64 + m * 16 + fr;
                if (rl < u.mvalid) {
#pragma unroll
                    for (int bj = 0; bj < 2; ++bj) { const uint2 lo = pack4(acc[ai][bj][m][0]), hi = pack4(acc[ai][bj][m][1]);
                        *(uint4*)(YB + (size_t)(u.rowbase + rl) * 1024 + u.pn * 256 + bj * 128 + wc * 32 + 8 * fq) = make_uint4(lo.x, lo.y, hi.x, hi.y); } } }
    }
};

PHASE_FN void ph_moe(const Params& p, int layer, int which, float* smem) {
    KParams* pp = kparams();
    GU8* wsg_ = (GU8*)pp->ws; asm volatile("" : "+s"(wsg_)); unsigned char* ws_ = (unsigned char*)wsg_;
    int ldz_ = 0; asm volatile("" : "+s"(ldz_));
    int tid_ = threadIdx.x; asm volatile("" : "+v"(tid_)); const int tid = tid_;
    int* sPad = (int*)(g_smem + ldz_ + 131072); int* sTs = sPad + 40;
    const int* CNT = (const int*)(ws_ + OFF_CNT) + layer * 32 * CSTR;
    __syncthreads();
    if (tid == 0) { int a = 0, ts = 0; for (int e = 0; e < 32; ++e) { sPad[e] = a; sTs[e] = ts; a += ((CNT[e * CSTR] + 127) / 128) * 128; ts += (CNT[e * CSTR] + 255) / 256; } sTs[32] = ts; sPad[32] = a; }
    __syncthreads();
    MoeOrder S; S.sTs = sTs; S.sPad = sPad; S.CNT = CNT; S.LIST = (const int*)(ws_ + OFF_LIST); S.G = gridDim.x; S.which = which; S.K = which ? 512 : 1024;
    S.c = (((int)gridDim.x & 7) == 0) ? (((int)blockIdx.x & 7) * ((int)gridDim.x >> 3) + ((int)blockIdx.x >> 3)) : (int)blockIdx.x;
    if (which == 0) {
        EpiMoe1 E; E.HID = (bf16_t*)(ws_ + OFF_HID);
        pg8::gemm_phase<EpiMoe1, MoeOrder, true>((LAS unsigned char*)(g_smem + ldz_), (const bf16_t*)(ws_ + OFF_H), (const bf16_t*)(ws_ + OFF_W13), 1024, S, E);
    } else {
        EpiMoe2 E; E.YB = (bf16_t*)(ws_ + OFF_YB);
        pg8::gemm_phase<EpiMoe2, MoeOrder, false>((LAS unsigned char*)(g_smem + ldz_), (const bf16_t*)(ws_ + OFF_HID), (const bf16_t*)(ws_ + OFF_W2T), 512, S, E);
    }
    __syncthreads();
}

PHASE_FN void ph_conv_dense(const Params& p, float* smem) {
    KParams* pp = kparams();
    GU8* wsg_ = (GU8*)pp->ws; asm volatile("" : "+s"(wsg_)); unsigned char* ws_ = (unsigned char*)wsg_;
    { int ldz_ = 0; asm volatile("" : "+s"(ldz_)); smem = (float*)(g_smem + ldz_); }
    auto dec = [&](int t, const float*& s0, const float*& s1, bf16_t*& dst, int& mode, int& K, int& N, int& ld, int& rt, int& kt) {
        s1 = nullptr; mode = 0; K = 1024;
        if (t >= 4672) t = 4671;
        if (t >= 4608) { const int v = t - 4608, l = v >> 5, u = v & 31; s0 = as_global(pp->gla_w_in) + (size_t)l * 1024 * 3088 + 3072; N = 16; ld = 3088; dst = (bf16_t*)(ws_ + OFF_WGL) + (size_t)l * 128 * 1024; rt = u >> 4; kt = u & 15; }
        else if (t < 2048) { const int l = t >> 10, u = t & 1023; s0 = as_global(pp->even_w_in) + (size_t)l * 1024 * 3916; N = 3916; ld = 3916; dst = (bf16_t*)(ws_ + OFF_WINE) + (size_t)l * 4096 * 1024; rt = u >> 4; kt = u & 15; }
        else if (t < 3584) { const int v = t - 2048, l = v / 768, u = v % 768; s0 = as_global(pp->gla_w_in) + (size_t)l * 1024 * 3088; N = 3072; ld = 3088; dst = (bf16_t*)(ws_ + OFF_WINO) + (size_t)l * 3072 * 1024; rt = u >> 4; kt = u & 15; }
        else { const int v = t - 3584, l = v >> 8, u = v & 255; s0 = ((l & 1) ? as_global(pp->gla_w_out) : as_global(pp->even_w_out)) + (size_t)(l >> 1) * 1024 * 1024; N = 1024; ld = 1024; dst = (bf16_t*)(ws_ + OFF_WOUT) + (size_t)l * 1024 * 1024; rt = u >> 4; kt = u & 15; }
    };
    convert_stream(dec, blockIdx.x * 4, gridDim.x * 4, 4672, smem);
}

PHASE_FN void ph_conv_exp(const Params& p, int layer, float* smem, int first_blk) {
    KParams* pp = kparams();
    GU8* wsg_ = (GU8*)pp->ws; asm volatile("" : "+s"(wsg_)); unsigned char* ws_ = (unsigned char*)wsg_;
    { int ldz_ = 0; asm volatile("" : "+s"(ldz_)); smem = (float*)(g_smem + ldz_); }
    if ((int)blockIdx.x < first_blk) return;
    auto dec = [&](int t, const float*& s0, const float*& s1, bf16_t*& dst, int& mode, int& K, int& N, int& ld, int& rt, int& kt) {
        if (t >= 12288) t = 12287;
        if (t < 8192) { const int e = t >> 8, u = t & 255; s0 = as_global(pp->w1) + (size_t)(layer * 32 + e) * 1024 * 512; s1 = as_global(pp->w3) + (size_t)(layer * 32 + e) * 1024 * 512; mode = 1; K = 1024; N = 512; ld = 512;
            dst = (bf16_t*)(ws_ + OFF_W13) + (size_t)e * 1024 * 1024; rt = u >> 4; kt = u & 15; }
        else { const int v = t - 8192, e = v >> 7, u = v & 127; s0 = as_global(pp->w2) + (size_t)(layer * 32 + e) * 512 * 1024; s1 = nullptr; mode = 0; K = 512; N = 1024; ld = 1024;
            dst = (bf16_t*)(ws_ + OFF_W2T) + (size_t)e * 1024 * 512; rt = u >> 3; kt = u & 7; }
    };
    convert_stream(dec, ((int)blockIdx.x - first_blk) * 4, ((int)gridDim.x - first_blk) * 4, 12288, smem);
}

PHASE_FN void ph_gla_tok(const Params& p, int layer) {
    KParams* pp = kparams();
    GU8* wsg_ = (GU8*)pp->ws; asm volatile("" : "+s"(wsg_)); unsigned char* ws_ = (unsigned char*)wsg_;
    int tid_ = threadIdx.x; asm volatile("" : "+v"(tid_)); const int tid = tid_, lane = tid & 63, wv = tid >> 6, li = layer >> 1;
    const float* AUX = (const float*)(ws_ + OFF_AUX);
    float* LA = (float*)(ws_ + OFF_LA);
    const float* w2 = as_global(pp->gla_w_gate2) + (size_t)li * 16 * 512; const float* b2 = as_global(pp->gla_b_gate2) + li * 512;
    for (int t = blockIdx.x * 8 + wv; t < NT; t += gridDim.x * 8) {
        float glr[16];
#pragma unroll
        for (int r = 0; r < 16; ++r) glr[r] = AUX[(size_t)t * 16 + r];
#pragma unroll 1
        for (int i = 0; i < 8; ++i) {
            const int c = lane + 64 * i; float z = b2[c];
#pragma unroll
            for (int r = 0; r < 16; ++r) z += glr[r] * w2[r * 512 + c];
            LA[(size_t)t * 512 + c] = -softplusf_(-z) * (1.f / 16.f);
        }
    }
}

PHASE_FN void ph_gla_chunk(const Params& p, int layer, float* smem) {
    KParams* pp = kparams();
    GU8* wsg_ = (GU8*)pp->ws; asm volatile("" : "+s"(wsg_)); unsigned char* ws_ = (unsigned char*)wsg_;
    int tid_ = threadIdx.x; asm volatile("" : "+v"(tid_)); const int tid = tid_, lane = tid & 63, wv = __builtin_amdgcn_readfirstlane(tid >> 6), q4 = lane >> 4, c16 = lane & 15;
    int ldz_ = 0; asm volatile("" : "+s"(ldz_)); unsigned char* lds = g_smem + ldz_;
    constexpr int SN = 272, ST = 144;
    float* sBc = (float*)lds;
    unsigned char* bQE = lds + 33024;
    unsigned char* bKE = lds + 50432;
    unsigned char* bKD = lds + 67840;
    unsigned char* bVT = lds + 86272;
    unsigned char* bATT = lds + 123136;
    const bf16_t* P = (const bf16_t*)(ws_ + OFF_P); const float* AUX = (const float*)(ws_ + OFF_AUX);
    const float* w2 = as_global(pp->gla_w_gate2) + (size_t)(layer >> 1) * 16 * 512; const float* b2 = as_global(pp->gla_b_gate2) + (layer >> 1) * 512;
    float* sGlr = (float*)(lds + 132352);
    uint4* QEF = (uint4*)(ws_ + OFF_GQE); uint2* OIF = (uint2*)(ws_ + OFF_GOI); uint2* HF = (uint2*)(ws_ + OFF_GH); float* EBL = (float*)(ws_ + OFF_GEBL);
    for (int ci = blockIdx.x; ci < 1024; ci += gridDim.x) {
        const int b = ci >> 9, h = (ci >> 7) & 3, n = ci & 127;
        const int t0 = b * 8192 + n * 64;
        __syncthreads();
        for (int e = tid; e < 1024; e += NTHREADS) sGlr[e] = AUX[(size_t)(t0 + (e >> 4)) * 16 + (e & 15)];
        __syncthreads();
        {
            const int d = tid & 127, c = h * 128 + d;
            float wg[16];
#pragma unroll
            for (int r = 0; r < 16; ++r) wg[r] = w2[r * 512 + c];
            const float bz = b2[c];
            for (int i = tid >> 7; i < 64; i += 4) {
                float z = bz;
#pragma unroll
                for (int r = 0; r < 16; ++r) z += sGlr[i * 16 + r] * wg[r];
                sBc[i * 129 + d] = -softplusf_(-z) * (1.f / 16.f);
            }
        }
        for (int e = tid; e < 64 * 36; e += NTHREADS) ((unsigned*)bATT)[e] = 0u;
        __syncthreads();
        if (tid < 128) { float a = 0.f; for (int i = 0; i < 64; ++i) { a += sBc[i * 129 + tid]; sBc[i * 129 + tid] = a; } }
        __syncthreads();
        {
            const int d = tid & 127, ig = tid >> 7;
            const float bl = sBc[63 * 129 + d];
#pragma unroll
            for (int gg = 0; gg < 2; ++gg) { const int g = ig + 4 * gg;
                float kd8[8];
#pragma unroll
                for (int r = 0; r < 8; ++r) { const int i = g * 8 + r;
                    const float bb = sBc[i * 129 + d];
                    const float qf = PBF(P, t0 + i, h * 128 + d), kf = PBF(P, t0 + i, 512 + h * 128 + d);
                    *(bf16_t*)(bQE + i * SN + d * 2) = f2bf(qf * SCALE128 * expf(bb));
                    *(bf16_t*)(bKE + i * SN + d * 2) = f2bf(kf * expf(-bb));
                    kd8[r] = kf * expf(bl - bb); }
                *(uint4*)(bKD + d * ST + g * 16) = make_uint4(cvt_pk_bf16(kd8[0], kd8[1]), cvt_pk_bf16(kd8[2], kd8[3]), cvt_pk_bf16(kd8[4], kd8[5]), cvt_pk_bf16(kd8[6], kd8[7]));
            }
            const int dv = tid & 255, hf = tid >> 8;
#pragma unroll
            for (int gg = 0; gg < 4; ++gg) { const int g = hf * 4 + gg;
                unsigned short v8[8];
#pragma unroll
                for (int r = 0; r < 8; ++r) v8[r] = P[(size_t)(t0 + g * 8 + r) * LDPB + 1024 + h * 256 + dv];
                *(uint4*)(bVT + dv * ST + g * 16) = make_uint4((unsigned)v8[0] | ((unsigned)v8[1] << 16), (unsigned)v8[2] | ((unsigned)v8[3] << 16), (unsigned)v8[4] | ((unsigned)v8[5] << 16), (unsigned)v8[6] | ((unsigned)v8[7] << 16));
            }
        }
        if (tid < 128) EBL[ci * 128 + tid] = expf(sBc[63 * 129 + tid]);
        __syncthreads();
        for (int u = wv; u < 10; u += 8) {
            const int ti = (u >= 6) ? 3 : (u >= 3) ? 2 : (u >= 1) ? 1 : 0, tj = u - ((ti * (ti + 1)) >> 1);
            f32x4 acc = (f32x4){0.f, 0.f, 0.f, 0.f};
            acc = mma_lds(bQE, SN, 16 * ti, bKE, SN, 16 * tj, 128, acc, c16, q4);
            const int j = 16 * tj + c16;
#pragma unroll
            for (int r = 0; r < 4; ++r) { const int i = 16 * ti + 4 * q4 + r; *(bf16_t*)(bATT + i * ST + j * 2) = f2bf((j <= i) ? acc[r] : 0.f); }
        }
        for (int x = 0; x < 2; ++x) {
            const int u = wv * 2 + x, ti = u >> 2, a = u & 3;
            const unsigned char* rp = bQE + (16 * ti + c16) * SN;
            const uint2 lo = *(const uint2*)(rp + (32 * a + 4 * q4) * 2), hi = *(const uint2*)(rp + (32 * a + 16 + 4 * q4) * 2);
            QEF[((size_t)(ci * 4 + ti) * 4 + a) * 64 + lane] = make_uint4(lo.x, lo.y, hi.x, hi.y);
        }
        __syncthreads();
#pragma unroll 4
        for (int x = 0; x < 8; ++x) {
            const int u = wv * 8 + x, tdv = u >> 2, ti = u & 3;
            f32x4 acc = (f32x4){0.f, 0.f, 0.f, 0.f};
            acc = mma_lds(bATT, ST, 16 * ti, bVT, ST, 16 * tdv, 64, acc, c16, q4);
            OIF[((size_t)(ci * 16 + tdv) * 4 + ti) * 64 + lane] = pack4(acc);
        }
#pragma unroll 4
        for (int x = 0; x < 16; ++x) {
            const int u = wv * 16 + x, tdv = u >> 3, tdk = u & 7;
            f32x4 acc = (f32x4){0.f, 0.f, 0.f, 0.f};
            acc = mma_lds(bKD, ST, 16 * tdk, bVT, ST, 16 * tdv, 64, acc, c16, q4);
            HF[((size_t)(ci * 16 + tdv) * 8 + tdk) * 64 + lane] = pack4(acc);
        }
    }
}

PHASE_FN void ph_gla_scan(const Params& p, float* smem) {
    KParams* pp = kparams();
    GU8* wsg_ = (GU8*)pp->ws; asm volatile("" : "+s"(wsg_)); unsigned char* ws_ = (unsigned char*)wsg_;
    int tid_ = threadIdx.x; asm volatile("" : "+v"(tid_)); const int tid = tid_, lane = tid & 63, wv = __builtin_amdgcn_readfirstlane(tid >> 6), q4 = lane >> 4, c16 = lane & 15;
    int ldz_ = 0; asm volatile("" : "+s"(ldz_)); unsigned char* lds = g_smem + ldz_;
    constexpr int STG = 29184;
    const unsigned char* QEF = ws_ + OFF_GQE; const unsigned char* HF = ws_ + OFF_GH; const unsigned char* OIF = ws_ + OFF_GOI; const unsigned char* EBL = ws_ + OFF_GEBL;
    float* O = (float*)(ws_ + OFF_O);
    for (int it = blockIdx.x; it < 64; it += gridDim.x) {
        const int bh = it >> 3, pair = it & 7, b = bh >> 2, h = bh & 3;
        __syncthreads();
        if (wv >= 2) {
            const int lt = tid - 128;
            const unsigned char* Qb = QEF + (size_t)bh * 128 * 16384;
            const unsigned char* Hb = HF + (size_t)bh * 128 * 65536 + pair * 8192;
            const unsigned char* Ob = OIF + (size_t)bh * 128 * 32768 + pair * 4096;
            const unsigned char* Lb = EBL + (size_t)bh * 128 * 512;
            uint4 ra0, ra1, ra2, ra3, ra4, ra5, ra6, rb0, rb1, rb2, rb3, rb4, rb5, rb6, rc0, rc1, rc2, rc3, rc4, rc5, rc6, rd0, rd1, rd2, rd3, rd4, rd5, rd6;
#define GL_LOAD(X, n_) do { const unsigned char* q_ = Qb + (size_t)(n_) * 16384; const unsigned char* h_ = Hb + (size_t)(n_) * 65536; \
                const unsigned char* o_ = Ob + (size_t)(n_) * 32768; const unsigned char* l_ = Lb + (size_t)(n_) * 512; \
                X##0 = LDC(q_, lt, 1023); X##1 = LDC(q_, lt + 384, 1023); X##2 = LDC(q_, lt + 768, 1023); \
                X##3 = LDC(h_, lt, 511); X##4 = LDC(h_, lt + 384, 511); X##5 = LDC(o_, lt, 255); X##6 = LDC(l_, lt, 31); } while (0)
#define GL_STORE(X, st_) do { unsigned char* sb_ = lds + (st_) * STG; \
                STC(0, lt, 1024, X##0); STC(0, lt + 384, 1024, X##1); STC(0, lt + 768, 1024, X##2); \
                STC(16384, lt, 512, X##3); STC(16384, lt + 384, 512, X##4); STC(24576, lt, 256, X##5); STC(28672, lt, 32, X##6); } while (0)
            GL_LOAD(ra, 0); GL_STORE(ra, 0);
            GL_LOAD(rb, 1); GL_LOAD(rc, 2); GL_LOAD(rd, 3); GL_LOAD(ra, 4);
            __syncthreads();
            for (int n = 0; n < 128; n += 4) {
                GL_STORE(rb, 1); GL_LOAD(rb, CLAMPN(n + 5)); LBAR();
                GL_STORE(rc, 0); GL_LOAD(rc, CLAMPN(n + 6)); LBAR();
                GL_STORE(rd, 1); GL_LOAD(rd, CLAMPN(n + 7)); LBAR();
                if (n + 4 < 128) GL_STORE(ra, 0);
                GL_LOAD(ra, CLAMPN(n + 8)); LBAR();
            }
        } else {
            const int tdv = pair * 2 + wv;
            f32x4 S[8];
#pragma unroll
            for (int t = 0; t < 8; ++t) S[t] = (f32x4){0.f, 0.f, 0.f, 0.f};
            __syncthreads();
            for (int n = 0; n < 128; ++n) {
                const unsigned char* base = lds + (n & 1) * STG;
                const unsigned char* Qf = base + lane * 16, *Hf = base + 16384 + wv * 4096 + lane * 8, *Of = base + 24576 + wv * 2048 + lane * 8, *Lf = base + 28672 + q4 * 16;
                bf16x8 Sb[4];
#pragma unroll
                for (int a = 0; a < 4; ++a) { union { uint4 u; bf16x8 v; } cv; const uint2 lo = pack4(S[2 * a]), hi = pack4(S[2 * a + 1]); cv.u.x = lo.x; cv.u.y = lo.y; cv.u.z = hi.x; cv.u.w = hi.y; Sb[a] = cv.v; }
                const int t0 = b * 8192 + n * 64;
                f32x4 oa[4];
                uint2 o4[4];
#pragma unroll
                for (int ti = 0; ti < 4; ++ti) o4[ti] = *(const uint2*)(Of + ti * 512);
#pragma unroll
                for (int hf = 0; hf < 2; ++hf) {
                    bf16x8 qf[8];
#pragma unroll
                    for (int tt = 0; tt < 2; ++tt)
#pragma unroll
                        for (int a = 0; a < 4; ++a) qf[tt * 4 + a] = *(const bf16x8*)(Qf + ((hf * 2 + tt) * 4 + a) * 1024);
                    asm volatile("" : "+v"(qf[0]), "+v"(qf[1]), "+v"(qf[2]), "+v"(qf[3]), "+v"(qf[4]), "+v"(qf[5]), "+v"(qf[6]), "+v"(qf[7]));
                    oa[hf * 2] = unpack4(o4[hf * 2]); oa[hf * 2 + 1] = unpack4(o4[hf * 2 + 1]);
#pragma unroll
                    for (int a = 0; a < 4; ++a)
#pragma unroll
                        for (int tt = 0; tt < 2; ++tt) oa[hf * 2 + tt] = __builtin_amdgcn_mfma_f32_16x16x32_bf16(qf[tt * 4 + a], Sb[a], oa[hf * 2 + tt], 0, 0, 0);
                }
                {
                    f32x4 lam[8]; uint2 h8[8];
#pragma unroll
                    for (int t = 0; t < 8; ++t) { lam[t] = *(const f32x4*)(Lf + t * 64); h8[t] = *(const uint2*)(Hf + t * 512); }
                    asm volatile("" : "+v"(lam[0]), "+v"(lam[1]), "+v"(lam[2]), "+v"(lam[3]), "+v"(lam[4]), "+v"(lam[5]), "+v"(lam[6]), "+v"(lam[7]));
#pragma unroll
                    for (int ti = 0; ti < 4; ++ti) {
                        float* op = O + (size_t)(t0 + 16 * ti + 4 * q4) * 1024 + h * 256 + 16 * tdv + c16;
                        op[0] = oa[ti][0]; op[1024] = oa[ti][1]; op[2048] = oa[ti][2]; op[3072] = oa[ti][3]; }
#pragma unroll
                    for (int t = 0; t < 8; ++t) S[t] = S[t] * lam[t] + unpack4(h8[t]);
                }
                LBAR();
            }
        }
    }
}

PHASE_FN void ph_gla_out(const Params& p, int layer) {
    KParams* pp = kparams();
    GU8* wsg_ = (GU8*)pp->ws; asm volatile("" : "+s"(wsg_)); unsigned char* ws_ = (unsigned char*)wsg_;
    int tid_ = threadIdx.x; asm volatile("" : "+v"(tid_)); const int tid = tid_, lane = tid & 63, wv = tid >> 6;
    const float* O = (const float*)(ws_ + OFF_O); const bf16_t* P = (const bf16_t*)(ws_ + OFF_P); bf16_t* OB = (bf16_t*)(ws_ + OFF_OB);
    const float* onw = as_global(pp->gla_out_norm) + (layer >> 1) * 256;
    for (int t = blockIdx.x * 8 + wv; t < NT; t += gridDim.x * 8) {
#pragma unroll
        for (int h = 0; h < 4; ++h) {
            const float* op = O + (size_t)t * 1024 + h * 256;
            const float4 o = *(const float4*)(op + lane * 4);
            const float ss = wave_sum(o.x * o.x + o.y * o.y + o.z * o.z + o.w * o.w);
            const float r = rsqrtf(ss * (1.f / 256.f) + EPS);
            const f32x4 z = unpack4(*(const uint2*)(P + (size_t)t * LDPB + 2048 + h * 256 + lane * 4));
            const float4 w = *(const float4*)(onw + lane * 4);
            f32x4 ov; ov[0] = o.x * r * w.x * siluf_(z[0]); ov[1] = o.y * r * w.y * siluf_(z[1]); ov[2] = o.z * r * w.z * siluf_(z[2]); ov[3] = o.w * r * w.w * siluf_(z[3]);
            *(uint2*)(OB + (size_t)t * 1024 + h * 256 + lane * 4) = pack4(ov);
        }
    }
}

template <int PH>
__device__ __forceinline__ void run_phase(const Params& p, int layer, float* smem) {
    if (PH == PH_PROLOGUE) { ph_prologue(p, smem); ph_conv_dense(p, smem); }
    else if (PH == PH_NORM_MIX) ph_rows(p, layer, 0, smem);
    else if (PH == PH_GEMM_IN_EVEN) ph_gemm_in(p, layer, true, smem);
    else if (PH == PH_EVEN_TOK) { ph_even_tok(p, layer, smem); ph_gdn_chunk(p, layer, smem); if (DUP_MASK & 8192) ph_gdn_chunk(p, layer, smem); if (DUP_MASK & 16384) ph_even_tok(p, layer, smem); }
    else if (PH == PH_GDN_CHUNK) ph_gdn_chunk(p, layer, smem);
    else if (PH == PH_GDN_SCAN) { ph_gdn_scan(p, smem); ph_conv_exp(p, layer, smem, 32); ph_dsa_topk(p, layer, smem); }
    else if (PH == PH_DSA_TOPK) ph_dsa_topk(p, layer, smem);
    else if (PH == PH_DSA_ATTN) { ph_dsa_attn(p, smem); ph_gdn_out(p, layer); if (DUP_MASK & 32768) ph_dsa_attn(p, smem); }
    else if (PH == PH_GDN_OUT) ph_gdn_out(p, layer);
    else if (PH == PH_GEMM_OUT) ph_gemm_out(p, layer, smem);
    else if (PH == PH_NORM_FFN) ph_norm_ffn(p, layer);
    else if (PH == PH_MOE1) ph_moe(p, layer, 0, smem);
    else if (PH == PH_MOE2) ph_moe(p, layer, 1, smem);
    else if (PH == PH_GEMM_IN_ODD) ph_gemm_in(p, layer, false, smem);
    else if (PH == PH_GLA_TOK) ph_gla_tok(p, layer);
    else if (PH == PH_GLA_CHUNK) ph_gla_chunk(p, layer, smem);
    else if (PH == PH_GLA_SCAN) { ph_gla_scan(p, smem); ph_conv_exp(p, layer, smem, 64); if (DUP_MASK & 65536) ph_gla_scan(p, smem); if (DUP_MASK & 131072) ph_conv_exp(p, layer, smem, 64); }
    else if (PH == PH_GLA_OUT) ph_gla_out(p, layer);
    else if (PH == PH_FINAL) ph_rows(p, 0, 1, smem);
}

#if MK_MULTI
template <int PH>
__global__ void __launch_bounds__(NTHREADS, 2) k_phase(Params p, int layer) {
    run_phase<PH>(p, layer, (float*)g_smem);
}
#else
__global__ void __launch_bounds__(NTHREADS, 2) k_mega(Params p) {
    float* smem = (float*)g_smem;
    volatile LAS unsigned* xbw = (volatile LAS unsigned*)(LAS unsigned char*)(g_smem + LDS_BYTES - 16);
    if (threadIdx.x == 0) { xbw[0] = 0u; xbw[1] = 0u; xbw[2] = 0u; xbw[3] = 0u; }
    __syncthreads();
    XcdBarrier bar = xcd_barrier_post((unsigned*)(p.ws + OFF_BAR), xbw);
#define BAR() do { XcdBarrier bb_ = bar; asm volatile("" : "+s"(bb_.x)); { __attribute__((address_space(1))) unsigned* gb_ = (__attribute__((address_space(1))) unsigned*)bb_.bar; asm volatile("" : "+s"(gb_)); bb_.bar = (unsigned*)gb_; } xcd_barrier(bb_); } while (0)
    run_phase<PH_PROLOGUE>(p, 0, smem); BAR(); if (DUP_MASK & 4096) { run_phase<PH_PROLOGUE>(p, 0, smem); BAR(); }
    for (int lp = 0; lp < 2; ++lp) {
        const int le = 2 * lp, lo = 2 * lp + 1;
        run_phase<PH_NORM_MIX>(p, le, smem); BAR();
        run_phase<PH_GEMM_IN_EVEN>(p, le, smem); BAR(); if (DUP_MASK & 1) { run_phase<PH_GEMM_IN_EVEN>(p, le, smem); BAR(); }
        run_phase<PH_EVEN_TOK>(p, le, smem); BAR(); if (DUP_MASK & 2) { run_phase<PH_EVEN_TOK>(p, le, smem); BAR(); }
        run_phase<PH_GDN_SCAN>(p, le, smem); BAR(); if (DUP_MASK & 8) { run_phase<PH_GDN_SCAN>(p, le, smem); BAR(); } if (DUP_MASK & 262144) { run_phase<PH_DSA_TOPK>(p, le + 1, smem); BAR(); }
        run_phase<PH_DSA_ATTN>(p, le, smem); BAR(); if (DUP_MASK & 32) { run_phase<PH_DSA_ATTN>(p, le, smem); BAR(); }
        run_phase<PH_GEMM_OUT>(p, le, smem); BAR();
        run_phase<PH_NORM_FFN>(p, le, smem); BAR();
        run_phase<PH_MOE1>(p, le, smem); BAR(); if (DUP_MASK & 64) { run_phase<PH_MOE1>(p, le, smem); BAR(); }
        run_phase<PH_MOE2>(p, le, smem); BAR(); if (DUP_MASK & 128) { run_phase<PH_MOE2>(p, le, smem); BAR(); }
        run_phase<PH_NORM_MIX>(p, lo, smem); BAR();
        run_phase<PH_GEMM_IN_ODD>(p, lo, smem); BAR(); if (DUP_MASK & 256) { run_phase<PH_GEMM_IN_ODD>(p, lo, smem); BAR(); }
        run_phase<PH_GLA_CHUNK>(p, lo, smem); BAR(); if (DUP_MASK & 1024) { run_phase<PH_GLA_CHUNK>(p, lo, smem); BAR(); }
        run_phase<PH_GLA_SCAN>(p, lo, smem); BAR(); if (DUP_MASK & 2048) { run_phase<PH_GLA_SCAN>(p, lo, smem); BAR(); }
        run_phase<PH_GLA_OUT>(p, lo, smem); BAR();
        run_phase<PH_GEMM_OUT>(p, lo, smem); BAR();
        run_phase<PH_NORM_FFN>(p, lo, smem); BAR();
        run_phase<PH_MOE1>(p, lo, smem); BAR(); if (DUP_MASK & 64) { run_phase<PH_MOE1>(p, lo, smem); BAR(); }
        run_phase<PH_MOE2>(p, lo, smem); BAR(); if (DUP_MASK & 128) { run_phase<PH_MOE2>(p, lo, smem); BAR(); }
    }
    for (int xb = 0; xb < EXTRA_BARS; ++xb) BAR();
    run_phase<PH_FINAL>(p, 0, smem);
}
#endif

}

#if MK_MULTI
template <int PH>
static void launch_phase(const Params& p, int layer, hipStream_t stream) {
    static bool attr_set = false;
    if (!attr_set) { hipFuncSetAttribute((const void*)k_phase<PH>, hipFuncAttributeMaxDynamicSharedMemorySize, (int)LDS_BYTES); attr_set = true; }
    hipLaunchKernelGGL((k_phase<PH>), dim3(256), dim3(NTHREADS), LDS_BYTES, stream, p, layer);
}
#endif

extern "C" void kernel_launch(void* const* d_in, const int* in_sizes, int n_in, void* d_out, int out_size, void* d_ws, size_t ws_size, hipStream_t stream) {
    (void)in_sizes; (void)n_in; (void)out_size;
    if (ws_size < WS_NEEDED) { fprintf(stderr, "workspace too small: %zu < %zu\n", ws_size, (size_t)WS_NEEDED); return; }
    Params p{};
    p.x = (const float*)d_in[0]; p.c = (const float*)d_in[1]; p.pos = (const int*)d_in[2]; p.ada_w = (const float*)d_in[3]; p.ada_b = (const float*)d_in[4];
    p.norm_mix = (const float*)d_in[5]; p.norm_ffn = (const float*)d_in[6]; p.even_w_in = (const float*)d_in[7]; p.conv_w = (const float*)d_in[8];
    p.a_log = (const float*)d_in[9]; p.dt_bias = (const float*)d_in[10]; p.gdn_out_norm = (const float*)d_in[11]; p.even_w_out = (const float*)d_in[12];
    p.gla_w_in = (const float*)d_in[13]; p.gla_w_gate2 = (const float*)d_in[14]; p.gla_b_gate2 = (const float*)d_in[15]; p.gla_out_norm = (const float*)d_in[16]; p.gla_w_out = (const float*)d_in[17];
    p.rg_w = (const float*)d_in[18]; p.rg_b = (const float*)d_in[19]; p.re_w = (const float*)d_in[20]; p.re_b = (const float*)d_in[21];
    p.w1 = (const float*)d_in[22]; p.w3 = (const float*)d_in[23]; p.w2 = (const float*)d_in[24]; p.final_norm = (const float*)d_in[25];
    p.X = (float*)d_out; p.ws = (unsigned char*)d_ws;
    p.rA = pow(10000.0, -2.0 / 128.0); p.rI = pow(10000.0, -2.0 / 64.0);
    hipMemsetAsync(d_ws, 0, ZERO_BYTES, stream);
#if MK_MULTI
    launch_phase<PH_PROLOGUE>(p, 0, stream);
    for (int lp = 0; lp < 2; ++lp) {
        const int le = 2 * lp, lo = 2 * lp + 1;
        launch_phase<PH_NORM_MIX>(p, le, stream);
        launch_phase<PH_GEMM_IN_EVEN>(p, le, stream);
        launch_phase<PH_EVEN_TOK>(p, le, stream);
        launch_phase<PH_GDN_SCAN>(p, le, stream);
        launch_phase<PH_DSA_ATTN>(p, le, stream);
        launch_phase<PH_GEMM_OUT>(p, le, stream);
        launch_phase<PH_NORM_FFN>(p, le, stream);
        launch_phase<PH_MOE1>(p, le, stream);
        launch_phase<PH_MOE2>(p, le, stream);
        launch_phase<PH_NORM_MIX>(p, lo, stream);
        launch_phase<PH_GEMM_IN_ODD>(p, lo, stream);
        launch_phase<PH_GLA_CHUNK>(p, lo, stream);
        launch_phase<PH_GLA_SCAN>(p, lo, stream);
        launch_phase<PH_GLA_OUT>(p, lo, stream);
        launch_phase<PH_GEMM_OUT>(p, lo, stream);
        launch_phase<PH_NORM_FFN>(p, lo, stream);
        launch_phase<PH_MOE1>(p, lo, stream);
        launch_phase<PH_MOE2>(p, lo, stream);
    }
    launch_phase<PH_FINAL>(p, 0, stream);
#else
    static int grid = 0;
    if (!grid) {
        int dev = 0, cus = 0, per_cu = 0;
        hipGetDevice(&dev);
        hipDeviceGetAttribute(&cus, hipDeviceAttributeMultiprocessorCount, dev);
        hipFuncSetAttribute((const void*)k_mega, hipFuncAttributeMaxDynamicSharedMemorySize, (int)LDS_BYTES);
        hipOccupancyMaxActiveBlocksPerMultiprocessor(&per_cu, k_mega, NTHREADS, LDS_BYTES);
        if (cus <= 0) cus = 256;
        grid = cus * (per_cu < 1 ? 1 : 1);
    }
    hipLaunchKernelGGL(k_mega, dim3(grid), dim3(NTHREADS), LDS_BYTES, stream, p);
#endif
}
```

```cpp
#include <hip/hip_runtime.h>
#include <stdint.h>
#include <math.h>
#include <stdio.h>

#define EXTRA_BARS 0
#define REP_A 1
#ifndef REP_Q
#define REP_Q 1
#endif
#ifndef REP_S
#define REP_S 1
#endif
#ifndef REP_T
#define REP_T 1
#endif
#ifndef REP_E
#define REP_E 1
#endif
#define REP_B 1
#define REP_C 1
#ifndef DUP_MASK
#define DUP_MASK 0
#endif
#ifndef MK_MULTI
#define MK_MULTI 0
#endif

namespace {

constexpr int NT = 16384, ND = 1024, LDP = 3920, LDPB = 3968;
constexpr float EPS = 1e-6f;
constexpr int NTHREADS = 512;
constexpr size_t LDS_BYTES = 163840;
constexpr float SCALE128 = 0.08838834764831845f;
constexpr float SCQ = 0.08838834764831845f * 1.4426950408889634f;
constexpr int LISTCAP = 32768;
constexpr int CSTR = 16;

constexpr size_t OFF_BAR  = 0;
constexpr size_t OFF_CNT  = 16384;
constexpr size_t ZERO_BYTES = 32768;
constexpr size_t OFF_DONE = 24576;
constexpr size_t OFF_QCTR = 28672;
constexpr size_t OFF_GFLG = 30208;
constexpr size_t OFF_MOD  = 32768;
constexpr size_t OFF_COSA = OFF_MOD + 4 * 2 * 6144 * 4;
constexpr size_t OFF_SINA = OFF_COSA + (size_t)NT * 64 * 4;
constexpr size_t OFF_COSI = OFF_SINA + (size_t)NT * 64 * 4;
constexpr size_t OFF_SINI = OFF_COSI + (size_t)NT * 32 * 4;
constexpr size_t OFF_H    = OFF_SINI + (size_t)NT * 32 * 4;
constexpr size_t OFF_P    = OFF_H + (size_t)NT * 1024 * 4;
constexpr size_t OFF_HID  = OFF_P;
constexpr size_t OFF_YB   = OFF_HID + (size_t)36864 * 512 * 4;
constexpr size_t OFF_O    = OFF_P + (size_t)NT * LDP * 4;
constexpr size_t OFF_ASG  = OFF_O + (size_t)NT * 1024 * 4;
constexpr size_t OFF_GATE = OFF_ASG + (size_t)NT * 4 * 4;
constexpr size_t OFF_LIST = OFF_GATE + (size_t)NT * 2 * 4;
constexpr size_t OFF_R    = OFF_LIST + (size_t)32 * LISTCAP * 4;
constexpr size_t OFF_QN   = OFF_R;
constexpr size_t OFF_KN   = OFF_QN + (size_t)NT * 512 * 4;
constexpr size_t OFF_VC   = OFF_KN + (size_t)NT * 512 * 4;
constexpr size_t OFF_BETA = OFF_VC + (size_t)NT * 512 * 4;
constexpr size_t OFF_G    = OFF_BETA + (size_t)NT * 4 * 4;
constexpr size_t OFF_W    = OFF_G + (size_t)NT * 4 * 4;
constexpr size_t OFF_U    = OFF_W + (size_t)1024 * 8192 * 4;
constexpr size_t OFF_QG   = OFF_U + (size_t)1024 * 8192 * 4;
constexpr size_t OFF_KD   = OFF_QG + (size_t)1024 * 8192 * 4;
constexpr size_t OFF_AQK  = OFF_KD + (size_t)1024 * 8192 * 4;
constexpr size_t OFF_GL   = OFF_AQK + (size_t)1024 * 4096 * 4;
constexpr size_t OFF_QB   = OFF_GL + 4096;
constexpr size_t OFF_KB   = OFF_QB + (size_t)NT * 512 * 4;
constexpr size_t OFF_QI   = OFF_KB + (size_t)NT * 512 * 4;
constexpr size_t OFF_KI   = OFF_QI + (size_t)NT * 256 * 4;
constexpr size_t OFF_WI   = OFF_KI + (size_t)NT * 64 * 4;
constexpr size_t OFF_SEL  = OFF_WI + (size_t)NT * 4 * 4;
constexpr size_t OFF_EVEN_END = OFF_SEL + (size_t)NT * 256 * 4;
constexpr size_t OFF_PFR  = OFF_W;
constexpr size_t OFF_RFR  = OFF_PFR + (size_t)1024 * 32768;
constexpr size_t OFF_QFR  = OFF_RFR + (size_t)1024 * 16384;
constexpr size_t OFF_OFR  = OFF_QFR + (size_t)1024 * 32768;
static_assert(OFF_OFR + (size_t)1024 * 16384 <= OFF_GL, "gdn v2 buffers overflow");
constexpr size_t OFF_QBB  = OFF_QB;
constexpr size_t OFF_KBB  = OFF_QBB + (size_t)NT * 512 * 2;
constexpr size_t OFF_VT   = OFF_KBB + (size_t)NT * 512 * 2;
constexpr size_t OFF_QIB  = OFF_VT + (size_t)NT * 512 * 2;
constexpr size_t OFF_KIB  = OFF_QIB + (size_t)NT * 256 * 2;
constexpr size_t OFF_M16  = OFF_KIB + (size_t)NT * 64 * 2;
static_assert(OFF_M16 + (size_t)NT * 512 * 2 <= OFF_WI, "dsa v2 buffers overflow");
constexpr size_t OFF_LA   = OFF_R;
constexpr size_t OFF_ATT  = OFF_LA + (size_t)NT * 512 * 4;
constexpr size_t OFF_QE   = OFF_ATT + (size_t)1024 * 4096 * 4;
constexpr size_t OFF_GKD  = OFF_QE + (size_t)1024 * 8192 * 4;
constexpr size_t OFF_EBL  = OFF_GKD + (size_t)1024 * 8192 * 4;
constexpr size_t OFF_GQE  = OFF_LA + (size_t)NT * 512 * 4;
constexpr size_t OFF_GOI  = OFF_GQE + (size_t)1024 * 16384;
constexpr size_t OFF_GH   = OFF_GOI + (size_t)1024 * 32768;
constexpr size_t OFF_GEBL = OFF_GH + (size_t)1024 * 65536;
static_assert(OFF_GEBL + (size_t)1024 * 512 <= OFF_EVEN_END, "gla v2 buffers overflow");
constexpr size_t OFF_WINE = OFF_EVEN_END;
constexpr size_t OFF_WINO = OFF_WINE + (size_t)2 * 4096 * 1024 * 2;
constexpr size_t OFF_WOUT = OFF_WINO + (size_t)2 * 3200 * 1024 * 2;
constexpr size_t OFF_W13  = OFF_WOUT + (size_t)4 * 1024 * 1024 * 2;
constexpr size_t OFF_W2T  = OFF_W13 + (size_t)32 * 1024 * 1024 * 2;
constexpr size_t OFF_OB   = OFF_W2T + (size_t)32 * 1024 * 512 * 2;
constexpr size_t OFF_AUX  = OFF_OB + (size_t)NT * 1024 * 2;
constexpr size_t OFF_WGL  = OFF_AUX + (size_t)NT * 16 * 4;
constexpr size_t WS_NEEDED = OFF_WGL + (size_t)2 * 128 * 1024 * 2;

struct Params {
    const float* x; const float* c; const int* pos; const float* ada_w; const float* ada_b;
    const float* norm_mix; const float* norm_ffn; const float* even_w_in; const float* conv_w;
    const float* a_log; const float* dt_bias; const float* gdn_out_norm; const float* even_w_out;
    const float* gla_w_in; const float* gla_w_gate2; const float* gla_b_gate2; const float* gla_out_norm; const float* gla_w_out;
    const float* rg_w; const float* rg_b; const float* re_w; const float* re_b;
    const float* w1; const float* w3; const float* w2; const float* final_norm;
    float* X;
    unsigned char* ws;
    double rA, rI;
};

#define XB_TMO      128
#define XB_XCNT(j)  (256  + 64 * (j))
#define XB_XSUB(j)  (1280 + 64 * (j))
#define XB_XGEN(j)  (2304 + 64 * (j))
#define XB_TOP      3328
#define XB_TOPGEN   3392
#define XCD_BAR_WORDS 3456
#define XB_SPIN_CAP (1u << 18)
#define LAS __attribute__((address_space(3)))

__device__ __forceinline__ unsigned xb_ld(unsigned* p)              { return __hip_atomic_load(p, __ATOMIC_RELAXED, __HIP_MEMORY_SCOPE_AGENT); }
__device__ __forceinline__ unsigned xb_add(unsigned* p, unsigned v) { return __hip_atomic_fetch_add(p, v, __ATOMIC_RELAXED, __HIP_MEMORY_SCOPE_AGENT); }
__device__ __forceinline__ unsigned xb_xcc_id() { return (unsigned)__builtin_amdgcn_s_getreg((3 << 11) | 20) & 0xFu; }
#define XB_SPIN(cond, bar) do { unsigned _sp = 0; while (cond) { __builtin_amdgcn_s_sleep(1); \
    if ((++_sp & 255u) == 0u) { if (xb_ld(&(bar)[XB_TMO])) break; if (_sp > XB_SPIN_CAP) { atomicAdd(&(bar)[XB_TMO], 1u); break; } } } } while (0)

struct XcdBarrier { unsigned* bar; unsigned x; volatile LAS unsigned* st; };

__device__ __forceinline__ XcdBarrier xcd_barrier_post(unsigned* bar, volatile LAS unsigned* st) {
    XcdBarrier b; b.bar = bar; b.x = xb_xcc_id(); b.st = st;
    if (threadIdx.x == 0) (void)xb_add(&bar[XB_XCNT(b.x)], 1u);
    return b;
}
__device__ __forceinline__ void xcd_barrier_complete(unsigned* bar, unsigned x, unsigned& nloc, unsigned& nx) {
    const unsigned G = gridDim.x * gridDim.y * gridDim.z;
    unsigned sum, cnt, mine, sp = 0u;
    for (;;) {
        sum = 0u; cnt = 0u; mine = 0u;
#pragma unroll
        for (unsigned j = 0; j < 16; ++j) { const unsigned c = xb_ld(&bar[XB_XCNT(j)]); sum += c; cnt += (c > 0u) ? 1u : 0u; mine = (j == x) ? c : mine; }
        if (sum == G) break;
        __builtin_amdgcn_s_sleep(1);
        if ((++sp & 255u) == 0u) { if (xb_ld(&bar[XB_TMO])) break; if (sp > XB_SPIN_CAP) { atomicAdd(&bar[XB_TMO], 1u); break; } }
    }
    nloc = mine > 0u ? mine : 1u; nx = cnt > 0u ? cnt : 1u;
}
__device__ __forceinline__ void xcd_barrier(const XcdBarrier& b) {
    asm volatile("s_waitcnt vmcnt(0)" ::: "memory");
    __syncthreads();
    if (threadIdx.x == 0) {
        unsigned* bar = b.bar;
        __builtin_amdgcn_s_waitcnt(0);
        unsigned nloc = b.st[0], nx = b.st[1];
        if (nloc == 0u) { xcd_barrier_complete(bar, b.x, nloc, nx); b.st[0] = nloc; b.st[1] = nx; }
        const unsigned old = xb_add(&bar[XB_XSUB(b.x)], 1u);
        const unsigned gen = old / nloc;
        if (old + 1u == (gen + 1u) * nloc) {
            __builtin_amdgcn_fence(__ATOMIC_RELEASE, "agent");
            asm volatile("s_waitcnt vmcnt(0)" ::: "memory");
            const unsigned og = xb_add(&bar[XB_TOP], 1u);
            const unsigned tg = og / nx;
            if (og + 1u == (tg + 1u) * nx) xb_add(&bar[XB_TOPGEN], 1u);
            else XB_SPIN(xb_ld(&bar[XB_TOPGEN]) == tg, bar);
            __builtin_amdgcn_fence(__ATOMIC_ACQUIRE, "agent");
            xb_add(&bar[XB_XGEN(b.x)], 1u);
            asm volatile("s_waitcnt vmcnt(0)" ::: "memory");
        } else {
            XB_SPIN(xb_ld(&bar[XB_XGEN(b.x)]) == gen, bar);
            __builtin_amdgcn_fence(__ATOMIC_ACQUIRE, "agent");
            asm volatile("s_waitcnt vmcnt(0)" ::: "memory");
        }
    }
    __syncthreads();
}

template <class T> __device__ __forceinline__ T* as_global(T* p) { return (T*)(__attribute__((address_space(1))) T*)p; }
typedef __attribute__((address_space(1))) unsigned char GU8;
#if defined(__HIP_DEVICE_COMPILE__)
#define ASSUME_GLOBAL(p_) do { __builtin_assume(!__builtin_amdgcn_is_shared((const void*)(p_))); __builtin_assume(!__builtin_amdgcn_is_private((const void*)(p_))); } while (0)
#else
#define ASSUME_GLOBAL(p_) do { } while (0)
#endif
#if defined(__HIP_DEVICE_COMPILE__)
typedef unsigned u32x4_ __attribute__((ext_vector_type(4)));
__device__ __forceinline__ void st_wt16(void* p, uint4 v) { __attribute__((address_space(1))) uint4* g = (__attribute__((address_space(1))) uint4*)p; u32x4_ x; x[0] = v.x; x[1] = v.y; x[2] = v.z; x[3] = v.w; asm volatile("s_nop 1\n\tglobal_store_dwordx4 %0, %1, off sc1\n\ts_nop 1" :: "v"(g), "v"(x) : "memory"); }
__device__ __forceinline__ void st_wt8(void* p, uint2 v) { __attribute__((address_space(1))) uint2* g = (__attribute__((address_space(1))) uint2*)p; asm volatile("global_store_dwordx2 %0, %1, off sc1" :: "v"(g), "v"(v) : "memory"); }
__device__ __forceinline__ void st_wt4(void* p, float v) { __attribute__((address_space(1))) float* g = (__attribute__((address_space(1))) float*)p; asm volatile("global_store_dword %0, %1, off sc1" :: "v"(g), "v"(v) : "memory"); }
#else
__device__ __forceinline__ void st_wt16(void* p, uint4 v) {}
__device__ __forceinline__ void st_wt8(void* p, uint2 v) {}
__device__ __forceinline__ void st_wt4(void* p, float v) {}
#endif
#define LBAR() do { asm volatile("s_waitcnt lgkmcnt(0)" ::: "memory"); __builtin_amdgcn_s_barrier(); asm volatile("" ::: "memory"); } while (0)
typedef const Params __attribute__((address_space(4))) KParams;
__device__ __forceinline__ KParams* kparams() { KParams* q = (KParams*)__builtin_amdgcn_kernarg_segment_ptr(); asm volatile("" : "+s"(q)); return q; }
#if defined(__HIP_DEVICE_COMPILE__)
#define DPPI_(v_, c_) __builtin_amdgcn_update_dpp(0, (v_), (c_), 0xf, 0xf, true)
#define DPPF_(v_, c_) __int_as_float(__builtin_amdgcn_update_dpp(0, __float_as_int(v_), (c_), 0xf, 0xf, true))
__device__ __forceinline__ float xor16_sum(float v) { const auto r = __builtin_amdgcn_permlane16_swap(__float_as_int(v), __float_as_int(v), false, false); return __int_as_float(r[0]) + __int_as_float(r[1]); }
__device__ __forceinline__ float xor32_sum(float v) { const auto r = __builtin_amdgcn_permlane32_swap(__float_as_int(v), __float_as_int(v), false, false); return __int_as_float(r[0]) + __int_as_float(r[1]); }
__device__ __forceinline__ float xor16_max(float v) { const auto r = __builtin_amdgcn_permlane16_swap(__float_as_int(v), __float_as_int(v), false, false); return fmaxf(__int_as_float(r[0]), __int_as_float(r[1])); }
__device__ __forceinline__ float xor32_max(float v) { const auto r = __builtin_amdgcn_permlane32_swap(__float_as_int(v), __float_as_int(v), false, false); return fmaxf(__int_as_float(r[0]), __int_as_float(r[1])); }
__device__ __forceinline__ float wave_sum(float v) {
    v += DPPF_(v, 0xB1); v += DPPF_(v, 0x4E); v += DPPF_(v, 0x141); v += DPPF_(v, 0x140);
    return xor32_sum(xor16_sum(v));
}
__device__ __forceinline__ int wave_sum_i(int v) {
    v += DPPI_(v, 0xB1); v += DPPI_(v, 0x4E); v += DPPI_(v, 0x141); v += DPPI_(v, 0x140);
    { const auto r = __builtin_amdgcn_permlane16_swap(v, v, false, false); v = (int)r[0] + (int)r[1]; }
    { const auto r = __builtin_amdgcn_permlane32_swap(v, v, false, false); v = (int)r[0] + (int)r[1]; }
    return v;
}
__device__ __forceinline__ float wave_max(float v) {
    v = fmaxf(v, DPPF_(v, 0xB1)); v = fmaxf(v, DPPF_(v, 0x4E)); v = fmaxf(v, DPPF_(v, 0x141)); v = fmaxf(v, DPPF_(v, 0x140));
    return xor32_max(xor16_max(v));
}
#else
__device__ __forceinline__ float xor16_sum(float v) { return v; }
__device__ __forceinline__ float xor32_sum(float v) { return v; }
__device__ __forceinline__ float xor16_max(float v) { return v; }
__device__ __forceinline__ float xor32_max(float v) { return v; }
__device__ __forceinline__ float wave_sum(float v) { return v; }
__device__ __forceinline__ int wave_sum_i(int v) { return v; }
__device__ __forceinline__ float wave_max(float v) { return v; }
#endif
__device__ __forceinline__ float sigmoidf_(float x) { return 1.f / (1.f + expf(-x)); }
__device__ __forceinline__ float siluf_(float x) { return x / (1.f + expf(-x)); }
__device__ __forceinline__ float silu_fast(float x) { return x * __builtin_amdgcn_rcpf(1.f + __expf(-x)); }
__device__ __forceinline__ float softplusf_(float x) { return fmaxf(x, 0.f) + log1pf(expf(-fabsf(x))); }
__device__ __forceinline__ unsigned ordkey(float f) { const unsigned u = __float_as_uint(f); return u ^ ((unsigned)((int)u >> 31) | 0x80000000u); }

__device__ __forceinline__ void sincos_d(double a, double& s, double& c) {
    const double kq = rint(a * 0.63661977236758134308);
    double r = fma(-kq, 1.57079632673412561417e+00, a);
    r = fma(-kq, 6.07710050650619224932e-11, r);
    const int q = (int)((long long)kq & 3);
    const double r2 = r * r;
    const double sp = r * (1.0 + r2 * (-1.0 / 6 + r2 * (1.0 / 120 + r2 * (-1.0 / 5040 + r2 * (1.0 / 362880 + r2 * (-1.0 / 39916800 + r2 * (1.0 / 6227020800.0)))))));
    const double cp = 1.0 + r2 * (-0.5 + r2 * (1.0 / 24 + r2 * (-1.0 / 720 + r2 * (1.0 / 40320 + r2 * (-1.0 / 3628800 + r2 * (1.0 / 479001600.0 + r2 * (-1.0 / 87178291200.0)))))));
    if (q == 0) { s = sp; c = cp; } else if (q == 1) { s = cp; c = -sp; } else if (q == 2) { s = -sp; c = -cp; } else { s = -cp; c = sp; }
}
__device__ __forceinline__ double ipow_d(double b, int e) { double v = 1.0; while (e) { if (e & 1) v *= b; b *= b; e >>= 1; } return v; }

struct GemmArgs { const float* A; int lda; const int* rows; int m0; int mvalid; const float* B; int ldb; int n0; int N; int K; };

template <class Epi>
__device__ __forceinline__ void gemm128(const GemmArgs& g, float* smem, Epi epi) {
    float* As = smem;
    float* Bs = smem + 16 * 132;
    int tid_ = threadIdx.x; asm volatile("" : "+v"(tid_)); const int tid = tid_, ty = tid >> 4, tx = tid & 15;
    const int arow = tid >> 2, kq = (tid & 3) * 4;
    const int bk = tid >> 5, bn = (tid & 31) * 4;
    long asrc = -1;
    if (arow < g.mvalid) { const int r = g.rows ? g.rows[arow] : (g.m0 + arow); if (r >= 0) asrc = (long)r * g.lda; }
    const bool bval = (g.n0 + bn) < g.N;
    float acc[4][8];
#pragma unroll
    for (int i = 0; i < 4; ++i)
#pragma unroll
        for (int j = 0; j < 8; ++j) acc[i][j] = 0.f;
    for (int k0 = 0; k0 < g.K; k0 += 16) {
        float4 av = make_float4(0.f, 0.f, 0.f, 0.f), bv = make_float4(0.f, 0.f, 0.f, 0.f);
        if (asrc >= 0) av = *(const float4*)(g.A + asrc + k0 + kq);
        if (bval) bv = *(const float4*)(g.B + (size_t)(k0 + bk) * g.ldb + g.n0 + bn);
        __syncthreads();
        As[(kq + 0) * 132 + arow] = av.x; As[(kq + 1) * 132 + arow] = av.y; As[(kq + 2) * 132 + arow] = av.z; As[(kq + 3) * 132 + arow] = av.w;
        *(float4*)&Bs[bk * 132 + bn] = bv;
        __syncthreads();
#pragma unroll
        for (int kk = 0; kk < 16; ++kk) {
            const float4 a = *(const float4*)&As[kk * 132 + ty * 4];
            const float4 b0 = *(const float4*)&Bs[kk * 132 + tx * 8];
            const float4 b1 = *(const float4*)&Bs[kk * 132 + tx * 8 + 4];
            const float aa[4] = {a.x, a.y, a.z, a.w};
            const float bb[8] = {b0.x, b0.y, b0.z, b0.w, b1.x, b1.y, b1.z, b1.w};
#pragma unroll
            for (int i = 0; i < 4; ++i)
#pragma unroll
                for (int j = 0; j < 8; ++j) acc[i][j] += aa[i] * bb[j];
        }
    }
#pragma unroll
    for (int i = 0; i < 4; ++i) {
        const int r = ty * 4 + i;
        if (r < g.mvalid) {
#pragma unroll
            for (int j = 0; j < 8; ++j) { const int n = g.n0 + tx * 8 + j; if (n < g.N) epi(r, n, acc[i][j]); }
        }
    }
}


typedef short bf16x8 __attribute__((ext_vector_type(8)));
typedef float f32x4 __attribute__((ext_vector_type(4)));
typedef unsigned short bf16_t;
typedef __bf16 bf16x2_t __attribute__((ext_vector_type(2)));
typedef float f32x2_t __attribute__((ext_vector_type(2)));
__device__ __forceinline__ unsigned cvt_pk_bf16(float lo, float hi) { const f32x2_t v = {lo, hi}; const bf16x2_t r = __builtin_convertvector(v, bf16x2_t); return __builtin_bit_cast(unsigned, r); }
__device__ __forceinline__ bf16_t f2bf(float f) { return (bf16_t)(cvt_pk_bf16(f, 0.f) & 0xffffu); }
__device__ __forceinline__ float bf16_to_f32(bf16_t v) { return __uint_as_float(((unsigned)v) << 16); }
__device__ __forceinline__ uint2 pack4(const f32x4 v) { uint2 r; r.x = cvt_pk_bf16(v[0], v[1]); r.y = cvt_pk_bf16(v[2], v[3]); return r; }
__device__ __forceinline__ f32x4 unpack4(const uint2 u) { f32x4 r; r[0] = __uint_as_float(u.x << 16); r[1] = __uint_as_float(u.x & 0xffff0000u); r[2] = __uint_as_float(u.y << 16); r[3] = __uint_as_float(u.y & 0xffff0000u); return r; }
#define PBF(Pb_, t_, c_) bf16_to_f32((Pb_)[(size_t)(t_) * LDPB + (c_)])
__device__ __forceinline__ uint4 pack8(const float4 a, const float4 b) { uint4 r; r.x = cvt_pk_bf16(a.x, a.y); r.y = cvt_pk_bf16(a.z, a.w); r.z = cvt_pk_bf16(b.x, b.y); r.w = cvt_pk_bf16(b.z, b.w); return r; }
__device__ __forceinline__ int lds_off(int r, int c) { return r * 128 + ((c ^ (r & 7)) << 4); }

template <class ALoad, class BLoad, class Epi>
__device__ __forceinline__ void gemm_tile_bf16(const int K, unsigned char* lds, ALoad aload, BLoad bload, Epi epi, const int mrows = 256) {
    int tid_ = threadIdx.x; asm volatile("" : "+v"(tid_)); const int tid = tid_, lane = tid & 63, wid = tid >> 6, wm = wid >> 1, wn = wid & 1;
    f32x4 acc[4][4];
#pragma unroll
    for (int mi = 0; mi < 4; ++mi)
#pragma unroll
        for (int ni = 0; ni < 4; ++ni) acc[mi][ni] = (f32x4){0.f, 0.f, 0.f, 0.f};
    uint4 ra[4], rb[2];
    const int nk = K >> 6;
#pragma unroll
    for (int i = 0; i < 4; ++i) { const int q = tid + 512 * i; ra[i] = aload(i, q >> 3, (q & 7) * 8); }
#pragma unroll
    for (int i = 0; i < 2; ++i) { const int q = tid + 512 * i; rb[i] = bload(i, q >> 3, (q & 7) * 8); }
    __syncthreads();
#pragma unroll
    for (int i = 0; i < 4; ++i) { const int q = tid + 512 * i; *(uint4*)(lds + lds_off(q >> 3, q & 7)) = ra[i]; }
#pragma unroll
    for (int i = 0; i < 2; ++i) { const int q = tid + 512 * i; *(uint4*)(lds + 32768 + lds_off(q >> 3, q & 7)) = rb[i]; }
    __syncthreads();
    for (int kt = 0; kt < nk; ++kt) {
        if (kt + 1 < nk) {
#pragma unroll
            for (int i = 0; i < 4; ++i) { const int q = tid + 512 * i; ra[i] = aload(i, q >> 3, (kt + 1) * 64 + (q & 7) * 8); }
#pragma unroll
            for (int i = 0; i < 2; ++i) { const int q = tid + 512 * i; rb[i] = bload(i, q >> 3, (kt + 1) * 64 + (q & 7) * 8); }
        }
        const unsigned char* At = lds + (kt & 1) * 49152;
        const unsigned char* Bt = At + 32768;
        if (__builtin_amdgcn_readfirstlane(wm) * 64 < mrows) {
#pragma unroll
        for (int ks = 0; ks < 2; ++ks) {
            bf16x8 af[4], bfr[4];
            const int c = ks * 4 + (lane >> 4);
#pragma unroll
            for (int mi = 0; mi < 4; ++mi) af[mi] = *(const bf16x8*)(At + lds_off(wm * 64 + mi * 16 + (lane & 15), c));
#pragma unroll
            for (int ni = 0; ni < 4; ++ni) bfr[ni] = *(const bf16x8*)(Bt + lds_off(wn * 64 + ni * 16 + (lane & 15), c));
            __builtin_amdgcn_s_setprio(1);
#pragma unroll
            for (int mi = 0; mi < 4; ++mi)
#pragma unroll
                for (int ni = 0; ni < 4; ++ni) acc[mi][ni] = __builtin_amdgcn_mfma_f32_16x16x32_bf16(bfr[ni], af[mi], acc[mi][ni], 0, 0, 0);
            __builtin_amdgcn_s_setprio(0);
        }
        }
        if (kt + 1 < nk) {
            unsigned char* An = lds + ((kt + 1) & 1) * 49152;
#pragma unroll
            for (int i = 0; i < 4; ++i) { const int q = tid + 512 * i; *(uint4*)(An + lds_off(q >> 3, q & 7)) = ra[i]; }
#pragma unroll
            for (int i = 0; i < 2; ++i) { const int q = tid + 512 * i; *(uint4*)(An + 32768 + lds_off(q >> 3, q & 7)) = rb[i]; }
        }
        __syncthreads();
    }
    epi(acc, wm, wn, lane);
}

__device__ __forceinline__ void convert_tile(const float* src0, const float* src1, int mode, int K, int N, int ld, bf16_t* dst, int rt, int kt, float* smem) {
    int tid_ = threadIdx.x; asm volatile("" : "+v"(tid_)); const int tid = tid_;
    __syncthreads();
    { const int k = tid >> 3, R0 = rt * 64 + (tid & 7) * 8;
      const float* sp; int col;
      if (mode == 0) { sp = src0; col = R0; } else { sp = (R0 & 32) ? src1 : src0; col = (R0 >> 6) * 32 + (R0 & 31); }
      float4 a = make_float4(0.f, 0.f, 0.f, 0.f), b = a;
      const float* rp = sp + (size_t)(kt * 64 + k) * ld + col;
      if (col < N) a = *(const float4*)rp;
      if (col + 4 < N) b = *(const float4*)(rp + 4);
      float* d = smem + k * 65 + (tid & 7) * 8;
      d[0] = a.x; d[1] = a.y; d[2] = a.z; d[3] = a.w; d[4] = b.x; d[5] = b.y; d[6] = b.z; d[7] = b.w; }
    __syncthreads();
    { const int R = tid >> 3, kc = (tid & 7) * 8;
      float v[8];
#pragma unroll
      for (int j = 0; j < 8; ++j) v[j] = smem[(kc + j) * 65 + R];
      uint4 o; o.x = cvt_pk_bf16(v[0], v[1]); o.y = cvt_pk_bf16(v[2], v[3]); o.z = cvt_pk_bf16(v[4], v[5]); o.w = cvt_pk_bf16(v[6], v[7]);
      *(uint4*)(dst + (size_t)(rt * 64 + R) * K + kt * 64 + kc) = o; }
}

#define CT_LOAD(S0, S1, MODE, NN, LD, RT, KT, A, B) do { const int k_ = tid >> 3, R0_ = (RT) * 64 + (tid & 7) * 8; const float* sp_; int col_; \
        if ((MODE) == 0) { sp_ = (S0); col_ = R0_; } else { sp_ = (R0_ & 16) ? (S1) : (S0); col_ = (R0_ >> 5) * 16 + (R0_ & 15); } \
        const bool oka_ = col_ < (NN), okb_ = col_ + 4 < (NN); const float* rp_ = sp_ + (size_t)((KT) * 64 + k_) * (LD) + (oka_ ? col_ : 0); \
        A = *(const float4*)rp_; B = *(const float4*)(rp_ + (okb_ ? 4 : 0));        \
        if (!oka_) A = make_float4(0.f, 0.f, 0.f, 0.f); if (!okb_) B = make_float4(0.f, 0.f, 0.f, 0.f); } while (0)
#define CT_WRITE(BUF, A, B) do { float* d_ = smem + (BUF) * 4160 + (tid >> 3) * 65 + (tid & 7) * 8; \
        d_[0] = A.x; d_[1] = A.y; d_[2] = A.z; d_[3] = A.w; d_[4] = B.x; d_[5] = B.y; d_[6] = B.z; d_[7] = B.w; } while (0)
#define CT_STORE(DST, KK, RT, KT, BUF) do { const int R_ = tid >> 3, kc_ = (tid & 7) * 8; const float* sb_ = smem + (BUF) * 4160; \
        uint4 o_; o_.x = cvt_pk_bf16(sb_[(kc_ + 0) * 65 + R_], sb_[(kc_ + 1) * 65 + R_]); o_.y = cvt_pk_bf16(sb_[(kc_ + 2) * 65 + R_], sb_[(kc_ + 3) * 65 + R_]); \
        o_.z = cvt_pk_bf16(sb_[(kc_ + 4) * 65 + R_], sb_[(kc_ + 5) * 65 + R_]); o_.w = cvt_pk_bf16(sb_[(kc_ + 6) * 65 + R_], sb_[(kc_ + 7) * 65 + R_]); \
        *(uint4*)((DST) + (size_t)((RT) * 64 + R_) * (KK) + (KT) * 64 + kc_) = o_; } while (0)
#define CT_DECL(I) const float* s0_##I; const float* s1_##I; bf16_t* d_##I; int md_##I, K_##I, N_##I, ld_##I, rt_##I, kt_##I
#define CT_ARGS(I) s0_##I, s1_##I, d_##I, md_##I, K_##I, N_##I, ld_##I, rt_##I, kt_##I
#define CT_LOADSET(X, T) do {   \
        { CT_DECL(0); dec((T), CT_ARGS(0)); CT_LOAD(s0_0, s1_0, md_0, N_0, ld_0, rt_0, kt_0, X##a0, X##b0); } \
        { CT_DECL(1); dec((T) + 1, CT_ARGS(1)); CT_LOAD(s0_1, s1_1, md_1, N_1, ld_1, rt_1, kt_1, X##a1, X##b1); } \
        { CT_DECL(2); dec((T) + 2, CT_ARGS(2)); CT_LOAD(s0_2, s1_2, md_2, N_2, ld_2, rt_2, kt_2, X##a2, X##b2); } \
        { CT_DECL(3); dec((T) + 3, CT_ARGS(3)); CT_LOAD(s0_3, s1_3, md_3, N_3, ld_3, rt_3, kt_3, X##a3, X##b3); } } while (0)
#define CT_PROCESS(X, T) do { \
        LBAR();   \
        CT_WRITE(0, X##a0, X##b0); CT_WRITE(1, X##a1, X##b1); CT_WRITE(2, X##a2, X##b2); CT_WRITE(3, X##a3, X##b3); \
        LBAR(); \
        { CT_DECL(0); dec((T), CT_ARGS(0)); CT_STORE(d_0, K_0, rt_0, kt_0, 0); } \
        { CT_DECL(1); dec((T) + 1, CT_ARGS(1)); CT_STORE(d_1, K_1, rt_1, kt_1, 1); } \
        { CT_DECL(2); dec((T) + 2, CT_ARGS(2)); CT_STORE(d_2, K_2, rt_2, kt_2, 2); } \
        { CT_DECL(3); dec((T) + 3, CT_ARGS(3)); CT_STORE(d_3, K_3, rt_3, kt_3, 3); } } while (0)
template <class Dec>
__device__ __forceinline__ void convert_stream(const Dec& dec, int t0, int tstep, int total, float* smem) {
    int tid_ = threadIdx.x; asm volatile("" : "+v"(tid_)); const int tid = tid_;
    if (t0 >= total) return;
    const float4 z4 = make_float4(0.f, 0.f, 0.f, 0.f);
    float4 Aa0 = z4, Ab0 = z4, Aa1 = z4, Ab1 = z4, Aa2 = z4, Ab2 = z4, Aa3 = z4, Ab3 = z4, Ba0 = z4, Bb0 = z4, Ba1 = z4, Bb1 = z4, Ba2 = z4, Bb2 = z4, Ba3 = z4, Bb3 = z4;
    CT_LOADSET(A, t0);
    for (int t = t0; t < total; t += 2 * tstep) {
        if (t + tstep < total) CT_LOADSET(B, t + tstep);
        CT_PROCESS(A, t);
        if (t + tstep >= total) break;
        if (t + 2 * tstep < total) CT_LOADSET(A, t + 2 * tstep);
        CT_PROCESS(B, t + tstep);
    }
}


namespace pg8 {
constexpr int BM = 256, BK = 64, HALF = 128, HTB = HALF * BK * 2, STAGE_BYTES = 8 * HTB;
__host__ __device__ __forceinline__ int lds_byte(int r, int c) { const int st = (r >> 4) * 2 + (c >> 5), rr = r & 15, cc = c & 31, ob = rr * 64 + cc * 2; return st * 1024 + (ob ^ (((ob >> 9) & 1) << 5)); }
__host__ __device__ __forceinline__ void stage_rc(int b, int& R, int& C) { const int st = b / 1024, sb = b % 1024, swz = sb ^ (((sb >> 9) & 1) << 5); R = (st >> 1) * 16 + swz / 64; C = (st & 1) * 32 + (swz % 64) / 2; }
__host__ __device__ __forceinline__ int perm32(int rho) { const int n = rho >> 4, i = rho & 15; return 8 * (i >> 2) + 4 * n + (i & 3); }

struct Unit { size_t aoff, boff; int pm, pn, e, mvalid, rowbase, mi; };
template <class Epi, class Sched, bool GATHER>
__device__ __forceinline__ void gemm_phase(LAS unsigned char* lds, const bf16_t* Abase, const bf16_t* Bbase, const int K, const Sched& S, const Epi& E) {
    int tid_ = threadIdx.x; asm volatile("" : "+v"(tid_));
    const int tid = tid_, wid = __builtin_amdgcn_readfirstlane(tid >> 6), lane = tid & 63, wr = wid >> 2, wc = wid & 3, fr = lane & 15, fq = lane >> 4;
    const int nt = K / BK;
    unsigned voffB[2];
#pragma unroll
    for (int i = 0; i < 2; ++i) { int R, C; stage_rc(tid * 16 + i * 8192, R, C); const int Rb = Epi::PERM ? ((R & ~31) + perm32(R & 31)) : R; voffB[i] = (unsigned)(Rb * K + C) * 2u; }
    const size_t kstep = (size_t)(BK * 2);
    const size_t hstep = (size_t)HALF * K * 2;
    const unsigned ldsw = (unsigned)wid * 1024u;
    const int aoff = lds_byte(wr * 64 + fr, fq * 8), boff = lds_byte(wc * 32 + fr, fq * 8);
#define PG8_SA(b, h) (((b) * 2 + (h)) * HTB)
#define PG8_SB(b, h) ((4 + (b) * 2 + (h)) * HTB)
#define PG8_STAGE(bufoff, gbase, voff) do { _Pragma("unroll") for (int _i = 0; _i < 2; ++_i) \
        __builtin_amdgcn_global_load_lds((const unsigned*)((const char*)(gbase) + (voff)[_i]), (LAS unsigned*)(lds + (bufoff) + ldsw + _i * 8192), 16, 0, 0); } while (0)
#define PG8_LDA(dst, b, h) do { _Pragma("unroll") for (int m = 0; m < 4; ++m) _Pragma("unroll") for (int k = 0; k < 2; ++k) dst[m][k] = *(const LAS bf16x8*)(lds + PG8_SA(b, h) + aoff + m * 2048 + k * 1024); } while (0)
#define PG8_LDB(dst, b, h) do { _Pragma("unroll") for (int n = 0; n < 2; ++n) _Pragma("unroll") for (int k = 0; k < 2; ++k) dst[n][k] = *(const LAS bf16x8*)(lds + PG8_SB(b, h) + boff + n * 2048 + k * 1024); } while (0)
#define PG8_MMA(ai, bj, At, Bt) do { __builtin_amdgcn_s_setprio(1); _Pragma("unroll") for (int m = 0; m < 4; ++m) _Pragma("unroll") for (int n = 0; n < 2; ++n) _Pragma("unroll") for (int k = 0; k < 2; ++k) \
        acc[ai][bj][m][n] = __builtin_amdgcn_mfma_f32_16x16x32_bf16(Bt[n][k], At[m][k], acc[ai][bj][m][n], 0, 0, 0); __builtin_amdgcn_s_setprio(0); } while (0)
#define PG8_WAIT_V(n) asm volatile("s_waitcnt vmcnt(" #n ")" ::: "memory")
#define PG8_WAIT_L(n) asm volatile("s_waitcnt lgkmcnt(" #n ")" ::: "memory")
#define PG8_BAR __builtin_amdgcn_s_barrier()
#define PG8_SCHED __builtin_amdgcn_sched_barrier(0)
#define PG8_AVOFF(U, V0, V1) do { _Pragma("unroll") for (int _i = 0; _i < 2; ++_i) { int R_, C_; stage_rc(tid * 16 + _i * 8192, R_, C_); \
        if (GATHER) { V0[_i] = (unsigned)((size_t)S.row(U, R_) * K + C_) * 2u; V1[_i] = (unsigned)((size_t)S.row(U, 128 + R_) * K + C_) * 2u; } \
        else { V0[_i] = (unsigned)(R_ * K + C_) * 2u; V1[_i] = V0[_i] + (unsigned)hstep; } } } while (0)
    Unit cur, nxt; int ui = 0;
    if (!S.next(0, cur)) return;
    if (Sched::WAITS) { S.wait(cur, tid); __builtin_amdgcn_s_barrier(); }
    f32x4 acc[2][2][4][2];
#pragma unroll
    for (int a = 0; a < 2; ++a)
#pragma unroll
        for (int b = 0; b < 2; ++b)
#pragma unroll
            for (int m = 0; m < 4; ++m)
#pragma unroll
                for (int n = 0; n < 2; ++n) acc[a][b][m][n] = (f32x4){0.f, 0.f, 0.f, 0.f};
    bf16x8 At[4][2], B0[2][2], B1[2][2];
    unsigned cv0[2], cv1[2];
    PG8_AVOFF(cur, cv0, cv1);
    const char* cA = (const char*)Abase + cur.aoff; const char* cB = (const char*)Bbase + cur.boff;
    PG8_STAGE(PG8_SB(0, 0), cB, voffB); PG8_STAGE(PG8_SA(0, 0), cA, cv0); PG8_STAGE(PG8_SB(0, 1), cB + hstep, voffB); PG8_STAGE(PG8_SA(0, 1), cA, cv1);
    if (wr == 1) PG8_BAR;
    PG8_WAIT_V(4); PG8_BAR;
    PG8_STAGE(PG8_SB(1, 0), cB + kstep, voffB); PG8_STAGE(PG8_SA(1, 0), cA + kstep, cv0); PG8_STAGE(PG8_SB(1, 1), cB + hstep + kstep, voffB);
    PG8_WAIT_V(6); PG8_BAR;
    for (;;) {
        const bool has_next = S.next(ui + 1, nxt);
        const char* nA = has_next ? (const char*)Abase + nxt.aoff : cA; const char* nB = has_next ? (const char*)Bbase + nxt.boff : cB;
        for (int t = 0; t < nt; t += 2) {
            const bool last = (t == nt - 2);
            const char* a1 = cA + (size_t)(t + 1) * kstep;
            const char* a2 = last ? nA : cA + (size_t)(t + 2) * kstep; const char* b2 = last ? nB : cB + (size_t)(t + 2) * kstep;
            const char* a3 = a2 + kstep; const char* b3 = b2 + kstep;
            PG8_LDB(B0, 0, 0); PG8_SCHED; PG8_LDA(At, 0, 0); PG8_STAGE(PG8_SA(1, 1), a1, cv1);
            if (last && has_next) { if (Sched::WAITS) S.wait(nxt, tid); PG8_AVOFF(nxt, cv0, cv1); }
            PG8_WAIT_L(8); PG8_BAR; PG8_WAIT_L(0); PG8_MMA(0, 0, At, B0); PG8_BAR; PG8_SCHED;
            PG8_LDB(B1, 0, 1); PG8_STAGE(PG8_SB(0, 0), b2, voffB);
            PG8_BAR; PG8_WAIT_L(0); PG8_MMA(0, 1, At, B1); PG8_BAR;
            PG8_LDA(At, 0, 1); PG8_STAGE(PG8_SA(0, 0), a2, cv0);
            PG8_BAR; PG8_WAIT_L(0); PG8_MMA(1, 0, At, B0); PG8_BAR; PG8_SCHED;
            PG8_STAGE(PG8_SB(0, 1), b2 + hstep, voffB);
            PG8_WAIT_V(6); PG8_BAR; PG8_MMA(1, 1, At, B1); PG8_BAR;
            PG8_LDB(B0, 1, 0); PG8_SCHED; PG8_LDA(At, 1, 0); PG8_STAGE(PG8_SA(0, 1), a2, cv1);
            PG8_WAIT_L(8); PG8_BAR; PG8_WAIT_L(0); PG8_MMA(0, 0, At, B0); PG8_BAR; PG8_SCHED;
            PG8_LDB(B1, 1, 1); PG8_STAGE(PG8_SB(1, 0), b3, voffB);
            PG8_BAR; PG8_WAIT_L(0); PG8_MMA(0, 1, At, B1); PG8_BAR;
            PG8_LDA(At, 1, 1); PG8_STAGE(PG8_SA(1, 0), a3, cv0);
            PG8_BAR; PG8_WAIT_L(0); PG8_MMA(1, 0, At, B0); PG8_BAR; PG8_SCHED;
            PG8_STAGE(PG8_SB(1, 1), b3 + hstep, voffB);
            PG8_WAIT_V(6); PG8_BAR; PG8_MMA(1, 1, At, B1); PG8_BAR;
        }
        E(acc, cur, wr, wc, fr, fq);
        if (Sched::PUBLISH) {
            PG8_WAIT_V(0); PG8_BAR;
            if (wid == 4 && lane == 0) S.publish(cur);
        }
        if (!has_next) break;
#pragma unroll
        for (int a = 0; a < 2; ++a)
#pragma unroll
            for (int b = 0; b < 2; ++b)
#pragma unroll
                for (int m = 0; m < 4; ++m)
#pragma unroll
                    for (int n = 0; n < 2; ++n) acc[a][b][m][n] = (f32x4){0.f, 0.f, 0.f, 0.f};
        cur = nxt; cA = nA; cB = nB; ++ui;
    }
    PG8_WAIT_V(0);
    if (wr == 0) PG8_BAR;
    PG8_BAR;
#undef PG8_SA
#undef PG8_SB
#undef PG8_STAGE
#undef PG8_LDA
#undef PG8_LDB
#undef PG8_MMA
#undef PG8_WAIT_V
#undef PG8_WAIT_L
#undef PG8_BAR
#undef PG8_SCHED
#undef PG8_AVOFF
}
struct DenseOrder {
    int nM, nN, nwg, G, c, K;
    __device__ __forceinline__ void init(int nM_, int nN_, int G_, int c_, int K_) { nM = nM_; nN = nN_; nwg = nM * nN; G = G_; c = c_; K = K_; }
    __device__ __forceinline__ bool next(int i, Unit& u) const {
        const long L = (long)i * G + c; if (L >= nwg) return false;
        int wgid = (int)L; { const int q = nwg / 8, r = nwg % 8, xcd = wgid % 8, off = wgid / 8; wgid = (xcd < r ? xcd * (q + 1) : r * (q + 1) + (xcd - r) * q) + off; }
        const int nig = 8 * nN, gid = wgid / nig, fm = gid * 8, gsz = (nM - fm) < 8 ? (nM - fm) : 8;
        u.pm = fm + ((wgid % nig) % gsz); u.pn = (wgid % nig) / gsz;
        u.aoff = (size_t)u.pm * 256 * K * 2; u.boff = (size_t)u.pn * 256 * K * 2; u.e = 0; u.mvalid = 256; u.rowbase = u.pm * 256; u.mi = 0;
        return true;
    }
    __device__ __forceinline__ int row(const Unit&, int r) const { return r; }
    static constexpr bool PUBLISH = false, WAITS = false;
    __device__ __forceinline__ void wait(const Unit&, int) const {}
    __device__ __forceinline__ void publish(const Unit&) const {}
};
}

extern __shared__ __attribute__((aligned(16))) unsigned char g_smem[];
#define PHASE_FN __device__ __forceinline__
enum { PH_PROLOGUE = 0, PH_NORM_MIX, PH_GEMM_IN_EVEN, PH_EVEN_TOK, PH_GDN_CHUNK, PH_GDN_SCAN, PH_DSA_TOPK, PH_DSA_ATTN, PH_GDN_OUT,
       PH_GEMM_OUT, PH_NORM_FFN, PH_MOE1, PH_MOE2, PH_GEMM_IN_ODD, PH_GLA_TOK, PH_GLA_CHUNK, PH_GLA_SCAN, PH_GLA_OUT, PH_FINAL };

PHASE_FN void ph_prologue(const Params& p, float* smem) {
    KParams* pp = kparams();
    GU8* wsg_ = (GU8*)pp->ws; asm volatile("" : "+s"(wsg_)); unsigned char* ws_ = (unsigned char*)wsg_;
    { int ldz_ = 0; asm volatile("" : "+s"(ldz_)); smem = (float*)(g_smem + ldz_); }
    int tid_ = threadIdx.x; asm volatile("" : "+v"(tid_)); const int tid = tid_, nthr = gridDim.x * NTHREADS, gid = blockIdx.x * NTHREADS + tid;
    for (int i = tid; i < 2 * ND; i += NTHREADS) smem[i] = siluf_(as_global(pp->c)[i]);
    __syncthreads();
    float* MOD = (float*)(ws_ + OFF_MOD);
    { float* red = smem + 2048;
      const int lane = tid & 63, wv = tid >> 6;
      for (int item = blockIdx.x; item < 4 * 96; item += gridDim.x) {
          const int l = item / 96, n = (item % 96) * 64 + lane;
          const float* w = as_global(pp->ada_w) + (size_t)l * ND * 6144 + n;
          float a0 = 0.f, a1 = 0.f;
          for (int k0 = wv * 128; k0 < wv * 128 + 128; k0 += 16) {
              float wr_[16];
#pragma unroll
              for (int q = 0; q < 16; ++q) wr_[q] = w[(size_t)(k0 + q) * 6144];
              asm volatile("" : "+v"(wr_[0]), "+v"(wr_[1]), "+v"(wr_[2]), "+v"(wr_[3]), "+v"(wr_[4]), "+v"(wr_[5]), "+v"(wr_[6]), "+v"(wr_[7]), "+v"(wr_[8]), "+v"(wr_[9]), "+v"(wr_[10]), "+v"(wr_[11]), "+v"(wr_[12]), "+v"(wr_[13]), "+v"(wr_[14]), "+v"(wr_[15]));
#pragma unroll
              for (int q = 0; q < 16; ++q) { a0 += smem[k0 + q] * wr_[q]; a1 += smem[ND + k0 + q] * wr_[q]; }
          }
          __syncthreads();
          red[(wv * 64 + lane) * 2] = a0; red[(wv * 64 + lane) * 2 + 1] = a1;
          __syncthreads();
          if (tid < 128) { const int c = tid >> 1, bb = tid & 1; float a = 0.f; for (int w8 = 0; w8 < 8; ++w8) a += red[(w8 * 64 + c) * 2 + bb];
              MOD[(l * 2 + bb) * 6144 + (item % 96) * 64 + c] = a + as_global(pp->ada_b)[l * 6144 + (item % 96) * 64 + c]; }
      }
      __syncthreads(); }
    float* COSA = (float*)(ws_ + OFF_COSA); float* SINA = (float*)(ws_ + OFF_SINA);
    float* COSI = (float*)(ws_ + OFF_COSI); float* SINI = (float*)(ws_ + OFF_SINI);
    for (size_t i = gid; i < (size_t)NT * 64; i += nthr) {
        const int t = (int)(i >> 6), j = (int)(i & 63);
        double s, c; sincos_d((double)as_global(pp->pos)[t] * ipow_d(pp->rA, j), s, c);
        COSA[i] = (float)c; SINA[i] = (float)s;
    }
    for (size_t i = gid; i < (size_t)NT * 32; i += nthr) {
        const int t = (int)(i >> 5), j = (int)(i & 31);
        double s, c; sincos_d((double)as_global(pp->pos)[t] * ipow_d(pp->rI, j), s, c);
        COSI[i] = (float)c; SINI[i] = (float)s;
    }
}

PHASE_FN void ph_rows(const Params& p, int layer, int mode, float* smem) {
    KParams* pp = kparams();
    GU8* wsg_ = (GU8*)pp->ws; asm volatile("" : "+s"(wsg_)); unsigned char* ws_ = (unsigned char*)wsg_;
    { int ldz_ = 0; asm volatile("" : "+s"(ldz_)); smem = (float*)(g_smem + ldz_); }
    int tid_ = threadIdx.x; asm volatile("" : "+v"(tid_)); const int tid = tid_, lane = tid & 63, wv = tid >> 6;
    int* pad = (int*)smem;
    const int moe_layer = (mode == 1) ? 3 : layer - 1;
    const float* MOD = (const float*)(ws_ + OFF_MOD);
    float4* sG = (float4*)(smem + 64); float4* sNA = sG + 512; float4* sNB = sNA + 512;
    __syncthreads();
    if (moe_layer >= 0 && tid == 0) { const int* cnt = (const int*)(ws_ + OFF_CNT) + moe_layer * 32 * CSTR; int a = 0; for (int e = 0; e < 32; ++e) { pad[e] = a; a += ((cnt[e * CSTR] + 127) / 128) * 128; } }
    { const int bsel = tid >> 8, col = ((tid >> 6) & 3) * 256 + lane * 4;
      if (moe_layer >= 0) sG[tid] = *(const float4*)(MOD + (size_t)(moe_layer * 2 + bsel) * 6144 + 5 * 1024 + col);
      if (mode == 0) { const float* sh = MOD + (size_t)(layer * 2 + bsel) * 6144; const float4 w = *(const float4*)(as_global(pp->norm_mix) + layer * 1024 + col), s4 = *(const float4*)(sh + 1024 + col);
          sNA[tid] = make_float4(w.x * (1.f + s4.x), w.y * (1.f + s4.y), w.z * (1.f + s4.z), w.w * (1.f + s4.w)); sNB[tid] = *(const float4*)(sh + col); }
      else sNA[tid] = *(const float4*)(as_global(pp->final_norm) + col); }
    __syncthreads();
    bf16_t* H = (bf16_t*)(ws_ + OFF_H);
    const bf16_t* YB = (const bf16_t*)(ws_ + OFF_YB);
    const int* ASG = (const int*)(ws_ + OFF_ASG);
    const float* GATE = (const float*)(ws_ + OFF_GATE);
    auto load_x = [&](int row, float (&xv)[16]) {
        const float* xin = (mode == 0 && layer == 0) ? (as_global(pp->x) + (size_t)row * ND) : (as_global(pp->X) + (size_t)row * ND);
#pragma unroll
        for (int j = 0; j < 4; ++j) { const float4 v = *(const float4*)(xin + j * 256 + lane * 4); xv[4 * j] = v.x; xv[4 * j + 1] = v.y; xv[4 * j + 2] = v.z; xv[4 * j + 3] = v.w; }
    };
    auto load_y = [&](const int4& as, uint2 (&ya)[4], uint2 (&yb)[4]) {
        const bf16_t* y0 = YB + (size_t)(pad[as.x] + as.y) * ND;
        const bf16_t* y1 = YB + (size_t)(pad[as.z] + as.w) * ND;
#pragma unroll
        for (int j = 0; j < 4; ++j) { ya[j] = *(const uint2*)(y0 + j * 256 + lane * 4); yb[j] = *(const uint2*)(y1 + j * 256 + lane * 4); }
    };
    auto finish = [&](int row, float (&xv)[16], const uint2 (&ya)[4], const uint2 (&yb)[4], float g0, float g1) {
        const int bo = (row >> 13) * 256 + lane;
        float* xr = as_global(pp->X) + (size_t)row * ND;
        if (moe_layer >= 0) {
#pragma unroll
            for (int j = 0; j < 4; ++j) {
                const int col = j * 256 + lane * 4;
                const f32x4 a = unpack4(ya[j]), bq = unpack4(yb[j]); const float4 g = sG[bo + j * 64];
                xv[4 * j] += g.x * (g0 * a[0] + g1 * bq[0]); xv[4 * j + 1] += g.y * (g0 * a[1] + g1 * bq[1]);
                xv[4 * j + 2] += g.z * (g0 * a[2] + g1 * bq[2]); xv[4 * j + 3] += g.w * (g0 * a[3] + g1 * bq[3]);
                if (mode == 0) *(float4*)(xr + col) = make_float4(xv[4 * j], xv[4 * j + 1], xv[4 * j + 2], xv[4 * j + 3]);
            }
        }
        float ss = 0.f;
#pragma unroll
        for (int j = 0; j < 16; ++j) ss += xv[j] * xv[j];
        ss = wave_sum(ss);
        const float rstd = rsqrtf(ss * (1.f / 1024.f) + EPS);
        if (mode == 0) {
#pragma unroll
            for (int j = 0; j < 4; ++j) {
                const int col = j * 256 + lane * 4;
                const float4 wa = sNA[bo + j * 64], h4 = sNB[bo + j * 64];
                f32x4 ov;
                ov[0] = xv[4 * j] * rstd * wa.x + h4.x; ov[1] = xv[4 * j + 1] * rstd * wa.y + h4.y;
                ov[2] = xv[4 * j + 2] * rstd * wa.z + h4.z; ov[3] = xv[4 * j + 3] * rstd * wa.w + h4.w;
                *(uint2*)(H + (size_t)row * ND + col) = pack4(ov);
            }
        } else {
#pragma unroll
            for (int j = 0; j < 4; ++j) {
                const int col = j * 256 + lane * 4;
                const float4 w = sNA[lane + j * 64];
                *(float4*)(xr + col) = make_float4(xv[4 * j] * rstd * w.x, xv[4 * j + 1] * rstd * w.y, xv[4 * j + 2] * rstd * w.z, xv[4 * j + 3] * rstd * w.w);
            }
        }
    };
    const int stride = gridDim.x * 8, step = 2 * stride;
    const int row0 = blockIdx.x * 8 + wv;
#define RCL(r_) (((r_) < NT) ? (r_) : (NT - 1))
    int4 asA = make_int4(0, 0, 0, 0), asB = asA, nsA = asA, nsB = asA; float2 gA = make_float2(0.f, 0.f), gB = gA, ngA = gA, ngB = gA;
    float xa[16], xb[16], nxa[16], nxb[16]; uint2 yaa[4], yab[4], yba[4], ybb[4], nyaa[4], nyab[4], nyba[4], nybb[4];
#pragma unroll
    for (int j = 0; j < 4; ++j) { yaa[j] = yab[j] = yba[j] = ybb[j] = nyaa[j] = nyab[j] = nyba[j] = nybb[j] = make_uint2(0u, 0u); }
    if (moe_layer >= 0) { asA = *(const int4*)(ASG + RCL(row0) * 4); gA = *(const float2*)(GATE + RCL(row0) * 2); asB = *(const int4*)(ASG + RCL(row0 + stride) * 4); gB = *(const float2*)(GATE + RCL(row0 + stride) * 2);
                          nsA = *(const int4*)(ASG + RCL(row0 + step) * 4); ngA = *(const float2*)(GATE + RCL(row0 + step) * 2); nsB = *(const int4*)(ASG + RCL(row0 + step + stride) * 4); ngB = *(const float2*)(GATE + RCL(row0 + step + stride) * 2); }
    load_x(RCL(row0), xa); load_x(RCL(row0 + stride), xb);
    if (moe_layer >= 0) { load_y(asA, yaa, yab); load_y(asB, yba, ybb); }
    for (int row = row0; row < NT; row += step) {
        const int rowB = row + stride, nrow = row + step;
        int4 fsA = make_int4(0, 0, 0, 0), fsB = fsA; float2 fgA = make_float2(0.f, 0.f), fgB = fgA;
        if (nrow < NT) {
            if (moe_layer >= 0) { fsA = *(const int4*)(ASG + RCL(nrow + step) * 4); fgA = *(const float2*)(GATE + RCL(nrow + step) * 2); fsB = *(const int4*)(ASG + RCL(nrow + step + stride) * 4); fgB = *(const float2*)(GATE + RCL(nrow + step + stride) * 2); }
            load_x(nrow, nxa); load_x(RCL(nrow + stride), nxb);
            if (moe_layer >= 0) { load_y(nsA, nyaa, nyab); load_y(nsB, nyba, nybb); }
        }
        finish(row, xa, yaa, yab, gA.x, gA.y);
        if (rowB < NT) finish(rowB, xb, yba, ybb, gB.x, gB.y);
#pragma unroll
        for (int j = 0; j < 16; ++j) { xa[j] = nxa[j]; xb[j] = nxb[j]; }
#pragma unroll
        for (int j = 0; j < 4; ++j) { yaa[j] = nyaa[j]; yab[j] = nyab[j]; yba[j] = nyba[j]; ybb[j] = nybb[j]; }
        asA = nsA; asB = nsB; gA = ngA; gB = ngB; nsA = fsA; nsB = fsB; ngA = fgA; ngB = fgB;
    }
#undef RCL
}

struct EpiIn {
    static constexpr bool PERM = true;
    bf16_t* P; float* AUX; int ncols; int even;
    __device__ __forceinline__ void operator()(const f32x4 (&acc)[2][2][4][2], const pg8::Unit& u, int wr, int wc, int fr, int fq) const {
        const int row0 = u.pm * 256 + wr * 64 + fr, col0 = u.pn * 256 + wc * 32 + 8 * fq;
#pragma unroll
        for (int ai = 0; ai < 2; ++ai)
#pragma unroll
            for (int m = 0; m < 4; ++m) { const int r = row0 + ai * 128 + m * 16;
#pragma unroll
                for (int bj = 0; bj < 2; ++bj) { const int c = col0 + bj * 128;
                    if (c < ncols) { const uint2 lo = pack4(acc[ai][bj][m][0]), hi = pack4(acc[ai][bj][m][1]); *(uint4*)(P + (size_t)r * LDPB + c) = make_uint4(lo.x, lo.y, hi.x, hi.y); }
                    if (even) {
                        if (c == 2048) { *(f32x4*)(AUX + (size_t)r * 16) = acc[ai][bj][m][0]; *(f32x4*)(AUX + (size_t)r * 16 + 4) = acc[ai][bj][m][1]; }
                        if (c == 3912) *(f32x4*)(AUX + (size_t)r * 16 + 8) = acc[ai][bj][m][0];
                    } } }
    }
};

PHASE_FN void ph_gemm_in(const Params& p, int layer, bool even, float* smem) {
    KParams* pp = kparams();
    GU8* wsg_ = (GU8*)pp->ws; asm volatile("" : "+s"(wsg_)); unsigned char* ws_ = (unsigned char*)wsg_;
    int ldz_ = 0; asm volatile("" : "+s"(ldz_));
    const bf16_t* Wt = even ? (const bf16_t*)(ws_ + OFF_WINE) + (size_t)(layer >> 1) * 4096 * 1024 : (const bf16_t*)(ws_ + OFF_WINO) + (size_t)(layer >> 1) * 3072 * 1024;
    EpiIn E; E.P = (bf16_t*)(ws_ + OFF_P); E.AUX = (float*)(ws_ + OFF_AUX); E.ncols = even ? 3920 : 3072; E.even = even ? 1 : 0;
    pg8::DenseOrder S; S.init(64, even ? 16 : 12, gridDim.x, blockIdx.x, 1024);
    __syncthreads();
    pg8::gemm_phase<EpiIn, pg8::DenseOrder, false>((LAS unsigned char*)(g_smem + ldz_), (const bf16_t*)(ws_ + OFF_H), Wt, 1024, S, E);
    __syncthreads();
    if (!even) {
        const bf16_t* H = (const bf16_t*)(ws_ + OFF_H);
        const bf16_t* Wg = (const bf16_t*)(ws_ + OFF_WGL) + (size_t)(layer >> 1) * 128 * 1024;
        float* AUX = (float*)(ws_ + OFF_AUX);
        for (int mt = blockIdx.x; mt < 64; mt += gridDim.x) {
            const bf16_t* Ab = H + (size_t)mt * 256 * 1024;
            float* At = AUX + (size_t)mt * 256 * 16;
            gemm_tile_bf16(1024, g_smem + ldz_,
                [=](int i, int r, int k) -> uint4 { return *(const uint4*)(Ab + (size_t)r * 1024 + k); },
                [=](int i, int r, int k) -> uint4 { return *(const uint4*)(Wg + (size_t)r * 1024 + k); },
                [=](const f32x4 (&acc)[4][4], int wm, int wn, int lane) {
                    if (wn == 0 && (lane >> 4) < 4) {
#pragma unroll
                        for (int mi = 0; mi < 4; ++mi) { const int m = wm * 64 + mi * 16 + (lane & 15); *(f32x4*)(At + (size_t)m * 16 + 4 * (lane >> 4)) = acc[mi][0]; }
                    }
                });
        }
        __syncthreads();
    }
}

PHASE_FN void ph_even_tok(const Params& p, int layer, float* smem) {
    KParams* pp = kparams();
    GU8* wsg_ = (GU8*)pp->ws; asm volatile("" : "+s"(wsg_)); unsigned char* ws_ = (unsigned char*)wsg_;
    { int ldz_ = 0; asm volatile("" : "+s"(ldz_)); smem = (float*)(g_smem + ldz_); }
    int tid_ = threadIdx.x; asm volatile("" : "+v"(tid_)); const int tid = tid_, lane = tid & 63, wv = tid >> 6, li = layer >> 1;
    const bf16_t* P = (const bf16_t*)(ws_ + OFF_P); const float* AUX = (const float*)(ws_ + OFF_AUX);
    bf16_t* QB = (bf16_t*)(ws_ + OFF_QBB); bf16_t* KB = (bf16_t*)(ws_ + OFF_KBB); bf16_t* QI = (bf16_t*)(ws_ + OFF_QIB); bf16_t* KI = (bf16_t*)(ws_ + OFF_KIB); float* WI = (float*)(ws_ + OFF_WI);
    const float* COSA = (const float*)(ws_ + OFF_COSA); const float* SINA = (const float*)(ws_ + OFF_SINA);
    const float* COSI = (const float*)(ws_ + OFF_COSI); const float* SINI = (const float*)(ws_ + OFF_SINI);
    struct TokIn { float c, sn, ci0, si0, ci1, si1, wi; unsigned short q1[4], q2[4], k1[4], k2[4], qi1[2], qi2[2], ki1, ki2; };
    auto tok_load = [&](int t, TokIn& r) {
        const bf16_t* Pt = P + (size_t)t * LDPB;
        r.wi = (lane < 4) ? AUX[(size_t)t * 16 + 8 + lane] : 0.f;
        r.c = COSA[(size_t)t * 64 + lane]; r.sn = SINA[(size_t)t * 64 + lane];
#pragma unroll
        for (int h = 0; h < 4; ++h) { r.q1[h] = Pt[2056 + h * 128 + lane]; r.q2[h] = Pt[2056 + h * 128 + 64 + lane]; r.k1[h] = Pt[2568 + h * 128 + lane]; r.k2[h] = Pt[2568 + h * 128 + 64 + lane]; }
        r.ci0 = COSI[(size_t)t * 32 + (lane & 31)]; r.si0 = SINI[(size_t)t * 32 + (lane & 31)]; r.ci1 = r.ci0; r.si1 = r.si0;
#pragma unroll
        for (int rr = 0; rr < 2; ++rr) { const int item = lane + 64 * rr, hh = item >> 5, ii = item & 31; r.qi1[rr] = Pt[3592 + hh * 64 + ii]; r.qi2[rr] = Pt[3592 + hh * 64 + 32 + ii]; }
        r.ki1 = Pt[3848 + (lane & 31)]; r.ki2 = Pt[3848 + 32 + (lane & 31)];
    };
    auto tok_store = [&](int t, const TokIn& r) {
        if (lane < 4) WI[t * 4 + lane] = r.wi * 0.0625f;
#pragma unroll
        for (int h = 0; h < 4; ++h) {
            float t1 = bf16_to_f32(r.q1[h]), t2 = bf16_to_f32(r.q2[h]);
            QB[(size_t)t * 512 + h * 128 + lane] = f2bf((t1 * r.c - t2 * r.sn) * SCQ); QB[(size_t)t * 512 + h * 128 + 64 + lane] = f2bf((t2 * r.c + t1 * r.sn) * SCQ);
            t1 = bf16_to_f32(r.k1[h]); t2 = bf16_to_f32(r.k2[h]);
            KB[(size_t)t * 512 + h * 128 + lane] = f2bf(t1 * r.c - t2 * r.sn); KB[(size_t)t * 512 + h * 128 + 64 + lane] = f2bf(t2 * r.c + t1 * r.sn);
        }
#pragma unroll
        for (int rr = 0; rr < 2; ++rr) {
            const int item = lane + 64 * rr, hh = item >> 5, ii = item & 31;
            const float t1 = bf16_to_f32(r.qi1[rr]), t2 = bf16_to_f32(r.qi2[rr]);
            QI[(size_t)t * 256 + hh * 64 + ii] = f2bf(t1 * r.ci0 - t2 * r.si0); QI[(size_t)t * 256 + hh * 64 + 32 + ii] = f2bf(t2 * r.ci0 + t1 * r.si0);
        }
        if (lane < 32) {
            const float t1 = bf16_to_f32(r.ki1), t2 = bf16_to_f32(r.ki2);
            bf16_t* kd = KI + (size_t)(t >> 4) * 1024 + ((lane >> 3) * 16 + (t & 15)) * 8 + (lane & 7);
            kd[0] = f2bf(t1 * r.ci0 - t2 * r.si0); kd[512] = f2bf(t2 * r.ci0 + t1 * r.si0);
        }
    };
    { const int tstep = gridDim.x * 8;
      for (int t = blockIdx.x * 8 + wv; t < NT; t += 4 * tstep) {
          const int tB = t + tstep, tC = t + 2 * tstep, tD = t + 3 * tstep; const bool hasB = tB < NT, hasC = tC < NT, hasD = tD < NT;
          TokIn ra, rb, rc, rd;
          tok_load(t, ra); tok_load(hasB ? tB : t, rb); tok_load(hasC ? tC : t, rc); tok_load(hasD ? tD : t, rd);
          tok_store(t, ra); if (hasB) tok_store(tB, rb); if (hasC) tok_store(tC, rc); if (hasD) tok_store(tD, rd);
      } }
    { bf16_t* VT = (bf16_t*)(ws_ + OFF_VT);
      bf16_t* sv = (bf16_t*)g_smem;
      for (int item = blockIdx.x; item < 2 * 128 * 4; item += gridDim.x) {
          const int h = item & 3, tt = item >> 2, b = tt >> 7, s0 = (tt & 127) * 64;
          __syncthreads();
          for (int e = tid; e < 64 * 128; e += NTHREADS) { const int i = e >> 7, d = e & 127; sv[d * 72 + i] = P[(size_t)(b * 8192 + s0 + i) * LDPB + 3080 + h * 128 + d]; }
          __syncthreads();
          for (int e = tid; e < 128 * 8; e += NTHREADS) { const int d = e >> 3, c = e & 7;
              *(uint4*)(VT + ((size_t)((b * 4 + h) * 128 + d)) * 8192 + s0 + c * 8) = *(const uint4*)(sv + d * 72 + c * 8); }
      } }
}

__device__ __forceinline__ f32x4 mma_lds(const unsigned char* A, int sa, int a0, const unsigned char* B, int sb, int b0, int K, f32x4 acc, int c16, int q4) {
    const unsigned char* ap = A + (a0 + c16) * sa + q4 * 16;
    const unsigned char* bp = B + (b0 + c16) * sb + q4 * 16;
#pragma unroll
    for (int kk = 0; kk < K; kk += 32) { acc = __builtin_amdgcn_mfma_f32_16x16x32_bf16(*(const bf16x8*)(ap + kk * 2), *(const bf16x8*)(bp + kk * 2), acc, 0, 0, 0); }
    return acc;
}

PHASE_FN void ph_gdn_chunk(const Params& p, int layer, float* smem) {
    KParams* pp = kparams();
    GU8* wsg_ = (GU8*)pp->ws; asm volatile("" : "+s"(wsg_)); unsigned char* ws_ = (unsigned char*)wsg_;
    int tid_ = threadIdx.x; asm volatile("" : "+v"(tid_)); const int tid = tid_, lane = tid & 63, wv = __builtin_amdgcn_readfirstlane(tid >> 6), q4 = lane >> 4, c16 = lane & 15;
    int ldz_ = 0; asm volatile("" : "+s"(ldz_)); unsigned char* lds = g_smem + ldz_;
    constexpr int SN = 272, ST = 144;
    unsigned char* bKN = lds;
    unsigned char* bQN = lds + 18432;
    unsigned char* bKBG = lds + 35840;
    unsigned char* bVB = lds + 54272;
    unsigned char* bKD = lds + 72704;
    unsigned char* bUT = lds + 91136;
    float* sL = (float*)(lds + 109568);
    unsigned char* bAQK = lds + 126976;
    unsigned char* bTB = lds + 136192;
    float* sG = (float*)(lds + 145408); float* sB = sG + 64; float* sEg = sB + 64;
    const int li = layer >> 1;
    const bf16_t* P = (const bf16_t*)(ws_ + OFF_P); const float* AUX = (const float*)(ws_ + OFF_AUX);
    const float* cw = as_global(pp->conv_w) + (size_t)li * 4 * 1536;
    uint4* PFR = (uint4*)(ws_ + OFF_PFR); uint4* RFR = (uint4*)(ws_ + OFF_RFR); uint2* QFR = (uint2*)(ws_ + OFF_QFR); uint2* OFR = (uint2*)(ws_ + OFF_OFR);
    float* GL = (float*)(ws_ + OFF_GL);
    for (int ci = blockIdx.x; ci < 1024; ci += gridDim.x) {
        const int b = ci >> 9, h = (ci >> 7) & 3, n = ci & 127;
        const int t0 = b * 8192 + n * 64;
        __syncthreads();
        if (tid < 64) { float g = -expf(as_global(pp->a_log)[li * 4 + h]) * softplusf_(AUX[(size_t)(t0 + tid) * 16 + 4 + h] + as_global(pp->dt_bias)[li * 4 + h]);
#pragma unroll
            for (int o = 1; o < 64; o <<= 1) { const float nb = __shfl_up(g, o); if (lane >= o) g += nb; }
            sG[tid] = g; sB[tid] = sigmoidf_(AUX[(size_t)(t0 + tid) * 16 + h]); sEg[tid] = expf(g); }
        for (int e = tid; e < 64 * 36; e += NTHREADS) ((unsigned*)bAQK)[e] = 0u;
        __syncthreads();
        const float gl = sG[63];
        for (int rep_a = 0; rep_a < REP_A; ++rep_a)
        {
            const int d0 = 2 * lane, cb = h * 128 + d0, s00 = n * 64;
            float wq[4][2], wk[4][2], wvv[4][2];
#pragma unroll
            for (int jj = 0; jj < 4; ++jj) { wq[jj][0] = cw[jj * 1536 + cb]; wq[jj][1] = cw[jj * 1536 + cb + 1]; wk[jj][0] = cw[jj * 1536 + 512 + cb]; wk[jj][1] = cw[jj * 1536 + 512 + cb + 1];
                                            wvv[jj][0] = cw[jj * 1536 + 1024 + cb]; wvv[jj][1] = cw[jj * 1536 + 1024 + cb + 1]; }
            float tk0[8], tk1[8], tv0[8], tv1[8], td0[8], td1[8];
#pragma unroll
            for (int rp2 = 0; rp2 < 4; ++rp2) {
                unsigned uq[2][4], uk[2][4], uv[2][4];
#pragma unroll
                for (int rr = 0; rr < 2; ++rr) { const int i = wv * 8 + rp2 * 2 + rr;
#pragma unroll
                    for (int jj = 0; jj < 4; ++jj) {
                        const bool okr = s00 + i - 3 + jj >= 0;
                        const bf16_t* rp = P + (size_t)(okr ? t0 + i - 3 + jj : t0) * LDPB + cb;
                        uq[rr][jj] = *(const unsigned*)rp; uk[rr][jj] = *(const unsigned*)(rp + 512); uv[rr][jj] = *(const unsigned*)(rp + 1024); } }
                asm volatile("" : "+v"(uq[0][0]), "+v"(uq[0][1]), "+v"(uq[0][2]), "+v"(uq[0][3]), "+v"(uk[0][0]), "+v"(uk[0][1]), "+v"(uk[0][2]), "+v"(uk[0][3]), "+v"(uv[0][0]), "+v"(uv[0][1]), "+v"(uv[0][2]), "+v"(uv[0][3]),
                                  "+v"(uq[1][0]), "+v"(uq[1][1]), "+v"(uq[1][2]), "+v"(uq[1][3]), "+v"(uk[1][0]), "+v"(uk[1][1]), "+v"(uk[1][2]), "+v"(uk[1][3]), "+v"(uv[1][0]), "+v"(uv[1][1]), "+v"(uv[1][2]), "+v"(uv[1][3]));
#pragma unroll
                for (int rr = 0; rr < 2; ++rr) { const int r = rp2 * 2 + rr, i = wv * 8 + r;
                    float aq0 = 0.f, aq1 = 0.f, ak0 = 0.f, ak1 = 0.f, av0 = 0.f, av1 = 0.f;
#pragma unroll
                    for (int jj = 0; jj < 4; ++jj) {
                        const bool okr = s00 + i - 3 + jj >= 0;
                        const unsigned q_ = okr ? uq[rr][jj] : 0u, k_ = okr ? uk[rr][jj] : 0u, v_ = okr ? uv[rr][jj] : 0u;
                        aq0 += wq[jj][0] * __uint_as_float(q_ << 16); aq1 += wq[jj][1] * __uint_as_float(q_ & 0xffff0000u);
                        ak0 += wk[jj][0] * __uint_as_float(k_ << 16); ak1 += wk[jj][1] * __uint_as_float(k_ & 0xffff0000u);
                        av0 += wvv[jj][0] * __uint_as_float(v_ << 16); av1 += wvv[jj][1] * __uint_as_float(v_ & 0xffff0000u);
                    }
                    aq0 = siluf_(aq0); aq1 = siluf_(aq1); ak0 = siluf_(ak0); ak1 = siluf_(ak1); av0 = siluf_(av0); av1 = siluf_(av1);
                    const float rq = rsqrtf(wave_sum(aq0 * aq0 + aq1 * aq1) + EPS), rk = rsqrtf(wave_sum(ak0 * ak0 + ak1 * ak1) + EPS);
                    aq0 *= rq; aq1 *= rq; ak0 *= rk; ak1 *= rk;
                    const float be = sB[i], eg_i = sEg[i], ekd = expf(gl - sG[i]);
                    *(unsigned*)(bKN + i * SN + d0 * 2) = cvt_pk_bf16(ak0, ak1);
                    *(unsigned*)(bQN + i * SN + d0 * 2) = cvt_pk_bf16(aq0, aq1);
                    tk0[r] = ak0 * be * eg_i; tk1[r] = ak1 * be * eg_i; tv0[r] = av0 * be; tv1[r] = av1 * be; td0[r] = ak0 * ekd; td1[r] = ak1 * ekd;
                }
            }
#define PK8(T) make_uint4(cvt_pk_bf16(T[0], T[1]), cvt_pk_bf16(T[2], T[3]), cvt_pk_bf16(T[4], T[5]), cvt_pk_bf16(T[6], T[7]))
            *(uint4*)(bKBG + d0 * ST + wv * 16) = PK8(tk0); *(uint4*)(bKBG + (d0 + 1) * ST + wv * 16) = PK8(tk1);
            *(uint4*)(bVB + d0 * ST + wv * 16) = PK8(tv0); *(uint4*)(bVB + (d0 + 1) * ST + wv * 16) = PK8(tv1);
            *(uint4*)(bKD + d0 * ST + wv * 16) = PK8(td0); *(uint4*)(bKD + (d0 + 1) * ST + wv * 16) = PK8(td1);
        }
        __syncthreads();
        for (int u = wv; u < 20; u += 8) {
            const int kind = (u >= 10) ? 1 : 0, idx = u - kind * 10;
            const int ti = (idx >= 6) ? 3 : (idx >= 3) ? 2 : (idx >= 1) ? 1 : 0, tj = idx - ((ti * (ti + 1)) >> 1);
            f32x4 acc = (f32x4){0.f, 0.f, 0.f, 0.f};
            acc = mma_lds(kind ? bQN : bKN, SN, 16 * ti, bKN, SN, 16 * tj, 128, acc, c16, q4);
            const int j = 16 * tj + c16;
#pragma unroll
            for (int r = 0; r < 4; ++r) { const int i = 16 * ti + 4 * q4 + r;
                const float dec = (j <= i) ? expf(sG[i] - sG[j]) : 0.f;
                if (kind == 0) sL[i * 68 + j] = (j < i) ? sB[i] * acc[r] * dec : 0.f;
                else *(bf16_t*)(bAQK + i * ST + j * 2) = f2bf(acc[r] * SCALE128 * dec); }
        }
        __syncthreads();
        for (int rep_b = 0; rep_b < REP_B; ++rep_b)
        if (wv == 0) {
            float t[64];
            int zz = 0; asm volatile("" : "+v"(zz)); const float* sLo = sL + zz;
#pragma clang loop unroll(full)
            for (int i = 0; i < 64; ++i) { float a0 = (i == lane) ? 1.f : 0.f, a1 = 0.f, a2 = 0.f, a3 = 0.f;
#define LQ(q) float4 lv##q = make_float4(0.f, 0.f, 0.f, 0.f); if (4 * q < i) lv##q = *(const float4*)(sLo + i * 68 + 4 * q);
#define FQ(q) if (4 * q < i) { a0 -= lv##q.x * t[4 * q]; if (4 * q + 1 < i) a1 -= lv##q.y * t[4 * q + 1]; if (4 * q + 2 < i) a2 -= lv##q.z * t[4 * q + 2]; if (4 * q + 3 < i) a3 -= lv##q.w * t[4 * q + 3]; }
                { LQ(0) LQ(1) LQ(2) LQ(3) LQ(4) LQ(5) LQ(6) LQ(7)
                  FQ(0) FQ(1) FQ(2) FQ(3) FQ(4) FQ(5) FQ(6) FQ(7) }
                if (i > 32) { asm volatile("" ::: "memory");
                  LQ(8) LQ(9) LQ(10) LQ(11) LQ(12) LQ(13) LQ(14) LQ(15)
                  FQ(8) FQ(9) FQ(10) FQ(11) FQ(12) FQ(13) FQ(14) FQ(15) }
                t[i] = (a0 + a1) + (a2 + a3); asm volatile("" ::: "memory"); }
#pragma unroll
            for (int i = 0; i < 64; ++i) *(bf16_t*)(bTB + i * ST + lane * 2) = f2bf(t[i]);
        }
        __syncthreads();
#pragma unroll 4
        for (int x = 0; x < 8; ++x) {
            const int u = wv * 8 + x, kind = u >> 5, ti = (u >> 3) & 3, td = u & 7;
            f32x4 acc = (f32x4){0.f, 0.f, 0.f, 0.f};
            acc = mma_lds(bTB, ST, 16 * ti, kind ? bVB : bKBG, ST, 16 * td, 64, acc, c16, q4);
            *(uint2*)((kind ? bUT : bKN) + (16 * td + c16) * ST + (16 * ti + 4 * q4) * 2) = pack4(acc);
        }
        __syncthreads();
        unsigned char* bWT = bKN;
        const float eg = expf(gl);
        for (int rep_c = 0; rep_c < REP_C; ++rep_c) {
        for (int x = 0; x < 4; ++x) {
            const int u = wv * 4 + x, ti = u >> 2, a = u & 3;
            uint4 fr;
#pragma unroll
            for (int hf = 0; hf < 2; ++hf) { const int tk = 2 * a + hf;
                f32x4 acc = (f32x4){0.f, 0.f, 0.f, 0.f};
                acc = mma_lds(bWT, ST, 16 * tk, bKD, ST, 16 * ti, 64, acc, c16, q4);
                f32x4 v;
#pragma unroll
                for (int r = 0; r < 4; ++r) v[r] = ((16 * tk + 4 * q4 + r) == (16 * ti + c16) ? eg : 0.f) - acc[r];
                const uint2 pk = pack4(v);
                if (hf == 0) { fr.x = pk.x; fr.y = pk.y; } else { fr.z = pk.x; fr.w = pk.y; } }
            PFR[((size_t)(ci * 8 + ti) * 4 + a) * 64 + lane] = fr;
        }
        for (int x = 0; x < 2; ++x) {
            const int u = wv * 2 + x, ti = u >> 2, a = u & 3;
            uint4 fr;
            const int i = 16 * ti + c16;
            const float qs = SCALE128 * sEg[i];
#pragma unroll
            for (int hf = 0; hf < 2; ++hf) { const int tk = 2 * a + hf;
                f32x4 acc = (f32x4){0.f, 0.f, 0.f, 0.f};
                acc = mma_lds(bWT, ST, 16 * tk, bAQK, ST, 16 * ti, 64, acc, c16, q4);
                const f32x4 qv = unpack4(*(const uint2*)(bQN + i * SN + (16 * tk + 4 * q4) * 2));
                const uint2 pk = pack4(qv * qs - acc);
                if (hf == 0) { fr.x = pk.x; fr.y = pk.y; } else { fr.z = pk.x; fr.w = pk.y; } }
            RFR[((size_t)(ci * 4 + ti) * 4 + a) * 64 + lane] = fr;
        }
#pragma unroll 4
        for (int x = 0; x < 8; ++x) {
            const int u = wv * 8 + x, tdv = u >> 3, tdk = u & 7;
            f32x4 acc = (f32x4){0.f, 0.f, 0.f, 0.f};
            acc = mma_lds(bKD, ST, 16 * tdk, bUT, ST, 16 * tdv, 64, acc, c16, q4);
            QFR[((size_t)(ci * 8 + tdv) * 8 + tdk) * 64 + lane] = pack4(acc);
        }
#pragma unroll
        for (int x = 0; x < 4; ++x) {
            const int u = wv * 4 + x, tdv = u >> 2, ti = u & 3;
            f32x4 acc = (f32x4){0.f, 0.f, 0.f, 0.f};
            acc = mma_lds(bAQK, ST, 16 * ti, bUT, ST, 16 * tdv, 64, acc, c16, q4);
            OFR[((size_t)(ci * 8 + tdv) * 4 + ti) * 64 + lane] = pack4(acc);
        }
        }
        if (tid == 0) GL[ci] = gl;
    }
}

__device__ __forceinline__ void gs_load(uint4 (&d)[12], const unsigned char* pp, const unsigned char* rr, const unsigned char* qq, const unsigned char* oo, const int lt) {
#pragma unroll
    for (int i = 0; i < 6; ++i) { int c = lt + 384 * i; c = c < 2048 ? c : 2047; d[i] = *(const uint4*)(pp + c * 16); }
#pragma unroll
    for (int i = 0; i < 3; ++i) { int c = lt + 384 * i; c = c < 1024 ? c : 1023; d[6 + i] = *(const uint4*)(rr + c * 16); }
#pragma unroll
    for (int i = 0; i < 2; ++i) { int c = lt + 384 * i; c = c < 512 ? c : 511; d[9 + i] = *(const uint4*)(qq + c * 16); }
    { const int c = lt < 256 ? lt : 255; d[11] = *(const uint4*)(oo + c * 16); }
}
__device__ __forceinline__ void gs_store(const uint4 (&d)[12], unsigned char* sb, const int lt) {
#pragma unroll
    for (int i = 0; i < 6; ++i) { const int c = lt + 384 * i; if (c < 2048) *(uint4*)(sb + c * 16) = d[i]; }
#pragma unroll
    for (int i = 0; i < 3; ++i) { const int c = lt + 384 * i; if (c < 1024) *(uint4*)(sb + 32768 + c * 16) = d[6 + i]; }
#pragma unroll
    for (int i = 0; i < 2; ++i) { const int c = lt + 384 * i; if (c < 512) *(uint4*)(sb + 49152 + c * 16) = d[9 + i]; }
    if (lt < 256) *(uint4*)(sb + 57344 + lt * 16) = d[11];
}

#define SCAN_BODY                 bf16x8 Sb[4]; \
_Pragma("unroll") \
                for (int a = 0; a < 4; ++a) { union { uint4 u; bf16x8 v; } cv; const uint2 lo = pack4(S[2 * a]), hi = pack4(S[2 * a + 1]); cv.u.x = lo.x; cv.u.y = lo.y; cv.u.z = hi.x; cv.u.w = hi.y; Sb[a] = cv.v; } \
                const int t0 = b * 8192 + n * 64; \
                {   f32x4 oa[4]; \
_Pragma("unroll") \
                    for (int ti = 0; ti < 4; ++ti) oa[ti] = unpack4(*(const uint2*)(Of + ti * 512)); \
_Pragma("unroll") \
                    for (int a = 0; a < 4; ++a) \
_Pragma("unroll") \
                        for (int ti = 0; ti < 4; ++ti) oa[ti] = __builtin_amdgcn_mfma_f32_16x16x32_bf16(*(const bf16x8*)(Rf + (ti * 4 + a) * 1024), Sb[a], oa[ti], 0, 0, 0); \
_Pragma("unroll") \
                    for (int ti = 0; ti < 4; ++ti) { \
                        float* op = O + (size_t)(t0 + 16 * ti + 4 * q4) * 1024 + h * 128 + 16 * tdv + c16; \
                        op[0] = oa[ti][0]; op[1024] = oa[ti][1]; op[2048] = oa[ti][2]; op[3072] = oa[ti][3]; } \
                } \
                asm volatile("" ::: "memory"); \
_Pragma("unroll") \
                for (int g = 0; g < 2; ++g) { \
                    f32x4 sa[4]; \
_Pragma("unroll") \
                    for (int t = 0; t < 4; ++t) sa[t] = unpack4(*(const uint2*)(Qf + (g * 4 + t) * 512)); \
_Pragma("unroll") \
                    for (int a = 0; a < 4; ++a) \
_Pragma("unroll") \
                        for (int t = 0; t < 4; ++t) sa[t] = __builtin_amdgcn_mfma_f32_16x16x32_bf16(*(const bf16x8*)(Pf + ((g * 4 + t) * 4 + a) * 1024), Sb[a], sa[t], 0, 0, 0); \
_Pragma("unroll") \
                    for (int t = 0; t < 4; ++t) S[g * 4 + t] = sa[t]; \
                    asm volatile("" ::: "memory"); \
                }
PHASE_FN void ph_gdn_scan(const Params& p, float* smem) {
    KParams* pp = kparams();
    GU8* wsg_ = (GU8*)pp->ws; asm volatile("" : "+s"(wsg_)); unsigned char* ws_ = (unsigned char*)wsg_;
    int tid_ = threadIdx.x; asm volatile("" : "+v"(tid_)); const int tid = tid_, lane = tid & 63, wv = __builtin_amdgcn_readfirstlane(tid >> 6), q4 = lane >> 4, c16 = lane & 15;
    int ldz_ = 0; asm volatile("" : "+s"(ldz_)); unsigned char* lds = g_smem + ldz_;
    constexpr int STG = 61440;
    const unsigned char* PFR = ws_ + OFF_PFR; const unsigned char* RFR = ws_ + OFF_RFR; const unsigned char* QFR = ws_ + OFF_QFR; const unsigned char* OFR = ws_ + OFF_OFR;
    float* O = (float*)(ws_ + OFF_O);
    for (int it = blockIdx.x; it < 32; it += gridDim.x) {
        const int bh = it >> 2, pair = it & 3, b = bh >> 2, h = bh & 3;
        __syncthreads();
        if (wv >= 2) {
            const int lt = tid - 128;
            const unsigned char* Pb = PFR + (size_t)bh * 128 * 32768;
            const unsigned char* Rb = RFR + (size_t)bh * 128 * 16384;
            const unsigned char* Qb = QFR + (size_t)bh * 128 * 32768 + pair * 8192;
            const unsigned char* Ob = OFR + (size_t)bh * 128 * 16384 + pair * 4096;
            uint4 ra0, ra1, ra2, ra3, ra4, ra5, ra6, ra7, ra8, ra9, ra10, ra11, rb0, rb1, rb2, rb3, rb4, rb5, rb6, rb7, rb8, rb9, rb10, rb11;
            uint4 rc0, rc1, rc2, rc3, rc4, rc5, rc6, rc7, rc8, rc9, rc10, rc11;
#define LDC(base_, c_, mx_) (*(const uint4*)((base_) + (size_t)(((c_) < (mx_)) ? (c_) : (mx_)) * 16))
#define GS_LOAD(X, n_) do { const unsigned char* pp_ = Pb + (size_t)(n_) * 32768; const unsigned char* rr_ = Rb + (size_t)(n_) * 16384; \
                const unsigned char* qq_ = Qb + (size_t)(n_) * 32768; const unsigned char* oo_ = Ob + (size_t)(n_) * 16384; \
                X##0 = LDC(pp_, lt, 2047); X##1 = LDC(pp_, lt + 384, 2047); X##2 = LDC(pp_, lt + 768, 2047); X##3 = LDC(pp_, lt + 1152, 2047); X##4 = LDC(pp_, lt + 1536, 2047); X##5 = LDC(pp_, lt + 1920, 2047); \
                X##6 = LDC(rr_, lt, 1023); X##7 = LDC(rr_, lt + 384, 1023); X##8 = LDC(rr_, lt + 768, 1023); \
                X##9 = LDC(qq_, lt, 511); X##10 = LDC(qq_, lt + 384, 511); X##11 = LDC(oo_, lt, 255); } while (0)
#define STC(off_, c_, lim_, v_) do { if ((c_) < (lim_)) *(uint4*)(sb_ + (off_) + (c_) * 16) = v_; } while (0)
#define GS_STORE(X, st_) do { unsigned char* sb_ = lds + (st_) * STG; \
                STC(0, lt, 2048, X##0); STC(0, lt + 384, 2048, X##1); STC(0, lt + 768, 2048, X##2); STC(0, lt + 1152, 2048, X##3); STC(0, lt + 1536, 2048, X##4); STC(0, lt + 1920, 2048, X##5); \
                STC(32768, lt, 1024, X##6); STC(32768, lt + 384, 1024, X##7); STC(32768, lt + 768, 1024, X##8); \
                STC(49152, lt, 512, X##9); STC(49152, lt + 384, 512, X##10); STC(57344, lt, 256, X##11); } while (0)
            GS_LOAD(ra, 0); GS_STORE(ra, 0);
            GS_LOAD(rb, 1); GS_LOAD(rc, 2); GS_LOAD(ra, 3);
            __syncthreads();
#define CLAMPN(x_) (((x_) < 128) ? (x_) : 127)
            for (int n = 0; n < 128; n += 3) {
                if (n + 1 < 128) GS_STORE(rb, (n + 1) & 1);
                GS_LOAD(rb, CLAMPN(n + 4)); LBAR();
                if (n + 1 < 128) { if (n + 2 < 128) GS_STORE(rc, (n + 2) & 1);
                    GS_LOAD(rc, CLAMPN(n + 5)); LBAR(); }
                if (n + 2 < 128) { if (n + 3 < 128) GS_STORE(ra, (n + 3) & 1);
                    GS_LOAD(ra, CLAMPN(n + 6)); LBAR(); }
            }
        } else {
            const int tdv = pair * 2 + wv;
            f32x4 S[8];
#pragma unroll
            for (int t = 0; t < 8; ++t) S[t] = (f32x4){0.f, 0.f, 0.f, 0.f};
            __syncthreads();
            for (int n = 0; n < 128; ++n) {
                const unsigned char* base = lds + (n & 1) * STG;
                const unsigned char* Pf = base + lane * 16, *Rf = base + 32768 + lane * 16;
                const unsigned char* Qf = base + 49152 + wv * 4096 + lane * 8, *Of = base + 57344 + wv * 2048 + lane * 8;
                SCAN_BODY
                LBAR();
            }
        }
    }
}

__device__ __forceinline__ void block_sum4(int (&v)[4], int* buf) {
    const int lane = threadIdx.x & 63, wv = threadIdx.x >> 6;
#pragma unroll
    for (int q = 0; q < 4; ++q) v[q] = wave_sum_i(v[q]);
    if (lane == 0) {
#pragma unroll
        for (int q = 0; q < 4; ++q) buf[wv * 4 + q] = v[q];
    }
    __syncthreads();
#pragma unroll
    for (int q = 0; q < 4; ++q) { int a = 0; for (int w = 0; w < 8; ++w) a += buf[w * 4 + q]; v[q] = a; }
}

PHASE_FN void ph_dsa_topk(const Params& p, int layer, float* smem) {
    KParams* pp = kparams();
    GU8* wsg_ = (GU8*)pp->ws; asm volatile("" : "+s"(wsg_)); unsigned char* ws_ = (unsigned char*)wsg_;
    int tid_ = threadIdx.x; asm volatile("" : "+v"(tid_)); const int tid = tid_, lane = tid & 63, wv = __builtin_amdgcn_readfirstlane(tid >> 6), q4 = lane >> 4, c16 = lane & 15;
    int* sRed = (int*)g_smem;
    const bf16_t* QIb = (const bf16_t*)(ws_ + OFF_QIB); const bf16_t* KIb = (const bf16_t*)(ws_ + OFF_KIB); const float* WI = (const float*)(ws_ + OFF_WI);
    unsigned short* M16 = (unsigned short*)(ws_ + OFF_M16);
    int* qhead = (int*)(ws_ + OFF_QCTR) + layer * 16;
    int* sIt = (int*)(g_smem + 512);
    __syncthreads();
    if (tid == 0) *sIt = atomicAdd(qhead, 1);
    __syncthreads();
    int it = *sIt;
    while (it < 2048) {
        int nxt = 0;
        const int b = it & 1, gp = 1023 - (it >> 1);
        const int s0 = gp * 8, t0 = b * 8192 + s0;
        const int ntiles = (s0 >> 4) + 1;
        const int nreg = (ntiles > wv) ? ((ntiles - wv + 7) >> 3) : 0;
        const bf16_t* qp = QIb + (size_t)(t0 + (c16 >> 2)) * 256 + (c16 & 3) * 64 + 8 * q4;
        const bf16x8 a0A = *(const bf16x8*)qp, a1A = *(const bf16x8*)(qp + 32), a0B = *(const bf16x8*)(qp + 4 * 256), a1B = *(const bf16x8*)(qp + 4 * 256 + 32);
        const float4 wqA = *(const float4*)(WI + (size_t)(t0 + q4) * 4), wqB = *(const float4*)(WI + (size_t)(t0 + 4 + q4) * 4);
        const int myqA = s0 + q4, myqB = s0 + 4 + q4;
        int c16s = c16; asm volatile("" : "+v"(c16s));
        int lanes = lane; asm volatile("" : "+v"(lanes));
        int wvs = wv; asm volatile("" : "+s"(wvs));
        unsigned kA[64], kB[64];
#pragma unroll
        for (int i = 0; i < 64; ++i) { kA[i] = 0u; kB[i] = 0u; }
#define RELU_(x_) __builtin_amdgcn_fmed3f((x_), 0.f, __builtin_inff())
#define SC_TILE(il_, tile_, k0_, k1_) { \
                    f32x4 accA = (f32x4){0.f, 0.f, 0.f, 0.f}, accB = accA; \
                    accA = __builtin_amdgcn_mfma_f32_16x16x32_bf16(a0A, k0_, accA, 0, 0, 0); \
                    accB = __builtin_amdgcn_mfma_f32_16x16x32_bf16(a0B, k0_, accB, 0, 0, 0); \
                    accA = __builtin_amdgcn_mfma_f32_16x16x32_bf16(a1A, k1_, accA, 0, 0, 0); \
                    accB = __builtin_amdgcn_mfma_f32_16x16x32_bf16(a1B, k1_, accB, 0, 0, 0); \
                    const float sa = fmaf(wqA.w, RELU_(accA[3]), fmaf(wqA.z, RELU_(accA[2]), fmaf(wqA.y, RELU_(accA[1]), wqA.x * RELU_(accA[0])))); \
                    const float sb = fmaf(wqB.w, RELU_(accB[3]), fmaf(wqB.z, RELU_(accB[2]), fmaf(wqB.y, RELU_(accB[1]), wqB.x * RELU_(accB[0])))); \
                    const int kidx = (tile_) * 16 + c16s; \
                    kA[il_] = (kidx <= myqA) ? ordkey(sa) : 0u; \
                    kB[il_] = (kidx <= myqB) ? ordkey(sb) : 0u; }
        const int nblk = (nreg + 15) >> 4;
        for (int rep_s = 0; rep_s < REP_S; ++rep_s) {
        if (rep_s > 0) {
#pragma unroll
            for (int i = 0; i < 64; ++i) { kA[i] = 0u; kB[i] = 0u; } }
#pragma nounroll
        for (int blk = nblk - 1; blk >= 0; --blk) {
#pragma unroll
            for (int i = 63; i >= 16; --i) { kA[i] = kA[i - 16]; kB[i] = kB[i - 16]; }
#pragma unroll
            for (int i = 0; i < 16; ++i) { kA[i] = 0u; kB[i] = 0u; }
            const int tb = wvs + 128 * blk;
#pragma unroll
            for (int g = 0; g < 4; ++g) { const int tg = tb + 32 * g;
                if (tg < ntiles) {
                    const bf16_t* kp = KIb + (size_t)(b * 512 + tg) * 1024 + lanes * 8;
                    const bf16x8 k00 = *(const bf16x8*)kp, k01 = *(const bf16x8*)(kp + 512);
                    const bf16x8 k10 = *(const bf16x8*)(kp + 8 * 1024), k11 = *(const bf16x8*)(kp + 8 * 1024 + 512);
                    const bf16x8 k20 = *(const bf16x8*)(kp + 16 * 1024), k21 = *(const bf16x8*)(kp + 16 * 1024 + 512);
                    const bf16x8 k30 = *(const bf16x8*)(kp + 24 * 1024), k31 = *(const bf16x8*)(kp + 24 * 1024 + 512);
                    SC_TILE(g * 4, tg, k00, k01) SC_TILE(g * 4 + 1, tg + 8, k10, k11) SC_TILE(g * 4 + 2, tg + 16, k20, k21) SC_TILE(g * 4 + 3, tg + 24, k30, k31)
                }
                asm volatile("" ::: "memory"); }
        }
        }
        if (tid == 0) nxt = atomicAdd(qhead, 1);
        const int keffA = (myqA + 1 < 256) ? (myqA + 1) : 256, keffB = (myqB + 1 < 256) ? (myqB + 1) : 256;
        int par = 0;
        int mydone = 0, alldone = 0;
        auto qsum = [&](int c) -> int {
            c += __builtin_amdgcn_update_dpp(0, c, 0xB1, 0xf, 0xf, true);
            c += __builtin_amdgcn_update_dpp(0, c, 0x4E, 0xf, 0xf, true);
            c += __builtin_amdgcn_update_dpp(0, c, 0x124, 0xf, 0xf, true);
            c += __builtin_amdgcn_update_dpp(0, c, 0x128, 0xf, 0xf, true);
            par ^= 1;
            sRed[par * 32 + q4 * 8 + wv] = c;
            LBAR();
            const int4 r0 = *(const int4*)(sRed + par * 32 + q4 * 8), r1 = *(const int4*)(sRed + par * 32 + q4 * 8 + 4);
            return r0.x + r0.y + r0.z + r0.w + r1.x + r1.y + r1.z + r1.w;
        };
        const bool has1 = nreg > 32;
#define TR_STEP(a, base, J_, M_) { _Pragma("unroll") for (int k_ = 0; k_ < 32; ++k_) if ((k_ & (J_)) == 0) { \
                const unsigned lo_ = a[(base) + k_], hi_ = a[(base) + k_ + (J_)]; \
                a[(base) + k_] = ((M_) & lo_) | (~(M_) & (hi_ << (J_))); \
                a[(base) + k_ + (J_)] = ((M_) & (lo_ >> (J_))) | (~(M_) & hi_); } }
#define TR32(a, base) { TR_STEP(a, base, 16, 0x0000FFFFu) TR_STEP(a, base, 8, 0x00FF00FFu) TR_STEP(a, base, 4, 0x0F0F0F0Fu) TR_STEP(a, base, 2, 0x33333333u) TR_STEP(a, base, 1, 0x55555555u) }
        for (int rep_t = 0; rep_t < REP_T; ++rep_t) {
        TR32(kA, 0) TR32(kB, 0)
        if (has1) { TR32(kA, 32) TR32(kB, 32) } }
        unsigned alA0, alA1, alB0, alB1, gmA0, gmA1, gmB0, gmB1;
        int GA, GB;
        for (int rep_q = 0; rep_q < REP_Q; ++rep_q) {
        alA0 = ~0u; alA1 = has1 ? ~0u : 0u; alB0 = ~0u; alB1 = alA1; gmA0 = 0u; gmA1 = 0u; gmB0 = 0u; gmB1 = 0u; GA = 0; GB = 0; mydone = 0; alldone = 0;
#pragma unroll
        for (int bit = 31; bit >= 0; --bit) {
            if (alldone) continue;
            const unsigned mA0 = alA0 & kA[bit], mA1 = alA1 & kA[32 + bit], mB0 = alB0 & kB[bit], mB1 = alB1 & kB[32 + bit];
            const int ca = __builtin_popcount(mA0) + __builtin_popcount(mA1), cb = __builtin_popcount(mB0) + __builtin_popcount(mB1);
            const int tot = qsum(ca | (cb << 16));
            const int tA = GA + (tot & 0xffff), tB = GB + (tot >> 16);
            if (tA >= keffA) { alA0 = mA0; alA1 = mA1; mydone = (mydone & 2) | ((tA == keffA) ? 1 : 0); }
            else { GA = tA; gmA0 |= mA0; gmA1 |= mA1; alA0 ^= mA0; alA1 ^= mA1; }
            if (tB >= keffB) { alB0 = mB0; alB1 = mB1; mydone = (mydone & 1) | ((tB == keffB) ? 2 : 0); }
            else { GB = tB; gmB0 |= mB0; gmB1 |= mB1; alB0 ^= mB0; alB1 ^= mB1; }
            alldone = (__ballot(mydone == 3) == ~0ull) ? 1 : 0;
        }
        }
        const int ce = qsum((__builtin_popcount(alA0) + __builtin_popcount(alA1)) | ((__builtin_popcount(alB0) + __builtin_popcount(alB1)) << 16));
        const int needA = keffA - GA, needB = keffB - GB;
        par ^= 1;
        sRed[par * 32 + q4 * 8 + wv] = (((ce & 0xffff) > needA) || ((ce >> 16) > needB)) ? 1 : 0;
        LBAR();
        int anyov = 0;
#pragma unroll
        for (int w = 0; w < 32; ++w) anyov |= sRed[par * 32 + w];
        if (anyov) {
            int JA = 0, JB = 0;
            int c16j = c16; asm volatile("" : "+v"(c16j));
            int wvj = wv; asm volatile("" : "+s"(wvj));
            for (int bit = 12; bit >= 0; --bit) {
                const int cjA = JA | (1 << bit), cjB = JB | (1 << bit);
                int c = 0;
#pragma unroll
                for (int i = 0; i < 64; ++i) { const int kidx = (wvj + 8 * i) * 16 + c16j;
                    const unsigned ba = ((i < 32 ? alA0 : alA1) >> (i & 31)) & 1u, bb = ((i < 32 ? alB0 : alB1) >> (i & 31)) & 1u;
                    c += (ba && kidx < cjA) ? 1 : 0; c += (bb && kidx < cjB) ? 65536 : 0; }
                const int tot = qsum(c);
                if ((tot & 0xffff) <= needA - 1) JA = cjA;
                if ((tot >> 16) <= needB - 1) JB = cjB;
            }
            unsigned kpA0 = 0u, kpA1 = 0u, kpB0 = 0u, kpB1 = 0u;
#pragma unroll
            for (int i = 0; i < 32; ++i) { const int k0 = (wvj + 8 * i) * 16 + c16j, k1 = k0 + 4096;
                kpA0 |= (k0 <= JA) ? (1u << i) : 0u; kpA1 |= (k1 <= JA) ? (1u << i) : 0u; kpB0 |= (k0 <= JB) ? (1u << i) : 0u; kpB1 |= (k1 <= JB) ? (1u << i) : 0u; }
            alA0 &= kpA0; alA1 &= kpA1; alB0 &= kpB0; alB1 &= kpB1;
        }
        const unsigned selA0 = gmA0 | alA0, selA1 = gmA1 | alA1, selB0 = gmB0 | alB0, selB1 = gmB1 | alB1;
        unsigned short* sM = (unsigned short*)(g_smem + 1024);
        {
            int c16e = c16; asm volatile("" : "+v"(c16e));
            unsigned wsel[4] = {selA0, selA1, selB0, selB1};
#pragma unroll
            for (int st = 0; st < 4; ++st) {
                const int d = 8 >> st;
                const unsigned m = (d == 8) ? 0x00FF00FFu : (d == 4) ? 0x0F0F0F0Fu : (d == 2) ? 0x33333333u : 0x55555555u;
                const bool lowr = (c16e & d) != 0;
                const unsigned km = lowr ? ~m : m, rr = lowr ? (unsigned)d : (unsigned)(32 - d);
#pragma unroll
                for (int w = 0; w < 4; ++w) {
                    int pw = (int)wsel[w];
                    if (d == 8) { pw = __builtin_amdgcn_update_dpp(0, pw, 0x128, 0xf, 0xf, true); }
                    else if (d == 4) { pw = __builtin_amdgcn_update_dpp(0, pw, 0x141, 0xf, 0xf, true); pw = __builtin_amdgcn_update_dpp(0, pw, 0x1B, 0xf, 0xf, true); }
                    else if (d == 2) { pw = __builtin_amdgcn_update_dpp(0, pw, 0x4E, 0xf, 0xf, true); }
                    else { pw = __builtin_amdgcn_update_dpp(0, pw, 0xB1, 0xf, 0xf, true); }
                    const unsigned q = __builtin_amdgcn_alignbit((unsigned)pw, (unsigned)pw, rr);
                    wsel[w] = (wsel[w] & km) | (q & ~km);
                }
            }
            const int wve = wv;
#pragma unroll
            for (int w = 0; w < 4; ++w) { const int qrow = (w >> 1) * 4 + q4, g = w & 1;
                sM[qrow * 512 + wve + 8 * (32 * g + c16e)] = (unsigned short)(wsel[w] & 0xffffu);
                sM[qrow * 512 + wve + 8 * (32 * g + 16 + c16e)] = (unsigned short)(wsel[w] >> 16); }
        }
        if (tid == 0) *sIt = nxt;
        __syncthreads();
        *(uint4*)(M16 + (size_t)(t0 + (tid >> 6)) * 512 + (tid & 63) * 8) = ((const uint4*)sM)[tid];
        it = *sIt;
    }
}

PHASE_FN void ph_dsa_attn(const Params& p, float* smem) {
    KParams* pp = kparams();
    GU8* wsg_ = (GU8*)pp->ws; asm volatile("" : "+s"(wsg_)); unsigned char* ws_ = (unsigned char*)wsg_;
    int tid_ = threadIdx.x; asm volatile("" : "+v"(tid_)); const int tid = tid_, lane = tid & 63, wv = __builtin_amdgcn_readfirstlane(tid >> 6), q4 = lane >> 4, c16 = lane & 15;
    const int qg = wv & 3, kh = wv >> 2;
    int ldz_ = 0; asm volatile("" : "+s"(ldz_)); unsigned char* lds = g_smem + ldz_;
    const bf16_t* QBb = (const bf16_t*)(ws_ + OFF_QBB); const bf16_t* KBb = (const bf16_t*)(ws_ + OFF_KBB); const bf16_t* VT = (const bf16_t*)(ws_ + OFF_VT);
    const unsigned short* M16 = (const unsigned short*)(ws_ + OFF_M16);
    bf16_t* OB = (bf16_t*)(ws_ + OFF_OB);
    for (int it = blockIdx.x; it < 256; it += gridDim.x) {
        const int bh = it & 7, jp = it >> 3, b = bh >> 2, h = bh & 3;
        for (int half = 0; half < 2; ++half) {
            const int jq = half ? jp : 63 - jp;
            const int qs = jq * 128, nkt = 2 * jq + 2;
            const int tq0 = b * 8192 + qs + qg * 32 + c16, tq1 = tq0 + 16;
            unsigned char* qL = lds + 65536 + wv * 8192 + lane * 16;
            float m0 = -1e30f, m1 = -1e30f, ls0 = 0.f, ls1 = 0.f;
            f32x4 oa0[8], oa1[8];
#pragma unroll
            for (int t = 0; t < 8; ++t) { oa0[t] = (f32x4){0.f, 0.f, 0.f, 0.f}; oa1[t] = (f32x4){0.f, 0.f, 0.f, 0.f}; }
            uint4 rkA0, rkA1, rvA0, rvA1, rkB0, rkB1, rvB0, rvB1;
            const int q0 = tid, q1 = tid + 512;
            const bf16_t* kg0 = KBb + (size_t)(b * 8192 + (q0 >> 4)) * 512 + h * 128 + (q0 & 15) * 8;
            const bf16_t* kg1 = KBb + (size_t)(b * 8192 + (q1 >> 4)) * 512 + h * 128 + (q1 & 15) * 8;
            const bf16_t* vg0 = VT + ((size_t)((b * 4 + h) * 128 + (q0 >> 3))) * 8192 + (q0 & 7) * 8;
            const bf16_t* vg1 = VT + ((size_t)((b * 4 + h) * 128 + (q1 >> 3))) * 8192 + (q1 & 7) * 8;
            const int lk0 = (q0 >> 4) * 256 + ((((q0 & 15)) ^ ((q0 >> 4) & 15)) << 4), lk1 = (q1 >> 4) * 256 + ((((q1 & 15)) ^ ((q1 >> 4) & 15)) << 4);
            const int lv0 = 16384 + (q0 >> 3) * 128 + ((((q0 & 7)) ^ ((q0 >> 3) & 7)) << 4), lv1 = 16384 + (q1 >> 3) * 128 + ((((q1 & 7)) ^ ((q1 >> 3) & 7)) << 4);
#define ATT_GLOAD(X, kt_) do { rk##X##0 = *(const uint4*)(kg0 + (size_t)(kt_) * 64 * 512); rk##X##1 = *(const uint4*)(kg1 + (size_t)(kt_) * 64 * 512); \
                            rv##X##0 = *(const uint4*)(vg0 + (kt_) * 64); rv##X##1 = *(const uint4*)(vg1 + (kt_) * 64); } while (0)
#define ATT_LSTORE(X, st_) do { unsigned char* base_ = lds + (st_) * 32768; *(uint4*)(base_ + lk0) = rk##X##0; *(uint4*)(base_ + lk1) = rk##X##1; *(uint4*)(base_ + lv0) = rv##X##0; *(uint4*)(base_ + lv1) = rv##X##1; } while (0)
#define ATT_SOFT(S0_, S1_, MW_, M_, LS_, OA_, PB_) do { \
                const unsigned mwl_ = (MW_) >> (4 * q4); float mx_ = M_; \
                _Pragma("unroll") for (int r = 0; r < 4; ++r) { const int v0_ = __builtin_amdgcn_sbfe((int)mwl_, r, 1), v1_ = __builtin_amdgcn_sbfe((int)mwl_, 16 + r, 1); \
                    S0_[r] = __int_as_float((v0_ & __float_as_int(S0_[r])) | (~v0_ & (int)0xFF800000u));        \
                    S1_[r] = __int_as_float((v1_ & __float_as_int(S1_[r])) | (~v1_ & (int)0xFF800000u)); \
                    mx_ = fmaxf(mx_, fmaxf(S0_[r], S1_[r])); } \
                mx_ = xor32_max(xor16_max(mx_)); \
                const float alpha_ = __builtin_amdgcn_exp2f(M_ - mx_); M_ = mx_; float ps_ = 0.f; \
                _Pragma("unroll") for (int r = 0; r < 4; ++r) { \
                    const float p0_ = __builtin_amdgcn_exp2f(S0_[r] - mx_), p1_ = __builtin_amdgcn_exp2f(S1_[r] - mx_); \
                    S0_[r] = p0_; S1_[r] = p1_; ps_ += p0_ + p1_; } \
                LS_ = LS_ * alpha_ + ps_; \
                if (!__all(alpha_ == 1.f)) { _Pragma("unroll") for (int t = 0; t < 8; ++t) OA_[t] = OA_[t] * alpha_; } \
                { union { uint4 u; bf16x8 v; } cv_; cv_.u.x = cvt_pk_bf16(S0_[0], S0_[1]); cv_.u.y = cvt_pk_bf16(S0_[2], S0_[3]); cv_.u.z = cvt_pk_bf16(S1_[0], S1_[1]); cv_.u.w = cvt_pk_bf16(S1_[2], S1_[3]); PB_ = cv_.v; } } while (0)
            auto att_step = [&](const int stg_, const unsigned mw0, const unsigned mw1) {
                const unsigned char* Kt = lds + stg_ * 32768;
                const unsigned char* Vt = Kt + 16384;
                f32x4 s00, s01, s10, s11;
                s00 = (f32x4){0.f, 0.f, 0.f, 0.f}; s01 = s00; s10 = s00; s11 = s00;
#pragma unroll
                for (int ah = 0; ah < 2; ++ah) {
                    bf16x8 kf[4], qq[4];
#pragma unroll
                    for (int aa = 0; aa < 2; ++aa) { const int a = ah * 2 + aa;
                        const int r0 = 16 * (kh * 2) + c16, r1 = r0 + 16;
                        kf[aa] = *(const bf16x8*)(Kt + r0 * 256 + ((((q4 + 4 * a)) ^ (r0 & 15)) << 4)); kf[2 + aa] = *(const bf16x8*)(Kt + r1 * 256 + ((((q4 + 4 * a)) ^ (r1 & 15)) << 4));
                        qq[aa] = *(const bf16x8*)(qL + a * 1024); qq[2 + aa] = *(const bf16x8*)(qL + 4096 + a * 1024); }
                    asm volatile("" : "+v"(kf[0]), "+v"(kf[1]), "+v"(kf[2]), "+v"(kf[3]), "+v"(qq[0]), "+v"(qq[1]), "+v"(qq[2]), "+v"(qq[3]));
#pragma unroll
                    for (int aa = 0; aa < 2; ++aa) {
                        s00 = __builtin_amdgcn_mfma_f32_16x16x32_bf16(kf[aa], qq[aa], s00, 0, 0, 0); s10 = __builtin_amdgcn_mfma_f32_16x16x32_bf16(kf[aa], qq[2 + aa], s10, 0, 0, 0);
                        s01 = __builtin_amdgcn_mfma_f32_16x16x32_bf16(kf[2 + aa], qq[aa], s01, 0, 0, 0); s11 = __builtin_amdgcn_mfma_f32_16x16x32_bf16(kf[2 + aa], qq[2 + aa], s11, 0, 0, 0); }
                }
                bf16x8 pb0, pb1;
                ATT_SOFT(s00, s01, mw0, m0, ls0, oa0, pb0);
                ATT_SOFT(s10, s11, mw1, m1, ls1, oa1, pb1);
#pragma unroll
                for (int tg = 0; tg < 2; ++tg) {
                    bf16x8 vfr[4];
#pragma unroll
                    for (int tt = 0; tt < 4; ++tt) { const int row = 16 * (tg * 4 + tt) + c16;
                        union { uint2 h2[2]; bf16x8 v; } vf;
                        vf.h2[0] = *(const uint2*)(Vt + row * 128 + ((((4 * kh + (q4 >> 1))) ^ (row & 7)) << 4) + 8 * (q4 & 1));
                        vf.h2[1] = *(const uint2*)(Vt + row * 128 + ((((4 * kh + 2 + (q4 >> 1))) ^ (row & 7)) << 4) + 8 * (q4 & 1));
                        vfr[tt] = vf.v; }
                    asm volatile("" : "+v"(vfr[0]), "+v"(vfr[1]), "+v"(vfr[2]), "+v"(vfr[3]));
#pragma unroll
                    for (int tt = 0; tt < 4; ++tt) { oa0[tg * 4 + tt] = __builtin_amdgcn_mfma_f32_16x16x32_bf16(vfr[tt], pb0, oa0[tg * 4 + tt], 0, 0, 0);
                                                     oa1[tg * 4 + tt] = __builtin_amdgcn_mfma_f32_16x16x32_bf16(vfr[tt], pb1, oa1[tg * 4 + tt], 0, 0, 0); }
                }
            };
            const unsigned* mp0 = (const unsigned*)(M16 + (size_t)tq0 * 512 + 2 * kh); const unsigned* mp1 = (const unsigned*)(M16 + (size_t)tq1 * 512 + 2 * kh);
            __syncthreads();
#pragma unroll
            for (int a = 0; a < 4; ++a) { *(bf16x8*)(qL + a * 1024) = *(const bf16x8*)(QBb + (size_t)tq0 * 512 + h * 128 + 8 * q4 + 32 * a);
                                          *(bf16x8*)(qL + 4096 + a * 1024) = *(const bf16x8*)(QBb + (size_t)tq1 * 512 + h * 128 + 8 * q4 + 32 * a); }
            unsigned ma0 = mp0[0], ma1 = mp1[0], mb0 = mp0[2], mb1 = mp1[2];
            ATT_GLOAD(A, 0); ATT_LSTORE(A, 0);
            __syncthreads();
            ATT_GLOAD(B, 1);
            for (int kt = 0; kt < nkt; kt += 2) {
                const int kn = (kt + 2 < nkt) ? kt + 2 : kt;
                const unsigned na0 = mp0[2 * kn], na1 = mp1[2 * kn], nb0 = mp0[2 * kn + 2], nb1 = mp1[2 * kn + 2];
                if (kt + 2 < nkt) ATT_GLOAD(A, kt + 2);
                att_step(0, ma0, ma1);
                ATT_LSTORE(B, 1);
                LBAR();
                if (kt + 3 < nkt) ATT_GLOAD(B, kt + 3);
                att_step(1, mb0, mb1);
                if (kt + 2 < nkt) ATT_LSTORE(A, 0);
                LBAR();
                ma0 = na0; ma1 = na1; mb0 = nb0; mb1 = nb1;
            }
            ls0 = xor32_sum(xor16_sum(ls0)); ls1 = xor32_sum(xor16_sum(ls1));
            float* mg = (float*)(lds + 65536) + (size_t)qg * (68 * 64) + lane;
            if (kh == 1) {
#pragma unroll
                for (int t = 0; t < 8; ++t)
#pragma unroll
                    for (int r = 0; r < 4; ++r) { mg[(t * 4 + r) * 64] = oa0[t][r]; mg[(32 + t * 4 + r) * 64] = oa1[t][r]; }
                mg[64 * 64] = m0; mg[65 * 64] = m1; mg[66 * 64] = ls0; mg[67 * 64] = ls1;
            }
            __syncthreads();
            if (kh == 0) {
                const float pm0 = mg[64 * 64], pm1 = mg[65 * 64], pl0 = mg[66 * 64], pl1 = mg[67 * 64];
                const float M0 = fmaxf(m0, pm0), M1 = fmaxf(m1, pm1);
                const float a0 = __builtin_amdgcn_exp2f(m0 - M0), b0 = __builtin_amdgcn_exp2f(pm0 - M0), a1 = __builtin_amdgcn_exp2f(m1 - M1), b1 = __builtin_amdgcn_exp2f(pm1 - M1);
                const float inv0 = 1.f / (ls0 * a0 + pl0 * b0), inv1 = 1.f / (ls1 * a1 + pl1 * b1);
#pragma unroll
                for (int t = 0; t < 8; ++t) { f32x4 o0, o1;
#pragma unroll
                    for (int r = 0; r < 4; ++r) { o0[r] = (oa0[t][r] * a0 + mg[(t * 4 + r) * 64] * b0) * inv0; o1[r] = (oa1[t][r] * a1 + mg[(32 + t * 4 + r) * 64] * b1) * inv1; }
                    *(uint2*)(OB + (size_t)tq0 * 1024 + 512 + h * 128 + 16 * t + 4 * q4) = pack4(o0);
                    *(uint2*)(OB + (size_t)tq1 * 1024 + 512 + h * 128 + 16 * t + 4 * q4) = pack4(o1); }
            }
        }
    }
}

PHASE_FN void ph_gdn_out(const Params& p, int layer) {
    KParams* pp = kparams();
    GU8* wsg_ = (GU8*)pp->ws; asm volatile("" : "+s"(wsg_)); unsigned char* ws_ = (unsigned char*)wsg_;
    int tid_ = threadIdx.x; asm volatile("" : "+v"(tid_)); const int tid = tid_, lane = tid & 63, wv = tid >> 6;
    const float* O = (const float*)(ws_ + OFF_O); const bf16_t* P = (const bf16_t*)(ws_ + OFF_P); bf16_t* OB = (bf16_t*)(ws_ + OFF_OB);
    const float* onw = as_global(pp->gdn_out_norm) + (layer >> 1) * 128;
    const float nw0 = onw[lane], nw1 = onw[64 + lane];
    const int tstep = gridDim.x * 8;
    for (int t = blockIdx.x * 8 + wv; t < NT; t += 2 * tstep) {
        const int tB = (t + tstep < NT) ? t + tstep : t; const bool hasB = t + tstep < NT;
        float oa[2][4][2]; unsigned za[2][4][2];
#pragma unroll
        for (int u = 0; u < 2; ++u) { const int tt = u ? tB : t;
#pragma unroll
            for (int h = 0; h < 4; ++h) { const float* op = O + (size_t)tt * 1024 + h * 128;
                oa[u][h][0] = op[lane]; oa[u][h][1] = op[64 + lane];
                za[u][h][0] = P[(size_t)tt * LDPB + 1536 + h * 128 + lane]; za[u][h][1] = P[(size_t)tt * LDPB + 1536 + h * 128 + 64 + lane]; } }
        asm volatile("" ::: "memory");
#pragma unroll
        for (int u = 0; u < 2; ++u) { const int tt = u ? tB : t;
            if (u == 1 && !hasB) break;
#pragma unroll
            for (int h = 0; h < 4; ++h) { bf16_t* ob = OB + (size_t)tt * 1024 + h * 128;
                const float o0 = oa[u][h][0], o1 = oa[u][h][1];
                const float ss = wave_sum(o0 * o0 + o1 * o1);
                const float r = rsqrtf(ss * (1.f / 128.f) + EPS);
                const float z0 = __uint_as_float(za[u][h][0] << 16), z1 = __uint_as_float(za[u][h][1] << 16);
                ob[lane] = f2bf(o0 * r * nw0 * siluf_(z0)); ob[64 + lane] = f2bf(o1 * r * nw1 * siluf_(z1)); } }
    }
}

struct EpiOut {
    static constexpr bool PERM = false;
    const float* Xres; float* X; const float* gt0;
    __device__ __forceinline__ void operator()(const f32x4 (&acc)[2][2][4][2], const pg8::Unit& u, int wr, int wc, int fr, int fq) const {
        const int row0 = u.pm * 256 + wr * 64 + fr, col0 = u.pn * 256 + wc * 32 + 4 * fq;
        const float* gt = gt0 + (size_t)(row0 >> 13) * 6144 + col0;
        f32x4 gv[2][2];
#pragma unroll
        for (int bj = 0; bj < 2; ++bj)
#pragma unroll
            for (int n = 0; n < 2; ++n) gv[bj][n] = *(const f32x4*)(gt + bj * 128 + n * 16);
#pragma unroll
        for (int ai = 0; ai < 2; ++ai) {
            f32x4 rs[4][2][2];
#pragma unroll
            for (int m = 0; m < 4; ++m) { const size_t off = (size_t)(row0 + ai * 128 + m * 16) * ND + col0;
#pragma unroll
                for (int bj = 0; bj < 2; ++bj)
#pragma unroll
                    for (int n = 0; n < 2; ++n) rs[m][bj][n] = *(const f32x4*)(Xres + off + bj * 128 + n * 16); }
            asm volatile("" ::: "memory");
#pragma unroll
            for (int m = 0; m < 4; ++m) { const size_t off = (size_t)(row0 + ai * 128 + m * 16) * ND + col0;
#pragma unroll
                for (int bj = 0; bj < 2; ++bj)
#pragma unroll
                    for (int n = 0; n < 2; ++n) *(f32x4*)(X + off + bj * 128 + n * 16) = rs[m][bj][n] + gv[bj][n] * acc[ai][bj][m][n]; }
        }
    }
};

PHASE_FN void ph_gemm_out(const Params& p, int layer, float* smem) {
    KParams* pp = kparams();
    GU8* wsg_ = (GU8*)pp->ws; asm volatile("" : "+s"(wsg_)); unsigned char* ws_ = (unsigned char*)wsg_;
    int ldz_ = 0; asm volatile("" : "+s"(ldz_));
    const bf16_t* Wt = (const bf16_t*)(ws_ + OFF_WOUT) + (size_t)layer * 1024 * 1024;
    EpiOut E; E.Xres = (layer == 0) ? as_global(pp->x) : (const float*)as_global(pp->X); E.X = as_global(pp->X); E.gt0 = (const float*)(ws_ + OFF_MOD) + (size_t)(layer * 2) * 6144 + 2048;
    pg8::DenseOrder S; S.init(64, 4, gridDim.x, blockIdx.x, 1024);
    __syncthreads();
    pg8::gemm_phase<EpiOut, pg8::DenseOrder, false>((LAS unsigned char*)(g_smem + ldz_), (const bf16_t*)(ws_ + OFF_OB), Wt, 1024, S, E);
    __syncthreads();
}

PHASE_FN void ph_norm_ffn(const Params& p, int layer) {
    KParams* pp = kparams();
    GU8* wsg_ = (GU8*)pp->ws; asm volatile("" : "+s"(wsg_)); unsigned char* ws_ = (unsigned char*)wsg_;
    int tid_ = threadIdx.x; asm volatile("" : "+v"(tid_)); const int tid = tid_, lane = tid & 63, wv = tid >> 6;
    const float* MOD = (const float*)(ws_ + OFF_MOD);
    bf16_t* H = (bf16_t*)(ws_ + OFF_H);
    int* CNT = (int*)(ws_ + OFF_CNT) + layer * 32 * CSTR;
    int* sCnt = (int*)g_smem; int* sBase = sCnt + 32; int* sE = sBase + 32; int* sR = sE + 256;
    const int G2 = (int)gridDim.x >> 1, bsel_ = ((int)blockIdx.x >= G2) ? 1 : 0, bi_ = (int)blockIdx.x - bsel_ * G2;
    const int nrb = (8192 + G2 - 1) / G2;
    const int row_lo_ = bsel_ * 8192 + bi_ * nrb, row_end_ = (bsel_ + 1) * 8192;
    const int row_lo = ((int)blockIdx.x < 2 * G2 && row_lo_ < row_end_) ? row_lo_ : NT, row_hi = (row_lo == NT) ? NT : ((row_lo + nrb < row_end_) ? row_lo + nrb : row_end_);
    __syncthreads();
    if (tid < 32) sCnt[tid] = 0;
    __syncthreads();
    int* ASG = (int*)(ws_ + OFF_ASG); float* GATE = (float*)(ws_ + OFF_GATE); int* LIST = (int*)(ws_ + OFF_LIST);
    const float* nw = as_global(pp->norm_ffn) + layer * 1024;
    const float* wg = as_global(pp->rg_w) + (size_t)layer * 1024 * 4;
    float4* sW = (float4*)(g_smem + 2560);
    float4* sNA = (float4*)(g_smem + 2560 + 147456); float4* sNB = sNA + 256;
    float* sBias = (float*)(sNB + 256);
    { const float* weL = as_global(pp->re_w) + (size_t)(layer * 4) * 1024 * 8;
      for (int idx = tid; idx < 144 * 64; idx += NTHREADS) { const int slot = idx >> 6, ln = idx & 63;
          if (slot < 16) { const int col = (slot >> 2) * 256 + ln * 4 + (slot & 3); sW[idx] = *(const float4*)(wg + (size_t)col * 4); }
          else { const int s2 = slot - 16, gx = s2 >> 5, r = s2 & 31, col = (r >> 3) * 256 + ln * 4 + ((r >> 1) & 3);
                 sW[idx] = *(const float4*)(weL + ((size_t)gx * 1024 + col) * 8 + (r & 1) * 4); } } }
    { const int b0 = (row_lo < NT) ? (row_lo >> 13) : 0;
      const float* sh0 = MOD + (size_t)(layer * 2 + b0) * 6144 + 3072; const float* sc0 = sh0 + 1024;
      if (tid < 256) { const int col = (tid >> 6) * 256 + (tid & 63) * 4;
          const float4 w = *(const float4*)(nw + col), s4 = *(const float4*)(sc0 + col);
          sNA[tid] = make_float4(w.x * (1.f + s4.x), w.y * (1.f + s4.y), w.z * (1.f + s4.z), w.w * (1.f + s4.w)); sNB[tid] = *(const float4*)(sh0 + col); }
      if (tid < 4) sBias[tid] = as_global(pp->rg_b)[layer * 4 + tid];
      if (tid >= 64 && tid < 96) sBias[4 + tid - 64] = as_global(pp->re_b)[layer * 32 + tid - 64]; }
    __syncthreads();
    float4 nx0 = make_float4(0.f, 0.f, 0.f, 0.f), nx1 = nx0, nx2 = nx0, nx3 = nx0;
    if (row_lo + wv < row_hi) { const float* xr = as_global(pp->X) + (size_t)(row_lo + wv) * ND + lane * 4;
        nx0 = *(const float4*)xr; nx1 = *(const float4*)(xr + 256); nx2 = *(const float4*)(xr + 512); nx3 = *(const float4*)(xr + 768); }
    for (int row = row_lo + wv; row < row_hi; row += 8) {
        float hv[16]; float ss = 0.f;
        hv[0] = nx0.x; hv[1] = nx0.y; hv[2] = nx0.z; hv[3] = nx0.w; hv[4] = nx1.x; hv[5] = nx1.y; hv[6] = nx1.z; hv[7] = nx1.w;
        hv[8] = nx2.x; hv[9] = nx2.y; hv[10] = nx2.z; hv[11] = nx2.w; hv[12] = nx3.x; hv[13] = nx3.y; hv[14] = nx3.z; hv[15] = nx3.w;
        if (row + 8 < row_hi) { const float* xr = as_global(pp->X) + (size_t)(row + 8) * ND + lane * 4;
            nx0 = *(const float4*)xr; nx1 = *(const float4*)(xr + 256); nx2 = *(const float4*)(xr + 512); nx3 = *(const float4*)(xr + 768); }
#pragma unroll
        for (int j = 0; j < 16; ++j) ss += hv[j] * hv[j];
        ss = wave_sum(ss);
        const float rstd = rsqrtf(ss * (1.f / 1024.f) + EPS);
#pragma unroll
        for (int j = 0; j < 4; ++j) {
            const int col = j * 256 + lane * 4;
            const float4 wa = sNA[j * 64 + lane], h4 = sNB[j * 64 + lane];
            hv[4 * j] = hv[4 * j] * rstd * wa.x + h4.x; hv[4 * j + 1] = hv[4 * j + 1] * rstd * wa.y + h4.y;
            hv[4 * j + 2] = hv[4 * j + 2] * rstd * wa.z + h4.z; hv[4 * j + 3] = hv[4 * j + 3] * rstd * wa.w + h4.w;
            { f32x4 ov; ov[0] = hv[4 * j]; ov[1] = hv[4 * j + 1]; ov[2] = hv[4 * j + 2]; ov[3] = hv[4 * j + 3]; *(uint2*)(H + (size_t)row * ND + col) = pack4(ov); }
        }
        float gl[4] = {0.f, 0.f, 0.f, 0.f};
#pragma unroll
        for (int j = 0; j < 4; ++j)
#pragma unroll
            for (int e = 0; e < 4; ++e) { const float4 w = sW[(j * 4 + e) * 64 + lane]; const float hh = hv[4 * j + e];
                gl[0] += hh * w.x; gl[1] += hh * w.y; gl[2] += hh * w.z; gl[3] += hh * w.w; }
#pragma unroll
        for (int g = 0; g < 4; ++g) gl[g] = wave_sum(gl[g]) + sBias[g];
        int gs = 0; float gm = gl[0];
#pragma unroll
        for (int g = 1; g < 4; ++g) if (gl[g] > gm) { gm = gl[g]; gs = g; }
        float gsum = 0.f;
#pragma unroll
        for (int g = 0; g < 4; ++g) gsum += expf(gl[g] - gm);
        const float ggate = 1.f / gsum;
        const float4* we4 = sW + (16 + gs * 32) * 64 + lane;
        float el[8] = {0.f, 0.f, 0.f, 0.f, 0.f, 0.f, 0.f, 0.f};
#pragma unroll
        for (int j = 0; j < 4; ++j)
#pragma unroll
            for (int e = 0; e < 4; ++e) { const float4 w0 = we4[((j * 4 + e) * 2) * 64], w1 = we4[((j * 4 + e) * 2 + 1) * 64]; const float hh = hv[4 * j + e];
                el[0] += hh * w0.x; el[1] += hh * w0.y; el[2] += hh * w0.z; el[3] += hh * w0.w; el[4] += hh * w1.x; el[5] += hh * w1.y; el[6] += hh * w1.z; el[7] += hh * w1.w; }
#pragma unroll
        for (int e = 0; e < 8; ++e) el[e] = wave_sum(el[e]) + sBias[4 + gs * 8 + e];
        int i1 = 0; float l1 = el[0];
#pragma unroll
        for (int e = 1; e < 8; ++e) if (el[e] > l1) { l1 = el[e]; i1 = e; }
        int i2 = -1; float l2 = -INFINITY;
#pragma unroll
        for (int e = 0; e < 8; ++e) if (e != i1 && el[e] > l2) { l2 = el[e]; i2 = e; }
        const float ex = expf(l2 - l1);
        const float p1 = 1.f / (1.f + ex), p2 = ex / (1.f + ex);
        if (lane == 0) {
            const int e1 = gs * 8 + i1, e2 = gs * 8 + i2, lr = row - row_lo;
            sE[lr * 2] = e1; sE[lr * 2 + 1] = e2;
            sR[lr * 2] = atomicAdd(&sCnt[e1], 1); sR[lr * 2 + 1] = atomicAdd(&sCnt[e2], 1);
            GATE[row * 2] = ggate * p1; GATE[row * 2 + 1] = ggate * p2;
        }
    }
    __syncthreads();
    if (tid < 32) sBase[tid] = (sCnt[tid] > 0) ? atomicAdd(&CNT[tid * CSTR], sCnt[tid]) : 0;
    __syncthreads();
    for (int a = tid; a < (row_hi - row_lo) * 2; a += NTHREADS) {
        const int row = row_lo + (a >> 1), e = sE[a], r = sBase[e] + sR[a];
        LIST[(size_t)e * LISTCAP + r] = row;
        ASG[row * 4 + (a & 1) * 2] = e; ASG[row * 4 + (a & 1) * 2 + 1] = r;
    }
}

template <int WHICH>
struct MoeOrderT {
    const int* sTs; const int* sPad; const int* CNT; const int* LIST; int* DONE; int G, c, which, K;
    static constexpr bool PUBLISH = (WHICH == 0), WAITS = (WHICH == 1);
    __device__ __forceinline__ bool next(int i, pg8::Unit& u) const {
        const int NU = __builtin_amdgcn_readfirstlane(sTs[32]) * 4;
        long L = (long)i * G + c;
        if (WHICH == 1 && NU > 2 * G && NU <= 3 * G) { const int R1 = NU - 2 * G;
            if (c < R1) { if (i > 0) return false; L = NU - R1 + c; }
            else { L = (long)i * (G - R1) + (c - R1); if (L >= NU - R1) return false; } }
        if (L >= NU) return false;
        const int mt = (int)(L >> 2), nt = (int)(L & 3);
        int e = 0;
        for (int q = 1; q < 32; ++q) if (__builtin_amdgcn_readfirstlane(sTs[q]) <= mt) e = q;
        const int mi = mt - __builtin_amdgcn_readfirstlane(sTs[e]), cnt = __builtin_amdgcn_readfirstlane(CNT[e * CSTR]);
        u.pm = mt; u.pn = nt; u.e = e; u.mi = mi; u.mvalid = (cnt - mi * 256 < 256) ? (cnt - mi * 256) : 256; u.rowbase = __builtin_amdgcn_readfirstlane(sPad[e]) + mi * 256;
        u.boff = ((size_t)e * 1024 + nt * 256) * K * 2;
        u.aoff = which ? (size_t)u.rowbase * 512 * 2 : 0;
        return true;
    }
    __device__ __forceinline__ int row(const pg8::Unit& u, int r) const { const int rr = (r < u.mvalid) ? r : 0; return LIST[(size_t)u.e * LISTCAP + u.mi * 256 + rr]; }
    __device__ __forceinline__ void publish(const pg8::Unit& u) const { __hip_atomic_fetch_add(DONE + u.pm, 1, __ATOMIC_RELAXED, __HIP_MEMORY_SCOPE_AGENT); }
    __device__ __forceinline__ void wait(const pg8::Unit& u, int tid) const {
        if (tid == 0) { int sp = 0; while (__hip_atomic_load(DONE + u.pm, __ATOMIC_RELAXED, __HIP_MEMORY_SCOPE_AGENT) < 4) { __builtin_amdgcn_s_sleep(1); if (++sp > (1 << 22)) break; } }
        if (tid < 64) __builtin_amdgcn_fence(__ATOMIC_ACQUIRE, "agent");
    }
};
struct EpiMoe1 {
    static constexpr bool PERM = false;
    bf16_t* HID;
    __device__ __forceinline__ void operator()(const f32x4 (&acc)[2][2][4][2], const pg8::Unit& u, int wr, int wc, int fr, int fq) const {
#pragma unroll
        for (int ai = 0; ai < 2; ++ai)
#pragma unroll
            for (int m = 0; m < 4; ++m) { const int rl = ai * 128 + wr * 64 + m * 16 + fr;
                if (rl < u.mvalid) {
#pragma unroll
                    for (int bj = 0; bj < 2; ++bj) { const f32x4 a1 = acc[ai][bj][m][0], a3 = acc[ai][bj][m][1]; f32x4 hv;
                        hv[0] = silu_fast(a1[0]) * a3[0]; hv[1] = silu_fast(a1[1]) * a3[1]; hv[2] = silu_fast(a1[2]) * a3[2]; hv[3] = silu_fast(a1[3]) * a3[3];
                        const uint2 pk_ = pack4(hv); __attribute__((address_space(1))) uint2* dp_ = (__attribute__((address_space(1))) uint2*)(HID + (size_t)(u.rowbase + rl) * 512 + u.pn * 128 + bj * 64 + wc * 16 + 4 * fq);
                        asm volatile("global_store_dwordx2 %0, %1, off sc1" :: "v"(dp_), "v"(pk_) : "memory"); } } }
    }
};
struct EpiMoe2 {
    static constexpr bool PERM = true;
    bf16_t* YB;
    __device__ __forceinline__ void operator()(const f32x4 (&acc)[2][2][4][2], const pg8::Unit& u, int wr, int wc, int fr, int fq) const {
#pragma unroll
        for (int ai = 0; ai < 2; ++ai)
#pragma unroll
            for (int m = 0; m < 4; ++m) { const int rl = ai * 128 + wr * 64 + m * 16 + fr;
                if (rl < u.mvalid) {
#pragma unroll
                    for (int bj = 0; bj < 2; ++bj) { const uint2 lo = pack4(acc[ai][bj][m][0]), hi = pack4(acc[ai][bj][m][1]);
                        *(uint4*)(YB + (size_t)(u.rowbase + rl) * 1024 + u.pn * 256 + bj * 128 + wc * 32 + 8 * fq) = make_uint4(lo.x, lo.y, hi.x, hi.y); } } }
    }
};

PHASE_FN void ph_moe(const Params& p, int layer, int which, float* smem) {
    KParams* pp = kparams();
    GU8* wsg_ = (GU8*)pp->ws; asm volatile("" : "+s"(wsg_)); unsigned char* ws_ = (unsigned char*)wsg_;
    int ldz_ = 0; asm volatile("" : "+s"(ldz_));
    int tid_ = threadIdx.x; asm volatile("" : "+v"(tid_)); const int tid = tid_;
    int* sPad = (int*)(g_smem + ldz_ + 131072); int* sTs = sPad + 40;
    const int* CNT = (const int*)(ws_ + OFF_CNT) + layer * 32 * CSTR;
    __syncthreads();
    if (tid == 0) { int a = 0, ts = 0; for (int e = 0; e < 32; ++e) { sPad[e] = a; sTs[e] = ts; a += ((CNT[e * CSTR] + 127) / 128) * 128; ts += (CNT[e * CSTR] + 255) / 256; } sTs[32] = ts; sPad[32] = a; }
    __syncthreads();
    const int cblk = (((int)gridDim.x & 7) == 0) ? (((int)blockIdx.x & 7) * ((int)gridDim.x >> 3) + ((int)blockIdx.x >> 3)) : (int)blockIdx.x;
    int* DONE = (int*)(ws_ + OFF_DONE) + layer * 160;
#define MOE_SCHED(S_) S_.sTs = sTs; S_.sPad = sPad; S_.CNT = CNT; S_.LIST = (const int*)(ws_ + OFF_LIST); S_.DONE = DONE; S_.G = gridDim.x; S_.which = which; S_.K = which ? 512 : 1024; S_.c = cblk;
    if (which == 0) {
        EpiMoe1 E; E.HID = (bf16_t*)(ws_ + OFF_HID);
        MoeOrderT<0> S; MOE_SCHED(S)
        pg8::gemm_phase<EpiMoe1, MoeOrderT<0>, true>((LAS unsigned char*)(g_smem + ldz_), (const bf16_t*)(ws_ + OFF_H), (const bf16_t*)(ws_ + OFF_W13), 1024, S, E);
    } else {
        EpiMoe2 E; E.YB = (bf16_t*)(ws_ + OFF_YB);
        MoeOrderT<1> S; MOE_SCHED(S)
        pg8::gemm_phase<EpiMoe2, MoeOrderT<1>, false>((LAS unsigned char*)(g_smem + ldz_), (const bf16_t*)(ws_ + OFF_HID), (const bf16_t*)(ws_ + OFF_W2T), 512, S, E);
    }
    __syncthreads();
}

PHASE_FN void ph_conv_dense(const Params& p, float* smem) {
    KParams* pp = kparams();
    GU8* wsg_ = (GU8*)pp->ws; asm volatile("" : "+s"(wsg_)); unsigned char* ws_ = (unsigned char*)wsg_;
    { int ldz_ = 0; asm volatile("" : "+s"(ldz_)); smem = (float*)(g_smem + ldz_); }
    auto dec = [&](int t, const float*& s0, const float*& s1, bf16_t*& dst, int& mode, int& K, int& N, int& ld, int& rt, int& kt) {
        s1 = nullptr; mode = 0; K = 1024;
        if (t >= 4672) t = 4671;
        if (t >= 4608) { const int v = t - 4608, l = v >> 5, u = v & 31; s0 = as_global(pp->gla_w_in) + (size_t)l * 1024 * 3088 + 3072; N = 16; ld = 3088; dst = (bf16_t*)(ws_ + OFF_WGL) + (size_t)l * 128 * 1024; rt = u >> 4; kt = u & 15; }
        else if (t < 2048) { const int l = t >> 10, u = t & 1023; s0 = as_global(pp->even_w_in) + (size_t)l * 1024 * 3916; N = 3916; ld = 3916; dst = (bf16_t*)(ws_ + OFF_WINE) + (size_t)l * 4096 * 1024; rt = u >> 4; kt = u & 15; }
        else if (t < 3584) { const int v = t - 2048, l = v / 768, u = v % 768; s0 = as_global(pp->gla_w_in) + (size_t)l * 1024 * 3088; N = 3072; ld = 3088; dst = (bf16_t*)(ws_ + OFF_WINO) + (size_t)l * 3072 * 1024; rt = u >> 4; kt = u & 15; }
        else { const int v = t - 3584, l = v >> 8, u = v & 255; s0 = ((l & 1) ? as_global(pp->gla_w_out) : as_global(pp->even_w_out)) + (size_t)(l >> 1) * 1024 * 1024; N = 1024; ld = 1024; dst = (bf16_t*)(ws_ + OFF_WOUT) + (size_t)l * 1024 * 1024; rt = u >> 4; kt = u & 15; }
    };
    convert_stream(dec, blockIdx.x * 4, gridDim.x * 4, 4672, smem);
}

PHASE_FN void ph_conv_exp(const Params& p, int layer, float* smem, int first_blk, int share) {
    KParams* pp = kparams();
    GU8* wsg_ = (GU8*)pp->ws; asm volatile("" : "+s"(wsg_)); unsigned char* ws_ = (unsigned char*)wsg_;
    { int ldz_ = 0; asm volatile("" : "+s"(ldz_)); smem = (float*)(g_smem + ldz_); }
    if ((int)blockIdx.x < first_blk && share == 0) return;
    auto dec = [&](int t, const float*& s0, const float*& s1, bf16_t*& dst, int& mode, int& K, int& N, int& ld, int& rt, int& kt) {
        if (t >= 12288) t = 12287;
        if (t < 8192) { const int e = t >> 8, u = t & 255; s0 = as_global(pp->w1) + (size_t)(layer * 32 + e) * 1024 * 512; s1 = as_global(pp->w3) + (size_t)(layer * 32 + e) * 1024 * 512; mode = 1; K = 1024; N = 512; ld = 512;
            dst = (bf16_t*)(ws_ + OFF_W13) + (size_t)e * 1024 * 1024; rt = u >> 4; kt = u & 15; }
        else { const int v = t - 8192, e = v >> 7, u = v & 127; s0 = as_global(pp->w2) + (size_t)(layer * 32 + e) * 512 * 1024; s1 = nullptr; mode = 0; K = 512; N = 1024; ld = 1024;
            dst = (bf16_t*)(ws_ + OFF_W2T) + (size_t)e * 1024 * 512; rt = u >> 3; kt = u & 7; }
    };
    const bool early = (int)blockIdx.x < first_blk;
    const int base = early ? (int)blockIdx.x * share : first_blk * share;
    auto dec_o = [&](int t, const float*& s0, const float*& s1, bf16_t*& dst, int& mode, int& K, int& N, int& ld, int& rt, int& kt) { dec(t + base, s0, s1, dst, mode, K, N, ld, rt, kt); };
    convert_stream(dec_o, early ? 0 : ((int)blockIdx.x - first_blk) * 4, early ? 4 : ((int)gridDim.x - first_blk) * 4, early ? share : 12288 - base, smem);
}

PHASE_FN void ph_gla_tok(const Params& p, int layer) {
    KParams* pp = kparams();
    GU8* wsg_ = (GU8*)pp->ws; asm volatile("" : "+s"(wsg_)); unsigned char* ws_ = (unsigned char*)wsg_;
    int tid_ = threadIdx.x; asm volatile("" : "+v"(tid_)); const int tid = tid_, lane = tid & 63, wv = tid >> 6, li = layer >> 1;
    const float* AUX = (const float*)(ws_ + OFF_AUX);
    float* LA = (float*)(ws_ + OFF_LA);
    const float* w2 = as_global(pp->gla_w_gate2) + (size_t)li * 16 * 512; const float* b2 = as_global(pp->gla_b_gate2) + li * 512;
    for (int t = blockIdx.x * 8 + wv; t < NT; t += gridDim.x * 8) {
        float glr[16];
#pragma unroll
        for (int r = 0; r < 16; ++r) glr[r] = AUX[(size_t)t * 16 + r];
#pragma unroll 1
        for (int i = 0; i < 8; ++i) {
            const int c = lane + 64 * i; float z = b2[c];
#pragma unroll
            for (int r = 0; r < 16; ++r) z += glr[r] * w2[r * 512 + c];
            LA[(size_t)t * 512 + c] = -softplusf_(-z) * (1.f / 16.f);
        }
    }
}

PHASE_FN void ph_gla_chunk(const Params& p, int layer, float* smem, int first_blk) {
    KParams* pp = kparams();
    GU8* wsg_ = (GU8*)pp->ws; asm volatile("" : "+s"(wsg_)); unsigned char* ws_ = (unsigned char*)wsg_;
    int tid_ = threadIdx.x; asm volatile("" : "+v"(tid_)); const int tid = tid_, lane = tid & 63, wv = __builtin_amdgcn_readfirstlane(tid >> 6), q4 = lane >> 4, c16 = lane & 15;
    int ldz_ = 0; asm volatile("" : "+s"(ldz_)); unsigned char* lds = g_smem + ldz_;
    constexpr int SN = 272, ST = 144;
    float* sBc = (float*)lds;
    unsigned char* bQE = lds + 33024;
    unsigned char* bKE = lds + 50432;
    unsigned char* bKD = lds + 67840;
    unsigned char* bVT = lds + 86272;
    unsigned char* bATT = lds + 123136;
    const bf16_t* P = (const bf16_t*)(ws_ + OFF_P); const float* AUX = (const float*)(ws_ + OFF_AUX);
    const float* w2 = as_global(pp->gla_w_gate2) + (size_t)(layer >> 1) * 16 * 512; const float* b2 = as_global(pp->gla_b_gate2) + (layer >> 1) * 512;
    float* sGlr = (float*)(lds + 132352);
    uint4* QEF = (uint4*)(ws_ + OFF_GQE); uint2* OIF = (uint2*)(ws_ + OFF_GOI); uint2* HF = (uint2*)(ws_ + OFF_GH); float* EBL = (float*)(ws_ + OFF_GEBL);
    unsigned* GFLG = (unsigned*)(ws_ + OFF_GFLG) + (layer >> 1) * 128;
    for (int kk = 0; ; ++kk) {
        int cj;
        if ((int)blockIdx.x < first_blk) { if (kk > 0) break; cj = ((int)blockIdx.x & 7) * 8 + ((int)blockIdx.x >> 3); }
        else { cj = (int)blockIdx.x + kk * ((int)gridDim.x - first_blk); if (cj >= 1024) break; }
        const int n = cj >> 3, bh_ = cj & 7, ci = bh_ * 128 + n, b = bh_ >> 2, h = bh_ & 3;
        const int t0 = b * 8192 + n * 64;
        __syncthreads();
        for (int e = tid; e < 1024; e += NTHREADS) sGlr[e] = AUX[(size_t)(t0 + (e >> 4)) * 16 + (e & 15)];
        __syncthreads();
        {
            const int d = tid & 127, c = h * 128 + d;
            float wg[16];
#pragma unroll
            for (int r = 0; r < 16; ++r) wg[r] = w2[r * 512 + c];
            asm volatile("" : "+v"(wg[0]), "+v"(wg[1]), "+v"(wg[2]), "+v"(wg[3]), "+v"(wg[4]), "+v"(wg[5]), "+v"(wg[6]), "+v"(wg[7]), "+v"(wg[8]), "+v"(wg[9]), "+v"(wg[10]), "+v"(wg[11]), "+v"(wg[12]), "+v"(wg[13]), "+v"(wg[14]), "+v"(wg[15]));
            const float bz = b2[c];
            for (int i = tid >> 7; i < 64; i += 4) {
                float z = bz;
#pragma unroll
                for (int r = 0; r < 16; ++r) z += sGlr[i * 16 + r] * wg[r];
                sBc[i * 129 + d] = -softplusf_(-z) * (1.f / 16.f);
            }
        }
        for (int e = tid; e < 64 * 36; e += NTHREADS) ((unsigned*)bATT)[e] = 0u;
        __syncthreads();
        if (tid < 128) { float a = 0.f; for (int i = 0; i < 64; ++i) { a += sBc[i * 129 + tid]; sBc[i * 129 + tid] = a; } }
        __syncthreads();
        {
            const int d = tid & 127, ig = tid >> 7;
            const float bl = sBc[63 * 129 + d];
#pragma unroll
            for (int gg = 0; gg < 2; ++gg) { const int g = ig + 4 * gg;
                float kd8[8];
                unsigned q8[8], k8[8];
#pragma unroll
                for (int r = 0; r < 8; ++r) { q8[r] = P[(size_t)(t0 + g * 8 + r) * LDPB + h * 128 + d]; k8[r] = P[(size_t)(t0 + g * 8 + r) * LDPB + 512 + h * 128 + d]; }
                asm volatile("" : "+v"(q8[0]), "+v"(q8[1]), "+v"(q8[2]), "+v"(q8[3]), "+v"(q8[4]), "+v"(q8[5]), "+v"(q8[6]), "+v"(q8[7]), "+v"(k8[0]), "+v"(k8[1]), "+v"(k8[2]), "+v"(k8[3]), "+v"(k8[4]), "+v"(k8[5]), "+v"(k8[6]), "+v"(k8[7]));
#pragma unroll
                for (int r = 0; r < 8; ++r) { const int i = g * 8 + r;
                    const float bb = sBc[i * 129 + d];
                    const float qf = __uint_as_float(q8[r] << 16), kf = __uint_as_float(k8[r] << 16);
                    *(bf16_t*)(bQE + i * SN + d * 2) = f2bf(qf * SCALE128 * expf(bb));
                    *(bf16_t*)(bKE + i * SN + d * 2) = f2bf(kf * expf(-bb));
                    kd8[r] = kf * expf(bl - bb); }
                *(uint4*)(bKD + d * ST + g * 16) = make_uint4(cvt_pk_bf16(kd8[0], kd8[1]), cvt_pk_bf16(kd8[2], kd8[3]), cvt_pk_bf16(kd8[4], kd8[5]), cvt_pk_bf16(kd8[6], kd8[7]));
            }
            const int dv = tid & 255, hf = tid >> 8;
#pragma unroll
            for (int gg = 0; gg < 4; ++gg) { const int g = hf * 4 + gg;
                unsigned v8[8];
#pragma unroll
                for (int r = 0; r < 8; ++r) v8[r] = P[(size_t)(t0 + g * 8 + r) * LDPB + 1024 + h * 256 + dv];
                asm volatile("" : "+v"(v8[0]), "+v"(v8[1]), "+v"(v8[2]), "+v"(v8[3]), "+v"(v8[4]), "+v"(v8[5]), "+v"(v8[6]), "+v"(v8[7]));
                *(uint4*)(bVT + dv * ST + g * 16) = make_uint4((unsigned)v8[0] | ((unsigned)v8[1] << 16), (unsigned)v8[2] | ((unsigned)v8[3] << 16), (unsigned)v8[4] | ((unsigned)v8[5] << 16), (unsigned)v8[6] | ((unsigned)v8[7] << 16));
            }
        }
        if (tid < 128) st_wt4(EBL + ci * 128 + tid, expf(sBc[63 * 129 + tid]));
        __syncthreads();
        for (int u = wv; u < 10; u += 8) {
            const int ti = (u >= 6) ? 3 : (u >= 3) ? 2 : (u >= 1) ? 1 : 0, tj = u - ((ti * (ti + 1)) >> 1);
            f32x4 acc = (f32x4){0.f, 0.f, 0.f, 0.f};
            acc = mma_lds(bQE, SN, 16 * ti, bKE, SN, 16 * tj, 128, acc, c16, q4);
            const int j = 16 * tj + c16;
#pragma unroll
            for (int r = 0; r < 4; ++r) { const int i = 16 * ti + 4 * q4 + r; *(bf16_t*)(bATT + i * ST + j * 2) = f2bf((j <= i) ? acc[r] : 0.f); }
        }
        for (int x = 0; x < 2; ++x) {
            const int u = wv * 2 + x, ti = u >> 2, a = u & 3;
            const unsigned char* rp = bQE + (16 * ti + c16) * SN;
            const uint2 lo = *(const uint2*)(rp + (32 * a + 4 * q4) * 2), hi = *(const uint2*)(rp + (32 * a + 16 + 4 * q4) * 2);
            st_wt16(QEF + ((size_t)(ci * 4 + ti) * 4 + a) * 64 + lane, make_uint4(lo.x, lo.y, hi.x, hi.y));
        }
        __syncthreads();
#pragma unroll 4
        for (int x = 0; x < 8; ++x) {
            const int u = wv * 8 + x, tdv = u >> 2, ti = u & 3;
            f32x4 acc = (f32x4){0.f, 0.f, 0.f, 0.f};
            acc = mma_lds(bATT, ST, 16 * ti, bVT, ST, 16 * tdv, 64, acc, c16, q4);
            st_wt8(OIF + ((size_t)(ci * 16 + tdv) * 4 + ti) * 64 + lane, pack4(acc));
        }
#pragma unroll 4
        for (int x = 0; x < 16; ++x) {
            const int u = wv * 16 + x, tdv = u >> 3, tdk = u & 7;
            f32x4 acc = (f32x4){0.f, 0.f, 0.f, 0.f};
            acc = mma_lds(bKD, ST, 16 * tdk, bVT, ST, 16 * tdv, 64, acc, c16, q4);
            st_wt8(HF + ((size_t)(ci * 16 + tdv) * 8 + tdk) * 64 + lane, pack4(acc));
        }
        asm volatile("s_waitcnt vmcnt(0)" ::: "memory");
        __syncthreads();
        if (tid == 0) __hip_atomic_fetch_or(GFLG + bh_ * 16 + (n >> 5), 1u << (n & 31), __ATOMIC_RELAXED, __HIP_MEMORY_SCOPE_AGENT);
    }
}

PHASE_FN void ph_gla_scan(const Params& p, int layer, float* smem) {
    KParams* pp = kparams();
    GU8* wsg_ = (GU8*)pp->ws; asm volatile("" : "+s"(wsg_)); unsigned char* ws_ = (unsigned char*)wsg_;
    int tid_ = threadIdx.x; asm volatile("" : "+v"(tid_)); const int tid = tid_, lane = tid & 63, wv = __builtin_amdgcn_readfirstlane(tid >> 6), q4 = lane >> 4, c16 = lane & 15;
    int ldz_ = 0; asm volatile("" : "+s"(ldz_)); unsigned char* lds = g_smem + ldz_;
    constexpr int STG = 29184;
    const unsigned char* QEF = ws_ + OFF_GQE; const unsigned char* HF = ws_ + OFF_GH; const unsigned char* OIF = ws_ + OFF_GOI; const unsigned char* EBL = ws_ + OFF_GEBL;
    float* O = (float*)(ws_ + OFF_O);
    for (int it = blockIdx.x; it < 64; it += gridDim.x) {
        const int bh = it >> 3, pair = it & 7, b = bh >> 2, h = bh & 3;
        __syncthreads();
        if (wv >= 2) {
            const int lt = tid - 128;
            const unsigned char* Qb = QEF + (size_t)bh * 128 * 16384;
            const unsigned char* Hb = HF + (size_t)bh * 128 * 65536 + pair * 8192;
            const unsigned char* Ob = OIF + (size_t)bh * 128 * 32768 + pair * 4096;
            const unsigned char* Lb = EBL + (size_t)bh * 128 * 512;
            const unsigned* gflg = (const unsigned*)(ws_ + OFF_GFLG) + (layer >> 1) * 128 + bh * 16;
            int ndone = 0;
#define GL_NEED(n_) do { const int nn_ = (n_); if (nn_ >= ndone) { unsigned w_; int sp_ = 0; \
                    for (;;) { w_ = __builtin_amdgcn_readfirstlane(__hip_atomic_load(gflg + (nn_ >> 5), __ATOMIC_RELAXED, __HIP_MEMORY_SCOPE_AGENT)); if ((w_ >> (nn_ & 31)) & 1u) break; \
                               __builtin_amdgcn_s_sleep(2); if (++sp_ > (1 << 22)) break; } \
                    int k_ = nn_ + 1; while ((k_ & 31) != 0 && ((w_ >> (k_ & 31)) & 1u)) ++k_; ndone = k_; \
                    __builtin_amdgcn_fence(__ATOMIC_ACQUIRE, "agent"); } } while (0)
            uint4 ra0, ra1, ra2, ra3, ra4, ra5, ra6, rb0, rb1, rb2, rb3, rb4, rb5, rb6, rc0, rc1, rc2, rc3, rc4, rc5, rc6, rd0, rd1, rd2, rd3, rd4, rd5, rd6;
#define GL_LOAD(X, n_) do { GL_NEED(n_); const unsigned char* q_ = Qb + (size_t)(n_) * 16384; const unsigned char* h_ = Hb + (size_t)(n_) * 65536; \
                const unsigned char* o_ = Ob + (size_t)(n_) * 32768; const unsigned char* l_ = Lb + (size_t)(n_) * 512; \
                X##0 = LDC(q_, lt, 1023); X##1 = LDC(q_, lt + 384, 1023); X##2 = LDC(q_, lt + 768, 1023); \
                X##3 = LDC(h_, lt, 511); X##4 = LDC(h_, lt + 384, 511); X##5 = LDC(o_, lt, 255); X##6 = LDC(l_, lt, 31); } while (0)
#define GL_STORE(X, st_) do { unsigned char* sb_ = lds + (st_) * STG; \
                STC(0, lt, 1024, X##0); STC(0, lt + 384, 1024, X##1); STC(0, lt + 768, 1024, X##2); \
                STC(16384, lt, 512, X##3); STC(16384, lt + 384, 512, X##4); STC(24576, lt, 256, X##5); STC(28672, lt, 32, X##6); } while (0)
            GL_LOAD(ra, 0); GL_STORE(ra, 0);
            GL_LOAD(rb, 1); GL_LOAD(rc, 2); GL_LOAD(rd, 3); GL_LOAD(ra, 4);
            __syncthreads();
            for (int n = 0; n < 128; n += 4) {
                GL_STORE(rb, 1); GL_LOAD(rb, CLAMPN(n + 5)); LBAR();
                GL_STORE(rc, 0); GL_LOAD(rc, CLAMPN(n + 6)); LBAR();
                GL_STORE(rd, 1); GL_LOAD(rd, CLAMPN(n + 7)); LBAR();
                if (n + 4 < 128) GL_STORE(ra, 0);
                GL_LOAD(ra, CLAMPN(n + 8)); LBAR();
            }
        } else {
            const int tdv = pair * 2 + wv;
            f32x4 S[8];
#pragma unroll
            for (int t = 0; t < 8; ++t) S[t] = (f32x4){0.f, 0.f, 0.f, 0.f};
            __syncthreads();
            for (int n = 0; n < 128; ++n) {
                const unsigned char* base = lds + (n & 1) * STG;
                const unsigned char* Qf = base + lane * 16, *Hf = base + 16384 + wv * 4096 + lane * 8, *Of = base + 24576 + wv * 2048 + lane * 8, *Lf = base + 28672 + q4 * 16;
                bf16x8 Sb[4];
#pragma unroll
                for (int a = 0; a < 4; ++a) { union { uint4 u; bf16x8 v; } cv; const uint2 lo = pack4(S[2 * a]), hi = pack4(S[2 * a + 1]); cv.u.x = lo.x; cv.u.y = lo.y; cv.u.z = hi.x; cv.u.w = hi.y; Sb[a] = cv.v; }
                const int t0 = b * 8192 + n * 64;
                f32x4 oa[4];
                uint2 o4[4];
#pragma unroll
                for (int ti = 0; ti < 4; ++ti) o4[ti] = *(const uint2*)(Of + ti * 512);
#pragma unroll
                for (int hf = 0; hf < 2; ++hf) {
                    bf16x8 qf[8];
#pragma unroll
                    for (int tt = 0; tt < 2; ++tt)
#pragma unroll
                        for (int a = 0; a < 4; ++a) qf[tt * 4 + a] = *(const bf16x8*)(Qf + ((hf * 2 + tt) * 4 + a) * 1024);
                    asm volatile("" : "+v"(qf[0]), "+v"(qf[1]), "+v"(qf[2]), "+v"(qf[3]), "+v"(qf[4]), "+v"(qf[5]), "+v"(qf[6]), "+v"(qf[7]));
                    oa[hf * 2] = unpack4(o4[hf * 2]); oa[hf * 2 + 1] = unpack4(o4[hf * 2 + 1]);
#pragma unroll
                    for (int a = 0; a < 4; ++a)
#pragma unroll
                        for (int tt = 0; tt < 2; ++tt) oa[hf * 2 + tt] = __builtin_amdgcn_mfma_f32_16x16x32_bf16(qf[tt * 4 + a], Sb[a], oa[hf * 2 + tt], 0, 0, 0);
                }
                {
                    f32x4 lam[8]; uint2 h8[8];
#pragma unroll
                    for (int t = 0; t < 8; ++t) { lam[t] = *(const f32x4*)(Lf + t * 64); h8[t] = *(const uint2*)(Hf + t * 512); }
                    asm volatile("" : "+v"(lam[0]), "+v"(lam[1]), "+v"(lam[2]), "+v"(lam[3]), "+v"(lam[4]), "+v"(lam[5]), "+v"(lam[6]), "+v"(lam[7]));
#pragma unroll
                    for (int ti = 0; ti < 4; ++ti) {
                        float* op = O + (size_t)(t0 + 16 * ti + 4 * q4) * 1024 + h * 256 + 16 * tdv + c16;
                        op[0] = oa[ti][0]; op[1024] = oa[ti][1]; op[2048] = oa[ti][2]; op[3072] = oa[ti][3]; }
#pragma unroll
                    for (int t = 0; t < 8; ++t) S[t] = S[t] * lam[t] + unpack4(h8[t]);
                }
                LBAR();
            }
        }
    }
}

PHASE_FN void ph_gla_out(const Params& p, int layer) {
    KParams* pp = kparams();
    GU8* wsg_ = (GU8*)pp->ws; asm volatile("" : "+s"(wsg_)); unsigned char* ws_ = (unsigned char*)wsg_;
    int tid_ = threadIdx.x; asm volatile("" : "+v"(tid_)); const int tid = tid_, lane = tid & 63, wv = tid >> 6;
    const float* O = (const float*)(ws_ + OFF_O); const bf16_t* P = (const bf16_t*)(ws_ + OFF_P); bf16_t* OB = (bf16_t*)(ws_ + OFF_OB);
    const float* onw = as_global(pp->gla_out_norm) + (layer >> 1) * 256;
    const float4 w = *(const float4*)(onw + lane * 4);
    const int tstep = gridDim.x * 8;
    for (int t = blockIdx.x * 8 + wv; t < NT; t += 2 * tstep) {
        const int tB = (t + tstep < NT) ? t + tstep : t; const bool hasB = t + tstep < NT;
        float4 oa[2][4]; uint2 za[2][4];
#pragma unroll
        for (int u = 0; u < 2; ++u) { const int tt = u ? tB : t;
#pragma unroll
            for (int h = 0; h < 4; ++h) { oa[u][h] = *(const float4*)(O + (size_t)tt * 1024 + h * 256 + lane * 4); za[u][h] = *(const uint2*)(P + (size_t)tt * LDPB + 2048 + h * 256 + lane * 4); } }
        asm volatile("" ::: "memory");
#pragma unroll
        for (int u = 0; u < 2; ++u) { const int tt = u ? tB : t;
            if (u == 1 && !hasB) break;
#pragma unroll
            for (int h = 0; h < 4; ++h) {
                const float4 o = oa[u][h];
                const float ss = wave_sum(o.x * o.x + o.y * o.y + o.z * o.z + o.w * o.w);
                const float r = rsqrtf(ss * (1.f / 256.f) + EPS);
                const f32x4 z = unpack4(za[u][h]);
                f32x4 ov; ov[0] = o.x * r * w.x * siluf_(z[0]); ov[1] = o.y * r * w.y * siluf_(z[1]); ov[2] = o.z * r * w.z * siluf_(z[2]); ov[3] = o.w * r * w.w * siluf_(z[3]);
                *(uint2*)(OB + (size_t)tt * 1024 + h * 256 + lane * 4) = pack4(ov); } }
    }
}

template <int PH>
__device__ __forceinline__ void run_phase(const Params& p, int layer, float* smem) {
    if (PH == PH_PROLOGUE) { ph_prologue(p, smem); ph_conv_dense(p, smem); }
    else if (PH == PH_NORM_MIX) ph_rows(p, layer, 0, smem);
    else if (PH == PH_GEMM_IN_EVEN) ph_gemm_in(p, layer, true, smem);
    else if (PH == PH_EVEN_TOK) { ph_even_tok(p, layer, smem); ph_gdn_chunk(p, layer, smem); if (DUP_MASK & 8192) ph_gdn_chunk(p, layer, smem); if (DUP_MASK & 16384) ph_even_tok(p, layer, smem); }
    else if (PH == PH_GDN_CHUNK) ph_gdn_chunk(p, layer, smem);
    else if (PH == PH_GDN_SCAN) { ph_gdn_scan(p, smem); ph_conv_exp(p, layer, smem, 32, 0); ph_dsa_topk(p, layer, smem); }
    else if (PH == PH_DSA_TOPK) ph_dsa_topk(p, layer, smem);
    else if (PH == PH_DSA_ATTN) { ph_dsa_attn(p, smem); ph_gdn_out(p, layer); if (DUP_MASK & 32768) ph_dsa_attn(p, smem); }
    else if (PH == PH_GDN_OUT) ph_gdn_out(p, layer);
    else if (PH == PH_GEMM_OUT) ph_gemm_out(p, layer, smem);
    else if (PH == PH_NORM_FFN) ph_norm_ffn(p, layer);
    else if (PH == PH_MOE1) ph_moe(p, layer, 0, smem);
    else if (PH == PH_MOE2) ph_moe(p, layer, 1, smem);
    else if (PH == PH_GEMM_IN_ODD) ph_gemm_in(p, layer, false, smem);
    else if (PH == PH_GLA_TOK) ph_gla_tok(p, layer);
    else if (PH == PH_GLA_CHUNK) ph_gla_chunk(p, layer, smem, 0);
    else if (PH == PH_GLA_SCAN) { if (gridDim.x >= 128) ph_gla_chunk(p, layer, smem, 64); ph_gla_scan(p, layer, smem); ph_conv_exp(p, layer, smem, 64, (gridDim.x >= 128) ? 20 : 0); }
    else if (PH == PH_GLA_OUT) ph_gla_out(p, layer);
    else if (PH == PH_FINAL) ph_rows(p, 0, 1, smem);
}

#if MK_MULTI
template <int PH>
__global__ void __launch_bounds__(NTHREADS, 2) k_phase(Params p, int layer) {
    run_phase<PH>(p, layer, (float*)g_smem);
}
#else
__global__ void __launch_bounds__(NTHREADS, 2) k_mega(Params p) {
    float* smem = (float*)g_smem;
    volatile LAS unsigned* xbw = (volatile LAS unsigned*)(LAS unsigned char*)(g_smem + LDS_BYTES - 16);
    if (threadIdx.x == 0) { xbw[0] = 0u; xbw[1] = 0u; xbw[2] = 0u; xbw[3] = 0u; }
    __syncthreads();
    XcdBarrier bar = xcd_barrier_post((unsigned*)(p.ws + OFF_BAR), xbw);
#define BAR() do { XcdBarrier bb_ = bar; asm volatile("" : "+s"(bb_.x)); { __attribute__((address_space(1))) unsigned* gb_ = (__attribute__((address_space(1))) unsigned*)bb_.bar; asm volatile("" : "+s"(gb_)); bb_.bar = (unsigned*)gb_; } xcd_barrier(bb_); } while (0)
    run_phase<PH_PROLOGUE>(p, 0, smem); BAR(); if (DUP_MASK & 4096) { run_phase<PH_PROLOGUE>(p, 0, smem); BAR(); }
    for (int lp = 0; lp < 2; ++lp) {
        const int le = 2 * lp, lo = 2 * lp + 1;
        run_phase<PH_NORM_MIX>(p, le, smem); BAR();
        run_phase<PH_GEMM_IN_EVEN>(p, le, smem); BAR(); if (DUP_MASK & 1) { run_phase<PH_GEMM_IN_EVEN>(p, le, smem); BAR(); }
        run_phase<PH_EVEN_TOK>(p, le, smem); BAR(); if (DUP_MASK & 2) { run_phase<PH_EVEN_TOK>(p, le, smem); BAR(); }
        run_phase<PH_GDN_SCAN>(p, le, smem); BAR(); if (DUP_MASK & 8) { run_phase<PH_GDN_SCAN>(p, le, smem); BAR(); } if (DUP_MASK & 262144) { run_phase<PH_DSA_TOPK>(p, le + 1, smem); BAR(); }
        run_phase<PH_DSA_ATTN>(p, le, smem); BAR(); if (DUP_MASK & 32) { run_phase<PH_DSA_ATTN>(p, le, smem); BAR(); }
        run_phase<PH_GEMM_OUT>(p, le, smem); BAR();
        run_phase<PH_NORM_FFN>(p, le, smem); BAR();
        run_phase<PH_MOE1>(p, le, smem);
        run_phase<PH_MOE2>(p, le, smem); BAR(); if (DUP_MASK & 128) { run_phase<PH_MOE2>(p, le, smem); BAR(); }
        run_phase<PH_NORM_MIX>(p, lo, smem); BAR();
        run_phase<PH_GEMM_IN_ODD>(p, lo, smem); BAR(); if (DUP_MASK & 256) { run_phase<PH_GEMM_IN_ODD>(p, lo, smem); BAR(); }
        if (gridDim.x < 128) { run_phase<PH_GLA_CHUNK>(p, lo, smem); BAR(); }
        run_phase<PH_GLA_SCAN>(p, lo, smem); BAR();
        run_phase<PH_GLA_OUT>(p, lo, smem); BAR();
        run_phase<PH_GEMM_OUT>(p, lo, smem); BAR();
        run_phase<PH_NORM_FFN>(p, lo, smem); BAR();
        run_phase<PH_MOE1>(p, lo, smem);
        run_phase<PH_MOE2>(p, lo, smem); BAR(); if (DUP_MASK & 128) { run_phase<PH_MOE2>(p, lo, smem); BAR(); }
    }
    for (int xb = 0; xb < EXTRA_BARS; ++xb) BAR();
    run_phase<PH_FINAL>(p, 0, smem);
}
#endif

}

#if MK_MULTI
template <int PH>
static void launch_phase(const Params& p, int layer, hipStream_t stream) {
    static bool attr_set = false;
    if (!attr_set) { hipFuncSetAttribute((const void*)k_phase<PH>, hipFuncAttributeMaxDynamicSharedMemorySize, (int)LDS_BYTES); attr_set = true; }
    hipLaunchKernelGGL((k_phase<PH>), dim3(256), dim3(NTHREADS), LDS_BYTES, stream, p, layer);
}
#endif

extern "C" void kernel_launch(void* const* d_in, const int* in_sizes, int n_in, void* d_out, int out_size, void* d_ws, size_t ws_size, hipStream_t stream) {
    (void)in_sizes; (void)n_in; (void)out_size;
    if (ws_size < WS_NEEDED) { fprintf(stderr, "workspace too small: %zu < %zu\n", ws_size, (size_t)WS_NEEDED); return; }
    Params p{};
    p.x = (const float*)d_in[0]; p.c = (const float*)d_in[1]; p.pos = (const int*)d_in[2]; p.ada_w = (const float*)d_in[3]; p.ada_b = (const float*)d_in[4];
    p.norm_mix = (const float*)d_in[5]; p.norm_ffn = (const float*)d_in[6]; p.even_w_in = (const float*)d_in[7]; p.conv_w = (const float*)d_in[8];
    p.a_log = (const float*)d_in[9]; p.dt_bias = (const float*)d_in[10]; p.gdn_out_norm = (const float*)d_in[11]; p.even_w_out = (const float*)d_in[12];
    p.gla_w_in = (const float*)d_in[13]; p.gla_w_gate2 = (const float*)d_in[14]; p.gla_b_gate2 = (const float*)d_in[15]; p.gla_out_norm = (const float*)d_in[16]; p.gla_w_out = (const float*)d_in[17];
    p.rg_w = (const float*)d_in[18]; p.rg_b = (const float*)d_in[19]; p.re_w = (const float*)d_in[20]; p.re_b = (const float*)d_in[21];
    p.w1 = (const float*)d_in[22]; p.w3 = (const float*)d_in[23]; p.w2 = (const float*)d_in[24]; p.final_norm = (const float*)d_in[25];
    p.X = (float*)d_out; p.ws = (unsigned char*)d_ws;
    p.rA = pow(10000.0, -2.0 / 128.0); p.rI = pow(10000.0, -2.0 / 64.0);
    hipMemsetAsync(d_ws, 0, ZERO_BYTES, stream);
#if MK_MULTI
    launch_phase<PH_PROLOGUE>(p, 0, stream);
    for (int lp = 0; lp < 2; ++lp) {
        const int le = 2 * lp, lo = 2 * lp + 1;
        launch_phase<PH_NORM_MIX>(p, le, stream);
        launch_phase<PH_GEMM_IN_EVEN>(p, le, stream);
        launch_phase<PH_EVEN_TOK>(p, le, stream);
        launch_phase<PH_GDN_SCAN>(p, le, stream);
        launch_phase<PH_DSA_ATTN>(p, le, stream);
        launch_phase<PH_GEMM_OUT>(p, le, stream);
        launch_phase<PH_NORM_FFN>(p, le, stream);
        launch_phase<PH_MOE1>(p, le, stream);
        launch_phase<PH_MOE2>(p, le, stream);
        launch_phase<PH_NORM_MIX>(p, lo, stream);
        launch_phase<PH_GEMM_IN_ODD>(p, lo, stream);
        launch_phase<PH_GLA_CHUNK>(p, lo, stream);
        launch_phase<PH_GLA_SCAN>(p, lo, stream);
        launch_phase<PH_GLA_OUT>(p, lo, stream);
        launch_phase<PH_GEMM_OUT>(p, lo, stream);
        launch_phase<PH_NORM_FFN>(p, lo, stream);
        launch_phase<PH_MOE1>(p, lo, stream);
        launch_phase<PH_MOE2>(p, lo, stream);
    }
    launch_phase<PH_FINAL>(p, 0, stream);
#else
    static int grid = 0;
    if (!grid) {
        int dev = 0, cus = 0, per_cu = 0;
        hipGetDevice(&dev);
        hipDeviceGetAttribute(&cus, hipDeviceAttributeMultiprocessorCount, dev);
        hipFuncSetAttribute((const void*)k_mega, hipFuncAttributeMaxDynamicSharedMemorySize, (int)LDS_BYTES);
        hipOccupancyMaxActiveBlocksPerMultiprocessor(&per_cu, k_mega, NTHREADS, LDS_BYTES);
        if (cus <= 0) cus = 256;
        grid = cus * (per_cu < 1 ? 1 : 1);
    }
    hipLaunchKernelGGL(k_mega, dim3(grid), dim3(NTHREADS), LDS_BYTES, stream, p);
#endif
}
```
